# Optimizing an MI355X kernel written in HIP

```python
import math
import jax, jax.numpy as jnp
from jax import lax
import numpy as np


D_MODEL = 1024
BATCH = 4
SEQ = 8192
DEPTH = 4
DEC_BATCH = 16
DEC_SEQ = 32
PAST_LEN = 2048

CHUNK = 64
N_ATT = 8
ATT_HD = 64
ATT_W = N_ATT * 2 * ATT_HD
N_HG = 8
HG_DK = 128
HG_DV = 128
HG_KW = N_HG * HG_DK
HG_VW = N_HG * HG_DV
D_FF = 2816
N_ADA = 9
Q_BLOCK = 128
MACARON_WEIGHT = 0.5
EPS = 1e-6
MASK_VALUE = -1e30
TINY = 1e-30
IN_SPLIT_POINTS = (ATT_W, 2 * ATT_W, 3 * ATT_W,
                   3 * ATT_W + HG_KW, 3 * ATT_W + 2 * HG_KW,
                   3 * ATT_W + 2 * HG_KW + HG_VW, 3 * ATT_W + 2 * HG_KW + 2 * HG_VW,
                   3 * ATT_W + 2 * HG_KW + 2 * HG_VW + D_MODEL)
D_IN = 3 * ATT_W + 2 * HG_KW + 2 * HG_VW + 2 * D_MODEL

kernel_name = 'hybrid_diffattn_hgrn2_macaron_adaln_stream_step'


def rmsnorm(x, g):
    xf = x.astype(jnp.float32)
    y = xf * lax.rsqrt(jnp.mean(xf * xf, axis=-1, keepdims=True) + EPS)
    return (y * g.astype(jnp.float32)).astype(x.dtype)


def swiglu(h, w_gu, w_d):
    gate, up = jnp.split(h @ w_gu, 2, axis=-1)
    return (jax.nn.silu(gate) * up) @ w_d


def diff_attention(q, k, v, q_pos, k_pos, lam):
    B, Tq = q.shape[:2]
    kf = k.astype(jnp.float32)
    vf = v.astype(jnp.float32)

    def block(args):
        qb, pb = args
        s = jnp.einsum('bqhmd,bkhmd->bhmqk', qb.astype(jnp.float32), kf) * (ATT_HD ** -0.5)
        visible = k_pos[None, :] < ((pb // CHUNK + 1) * CHUNK)[:, None]
        p = jax.nn.softmax(jnp.where(visible, s, MASK_VALUE), axis=-1)
        a = p[:, :, 0] - lam * p[:, :, 1]
        return jnp.einsum('bhqk,bkhe->bqhe', a, vf)

    if Tq > Q_BLOCK:
        nb = Tq // Q_BLOCK
        qb = jnp.moveaxis(q.reshape(B, nb, Q_BLOCK, *q.shape[2:]), 1, 0)
        pb = q_pos.reshape(nb, Q_BLOCK)
        o = lax.map(block, (qb, pb))
        return jnp.moveaxis(o, 0, 1).reshape(B, Tq, *o.shape[3:])
    return block((q, q_pos))


def hgrn2_chunked(q, k, v, logf, s0):
    B, T = q.shape[:2]
    L = min(CHUNK, T)
    n = T // L

    def to_chunks(a):
        return jnp.moveaxis(a.reshape(B, n, L, *a.shape[2:]), 1, 0)

    causal = jnp.tril(jnp.ones((L, L), dtype=bool))[None, :, :, None, None]

    def step(S, inp):
        qc, kc, vc, lfc = inp
        b = lax.cumsum(lfc, axis=1)
        b_last = b[:, -1]
        o_inter = jnp.einsum('bthk,bhkv->bthv', qc * jnp.exp(b), S)
        rel = b[:, :, None] - b[:, None, :]
        decay = jnp.where(causal, jnp.exp(jnp.where(causal, rel, 0.0)), 0.0)
        A = jnp.einsum('bthk,btshk,bshk->bhts', qc, decay, kc)
        o_intra = jnp.einsum('bhts,bshv->bthv', A, vc)
        S_new = S * jnp.exp(b_last)[..., None] + jnp.einsum(
            'bshk,bshv->bhkv', kc * jnp.exp(b_last[:, None] - b), vc)
        return S_new, o_inter + o_intra

    s_fin, o = lax.scan(step, s0, (to_chunks(q), to_chunks(k), to_chunks(v), to_chunks(logf)))
    o = jnp.moveaxis(o, 0, 1).reshape(B, T, *o.shape[3:])
    return o, s_fin


def trunk(x, c, q_pos, k_pos, past_k, past_v, past_s, p):
    B, T, _ = x.shape
    f32 = jnp.float32
    lb_sm = jax.nn.softmax(p['hg_lb_logits'].astype(f32), axis=0)
    lb_all = lax.cumsum(lb_sm, axis=0) - lb_sm[0]
    c_act = jax.nn.silu(c.astype(f32))
    new_k, new_v, new_s = [], [], []
    for l in range(DEPTH):
        m = (c_act @ p['w_ada'][l].astype(f32) + p['b_ada'][l].astype(f32)).astype(x.dtype)
        m = m.reshape(B, N_ADA, 1, D_MODEL)
        sh1, sc1, g1, sh2, sc2, g2, sh3, sc3, g3 = [m[:, i] for i in range(N_ADA)]

        h = rmsnorm(x, p['g_ffn1'][l]) * (1 + sc1) + sh1
        x = x + MACARON_WEIGHT * g1 * swiglu(h, p['w_ffn1_gu'][l], p['w_ffn1_d'][l])

        u = rmsnorm(x, p['g_mix'][l]) * (1 + sc2) + sh2
        z = u @ p['w_in'][l]
        zq, zk, zv, hq, hf, hi, hg, za, zh = jnp.split(z, IN_SPLIT_POINTS, axis=-1)

        q = zq.reshape(B, T, N_ATT, 2, ATT_HD)
        k_rows = zk.reshape(B, T, N_ATT, 2 * ATT_HD)
        v_rows = zv.reshape(B, T, N_ATT, 2 * ATT_HD)
        new_k.append(k_rows)
        new_v.append(v_rows)
        if past_k is None:
            k_all, v_all = k_rows, v_rows
        else:
            k_all = jnp.concatenate([past_k[l].astype(k_rows.dtype), k_rows], axis=1)
            v_all = jnp.concatenate([past_v[l].astype(v_rows.dtype), v_rows], axis=1)
        lam_init = 0.8 - 0.6 * math.exp(-0.3 * l)
        lp = p['att_lambda'][l].astype(f32)
        lam = jnp.exp(jnp.sum(lp[0] * lp[1])) - jnp.exp(jnp.sum(lp[2] * lp[3])) + lam_init
        o_att = diff_attention(q, k_all.reshape(B, -1, N_ATT, 2, ATT_HD), v_all, q_pos, k_pos, lam)
        o_att = rmsnorm(o_att, p['g_att_sub'][l]) * (1.0 - lam_init)
        o_att = o_att.reshape(B, T, ATT_W).astype(x.dtype)

        lb = lb_all[l].reshape(N_HG, HG_DK)
        fr = hf.astype(f32).reshape(B, T, N_HG, HG_DK)
        sig = jax.nn.sigmoid(fr)
        f_gate = lb + (1.0 - lb) * sig
        logf = jnp.log(jnp.maximum(f_gate, TINY))
        kk = (1.0 - lb) * (1.0 - sig)
        qq = jax.nn.silu(hq.astype(f32)).reshape(B, T, N_HG, HG_DK)
        vv = hi.astype(f32).reshape(B, T, N_HG, HG_DV)
        s0 = jnp.zeros((B, N_HG, HG_DK, HG_DV), f32) if past_s is None else past_s[l].astype(f32)
        o_h, s_fin = hgrn2_chunked(qq, kk, vv, logf, s0)
        new_s.append(s_fin.astype(x.dtype))
        o_h = rmsnorm(o_h, p['g_hg_norm'][l]) * jax.nn.silu(hg.astype(f32).reshape(B, T, N_HG, HG_DV))
        o_h = o_h.reshape(B, T, HG_VW).astype(x.dtype)

        merged = (jax.nn.sigmoid(za) * (o_att @ p['w_br_att'][l])
                  + jax.nn.sigmoid(zh) * (o_h @ p['w_br_hg'][l]))
        x = x + g2 * (merged @ p['w_out'][l])

        h = rmsnorm(x, p['g_ffn2'][l]) * (1 + sc3) + sh3
        x = x + MACARON_WEIGHT * g3 * swiglu(h, p['w_ffn2_gu'][l], p['w_ffn2_d'][l])
    y = rmsnorm(x, p['g_final'])
    return y, jnp.stack(new_k), jnp.stack(new_v), jnp.stack(new_s)


def setup_inputs(seed: int = 0) -> dict:
    key = jax.random.key(seed)
    ks = jax.random.split(key, 32)
    f32 = jnp.float32

    def nrm(k, shape, scale):
        return jax.random.normal(k, shape, f32) * scale

    def gain(k, shape):
        return 1.0 + 0.02 * jax.random.normal(k, shape, f32)

    return {
        'x_prompt': nrm(ks[0], (BATCH, SEQ, D_MODEL), 1.0),
        'x_sample': nrm(ks[1], (DEC_BATCH, DEC_SEQ, D_MODEL), 1.0),
        'cache_k': nrm(ks[2], (DEPTH, DEC_BATCH, PAST_LEN, N_ATT, 2 * ATT_HD), 1.0),
        'cache_v': nrm(ks[3], (DEPTH, DEC_BATCH, PAST_LEN, N_ATT, 2 * ATT_HD), 1.0),
        'state_hgrn': nrm(ks[4], (DEPTH, DEC_BATCH, N_HG, HG_DK, HG_DV), 0.5),
        'c_prompt': nrm(ks[5], (BATCH, D_MODEL), 1.0),
        'c_sample': nrm(ks[6], (DEC_BATCH, D_MODEL), 1.0),
        'w_ada': nrm(ks[7], (DEPTH, D_MODEL, N_ADA * D_MODEL), 0.5 * D_MODEL ** -0.5),
        'b_ada': nrm(ks[8], (DEPTH, N_ADA * D_MODEL), 0.01),
        'g_ffn1': gain(ks[9], (DEPTH, D_MODEL)),
        'w_ffn1_gu': nrm(ks[10], (DEPTH, D_MODEL, 2 * D_FF), D_MODEL ** -0.5),
        'w_ffn1_d': nrm(ks[11], (DEPTH, D_FF, D_MODEL), D_FF ** -0.5),
        'g_mix': gain(ks[12], (DEPTH, D_MODEL)),
        'w_in': nrm(ks[13], (DEPTH, D_MODEL, D_IN), D_MODEL ** -0.5),
        'att_lambda': nrm(ks[14], (DEPTH, 4, ATT_HD), 0.1),
        'g_att_sub': gain(ks[15], (DEPTH, 2 * ATT_HD)),
        'hg_lb_logits': nrm(ks[16], (DEPTH, HG_KW), 0.5),
        'g_hg_norm': gain(ks[17], (DEPTH, HG_DV)),
        'w_br_att': nrm(ks[18], (DEPTH, ATT_W, D_MODEL), ATT_W ** -0.5),
        'w_br_hg': nrm(ks[19], (DEPTH, HG_VW, D_MODEL), HG_VW ** -0.5),
        'w_out': nrm(ks[20], (DEPTH, D_MODEL, D_MODEL), D_MODEL ** -0.5),
        'g_ffn2': gain(ks[21], (DEPTH, D_MODEL)),
        'w_ffn2_gu': nrm(ks[22], (DEPTH, D_MODEL, 2 * D_FF), D_MODEL ** -0.5),
        'w_ffn2_d': nrm(ks[23], (DEPTH, D_FF, D_MODEL), D_FF ** -0.5),
        'g_final': gain(ks[24], (D_MODEL,)),
    }


def reference(x_prompt, x_sample, cache_k, cache_v, state_hgrn, c_prompt, c_sample,
              w_ada, b_ada, g_ffn1, w_ffn1_gu, w_ffn1_d, g_mix, w_in, att_lambda, g_att_sub,
              hg_lb_logits, g_hg_norm, w_br_att, w_br_hg, w_out, g_ffn2, w_ffn2_gu, w_ffn2_d,
              g_final):
    params = dict(w_ada=w_ada, b_ada=b_ada, g_ffn1=g_ffn1, w_ffn1_gu=w_ffn1_gu, w_ffn1_d=w_ffn1_d,
                  g_mix=g_mix, w_in=w_in, att_lambda=att_lambda, g_att_sub=g_att_sub,
                  hg_lb_logits=hg_lb_logits, g_hg_norm=g_hg_norm, w_br_att=w_br_att,
                  w_br_hg=w_br_hg, w_out=w_out, g_ffn2=g_ffn2, w_ffn2_gu=w_ffn2_gu,
                  w_ffn2_d=w_ffn2_d, g_final=g_final)
    t_p = x_prompt.shape[1]
    pos_p = jnp.arange(t_p, dtype=jnp.int32)
    y_prompt, k_prompt, v_prompt, s_prompt = trunk(
        x_prompt, c_prompt, pos_p, pos_p, None, None, None, params)
    past = cache_k.shape[2]
    t_s = x_sample.shape[1]
    pos_s = past + jnp.arange(t_s, dtype=jnp.int32)
    kpos_s = jnp.arange(past + t_s, dtype=jnp.int32)
    y_sample, k_sample, v_sample, s_sample = trunk(
        x_sample, c_sample, pos_s, kpos_s, cache_k, cache_v, state_hgrn, params)
    return (y_prompt, y_sample, k_prompt, v_prompt, s_prompt, k_sample, v_sample, s_sample)
```

```cpp
#include <hip/hip_runtime.h>
#include <hip/hip_bf16.h>
#include <cstdio>
#include <cstdint>
#include <cmath>
__device__ __forceinline__ int opaque_tid() { int t = (int)threadIdx.x; asm volatile("" : "+v"(t)); return t; }
__device__ __forceinline__ int opaque_bid() { int b = (int)blockIdx.x; asm volatile("" : "+s"(b)); return b; }
namespace pg8 {
#define PG8_LAS __attribute__((address_space(3)))
typedef unsigned short bf16_t;
typedef short bf16x8 __attribute__((ext_vector_type(8)));
typedef float f32x4 __attribute__((ext_vector_type(4)));
typedef unsigned u32x4 __attribute__((ext_vector_type(4)));
constexpr int BM = 256, BK = 64, HALF = 128, HTB = HALF * BK * 2  , STAGE_BYTES = 8 * HTB, NXCD = 8, WGM = 8;

__host__ __device__ __forceinline__ int lds_byte(int r, int c) { const int st = (r >> 4) * 2 + (c >> 5), rr = r & 15, cc = c & 31, ob = rr * 64 + cc * 2; return st * 1024 + (ob ^ (((ob >> 9) & 1) << 5)); }
__host__ __device__ __forceinline__ void stage_rc(int b, int& R, int& C) { const int st = b / 1024, sb = b % 1024, swz = sb ^ (((sb >> 9) & 1) << 5); R = (st >> 1) * 16 + swz / 64; C = (st & 1) * 32 + (swz % 64) / 2; }
__host__ __device__ __forceinline__ int perm32(int rho) { const int n = rho >> 4, i = rho & 15; return 8 * (i >> 2) + 4 * n + (i & 3); }

struct Unit { int pm, pn; };
struct Gemm { const bf16_t* A; const bf16_t* Bt; int M, N, K; };

struct StaticOrder {
    int nM, nN, nwg, G, c;
    __host__ __device__ void init(int M, int N, int G_, int c_) { nM = M / BM; nN = N / BM; nwg = nM * nN; G = G_; c = c_; }
    __host__ __device__ bool next(int i, Unit& u) const {
        const long L = (long)i * G + c; if (L >= nwg) return false;
        int wgid = (int)L; { const int q = nwg / NXCD, r = nwg % NXCD, xcd = wgid % NXCD, off = wgid / NXCD; wgid = (xcd < r ? xcd * (q + 1) : r * (q + 1) + (xcd - r) * q) + off; }
        const int nig = WGM * nN, gid = wgid / nig, fm = gid * WGM, gsz = (nM - fm) < WGM ? (nM - fm) : WGM;
        u.pm = fm + ((wgid % nig) % gsz); u.pn = (wgid % nig) / gsz; return true;
    }
    __device__ __forceinline__ void a_ready(const Unit&) const {}
    __device__ __forceinline__ void done(const Unit&) const {}
};

__device__ __forceinline__ unsigned cvt_pk_bf16(float lo, float hi) { unsigned r; asm volatile("v_cvt_pk_bf16_f32 %0, %1, %2" : "=v"(r) : "v"(lo), "v"(hi)); return r; }
__device__ __forceinline__ float bf_lo(unsigned w) { return __builtin_bit_cast(float, w << 16); }
__device__ __forceinline__ float bf_hi(unsigned w) { return __builtin_bit_cast(float, w & 0xffff0000u); }
__device__ __forceinline__ float sigmoid_f(float x) { return __builtin_amdgcn_rcpf(1.f + __expf(-x)); }
__device__ __forceinline__ float silu_f(float x) { return x * sigmoid_f(x); }
__device__ __forceinline__ void store8bf(bf16_t* p, f32x4 a, f32x4 b) { u32x4 w; w.x = cvt_pk_bf16(a[0], a[1]); w.y = cvt_pk_bf16(a[2], a[3]); w.z = cvt_pk_bf16(b[0], b[1]); w.w = cvt_pk_bf16(b[2], b[3]); *(u32x4*)p = w; }
__device__ __forceinline__ int row_seq(int row) { return row < 32768 ? (row >> 13) : 4 + ((row - 32768) >> 5); }

struct EpiSwiglu {
    static constexpr bool PERM = true, AFTER_DRAIN = false;
    bf16_t* O;
    __device__ __forceinline__ void operator()(const f32x4 (&acc)[2][2][4][2], const Unit& u, int wr, int wc, int fr, int fq) const {
        const int row0 = u.pm * BM + wr * 64 + fr, col0 = u.pn * HALF + wc * 32 + 8 * fq;
#pragma unroll
        for (int ai = 0; ai < 2; ++ai)
#pragma unroll
            for (int m = 0; m < 4; ++m) {
                f32x4 g0 = acc[ai][0][m][0], g1 = acc[ai][0][m][1]; const f32x4 u0 = acc[ai][1][m][0], u1 = acc[ai][1][m][1];
#pragma unroll
                for (int i = 0; i < 4; ++i) { g0[i] = silu_f(g0[i]) * u0[i]; g1[i] = silu_f(g1[i]) * u1[i]; }
                store8bf(O + (size_t)(row0 + ai * HALF + m * 16) * 2816 + col0, g0, g1); asm volatile("" ::: "memory");
            }
    }
};

struct EpiResid {
    static constexpr bool PERM = true, AFTER_DRAIN = false;
    float* X; const float* gate; float coef;
    __device__ __forceinline__ void operator()(const f32x4 (&acc)[2][2][4][2], const Unit& u, int wr, int wc, int fr, int fq) const {
#pragma unroll
        for (int ai = 0; ai < 2; ++ai)
#pragma unroll
            for (int m = 0; m < 4; ++m) {
                const int row = u.pm * BM + ai * HALF + wr * 64 + m * 16 + fr; const float* gp = gate + (size_t)row_seq(row) * 9216;
#pragma unroll
                for (int bj = 0; bj < 2; ++bj) { const int col = u.pn * BM + bj * HALF + wc * 32 + 8 * fq;
#pragma unroll
                    for (int n = 0; n < 2; ++n) { const f32x4 g = *(const f32x4*)(gp + col + 4 * n); f32x4* xp = (f32x4*)(X + (size_t)row * 1024 + col + 4 * n); const f32x4 xv = *xp; *xp = xv + (g * coef) * acc[ai][bj][m][n]; } asm volatile("" ::: "memory"); }
            }
    }
};

struct EpiWin {
    static constexpr bool PERM = true, AFTER_DRAIN = false;
    unsigned char* ws; float* out; int l; float qscale;
    static constexpr size_t MiB_ = 1u << 20;
    static constexpr size_t O_Q = 435 * MiB_, O_K = 500 * MiB_, O_V = 565 * MiB_, O_QQ = 630 * MiB_, O_KK = 695 * MiB_, O_VV = 760 * MiB_, O_HGS = 825 * MiB_, O_SZA = 890 * MiB_, O_SZH = 955 * MiB_, O_LOGF = 1020 * MiB_, O_LB = 4 * MiB_;
    static constexpr size_t OK_P_ = 34078720, OV_P_ = 168296448, OK_S_ = 304611328, OV_S_ = 306708480;
    __device__ __forceinline__ void operator()(const f32x4 (&acc)[2][2][4][2], const Unit& u, int wr, int wc, int fr, int fq) const {
        const int seg = u.pn >> 2, cb = (u.pn & 3) * BM + wc * 32 + 8 * fq, row0 = u.pm * BM + wr * 64 + fr;
        const size_t boff = seg == 0 ? O_Q : seg == 1 ? O_K : seg == 2 ? O_V : seg == 3 ? O_QQ : seg == 4 ? O_KK : seg == 5 ? O_VV : seg == 6 ? O_HGS : seg == 7 ? O_SZA : O_SZH;
        bf16_t* const O = (bf16_t*)(ws + boff) + (size_t)row0 * 1024 + cb;
        float* F32 = nullptr;
        if (seg == 1 || seg == 2) { const size_t ob = (u.pm < 128) ? (seg == 1 ? OK_P_ : OV_P_) + (size_t)l * 32768 * 1024 + (size_t)(u.pm * BM) * 1024 : (seg == 1 ? OK_S_ : OV_S_) + (size_t)l * 512 * 1024 + (size_t)((u.pm - 128) * BM) * 1024;
            F32 = out + ob + (size_t)(wr * 64 + fr) * 1024 + cb; }
        else if (seg == 4) F32 = (float*)(ws + O_LOGF) + (size_t)row0 * 1024 + cb;
        const float* const lb = (const float*)(ws + O_LB) + l * 1024 + cb;
        const float sc = seg == 0 ? qscale : 1.f;
#pragma unroll
        for (int bj = 0; bj < 2; ++bj) {
            f32x4 l0 = {0.f, 0.f, 0.f, 0.f}, l1 = l0; if (seg == 4) { l0 = *(const f32x4*)(lb + bj * HALF); l1 = *(const f32x4*)(lb + bj * HALF + 4); }
#pragma unroll
            for (int ai = 0; ai < 2; ++ai)
#pragma unroll
                for (int m = 0; m < 4; ++m) { const size_t off = (size_t)(ai * HALF + m * 16) * 1024 + bj * HALF;
                    f32x4 a = acc[ai][bj][m][0], b = acc[ai][bj][m][1];
                    if (seg == 4) { f32x4 fa, fb;
#pragma unroll
                        for (int i = 0; i < 4; ++i) {
                            { const float x = a[i], lbv = l0[i], e = __expf(-__builtin_fabsf(x)), r = __builtin_amdgcn_rcpf(1.f + e), er = e * r, sig = x >= 0.f ? r : er, om = x >= 0.f ? er : r;
                              fa[i] = __logf(__builtin_fmaxf(lbv + (1.f - lbv) * sig, 1e-30f)); a[i] = (1.f - lbv) * om; }
                            { const float x = b[i], lbv = l1[i], e = __expf(-__builtin_fabsf(x)), r = __builtin_amdgcn_rcpf(1.f + e), er = e * r, sig = x >= 0.f ? r : er, om = x >= 0.f ? er : r;
                              fb[i] = __logf(__builtin_fmaxf(lbv + (1.f - lbv) * sig, 1e-30f)); b[i] = (1.f - lbv) * om; } }
                        *(f32x4*)(F32 + off) = fa; *(f32x4*)(F32 + off + 4) = fb;
                    } else if (seg == 3 || seg == 6) {
#pragma unroll
                        for (int i = 0; i < 4; ++i) { a[i] = silu_f(a[i]); b[i] = silu_f(b[i]); }
                    } else if (seg >= 7) {
#pragma unroll
                        for (int i = 0; i < 4; ++i) { a[i] = sigmoid_f(a[i]); b[i] = sigmoid_f(b[i]); }
                    } else {
                        if (seg == 1 || seg == 2) { *(f32x4*)(F32 + off) = a; *(f32x4*)(F32 + off + 4) = b; }
                        a = a * sc; b = b * sc;
                    }
                    store8bf(O + off, a, b); asm volatile("" ::: "memory"); }
        }
    }
};

struct EpiGateT {
    static constexpr bool PERM = true, AFTER_DRAIN = false;
    float* T; const bf16_t* G;
    __device__ __forceinline__ void operator()(const f32x4 (&acc)[2][2][4][2], const Unit& u, int wr, int wc, int fr, int fq) const {
        const int row0 = u.pm * BM + wr * 64 + fr, cb = u.pn * BM + wc * 32 + 8 * fq;
#pragma unroll
        for (int ai = 0; ai < 2; ++ai)
#pragma unroll
            for (int m = 0; m < 4; ++m)
#pragma unroll
                for (int bj = 0; bj < 2; ++bj) { const size_t off = (size_t)(row0 + ai * HALF + m * 16) * 1024 + cb + bj * HALF; const u32x4 g = *(const u32x4*)(G + off);
                    const f32x4 g0 = {bf_lo(g.x), bf_hi(g.x), bf_lo(g.y), bf_hi(g.y)}, g1 = {bf_lo(g.z), bf_hi(g.z), bf_lo(g.w), bf_hi(g.w)};
                    *(f32x4*)(T + off) = g0 * acc[ai][bj][m][0]; *(f32x4*)(T + off + 4) = g1 * acc[ai][bj][m][1]; asm volatile("" ::: "memory"); }
    }
};
struct EpiGateM {
    static constexpr bool PERM = true, AFTER_DRAIN = false;
    const float* T; const bf16_t* G; bf16_t* O;
    __device__ __forceinline__ void operator()(const f32x4 (&acc)[2][2][4][2], const Unit& u, int wr, int wc, int fr, int fq) const {
        const int row0 = u.pm * BM + wr * 64 + fr, cb = u.pn * BM + wc * 32 + 8 * fq;
#pragma unroll
        for (int ai = 0; ai < 2; ++ai)
#pragma unroll
            for (int m = 0; m < 4; ++m)
#pragma unroll
                for (int bj = 0; bj < 2; ++bj) { const size_t off = (size_t)(row0 + ai * HALF + m * 16) * 1024 + cb + bj * HALF; const u32x4 g = *(const u32x4*)(G + off);
                    const f32x4 g0 = {bf_lo(g.x), bf_hi(g.x), bf_lo(g.y), bf_hi(g.y)}, g1 = {bf_lo(g.z), bf_hi(g.z), bf_lo(g.w), bf_hi(g.w)};
                    const f32x4 t0 = *(const f32x4*)(T + off), t1 = *(const f32x4*)(T + off + 4);
                    store8bf(O + off, t0 + g0 * acc[ai][bj][m][0], t1 + g1 * acc[ai][bj][m][1]); asm volatile("" ::: "memory"); }
    }
};

template <int NM, int NN, int GM> struct FixedOrder {
    static_assert(NM % GM == 0, "GM divides NM");
    int G, c;
    __device__ __forceinline__ void init(int G_, int c_) { G = G_; c = c_; }
    __device__ __forceinline__ bool next(int i, Unit& u) const {
        constexpr int nwg = NM * NN, q = nwg / NXCD, r = nwg % NXCD, nig = GM * NN;
        const int L = i * G + c; if (L >= nwg) return false;
        const int xcd = L % NXCD, off = L / NXCD; const int wgid = (xcd < r ? xcd * (q + 1) : r * (q + 1) + (xcd - r) * q) + off;
        const int gid = wgid / nig, w = wgid % nig; u.pm = gid * GM + (w % GM); u.pn = w / GM; return true;
    }
    __device__ __forceinline__ void a_ready(const Unit&) const {}
    __device__ __forceinline__ void done(const Unit&) const {}
};
template <class Epi, class Sched, bool ALIGN_EPI = false, bool SP2 = false>
__device__ __forceinline__ void gemm_phase(PG8_LAS unsigned char* lds, const Gemm g, const Sched& S, const Epi& E) {
    const int tid = opaque_tid(), wid = __builtin_amdgcn_readfirstlane(tid >> 6), lane = tid & 63, wr = wid >> 2, wc = wid & 3, fr = lane & 15, fq = lane >> 4;
    const int K = g.K, nt = K / BK;
    unsigned voffA[2], voffB[2];
#pragma unroll
    for (int i = 0; i < 2; ++i) { int R, C; stage_rc(tid * 16 + i * 8192, R, C); const int Rb = Epi::PERM ? ((R & ~31) + perm32(R & 31)) : R;
        voffA[i] = (unsigned)(R * K + C) * 2u; voffB[i] = (unsigned)(Rb * K + C) * 2u; }
    const size_t kstep = (size_t)(BK * 2);
    const size_t hstep = (size_t)HALF * K * 2;
    const size_t tstep = 2 * hstep;
    const unsigned ldsw = (unsigned)wid * 1024u;
    const int aoff = lds_byte(wr * 64 + fr, fq * 8), boff = lds_byte(wc * 32 + fr, fq * 8);
#define PG8_SA(b, h) (((b) * 2 + (h)) * HTB)
#define PG8_SB(b, h) ((4 + (b) * 2 + (h)) * HTB)
#define PG8_STAGE(bufoff, gbase, voff) do { _Pragma("unroll") for (int _i = 0; _i < 2; ++_i) \
        __builtin_amdgcn_global_load_lds((const unsigned*)((const char*)(gbase) + (voff)[_i]), (PG8_LAS unsigned*)(lds + (bufoff) + ldsw + _i * 8192), 16, 0, 0); } while (0)
#define PG8_LDA(dst, b, h) do { _Pragma("unroll") for (int m = 0; m < 4; ++m) _Pragma("unroll") for (int k = 0; k < 2; ++k) dst[m][k] = *(const PG8_LAS bf16x8*)(lds + PG8_SA(b, h) + aoff + m * 2048 + k * 1024); } while (0)
#define PG8_LDB(dst, b, h) do { _Pragma("unroll") for (int n = 0; n < 2; ++n) _Pragma("unroll") for (int k = 0; k < 2; ++k) dst[n][k] = *(const PG8_LAS bf16x8*)(lds + PG8_SB(b, h) + boff + n * 2048 + k * 1024); } while (0)
#define PG8_MMA(ai, bj, At, Bt) do { __builtin_amdgcn_s_setprio(1); _Pragma("unroll") for (int m = 0; m < 4; ++m) _Pragma("unroll") for (int n = 0; n < 2; ++n) _Pragma("unroll") for (int k = 0; k < 2; ++k) \
        acc[ai][bj][m][n] = __builtin_amdgcn_mfma_f32_16x16x32_bf16(Bt[n][k], At[m][k], acc[ai][bj][m][n], 0, 0, 0); __builtin_amdgcn_s_setprio(0); } while (0)
#define PG8_WAIT_V(n) asm volatile("s_waitcnt vmcnt(" #n ")" ::: "memory")
#define PG8_WAIT_L(n) asm volatile("s_waitcnt lgkmcnt(" #n ")" ::: "memory")
#define PG8_BAR __builtin_amdgcn_s_barrier()
#define PG8_SCHED __builtin_amdgcn_sched_barrier(0)
    Unit cur, nxt; int ui = 0;
    if (!S.next(0, cur)) return;
    f32x4 acc[2][2][4][2];
#pragma unroll
    for (int a = 0; a < 2; ++a)
#pragma unroll
        for (int b = 0; b < 2; ++b)
#pragma unroll
            for (int m = 0; m < 4; ++m)
#pragma unroll
                for (int n = 0; n < 2; ++n) acc[a][b][m][n] = (f32x4){0.f, 0.f, 0.f, 0.f};
    bf16x8 At[4][2], B0[2][2], B1[2][2];
    const char* cA = (const char*)g.A + (size_t)cur.pm * tstep; const char* cB = (const char*)g.Bt + (size_t)cur.pn * tstep;
    S.a_ready(cur);
    if constexpr (SP2) {
        PG8_STAGE(PG8_SB(0, 0), cB, voffB); PG8_STAGE(PG8_SB(0, 1), cB + hstep, voffB); PG8_STAGE(PG8_SA(0, 0), cA, voffA); PG8_STAGE(PG8_SA(0, 1), cA + hstep, voffA);
        if (wr == 1) PG8_BAR;
        PG8_WAIT_V(2); PG8_BAR;
        PG8_STAGE(PG8_SB(1, 0), cB + kstep, voffB); PG8_STAGE(PG8_SA(1, 0), cA + kstep, voffA); PG8_STAGE(PG8_SB(1, 1), cB + hstep + kstep, voffB);
        PG8_WAIT_V(6); PG8_BAR;
    } else {
        PG8_STAGE(PG8_SB(0, 0), cB, voffB); PG8_STAGE(PG8_SA(0, 0), cA, voffA); PG8_STAGE(PG8_SB(0, 1), cB + hstep, voffB); PG8_STAGE(PG8_SA(0, 1), cA + hstep, voffA);
        if (wr == 1) PG8_BAR;
        PG8_WAIT_V(4); PG8_BAR;
        PG8_STAGE(PG8_SB(1, 0), cB + kstep, voffB); PG8_STAGE(PG8_SA(1, 0), cA + kstep, voffA); PG8_STAGE(PG8_SB(1, 1), cB + hstep + kstep, voffB);
        PG8_WAIT_V(6); PG8_BAR;
    }
    for (;;) {
        const bool has_next = S.next(ui + 1, nxt);
        const char* nA = has_next ? (const char*)g.A + (size_t)nxt.pm * tstep : cA; const char* nB = has_next ? (const char*)g.Bt + (size_t)nxt.pn * tstep : cB;
        for (int t = 0; t < nt; t += 2) {
            const bool last = (t == nt - 2);
            const char* a1 = cA + (size_t)(t + 1) * kstep;
            const char* a2 = last ? nA : cA + (size_t)(t + 2) * kstep; const char* b2 = last ? nB : cB + (size_t)(t + 2) * kstep;
            const char* a3 = a2 + kstep; const char* b3 = b2 + kstep;
            if (last && has_next) S.a_ready(nxt);
            if constexpr (SP2) {
            PG8_LDB(B0, 0, 0); PG8_LDB(B1, 0, 1); PG8_SCHED; PG8_LDA(At, 0, 0); PG8_STAGE(PG8_SA(1, 1), a1 + hstep, voffA);
            PG8_WAIT_V(8); PG8_WAIT_L(0); PG8_BAR; PG8_MMA(0, 0, At, B0); PG8_MMA(0, 1, At, B1); PG8_BAR; PG8_SCHED;
            PG8_LDA(At, 0, 1); PG8_STAGE(PG8_SB(0, 0), b2, voffB); PG8_STAGE(PG8_SB(0, 1), b2 + hstep, voffB); PG8_STAGE(PG8_SA(0, 0), a2, voffA);
            PG8_WAIT_V(8); PG8_WAIT_L(0); PG8_BAR; PG8_MMA(1, 0, At, B0); PG8_MMA(1, 1, At, B1); PG8_BAR; PG8_SCHED;
            PG8_LDB(B0, 1, 0); PG8_LDB(B1, 1, 1); PG8_SCHED; PG8_LDA(At, 1, 0); PG8_STAGE(PG8_SA(0, 1), a2 + hstep, voffA);
            PG8_WAIT_V(8); PG8_WAIT_L(0); PG8_BAR; PG8_MMA(0, 0, At, B0); PG8_MMA(0, 1, At, B1); PG8_BAR; PG8_SCHED;
            PG8_LDA(At, 1, 1); PG8_STAGE(PG8_SB(1, 0), b3, voffB); PG8_STAGE(PG8_SB(1, 1), b3 + hstep, voffB); PG8_STAGE(PG8_SA(1, 0), a3, voffA);
            PG8_WAIT_V(8); PG8_WAIT_L(0); PG8_BAR; PG8_MMA(1, 0, At, B0); PG8_MMA(1, 1, At, B1); PG8_BAR; PG8_SCHED;
            } else {
            PG8_LDB(B0, 0, 0); PG8_SCHED; PG8_LDA(At, 0, 0); PG8_STAGE(PG8_SA(1, 1), a1 + hstep, voffA);
            PG8_WAIT_L(8); PG8_BAR; PG8_WAIT_L(0); PG8_MMA(0, 0, At, B0); PG8_BAR; PG8_SCHED;
            PG8_LDB(B1, 0, 1); PG8_STAGE(PG8_SB(0, 0), b2, voffB);
            PG8_BAR; PG8_WAIT_L(0); PG8_MMA(0, 1, At, B1); PG8_BAR;
            PG8_LDA(At, 0, 1); PG8_STAGE(PG8_SA(0, 0), a2, voffA);
            PG8_BAR; PG8_WAIT_L(0); PG8_MMA(1, 0, At, B0); PG8_BAR; PG8_SCHED;
            PG8_STAGE(PG8_SB(0, 1), b2 + hstep, voffB);
            PG8_WAIT_V(6); PG8_BAR; PG8_MMA(1, 1, At, B1); PG8_BAR;
            PG8_LDB(B0, 1, 0); PG8_SCHED; PG8_LDA(At, 1, 0); PG8_STAGE(PG8_SA(0, 1), a2 + hstep, voffA);
            PG8_WAIT_L(8); PG8_BAR; PG8_WAIT_L(0); PG8_MMA(0, 0, At, B0); PG8_BAR; PG8_SCHED;
            PG8_LDB(B1, 1, 1); PG8_STAGE(PG8_SB(1, 0), b3, voffB);
            PG8_BAR; PG8_WAIT_L(0); PG8_MMA(0, 1, At, B1); PG8_BAR;
            PG8_LDA(At, 1, 1); PG8_STAGE(PG8_SA(1, 0), a3, voffA);
            PG8_BAR; PG8_WAIT_L(0); PG8_MMA(1, 0, At, B0); PG8_BAR; PG8_SCHED;
            PG8_STAGE(PG8_SB(1, 1), b3 + hstep, voffB);
            PG8_WAIT_V(6); PG8_BAR; PG8_MMA(1, 1, At, B1); PG8_BAR;
            }
        }
        if constexpr (ALIGN_EPI) { if (wr == 0) PG8_BAR; }
        if constexpr (!Epi::AFTER_DRAIN) { E(acc, cur, wr, wc, fr, fq); S.done(cur); }
        if (!has_next) break;
#pragma unroll
        for (int a = 0; a < 2; ++a)
#pragma unroll
            for (int b = 0; b < 2; ++b)
#pragma unroll
                for (int m = 0; m < 4; ++m)
#pragma unroll
                    for (int n = 0; n < 2; ++n) acc[a][b][m][n] = (f32x4){0.f, 0.f, 0.f, 0.f};
        cur = nxt; cA = nA; cB = nB; ++ui;
        if constexpr (ALIGN_EPI) { if (wr == 1) PG8_BAR; }
    }
    PG8_WAIT_V(0);
    if constexpr (!ALIGN_EPI) { if (wr == 0) PG8_BAR; }
    PG8_BAR;
    if constexpr (Epi::AFTER_DRAIN) { E.fused(acc, cur, wr, wc, fr, fq, lds, wid, lane); S.done(cur); }
#undef PG8_SA
#undef PG8_SB
#undef PG8_STAGE
#undef PG8_LDA
#undef PG8_LDB
#undef PG8_MMA
#undef PG8_WAIT_V
#undef PG8_WAIT_L
#undef PG8_BAR
#undef PG8_SCHED
}
}
namespace attn_body {
using bf16=__hip_bfloat16;
using bf16x8=__attribute__((ext_vector_type(8)))short;
using s16x4=__attribute__((ext_vector_type(4)))short;
using f32x16=__attribute__((ext_vector_type(16)))float;
using u32x4=__attribute__((ext_vector_type(4)))unsigned;
constexpr int BATCH=4,NHEAD=16,SEQ=8192,D=64,DM=NHEAD*D;
constexpr int NW=8,QBLK=32,QB=QBLK*NW,KVBLK=64,NQB=SEQ/QB;
constexpr int ATTN_PITCH=DM, ATTN_UNIT_ROWS=QB;
__device__ __forceinline__ int crow(int r,int hi){return (r&3)+8*(r>>2)+4*hi;}
#define SBAR() __builtin_amdgcn_sched_barrier(0)
__device__ __forceinline__ void cmask(f32x16&p0,f32x16&p1,int jb,int qrel,int hi){
  const float NEG=-INFINITY; (void)hi;
  if(jb>(qrel>>6)){
  #pragma unroll
  for(int r=0;r<16;++r){p0[r]=NEG;p1[r]=NEG;} }
}

constexpr int NSLOT=3, SLOTB=8192;
constexpr int LDS_K=0, LDS_V=NSLOT*SLOTB, LDS_WS=2*NSLOT*SLOTB, LDS_OST=LDS_WS+NW*64*4, LDS_BYTES=LDS_OST+NW*4096;
constexpr float C2=0.125f*1.4426950408889634f;
__device__ __forceinline__ void glds16(const void*gsrc,unsigned lds_dst){unsigned keep;
  asm volatile("s_mov_b32 %0, m0\n\ts_mov_b32 m0, %2\n\ts_nop 0\n\tglobal_load_lds_dwordx4 %1, off\n\ts_mov_b32 m0, %0":"=&s"(keep):"v"(gsrc),"s"(lds_dst):"memory");}
__device__ __forceinline__ float max3f(float a,float b,float c){float r;asm("v_max3_f32 %0, %1, %2, %3":"=v"(r):"v"(a),"v"(b),"v"(c));return r;}
__device__ __forceinline__ float max2f(float a,float b){float r;asm("v_max_f32_e32 %0, %1, %2":"=v"(r):"v"(a),"v"(b));return r;}
__device__ __forceinline__ float fadd_s(float a,float b){float r;asm("v_add_f32_e32 %0, %1, %2":"=v"(r):"v"(a),"v"(b));return r;}
__device__ __forceinline__ float fsub_s(float a,float b){float r;asm("v_sub_f32_e32 %0, %1, %2":"=v"(r):"v"(a),"v"(b));return r;}
typedef float f32x2_t __attribute__((ext_vector_type(2))); typedef __bf16 bf16x2_t __attribute__((ext_vector_type(2)));
__device__ __forceinline__ unsigned cvtpk_s(float lo,float hi){f32x2_t v={lo,hi};bf16x2_t b=__builtin_convertvector(v,bf16x2_t);return __builtin_bit_cast(unsigned,b);}
#define WAIT_BAR(N) asm volatile("s_waitcnt vmcnt(" #N ") lgkmcnt(0)\n\ts_barrier":::"memory")

__device__ __forceinline__ void qkt(f32x16&p0,f32x16&p1,const char*Kslot,const bf16x8*qr,const f32x16&negm,int r32,int hi){
  const char*kb=Kslot+hi*1024+r32*16;
  #pragma unroll
  for(int d0=0;d0<4;++d0){
    const bf16x8 b0=*reinterpret_cast<const bf16x8*>(kb+d0*2048);
    const bf16x8 b1=*reinterpret_cast<const bf16x8*>(kb+d0*2048+512);
    if(d0==0){p0=__builtin_amdgcn_mfma_f32_32x32x16_bf16(b0,qr[0],negm,0,0,0);p1=__builtin_amdgcn_mfma_f32_32x32x16_bf16(b1,qr[0],negm,0,0,0);}
    else{p0=__builtin_amdgcn_mfma_f32_32x32x16_bf16(b0,qr[d0],p0,0,0,0);p1=__builtin_amdgcn_mfma_f32_32x32x16_bf16(b1,qr[d0],p1,0,0,0);}}
}
typedef __attribute__((address_space(3))) const char* lds_cptr;
typedef short v4i16_t __attribute__((ext_vector_type(4)));
__device__ __forceinline__ void kload8(bf16x8*kf,lds_cptr kp){
  kf[0]=*(const __attribute__((address_space(3))) bf16x8*)(kp);      kf[1]=*(const __attribute__((address_space(3))) bf16x8*)(kp+512);
  kf[2]=*(const __attribute__((address_space(3))) bf16x8*)(kp+2048); kf[3]=*(const __attribute__((address_space(3))) bf16x8*)(kp+2560);
  kf[4]=*(const __attribute__((address_space(3))) bf16x8*)(kp+4096); kf[5]=*(const __attribute__((address_space(3))) bf16x8*)(kp+4608);
  kf[6]=*(const __attribute__((address_space(3))) bf16x8*)(kp+6144); kf[7]=*(const __attribute__((address_space(3))) bf16x8*)(kp+6656);
}
__device__ __forceinline__ void kload2(bf16x8*kf,lds_cptr kp,int j){ kf[2*j]=*(const __attribute__((address_space(3))) bf16x8*)(kp+j*2048); kf[2*j+1]=*(const __attribute__((address_space(3))) bf16x8*)(kp+j*2048+512); }
__device__ __forceinline__ s16x4 vtr(lds_cptr p){ return __builtin_bit_cast(s16x4,__builtin_amdgcn_ds_read_tr16_b64_v4i16((__attribute__((address_space(3))) v4i16_t*)p)); }
__device__ __forceinline__ float rowmax(const f32x16&p0,const f32x16&p1){
  float a=max3f(p0[0],p0[1],p1[0]),b=max3f(p0[2],p0[3],p1[1]);a=max3f(a,p1[2],p1[3]);
  #pragma unroll
  for(int r=4;r<16;r+=4){a=max3f(a,p0[r],p0[r+1]);b=max3f(b,p0[r+2],p0[r+3]);a=max3f(a,p1[r],p1[r+1]);b=max3f(b,p1[r+2],p1[r+3]);}
  const float m=max2f(a,b);
  auto rr=__builtin_amdgcn_permlane32_swap(__float_as_uint(m),__float_as_uint(m),false,false);
  return max2f(__uint_as_float(rr[0]),__uint_as_float(rr[1]));
}
__device__ __forceinline__ void pv(f32x16*o,int vb,bf16x8 pa0,bf16x8 pa1,bf16x8 pa2,bf16x8 pa3){
  #pragma unroll
  for(int d0=0;d0<2;++d0){s16x4 lo[4],hi[4];
    #pragma unroll
    for(int ks=0;ks<4;++ks){
      asm volatile("ds_read_b64_tr_b16 %0,%1 offset:%c2":"=&v"(lo[ks]):"v"(vb),"i"(d0*4096+ks*1024):"memory");
      asm volatile("ds_read_b64_tr_b16 %0,%1 offset:%c2":"=&v"(hi[ks]):"v"(vb),"i"(d0*4096+ks*1024+512):"memory");}
    asm volatile("s_waitcnt lgkmcnt(0)":::"memory");SBAR();
    #define PK(k) (bf16x8){lo[k][0],lo[k][1],lo[k][2],lo[k][3],hi[k][0],hi[k][1],hi[k][2],hi[k][3]}
    o[d0]=__builtin_amdgcn_mfma_f32_32x32x16_bf16(pa0,PK(0),o[d0],0,0,0);
    o[d0]=__builtin_amdgcn_mfma_f32_32x32x16_bf16(pa1,PK(1),o[d0],0,0,0);
    o[d0]=__builtin_amdgcn_mfma_f32_32x32x16_bf16(pa2,PK(2),o[d0],0,0,0);
    o[d0]=__builtin_amdgcn_mfma_f32_32x32x16_bf16(pa3,PK(3),o[d0],0,0,0);
    #undef PK
  }
}

#ifndef ATTN_STORE16
#define ATTN_STORE16(p,v) (*(u32x4*)(p)=(v))
#endif
template<int THRL> __device__ __forceinline__ void attn_unit(int b,int hq,int hv,int qb,const bf16*Q,const bf16*__restrict__ K,const bf16*__restrict__ V,bf16*O,char*shm){
  const int tid=opaque_tid(),lane=tid&63,r32=lane&31,hi=lane>>5; const int wid=__builtin_amdgcn_readfirstlane(tid>>6);
  const long rowbase=(long)b*SEQ; const int q0=qb*QB;
  const bf16*Qw=Q+(rowbase+q0+wid*QBLK)*DM+hq*D;
  const bf16*Kh=K+rowbase*DM+hq*D,*Vh=V+rowbase*DM+hv*D;
  const unsigned lds0=(unsigned)(uintptr_t)shm;
  float*wsf=(float*)(shm+LDS_WS)+wid*64;
  const bf16*ksrc=Kh+(long)lane*DM+wid*8;
  const bf16*vsrc=Vh+(long)(16*(wid&3)+(lane>>2))*DM+(wid>>2)*32+(lane&3)*8;
  const unsigned kdst=lds0+LDS_K+wid*1024, vdst=lds0+LDS_V+wid*1024;
  #define DMA_K(t,slot) glds16(ksrc+(long)(t)*KVBLK*DM,(unsigned)__builtin_amdgcn_readfirstlane(kdst+(slot)))
  #define DMA_V(t,slot) glds16(vsrc+(long)(t)*KVBLK*DM,(unsigned)__builtin_amdgcn_readfirstlane(vdst+(slot)))
  const int vb0=(int)(lds0+LDS_V)+((lane>>4)&1)*32+(lane&3)*8+(4*hi+((lane&15)>>2))*64;
  const char*Kbase=shm+LDS_K; bf16x8 kf[8];
  const lds_cptr shm3=(lds_cptr)shm; const lds_cptr kp0=shm3+LDS_K+hi*1024+r32*16; const lds_cptr vp0=shm3+LDS_V+((lane>>4)&1)*32+(lane&3)*8+(4*hi+((lane&15)>>2))*64;
  const int NT=(q0+QB)/KVBLK;
  DMA_K(0,0);DMA_V(0,0);DMA_K(1,SLOTB);
  bf16x8 qr[4];
  #pragma unroll
  for(int d0=0;d0<4;++d0)qr[d0]=*reinterpret_cast<const bf16x8*>(&Qw[(long)r32*DM+d0*16+hi*8]);
  float mhat=0.f,l_reg=0.f;f32x16 o[2];o[0]=f32x16{};o[1]=f32x16{};f32x16 negm=f32x16{};asm volatile("":"+v"(negm));
  const int qrel=wid*QBLK+r32;
  #define CMASK(P0,P1,t) do{int jb_=(t)-(NT-4); if(jb_>=0)cmask(P0,P1,jb_,qrel,hi);}while(0)
  bool resc=false;
  #define START(P0,P1) do{ const float rm=rowmax(P0,P1); resc=false; \
    { const float dl=rm; mhat=fadd_s(mhat,dl); \
      _Pragma("unroll") for(int r=0;r<16;++r){P0[r]=fsub_s(P0[r],dl);P1[r]=fsub_s(P1[r],dl);} \
      _Pragma("unroll") for(int r=0;r<16;++r)negm[r]=-mhat; asm volatile("":"+v"(negm)); } \
    _Pragma("unroll") for(int r=0;r<16;++r)P0[r]=__builtin_amdgcn_exp2f(P0[r]); }while(0)
  #define RESC() do{ if(resc){ asm volatile("s_waitcnt lgkmcnt(0)":::"memory"); \
      _Pragma("unroll") for(int d_=0;d_<2;++d_) _Pragma("unroll") for(int r=0;r<16;++r)o[d_][r]*=wsf[crow(r,hi)]; } }while(0)
  f32x16 pA0,pA1,pB0,pB1;
  int sl_prev=0,sl_cur=0,sl_next=SLOTB;
  #define ROT() do{sl_prev=sl_cur;sl_cur=sl_next;sl_next=(sl_next==(NSLOT-1)*SLOTB)?0:sl_next+SLOTB;}while(0)
  DMA_K(2,2*SLOTB);
  WAIT_BAR(3);
  qkt(pA0,pA1,Kbase,qr,negm,r32,hi);asm volatile("s_nop 15\n\ts_nop 7":"+v"(pA0),"+v"(pA1));CMASK(pA0,pA1,0);
  START(pA0,pA1);
  _Pragma("unroll") for(int r=0;r<16;++r)pA1[r]=__builtin_amdgcn_exp2f(pA1[r]);
  WAIT_BAR(0);
  DMA_K(3,0);DMA_V(1,SLOTB);
  ROT();
  kload8(kf,kp0+sl_cur);
  WAIT_BAR(2);
  s16x4 vlo[8],vhi[8]; u32x4 pw0,pw1,pw2,pw3;
  #define PKW(P,B) cvtpk_s(P[B],P[B+1])
  #define PAF(k) __builtin_bit_cast(bf16x8,pw##k)
  #define VFR(i) (bf16x8){vlo[i][0],vlo[i][1],vlo[i][2],vlo[i][3],vhi[i][0],vhi[i][1],vhi[i][2],vhi[i][3]}
  #define PIN(x) asm volatile("":"+v"(x))
  #define MX3(a,b,c) __builtin_fmaxf(__builtin_fmaxf((a),(b)),(c))
  #define GAPA(MF,A0,A1,A2,A3,W0,W1,PW) do{ MF; sacc+=A0; sacc+=A1; sacc+=A2; sacc+=A3; PIN(sacc); W0; W1; PIN(PW); SBAR(); }while(0)
  #define EX(v) __builtin_amdgcn_exp2f(v)
  #define GAPB(MF,X,B) do{ MF; X[B]=EX(X[B]); X[B+1]=EX(X[B+1]); X[B+2]=EX(X[B+2]); X[B+3]=EX(X[B+3]); PIN(X); SBAR(); }while(0)
  #define VRD(i) do{ vlo[i]=vtr(vp_+(((i)>>2)*4096+((i)&3)*1024)); vhi[i]=vtr(vp_+(((i)>>2)*4096+((i)&3)*1024+512)); }while(0)
  #define KRD(G,j) do{ if(G){ kload2(kf,kp0+sl_next,j); SBAR(); } }while(0)
  #define STEP(C0,C1,P0,P1,t,GK,GV,GL) do{ SBAR(); \
    const lds_cptr vp_=vp0+sl_prev; \
    VRD(0); SBAR(); float sacc=(P0[0]+P0[1]); \
    GAPA(C0=__builtin_amdgcn_mfma_f32_32x32x16_bf16(kf[0],qr[0],negm,0,0,0), P0[2],P0[3],P0[4],P0[5],     pw0[0]=PKW(P0,0), pw0[1]=PKW(P0,2), pw0); \
    VRD(4); SBAR(); GAPA(C1=__builtin_amdgcn_mfma_f32_32x32x16_bf16(kf[1],qr[0],negm,0,0,0), P0[6],P0[7],P0[8],P0[9],     pw0[2]=PKW(P0,4), pw0[3]=PKW(P0,6), pw0); \
    VRD(1); SBAR(); GAPA(C0=__builtin_amdgcn_mfma_f32_32x32x16_bf16(kf[2],qr[1],C0,0,0,0),   P0[10],P0[11],P0[12],P0[13], pw1[0]=PKW(P0,8), pw1[1]=PKW(P0,10), pw1); \
    VRD(5); SBAR(); GAPA(C1=__builtin_amdgcn_mfma_f32_32x32x16_bf16(kf[3],qr[1],C1,0,0,0),   P0[14],P0[15],P1[0],P1[1],   pw1[2]=PKW(P0,12),pw1[3]=PKW(P0,14), pw1); \
    VRD(2); SBAR(); GAPA(C0=__builtin_amdgcn_mfma_f32_32x32x16_bf16(kf[4],qr[2],C0,0,0,0),   P1[2],P1[3],P1[4],P1[5],     pw2[0]=PKW(P1,0), pw2[1]=PKW(P1,2), pw2); \
    VRD(6); SBAR(); GAPA(C1=__builtin_amdgcn_mfma_f32_32x32x16_bf16(kf[5],qr[2],C1,0,0,0),   P1[6],P1[7],P1[8],P1[9],     pw2[2]=PKW(P1,4), pw2[3]=PKW(P1,6), pw2); \
    VRD(3); SBAR(); GAPA(C0=__builtin_amdgcn_mfma_f32_32x32x16_bf16(kf[6],qr[3],C0,0,0,0),   P1[10],P1[11],P1[12],P1[13], pw3[0]=PKW(P1,8), pw3[1]=PKW(P1,10), pw3); \
    VRD(7); SBAR(); GAPA(C1=__builtin_amdgcn_mfma_f32_32x32x16_bf16(kf[7],qr[3],C1,0,0,0),   P1[14],P1[15],0.f,0.f,       pw3[2]=PKW(P1,12),pw3[3]=PKW(P1,14), pw3); \
    l_reg+=sacc; \
    if(GK){DMA_K((t)+3,sl_cur);} if(GV){DMA_V((t)+1,sl_next);} \
    CMASK(C0,C1,t); \
    { float a=MX3(C0[0],C0[1],C1[0]),b=MX3(C0[2],C0[3],C1[1]); a=MX3(a,C1[2],C1[3]); \
      _Pragma("unroll") for(int r=4;r<16;r+=4){a=MX3(a,C0[r],C0[r+1]);b=MX3(b,C0[r+2],C0[r+3]);a=MX3(a,C1[r],C1[r+1]);b=MX3(b,C1[r+2],C1[r+3]);} \
      float rm=__builtin_fmaxf(a,b); { auto rr=__builtin_amdgcn_permlane32_swap(__float_as_uint(rm),__float_as_uint(rm),false,false); rm=__builtin_fmaxf(__uint_as_float(rr[0]),__uint_as_float(rr[1])); } \
      resc=false; \
      if(__builtin_expect(__any(rm>(float)THRL),0)){ const float dl=__builtin_fmaxf(rm,0.f); mhat+=dl; \
        _Pragma("unroll") for(int r=0;r<16;++r){C0[r]-=dl;C1[r]-=dl;} \
        _Pragma("unroll") for(int r=0;r<16;++r)negm[r]=-mhat; asm volatile("":"+v"(negm)); \
        const float f=__builtin_amdgcn_exp2f(-dl); l_reg*=f; if(hi==0)wsf[r32]=f; resc=true; } } \
    SBAR(); \
    GAPB(o[0]=__builtin_amdgcn_mfma_f32_32x32x16_bf16(PAF(0),VFR(0),o[0],0,0,0), C0,0); \
    GAPB(o[1]=__builtin_amdgcn_mfma_f32_32x32x16_bf16(PAF(0),VFR(4),o[1],0,0,0), C0,4); \
    KRD(GL,0); GAPB(o[0]=__builtin_amdgcn_mfma_f32_32x32x16_bf16(PAF(1),VFR(1),o[0],0,0,0), C0,8); \
    KRD(GL,1); GAPB(o[1]=__builtin_amdgcn_mfma_f32_32x32x16_bf16(PAF(1),VFR(5),o[1],0,0,0), C0,12); \
    KRD(GL,2); GAPB(o[0]=__builtin_amdgcn_mfma_f32_32x32x16_bf16(PAF(2),VFR(2),o[0],0,0,0), C1,0); \
    KRD(GL,3); GAPB(o[1]=__builtin_amdgcn_mfma_f32_32x32x16_bf16(PAF(2),VFR(6),o[1],0,0,0), C1,4); \
    GAPB(o[0]=__builtin_amdgcn_mfma_f32_32x32x16_bf16(PAF(3),VFR(3),o[0],0,0,0), C1,8); \
    GAPB(o[1]=__builtin_amdgcn_mfma_f32_32x32x16_bf16(PAF(3),VFR(7),o[1],0,0,0), C1,12); \
    }while(0)
  int t=1;
  #undef CMASK
  #define CMASK(P0,P1,t) do{}while(0)
  for(;t+5<NT;t+=2){
    STEP(pB0,pB1,pA0,pA1,t,true,true,true);     WAIT_BAR(2); RESC(); ROT();
    STEP(pA0,pA1,pB0,pB1,t+1,true,true,true);   WAIT_BAR(2); RESC(); ROT();
  }
  #undef CMASK
  #define CMASK(P0,P1,t) do{int jb_=(t)-(NT-4); if(jb_>=0)cmask(P0,P1,jb_,qrel,hi);}while(0)
  #define ENDW(tt) do{ if((tt)+3<NT){WAIT_BAR(2);} else if((tt)+2<NT){WAIT_BAR(1);} else {WAIT_BAR(0);} }while(0)
  for(;t+1<NT;t+=2){
    STEP(pB0,pB1,pA0,pA1,t,(t+3<NT),(t+1<NT),(t+1<NT));       ENDW(t);   RESC(); ROT();
    STEP(pA0,pA1,pB0,pB1,t+1,(t+4<NT),(t+2<NT),(t+2<NT));     ENDW(t+1); RESC(); ROT();
  }
  STEP(pB0,pB1,pA0,pA1,NT-1,false,false,false); RESC();
  { float sacc=pB0[0]+pB0[1]; _Pragma("unroll") for(int r=2;r<16;++r)sacc+=pB0[r]; _Pragma("unroll") for(int r=0;r<16;++r)sacc+=pB1[r]; l_reg+=sacc;
    pw0=(u32x4){PKW(pB0,0),PKW(pB0,2),PKW(pB0,4),PKW(pB0,6)};pw1=(u32x4){PKW(pB0,8),PKW(pB0,10),PKW(pB0,12),PKW(pB0,14)};pw2=(u32x4){PKW(pB1,0),PKW(pB1,2),PKW(pB1,4),PKW(pB1,6)};pw3=(u32x4){PKW(pB1,8),PKW(pB1,10),PKW(pB1,12),PKW(pB1,14)};
    SBAR(); pv(o,vb0+sl_cur,PAF(0),PAF(1),PAF(2),PAF(3)); }
  #undef PKW
  #undef PAF
  #undef VFR
  #undef PIN
  #undef MX3
  #undef GAPA
  #undef GAPB
  #undef EX
  #undef VRD
  #undef KRD
  #undef STEP
  #undef ENDW
  {auto rr=__builtin_amdgcn_permlane32_swap(__float_as_uint(l_reg),__float_as_uint(l_reg),false,false);l_reg=__uint_as_float(rr[0])+__uint_as_float(rr[1]);}
  if(hi==0)wsf[32+r32]=l_reg;asm volatile("s_waitcnt lgkmcnt(0)":::"memory");
  float rli[16];
  #pragma unroll
  for(int r=0;r<16;++r)rli[r]=__builtin_amdgcn_rcpf(wsf[32+crow(r,hi)]);
  bf16*Ow=O+(rowbase+q0+wid*QBLK)*DM+hv*D;
  { bf16*stg=(bf16*)(shm+LDS_OST)+wid*2048;
    #pragma unroll
    for(int r=0;r<16;++r){const int orow=crow(r,hi);
      #pragma unroll
      for(int d0=0;d0<2;++d0)stg[orow*64+d0*32+r32]=__float2bfloat16(o[d0][r]*rli[r]);}
    asm volatile("s_waitcnt lgkmcnt(0)":::"memory");
    #pragma unroll
    for(int i=0;i<4;++i){const int row=i*8+(lane>>3),ch=lane&7; const u32x4 v=*(const u32x4*)(stg+row*64+ch*8); ATTN_STORE16(Ow+(long)row*DM+ch*8,v);} }
  asm volatile("s_waitcnt lgkmcnt(0)\n\ts_barrier":::"memory");
  #undef DMA_K
  #undef DMA_V
  #undef CMASK
  #undef START
  #undef RESC
  #undef ROT
}
constexpr int ATTN_LDS_BYTES=LDS_BYTES;
#undef SBAR
#undef WAIT_BAR
}
#define GAS __attribute__((address_space(1)))
#define LAS __attribute__((address_space(3)))
typedef unsigned short bf16;
typedef unsigned v4u __attribute__((ext_vector_type(4)));
typedef float f32x4 __attribute__((ext_vector_type(4)));
typedef short bf16x8 __attribute__((ext_vector_type(8)));
typedef GAS unsigned gu32;
typedef GAS unsigned long long gu64;
#define RLX_AGENT __ATOMIC_RELAXED, __HIP_MEMORY_SCOPE_AGENT
#define LDS_WAIT() asm volatile("s_waitcnt lgkmcnt(0)" ::: "memory")
#define VM_WAIT() asm volatile("s_waitcnt vmcnt(0)" ::: "memory")
__device__ __forceinline__ unsigned long long rt() { return __builtin_amdgcn_s_memrealtime(); }
__device__ __forceinline__ unsigned f2bf(float f) { unsigned u = __builtin_bit_cast(unsigned, f); return (u + 0x7fffu + ((u >> 16) & 1u)) >> 16; }
__device__ __forceinline__ unsigned pk2(float lo, float hi) { return f2bf(lo) | (f2bf(hi) << 16); }

#define XB_TMO      128
#define XB_XCNT(j)  (256  + 64 * (j))
#define XB_XSUB(j)  (1280 + 64 * (j))
#define XB_XGEN(j)  (2304 + 64 * (j))
#define XB_TOP      3328
#define XB_TOPGEN   3392
#define XCD_BAR_WORDS 3456
#define XB_SPIN_CAP (1u << 18)

__device__ __forceinline__ unsigned xb_ld(unsigned* p)              { return __hip_atomic_load(p, __ATOMIC_RELAXED, __HIP_MEMORY_SCOPE_AGENT); }
__device__ __forceinline__ unsigned xb_add(unsigned* p, unsigned v) { return __hip_atomic_fetch_add(p, v, __ATOMIC_RELAXED, __HIP_MEMORY_SCOPE_AGENT); }
__device__ __forceinline__ unsigned xb_xcc_id() { return (unsigned)__builtin_amdgcn_s_getreg((3 << 11) | 20) & 0xFu; }
#define XB_SPIN(cond, bar) do { unsigned _sp = 0; while (cond) { __builtin_amdgcn_s_sleep(1); \
    if ((++_sp & 255u) == 0u) { if (xb_ld(&(bar)[XB_TMO])) break; if (_sp > XB_SPIN_CAP) { atomicAdd(&(bar)[XB_TMO], 1u); break; } } } } while (0)

struct XcdBarrier {
    unsigned* bar; unsigned x;
    volatile LAS unsigned* st;
};

__device__ __forceinline__ XcdBarrier xcd_barrier_post(unsigned* bar, volatile LAS unsigned* st) {
    XcdBarrier b; b.bar = bar; b.x = xb_xcc_id(); b.st = st;
    if (threadIdx.x == 0) (void)xb_add(&bar[XB_XCNT(b.x)], 1u);
    return b;
}
__device__ __forceinline__ void xcd_barrier_complete(unsigned* bar, unsigned x, unsigned& nloc, unsigned& nx) {
    const unsigned G = gridDim.x * gridDim.y * gridDim.z;
    unsigned sum, cnt, mine, sp = 0u;
    for (;;) {
        sum = 0u; cnt = 0u;
#pragma unroll
        for (unsigned j = 0; j < 16; ++j) { const unsigned c = xb_ld(&bar[XB_XCNT(j)]); sum += c; cnt += (c > 0u) ? 1u : 0u; }
        if (sum == G) break;
        __builtin_amdgcn_s_sleep(1);
        if ((++sp & 255u) == 0u) { if (xb_ld(&bar[XB_TMO])) break; if (sp > XB_SPIN_CAP) { atomicAdd(&bar[XB_TMO], 1u); break; } }
    }
    mine = xb_ld(&bar[XB_XCNT(x)]);
    nloc = mine > 0u ? mine : 1u; nx = cnt > 0u ? cnt : 1u;
}

__device__ __forceinline__ void xcd_barrier(const XcdBarrier& b) {
    asm volatile("s_waitcnt vmcnt(0)" ::: "memory");
    __syncthreads();
    if (threadIdx.x == 0) {
        unsigned* bar = b.bar;
        __builtin_amdgcn_s_waitcnt(0);
        unsigned nloc = b.st[0], nx = b.st[1];
        if (nloc == 0u) { xcd_barrier_complete(bar, b.x, nloc, nx); b.st[0] = nloc; b.st[1] = nx; }
        const unsigned old = xb_add(&bar[XB_XSUB(b.x)], 1u);
        const unsigned gen = old / nloc;
        if (old + 1u == (gen + 1u) * nloc) {
            __builtin_amdgcn_fence(__ATOMIC_RELEASE, "agent");
            asm volatile("s_waitcnt vmcnt(0)" ::: "memory");
            const unsigned og = xb_add(&bar[XB_TOP], 1u);
            const unsigned tg = og / nx;
            if (og + 1u == (tg + 1u) * nx) xb_add(&bar[XB_TOPGEN], 1u);
            else XB_SPIN(xb_ld(&bar[XB_TOPGEN]) == tg, bar);
            __builtin_amdgcn_fence(__ATOMIC_ACQUIRE, "agent");
            xb_add(&bar[XB_XGEN(b.x)], 1u);
            asm volatile("s_waitcnt vmcnt(0)" ::: "memory");
        } else {
            XB_SPIN(xb_ld(&bar[XB_XGEN(b.x)]) == gen, bar);
            __builtin_amdgcn_fence(__ATOMIC_ACQUIRE, "agent");
            asm volatile("s_waitcnt vmcnt(0)" ::: "memory");
        }
    }
    __syncthreads();
}
constexpr int NWAVES = 8;
constexpr int DM = 1024, MP = 32768, MS = 512, MROWS = MP + MS, NSEQ = 20, DEPTH = 4, DFF = 2816, DIN = 9216, PAST = 2048;
constexpr int NCHUNK_P = 512, NCHUNK = 528;
constexpr float EPS = 1e-6f;
constexpr size_t OY_P = 0, OY_S = 33554432, OK_P = 34078720, OV_P = 168296448, OS_P = 302514176, OK_S = 304611328, OV_S = 306708480, OS_S = 308805632, OUT_TOTAL = 317194240;

constexpr size_t MiB = 1u << 20;
constexpr size_t WS_CTL = 0, CTL_ZERO_BYTES = 1 * MiB;
constexpr size_t WS_MOD = 1 * MiB;
constexpr size_t WS_LB = 4 * MiB;
constexpr size_t WS_W = 8 * MiB, W_LAYER = 57 * MiB;
constexpr size_t WO_GU1 = 0, WO_D1 = 11 * MiB, WO_IN = 16 * MiB + MiB / 2, WO_BA = 34 * MiB + MiB / 2, WO_BH = 36 * MiB + MiB / 2, WO_OUT = 38 * MiB + MiB / 2, WO_GU2 = 40 * MiB + MiB / 2, WO_D2 = 51 * MiB + MiB / 2;
constexpr size_t WS_X = 240 * MiB;
constexpr size_t WS_XN = 370 * MiB;
constexpr size_t WS_Q = 435 * MiB, WS_K = 500 * MiB, WS_V = 565 * MiB;
constexpr size_t WS_QQ = 630 * MiB, WS_KK = 695 * MiB, WS_VV = 760 * MiB, WS_HGS = 825 * MiB, WS_SZA = 890 * MiB, WS_SZH = 955 * MiB;
constexpr size_t WS_LOGF = 1020 * MiB;
constexpr size_t WS_O1 = 1150 * MiB, WS_O2 = 1215 * MiB, WS_OATT = 1280 * MiB, WS_OH = 1345 * MiB, WS_MRG = 1410 * MiB;
constexpr size_t WS_BIG = 1475 * MiB;
constexpr size_t WS_SST = 1739 * MiB;
constexpr size_t WS_DD = 1871 * MiB;
constexpr size_t WS_END = 1874 * MiB;
constexpr int CW_BAR = 4096;
static_assert(pg8::EpiWin::O_Q == WS_Q && pg8::EpiWin::O_K == WS_K && pg8::EpiWin::O_V == WS_V && pg8::EpiWin::O_QQ == WS_QQ && pg8::EpiWin::O_KK == WS_KK && pg8::EpiWin::O_VV == WS_VV && pg8::EpiWin::O_HGS == WS_HGS && pg8::EpiWin::O_SZA == WS_SZA && pg8::EpiWin::O_SZH == WS_SZH && pg8::EpiWin::O_LOGF == WS_LOGF && pg8::EpiWin::O_LB == WS_LB && pg8::EpiWin::OK_P_ == OK_P && pg8::EpiWin::OV_P_ == OV_P && pg8::EpiWin::OK_S_ == OK_S && pg8::EpiWin::OV_S_ == OV_S, "EpiWin offsets");

constexpr int RING_OFF = 0, RING_BYTES = 131072;
constexpr int LDSCTL_OFF = RING_BYTES, MISC_OFF = LDSCTL_OFF + 320;
constexpr int LDS_BYTES = 147456;

struct Frame {
    LAS unsigned char* lds;
    volatile LAS unsigned* MISC;
    gu32* ctl;
    int tid, lane, wave;
    int vcu, G;
};
typedef float f32x16 __attribute__((ext_vector_type(16)));
typedef unsigned v2u __attribute__((ext_vector_type(2)));

__device__ __forceinline__ float wave_sum(float v) {
#pragma unroll
    for (int o = 1; o < 64; o <<= 1) v += __shfl_xor(v, o);
    return v;
}
__device__ __forceinline__ float bf2f(bf16 b) { return __builtin_bit_cast(float, (unsigned)b << 16); }
__device__ __forceinline__ unsigned cvtpk(float lo, float hi) { return pg8::cvt_pk_bf16(lo, hi); }
__device__ __forceinline__ bf16x8 pack8(f32x4 a, f32x4 b) { v4u w; w.x = cvtpk(a[0], a[1]); w.y = cvtpk(a[2], a[3]); w.z = cvtpk(b[0], b[1]); w.w = cvtpk(b[2], b[3]); return __builtin_bit_cast(bf16x8, w); }
__device__ __forceinline__ float lam_init_of(int l) { return 0.8f - 0.6f * __expf(-0.3f * (float)l); }

__device__ __forceinline__ void p0_transpose_item(const float* W, int K, int N, bf16* WT, bool gu, LAS float* scr, int item, int lane) {
    const int nblk = N / 32, kb = item / nblk, nb = item % nblk, k0 = 64 * kb, nd0 = 32 * nb;
    const int ns0 = gu ? (((nd0 >> 7) & 1) * 2816 + (nd0 >> 8) * 128 + (nd0 & 127)) : nd0;
#pragma unroll 8
    for (int i = 0; i < 32; ++i) { const int kk = 2 * i + (lane >> 5); scr[kk * 33 + (lane & 31)] = W[(size_t)(k0 + kk) * N + ns0 + (lane & 31)]; }
    LDS_WAIT(); asm volatile("" ::: "memory");
    const int c = lane & 7;
#pragma unroll
    for (int j = 0; j < 4; ++j) { const int n = (lane >> 3) + 8 * j; const LAS float* s = scr + (8 * c) * 33 + n;
        v4u o; o.x = pk2(s[0 * 33], s[1 * 33]); o.y = pk2(s[2 * 33], s[3 * 33]); o.z = pk2(s[4 * 33], s[5 * 33]); o.w = pk2(s[6 * 33], s[7 * 33]);
        *(GAS v4u*)(WT + (size_t)(nd0 + n) * K + k0 + 8 * c) = o; }
    LDS_WAIT(); asm volatile("" ::: "memory");
}
typedef const __attribute__((address_space(4))) char* kaptr_t;
__device__ __forceinline__ const float* karg(int i) { kaptr_t ka = (kaptr_t)__builtin_amdgcn_kernarg_segment_ptr(); asm volatile("" : "+s"(ka)); return *(const float* const __attribute__((address_space(4)))*)(ka + 8 * i); }
enum { A_XP = 0, A_XS, A_CK, A_CV, A_ST, A_CP, A_CS, A_WADA, A_BADA, A_GFFN1, A_WGU1, A_WD1, A_GMIX, A_WIN, A_LAM, A_GSUB, A_LBL, A_GHG, A_WBA, A_WBH, A_WOUT, A_GFFN2, A_WGU2, A_WD2, A_GFIN, A_OUT, A_WS };
__device__ __forceinline__ void p0_prologue(Frame& F, unsigned char* ws) {
    { LAS float* scr = (LAS float*)(F.lds + RING_OFF + F.wave * 16384);
      const int gw = F.vcu * NWAVES + F.wave, NGW = F.G * NWAVES;
      constexpr int I_GU = 16 * 176, I_D = 44 * 32, I_IN = 16 * 288, I_SQ = 16 * 32, I_LAYER = 2 * I_GU + 2 * I_D + I_IN + 3 * I_SQ;
      for (int it = gw; it < DEPTH * I_LAYER; it += NGW) {
          const int l = it / I_LAYER; int r = it % I_LAYER; unsigned char* wl = ws + WS_W + (size_t)l * W_LAYER;
          if (r < I_GU) { p0_transpose_item(karg(A_WGU1) + (size_t)l * 1024 * 5632, 1024, 5632, (bf16*)(wl + WO_GU1), true, scr, r, F.lane); continue; } r -= I_GU;
          if (r < I_D)  { p0_transpose_item(karg(A_WD1) + (size_t)l * 2816 * 1024, 2816, 1024, (bf16*)(wl + WO_D1), false, scr, r, F.lane); continue; } r -= I_D;
          if (r < I_IN) { p0_transpose_item(karg(A_WIN) + (size_t)l * 1024 * 9216, 1024, 9216, (bf16*)(wl + WO_IN), false, scr, r, F.lane); continue; } r -= I_IN;
          if (r < I_SQ) { p0_transpose_item(karg(A_WBA) + (size_t)l * 1024 * 1024, 1024, 1024, (bf16*)(wl + WO_BA), false, scr, r, F.lane); continue; } r -= I_SQ;
          if (r < I_SQ) { p0_transpose_item(karg(A_WBH) + (size_t)l * 1024 * 1024, 1024, 1024, (bf16*)(wl + WO_BH), false, scr, r, F.lane); continue; } r -= I_SQ;
          if (r < I_SQ) { p0_transpose_item(karg(A_WOUT) + (size_t)l * 1024 * 1024, 1024, 1024, (bf16*)(wl + WO_OUT), false, scr, r, F.lane); continue; } r -= I_SQ;
          if (r < I_GU) { p0_transpose_item(karg(A_WGU2) + (size_t)l * 1024 * 5632, 1024, 5632, (bf16*)(wl + WO_GU2), true, scr, r, F.lane); continue; } r -= I_GU;
          p0_transpose_item(karg(A_WD2) + (size_t)l * 2816 * 1024, 2816, 1024, (bf16*)(wl + WO_D2), false, scr, r, F.lane);
      } }
    __syncthreads();
    { const float* c_p = karg(A_CP); const float* c_s = karg(A_CS); const float* w_ada = karg(A_WADA); const float* b_ada = karg(A_BADA);
      LAS float* ca = (LAS float*)(F.lds);
      LAS float* red = (LAS float*)(F.lds + 81920);
      for (int i = F.tid; i < NSEQ * 1024; i += NWAVES * 64) { const int s = i >> 10, k = i & 1023; const float c = s < 4 ? c_p[s * 1024 + k] : c_s[(s - 4) * 1024 + k]; ca[i] = pg8::silu_f(c); }
      __syncthreads();
      float* MOD = (float*)(ws + WS_MOD);
      for (int it = F.vcu; it < DEPTH * 144; it += F.G) {
          const int l = it / 144, n = (it % 144) * 64 + F.lane; const float* wp = w_ada + ((size_t)l * 1024 + F.wave * 128) * 9216 + n;
          float acc[NSEQ];
#pragma unroll
          for (int s = 0; s < NSEQ; ++s) acc[s] = 0.f;
#pragma unroll 4
          for (int k = 0; k < 128; ++k) { const float w = wp[(size_t)k * 9216];
#pragma unroll
              for (int s = 0; s < NSEQ; ++s) acc[s] += ca[s * 1024 + F.wave * 128 + k] * w; }
#pragma unroll
          for (int s = 0; s < NSEQ; ++s) red[(F.wave * NSEQ + s) * 64 + F.lane] = acc[s];
          __syncthreads();
          for (int i = F.tid; i < NSEQ * 64; i += NWAVES * 64) { const int s = i >> 6, c = i & 63; float v = 0.f;
#pragma unroll
              for (int w = 0; w < 8; ++w) v += red[(w * NSEQ + s) * 64 + c];
              const int nn = (it % 144) * 64 + c; MOD[((size_t)l * NSEQ + s) * 9216 + nn] = v + b_ada[(size_t)l * 9216 + nn]; }
          __syncthreads();
      } }
    if (F.vcu == 0) { float* LB = (float*)(ws + WS_LB); const float* lb_logits = karg(A_LBL);
        for (int c = F.tid; c < 1024; c += NWAVES * 64) { float lg[4], mx = -INFINITY;
#pragma unroll
            for (int l = 0; l < 4; ++l) { lg[l] = lb_logits[l * 1024 + c]; mx = __builtin_fmaxf(mx, lg[l]); }
            float sum = 0.f;
#pragma unroll
            for (int l = 0; l < 4; ++l) { lg[l] = __expf(lg[l] - mx); sum += lg[l]; }
            const float inv = 1.f / sum; float cs = 0.f;
#pragma unroll
            for (int l = 0; l < 4; ++l) { cs += lg[l] * inv; LB[l * 1024 + c] = cs - lg[0] * inv; } } }
}

__device__ __forceinline__ void norm_phase(Frame& F, const float* x_p, const float* x_s, bool first, float* X, const float* g, const float* mod_l, int sub, bf16* XN) {
    const int gw = F.vcu * NWAVES + F.wave, NGW = F.G * NWAVES;
    for (int row = gw; row < MROWS; row += NGW) {
        const float* src = first ? (row < MP ? x_p + (size_t)row * DM : x_s + (size_t)(row - MP) * DM) : X + (size_t)row * DM;
        const float* mp = mod_l + (size_t)pg8::row_seq(row) * 9216 + sub * 3 * 1024;
        const f32x4* xr = (const f32x4*)src + F.lane; f32x4 v[4]; float s2 = 0.f;
#pragma unroll
        for (int j = 0; j < 4; ++j) { v[j] = xr[64 * j]; s2 += (v[j].x * v[j].x + v[j].y * v[j].y) + (v[j].z * v[j].z + v[j].w * v[j].w); }
        const float rstd = __builtin_amdgcn_rsqf(wave_sum(s2) * (1.f / DM) + EPS);
        if (first) { f32x4* xo = (f32x4*)(X + (size_t)row * DM) + F.lane;
#pragma unroll
            for (int j = 0; j < 4; ++j) xo[64 * j] = v[j]; }
        v2u* o8 = (v2u*)(XN + (size_t)row * DM) + F.lane;
#pragma unroll
        for (int j = 0; j < 4; ++j) { const int c = 4 * F.lane + 256 * j; const f32x4 gg = *(const f32x4*)(g + c), sh = *(const f32x4*)(mp + c), sc = *(const f32x4*)(mp + 1024 + c);
            const f32x4 h = (v[j] * rstd) * gg * (sc + 1.f) + sh; v2u o; o.x = cvtpk(h.x, h.y); o.y = cvtpk(h.z, h.w); o8[64 * j] = o; }
    }
}
__device__ __forceinline__ void final_norm_phase(Frame& F, const float* X, const float* g, float* out) {
    const int gw = F.vcu * NWAVES + F.wave, NGW = F.G * NWAVES;
    for (int row = gw; row < MROWS; row += NGW) {
        const f32x4* xr = (const f32x4*)(X + (size_t)row * DM) + F.lane; f32x4 v[4]; float s2 = 0.f;
#pragma unroll
        for (int j = 0; j < 4; ++j) { v[j] = xr[64 * j]; s2 += (v[j].x * v[j].x + v[j].y * v[j].y) + (v[j].z * v[j].z + v[j].w * v[j].w); }
        const float rstd = __builtin_amdgcn_rsqf(wave_sum(s2) * (1.f / DM) + EPS);
        f32x4* o = (f32x4*)(out + (row < MP ? OY_P + (size_t)row * DM : OY_S + (size_t)(row - MP) * DM)) + F.lane;
#pragma unroll
        for (int j = 0; j < 4; ++j) { const f32x4 gg = *(const f32x4*)(g + 4 * F.lane + 256 * j); o[64 * j] = (v[j] * rstd) * gg; }
    }
}
__device__ __forceinline__ float lam_of(const float* att_lambda, int l, int lane) {
    const float* lp = att_lambda + (size_t)l * 256;
    const float a = wave_sum(lp[lane] * lp[64 + lane]), b = wave_sum(lp[128 + lane] * lp[192 + lane]);
    return __expf(a) - __expf(b) + lam_init_of(l);
}
__device__ __forceinline__ void attn_combine_phase(Frame& F, const bf16* O1, const bf16* O2, const float* gsub, float lam, float osc, bf16* OATT) {
    const int gw = F.vcu * NWAVES + F.wave, NGW = F.G * NWAVES; const int cl = (F.lane & 7) * 16;
    float gv[16];
#pragma unroll
    for (int i = 0; i < 16; ++i) gv[i] = gsub[cl + i] * osc;
    for (int row = gw; row < MP; row += NGW) {
        const size_t off = (size_t)row * DM + F.lane * 16; const v4u a0 = *(const v4u*)(O1 + off), a1 = *(const v4u*)(O1 + off + 8), b0 = *(const v4u*)(O2 + off), b1 = *(const v4u*)(O2 + off + 8);
        const unsigned aw[8] = {a0.x, a0.y, a0.z, a0.w, a1.x, a1.y, a1.z, a1.w}, bw[8] = {b0.x, b0.y, b0.z, b0.w, b1.x, b1.y, b1.z, b1.w};
        float o[16]; float ss = 0.f;
#pragma unroll
        for (int i = 0; i < 8; ++i) { o[2 * i] = pg8::bf_lo(aw[i]) - lam * pg8::bf_lo(bw[i]); o[2 * i + 1] = pg8::bf_hi(aw[i]) - lam * pg8::bf_hi(bw[i]); ss += o[2 * i] * o[2 * i] + o[2 * i + 1] * o[2 * i + 1]; }
        ss += __shfl_xor(ss, 1); ss += __shfl_xor(ss, 2); ss += __shfl_xor(ss, 4);
        const float rstd = __builtin_amdgcn_rsqf(ss * (1.f / 128.f) + EPS);
        v4u w0, w1;
        w0.x = cvtpk(o[0] * rstd * gv[0], o[1] * rstd * gv[1]); w0.y = cvtpk(o[2] * rstd * gv[2], o[3] * rstd * gv[3]); w0.z = cvtpk(o[4] * rstd * gv[4], o[5] * rstd * gv[5]); w0.w = cvtpk(o[6] * rstd * gv[6], o[7] * rstd * gv[7]);
        w1.x = cvtpk(o[8] * rstd * gv[8], o[9] * rstd * gv[9]); w1.y = cvtpk(o[10] * rstd * gv[10], o[11] * rstd * gv[11]); w1.z = cvtpk(o[12] * rstd * gv[12], o[13] * rstd * gv[13]); w1.w = cvtpk(o[14] * rstd * gv[14], o[15] * rstd * gv[15]);
        *(v4u*)(OATT + off) = w0; *(v4u*)(OATT + off + 8) = w1;
    }
}

__device__ __forceinline__ void attn_sample_unit(Frame& F, const float* cache_k, const float* cache_v, int l, int s, int head, const bf16* Qb, const bf16* Kb, const bf16* Vb, float lam, float osc, const float* gsub, bf16* OATT) {
    const int lane = F.lane, w = F.wave, q = lane & 31, hh = lane >> 5, vt = w & 3, kh = w >> 2;
    LAS float* SLOT = (LAS float*)(F.lds);
    LAS float* ML = (LAS float*)(F.lds + 16384);
    LAS float* SSQ = (LAS float*)(F.lds + 16384 + 512);
    const size_t qrow = (size_t)MP + (size_t)s * 32;
    const float* ck = cache_k + ((size_t)(l * 16 + s) * PAST) * 1024 + head * 128;
    const float* cv = cache_v + ((size_t)(l * 16 + s) * PAST) * 1024 + head * 128;
    f32x16 o1;
#pragma unroll
    for (int r = 0; r < 16; ++r) o1[r] = 0.f;
    for (int m = 0; m < 2; ++m) {
        bf16x8 qf[4];
#pragma unroll
        for (int ks = 0; ks < 4; ++ks) qf[ks] = *(const bf16x8*)(Qb + (qrow + q) * 1024 + head * 128 + m * 64 + ks * 16 + 8 * hh);
        float mrun = -INFINITY, lrun = 0.f; f32x16 ot;
#pragma unroll
        for (int r = 0; r < 16; ++r) ot[r] = 0.f;
        const int ntile = 32 + kh;
        for (int t = 0; t < ntile; ++t) {
            const bool nw = (t == 32); const int key0 = kh * 1024 + t * 32;
            bf16x8 kf[4];
            if (!nw) { const float* kp = ck + (size_t)(key0 + q) * 1024 + m * 64 + 8 * hh;
#pragma unroll
                for (int ks = 0; ks < 4; ++ks) { const f32x4 a = *(const f32x4*)(kp + ks * 16), b = *(const f32x4*)(kp + ks * 16 + 4); kf[ks] = pack8(a, b); } }
            else {
#pragma unroll
                for (int ks = 0; ks < 4; ++ks) kf[ks] = *(const bf16x8*)(Kb + (qrow + q) * 1024 + head * 128 + m * 64 + ks * 16 + 8 * hh); }
            float vf[2][8];
            { const float* vp = cv + (size_t)(key0 + 4 * hh) * 1024 + 32 * vt + q; const bf16* vpn = Vb + (qrow + 4 * hh) * 1024 + head * 128 + 32 * vt + q;
#pragma unroll
              for (int s2 = 0; s2 < 2; ++s2)
#pragma unroll
                  for (int j = 0; j < 8; ++j) { const int kr = 16 * s2 + 8 * (j >> 2) + (j & 3);
                      vf[s2][j] = nw ? bf2f(vpn[kr * 1024]) : vp[kr * 1024]; } }
            f32x16 st;
#pragma unroll
            for (int r = 0; r < 16; ++r) st[r] = 0.f;
#pragma unroll
            for (int ks = 0; ks < 4; ++ks) st = __builtin_amdgcn_mfma_f32_32x32x16_bf16(kf[ks], qf[ks], st, 0, 0, 0);
            float tm = st[0];
#pragma unroll
            for (int r = 1; r < 16; ++r) tm = __builtin_fmaxf(tm, st[r]);
            tm = __builtin_fmaxf(tm, __shfl_xor(tm, 32));
            const float mnew = __builtin_fmaxf(mrun, tm), alpha = __builtin_amdgcn_exp2f(mrun - mnew);
            float ls = 0.f;
#pragma unroll
            for (int r = 0; r < 16; ++r) { st[r] = __builtin_amdgcn_exp2f(st[r] - mnew); ls += st[r]; }
            ls += __shfl_xor(ls, 32);
            lrun = lrun * alpha + ls; mrun = mnew;
#pragma unroll
            for (int r = 0; r < 16; ++r) ot[r] *= alpha;
#pragma unroll
            for (int s2 = 0; s2 < 2; ++s2) { v4u pw; pw.x = cvtpk(st[8 * s2], st[8 * s2 + 1]); pw.y = cvtpk(st[8 * s2 + 2], st[8 * s2 + 3]); pw.z = cvtpk(st[8 * s2 + 4], st[8 * s2 + 5]); pw.w = cvtpk(st[8 * s2 + 6], st[8 * s2 + 7]);
                v4u aw; aw.x = cvtpk(vf[s2][0], vf[s2][1]); aw.y = cvtpk(vf[s2][2], vf[s2][3]); aw.z = cvtpk(vf[s2][4], vf[s2][5]); aw.w = cvtpk(vf[s2][6], vf[s2][7]);
                ot = __builtin_amdgcn_mfma_f32_32x32x16_bf16(__builtin_bit_cast(bf16x8, aw), __builtin_bit_cast(bf16x8, pw), ot, 0, 0, 0); }
        }
        if (vt == 0 && hh == 0) { ML[(kh * 32 + q) * 2] = mrun; ML[(kh * 32 + q) * 2 + 1] = lrun; }
        __syncthreads();
        const float m0 = ML[q * 2], l0 = ML[q * 2 + 1], m1 = ML[(32 + q) * 2], l1 = ML[(32 + q) * 2 + 1];
        const float Mx = __builtin_fmaxf(m0, m1), L = l0 * __builtin_amdgcn_exp2f(m0 - Mx) + l1 * __builtin_amdgcn_exp2f(m1 - Mx);
        { const float sc = __builtin_amdgcn_exp2f(mrun - Mx);
#pragma unroll
          for (int r = 0; r < 16; ++r) ot[r] *= sc; }
        if (kh == 1) {
#pragma unroll
            for (int r = 0; r < 16; ++r) SLOT[(vt * 16 + r) * 64 + lane] = ot[r]; }
        __syncthreads();
        if (kh == 0) { const float rl = 1.f / L;
#pragma unroll
            for (int r = 0; r < 16; ++r) ot[r] = (ot[r] + SLOT[(vt * 16 + r) * 64 + lane]) * rl;
            if (m == 0) {
#pragma unroll
                for (int r = 0; r < 16; ++r) o1[r] = ot[r];
            } else { float ss = 0.f;
#pragma unroll
                for (int r = 0; r < 16; ++r) { o1[r] = o1[r] - lam * ot[r]; ss += o1[r] * o1[r]; }
                ss += __shfl_xor(ss, 32);
                if (hh == 0) SSQ[vt * 32 + q] = ss; } }
        __syncthreads();
    }
    if (kh == 0) {
        const float ss = SSQ[q] + SSQ[32 + q] + SSQ[64 + q] + SSQ[96 + q];
        const float rstd = __builtin_amdgcn_rsqf(ss * (1.f / 128.f) + EPS) * osc;
#pragma unroll
        for (int r = 0; r < 16; ++r) { const int v = 32 * vt + (r & 3) + 8 * (r >> 2) + 4 * hh; OATT[(qrow + q) * 1024 + head * 128 + v] = (bf16)f2bf(o1[r] * rstd * gsub[v]); }
    }
    __syncthreads();
}

constexpr int HS = 72, HK = 136;
__device__ __forceinline__ f32x4 mfma16(bf16x8 a, bf16x8 b, f32x4 c) { return __builtin_amdgcn_mfma_f32_16x16x32_bf16(a, b, c, 0, 0, 0); }
__device__ __forceinline__ void st16bf(LAS bf16* p, const float (&v)[16]) {
    v4u a, b; a.x = cvtpk(v[0], v[1]); a.y = cvtpk(v[2], v[3]); a.z = cvtpk(v[4], v[5]); a.w = cvtpk(v[6], v[7]); b.x = cvtpk(v[8], v[9]); b.y = cvtpk(v[10], v[11]); b.z = cvtpk(v[12], v[13]); b.w = cvtpk(v[14], v[15]);
    *(LAS v4u*)p = a; *(LAS v4u*)(p + 8) = b;
}
__device__ __forceinline__ void h1_unit(Frame& F, int cid, int h, const float* LOGF, const bf16* KK, const bf16* VV, float* DS, float* DD) {
    LAS float* seg = (LAS float*)(F.lds);
    LAS bf16* KT = (LAS bf16*)(F.lds + 2048); LAS bf16* VT = KT + 128 * HS;
    const int k = F.tid & 127, sg = F.tid >> 7;
    const bool samp = cid >= NCHUNK_P; const int nvalid = samp ? 32 : 64; const size_t row0 = samp ? (size_t)MP + (size_t)(cid - NCHUNK_P) * 32 : (size_t)cid * 64;
    const size_t cbase = row0 * 1024 + h * 128 + k;
    float c[16]; float run = 0.f;
#pragma unroll
    for (int i = 0; i < 16; ++i) { const int r = sg * 16 + i; const float lf = (r < nvalid) ? LOGF[cbase + (size_t)r * 1024] : 0.f; run += lf; c[i] = run; }
    seg[sg * 128 + k] = run;
    __syncthreads();
    float pre = 0.f, tot = 0.f;
#pragma unroll
    for (int s = 0; s < 4; ++s) { const float v = seg[s * 128 + k]; tot += v; pre += (s < sg) ? v : 0.f; }
    float e[16];
#pragma unroll
    for (int i = 0; i < 16; ++i) { const int r = sg * 16 + i; const float kv = (r < nvalid) ? bf2f(KK[cbase + (size_t)r * 1024]) : 0.f; e[i] = kv * __expf(tot - (pre + c[i])); }
    st16bf(KT + k * HS + sg * 16, e);
#pragma unroll
    for (int i = 0; i < 16; ++i) { const int r = sg * 16 + i; e[i] = (r < nvalid) ? bf2f(VV[cbase + (size_t)r * 1024]) : 0.f; }
    st16bf(VT + k * HS + sg * 16, e);
    const size_t ch = (size_t)cid * 8 + h;
    if (sg == 0) DD[ch * 128 + k] = __expf(tot);
    __syncthreads();
    { const int w = F.wave, lr = F.lane & 15, lq = F.lane >> 4;
      bf16x8 af[2];
#pragma unroll
      for (int ks = 0; ks < 2; ++ks) af[ks] = *(const LAS bf16x8*)(VT + (16 * w + lr) * HS + ks * 32 + 8 * lq);
#pragma unroll
      for (int n = 0; n < 8; ++n) { f32x4 acc = {0.f, 0.f, 0.f, 0.f};
#pragma unroll
          for (int ks = 0; ks < 2; ++ks) { const bf16x8 bf = *(const LAS bf16x8*)(KT + (16 * n + lr) * HS + ks * 32 + 8 * lq); acc = mfma16(af[ks], bf, acc); }
#pragma unroll
          for (int r = 0; r < 4; ++r) DS[(ch * 128 + 16 * w + 4 * lq + r) * 128 + 16 * n + lr] = acc[r]; } }
    __syncthreads();
}
__device__ __forceinline__ void h2_phase(Frame& F, const float* state, int l, const float* DS, const float* DD, bf16* SST, float* out) {
    const int gt = F.vcu * (NWAVES * 64) + F.tid, NT = F.G * NWAVES * 64;
    for (int g = gt; g < 4 * 8 * 128 * 32; g += NT) {
        const int kq = g & 31, v = (g >> 5) & 127, h = (g >> 12) & 7, b = g >> 15;
        f32x4 S = {0.f, 0.f, 0.f, 0.f};
#pragma unroll 4
        for (int c = 0; c < 128; ++c) { const size_t ch = (size_t)(b * 128 + c) * 8 + h, base = (ch * 128 + v) * 128 + kq * 4;
            v2u o; o.x = cvtpk(S.x, S.y); o.y = cvtpk(S.z, S.w); *(v2u*)(SST + base) = o;
            const f32x4 dl = *(const f32x4*)(DS + base), dv = *(const f32x4*)(DD + ch * 128 + kq * 4); S = dv * S + dl; }
        float* so = out + OS_P + ((size_t)((l * 4 + b) * 8 + h) * 128 + kq * 4) * 128 + v;
        so[0] = S.x; so[128] = S.y; so[256] = S.z; so[384] = S.w;
    }
    for (int g = gt; g < 16 * 8 * 32 * 128; g += NT) {
        const int v = g & 127, kq = (g >> 7) & 31, h = (g >> 12) & 7, s = g >> 15;
        const size_t ch = (size_t)(NCHUNK_P + s) * 8 + h, base = (ch * 128 + v) * 128 + kq * 4;
        const float* s0 = state + ((size_t)((l * 16 + s) * 8 + h) * 128 + kq * 4) * 128 + v;
        const f32x4 S = {s0[0], s0[128], s0[256], s0[384]};
        v2u o; o.x = cvtpk(S.x, S.y); o.y = cvtpk(S.z, S.w); *(v2u*)(SST + base) = o;
        const f32x4 dl = *(const f32x4*)(DS + base), dv = *(const f32x4*)(DD + ch * 128 + kq * 4); const f32x4 Sn = dv * S + dl;
        float* so = out + OS_S + ((size_t)((l * 16 + s) * 8 + h) * 128 + kq * 4) * 128 + v;
        so[0] = Sn.x; so[128] = Sn.y; so[256] = Sn.z; so[384] = Sn.w;
    }
}
__device__ __forceinline__ void h3_unit(Frame& F, int cid, int h, const float* LOGF, const bf16* QQ, const bf16* KK, const bf16* VV, const bf16* HGS, const bf16* SST, const float* ghg, bf16* OH) {
    LAS float* seg = (LAS float*)(F.lds);
    LAS float* part = (LAS float*)(F.lds + 2048);
    LAS bf16* QH = (LAS bf16*)(F.lds + 4096);
    LAS bf16* QT = QH + 64 * HK;
    LAS bf16* KH = QT + 64 * HK;
    LAS bf16* VT = KH + 160 * HK;
    LAS bf16* AL = VT + 128 * HS;
    const int k = F.tid & 127, sg = F.tid >> 7;
    const bool samp = cid >= NCHUNK_P; const int nvalid = samp ? 32 : 64; const size_t row0 = samp ? (size_t)MP + (size_t)(cid - NCHUNK_P) * 32 : (size_t)cid * 64;
    const size_t cbase = row0 * 1024 + h * 128 + k;
    float c[16]; float run = 0.f;
#pragma unroll
    for (int i = 0; i < 16; ++i) { const int r = sg * 16 + i; const float lf = (r < nvalid) ? LOGF[cbase + (size_t)r * 1024] : 0.f; run += lf; c[i] = run; }
    seg[sg * 128 + k] = run;
    __syncthreads();
    float pre[4]; { float p = 0.f;
#pragma unroll
        for (int s = 0; s < 4; ++s) { pre[s] = p; p += seg[s * 128 + k]; } }
    float mypre = 0.f;
#pragma unroll
    for (int s = 0; s < 4; ++s) mypre = (s == sg) ? pre[s] : mypre;
#pragma unroll
    for (int i = 0; i < 16; ++i) { const int r = sg * 16 + i; const float qv = (r < nvalid) ? bf2f(QQ[cbase + (size_t)r * 1024]) : 0.f;
        QH[r * HK + k] = (bf16)f2bf(qv * __expf(c[i])); QT[r * HK + k] = (bf16)f2bf(qv * __expf(mypre + c[i])); }
#pragma unroll
    for (int i = 0; i < 16; ++i) { const int r = sg * 16 + i; const float kv = (r < nvalid) ? bf2f(KK[cbase + (size_t)r * 1024]) : 0.f;
#pragma unroll
        for (int ii = 0; ii < 4; ++ii) if (ii >= sg) { const int rb = (ii == 0) ? 0 : (ii == 1) ? 16 : (ii == 2) ? 48 : 96;
            KH[(rb + r) * HK + k] = (bf16)f2bf(kv * __expf(__builtin_fminf(pre[ii] - mypre - c[i], 80.f))); } }
    { float e[16];
#pragma unroll
      for (int i = 0; i < 16; ++i) { const int r = sg * 16 + i; e[i] = (r < nvalid) ? bf2f(VV[cbase + (size_t)r * 1024]) : 0.f; }
      st16bf(VT + k * HS + sg * 16, e); }
    __syncthreads();
    const int w = F.wave, lr = F.lane & 15, lq = F.lane >> 4;
#pragma unroll
    for (int rr = 0; rr < 2; ++rr) { const int blk = w + 8 * rr, bi = blk >> 2, bj = blk & 3;
        f32x4 acc = {0.f, 0.f, 0.f, 0.f};
        if (bj <= bi) { const int rb = (bi == 0) ? 0 : (bi == 1) ? 16 : (bi == 2) ? 48 : 96;
#pragma unroll
            for (int ks = 0; ks < 4; ++ks) { const bf16x8 a = *(const LAS bf16x8*)(QH + (16 * bi + lr) * HK + ks * 32 + 8 * lq), b = *(const LAS bf16x8*)(KH + (rb + 16 * bj + lr) * HK + ks * 32 + 8 * lq); acc = mfma16(a, b, acc); }
            if (bi == bj) {
#pragma unroll
                for (int r = 0; r < 4; ++r) acc[r] = (lr <= 4 * lq + r) ? acc[r] : 0.f; } }
#pragma unroll
        for (int r = 0; r < 4; ++r) AL[(16 * bi + 4 * lq + r) * HS + 16 * bj + lr] = (bf16)f2bf(acc[r]); }
    __syncthreads();
    const size_t ch = (size_t)cid * 8 + h;
    bf16x8 bS[4], bV[2];
#pragma unroll
    for (int ks = 0; ks < 4; ++ks) bS[ks] = *(const bf16x8*)(SST + (ch * 128 + 16 * w + lr) * 128 + ks * 32 + 8 * lq);
#pragma unroll
    for (int ks = 0; ks < 2; ++ks) bV[ks] = *(const LAS bf16x8*)(VT + (16 * w + lr) * HS + ks * 32 + 8 * lq);
    f32x4 o[4];
#pragma unroll
    for (int mt = 0; mt < 4; ++mt) { f32x4 acc = {0.f, 0.f, 0.f, 0.f};
#pragma unroll
        for (int ks = 0; ks < 4; ++ks) acc = mfma16(*(const LAS bf16x8*)(QT + (16 * mt + lr) * HK + ks * 32 + 8 * lq), bS[ks], acc);
#pragma unroll
        for (int ks = 0; ks < 2; ++ks) acc = mfma16(*(const LAS bf16x8*)(AL + (16 * mt + lr) * HS + ks * 32 + 8 * lq), bV[ks], acc);
        o[mt] = acc;
#pragma unroll
        for (int r = 0; r < 4; ++r) { float p = acc[r] * acc[r]; p += __shfl_xor(p, 1); p += __shfl_xor(p, 2); p += __shfl_xor(p, 4); p += __shfl_xor(p, 8); if (lr == 0) part[(16 * mt + 4 * lq + r) * 8 + w] = p; } }
    __syncthreads();
    { const int v = 16 * w + lr; const float gv = ghg[v];
#pragma unroll
      for (int mt = 0; mt < 4; ++mt)
#pragma unroll
          for (int r = 0; r < 4; ++r) { const int t = 16 * mt + 4 * lq + r; float ss = 0.f;
#pragma unroll
              for (int w2 = 0; w2 < 8; ++w2) ss += part[t * 8 + w2];
              const float rstd = __builtin_amdgcn_rsqf(ss * (1.f / 128.f) + EPS);
              if (t < nvalid) { const size_t off = (row0 + t) * 1024 + h * 128 + v; OH[off] = (bf16)f2bf(o[mt][r] * rstd * gv * bf2f(HGS[off])); } } }
    __syncthreads();
}
struct Args { const float* in[25]; float* out; unsigned char* ws; };
__global__ void __launch_bounds__(NWAVES * 64, 2) mk_fwd(Args args) {
    extern __shared__ __attribute__((aligned(16))) unsigned char lds[];
    Frame F;
    F.lds = (LAS unsigned char*)lds;
    F.MISC = (volatile LAS unsigned*)(F.lds + MISC_OFF);
#define ENTER() do { F.tid = opaque_tid(); F.lane = F.tid & 63; F.wave = __builtin_amdgcn_readfirstlane(F.tid >> 6); F.G = gridDim.x; { const int bx = opaque_bid(); F.vcu = (F.G % 8 == 0) ? (bx % 8) * (F.G / 8) + bx / 8 : bx; } } while (0)
    ENTER();
    F.ctl = (gu32*)((unsigned char*)karg(A_WS) + WS_CTL);
    for (int u = F.tid; u < (LDS_BYTES - LDSCTL_OFF) / 4; u += NWAVES * 64) ((LAS unsigned*)(F.lds + LDSCTL_OFF))[u] = 0u;
    __syncthreads();
    XcdBarrier bar = xcd_barrier_post((unsigned*)(F.ctl + CW_BAR), F.MISC + 8);
#define GRID_BAR() xcd_barrier(bar)
#define WSP(T, off) ((T*)((unsigned char*)karg(A_WS) + (off)))
#define OUTP(off) ((float*)karg(A_OUT) + (off))

#ifndef NO_P0
    p0_prologue(F, WSP(unsigned char, 0));
#endif
    GRID_BAR();

    for (int l = 0; l < DEPTH; ++l) {
        const size_t wlo = WS_W + (size_t)l * W_LAYER, modo = WS_MOD + (size_t)l * NSEQ * 9216 * 4;
        norm_phase(F, karg(A_XP), karg(A_XS), l == 0, WSP(float, WS_X), karg(A_GFFN1) + l * 1024, WSP(const float, modo), 0, WSP(bf16, WS_XN));
        GRID_BAR(); ENTER();
#ifndef NO_G1
        { pg8::Gemm g{WSP(bf16, WS_XN), WSP(const bf16, wlo + WO_GU1), MROWS, 2 * DFF, DM}; typedef pg8::FixedOrder<130, 22, 10> Ord; Ord S; S.init(F.G, opaque_bid());
          pg8::EpiSwiglu E{WSP(bf16, WS_BIG)};
          pg8::gemm_phase<pg8::EpiSwiglu, Ord, true, true>(F.lds + RING_OFF, g, S, E); }
#endif
        GRID_BAR(); ENTER();
#ifndef NO_G2
        { pg8::Gemm g{WSP(bf16, WS_BIG), WSP(const bf16, wlo + WO_D1), MROWS, DM, DFF}; typedef pg8::FixedOrder<130, 4, 10> Ord; Ord S; S.init(F.G, opaque_bid());
          pg8::EpiResid E{WSP(float, WS_X), WSP(const float, modo) + 2 * 1024, 0.5f};
          pg8::gemm_phase<pg8::EpiResid, Ord, true, true>(F.lds + RING_OFF, g, S, E); }
#endif
        GRID_BAR(); ENTER();
        norm_phase(F, nullptr, nullptr, false, WSP(float, WS_X), karg(A_GMIX) + l * 1024, WSP(const float, modo), 1, WSP(bf16, WS_XN));
        GRID_BAR(); ENTER();
#ifndef NO_G3
        { pg8::Gemm g{WSP(bf16, WS_XN), WSP(const bf16, wlo + WO_IN), MROWS, DIN, DM}; typedef pg8::FixedOrder<130, 36, 10> Ord; Ord S; S.init(F.G, opaque_bid());
          pg8::EpiWin E{WSP(unsigned char, 0), OUTP(0), l, attn_body::C2};
          pg8::gemm_phase<pg8::EpiWin, Ord, true, true>(F.lds + RING_OFF, g, S, E); }
#endif
        GRID_BAR(); ENTER();
        {
#ifndef NO_ATT
          { const attn_body::bf16* Qb = WSP(const attn_body::bf16, WS_Q); const attn_body::bf16* Kb = WSP(const attn_body::bf16, WS_K); const attn_body::bf16* Vb = WSP(const attn_body::bf16, WS_V); attn_body::bf16* O1 = WSP(attn_body::bf16, WS_O1);
            for (int u = F.vcu; u < 4096; u += F.G) {
              const int vc = u & 255, i = u >> 8, combo = (vc >> 3) + 32 * (i >> 2), s8 = vc & 7, j = i & 3;
              const int qb = (j == 0) ? s8 : (j == 1) ? 15 - s8 : (j == 2) ? 16 + s8 : 31 - s8;
              const int vh = combo & 1, mp = (combo >> 1) & 1, head = (combo >> 2) & 7, b = combo >> 5;
              attn_body::attn_unit<8>(b, head * 2 + mp, head * 2 + vh, qb, Qb, Kb, Vb, O1 + (size_t)mp * ((WS_O2 - WS_O1) / 2), (char*)lds + RING_OFF); } }
#endif
          __syncthreads();
#ifndef NO_SAMP
          if (F.vcu < 128) { const float lam = lam_of(karg(A_LAM), l, F.lane), osc = 1.f - lam_init_of(l);
            for (int u = F.vcu; u < 128; u += F.G) attn_sample_unit(F, karg(A_CK), karg(A_CV), l, u >> 3, u & 7, WSP(const bf16, WS_Q), WSP(const bf16, WS_K), WSP(const bf16, WS_V), lam, osc, karg(A_GSUB) + l * 128, WSP(bf16, WS_OATT)); }
#endif
#ifndef NO_H1
          { const float* LOGF = WSP(const float, WS_LOGF); const bf16* KK = WSP(const bf16, WS_KK); const bf16* VV = WSP(const bf16, WS_VV); float* DS = WSP(float, WS_BIG); float* DD = WSP(float, WS_DD);
            for (int u = F.vcu; u < NCHUNK * 8; u += F.G) h1_unit(F, u >> 3, u & 7, LOGF, KK, VV, DS, DD); }
#endif
        }
        GRID_BAR(); ENTER();
#ifndef NO_H2
        h2_phase(F, karg(A_ST), l, WSP(const float, WS_BIG), WSP(const float, WS_DD), WSP(bf16, WS_SST), OUTP(0));
#endif
        { const float lam = lam_of(karg(A_LAM), l, F.lane), osc = 1.f - lam_init_of(l);
          attn_combine_phase(F, WSP(const bf16, WS_O1), WSP(const bf16, WS_O2), karg(A_GSUB) + l * 128, lam, osc, WSP(bf16, WS_OATT)); }
        GRID_BAR(); ENTER();
#ifndef NO_H3
        { const float* LOGF = WSP(const float, WS_LOGF); const bf16* QQ = WSP(const bf16, WS_QQ); const bf16* KK = WSP(const bf16, WS_KK); const bf16* VV = WSP(const bf16, WS_VV); const bf16* HGS = WSP(const bf16, WS_HGS);
          const bf16* SST = WSP(const bf16, WS_SST); const float* ghg = karg(A_GHG) + l * 128; bf16* OH = WSP(bf16, WS_OH);
          for (int u = F.vcu; u < NCHUNK * 8; u += F.G) h3_unit(F, u >> 3, u & 7, LOGF, QQ, KK, VV, HGS, SST, ghg, OH); }
#endif
        GRID_BAR(); ENTER();
#ifndef NO_G4
        { pg8::Gemm g{WSP(bf16, WS_OATT), WSP(const bf16, wlo + WO_BA), MROWS, DM, DM}; typedef pg8::FixedOrder<130, 4, 10> Ord; Ord S; S.init(F.G, opaque_bid());
          pg8::EpiGateT E{WSP(float, WS_LOGF), WSP(const bf16, WS_SZA)};
          pg8::gemm_phase<pg8::EpiGateT, Ord, true, true>(F.lds + RING_OFF, g, S, E); }
#endif
        GRID_BAR(); ENTER();
#ifndef NO_G5
        { pg8::Gemm g{WSP(bf16, WS_OH), WSP(const bf16, wlo + WO_BH), MROWS, DM, DM}; typedef pg8::FixedOrder<130, 4, 10> Ord; Ord S; S.init(F.G, opaque_bid());
          pg8::EpiGateM E{WSP(const float, WS_LOGF), WSP(const bf16, WS_SZH), WSP(bf16, WS_MRG)};
          pg8::gemm_phase<pg8::EpiGateM, Ord, true, true>(F.lds + RING_OFF, g, S, E); }
#endif
        GRID_BAR(); ENTER();
#ifndef NO_G6
        { pg8::Gemm g{WSP(bf16, WS_MRG), WSP(const bf16, wlo + WO_OUT), MROWS, DM, DM}; typedef pg8::FixedOrder<130, 4, 10> Ord; Ord S; S.init(F.G, opaque_bid());
          pg8::EpiResid E{WSP(float, WS_X), WSP(const float, modo) + 5 * 1024, 1.0f};
          pg8::gemm_phase<pg8::EpiResid, Ord, true, true>(F.lds + RING_OFF, g, S, E); }
#endif
        GRID_BAR(); ENTER();
        norm_phase(F, nullptr, nullptr, false, WSP(float, WS_X), karg(A_GFFN2) + l * 1024, WSP(const float, modo), 2, WSP(bf16, WS_XN));
        GRID_BAR(); ENTER();
#ifndef NO_G7
        { pg8::Gemm g{WSP(bf16, WS_XN), WSP(const bf16, wlo + WO_GU2), MROWS, 2 * DFF, DM}; typedef pg8::FixedOrder<130, 22, 10> Ord; Ord S; S.init(F.G, opaque_bid());
          pg8::EpiSwiglu E{WSP(bf16, WS_BIG)};
          pg8::gemm_phase<pg8::EpiSwiglu, Ord, true, true>(F.lds + RING_OFF, g, S, E); }
#endif
        GRID_BAR(); ENTER();
#ifndef NO_G8
        { pg8::Gemm g{WSP(bf16, WS_BIG), WSP(const bf16, wlo + WO_D2), MROWS, DM, DFF}; typedef pg8::FixedOrder<130, 4, 10> Ord; Ord S; S.init(F.G, opaque_bid());
          pg8::EpiResid E{WSP(float, WS_X), WSP(const float, modo) + 8 * 1024, 0.5f};
          pg8::gemm_phase<pg8::EpiResid, Ord, true, true>(F.lds + RING_OFF, g, S, E); }
#endif
        GRID_BAR(); ENTER();
    }
    final_norm_phase(F, WSP(const float, WS_X), karg(A_GFIN), OUTP(0));
#undef GRID_BAR
#undef ENTER
#undef WSP
#undef OUTP
}

extern "C" void kernel_launch(void* const* d_in, const int* in_sizes, int n_in, void* d_out, int out_size, void* d_ws, size_t ws_size, hipStream_t stream) {
    static int grid = 0;
    if (grid == 0) {
        if (n_in != 25 || (size_t)out_size != OUT_TOTAL || ws_size < WS_END) { fprintf(stderr, "kernel_launch: unexpected sizes: n_in %d out %d ws %zu (need %zu)\n", n_in, out_size, ws_size, (size_t)WS_END); grid = -1; return; }
        int dev = 0, cus = 0, per_cu = 0;
        if (hipGetDevice(&dev) != hipSuccess || hipDeviceGetAttribute(&cus, hipDeviceAttributeMultiprocessorCount, dev) != hipSuccess) { grid = -1; return; }
        if (hipFuncSetAttribute((const void*)mk_fwd, hipFuncAttributeMaxDynamicSharedMemorySize, LDS_BYTES) != hipSuccess) { fprintf(stderr, "kernel_launch: hipFuncSetAttribute failed\n"); grid = -1; return; }
        if (hipOccupancyMaxActiveBlocksPerMultiprocessor(&per_cu, (const void*)mk_fwd, NWAVES * 64, LDS_BYTES) != hipSuccess || per_cu < 1) { fprintf(stderr, "kernel_launch: occupancy query reports %d\n", per_cu); }
        (void)hipGetLastError();
        grid = cus;
    }
    if (grid < 0) return;
    if (hipMemsetAsync((char*)d_ws + WS_CTL, 0, CTL_ZERO_BYTES, stream) != hipSuccess) return;
    Args a{};
    for (int i = 0; i < 25; ++i) a.in[i] = (const float*)d_in[i];
    a.out = (float*)d_out; a.ws = (unsigned char*)d_ws;
    hipLaunchKernelGGL(mk_fwd, dim3(grid), dim3(NWAVES * 64), LDS_BYTES, stream, a);
    (void)in_sizes;
}
```

```cpp
#include <hip/hip_runtime.h>
#include <hip/hip_bf16.h>
#include <cstdio>
#include <cstdint>
#include <cmath>
__device__ __forceinline__ int opaque_tid() { int t = (int)threadIdx.x; asm volatile("" : "+v"(t)); return t; }
__device__ __forceinline__ int opaque_bid() { int b = (int)blockIdx.x; asm volatile("" : "+s"(b)); return b; }
namespace pg8 {
#define PG8_LAS __attribute__((address_space(3)))
typedef unsigned short bf16_t;
typedef short bf16x8 __attribute__((ext_vector_type(8)));
typedef float f32x4 __attribute__((ext_vector_type(4)));
typedef unsigned u32x4 __attribute__((ext_vector_type(4)));
constexpr int BM = 256, BK = 64, HALF = 128, HTB = HALF * BK * 2  , STAGE_BYTES = 8 * HTB, NXCD = 8, WGM = 8;

__host__ __device__ __forceinline__ int lds_byte(int r, int c) { const int st = (r >> 4) * 2 + (c >> 5), rr = r & 15, cc = c & 31, ob = rr * 64 + cc * 2; return st * 1024 + (ob ^ (((ob >> 9) & 1) << 5)); }
__host__ __device__ __forceinline__ void stage_rc(int b, int& R, int& C) { const int st = b / 1024, sb = b % 1024, swz = sb ^ (((sb >> 9) & 1) << 5); R = (st >> 1) * 16 + swz / 64; C = (st & 1) * 32 + (swz % 64) / 2; }
__host__ __device__ __forceinline__ int perm32(int rho) { const int n = rho >> 4, i = rho & 15; return 8 * (i >> 2) + 4 * n + (i & 3); }

struct Unit { int pm, pn; };
struct Gemm { const bf16_t* A; const bf16_t* Bt; int M, N, K; };

struct StaticOrder {
    int nM, nN, nwg, G, c;
    __host__ __device__ void init(int M, int N, int G_, int c_) { nM = M / BM; nN = N / BM; nwg = nM * nN; G = G_; c = c_; }
    __host__ __device__ bool next(int i, Unit& u) const {
        const long L = (long)i * G + c; if (L >= nwg) return false;
        int wgid = (int)L; { const int q = nwg / NXCD, r = nwg % NXCD, xcd = wgid % NXCD, off = wgid / NXCD; wgid = (xcd < r ? xcd * (q + 1) : r * (q + 1) + (xcd - r) * q) + off; }
        const int nig = WGM * nN, gid = wgid / nig, fm = gid * WGM, gsz = (nM - fm) < WGM ? (nM - fm) : WGM;
        u.pm = fm + ((wgid % nig) % gsz); u.pn = (wgid % nig) / gsz; return true;
    }
    __device__ __forceinline__ void a_ready(const Unit&) const {}
    __device__ __forceinline__ void done(const Unit&) const {}
};

__device__ __forceinline__ unsigned cvt_pk_bf16(float lo, float hi) { unsigned r; asm volatile("v_cvt_pk_bf16_f32 %0, %1, %2" : "=v"(r) : "v"(lo), "v"(hi)); return r; }
__device__ __forceinline__ float bf_lo(unsigned w) { return __builtin_bit_cast(float, w << 16); }
__device__ __forceinline__ float bf_hi(unsigned w) { return __builtin_bit_cast(float, w & 0xffff0000u); }
__device__ __forceinline__ float sigmoid_f(float x) { return __builtin_amdgcn_rcpf(1.f + __expf(-x)); }
__device__ __forceinline__ float silu_f(float x) { return x * sigmoid_f(x); }
__device__ __forceinline__ void store8bf(bf16_t* p, f32x4 a, f32x4 b) { u32x4 w; w.x = cvt_pk_bf16(a[0], a[1]); w.y = cvt_pk_bf16(a[2], a[3]); w.z = cvt_pk_bf16(b[0], b[1]); w.w = cvt_pk_bf16(b[2], b[3]); *(u32x4*)p = w; }
__device__ __forceinline__ int row_seq(int row) { return row < 32768 ? (row >> 13) : 4 + ((row - 32768) >> 5); }

struct EpiSwiglu {
    static constexpr bool PERM = true, AFTER_DRAIN = false;
    bf16_t* O;
    __device__ __forceinline__ void operator()(const f32x4 (&acc)[2][2][4][2], const Unit& u, int wr, int wc, int fr, int fq) const {
        const int row0 = u.pm * BM + wr * 64 + fr, col0 = u.pn * HALF + wc * 32 + 8 * fq;
#pragma unroll
        for (int ai = 0; ai < 2; ++ai)
#pragma unroll
            for (int m = 0; m < 4; ++m) {
                f32x4 g0 = acc[ai][0][m][0], g1 = acc[ai][0][m][1]; const f32x4 u0 = acc[ai][1][m][0], u1 = acc[ai][1][m][1];
#pragma unroll
                for (int i = 0; i < 4; ++i) { g0[i] = silu_f(g0[i]) * u0[i]; g1[i] = silu_f(g1[i]) * u1[i]; }
                store8bf(O + (size_t)(row0 + ai * HALF + m * 16) * 2816 + col0, g0, g1); asm volatile("" ::: "memory");
            }
    }
};

struct EpiResid {
    static constexpr bool PERM = true, AFTER_DRAIN = false;
    float* X; const float* gate; float coef;
    __device__ __forceinline__ void operator()(const f32x4 (&acc)[2][2][4][2], const Unit& u, int wr, int wc, int fr, int fq) const {
#pragma unroll
        for (int ai = 0; ai < 2; ++ai)
#pragma unroll
            for (int m = 0; m < 4; ++m) {
                const int row = u.pm * BM + ai * HALF + wr * 64 + m * 16 + fr; const float* gp = gate + (size_t)row_seq(row) * 9216;
#pragma unroll
                for (int bj = 0; bj < 2; ++bj) { const int col = u.pn * BM + bj * HALF + wc * 32 + 8 * fq;
#pragma unroll
                    for (int n = 0; n < 2; ++n) { const f32x4 g = *(const f32x4*)(gp + col + 4 * n); f32x4* xp = (f32x4*)(X + (size_t)row * 1024 + col + 4 * n); const f32x4 xv = *xp; *xp = xv + (g * coef) * acc[ai][bj][m][n]; } asm volatile("" ::: "memory"); }
            }
    }
};

struct EpiWin {
    static constexpr bool PERM = true, AFTER_DRAIN = false;
    unsigned char* ws; float* out; int l; float qscale;
    static constexpr size_t MiB_ = 1u << 20;
    static constexpr size_t O_Q = 435 * MiB_, O_K = 500 * MiB_, O_V = 565 * MiB_, O_QQ = 630 * MiB_, O_KK = 695 * MiB_, O_VV = 760 * MiB_, O_HGS = 825 * MiB_, O_SZA = 890 * MiB_, O_SZH = 955 * MiB_, O_LOGF = 1020 * MiB_, O_LB = 4 * MiB_;
    static constexpr size_t OK_P_ = 34078720, OV_P_ = 168296448, OK_S_ = 304611328, OV_S_ = 306708480;
    __device__ __forceinline__ void operator()(const f32x4 (&acc)[2][2][4][2], const Unit& u, int wr, int wc, int fr, int fq) const {
        const int seg = u.pn >> 2, cb = (u.pn & 3) * BM + wc * 32 + 8 * fq, row0 = u.pm * BM + wr * 64 + fr;
        const size_t boff = seg == 0 ? O_Q : seg == 1 ? O_K : seg == 2 ? O_V : seg == 3 ? O_QQ : seg == 4 ? O_KK : seg == 5 ? O_VV : seg == 6 ? O_HGS : seg == 7 ? O_SZA : O_SZH;
        bf16_t* const O = (bf16_t*)(ws + boff) + (size_t)row0 * 1024 + cb;
        float* F32 = nullptr;
        if (seg == 1 || seg == 2) { const size_t ob = (u.pm < 128) ? (seg == 1 ? OK_P_ : OV_P_) + (size_t)l * 32768 * 1024 + (size_t)(u.pm * BM) * 1024 : (seg == 1 ? OK_S_ : OV_S_) + (size_t)l * 512 * 1024 + (size_t)((u.pm - 128) * BM) * 1024;
            F32 = out + ob + (size_t)(wr * 64 + fr) * 1024 + cb; }
        else if (seg == 4) F32 = (float*)(ws + O_LOGF) + (size_t)row0 * 1024 + cb;
        const float* const lb = (const float*)(ws + O_LB) + l * 1024 + cb;
        const float sc = seg == 0 ? qscale : 1.f;
#pragma unroll
        for (int bj = 0; bj < 2; ++bj) {
            f32x4 l0 = {0.f, 0.f, 0.f, 0.f}, l1 = l0; if (seg == 4) { l0 = *(const f32x4*)(lb + bj * HALF); l1 = *(const f32x4*)(lb + bj * HALF + 4); }
#pragma unroll
            for (int ai = 0; ai < 2; ++ai)
#pragma unroll
                for (int m = 0; m < 4; ++m) { const size_t off = (size_t)(ai * HALF + m * 16) * 1024 + bj * HALF;
                    f32x4 a = acc[ai][bj][m][0], b = acc[ai][bj][m][1];
                    if (seg == 4) { f32x4 fa, fb;
#pragma unroll
                        for (int i = 0; i < 4; ++i) {
                            { const float x = a[i], lbv = l0[i], e = __expf(-__builtin_fabsf(x)), r = __builtin_amdgcn_rcpf(1.f + e), er = e * r, sig = x >= 0.f ? r : er, om = x >= 0.f ? er : r;
                              fa[i] = __logf(__builtin_fmaxf(lbv + (1.f - lbv) * sig, 1e-30f)); a[i] = (1.f - lbv) * om; }
                            { const float x = b[i], lbv = l1[i], e = __expf(-__builtin_fabsf(x)), r = __builtin_amdgcn_rcpf(1.f + e), er = e * r, sig = x >= 0.f ? r : er, om = x >= 0.f ? er : r;
                              fb[i] = __logf(__builtin_fmaxf(lbv + (1.f - lbv) * sig, 1e-30f)); b[i] = (1.f - lbv) * om; } }
                        *(f32x4*)(F32 + off) = fa; *(f32x4*)(F32 + off + 4) = fb;
                    } else if (seg == 3 || seg == 6) {
#pragma unroll
                        for (int i = 0; i < 4; ++i) { a[i] = silu_f(a[i]); b[i] = silu_f(b[i]); }
                    } else if (seg >= 7) {
#pragma unroll
                        for (int i = 0; i < 4; ++i) { a[i] = sigmoid_f(a[i]); b[i] = sigmoid_f(b[i]); }
                    } else {
                        if (seg == 1 || seg == 2) { *(f32x4*)(F32 + off) = a; *(f32x4*)(F32 + off + 4) = b; }
                        a = a * sc; b = b * sc;
                    }
                    store8bf(O + off, a, b); asm volatile("" ::: "memory"); }
        }
    }
};

struct EpiGateT {
    static constexpr bool PERM = true, AFTER_DRAIN = false;
    float* T; const bf16_t* G;
    __device__ __forceinline__ void operator()(const f32x4 (&acc)[2][2][4][2], const Unit& u, int wr, int wc, int fr, int fq) const {
        const int row0 = u.pm * BM + wr * 64 + fr, cb = u.pn * BM + wc * 32 + 8 * fq;
#pragma unroll
        for (int ai = 0; ai < 2; ++ai)
#pragma unroll
            for (int m = 0; m < 4; ++m)
#pragma unroll
                for (int bj = 0; bj < 2; ++bj) { const size_t off = (size_t)(row0 + ai * HALF + m * 16) * 1024 + cb + bj * HALF; const u32x4 g = *(const u32x4*)(G + off);
                    const f32x4 g0 = {bf_lo(g.x), bf_hi(g.x), bf_lo(g.y), bf_hi(g.y)}, g1 = {bf_lo(g.z), bf_hi(g.z), bf_lo(g.w), bf_hi(g.w)};
                    *(f32x4*)(T + off) = g0 * acc[ai][bj][m][0]; *(f32x4*)(T + off + 4) = g1 * acc[ai][bj][m][1]; asm volatile("" ::: "memory"); }
    }
};
struct EpiGateM {
    static constexpr bool PERM = true, AFTER_DRAIN = false;
    const float* T; const bf16_t* G; bf16_t* O;
    __device__ __forceinline__ void operator()(const f32x4 (&acc)[2][2][4][2], const Unit& u, int wr, int wc, int fr, int fq) const {
        const int row0 = u.pm * BM + wr * 64 + fr, cb = u.pn * BM + wc * 32 + 8 * fq;
#pragma unroll
        for (int ai = 0; ai < 2; ++ai)
#pragma unroll
            for (int m = 0; m < 4; ++m)
#pragma unroll
                for (int bj = 0; bj < 2; ++bj) { const size_t off = (size_t)(row0 + ai * HALF + m * 16) * 1024 + cb + bj * HALF; const u32x4 g = *(const u32x4*)(G + off);
                    const f32x4 g0 = {bf_lo(g.x), bf_hi(g.x), bf_lo(g.y), bf_hi(g.y)}, g1 = {bf_lo(g.z), bf_hi(g.z), bf_lo(g.w), bf_hi(g.w)};
                    const f32x4 t0 = *(const f32x4*)(T + off), t1 = *(const f32x4*)(T + off + 4);
                    store8bf(O + off, t0 + g0 * acc[ai][bj][m][0], t1 + g1 * acc[ai][bj][m][1]); asm volatile("" ::: "memory"); }
    }
};

template <int NM, int NN, int GM> struct FixedOrder {
    static_assert(NM % GM == 0, "GM divides NM");
    int G, c;
    __device__ __forceinline__ void init(int G_, int c_) { G = G_; c = c_; }
    __device__ __forceinline__ bool next(int i, Unit& u) const {
        constexpr int nwg = NM * NN, q = nwg / NXCD, r = nwg % NXCD, nig = GM * NN;
        const int L = i * G + c; if (L >= nwg) return false;
        const int xcd = L % NXCD, off = L / NXCD; const int wgid = (xcd < r ? xcd * (q + 1) : r * (q + 1) + (xcd - r) * q) + off;
        const int gid = wgid / nig, w = wgid % nig; u.pm = gid * GM + (w % GM); u.pn = w / GM; return true;
    }
    __device__ __forceinline__ void a_ready(const Unit&) const {}
    __device__ __forceinline__ void done(const Unit&) const {}
};
template <class Epi, class Sched, bool ALIGN_EPI = false, bool SP2 = false>
__device__ __forceinline__ void gemm_phase(PG8_LAS unsigned char* lds, const Gemm g, const Sched& S, const Epi& E) {
    const int tid = opaque_tid(), wid = __builtin_amdgcn_readfirstlane(tid >> 6), lane = tid & 63, wr = wid >> 2, wc = wid & 3, fr = lane & 15, fq = lane >> 4;
    const int K = g.K, nt = K / BK;
    unsigned voffA[2], voffB[2];
#pragma unroll
    for (int i = 0; i < 2; ++i) { int R, C; stage_rc(tid * 16 + i * 8192, R, C); const int Rb = Epi::PERM ? ((R & ~31) + perm32(R & 31)) : R;
        voffA[i] = (unsigned)(R * K + C) * 2u; voffB[i] = (unsigned)(Rb * K + C) * 2u; }
    const size_t kstep = (size_t)(BK * 2);
    const size_t hstep = (size_t)HALF * K * 2;
    const size_t tstep = 2 * hstep;
    const unsigned ldsw = (unsigned)wid * 1024u;
    const int aoff = lds_byte(wr * 64 + fr, fq * 8), boff = lds_byte(wc * 32 + fr, fq * 8);
#define PG8_SA(b, h) (((b) * 2 + (h)) * HTB)
#define PG8_SB(b, h) ((4 + (b) * 2 + (h)) * HTB)
#define PG8_STAGE(bufoff, gbase, voff) do { _Pragma("unroll") for (int _i = 0; _i < 2; ++_i) \
        __builtin_amdgcn_global_load_lds((const unsigned*)((const char*)(gbase) + (voff)[_i]), (PG8_LAS unsigned*)(lds + (bufoff) + ldsw + _i * 8192), 16, 0, 0); } while (0)
#define PG8_LDA(dst, b, h) do { _Pragma("unroll") for (int m = 0; m < 4; ++m) _Pragma("unroll") for (int k = 0; k < 2; ++k) dst[m][k] = *(const PG8_LAS bf16x8*)(lds + PG8_SA(b, h) + aoff + m * 2048 + k * 1024); } while (0)
#define PG8_LDB(dst, b, h) do { _Pragma("unroll") for (int n = 0; n < 2; ++n) _Pragma("unroll") for (int k = 0; k < 2; ++k) dst[n][k] = *(const PG8_LAS bf16x8*)(lds + PG8_SB(b, h) + boff + n * 2048 + k * 1024); } while (0)
#define PG8_MMA(ai, bj, At, Bt) do { __builtin_amdgcn_s_setprio(1); _Pragma("unroll") for (int m = 0; m < 4; ++m) _Pragma("unroll") for (int n = 0; n < 2; ++n) _Pragma("unroll") for (int k = 0; k < 2; ++k) \
        acc[ai][bj][m][n] = __builtin_amdgcn_mfma_f32_16x16x32_bf16(Bt[n][k], At[m][k], acc[ai][bj][m][n], 0, 0, 0); __builtin_amdgcn_s_setprio(0); } while (0)
#define PG8_WAIT_V(n) asm volatile("s_waitcnt vmcnt(" #n ")" ::: "memory")
#define PG8_WAIT_L(n) asm volatile("s_waitcnt lgkmcnt(" #n ")" ::: "memory")
#define PG8_BAR __builtin_amdgcn_s_barrier()
#define PG8_SCHED __builtin_amdgcn_sched_barrier(0)
    Unit cur, nxt; int ui = 0;
    if (!S.next(0, cur)) return;
    f32x4 acc[2][2][4][2];
#pragma unroll
    for (int a = 0; a < 2; ++a)
#pragma unroll
        for (int b = 0; b < 2; ++b)
#pragma unroll
            for (int m = 0; m < 4; ++m)
#pragma unroll
                for (int n = 0; n < 2; ++n) acc[a][b][m][n] = (f32x4){0.f, 0.f, 0.f, 0.f};
    bf16x8 At[4][2], B0[2][2], B1[2][2];
    const char* cA = (const char*)g.A + (size_t)cur.pm * tstep; const char* cB = (const char*)g.Bt + (size_t)cur.pn * tstep;
    S.a_ready(cur);
    if constexpr (SP2) {
        PG8_STAGE(PG8_SB(0, 0), cB, voffB); PG8_STAGE(PG8_SB(0, 1), cB + hstep, voffB); PG8_STAGE(PG8_SA(0, 0), cA, voffA); PG8_STAGE(PG8_SA(0, 1), cA + hstep, voffA);
        if (wr == 1) PG8_BAR;
        PG8_WAIT_V(2); PG8_BAR;
        PG8_STAGE(PG8_SB(1, 0), cB + kstep, voffB); PG8_STAGE(PG8_SA(1, 0), cA + kstep, voffA); PG8_STAGE(PG8_SB(1, 1), cB + hstep + kstep, voffB);
        PG8_WAIT_V(6); PG8_BAR;
    } else {
        PG8_STAGE(PG8_SB(0, 0), cB, voffB); PG8_STAGE(PG8_SA(0, 0), cA, voffA); PG8_STAGE(PG8_SB(0, 1), cB + hstep, voffB); PG8_STAGE(PG8_SA(0, 1), cA + hstep, voffA);
        if (wr == 1) PG8_BAR;
        PG8_WAIT_V(4); PG8_BAR;
        PG8_STAGE(PG8_SB(1, 0), cB + kstep, voffB); PG8_STAGE(PG8_SA(1, 0), cA + kstep, voffA); PG8_STAGE(PG8_SB(1, 1), cB + hstep + kstep, voffB);
        PG8_WAIT_V(6); PG8_BAR;
    }
    for (;;) {
        const bool has_next = S.next(ui + 1, nxt);
        const char* nA = has_next ? (const char*)g.A + (size_t)nxt.pm * tstep : cA; const char* nB = has_next ? (const char*)g.Bt + (size_t)nxt.pn * tstep : cB;
        for (int t = 0; t < nt; t += 2) {
            const bool last = (t == nt - 2);
            const char* a1 = cA + (size_t)(t + 1) * kstep;
            const char* a2 = last ? nA : cA + (size_t)(t + 2) * kstep; const char* b2 = last ? nB : cB + (size_t)(t + 2) * kstep;
            const char* a3 = a2 + kstep; const char* b3 = b2 + kstep;
            if (last && has_next) S.a_ready(nxt);
            if constexpr (SP2) {
            PG8_LDB(B0, 0, 0); PG8_LDB(B1, 0, 1); PG8_SCHED; PG8_LDA(At, 0, 0); PG8_STAGE(PG8_SA(1, 1), a1 + hstep, voffA);
            PG8_WAIT_V(8); PG8_WAIT_L(0); PG8_BAR; PG8_MMA(0, 0, At, B0); PG8_MMA(0, 1, At, B1); PG8_BAR; PG8_SCHED;
            PG8_LDA(At, 0, 1); PG8_STAGE(PG8_SB(0, 0), b2, voffB); PG8_STAGE(PG8_SB(0, 1), b2 + hstep, voffB); PG8_STAGE(PG8_SA(0, 0), a2, voffA);
            PG8_WAIT_V(8); PG8_WAIT_L(0); PG8_BAR; PG8_MMA(1, 0, At, B0); PG8_MMA(1, 1, At, B1); PG8_BAR; PG8_SCHED;
            PG8_LDB(B0, 1, 0); PG8_LDB(B1, 1, 1); PG8_SCHED; PG8_LDA(At, 1, 0); PG8_STAGE(PG8_SA(0, 1), a2 + hstep, voffA);
            PG8_WAIT_V(8); PG8_WAIT_L(0); PG8_BAR; PG8_MMA(0, 0, At, B0); PG8_MMA(0, 1, At, B1); PG8_BAR; PG8_SCHED;
            PG8_LDA(At, 1, 1); PG8_STAGE(PG8_SB(1, 0), b3, voffB); PG8_STAGE(PG8_SB(1, 1), b3 + hstep, voffB); PG8_STAGE(PG8_SA(1, 0), a3, voffA);
            PG8_WAIT_V(8); PG8_WAIT_L(0); PG8_BAR; PG8_MMA(1, 0, At, B0); PG8_MMA(1, 1, At, B1); PG8_BAR; PG8_SCHED;
            } else {
            PG8_LDB(B0, 0, 0); PG8_SCHED; PG8_LDA(At, 0, 0); PG8_STAGE(PG8_SA(1, 1), a1 + hstep, voffA);
            PG8_WAIT_L(8); PG8_BAR; PG8_WAIT_L(0); PG8_MMA(0, 0, At, B0); PG8_BAR; PG8_SCHED;
            PG8_LDB(B1, 0, 1); PG8_STAGE(PG8_SB(0, 0), b2, voffB);
            PG8_BAR; PG8_WAIT_L(0); PG8_MMA(0, 1, At, B1); PG8_BAR;
            PG8_LDA(At, 0, 1); PG8_STAGE(PG8_SA(0, 0), a2, voffA);
            PG8_BAR; PG8_WAIT_L(0); PG8_MMA(1, 0, At, B0); PG8_BAR; PG8_SCHED;
            PG8_STAGE(PG8_SB(0, 1), b2 + hstep, voffB);
            PG8_WAIT_V(6); PG8_BAR; PG8_MMA(1, 1, At, B1); PG8_BAR;
            PG8_LDB(B0, 1, 0); PG8_SCHED; PG8_LDA(At, 1, 0); PG8_STAGE(PG8_SA(0, 1), a2 + hstep, voffA);
            PG8_WAIT_L(8); PG8_BAR; PG8_WAIT_L(0); PG8_MMA(0, 0, At, B0); PG8_BAR; PG8_SCHED;
            PG8_LDB(B1, 1, 1); PG8_STAGE(PG8_SB(1, 0), b3, voffB);
            PG8_BAR; PG8_WAIT_L(0); PG8_MMA(0, 1, At, B1); PG8_BAR;
            PG8_LDA(At, 1, 1); PG8_STAGE(PG8_SA(1, 0), a3, voffA);
            PG8_BAR; PG8_WAIT_L(0); PG8_MMA(1, 0, At, B0); PG8_BAR; PG8_SCHED;
            PG8_STAGE(PG8_SB(1, 1), b3 + hstep, voffB);
            PG8_WAIT_V(6); PG8_BAR; PG8_MMA(1, 1, At, B1); PG8_BAR;
            }
        }
        if constexpr (ALIGN_EPI) { if (wr == 0) PG8_BAR; }
        if constexpr (!Epi::AFTER_DRAIN) { E(acc, cur, wr, wc, fr, fq); S.done(cur); }
        if (!has_next) break;
#pragma unroll
        for (int a = 0; a < 2; ++a)
#pragma unroll
            for (int b = 0; b < 2; ++b)
#pragma unroll
                for (int m = 0; m < 4; ++m)
#pragma unroll
                    for (int n = 0; n < 2; ++n) acc[a][b][m][n] = (f32x4){0.f, 0.f, 0.f, 0.f};
        cur = nxt; cA = nA; cB = nB; ++ui;
        if constexpr (ALIGN_EPI) { if (wr == 1) PG8_BAR; }
    }
    PG8_WAIT_V(0);
    if constexpr (!ALIGN_EPI) { if (wr == 0) PG8_BAR; }
    PG8_BAR;
    if constexpr (Epi::AFTER_DRAIN) { E.fused(acc, cur, wr, wc, fr, fq, lds, wid, lane); S.done(cur); }
#undef PG8_SA
#undef PG8_SB
#undef PG8_STAGE
#undef PG8_LDA
#undef PG8_LDB
#undef PG8_MMA
#undef PG8_WAIT_V
#undef PG8_WAIT_L
#undef PG8_BAR
#undef PG8_SCHED
}
}
namespace attn_body {
using bf16=__hip_bfloat16;
using bf16x8=__attribute__((ext_vector_type(8)))short;
using s16x4=__attribute__((ext_vector_type(4)))short;
using f32x16=__attribute__((ext_vector_type(16)))float;
using u32x4=__attribute__((ext_vector_type(4)))unsigned;
constexpr int BATCH=4,NHEAD=16,SEQ=8192,D=64,DM=NHEAD*D;
constexpr int NW=8,QBLK=32,QB=QBLK*NW,KVBLK=64,NQB=SEQ/QB;
constexpr int ATTN_PITCH=DM, ATTN_UNIT_ROWS=QB;
__device__ __forceinline__ int crow(int r,int hi){return (r&3)+8*(r>>2)+4*hi;}
#define SBAR() __builtin_amdgcn_sched_barrier(0)
__device__ __forceinline__ void cmask(f32x16&p0,f32x16&p1,int jb,int qrel,int hi){
  const float NEG=-INFINITY; (void)hi;
  if(jb>(qrel>>6)){
  #pragma unroll
  for(int r=0;r<16;++r){p0[r]=NEG;p1[r]=NEG;} }
}

constexpr int NSLOT=3, SLOTB=8192;
constexpr int LDS_K=0, LDS_V=NSLOT*SLOTB, LDS_WS=2*NSLOT*SLOTB, LDS_OST=LDS_WS+NW*64*4, LDS_BYTES=LDS_OST+NW*4096;
constexpr float C2=0.125f*1.4426950408889634f;
__device__ __forceinline__ void glds16(const void*gsrc,unsigned lds_dst){unsigned keep;
  asm volatile("s_mov_b32 %0, m0\n\ts_mov_b32 m0, %2\n\ts_nop 0\n\tglobal_load_lds_dwordx4 %1, off\n\ts_mov_b32 m0, %0":"=&s"(keep):"v"(gsrc),"s"(lds_dst):"memory");}
__device__ __forceinline__ float max3f(float a,float b,float c){float r;asm("v_max3_f32 %0, %1, %2, %3":"=v"(r):"v"(a),"v"(b),"v"(c));return r;}
__device__ __forceinline__ float max2f(float a,float b){float r;asm("v_max_f32_e32 %0, %1, %2":"=v"(r):"v"(a),"v"(b));return r;}
__device__ __forceinline__ float fadd_s(float a,float b){float r;asm("v_add_f32_e32 %0, %1, %2":"=v"(r):"v"(a),"v"(b));return r;}
__device__ __forceinline__ float fsub_s(float a,float b){float r;asm("v_sub_f32_e32 %0, %1, %2":"=v"(r):"v"(a),"v"(b));return r;}
typedef float f32x2_t __attribute__((ext_vector_type(2))); typedef __bf16 bf16x2_t __attribute__((ext_vector_type(2)));
__device__ __forceinline__ unsigned cvtpk_s(float lo,float hi){f32x2_t v={lo,hi};bf16x2_t b=__builtin_convertvector(v,bf16x2_t);return __builtin_bit_cast(unsigned,b);}
#define WAIT_BAR(N) asm volatile("s_waitcnt vmcnt(" #N ") lgkmcnt(0)\n\ts_barrier":::"memory")

__device__ __forceinline__ void qkt(f32x16&p0,f32x16&p1,const char*Kslot,const bf16x8*qr,const f32x16&negm,int r32,int hi){
  const char*kb=Kslot+hi*1024+r32*16;
  #pragma unroll
  for(int d0=0;d0<4;++d0){
    const bf16x8 b0=*reinterpret_cast<const bf16x8*>(kb+d0*2048);
    const bf16x8 b1=*reinterpret_cast<const bf16x8*>(kb+d0*2048+512);
    if(d0==0){p0=__builtin_amdgcn_mfma_f32_32x32x16_bf16(b0,qr[0],negm,0,0,0);p1=__builtin_amdgcn_mfma_f32_32x32x16_bf16(b1,qr[0],negm,0,0,0);}
    else{p0=__builtin_amdgcn_mfma_f32_32x32x16_bf16(b0,qr[d0],p0,0,0,0);p1=__builtin_amdgcn_mfma_f32_32x32x16_bf16(b1,qr[d0],p1,0,0,0);}}
}
typedef __attribute__((address_space(3))) const char* lds_cptr;
typedef short v4i16_t __attribute__((ext_vector_type(4)));
__device__ __forceinline__ void kload8(bf16x8*kf,lds_cptr kp){
  kf[0]=*(const __attribute__((address_space(3))) bf16x8*)(kp);      kf[1]=*(const __attribute__((address_space(3))) bf16x8*)(kp+512);
  kf[2]=*(const __attribute__((address_space(3))) bf16x8*)(kp+2048); kf[3]=*(const __attribute__((address_space(3))) bf16x8*)(kp+2560);
  kf[4]=*(const __attribute__((address_space(3))) bf16x8*)(kp+4096); kf[5]=*(const __attribute__((address_space(3))) bf16x8*)(kp+4608);
  kf[6]=*(const __attribute__((address_space(3))) bf16x8*)(kp+6144); kf[7]=*(const __attribute__((address_space(3))) bf16x8*)(kp+6656);
}
__device__ __forceinline__ void kload2(bf16x8*kf,lds_cptr kp,int j){ kf[2*j]=*(const __attribute__((address_space(3))) bf16x8*)(kp+j*2048); kf[2*j+1]=*(const __attribute__((address_space(3))) bf16x8*)(kp+j*2048+512); }
__device__ __forceinline__ s16x4 vtr(lds_cptr p){ return __builtin_bit_cast(s16x4,__builtin_amdgcn_ds_read_tr16_b64_v4i16((__attribute__((address_space(3))) v4i16_t*)p)); }
__device__ __forceinline__ float rowmax(const f32x16&p0,const f32x16&p1){
  float a=max3f(p0[0],p0[1],p1[0]),b=max3f(p0[2],p0[3],p1[1]);a=max3f(a,p1[2],p1[3]);
  #pragma unroll
  for(int r=4;r<16;r+=4){a=max3f(a,p0[r],p0[r+1]);b=max3f(b,p0[r+2],p0[r+3]);a=max3f(a,p1[r],p1[r+1]);b=max3f(b,p1[r+2],p1[r+3]);}
  const float m=max2f(a,b);
  auto rr=__builtin_amdgcn_permlane32_swap(__float_as_uint(m),__float_as_uint(m),false,false);
  return max2f(__uint_as_float(rr[0]),__uint_as_float(rr[1]));
}
__device__ __forceinline__ void pv(f32x16*o,int vb,bf16x8 pa0,bf16x8 pa1,bf16x8 pa2,bf16x8 pa3){
  #pragma unroll
  for(int d0=0;d0<2;++d0){s16x4 lo[4],hi[4];
    #pragma unroll
    for(int ks=0;ks<4;++ks){
      asm volatile("ds_read_b64_tr_b16 %0,%1 offset:%c2":"=&v"(lo[ks]):"v"(vb),"i"(d0*4096+ks*1024):"memory");
      asm volatile("ds_read_b64_tr_b16 %0,%1 offset:%c2":"=&v"(hi[ks]):"v"(vb),"i"(d0*4096+ks*1024+512):"memory");}
    asm volatile("s_waitcnt lgkmcnt(0)":::"memory");SBAR();
    #define PK(k) (bf16x8){lo[k][0],lo[k][1],lo[k][2],lo[k][3],hi[k][0],hi[k][1],hi[k][2],hi[k][3]}
    o[d0]=__builtin_amdgcn_mfma_f32_32x32x16_bf16(pa0,PK(0),o[d0],0,0,0);
    o[d0]=__builtin_amdgcn_mfma_f32_32x32x16_bf16(pa1,PK(1),o[d0],0,0,0);
    o[d0]=__builtin_amdgcn_mfma_f32_32x32x16_bf16(pa2,PK(2),o[d0],0,0,0);
    o[d0]=__builtin_amdgcn_mfma_f32_32x32x16_bf16(pa3,PK(3),o[d0],0,0,0);
    #undef PK
  }
}

#ifndef ATTN_STORE16
#define ATTN_STORE16(p,v) (*(u32x4*)(p)=(v))
#endif
template<int THRL> __device__ __forceinline__ void attn_unit(int b,int hq,int hv,int qb,const bf16*Q,const bf16*__restrict__ K,const bf16*__restrict__ V,bf16*O,char*shm){
  const int tid=opaque_tid(),lane=tid&63,r32=lane&31,hi=lane>>5; const int wid=__builtin_amdgcn_readfirstlane(tid>>6);
  const long rowbase=(long)b*SEQ; const int q0=qb*QB;
  const bf16*Qw=Q+(rowbase+q0+wid*QBLK)*DM+hq*D;
  const bf16*Kh=K+rowbase*DM+hq*D,*Vh=V+rowbase*DM+hv*D;
  const unsigned lds0=(unsigned)(uintptr_t)shm;
  float*wsf=(float*)(shm+LDS_WS)+wid*64;
  const bf16*ksrc=Kh+(long)lane*DM+wid*8;
  const bf16*vsrc=Vh+(long)(16*(wid&3)+(lane>>2))*DM+(wid>>2)*32+(lane&3)*8;
  const unsigned kdst=lds0+LDS_K+wid*1024, vdst=lds0+LDS_V+wid*1024;
  #define DMA_K(t,slot) glds16(ksrc+(long)(t)*KVBLK*DM,(unsigned)__builtin_amdgcn_readfirstlane(kdst+(slot)))
  #define DMA_V(t,slot) glds16(vsrc+(long)(t)*KVBLK*DM,(unsigned)__builtin_amdgcn_readfirstlane(vdst+(slot)))
  const int vb0=(int)(lds0+LDS_V)+((lane>>4)&1)*32+(lane&3)*8+(4*hi+((lane&15)>>2))*64;
  const char*Kbase=shm+LDS_K; bf16x8 kf[8];
  const lds_cptr shm3=(lds_cptr)shm; const lds_cptr kp0=shm3+LDS_K+hi*1024+r32*16; const lds_cptr vp0=shm3+LDS_V+((lane>>4)&1)*32+(lane&3)*8+(4*hi+((lane&15)>>2))*64;
  const int NT=(q0+QB)/KVBLK;
  DMA_K(0,0);DMA_V(0,0);DMA_K(1,SLOTB);
  bf16x8 qr[4];
  #pragma unroll
  for(int d0=0;d0<4;++d0)qr[d0]=*reinterpret_cast<const bf16x8*>(&Qw[(long)r32*DM+d0*16+hi*8]);
  float mhat=0.f,l_reg=0.f;f32x16 o[2];o[0]=f32x16{};o[1]=f32x16{};f32x16 negm=f32x16{};asm volatile("":"+v"(negm));
  const int qrel=wid*QBLK+r32;
  #define CMASK(P0,P1,t) do{int jb_=(t)-(NT-4); if(jb_>=0)cmask(P0,P1,jb_,qrel,hi);}while(0)
  bool resc=false;
  #define START(P0,P1) do{ const float rm=rowmax(P0,P1); resc=false; \
    { const float dl=rm; mhat=fadd_s(mhat,dl); \
      _Pragma("unroll") for(int r=0;r<16;++r){P0[r]=fsub_s(P0[r],dl);P1[r]=fsub_s(P1[r],dl);} \
      _Pragma("unroll") for(int r=0;r<16;++r)negm[r]=-mhat; asm volatile("":"+v"(negm)); } \
    _Pragma("unroll") for(int r=0;r<16;++r)P0[r]=__builtin_amdgcn_exp2f(P0[r]); }while(0)
  #define RESC() do{ if(resc){ asm volatile("s_waitcnt lgkmcnt(0)":::"memory"); \
      _Pragma("unroll") for(int d_=0;d_<2;++d_) _Pragma("unroll") for(int r=0;r<16;++r)o[d_][r]*=wsf[crow(r,hi)]; } }while(0)
  f32x16 pA0,pA1,pB0,pB1;
  int sl_prev=0,sl_cur=0,sl_next=SLOTB;
  #define ROT() do{sl_prev=sl_cur;sl_cur=sl_next;sl_next=(sl_next==(NSLOT-1)*SLOTB)?0:sl_next+SLOTB;}while(0)
  DMA_K(2,2*SLOTB);
  WAIT_BAR(3);
  qkt(pA0,pA1,Kbase,qr,negm,r32,hi);asm volatile("s_nop 15\n\ts_nop 7":"+v"(pA0),"+v"(pA1));CMASK(pA0,pA1,0);
  START(pA0,pA1);
  _Pragma("unroll") for(int r=0;r<16;++r)pA1[r]=__builtin_amdgcn_exp2f(pA1[r]);
  WAIT_BAR(0);
  DMA_K(3,0);DMA_V(1,SLOTB);
  ROT();
  kload8(kf,kp0+sl_cur);
  WAIT_BAR(2);
  s16x4 vlo[8],vhi[8]; u32x4 pw0,pw1,pw2,pw3;
  #define PKW(P,B) cvtpk_s(P[B],P[B+1])
  #define PAF(k) __builtin_bit_cast(bf16x8,pw##k)
  #define VFR(i) (bf16x8){vlo[i][0],vlo[i][1],vlo[i][2],vlo[i][3],vhi[i][0],vhi[i][1],vhi[i][2],vhi[i][3]}
  #define PIN(x) asm volatile("":"+v"(x))
  #define MX3(a,b,c) __builtin_fmaxf(__builtin_fmaxf((a),(b)),(c))
  #define GAPA(MF,A0,A1,A2,A3,W0,W1,PW) do{ MF; sacc+=A0; sacc+=A1; sacc+=A2; sacc+=A3; PIN(sacc); W0; W1; PIN(PW); SBAR(); }while(0)
  #define EX(v) __builtin_amdgcn_exp2f(v)
  #define GAPB(MF,X,B) do{ MF; X[B]=EX(X[B]); X[B+1]=EX(X[B+1]); X[B+2]=EX(X[B+2]); X[B+3]=EX(X[B+3]); PIN(X); SBAR(); }while(0)
  #define VRD(i) do{ vlo[i]=vtr(vp_+(((i)>>2)*4096+((i)&3)*1024)); vhi[i]=vtr(vp_+(((i)>>2)*4096+((i)&3)*1024+512)); }while(0)
  #define KRD(G,j) do{ if(G){ kload2(kf,kp0+sl_next,j); SBAR(); } }while(0)
  #define STEP(C0,C1,P0,P1,t,GK,GV,GL) do{ SBAR(); \
    const lds_cptr vp_=vp0+sl_prev; \
    VRD(0); SBAR(); float sacc=(P0[0]+P0[1]); \
    GAPA(C0=__builtin_amdgcn_mfma_f32_32x32x16_bf16(kf[0],qr[0],negm,0,0,0), P0[2],P0[3],P0[4],P0[5],     pw0[0]=PKW(P0,0), pw0[1]=PKW(P0,2), pw0); \
    VRD(4); SBAR(); GAPA(C1=__builtin_amdgcn_mfma_f32_32x32x16_bf16(kf[1],qr[0],negm,0,0,0), P0[6],P0[7],P0[8],P0[9],     pw0[2]=PKW(P0,4), pw0[3]=PKW(P0,6), pw0); \
    VRD(1); SBAR(); GAPA(C0=__builtin_amdgcn_mfma_f32_32x32x16_bf16(kf[2],qr[1],C0,0,0,0),   P0[10],P0[11],P0[12],P0[13], pw1[0]=PKW(P0,8), pw1[1]=PKW(P0,10), pw1); \
    VRD(5); SBAR(); GAPA(C1=__builtin_amdgcn_mfma_f32_32x32x16_bf16(kf[3],qr[1],C1,0,0,0),   P0[14],P0[15],P1[0],P1[1],   pw1[2]=PKW(P0,12),pw1[3]=PKW(P0,14), pw1); \
    VRD(2); SBAR(); GAPA(C0=__builtin_amdgcn_mfma_f32_32x32x16_bf16(kf[4],qr[2],C0,0,0,0),   P1[2],P1[3],P1[4],P1[5],     pw2[0]=PKW(P1,0), pw2[1]=PKW(P1,2), pw2); \
    VRD(6); SBAR(); GAPA(C1=__builtin_amdgcn_mfma_f32_32x32x16_bf16(kf[5],qr[2],C1,0,0,0),   P1[6],P1[7],P1[8],P1[9],     pw2[2]=PKW(P1,4), pw2[3]=PKW(P1,6), pw2); \
    VRD(3); SBAR(); GAPA(C0=__builtin_amdgcn_mfma_f32_32x32x16_bf16(kf[6],qr[3],C0,0,0,0),   P1[10],P1[11],P1[12],P1[13], pw3[0]=PKW(P1,8), pw3[1]=PKW(P1,10), pw3); \
    VRD(7); SBAR(); GAPA(C1=__builtin_amdgcn_mfma_f32_32x32x16_bf16(kf[7],qr[3],C1,0,0,0),   P1[14],P1[15],0.f,0.f,       pw3[2]=PKW(P1,12),pw3[3]=PKW(P1,14), pw3); \
    l_reg+=sacc; \
    if(GK){DMA_K((t)+3,sl_cur);} if(GV){DMA_V((t)+1,sl_next);} \
    CMASK(C0,C1,t); \
    { float a=MX3(C0[0],C0[1],C1[0]),b=MX3(C0[2],C0[3],C1[1]); a=MX3(a,C1[2],C1[3]); \
      _Pragma("unroll") for(int r=4;r<16;r+=4){a=MX3(a,C0[r],C0[r+1]);b=MX3(b,C0[r+2],C0[r+3]);a=MX3(a,C1[r],C1[r+1]);b=MX3(b,C1[r+2],C1[r+3]);} \
      float rm=__builtin_fmaxf(a,b); { auto rr=__builtin_amdgcn_permlane32_swap(__float_as_uint(rm),__float_as_uint(rm),false,false); rm=__builtin_fmaxf(__uint_as_float(rr[0]),__uint_as_float(rr[1])); } \
      resc=false; \
      if(__builtin_expect(__any(rm>(float)THRL),0)){ const float dl=__builtin_fmaxf(rm,0.f); mhat+=dl; \
        _Pragma("unroll") for(int r=0;r<16;++r){C0[r]-=dl;C1[r]-=dl;} \
        _Pragma("unroll") for(int r=0;r<16;++r)negm[r]=-mhat; asm volatile("":"+v"(negm)); \
        const float f=__builtin_amdgcn_exp2f(-dl); l_reg*=f; if(hi==0)wsf[r32]=f; resc=true; } } \
    SBAR(); \
    GAPB(o[0]=__builtin_amdgcn_mfma_f32_32x32x16_bf16(PAF(0),VFR(0),o[0],0,0,0), C0,0); \
    GAPB(o[1]=__builtin_amdgcn_mfma_f32_32x32x16_bf16(PAF(0),VFR(4),o[1],0,0,0), C0,4); \
    KRD(GL,0); GAPB(o[0]=__builtin_amdgcn_mfma_f32_32x32x16_bf16(PAF(1),VFR(1),o[0],0,0,0), C0,8); \
    KRD(GL,1); GAPB(o[1]=__builtin_amdgcn_mfma_f32_32x32x16_bf16(PAF(1),VFR(5),o[1],0,0,0), C0,12); \
    KRD(GL,2); GAPB(o[0]=__builtin_amdgcn_mfma_f32_32x32x16_bf16(PAF(2),VFR(2),o[0],0,0,0), C1,0); \
    KRD(GL,3); GAPB(o[1]=__builtin_amdgcn_mfma_f32_32x32x16_bf16(PAF(2),VFR(6),o[1],0,0,0), C1,4); \
    GAPB(o[0]=__builtin_amdgcn_mfma_f32_32x32x16_bf16(PAF(3),VFR(3),o[0],0,0,0), C1,8); \
    GAPB(o[1]=__builtin_amdgcn_mfma_f32_32x32x16_bf16(PAF(3),VFR(7),o[1],0,0,0), C1,12); \
    }while(0)
  int t=1;
  #undef CMASK
  #define CMASK(P0,P1,t) do{}while(0)
  for(;t+5<NT;t+=2){
    STEP(pB0,pB1,pA0,pA1,t,true,true,true);     WAIT_BAR(2); RESC(); ROT();
    STEP(pA0,pA1,pB0,pB1,t+1,true,true,true);   WAIT_BAR(2); RESC(); ROT();
  }
  #undef CMASK
  #define CMASK(P0,P1,t) do{int jb_=(t)-(NT-4); if(jb_>=0)cmask(P0,P1,jb_,qrel,hi);}while(0)
  #define ENDW(tt) do{ if((tt)+3<NT){WAIT_BAR(2);} else if((tt)+2<NT){WAIT_BAR(1);} else {WAIT_BAR(0);} }while(0)
  for(;t+1<NT;t+=2){
    STEP(pB0,pB1,pA0,pA1,t,(t+3<NT),(t+1<NT),(t+1<NT));       ENDW(t);   RESC(); ROT();
    STEP(pA0,pA1,pB0,pB1,t+1,(t+4<NT),(t+2<NT),(t+2<NT));     ENDW(t+1); RESC(); ROT();
  }
  STEP(pB0,pB1,pA0,pA1,NT-1,false,false,false); RESC();
  { float sacc=pB0[0]+pB0[1]; _Pragma("unroll") for(int r=2;r<16;++r)sacc+=pB0[r]; _Pragma("unroll") for(int r=0;r<16;++r)sacc+=pB1[r]; l_reg+=sacc;
    pw0=(u32x4){PKW(pB0,0),PKW(pB0,2),PKW(pB0,4),PKW(pB0,6)};pw1=(u32x4){PKW(pB0,8),PKW(pB0,10),PKW(pB0,12),PKW(pB0,14)};pw2=(u32x4){PKW(pB1,0),PKW(pB1,2),PKW(pB1,4),PKW(pB1,6)};pw3=(u32x4){PKW(pB1,8),PKW(pB1,10),PKW(pB1,12),PKW(pB1,14)};
    SBAR(); pv(o,vb0+sl_cur,PAF(0),PAF(1),PAF(2),PAF(3)); }
  #undef PKW
  #undef PAF
  #undef VFR
  #undef PIN
  #undef MX3
  #undef GAPA
  #undef GAPB
  #undef EX
  #undef VRD
  #undef KRD
  #undef STEP
  #undef ENDW
  {auto rr=__builtin_amdgcn_permlane32_swap(__float_as_uint(l_reg),__float_as_uint(l_reg),false,false);l_reg=__uint_as_float(rr[0])+__uint_as_float(rr[1]);}
  if(hi==0)wsf[32+r32]=l_reg;asm volatile("s_waitcnt lgkmcnt(0)":::"memory");
  float rli[16];
  #pragma unroll
  for(int r=0;r<16;++r)rli[r]=__builtin_amdgcn_rcpf(wsf[32+crow(r,hi)]);
  bf16*Ow=O+(rowbase+q0+wid*QBLK)*DM+hv*D;
  { bf16*stg=(bf16*)(shm+LDS_OST)+wid*2048;
    #pragma unroll
    for(int r=0;r<16;++r){const int orow=crow(r,hi);
      #pragma unroll
      for(int d0=0;d0<2;++d0)stg[orow*64+d0*32+r32]=__float2bfloat16(o[d0][r]*rli[r]);}
    asm volatile("s_waitcnt lgkmcnt(0)":::"memory");
    #pragma unroll
    for(int i=0;i<4;++i){const int row=i*8+(lane>>3),ch=lane&7; const u32x4 v=*(const u32x4*)(stg+row*64+ch*8); ATTN_STORE16(Ow+(long)row*DM+ch*8,v);} }
  asm volatile("s_waitcnt lgkmcnt(0)\n\ts_barrier":::"memory");
  #undef DMA_K
  #undef DMA_V
  #undef CMASK
  #undef START
  #undef RESC
  #undef ROT
}
constexpr int ATTN_LDS_BYTES=LDS_BYTES;
#undef SBAR
#undef WAIT_BAR
}
#define GAS __attribute__((address_space(1)))
#define LAS __attribute__((address_space(3)))
typedef unsigned short bf16;
typedef unsigned v4u __attribute__((ext_vector_type(4)));
typedef float f32x4 __attribute__((ext_vector_type(4)));
typedef short bf16x8 __attribute__((ext_vector_type(8)));
typedef GAS unsigned gu32;
typedef GAS unsigned long long gu64;
#define RLX_AGENT __ATOMIC_RELAXED, __HIP_MEMORY_SCOPE_AGENT
#define LDS_WAIT() asm volatile("s_waitcnt lgkmcnt(0)" ::: "memory")
#define VM_WAIT() asm volatile("s_waitcnt vmcnt(0)" ::: "memory")
__device__ __forceinline__ unsigned long long rt() { return __builtin_amdgcn_s_memrealtime(); }
__device__ __forceinline__ unsigned f2bf(float f) { unsigned u = __builtin_bit_cast(unsigned, f); return (u + 0x7fffu + ((u >> 16) & 1u)) >> 16; }
__device__ __forceinline__ unsigned pk2(float lo, float hi) { return f2bf(lo) | (f2bf(hi) << 16); }

#define XB_TMO      128
#define XB_XCNT(j)  (256  + 64 * (j))
#define XB_XSUB(j)  (1280 + 64 * (j))
#define XB_XGEN(j)  (2304 + 64 * (j))
#define XB_TOP      3328
#define XB_TOPGEN   3392
#define XCD_BAR_WORDS 3456
#define XB_SPIN_CAP (1u << 18)

__device__ __forceinline__ unsigned xb_ld(unsigned* p)              { return __hip_atomic_load(p, __ATOMIC_RELAXED, __HIP_MEMORY_SCOPE_AGENT); }
__device__ __forceinline__ unsigned xb_add(unsigned* p, unsigned v) { return __hip_atomic_fetch_add(p, v, __ATOMIC_RELAXED, __HIP_MEMORY_SCOPE_AGENT); }
__device__ __forceinline__ unsigned xb_xcc_id() { return (unsigned)__builtin_amdgcn_s_getreg((3 << 11) | 20) & 0xFu; }
#define XB_SPIN(cond, bar) do { unsigned _sp = 0; while (cond) { __builtin_amdgcn_s_sleep(1); \
    if ((++_sp & 255u) == 0u) { if (xb_ld(&(bar)[XB_TMO])) break; if (_sp > XB_SPIN_CAP) { atomicAdd(&(bar)[XB_TMO], 1u); break; } } } } while (0)

struct XcdBarrier {
    unsigned* bar; unsigned x;
    volatile LAS unsigned* st;
};

__device__ __forceinline__ XcdBarrier xcd_barrier_post(unsigned* bar, volatile LAS unsigned* st) {
    XcdBarrier b; b.bar = bar; b.x = xb_xcc_id(); b.st = st;
    if (threadIdx.x == 0) (void)xb_add(&bar[XB_XCNT(b.x)], 1u);
    return b;
}
__device__ __forceinline__ void xcd_barrier_complete(unsigned* bar, unsigned x, unsigned& nloc, unsigned& nx) {
    const unsigned G = gridDim.x * gridDim.y * gridDim.z;
    unsigned sum, cnt, mine, sp = 0u;
    for (;;) {
        sum = 0u; cnt = 0u;
#pragma unroll
        for (unsigned j = 0; j < 16; ++j) { const unsigned c = xb_ld(&bar[XB_XCNT(j)]); sum += c; cnt += (c > 0u) ? 1u : 0u; }
        if (sum == G) break;
        __builtin_amdgcn_s_sleep(1);
        if ((++sp & 255u) == 0u) { if (xb_ld(&bar[XB_TMO])) break; if (sp > XB_SPIN_CAP) { atomicAdd(&bar[XB_TMO], 1u); break; } }
    }
    mine = xb_ld(&bar[XB_XCNT(x)]);
    nloc = mine > 0u ? mine : 1u; nx = cnt > 0u ? cnt : 1u;
}

__device__ __forceinline__ void xcd_barrier(const XcdBarrier& b) {
    asm volatile("s_waitcnt vmcnt(0)" ::: "memory");
    __syncthreads();
    if (threadIdx.x == 0) {
        unsigned* bar = b.bar;
        __builtin_amdgcn_s_waitcnt(0);
        unsigned nloc = b.st[0], nx = b.st[1];
        if (nloc == 0u) { xcd_barrier_complete(bar, b.x, nloc, nx); b.st[0] = nloc; b.st[1] = nx; }
        const unsigned old = xb_add(&bar[XB_XSUB(b.x)], 1u);
        const unsigned gen = old / nloc;
        if (old + 1u == (gen + 1u) * nloc) {
            __builtin_amdgcn_fence(__ATOMIC_RELEASE, "agent");
            asm volatile("s_waitcnt vmcnt(0)" ::: "memory");
            const unsigned og = xb_add(&bar[XB_TOP], 1u);
            const unsigned tg = og / nx;
            if (og + 1u == (tg + 1u) * nx) xb_add(&bar[XB_TOPGEN], 1u);
            else XB_SPIN(xb_ld(&bar[XB_TOPGEN]) == tg, bar);
            __builtin_amdgcn_fence(__ATOMIC_ACQUIRE, "agent");
            xb_add(&bar[XB_XGEN(b.x)], 1u);
            asm volatile("s_waitcnt vmcnt(0)" ::: "memory");
        } else {
            XB_SPIN(xb_ld(&bar[XB_XGEN(b.x)]) == gen, bar);
            __builtin_amdgcn_fence(__ATOMIC_ACQUIRE, "agent");
            asm volatile("s_waitcnt vmcnt(0)" ::: "memory");
        }
    }
    __syncthreads();
}
constexpr int NWAVES = 8;
constexpr int DM = 1024, MP = 32768, MS = 512, MROWS = MP + MS, NSEQ = 20, DEPTH = 4, DFF = 2816, DIN = 9216, PAST = 2048;
constexpr int NCHUNK_P = 512, NCHUNK = 528;
constexpr float EPS = 1e-6f;
constexpr size_t OY_P = 0, OY_S = 33554432, OK_P = 34078720, OV_P = 168296448, OS_P = 302514176, OK_S = 304611328, OV_S = 306708480, OS_S = 308805632, OUT_TOTAL = 317194240;

constexpr size_t MiB = 1u << 20;
constexpr size_t WS_CTL = 0, CTL_ZERO_BYTES = 1 * MiB;
constexpr size_t WS_MOD = 1 * MiB;
constexpr size_t WS_LB = 4 * MiB;
constexpr size_t WS_W = 8 * MiB, W_LAYER = 57 * MiB;
constexpr size_t WO_GU1 = 0, WO_D1 = 11 * MiB, WO_IN = 16 * MiB + MiB / 2, WO_BA = 34 * MiB + MiB / 2, WO_BH = 36 * MiB + MiB / 2, WO_OUT = 38 * MiB + MiB / 2, WO_GU2 = 40 * MiB + MiB / 2, WO_D2 = 51 * MiB + MiB / 2;
constexpr size_t WS_X = 240 * MiB;
constexpr size_t WS_XN = 370 * MiB;
constexpr size_t WS_Q = 435 * MiB, WS_K = 500 * MiB, WS_V = 565 * MiB;
constexpr size_t WS_QQ = 630 * MiB, WS_KK = 695 * MiB, WS_VV = 760 * MiB, WS_HGS = 825 * MiB, WS_SZA = 890 * MiB, WS_SZH = 955 * MiB;
constexpr size_t WS_LOGF = 1020 * MiB;
constexpr size_t WS_O1 = 1150 * MiB, WS_O2 = 1215 * MiB, WS_OATT = 1280 * MiB, WS_OH = 1345 * MiB, WS_MRG = 1410 * MiB;
constexpr size_t WS_BIG = 1475 * MiB;
constexpr size_t WS_SST = 1739 * MiB;
constexpr size_t WS_DD = 1871 * MiB;
constexpr size_t WS_END = 1874 * MiB;
constexpr int CW_BAR = 4096, CW_Q = 8192;
static_assert(pg8::EpiWin::O_Q == WS_Q && pg8::EpiWin::O_K == WS_K && pg8::EpiWin::O_V == WS_V && pg8::EpiWin::O_QQ == WS_QQ && pg8::EpiWin::O_KK == WS_KK && pg8::EpiWin::O_VV == WS_VV && pg8::EpiWin::O_HGS == WS_HGS && pg8::EpiWin::O_SZA == WS_SZA && pg8::EpiWin::O_SZH == WS_SZH && pg8::EpiWin::O_LOGF == WS_LOGF && pg8::EpiWin::O_LB == WS_LB && pg8::EpiWin::OK_P_ == OK_P && pg8::EpiWin::OV_P_ == OV_P && pg8::EpiWin::OK_S_ == OK_S && pg8::EpiWin::OV_S_ == OV_S, "EpiWin offsets");

constexpr int RING_OFF = 0, RING_BYTES = 139264;
constexpr int LDSCTL_OFF = RING_BYTES, MISC_OFF = LDSCTL_OFF + 320;
constexpr int LDS_BYTES = 147456;

struct Frame {
    LAS unsigned char* lds;
    volatile LAS unsigned* MISC;
    gu32* ctl;
    int tid, lane, wave;
    int vcu, G;
};
typedef float f32x16 __attribute__((ext_vector_type(16)));
typedef unsigned v2u __attribute__((ext_vector_type(2)));

__device__ __forceinline__ float wave_sum(float v) {
#pragma unroll
    for (int o = 1; o < 64; o <<= 1) v += __shfl_xor(v, o);
    return v;
}
__device__ __forceinline__ float bf2f(bf16 b) { return __builtin_bit_cast(float, (unsigned)b << 16); }
__device__ __forceinline__ unsigned cvtpk(float lo, float hi) { return pg8::cvt_pk_bf16(lo, hi); }
__device__ __forceinline__ bf16x8 pack8(f32x4 a, f32x4 b) { v4u w; w.x = cvtpk(a[0], a[1]); w.y = cvtpk(a[2], a[3]); w.z = cvtpk(b[0], b[1]); w.w = cvtpk(b[2], b[3]); return __builtin_bit_cast(bf16x8, w); }
__device__ __forceinline__ float lam_init_of(int l) { return 0.8f - 0.6f * __expf(-0.3f * (float)l); }

__device__ __forceinline__ void p0_transpose_item(const float* W, int K, int N, bf16* WT, bool gu, LAS float* scr, int item, int lane) {
    const int nblk = N / 32, kb = item / nblk, nb = item % nblk, k0 = 64 * kb, nd0 = 32 * nb;
    const int ns0 = gu ? (((nd0 >> 7) & 1) * 2816 + (nd0 >> 8) * 128 + (nd0 & 127)) : nd0;
#pragma unroll 8
    for (int i = 0; i < 32; ++i) { const int kk = 2 * i + (lane >> 5); scr[kk * 33 + (lane & 31)] = W[(size_t)(k0 + kk) * N + ns0 + (lane & 31)]; }
    LDS_WAIT(); asm volatile("" ::: "memory");
    const int c = lane & 7;
#pragma unroll
    for (int j = 0; j < 4; ++j) { const int n = (lane >> 3) + 8 * j; const LAS float* s = scr + (8 * c) * 33 + n;
        v4u o; o.x = pk2(s[0 * 33], s[1 * 33]); o.y = pk2(s[2 * 33], s[3 * 33]); o.z = pk2(s[4 * 33], s[5 * 33]); o.w = pk2(s[6 * 33], s[7 * 33]);
        *(GAS v4u*)(WT + (size_t)(nd0 + n) * K + k0 + 8 * c) = o; }
    LDS_WAIT(); asm volatile("" ::: "memory");
}
typedef const __attribute__((address_space(4))) char* kaptr_t;
__device__ __forceinline__ const float* karg(int i) { kaptr_t ka = (kaptr_t)__builtin_amdgcn_kernarg_segment_ptr(); asm volatile("" : "+s"(ka)); return *(const float* const __attribute__((address_space(4)))*)(ka + 8 * i); }
enum { A_XP = 0, A_XS, A_CK, A_CV, A_ST, A_CP, A_CS, A_WADA, A_BADA, A_GFFN1, A_WGU1, A_WD1, A_GMIX, A_WIN, A_LAM, A_GSUB, A_LBL, A_GHG, A_WBA, A_WBH, A_WOUT, A_GFFN2, A_WGU2, A_WD2, A_GFIN, A_OUT, A_WS };
__device__ __forceinline__ void p0_prologue(Frame& F, unsigned char* ws) {
    { LAS float* scr = (LAS float*)(F.lds + RING_OFF + F.wave * 16384);
      const int gw = F.vcu * NWAVES + F.wave, NGW = F.G * NWAVES;
      constexpr int I_GU = 16 * 176, I_D = 44 * 32, I_IN = 16 * 288, I_SQ = 16 * 32, I_LAYER = 2 * I_GU + 2 * I_D + I_IN + 3 * I_SQ;
      for (int it = gw; it < DEPTH * I_LAYER; it += NGW) {
          const int l = it / I_LAYER; int r = it % I_LAYER; unsigned char* wl = ws + WS_W + (size_t)l * W_LAYER;
          if (r < I_GU) { p0_transpose_item(karg(A_WGU1) + (size_t)l * 1024 * 5632, 1024, 5632, (bf16*)(wl + WO_GU1), true, scr, r, F.lane); continue; } r -= I_GU;
          if (r < I_D)  { p0_transpose_item(karg(A_WD1) + (size_t)l * 2816 * 1024, 2816, 1024, (bf16*)(wl + WO_D1), false, scr, r, F.lane); continue; } r -= I_D;
          if (r < I_IN) { p0_transpose_item(karg(A_WIN) + (size_t)l * 1024 * 9216, 1024, 9216, (bf16*)(wl + WO_IN), false, scr, r, F.lane); continue; } r -= I_IN;
          if (r < I_SQ) { p0_transpose_item(karg(A_WBA) + (size_t)l * 1024 * 1024, 1024, 1024, (bf16*)(wl + WO_BA), false, scr, r, F.lane); continue; } r -= I_SQ;
          if (r < I_SQ) { p0_transpose_item(karg(A_WBH) + (size_t)l * 1024 * 1024, 1024, 1024, (bf16*)(wl + WO_BH), false, scr, r, F.lane); continue; } r -= I_SQ;
          if (r < I_SQ) { p0_transpose_item(karg(A_WOUT) + (size_t)l * 1024 * 1024, 1024, 1024, (bf16*)(wl + WO_OUT), false, scr, r, F.lane); continue; } r -= I_SQ;
          if (r < I_GU) { p0_transpose_item(karg(A_WGU2) + (size_t)l * 1024 * 5632, 1024, 5632, (bf16*)(wl + WO_GU2), true, scr, r, F.lane); continue; } r -= I_GU;
          p0_transpose_item(karg(A_WD2) + (size_t)l * 2816 * 1024, 2816, 1024, (bf16*)(wl + WO_D2), false, scr, r, F.lane);
      } }
    __syncthreads();
    { const float* c_p = karg(A_CP); const float* c_s = karg(A_CS); const float* w_ada = karg(A_WADA); const float* b_ada = karg(A_BADA);
      LAS float* ca = (LAS float*)(F.lds);
      LAS float* red = (LAS float*)(F.lds + 81920);
      for (int i = F.tid; i < NSEQ * 1024; i += NWAVES * 64) { const int s = i >> 10, k = i & 1023; const float c = s < 4 ? c_p[s * 1024 + k] : c_s[(s - 4) * 1024 + k]; ca[i] = pg8::silu_f(c); }
      __syncthreads();
      float* MOD = (float*)(ws + WS_MOD);
      for (int it = F.vcu; it < DEPTH * 144; it += F.G) {
          const int l = it / 144, n = (it % 144) * 64 + F.lane; const float* wp = w_ada + ((size_t)l * 1024 + F.wave * 128) * 9216 + n;
          float acc[NSEQ];
#pragma unroll
          for (int s = 0; s < NSEQ; ++s) acc[s] = 0.f;
#pragma unroll 4
          for (int k = 0; k < 128; ++k) { const float w = wp[(size_t)k * 9216];
#pragma unroll
              for (int s = 0; s < NSEQ; ++s) acc[s] += ca[s * 1024 + F.wave * 128 + k] * w; }
#pragma unroll
          for (int s = 0; s < NSEQ; ++s) red[(F.wave * NSEQ + s) * 64 + F.lane] = acc[s];
          __syncthreads();
          for (int i = F.tid; i < NSEQ * 64; i += NWAVES * 64) { const int s = i >> 6, c = i & 63; float v = 0.f;
#pragma unroll
              for (int w = 0; w < 8; ++w) v += red[(w * NSEQ + s) * 64 + c];
              const int nn = (it % 144) * 64 + c; MOD[((size_t)l * NSEQ + s) * 9216 + nn] = v + b_ada[(size_t)l * 9216 + nn]; }
          __syncthreads();
      } }
    if (F.vcu == 0) { float* LB = (float*)(ws + WS_LB); const float* lb_logits = karg(A_LBL);
        for (int c = F.tid; c < 1024; c += NWAVES * 64) { float lg[4], mx = -INFINITY;
#pragma unroll
            for (int l = 0; l < 4; ++l) { lg[l] = lb_logits[l * 1024 + c]; mx = __builtin_fmaxf(mx, lg[l]); }
            float sum = 0.f;
#pragma unroll
            for (int l = 0; l < 4; ++l) { lg[l] = __expf(lg[l] - mx); sum += lg[l]; }
            const float inv = 1.f / sum; float cs = 0.f;
#pragma unroll
            for (int l = 0; l < 4; ++l) { cs += lg[l] * inv; LB[l * 1024 + c] = cs - lg[0] * inv; } } }
}

__device__ __forceinline__ void norm_phase(Frame& F, const float* x_p, const float* x_s, bool first, float* X, const float* g, const float* mod_l, int sub, bf16* XN) {
    const int gw = F.vcu * NWAVES + F.wave, NGW = F.G * NWAVES;
    for (int row = gw; row < MROWS; row += NGW) {
        const float* src = first ? (row < MP ? x_p + (size_t)row * DM : x_s + (size_t)(row - MP) * DM) : X + (size_t)row * DM;
        const float* mp = mod_l + (size_t)pg8::row_seq(row) * 9216 + sub * 3 * 1024;
        const f32x4* xr = (const f32x4*)src + F.lane; f32x4 v[4]; float s2 = 0.f;
#pragma unroll
        for (int j = 0; j < 4; ++j) { v[j] = xr[64 * j]; s2 += (v[j].x * v[j].x + v[j].y * v[j].y) + (v[j].z * v[j].z + v[j].w * v[j].w); }
        const float rstd = __builtin_amdgcn_rsqf(wave_sum(s2) * (1.f / DM) + EPS);
        if (first) { f32x4* xo = (f32x4*)(X + (size_t)row * DM) + F.lane;
#pragma unroll
            for (int j = 0; j < 4; ++j) xo[64 * j] = v[j]; }
        v2u* o8 = (v2u*)(XN + (size_t)row * DM) + F.lane;
#pragma unroll
        for (int j = 0; j < 4; ++j) { const int c = 4 * F.lane + 256 * j; const f32x4 gg = *(const f32x4*)(g + c), sh = *(const f32x4*)(mp + c), sc = *(const f32x4*)(mp + 1024 + c);
            const f32x4 h = (v[j] * rstd) * gg * (sc + 1.f) + sh; v2u o; o.x = cvtpk(h.x, h.y); o.y = cvtpk(h.z, h.w); o8[64 * j] = o; }
    }
}
__device__ __forceinline__ void final_norm_phase(Frame& F, const float* X, const float* g, float* out) {
    const int gw = F.vcu * NWAVES + F.wave, NGW = F.G * NWAVES;
    for (int row = gw; row < MROWS; row += NGW) {
        const f32x4* xr = (const f32x4*)(X + (size_t)row * DM) + F.lane; f32x4 v[4]; float s2 = 0.f;
#pragma unroll
        for (int j = 0; j < 4; ++j) { v[j] = xr[64 * j]; s2 += (v[j].x * v[j].x + v[j].y * v[j].y) + (v[j].z * v[j].z + v[j].w * v[j].w); }
        const float rstd = __builtin_amdgcn_rsqf(wave_sum(s2) * (1.f / DM) + EPS);
        f32x4* o = (f32x4*)(out + (row < MP ? OY_P + (size_t)row * DM : OY_S + (size_t)(row - MP) * DM)) + F.lane;
#pragma unroll
        for (int j = 0; j < 4; ++j) { const f32x4 gg = *(const f32x4*)(g + 4 * F.lane + 256 * j); o[64 * j] = (v[j] * rstd) * gg; }
    }
}
__device__ __forceinline__ float lam_of(const float* att_lambda, int l, int lane) {
    const float* lp = att_lambda + (size_t)l * 256;
    const float a = wave_sum(lp[lane] * lp[64 + lane]), b = wave_sum(lp[128 + lane] * lp[192 + lane]);
    return __expf(a) - __expf(b) + lam_init_of(l);
}
__device__ __forceinline__ void attn_combine_phase(Frame& F, const bf16* O1, const bf16* O2, const float* gsub, float lam, float osc, bf16* OATT) {
    const int gw = F.vcu * NWAVES + F.wave, NGW = F.G * NWAVES; const int cl = (F.lane & 7) * 16;
    float gv[16];
#pragma unroll
    for (int i = 0; i < 16; ++i) gv[i] = gsub[cl + i] * osc;
    for (int row = gw; row < MP; row += NGW) {
        const size_t off = (size_t)row * DM + F.lane * 16; const v4u a0 = *(const v4u*)(O1 + off), a1 = *(const v4u*)(O1 + off + 8), b0 = *(const v4u*)(O2 + off), b1 = *(const v4u*)(O2 + off + 8);
        const unsigned aw[8] = {a0.x, a0.y, a0.z, a0.w, a1.x, a1.y, a1.z, a1.w}, bw[8] = {b0.x, b0.y, b0.z, b0.w, b1.x, b1.y, b1.z, b1.w};
        float o[16]; float ss = 0.f;
#pragma unroll
        for (int i = 0; i < 8; ++i) { o[2 * i] = pg8::bf_lo(aw[i]) - lam * pg8::bf_lo(bw[i]); o[2 * i + 1] = pg8::bf_hi(aw[i]) - lam * pg8::bf_hi(bw[i]); ss += o[2 * i] * o[2 * i] + o[2 * i + 1] * o[2 * i + 1]; }
        ss += __shfl_xor(ss, 1); ss += __shfl_xor(ss, 2); ss += __shfl_xor(ss, 4);
        const float rstd = __builtin_amdgcn_rsqf(ss * (1.f / 128.f) + EPS);
        v4u w0, w1;
        w0.x = cvtpk(o[0] * rstd * gv[0], o[1] * rstd * gv[1]); w0.y = cvtpk(o[2] * rstd * gv[2], o[3] * rstd * gv[3]); w0.z = cvtpk(o[4] * rstd * gv[4], o[5] * rstd * gv[5]); w0.w = cvtpk(o[6] * rstd * gv[6], o[7] * rstd * gv[7]);
        w1.x = cvtpk(o[8] * rstd * gv[8], o[9] * rstd * gv[9]); w1.y = cvtpk(o[10] * rstd * gv[10], o[11] * rstd * gv[11]); w1.z = cvtpk(o[12] * rstd * gv[12], o[13] * rstd * gv[13]); w1.w = cvtpk(o[14] * rstd * gv[14], o[15] * rstd * gv[15]);
        *(v4u*)(OATT + off) = w0; *(v4u*)(OATT + off + 8) = w1;
    }
}

__device__ __forceinline__ void attn_sample_unit(Frame& F, const float* cache_k, const float* cache_v, int l, int s, int head, const bf16* Qb, const bf16* Kb, const bf16* Vb, float lam, float osc, const float* gsub, bf16* OATT) {
    const int lane = F.lane, w = F.wave, q = lane & 31, hh = lane >> 5, vt = w & 3, kh = w >> 2;
    LAS float* SLOT = (LAS float*)(F.lds);
    LAS float* ML = (LAS float*)(F.lds + 16384);
    LAS float* SSQ = (LAS float*)(F.lds + 16384 + 512);
    const size_t qrow = (size_t)MP + (size_t)s * 32;
    const float* ck = cache_k + ((size_t)(l * 16 + s) * PAST) * 1024 + head * 128;
    const float* cv = cache_v + ((size_t)(l * 16 + s) * PAST) * 1024 + head * 128;
    f32x16 o1;
#pragma unroll
    for (int r = 0; r < 16; ++r) o1[r] = 0.f;
    for (int m = 0; m < 2; ++m) {
        bf16x8 qf[4];
#pragma unroll
        for (int ks = 0; ks < 4; ++ks) qf[ks] = *(const bf16x8*)(Qb + (qrow + q) * 1024 + head * 128 + m * 64 + ks * 16 + 8 * hh);
        float mrun = -INFINITY, lrun = 0.f; f32x16 ot;
#pragma unroll
        for (int r = 0; r < 16; ++r) ot[r] = 0.f;
        const int ntile = 32 + kh;
        for (int t = 0; t < ntile; ++t) {
            const bool nw = (t == 32); const int key0 = kh * 1024 + t * 32;
            bf16x8 kf[4];
            if (!nw) { const float* kp = ck + (size_t)(key0 + q) * 1024 + m * 64 + 8 * hh;
#pragma unroll
                for (int ks = 0; ks < 4; ++ks) { const f32x4 a = *(const f32x4*)(kp + ks * 16), b = *(const f32x4*)(kp + ks * 16 + 4); kf[ks] = pack8(a, b); } }
            else {
#pragma unroll
                for (int ks = 0; ks < 4; ++ks) kf[ks] = *(const bf16x8*)(Kb + (qrow + q) * 1024 + head * 128 + m * 64 + ks * 16 + 8 * hh); }
            float vf[2][8];
            { const float* vp = cv + (size_t)(key0 + 4 * hh) * 1024 + 32 * vt + q; const bf16* vpn = Vb + (qrow + 4 * hh) * 1024 + head * 128 + 32 * vt + q;
#pragma unroll
              for (int s2 = 0; s2 < 2; ++s2)
#pragma unroll
                  for (int j = 0; j < 8; ++j) { const int kr = 16 * s2 + 8 * (j >> 2) + (j & 3);
                      vf[s2][j] = nw ? bf2f(vpn[kr * 1024]) : vp[kr * 1024]; } }
            f32x16 st;
#pragma unroll
            for (int r = 0; r < 16; ++r) st[r] = 0.f;
#pragma unroll
            for (int ks = 0; ks < 4; ++ks) st = __builtin_amdgcn_mfma_f32_32x32x16_bf16(kf[ks], qf[ks], st, 0, 0, 0);
            float tm = st[0];
#pragma unroll
            for (int r = 1; r < 16; ++r) tm = __builtin_fmaxf(tm, st[r]);
            tm = __builtin_fmaxf(tm, __shfl_xor(tm, 32));
            const float mnew = __builtin_fmaxf(mrun, tm), alpha = __builtin_amdgcn_exp2f(mrun - mnew);
            float ls = 0.f;
#pragma unroll
            for (int r = 0; r < 16; ++r) { st[r] = __builtin_amdgcn_exp2f(st[r] - mnew); ls += st[r]; }
            ls += __shfl_xor(ls, 32);
            lrun = lrun * alpha + ls; mrun = mnew;
#pragma unroll
            for (int r = 0; r < 16; ++r) ot[r] *= alpha;
#pragma unroll
            for (int s2 = 0; s2 < 2; ++s2) { v4u pw; pw.x = cvtpk(st[8 * s2], st[8 * s2 + 1]); pw.y = cvtpk(st[8 * s2 + 2], st[8 * s2 + 3]); pw.z = cvtpk(st[8 * s2 + 4], st[8 * s2 + 5]); pw.w = cvtpk(st[8 * s2 + 6], st[8 * s2 + 7]);
                v4u aw; aw.x = cvtpk(vf[s2][0], vf[s2][1]); aw.y = cvtpk(vf[s2][2], vf[s2][3]); aw.z = cvtpk(vf[s2][4], vf[s2][5]); aw.w = cvtpk(vf[s2][6], vf[s2][7]);
                ot = __builtin_amdgcn_mfma_f32_32x32x16_bf16(__builtin_bit_cast(bf16x8, aw), __builtin_bit_cast(bf16x8, pw), ot, 0, 0, 0); }
        }
        if (vt == 0 && hh == 0) { ML[(kh * 32 + q) * 2] = mrun; ML[(kh * 32 + q) * 2 + 1] = lrun; }
        __syncthreads();
        const float m0 = ML[q * 2], l0 = ML[q * 2 + 1], m1 = ML[(32 + q) * 2], l1 = ML[(32 + q) * 2 + 1];
        const float Mx = __builtin_fmaxf(m0, m1), L = l0 * __builtin_amdgcn_exp2f(m0 - Mx) + l1 * __builtin_amdgcn_exp2f(m1 - Mx);
        { const float sc = __builtin_amdgcn_exp2f(mrun - Mx);
#pragma unroll
          for (int r = 0; r < 16; ++r) ot[r] *= sc; }
        if (kh == 1) {
#pragma unroll
            for (int r = 0; r < 16; ++r) SLOT[(vt * 16 + r) * 64 + lane] = ot[r]; }
        __syncthreads();
        if (kh == 0) { const float rl = 1.f / L;
#pragma unroll
            for (int r = 0; r < 16; ++r) ot[r] = (ot[r] + SLOT[(vt * 16 + r) * 64 + lane]) * rl;
            if (m == 0) {
#pragma unroll
                for (int r = 0; r < 16; ++r) o1[r] = ot[r];
            } else { float ss = 0.f;
#pragma unroll
                for (int r = 0; r < 16; ++r) { o1[r] = o1[r] - lam * ot[r]; ss += o1[r] * o1[r]; }
                ss += __shfl_xor(ss, 32);
                if (hh == 0) SSQ[vt * 32 + q] = ss; } }
        __syncthreads();
    }
    if (kh == 0) {
        const float ss = SSQ[q] + SSQ[32 + q] + SSQ[64 + q] + SSQ[96 + q];
        const float rstd = __builtin_amdgcn_rsqf(ss * (1.f / 128.f) + EPS) * osc;
#pragma unroll
        for (int r = 0; r < 16; ++r) { const int v = 32 * vt + (r & 3) + 8 * (r >> 2) + 4 * hh; OATT[(qrow + q) * 1024 + head * 128 + v] = (bf16)f2bf(o1[r] * rstd * gsub[v]); }
    }
    __syncthreads();
}

constexpr int HS = 72, HK = 136;
__device__ __forceinline__ f32x4 mfma16(bf16x8 a, bf16x8 b, f32x4 c) { return __builtin_amdgcn_mfma_f32_16x16x32_bf16(a, b, c, 0, 0, 0); }
__device__ __forceinline__ void st16bf(LAS bf16* p, const float (&v)[16]) {
    v4u a, b; a.x = cvtpk(v[0], v[1]); a.y = cvtpk(v[2], v[3]); a.z = cvtpk(v[4], v[5]); a.w = cvtpk(v[6], v[7]); b.x = cvtpk(v[8], v[9]); b.y = cvtpk(v[10], v[11]); b.z = cvtpk(v[12], v[13]); b.w = cvtpk(v[14], v[15]);
    *(LAS v4u*)p = a; *(LAS v4u*)(p + 8) = b;
}
__device__ __forceinline__ float bfu(unsigned b) { return __builtin_bit_cast(float, b << 16); }
struct HgPtrs { const float* LOGF; const bf16 *QQ, *KK, *VV, *HGS; const float* ghg; bf16* OH; bf16* dump; };
typedef float f32x2v __attribute__((ext_vector_type(2)));
__device__ __forceinline__ void hg_load(const HgPtrs& P, size_t ubase  , unsigned k0, int w, int nvalid, f32x2v (&lf)[8], unsigned (&qv)[8], unsigned (&kv)[8], unsigned (&vv)[8]) {
    if (w * 8 < nvalid) {
#pragma unroll
        for (int i = 0; i < 8; ++i) { const size_t o = ubase + (size_t)(w * 8 + i) * 1024;
            const float* lp = P.LOGF + o; const bf16* qp = P.QQ + o; const bf16* kp = P.KK + o; const bf16* vp = P.VV + o;
            lf[i] = *(const f32x2v*)(lp + k0); qv[i] = *(const unsigned*)(qp + k0); kv[i] = *(const unsigned*)(kp + k0); vv[i] = *(const unsigned*)(vp + k0); }
    } else {
#pragma unroll
        for (int i = 0; i < 8; ++i) { lf[i] = (f32x2v){0.f, 0.f}; qv[i] = 0u; kv[i] = 0u; vv[i] = 0u; }
    }
}
__device__ __forceinline__ void hg_sequence(Frame& F, const HgPtrs& P, size_t row0, int h, int nchunk, int nvalid, const float* s_in, float* s_out) {
    LAS float* seg = (LAS float*)(F.lds);
    LAS float* part = (LAS float*)(F.lds + 4096);
    LAS float* dvec = (LAS float*)(F.lds + 6144);
    LAS bf16* QH = (LAS bf16*)(F.lds + 8192);
    LAS bf16* QT = QH + 64 * HK;
    LAS bf16* KH = QT + 64 * HK;
    LAS bf16* VT = KH + 160 * HK;
    LAS bf16* KT = VT + 128 * HS;
    LAS bf16* AL = KT + 128 * HS;
    const int w = __builtin_amdgcn_readfirstlane(F.wave), sc = w >> 1, lr_ = F.lane & 15, lq_ = F.lane >> 4; const unsigned k0_ = 2u * (unsigned)F.lane;
    f32x4 S[8];
#pragma unroll
    for (int kb = 0; kb < 8; ++kb)
#pragma unroll
        for (int r = 0; r < 4; ++r) S[kb][r] = s_in ? s_in[(size_t)(16 * kb + 4 * lq_ + r) * 128 + 16 * w + lr_] : 0.f;
    const float gv = P.ghg[16 * w + lr_];
    f32x2v lf[8]; unsigned qv[8], kv[8], vv[8];
    hg_load(P, row0 * 1024 + h * 128, k0_, w, nvalid, lf, qv, kv, vv);
    for (int c = 0; c < nchunk; ++c) {
        int lr = lr_, lq = lq_; unsigned k0 = k0_; asm volatile("" : "+v"(lr), "+v"(lq), "+v"(k0));
        const size_t crow = row0 + (size_t)c * 64;
        f32x2v cs[8]; { f32x2v run = {0.f, 0.f};
#pragma unroll
            for (int i = 0; i < 8; ++i) { run = run + lf[i]; cs[i] = run; }
            *(LAS f32x2v*)(seg + w * 128 + k0) = run; }
        __syncthreads();
        f32x2v P2[4], mypre = {0.f, 0.f}, tot; { f32x2v p = {0.f, 0.f};
#pragma unroll
            for (int s = 0; s < 8; ++s) { if ((s & 1) == 0) P2[s >> 1] = p; mypre = (s == w) ? p : mypre; p = p + *(const LAS f32x2v*)(seg + s * 128 + k0); } tot = p; }
        f32x2v myref = P2[0];
#pragma unroll
        for (int s = 1; s < 4; ++s) myref = (s == sc) ? P2[s] : myref;
        const f32x2v dq = mypre - myref;
#pragma unroll
        for (int i = 0; i < 8; ++i) { const int r = w * 8 + i; const float q0 = bfu(qv[i] & 0xffffu), q1 = bfu(qv[i] >> 16);
            *(LAS unsigned*)(QH + r * HK + k0) = cvtpk(q0 * __expf(dq.x + cs[i].x), q1 * __expf(dq.y + cs[i].y));
            *(LAS unsigned*)(QT + r * HK + k0) = cvtpk(q0 * __expf(mypre.x + cs[i].x), q1 * __expf(mypre.y + cs[i].y)); asm volatile("" ::: "memory"); }
#pragma unroll
        for (int ii = 0; ii < 4; ++ii) if (ii >= sc) { const int rb = (ii == 0) ? 0 : (ii == 1) ? 16 : (ii == 2) ? 48 : 96; const f32x2v dk = P2[ii] - mypre;
#pragma unroll
            for (int i = 0; i < 8; ++i) { const int r = w * 8 + i; const float a0 = bfu(kv[i] & 0xffffu), a1 = bfu(kv[i] >> 16);
                *(LAS unsigned*)(KH + (rb + r) * HK + k0) = cvtpk(a0 * __expf(__builtin_fminf(dk.x - cs[i].x, 80.f)), a1 * __expf(__builtin_fminf(dk.y - cs[i].y, 80.f))); asm volatile("" ::: "memory"); } }
        { const f32x2v de = tot - mypre; float e0[8], e1[8];
#pragma unroll
          for (int i = 0; i < 8; ++i) { e0[i] = bfu(kv[i] & 0xffffu) * __expf(de.x - cs[i].x); e1[i] = bfu(kv[i] >> 16) * __expf(de.y - cs[i].y); }
          v4u t0, t1; t0.x = cvtpk(e0[0], e0[1]); t0.y = cvtpk(e0[2], e0[3]); t0.z = cvtpk(e0[4], e0[5]); t0.w = cvtpk(e0[6], e0[7]); t1.x = cvtpk(e1[0], e1[1]); t1.y = cvtpk(e1[2], e1[3]); t1.z = cvtpk(e1[4], e1[5]); t1.w = cvtpk(e1[6], e1[7]);
          *(LAS v4u*)(KT + k0 * HS + 8 * w) = t0; *(LAS v4u*)(KT + (k0 + 1) * HS + 8 * w) = t1;
          v4u u0, u1;
          u0.x = (vv[0] & 0xffffu) | (vv[1] << 16); u0.y = (vv[2] & 0xffffu) | (vv[3] << 16); u0.z = (vv[4] & 0xffffu) | (vv[5] << 16); u0.w = (vv[6] & 0xffffu) | (vv[7] << 16);
          u1.x = (vv[0] >> 16) | (vv[1] & 0xffff0000u); u1.y = (vv[2] >> 16) | (vv[3] & 0xffff0000u); u1.z = (vv[4] >> 16) | (vv[5] & 0xffff0000u); u1.w = (vv[6] >> 16) | (vv[7] & 0xffff0000u);
          *(LAS v4u*)(VT + k0 * HS + 8 * w) = u0; *(LAS v4u*)(VT + (k0 + 1) * HS + 8 * w) = u1;
          if (w == 0) { f32x2v d; d.x = __expf(tot.x); d.y = __expf(tot.y); *(LAS f32x2v*)(dvec + k0) = d; } }
        __syncthreads();
        if (c + 1 < nchunk) hg_load(P, (crow + 64) * 1024 + h * 128, k0, w, nvalid, lf, qv, kv, vv);
        unsigned short hgv[16];
        { const bf16* hp = P.HGS + crow * 1024 + h * 128 + 16 * w;
#pragma unroll
          for (int mt = 0; mt < 4; ++mt)
#pragma unroll
              for (int r = 0; r < 4; ++r) { int t = 16 * mt + 4 * lq + r; t = t < nvalid ? t : nvalid - 1; hgv[mt * 4 + r] = hp[(unsigned)(t * 1024 + lr)]; } }
#pragma unroll
        for (int rr = 0; rr < 2; ++rr) { const int blk = w + 8 * rr, bi = blk >> 2, bj = blk & 3;
            f32x4 acc = {0.f, 0.f, 0.f, 0.f};
            if (bj <= bi) { const int rb = (bi == 0) ? 0 : (bi == 1) ? 16 : (bi == 2) ? 48 : 96;
#pragma unroll
                for (int ks = 0; ks < 4; ++ks) { const bf16x8 a = *(const LAS bf16x8*)(QH + (16 * bi + lr) * HK + ks * 32 + 8 * lq), b = *(const LAS bf16x8*)(KH + (rb + 16 * bj + lr) * HK + ks * 32 + 8 * lq); acc = mfma16(a, b, acc); }
                if (bi == bj) {
#pragma unroll
                    for (int r = 0; r < 4; ++r) acc[r] = (lr <= 4 * lq + r) ? acc[r] : 0.f; } }
#pragma unroll
            for (int r = 0; r < 4; ++r) AL[(16 * bi + 4 * lq + r) * HS + 16 * bj + lr] = (bf16)f2bf(acc[r]); }
        __syncthreads();
        f32x4 o[4];
        { bf16x8 bS[4], bV[2];
#pragma unroll
          for (int kp = 0; kp < 4; ++kp) { v4u t; t.x = cvtpk(S[2 * kp][0], S[2 * kp][1]); t.y = cvtpk(S[2 * kp][2], S[2 * kp][3]); t.z = cvtpk(S[2 * kp + 1][0], S[2 * kp + 1][1]); t.w = cvtpk(S[2 * kp + 1][2], S[2 * kp + 1][3]); bS[kp] = __builtin_bit_cast(bf16x8, t); }
#pragma unroll
          for (int ks = 0; ks < 2; ++ks) bV[ks] = *(const LAS bf16x8*)(VT + (16 * w + lr) * HS + ks * 32 + 8 * lq);
#pragma unroll
          for (int mt = 0; mt < 4; ++mt) { f32x4 acc = {0.f, 0.f, 0.f, 0.f};
#pragma unroll
              for (int kp = 0; kp < 4; ++kp) { const LAS bf16* qp = QT + (16 * mt + lr) * HK + 32 * kp + 4 * lq; const v2u a0 = *(const LAS v2u*)qp, a1 = *(const LAS v2u*)(qp + 16);
                  v4u a; a.x = a0.x; a.y = a0.y; a.z = a1.x; a.w = a1.y; acc = mfma16(__builtin_bit_cast(bf16x8, a), bS[kp], acc); }
#pragma unroll
              for (int ks = 0; ks < 2; ++ks) acc = mfma16(*(const LAS bf16x8*)(AL + (16 * mt + lr) * HS + ks * 32 + 8 * lq), bV[ks], acc);
              o[mt] = acc;
#pragma unroll
              for (int r = 0; r < 4; ++r) { float p = acc[r] * acc[r]; p += __shfl_xor(p, 1); p += __shfl_xor(p, 2); p += __shfl_xor(p, 4); p += __shfl_xor(p, 8); if (lr == 0) part[(16 * mt + 4 * lq + r) * 8 + w] = p; } } }
        { bf16x8 bV[2];
#pragma unroll
          for (int ks = 0; ks < 2; ++ks) bV[ks] = *(const LAS bf16x8*)(VT + (16 * w + lr) * HS + ks * 32 + 8 * lq);
#pragma unroll
          for (int kb = 0; kb < 8; ++kb) { const f32x4 d = *(const LAS f32x4*)(dvec + 16 * kb + 4 * lq); f32x4 acc = S[kb] * d;
#pragma unroll
              for (int ks = 0; ks < 2; ++ks) acc = mfma16(*(const LAS bf16x8*)(KT + (16 * kb + lr) * HS + ks * 32 + 8 * lq), bV[ks], acc);
              S[kb] = acc; } }
        __syncthreads();
        { bf16* op = P.OH + crow * 1024 + h * 128 + 16 * w;
#pragma unroll
          for (int mt = 0; mt < 4; ++mt)
#pragma unroll
              for (int r = 0; r < 4; ++r) { const int t = 16 * mt + 4 * lq + r; const f32x4 p0 = *(const LAS f32x4*)(part + t * 8), p1 = *(const LAS f32x4*)(part + t * 8 + 4);
                  const float ss = ((p0[0] + p0[1]) + (p0[2] + p0[3])) + ((p1[0] + p1[1]) + (p1[2] + p1[3]));
                  const float rstd = __builtin_amdgcn_rsqf(ss * (1.f / 128.f) + EPS);
                  const bf16 ov = (bf16)f2bf(o[mt][r] * rstd * gv * bf2f(hgv[mt * 4 + r]));
                  bf16* dst = (t < nvalid) ? op + (unsigned)(t * 1024 + lr) : P.dump + F.tid;
                  *dst = ov; } }
        __syncthreads();
    }
#pragma unroll
    for (int kb = 0; kb < 8; ++kb)
#pragma unroll
        for (int r = 0; r < 4; ++r) s_out[(size_t)(16 * kb + 4 * lq_ + r) * 128 + 16 * w + lr_] = S[kb][r];
}
__device__ __forceinline__ int wg_pull(Frame& F, gu32* ctr) {
    if (F.tid == 0) F.MISC[16] = __hip_atomic_fetch_add(ctr, 1u, RLX_AGENT);
    __syncthreads();
    const int v = (int)F.MISC[16];
    __syncthreads();
    return __builtin_amdgcn_readfirstlane(v);
}
struct Args { const float* in[25]; float* out; unsigned char* ws; };
__global__ void __launch_bounds__(NWAVES * 64, 2) mk_fwd(Args args) {
    extern __shared__ __attribute__((aligned(16))) unsigned char lds[];
    Frame F;
    F.lds = (LAS unsigned char*)lds;
    F.MISC = (volatile LAS unsigned*)(F.lds + MISC_OFF);
#define ENTER() do { F.tid = opaque_tid(); F.lane = F.tid & 63; F.wave = __builtin_amdgcn_readfirstlane(F.tid >> 6); F.G = gridDim.x; { const int bx = opaque_bid(); F.vcu = (F.G % 8 == 0) ? (bx % 8) * (F.G / 8) + bx / 8 : bx; } } while (0)
    ENTER();
    F.ctl = (gu32*)((unsigned char*)karg(A_WS) + WS_CTL);
    for (int u = F.tid; u < (LDS_BYTES - LDSCTL_OFF) / 4; u += NWAVES * 64) ((LAS unsigned*)(F.lds + LDSCTL_OFF))[u] = 0u;
    __syncthreads();
    XcdBarrier bar = xcd_barrier_post((unsigned*)(F.ctl + CW_BAR), F.MISC + 8);
#define GRID_BAR() do { asm volatile("" : "+s"(bar.x)); xcd_barrier(bar); } while (0)
#define WSP(T, off) ((T*)((unsigned char*)karg(A_WS) + (off)))
#define OUTP(off) ((float*)karg(A_OUT) + (off))

#ifndef NO_P0
    p0_prologue(F, WSP(unsigned char, 0));
#endif
    GRID_BAR();

    for (int l = 0; l < DEPTH; ++l) {
        const size_t wlo = WS_W + (size_t)l * W_LAYER, modo = WS_MOD + (size_t)l * NSEQ * 9216 * 4;
        norm_phase(F, karg(A_XP), karg(A_XS), l == 0, WSP(float, WS_X), karg(A_GFFN1) + l * 1024, WSP(const float, modo), 0, WSP(bf16, WS_XN));
        GRID_BAR(); ENTER();
#ifndef NO_G1
        { pg8::Gemm g{WSP(bf16, WS_XN), WSP(const bf16, wlo + WO_GU1), MROWS, 2 * DFF, DM}; typedef pg8::FixedOrder<130, 22, 10> Ord; Ord S; S.init(F.G, opaque_bid());
          pg8::EpiSwiglu E{WSP(bf16, WS_BIG)};
          pg8::gemm_phase<pg8::EpiSwiglu, Ord, true, true>(F.lds + RING_OFF, g, S, E); }
#endif
        GRID_BAR(); ENTER();
#ifndef NO_G2
        { pg8::Gemm g{WSP(bf16, WS_BIG), WSP(const bf16, wlo + WO_D1), MROWS, DM, DFF}; typedef pg8::FixedOrder<130, 4, 10> Ord; Ord S; S.init(F.G, opaque_bid());
          pg8::EpiResid E{WSP(float, WS_X), WSP(const float, modo) + 2 * 1024, 0.5f};
          pg8::gemm_phase<pg8::EpiResid, Ord, true, true>(F.lds + RING_OFF, g, S, E); }
#endif
        GRID_BAR(); ENTER();
        norm_phase(F, nullptr, nullptr, false, WSP(float, WS_X), karg(A_GMIX) + l * 1024, WSP(const float, modo), 1, WSP(bf16, WS_XN));
        GRID_BAR(); ENTER();
#ifndef NO_G3
        { pg8::Gemm g{WSP(bf16, WS_XN), WSP(const bf16, wlo + WO_IN), MROWS, DIN, DM}; typedef pg8::FixedOrder<130, 36, 10> Ord; Ord S; S.init(F.G, opaque_bid());
          pg8::EpiWin E{WSP(unsigned char, 0), OUTP(0), l, attn_body::C2};
          pg8::gemm_phase<pg8::EpiWin, Ord, true, true>(F.lds + RING_OFF, g, S, E); }
#endif
        GRID_BAR(); ENTER();
        { gu32* qs = F.ctl + CW_Q + 64 * (l * 16);
          for (;;) { const int it = wg_pull(F, qs); if (it >= 288) break;
#ifndef NO_H
              if (it < 160) {
                  const HgPtrs P{WSP(const float, WS_LOGF), WSP(const bf16, WS_QQ), WSP(const bf16, WS_KK), WSP(const bf16, WS_VV), WSP(const bf16, WS_HGS), karg(A_GHG) + l * 128, WSP(bf16, WS_OH), WSP(bf16, WS_DD)};
                  const bool smp = it >= 32; const int u = smp ? it - 32 : it, sq = u >> 3, h = u & 7;
                  const size_t so = smp ? OS_S + ((size_t)((l * 16 + sq) * 8 + h)) * 16384 : OS_P + ((size_t)((l * 4 + sq) * 8 + h)) * 16384;
#ifdef DUP_HSEQ
                  if (!smp) hg_sequence(F, P, (size_t)sq * 8192, h, 128, 64, nullptr, OUTP(0) + so);
#endif
                  hg_sequence(F, P, smp ? (size_t)MP + (size_t)sq * 32 : (size_t)sq * 8192, h, smp ? 1 : 128, smp ? 32 : 64, smp ? karg(A_ST) + ((size_t)((l * 16 + sq) * 8 + h)) * 16384 : nullptr, OUTP(0) + so);
              } else
#endif
              {
#ifndef NO_SAMP
                  const int u = it - 160; const float lam = lam_of(karg(A_LAM), l, F.lane), osc = 1.f - lam_init_of(l);
                  attn_sample_unit(F, karg(A_CK), karg(A_CV), l, u >> 3, u & 7, WSP(const bf16, WS_Q), WSP(const bf16, WS_K), WSP(const bf16, WS_V), lam, osc, karg(A_GSUB) + l * 128, WSP(bf16, WS_OATT));
#endif
              } }
#ifndef NO_ATT
          { const attn_body::bf16* Qb = WSP(const attn_body::bf16, WS_Q); const attn_body::bf16* Kb = WSP(const attn_body::bf16, WS_K); const attn_body::bf16* Vb = WSP(const attn_body::bf16, WS_V); attn_body::bf16* O1 = WSP(attn_body::bf16, WS_O1);
            const int x0 = (int)(xb_xcc_id() & 7u);
            for (int dx = 0; dx < 8; ++dx) { const int head = (x0 + dx) & 7; gu32* qa = F.ctl + CW_Q + 64 * (l * 16 + 1 + head);
                for (;;) { const int it = wg_pull(F, qa); if (it >= 512) break;
                    const int b = it >> 7, r = it & 127, qb = 31 - (r >> 2), mp = (r >> 1) & 1, vh = r & 1;
                    attn_body::attn_unit<8>(b, head * 2 + mp, head * 2 + vh, qb, Qb, Kb, Vb, O1 + (size_t)mp * ((WS_O2 - WS_O1) / 2), (char*)lds + RING_OFF); } } }
#endif
        }
        GRID_BAR(); ENTER();
        { const float lam = lam_of(karg(A_LAM), l, F.lane), osc = 1.f - lam_init_of(l);
          attn_combine_phase(F, WSP(const bf16, WS_O1), WSP(const bf16, WS_O2), karg(A_GSUB) + l * 128, lam, osc, WSP(bf16, WS_OATT)); }
        GRID_BAR(); ENTER();
#ifndef NO_G4
        { pg8::Gemm g{WSP(bf16, WS_OATT), WSP(const bf16, wlo + WO_BA), MROWS, DM, DM}; typedef pg8::FixedOrder<130, 4, 10> Ord; Ord S; S.init(F.G, opaque_bid());
          pg8::EpiGateT E{WSP(float, WS_LOGF), WSP(const bf16, WS_SZA)};
          pg8::gemm_phase<pg8::EpiGateT, Ord, true, true>(F.lds + RING_OFF, g, S, E); }
#endif
        GRID_BAR(); ENTER();
#ifndef NO_G5
        { pg8::Gemm g{WSP(bf16, WS_OH), WSP(const bf16, wlo + WO_BH), MROWS, DM, DM}; typedef pg8::FixedOrder<130, 4, 10> Ord; Ord S; S.init(F.G, opaque_bid());
          pg8::EpiGateM E{WSP(const float, WS_LOGF), WSP(const bf16, WS_SZH), WSP(bf16, WS_MRG)};
          pg8::gemm_phase<pg8::EpiGateM, Ord, true, true>(F.lds + RING_OFF, g, S, E); }
#endif
        GRID_BAR(); ENTER();
#ifndef NO_G6
        { pg8::Gemm g{WSP(bf16, WS_MRG), WSP(const bf16, wlo + WO_OUT), MROWS, DM, DM}; typedef pg8::FixedOrder<130, 4, 10> Ord; Ord S; S.init(F.G, opaque_bid());
          pg8::EpiResid E{WSP(float, WS_X), WSP(const float, modo) + 5 * 1024, 1.0f};
          pg8::gemm_phase<pg8::EpiResid, Ord, true, true>(F.lds + RING_OFF, g, S, E); }
#endif
        GRID_BAR(); ENTER();
        norm_phase(F, nullptr, nullptr, false, WSP(float, WS_X), karg(A_GFFN2) + l * 1024, WSP(const float, modo), 2, WSP(bf16, WS_XN));
        GRID_BAR(); ENTER();
#ifndef NO_G7
        { pg8::Gemm g{WSP(bf16, WS_XN), WSP(const bf16, wlo + WO_GU2), MROWS, 2 * DFF, DM}; typedef pg8::FixedOrder<130, 22, 10> Ord; Ord S; S.init(F.G, opaque_bid());
          pg8::EpiSwiglu E{WSP(bf16, WS_BIG)};
          pg8::gemm_phase<pg8::EpiSwiglu, Ord, true, true>(F.lds + RING_OFF, g, S, E); }
#endif
        GRID_BAR(); ENTER();
#ifndef NO_G8
        { pg8::Gemm g{WSP(bf16, WS_BIG), WSP(const bf16, wlo + WO_D2), MROWS, DM, DFF}; typedef pg8::FixedOrder<130, 4, 10> Ord; Ord S; S.init(F.G, opaque_bid());
          pg8::EpiResid E{WSP(float, WS_X), WSP(const float, modo) + 8 * 1024, 0.5f};
          pg8::gemm_phase<pg8::EpiResid, Ord, true, true>(F.lds + RING_OFF, g, S, E); }
#endif
        GRID_BAR(); ENTER();
    }
    final_norm_phase(F, WSP(const float, WS_X), karg(A_GFIN), OUTP(0));
#undef GRID_BAR
#undef ENTER
#undef WSP
#undef OUTP
}

extern "C" void kernel_launch(void* const* d_in, const int* in_sizes, int n_in, void* d_out, int out_size, void* d_ws, size_t ws_size, hipStream_t stream) {
    static int grid = 0;
    if (grid == 0) {
        if (n_in != 25 || (size_t)out_size != OUT_TOTAL || ws_size < WS_END) { fprintf(stderr, "kernel_launch: unexpected sizes: n_in %d out %d ws %zu (need %zu)\n", n_in, out_size, ws_size, (size_t)WS_END); grid = -1; return; }
        int dev = 0, cus = 0, per_cu = 0;
        if (hipGetDevice(&dev) != hipSuccess || hipDeviceGetAttribute(&cus, hipDeviceAttributeMultiprocessorCount, dev) != hipSuccess) { grid = -1; return; }
        if (hipFuncSetAttribute((const void*)mk_fwd, hipFuncAttributeMaxDynamicSharedMemorySize, LDS_BYTES) != hipSuccess) { fprintf(stderr, "kernel_launch: hipFuncSetAttribute failed\n"); grid = -1; return; }
        if (hipOccupancyMaxActiveBlocksPerMultiprocessor(&per_cu, (const void*)mk_fwd, NWAVES * 64, LDS_BYTES) != hipSuccess || per_cu < 1) { fprintf(stderr, "kernel_launch: occupancy query reports %d\n", per_cu); }
        (void)hipGetLastError();
        grid = cus;
    }
    if (grid < 0) return;
    if (hipMemsetAsync((char*)d_ws + WS_CTL, 0, CTL_ZERO_BYTES, stream) != hipSuccess) return;
    Args a{};
    for (int i = 0; i < 25; ++i) a.in[i] = (const float*)d_in[i];
    a.out = (float*)d_out; a.ws = (unsigned char*)d_ws;
    hipLaunchKernelGGL(mk_fwd, dim3(grid), dim3(NWAVES * 64), LDS_BYTES, stream, a);
    (void)in_sizes;
}
```

```cpp
#include <hip/hip_runtime.h>
#include <hip/hip_bf16.h>
#include <cstdio>
#include <cstdint>
#include <cmath>
__device__ __forceinline__ int opaque_tid() { int t = (int)threadIdx.x; asm volatile("" : "+v"(t)); return t; }
__device__ __forceinline__ int opaque_bid() { int b = (int)blockIdx.x; asm volatile("" : "+s"(b)); return b; }
namespace pg8 {
#define PG8_LAS __attribute__((address_space(3)))
typedef unsigned short bf16_t;
typedef short bf16x8 __attribute__((ext_vector_type(8)));
typedef float f32x4 __attribute__((ext_vector_type(4)));
typedef unsigned u32x4 __attribute__((ext_vector_type(4)));
constexpr int BM = 256, BK = 64, HALF = 128, HTB = HALF * BK * 2  , STAGE_BYTES = 8 * HTB, NXCD = 8, WGM = 8;

__host__ __device__ __forceinline__ int lds_byte(int r, int c) { const int st = (r >> 4) * 2 + (c >> 5), rr = r & 15, cc = c & 31, ob = rr * 64 + cc * 2; return st * 1024 + (ob ^ (((ob >> 9) & 1) << 5)); }
__host__ __device__ __forceinline__ void stage_rc(int b, int& R, int& C) { const int st = b / 1024, sb = b % 1024, swz = sb ^ (((sb >> 9) & 1) << 5); R = (st >> 1) * 16 + swz / 64; C = (st & 1) * 32 + (swz % 64) / 2; }
__host__ __device__ __forceinline__ int perm32(int rho) { const int n = rho >> 4, i = rho & 15; return 8 * (i >> 2) + 4 * n + (i & 3); }

struct Unit { int pm, pn; };
struct Gemm { const bf16_t* A; const bf16_t* Bt; int M, N, K; };

struct StaticOrder {
    int nM, nN, nwg, G, c;
    __host__ __device__ void init(int M, int N, int G_, int c_) { nM = M / BM; nN = N / BM; nwg = nM * nN; G = G_; c = c_; }
    __host__ __device__ bool next(int i, Unit& u) const {
        const long L = (long)i * G + c; if (L >= nwg) return false;
        int wgid = (int)L; { const int q = nwg / NXCD, r = nwg % NXCD, xcd = wgid % NXCD, off = wgid / NXCD; wgid = (xcd < r ? xcd * (q + 1) : r * (q + 1) + (xcd - r) * q) + off; }
        const int nig = WGM * nN, gid = wgid / nig, fm = gid * WGM, gsz = (nM - fm) < WGM ? (nM - fm) : WGM;
        u.pm = fm + ((wgid % nig) % gsz); u.pn = (wgid % nig) / gsz; return true;
    }
    __device__ __forceinline__ void a_ready(const Unit&) const {}
    __device__ __forceinline__ void done(const Unit&) const {}
};

__device__ __forceinline__ unsigned cvt_pk_bf16(float lo, float hi) { unsigned r; asm volatile("v_cvt_pk_bf16_f32 %0, %1, %2" : "=v"(r) : "v"(lo), "v"(hi)); return r; }
__device__ __forceinline__ float bf_lo(unsigned w) { return __builtin_bit_cast(float, w << 16); }
__device__ __forceinline__ float bf_hi(unsigned w) { return __builtin_bit_cast(float, w & 0xffff0000u); }
__device__ __forceinline__ float sigmoid_f(float x) { return __builtin_amdgcn_rcpf(1.f + __expf(-x)); }
__device__ __forceinline__ float silu_f(float x) { return x * sigmoid_f(x); }
__device__ __forceinline__ void store8bf(bf16_t* p, f32x4 a, f32x4 b) { u32x4 w; w.x = cvt_pk_bf16(a[0], a[1]); w.y = cvt_pk_bf16(a[2], a[3]); w.z = cvt_pk_bf16(b[0], b[1]); w.w = cvt_pk_bf16(b[2], b[3]); *(u32x4*)p = w; }
__device__ __forceinline__ int row_seq(int row) { return row < 32768 ? (row >> 13) : 4 + ((row - 32768) >> 5); }

struct EpiSwiglu {
    static constexpr bool PERM = true, AFTER_DRAIN = false;
    bf16_t* O;
    __device__ __forceinline__ void operator()(const f32x4 (&acc)[2][2][4][2], const Unit& u, int wr, int wc, int fr, int fq) const {
        const int row0 = u.pm * BM + wr * 64 + fr, col0 = u.pn * HALF + wc * 32 + 8 * fq;
#pragma unroll
        for (int ai = 0; ai < 2; ++ai)
#pragma unroll
            for (int m = 0; m < 4; ++m) {
                f32x4 g0 = acc[ai][0][m][0], g1 = acc[ai][0][m][1]; const f32x4 u0 = acc[ai][1][m][0], u1 = acc[ai][1][m][1];
#pragma unroll
                for (int i = 0; i < 4; ++i) { g0[i] = silu_f(g0[i]) * u0[i]; g1[i] = silu_f(g1[i]) * u1[i]; }
                store8bf(O + (size_t)(row0 + ai * HALF + m * 16) * 2816 + col0, g0, g1); asm volatile("" ::: "memory");
            }
    }
};

struct EpiResid {
    static constexpr bool PERM = true, AFTER_DRAIN = false;
    float* X; const float* gate; float coef;
    __device__ __forceinline__ void operator()(const f32x4 (&acc)[2][2][4][2], const Unit& u, int wr, int wc, int fr, int fq) const {
#pragma unroll
        for (int ai = 0; ai < 2; ++ai)
#pragma unroll
            for (int m = 0; m < 4; ++m) {
                const int row = u.pm * BM + ai * HALF + wr * 64 + m * 16 + fr; const float* gp = gate + (size_t)row_seq(row) * 9216;
#pragma unroll
                for (int bj = 0; bj < 2; ++bj) { const int col = u.pn * BM + bj * HALF + wc * 32 + 8 * fq;
#pragma unroll
                    for (int n = 0; n < 2; ++n) { const f32x4 g = *(const f32x4*)(gp + col + 4 * n); f32x4* xp = (f32x4*)(X + (size_t)row * 1024 + col + 4 * n); const f32x4 xv = *xp; *xp = xv + (g * coef) * acc[ai][bj][m][n]; } asm volatile("" ::: "memory"); }
            }
    }
};

struct EpiWin {
    static constexpr bool PERM = true, AFTER_DRAIN = false;
    unsigned char* ws; float* out; int l; float qscale;
    static constexpr size_t MiB_ = 1u << 20;
    static constexpr size_t O_Q = 435 * MiB_, O_K = 500 * MiB_, O_V = 565 * MiB_, O_QQ = 630 * MiB_, O_KK = 695 * MiB_, O_VV = 760 * MiB_, O_HGS = 825 * MiB_, O_SZA = 890 * MiB_, O_SZH = 955 * MiB_, O_LOGF = 1020 * MiB_, O_LB = 4 * MiB_;
    static constexpr size_t OK_P_ = 34078720, OV_P_ = 168296448, OK_S_ = 304611328, OV_S_ = 306708480;
    __device__ __forceinline__ void operator()(const f32x4 (&acc)[2][2][4][2], const Unit& u, int wr, int wc, int fr, int fq) const {
        const int seg = u.pn >> 2, cb = (u.pn & 3) * BM + wc * 32 + 8 * fq, row0 = u.pm * BM + wr * 64 + fr;
        const size_t boff = seg == 0 ? O_Q : seg == 1 ? O_K : seg == 2 ? O_V : seg == 3 ? O_QQ : seg == 4 ? O_KK : seg == 5 ? O_VV : seg == 6 ? O_HGS : seg == 7 ? O_SZA : O_SZH;
        bf16_t* const O = (bf16_t*)(ws + boff) + (size_t)row0 * 1024 + cb;
        float* F32 = nullptr;
        if (seg == 1 || seg == 2) { const size_t ob = (u.pm < 128) ? (seg == 1 ? OK_P_ : OV_P_) + (size_t)l * 32768 * 1024 + (size_t)(u.pm * BM) * 1024 : (seg == 1 ? OK_S_ : OV_S_) + (size_t)l * 512 * 1024 + (size_t)((u.pm - 128) * BM) * 1024;
            F32 = out + ob + (size_t)(wr * 64 + fr) * 1024 + cb; }
        else if (seg == 4) F32 = (float*)(ws + O_LOGF) + (size_t)row0 * 1024 + cb;
        const float* const lb = (const float*)(ws + O_LB) + l * 1024 + cb;
        const float sc = seg == 0 ? qscale : 1.f;
#pragma unroll
        for (int bj = 0; bj < 2; ++bj) {
            f32x4 l0 = {0.f, 0.f, 0.f, 0.f}, l1 = l0; if (seg == 4) { l0 = *(const f32x4*)(lb + bj * HALF); l1 = *(const f32x4*)(lb + bj * HALF + 4); }
#pragma unroll
            for (int ai = 0; ai < 2; ++ai)
#pragma unroll
                for (int m = 0; m < 4; ++m) { const size_t off = (size_t)(ai * HALF + m * 16) * 1024 + bj * HALF;
                    f32x4 a = acc[ai][bj][m][0], b = acc[ai][bj][m][1];
                    if (seg == 4) { f32x4 fa, fb;
#pragma unroll
                        for (int i = 0; i < 4; ++i) {
                            { const float x = a[i], lbv = l0[i], e = __expf(-__builtin_fabsf(x)), r = __builtin_amdgcn_rcpf(1.f + e), er = e * r, sig = x >= 0.f ? r : er, om = x >= 0.f ? er : r;
                              fa[i] = __logf(__builtin_fmaxf(lbv + (1.f - lbv) * sig, 1e-30f)); a[i] = (1.f - lbv) * om; }
                            { const float x = b[i], lbv = l1[i], e = __expf(-__builtin_fabsf(x)), r = __builtin_amdgcn_rcpf(1.f + e), er = e * r, sig = x >= 0.f ? r : er, om = x >= 0.f ? er : r;
                              fb[i] = __logf(__builtin_fmaxf(lbv + (1.f - lbv) * sig, 1e-30f)); b[i] = (1.f - lbv) * om; } }
                        *(f32x4*)(F32 + off) = fa; *(f32x4*)(F32 + off + 4) = fb;
                    } else if (seg == 3 || seg == 6) {
#pragma unroll
                        for (int i = 0; i < 4; ++i) { a[i] = silu_f(a[i]); b[i] = silu_f(b[i]); }
                    } else if (seg >= 7) {
#pragma unroll
                        for (int i = 0; i < 4; ++i) { a[i] = sigmoid_f(a[i]); b[i] = sigmoid_f(b[i]); }
                    } else {
                        if (seg == 1 || seg == 2) { *(f32x4*)(F32 + off) = a; *(f32x4*)(F32 + off + 4) = b; }
                        a = a * sc; b = b * sc;
                    }
                    store8bf(O + off, a, b); asm volatile("" ::: "memory"); }
        }
    }
};

struct EpiGateT {
    static constexpr bool PERM = true, AFTER_DRAIN = false;
    float* T; const bf16_t* G;
    __device__ __forceinline__ void operator()(const f32x4 (&acc)[2][2][4][2], const Unit& u, int wr, int wc, int fr, int fq) const {
        const int row0 = u.pm * BM + wr * 64 + fr, cb = u.pn * BM + wc * 32 + 8 * fq;
#pragma unroll
        for (int ai = 0; ai < 2; ++ai)
#pragma unroll
            for (int m = 0; m < 4; ++m)
#pragma unroll
                for (int bj = 0; bj < 2; ++bj) { const size_t off = (size_t)(row0 + ai * HALF + m * 16) * 1024 + cb + bj * HALF; const u32x4 g = *(const u32x4*)(G + off);
                    const f32x4 g0 = {bf_lo(g.x), bf_hi(g.x), bf_lo(g.y), bf_hi(g.y)}, g1 = {bf_lo(g.z), bf_hi(g.z), bf_lo(g.w), bf_hi(g.w)};
                    *(f32x4*)(T + off) = g0 * acc[ai][bj][m][0]; *(f32x4*)(T + off + 4) = g1 * acc[ai][bj][m][1]; asm volatile("" ::: "memory"); }
    }
};
struct EpiGateM {
    static constexpr bool PERM = true, AFTER_DRAIN = false;
    const float* T; const bf16_t* G; bf16_t* O;
    __device__ __forceinline__ void operator()(const f32x4 (&acc)[2][2][4][2], const Unit& u, int wr, int wc, int fr, int fq) const {
        const int row0 = u.pm * BM + wr * 64 + fr, cb = u.pn * BM + wc * 32 + 8 * fq;
#pragma unroll
        for (int ai = 0; ai < 2; ++ai)
#pragma unroll
            for (int m = 0; m < 4; ++m)
#pragma unroll
                for (int bj = 0; bj < 2; ++bj) { const size_t off = (size_t)(row0 + ai * HALF + m * 16) * 1024 + cb + bj * HALF; const u32x4 g = *(const u32x4*)(G + off);
                    const f32x4 g0 = {bf_lo(g.x), bf_hi(g.x), bf_lo(g.y), bf_hi(g.y)}, g1 = {bf_lo(g.z), bf_hi(g.z), bf_lo(g.w), bf_hi(g.w)};
                    const f32x4 t0 = *(const f32x4*)(T + off), t1 = *(const f32x4*)(T + off + 4);
                    store8bf(O + off, t0 + g0 * acc[ai][bj][m][0], t1 + g1 * acc[ai][bj][m][1]); asm volatile("" ::: "memory"); }
    }
};

template <int NM, int NN, int GM> struct FixedOrder {
    static_assert(NM % GM == 0, "GM divides NM");
    int G, c;
    __device__ __forceinline__ void init(int G_, int c_) { G = G_; c = c_; }
    __device__ __forceinline__ bool next(int i, Unit& u) const {
        constexpr int nwg = NM * NN, q = nwg / NXCD, r = nwg % NXCD, nig = GM * NN;
        const int L = i * G + c; if (L >= nwg) return false;
        const int xcd = L % NXCD, off = L / NXCD; const int wgid = (xcd < r ? xcd * (q + 1) : r * (q + 1) + (xcd - r) * q) + off;
        const int gid = wgid / nig, w = wgid % nig; u.pm = gid * GM + (w % GM); u.pn = w / GM; return true;
    }
    __device__ __forceinline__ void a_ready(const Unit&) const {}
    __device__ __forceinline__ void done(const Unit&) const {}
};

template <int NN> struct TeamOrder {
    int T, r;
    __device__ __forceinline__ void init(int T_, int r_) { T = T_; r = r_; }
    __device__ __forceinline__ bool next(int i, Unit& u) const { const int L = i * T + r; if (L >= 2 * NN) return false; u.pm = 128 + L / NN; u.pn = L % NN; return true; }
    __device__ __forceinline__ void a_ready(const Unit&) const {}
    __device__ __forceinline__ void done(const Unit&) const {}
};
template <class Epi, class Sched, bool ALIGN_EPI = false, bool SP2 = false>
__device__ __forceinline__ void gemm_phase(PG8_LAS unsigned char* lds, const Gemm g, const Sched& S, const Epi& E) {
    const int tid = opaque_tid(), wid = __builtin_amdgcn_readfirstlane(tid >> 6), lane = tid & 63, wr = wid >> 2, wc = wid & 3, fr = lane & 15, fq = lane >> 4;
    const int K = g.K, nt = K / BK;
    unsigned voffA[2], voffB[2];
#pragma unroll
    for (int i = 0; i < 2; ++i) { int R, C; stage_rc(tid * 16 + i * 8192, R, C); const int Rb = Epi::PERM ? ((R & ~31) + perm32(R & 31)) : R;
        voffA[i] = (unsigned)(R * K + C) * 2u; voffB[i] = (unsigned)(Rb * K + C) * 2u; }
    const size_t kstep = (size_t)(BK * 2);
    const size_t hstep = (size_t)HALF * K * 2;
    const size_t tstep = 2 * hstep;
    const unsigned ldsw = (unsigned)wid * 1024u;
    const int aoff = lds_byte(wr * 64 + fr, fq * 8), boff = lds_byte(wc * 32 + fr, fq * 8);
#define PG8_SA(b, h) (((b) * 2 + (h)) * HTB)
#define PG8_SB(b, h) ((4 + (b) * 2 + (h)) * HTB)
#define PG8_STAGE(bufoff, gbase, voff) do { _Pragma("unroll") for (int _i = 0; _i < 2; ++_i) \
        __builtin_amdgcn_global_load_lds((const unsigned*)((const char*)(gbase) + (voff)[_i]), (PG8_LAS unsigned*)(lds + (bufoff) + ldsw + _i * 8192), 16, 0, 0); } while (0)
#define PG8_LDA(dst, b, h) do { _Pragma("unroll") for (int m = 0; m < 4; ++m) _Pragma("unroll") for (int k = 0; k < 2; ++k) dst[m][k] = *(const PG8_LAS bf16x8*)(lds + PG8_SA(b, h) + aoff + m * 2048 + k * 1024); } while (0)
#define PG8_LDB(dst, b, h) do { _Pragma("unroll") for (int n = 0; n < 2; ++n) _Pragma("unroll") for (int k = 0; k < 2; ++k) dst[n][k] = *(const PG8_LAS bf16x8*)(lds + PG8_SB(b, h) + boff + n * 2048 + k * 1024); } while (0)
#define PG8_MMA(ai, bj, At, Bt) do { __builtin_amdgcn_s_setprio(1); _Pragma("unroll") for (int m = 0; m < 4; ++m) _Pragma("unroll") for (int n = 0; n < 2; ++n) _Pragma("unroll") for (int k = 0; k < 2; ++k) \
        acc[ai][bj][m][n] = __builtin_amdgcn_mfma_f32_16x16x32_bf16(Bt[n][k], At[m][k], acc[ai][bj][m][n], 0, 0, 0); __builtin_amdgcn_s_setprio(0); } while (0)
#define PG8_WAIT_V(n) asm volatile("s_waitcnt vmcnt(" #n ")" ::: "memory")
#define PG8_WAIT_L(n) asm volatile("s_waitcnt lgkmcnt(" #n ")" ::: "memory")
#define PG8_BAR __builtin_amdgcn_s_barrier()
#define PG8_SCHED __builtin_amdgcn_sched_barrier(0)
    Unit cur, nxt; int ui = 0;
    if (!S.next(0, cur)) return;
    f32x4 acc[2][2][4][2];
#pragma unroll
    for (int a = 0; a < 2; ++a)
#pragma unroll
        for (int b = 0; b < 2; ++b)
#pragma unroll
            for (int m = 0; m < 4; ++m)
#pragma unroll
                for (int n = 0; n < 2; ++n) acc[a][b][m][n] = (f32x4){0.f, 0.f, 0.f, 0.f};
    bf16x8 At[4][2], B0[2][2], B1[2][2];
    const char* cA = (const char*)g.A + (size_t)cur.pm * tstep; const char* cB = (const char*)g.Bt + (size_t)cur.pn * tstep;
    S.a_ready(cur);
    if constexpr (SP2) {
        PG8_STAGE(PG8_SB(0, 0), cB, voffB); PG8_STAGE(PG8_SB(0, 1), cB + hstep, voffB); PG8_STAGE(PG8_SA(0, 0), cA, voffA); PG8_STAGE(PG8_SA(0, 1), cA + hstep, voffA);
        if (wr == 1) PG8_BAR;
        PG8_WAIT_V(2); PG8_BAR;
        PG8_STAGE(PG8_SB(1, 0), cB + kstep, voffB); PG8_STAGE(PG8_SA(1, 0), cA + kstep, voffA); PG8_STAGE(PG8_SB(1, 1), cB + hstep + kstep, voffB);
        PG8_WAIT_V(6); PG8_BAR;
    } else {
        PG8_STAGE(PG8_SB(0, 0), cB, voffB); PG8_STAGE(PG8_SA(0, 0), cA, voffA); PG8_STAGE(PG8_SB(0, 1), cB + hstep, voffB); PG8_STAGE(PG8_SA(0, 1), cA + hstep, voffA);
        if (wr == 1) PG8_BAR;
        PG8_WAIT_V(4); PG8_BAR;
        PG8_STAGE(PG8_SB(1, 0), cB + kstep, voffB); PG8_STAGE(PG8_SA(1, 0), cA + kstep, voffA); PG8_STAGE(PG8_SB(1, 1), cB + hstep + kstep, voffB);
        PG8_WAIT_V(6); PG8_BAR;
    }
    for (;;) {
        const bool has_next = S.next(ui + 1, nxt);
        const char* nA = has_next ? (const char*)g.A + (size_t)nxt.pm * tstep : cA; const char* nB = has_next ? (const char*)g.Bt + (size_t)nxt.pn * tstep : cB;
        for (int t = 0; t < nt; t += 2) {
            const bool last = (t == nt - 2);
            const char* a1 = cA + (size_t)(t + 1) * kstep;
            const char* a2 = last ? nA : cA + (size_t)(t + 2) * kstep; const char* b2 = last ? nB : cB + (size_t)(t + 2) * kstep;
            const char* a3 = a2 + kstep; const char* b3 = b2 + kstep;
            if (last && has_next) S.a_ready(nxt);
            if constexpr (SP2) {
            PG8_LDB(B0, 0, 0); PG8_LDB(B1, 0, 1); PG8_SCHED; PG8_LDA(At, 0, 0); PG8_STAGE(PG8_SA(1, 1), a1 + hstep, voffA);
            PG8_WAIT_V(8); PG8_WAIT_L(0); PG8_BAR; PG8_MMA(0, 0, At, B0); PG8_MMA(0, 1, At, B1); PG8_BAR; PG8_SCHED;
            PG8_LDA(At, 0, 1); PG8_STAGE(PG8_SB(0, 0), b2, voffB); PG8_STAGE(PG8_SB(0, 1), b2 + hstep, voffB); PG8_STAGE(PG8_SA(0, 0), a2, voffA);
            PG8_WAIT_V(8); PG8_WAIT_L(0); PG8_BAR; PG8_MMA(1, 0, At, B0); PG8_MMA(1, 1, At, B1); PG8_BAR; PG8_SCHED;
            PG8_LDB(B0, 1, 0); PG8_LDB(B1, 1, 1); PG8_SCHED; PG8_LDA(At, 1, 0); PG8_STAGE(PG8_SA(0, 1), a2 + hstep, voffA);
            PG8_WAIT_V(8); PG8_WAIT_L(0); PG8_BAR; PG8_MMA(0, 0, At, B0); PG8_MMA(0, 1, At, B1); PG8_BAR; PG8_SCHED;
            PG8_LDA(At, 1, 1); PG8_STAGE(PG8_SB(1, 0), b3, voffB); PG8_STAGE(PG8_SB(1, 1), b3 + hstep, voffB); PG8_STAGE(PG8_SA(1, 0), a3, voffA);
            PG8_WAIT_V(8); PG8_WAIT_L(0); PG8_BAR; PG8_MMA(1, 0, At, B0); PG8_MMA(1, 1, At, B1); PG8_BAR; PG8_SCHED;
            } else {
            PG8_LDB(B0, 0, 0); PG8_SCHED; PG8_LDA(At, 0, 0); PG8_STAGE(PG8_SA(1, 1), a1 + hstep, voffA);
            PG8_WAIT_L(8); PG8_BAR; PG8_WAIT_L(0); PG8_MMA(0, 0, At, B0); PG8_BAR; PG8_SCHED;
            PG8_LDB(B1, 0, 1); PG8_STAGE(PG8_SB(0, 0), b2, voffB);
            PG8_BAR; PG8_WAIT_L(0); PG8_MMA(0, 1, At, B1); PG8_BAR;
            PG8_LDA(At, 0, 1); PG8_STAGE(PG8_SA(0, 0), a2, voffA);
            PG8_BAR; PG8_WAIT_L(0); PG8_MMA(1, 0, At, B0); PG8_BAR; PG8_SCHED;
            PG8_STAGE(PG8_SB(0, 1), b2 + hstep, voffB);
            PG8_WAIT_V(6); PG8_BAR; PG8_MMA(1, 1, At, B1); PG8_BAR;
            PG8_LDB(B0, 1, 0); PG8_SCHED; PG8_LDA(At, 1, 0); PG8_STAGE(PG8_SA(0, 1), a2 + hstep, voffA);
            PG8_WAIT_L(8); PG8_BAR; PG8_WAIT_L(0); PG8_MMA(0, 0, At, B0); PG8_BAR; PG8_SCHED;
            PG8_LDB(B1, 1, 1); PG8_STAGE(PG8_SB(1, 0), b3, voffB);
            PG8_BAR; PG8_WAIT_L(0); PG8_MMA(0, 1, At, B1); PG8_BAR;
            PG8_LDA(At, 1, 1); PG8_STAGE(PG8_SA(1, 0), a3, voffA);
            PG8_BAR; PG8_WAIT_L(0); PG8_MMA(1, 0, At, B0); PG8_BAR; PG8_SCHED;
            PG8_STAGE(PG8_SB(1, 1), b3 + hstep, voffB);
            PG8_WAIT_V(6); PG8_BAR; PG8_MMA(1, 1, At, B1); PG8_BAR;
            }
        }
        if constexpr (ALIGN_EPI) { if (wr == 0) PG8_BAR; }
        if constexpr (!Epi::AFTER_DRAIN) { E(acc, cur, wr, wc, fr, fq); S.done(cur); }
        if (!has_next) break;
#pragma unroll
        for (int a = 0; a < 2; ++a)
#pragma unroll
            for (int b = 0; b < 2; ++b)
#pragma unroll
                for (int m = 0; m < 4; ++m)
#pragma unroll
                    for (int n = 0; n < 2; ++n) acc[a][b][m][n] = (f32x4){0.f, 0.f, 0.f, 0.f};
        cur = nxt; cA = nA; cB = nB; ++ui;
        if constexpr (ALIGN_EPI) { if (wr == 1) PG8_BAR; }
    }
    PG8_WAIT_V(0);
    if constexpr (!ALIGN_EPI) { if (wr == 0) PG8_BAR; }
    PG8_BAR;
    if constexpr (Epi::AFTER_DRAIN) { E.fused(acc, cur, wr, wc, fr, fq, lds, wid, lane); S.done(cur); }
#undef PG8_SA
#undef PG8_SB
#undef PG8_STAGE
#undef PG8_LDA
#undef PG8_LDB
#undef PG8_MMA
#undef PG8_WAIT_V
#undef PG8_WAIT_L
#undef PG8_BAR
#undef PG8_SCHED
}
}
namespace attn_body {
using bf16=__hip_bfloat16;
using bf16x8=__attribute__((ext_vector_type(8)))short;
using s16x4=__attribute__((ext_vector_type(4)))short;
using f32x16=__attribute__((ext_vector_type(16)))float;
using u32x4=__attribute__((ext_vector_type(4)))unsigned;
constexpr int BATCH=4,NHEAD=16,SEQ=8192,D=64,DM=NHEAD*D;
constexpr int NW=8,QBLK=32,QB=QBLK*NW,KVBLK=64,NQB=SEQ/QB;
constexpr int ATTN_PITCH=DM, ATTN_UNIT_ROWS=QB;
__device__ __forceinline__ int crow(int r,int hi){return (r&3)+8*(r>>2)+4*hi;}
#define SBAR() __builtin_amdgcn_sched_barrier(0)
__device__ __forceinline__ void cmask(f32x16&p0,f32x16&p1,int jb,int qrel,int hi){
  const float NEG=-INFINITY; (void)hi;
  if(jb>(qrel>>6)){
  #pragma unroll
  for(int r=0;r<16;++r){p0[r]=NEG;p1[r]=NEG;} }
}

constexpr int NSLOT=3, SLOTB=8192;
constexpr int LDS_K=0, LDS_V=NSLOT*SLOTB, LDS_WS=2*NSLOT*SLOTB, LDS_OST=LDS_WS+NW*64*4, LDS_BYTES=LDS_OST+NW*4096;
constexpr float C2=0.125f*1.4426950408889634f;
__device__ __forceinline__ void glds16(const void*gsrc,unsigned lds_dst){unsigned keep;
  asm volatile("s_mov_b32 %0, m0\n\ts_mov_b32 m0, %2\n\ts_nop 0\n\tglobal_load_lds_dwordx4 %1, off\n\ts_mov_b32 m0, %0":"=&s"(keep):"v"(gsrc),"s"(lds_dst):"memory");}
__device__ __forceinline__ float max3f(float a,float b,float c){float r;asm("v_max3_f32 %0, %1, %2, %3":"=v"(r):"v"(a),"v"(b),"v"(c));return r;}
__device__ __forceinline__ float max2f(float a,float b){float r;asm("v_max_f32_e32 %0, %1, %2":"=v"(r):"v"(a),"v"(b));return r;}
__device__ __forceinline__ float fadd_s(float a,float b){float r;asm("v_add_f32_e32 %0, %1, %2":"=v"(r):"v"(a),"v"(b));return r;}
__device__ __forceinline__ float fsub_s(float a,float b){float r;asm("v_sub_f32_e32 %0, %1, %2":"=v"(r):"v"(a),"v"(b));return r;}
typedef float f32x2_t __attribute__((ext_vector_type(2))); typedef __bf16 bf16x2_t __attribute__((ext_vector_type(2)));
__device__ __forceinline__ unsigned cvtpk_s(float lo,float hi){f32x2_t v={lo,hi};bf16x2_t b=__builtin_convertvector(v,bf16x2_t);return __builtin_bit_cast(unsigned,b);}
#define WAIT_BAR(N) asm volatile("s_waitcnt vmcnt(" #N ") lgkmcnt(0)\n\ts_barrier":::"memory")

__device__ __forceinline__ void qkt(f32x16&p0,f32x16&p1,const char*Kslot,const bf16x8*qr,const f32x16&negm,int r32,int hi){
  const char*kb=Kslot+hi*1024+r32*16;
  #pragma unroll
  for(int d0=0;d0<4;++d0){
    const bf16x8 b0=*reinterpret_cast<const bf16x8*>(kb+d0*2048);
    const bf16x8 b1=*reinterpret_cast<const bf16x8*>(kb+d0*2048+512);
    if(d0==0){p0=__builtin_amdgcn_mfma_f32_32x32x16_bf16(b0,qr[0],negm,0,0,0);p1=__builtin_amdgcn_mfma_f32_32x32x16_bf16(b1,qr[0],negm,0,0,0);}
    else{p0=__builtin_amdgcn_mfma_f32_32x32x16_bf16(b0,qr[d0],p0,0,0,0);p1=__builtin_amdgcn_mfma_f32_32x32x16_bf16(b1,qr[d0],p1,0,0,0);}}
}
typedef __attribute__((address_space(3))) const char* lds_cptr;
typedef short v4i16_t __attribute__((ext_vector_type(4)));
__device__ __forceinline__ void kload8(bf16x8*kf,lds_cptr kp){
  kf[0]=*(const __attribute__((address_space(3))) bf16x8*)(kp);      kf[1]=*(const __attribute__((address_space(3))) bf16x8*)(kp+512);
  kf[2]=*(const __attribute__((address_space(3))) bf16x8*)(kp+2048); kf[3]=*(const __attribute__((address_space(3))) bf16x8*)(kp+2560);
  kf[4]=*(const __attribute__((address_space(3))) bf16x8*)(kp+4096); kf[5]=*(const __attribute__((address_space(3))) bf16x8*)(kp+4608);
  kf[6]=*(const __attribute__((address_space(3))) bf16x8*)(kp+6144); kf[7]=*(const __attribute__((address_space(3))) bf16x8*)(kp+6656);
}
__device__ __forceinline__ void kload2(bf16x8*kf,lds_cptr kp,int j){ kf[2*j]=*(const __attribute__((address_space(3))) bf16x8*)(kp+j*2048); kf[2*j+1]=*(const __attribute__((address_space(3))) bf16x8*)(kp+j*2048+512); }
__device__ __forceinline__ s16x4 vtr(lds_cptr p){ return __builtin_bit_cast(s16x4,__builtin_amdgcn_ds_read_tr16_b64_v4i16((__attribute__((address_space(3))) v4i16_t*)p)); }
__device__ __forceinline__ float rowmax(const f32x16&p0,const f32x16&p1){
  float a=max3f(p0[0],p0[1],p1[0]),b=max3f(p0[2],p0[3],p1[1]);a=max3f(a,p1[2],p1[3]);
  #pragma unroll
  for(int r=4;r<16;r+=4){a=max3f(a,p0[r],p0[r+1]);b=max3f(b,p0[r+2],p0[r+3]);a=max3f(a,p1[r],p1[r+1]);b=max3f(b,p1[r+2],p1[r+3]);}
  const float m=max2f(a,b);
  auto rr=__builtin_amdgcn_permlane32_swap(__float_as_uint(m),__float_as_uint(m),false,false);
  return max2f(__uint_as_float(rr[0]),__uint_as_float(rr[1]));
}
__device__ __forceinline__ void pv(f32x16*o,int vb,bf16x8 pa0,bf16x8 pa1,bf16x8 pa2,bf16x8 pa3){
  #pragma unroll
  for(int d0=0;d0<2;++d0){s16x4 lo[4],hi[4];
    #pragma unroll
    for(int ks=0;ks<4;++ks){
      asm volatile("ds_read_b64_tr_b16 %0,%1 offset:%c2":"=&v"(lo[ks]):"v"(vb),"i"(d0*4096+ks*1024):"memory");
      asm volatile("ds_read_b64_tr_b16 %0,%1 offset:%c2":"=&v"(hi[ks]):"v"(vb),"i"(d0*4096+ks*1024+512):"memory");}
    asm volatile("s_waitcnt lgkmcnt(0)":::"memory");SBAR();
    #define PK(k) (bf16x8){lo[k][0],lo[k][1],lo[k][2],lo[k][3],hi[k][0],hi[k][1],hi[k][2],hi[k][3]}
    o[d0]=__builtin_amdgcn_mfma_f32_32x32x16_bf16(pa0,PK(0),o[d0],0,0,0);
    o[d0]=__builtin_amdgcn_mfma_f32_32x32x16_bf16(pa1,PK(1),o[d0],0,0,0);
    o[d0]=__builtin_amdgcn_mfma_f32_32x32x16_bf16(pa2,PK(2),o[d0],0,0,0);
    o[d0]=__builtin_amdgcn_mfma_f32_32x32x16_bf16(pa3,PK(3),o[d0],0,0,0);
    #undef PK
  }
}

#ifndef ATTN_STORE16
#define ATTN_STORE16(p,v) (*(u32x4*)(p)=(v))
#endif
template<int THRL> __device__ __forceinline__ void attn_unit(int b,int hq,int hv,int qb,const bf16*Q,const bf16*__restrict__ K,const bf16*__restrict__ V,bf16*O,char*shm){
  const int tid=opaque_tid(),lane=tid&63,r32=lane&31,hi=lane>>5; const int wid=__builtin_amdgcn_readfirstlane(tid>>6);
  const long rowbase=(long)b*SEQ; const int q0=qb*QB;
  const bf16*Qw=Q+(rowbase+q0+wid*QBLK)*DM+hq*D;
  const bf16*Kh=K+rowbase*DM+hq*D,*Vh=V+rowbase*DM+hv*D;
  const unsigned lds0=(unsigned)(uintptr_t)shm;
  float*wsf=(float*)(shm+LDS_WS)+wid*64;
  const bf16*ksrc=Kh+(long)lane*DM+wid*8;
  const bf16*vsrc=Vh+(long)(16*(wid&3)+(lane>>2))*DM+(wid>>2)*32+(lane&3)*8;
  const unsigned kdst=lds0+LDS_K+wid*1024, vdst=lds0+LDS_V+wid*1024;
  #define DMA_K(t,slot) glds16(ksrc+(long)(t)*KVBLK*DM,(unsigned)__builtin_amdgcn_readfirstlane(kdst+(slot)))
  #define DMA_V(t,slot) glds16(vsrc+(long)(t)*KVBLK*DM,(unsigned)__builtin_amdgcn_readfirstlane(vdst+(slot)))
  const int vb0=(int)(lds0+LDS_V)+((lane>>4)&1)*32+(lane&3)*8+(4*hi+((lane&15)>>2))*64;
  const char*Kbase=shm+LDS_K; bf16x8 kf[8];
  const lds_cptr shm3=(lds_cptr)shm; const lds_cptr kp0=shm3+LDS_K+hi*1024+r32*16; const lds_cptr vp0=shm3+LDS_V+((lane>>4)&1)*32+(lane&3)*8+(4*hi+((lane&15)>>2))*64;
  const int NT=(q0+QB)/KVBLK;
  DMA_K(0,0);DMA_V(0,0);DMA_K(1,SLOTB);
  bf16x8 qr[4];
  #pragma unroll
  for(int d0=0;d0<4;++d0)qr[d0]=*reinterpret_cast<const bf16x8*>(&Qw[(long)r32*DM+d0*16+hi*8]);
  float mhat=0.f,l_reg=0.f;f32x16 o[2];o[0]=f32x16{};o[1]=f32x16{};f32x16 negm=f32x16{};asm volatile("":"+v"(negm));
  const int qrel=wid*QBLK+r32;
  #define CMASK(P0,P1,t) do{int jb_=(t)-(NT-4); if(jb_>=0)cmask(P0,P1,jb_,qrel,hi);}while(0)
  bool resc=false;
  #define START(P0,P1) do{ const float rm=rowmax(P0,P1); resc=false; \
    { const float dl=rm; mhat=fadd_s(mhat,dl); \
      _Pragma("unroll") for(int r=0;r<16;++r){P0[r]=fsub_s(P0[r],dl);P1[r]=fsub_s(P1[r],dl);} \
      _Pragma("unroll") for(int r=0;r<16;++r)negm[r]=-mhat; asm volatile("":"+v"(negm)); } \
    _Pragma("unroll") for(int r=0;r<16;++r)P0[r]=__builtin_amdgcn_exp2f(P0[r]); }while(0)
  #define RESC() do{ if(resc){ asm volatile("s_waitcnt lgkmcnt(0)":::"memory"); \
      _Pragma("unroll") for(int d_=0;d_<2;++d_) _Pragma("unroll") for(int r=0;r<16;++r)o[d_][r]*=wsf[crow(r,hi)]; } }while(0)
  f32x16 pA0,pA1,pB0,pB1;
  int sl_prev=0,sl_cur=0,sl_next=SLOTB;
  #define ROT() do{sl_prev=sl_cur;sl_cur=sl_next;sl_next=(sl_next==(NSLOT-1)*SLOTB)?0:sl_next+SLOTB;}while(0)
  DMA_K(2,2*SLOTB);
  WAIT_BAR(3);
  qkt(pA0,pA1,Kbase,qr,negm,r32,hi);asm volatile("s_nop 15\n\ts_nop 7":"+v"(pA0),"+v"(pA1));CMASK(pA0,pA1,0);
  START(pA0,pA1);
  _Pragma("unroll") for(int r=0;r<16;++r)pA1[r]=__builtin_amdgcn_exp2f(pA1[r]);
  WAIT_BAR(0);
  DMA_K(3,0);DMA_V(1,SLOTB);
  ROT();
  kload8(kf,kp0+sl_cur);
  WAIT_BAR(2);
  s16x4 vlo[8],vhi[8]; u32x4 pw0,pw1,pw2,pw3;
  #define PKW(P,B) cvtpk_s(P[B],P[B+1])
  #define PAF(k) __builtin_bit_cast(bf16x8,pw##k)
  #define VFR(i) (bf16x8){vlo[i][0],vlo[i][1],vlo[i][2],vlo[i][3],vhi[i][0],vhi[i][1],vhi[i][2],vhi[i][3]}
  #define PIN(x) asm volatile("":"+v"(x))
  #define MX3(a,b,c) __builtin_fmaxf(__builtin_fmaxf((a),(b)),(c))
  #define GAPA(MF,A0,A1,A2,A3,W0,W1,PW) do{ MF; sacc+=A0; sacc+=A1; sacc+=A2; sacc+=A3; PIN(sacc); W0; W1; PIN(PW); SBAR(); }while(0)
  #define EX(v) __builtin_amdgcn_exp2f(v)
  #define GAPB(MF,X,B) do{ MF; X[B]=EX(X[B]); X[B+1]=EX(X[B+1]); X[B+2]=EX(X[B+2]); X[B+3]=EX(X[B+3]); PIN(X); SBAR(); }while(0)
  #define VRD(i) do{ vlo[i]=vtr(vp_+(((i)>>2)*4096+((i)&3)*1024)); vhi[i]=vtr(vp_+(((i)>>2)*4096+((i)&3)*1024+512)); }while(0)
  #define KRD(G,j) do{ if(G){ kload2(kf,kp0+sl_next,j); SBAR(); } }while(0)
  #define STEP(C0,C1,P0,P1,t,GK,GV,GL) do{ SBAR(); \
    const lds_cptr vp_=vp0+sl_prev; \
    VRD(0); SBAR(); float sacc=(P0[0]+P0[1]); \
    GAPA(C0=__builtin_amdgcn_mfma_f32_32x32x16_bf16(kf[0],qr[0],negm,0,0,0), P0[2],P0[3],P0[4],P0[5],     pw0[0]=PKW(P0,0), pw0[1]=PKW(P0,2), pw0); \
    VRD(4); SBAR(); GAPA(C1=__builtin_amdgcn_mfma_f32_32x32x16_bf16(kf[1],qr[0],negm,0,0,0), P0[6],P0[7],P0[8],P0[9],     pw0[2]=PKW(P0,4), pw0[3]=PKW(P0,6), pw0); \
    VRD(1); SBAR(); GAPA(C0=__builtin_amdgcn_mfma_f32_32x32x16_bf16(kf[2],qr[1],C0,0,0,0),   P0[10],P0[11],P0[12],P0[13], pw1[0]=PKW(P0,8), pw1[1]=PKW(P0,10), pw1); \
    VRD(5); SBAR(); GAPA(C1=__builtin_amdgcn_mfma_f32_32x32x16_bf16(kf[3],qr[1],C1,0,0,0),   P0[14],P0[15],P1[0],P1[1],   pw1[2]=PKW(P0,12),pw1[3]=PKW(P0,14), pw1); \
    VRD(2); SBAR(); GAPA(C0=__builtin_amdgcn_mfma_f32_32x32x16_bf16(kf[4],qr[2],C0,0,0,0),   P1[2],P1[3],P1[4],P1[5],     pw2[0]=PKW(P1,0), pw2[1]=PKW(P1,2), pw2); \
    VRD(6); SBAR(); GAPA(C1=__builtin_amdgcn_mfma_f32_32x32x16_bf16(kf[5],qr[2],C1,0,0,0),   P1[6],P1[7],P1[8],P1[9],     pw2[2]=PKW(P1,4), pw2[3]=PKW(P1,6), pw2); \
    VRD(3); SBAR(); GAPA(C0=__builtin_amdgcn_mfma_f32_32x32x16_bf16(kf[6],qr[3],C0,0,0,0),   P1[10],P1[11],P1[12],P1[13], pw3[0]=PKW(P1,8), pw3[1]=PKW(P1,10), pw3); \
    VRD(7); SBAR(); GAPA(C1=__builtin_amdgcn_mfma_f32_32x32x16_bf16(kf[7],qr[3],C1,0,0,0),   P1[14],P1[15],0.f,0.f,       pw3[2]=PKW(P1,12),pw3[3]=PKW(P1,14), pw3); \
    l_reg+=sacc; \
    if(GK){DMA_K((t)+3,sl_cur);} if(GV){DMA_V((t)+1,sl_next);} \
    CMASK(C0,C1,t); \
    { float a=MX3(C0[0],C0[1],C1[0]),b=MX3(C0[2],C0[3],C1[1]); a=MX3(a,C1[2],C1[3]); \
      _Pragma("unroll") for(int r=4;r<16;r+=4){a=MX3(a,C0[r],C0[r+1]);b=MX3(b,C0[r+2],C0[r+3]);a=MX3(a,C1[r],C1[r+1]);b=MX3(b,C1[r+2],C1[r+3]);} \
      float rm=__builtin_fmaxf(a,b); { auto rr=__builtin_amdgcn_permlane32_swap(__float_as_uint(rm),__float_as_uint(rm),false,false); rm=__builtin_fmaxf(__uint_as_float(rr[0]),__uint_as_float(rr[1])); } \
      resc=false; \
      if(__builtin_expect(__any(rm>(float)THRL),0)){ const float dl=__builtin_fmaxf(rm,0.f); mhat+=dl; \
        _Pragma("unroll") for(int r=0;r<16;++r){C0[r]-=dl;C1[r]-=dl;} \
        _Pragma("unroll") for(int r=0;r<16;++r)negm[r]=-mhat; asm volatile("":"+v"(negm)); \
        const float f=__builtin_amdgcn_exp2f(-dl); l_reg*=f; if(hi==0)wsf[r32]=f; resc=true; } } \
    SBAR(); \
    GAPB(o[0]=__builtin_amdgcn_mfma_f32_32x32x16_bf16(PAF(0),VFR(0),o[0],0,0,0), C0,0); \
    GAPB(o[1]=__builtin_amdgcn_mfma_f32_32x32x16_bf16(PAF(0),VFR(4),o[1],0,0,0), C0,4); \
    KRD(GL,0); GAPB(o[0]=__builtin_amdgcn_mfma_f32_32x32x16_bf16(PAF(1),VFR(1),o[0],0,0,0), C0,8); \
    KRD(GL,1); GAPB(o[1]=__builtin_amdgcn_mfma_f32_32x32x16_bf16(PAF(1),VFR(5),o[1],0,0,0), C0,12); \
    KRD(GL,2); GAPB(o[0]=__builtin_amdgcn_mfma_f32_32x32x16_bf16(PAF(2),VFR(2),o[0],0,0,0), C1,0); \
    KRD(GL,3); GAPB(o[1]=__builtin_amdgcn_mfma_f32_32x32x16_bf16(PAF(2),VFR(6),o[1],0,0,0), C1,4); \
    GAPB(o[0]=__builtin_amdgcn_mfma_f32_32x32x16_bf16(PAF(3),VFR(3),o[0],0,0,0), C1,8); \
    GAPB(o[1]=__builtin_amdgcn_mfma_f32_32x32x16_bf16(PAF(3),VFR(7),o[1],0,0,0), C1,12); \
    }while(0)
  int t=1;
  #undef CMASK
  #define CMASK(P0,P1,t) do{}while(0)
  for(;t+5<NT;t+=2){
    STEP(pB0,pB1,pA0,pA1,t,true,true,true);     WAIT_BAR(2); RESC(); ROT();
    STEP(pA0,pA1,pB0,pB1,t+1,true,true,true);   WAIT_BAR(2); RESC(); ROT();
  }
  #undef CMASK
  #define CMASK(P0,P1,t) do{int jb_=(t)-(NT-4); if(jb_>=0)cmask(P0,P1,jb_,qrel,hi);}while(0)
  #define ENDW(tt) do{ if((tt)+3<NT){WAIT_BAR(2);} else if((tt)+2<NT){WAIT_BAR(1);} else {WAIT_BAR(0);} }while(0)
  for(;t+1<NT;t+=2){
    STEP(pB0,pB1,pA0,pA1,t,(t+3<NT),(t+1<NT),(t+1<NT));       ENDW(t);   RESC(); ROT();
    STEP(pA0,pA1,pB0,pB1,t+1,(t+4<NT),(t+2<NT),(t+2<NT));     ENDW(t+1); RESC(); ROT();
  }
  STEP(pB0,pB1,pA0,pA1,NT-1,false,false,false); RESC();
  { float sacc=pB0[0]+pB0[1]; _Pragma("unroll") for(int r=2;r<16;++r)sacc+=pB0[r]; _Pragma("unroll") for(int r=0;r<16;++r)sacc+=pB1[r]; l_reg+=sacc;
    pw0=(u32x4){PKW(pB0,0),PKW(pB0,2),PKW(pB0,4),PKW(pB0,6)};pw1=(u32x4){PKW(pB0,8),PKW(pB0,10),PKW(pB0,12),PKW(pB0,14)};pw2=(u32x4){PKW(pB1,0),PKW(pB1,2),PKW(pB1,4),PKW(pB1,6)};pw3=(u32x4){PKW(pB1,8),PKW(pB1,10),PKW(pB1,12),PKW(pB1,14)};
    SBAR(); pv(o,vb0+sl_cur,PAF(0),PAF(1),PAF(2),PAF(3)); }
  #undef PKW
  #undef PAF
  #undef VFR
  #undef PIN
  #undef MX3
  #undef GAPA
  #undef GAPB
  #undef EX
  #undef VRD
  #undef KRD
  #undef STEP
  #undef ENDW
  {auto rr=__builtin_amdgcn_permlane32_swap(__float_as_uint(l_reg),__float_as_uint(l_reg),false,false);l_reg=__uint_as_float(rr[0])+__uint_as_float(rr[1]);}
  if(hi==0)wsf[32+r32]=l_reg;asm volatile("s_waitcnt lgkmcnt(0)":::"memory");
  float rli[16];
  #pragma unroll
  for(int r=0;r<16;++r)rli[r]=__builtin_amdgcn_rcpf(wsf[32+crow(r,hi)]);
  bf16*Ow=O+(rowbase+q0+wid*QBLK)*DM+hv*D;
  { bf16*stg=(bf16*)(shm+LDS_OST)+wid*2048;
    #pragma unroll
    for(int r=0;r<16;++r){const int orow=crow(r,hi);
      #pragma unroll
      for(int d0=0;d0<2;++d0)stg[orow*64+d0*32+r32]=__float2bfloat16(o[d0][r]*rli[r]);}
    asm volatile("s_waitcnt lgkmcnt(0)":::"memory");
    #pragma unroll
    for(int i=0;i<4;++i){const int row=i*8+(lane>>3),ch=lane&7; const u32x4 v=*(const u32x4*)(stg+row*64+ch*8); ATTN_STORE16(Ow+(long)row*DM+ch*8,v);} }
  asm volatile("s_waitcnt lgkmcnt(0)\n\ts_barrier":::"memory");
  #undef DMA_K
  #undef DMA_V
  #undef CMASK
  #undef START
  #undef RESC
  #undef ROT
}
constexpr int ATTN_LDS_BYTES=LDS_BYTES;
#undef SBAR
#undef WAIT_BAR
}
#define GAS __attribute__((address_space(1)))
#define LAS __attribute__((address_space(3)))
typedef unsigned short bf16;
typedef unsigned v4u __attribute__((ext_vector_type(4)));
typedef float f32x4 __attribute__((ext_vector_type(4)));
typedef short bf16x8 __attribute__((ext_vector_type(8)));
typedef GAS unsigned gu32;
typedef GAS unsigned long long gu64;
#define RLX_AGENT __ATOMIC_RELAXED, __HIP_MEMORY_SCOPE_AGENT
#define LDS_WAIT() asm volatile("s_waitcnt lgkmcnt(0)" ::: "memory")
#define VM_WAIT() asm volatile("s_waitcnt vmcnt(0)" ::: "memory")
__device__ __forceinline__ unsigned long long rt() { return __builtin_amdgcn_s_memrealtime(); }
__device__ __forceinline__ unsigned f2bf(float f) { unsigned u = __builtin_bit_cast(unsigned, f); return (u + 0x7fffu + ((u >> 16) & 1u)) >> 16; }
__device__ __forceinline__ unsigned pk2(float lo, float hi) { return f2bf(lo) | (f2bf(hi) << 16); }

#define XB_TMO      128
#define XB_XCNT(j)  (256  + 64 * (j))
#define XB_XSUB(j)  (1280 + 64 * (j))
#define XB_XGEN(j)  (2304 + 64 * (j))
#define XB_TOP      3328
#define XB_TOPGEN   3392
#define XCD_BAR_WORDS 3456
#define XB_SPIN_CAP (1u << 18)

__device__ __forceinline__ unsigned xb_ld(unsigned* p)              { return __hip_atomic_load(p, __ATOMIC_RELAXED, __HIP_MEMORY_SCOPE_AGENT); }
__device__ __forceinline__ unsigned xb_add(unsigned* p, unsigned v) { return __hip_atomic_fetch_add(p, v, __ATOMIC_RELAXED, __HIP_MEMORY_SCOPE_AGENT); }
__device__ __forceinline__ unsigned xb_xcc_id() { return (unsigned)__builtin_amdgcn_s_getreg((3 << 11) | 20) & 0xFu; }
#define XB_SPIN(cond, bar) do { unsigned _sp = 0; while (cond) { __builtin_amdgcn_s_sleep(1); \
    if ((++_sp & 255u) == 0u) { if (xb_ld(&(bar)[XB_TMO])) break; if (_sp > XB_SPIN_CAP) { atomicAdd(&(bar)[XB_TMO], 1u); break; } } } } while (0)

struct XcdBarrier {
    unsigned* bar; unsigned x;
    volatile LAS unsigned* st;
};

__device__ __forceinline__ XcdBarrier xcd_barrier_post(unsigned* bar, volatile LAS unsigned* st) {
    XcdBarrier b; b.bar = bar; b.x = xb_xcc_id(); b.st = st;
    if (threadIdx.x == 0) (void)xb_add(&bar[XB_XCNT(b.x)], 1u);
    return b;
}
__device__ __forceinline__ void xcd_barrier_complete(unsigned* bar, unsigned x, unsigned& nloc, unsigned& nx) {
    const unsigned G = gridDim.x * gridDim.y * gridDim.z;
    unsigned sum, cnt, mine, sp = 0u;
    for (;;) {
        sum = 0u; cnt = 0u;
#pragma unroll
        for (unsigned j = 0; j < 16; ++j) { const unsigned c = xb_ld(&bar[XB_XCNT(j)]); sum += c; cnt += (c > 0u) ? 1u : 0u; }
        if (sum == G) break;
        __builtin_amdgcn_s_sleep(1);
        if ((++sp & 255u) == 0u) { if (xb_ld(&bar[XB_TMO])) break; if (sp > XB_SPIN_CAP) { atomicAdd(&bar[XB_TMO], 1u); break; } }
    }
    mine = xb_ld(&bar[XB_XCNT(x)]);
    nloc = mine > 0u ? mine : 1u; nx = cnt > 0u ? cnt : 1u;
}

__device__ __forceinline__ void xcd_barrier(const XcdBarrier& b) {
    asm volatile("s_waitcnt vmcnt(0)" ::: "memory");
    __syncthreads();
    if (threadIdx.x == 0) {
        unsigned* bar = b.bar;
        __builtin_amdgcn_s_waitcnt(0);
        unsigned nloc = b.st[0], nx = b.st[1];
        if (nloc == 0u) { xcd_barrier_complete(bar, b.x, nloc, nx); b.st[0] = nloc; b.st[1] = nx; }
        const unsigned old = xb_add(&bar[XB_XSUB(b.x)], 1u);
        const unsigned gen = old / nloc;
        if (old + 1u == (gen + 1u) * nloc) {
            __builtin_amdgcn_fence(__ATOMIC_RELEASE, "agent");
            asm volatile("s_waitcnt vmcnt(0)" ::: "memory");
            const unsigned og = xb_add(&bar[XB_TOP], 1u);
            const unsigned tg = og / nx;
            if (og + 1u == (tg + 1u) * nx) xb_add(&bar[XB_TOPGEN], 1u);
            else XB_SPIN(xb_ld(&bar[XB_TOPGEN]) == tg, bar);
            __builtin_amdgcn_fence(__ATOMIC_ACQUIRE, "agent");
            xb_add(&bar[XB_XGEN(b.x)], 1u);
            asm volatile("s_waitcnt vmcnt(0)" ::: "memory");
        } else {
            XB_SPIN(xb_ld(&bar[XB_XGEN(b.x)]) == gen, bar);
            __builtin_amdgcn_fence(__ATOMIC_ACQUIRE, "agent");
            asm volatile("s_waitcnt vmcnt(0)" ::: "memory");
        }
    }
    __syncthreads();
}
constexpr int NWAVES = 8;
constexpr int DM = 1024, MP = 32768, MS = 512, MROWS = MP + MS, NSEQ = 20, DEPTH = 4, DFF = 2816, DIN = 9216, PAST = 2048;
constexpr int NCHUNK_P = 512, NCHUNK = 528;
constexpr float EPS = 1e-6f;
constexpr size_t OY_P = 0, OY_S = 33554432, OK_P = 34078720, OV_P = 168296448, OS_P = 302514176, OK_S = 304611328, OV_S = 306708480, OS_S = 308805632, OUT_TOTAL = 317194240;

constexpr size_t MiB = 1u << 20;
constexpr size_t WS_CTL = 0, CTL_ZERO_BYTES = 1 * MiB;
constexpr size_t WS_MOD = 1 * MiB;
constexpr size_t WS_LB = 4 * MiB;
constexpr size_t WS_W = 8 * MiB, W_LAYER = 57 * MiB;
constexpr size_t WO_GU1 = 0, WO_D1 = 11 * MiB, WO_IN = 16 * MiB + MiB / 2, WO_BA = 34 * MiB + MiB / 2, WO_BH = 36 * MiB + MiB / 2, WO_OUT = 38 * MiB + MiB / 2, WO_GU2 = 40 * MiB + MiB / 2, WO_D2 = 51 * MiB + MiB / 2;
constexpr size_t WS_X = 240 * MiB;
constexpr size_t WS_XN = 370 * MiB;
constexpr size_t WS_Q = 435 * MiB, WS_K = 500 * MiB, WS_V = 565 * MiB;
constexpr size_t WS_QQ = 630 * MiB, WS_KK = 695 * MiB, WS_VV = 760 * MiB, WS_HGS = 825 * MiB, WS_SZA = 890 * MiB, WS_SZH = 955 * MiB;
constexpr size_t WS_LOGF = 1020 * MiB;
constexpr size_t WS_O1 = 1150 * MiB, WS_O2 = 1215 * MiB, WS_OATT = 1280 * MiB, WS_OH = 1345 * MiB, WS_MRG = 1410 * MiB;
constexpr size_t WS_BIG = 1475 * MiB;
constexpr size_t WS_SST = 1739 * MiB;
constexpr size_t WS_DD = 1871 * MiB;
constexpr size_t WS_END = 1874 * MiB;
constexpr int T_TEAM = 32;
constexpr int CW_BAR = 4096, CW_Q = 8192;
static_assert(pg8::EpiWin::O_Q == WS_Q && pg8::EpiWin::O_K == WS_K && pg8::EpiWin::O_V == WS_V && pg8::EpiWin::O_QQ == WS_QQ && pg8::EpiWin::O_KK == WS_KK && pg8::EpiWin::O_VV == WS_VV && pg8::EpiWin::O_HGS == WS_HGS && pg8::EpiWin::O_SZA == WS_SZA && pg8::EpiWin::O_SZH == WS_SZH && pg8::EpiWin::O_LOGF == WS_LOGF && pg8::EpiWin::O_LB == WS_LB && pg8::EpiWin::OK_P_ == OK_P && pg8::EpiWin::OV_P_ == OV_P && pg8::EpiWin::OK_S_ == OK_S && pg8::EpiWin::OV_S_ == OV_S, "EpiWin offsets");

constexpr int RING_OFF = 0, RING_BYTES = 139264;
constexpr int LDSCTL_OFF = RING_BYTES, MISC_OFF = LDSCTL_OFF + 320;
constexpr int LDS_BYTES = 147456;

struct Frame {
    LAS unsigned char* lds;
    volatile LAS unsigned* MISC;
    gu32* ctl;
    int tid, lane, wave;
    int vcu, G;
};
typedef float f32x16 __attribute__((ext_vector_type(16)));
typedef unsigned v2u __attribute__((ext_vector_type(2)));

__device__ __forceinline__ float wave_sum(float v) {
#pragma unroll
    for (int o = 1; o < 64; o <<= 1) v += __shfl_xor(v, o);
    return v;
}
__device__ __forceinline__ float bf2f(bf16 b) { return __builtin_bit_cast(float, (unsigned)b << 16); }
__device__ __forceinline__ unsigned cvtpk(float lo, float hi) { return pg8::cvt_pk_bf16(lo, hi); }
__device__ __forceinline__ bf16x8 pack8(f32x4 a, f32x4 b) { v4u w; w.x = cvtpk(a[0], a[1]); w.y = cvtpk(a[2], a[3]); w.z = cvtpk(b[0], b[1]); w.w = cvtpk(b[2], b[3]); return __builtin_bit_cast(bf16x8, w); }
__device__ __forceinline__ float lam_init_of(int l) { return 0.8f - 0.6f * __expf(-0.3f * (float)l); }

__device__ __forceinline__ void p0_transpose_item(const float* W, int K, int N, bf16* WT, bool gu, LAS float* scr, int item, int lane) {
    const int nblk = N / 32, kb = item / nblk, nb = item % nblk, k0 = 64 * kb, nd0 = 32 * nb;
    const int ns0 = gu ? (((nd0 >> 7) & 1) * 2816 + (nd0 >> 8) * 128 + (nd0 & 127)) : nd0;
#pragma unroll 8
    for (int i = 0; i < 32; ++i) { const int kk = 2 * i + (lane >> 5); scr[kk * 33 + (lane & 31)] = W[(size_t)(k0 + kk) * N + ns0 + (lane & 31)]; }
    LDS_WAIT(); asm volatile("" ::: "memory");
    const int c = lane & 7;
#pragma unroll
    for (int j = 0; j < 4; ++j) { const int n = (lane >> 3) + 8 * j; const LAS float* s = scr + (8 * c) * 33 + n;
        v4u o; o.x = pk2(s[0 * 33], s[1 * 33]); o.y = pk2(s[2 * 33], s[3 * 33]); o.z = pk2(s[4 * 33], s[5 * 33]); o.w = pk2(s[6 * 33], s[7 * 33]);
        *(GAS v4u*)(WT + (size_t)(nd0 + n) * K + k0 + 8 * c) = o; }
    LDS_WAIT(); asm volatile("" ::: "memory");
}
typedef const __attribute__((address_space(4))) char* kaptr_t;
__device__ __forceinline__ const float* karg(int i) { kaptr_t ka = (kaptr_t)__builtin_amdgcn_kernarg_segment_ptr(); asm volatile("" : "+s"(ka)); return *(const float* const __attribute__((address_space(4)))*)(ka + 8 * i); }
enum { A_XP = 0, A_XS, A_CK, A_CV, A_ST, A_CP, A_CS, A_WADA, A_BADA, A_GFFN1, A_WGU1, A_WD1, A_GMIX, A_WIN, A_LAM, A_GSUB, A_LBL, A_GHG, A_WBA, A_WBH, A_WOUT, A_GFFN2, A_WGU2, A_WD2, A_GFIN, A_OUT, A_WS };
__device__ __forceinline__ void p0_prologue(Frame& F, unsigned char* ws) {
    { LAS float* scr = (LAS float*)(F.lds + RING_OFF + F.wave * 16384);
      const int gw = F.vcu * NWAVES + F.wave, NGW = F.G * NWAVES;
      constexpr int I_GU = 16 * 176, I_D = 44 * 32, I_IN = 16 * 288, I_SQ = 16 * 32, I_LAYER = 2 * I_GU + 2 * I_D + I_IN + 3 * I_SQ;
      for (int it = gw; it < DEPTH * I_LAYER; it += NGW) {
          const int l = it / I_LAYER; int r = it % I_LAYER; unsigned char* wl = ws + WS_W + (size_t)l * W_LAYER;
          if (r < I_GU) { p0_transpose_item(karg(A_WGU1) + (size_t)l * 1024 * 5632, 1024, 5632, (bf16*)(wl + WO_GU1), true, scr, r, F.lane); continue; } r -= I_GU;
          if (r < I_D)  { p0_transpose_item(karg(A_WD1) + (size_t)l * 2816 * 1024, 2816, 1024, (bf16*)(wl + WO_D1), false, scr, r, F.lane); continue; } r -= I_D;
          if (r < I_IN) { p0_transpose_item(karg(A_WIN) + (size_t)l * 1024 * 9216, 1024, 9216, (bf16*)(wl + WO_IN), false, scr, r, F.lane); continue; } r -= I_IN;
          if (r < I_SQ) { p0_transpose_item(karg(A_WBA) + (size_t)l * 1024 * 1024, 1024, 1024, (bf16*)(wl + WO_BA), false, scr, r, F.lane); continue; } r -= I_SQ;
          if (r < I_SQ) { p0_transpose_item(karg(A_WBH) + (size_t)l * 1024 * 1024, 1024, 1024, (bf16*)(wl + WO_BH), false, scr, r, F.lane); continue; } r -= I_SQ;
          if (r < I_SQ) { p0_transpose_item(karg(A_WOUT) + (size_t)l * 1024 * 1024, 1024, 1024, (bf16*)(wl + WO_OUT), false, scr, r, F.lane); continue; } r -= I_SQ;
          if (r < I_GU) { p0_transpose_item(karg(A_WGU2) + (size_t)l * 1024 * 5632, 1024, 5632, (bf16*)(wl + WO_GU2), true, scr, r, F.lane); continue; } r -= I_GU;
          p0_transpose_item(karg(A_WD2) + (size_t)l * 2816 * 1024, 2816, 1024, (bf16*)(wl + WO_D2), false, scr, r, F.lane);
      } }
    __syncthreads();
    { const float* c_p = karg(A_CP); const float* c_s = karg(A_CS); const float* w_ada = karg(A_WADA); const float* b_ada = karg(A_BADA);
      LAS float* ca = (LAS float*)(F.lds);
      LAS float* red = (LAS float*)(F.lds + 81920);
      for (int i = F.tid; i < NSEQ * 1024; i += NWAVES * 64) { const int s = i >> 10, k = i & 1023; const float c = s < 4 ? c_p[s * 1024 + k] : c_s[(s - 4) * 1024 + k]; ca[i] = pg8::silu_f(c); }
      __syncthreads();
      float* MOD = (float*)(ws + WS_MOD);
      for (int it = F.vcu; it < DEPTH * 144; it += F.G) {
          const int l = it / 144, n = (it % 144) * 64 + F.lane; const float* wp = w_ada + ((size_t)l * 1024 + F.wave * 128) * 9216 + n;
          float acc[NSEQ];
#pragma unroll
          for (int s = 0; s < NSEQ; ++s) acc[s] = 0.f;
#pragma unroll 4
          for (int k = 0; k < 128; ++k) { const float w = wp[(size_t)k * 9216];
#pragma unroll
              for (int s = 0; s < NSEQ; ++s) acc[s] += ca[s * 1024 + F.wave * 128 + k] * w; }
#pragma unroll
          for (int s = 0; s < NSEQ; ++s) red[(F.wave * NSEQ + s) * 64 + F.lane] = acc[s];
          __syncthreads();
          for (int i = F.tid; i < NSEQ * 64; i += NWAVES * 64) { const int s = i >> 6, c = i & 63; float v = 0.f;
#pragma unroll
              for (int w = 0; w < 8; ++w) v += red[(w * NSEQ + s) * 64 + c];
              const int nn = (it % 144) * 64 + c; MOD[((size_t)l * NSEQ + s) * 9216 + nn] = v + b_ada[(size_t)l * 9216 + nn]; }
          __syncthreads();
      } }
    if (F.vcu == 0) { float* LB = (float*)(ws + WS_LB); const float* lb_logits = karg(A_LBL);
        for (int c = F.tid; c < 1024; c += NWAVES * 64) { float lg[4], mx = -INFINITY;
#pragma unroll
            for (int l = 0; l < 4; ++l) { lg[l] = lb_logits[l * 1024 + c]; mx = __builtin_fmaxf(mx, lg[l]); }
            float sum = 0.f;
#pragma unroll
            for (int l = 0; l < 4; ++l) { lg[l] = __expf(lg[l] - mx); sum += lg[l]; }
            const float inv = 1.f / sum; float cs = 0.f;
#pragma unroll
            for (int l = 0; l < 4; ++l) { cs += lg[l] * inv; LB[l * 1024 + c] = cs - lg[0] * inv; } } }
}

__device__ __forceinline__ void norm_phase(Frame& F, const float* x_p, const float* x_s, bool first, float* X, const float* g, const float* mod_l, int sub, bf16* XN, int row0, int row1, int gw, int NGW) {
    for (int row = row0 + gw; row < row1; row += NGW) {
        const float* src = first ? (row < MP ? x_p + (size_t)row * DM : x_s + (size_t)(row - MP) * DM) : X + (size_t)row * DM;
        const float* mp = mod_l + (size_t)pg8::row_seq(row) * 9216 + sub * 3 * 1024;
        const f32x4* xr = (const f32x4*)src + F.lane; f32x4 v[4]; float s2 = 0.f;
#pragma unroll
        for (int j = 0; j < 4; ++j) { v[j] = xr[64 * j]; s2 += (v[j].x * v[j].x + v[j].y * v[j].y) + (v[j].z * v[j].z + v[j].w * v[j].w); }
        const float rstd = __builtin_amdgcn_rsqf(wave_sum(s2) * (1.f / DM) + EPS);
        if (first) { f32x4* xo = (f32x4*)(X + (size_t)row * DM) + F.lane;
#pragma unroll
            for (int j = 0; j < 4; ++j) xo[64 * j] = v[j]; }
        v2u* o8 = (v2u*)(XN + (size_t)row * DM) + F.lane;
#pragma unroll
        for (int j = 0; j < 4; ++j) { const int c = 4 * F.lane + 256 * j; const f32x4 gg = *(const f32x4*)(g + c), sh = *(const f32x4*)(mp + c), sc = *(const f32x4*)(mp + 1024 + c);
            const f32x4 h = (v[j] * rstd) * gg * (sc + 1.f) + sh; v2u o; o.x = cvtpk(h.x, h.y); o.y = cvtpk(h.z, h.w); o8[64 * j] = o; }
    }
}
__device__ __forceinline__ void final_norm_phase(Frame& F, const float* X, const float* g, float* out) {
    const int gw = F.vcu * NWAVES + F.wave, NGW = F.G * NWAVES;
    for (int row = gw; row < MROWS; row += NGW) {
        const f32x4* xr = (const f32x4*)(X + (size_t)row * DM) + F.lane; f32x4 v[4]; float s2 = 0.f;
#pragma unroll
        for (int j = 0; j < 4; ++j) { v[j] = xr[64 * j]; s2 += (v[j].x * v[j].x + v[j].y * v[j].y) + (v[j].z * v[j].z + v[j].w * v[j].w); }
        const float rstd = __builtin_amdgcn_rsqf(wave_sum(s2) * (1.f / DM) + EPS);
        f32x4* o = (f32x4*)(out + (row < MP ? OY_P + (size_t)row * DM : OY_S + (size_t)(row - MP) * DM)) + F.lane;
#pragma unroll
        for (int j = 0; j < 4; ++j) { const f32x4 gg = *(const f32x4*)(g + 4 * F.lane + 256 * j); o[64 * j] = (v[j] * rstd) * gg; }
    }
}
__device__ __forceinline__ float lam_of(const float* att_lambda, int l, int lane) {
    const float* lp = att_lambda + (size_t)l * 256;
    const float a = wave_sum(lp[lane] * lp[64 + lane]), b = wave_sum(lp[128 + lane] * lp[192 + lane]);
    return __expf(a) - __expf(b) + lam_init_of(l);
}
__device__ __forceinline__ void attn_combine_phase(Frame& F, const bf16* O1, const bf16* O2, const float* gsub, float lam, float osc, bf16* OATT) {
    const int gw = F.vcu * NWAVES + F.wave, NGW = F.G * NWAVES; const int cl = (F.lane & 7) * 16;
    float gv[16];
#pragma unroll
    for (int i = 0; i < 16; ++i) gv[i] = gsub[cl + i] * osc;
    for (int row = gw; row < MP; row += NGW) {
        const size_t off = (size_t)row * DM + F.lane * 16; const v4u a0 = *(const v4u*)(O1 + off), a1 = *(const v4u*)(O1 + off + 8), b0 = *(const v4u*)(O2 + off), b1 = *(const v4u*)(O2 + off + 8);
        const unsigned aw[8] = {a0.x, a0.y, a0.z, a0.w, a1.x, a1.y, a1.z, a1.w}, bw[8] = {b0.x, b0.y, b0.z, b0.w, b1.x, b1.y, b1.z, b1.w};
        float o[16]; float ss = 0.f;
#pragma unroll
        for (int i = 0; i < 8; ++i) { o[2 * i] = pg8::bf_lo(aw[i]) - lam * pg8::bf_lo(bw[i]); o[2 * i + 1] = pg8::bf_hi(aw[i]) - lam * pg8::bf_hi(bw[i]); ss += o[2 * i] * o[2 * i] + o[2 * i + 1] * o[2 * i + 1]; }
        ss += __shfl_xor(ss, 1); ss += __shfl_xor(ss, 2); ss += __shfl_xor(ss, 4);
        const float rstd = __builtin_amdgcn_rsqf(ss * (1.f / 128.f) + EPS);
        v4u w0, w1;
        w0.x = cvtpk(o[0] * rstd * gv[0], o[1] * rstd * gv[1]); w0.y = cvtpk(o[2] * rstd * gv[2], o[3] * rstd * gv[3]); w0.z = cvtpk(o[4] * rstd * gv[4], o[5] * rstd * gv[5]); w0.w = cvtpk(o[6] * rstd * gv[6], o[7] * rstd * gv[7]);
        w1.x = cvtpk(o[8] * rstd * gv[8], o[9] * rstd * gv[9]); w1.y = cvtpk(o[10] * rstd * gv[10], o[11] * rstd * gv[11]); w1.z = cvtpk(o[12] * rstd * gv[12], o[13] * rstd * gv[13]); w1.w = cvtpk(o[14] * rstd * gv[14], o[15] * rstd * gv[15]);
        *(v4u*)(OATT + off) = w0; *(v4u*)(OATT + off + 8) = w1;
    }
}

__device__ __forceinline__ void attn_sample_unit(Frame& F, const float* cache_k, const float* cache_v, int l, int s, int head, const bf16* Qb, const bf16* Kb, const bf16* Vb, float lam, float osc, const float* gsub, bf16* OATT) {
    const int lane = F.lane, w = F.wave, q = lane & 31, hh = lane >> 5, vt = w & 3, kh = w >> 2;
    LAS float* SLOT = (LAS float*)(F.lds);
    LAS float* ML = (LAS float*)(F.lds + 16384);
    LAS float* SSQ = (LAS float*)(F.lds + 16384 + 512);
    const size_t qrow = (size_t)MP + (size_t)s * 32;
    const float* ck = cache_k + ((size_t)(l * 16 + s) * PAST) * 1024 + head * 128;
    const float* cv = cache_v + ((size_t)(l * 16 + s) * PAST) * 1024 + head * 128;
    f32x16 o1;
#pragma unroll
    for (int r = 0; r < 16; ++r) o1[r] = 0.f;
    for (int m = 0; m < 2; ++m) {
        bf16x8 qf[4];
#pragma unroll
        for (int ks = 0; ks < 4; ++ks) qf[ks] = *(const bf16x8*)(Qb + (qrow + q) * 1024 + head * 128 + m * 64 + ks * 16 + 8 * hh);
        float mrun = -INFINITY, lrun = 0.f; f32x16 ot;
#pragma unroll
        for (int r = 0; r < 16; ++r) ot[r] = 0.f;
        const int ntile = 32 + kh;
        for (int t = 0; t < ntile; ++t) {
            const bool nw = (t == 32); const int key0 = kh * 1024 + t * 32;
            bf16x8 kf[4];
            if (!nw) { const float* kp = ck + (size_t)(key0 + q) * 1024 + m * 64 + 8 * hh;
#pragma unroll
                for (int ks = 0; ks < 4; ++ks) { const f32x4 a = *(const f32x4*)(kp + ks * 16), b = *(const f32x4*)(kp + ks * 16 + 4); kf[ks] = pack8(a, b); } }
            else {
#pragma unroll
                for (int ks = 0; ks < 4; ++ks) kf[ks] = *(const bf16x8*)(Kb + (qrow + q) * 1024 + head * 128 + m * 64 + ks * 16 + 8 * hh); }
            float vf[2][8];
            { const float* vp = cv + (size_t)(key0 + 4 * hh) * 1024 + 32 * vt + q; const bf16* vpn = Vb + (qrow + 4 * hh) * 1024 + head * 128 + 32 * vt + q;
#pragma unroll
              for (int s2 = 0; s2 < 2; ++s2)
#pragma unroll
                  for (int j = 0; j < 8; ++j) { const int kr = 16 * s2 + 8 * (j >> 2) + (j & 3);
                      vf[s2][j] = nw ? bf2f(vpn[kr * 1024]) : vp[kr * 1024]; } }
            f32x16 st;
#pragma unroll
            for (int r = 0; r < 16; ++r) st[r] = 0.f;
#pragma unroll
            for (int ks = 0; ks < 4; ++ks) st = __builtin_amdgcn_mfma_f32_32x32x16_bf16(kf[ks], qf[ks], st, 0, 0, 0);
            float tm = st[0];
#pragma unroll
            for (int r = 1; r < 16; ++r) tm = __builtin_fmaxf(tm, st[r]);
            tm = __builtin_fmaxf(tm, __shfl_xor(tm, 32));
            const float mnew = __builtin_fmaxf(mrun, tm), alpha = __builtin_amdgcn_exp2f(mrun - mnew);
            float ls = 0.f;
#pragma unroll
            for (int r = 0; r < 16; ++r) { st[r] = __builtin_amdgcn_exp2f(st[r] - mnew); ls += st[r]; }
            ls += __shfl_xor(ls, 32);
            lrun = lrun * alpha + ls; mrun = mnew;
#pragma unroll
            for (int r = 0; r < 16; ++r) ot[r] *= alpha;
#pragma unroll
            for (int s2 = 0; s2 < 2; ++s2) { v4u pw; pw.x = cvtpk(st[8 * s2], st[8 * s2 + 1]); pw.y = cvtpk(st[8 * s2 + 2], st[8 * s2 + 3]); pw.z = cvtpk(st[8 * s2 + 4], st[8 * s2 + 5]); pw.w = cvtpk(st[8 * s2 + 6], st[8 * s2 + 7]);
                v4u aw; aw.x = cvtpk(vf[s2][0], vf[s2][1]); aw.y = cvtpk(vf[s2][2], vf[s2][3]); aw.z = cvtpk(vf[s2][4], vf[s2][5]); aw.w = cvtpk(vf[s2][6], vf[s2][7]);
                ot = __builtin_amdgcn_mfma_f32_32x32x16_bf16(__builtin_bit_cast(bf16x8, aw), __builtin_bit_cast(bf16x8, pw), ot, 0, 0, 0); }
        }
        if (vt == 0 && hh == 0) { ML[(kh * 32 + q) * 2] = mrun; ML[(kh * 32 + q) * 2 + 1] = lrun; }
        __syncthreads();
        const float m0 = ML[q * 2], l0 = ML[q * 2 + 1], m1 = ML[(32 + q) * 2], l1 = ML[(32 + q) * 2 + 1];
        const float Mx = __builtin_fmaxf(m0, m1), L = l0 * __builtin_amdgcn_exp2f(m0 - Mx) + l1 * __builtin_amdgcn_exp2f(m1 - Mx);
        { const float sc = __builtin_amdgcn_exp2f(mrun - Mx);
#pragma unroll
          for (int r = 0; r < 16; ++r) ot[r] *= sc; }
        if (kh == 1) {
#pragma unroll
            for (int r = 0; r < 16; ++r) SLOT[(vt * 16 + r) * 64 + lane] = ot[r]; }
        __syncthreads();
        if (kh == 0) { const float rl = 1.f / L;
#pragma unroll
            for (int r = 0; r < 16; ++r) ot[r] = (ot[r] + SLOT[(vt * 16 + r) * 64 + lane]) * rl;
            if (m == 0) {
#pragma unroll
                for (int r = 0; r < 16; ++r) o1[r] = ot[r];
            } else { float ss = 0.f;
#pragma unroll
                for (int r = 0; r < 16; ++r) { o1[r] = o1[r] - lam * ot[r]; ss += o1[r] * o1[r]; }
                ss += __shfl_xor(ss, 32);
                if (hh == 0) SSQ[vt * 32 + q] = ss; } }
        __syncthreads();
    }
    if (kh == 0) {
        const float ss = SSQ[q] + SSQ[32 + q] + SSQ[64 + q] + SSQ[96 + q];
        const float rstd = __builtin_amdgcn_rsqf(ss * (1.f / 128.f) + EPS) * osc;
#pragma unroll
        for (int r = 0; r < 16; ++r) { const int v = 32 * vt + (r & 3) + 8 * (r >> 2) + 4 * hh; OATT[(qrow + q) * 1024 + head * 128 + v] = (bf16)f2bf(o1[r] * rstd * gsub[v]); }
    }
    __syncthreads();
}

constexpr int HS = 72, HK = 136;
__device__ __forceinline__ f32x4 mfma16(bf16x8 a, bf16x8 b, f32x4 c) { return __builtin_amdgcn_mfma_f32_16x16x32_bf16(a, b, c, 0, 0, 0); }
__device__ __forceinline__ void st16bf(LAS bf16* p, const float (&v)[16]) {
    v4u a, b; a.x = cvtpk(v[0], v[1]); a.y = cvtpk(v[2], v[3]); a.z = cvtpk(v[4], v[5]); a.w = cvtpk(v[6], v[7]); b.x = cvtpk(v[8], v[9]); b.y = cvtpk(v[10], v[11]); b.z = cvtpk(v[12], v[13]); b.w = cvtpk(v[14], v[15]);
    *(LAS v4u*)p = a; *(LAS v4u*)(p + 8) = b;
}
__device__ __forceinline__ float bfu(unsigned b) { return __builtin_bit_cast(float, b << 16); }
struct HgPtrs { const float* LOGF; const bf16 *QQ, *KK, *VV, *HGS; const float* ghg; bf16* OH; bf16* dump; };
typedef float f32x2v __attribute__((ext_vector_type(2)));
__device__ __forceinline__ void hg_load(const HgPtrs& P, size_t ubase  , unsigned k0, int w, int nvalid, f32x2v (&lf)[8], unsigned (&qv)[8], unsigned (&kv)[8], unsigned (&vv)[8]) {
    if (w * 8 < nvalid) {
#pragma unroll
        for (int i = 0; i < 8; ++i) { const size_t o = ubase + (size_t)(w * 8 + i) * 1024;
            const float* lp = P.LOGF + o; const bf16* qp = P.QQ + o; const bf16* kp = P.KK + o; const bf16* vp = P.VV + o;
            lf[i] = *(const f32x2v*)(lp + k0); qv[i] = *(const unsigned*)(qp + k0); kv[i] = *(const unsigned*)(kp + k0); vv[i] = *(const unsigned*)(vp + k0); }
    } else {
#pragma unroll
        for (int i = 0; i < 8; ++i) { lf[i] = (f32x2v){0.f, 0.f}; qv[i] = 0u; kv[i] = 0u; vv[i] = 0u; }
    }
}
#define HG_BAR() asm volatile("s_waitcnt lgkmcnt(0)\n\ts_barrier" ::: "memory")
__device__ __forceinline__ void hg_sequence(Frame& F, const HgPtrs& P, size_t row0, int h, int nchunk, int nvalid, const float* s_in, float* s_out) {
    LAS float* seg = (LAS float*)(F.lds);
    LAS float* part = (LAS float*)(F.lds + 4096);
    LAS float* dvec = (LAS float*)(F.lds + 6144);
    LAS bf16* QH = (LAS bf16*)(F.lds + 8192);
    LAS bf16* QT = QH + 64 * HK;
    LAS bf16* KH = QT + 64 * HK;
    LAS bf16* VT = KH + 160 * HK;
    LAS bf16* KT = VT + 128 * HS;
    LAS bf16* AL = KT + 128 * HS;
    const int w = __builtin_amdgcn_readfirstlane(F.wave), sc = w >> 1, lr_ = F.lane & 15, lq_ = F.lane >> 4; const unsigned k0_ = 2u * (unsigned)F.lane;
    f32x4 S[8];
#pragma unroll
    for (int kb = 0; kb < 8; ++kb)
#pragma unroll
        for (int r = 0; r < 4; ++r) S[kb][r] = s_in ? s_in[(size_t)(16 * kb + 4 * lq_ + r) * 128 + 16 * w + lr_] : 0.f;
    const float gv = P.ghg[16 * w + lr_];
    f32x2v lf[8]; unsigned qv[8], kv[8], vv[8];
    hg_load(P, row0 * 1024 + h * 128, k0_, w, nvalid, lf, qv, kv, vv);
    for (int c = 0; c < nchunk; ++c) {
        int lr = lr_, lq = lq_; unsigned k0 = k0_; asm volatile("" : "+v"(lr), "+v"(lq), "+v"(k0));
        const size_t crow = row0 + (size_t)c * 64;
        f32x2v cs[8]; { f32x2v run = {0.f, 0.f};
#pragma unroll
            for (int i = 0; i < 8; ++i) { run = run + lf[i]; cs[i] = run; }
            *(LAS f32x2v*)(seg + w * 128 + k0) = run; }
        HG_BAR();
        f32x2v P2[4], mypre = {0.f, 0.f}, tot; { f32x2v p = {0.f, 0.f};
#pragma unroll
            for (int s = 0; s < 8; ++s) { if ((s & 1) == 0) P2[s >> 1] = p; mypre = (s == w) ? p : mypre; p = p + *(const LAS f32x2v*)(seg + s * 128 + k0); } tot = p; }
        f32x2v myref = P2[0], nref = P2[1];
#pragma unroll
        for (int s = 1; s < 4; ++s) { myref = (s == sc) ? P2[s] : myref; nref = (s == sc) ? (s == 3 ? tot : P2[s < 3 ? s + 1 : 3]) : nref; }
        const f32x2v dq = mypre - myref;
        f32x2v fq, fT, fK[4]; fq.x = __expf(myref.x); fq.y = __expf(myref.y); fT.x = __expf(tot.x - nref.x); fT.y = __expf(tot.y - nref.y);
#pragma unroll
        for (int ii = 1; ii < 4; ++ii) { fK[ii].x = __expf(__builtin_fminf(P2[ii].x - nref.x, 0.f)); fK[ii].y = __expf(__builtin_fminf(P2[ii].y - nref.y, 0.f)); }
        float t0[8], t1[8];
#pragma unroll
        for (int i = 0; i < 8; ++i) { const int r = w * 8 + i; const float q0 = bfu(qv[i] & 0xffffu), q1 = bfu(qv[i] >> 16), a0 = bfu(kv[i] & 0xffffu), a1 = bfu(kv[i] >> 16);
            const float E0 = dq.x + cs[i].x, E1 = dq.y + cs[i].y;
            const float e1x = __expf(E0), e1y = __expf(E1);
            const float e2x = __builtin_fminf(__builtin_amdgcn_rcpf(e1x), 5.5e34f), e2y = __builtin_fminf(__builtin_amdgcn_rcpf(e1y), 5.5e34f);
            const float e3x = __expf((nref.x - myref.x) - E0), e3y = __expf((nref.y - myref.y) - E1);
            *(LAS unsigned*)(QH + r * HK + k0) = cvtpk(q0 * e1x, q1 * e1y);
            *(LAS unsigned*)(QT + r * HK + k0) = cvtpk(q0 * e1x * fq.x, q1 * e1y * fq.y);
            const float b0 = a0 * e3x, b1 = a1 * e3y;
            { const int rb = (sc == 0) ? 0 : (sc == 1) ? 16 : (sc == 2) ? 48 : 96; *(LAS unsigned*)(KH + (rb + r) * HK + k0) = cvtpk(a0 * e2x, a1 * e2y); }
#pragma unroll
            for (int ii = 1; ii < 4; ++ii) if (ii > sc) { const int rb = (ii == 1) ? 16 : (ii == 2) ? 48 : 96; *(LAS unsigned*)(KH + (rb + r) * HK + k0) = cvtpk(b0 * fK[ii].x, b1 * fK[ii].y); }
            t0[i] = b0 * fT.x; t1[i] = b1 * fT.y; }
        { v4u u0, u1; u0.x = cvtpk(t0[0], t0[1]); u0.y = cvtpk(t0[2], t0[3]); u0.z = cvtpk(t0[4], t0[5]); u0.w = cvtpk(t0[6], t0[7]); u1.x = cvtpk(t1[0], t1[1]); u1.y = cvtpk(t1[2], t1[3]); u1.z = cvtpk(t1[4], t1[5]); u1.w = cvtpk(t1[6], t1[7]);
          *(LAS v4u*)(KT + k0 * HS + 8 * w) = u0; *(LAS v4u*)(KT + (k0 + 1) * HS + 8 * w) = u1; }
        { v4u u0, u1;
          u0.x = (vv[0] & 0xffffu) | (vv[1] << 16); u0.y = (vv[2] & 0xffffu) | (vv[3] << 16); u0.z = (vv[4] & 0xffffu) | (vv[5] << 16); u0.w = (vv[6] & 0xffffu) | (vv[7] << 16);
          u1.x = (vv[0] >> 16) | (vv[1] & 0xffff0000u); u1.y = (vv[2] >> 16) | (vv[3] & 0xffff0000u); u1.z = (vv[4] >> 16) | (vv[5] & 0xffff0000u); u1.w = (vv[6] >> 16) | (vv[7] & 0xffff0000u);
          *(LAS v4u*)(VT + k0 * HS + 8 * w) = u0; *(LAS v4u*)(VT + (k0 + 1) * HS + 8 * w) = u1;
          if (w == 0) { f32x2v d; d.x = __expf(tot.x); d.y = __expf(tot.y); *(LAS f32x2v*)(dvec + k0) = d; } }
        HG_BAR();
        if (c + 1 < nchunk) hg_load(P, (crow + 64) * 1024 + h * 128, k0, w, nvalid, lf, qv, kv, vv);
        unsigned short hgv[16];
        { const bf16* hp = P.HGS + crow * 1024 + h * 128 + 16 * w;
#pragma unroll
          for (int mt = 0; mt < 4; ++mt)
#pragma unroll
              for (int r = 0; r < 4; ++r) { int t = 16 * mt + 4 * lq + r; t = t < nvalid ? t : nvalid - 1; hgv[mt * 4 + r] = hp[(unsigned)(t * 1024 + lr)]; } }
#pragma unroll
        for (int rr = 0; rr < 2; ++rr) { const int blk = w + 8 * rr, bi = blk >> 2, bj = blk & 3;
            f32x4 acc = {0.f, 0.f, 0.f, 0.f};
            if (bj <= bi) { const int rb = (bi == 0) ? 0 : (bi == 1) ? 16 : (bi == 2) ? 48 : 96;
#pragma unroll
                for (int ks = 0; ks < 4; ++ks) { const bf16x8 a = *(const LAS bf16x8*)(QH + (16 * bi + lr) * HK + ks * 32 + 8 * lq), b = *(const LAS bf16x8*)(KH + (rb + 16 * bj + lr) * HK + ks * 32 + 8 * lq); acc = mfma16(a, b, acc); }
                if (bi == bj) {
#pragma unroll
                    for (int r = 0; r < 4; ++r) acc[r] = (lr <= 4 * lq + r) ? acc[r] : 0.f; } }
#pragma unroll
            for (int r = 0; r < 4; ++r) AL[(16 * bi + 4 * lq + r) * HS + 16 * bj + lr] = (bf16)f2bf(acc[r]); }
        HG_BAR();
        f32x4 o[4];
        { bf16x8 bS[4], bV[2];
#pragma unroll
          for (int kp = 0; kp < 4; ++kp) { v4u t; t.x = cvtpk(S[2 * kp][0], S[2 * kp][1]); t.y = cvtpk(S[2 * kp][2], S[2 * kp][3]); t.z = cvtpk(S[2 * kp + 1][0], S[2 * kp + 1][1]); t.w = cvtpk(S[2 * kp + 1][2], S[2 * kp + 1][3]); bS[kp] = __builtin_bit_cast(bf16x8, t); }
#pragma unroll
          for (int ks = 0; ks < 2; ++ks) bV[ks] = *(const LAS bf16x8*)(VT + (16 * w + lr) * HS + ks * 32 + 8 * lq);
#pragma unroll
          for (int mt = 0; mt < 4; ++mt) { f32x4 acc = {0.f, 0.f, 0.f, 0.f};
#pragma unroll
              for (int kp = 0; kp < 4; ++kp) { const LAS bf16* qp = QT + (16 * mt + lr) * HK + 32 * kp + 4 * lq; const v2u a0 = *(const LAS v2u*)qp, a1 = *(const LAS v2u*)(qp + 16);
                  v4u a; a.x = a0.x; a.y = a0.y; a.z = a1.x; a.w = a1.y; acc = mfma16(__builtin_bit_cast(bf16x8, a), bS[kp], acc); }
#pragma unroll
              for (int ks = 0; ks < 2; ++ks) acc = mfma16(*(const LAS bf16x8*)(AL + (16 * mt + lr) * HS + ks * 32 + 8 * lq), bV[ks], acc);
              o[mt] = acc;
#pragma unroll
              for (int r = 0; r < 4; ++r) { float p = acc[r] * acc[r]; p += __shfl_xor(p, 1); p += __shfl_xor(p, 2); p += __shfl_xor(p, 4); p += __shfl_xor(p, 8); if (lr == 0) part[(16 * mt + 4 * lq + r) * 8 + w] = p; } } }
        { bf16x8 bV[2];
#pragma unroll
          for (int ks = 0; ks < 2; ++ks) bV[ks] = *(const LAS bf16x8*)(VT + (16 * w + lr) * HS + ks * 32 + 8 * lq);
#pragma unroll
          for (int kb = 0; kb < 8; ++kb) { const f32x4 d = *(const LAS f32x4*)(dvec + 16 * kb + 4 * lq); f32x4 acc = S[kb] * d;
#pragma unroll
              for (int ks = 0; ks < 2; ++ks) acc = mfma16(*(const LAS bf16x8*)(KT + (16 * kb + lr) * HS + ks * 32 + 8 * lq), bV[ks], acc);
              S[kb] = acc; } }
        HG_BAR();
        { bf16* op = P.OH + crow * 1024 + h * 128 + 16 * w;
#pragma unroll
          for (int mt = 0; mt < 4; ++mt)
#pragma unroll
              for (int r = 0; r < 4; ++r) { const int t = 16 * mt + 4 * lq + r; const f32x4 p0 = *(const LAS f32x4*)(part + t * 8), p1 = *(const LAS f32x4*)(part + t * 8 + 4);
                  const float ss = ((p0[0] + p0[1]) + (p0[2] + p0[3])) + ((p1[0] + p1[1]) + (p1[2] + p1[3]));
                  const float rstd = __builtin_amdgcn_rsqf(ss * (1.f / 128.f) + EPS);
                  const bf16 ov = (bf16)f2bf(o[mt][r] * rstd * gv * bf2f(hgv[mt * 4 + r]));
                  bf16* dst = (t < nvalid) ? op + (unsigned)(t * 1024 + lr) : P.dump + F.tid;
                  *dst = ov; } }
        HG_BAR();
    }
#pragma unroll
    for (int kb = 0; kb < 8; ++kb)
#pragma unroll
        for (int r = 0; r < 4; ++r) s_out[(size_t)(16 * kb + 4 * lq_ + r) * 128 + 16 * w + lr_] = S[kb][r];
}
#undef HG_BAR
__device__ __forceinline__ void team_barrier(Frame& F, gu32* w, unsigned target) {
    asm volatile("s_waitcnt vmcnt(0)" ::: "memory");
    __syncthreads();
    if (F.tid == 0) {
        __builtin_amdgcn_fence(__ATOMIC_RELEASE, "agent");
        asm volatile("s_waitcnt vmcnt(0)" ::: "memory");
        (void)__hip_atomic_fetch_add(w, 1u, RLX_AGENT);
        unsigned sp = 0;
        while (__hip_atomic_load(w, RLX_AGENT) < target) { __builtin_amdgcn_s_sleep(2); if (++sp > (1u << 22)) { __hip_atomic_store(F.ctl + 1, 0x7ea0u, RLX_AGENT); break; } }
        __builtin_amdgcn_fence(__ATOMIC_ACQUIRE, "agent");
        asm volatile("s_waitcnt vmcnt(0)" ::: "memory");
    }
    __syncthreads();
}
__device__ __forceinline__ int wg_pull(Frame& F, gu32* ctr) {
    if (F.tid == 0) F.MISC[16] = __hip_atomic_fetch_add(ctr, 1u, RLX_AGENT);
    __syncthreads();
    const int v = (int)F.MISC[16];
    __syncthreads();
    return __builtin_amdgcn_readfirstlane(v);
}
struct Args { const float* in[25]; float* out; unsigned char* ws; };
__global__ void __launch_bounds__(NWAVES * 64, 2) mk_fwd(Args args) {
    extern __shared__ __attribute__((aligned(16))) unsigned char lds[];
    Frame F;
    F.lds = (LAS unsigned char*)lds;
    F.MISC = (volatile LAS unsigned*)(F.lds + MISC_OFF);
#define ENTER() do { F.tid = opaque_tid(); F.lane = F.tid & 63; F.wave = __builtin_amdgcn_readfirstlane(F.tid >> 6); F.G = gridDim.x; { const int bx = opaque_bid(); F.vcu = (F.G % 8 == 0) ? (bx % 8) * (F.G / 8) + bx / 8 : bx; } } while (0)
    ENTER();
    F.ctl = (gu32*)((unsigned char*)karg(A_WS) + WS_CTL);
    for (int u = F.tid; u < (LDS_BYTES - LDSCTL_OFF) / 4; u += NWAVES * 64) ((LAS unsigned*)(F.lds + LDSCTL_OFF))[u] = 0u;
    __syncthreads();
    XcdBarrier bar = xcd_barrier_post((unsigned*)(F.ctl + CW_BAR), F.MISC + 8);
#define GRID_BAR() do { asm volatile("" : "+s"(bar.x)); xcd_barrier(bar); } while (0)
#define WSP(T, off) ((T*)((unsigned char*)karg(A_WS) + (off)))
#define OUTP(off) ((float*)karg(A_OUT) + (off))

#ifndef NO_P0
    p0_prologue(F, WSP(unsigned char, 0));
#endif
    GRID_BAR();

    for (int l = 0; l < DEPTH; ++l) {
        const size_t wlo = WS_W + (size_t)l * W_LAYER, modo = WS_MOD + (size_t)l * NSEQ * 9216 * 4;
        norm_phase(F, karg(A_XP), nullptr, l == 0, WSP(float, WS_X), karg(A_GFFN1) + l * 1024, WSP(const float, modo), 0, WSP(bf16, WS_XN), 0, MP, F.vcu * NWAVES + F.wave, F.G * NWAVES);
        GRID_BAR(); ENTER();
#ifndef NO_G1
        { pg8::Gemm g{WSP(bf16, WS_XN), WSP(const bf16, wlo + WO_GU1), MP, 2 * DFF, DM}; typedef pg8::FixedOrder<128, 22, 8> Ord; Ord S; S.init(F.G, opaque_bid());
          pg8::EpiSwiglu E{WSP(bf16, WS_BIG)};
          pg8::gemm_phase<pg8::EpiSwiglu, Ord, true, true>(F.lds + RING_OFF, g, S, E); }
#endif
        GRID_BAR(); ENTER();
#ifndef NO_G2
        { pg8::Gemm g{WSP(bf16, WS_BIG), WSP(const bf16, wlo + WO_D1), MP, DM, DFF}; typedef pg8::FixedOrder<128, 4, 8> Ord; Ord S; S.init(F.G, opaque_bid());
          pg8::EpiResid E{WSP(float, WS_X), WSP(const float, modo) + 2 * 1024, 0.5f};
          pg8::gemm_phase<pg8::EpiResid, Ord, true, true>(F.lds + RING_OFF, g, S, E); }
#endif
        GRID_BAR(); ENTER();
        norm_phase(F, nullptr, nullptr, false, WSP(float, WS_X), karg(A_GMIX) + l * 1024, WSP(const float, modo), 1, WSP(bf16, WS_XN), 0, MP, F.vcu * NWAVES + F.wave, F.G * NWAVES);
        GRID_BAR(); ENTER();
#ifndef NO_G3
        { pg8::Gemm g{WSP(bf16, WS_XN), WSP(const bf16, wlo + WO_IN), MP, DIN, DM}; typedef pg8::FixedOrder<128, 36, 8> Ord; Ord S; S.init(F.G, opaque_bid());
          pg8::EpiWin E{WSP(unsigned char, 0), OUTP(0), l, attn_body::C2};
          pg8::gemm_phase<pg8::EpiWin, Ord, true, true>(F.lds + RING_OFF, g, S, E); }
#endif
        GRID_BAR(); ENTER();
        { gu32* qbase = F.ctl + CW_Q + 64 * (l * 16);
          const int ticket = wg_pull(F, qbase + 64 * 9); const bool team = ticket < T_TEAM; gu32* tb = qbase + 64 * 10; unsigned tstage = 0;
#define TEAM_BAR() do { ++tstage; team_barrier(F, tb, (unsigned)T_TEAM * tstage); ENTER(); } while (0)
#ifndef NO_TEAM
          if (team) {
              const int tgw = ticket * NWAVES + F.wave, TNW = T_TEAM * NWAVES;
              norm_phase(F, nullptr, karg(A_XS), l == 0, WSP(float, WS_X), karg(A_GFFN1) + l * 1024, WSP(const float, modo), 0, WSP(bf16, WS_XN), MP, MROWS, tgw, TNW);
              TEAM_BAR();
              { pg8::Gemm g{WSP(bf16, WS_XN), WSP(const bf16, wlo + WO_GU1), MROWS, 2 * DFF, DM}; typedef pg8::TeamOrder<22> Ord; Ord S; S.init(T_TEAM, ticket);
                pg8::EpiSwiglu E{WSP(bf16, WS_BIG)};
                pg8::gemm_phase<pg8::EpiSwiglu, Ord, true, true>(F.lds + RING_OFF, g, S, E); }
              TEAM_BAR();
              { pg8::Gemm g{WSP(bf16, WS_BIG), WSP(const bf16, wlo + WO_D1), MROWS, DM, DFF}; typedef pg8::TeamOrder<4> Ord; Ord S; S.init(T_TEAM, ticket);
                pg8::EpiResid E{WSP(float, WS_X), WSP(const float, modo) + 2 * 1024, 0.5f};
                pg8::gemm_phase<pg8::EpiResid, Ord, true, true>(F.lds + RING_OFF, g, S, E); }
              TEAM_BAR();
              norm_phase(F, nullptr, nullptr, false, WSP(float, WS_X), karg(A_GMIX) + l * 1024, WSP(const float, modo), 1, WSP(bf16, WS_XN), MP, MROWS, ticket * NWAVES + F.wave, T_TEAM * NWAVES);
              TEAM_BAR();
              { pg8::Gemm g{WSP(bf16, WS_XN), WSP(const bf16, wlo + WO_IN), MROWS, DIN, DM}; typedef pg8::TeamOrder<36> Ord; Ord S; S.init(T_TEAM, ticket);
                pg8::EpiWin E{WSP(unsigned char, 0), OUTP(0), l, attn_body::C2};
                pg8::gemm_phase<pg8::EpiWin, Ord, true, true>(F.lds + RING_OFF, g, S, E); }
              TEAM_BAR();
          }
#endif
          { gu32* qs = team ? qbase + 64 * 11 : qbase; const int lim = team ? 256 : 32;
            for (;;) { int it = wg_pull(F, qs); if (it >= lim) break; if (team) it += 32;
#ifndef NO_H
              if (it < 160) {
                  const HgPtrs P{WSP(const float, WS_LOGF), WSP(const bf16, WS_QQ), WSP(const bf16, WS_KK), WSP(const bf16, WS_VV), WSP(const bf16, WS_HGS), karg(A_GHG) + l * 128, WSP(bf16, WS_OH), WSP(bf16, WS_DD)};
                  const bool smp = it >= 32; const int u = smp ? it - 32 : it, sq = u >> 3, h = u & 7;
                  const size_t so = smp ? OS_S + ((size_t)((l * 16 + sq) * 8 + h)) * 16384 : OS_P + ((size_t)((l * 4 + sq) * 8 + h)) * 16384;
                  hg_sequence(F, P, smp ? (size_t)MP + (size_t)sq * 32 : (size_t)sq * 8192, h, smp ? 1 : 128, smp ? 32 : 64, smp ? karg(A_ST) + ((size_t)((l * 16 + sq) * 8 + h)) * 16384 : nullptr, OUTP(0) + so);
              } else
#endif
              {
#ifndef NO_SAMP
                  const int u = it - 160; const float lam = lam_of(karg(A_LAM), l, F.lane), osc = 1.f - lam_init_of(l);
                  attn_sample_unit(F, karg(A_CK), karg(A_CV), l, u >> 3, u & 7, WSP(const bf16, WS_Q), WSP(const bf16, WS_K), WSP(const bf16, WS_V), lam, osc, karg(A_GSUB) + l * 128, WSP(bf16, WS_OATT));
#endif
              } } }
#ifndef NO_TEAM
          if (team) {
              TEAM_BAR();
              { pg8::Gemm g{WSP(bf16, WS_OATT), WSP(const bf16, wlo + WO_BA), MROWS, DM, DM}; typedef pg8::TeamOrder<4> Ord; Ord S; S.init(T_TEAM, ticket);
                pg8::EpiGateT E{WSP(float, WS_LOGF), WSP(const bf16, WS_SZA)};
                pg8::gemm_phase<pg8::EpiGateT, Ord, true, true>(F.lds + RING_OFF, g, S, E); }
              TEAM_BAR();
              { pg8::Gemm g{WSP(bf16, WS_OH), WSP(const bf16, wlo + WO_BH), MROWS, DM, DM}; typedef pg8::TeamOrder<4> Ord; Ord S; S.init(T_TEAM, ticket);
                pg8::EpiGateM E{WSP(const float, WS_LOGF), WSP(const bf16, WS_SZH), WSP(bf16, WS_MRG)};
                pg8::gemm_phase<pg8::EpiGateM, Ord, true, true>(F.lds + RING_OFF, g, S, E); }
              TEAM_BAR();
              { pg8::Gemm g{WSP(bf16, WS_MRG), WSP(const bf16, wlo + WO_OUT), MROWS, DM, DM}; typedef pg8::TeamOrder<4> Ord; Ord S; S.init(T_TEAM, ticket);
                pg8::EpiResid E{WSP(float, WS_X), WSP(const float, modo) + 5 * 1024, 1.0f};
                pg8::gemm_phase<pg8::EpiResid, Ord, true, true>(F.lds + RING_OFF, g, S, E); }
              TEAM_BAR();
              norm_phase(F, nullptr, nullptr, false, WSP(float, WS_X), karg(A_GFFN2) + l * 1024, WSP(const float, modo), 2, WSP(bf16, WS_XN), MP, MROWS, ticket * NWAVES + F.wave, T_TEAM * NWAVES);
              TEAM_BAR();
              { pg8::Gemm g{WSP(bf16, WS_XN), WSP(const bf16, wlo + WO_GU2), MROWS, 2 * DFF, DM}; typedef pg8::TeamOrder<22> Ord; Ord S; S.init(T_TEAM, ticket);
                pg8::EpiSwiglu E{WSP(bf16, WS_BIG)};
                pg8::gemm_phase<pg8::EpiSwiglu, Ord, true, true>(F.lds + RING_OFF, g, S, E); }
              TEAM_BAR();
              { pg8::Gemm g{WSP(bf16, WS_BIG), WSP(const bf16, wlo + WO_D2), MROWS, DM, DFF}; typedef pg8::TeamOrder<4> Ord; Ord S; S.init(T_TEAM, ticket);
                pg8::EpiResid E{WSP(float, WS_X), WSP(const float, modo) + 8 * 1024, 0.5f};
                pg8::gemm_phase<pg8::EpiResid, Ord, true, true>(F.lds + RING_OFF, g, S, E); }
              ENTER();
          }
#endif
#undef TEAM_BAR
#ifndef NO_ATT
          { const attn_body::bf16* Qb = WSP(const attn_body::bf16, WS_Q); const attn_body::bf16* Kb = WSP(const attn_body::bf16, WS_K); const attn_body::bf16* Vb = WSP(const attn_body::bf16, WS_V); attn_body::bf16* O1 = WSP(attn_body::bf16, WS_O1);
            const int x0 = (int)(xb_xcc_id() & 7u);
            for (int dx = 0; dx < 8; ++dx) { const int head = (x0 + dx) & 7; gu32* qa = qbase + 64 * (1 + head);
                for (;;) { const int it = wg_pull(F, qa); if (it >= 512) break;
                    const int b = it >> 7, r = it & 127, qb = 31 - (r >> 2), mp = (r >> 1) & 1, vh = r & 1;
                    attn_body::attn_unit<8>(b, head * 2 + mp, head * 2 + vh, qb, Qb, Kb, Vb, O1 + (size_t)mp * ((WS_O2 - WS_O1) / 2), (char*)lds + RING_OFF); } } }
#endif
        }
        GRID_BAR(); ENTER();
        { const float lam = lam_of(karg(A_LAM), l, F.lane), osc = 1.f - lam_init_of(l);
          attn_combine_phase(F, WSP(const bf16, WS_O1), WSP(const bf16, WS_O2), karg(A_GSUB) + l * 128, lam, osc, WSP(bf16, WS_OATT)); }
        GRID_BAR(); ENTER();
#ifndef NO_G4
        { pg8::Gemm g{WSP(bf16, WS_OATT), WSP(const bf16, wlo + WO_BA), MP, DM, DM}; typedef pg8::FixedOrder<128, 4, 8> Ord; Ord S; S.init(F.G, opaque_bid());
          pg8::EpiGateT E{WSP(float, WS_LOGF), WSP(const bf16, WS_SZA)};
          pg8::gemm_phase<pg8::EpiGateT, Ord, true, true>(F.lds + RING_OFF, g, S, E); }
#endif
        GRID_BAR(); ENTER();
#ifndef NO_G5
        { pg8::Gemm g{WSP(bf16, WS_OH), WSP(const bf16, wlo + WO_BH), MP, DM, DM}; typedef pg8::FixedOrder<128, 4, 8> Ord; Ord S; S.init(F.G, opaque_bid());
          pg8::EpiGateM E{WSP(const float, WS_LOGF), WSP(const bf16, WS_SZH), WSP(bf16, WS_MRG)};
          pg8::gemm_phase<pg8::EpiGateM, Ord, true, true>(F.lds + RING_OFF, g, S, E); }
#endif
        GRID_BAR(); ENTER();
#ifndef NO_G6
        { pg8::Gemm g{WSP(bf16, WS_MRG), WSP(const bf16, wlo + WO_OUT), MP, DM, DM}; typedef pg8::FixedOrder<128, 4, 8> Ord; Ord S; S.init(F.G, opaque_bid());
          pg8::EpiResid E{WSP(float, WS_X), WSP(const float, modo) + 5 * 1024, 1.0f};
          pg8::gemm_phase<pg8::EpiResid, Ord, true, true>(F.lds + RING_OFF, g, S, E); }
#endif
        GRID_BAR(); ENTER();
        norm_phase(F, nullptr, nullptr, false, WSP(float, WS_X), karg(A_GFFN2) + l * 1024, WSP(const float, modo), 2, WSP(bf16, WS_XN), 0, MP, F.vcu * NWAVES + F.wave, F.G * NWAVES);
        GRID_BAR(); ENTER();
#ifndef NO_G7
        { pg8::Gemm g{WSP(bf16, WS_XN), WSP(const bf16, wlo + WO_GU2), MP, 2 * DFF, DM}; typedef pg8::FixedOrder<128, 22, 8> Ord; Ord S; S.init(F.G, opaque_bid());
          pg8::EpiSwiglu E{WSP(bf16, WS_BIG)};
          pg8::gemm_phase<pg8::EpiSwiglu, Ord, true, true>(F.lds + RING_OFF, g, S, E); }
#endif
        GRID_BAR(); ENTER();
#ifndef NO_G8
        { pg8::Gemm g{WSP(bf16, WS_BIG), WSP(const bf16, wlo + WO_D2), MP, DM, DFF}; typedef pg8::FixedOrder<128, 4, 8> Ord; Ord S; S.init(F.G, opaque_bid());
          pg8::EpiResid E{WSP(float, WS_X), WSP(const float, modo) + 8 * 1024, 0.5f};
          pg8::gemm_phase<pg8::EpiResid, Ord, true, true>(F.lds + RING_OFF, g, S, E); }
#endif
        GRID_BAR(); ENTER();
    }
    final_norm_phase(F, WSP(const float, WS_X), karg(A_GFIN), OUTP(0));
#undef GRID_BAR
#undef ENTER
#undef WSP
#undef OUTP
}

extern "C" void kernel_launch(void* const* d_in, const int* in_sizes, int n_in, void* d_out, int out_size, void* d_ws, size_t ws_size, hipStream_t stream) {
    static int grid = 0;
    if (grid == 0) {
        if (n_in != 25 || (size_t)out_size != OUT_TOTAL || ws_size < WS_END) { fprintf(stderr, "kernel_launch: unexpected sizes: n_in %d out %d ws %zu (need %zu)\n", n_in, out_size, ws_size, (size_t)WS_END); grid = -1; return; }
        int dev = 0, cus = 0, per_cu = 0;
        if (hipGetDevice(&dev) != hipSuccess || hipDeviceGetAttribute(&cus, hipDeviceAttributeMultiprocessorCount, dev) != hipSuccess) { grid = -1; return; }
        if (hipFuncSetAttribute((const void*)mk_fwd, hipFuncAttributeMaxDynamicSharedMemorySize, LDS_BYTES) != hipSuccess) { fprintf(stderr, "kernel_launch: hipFuncSetAttribute failed\n"); grid = -1; return; }
        if (hipOccupancyMaxActiveBlocksPerMultiprocessor(&per_cu, (const void*)mk_fwd, NWAVES * 64, LDS_BYTES) != hipSuccess || per_cu < 1) { fprintf(stderr, "kernel_launch: occupancy query reports %d\n", per_cu); }
        (void)hipGetLastError();
        grid = cus;
    }
    if (grid < 0) return;
    if (hipMemsetAsync((char*)d_ws + WS_CTL, 0, CTL_ZERO_BYTES, stream) != hipSuccess) return;
    Args a{};
    for (int i = 0; i < 25; ++i) a.in[i] = (const float*)d_in[i];
    a.out = (float*)d_out; a.ws = (unsigned char*)d_ws;
    hipLaunchKernelGGL(mk_fwd, dim3(grid), dim3(NWAVES * 64), LDS_BYTES, stream, a);
    (void)in_sizes;
}
```

```cpp
#include <hip/hip_runtime.h>
#include <hip/hip_bf16.h>
#include <cstdio>
#include <cstdint>
#include <cmath>
__device__ __forceinline__ int opaque_tid() { int t = (int)threadIdx.x; asm volatile("" : "+v"(t)); return t; }
__device__ __forceinline__ int opaque_bid() { int b = (int)blockIdx.x; asm volatile("" : "+s"(b)); return b; }
namespace pg8 {
#define PG8_LAS __attribute__((address_space(3)))
typedef unsigned short bf16_t;
typedef short bf16x8 __attribute__((ext_vector_type(8)));
typedef float f32x4 __attribute__((ext_vector_type(4)));
typedef unsigned u32x4 __attribute__((ext_vector_type(4)));
constexpr int BM = 256, BK = 64, HALF = 128, HTB = HALF * BK * 2  , STAGE_BYTES = 8 * HTB, NXCD = 8, WGM = 8;

__host__ __device__ __forceinline__ int lds_byte(int r, int c) { const int st = (r >> 4) * 2 + (c >> 5), rr = r & 15, cc = c & 31, ob = rr * 64 + cc * 2; return st * 1024 + (ob ^ (((ob >> 9) & 1) << 5)); }
__host__ __device__ __forceinline__ void stage_rc(int b, int& R, int& C) { const int st = b / 1024, sb = b % 1024, swz = sb ^ (((sb >> 9) & 1) << 5); R = (st >> 1) * 16 + swz / 64; C = (st & 1) * 32 + (swz % 64) / 2; }
__host__ __device__ __forceinline__ int perm32(int rho) { const int n = rho >> 4, i = rho & 15; return 8 * (i >> 2) + 4 * n + (i & 3); }

struct Unit { int pm, pn; };
struct Gemm { const bf16_t* A; const bf16_t* Bt; int M, N, K; };

struct StaticOrder {
    int nM, nN, nwg, G, c;
    __host__ __device__ void init(int M, int N, int G_, int c_) { nM = M / BM; nN = N / BM; nwg = nM * nN; G = G_; c = c_; }
    __host__ __device__ bool next(int i, Unit& u) const {
        const long L = (long)i * G + c; if (L >= nwg) return false;
        int wgid = (int)L; { const int q = nwg / NXCD, r = nwg % NXCD, xcd = wgid % NXCD, off = wgid / NXCD; wgid = (xcd < r ? xcd * (q + 1) : r * (q + 1) + (xcd - r) * q) + off; }
        const int nig = WGM * nN, gid = wgid / nig, fm = gid * WGM, gsz = (nM - fm) < WGM ? (nM - fm) : WGM;
        u.pm = fm + ((wgid % nig) % gsz); u.pn = (wgid % nig) / gsz; return true;
    }
    __device__ __forceinline__ void a_ready(const Unit&) const {}
    __device__ __forceinline__ void done(const Unit&) const {}
};

__device__ __forceinline__ unsigned cvt_pk_bf16(float lo, float hi) { unsigned r; asm volatile("v_cvt_pk_bf16_f32 %0, %1, %2" : "=v"(r) : "v"(lo), "v"(hi)); return r; }
__device__ __forceinline__ float bf_lo(unsigned w) { return __builtin_bit_cast(float, w << 16); }
__device__ __forceinline__ float bf_hi(unsigned w) { return __builtin_bit_cast(float, w & 0xffff0000u); }
__device__ __forceinline__ float sigmoid_f(float x) { return __builtin_amdgcn_rcpf(1.f + __expf(-x)); }
__device__ __forceinline__ float silu_f(float x) { return x * sigmoid_f(x); }
__device__ __forceinline__ void store8bf(bf16_t* p, f32x4 a, f32x4 b) { u32x4 w; w.x = cvt_pk_bf16(a[0], a[1]); w.y = cvt_pk_bf16(a[2], a[3]); w.z = cvt_pk_bf16(b[0], b[1]); w.w = cvt_pk_bf16(b[2], b[3]); *(u32x4*)p = w; }
__device__ __forceinline__ int row_seq(int row) { return row < 32768 ? (row >> 13) : 4 + ((row - 32768) >> 5); }

struct EpiSwiglu {
    static constexpr bool PERM = true, AFTER_DRAIN = false;
    bf16_t* O;
    __device__ __forceinline__ void operator()(const f32x4 (&acc)[2][2][4][2], const Unit& u, int wr, int wc, int fr, int fq) const {
        const int row0 = u.pm * BM + wr * 64 + fr, col0 = u.pn * HALF + wc * 32 + 8 * fq;
#pragma unroll
        for (int ai = 0; ai < 2; ++ai)
#pragma unroll
            for (int m = 0; m < 4; ++m) {
                f32x4 g0 = acc[ai][0][m][0], g1 = acc[ai][0][m][1]; const f32x4 u0 = acc[ai][1][m][0], u1 = acc[ai][1][m][1];
#pragma unroll
                for (int i = 0; i < 4; ++i) { g0[i] = silu_f(g0[i]) * u0[i]; g1[i] = silu_f(g1[i]) * u1[i]; }
                store8bf(O + (size_t)(row0 + ai * HALF + m * 16) * 2816 + col0, g0, g1); asm volatile("" ::: "memory");
            }
    }
};

struct EpiResid {
    static constexpr bool PERM = true, AFTER_DRAIN = false;
    float* X; const float* gate; float coef;
    __device__ __forceinline__ void operator()(const f32x4 (&acc)[2][2][4][2], const Unit& u, int wr, int wc, int fr, int fq) const {
#pragma unroll
        for (int ai = 0; ai < 2; ++ai)
#pragma unroll
            for (int m = 0; m < 4; ++m) {
                const int row = u.pm * BM + ai * HALF + wr * 64 + m * 16 + fr; const float* gp = gate + (size_t)row_seq(row) * 9216;
#pragma unroll
                for (int bj = 0; bj < 2; ++bj) { const int col = u.pn * BM + bj * HALF + wc * 32 + 8 * fq;
#pragma unroll
                    for (int n = 0; n < 2; ++n) { const f32x4 g = *(const f32x4*)(gp + col + 4 * n); f32x4* xp = (f32x4*)(X + (size_t)row * 1024 + col + 4 * n); const f32x4 xv = *xp; *xp = xv + (g * coef) * acc[ai][bj][m][n]; } asm volatile("" ::: "memory"); }
            }
    }
};

struct EpiWin {
    static constexpr bool PERM = true, AFTER_DRAIN = false;
    unsigned char* ws; float* out; int l; float qscale;
    static constexpr size_t MiB_ = 1u << 20;
    static constexpr size_t O_Q = 435 * MiB_, O_K = 500 * MiB_, O_V = 565 * MiB_, O_QQ = 630 * MiB_, O_KK = 695 * MiB_, O_VV = 760 * MiB_, O_HGS = 825 * MiB_, O_SZA = 890 * MiB_, O_SZH = 955 * MiB_, O_LOGF = 1020 * MiB_, O_LB = 4 * MiB_;
    static constexpr size_t OK_P_ = 34078720, OV_P_ = 168296448, OK_S_ = 304611328, OV_S_ = 306708480;
    __device__ __forceinline__ void operator()(const f32x4 (&acc)[2][2][4][2], const Unit& u, int wr, int wc, int fr, int fq) const {
        const int seg = u.pn >> 2, cb = (u.pn & 3) * BM + wc * 32 + 8 * fq, row0 = u.pm * BM + wr * 64 + fr;
        const size_t boff = seg == 0 ? O_Q : seg == 1 ? O_K : seg == 2 ? O_V : seg == 3 ? O_QQ : seg == 4 ? O_KK : seg == 5 ? O_VV : seg == 6 ? O_HGS : seg == 7 ? O_SZA : O_SZH;
        bf16_t* const O = (bf16_t*)(ws + boff) + (size_t)row0 * 1024 + cb;
        float* F32 = nullptr;
        if (seg == 1 || seg == 2) { const size_t ob = (u.pm < 128) ? (seg == 1 ? OK_P_ : OV_P_) + (size_t)l * 32768 * 1024 + (size_t)(u.pm * BM) * 1024 : (seg == 1 ? OK_S_ : OV_S_) + (size_t)l * 512 * 1024 + (size_t)((u.pm - 128) * BM) * 1024;
            F32 = out + ob + (size_t)(wr * 64 + fr) * 1024 + cb; }
        else if (seg == 4) F32 = (float*)(ws + O_LOGF) + (size_t)row0 * 1024 + cb;
        const float* const lb = (const float*)(ws + O_LB) + l * 1024 + cb;
        const float sc = seg == 0 ? qscale : 1.f;
#pragma unroll
        for (int bj = 0; bj < 2; ++bj) {
            f32x4 l0 = {0.f, 0.f, 0.f, 0.f}, l1 = l0; if (seg == 4) { l0 = *(const f32x4*)(lb + bj * HALF); l1 = *(const f32x4*)(lb + bj * HALF + 4); }
#pragma unroll
            for (int ai = 0; ai < 2; ++ai)
#pragma unroll
                for (int m = 0; m < 4; ++m) { const size_t off = (size_t)(ai * HALF + m * 16) * 1024 + bj * HALF;
                    f32x4 a = acc[ai][bj][m][0], b = acc[ai][bj][m][1];
                    if (seg == 4) { f32x4 fa, fb;
#pragma unroll
                        for (int i = 0; i < 4; ++i) {
                            { const float x = a[i], lbv = l0[i], e = __expf(-__builtin_fabsf(x)), r = __builtin_amdgcn_rcpf(1.f + e), er = e * r, sig = x >= 0.f ? r : er, om = x >= 0.f ? er : r;
                              fa[i] = __logf(__builtin_fmaxf(lbv + (1.f - lbv) * sig, 1e-30f)); a[i] = (1.f - lbv) * om; }
                            { const float x = b[i], lbv = l1[i], e = __expf(-__builtin_fabsf(x)), r = __builtin_amdgcn_rcpf(1.f + e), er = e * r, sig = x >= 0.f ? r : er, om = x >= 0.f ? er : r;
                              fb[i] = __logf(__builtin_fmaxf(lbv + (1.f - lbv) * sig, 1e-30f)); b[i] = (1.f - lbv) * om; } }
                        *(f32x4*)(F32 + off) = fa; *(f32x4*)(F32 + off + 4) = fb;
                    } else if (seg == 3 || seg == 6) {
#pragma unroll
                        for (int i = 0; i < 4; ++i) { a[i] = silu_f(a[i]); b[i] = silu_f(b[i]); }
                    } else if (seg >= 7) {
#pragma unroll
                        for (int i = 0; i < 4; ++i) { a[i] = sigmoid_f(a[i]); b[i] = sigmoid_f(b[i]); }
                    } else {
                        if (seg == 1 || seg == 2) { *(f32x4*)(F32 + off) = a; *(f32x4*)(F32 + off + 4) = b; }
                        a = a * sc; b = b * sc;
                    }
                    store8bf(O + off, a, b); asm volatile("" ::: "memory"); }
        }
    }
};

struct EpiGateT {
    static constexpr bool PERM = true, AFTER_DRAIN = false;
    float* T; const bf16_t* G;
    __device__ __forceinline__ void operator()(const f32x4 (&acc)[2][2][4][2], const Unit& u, int wr, int wc, int fr, int fq) const {
        const int row0 = u.pm * BM + wr * 64 + fr, cb = u.pn * BM + wc * 32 + 8 * fq;
#pragma unroll
        for (int ai = 0; ai < 2; ++ai)
#pragma unroll
            for (int m = 0; m < 4; ++m)
#pragma unroll
                for (int bj = 0; bj < 2; ++bj) { const size_t off = (size_t)(row0 + ai * HALF + m * 16) * 1024 + cb + bj * HALF; const u32x4 g = *(const u32x4*)(G + off);
                    const f32x4 g0 = {bf_lo(g.x), bf_hi(g.x), bf_lo(g.y), bf_hi(g.y)}, g1 = {bf_lo(g.z), bf_hi(g.z), bf_lo(g.w), bf_hi(g.w)};
                    *(f32x4*)(T + off) = g0 * acc[ai][bj][m][0]; *(f32x4*)(T + off + 4) = g1 * acc[ai][bj][m][1]; asm volatile("" ::: "memory"); }
    }
};
struct EpiGateM {
    static constexpr bool PERM = true, AFTER_DRAIN = false;
    const float* T; const bf16_t* G; bf16_t* O;
    __device__ __forceinline__ void operator()(const f32x4 (&acc)[2][2][4][2], const Unit& u, int wr, int wc, int fr, int fq) const {
        const int row0 = u.pm * BM + wr * 64 + fr, cb = u.pn * BM + wc * 32 + 8 * fq;
#pragma unroll
        for (int ai = 0; ai < 2; ++ai)
#pragma unroll
            for (int m = 0; m < 4; ++m)
#pragma unroll
                for (int bj = 0; bj < 2; ++bj) { const size_t off = (size_t)(row0 + ai * HALF + m * 16) * 1024 + cb + bj * HALF; const u32x4 g = *(const u32x4*)(G + off);
                    const f32x4 g0 = {bf_lo(g.x), bf_hi(g.x), bf_lo(g.y), bf_hi(g.y)}, g1 = {bf_lo(g.z), bf_hi(g.z), bf_lo(g.w), bf_hi(g.w)};
                    const f32x4 t0 = *(const f32x4*)(T + off), t1 = *(const f32x4*)(T + off + 4);
                    store8bf(O + off, t0 + g0 * acc[ai][bj][m][0], t1 + g1 * acc[ai][bj][m][1]); asm volatile("" ::: "memory"); }
    }
};

template <int NM, int NN, int GM> struct FixedOrder {
    static_assert(NM % GM == 0, "GM divides NM");
    int G, c;
    __device__ __forceinline__ void init(int G_, int c_) { G = G_; c = c_; }
    __device__ __forceinline__ bool next(int i, Unit& u) const {
        constexpr int nwg = NM * NN, q = nwg / NXCD, r = nwg % NXCD, nig = GM * NN;
        const int L = i * G + c; if (L >= nwg) return false;
        const int xcd = L % NXCD, off = L / NXCD; const int wgid = (xcd < r ? xcd * (q + 1) : r * (q + 1) + (xcd - r) * q) + off;
        const int gid = wgid / nig, w = wgid % nig; u.pm = gid * GM + (w % GM); u.pn = w / GM; return true;
    }
    __device__ __forceinline__ void a_ready(const Unit&) const {}
    __device__ __forceinline__ void done(const Unit&) const {}
};

template <int NN> struct TeamOrder {
    int T, r;
    __device__ __forceinline__ void init(int T_, int r_) { T = T_; r = r_; }
    __device__ __forceinline__ bool next(int i, Unit& u) const { const int L = i * T + r; if (L >= 2 * NN) return false; u.pm = 128 + L / NN; u.pn = L % NN; return true; }
    __device__ __forceinline__ void a_ready(const Unit&) const {}
    __device__ __forceinline__ void done(const Unit&) const {}
};
template <class Epi, class Sched, bool ALIGN_EPI = false, bool SP2 = false>
__device__ __forceinline__ void gemm_phase(PG8_LAS unsigned char* lds, const Gemm g, const Sched& S, const Epi& E) {
    const int tid = opaque_tid(), wid = __builtin_amdgcn_readfirstlane(tid >> 6), lane = tid & 63, wr = wid >> 2, wc = wid & 3, fr = lane & 15, fq = lane >> 4;
    const int K = g.K, nt = K / BK;
    unsigned voffA[2], voffB[2];
#pragma unroll
    for (int i = 0; i < 2; ++i) { int R, C; stage_rc(tid * 16 + i * 8192, R, C); const int Rb = Epi::PERM ? ((R & ~31) + perm32(R & 31)) : R;
        voffA[i] = (unsigned)(R * K + C) * 2u; voffB[i] = (unsigned)(Rb * K + C) * 2u; }
    const size_t kstep = (size_t)(BK * 2);
    const size_t hstep = (size_t)HALF * K * 2;
    const size_t tstep = 2 * hstep;
    const unsigned ldsw = (unsigned)wid * 1024u;
    const int aoff = lds_byte(wr * 64 + fr, fq * 8), boff = lds_byte(wc * 32 + fr, fq * 8);
#define PG8_SA(b, h) (((b) * 2 + (h)) * HTB)
#define PG8_SB(b, h) ((4 + (b) * 2 + (h)) * HTB)
#define PG8_STAGE(bufoff, gbase, voff) do { _Pragma("unroll") for (int _i = 0; _i < 2; ++_i) \
        __builtin_amdgcn_global_load_lds((const unsigned*)((const char*)(gbase) + (voff)[_i]), (PG8_LAS unsigned*)(lds + (bufoff) + ldsw + _i * 8192), 16, 0, 0); } while (0)
#define PG8_LDA(dst, b, h) do { _Pragma("unroll") for (int m = 0; m < 4; ++m) _Pragma("unroll") for (int k = 0; k < 2; ++k) dst[m][k] = *(const PG8_LAS bf16x8*)(lds + PG8_SA(b, h) + aoff + m * 2048 + k * 1024); } while (0)
#define PG8_LDB(dst, b, h) do { _Pragma("unroll") for (int n = 0; n < 2; ++n) _Pragma("unroll") for (int k = 0; k < 2; ++k) dst[n][k] = *(const PG8_LAS bf16x8*)(lds + PG8_SB(b, h) + boff + n * 2048 + k * 1024); } while (0)
#define PG8_MMA(ai, bj, At, Bt) do { __builtin_amdgcn_s_setprio(1); _Pragma("unroll") for (int m = 0; m < 4; ++m) _Pragma("unroll") for (int n = 0; n < 2; ++n) _Pragma("unroll") for (int k = 0; k < 2; ++k) \
        acc[ai][bj][m][n] = __builtin_amdgcn_mfma_f32_16x16x32_bf16(Bt[n][k], At[m][k], acc[ai][bj][m][n], 0, 0, 0); __builtin_amdgcn_s_setprio(0); } while (0)
#define PG8_WAIT_V(n) asm volatile("s_waitcnt vmcnt(" #n ")" ::: "memory")
#define PG8_WAIT_L(n) asm volatile("s_waitcnt lgkmcnt(" #n ")" ::: "memory")
#define PG8_BAR __builtin_amdgcn_s_barrier()
#define PG8_SCHED __builtin_amdgcn_sched_barrier(0)
    Unit cur, nxt; int ui = 0;
    if (!S.next(0, cur)) return;
    f32x4 acc[2][2][4][2];
#pragma unroll
    for (int a = 0; a < 2; ++a)
#pragma unroll
        for (int b = 0; b < 2; ++b)
#pragma unroll
            for (int m = 0; m < 4; ++m)
#pragma unroll
                for (int n = 0; n < 2; ++n) acc[a][b][m][n] = (f32x4){0.f, 0.f, 0.f, 0.f};
    bf16x8 At[4][2], B0[2][2], B1[2][2];
    const char* cA = (const char*)g.A + (size_t)cur.pm * tstep; const char* cB = (const char*)g.Bt + (size_t)cur.pn * tstep;
    S.a_ready(cur);
    if constexpr (SP2) {
        PG8_STAGE(PG8_SB(0, 0), cB, voffB); PG8_STAGE(PG8_SB(0, 1), cB + hstep, voffB); PG8_STAGE(PG8_SA(0, 0), cA, voffA); PG8_STAGE(PG8_SA(0, 1), cA + hstep, voffA);
        if (wr == 1) PG8_BAR;
        PG8_WAIT_V(2); PG8_BAR;
        PG8_STAGE(PG8_SB(1, 0), cB + kstep, voffB); PG8_STAGE(PG8_SA(1, 0), cA + kstep, voffA); PG8_STAGE(PG8_SB(1, 1), cB + hstep + kstep, voffB);
        PG8_WAIT_V(6); PG8_BAR;
    } else {
        PG8_STAGE(PG8_SB(0, 0), cB, voffB); PG8_STAGE(PG8_SA(0, 0), cA, voffA); PG8_STAGE(PG8_SB(0, 1), cB + hstep, voffB); PG8_STAGE(PG8_SA(0, 1), cA + hstep, voffA);
        if (wr == 1) PG8_BAR;
        PG8_WAIT_V(4); PG8_BAR;
        PG8_STAGE(PG8_SB(1, 0), cB + kstep, voffB); PG8_STAGE(PG8_SA(1, 0), cA + kstep, voffA); PG8_STAGE(PG8_SB(1, 1), cB + hstep + kstep, voffB);
        PG8_WAIT_V(6); PG8_BAR;
    }
    for (;;) {
        const bool has_next = S.next(ui + 1, nxt);
        const char* nA = has_next ? (const char*)g.A + (size_t)nxt.pm * tstep : cA; const char* nB = has_next ? (const char*)g.Bt + (size_t)nxt.pn * tstep : cB;
        for (int t = 0; t < nt; t += 2) {
            const bool last = (t == nt - 2);
            const char* a1 = cA + (size_t)(t + 1) * kstep;
            const char* a2 = last ? nA : cA + (size_t)(t + 2) * kstep; const char* b2 = last ? nB : cB + (size_t)(t + 2) * kstep;
            const char* a3 = a2 + kstep; const char* b3 = b2 + kstep;
            if (last && has_next) S.a_ready(nxt);
            if constexpr (SP2) {
            PG8_LDB(B0, 0, 0); PG8_LDB(B1, 0, 1); PG8_SCHED; PG8_LDA(At, 0, 0); PG8_STAGE(PG8_SA(1, 1), a1 + hstep, voffA);
            PG8_WAIT_V(8); PG8_WAIT_L(0); PG8_BAR; PG8_MMA(0, 0, At, B0); PG8_MMA(0, 1, At, B1); PG8_BAR; PG8_SCHED;
            PG8_LDA(At, 0, 1); PG8_STAGE(PG8_SB(0, 0), b2, voffB); PG8_STAGE(PG8_SB(0, 1), b2 + hstep, voffB); PG8_STAGE(PG8_SA(0, 0), a2, voffA);
            PG8_WAIT_V(8); PG8_WAIT_L(0); PG8_BAR; PG8_MMA(1, 0, At, B0); PG8_MMA(1, 1, At, B1); PG8_BAR; PG8_SCHED;
            PG8_LDB(B0, 1, 0); PG8_LDB(B1, 1, 1); PG8_SCHED; PG8_LDA(At, 1, 0); PG8_STAGE(PG8_SA(0, 1), a2 + hstep, voffA);
            PG8_WAIT_V(8); PG8_WAIT_L(0); PG8_BAR; PG8_MMA(0, 0, At, B0); PG8_MMA(0, 1, At, B1); PG8_BAR; PG8_SCHED;
            PG8_LDA(At, 1, 1); PG8_STAGE(PG8_SB(1, 0), b3, voffB); PG8_STAGE(PG8_SB(1, 1), b3 + hstep, voffB); PG8_STAGE(PG8_SA(1, 0), a3, voffA);
            PG8_WAIT_V(8); PG8_WAIT_L(0); PG8_BAR; PG8_MMA(1, 0, At, B0); PG8_MMA(1, 1, At, B1); PG8_BAR; PG8_SCHED;
            } else {
            PG8_LDB(B0, 0, 0); PG8_SCHED; PG8_LDA(At, 0, 0); PG8_STAGE(PG8_SA(1, 1), a1 + hstep, voffA);
            PG8_WAIT_L(8); PG8_BAR; PG8_WAIT_L(0); PG8_MMA(0, 0, At, B0); PG8_BAR; PG8_SCHED;
            PG8_LDB(B1, 0, 1); PG8_STAGE(PG8_SB(0, 0), b2, voffB);
            PG8_BAR; PG8_WAIT_L(0); PG8_MMA(0, 1, At, B1); PG8_BAR;
            PG8_LDA(At, 0, 1); PG8_STAGE(PG8_SA(0, 0), a2, voffA);
            PG8_BAR; PG8_WAIT_L(0); PG8_MMA(1, 0, At, B0); PG8_BAR; PG8_SCHED;
            PG8_STAGE(PG8_SB(0, 1), b2 + hstep, voffB);
            PG8_WAIT_V(6); PG8_BAR; PG8_MMA(1, 1, At, B1); PG8_BAR;
            PG8_LDB(B0, 1, 0); PG8_SCHED; PG8_LDA(At, 1, 0); PG8_STAGE(PG8_SA(0, 1), a2 + hstep, voffA);
            PG8_WAIT_L(8); PG8_BAR; PG8_WAIT_L(0); PG8_MMA(0, 0, At, B0); PG8_BAR; PG8_SCHED;
            PG8_LDB(B1, 1, 1); PG8_STAGE(PG8_SB(1, 0), b3, voffB);
            PG8_BAR; PG8_WAIT_L(0); PG8_MMA(0, 1, At, B1); PG8_BAR;
            PG8_LDA(At, 1, 1); PG8_STAGE(PG8_SA(1, 0), a3, voffA);
            PG8_BAR; PG8_WAIT_L(0); PG8_MMA(1, 0, At, B0); PG8_BAR; PG8_SCHED;
            PG8_STAGE(PG8_SB(1, 1), b3 + hstep, voffB);
            PG8_WAIT_V(6); PG8_BAR; PG8_MMA(1, 1, At, B1); PG8_BAR;
            }
        }
        if constexpr (ALIGN_EPI) { if (wr == 0) PG8_BAR; }
        if constexpr (!Epi::AFTER_DRAIN) { E(acc, cur, wr, wc, fr, fq); S.done(cur); }
        if (!has_next) break;
#pragma unroll
        for (int a = 0; a < 2; ++a)
#pragma unroll
            for (int b = 0; b < 2; ++b)
#pragma unroll
                for (int m = 0; m < 4; ++m)
#pragma unroll
                    for (int n = 0; n < 2; ++n) acc[a][b][m][n] = (f32x4){0.f, 0.f, 0.f, 0.f};
        cur = nxt; cA = nA; cB = nB; ++ui;
        if constexpr (ALIGN_EPI) { if (wr == 1) PG8_BAR; }
    }
    PG8_WAIT_V(0);
    if constexpr (!ALIGN_EPI) { if (wr == 0) PG8_BAR; }
    PG8_BAR;
    if constexpr (Epi::AFTER_DRAIN) { E.fused(acc, cur, wr, wc, fr, fq, lds, wid, lane); S.done(cur); }
#undef PG8_SA
#undef PG8_SB
#undef PG8_STAGE
#undef PG8_LDA
#undef PG8_LDB
#undef PG8_MMA
#undef PG8_WAIT_V
#undef PG8_WAIT_L
#undef PG8_BAR
#undef PG8_SCHED
}
}
namespace attn_body {
using bf16=__hip_bfloat16;
using bf16x8=__attribute__((ext_vector_type(8)))short;
using s16x4=__attribute__((ext_vector_type(4)))short;
using f32x16=__attribute__((ext_vector_type(16)))float;
using u32x4=__attribute__((ext_vector_type(4)))unsigned;
constexpr int BATCH=4,NHEAD=16,SEQ=8192,D=64,DM=NHEAD*D;
constexpr int NW=8,QBLK=32,QB=QBLK*NW,KVBLK=64,NQB=SEQ/QB;
constexpr int ATTN_PITCH=DM, ATTN_UNIT_ROWS=QB;
__device__ __forceinline__ int crow(int r,int hi){return (r&3)+8*(r>>2)+4*hi;}
#define SBAR() __builtin_amdgcn_sched_barrier(0)
__device__ __forceinline__ void cmask(f32x16&p0,f32x16&p1,int jb,int qrel,int hi){
  const float NEG=-INFINITY; (void)hi;
  if(jb>(qrel>>6)){
  #pragma unroll
  for(int r=0;r<16;++r){p0[r]=NEG;p1[r]=NEG;} }
}

constexpr int NSLOT=3, SLOTB=8192;
constexpr int LDS_K=0, LDS_V=NSLOT*SLOTB, LDS_WS=2*NSLOT*SLOTB, LDS_OST=LDS_WS+NW*64*4, LDS_BYTES=LDS_OST+NW*4096;
constexpr float C2=0.125f*1.4426950408889634f;
__device__ __forceinline__ void glds16(const void*gsrc,unsigned lds_dst){unsigned keep;
  asm volatile("s_mov_b32 %0, m0\n\ts_mov_b32 m0, %2\n\ts_nop 0\n\tglobal_load_lds_dwordx4 %1, off\n\ts_mov_b32 m0, %0":"=&s"(keep):"v"(gsrc),"s"(lds_dst):"memory");}
__device__ __forceinline__ float max3f(float a,float b,float c){float r;asm("v_max3_f32 %0, %1, %2, %3":"=v"(r):"v"(a),"v"(b),"v"(c));return r;}
__device__ __forceinline__ float max2f(float a,float b){float r;asm("v_max_f32_e32 %0, %1, %2":"=v"(r):"v"(a),"v"(b));return r;}
__device__ __forceinline__ float fadd_s(float a,float b){float r;asm("v_add_f32_e32 %0, %1, %2":"=v"(r):"v"(a),"v"(b));return r;}
__device__ __forceinline__ float fsub_s(float a,float b){float r;asm("v_sub_f32_e32 %0, %1, %2":"=v"(r):"v"(a),"v"(b));return r;}
typedef float f32x2_t __attribute__((ext_vector_type(2))); typedef __bf16 bf16x2_t __attribute__((ext_vector_type(2)));
__device__ __forceinline__ unsigned cvtpk_s(float lo,float hi){f32x2_t v={lo,hi};bf16x2_t b=__builtin_convertvector(v,bf16x2_t);return __builtin_bit_cast(unsigned,b);}
#define WAIT_BAR(N) asm volatile("s_waitcnt vmcnt(" #N ") lgkmcnt(0)\n\ts_barrier":::"memory")

__device__ __forceinline__ void qkt(f32x16&p0,f32x16&p1,const char*Kslot,const bf16x8*qr,const f32x16&negm,int r32,int hi){
  const char*kb=Kslot+hi*1024+r32*16;
  #pragma unroll
  for(int d0=0;d0<4;++d0){
    const bf16x8 b0=*reinterpret_cast<const bf16x8*>(kb+d0*2048);
    const bf16x8 b1=*reinterpret_cast<const bf16x8*>(kb+d0*2048+512);
    if(d0==0){p0=__builtin_amdgcn_mfma_f32_32x32x16_bf16(b0,qr[0],negm,0,0,0);p1=__builtin_amdgcn_mfma_f32_32x32x16_bf16(b1,qr[0],negm,0,0,0);}
    else{p0=__builtin_amdgcn_mfma_f32_32x32x16_bf16(b0,qr[d0],p0,0,0,0);p1=__builtin_amdgcn_mfma_f32_32x32x16_bf16(b1,qr[d0],p1,0,0,0);}}
}
typedef __attribute__((address_space(3))) const char* lds_cptr;
typedef short v4i16_t __attribute__((ext_vector_type(4)));
__device__ __forceinline__ void kload8(bf16x8*kf,lds_cptr kp){
  kf[0]=*(const __attribute__((address_space(3))) bf16x8*)(kp);      kf[1]=*(const __attribute__((address_space(3))) bf16x8*)(kp+512);
  kf[2]=*(const __attribute__((address_space(3))) bf16x8*)(kp+2048); kf[3]=*(const __attribute__((address_space(3))) bf16x8*)(kp+2560);
  kf[4]=*(const __attribute__((address_space(3))) bf16x8*)(kp+4096); kf[5]=*(const __attribute__((address_space(3))) bf16x8*)(kp+4608);
  kf[6]=*(const __attribute__((address_space(3))) bf16x8*)(kp+6144); kf[7]=*(const __attribute__((address_space(3))) bf16x8*)(kp+6656);
}
__device__ __forceinline__ void kload2(bf16x8*kf,lds_cptr kp,int j){ kf[2*j]=*(const __attribute__((address_space(3))) bf16x8*)(kp+j*2048); kf[2*j+1]=*(const __attribute__((address_space(3))) bf16x8*)(kp+j*2048+512); }
__device__ __forceinline__ s16x4 vtr(lds_cptr p){ return __builtin_bit_cast(s16x4,__builtin_amdgcn_ds_read_tr16_b64_v4i16((__attribute__((address_space(3))) v4i16_t*)p)); }
__device__ __forceinline__ float rowmax(const f32x16&p0,const f32x16&p1){
  float a=max3f(p0[0],p0[1],p1[0]),b=max3f(p0[2],p0[3],p1[1]);a=max3f(a,p1[2],p1[3]);
  #pragma unroll
  for(int r=4;r<16;r+=4){a=max3f(a,p0[r],p0[r+1]);b=max3f(b,p0[r+2],p0[r+3]);a=max3f(a,p1[r],p1[r+1]);b=max3f(b,p1[r+2],p1[r+3]);}
  const float m=max2f(a,b);
  auto rr=__builtin_amdgcn_permlane32_swap(__float_as_uint(m),__float_as_uint(m),false,false);
  return max2f(__uint_as_float(rr[0]),__uint_as_float(rr[1]));
}
__device__ __forceinline__ void pv(f32x16*o,int vb,bf16x8 pa0,bf16x8 pa1,bf16x8 pa2,bf16x8 pa3){
  #pragma unroll
  for(int d0=0;d0<2;++d0){s16x4 lo[4],hi[4];
    #pragma unroll
    for(int ks=0;ks<4;++ks){
      asm volatile("ds_read_b64_tr_b16 %0,%1 offset:%c2":"=&v"(lo[ks]):"v"(vb),"i"(d0*4096+ks*1024):"memory");
      asm volatile("ds_read_b64_tr_b16 %0,%1 offset:%c2":"=&v"(hi[ks]):"v"(vb),"i"(d0*4096+ks*1024+512):"memory");}
    asm volatile("s_waitcnt lgkmcnt(0)":::"memory");SBAR();
    #define PK(k) (bf16x8){lo[k][0],lo[k][1],lo[k][2],lo[k][3],hi[k][0],hi[k][1],hi[k][2],hi[k][3]}
    o[d0]=__builtin_amdgcn_mfma_f32_32x32x16_bf16(pa0,PK(0),o[d0],0,0,0);
    o[d0]=__builtin_amdgcn_mfma_f32_32x32x16_bf16(pa1,PK(1),o[d0],0,0,0);
    o[d0]=__builtin_amdgcn_mfma_f32_32x32x16_bf16(pa2,PK(2),o[d0],0,0,0);
    o[d0]=__builtin_amdgcn_mfma_f32_32x32x16_bf16(pa3,PK(3),o[d0],0,0,0);
    #undef PK
  }
}

#ifndef ATTN_STORE16
#define ATTN_STORE16(p,v) (*(u32x4*)(p)=(v))
#endif
template<int THRL> __device__ __forceinline__ void attn_unit(int b,int hq,int hv,int qb,const bf16*Q,const bf16*__restrict__ K,const bf16*__restrict__ V,bf16*O,char*shm){
  const int tid=opaque_tid(),lane=tid&63,r32=lane&31,hi=lane>>5; const int wid=__builtin_amdgcn_readfirstlane(tid>>6);
  const long rowbase=(long)b*SEQ; const int q0=qb*QB;
  const bf16*Qw=Q+(rowbase+q0+wid*QBLK)*DM+hq*D;
  const bf16*Kh=K+rowbase*DM+hq*D,*Vh=V+rowbase*DM+hv*D;
  const unsigned lds0=(unsigned)(uintptr_t)shm;
  float*wsf=(float*)(shm+LDS_WS)+wid*64;
  const bf16*ksrc=Kh+(long)lane*DM+wid*8;
  const bf16*vsrc=Vh+(long)(16*(wid&3)+(lane>>2))*DM+(wid>>2)*32+(lane&3)*8;
  const unsigned kdst=lds0+LDS_K+wid*1024, vdst=lds0+LDS_V+wid*1024;
  #define DMA_K(t,slot) glds16(ksrc+(long)(t)*KVBLK*DM,(unsigned)__builtin_amdgcn_readfirstlane(kdst+(slot)))
  #define DMA_V(t,slot) glds16(vsrc+(long)(t)*KVBLK*DM,(unsigned)__builtin_amdgcn_readfirstlane(vdst+(slot)))
  const int vb0=(int)(lds0+LDS_V)+((lane>>4)&1)*32+(lane&3)*8+(4*hi+((lane&15)>>2))*64;
  const char*Kbase=shm+LDS_K; bf16x8 kf[8];
  const lds_cptr shm3=(lds_cptr)shm; const lds_cptr kp0=shm3+LDS_K+hi*1024+r32*16; const lds_cptr vp0=shm3+LDS_V+((lane>>4)&1)*32+(lane&3)*8+(4*hi+((lane&15)>>2))*64;
  const int NT=(q0+QB)/KVBLK;
  DMA_K(0,0);DMA_V(0,0);DMA_K(1,SLOTB);
  bf16x8 qr[4];
  #pragma unroll
  for(int d0=0;d0<4;++d0)qr[d0]=*reinterpret_cast<const bf16x8*>(&Qw[(long)r32*DM+d0*16+hi*8]);
  float mhat=0.f,l_reg=0.f;f32x16 o[2];o[0]=f32x16{};o[1]=f32x16{};f32x16 negm=f32x16{};asm volatile("":"+v"(negm));
  const int qrel=wid*QBLK+r32;
  #define CMASK(P0,P1,t) do{int jb_=(t)-(NT-4); if(jb_>=0)cmask(P0,P1,jb_,qrel,hi);}while(0)
  bool resc=false;
  #define START(P0,P1) do{ const float rm=rowmax(P0,P1); resc=false; \
    { const float dl=rm; mhat=fadd_s(mhat,dl); \
      _Pragma("unroll") for(int r=0;r<16;++r){P0[r]=fsub_s(P0[r],dl);P1[r]=fsub_s(P1[r],dl);} \
      _Pragma("unroll") for(int r=0;r<16;++r)negm[r]=-mhat; asm volatile("":"+v"(negm)); } \
    _Pragma("unroll") for(int r=0;r<16;++r)P0[r]=__builtin_amdgcn_exp2f(P0[r]); }while(0)
  #define RESC() do{ if(resc){ asm volatile("s_waitcnt lgkmcnt(0)":::"memory"); \
      _Pragma("unroll") for(int d_=0;d_<2;++d_) _Pragma("unroll") for(int r=0;r<16;++r)o[d_][r]*=wsf[crow(r,hi)]; } }while(0)
  f32x16 pA0,pA1,pB0,pB1;
  int sl_prev=0,sl_cur=0,sl_next=SLOTB;
  #define ROT() do{sl_prev=sl_cur;sl_cur=sl_next;sl_next=(sl_next==(NSLOT-1)*SLOTB)?0:sl_next+SLOTB;}while(0)
  DMA_K(2,2*SLOTB);
  WAIT_BAR(3);
  qkt(pA0,pA1,Kbase,qr,negm,r32,hi);asm volatile("s_nop 15\n\ts_nop 7":"+v"(pA0),"+v"(pA1));CMASK(pA0,pA1,0);
  START(pA0,pA1);
  _Pragma("unroll") for(int r=0;r<16;++r)pA1[r]=__builtin_amdgcn_exp2f(pA1[r]);
  WAIT_BAR(0);
  DMA_K(3,0);DMA_V(1,SLOTB);
  ROT();
  kload8(kf,kp0+sl_cur);
  WAIT_BAR(2);
  s16x4 vlo[8],vhi[8]; u32x4 pw0,pw1,pw2,pw3;
  #define PKW(P,B) cvtpk_s(P[B],P[B+1])
  #define PAF(k) __builtin_bit_cast(bf16x8,pw##k)
  #define VFR(i) (bf16x8){vlo[i][0],vlo[i][1],vlo[i][2],vlo[i][3],vhi[i][0],vhi[i][1],vhi[i][2],vhi[i][3]}
  #define PIN(x) asm volatile("":"+v"(x))
  #define MX3(a,b,c) __builtin_fmaxf(__builtin_fmaxf((a),(b)),(c))
  #define GAPA(MF,A0,A1,A2,A3,W0,W1,PW) do{ MF; sacc+=A0; sacc+=A1; sacc+=A2; sacc+=A3; PIN(sacc); W0; W1; PIN(PW); SBAR(); }while(0)
  #define EX(v) __builtin_amdgcn_exp2f(v)
  #define GAPB(MF,X,B) do{ MF; X[B]=EX(X[B]); X[B+1]=EX(X[B+1]); X[B+2]=EX(X[B+2]); X[B+3]=EX(X[B+3]); PIN(X); SBAR(); }while(0)
  #define VRD(i) do{ vlo[i]=vtr(vp_+(((i)>>2)*4096+((i)&3)*1024)); vhi[i]=vtr(vp_+(((i)>>2)*4096+((i)&3)*1024+512)); }while(0)
  #define KRD(G,j) do{ if(G){ kload2(kf,kp0+sl_next,j); SBAR(); } }while(0)
  #define STEP(C0,C1,P0,P1,t,GK,GV,GL) do{ SBAR(); \
    const lds_cptr vp_=vp0+sl_prev; \
    VRD(0); SBAR(); float sacc=(P0[0]+P0[1]); \
    GAPA(C0=__builtin_amdgcn_mfma_f32_32x32x16_bf16(kf[0],qr[0],negm,0,0,0), P0[2],P0[3],P0[4],P0[5],     pw0[0]=PKW(P0,0), pw0[1]=PKW(P0,2), pw0); \
    VRD(4); SBAR(); GAPA(C1=__builtin_amdgcn_mfma_f32_32x32x16_bf16(kf[1],qr[0],negm,0,0,0), P0[6],P0[7],P0[8],P0[9],     pw0[2]=PKW(P0,4), pw0[3]=PKW(P0,6), pw0); \
    VRD(1); SBAR(); GAPA(C0=__builtin_amdgcn_mfma_f32_32x32x16_bf16(kf[2],qr[1],C0,0,0,0),   P0[10],P0[11],P0[12],P0[13], pw1[0]=PKW(P0,8), pw1[1]=PKW(P0,10), pw1); \
    VRD(5); SBAR(); GAPA(C1=__builtin_amdgcn_mfma_f32_32x32x16_bf16(kf[3],qr[1],C1,0,0,0),   P0[14],P0[15],P1[0],P1[1],   pw1[2]=PKW(P0,12),pw1[3]=PKW(P0,14), pw1); \
    VRD(2); SBAR(); GAPA(C0=__builtin_amdgcn_mfma_f32_32x32x16_bf16(kf[4],qr[2],C0,0,0,0),   P1[2],P1[3],P1[4],P1[5],     pw2[0]=PKW(P1,0), pw2[1]=PKW(P1,2), pw2); \
    VRD(6); SBAR(); GAPA(C1=__builtin_amdgcn_mfma_f32_32x32x16_bf16(kf[5],qr[2],C1,0,0,0),   P1[6],P1[7],P1[8],P1[9],     pw2[2]=PKW(P1,4), pw2[3]=PKW(P1,6), pw2); \
    VRD(3); SBAR(); GAPA(C0=__builtin_amdgcn_mfma_f32_32x32x16_bf16(kf[6],qr[3],C0,0,0,0),   P1[10],P1[11],P1[12],P1[13], pw3[0]=PKW(P1,8), pw3[1]=PKW(P1,10), pw3); \
    VRD(7); SBAR(); GAPA(C1=__builtin_amdgcn_mfma_f32_32x32x16_bf16(kf[7],qr[3],C1,0,0,0),   P1[14],P1[15],0.f,0.f,       pw3[2]=PKW(P1,12),pw3[3]=PKW(P1,14), pw3); \
    l_reg+=sacc; \
    if(GK){DMA_K((t)+3,sl_cur);} if(GV){DMA_V((t)+1,sl_next);} \
    CMASK(C0,C1,t); \
    { float a=MX3(C0[0],C0[1],C1[0]),b=MX3(C0[2],C0[3],C1[1]); a=MX3(a,C1[2],C1[3]); \
      _Pragma("unroll") for(int r=4;r<16;r+=4){a=MX3(a,C0[r],C0[r+1]);b=MX3(b,C0[r+2],C0[r+3]);a=MX3(a,C1[r],C1[r+1]);b=MX3(b,C1[r+2],C1[r+3]);} \
      float rm=__builtin_fmaxf(a,b); { auto rr=__builtin_amdgcn_permlane32_swap(__float_as_uint(rm),__float_as_uint(rm),false,false); rm=__builtin_fmaxf(__uint_as_float(rr[0]),__uint_as_float(rr[1])); } \
      resc=false; \
      if(__builtin_expect(__any(rm>(float)THRL),0)){ const float dl=__builtin_fmaxf(rm,0.f); mhat+=dl; \
        _Pragma("unroll") for(int r=0;r<16;++r){C0[r]-=dl;C1[r]-=dl;} \
        _Pragma("unroll") for(int r=0;r<16;++r)negm[r]=-mhat; asm volatile("":"+v"(negm)); \
        const float f=__builtin_amdgcn_exp2f(-dl); l_reg*=f; if(hi==0)wsf[r32]=f; resc=true; } } \
    SBAR(); \
    GAPB(o[0]=__builtin_amdgcn_mfma_f32_32x32x16_bf16(PAF(0),VFR(0),o[0],0,0,0), C0,0); \
    GAPB(o[1]=__builtin_amdgcn_mfma_f32_32x32x16_bf16(PAF(0),VFR(4),o[1],0,0,0), C0,4); \
    KRD(GL,0); GAPB(o[0]=__builtin_amdgcn_mfma_f32_32x32x16_bf16(PAF(1),VFR(1),o[0],0,0,0), C0,8); \
    KRD(GL,1); GAPB(o[1]=__builtin_amdgcn_mfma_f32_32x32x16_bf16(PAF(1),VFR(5),o[1],0,0,0), C0,12); \
    KRD(GL,2); GAPB(o[0]=__builtin_amdgcn_mfma_f32_32x32x16_bf16(PAF(2),VFR(2),o[0],0,0,0), C1,0); \
    KRD(GL,3); GAPB(o[1]=__builtin_amdgcn_mfma_f32_32x32x16_bf16(PAF(2),VFR(6),o[1],0,0,0), C1,4); \
    GAPB(o[0]=__builtin_amdgcn_mfma_f32_32x32x16_bf16(PAF(3),VFR(3),o[0],0,0,0), C1,8); \
    GAPB(o[1]=__builtin_amdgcn_mfma_f32_32x32x16_bf16(PAF(3),VFR(7),o[1],0,0,0), C1,12); \
    }while(0)
  int t=1;
  #undef CMASK
  #define CMASK(P0,P1,t) do{}while(0)
  for(;t+5<NT;t+=2){
    STEP(pB0,pB1,pA0,pA1,t,true,true,true);     WAIT_BAR(2); RESC(); ROT();
    STEP(pA0,pA1,pB0,pB1,t+1,true,true,true);   WAIT_BAR(2); RESC(); ROT();
  }
  #undef CMASK
  #define CMASK(P0,P1,t) do{int jb_=(t)-(NT-4); if(jb_>=0)cmask(P0,P1,jb_,qrel,hi);}while(0)
  #define ENDW(tt) do{ if((tt)+3<NT){WAIT_BAR(2);} else if((tt)+2<NT){WAIT_BAR(1);} else {WAIT_BAR(0);} }while(0)
  for(;t+1<NT;t+=2){
    STEP(pB0,pB1,pA0,pA1,t,(t+3<NT),(t+1<NT),(t+1<NT));       ENDW(t);   RESC(); ROT();
    STEP(pA0,pA1,pB0,pB1,t+1,(t+4<NT),(t+2<NT),(t+2<NT));     ENDW(t+1); RESC(); ROT();
  }
  STEP(pB0,pB1,pA0,pA1,NT-1,false,false,false); RESC();
  { float sacc=pB0[0]+pB0[1]; _Pragma("unroll") for(int r=2;r<16;++r)sacc+=pB0[r]; _Pragma("unroll") for(int r=0;r<16;++r)sacc+=pB1[r]; l_reg+=sacc;
    pw0=(u32x4){PKW(pB0,0),PKW(pB0,2),PKW(pB0,4),PKW(pB0,6)};pw1=(u32x4){PKW(pB0,8),PKW(pB0,10),PKW(pB0,12),PKW(pB0,14)};pw2=(u32x4){PKW(pB1,0),PKW(pB1,2),PKW(pB1,4),PKW(pB1,6)};pw3=(u32x4){PKW(pB1,8),PKW(pB1,10),PKW(pB1,12),PKW(pB1,14)};
    SBAR(); pv(o,vb0+sl_cur,PAF(0),PAF(1),PAF(2),PAF(3)); }
  #undef PKW
  #undef PAF
  #undef VFR
  #undef PIN
  #undef MX3
  #undef GAPA
  #undef GAPB
  #undef EX
  #undef VRD
  #undef KRD
  #undef STEP
  #undef ENDW
  {auto rr=__builtin_amdgcn_permlane32_swap(__float_as_uint(l_reg),__float_as_uint(l_reg),false,false);l_reg=__uint_as_float(rr[0])+__uint_as_float(rr[1]);}
  if(hi==0)wsf[32+r32]=l_reg;asm volatile("s_waitcnt lgkmcnt(0)":::"memory");
  float rli[16];
  #pragma unroll
  for(int r=0;r<16;++r)rli[r]=__builtin_amdgcn_rcpf(wsf[32+crow(r,hi)]);
  bf16*Ow=O+(rowbase+q0+wid*QBLK)*DM+hv*D;
  { bf16*stg=(bf16*)(shm+LDS_OST)+wid*2048;
    #pragma unroll
    for(int r=0;r<16;++r){const int orow=crow(r,hi);
      #pragma unroll
      for(int d0=0;d0<2;++d0)stg[orow*64+d0*32+r32]=__float2bfloat16(o[d0][r]*rli[r]);}
    asm volatile("s_waitcnt lgkmcnt(0)":::"memory");
    #pragma unroll
    for(int i=0;i<4;++i){const int row=i*8+(lane>>3),ch=lane&7; const u32x4 v=*(const u32x4*)(stg+row*64+ch*8); ATTN_STORE16(Ow+(long)row*DM+ch*8,v);} }
  asm volatile("s_waitcnt lgkmcnt(0)\n\ts_barrier":::"memory");
  #undef DMA_K
  #undef DMA_V
  #undef CMASK
  #undef START
  #undef RESC
  #undef ROT
}
__device__ __forceinline__ void pv128(f32x16*o,int vb,bf16x8 pa0,bf16x8 pa1,bf16x8 pa2,bf16x8 pa3){
  #pragma unroll
  for(int d0=0;d0<4;++d0){s16x4 lo[4],hi[4];
    #pragma unroll
    for(int ks=0;ks<4;++ks){
      asm volatile("ds_read_b64_tr_b16 %0,%1 offset:%c2":"=&v"(lo[ks]):"v"(vb),"i"(d0*4096+ks*1024):"memory");
      asm volatile("ds_read_b64_tr_b16 %0,%1 offset:%c2":"=&v"(hi[ks]):"v"(vb),"i"(d0*4096+ks*1024+512):"memory");}
    asm volatile("s_waitcnt lgkmcnt(0)":::"memory");SBAR();
    #define PK(k) (bf16x8){lo[k][0],lo[k][1],lo[k][2],lo[k][3],hi[k][0],hi[k][1],hi[k][2],hi[k][3]}
    o[d0]=__builtin_amdgcn_mfma_f32_32x32x16_bf16(pa0,PK(0),o[d0],0,0,0);
    o[d0]=__builtin_amdgcn_mfma_f32_32x32x16_bf16(pa1,PK(1),o[d0],0,0,0);
    o[d0]=__builtin_amdgcn_mfma_f32_32x32x16_bf16(pa2,PK(2),o[d0],0,0,0);
    o[d0]=__builtin_amdgcn_mfma_f32_32x32x16_bf16(pa3,PK(3),o[d0],0,0,0);
    #undef PK
  }
}
constexpr int SLOTV=16384, LDS_V2=NSLOT*SLOTB, LDS_WS2=LDS_V2+NSLOT*SLOTV, LDS_OST2=LDS_WS2+NW*64*4, LDS_BYTES2=LDS_OST2+NW*4096;
template<int THRL> __device__ __forceinline__ void attn_unit128(int b,int hq,int hv,int qb,const bf16*Q,const bf16*__restrict__ K,const bf16*__restrict__ V,bf16*O,char*shm){
  const int tid=opaque_tid(),lane=tid&63,r32=lane&31,hi=lane>>5; const int wid=__builtin_amdgcn_readfirstlane(tid>>6);
  const long rowbase=(long)b*SEQ; const int q0=qb*QB;
  const bf16*Qw=Q+(rowbase+q0+wid*QBLK)*DM+hq*D;
  const bf16*Kh=K+rowbase*DM+hq*D,*Vh=V+rowbase*DM+hv*D;
  const unsigned lds0=(unsigned)(uintptr_t)shm;
  float*wsf=(float*)(shm+LDS_WS2)+wid*64;
  const bf16*ksrc=Kh+(long)lane*DM+wid*8;
  const bf16*vsrc=Vh+(long)(16*(wid&3)+(lane>>2))*DM+(wid>>2)*32+(lane&3)*8;
  const unsigned kdst=lds0+LDS_K+wid*1024, vdst=lds0+LDS_V2+wid*1024;
  #define DMA_K(t,slot) glds16(ksrc+(long)(t)*KVBLK*DM,(unsigned)__builtin_amdgcn_readfirstlane(kdst+(slot)))
  #define DMA_V(t,slot) do{ glds16(vsrc+(long)(t)*KVBLK*DM,(unsigned)__builtin_amdgcn_readfirstlane(vdst+2*(slot))); glds16(vsrc+64+(long)(t)*KVBLK*DM,(unsigned)__builtin_amdgcn_readfirstlane(vdst+8192+2*(slot))); }while(0)
  const int vb0=(int)(lds0+LDS_V2)+((lane>>4)&1)*32+(lane&3)*8+(4*hi+((lane&15)>>2))*64;
  const char*Kbase=shm+LDS_K; bf16x8 kf[8];
  const lds_cptr shm3=(lds_cptr)shm; const lds_cptr kp0=shm3+LDS_K+hi*1024+r32*16; const lds_cptr vp0=shm3+LDS_V2+((lane>>4)&1)*32+(lane&3)*8+(4*hi+((lane&15)>>2))*64;
  const int NT=(q0+QB)/KVBLK;
  DMA_K(0,0);DMA_V(0,0);DMA_K(1,SLOTB);
  bf16x8 qr[4];
  #pragma unroll
  for(int d0=0;d0<4;++d0)qr[d0]=*reinterpret_cast<const bf16x8*>(&Qw[(long)r32*DM+d0*16+hi*8]);
  float mhat=0.f,l_reg=0.f;f32x16 o[4];o[0]=f32x16{};o[1]=f32x16{};o[2]=f32x16{};o[3]=f32x16{};const f32x16 zc=f32x16{};
  const int qrel=wid*QBLK+r32;
  #define CMASK(P0,P1,t) do{int jb_=(t)-(NT-4); if(jb_>=0)cmask(P0,P1,jb_,qrel,hi);}while(0)
  bool resc=false;
  #define START(P0,P1) do{ const float rm=rowmax(P0,P1); resc=false; \
    { const float dl=rm; mhat=fadd_s(mhat,dl); \
      _Pragma("unroll") for(int r=0;r<16;++r){P0[r]=fsub_s(P0[r],dl);P1[r]=fsub_s(P1[r],dl);} \
      } \
    _Pragma("unroll") for(int r=0;r<16;++r)P0[r]=__builtin_amdgcn_exp2f(P0[r]); }while(0)
  #define RESC() do{ if(resc){ asm volatile("s_waitcnt lgkmcnt(0)":::"memory"); \
      _Pragma("unroll") for(int d_=0;d_<4;++d_) _Pragma("unroll") for(int r=0;r<16;++r)o[d_][r]*=wsf[crow(r,hi)]; } }while(0)
  f32x16 pA0,pA1,pB0,pB1;
  int sl_prev=0,sl_cur=0,sl_next=SLOTB;
  #define ROT() do{sl_prev=sl_cur;sl_cur=sl_next;sl_next=(sl_next==(NSLOT-1)*SLOTB)?0:sl_next+SLOTB;}while(0)
  DMA_K(2,2*SLOTB);
  WAIT_BAR(3);
  qkt(pA0,pA1,Kbase,qr,zc,r32,hi);asm volatile("s_nop 15\n\ts_nop 7":"+v"(pA0),"+v"(pA1));CMASK(pA0,pA1,0);
  START(pA0,pA1);
  _Pragma("unroll") for(int r=0;r<16;++r)pA1[r]=__builtin_amdgcn_exp2f(pA1[r]);
  WAIT_BAR(0);
  DMA_K(3,0);DMA_V(1,SLOTB);
  ROT();
  kload8(kf,kp0+sl_cur);
  WAIT_BAR(3);
  s16x4 vlo[8],vhi[8]; u32x4 pw0,pw1,pw2,pw3;
  #define PKW(P,B) cvtpk_s(P[B],P[B+1])
  #define PAF(k) __builtin_bit_cast(bf16x8,pw##k)
  #define VFR(i) (bf16x8){vlo[i][0],vlo[i][1],vlo[i][2],vlo[i][3],vhi[i][0],vhi[i][1],vhi[i][2],vhi[i][3]}
  #define PIN(x) asm volatile("":"+v"(x))
  #define MX3(a,b,c) __builtin_fmaxf(__builtin_fmaxf((a),(b)),(c))
  #define GAPA(MF,A0,A1,A2,A3,W0,W1,PW) do{ MF; sacc+=A0; sacc+=A1; sacc+=A2; sacc+=A3; PIN(sacc); W0; W1; PIN(PW); SBAR(); }while(0)
  #define EX(v) __builtin_amdgcn_exp2f(v)
  #define GAPB(MF,X,B) do{ MF; X[B]=EX(X[B]); X[B+1]=EX(X[B+1]); X[B+2]=EX(X[B+2]); X[B+3]=EX(X[B+3]); PIN(X); SBAR(); }while(0)
  #define VRD(i) do{ vlo[i]=vtr(vp_+(((i)>>2)*4096+((i)&3)*1024)); vhi[i]=vtr(vp_+(((i)>>2)*4096+((i)&3)*1024+512)); }while(0)
  #define VRX(i) do{ vlo[i]=vtr(vp_+((((i)>>2)+2)*4096+((i)&3)*1024)); vhi[i]=vtr(vp_+((((i)>>2)+2)*4096+((i)&3)*1024+512)); SBAR(); }while(0)
  #define GAPB2(MF,X,B) do{ MF; X[B]=EX(X[B]-mhat); X[B+1]=EX(X[B+1]-mhat); PIN(X); SBAR(); }while(0)
  #define KRD(G,j) do{ if(G){ kload2(kf,kp0+sl_next,j); SBAR(); } }while(0)
  #define STEP(C0,C1,P0,P1,t,GK,GV,GL) do{ SBAR(); \
    const lds_cptr vp_=vp0+2*sl_prev; \
    VRD(0); SBAR(); float sacc=(P0[0]+P0[1]); \
    GAPA(C0=__builtin_amdgcn_mfma_f32_32x32x16_bf16(kf[0],qr[0],zc,0,0,0), P0[2],P0[3],P0[4],P0[5],     pw0[0]=PKW(P0,0), pw0[1]=PKW(P0,2), pw0); \
    VRD(4); SBAR(); GAPA(C1=__builtin_amdgcn_mfma_f32_32x32x16_bf16(kf[1],qr[0],zc,0,0,0), P0[6],P0[7],P0[8],P0[9],     pw0[2]=PKW(P0,4), pw0[3]=PKW(P0,6), pw0); \
    VRD(1); SBAR(); GAPA(C0=__builtin_amdgcn_mfma_f32_32x32x16_bf16(kf[2],qr[1],C0,0,0,0),   P0[10],P0[11],P0[12],P0[13], pw1[0]=PKW(P0,8), pw1[1]=PKW(P0,10), pw1); \
    VRD(5); SBAR(); GAPA(C1=__builtin_amdgcn_mfma_f32_32x32x16_bf16(kf[3],qr[1],C1,0,0,0),   P0[14],P0[15],P1[0],P1[1],   pw1[2]=PKW(P0,12),pw1[3]=PKW(P0,14), pw1); \
    VRD(2); SBAR(); GAPA(C0=__builtin_amdgcn_mfma_f32_32x32x16_bf16(kf[4],qr[2],C0,0,0,0),   P1[2],P1[3],P1[4],P1[5],     pw2[0]=PKW(P1,0), pw2[1]=PKW(P1,2), pw2); \
    VRD(6); SBAR(); GAPA(C1=__builtin_amdgcn_mfma_f32_32x32x16_bf16(kf[5],qr[2],C1,0,0,0),   P1[6],P1[7],P1[8],P1[9],     pw2[2]=PKW(P1,4), pw2[3]=PKW(P1,6), pw2); \
    VRD(3); SBAR(); GAPA(C0=__builtin_amdgcn_mfma_f32_32x32x16_bf16(kf[6],qr[3],C0,0,0,0),   P1[10],P1[11],P1[12],P1[13], pw3[0]=PKW(P1,8), pw3[1]=PKW(P1,10), pw3); \
    VRD(7); SBAR(); GAPA(C1=__builtin_amdgcn_mfma_f32_32x32x16_bf16(kf[7],qr[3],C1,0,0,0),   P1[14],P1[15],0.f,0.f,       pw3[2]=PKW(P1,12),pw3[3]=PKW(P1,14), pw3); \
    l_reg+=sacc; \
    if(GK){DMA_K((t)+3,sl_cur);} if(GV){DMA_V((t)+1,sl_next);} \
    CMASK(C0,C1,t); \
    { float a=MX3(C0[0],C0[1],C1[0]),b=MX3(C0[2],C0[3],C1[1]); a=MX3(a,C1[2],C1[3]); \
      _Pragma("unroll") for(int r=4;r<16;r+=4){a=MX3(a,C0[r],C0[r+1]);b=MX3(b,C0[r+2],C0[r+3]);a=MX3(a,C1[r],C1[r+1]);b=MX3(b,C1[r+2],C1[r+3]);} \
      float rm=__builtin_fmaxf(a,b); { auto rr=__builtin_amdgcn_permlane32_swap(__float_as_uint(rm),__float_as_uint(rm),false,false); rm=__builtin_fmaxf(__uint_as_float(rr[0]),__uint_as_float(rr[1])); } \
      rm-=mhat; resc=false; \
      if(__builtin_expect(__any(rm>(float)THRL),0)){ const float dl=__builtin_fmaxf(rm,0.f); mhat+=dl; \
        const float f=__builtin_amdgcn_exp2f(-dl); l_reg*=f; if(hi==0)wsf[r32]=f; resc=true; } } \
    SBAR(); \
    GAPB2(o[0]=__builtin_amdgcn_mfma_f32_32x32x16_bf16(PAF(0),VFR(0),o[0],0,0,0), C0,0);  VRX(0); \
    GAPB2(o[1]=__builtin_amdgcn_mfma_f32_32x32x16_bf16(PAF(0),VFR(4),o[1],0,0,0), C0,2);  VRX(4); \
    KRD(GL,0); GAPB2(o[0]=__builtin_amdgcn_mfma_f32_32x32x16_bf16(PAF(1),VFR(1),o[0],0,0,0), C0,4);  VRX(1); \
    KRD(GL,1); GAPB2(o[1]=__builtin_amdgcn_mfma_f32_32x32x16_bf16(PAF(1),VFR(5),o[1],0,0,0), C0,6);  VRX(5); \
    KRD(GL,2); GAPB2(o[0]=__builtin_amdgcn_mfma_f32_32x32x16_bf16(PAF(2),VFR(2),o[0],0,0,0), C0,8);  VRX(2); \
    KRD(GL,3); GAPB2(o[1]=__builtin_amdgcn_mfma_f32_32x32x16_bf16(PAF(2),VFR(6),o[1],0,0,0), C0,10); VRX(6); \
    GAPB2(o[0]=__builtin_amdgcn_mfma_f32_32x32x16_bf16(PAF(3),VFR(3),o[0],0,0,0), C0,12); VRX(3); \
    GAPB2(o[1]=__builtin_amdgcn_mfma_f32_32x32x16_bf16(PAF(3),VFR(7),o[1],0,0,0), C0,14); VRX(7); \
    GAPB2(o[2]=__builtin_amdgcn_mfma_f32_32x32x16_bf16(PAF(0),VFR(0),o[2],0,0,0), C1,0); \
    GAPB2(o[3]=__builtin_amdgcn_mfma_f32_32x32x16_bf16(PAF(0),VFR(4),o[3],0,0,0), C1,2); \
    GAPB2(o[2]=__builtin_amdgcn_mfma_f32_32x32x16_bf16(PAF(1),VFR(1),o[2],0,0,0), C1,4); \
    GAPB2(o[3]=__builtin_amdgcn_mfma_f32_32x32x16_bf16(PAF(1),VFR(5),o[3],0,0,0), C1,6); \
    GAPB2(o[2]=__builtin_amdgcn_mfma_f32_32x32x16_bf16(PAF(2),VFR(2),o[2],0,0,0), C1,8); \
    GAPB2(o[3]=__builtin_amdgcn_mfma_f32_32x32x16_bf16(PAF(2),VFR(6),o[3],0,0,0), C1,10); \
    GAPB2(o[2]=__builtin_amdgcn_mfma_f32_32x32x16_bf16(PAF(3),VFR(3),o[2],0,0,0), C1,12); \
    GAPB2(o[3]=__builtin_amdgcn_mfma_f32_32x32x16_bf16(PAF(3),VFR(7),o[3],0,0,0), C1,14); \
    }while(0)
  int t=1;
  #undef CMASK
  #define CMASK(P0,P1,t) do{}while(0)
  for(;t+5<NT;t+=2){
    STEP(pB0,pB1,pA0,pA1,t,true,true,true);     WAIT_BAR(3); RESC(); ROT();
    STEP(pA0,pA1,pB0,pB1,t+1,true,true,true);   WAIT_BAR(3); RESC(); ROT();
  }
  #undef CMASK
  #define CMASK(P0,P1,t) do{int jb_=(t)-(NT-4); if(jb_>=0)cmask(P0,P1,jb_,qrel,hi);}while(0)
  #define ENDW(tt) do{ if((tt)+3<NT){WAIT_BAR(3);} else if((tt)+2<NT){WAIT_BAR(2);} else {WAIT_BAR(0);} }while(0)
  for(;t+1<NT;t+=2){
    STEP(pB0,pB1,pA0,pA1,t,(t+3<NT),(t+1<NT),(t+1<NT));       ENDW(t);   RESC(); ROT();
    STEP(pA0,pA1,pB0,pB1,t+1,(t+4<NT),(t+2<NT),(t+2<NT));     ENDW(t+1); RESC(); ROT();
  }
  STEP(pB0,pB1,pA0,pA1,NT-1,false,false,false); RESC();
  { float sacc=pB0[0]+pB0[1]; _Pragma("unroll") for(int r=2;r<16;++r)sacc+=pB0[r]; _Pragma("unroll") for(int r=0;r<16;++r)sacc+=pB1[r]; l_reg+=sacc;
    pw0=(u32x4){PKW(pB0,0),PKW(pB0,2),PKW(pB0,4),PKW(pB0,6)};pw1=(u32x4){PKW(pB0,8),PKW(pB0,10),PKW(pB0,12),PKW(pB0,14)};pw2=(u32x4){PKW(pB1,0),PKW(pB1,2),PKW(pB1,4),PKW(pB1,6)};pw3=(u32x4){PKW(pB1,8),PKW(pB1,10),PKW(pB1,12),PKW(pB1,14)};
    SBAR(); pv128(o,vb0+2*sl_cur,PAF(0),PAF(1),PAF(2),PAF(3)); }
  #undef PKW
  #undef PAF
  #undef VFR
  #undef PIN
  #undef MX3
  #undef GAPA
  #undef GAPB
  #undef EX
  #undef VRD
  #undef VRX
  #undef GAPB2
  #undef KRD
  #undef STEP
  #undef ENDW
  {auto rr=__builtin_amdgcn_permlane32_swap(__float_as_uint(l_reg),__float_as_uint(l_reg),false,false);l_reg=__uint_as_float(rr[0])+__uint_as_float(rr[1]);}
  if(hi==0)wsf[32+r32]=l_reg;asm volatile("s_waitcnt lgkmcnt(0)":::"memory");
  float rli[16];
  #pragma unroll
  for(int r=0;r<16;++r)rli[r]=__builtin_amdgcn_rcpf(wsf[32+crow(r,hi)]);
  bf16*Ow=O+(rowbase+q0+wid*QBLK)*DM+hv*D;
  { bf16*stg=(bf16*)(shm+LDS_OST2)+wid*2048;
    #pragma unroll
    for(int hp=0;hp<2;++hp){
      #pragma unroll
      for(int r=0;r<16;++r){const int orow=crow(r,hi);
        #pragma unroll
        for(int d0=0;d0<2;++d0)stg[orow*64+d0*32+r32]=__float2bfloat16(o[2*hp+d0][r]*rli[r]);}
      asm volatile("s_waitcnt lgkmcnt(0)":::"memory");
      #pragma unroll
      for(int i=0;i<4;++i){const int row=i*8+(lane>>3),ch=lane&7; const u32x4 v=*(const u32x4*)(stg+row*64+ch*8); ATTN_STORE16(Ow+(long)row*DM+hp*64+ch*8,v);}
      asm volatile("s_waitcnt lgkmcnt(0)":::"memory"); } }
  asm volatile("s_waitcnt lgkmcnt(0)\n\ts_barrier":::"memory");
  #undef DMA_K
  #undef DMA_V
  #undef CMASK
  #undef START
  #undef RESC
  #undef ROT
}
constexpr int ATTN_LDS_BYTES=LDS_BYTES;
#undef SBAR
#undef WAIT_BAR
}
#define GAS __attribute__((address_space(1)))
#define LAS __attribute__((address_space(3)))
typedef unsigned short bf16;
typedef unsigned v4u __attribute__((ext_vector_type(4)));
typedef float f32x4 __attribute__((ext_vector_type(4)));
typedef short bf16x8 __attribute__((ext_vector_type(8)));
typedef GAS unsigned gu32;
typedef GAS unsigned long long gu64;
#define RLX_AGENT __ATOMIC_RELAXED, __HIP_MEMORY_SCOPE_AGENT
#define LDS_WAIT() asm volatile("s_waitcnt lgkmcnt(0)" ::: "memory")
#define VM_WAIT() asm volatile("s_waitcnt vmcnt(0)" ::: "memory")
__device__ __forceinline__ unsigned long long rt() { return __builtin_amdgcn_s_memrealtime(); }
__device__ __forceinline__ unsigned f2bf(float f) { unsigned u = __builtin_bit_cast(unsigned, f); return (u + 0x7fffu + ((u >> 16) & 1u)) >> 16; }
__device__ __forceinline__ unsigned pk2(float lo, float hi) { return f2bf(lo) | (f2bf(hi) << 16); }

#define XB_TMO      128
#define XB_XCNT(j)  (256  + 64 * (j))
#define XB_XSUB(j)  (1280 + 64 * (j))
#define XB_XGEN(j)  (2304 + 64 * (j))
#define XB_TOP      3328
#define XB_TOPGEN   3392
#define XCD_BAR_WORDS 3456
#define XB_SPIN_CAP (1u << 18)

__device__ __forceinline__ unsigned xb_ld(unsigned* p)              { return __hip_atomic_load(p, __ATOMIC_RELAXED, __HIP_MEMORY_SCOPE_AGENT); }
__device__ __forceinline__ unsigned xb_add(unsigned* p, unsigned v) { return __hip_atomic_fetch_add(p, v, __ATOMIC_RELAXED, __HIP_MEMORY_SCOPE_AGENT); }
__device__ __forceinline__ unsigned xb_xcc_id() { return (unsigned)__builtin_amdgcn_s_getreg((3 << 11) | 20) & 0xFu; }
#define XB_SPIN(cond, bar) do { unsigned _sp = 0; while (cond) { __builtin_amdgcn_s_sleep(1); \
    if ((++_sp & 255u) == 0u) { if (xb_ld(&(bar)[XB_TMO])) break; if (_sp > XB_SPIN_CAP) { atomicAdd(&(bar)[XB_TMO], 1u); break; } } } } while (0)

struct XcdBarrier {
    unsigned* bar; unsigned x;
    volatile LAS unsigned* st;
};

__device__ __forceinline__ XcdBarrier xcd_barrier_post(unsigned* bar, volatile LAS unsigned* st) {
    XcdBarrier b; b.bar = bar; b.x = xb_xcc_id(); b.st = st;
    if (threadIdx.x == 0) (void)xb_add(&bar[XB_XCNT(b.x)], 1u);
    return b;
}
__device__ __forceinline__ void xcd_barrier_complete(unsigned* bar, unsigned x, unsigned& nloc, unsigned& nx) {
    const unsigned G = gridDim.x * gridDim.y * gridDim.z;
    unsigned sum, cnt, mine, sp = 0u;
    for (;;) {
        sum = 0u; cnt = 0u;
#pragma unroll
        for (unsigned j = 0; j < 16; ++j) { const unsigned c = xb_ld(&bar[XB_XCNT(j)]); sum += c; cnt += (c > 0u) ? 1u : 0u; }
        if (sum == G) break;
        __builtin_amdgcn_s_sleep(1);
        if ((++sp & 255u) == 0u) { if (xb_ld(&bar[XB_TMO])) break; if (sp > XB_SPIN_CAP) { atomicAdd(&bar[XB_TMO], 1u); break; } }
    }
    mine = xb_ld(&bar[XB_XCNT(x)]);
    nloc = mine > 0u ? mine : 1u; nx = cnt > 0u ? cnt : 1u;
}

__device__ __forceinline__ void xcd_barrier(const XcdBarrier& b) {
    asm volatile("s_waitcnt vmcnt(0)" ::: "memory");
    __syncthreads();
    if (threadIdx.x == 0) {
        unsigned* bar = b.bar;
        __builtin_amdgcn_s_waitcnt(0);
        unsigned nloc = b.st[0], nx = b.st[1];
        if (nloc == 0u) { xcd_barrier_complete(bar, b.x, nloc, nx); b.st[0] = nloc; b.st[1] = nx; }
        const unsigned old = xb_add(&bar[XB_XSUB(b.x)], 1u);
        const unsigned gen = old / nloc;
        if (old + 1u == (gen + 1u) * nloc) {
            __builtin_amdgcn_fence(__ATOMIC_RELEASE, "agent");
            asm volatile("s_waitcnt vmcnt(0)" ::: "memory");
            const unsigned og = xb_add(&bar[XB_TOP], 1u);
            const unsigned tg = og / nx;
            if (og + 1u == (tg + 1u) * nx) xb_add(&bar[XB_TOPGEN], 1u);
            else XB_SPIN(xb_ld(&bar[XB_TOPGEN]) == tg, bar);
            __builtin_amdgcn_fence(__ATOMIC_ACQUIRE, "agent");
            xb_add(&bar[XB_XGEN(b.x)], 1u);
            asm volatile("s_waitcnt vmcnt(0)" ::: "memory");
        } else {
            XB_SPIN(xb_ld(&bar[XB_XGEN(b.x)]) == gen, bar);
            __builtin_amdgcn_fence(__ATOMIC_ACQUIRE, "agent");
            asm volatile("s_waitcnt vmcnt(0)" ::: "memory");
        }
    }
    __syncthreads();
}
constexpr int NWAVES = 8;
constexpr int DM = 1024, MP = 32768, MS = 512, MROWS = MP + MS, NSEQ = 20, DEPTH = 4, DFF = 2816, DIN = 9216, PAST = 2048;
constexpr int NCHUNK_P = 512, NCHUNK = 528;
constexpr float EPS = 1e-6f;
constexpr size_t OY_P = 0, OY_S = 33554432, OK_P = 34078720, OV_P = 168296448, OS_P = 302514176, OK_S = 304611328, OV_S = 306708480, OS_S = 308805632, OUT_TOTAL = 317194240;

constexpr size_t MiB = 1u << 20;
constexpr size_t WS_CTL = 0, CTL_ZERO_BYTES = 1 * MiB;
constexpr size_t WS_MOD = 1 * MiB;
constexpr size_t WS_LB = 4 * MiB;
constexpr size_t WS_W = 8 * MiB, W_LAYER = 57 * MiB;
constexpr size_t WO_GU1 = 0, WO_D1 = 11 * MiB, WO_IN = 16 * MiB + MiB / 2, WO_BA = 34 * MiB + MiB / 2, WO_BH = 36 * MiB + MiB / 2, WO_OUT = 38 * MiB + MiB / 2, WO_GU2 = 40 * MiB + MiB / 2, WO_D2 = 51 * MiB + MiB / 2;
constexpr size_t WS_X = 240 * MiB;
constexpr size_t WS_XN = 370 * MiB;
constexpr size_t WS_Q = 435 * MiB, WS_K = 500 * MiB, WS_V = 565 * MiB;
constexpr size_t WS_QQ = 630 * MiB, WS_KK = 695 * MiB, WS_VV = 760 * MiB, WS_HGS = 825 * MiB, WS_SZA = 890 * MiB, WS_SZH = 955 * MiB;
constexpr size_t WS_LOGF = 1020 * MiB;
constexpr size_t WS_O1 = 1150 * MiB, WS_O2 = 1215 * MiB, WS_OATT = 1280 * MiB, WS_OH = 1345 * MiB, WS_MRG = 1410 * MiB;
constexpr size_t WS_BIG = 1475 * MiB;
constexpr size_t WS_SST = 1739 * MiB;
constexpr size_t WS_DD = 1871 * MiB;
constexpr size_t WS_END = 1874 * MiB;
constexpr int T_TEAM = 32;
constexpr int CW_BAR = 4096, CW_Q = 8192;
static_assert(pg8::EpiWin::O_Q == WS_Q && pg8::EpiWin::O_K == WS_K && pg8::EpiWin::O_V == WS_V && pg8::EpiWin::O_QQ == WS_QQ && pg8::EpiWin::O_KK == WS_KK && pg8::EpiWin::O_VV == WS_VV && pg8::EpiWin::O_HGS == WS_HGS && pg8::EpiWin::O_SZA == WS_SZA && pg8::EpiWin::O_SZH == WS_SZH && pg8::EpiWin::O_LOGF == WS_LOGF && pg8::EpiWin::O_LB == WS_LB && pg8::EpiWin::OK_P_ == OK_P && pg8::EpiWin::OV_P_ == OV_P && pg8::EpiWin::OK_S_ == OK_S && pg8::EpiWin::OV_S_ == OV_S, "EpiWin offsets");

constexpr int RING_OFF = 0, RING_BYTES = 139264;
constexpr int LDSCTL_OFF = RING_BYTES, MISC_OFF = LDSCTL_OFF + 320;
constexpr int LDS_BYTES = 147456;

struct Frame {
    LAS unsigned char* lds;
    volatile LAS unsigned* MISC;
    gu32* ctl;
    int tid, lane, wave;
    int vcu, G;
};
typedef float f32x16 __attribute__((ext_vector_type(16)));
typedef unsigned v2u __attribute__((ext_vector_type(2)));

__device__ __forceinline__ float wave_sum(float v) {
#pragma unroll
    for (int o = 1; o < 64; o <<= 1) v += __shfl_xor(v, o);
    return v;
}
__device__ __forceinline__ float bf2f(bf16 b) { return __builtin_bit_cast(float, (unsigned)b << 16); }
__device__ __forceinline__ unsigned cvtpk(float lo, float hi) { return pg8::cvt_pk_bf16(lo, hi); }
__device__ __forceinline__ bf16x8 pack8(f32x4 a, f32x4 b) { v4u w; w.x = cvtpk(a[0], a[1]); w.y = cvtpk(a[2], a[3]); w.z = cvtpk(b[0], b[1]); w.w = cvtpk(b[2], b[3]); return __builtin_bit_cast(bf16x8, w); }
__device__ __forceinline__ float lam_init_of(int l) { asm volatile("" : "+s"(l)); return 0.8f - 0.6f * __expf(-0.3f * (float)l); }

__device__ __forceinline__ void p0_transpose_item(const float* W, int K, int N, bf16* WT, bool gu, LAS float* scr, int item, int lane) {
    const int nblk = N / 32, kb = item / nblk, nb = item % nblk, k0 = 64 * kb, nd0 = 32 * nb;
    const int ns0 = gu ? (((nd0 >> 7) & 1) * 2816 + (nd0 >> 8) * 128 + (nd0 & 127)) : nd0;
#pragma unroll 8
    for (int i = 0; i < 32; ++i) { const int kk = 2 * i + (lane >> 5); scr[kk * 33 + (lane & 31)] = W[(size_t)(k0 + kk) * N + ns0 + (lane & 31)]; }
    LDS_WAIT(); asm volatile("" ::: "memory");
    const int c = lane & 7;
#pragma unroll
    for (int j = 0; j < 4; ++j) { const int n = (lane >> 3) + 8 * j; const LAS float* s = scr + (8 * c) * 33 + n;
        v4u o; o.x = pk2(s[0 * 33], s[1 * 33]); o.y = pk2(s[2 * 33], s[3 * 33]); o.z = pk2(s[4 * 33], s[5 * 33]); o.w = pk2(s[6 * 33], s[7 * 33]);
        *(GAS v4u*)(WT + (size_t)(nd0 + n) * K + k0 + 8 * c) = o; }
    LDS_WAIT(); asm volatile("" ::: "memory");
}
typedef const __attribute__((address_space(4))) char* kaptr_t;
__device__ __forceinline__ const float* karg(int i) { kaptr_t ka = (kaptr_t)__builtin_amdgcn_kernarg_segment_ptr(); asm volatile("" : "+s"(ka)); return *(const float* const __attribute__((address_space(4)))*)(ka + 8 * i); }
enum { A_XP = 0, A_XS, A_CK, A_CV, A_ST, A_CP, A_CS, A_WADA, A_BADA, A_GFFN1, A_WGU1, A_WD1, A_GMIX, A_WIN, A_LAM, A_GSUB, A_LBL, A_GHG, A_WBA, A_WBH, A_WOUT, A_GFFN2, A_WGU2, A_WD2, A_GFIN, A_OUT, A_WS };
__device__ __forceinline__ void p0_prologue(Frame& F, unsigned char* ws) {
    { LAS float* scr = (LAS float*)(F.lds + RING_OFF + F.wave * 16384);
      const int gw = F.vcu * NWAVES + F.wave, NGW = F.G * NWAVES;
      constexpr int I_GU = 16 * 176, I_D = 44 * 32, I_IN = 16 * 288, I_SQ = 16 * 32, I_LAYER = 2 * I_GU + 2 * I_D + I_IN + 3 * I_SQ;
      for (int it = gw; it < DEPTH * I_LAYER; it += NGW) {
          const int l = it / I_LAYER; int r = it % I_LAYER; unsigned char* wl = ws + WS_W + (size_t)l * W_LAYER;
          if (r < I_GU) { p0_transpose_item(karg(A_WGU1) + (size_t)l * 1024 * 5632, 1024, 5632, (bf16*)(wl + WO_GU1), true, scr, r, F.lane); continue; } r -= I_GU;
          if (r < I_D)  { p0_transpose_item(karg(A_WD1) + (size_t)l * 2816 * 1024, 2816, 1024, (bf16*)(wl + WO_D1), false, scr, r, F.lane); continue; } r -= I_D;
          if (r < I_IN) { p0_transpose_item(karg(A_WIN) + (size_t)l * 1024 * 9216, 1024, 9216, (bf16*)(wl + WO_IN), false, scr, r, F.lane); continue; } r -= I_IN;
          if (r < I_SQ) { p0_transpose_item(karg(A_WBA) + (size_t)l * 1024 * 1024, 1024, 1024, (bf16*)(wl + WO_BA), false, scr, r, F.lane); continue; } r -= I_SQ;
          if (r < I_SQ) { p0_transpose_item(karg(A_WBH) + (size_t)l * 1024 * 1024, 1024, 1024, (bf16*)(wl + WO_BH), false, scr, r, F.lane); continue; } r -= I_SQ;
          if (r < I_SQ) { p0_transpose_item(karg(A_WOUT) + (size_t)l * 1024 * 1024, 1024, 1024, (bf16*)(wl + WO_OUT), false, scr, r, F.lane); continue; } r -= I_SQ;
          if (r < I_GU) { p0_transpose_item(karg(A_WGU2) + (size_t)l * 1024 * 5632, 1024, 5632, (bf16*)(wl + WO_GU2), true, scr, r, F.lane); continue; } r -= I_GU;
          p0_transpose_item(karg(A_WD2) + (size_t)l * 2816 * 1024, 2816, 1024, (bf16*)(wl + WO_D2), false, scr, r, F.lane);
      } }
    __syncthreads();
    { const float* c_p = karg(A_CP); const float* c_s = karg(A_CS); const float* w_ada = karg(A_WADA); const float* b_ada = karg(A_BADA);
      LAS float* ca = (LAS float*)(F.lds);
      LAS float* red = (LAS float*)(F.lds + 81920);
      for (int i = F.tid; i < NSEQ * 1024; i += NWAVES * 64) { const int s = i >> 10, k = i & 1023; const float c = s < 4 ? c_p[s * 1024 + k] : c_s[(s - 4) * 1024 + k]; ca[i] = pg8::silu_f(c); }
      __syncthreads();
      float* MOD = (float*)(ws + WS_MOD);
      for (int it = F.vcu; it < DEPTH * 144; it += F.G) {
          const int l = it / 144, n = (it % 144) * 64 + F.lane; const float* wp = w_ada + ((size_t)l * 1024 + F.wave * 128) * 9216 + n;
          float acc[NSEQ];
#pragma unroll
          for (int s = 0; s < NSEQ; ++s) acc[s] = 0.f;
#pragma unroll 4
          for (int k = 0; k < 128; ++k) { const float w = wp[(size_t)k * 9216];
#pragma unroll
              for (int s = 0; s < NSEQ; ++s) acc[s] += ca[s * 1024 + F.wave * 128 + k] * w; }
#pragma unroll
          for (int s = 0; s < NSEQ; ++s) red[(F.wave * NSEQ + s) * 64 + F.lane] = acc[s];
          __syncthreads();
          for (int i = F.tid; i < NSEQ * 64; i += NWAVES * 64) { const int s = i >> 6, c = i & 63; float v = 0.f;
#pragma unroll
              for (int w = 0; w < 8; ++w) v += red[(w * NSEQ + s) * 64 + c];
              const int nn = (it % 144) * 64 + c; MOD[((size_t)l * NSEQ + s) * 9216 + nn] = v + b_ada[(size_t)l * 9216 + nn]; }
          __syncthreads();
      } }
    if (F.vcu == 0) { float* LB = (float*)(ws + WS_LB); const float* lb_logits = karg(A_LBL);
        for (int c = F.tid; c < 1024; c += NWAVES * 64) { float lg[4], mx = -INFINITY;
#pragma unroll
            for (int l = 0; l < 4; ++l) { lg[l] = lb_logits[l * 1024 + c]; mx = __builtin_fmaxf(mx, lg[l]); }
            float sum = 0.f;
#pragma unroll
            for (int l = 0; l < 4; ++l) { lg[l] = __expf(lg[l] - mx); sum += lg[l]; }
            const float inv = 1.f / sum; float cs = 0.f;
#pragma unroll
            for (int l = 0; l < 4; ++l) { cs += lg[l] * inv; LB[l * 1024 + c] = cs - lg[0] * inv; } } }
}

__device__ __forceinline__ void norm_phase(Frame& F, const float* x_p, const float* x_s, bool first, float* X, const float* g, const float* mod_l, int sub, bf16* XN, int row0, int row1, int gw, int NGW) {
    for (int row = row0 + gw; row < row1; row += NGW) {
        const float* src = first ? (row < MP ? x_p + (size_t)row * DM : x_s + (size_t)(row - MP) * DM) : X + (size_t)row * DM;
        const float* mp = mod_l + (size_t)pg8::row_seq(row) * 9216 + sub * 3 * 1024;
        const f32x4* xr = (const f32x4*)src + F.lane; f32x4 v[4]; float s2 = 0.f;
#pragma unroll
        for (int j = 0; j < 4; ++j) { v[j] = xr[64 * j]; s2 += (v[j].x * v[j].x + v[j].y * v[j].y) + (v[j].z * v[j].z + v[j].w * v[j].w); }
        const float rstd = __builtin_amdgcn_rsqf(wave_sum(s2) * (1.f / DM) + EPS);
        if (first) { f32x4* xo = (f32x4*)(X + (size_t)row * DM) + F.lane;
#pragma unroll
            for (int j = 0; j < 4; ++j) xo[64 * j] = v[j]; }
        v2u* o8 = (v2u*)(XN + (size_t)row * DM) + F.lane;
#pragma unroll
        for (int j = 0; j < 4; ++j) { const int c = 4 * F.lane + 256 * j; const f32x4 gg = *(const f32x4*)(g + c), sh = *(const f32x4*)(mp + c), sc = *(const f32x4*)(mp + 1024 + c);
            const f32x4 h = (v[j] * rstd) * gg * (sc + 1.f) + sh; v2u o; o.x = cvtpk(h.x, h.y); o.y = cvtpk(h.z, h.w); o8[64 * j] = o; }
    }
}
__device__ __forceinline__ void final_norm_phase(Frame& F, const float* X, const float* g, float* out) {
    const int gw = F.vcu * NWAVES + F.wave, NGW = F.G * NWAVES;
    for (int row = gw; row < MROWS; row += NGW) {
        const f32x4* xr = (const f32x4*)(X + (size_t)row * DM) + F.lane; f32x4 v[4]; float s2 = 0.f;
#pragma unroll
        for (int j = 0; j < 4; ++j) { v[j] = xr[64 * j]; s2 += (v[j].x * v[j].x + v[j].y * v[j].y) + (v[j].z * v[j].z + v[j].w * v[j].w); }
        const float rstd = __builtin_amdgcn_rsqf(wave_sum(s2) * (1.f / DM) + EPS);
        f32x4* o = (f32x4*)(out + (row < MP ? OY_P + (size_t)row * DM : OY_S + (size_t)(row - MP) * DM)) + F.lane;
#pragma unroll
        for (int j = 0; j < 4; ++j) { const f32x4 gg = *(const f32x4*)(g + 4 * F.lane + 256 * j); o[64 * j] = (v[j] * rstd) * gg; }
    }
}
__device__ __forceinline__ float lam_of(const float* att_lambda, int l, int lane) {
    const float* lp = att_lambda + (size_t)l * 256;
    const float a = wave_sum(lp[lane] * lp[64 + lane]), b = wave_sum(lp[128 + lane] * lp[192 + lane]);
    return __expf(a) - __expf(b) + lam_init_of(l);
}
__device__ __forceinline__ void attn_combine_phase(Frame& F, const bf16* O1, const bf16* O2, const float* gsub, float lam, float osc, bf16* OATT) {
    const int gw = F.vcu * NWAVES + F.wave, NGW = F.G * NWAVES; const int cl = (F.lane & 7) * 16;
    float gv[16];
#pragma unroll
    for (int i = 0; i < 16; ++i) gv[i] = gsub[cl + i] * osc;
    for (int row = gw; row < MP; row += NGW) {
        const size_t off = (size_t)row * DM + F.lane * 16; const v4u a0 = *(const v4u*)(O1 + off), a1 = *(const v4u*)(O1 + off + 8), b0 = *(const v4u*)(O2 + off), b1 = *(const v4u*)(O2 + off + 8);
        const unsigned aw[8] = {a0.x, a0.y, a0.z, a0.w, a1.x, a1.y, a1.z, a1.w}, bw[8] = {b0.x, b0.y, b0.z, b0.w, b1.x, b1.y, b1.z, b1.w};
        float o[16]; float ss = 0.f;
#pragma unroll
        for (int i = 0; i < 8; ++i) { o[2 * i] = pg8::bf_lo(aw[i]) - lam * pg8::bf_lo(bw[i]); o[2 * i + 1] = pg8::bf_hi(aw[i]) - lam * pg8::bf_hi(bw[i]); ss += o[2 * i] * o[2 * i] + o[2 * i + 1] * o[2 * i + 1]; }
        ss += __shfl_xor(ss, 1); ss += __shfl_xor(ss, 2); ss += __shfl_xor(ss, 4);
        const float rstd = __builtin_amdgcn_rsqf(ss * (1.f / 128.f) + EPS);
        v4u w0, w1;
        w0.x = cvtpk(o[0] * rstd * gv[0], o[1] * rstd * gv[1]); w0.y = cvtpk(o[2] * rstd * gv[2], o[3] * rstd * gv[3]); w0.z = cvtpk(o[4] * rstd * gv[4], o[5] * rstd * gv[5]); w0.w = cvtpk(o[6] * rstd * gv[6], o[7] * rstd * gv[7]);
        w1.x = cvtpk(o[8] * rstd * gv[8], o[9] * rstd * gv[9]); w1.y = cvtpk(o[10] * rstd * gv[10], o[11] * rstd * gv[11]); w1.z = cvtpk(o[12] * rstd * gv[12], o[13] * rstd * gv[13]); w1.w = cvtpk(o[14] * rstd * gv[14], o[15] * rstd * gv[15]);
        *(v4u*)(OATT + off) = w0; *(v4u*)(OATT + off + 8) = w1;
    }
}

__device__ __forceinline__ void attn_sample_unit(Frame& F, const float* cache_k, const float* cache_v, int l, int s, int head, const bf16* Qb, const bf16* Kb, const bf16* Vb, float lam, float osc, const float* gsub, bf16* OATT) {
    const int lane = F.lane, w = F.wave, q = lane & 31, hh = lane >> 5, vt = w & 3, kh = w >> 2;
    LAS float* SLOT = (LAS float*)(F.lds);
    LAS float* ML = (LAS float*)(F.lds + 16384);
    LAS float* SSQ = (LAS float*)(F.lds + 16384 + 512);
    const size_t qrow = (size_t)MP + (size_t)s * 32;
    const float* ck = cache_k + ((size_t)(l * 16 + s) * PAST) * 1024 + head * 128;
    const float* cv = cache_v + ((size_t)(l * 16 + s) * PAST) * 1024 + head * 128;
    f32x16 o1;
#pragma unroll
    for (int r = 0; r < 16; ++r) o1[r] = 0.f;
    for (int m = 0; m < 2; ++m) {
        bf16x8 qf[4];
#pragma unroll
        for (int ks = 0; ks < 4; ++ks) qf[ks] = *(const bf16x8*)(Qb + (qrow + q) * 1024 + head * 128 + m * 64 + ks * 16 + 8 * hh);
        float mrun = -INFINITY, lrun = 0.f; f32x16 ot;
#pragma unroll
        for (int r = 0; r < 16; ++r) ot[r] = 0.f;
        const int ntile = 32 + kh;
        for (int t = 0; t < ntile; ++t) {
            const bool nw = (t == 32); const int key0 = kh * 1024 + t * 32;
            bf16x8 kf[4];
            if (!nw) { const float* kp = ck + (size_t)(key0 + q) * 1024 + m * 64 + 8 * hh;
#pragma unroll
                for (int ks = 0; ks < 4; ++ks) { const f32x4 a = *(const f32x4*)(kp + ks * 16), b = *(const f32x4*)(kp + ks * 16 + 4); kf[ks] = pack8(a, b); } }
            else {
#pragma unroll
                for (int ks = 0; ks < 4; ++ks) kf[ks] = *(const bf16x8*)(Kb + (qrow + q) * 1024 + head * 128 + m * 64 + ks * 16 + 8 * hh); }
            float vf[2][8];
            { const float* vp = cv + (size_t)(key0 + 4 * hh) * 1024 + 32 * vt + q; const bf16* vpn = Vb + (qrow + 4 * hh) * 1024 + head * 128 + 32 * vt + q;
#pragma unroll
              for (int s2 = 0; s2 < 2; ++s2)
#pragma unroll
                  for (int j = 0; j < 8; ++j) { const int kr = 16 * s2 + 8 * (j >> 2) + (j & 3);
                      vf[s2][j] = nw ? bf2f(vpn[kr * 1024]) : vp[kr * 1024]; } }
            f32x16 st;
#pragma unroll
            for (int r = 0; r < 16; ++r) st[r] = 0.f;
#pragma unroll
            for (int ks = 0; ks < 4; ++ks) st = __builtin_amdgcn_mfma_f32_32x32x16_bf16(kf[ks], qf[ks], st, 0, 0, 0);
            float tm = st[0];
#pragma unroll
            for (int r = 1; r < 16; ++r) tm = __builtin_fmaxf(tm, st[r]);
            tm = __builtin_fmaxf(tm, __shfl_xor(tm, 32));
            const float mnew = __builtin_fmaxf(mrun, tm), alpha = __builtin_amdgcn_exp2f(mrun - mnew);
            float ls = 0.f;
#pragma unroll
            for (int r = 0; r < 16; ++r) { st[r] = __builtin_amdgcn_exp2f(st[r] - mnew); ls += st[r]; }
            ls += __shfl_xor(ls, 32);
            lrun = lrun * alpha + ls; mrun = mnew;
#pragma unroll
            for (int r = 0; r < 16; ++r) ot[r] *= alpha;
#pragma unroll
            for (int s2 = 0; s2 < 2; ++s2) { v4u pw; pw.x = cvtpk(st[8 * s2], st[8 * s2 + 1]); pw.y = cvtpk(st[8 * s2 + 2], st[8 * s2 + 3]); pw.z = cvtpk(st[8 * s2 + 4], st[8 * s2 + 5]); pw.w = cvtpk(st[8 * s2 + 6], st[8 * s2 + 7]);
                v4u aw; aw.x = cvtpk(vf[s2][0], vf[s2][1]); aw.y = cvtpk(vf[s2][2], vf[s2][3]); aw.z = cvtpk(vf[s2][4], vf[s2][5]); aw.w = cvtpk(vf[s2][6], vf[s2][7]);
                ot = __builtin_amdgcn_mfma_f32_32x32x16_bf16(__builtin_bit_cast(bf16x8, aw), __builtin_bit_cast(bf16x8, pw), ot, 0, 0, 0); }
        }
        if (vt == 0 && hh == 0) { ML[(kh * 32 + q) * 2] = mrun; ML[(kh * 32 + q) * 2 + 1] = lrun; }
        __syncthreads();
        const float m0 = ML[q * 2], l0 = ML[q * 2 + 1], m1 = ML[(32 + q) * 2], l1 = ML[(32 + q) * 2 + 1];
        const float Mx = __builtin_fmaxf(m0, m1), L = l0 * __builtin_amdgcn_exp2f(m0 - Mx) + l1 * __builtin_amdgcn_exp2f(m1 - Mx);
        { const float sc = __builtin_amdgcn_exp2f(mrun - Mx);
#pragma unroll
          for (int r = 0; r < 16; ++r) ot[r] *= sc; }
        if (kh == 1) {
#pragma unroll
            for (int r = 0; r < 16; ++r) SLOT[(vt * 16 + r) * 64 + lane] = ot[r]; }
        __syncthreads();
        if (kh == 0) { const float rl = 1.f / L;
#pragma unroll
            for (int r = 0; r < 16; ++r) ot[r] = (ot[r] + SLOT[(vt * 16 + r) * 64 + lane]) * rl;
            if (m == 0) {
#pragma unroll
                for (int r = 0; r < 16; ++r) o1[r] = ot[r];
            } else { float ss = 0.f;
#pragma unroll
                for (int r = 0; r < 16; ++r) { o1[r] = o1[r] - lam * ot[r]; ss += o1[r] * o1[r]; }
                ss += __shfl_xor(ss, 32);
                if (hh == 0) SSQ[vt * 32 + q] = ss; } }
        __syncthreads();
    }
    if (kh == 0) {
        const float ss = SSQ[q] + SSQ[32 + q] + SSQ[64 + q] + SSQ[96 + q];
        const float rstd = __builtin_amdgcn_rsqf(ss * (1.f / 128.f) + EPS) * osc;
#pragma unroll
        for (int r = 0; r < 16; ++r) { const int v = 32 * vt + (r & 3) + 8 * (r >> 2) + 4 * hh; OATT[(qrow + q) * 1024 + head * 128 + v] = (bf16)f2bf(o1[r] * rstd * gsub[v]); }
    }
    __syncthreads();
}

constexpr int HS = 72, HK = 136;
__device__ __forceinline__ f32x4 mfma16(bf16x8 a, bf16x8 b, f32x4 c) { return __builtin_amdgcn_mfma_f32_16x16x32_bf16(a, b, c, 0, 0, 0); }
__device__ __forceinline__ void st16bf(LAS bf16* p, const float (&v)[16]) {
    v4u a, b; a.x = cvtpk(v[0], v[1]); a.y = cvtpk(v[2], v[3]); a.z = cvtpk(v[4], v[5]); a.w = cvtpk(v[6], v[7]); b.x = cvtpk(v[8], v[9]); b.y = cvtpk(v[10], v[11]); b.z = cvtpk(v[12], v[13]); b.w = cvtpk(v[14], v[15]);
    *(LAS v4u*)p = a; *(LAS v4u*)(p + 8) = b;
}
__device__ __forceinline__ float bfu(unsigned b) { return __builtin_bit_cast(float, b << 16); }
struct HgPtrs { const float* LOGF; const bf16 *QQ, *KK, *VV, *HGS; const float* ghg; bf16* OH; bf16* dump; };
typedef float f32x2v __attribute__((ext_vector_type(2)));
__device__ __forceinline__ void hg_load(const HgPtrs& P, size_t ubase  , unsigned k0, int w, int nvalid, f32x2v (&lf)[8], unsigned (&qv)[8], unsigned (&kv)[8], unsigned (&vv)[8]) {
    if (w * 8 < nvalid) {
#pragma unroll
        for (int i = 0; i < 8; ++i) { const size_t o = ubase + (size_t)(w * 8 + i) * 1024;
            const float* lp = P.LOGF + o; const bf16* qp = P.QQ + o; const bf16* kp = P.KK + o; const bf16* vp = P.VV + o;
            lf[i] = *(const f32x2v*)(lp + k0); qv[i] = *(const unsigned*)(qp + k0); kv[i] = *(const unsigned*)(kp + k0); vv[i] = *(const unsigned*)(vp + k0); }
    } else {
#pragma unroll
        for (int i = 0; i < 8; ++i) { lf[i] = (f32x2v){0.f, 0.f}; qv[i] = 0u; kv[i] = 0u; vv[i] = 0u; }
    }
}
#define HG_BAR() asm volatile("s_waitcnt lgkmcnt(0)\n\ts_barrier" ::: "memory")
__device__ __forceinline__ void hg_sequence(Frame& F, const HgPtrs& P, size_t row0, int h, int nchunk, int nvalid, const float* s_in, float* s_out) {
    LAS float* seg = (LAS float*)(F.lds);
    LAS float* part = (LAS float*)(F.lds + 4096);
    LAS float* dvec = (LAS float*)(F.lds + 6144);
    LAS bf16* QH = (LAS bf16*)(F.lds + 8192);
    LAS bf16* QT = QH + 64 * HK;
    LAS bf16* KH = QT + 64 * HK;
    LAS bf16* VT = KH + 160 * HK;
    LAS bf16* KT = VT + 128 * HS;
    LAS bf16* AL = KT + 128 * HS;
    const int w = __builtin_amdgcn_readfirstlane(F.wave), sc = w >> 1, lr_ = F.lane & 15, lq_ = F.lane >> 4; const unsigned k0_ = 2u * (unsigned)F.lane;
    f32x4 S[8];
#pragma unroll
    for (int kb = 0; kb < 8; ++kb)
#pragma unroll
        for (int r = 0; r < 4; ++r) S[kb][r] = s_in ? s_in[(size_t)(16 * kb + 4 * lq_ + r) * 128 + 16 * w + lr_] : 0.f;
    const float gv = P.ghg[16 * w + lr_];
    f32x2v lf[8]; unsigned qv[8], kv[8], vv[8];
    hg_load(P, row0 * 1024 + h * 128, k0_, w, nvalid, lf, qv, kv, vv);
    for (int c = 0; c < nchunk; ++c) {
        int lr = lr_, lq = lq_; unsigned k0 = k0_; asm volatile("" : "+v"(lr), "+v"(lq), "+v"(k0));
        const size_t crow = row0 + (size_t)c * 64;
        f32x2v cs[8]; { f32x2v run = {0.f, 0.f};
#pragma unroll
            for (int i = 0; i < 8; ++i) { run = run + lf[i]; cs[i] = run; }
            *(LAS f32x2v*)(seg + w * 128 + k0) = run; }
        HG_BAR();
        f32x2v P2[4], mypre = {0.f, 0.f}, tot; { f32x2v p = {0.f, 0.f};
#pragma unroll
            for (int s = 0; s < 8; ++s) { if ((s & 1) == 0) P2[s >> 1] = p; mypre = (s == w) ? p : mypre; p = p + *(const LAS f32x2v*)(seg + s * 128 + k0); } tot = p; }
        f32x2v myref = P2[0], nref = P2[1];
#pragma unroll
        for (int s = 1; s < 4; ++s) { myref = (s == sc) ? P2[s] : myref; nref = (s == sc) ? (s == 3 ? tot : P2[s < 3 ? s + 1 : 3]) : nref; }
        const f32x2v dq = mypre - myref;
        f32x2v fq, fT, fK[4]; fq.x = __expf(myref.x); fq.y = __expf(myref.y); fT.x = __expf(tot.x - nref.x); fT.y = __expf(tot.y - nref.y);
#pragma unroll
        for (int ii = 1; ii < 4; ++ii) { fK[ii].x = __expf(__builtin_fminf(P2[ii].x - nref.x, 0.f)); fK[ii].y = __expf(__builtin_fminf(P2[ii].y - nref.y, 0.f)); }
        float t0[8], t1[8];
#pragma unroll
        for (int i = 0; i < 8; ++i) { const int r = w * 8 + i; const float q0 = bfu(qv[i] & 0xffffu), q1 = bfu(qv[i] >> 16), a0 = bfu(kv[i] & 0xffffu), a1 = bfu(kv[i] >> 16);
            const float E0 = dq.x + cs[i].x, E1 = dq.y + cs[i].y;
            const float e1x = __expf(E0), e1y = __expf(E1);
            const float e2x = __builtin_fminf(__builtin_amdgcn_rcpf(e1x), 5.5e34f), e2y = __builtin_fminf(__builtin_amdgcn_rcpf(e1y), 5.5e34f);
            const float e3x = __expf((nref.x - myref.x) - E0), e3y = __expf((nref.y - myref.y) - E1);
            *(LAS unsigned*)(QH + r * HK + k0) = cvtpk(q0 * e1x, q1 * e1y);
            *(LAS unsigned*)(QT + r * HK + k0) = cvtpk(q0 * e1x * fq.x, q1 * e1y * fq.y);
            const float b0 = a0 * e3x, b1 = a1 * e3y;
            { const int rb = (sc == 0) ? 0 : (sc == 1) ? 16 : (sc == 2) ? 48 : 96; *(LAS unsigned*)(KH + (rb + r) * HK + k0) = cvtpk(a0 * e2x, a1 * e2y); }
#pragma unroll
            for (int ii = 1; ii < 4; ++ii) if (ii > sc) { const int rb = (ii == 1) ? 16 : (ii == 2) ? 48 : 96; *(LAS unsigned*)(KH + (rb + r) * HK + k0) = cvtpk(b0 * fK[ii].x, b1 * fK[ii].y); }
            t0[i] = b0 * fT.x; t1[i] = b1 * fT.y; }
        { v4u u0, u1; u0.x = cvtpk(t0[0], t0[1]); u0.y = cvtpk(t0[2], t0[3]); u0.z = cvtpk(t0[4], t0[5]); u0.w = cvtpk(t0[6], t0[7]); u1.x = cvtpk(t1[0], t1[1]); u1.y = cvtpk(t1[2], t1[3]); u1.z = cvtpk(t1[4], t1[5]); u1.w = cvtpk(t1[6], t1[7]);
          *(LAS v4u*)(KT + k0 * HS + 8 * w) = u0; *(LAS v4u*)(KT + (k0 + 1) * HS + 8 * w) = u1; }
        { v4u u0, u1;
          u0.x = (vv[0] & 0xffffu) | (vv[1] << 16); u0.y = (vv[2] & 0xffffu) | (vv[3] << 16); u0.z = (vv[4] & 0xffffu) | (vv[5] << 16); u0.w = (vv[6] & 0xffffu) | (vv[7] << 16);
          u1.x = (vv[0] >> 16) | (vv[1] & 0xffff0000u); u1.y = (vv[2] >> 16) | (vv[3] & 0xffff0000u); u1.z = (vv[4] >> 16) | (vv[5] & 0xffff0000u); u1.w = (vv[6] >> 16) | (vv[7] & 0xffff0000u);
          *(LAS v4u*)(VT + k0 * HS + 8 * w) = u0; *(LAS v4u*)(VT + (k0 + 1) * HS + 8 * w) = u1;
          if (w == 0) { f32x2v d; d.x = __expf(tot.x); d.y = __expf(tot.y); *(LAS f32x2v*)(dvec + k0) = d; } }
        HG_BAR();
        if (c + 1 < nchunk) hg_load(P, (crow + 64) * 1024 + h * 128, k0, w, nvalid, lf, qv, kv, vv);
        unsigned short hgv[16];
        { const bf16* hp = P.HGS + crow * 1024 + h * 128 + 16 * w;
#pragma unroll
          for (int mt = 0; mt < 4; ++mt)
#pragma unroll
              for (int r = 0; r < 4; ++r) { int t = 16 * mt + 4 * lq + r; t = t < nvalid ? t : nvalid - 1; hgv[mt * 4 + r] = hp[(unsigned)(t * 1024 + lr)]; } }
#pragma unroll
        for (int rr = 0; rr < 2; ++rr) { const int blk = w + 8 * rr, bi = blk >> 2, bj = blk & 3;
            f32x4 acc = {0.f, 0.f, 0.f, 0.f};
            if (bj <= bi) { const int rb = (bi == 0) ? 0 : (bi == 1) ? 16 : (bi == 2) ? 48 : 96;
#pragma unroll
                for (int ks = 0; ks < 4; ++ks) { const bf16x8 a = *(const LAS bf16x8*)(QH + (16 * bi + lr) * HK + ks * 32 + 8 * lq), b = *(const LAS bf16x8*)(KH + (rb + 16 * bj + lr) * HK + ks * 32 + 8 * lq); acc = mfma16(a, b, acc); }
                if (bi == bj) {
#pragma unroll
                    for (int r = 0; r < 4; ++r) acc[r] = (lr <= 4 * lq + r) ? acc[r] : 0.f; } }
#pragma unroll
            for (int r = 0; r < 4; ++r) AL[(16 * bi + 4 * lq + r) * HS + 16 * bj + lr] = (bf16)f2bf(acc[r]); }
        HG_BAR();
        f32x4 o[4];
        { bf16x8 bS[4], bV[2];
#pragma unroll
          for (int kp = 0; kp < 4; ++kp) { v4u t; t.x = cvtpk(S[2 * kp][0], S[2 * kp][1]); t.y = cvtpk(S[2 * kp][2], S[2 * kp][3]); t.z = cvtpk(S[2 * kp + 1][0], S[2 * kp + 1][1]); t.w = cvtpk(S[2 * kp + 1][2], S[2 * kp + 1][3]); bS[kp] = __builtin_bit_cast(bf16x8, t); }
#pragma unroll
          for (int ks = 0; ks < 2; ++ks) bV[ks] = *(const LAS bf16x8*)(VT + (16 * w + lr) * HS + ks * 32 + 8 * lq);
#pragma unroll
          for (int mt = 0; mt < 4; ++mt) { f32x4 acc = {0.f, 0.f, 0.f, 0.f};
#pragma unroll
              for (int kp = 0; kp < 4; ++kp) { const LAS bf16* qp = QT + (16 * mt + lr) * HK + 32 * kp + 4 * lq; const v2u a0 = *(const LAS v2u*)qp, a1 = *(const LAS v2u*)(qp + 16);
                  v4u a; a.x = a0.x; a.y = a0.y; a.z = a1.x; a.w = a1.y; acc = mfma16(__builtin_bit_cast(bf16x8, a), bS[kp], acc); }
#pragma unroll
              for (int ks = 0; ks < 2; ++ks) acc = mfma16(*(const LAS bf16x8*)(AL + (16 * mt + lr) * HS + ks * 32 + 8 * lq), bV[ks], acc);
              o[mt] = acc;
#pragma unroll
              for (int r = 0; r < 4; ++r) { float p = acc[r] * acc[r]; p += __shfl_xor(p, 1); p += __shfl_xor(p, 2); p += __shfl_xor(p, 4); p += __shfl_xor(p, 8); if (lr == 0) part[(16 * mt + 4 * lq + r) * 8 + w] = p; } } }
        { bf16x8 bV[2];
#pragma unroll
          for (int ks = 0; ks < 2; ++ks) bV[ks] = *(const LAS bf16x8*)(VT + (16 * w + lr) * HS + ks * 32 + 8 * lq);
#pragma unroll
          for (int kb = 0; kb < 8; ++kb) { const f32x4 d = *(const LAS f32x4*)(dvec + 16 * kb + 4 * lq); f32x4 acc = S[kb] * d;
#pragma unroll
              for (int ks = 0; ks < 2; ++ks) acc = mfma16(*(const LAS bf16x8*)(KT + (16 * kb + lr) * HS + ks * 32 + 8 * lq), bV[ks], acc);
              S[kb] = acc; } }
        HG_BAR();
        { bf16* op = P.OH + crow * 1024 + h * 128 + 16 * w;
#pragma unroll
          for (int mt = 0; mt < 4; ++mt)
#pragma unroll
              for (int r = 0; r < 4; ++r) { const int t = 16 * mt + 4 * lq + r; const f32x4 p0 = *(const LAS f32x4*)(part + t * 8), p1 = *(const LAS f32x4*)(part + t * 8 + 4);
                  const float ss = ((p0[0] + p0[1]) + (p0[2] + p0[3])) + ((p1[0] + p1[1]) + (p1[2] + p1[3]));
                  const float rstd = __builtin_amdgcn_rsqf(ss * (1.f / 128.f) + EPS);
                  const bf16 ov = (bf16)f2bf(o[mt][r] * rstd * gv * bf2f(hgv[mt * 4 + r]));
                  bf16* dst = (t < nvalid) ? op + (unsigned)(t * 1024 + lr) : P.dump + F.tid;
                  *dst = ov; } }
        HG_BAR();
    }
#pragma unroll
    for (int kb = 0; kb < 8; ++kb)
#pragma unroll
        for (int r = 0; r < 4; ++r) s_out[(size_t)(16 * kb + 4 * lq_ + r) * 128 + 16 * w + lr_] = S[kb][r];
}
#undef HG_BAR
__device__ __forceinline__ void team_barrier(Frame& F, gu32* w, unsigned target) {
    asm volatile("s_waitcnt vmcnt(0)" ::: "memory");
    __syncthreads();
    if (F.tid == 0) {
        __builtin_amdgcn_fence(__ATOMIC_RELEASE, "agent");
        asm volatile("s_waitcnt vmcnt(0)" ::: "memory");
        (void)__hip_atomic_fetch_add(w, 1u, RLX_AGENT);
        unsigned sp = 0;
        while (__hip_atomic_load(w, RLX_AGENT) < target) { __builtin_amdgcn_s_sleep(2); if (++sp > (1u << 22)) { __hip_atomic_store(F.ctl + 1, 0x7ea0u, RLX_AGENT); break; } }
        __builtin_amdgcn_fence(__ATOMIC_ACQUIRE, "agent");
        asm volatile("s_waitcnt vmcnt(0)" ::: "memory");
    }
    __syncthreads();
}
__device__ __forceinline__ int wg_pull(Frame& F, gu32* ctr) {
    if (F.tid == 0) F.MISC[16] = __hip_atomic_fetch_add(ctr, 1u, RLX_AGENT);
    __syncthreads();
    const int v = (int)F.MISC[16];
    __syncthreads();
    return __builtin_amdgcn_readfirstlane(v);
}
#ifdef PROBE_ID
#define PT_BEGIN(id) unsigned long long pt0_##id = 0; if ((id) == PROBE_ID && blockIdx.x == 0) pt0_##id = __builtin_amdgcn_s_memrealtime()
#define PT_END(id) do { if ((id) == PROBE_ID && blockIdx.x == 0) { const unsigned long long t1 = __builtin_amdgcn_s_memrealtime(), d = t1 - pt0_##id; while (__builtin_amdgcn_s_memrealtime() - t1 < d) __builtin_amdgcn_s_sleep(8); } } while (0)
#else
#define PT_BEGIN(id) do {} while (0)
#define PT_END(id) do {} while (0)
#endif
struct Args { const float* in[25]; float* out; unsigned char* ws; };
__global__ void __launch_bounds__(NWAVES * 64, 2) mk_fwd(Args args) {
    extern __shared__ __attribute__((aligned(16))) unsigned char lds[];
    Frame F;
    F.lds = (LAS unsigned char*)lds;
    F.MISC = (volatile LAS unsigned*)(F.lds + MISC_OFF);
#define ENTER() do { F.tid = opaque_tid(); F.lane = F.tid & 63; F.wave = __builtin_amdgcn_readfirstlane(F.tid >> 6); F.G = gridDim.x; { const int bx = opaque_bid(); F.vcu = (F.G % 8 == 0) ? (bx % 8) * (F.G / 8) + bx / 8 : bx; } } while (0)
    ENTER();
    F.ctl = (gu32*)((unsigned char*)karg(A_WS) + WS_CTL);
    for (int u = F.tid; u < (LDS_BYTES - LDSCTL_OFF) / 4; u += NWAVES * 64) ((LAS unsigned*)(F.lds + LDSCTL_OFF))[u] = 0u;
    __syncthreads();
    XcdBarrier bar = xcd_barrier_post((unsigned*)(F.ctl + CW_BAR), F.MISC + 8);
#define GRID_BAR() do { asm volatile("" : "+s"(bar.x)); xcd_barrier(bar); } while (0)
#define WSP(T, off) ((T*)((unsigned char*)karg(A_WS) + (off)))
#define OUTP(off) ((float*)karg(A_OUT) + (off))

#ifndef NO_P0
    p0_prologue(F, WSP(unsigned char, 0));
#ifdef DUP_P0
    GRID_BAR(); ENTER(); p0_prologue(F, WSP(unsigned char, 0));
#endif
#endif
    GRID_BAR();

    for (int l = 0; l < DEPTH; ++l) {
        const size_t wlo = WS_W + (size_t)l * W_LAYER, modo = WS_MOD + (size_t)l * NSEQ * 9216 * 4;
        norm_phase(F, karg(A_XP), nullptr, l == 0, WSP(float, WS_X), karg(A_GFFN1) + l * 1024, WSP(const float, modo), 0, WSP(bf16, WS_XN), 0, MP, F.vcu * NWAVES + F.wave, F.G * NWAVES);
#ifdef DUP_THIN
        GRID_BAR(); ENTER();
        norm_phase(F, nullptr, nullptr, false, WSP(float, WS_X), karg(A_GFFN1) + l * 1024, WSP(const float, modo), 0, WSP(bf16, WS_XN), 0, MP, F.vcu * NWAVES + F.wave, F.G * NWAVES);
#endif
        GRID_BAR(); ENTER();
#ifndef NO_G1
        { pg8::Gemm g{WSP(bf16, WS_XN), WSP(const bf16, wlo + WO_GU1), MP, 2 * DFF, DM}; typedef pg8::FixedOrder<128, 22, 8> Ord; Ord S; S.init(F.G, opaque_bid());
          pg8::EpiSwiglu E{WSP(bf16, WS_BIG)};
          pg8::gemm_phase<pg8::EpiSwiglu, Ord, true, true>(F.lds + RING_OFF, g, S, E);
#ifdef DUP_G1
          GRID_BAR(); ENTER(); pg8::gemm_phase<pg8::EpiSwiglu, Ord, true, true>(F.lds + RING_OFF, g, S, E);
#endif
        }
#endif
        GRID_BAR(); ENTER();
#ifndef NO_G2
        { pg8::Gemm g{WSP(bf16, WS_BIG), WSP(const bf16, wlo + WO_D1), MP, DM, DFF}; typedef pg8::FixedOrder<128, 4, 8> Ord; Ord S; S.init(F.G, opaque_bid());
          pg8::EpiResid E{WSP(float, WS_X), WSP(const float, modo) + 2 * 1024, 0.5f};
          pg8::gemm_phase<pg8::EpiResid, Ord, true, true>(F.lds + RING_OFF, g, S, E);
#ifdef DUP_RES
          GRID_BAR(); ENTER(); { pg8::EpiResid E0{E.X, E.gate, 0.f}; pg8::gemm_phase<pg8::EpiResid, Ord, true, true>(F.lds + RING_OFF, g, S, E0); }
#endif
        }
#endif
        GRID_BAR(); ENTER();
        norm_phase(F, nullptr, nullptr, false, WSP(float, WS_X), karg(A_GMIX) + l * 1024, WSP(const float, modo), 1, WSP(bf16, WS_XN), 0, MP, F.vcu * NWAVES + F.wave, F.G * NWAVES);
#ifdef DUP_THIN
        GRID_BAR(); ENTER();
        norm_phase(F, nullptr, nullptr, false, WSP(float, WS_X), karg(A_GMIX) + l * 1024, WSP(const float, modo), 1, WSP(bf16, WS_XN), 0, MP, F.vcu * NWAVES + F.wave, F.G * NWAVES);
#endif
        GRID_BAR(); ENTER();
        PT_BEGIN(2);
#ifndef NO_G3
        { pg8::Gemm g{WSP(bf16, WS_XN), WSP(const bf16, wlo + WO_IN), MP, DIN, DM}; typedef pg8::FixedOrder<128, 36, 8> Ord; Ord S; S.init(F.G, opaque_bid());
          pg8::EpiWin E{WSP(unsigned char, 0), OUTP(0), l, attn_body::C2};
          pg8::gemm_phase<pg8::EpiWin, Ord, true, true>(F.lds + RING_OFF, g, S, E); }
#endif
        GRID_BAR(); ENTER();
        PT_END(2);
        PT_BEGIN(1);
        { gu32* qbase = F.ctl + CW_Q + 64 * (l * 16);
          const int tk = wg_pull(F, qbase + 64 * 9);
#ifdef PROBE_ROLE
          const unsigned long long pr0 = __builtin_amdgcn_s_memrealtime();
#endif
          const int T_EFF = (F.G + 7) / 8 < T_TEAM ? (F.G + 7) / 8 : T_TEAM;
          const bool team = (tk & 7) == 0 && (tk >> 3) < T_EFF, hfirst = (tk & 7) == 1; const int ticket = tk >> 3; gu32* tb = qbase + 64 * 10; unsigned tstage = 0;
#define TEAM_BAR() do { ++tstage; team_barrier(F, tb, (unsigned)T_EFF * tstage); ENTER(); } while (0)
#ifndef NO_TEAM
          if (team) {
              const int tgw = ticket * NWAVES + F.wave, TNW = T_EFF * NWAVES;
              norm_phase(F, nullptr, karg(A_XS), l == 0, WSP(float, WS_X), karg(A_GFFN1) + l * 1024, WSP(const float, modo), 0, WSP(bf16, WS_XN), MP, MROWS, tgw, TNW);
              TEAM_BAR();
              { pg8::Gemm g{WSP(bf16, WS_XN), WSP(const bf16, wlo + WO_GU1), MROWS, 2 * DFF, DM}; typedef pg8::TeamOrder<22> Ord; Ord S; S.init(T_EFF, ticket);
                pg8::EpiSwiglu E{WSP(bf16, WS_BIG)};
                pg8::gemm_phase<pg8::EpiSwiglu, Ord, true, true>(F.lds + RING_OFF, g, S, E); }
              TEAM_BAR();
              { pg8::Gemm g{WSP(bf16, WS_BIG), WSP(const bf16, wlo + WO_D1), MROWS, DM, DFF}; typedef pg8::TeamOrder<4> Ord; Ord S; S.init(T_EFF, ticket);
                pg8::EpiResid E{WSP(float, WS_X), WSP(const float, modo) + 2 * 1024, 0.5f};
                pg8::gemm_phase<pg8::EpiResid, Ord, true, true>(F.lds + RING_OFF, g, S, E); }
              TEAM_BAR();
              norm_phase(F, nullptr, nullptr, false, WSP(float, WS_X), karg(A_GMIX) + l * 1024, WSP(const float, modo), 1, WSP(bf16, WS_XN), MP, MROWS, ticket * NWAVES + F.wave, T_EFF * NWAVES);
              TEAM_BAR();
              { pg8::Gemm g{WSP(bf16, WS_XN), WSP(const bf16, wlo + WO_IN), MROWS, DIN, DM}; typedef pg8::TeamOrder<36> Ord; Ord S; S.init(T_EFF, ticket);
                pg8::EpiWin E{WSP(unsigned char, 0), OUTP(0), l, attn_body::C2};
                pg8::gemm_phase<pg8::EpiWin, Ord, true, true>(F.lds + RING_OFF, g, S, E); }
              TEAM_BAR();
          }
#endif
          if (team || hfirst) { gu32* qs = team ? qbase + 64 * 11 : qbase; const int lim = team ? 256 : 32; const bool tq = team;
            for (;;) { int it = wg_pull(F, qs); if (it >= lim) break; if (tq) it += 32;
#ifndef NO_H
              if (it < 160) {
                  const HgPtrs P{WSP(const float, WS_LOGF), WSP(const bf16, WS_QQ), WSP(const bf16, WS_KK), WSP(const bf16, WS_VV), WSP(const bf16, WS_HGS), karg(A_GHG) + l * 128, WSP(bf16, WS_OH), WSP(bf16, WS_DD)};
                  const bool smp = it >= 32; const int u = smp ? it - 32 : it, sq = u >> 3, h = u & 7;
                  const size_t so = smp ? OS_S + ((size_t)((l * 16 + sq) * 8 + h)) * 16384 : OS_P + ((size_t)((l * 4 + sq) * 8 + h)) * 16384;
#ifdef DUP_HSEQ
                  if (!smp) hg_sequence(F, P, (size_t)sq * 8192, h, 128, 64, nullptr, OUTP(0) + so);
#endif
                  hg_sequence(F, P, smp ? (size_t)MP + (size_t)sq * 32 : (size_t)sq * 8192, h, smp ? 1 : 128, smp ? 32 : 64, smp ? karg(A_ST) + ((size_t)((l * 16 + sq) * 8 + h)) * 16384 : nullptr, OUTP(0) + so);
              } else
#endif
              {
#ifndef NO_SAMP
                  const int u = it - 160; const float lam = lam_of(karg(A_LAM), l, F.lane), osc = 1.f - lam_init_of(l);
                  attn_sample_unit(F, karg(A_CK), karg(A_CV), l, u >> 3, u & 7, WSP(const bf16, WS_Q), WSP(const bf16, WS_K), WSP(const bf16, WS_V), lam, osc, karg(A_GSUB) + l * 128, WSP(bf16, WS_OATT));
#endif
              } } }
#ifndef NO_TEAM
          if (team) {
              TEAM_BAR();
              { pg8::Gemm g{WSP(bf16, WS_OATT), WSP(const bf16, wlo + WO_BA), MROWS, DM, DM}; typedef pg8::TeamOrder<4> Ord; Ord S; S.init(T_EFF, ticket);
                pg8::EpiGateT E{WSP(float, WS_LOGF), WSP(const bf16, WS_SZA)};
                pg8::gemm_phase<pg8::EpiGateT, Ord, true, true>(F.lds + RING_OFF, g, S, E); }
              TEAM_BAR();
              { pg8::Gemm g{WSP(bf16, WS_OH), WSP(const bf16, wlo + WO_BH), MROWS, DM, DM}; typedef pg8::TeamOrder<4> Ord; Ord S; S.init(T_EFF, ticket);
                pg8::EpiGateM E{WSP(const float, WS_LOGF), WSP(const bf16, WS_SZH), WSP(bf16, WS_MRG)};
                pg8::gemm_phase<pg8::EpiGateM, Ord, true, true>(F.lds + RING_OFF, g, S, E); }
              TEAM_BAR();
              { pg8::Gemm g{WSP(bf16, WS_MRG), WSP(const bf16, wlo + WO_OUT), MROWS, DM, DM}; typedef pg8::TeamOrder<4> Ord; Ord S; S.init(T_EFF, ticket);
                pg8::EpiResid E{WSP(float, WS_X), WSP(const float, modo) + 5 * 1024, 1.0f};
                pg8::gemm_phase<pg8::EpiResid, Ord, true, true>(F.lds + RING_OFF, g, S, E); }
              TEAM_BAR();
              norm_phase(F, nullptr, nullptr, false, WSP(float, WS_X), karg(A_GFFN2) + l * 1024, WSP(const float, modo), 2, WSP(bf16, WS_XN), MP, MROWS, ticket * NWAVES + F.wave, T_EFF * NWAVES);
              TEAM_BAR();
              { pg8::Gemm g{WSP(bf16, WS_XN), WSP(const bf16, wlo + WO_GU2), MROWS, 2 * DFF, DM}; typedef pg8::TeamOrder<22> Ord; Ord S; S.init(T_EFF, ticket);
                pg8::EpiSwiglu E{WSP(bf16, WS_BIG)};
                pg8::gemm_phase<pg8::EpiSwiglu, Ord, true, true>(F.lds + RING_OFF, g, S, E); }
              TEAM_BAR();
              { pg8::Gemm g{WSP(bf16, WS_BIG), WSP(const bf16, wlo + WO_D2), MROWS, DM, DFF}; typedef pg8::TeamOrder<4> Ord; Ord S; S.init(T_EFF, ticket);
                pg8::EpiResid E{WSP(float, WS_X), WSP(const float, modo) + 8 * 1024, 0.5f};
                pg8::gemm_phase<pg8::EpiResid, Ord, true, true>(F.lds + RING_OFF, g, S, E); }
              ENTER();
          }
#endif
#ifndef NO_ATT
          { const attn_body::bf16* Qb = WSP(const attn_body::bf16, WS_Q); const attn_body::bf16* Kb = WSP(const attn_body::bf16, WS_K); const attn_body::bf16* Vb = WSP(const attn_body::bf16, WS_V); attn_body::bf16* O1 = WSP(attn_body::bf16, WS_O1);
            const int x0 = (int)(xb_xcc_id() & 7u);
            for (int dx = 0; dx < 8; ++dx) { const int head = (x0 + dx) & 7; gu32* qa = qbase + 64 * (1 + head);
                for (;;) { const int it = wg_pull(F, qa); if (it >= 256) break;
                    const int b = it >> 6, r = it & 63, qb = 31 - (r >> 1), mp = r & 1;
                    attn_body::attn_unit128<8>(b, head * 2 + mp, head * 2, qb, Qb, Kb, Vb, O1 + (size_t)mp * ((WS_O2 - WS_O1) / 2), (char*)lds + RING_OFF); } } }
#endif
#undef TEAM_BAR
#ifdef PROBE_ROLE
          if (tk == PROBE_ROLE) { const unsigned long long t1 = __builtin_amdgcn_s_memrealtime(), d = t1 - pr0; while (__builtin_amdgcn_s_memrealtime() - t1 < d) __builtin_amdgcn_s_sleep(8); }
#endif
        }
        GRID_BAR(); ENTER();
        PT_END(1);
        { const float lam = lam_of(karg(A_LAM), l, F.lane), osc = 1.f - lam_init_of(l);
          attn_combine_phase(F, WSP(const bf16, WS_O1), WSP(const bf16, WS_O2), karg(A_GSUB) + l * 128, lam, osc, WSP(bf16, WS_OATT));
#ifdef DUP_THIN
          GRID_BAR(); ENTER();
          attn_combine_phase(F, WSP(const bf16, WS_O1), WSP(const bf16, WS_O2), karg(A_GSUB) + l * 128, lam, osc, WSP(bf16, WS_OATT));
#endif
        }
        GRID_BAR(); ENTER();
#ifndef NO_G4
        { pg8::Gemm g{WSP(bf16, WS_OATT), WSP(const bf16, wlo + WO_BA), MP, DM, DM}; typedef pg8::FixedOrder<128, 4, 8> Ord; Ord S; S.init(F.G, opaque_bid());
          pg8::EpiGateT E{WSP(float, WS_LOGF), WSP(const bf16, WS_SZA)};
          pg8::gemm_phase<pg8::EpiGateT, Ord, true, true>(F.lds + RING_OFF, g, S, E);
#ifdef DUP_THIN
          GRID_BAR(); ENTER(); pg8::gemm_phase<pg8::EpiGateT, Ord, true, true>(F.lds + RING_OFF, g, S, E);
#endif
        }
#endif
        GRID_BAR(); ENTER();
#ifndef NO_G5
        { pg8::Gemm g{WSP(bf16, WS_OH), WSP(const bf16, wlo + WO_BH), MP, DM, DM}; typedef pg8::FixedOrder<128, 4, 8> Ord; Ord S; S.init(F.G, opaque_bid());
          pg8::EpiGateM E{WSP(const float, WS_LOGF), WSP(const bf16, WS_SZH), WSP(bf16, WS_MRG)};
          pg8::gemm_phase<pg8::EpiGateM, Ord, true, true>(F.lds + RING_OFF, g, S, E);
#ifdef DUP_THIN
          GRID_BAR(); ENTER(); pg8::gemm_phase<pg8::EpiGateM, Ord, true, true>(F.lds + RING_OFF, g, S, E);
#endif
        }
#endif
        GRID_BAR(); ENTER();
#ifndef NO_G6
        { pg8::Gemm g{WSP(bf16, WS_MRG), WSP(const bf16, wlo + WO_OUT), MP, DM, DM}; typedef pg8::FixedOrder<128, 4, 8> Ord; Ord S; S.init(F.G, opaque_bid());
          pg8::EpiResid E{WSP(float, WS_X), WSP(const float, modo) + 5 * 1024, 1.0f};
          pg8::gemm_phase<pg8::EpiResid, Ord, true, true>(F.lds + RING_OFF, g, S, E);
#ifdef DUP_RES
          GRID_BAR(); ENTER(); { pg8::EpiResid E0{E.X, E.gate, 0.f}; pg8::gemm_phase<pg8::EpiResid, Ord, true, true>(F.lds + RING_OFF, g, S, E0); }
#endif
        }
#endif
        GRID_BAR(); ENTER();
        norm_phase(F, nullptr, nullptr, false, WSP(float, WS_X), karg(A_GFFN2) + l * 1024, WSP(const float, modo), 2, WSP(bf16, WS_XN), 0, MP, F.vcu * NWAVES + F.wave, F.G * NWAVES);
#ifdef DUP_THIN
        GRID_BAR(); ENTER();
        norm_phase(F, nullptr, nullptr, false, WSP(float, WS_X), karg(A_GFFN2) + l * 1024, WSP(const float, modo), 2, WSP(bf16, WS_XN), 0, MP, F.vcu * NWAVES + F.wave, F.G * NWAVES);
#endif
        GRID_BAR(); ENTER();
#ifndef NO_G7
        { pg8::Gemm g{WSP(bf16, WS_XN), WSP(const bf16, wlo + WO_GU2), MP, 2 * DFF, DM}; typedef pg8::FixedOrder<128, 22, 8> Ord; Ord S; S.init(F.G, opaque_bid());
          pg8::EpiSwiglu E{WSP(bf16, WS_BIG)};
          pg8::gemm_phase<pg8::EpiSwiglu, Ord, true, true>(F.lds + RING_OFF, g, S, E); }
#endif
        GRID_BAR(); ENTER();
#ifndef NO_G8
        { pg8::Gemm g{WSP(bf16, WS_BIG), WSP(const bf16, wlo + WO_D2), MP, DM, DFF}; typedef pg8::FixedOrder<128, 4, 8> Ord; Ord S; S.init(F.G, opaque_bid());
          pg8::EpiResid E{WSP(float, WS_X), WSP(const float, modo) + 8 * 1024, 0.5f};
          pg8::gemm_phase<pg8::EpiResid, Ord, true, true>(F.lds + RING_OFF, g, S, E);
#ifdef DUP_RES
          GRID_BAR(); ENTER(); { pg8::EpiResid E0{E.X, E.gate, 0.f}; pg8::gemm_phase<pg8::EpiResid, Ord, true, true>(F.lds + RING_OFF, g, S, E0); }
#endif
        }
#endif
        GRID_BAR(); ENTER();
    }
    final_norm_phase(F, WSP(const float, WS_X), karg(A_GFIN), OUTP(0));
#undef GRID_BAR
#undef ENTER
#undef WSP
#undef OUTP
}

extern "C" void kernel_launch(void* const* d_in, const int* in_sizes, int n_in, void* d_out, int out_size, void* d_ws, size_t ws_size, hipStream_t stream) {
    static int grid = 0;
    if (grid == 0) {
        if (n_in != 25 || (size_t)out_size != OUT_TOTAL || ws_size < WS_END) { fprintf(stderr, "kernel_launch: unexpected sizes: n_in %d out %d ws %zu (need %zu)\n", n_in, out_size, ws_size, (size_t)WS_END); grid = -1; return; }
        int dev = 0, cus = 0, per_cu = 0;
        if (hipGetDevice(&dev) != hipSuccess || hipDeviceGetAttribute(&cus, hipDeviceAttributeMultiprocessorCount, dev) != hipSuccess) { grid = -1; return; }
        if (hipFuncSetAttribute((const void*)mk_fwd, hipFuncAttributeMaxDynamicSharedMemorySize, LDS_BYTES) != hipSuccess) { fprintf(stderr, "kernel_launch: hipFuncSetAttribute failed\n"); grid = -1; return; }
        if (hipOccupancyMaxActiveBlocksPerMultiprocessor(&per_cu, (const void*)mk_fwd, NWAVES * 64, LDS_BYTES) != hipSuccess || per_cu < 1) { fprintf(stderr, "kernel_launch: occupancy query reports %d\n", per_cu); }
        (void)hipGetLastError();
        grid = cus;
    }
    if (grid < 0) return;
    if (hipMemsetAsync((char*)d_ws + WS_CTL, 0, CTL_ZERO_BYTES, stream) != hipSuccess) return;
    Args a{};
    for (int i = 0; i < 25; ++i) a.in[i] = (const float*)d_in[i];
    a.out = (float*)d_out; a.ws = (unsigned char*)d_ws;
    hipLaunchKernelGGL(mk_fwd, dim3(grid), dim3(NWAVES * 64), LDS_BYTES, stream, a);
    (void)in_sizes;
}
```

```cpp
#include <hip/hip_runtime.h>
#include <hip/hip_bf16.h>
#include <cstdio>
#include <cstdint>
#include <cmath>
__device__ __forceinline__ int opaque_tid() { int t = (int)threadIdx.x; asm volatile("" : "+v"(t)); return t; }
__device__ __forceinline__ int opaque_bid() { int b = (int)blockIdx.x; asm volatile("" : "+s"(b)); return b; }
namespace pg8 {
#define PG8_LAS __attribute__((address_space(3)))
typedef unsigned short bf16_t;
typedef short bf16x8 __attribute__((ext_vector_type(8)));
typedef float f32x4 __attribute__((ext_vector_type(4)));
typedef unsigned u32x4 __attribute__((ext_vector_type(4)));
constexpr int BM = 256, BK = 64, HALF = 128, HTB = HALF * BK * 2  , STAGE_BYTES = 8 * HTB, NXCD = 8, WGM = 8;

__host__ __device__ __forceinline__ int lds_byte(int r, int c) { const int st = (r >> 4) * 2 + (c >> 5), rr = r & 15, cc = c & 31, ob = rr * 64 + cc * 2; return st * 1024 + (ob ^ (((ob >> 9) & 1) << 5)); }
__host__ __device__ __forceinline__ void stage_rc(int b, int& R, int& C) { const int st = b / 1024, sb = b % 1024, swz = sb ^ (((sb >> 9) & 1) << 5); R = (st >> 1) * 16 + swz / 64; C = (st & 1) * 32 + (swz % 64) / 2; }
__host__ __device__ __forceinline__ int perm32(int rho) { const int n = rho >> 4, i = rho & 15; return 8 * (i >> 2) + 4 * n + (i & 3); }

struct Unit { int pm, pn; };
struct Gemm { const bf16_t* A; const bf16_t* Bt; int M, N, K; };

struct StaticOrder {
    int nM, nN, nwg, G, c;
    __host__ __device__ void init(int M, int N, int G_, int c_) { nM = M / BM; nN = N / BM; nwg = nM * nN; G = G_; c = c_; }
    __host__ __device__ bool next(int i, Unit& u) const {
        const long L = (long)i * G + c; if (L >= nwg) return false;
        int wgid = (int)L; { const int q = nwg / NXCD, r = nwg % NXCD, xcd = wgid % NXCD, off = wgid / NXCD; wgid = (xcd < r ? xcd * (q + 1) : r * (q + 1) + (xcd - r) * q) + off; }
        const int nig = WGM * nN, gid = wgid / nig, fm = gid * WGM, gsz = (nM - fm) < WGM ? (nM - fm) : WGM;
        u.pm = fm + ((wgid % nig) % gsz); u.pn = (wgid % nig) / gsz; return true;
    }
    __device__ __forceinline__ void a_ready(const Unit&) const {}
    __device__ __forceinline__ void done(const Unit&) const {}
};

__device__ __forceinline__ unsigned cvt_pk_bf16(float lo, float hi) { unsigned r; asm volatile("v_cvt_pk_bf16_f32 %0, %1, %2" : "=v"(r) : "v"(lo), "v"(hi)); return r; }
__device__ __forceinline__ float bf_lo(unsigned w) { return __builtin_bit_cast(float, w << 16); }
__device__ __forceinline__ float bf_hi(unsigned w) { return __builtin_bit_cast(float, w & 0xffff0000u); }
__device__ __forceinline__ float sigmoid_f(float x) { return __builtin_amdgcn_rcpf(1.f + __expf(-x)); }
__device__ __forceinline__ float silu_f(float x) { return x * sigmoid_f(x); }
__device__ __forceinline__ void store8bf(bf16_t* p, f32x4 a, f32x4 b) { u32x4 w; w.x = cvt_pk_bf16(a[0], a[1]); w.y = cvt_pk_bf16(a[2], a[3]); w.z = cvt_pk_bf16(b[0], b[1]); w.w = cvt_pk_bf16(b[2], b[3]); *(u32x4*)p = w; }
__device__ __forceinline__ int row_seq(int row) { return row < 32768 ? (row >> 13) : 4 + ((row - 32768) >> 5); }

struct EpiSwiglu {
    static constexpr bool PERM = true, AFTER_DRAIN = false;
    bf16_t* O;
    __device__ __forceinline__ void operator()(const f32x4 (&acc)[2][2][4][2], const Unit& u, int wr, int wc, int fr, int fq) const {
        const int row0 = u.pm * BM + wr * 64 + fr, col0 = u.pn * HALF + wc * 32 + 8 * fq;
#pragma unroll
        for (int ai = 0; ai < 2; ++ai)
#pragma unroll
            for (int m = 0; m < 4; ++m) {
                f32x4 g0 = acc[ai][0][m][0], g1 = acc[ai][0][m][1]; const f32x4 u0 = acc[ai][1][m][0], u1 = acc[ai][1][m][1];
#pragma unroll
                for (int i = 0; i < 4; ++i) { g0[i] = silu_f(g0[i]) * u0[i]; g1[i] = silu_f(g1[i]) * u1[i]; }
                store8bf(O + (size_t)(row0 + ai * HALF + m * 16) * 2816 + col0, g0, g1); asm volatile("" ::: "memory");
            }
    }
};

struct EpiResid {
    static constexpr bool PERM = true, AFTER_DRAIN = false;
    float* X; const float* gate; float coef;
    __device__ __forceinline__ void operator()(const f32x4 (&acc)[2][2][4][2], const Unit& u, int wr, int wc, int fr, int fq) const {
#pragma unroll
        for (int ai = 0; ai < 2; ++ai)
#pragma unroll
            for (int m = 0; m < 4; ++m) {
                const int row = u.pm * BM + ai * HALF + wr * 64 + m * 16 + fr; const float* gp = gate + (size_t)row_seq(row) * 9216;
#pragma unroll
                for (int bj = 0; bj < 2; ++bj) { const int col = u.pn * BM + bj * HALF + wc * 32 + 8 * fq;
#pragma unroll
                    for (int n = 0; n < 2; ++n) { const f32x4 g = *(const f32x4*)(gp + col + 4 * n); f32x4* xp = (f32x4*)(X + (size_t)row * 1024 + col + 4 * n); const f32x4 xv = *xp; *xp = xv + (g * coef) * acc[ai][bj][m][n]; } asm volatile("" ::: "memory"); }
            }
    }
};

struct EpiWin {
    static constexpr bool PERM = true, AFTER_DRAIN = false;
    unsigned char* ws; float* out; int l; float qscale;
    static constexpr size_t MiB_ = 1u << 20;
    static constexpr size_t O_Q = 435 * MiB_, O_K = 500 * MiB_, O_V = 565 * MiB_, O_QQ = 630 * MiB_, O_KK = 695 * MiB_, O_VV = 760 * MiB_, O_HGS = 825 * MiB_, O_SZA = 890 * MiB_, O_SZH = 955 * MiB_, O_LOGF = 1020 * MiB_, O_LB = 4 * MiB_;
    static constexpr size_t OK_P_ = 34078720, OV_P_ = 168296448, OK_S_ = 304611328, OV_S_ = 306708480;
    __device__ __forceinline__ void operator()(const f32x4 (&acc)[2][2][4][2], const Unit& u, int wr, int wc, int fr, int fq) const {
        const int seg = u.pn >> 2, cb = (u.pn & 3) * BM + wc * 32 + 8 * fq, row0 = u.pm * BM + wr * 64 + fr;
        const size_t boff = seg == 0 ? O_Q : seg == 1 ? O_K : seg == 2 ? O_V : seg == 3 ? O_QQ : seg == 4 ? O_KK : seg == 5 ? O_VV : seg == 6 ? O_HGS : seg == 7 ? O_SZA : O_SZH;
        bf16_t* const O = (bf16_t*)(ws + boff) + (size_t)row0 * 1024 + cb;
        float* F32 = nullptr;
        if (seg == 1 || seg == 2) { const size_t ob = (u.pm < 128) ? (seg == 1 ? OK_P_ : OV_P_) + (size_t)l * 32768 * 1024 + (size_t)(u.pm * BM) * 1024 : (seg == 1 ? OK_S_ : OV_S_) + (size_t)l * 512 * 1024 + (size_t)((u.pm - 128) * BM) * 1024;
            F32 = out + ob + (size_t)(wr * 64 + fr) * 1024 + cb; }
        else if (seg == 4) F32 = (float*)(ws + O_LOGF) + (size_t)row0 * 1024 + cb;
        const float* const lb = (const float*)(ws + O_LB) + l * 1024 + cb;
        const float sc = seg == 0 ? qscale : 1.f;
#pragma unroll
        for (int bj = 0; bj < 2; ++bj) {
            f32x4 l0 = {0.f, 0.f, 0.f, 0.f}, l1 = l0; if (seg == 4) { l0 = *(const f32x4*)(lb + bj * HALF); l1 = *(const f32x4*)(lb + bj * HALF + 4); }
#pragma unroll
            for (int ai = 0; ai < 2; ++ai)
#pragma unroll
                for (int m = 0; m < 4; ++m) { const size_t off = (size_t)(ai * HALF + m * 16) * 1024 + bj * HALF;
                    f32x4 a = acc[ai][bj][m][0], b = acc[ai][bj][m][1];
                    if (seg == 4) { f32x4 fa, fb;
#pragma unroll
                        for (int i = 0; i < 4; ++i) {
                            { const float x = a[i], lbv = l0[i], e = __expf(-__builtin_fabsf(x)), r = __builtin_amdgcn_rcpf(1.f + e), er = e * r, sig = x >= 0.f ? r : er, om = x >= 0.f ? er : r;
                              fa[i] = __logf(__builtin_fmaxf(lbv + (1.f - lbv) * sig, 1e-30f)); a[i] = (1.f - lbv) * om; }
                            { const float x = b[i], lbv = l1[i], e = __expf(-__builtin_fabsf(x)), r = __builtin_amdgcn_rcpf(1.f + e), er = e * r, sig = x >= 0.f ? r : er, om = x >= 0.f ? er : r;
                              fb[i] = __logf(__builtin_fmaxf(lbv + (1.f - lbv) * sig, 1e-30f)); b[i] = (1.f - lbv) * om; } }
                        *(f32x4*)(F32 + off) = fa; *(f32x4*)(F32 + off + 4) = fb;
                    } else if (seg == 3 || seg == 6) {
#pragma unroll
                        for (int i = 0; i < 4; ++i) { a[i] = silu_f(a[i]); b[i] = silu_f(b[i]); }
                    } else if (seg >= 7) {
#pragma unroll
                        for (int i = 0; i < 4; ++i) { a[i] = sigmoid_f(a[i]); b[i] = sigmoid_f(b[i]); }
                    } else {
                        if (seg == 1 || seg == 2) { *(f32x4*)(F32 + off) = a; *(f32x4*)(F32 + off + 4) = b; }
                        a = a * sc; b = b * sc;
                    }
                    store8bf(O + off, a, b); asm volatile("" ::: "memory"); }
        }
    }
};

struct EpiGateT {
    static constexpr bool PERM = true, AFTER_DRAIN = false;
    float* T; const bf16_t* G;
    __device__ __forceinline__ void operator()(const f32x4 (&acc)[2][2][4][2], const Unit& u, int wr, int wc, int fr, int fq) const {
        const int row0 = u.pm * BM + wr * 64 + fr, cb = u.pn * BM + wc * 32 + 8 * fq;
#pragma unroll
        for (int ai = 0; ai < 2; ++ai)
#pragma unroll
            for (int m = 0; m < 4; ++m)
#pragma unroll
                for (int bj = 0; bj < 2; ++bj) { const size_t off = (size_t)(row0 + ai * HALF + m * 16) * 1024 + cb + bj * HALF; const u32x4 g = *(const u32x4*)(G + off);
                    const f32x4 g0 = {bf_lo(g.x), bf_hi(g.x), bf_lo(g.y), bf_hi(g.y)}, g1 = {bf_lo(g.z), bf_hi(g.z), bf_lo(g.w), bf_hi(g.w)};
                    *(f32x4*)(T + off) = g0 * acc[ai][bj][m][0]; *(f32x4*)(T + off + 4) = g1 * acc[ai][bj][m][1]; asm volatile("" ::: "memory"); }
    }
};
struct EpiGateM {
    static constexpr bool PERM = true, AFTER_DRAIN = false;
    const float* T; const bf16_t* G; bf16_t* O;
    __device__ __forceinline__ void operator()(const f32x4 (&acc)[2][2][4][2], const Unit& u, int wr, int wc, int fr, int fq) const {
        const int row0 = u.pm * BM + wr * 64 + fr, cb = u.pn * BM + wc * 32 + 8 * fq;
#pragma unroll
        for (int ai = 0; ai < 2; ++ai)
#pragma unroll
            for (int m = 0; m < 4; ++m)
#pragma unroll
                for (int bj = 0; bj < 2; ++bj) { const size_t off = (size_t)(row0 + ai * HALF + m * 16) * 1024 + cb + bj * HALF; const u32x4 g = *(const u32x4*)(G + off);
                    const f32x4 g0 = {bf_lo(g.x), bf_hi(g.x), bf_lo(g.y), bf_hi(g.y)}, g1 = {bf_lo(g.z), bf_hi(g.z), bf_lo(g.w), bf_hi(g.w)};
                    const f32x4 t0 = *(const f32x4*)(T + off), t1 = *(const f32x4*)(T + off + 4);
                    store8bf(O + off, t0 + g0 * acc[ai][bj][m][0], t1 + g1 * acc[ai][bj][m][1]); asm volatile("" ::: "memory"); }
    }
};

template <int NM, int NN, int GM> struct FixedOrder {
    static_assert(NM % GM == 0, "GM divides NM");
    int G, c;
    __device__ __forceinline__ void init(int G_, int c_) { G = G_; c = c_; }
    __device__ __forceinline__ bool next(int i, Unit& u) const {
        constexpr int nwg = NM * NN, q = nwg / NXCD, r = nwg % NXCD, nig = GM * NN;
        const int L = i * G + c; if (L >= nwg) return false;
        const int xcd = L % NXCD, off = L / NXCD; const int wgid = (xcd < r ? xcd * (q + 1) : r * (q + 1) + (xcd - r) * q) + off;
        const int gid = wgid / nig, w = wgid % nig; u.pm = gid * GM + (w % GM); u.pn = w / GM; return true;
    }
    __device__ __forceinline__ void a_ready(const Unit&) const {}
    __device__ __forceinline__ void done(const Unit&) const {}
};

template <int NN> struct TeamOrder {
    int T, r;
    __device__ __forceinline__ void init(int T_, int r_) { T = T_; r = r_; }
    __device__ __forceinline__ bool next(int i, Unit& u) const { const int L = i * T + r; if (L >= 2 * NN) return false; u.pm = 128 + L / NN; u.pn = L % NN; return true; }
    __device__ __forceinline__ void a_ready(const Unit&) const {}
    __device__ __forceinline__ void done(const Unit&) const {}
};
template <class Epi, class Sched, bool ALIGN_EPI = false, bool SP2 = false>
__device__ __forceinline__ void gemm_phase(PG8_LAS unsigned char* lds, const Gemm g, const Sched& S, const Epi& E) {
    const int tid = opaque_tid(), wid = __builtin_amdgcn_readfirstlane(tid >> 6), lane = tid & 63, wr = wid >> 2, wc = wid & 3, fr = lane & 15, fq = lane >> 4;
    const int K = g.K, nt = K / BK;
    unsigned voffA[2], voffB[2];
#pragma unroll
    for (int i = 0; i < 2; ++i) { int R, C; stage_rc(tid * 16 + i * 8192, R, C); const int Rb = Epi::PERM ? ((R & ~31) + perm32(R & 31)) : R;
        voffA[i] = (unsigned)(R * K + C) * 2u; voffB[i] = (unsigned)(Rb * K + C) * 2u; }
    const size_t kstep = (size_t)(BK * 2);
    const size_t hstep = (size_t)HALF * K * 2;
    const size_t tstep = 2 * hstep;
    const unsigned ldsw = (unsigned)wid * 1024u;
    const int aoff = lds_byte(wr * 64 + fr, fq * 8), boff = lds_byte(wc * 32 + fr, fq * 8);
#define PG8_SA(b, h) (((b) * 2 + (h)) * HTB)
#define PG8_SB(b, h) ((4 + (b) * 2 + (h)) * HTB)
#define PG8_STAGE(bufoff, gbase, voff) do { _Pragma("unroll") for (int _i = 0; _i < 2; ++_i) \
        __builtin_amdgcn_global_load_lds((const unsigned*)((const char*)(gbase) + (voff)[_i]), (PG8_LAS unsigned*)(lds + (bufoff) + ldsw + _i * 8192), 16, 0, 0); } while (0)
#define PG8_LDA(dst, b, h) do { _Pragma("unroll") for (int m = 0; m < 4; ++m) _Pragma("unroll") for (int k = 0; k < 2; ++k) dst[m][k] = *(const PG8_LAS bf16x8*)(lds + PG8_SA(b, h) + aoff + m * 2048 + k * 1024); } while (0)
#define PG8_LDB(dst, b, h) do { _Pragma("unroll") for (int n = 0; n < 2; ++n) _Pragma("unroll") for (int k = 0; k < 2; ++k) dst[n][k] = *(const PG8_LAS bf16x8*)(lds + PG8_SB(b, h) + boff + n * 2048 + k * 1024); } while (0)
#define PG8_MMA(ai, bj, At, Bt) do { __builtin_amdgcn_s_setprio(1); _Pragma("unroll") for (int m = 0; m < 4; ++m) _Pragma("unroll") for (int n = 0; n < 2; ++n) _Pragma("unroll") for (int k = 0; k < 2; ++k) \
        acc[ai][bj][m][n] = __builtin_amdgcn_mfma_f32_16x16x32_bf16(Bt[n][k], At[m][k], acc[ai][bj][m][n], 0, 0, 0); __builtin_amdgcn_s_setprio(0); } while (0)
#define PG8_WAIT_V(n) asm volatile("s_waitcnt vmcnt(" #n ")" ::: "memory")
#define PG8_WAIT_L(n) asm volatile("s_waitcnt lgkmcnt(" #n ")" ::: "memory")
#define PG8_BAR __builtin_amdgcn_s_barrier()
#define PG8_SCHED __builtin_amdgcn_sched_barrier(0)
    Unit cur, nxt; int ui = 0;
    if (!S.next(0, cur)) return;
    f32x4 acc[2][2][4][2];
#pragma unroll
    for (int a = 0; a < 2; ++a)
#pragma unroll
        for (int b = 0; b < 2; ++b)
#pragma unroll
            for (int m = 0; m < 4; ++m)
#pragma unroll
                for (int n = 0; n < 2; ++n) acc[a][b][m][n] = (f32x4){0.f, 0.f, 0.f, 0.f};
    bf16x8 At[4][2], B0[2][2], B1[2][2];
    const char* cA = (const char*)g.A + (size_t)cur.pm * tstep; const char* cB = (const char*)g.Bt + (size_t)cur.pn * tstep;
    S.a_ready(cur);
    if constexpr (SP2) {
        PG8_STAGE(PG8_SB(0, 0), cB, voffB); PG8_STAGE(PG8_SB(0, 1), cB + hstep, voffB); PG8_STAGE(PG8_SA(0, 0), cA, voffA); PG8_STAGE(PG8_SA(0, 1), cA + hstep, voffA);
        if (wr == 1) PG8_BAR;
        PG8_WAIT_V(2); PG8_BAR;
        PG8_STAGE(PG8_SB(1, 0), cB + kstep, voffB); PG8_STAGE(PG8_SA(1, 0), cA + kstep, voffA); PG8_STAGE(PG8_SB(1, 1), cB + hstep + kstep, voffB);
        PG8_WAIT_V(6); PG8_BAR;
    } else {
        PG8_STAGE(PG8_SB(0, 0), cB, voffB); PG8_STAGE(PG8_SA(0, 0), cA, voffA); PG8_STAGE(PG8_SB(0, 1), cB + hstep, voffB); PG8_STAGE(PG8_SA(0, 1), cA + hstep, voffA);
        if (wr == 1) PG8_BAR;
        PG8_WAIT_V(4); PG8_BAR;
        PG8_STAGE(PG8_SB(1, 0), cB + kstep, voffB); PG8_STAGE(PG8_SA(1, 0), cA + kstep, voffA); PG8_STAGE(PG8_SB(1, 1), cB + hstep + kstep, voffB);
        PG8_WAIT_V(6); PG8_BAR;
    }
    for (;;) {
        const bool has_next = S.next(ui + 1, nxt);
        const char* nA = has_next ? (const char*)g.A + (size_t)nxt.pm * tstep : cA; const char* nB = has_next ? (const char*)g.Bt + (size_t)nxt.pn * tstep : cB;
        for (int t = 0; t < nt; t += 2) {
            const bool last = (t == nt - 2);
            const char* a1 = cA + (size_t)(t + 1) * kstep;
            const char* a2 = last ? nA : cA + (size_t)(t + 2) * kstep; const char* b2 = last ? nB : cB + (size_t)(t + 2) * kstep;
            const char* a3 = a2 + kstep; const char* b3 = b2 + kstep;
            if (last && has_next) S.a_ready(nxt);
            if constexpr (SP2) {
            PG8_LDB(B0, 0, 0); PG8_LDB(B1, 0, 1); PG8_SCHED; PG8_LDA(At, 0, 0); PG8_STAGE(PG8_SA(1, 1), a1 + hstep, voffA);
            PG8_WAIT_V(8); PG8_WAIT_L(0); PG8_BAR; PG8_MMA(0, 0, At, B0); PG8_MMA(0, 1, At, B1); PG8_BAR; PG8_SCHED;
            PG8_LDA(At, 0, 1); PG8_STAGE(PG8_SB(0, 0), b2, voffB); PG8_STAGE(PG8_SB(0, 1), b2 + hstep, voffB); PG8_STAGE(PG8_SA(0, 0), a2, voffA);
            PG8_WAIT_V(8); PG8_WAIT_L(0); PG8_BAR; PG8_MMA(1, 0, At, B0); PG8_MMA(1, 1, At, B1); PG8_BAR; PG8_SCHED;
            PG8_LDB(B0, 1, 0); PG8_LDB(B1, 1, 1); PG8_SCHED; PG8_LDA(At, 1, 0); PG8_STAGE(PG8_SA(0, 1), a2 + hstep, voffA);
            PG8_WAIT_V(8); PG8_WAIT_L(0); PG8_BAR; PG8_MMA(0, 0, At, B0); PG8_MMA(0, 1, At, B1); PG8_BAR; PG8_SCHED;
            PG8_LDA(At, 1, 1); PG8_STAGE(PG8_SB(1, 0), b3, voffB); PG8_STAGE(PG8_SB(1, 1), b3 + hstep, voffB); PG8_STAGE(PG8_SA(1, 0), a3, voffA);
            PG8_WAIT_V(8); PG8_WAIT_L(0); PG8_BAR; PG8_MMA(1, 0, At, B0); PG8_MMA(1, 1, At, B1); PG8_BAR; PG8_SCHED;
            } else {
            PG8_LDB(B0, 0, 0); PG8_SCHED; PG8_LDA(At, 0, 0); PG8_STAGE(PG8_SA(1, 1), a1 + hstep, voffA);
            PG8_WAIT_L(8); PG8_BAR; PG8_WAIT_L(0); PG8_MMA(0, 0, At, B0); PG8_BAR; PG8_SCHED;
            PG8_LDB(B1, 0, 1); PG8_STAGE(PG8_SB(0, 0), b2, voffB);
            PG8_BAR; PG8_WAIT_L(0); PG8_MMA(0, 1, At, B1); PG8_BAR;
            PG8_LDA(At, 0, 1); PG8_STAGE(PG8_SA(0, 0), a2, voffA);
            PG8_BAR; PG8_WAIT_L(0); PG8_MMA(1, 0, At, B0); PG8_BAR; PG8_SCHED;
            PG8_STAGE(PG8_SB(0, 1), b2 + hstep, voffB);
            PG8_WAIT_V(6); PG8_BAR; PG8_MMA(1, 1, At, B1); PG8_BAR;
            PG8_LDB(B0, 1, 0); PG8_SCHED; PG8_LDA(At, 1, 0); PG8_STAGE(PG8_SA(0, 1), a2 + hstep, voffA);
            PG8_WAIT_L(8); PG8_BAR; PG8_WAIT_L(0); PG8_MMA(0, 0, At, B0); PG8_BAR; PG8_SCHED;
            PG8_LDB(B1, 1, 1); PG8_STAGE(PG8_SB(1, 0), b3, voffB);
            PG8_BAR; PG8_WAIT_L(0); PG8_MMA(0, 1, At, B1); PG8_BAR;
            PG8_LDA(At, 1, 1); PG8_STAGE(PG8_SA(1, 0), a3, voffA);
            PG8_BAR; PG8_WAIT_L(0); PG8_MMA(1, 0, At, B0); PG8_BAR; PG8_SCHED;
            PG8_STAGE(PG8_SB(1, 1), b3 + hstep, voffB);
            PG8_WAIT_V(6); PG8_BAR; PG8_MMA(1, 1, At, B1); PG8_BAR;
            }
        }
        if constexpr (ALIGN_EPI) { if (wr == 0) PG8_BAR; }
        if constexpr (!Epi::AFTER_DRAIN) { E(acc, cur, wr, wc, fr, fq); S.done(cur); }
        if (!has_next) break;
#pragma unroll
        for (int a = 0; a < 2; ++a)
#pragma unroll
            for (int b = 0; b < 2; ++b)
#pragma unroll
                for (int m = 0; m < 4; ++m)
#pragma unroll
                    for (int n = 0; n < 2; ++n) acc[a][b][m][n] = (f32x4){0.f, 0.f, 0.f, 0.f};
        cur = nxt; cA = nA; cB = nB; ++ui;
        if constexpr (ALIGN_EPI) { if (wr == 1) PG8_BAR; }
    }
    PG8_WAIT_V(0);
    if constexpr (!ALIGN_EPI) { if (wr == 0) PG8_BAR; }
    PG8_BAR;
    if constexpr (Epi::AFTER_DRAIN) { E.fused(acc, cur, wr, wc, fr, fq, lds, wid, lane); S.done(cur); }
#undef PG8_SA
#undef PG8_SB
#undef PG8_STAGE
#undef PG8_LDA
#undef PG8_LDB
#undef PG8_MMA
#undef PG8_WAIT_V
#undef PG8_WAIT_L
#undef PG8_BAR
#undef PG8_SCHED
}
}
namespace attn_body {
using bf16=__hip_bfloat16;
using bf16x8=__attribute__((ext_vector_type(8)))short;
using s16x4=__attribute__((ext_vector_type(4)))short;
using f32x16=__attribute__((ext_vector_type(16)))float;
using u32x4=__attribute__((ext_vector_type(4)))unsigned;
constexpr int BATCH=4,NHEAD=16,SEQ=8192,D=64,DM=NHEAD*D;
constexpr int NW=8,QBLK=32,QB=QBLK*NW,KVBLK=64,NQB=SEQ/QB;
constexpr int ATTN_PITCH=DM, ATTN_UNIT_ROWS=QB;
__device__ __forceinline__ int crow(int r,int hi){return (r&3)+8*(r>>2)+4*hi;}
#define SBAR() __builtin_amdgcn_sched_barrier(0)
__device__ __forceinline__ void cmask(f32x16&p0,f32x16&p1,int jb,int qrel,int hi){
  const float NEG=-INFINITY; (void)hi;
  if(jb>(qrel>>6)){
  #pragma unroll
  for(int r=0;r<16;++r){p0[r]=NEG;p1[r]=NEG;} }
}

constexpr int NSLOT=3, SLOTB=8192;
constexpr int LDS_K=0, LDS_V=NSLOT*SLOTB, LDS_WS=2*NSLOT*SLOTB, LDS_OST=LDS_WS+NW*64*4, LDS_BYTES=LDS_OST+NW*4096;
constexpr float C2=0.125f*1.4426950408889634f;
__device__ __forceinline__ void glds16(const void*gsrc,unsigned lds_dst){unsigned keep;
  asm volatile("s_mov_b32 %0, m0\n\ts_mov_b32 m0, %2\n\ts_nop 0\n\tglobal_load_lds_dwordx4 %1, off\n\ts_mov_b32 m0, %0":"=&s"(keep):"v"(gsrc),"s"(lds_dst):"memory");}
__device__ __forceinline__ float max3f(float a,float b,float c){float r;asm("v_max3_f32 %0, %1, %2, %3":"=v"(r):"v"(a),"v"(b),"v"(c));return r;}
__device__ __forceinline__ float max2f(float a,float b){float r;asm("v_max_f32_e32 %0, %1, %2":"=v"(r):"v"(a),"v"(b));return r;}
__device__ __forceinline__ float fadd_s(float a,float b){float r;asm("v_add_f32_e32 %0, %1, %2":"=v"(r):"v"(a),"v"(b));return r;}
__device__ __forceinline__ float fsub_s(float a,float b){float r;asm("v_sub_f32_e32 %0, %1, %2":"=v"(r):"v"(a),"v"(b));return r;}
typedef float f32x2_t __attribute__((ext_vector_type(2))); typedef __bf16 bf16x2_t __attribute__((ext_vector_type(2)));
__device__ __forceinline__ unsigned cvtpk_s(float lo,float hi){f32x2_t v={lo,hi};bf16x2_t b=__builtin_convertvector(v,bf16x2_t);return __builtin_bit_cast(unsigned,b);}
#define WAIT_BAR(N) asm volatile("s_waitcnt vmcnt(" #N ") lgkmcnt(0)\n\ts_barrier":::"memory")

__device__ __forceinline__ void qkt(f32x16&p0,f32x16&p1,const char*Kslot,const bf16x8*qr,const f32x16&negm,int r32,int hi){
  const char*kb=Kslot+hi*1024+r32*16;
  #pragma unroll
  for(int d0=0;d0<4;++d0){
    const bf16x8 b0=*reinterpret_cast<const bf16x8*>(kb+d0*2048);
    const bf16x8 b1=*reinterpret_cast<const bf16x8*>(kb+d0*2048+512);
    if(d0==0){p0=__builtin_amdgcn_mfma_f32_32x32x16_bf16(b0,qr[0],negm,0,0,0);p1=__builtin_amdgcn_mfma_f32_32x32x16_bf16(b1,qr[0],negm,0,0,0);}
    else{p0=__builtin_amdgcn_mfma_f32_32x32x16_bf16(b0,qr[d0],p0,0,0,0);p1=__builtin_amdgcn_mfma_f32_32x32x16_bf16(b1,qr[d0],p1,0,0,0);}}
}
typedef __attribute__((address_space(3))) const char* lds_cptr;
typedef short v4i16_t __attribute__((ext_vector_type(4)));
__device__ __forceinline__ void kload8(bf16x8*kf,lds_cptr kp){
  kf[0]=*(const __attribute__((address_space(3))) bf16x8*)(kp);      kf[1]=*(const __attribute__((address_space(3))) bf16x8*)(kp+512);
  kf[2]=*(const __attribute__((address_space(3))) bf16x8*)(kp+2048); kf[3]=*(const __attribute__((address_space(3))) bf16x8*)(kp+2560);
  kf[4]=*(const __attribute__((address_space(3))) bf16x8*)(kp+4096); kf[5]=*(const __attribute__((address_space(3))) bf16x8*)(kp+4608);
  kf[6]=*(const __attribute__((address_space(3))) bf16x8*)(kp+6144); kf[7]=*(const __attribute__((address_space(3))) bf16x8*)(kp+6656);
}
__device__ __forceinline__ void kload2(bf16x8*kf,lds_cptr kp,int j){ kf[2*j]=*(const __attribute__((address_space(3))) bf16x8*)(kp+j*2048); kf[2*j+1]=*(const __attribute__((address_space(3))) bf16x8*)(kp+j*2048+512); }
__device__ __forceinline__ s16x4 vtr(lds_cptr p){ return __builtin_bit_cast(s16x4,__builtin_amdgcn_ds_read_tr16_b64_v4i16((__attribute__((address_space(3))) v4i16_t*)p)); }
__device__ __forceinline__ float rowmax(const f32x16&p0,const f32x16&p1){
  float a=max3f(p0[0],p0[1],p1[0]),b=max3f(p0[2],p0[3],p1[1]);a=max3f(a,p1[2],p1[3]);
  #pragma unroll
  for(int r=4;r<16;r+=4){a=max3f(a,p0[r],p0[r+1]);b=max3f(b,p0[r+2],p0[r+3]);a=max3f(a,p1[r],p1[r+1]);b=max3f(b,p1[r+2],p1[r+3]);}
  const float m=max2f(a,b);
  auto rr=__builtin_amdgcn_permlane32_swap(__float_as_uint(m),__float_as_uint(m),false,false);
  return max2f(__uint_as_float(rr[0]),__uint_as_float(rr[1]));
}
__device__ __forceinline__ void pv(f32x16*o,int vb,bf16x8 pa0,bf16x8 pa1,bf16x8 pa2,bf16x8 pa3){
  #pragma unroll
  for(int d0=0;d0<2;++d0){s16x4 lo[4],hi[4];
    #pragma unroll
    for(int ks=0;ks<4;++ks){
      asm volatile("ds_read_b64_tr_b16 %0,%1 offset:%c2":"=&v"(lo[ks]):"v"(vb),"i"(d0*4096+ks*1024):"memory");
      asm volatile("ds_read_b64_tr_b16 %0,%1 offset:%c2":"=&v"(hi[ks]):"v"(vb),"i"(d0*4096+ks*1024+512):"memory");}
    asm volatile("s_waitcnt lgkmcnt(0)":::"memory");SBAR();
    #define PK(k) (bf16x8){lo[k][0],lo[k][1],lo[k][2],lo[k][3],hi[k][0],hi[k][1],hi[k][2],hi[k][3]}
    o[d0]=__builtin_amdgcn_mfma_f32_32x32x16_bf16(pa0,PK(0),o[d0],0,0,0);
    o[d0]=__builtin_amdgcn_mfma_f32_32x32x16_bf16(pa1,PK(1),o[d0],0,0,0);
    o[d0]=__builtin_amdgcn_mfma_f32_32x32x16_bf16(pa2,PK(2),o[d0],0,0,0);
    o[d0]=__builtin_amdgcn_mfma_f32_32x32x16_bf16(pa3,PK(3),o[d0],0,0,0);
    #undef PK
  }
}

#ifndef ATTN_STORE16
#define ATTN_STORE16(p,v) (*(u32x4*)(p)=(v))
#endif
template<int THRL> __device__ __forceinline__ void attn_unit(int b,int hq,int hv,int qb,const bf16*Q,const bf16*__restrict__ K,const bf16*__restrict__ V,bf16*O,char*shm){
  const int tid=opaque_tid(),lane=tid&63,r32=lane&31,hi=lane>>5; const int wid=__builtin_amdgcn_readfirstlane(tid>>6);
  const long rowbase=(long)b*SEQ; const int q0=qb*QB;
  const bf16*Qw=Q+(rowbase+q0+wid*QBLK)*DM+hq*D;
  const bf16*Kh=K+rowbase*DM+hq*D,*Vh=V+rowbase*DM+hv*D;
  const unsigned lds0=(unsigned)(uintptr_t)shm;
  float*wsf=(float*)(shm+LDS_WS)+wid*64;
  const bf16*ksrc=Kh+(long)lane*DM+wid*8;
  const bf16*vsrc=Vh+(long)(16*(wid&3)+(lane>>2))*DM+(wid>>2)*32+(lane&3)*8;
  const unsigned kdst=lds0+LDS_K+wid*1024, vdst=lds0+LDS_V+wid*1024;
  #define DMA_K(t,slot) glds16(ksrc+(long)(t)*KVBLK*DM,(unsigned)__builtin_amdgcn_readfirstlane(kdst+(slot)))
  #define DMA_V(t,slot) glds16(vsrc+(long)(t)*KVBLK*DM,(unsigned)__builtin_amdgcn_readfirstlane(vdst+(slot)))
  const int vb0=(int)(lds0+LDS_V)+((lane>>4)&1)*32+(lane&3)*8+(4*hi+((lane&15)>>2))*64;
  const char*Kbase=shm+LDS_K; bf16x8 kf[8];
  const lds_cptr shm3=(lds_cptr)shm; const lds_cptr kp0=shm3+LDS_K+hi*1024+r32*16; const lds_cptr vp0=shm3+LDS_V+((lane>>4)&1)*32+(lane&3)*8+(4*hi+((lane&15)>>2))*64;
  const int NT=(q0+QB)/KVBLK;
  DMA_K(0,0);DMA_V(0,0);DMA_K(1,SLOTB);
  bf16x8 qr[4];
  #pragma unroll
  for(int d0=0;d0<4;++d0)qr[d0]=*reinterpret_cast<const bf16x8*>(&Qw[(long)r32*DM+d0*16+hi*8]);
  float mhat=0.f,l_reg=0.f;f32x16 o[2];o[0]=f32x16{};o[1]=f32x16{};f32x16 negm=f32x16{};asm volatile("":"+v"(negm));
  const int qrel=wid*QBLK+r32;
  #define CMASK(P0,P1,t) do{int jb_=(t)-(NT-4); if(jb_>=0)cmask(P0,P1,jb_,qrel,hi);}while(0)
  bool resc=false;
  #define START(P0,P1) do{ const float rm=rowmax(P0,P1); resc=false; \
    { const float dl=rm; mhat=fadd_s(mhat,dl); \
      _Pragma("unroll") for(int r=0;r<16;++r){P0[r]=fsub_s(P0[r],dl);P1[r]=fsub_s(P1[r],dl);} \
      _Pragma("unroll") for(int r=0;r<16;++r)negm[r]=-mhat; asm volatile("":"+v"(negm)); } \
    _Pragma("unroll") for(int r=0;r<16;++r)P0[r]=__builtin_amdgcn_exp2f(P0[r]); }while(0)
  #define RESC() do{ if(resc){ asm volatile("s_waitcnt lgkmcnt(0)":::"memory"); \
      _Pragma("unroll") for(int d_=0;d_<2;++d_) _Pragma("unroll") for(int r=0;r<16;++r)o[d_][r]*=wsf[crow(r,hi)]; } }while(0)
  f32x16 pA0,pA1,pB0,pB1;
  int sl_prev=0,sl_cur=0,sl_next=SLOTB;
  #define ROT() do{sl_prev=sl_cur;sl_cur=sl_next;sl_next=(sl_next==(NSLOT-1)*SLOTB)?0:sl_next+SLOTB;}while(0)
  DMA_K(2,2*SLOTB);
  WAIT_BAR(3);
  qkt(pA0,pA1,Kbase,qr,negm,r32,hi);asm volatile("s_nop 15\n\ts_nop 7":"+v"(pA0),"+v"(pA1));CMASK(pA0,pA1,0);
  START(pA0,pA1);
  _Pragma("unroll") for(int r=0;r<16;++r)pA1[r]=__builtin_amdgcn_exp2f(pA1[r]);
  WAIT_BAR(0);
  DMA_K(3,0);DMA_V(1,SLOTB);
  ROT();
  kload8(kf,kp0+sl_cur);
  WAIT_BAR(2);
  s16x4 vlo[8],vhi[8]; u32x4 pw0,pw1,pw2,pw3;
  #define PKW(P,B) cvtpk_s(P[B],P[B+1])
  #define PAF(k) __builtin_bit_cast(bf16x8,pw##k)
  #define VFR(i) (bf16x8){vlo[i][0],vlo[i][1],vlo[i][2],vlo[i][3],vhi[i][0],vhi[i][1],vhi[i][2],vhi[i][3]}
  #define PIN(x) asm volatile("":"+v"(x))
  #define MX3(a,b,c) __builtin_fmaxf(__builtin_fmaxf((a),(b)),(c))
  #define GAPA(MF,A0,A1,A2,A3,W0,W1,PW) do{ MF; sacc+=A0; sacc+=A1; sacc+=A2; sacc+=A3; PIN(sacc); W0; W1; PIN(PW); SBAR(); }while(0)
  #define EX(v) __builtin_amdgcn_exp2f(v)
  #define GAPB(MF,X,B) do{ MF; X[B]=EX(X[B]); X[B+1]=EX(X[B+1]); X[B+2]=EX(X[B+2]); X[B+3]=EX(X[B+3]); PIN(X); SBAR(); }while(0)
  #define VRD(i) do{ vlo[i]=vtr(vp_+(((i)>>2)*4096+((i)&3)*1024)); vhi[i]=vtr(vp_+(((i)>>2)*4096+((i)&3)*1024+512)); }while(0)
  #define KRD(G,j) do{ if(G){ kload2(kf,kp0+sl_next,j); SBAR(); } }while(0)
  #define STEP(C0,C1,P0,P1,t,GK,GV,GL) do{ SBAR(); \
    const lds_cptr vp_=vp0+sl_prev; \
    VRD(0); SBAR(); float sacc=(P0[0]+P0[1]); \
    GAPA(C0=__builtin_amdgcn_mfma_f32_32x32x16_bf16(kf[0],qr[0],negm,0,0,0), P0[2],P0[3],P0[4],P0[5],     pw0[0]=PKW(P0,0), pw0[1]=PKW(P0,2), pw0); \
    VRD(4); SBAR(); GAPA(C1=__builtin_amdgcn_mfma_f32_32x32x16_bf16(kf[1],qr[0],negm,0,0,0), P0[6],P0[7],P0[8],P0[9],     pw0[2]=PKW(P0,4), pw0[3]=PKW(P0,6), pw0); \
    VRD(1); SBAR(); GAPA(C0=__builtin_amdgcn_mfma_f32_32x32x16_bf16(kf[2],qr[1],C0,0,0,0),   P0[10],P0[11],P0[12],P0[13], pw1[0]=PKW(P0,8), pw1[1]=PKW(P0,10), pw1); \
    VRD(5); SBAR(); GAPA(C1=__builtin_amdgcn_mfma_f32_32x32x16_bf16(kf[3],qr[1],C1,0,0,0),   P0[14],P0[15],P1[0],P1[1],   pw1[2]=PKW(P0,12),pw1[3]=PKW(P0,14), pw1); \
    VRD(2); SBAR(); GAPA(C0=__builtin_amdgcn_mfma_f32_32x32x16_bf16(kf[4],qr[2],C0,0,0,0),   P1[2],P1[3],P1[4],P1[5],     pw2[0]=PKW(P1,0), pw2[1]=PKW(P1,2), pw2); \
    VRD(6); SBAR(); GAPA(C1=__builtin_amdgcn_mfma_f32_32x32x16_bf16(kf[5],qr[2],C1,0,0,0),   P1[6],P1[7],P1[8],P1[9],     pw2[2]=PKW(P1,4), pw2[3]=PKW(P1,6), pw2); \
    VRD(3); SBAR(); GAPA(C0=__builtin_amdgcn_mfma_f32_32x32x16_bf16(kf[6],qr[3],C0,0,0,0),   P1[10],P1[11],P1[12],P1[13], pw3[0]=PKW(P1,8), pw3[1]=PKW(P1,10), pw3); \
    VRD(7); SBAR(); GAPA(C1=__builtin_amdgcn_mfma_f32_32x32x16_bf16(kf[7],qr[3],C1,0,0,0),   P1[14],P1[15],0.f,0.f,       pw3[2]=PKW(P1,12),pw3[3]=PKW(P1,14), pw3); \
    l_reg+=sacc; \
    if(GK){DMA_K((t)+3,sl_cur);} if(GV){DMA_V((t)+1,sl_next);} \
    CMASK(C0,C1,t); \
    { float a=MX3(C0[0],C0[1],C1[0]),b=MX3(C0[2],C0[3],C1[1]); a=MX3(a,C1[2],C1[3]); \
      _Pragma("unroll") for(int r=4;r<16;r+=4){a=MX3(a,C0[r],C0[r+1]);b=MX3(b,C0[r+2],C0[r+3]);a=MX3(a,C1[r],C1[r+1]);b=MX3(b,C1[r+2],C1[r+3]);} \
      float rm=__builtin_fmaxf(a,b); { auto rr=__builtin_amdgcn_permlane32_swap(__float_as_uint(rm),__float_as_uint(rm),false,false); rm=__builtin_fmaxf(__uint_as_float(rr[0]),__uint_as_float(rr[1])); } \
      resc=false; \
      if(__builtin_expect(__any(rm>(float)THRL),0)){ const float dl=__builtin_fmaxf(rm,0.f); mhat+=dl; \
        _Pragma("unroll") for(int r=0;r<16;++r){C0[r]-=dl;C1[r]-=dl;} \
        _Pragma("unroll") for(int r=0;r<16;++r)negm[r]=-mhat; asm volatile("":"+v"(negm)); \
        const float f=__builtin_amdgcn_exp2f(-dl); l_reg*=f; if(hi==0)wsf[r32]=f; resc=true; } } \
    SBAR(); \
    GAPB(o[0]=__builtin_amdgcn_mfma_f32_32x32x16_bf16(PAF(0),VFR(0),o[0],0,0,0), C0,0); \
    GAPB(o[1]=__builtin_amdgcn_mfma_f32_32x32x16_bf16(PAF(0),VFR(4),o[1],0,0,0), C0,4); \
    KRD(GL,0); GAPB(o[0]=__builtin_amdgcn_mfma_f32_32x32x16_bf16(PAF(1),VFR(1),o[0],0,0,0), C0,8); \
    KRD(GL,1); GAPB(o[1]=__builtin_amdgcn_mfma_f32_32x32x16_bf16(PAF(1),VFR(5),o[1],0,0,0), C0,12); \
    KRD(GL,2); GAPB(o[0]=__builtin_amdgcn_mfma_f32_32x32x16_bf16(PAF(2),VFR(2),o[0],0,0,0), C1,0); \
    KRD(GL,3); GAPB(o[1]=__builtin_amdgcn_mfma_f32_32x32x16_bf16(PAF(2),VFR(6),o[1],0,0,0), C1,4); \
    GAPB(o[0]=__builtin_amdgcn_mfma_f32_32x32x16_bf16(PAF(3),VFR(3),o[0],0,0,0), C1,8); \
    GAPB(o[1]=__builtin_amdgcn_mfma_f32_32x32x16_bf16(PAF(3),VFR(7),o[1],0,0,0), C1,12); \
    }while(0)
  int t=1;
  #undef CMASK
  #define CMASK(P0,P1,t) do{}while(0)
  for(;t+5<NT;t+=2){
    STEP(pB0,pB1,pA0,pA1,t,true,true,true);     WAIT_BAR(2); RESC(); ROT();
    STEP(pA0,pA1,pB0,pB1,t+1,true,true,true);   WAIT_BAR(2); RESC(); ROT();
  }
  #undef CMASK
  #define CMASK(P0,P1,t) do{int jb_=(t)-(NT-4); if(jb_>=0)cmask(P0,P1,jb_,qrel,hi);}while(0)
  #define ENDW(tt) do{ if((tt)+3<NT){WAIT_BAR(2);} else if((tt)+2<NT){WAIT_BAR(1);} else {WAIT_BAR(0);} }while(0)
  for(;t+1<NT;t+=2){
    STEP(pB0,pB1,pA0,pA1,t,(t+3<NT),(t+1<NT),(t+1<NT));       ENDW(t);   RESC(); ROT();
    STEP(pA0,pA1,pB0,pB1,t+1,(t+4<NT),(t+2<NT),(t+2<NT));     ENDW(t+1); RESC(); ROT();
  }
  STEP(pB0,pB1,pA0,pA1,NT-1,false,false,false); RESC();
  { float sacc=pB0[0]+pB0[1]; _Pragma("unroll") for(int r=2;r<16;++r)sacc+=pB0[r]; _Pragma("unroll") for(int r=0;r<16;++r)sacc+=pB1[r]; l_reg+=sacc;
    pw0=(u32x4){PKW(pB0,0),PKW(pB0,2),PKW(pB0,4),PKW(pB0,6)};pw1=(u32x4){PKW(pB0,8),PKW(pB0,10),PKW(pB0,12),PKW(pB0,14)};pw2=(u32x4){PKW(pB1,0),PKW(pB1,2),PKW(pB1,4),PKW(pB1,6)};pw3=(u32x4){PKW(pB1,8),PKW(pB1,10),PKW(pB1,12),PKW(pB1,14)};
    SBAR(); pv(o,vb0+sl_cur,PAF(0),PAF(1),PAF(2),PAF(3)); }
  #undef PKW
  #undef PAF
  #undef VFR
  #undef PIN
  #undef MX3
  #undef GAPA
  #undef GAPB
  #undef EX
  #undef VRD
  #undef KRD
  #undef STEP
  #undef ENDW
  {auto rr=__builtin_amdgcn_permlane32_swap(__float_as_uint(l_reg),__float_as_uint(l_reg),false,false);l_reg=__uint_as_float(rr[0])+__uint_as_float(rr[1]);}
  if(hi==0)wsf[32+r32]=l_reg;asm volatile("s_waitcnt lgkmcnt(0)":::"memory");
  float rli[16];
  #pragma unroll
  for(int r=0;r<16;++r)rli[r]=__builtin_amdgcn_rcpf(wsf[32+crow(r,hi)]);
  bf16*Ow=O+(rowbase+q0+wid*QBLK)*DM+hv*D;
  { bf16*stg=(bf16*)(shm+LDS_OST)+wid*2048;
    #pragma unroll
    for(int r=0;r<16;++r){const int orow=crow(r,hi);
      #pragma unroll
      for(int d0=0;d0<2;++d0)stg[orow*64+d0*32+r32]=__float2bfloat16(o[d0][r]*rli[r]);}
    asm volatile("s_waitcnt lgkmcnt(0)":::"memory");
    #pragma unroll
    for(int i=0;i<4;++i){const int row=i*8+(lane>>3),ch=lane&7; const u32x4 v=*(const u32x4*)(stg+row*64+ch*8); ATTN_STORE16(Ow+(long)row*DM+ch*8,v);} }
  asm volatile("s_waitcnt lgkmcnt(0)\n\ts_barrier":::"memory");
  #undef DMA_K
  #undef DMA_V
  #undef CMASK
  #undef START
  #undef RESC
  #undef ROT
}
__device__ __forceinline__ void pv128(f32x16*o,int vb,bf16x8 pa0,bf16x8 pa1,bf16x8 pa2,bf16x8 pa3){
  #pragma unroll
  for(int d0=0;d0<4;++d0){s16x4 lo[4],hi[4];
    #pragma unroll
    for(int ks=0;ks<4;++ks){
      asm volatile("ds_read_b64_tr_b16 %0,%1 offset:%c2":"=&v"(lo[ks]):"v"(vb),"i"(d0*4096+ks*1024):"memory");
      asm volatile("ds_read_b64_tr_b16 %0,%1 offset:%c2":"=&v"(hi[ks]):"v"(vb),"i"(d0*4096+ks*1024+512):"memory");}
    asm volatile("s_waitcnt lgkmcnt(0)":::"memory");SBAR();
    #define PK(k) (bf16x8){lo[k][0],lo[k][1],lo[k][2],lo[k][3],hi[k][0],hi[k][1],hi[k][2],hi[k][3]}
    o[d0]=__builtin_amdgcn_mfma_f32_32x32x16_bf16(pa0,PK(0),o[d0],0,0,0);
    o[d0]=__builtin_amdgcn_mfma_f32_32x32x16_bf16(pa1,PK(1),o[d0],0,0,0);
    o[d0]=__builtin_amdgcn_mfma_f32_32x32x16_bf16(pa2,PK(2),o[d0],0,0,0);
    o[d0]=__builtin_amdgcn_mfma_f32_32x32x16_bf16(pa3,PK(3),o[d0],0,0,0);
    #undef PK
  }
}
constexpr int SLOTV=16384, LDS_V2=NSLOT*SLOTB, LDS_WS2=LDS_V2+NSLOT*SLOTV, LDS_OST2=LDS_WS2+NW*64*4, LDS_BYTES2=LDS_OST2+NW*4096;
template<int THRL> __device__ __forceinline__ void attn_unit128(int b,int hq,int hv,int qb,const bf16*Q,const bf16*__restrict__ K,const bf16*__restrict__ V,bf16*O,char*shm){
  const int tid=opaque_tid(),lane=tid&63,r32=lane&31,hi=lane>>5; const int wid=__builtin_amdgcn_readfirstlane(tid>>6);
  const long rowbase=(long)b*SEQ; const int q0=qb*QB;
  const bf16*Qw=Q+(rowbase+q0+wid*QBLK)*DM+hq*D;
  const bf16*Kh=K+rowbase*DM+hq*D,*Vh=V+rowbase*DM+hv*D;
  const unsigned lds0=(unsigned)(uintptr_t)shm;
  float*wsf=(float*)(shm+LDS_WS2)+wid*64;
  const bf16*ksrc=Kh+(long)lane*DM+wid*8;
  const bf16*vsrc=Vh+(long)(16*(wid&3)+(lane>>2))*DM+(wid>>2)*32+(lane&3)*8;
  const unsigned kdst=lds0+LDS_K+wid*1024, vdst=lds0+LDS_V2+wid*1024;
  #define DMA_K(t,slot) glds16(ksrc+(long)(t)*KVBLK*DM,(unsigned)__builtin_amdgcn_readfirstlane(kdst+(slot)))
  #define DMA_V(t,slot) do{ glds16(vsrc+(long)(t)*KVBLK*DM,(unsigned)__builtin_amdgcn_readfirstlane(vdst+2*(slot))); glds16(vsrc+64+(long)(t)*KVBLK*DM,(unsigned)__builtin_amdgcn_readfirstlane(vdst+8192+2*(slot))); }while(0)
  const int vb0=(int)(lds0+LDS_V2)+((lane>>4)&1)*32+(lane&3)*8+(4*hi+((lane&15)>>2))*64;
  const char*Kbase=shm+LDS_K; bf16x8 kf[8];
  const lds_cptr shm3=(lds_cptr)shm; const lds_cptr kp0=shm3+LDS_K+hi*1024+r32*16; const lds_cptr vp0=shm3+LDS_V2+((lane>>4)&1)*32+(lane&3)*8+(4*hi+((lane&15)>>2))*64;
  const int NT=(q0+QB)/KVBLK;
  DMA_K(0,0);DMA_V(0,0);DMA_K(1,SLOTB);
  bf16x8 qr[4];
  #pragma unroll
  for(int d0=0;d0<4;++d0)qr[d0]=*reinterpret_cast<const bf16x8*>(&Qw[(long)r32*DM+d0*16+hi*8]);
  float mhat=0.f,l_reg=0.f;f32x16 o[4];o[0]=f32x16{};o[1]=f32x16{};o[2]=f32x16{};o[3]=f32x16{};const f32x16 zc=f32x16{};
  const int qrel=wid*QBLK+r32;
  #define CMASK(P0,P1,t) do{int jb_=(t)-(NT-4); if(jb_>=0)cmask(P0,P1,jb_,qrel,hi);}while(0)
  bool resc=false;
  #define START(P0,P1) do{ const float rm=rowmax(P0,P1); resc=false; \
    { const float dl=rm; mhat=fadd_s(mhat,dl); \
      _Pragma("unroll") for(int r=0;r<16;++r){P0[r]=fsub_s(P0[r],dl);P1[r]=fsub_s(P1[r],dl);} \
      } \
    _Pragma("unroll") for(int r=0;r<16;++r)P0[r]=__builtin_amdgcn_exp2f(P0[r]); }while(0)
  #define RESC() do{ if(resc){ asm volatile("s_waitcnt lgkmcnt(0)":::"memory"); \
      _Pragma("unroll") for(int d_=0;d_<4;++d_) _Pragma("unroll") for(int r=0;r<16;++r)o[d_][r]*=wsf[crow(r,hi)]; } }while(0)
  f32x16 pA0,pA1,pB0,pB1;
  int sl_prev=0,sl_cur=0,sl_next=SLOTB;
  #define ROT() do{sl_prev=sl_cur;sl_cur=sl_next;sl_next=(sl_next==(NSLOT-1)*SLOTB)?0:sl_next+SLOTB;}while(0)
  DMA_K(2,2*SLOTB);
  WAIT_BAR(3);
  qkt(pA0,pA1,Kbase,qr,zc,r32,hi);asm volatile("s_nop 15\n\ts_nop 7":"+v"(pA0),"+v"(pA1));CMASK(pA0,pA1,0);
  START(pA0,pA1);
  _Pragma("unroll") for(int r=0;r<16;++r)pA1[r]=__builtin_amdgcn_exp2f(pA1[r]);
  WAIT_BAR(0);
  DMA_K(3,0);DMA_V(1,SLOTB);
  ROT();
  kload8(kf,kp0+sl_cur);
  WAIT_BAR(3);
  s16x4 vlo[8],vhi[8]; u32x4 pw0,pw1,pw2,pw3;
  #define PKW(P,B) cvtpk_s(P[B],P[B+1])
  #define PAF(k) __builtin_bit_cast(bf16x8,pw##k)
  #define VFR(i) (bf16x8){vlo[i][0],vlo[i][1],vlo[i][2],vlo[i][3],vhi[i][0],vhi[i][1],vhi[i][2],vhi[i][3]}
  #define PIN(x) asm volatile("":"+v"(x))
  #define MX3(a,b,c) __builtin_fmaxf(__builtin_fmaxf((a),(b)),(c))
  #define GAPA(MF,A0,A1,A2,A3,W0,W1,PW) do{ MF; sacc+=A0; sacc+=A1; sacc+=A2; sacc+=A3; PIN(sacc); W0; W1; PIN(PW); SBAR(); }while(0)
  #define EX(v) __builtin_amdgcn_exp2f(v)
  #define GAPB(MF,X,B) do{ MF; X[B]=EX(X[B]); X[B+1]=EX(X[B+1]); X[B+2]=EX(X[B+2]); X[B+3]=EX(X[B+3]); PIN(X); SBAR(); }while(0)
  #define VRD(i) do{ vlo[i]=vtr(vp_+(((i)>>2)*4096+((i)&3)*1024)); vhi[i]=vtr(vp_+(((i)>>2)*4096+((i)&3)*1024+512)); }while(0)
  #define VRX(i) do{ vlo[i]=vtr(vp_+((((i)>>2)+2)*4096+((i)&3)*1024)); vhi[i]=vtr(vp_+((((i)>>2)+2)*4096+((i)&3)*1024+512)); SBAR(); }while(0)
  #define GAPB2(MF,X,B) do{ MF; X[B]=EX(X[B]-mhat); X[B+1]=EX(X[B+1]-mhat); PIN(X); SBAR(); }while(0)
  #define KRD(G,j) do{ if(G){ kload2(kf,kp0+sl_next,j); SBAR(); } }while(0)
  #define STEP(C0,C1,P0,P1,t,GK,GV,GL) do{ SBAR(); \
    const lds_cptr vp_=vp0+2*sl_prev; \
    VRD(0); SBAR(); float sacc=(P0[0]+P0[1]); \
    GAPA(C0=__builtin_amdgcn_mfma_f32_32x32x16_bf16(kf[0],qr[0],zc,0,0,0), P0[2],P0[3],P0[4],P0[5],     pw0[0]=PKW(P0,0), pw0[1]=PKW(P0,2), pw0); \
    VRD(4); SBAR(); GAPA(C1=__builtin_amdgcn_mfma_f32_32x32x16_bf16(kf[1],qr[0],zc,0,0,0), P0[6],P0[7],P0[8],P0[9],     pw0[2]=PKW(P0,4), pw0[3]=PKW(P0,6), pw0); \
    VRD(1); SBAR(); GAPA(C0=__builtin_amdgcn_mfma_f32_32x32x16_bf16(kf[2],qr[1],C0,0,0,0),   P0[10],P0[11],P0[12],P0[13], pw1[0]=PKW(P0,8), pw1[1]=PKW(P0,10), pw1); \
    VRD(5); SBAR(); GAPA(C1=__builtin_amdgcn_mfma_f32_32x32x16_bf16(kf[3],qr[1],C1,0,0,0),   P0[14],P0[15],P1[0],P1[1],   pw1[2]=PKW(P0,12),pw1[3]=PKW(P0,14), pw1); \
    VRD(2); SBAR(); GAPA(C0=__builtin_amdgcn_mfma_f32_32x32x16_bf16(kf[4],qr[2],C0,0,0,0),   P1[2],P1[3],P1[4],P1[5],     pw2[0]=PKW(P1,0), pw2[1]=PKW(P1,2), pw2); \
    VRD(6); SBAR(); GAPA(C1=__builtin_amdgcn_mfma_f32_32x32x16_bf16(kf[5],qr[2],C1,0,0,0),   P1[6],P1[7],P1[8],P1[9],     pw2[2]=PKW(P1,4), pw2[3]=PKW(P1,6), pw2); \
    VRD(3); SBAR(); GAPA(C0=__builtin_amdgcn_mfma_f32_32x32x16_bf16(kf[6],qr[3],C0,0,0,0),   P1[10],P1[11],P1[12],P1[13], pw3[0]=PKW(P1,8), pw3[1]=PKW(P1,10), pw3); \
    VRD(7); SBAR(); GAPA(C1=__builtin_amdgcn_mfma_f32_32x32x16_bf16(kf[7],qr[3],C1,0,0,0),   P1[14],P1[15],0.f,0.f,       pw3[2]=PKW(P1,12),pw3[3]=PKW(P1,14), pw3); \
    l_reg+=sacc; \
    if(GK){DMA_K((t)+3,sl_cur);} if(GV){DMA_V((t)+1,sl_next);} \
    CMASK(C0,C1,t); \
    { float a=MX3(C0[0],C0[1],C1[0]),b=MX3(C0[2],C0[3],C1[1]); a=MX3(a,C1[2],C1[3]); \
      _Pragma("unroll") for(int r=4;r<16;r+=4){a=MX3(a,C0[r],C0[r+1]);b=MX3(b,C0[r+2],C0[r+3]);a=MX3(a,C1[r],C1[r+1]);b=MX3(b,C1[r+2],C1[r+3]);} \
      float rm=__builtin_fmaxf(a,b); { auto rr=__builtin_amdgcn_permlane32_swap(__float_as_uint(rm),__float_as_uint(rm),false,false); rm=__builtin_fmaxf(__uint_as_float(rr[0]),__uint_as_float(rr[1])); } \
      rm-=mhat; resc=false; \
      if(__builtin_expect(__any(rm>(float)THRL),0)){ const float dl=__builtin_fmaxf(rm,0.f); mhat+=dl; \
        const float f=__builtin_amdgcn_exp2f(-dl); l_reg*=f; if(hi==0)wsf[r32]=f; resc=true; } } \
    SBAR(); \
    GAPB2(o[0]=__builtin_amdgcn_mfma_f32_32x32x16_bf16(PAF(0),VFR(0),o[0],0,0,0), C0,0);  VRX(0); \
    GAPB2(o[1]=__builtin_amdgcn_mfma_f32_32x32x16_bf16(PAF(0),VFR(4),o[1],0,0,0), C0,2);  VRX(4); \
    KRD(GL,0); GAPB2(o[0]=__builtin_amdgcn_mfma_f32_32x32x16_bf16(PAF(1),VFR(1),o[0],0,0,0), C0,4);  VRX(1); \
    KRD(GL,1); GAPB2(o[1]=__builtin_amdgcn_mfma_f32_32x32x16_bf16(PAF(1),VFR(5),o[1],0,0,0), C0,6);  VRX(5); \
    KRD(GL,2); GAPB2(o[0]=__builtin_amdgcn_mfma_f32_32x32x16_bf16(PAF(2),VFR(2),o[0],0,0,0), C0,8);  VRX(2); \
    KRD(GL,3); GAPB2(o[1]=__builtin_amdgcn_mfma_f32_32x32x16_bf16(PAF(2),VFR(6),o[1],0,0,0), C0,10); VRX(6); \
    GAPB2(o[0]=__builtin_amdgcn_mfma_f32_32x32x16_bf16(PAF(3),VFR(3),o[0],0,0,0), C0,12); VRX(3); \
    GAPB2(o[1]=__builtin_amdgcn_mfma_f32_32x32x16_bf16(PAF(3),VFR(7),o[1],0,0,0), C0,14); VRX(7); \
    GAPB2(o[2]=__builtin_amdgcn_mfma_f32_32x32x16_bf16(PAF(0),VFR(0),o[2],0,0,0), C1,0); \
    GAPB2(o[3]=__builtin_amdgcn_mfma_f32_32x32x16_bf16(PAF(0),VFR(4),o[3],0,0,0), C1,2); \
    GAPB2(o[2]=__builtin_amdgcn_mfma_f32_32x32x16_bf16(PAF(1),VFR(1),o[2],0,0,0), C1,4); \
    GAPB2(o[3]=__builtin_amdgcn_mfma_f32_32x32x16_bf16(PAF(1),VFR(5),o[3],0,0,0), C1,6); \
    GAPB2(o[2]=__builtin_amdgcn_mfma_f32_32x32x16_bf16(PAF(2),VFR(2),o[2],0,0,0), C1,8); \
    GAPB2(o[3]=__builtin_amdgcn_mfma_f32_32x32x16_bf16(PAF(2),VFR(6),o[3],0,0,0), C1,10); \
    GAPB2(o[2]=__builtin_amdgcn_mfma_f32_32x32x16_bf16(PAF(3),VFR(3),o[2],0,0,0), C1,12); \
    GAPB2(o[3]=__builtin_amdgcn_mfma_f32_32x32x16_bf16(PAF(3),VFR(7),o[3],0,0,0), C1,14); \
    }while(0)
  int t=1;
  #undef CMASK
  #define CMASK(P0,P1,t) do{}while(0)
  for(;t+5<NT;t+=2){
    STEP(pB0,pB1,pA0,pA1,t,true,true,true);     WAIT_BAR(3); RESC(); ROT();
    STEP(pA0,pA1,pB0,pB1,t+1,true,true,true);   WAIT_BAR(3); RESC(); ROT();
  }
  #undef CMASK
  #define CMASK(P0,P1,t) do{int jb_=(t)-(NT-4); if(jb_>=0)cmask(P0,P1,jb_,qrel,hi);}while(0)
  #define ENDW(tt) do{ if((tt)+3<NT){WAIT_BAR(3);} else if((tt)+2<NT){WAIT_BAR(2);} else {WAIT_BAR(0);} }while(0)
  for(;t+1<NT;t+=2){
    STEP(pB0,pB1,pA0,pA1,t,(t+3<NT),(t+1<NT),(t+1<NT));       ENDW(t);   RESC(); ROT();
    STEP(pA0,pA1,pB0,pB1,t+1,(t+4<NT),(t+2<NT),(t+2<NT));     ENDW(t+1); RESC(); ROT();
  }
  STEP(pB0,pB1,pA0,pA1,NT-1,false,false,false); RESC();
  { float sacc=pB0[0]+pB0[1]; _Pragma("unroll") for(int r=2;r<16;++r)sacc+=pB0[r]; _Pragma("unroll") for(int r=0;r<16;++r)sacc+=pB1[r]; l_reg+=sacc;
    pw0=(u32x4){PKW(pB0,0),PKW(pB0,2),PKW(pB0,4),PKW(pB0,6)};pw1=(u32x4){PKW(pB0,8),PKW(pB0,10),PKW(pB0,12),PKW(pB0,14)};pw2=(u32x4){PKW(pB1,0),PKW(pB1,2),PKW(pB1,4),PKW(pB1,6)};pw3=(u32x4){PKW(pB1,8),PKW(pB1,10),PKW(pB1,12),PKW(pB1,14)};
    SBAR(); pv128(o,vb0+2*sl_cur,PAF(0),PAF(1),PAF(2),PAF(3)); }
  #undef PKW
  #undef PAF
  #undef VFR
  #undef PIN
  #undef MX3
  #undef GAPA
  #undef GAPB
  #undef EX
  #undef VRD
  #undef VRX
  #undef GAPB2
  #undef KRD
  #undef STEP
  #undef ENDW
  {auto rr=__builtin_amdgcn_permlane32_swap(__float_as_uint(l_reg),__float_as_uint(l_reg),false,false);l_reg=__uint_as_float(rr[0])+__uint_as_float(rr[1]);}
  if(hi==0)wsf[32+r32]=l_reg;asm volatile("s_waitcnt lgkmcnt(0)":::"memory");
  float rli[16];
  #pragma unroll
  for(int r=0;r<16;++r)rli[r]=__builtin_amdgcn_rcpf(wsf[32+crow(r,hi)]);
  bf16*Ow=O+(rowbase+q0+wid*QBLK)*DM+hv*D;
  { bf16*stg=(bf16*)(shm+LDS_OST2)+wid*2048;
    #pragma unroll
    for(int hp=0;hp<2;++hp){
      #pragma unroll
      for(int r=0;r<16;++r){const int orow=crow(r,hi);
        #pragma unroll
        for(int d0=0;d0<2;++d0)stg[orow*64+d0*32+r32]=__float2bfloat16(o[2*hp+d0][r]*rli[r]);}
      asm volatile("s_waitcnt lgkmcnt(0)":::"memory");
      #pragma unroll
      for(int i=0;i<4;++i){const int row=i*8+(lane>>3),ch=lane&7; const u32x4 v=*(const u32x4*)(stg+row*64+ch*8); ATTN_STORE16(Ow+(long)row*DM+hp*64+ch*8,v);}
      asm volatile("s_waitcnt lgkmcnt(0)":::"memory"); } }
  asm volatile("s_waitcnt lgkmcnt(0)\n\ts_barrier":::"memory");
  #undef DMA_K
  #undef DMA_V
  #undef CMASK
  #undef START
  #undef RESC
  #undef ROT
}
constexpr int ATTN_LDS_BYTES=LDS_BYTES;
#undef SBAR
#undef WAIT_BAR
}
#define GAS __attribute__((address_space(1)))
#define LAS __attribute__((address_space(3)))
typedef unsigned short bf16;
typedef unsigned v4u __attribute__((ext_vector_type(4)));
typedef float f32x4 __attribute__((ext_vector_type(4)));
typedef short bf16x8 __attribute__((ext_vector_type(8)));
typedef GAS unsigned gu32;
typedef GAS unsigned long long gu64;
#define RLX_AGENT __ATOMIC_RELAXED, __HIP_MEMORY_SCOPE_AGENT
#define LDS_WAIT() asm volatile("s_waitcnt lgkmcnt(0)" ::: "memory")
#define VM_WAIT() asm volatile("s_waitcnt vmcnt(0)" ::: "memory")
__device__ __forceinline__ unsigned long long rt() { return __builtin_amdgcn_s_memrealtime(); }
__device__ __forceinline__ unsigned f2bf(float f) { unsigned u = __builtin_bit_cast(unsigned, f); return (u + 0x7fffu + ((u >> 16) & 1u)) >> 16; }
__device__ __forceinline__ unsigned pk2(float lo, float hi) { return f2bf(lo) | (f2bf(hi) << 16); }

#define XB_TMO      128
#define XB_XCNT(j)  (256  + 64 * (j))
#define XB_XSUB(j)  (1280 + 64 * (j))
#define XB_XGEN(j)  (2304 + 64 * (j))
#define XB_TOP      3328
#define XB_TOPGEN   3392
#define XCD_BAR_WORDS 3456
#define XB_SPIN_CAP (1u << 18)

__device__ __forceinline__ unsigned xb_ld(unsigned* p)              { return __hip_atomic_load(p, __ATOMIC_RELAXED, __HIP_MEMORY_SCOPE_AGENT); }
__device__ __forceinline__ unsigned xb_add(unsigned* p, unsigned v) { return __hip_atomic_fetch_add(p, v, __ATOMIC_RELAXED, __HIP_MEMORY_SCOPE_AGENT); }
__device__ __forceinline__ unsigned xb_xcc_id() { return (unsigned)__builtin_amdgcn_s_getreg((3 << 11) | 20) & 0xFu; }
#define XB_SPIN(cond, bar) do { unsigned _sp = 0; while (cond) { __builtin_amdgcn_s_sleep(1); \
    if ((++_sp & 255u) == 0u) { if (xb_ld(&(bar)[XB_TMO])) break; if (_sp > XB_SPIN_CAP) { atomicAdd(&(bar)[XB_TMO], 1u); break; } } } } while (0)

struct XcdBarrier {
    unsigned* bar; unsigned x;
    volatile LAS unsigned* st;
};

__device__ __forceinline__ XcdBarrier xcd_barrier_post(unsigned* bar, volatile LAS unsigned* st) {
    XcdBarrier b; b.bar = bar; b.x = xb_xcc_id(); b.st = st;
    if (threadIdx.x == 0) (void)xb_add(&bar[XB_XCNT(b.x)], 1u);
    return b;
}
__device__ __forceinline__ void xcd_barrier_complete(unsigned* bar, unsigned x, unsigned& nloc, unsigned& nx) {
    const unsigned G = gridDim.x * gridDim.y * gridDim.z;
    unsigned sum, cnt, mine, sp = 0u;
    for (;;) {
        sum = 0u; cnt = 0u;
#pragma unroll
        for (unsigned j = 0; j < 16; ++j) { const unsigned c = xb_ld(&bar[XB_XCNT(j)]); sum += c; cnt += (c > 0u) ? 1u : 0u; }
        if (sum == G) break;
        __builtin_amdgcn_s_sleep(1);
        if ((++sp & 255u) == 0u) { if (xb_ld(&bar[XB_TMO])) break; if (sp > XB_SPIN_CAP) { atomicAdd(&bar[XB_TMO], 1u); break; } }
    }
    mine = xb_ld(&bar[XB_XCNT(x)]);
    nloc = mine > 0u ? mine : 1u; nx = cnt > 0u ? cnt : 1u;
}

__device__ __forceinline__ void xcd_barrier(const XcdBarrier& b) {
    asm volatile("s_waitcnt vmcnt(0)" ::: "memory");
    __syncthreads();
    if (threadIdx.x == 0) {
        unsigned* bar = b.bar;
        __builtin_amdgcn_s_waitcnt(0);
        unsigned nloc = b.st[0], nx = b.st[1];
        if (nloc == 0u) { xcd_barrier_complete(bar, b.x, nloc, nx); b.st[0] = nloc; b.st[1] = nx; }
        const unsigned old = xb_add(&bar[XB_XSUB(b.x)], 1u);
        const unsigned gen = old / nloc;
        if (old + 1u == (gen + 1u) * nloc) {
            __builtin_amdgcn_fence(__ATOMIC_RELEASE, "agent");
            asm volatile("s_waitcnt vmcnt(0)" ::: "memory");
            const unsigned og = xb_add(&bar[XB_TOP], 1u);
            const unsigned tg = og / nx;
            if (og + 1u == (tg + 1u) * nx) xb_add(&bar[XB_TOPGEN], 1u);
            else XB_SPIN(xb_ld(&bar[XB_TOPGEN]) == tg, bar);
            __builtin_amdgcn_fence(__ATOMIC_ACQUIRE, "agent");
            xb_add(&bar[XB_XGEN(b.x)], 1u);
            asm volatile("s_waitcnt vmcnt(0)" ::: "memory");
        } else {
            XB_SPIN(xb_ld(&bar[XB_XGEN(b.x)]) == gen, bar);
            __builtin_amdgcn_fence(__ATOMIC_ACQUIRE, "agent");
            asm volatile("s_waitcnt vmcnt(0)" ::: "memory");
        }
    }
    __syncthreads();
}
constexpr int NWAVES = 8;
constexpr int DM = 1024, MP = 32768, MS = 512, MROWS = MP + MS, NSEQ = 20, DEPTH = 4, DFF = 2816, DIN = 9216, PAST = 2048;
constexpr int NCHUNK_P = 512, NCHUNK = 528;
constexpr float EPS = 1e-6f;
constexpr size_t OY_P = 0, OY_S = 33554432, OK_P = 34078720, OV_P = 168296448, OS_P = 302514176, OK_S = 304611328, OV_S = 306708480, OS_S = 308805632, OUT_TOTAL = 317194240;

constexpr size_t MiB = 1u << 20;
constexpr size_t WS_CTL = 0, CTL_ZERO_BYTES = 1 * MiB;
constexpr size_t WS_MOD = 1 * MiB;
constexpr size_t WS_LB = 4 * MiB;
constexpr size_t WS_W = 8 * MiB, W_LAYER = 57 * MiB;
constexpr size_t WO_GU1 = 0, WO_D1 = 11 * MiB, WO_IN = 16 * MiB + MiB / 2, WO_BA = 34 * MiB + MiB / 2, WO_BH = 36 * MiB + MiB / 2, WO_OUT = 38 * MiB + MiB / 2, WO_GU2 = 40 * MiB + MiB / 2, WO_D2 = 51 * MiB + MiB / 2;
constexpr size_t WS_X = 240 * MiB;
constexpr size_t WS_XN = 370 * MiB;
constexpr size_t WS_Q = 435 * MiB, WS_K = 500 * MiB, WS_V = 565 * MiB;
constexpr size_t WS_QQ = 630 * MiB, WS_KK = 695 * MiB, WS_VV = 760 * MiB, WS_HGS = 825 * MiB, WS_SZA = 890 * MiB, WS_SZH = 955 * MiB;
constexpr size_t WS_LOGF = 1020 * MiB;
constexpr size_t WS_O1 = 1150 * MiB, WS_O2 = 1215 * MiB, WS_OATT = 1280 * MiB, WS_OH = 1345 * MiB, WS_MRG = 1410 * MiB;
constexpr size_t WS_BIG = 1475 * MiB;
constexpr size_t WS_SST = 1739 * MiB;
constexpr size_t WS_DD = 1871 * MiB;
constexpr size_t WS_END = 1874 * MiB;
constexpr int T_TEAM = 32;
constexpr int HG_G = 4;
constexpr size_t WS_QS = WS_BIG, WS_SL = WS_BIG + 64 * MiB, WS_DSEG = WS_BIG + 72 * MiB, WS_RAW = WS_SST;
constexpr int CW_BAR = 4096, CW_Q = 8192, CW_HS = 16384;
static_assert(pg8::EpiWin::O_Q == WS_Q && pg8::EpiWin::O_K == WS_K && pg8::EpiWin::O_V == WS_V && pg8::EpiWin::O_QQ == WS_QQ && pg8::EpiWin::O_KK == WS_KK && pg8::EpiWin::O_VV == WS_VV && pg8::EpiWin::O_HGS == WS_HGS && pg8::EpiWin::O_SZA == WS_SZA && pg8::EpiWin::O_SZH == WS_SZH && pg8::EpiWin::O_LOGF == WS_LOGF && pg8::EpiWin::O_LB == WS_LB && pg8::EpiWin::OK_P_ == OK_P && pg8::EpiWin::OV_P_ == OV_P && pg8::EpiWin::OK_S_ == OK_S && pg8::EpiWin::OV_S_ == OV_S, "EpiWin offsets");

constexpr int RING_OFF = 0, RING_BYTES = 139264;
constexpr int LDSCTL_OFF = RING_BYTES, MISC_OFF = LDSCTL_OFF + 320;
constexpr int LDS_BYTES = 147456;

struct Frame {
    LAS unsigned char* lds;
    volatile LAS unsigned* MISC;
    gu32* ctl;
    int tid, lane, wave;
    int vcu, G;
};
typedef float f32x16 __attribute__((ext_vector_type(16)));
typedef unsigned v2u __attribute__((ext_vector_type(2)));

__device__ __forceinline__ float wave_sum(float v) {
#pragma unroll
    for (int o = 1; o < 64; o <<= 1) v += __shfl_xor(v, o);
    return v;
}
__device__ __forceinline__ float bf2f(bf16 b) { return __builtin_bit_cast(float, (unsigned)b << 16); }
__device__ __forceinline__ unsigned cvtpk(float lo, float hi) { return pg8::cvt_pk_bf16(lo, hi); }
__device__ __forceinline__ bf16x8 pack8(f32x4 a, f32x4 b) { v4u w; w.x = cvtpk(a[0], a[1]); w.y = cvtpk(a[2], a[3]); w.z = cvtpk(b[0], b[1]); w.w = cvtpk(b[2], b[3]); return __builtin_bit_cast(bf16x8, w); }
__device__ __forceinline__ float lam_init_of(int l) { asm volatile("" : "+s"(l)); return 0.8f - 0.6f * __expf(-0.3f * (float)l); }

__device__ __forceinline__ void p0_transpose_item(const float* W, int K, int N, bf16* WT, bool gu, LAS float* scr, int item, int lane) {
    const int nblk = N / 32, kb = item / nblk, nb = item % nblk, k0 = 64 * kb, nd0 = 32 * nb;
    const int ns0 = gu ? (((nd0 >> 7) & 1) * 2816 + (nd0 >> 8) * 128 + (nd0 & 127)) : nd0;
#pragma unroll 8
    for (int i = 0; i < 32; ++i) { const int kk = 2 * i + (lane >> 5); scr[kk * 33 + (lane & 31)] = W[(size_t)(k0 + kk) * N + ns0 + (lane & 31)]; }
    LDS_WAIT(); asm volatile("" ::: "memory");
    const int c = lane & 7;
#pragma unroll
    for (int j = 0; j < 4; ++j) { const int n = (lane >> 3) + 8 * j; const LAS float* s = scr + (8 * c) * 33 + n;
        v4u o; o.x = pk2(s[0 * 33], s[1 * 33]); o.y = pk2(s[2 * 33], s[3 * 33]); o.z = pk2(s[4 * 33], s[5 * 33]); o.w = pk2(s[6 * 33], s[7 * 33]);
        *(GAS v4u*)(WT + (size_t)(nd0 + n) * K + k0 + 8 * c) = o; }
    LDS_WAIT(); asm volatile("" ::: "memory");
}
typedef const __attribute__((address_space(4))) char* kaptr_t;
__device__ __forceinline__ const float* karg(int i) { kaptr_t ka = (kaptr_t)__builtin_amdgcn_kernarg_segment_ptr(); asm volatile("" : "+s"(ka)); return *(const float* const __attribute__((address_space(4)))*)(ka + 8 * i); }
enum { A_XP = 0, A_XS, A_CK, A_CV, A_ST, A_CP, A_CS, A_WADA, A_BADA, A_GFFN1, A_WGU1, A_WD1, A_GMIX, A_WIN, A_LAM, A_GSUB, A_LBL, A_GHG, A_WBA, A_WBH, A_WOUT, A_GFFN2, A_WGU2, A_WD2, A_GFIN, A_OUT, A_WS };
__device__ __forceinline__ void p0_prologue(Frame& F, unsigned char* ws) {
    { LAS float* scr = (LAS float*)(F.lds + RING_OFF + F.wave * 16384);
      const int gw = F.vcu * NWAVES + F.wave, NGW = F.G * NWAVES;
      constexpr int I_GU = 16 * 176, I_D = 44 * 32, I_IN = 16 * 288, I_SQ = 16 * 32, I_LAYER = 2 * I_GU + 2 * I_D + I_IN + 3 * I_SQ;
      for (int it = gw; it < DEPTH * I_LAYER; it += NGW) {
          const int l = it / I_LAYER; int r = it % I_LAYER; unsigned char* wl = ws + WS_W + (size_t)l * W_LAYER;
          if (r < I_GU) { p0_transpose_item(karg(A_WGU1) + (size_t)l * 1024 * 5632, 1024, 5632, (bf16*)(wl + WO_GU1), true, scr, r, F.lane); continue; } r -= I_GU;
          if (r < I_D)  { p0_transpose_item(karg(A_WD1) + (size_t)l * 2816 * 1024, 2816, 1024, (bf16*)(wl + WO_D1), false, scr, r, F.lane); continue; } r -= I_D;
          if (r < I_IN) { p0_transpose_item(karg(A_WIN) + (size_t)l * 1024 * 9216, 1024, 9216, (bf16*)(wl + WO_IN), false, scr, r, F.lane); continue; } r -= I_IN;
          if (r < I_SQ) { p0_transpose_item(karg(A_WBA) + (size_t)l * 1024 * 1024, 1024, 1024, (bf16*)(wl + WO_BA), false, scr, r, F.lane); continue; } r -= I_SQ;
          if (r < I_SQ) { p0_transpose_item(karg(A_WBH) + (size_t)l * 1024 * 1024, 1024, 1024, (bf16*)(wl + WO_BH), false, scr, r, F.lane); continue; } r -= I_SQ;
          if (r < I_SQ) { p0_transpose_item(karg(A_WOUT) + (size_t)l * 1024 * 1024, 1024, 1024, (bf16*)(wl + WO_OUT), false, scr, r, F.lane); continue; } r -= I_SQ;
          if (r < I_GU) { p0_transpose_item(karg(A_WGU2) + (size_t)l * 1024 * 5632, 1024, 5632, (bf16*)(wl + WO_GU2), true, scr, r, F.lane); continue; } r -= I_GU;
          p0_transpose_item(karg(A_WD2) + (size_t)l * 2816 * 1024, 2816, 1024, (bf16*)(wl + WO_D2), false, scr, r, F.lane);
      } }
    __syncthreads();
    { const float* c_p = karg(A_CP); const float* c_s = karg(A_CS); const float* w_ada = karg(A_WADA); const float* b_ada = karg(A_BADA);
      LAS float* ca = (LAS float*)(F.lds);
      LAS float* red = (LAS float*)(F.lds + 81920);
      for (int i = F.tid; i < NSEQ * 1024; i += NWAVES * 64) { const int s = i >> 10, k = i & 1023; const float c = s < 4 ? c_p[s * 1024 + k] : c_s[(s - 4) * 1024 + k]; ca[i] = pg8::silu_f(c); }
      __syncthreads();
      float* MOD = (float*)(ws + WS_MOD);
      for (int it = F.vcu; it < DEPTH * 144; it += F.G) {
          const int l = it / 144, n = (it % 144) * 64 + F.lane; const float* wp = w_ada + ((size_t)l * 1024 + F.wave * 128) * 9216 + n;
          float acc[NSEQ];
#pragma unroll
          for (int s = 0; s < NSEQ; ++s) acc[s] = 0.f;
#pragma unroll 4
          for (int k = 0; k < 128; ++k) { const float w = wp[(size_t)k * 9216];
#pragma unroll
              for (int s = 0; s < NSEQ; ++s) acc[s] += ca[s * 1024 + F.wave * 128 + k] * w; }
#pragma unroll
          for (int s = 0; s < NSEQ; ++s) red[(F.wave * NSEQ + s) * 64 + F.lane] = acc[s];
          __syncthreads();
          for (int i = F.tid; i < NSEQ * 64; i += NWAVES * 64) { const int s = i >> 6, c = i & 63; float v = 0.f;
#pragma unroll
              for (int w = 0; w < 8; ++w) v += red[(w * NSEQ + s) * 64 + c];
              const int nn = (it % 144) * 64 + c; MOD[((size_t)l * NSEQ + s) * 9216 + nn] = v + b_ada[(size_t)l * 9216 + nn]; }
          __syncthreads();
      } }
    if (F.vcu == 0) { float* LB = (float*)(ws + WS_LB); const float* lb_logits = karg(A_LBL);
        for (int c = F.tid; c < 1024; c += NWAVES * 64) { float lg[4], mx = -INFINITY;
#pragma unroll
            for (int l = 0; l < 4; ++l) { lg[l] = lb_logits[l * 1024 + c]; mx = __builtin_fmaxf(mx, lg[l]); }
            float sum = 0.f;
#pragma unroll
            for (int l = 0; l < 4; ++l) { lg[l] = __expf(lg[l] - mx); sum += lg[l]; }
            const float inv = 1.f / sum; float cs = 0.f;
#pragma unroll
            for (int l = 0; l < 4; ++l) { cs += lg[l] * inv; LB[l * 1024 + c] = cs - lg[0] * inv; } } }
}

__device__ __forceinline__ void norm_phase(Frame& F, const float* x_p, const float* x_s, bool first, float* X, const float* g, const float* mod_l, int sub, bf16* XN, int row0, int row1, int gw, int NGW) {
    for (int row = row0 + gw; row < row1; row += NGW) {
        const float* src = first ? (row < MP ? x_p + (size_t)row * DM : x_s + (size_t)(row - MP) * DM) : X + (size_t)row * DM;
        const float* mp = mod_l + (size_t)pg8::row_seq(row) * 9216 + sub * 3 * 1024;
        const f32x4* xr = (const f32x4*)src + F.lane; f32x4 v[4]; float s2 = 0.f;
#pragma unroll
        for (int j = 0; j < 4; ++j) { v[j] = xr[64 * j]; s2 += (v[j].x * v[j].x + v[j].y * v[j].y) + (v[j].z * v[j].z + v[j].w * v[j].w); }
        const float rstd = __builtin_amdgcn_rsqf(wave_sum(s2) * (1.f / DM) + EPS);
        if (first) { f32x4* xo = (f32x4*)(X + (size_t)row * DM) + F.lane;
#pragma unroll
            for (int j = 0; j < 4; ++j) xo[64 * j] = v[j]; }
        v2u* o8 = (v2u*)(XN + (size_t)row * DM) + F.lane;
#pragma unroll
        for (int j = 0; j < 4; ++j) { const int c = 4 * F.lane + 256 * j; const f32x4 gg = *(const f32x4*)(g + c), sh = *(const f32x4*)(mp + c), sc = *(const f32x4*)(mp + 1024 + c);
            const f32x4 h = (v[j] * rstd) * gg * (sc + 1.f) + sh; v2u o; o.x = cvtpk(h.x, h.y); o.y = cvtpk(h.z, h.w); o8[64 * j] = o; }
    }
}
__device__ __forceinline__ void final_norm_phase(Frame& F, const float* X, const float* g, float* out) {
    const int gw = F.vcu * NWAVES + F.wave, NGW = F.G * NWAVES;
    for (int row = gw; row < MROWS; row += NGW) {
        const f32x4* xr = (const f32x4*)(X + (size_t)row * DM) + F.lane; f32x4 v[4]; float s2 = 0.f;
#pragma unroll
        for (int j = 0; j < 4; ++j) { v[j] = xr[64 * j]; s2 += (v[j].x * v[j].x + v[j].y * v[j].y) + (v[j].z * v[j].z + v[j].w * v[j].w); }
        const float rstd = __builtin_amdgcn_rsqf(wave_sum(s2) * (1.f / DM) + EPS);
        f32x4* o = (f32x4*)(out + (row < MP ? OY_P + (size_t)row * DM : OY_S + (size_t)(row - MP) * DM)) + F.lane;
#pragma unroll
        for (int j = 0; j < 4; ++j) { const f32x4 gg = *(const f32x4*)(g + 4 * F.lane + 256 * j); o[64 * j] = (v[j] * rstd) * gg; }
    }
}
__device__ __forceinline__ float lam_of(const float* att_lambda, int l, int lane) {
    const float* lp = att_lambda + (size_t)l * 256;
    const float a = wave_sum(lp[lane] * lp[64 + lane]), b = wave_sum(lp[128 + lane] * lp[192 + lane]);
    return __expf(a) - __expf(b) + lam_init_of(l);
}
__device__ __forceinline__ void attn_combine_phase(Frame& F, const bf16* O1, const bf16* O2, const float* gsub, float lam, float osc, bf16* OATT) {
    const int gw = F.vcu * NWAVES + F.wave, NGW = F.G * NWAVES; const int cl = (F.lane & 7) * 16;
    float gv[16];
#pragma unroll
    for (int i = 0; i < 16; ++i) gv[i] = gsub[cl + i] * osc;
    for (int row = gw; row < MP; row += NGW) {
        const size_t off = (size_t)row * DM + F.lane * 16; const v4u a0 = *(const v4u*)(O1 + off), a1 = *(const v4u*)(O1 + off + 8), b0 = *(const v4u*)(O2 + off), b1 = *(const v4u*)(O2 + off + 8);
        const unsigned aw[8] = {a0.x, a0.y, a0.z, a0.w, a1.x, a1.y, a1.z, a1.w}, bw[8] = {b0.x, b0.y, b0.z, b0.w, b1.x, b1.y, b1.z, b1.w};
        float o[16]; float ss = 0.f;
#pragma unroll
        for (int i = 0; i < 8; ++i) { o[2 * i] = pg8::bf_lo(aw[i]) - lam * pg8::bf_lo(bw[i]); o[2 * i + 1] = pg8::bf_hi(aw[i]) - lam * pg8::bf_hi(bw[i]); ss += o[2 * i] * o[2 * i] + o[2 * i + 1] * o[2 * i + 1]; }
        ss += __shfl_xor(ss, 1); ss += __shfl_xor(ss, 2); ss += __shfl_xor(ss, 4);
        const float rstd = __builtin_amdgcn_rsqf(ss * (1.f / 128.f) + EPS);
        v4u w0, w1;
        w0.x = cvtpk(o[0] * rstd * gv[0], o[1] * rstd * gv[1]); w0.y = cvtpk(o[2] * rstd * gv[2], o[3] * rstd * gv[3]); w0.z = cvtpk(o[4] * rstd * gv[4], o[5] * rstd * gv[5]); w0.w = cvtpk(o[6] * rstd * gv[6], o[7] * rstd * gv[7]);
        w1.x = cvtpk(o[8] * rstd * gv[8], o[9] * rstd * gv[9]); w1.y = cvtpk(o[10] * rstd * gv[10], o[11] * rstd * gv[11]); w1.z = cvtpk(o[12] * rstd * gv[12], o[13] * rstd * gv[13]); w1.w = cvtpk(o[14] * rstd * gv[14], o[15] * rstd * gv[15]);
        *(v4u*)(OATT + off) = w0; *(v4u*)(OATT + off + 8) = w1;
    }
}

__device__ __forceinline__ void attn_sample_unit(Frame& F, const float* cache_k, const float* cache_v, int l, int s, int head, const bf16* Qb, const bf16* Kb, const bf16* Vb, float lam, float osc, const float* gsub, bf16* OATT) {
    const int lane = F.lane, w = F.wave, q = lane & 31, hh = lane >> 5, vt = w & 3, kh = w >> 2;
    LAS float* SLOT = (LAS float*)(F.lds);
    LAS float* ML = (LAS float*)(F.lds + 16384);
    LAS float* SSQ = (LAS float*)(F.lds + 16384 + 512);
    const size_t qrow = (size_t)MP + (size_t)s * 32;
    const float* ck = cache_k + ((size_t)(l * 16 + s) * PAST) * 1024 + head * 128;
    const float* cv = cache_v + ((size_t)(l * 16 + s) * PAST) * 1024 + head * 128;
    f32x16 o1;
#pragma unroll
    for (int r = 0; r < 16; ++r) o1[r] = 0.f;
    for (int m = 0; m < 2; ++m) {
        bf16x8 qf[4];
#pragma unroll
        for (int ks = 0; ks < 4; ++ks) qf[ks] = *(const bf16x8*)(Qb + (qrow + q) * 1024 + head * 128 + m * 64 + ks * 16 + 8 * hh);
        float mrun = -INFINITY, lrun = 0.f; f32x16 ot;
#pragma unroll
        for (int r = 0; r < 16; ++r) ot[r] = 0.f;
        const int ntile = 32 + kh;
        for (int t = 0; t < ntile; ++t) {
            const bool nw = (t == 32); const int key0 = kh * 1024 + t * 32;
            bf16x8 kf[4];
            if (!nw) { const float* kp = ck + (size_t)(key0 + q) * 1024 + m * 64 + 8 * hh;
#pragma unroll
                for (int ks = 0; ks < 4; ++ks) { const f32x4 a = *(const f32x4*)(kp + ks * 16), b = *(const f32x4*)(kp + ks * 16 + 4); kf[ks] = pack8(a, b); } }
            else {
#pragma unroll
                for (int ks = 0; ks < 4; ++ks) kf[ks] = *(const bf16x8*)(Kb + (qrow + q) * 1024 + head * 128 + m * 64 + ks * 16 + 8 * hh); }
            float vf[2][8];
            { const float* vp = cv + (size_t)(key0 + 4 * hh) * 1024 + 32 * vt + q; const bf16* vpn = Vb + (qrow + 4 * hh) * 1024 + head * 128 + 32 * vt + q;
#pragma unroll
              for (int s2 = 0; s2 < 2; ++s2)
#pragma unroll
                  for (int j = 0; j < 8; ++j) { const int kr = 16 * s2 + 8 * (j >> 2) + (j & 3);
                      vf[s2][j] = nw ? bf2f(vpn[kr * 1024]) : vp[kr * 1024]; } }
            f32x16 st;
#pragma unroll
            for (int r = 0; r < 16; ++r) st[r] = 0.f;
#pragma unroll
            for (int ks = 0; ks < 4; ++ks) st = __builtin_amdgcn_mfma_f32_32x32x16_bf16(kf[ks], qf[ks], st, 0, 0, 0);
            float tm = st[0];
#pragma unroll
            for (int r = 1; r < 16; ++r) tm = __builtin_fmaxf(tm, st[r]);
            tm = __builtin_fmaxf(tm, __shfl_xor(tm, 32));
            const float mnew = __builtin_fmaxf(mrun, tm), alpha = __builtin_amdgcn_exp2f(mrun - mnew);
            float ls = 0.f;
#pragma unroll
            for (int r = 0; r < 16; ++r) { st[r] = __builtin_amdgcn_exp2f(st[r] - mnew); ls += st[r]; }
            ls += __shfl_xor(ls, 32);
            lrun = lrun * alpha + ls; mrun = mnew;
#pragma unroll
            for (int r = 0; r < 16; ++r) ot[r] *= alpha;
#pragma unroll
            for (int s2 = 0; s2 < 2; ++s2) { v4u pw; pw.x = cvtpk(st[8 * s2], st[8 * s2 + 1]); pw.y = cvtpk(st[8 * s2 + 2], st[8 * s2 + 3]); pw.z = cvtpk(st[8 * s2 + 4], st[8 * s2 + 5]); pw.w = cvtpk(st[8 * s2 + 6], st[8 * s2 + 7]);
                v4u aw; aw.x = cvtpk(vf[s2][0], vf[s2][1]); aw.y = cvtpk(vf[s2][2], vf[s2][3]); aw.z = cvtpk(vf[s2][4], vf[s2][5]); aw.w = cvtpk(vf[s2][6], vf[s2][7]);
                ot = __builtin_amdgcn_mfma_f32_32x32x16_bf16(__builtin_bit_cast(bf16x8, aw), __builtin_bit_cast(bf16x8, pw), ot, 0, 0, 0); }
        }
        if (vt == 0 && hh == 0) { ML[(kh * 32 + q) * 2] = mrun; ML[(kh * 32 + q) * 2 + 1] = lrun; }
        __syncthreads();
        const float m0 = ML[q * 2], l0 = ML[q * 2 + 1], m1 = ML[(32 + q) * 2], l1 = ML[(32 + q) * 2 + 1];
        const float Mx = __builtin_fmaxf(m0, m1), L = l0 * __builtin_amdgcn_exp2f(m0 - Mx) + l1 * __builtin_amdgcn_exp2f(m1 - Mx);
        { const float sc = __builtin_amdgcn_exp2f(mrun - Mx);
#pragma unroll
          for (int r = 0; r < 16; ++r) ot[r] *= sc; }
        if (kh == 1) {
#pragma unroll
            for (int r = 0; r < 16; ++r) SLOT[(vt * 16 + r) * 64 + lane] = ot[r]; }
        __syncthreads();
        if (kh == 0) { const float rl = 1.f / L;
#pragma unroll
            for (int r = 0; r < 16; ++r) ot[r] = (ot[r] + SLOT[(vt * 16 + r) * 64 + lane]) * rl;
            if (m == 0) {
#pragma unroll
                for (int r = 0; r < 16; ++r) o1[r] = ot[r];
            } else { float ss = 0.f;
#pragma unroll
                for (int r = 0; r < 16; ++r) { o1[r] = o1[r] - lam * ot[r]; ss += o1[r] * o1[r]; }
                ss += __shfl_xor(ss, 32);
                if (hh == 0) SSQ[vt * 32 + q] = ss; } }
        __syncthreads();
    }
    if (kh == 0) {
        const float ss = SSQ[q] + SSQ[32 + q] + SSQ[64 + q] + SSQ[96 + q];
        const float rstd = __builtin_amdgcn_rsqf(ss * (1.f / 128.f) + EPS) * osc;
#pragma unroll
        for (int r = 0; r < 16; ++r) { const int v = 32 * vt + (r & 3) + 8 * (r >> 2) + 4 * hh; OATT[(qrow + q) * 1024 + head * 128 + v] = (bf16)f2bf(o1[r] * rstd * gsub[v]); }
    }
    __syncthreads();
}

constexpr int HS = 72, HK = 136;
__device__ __forceinline__ f32x4 mfma16(bf16x8 a, bf16x8 b, f32x4 c) { return __builtin_amdgcn_mfma_f32_16x16x32_bf16(a, b, c, 0, 0, 0); }
__device__ __forceinline__ void st16bf(LAS bf16* p, const float (&v)[16]) {
    v4u a, b; a.x = cvtpk(v[0], v[1]); a.y = cvtpk(v[2], v[3]); a.z = cvtpk(v[4], v[5]); a.w = cvtpk(v[6], v[7]); b.x = cvtpk(v[8], v[9]); b.y = cvtpk(v[10], v[11]); b.z = cvtpk(v[12], v[13]); b.w = cvtpk(v[14], v[15]);
    *(LAS v4u*)p = a; *(LAS v4u*)(p + 8) = b;
}
__device__ __forceinline__ float bfu(unsigned b) { return __builtin_bit_cast(float, b << 16); }
struct HgPtrs { const float* LOGF; const bf16 *QQ, *KK, *VV, *HGS; const float* ghg; bf16* OH; bf16* dump; };
typedef float f32x2v __attribute__((ext_vector_type(2)));
__device__ __forceinline__ void hg_load(const HgPtrs& P, size_t ubase  , unsigned k0, int w, int nvalid, f32x2v (&lf)[8], unsigned (&qv)[8], unsigned (&kv)[8], unsigned (&vv)[8]) {
    if (w * 8 < nvalid) {
#pragma unroll
        for (int i = 0; i < 8; ++i) { const size_t o = ubase + (size_t)(w * 8 + i) * 1024;
            const float* lp = P.LOGF + o; const bf16* qp = P.QQ + o; const bf16* kp = P.KK + o; const bf16* vp = P.VV + o;
            lf[i] = *(const f32x2v*)(lp + k0); qv[i] = *(const unsigned*)(qp + k0); kv[i] = *(const unsigned*)(kp + k0); vv[i] = *(const unsigned*)(vp + k0); }
    } else {
#pragma unroll
        for (int i = 0; i < 8; ++i) { lf[i] = (f32x2v){0.f, 0.f}; qv[i] = 0u; kv[i] = 0u; vv[i] = 0u; }
    }
}
#define HG_BAR() asm volatile("s_waitcnt lgkmcnt(0)\n\ts_barrier" ::: "memory")
template <int MODE> __device__ __forceinline__ void hg_sequence(Frame& F, const HgPtrs& P, size_t row0, int h, int nchunk, int nvalid, const float* s_in, float* s_out, bf16* QS, float* RAW, float* dseg) {
    LAS float* seg = (LAS float*)(F.lds);
    LAS float* part = (LAS float*)(F.lds + 4096);
    LAS float* dvec = (LAS float*)(F.lds + 6144);
    LAS bf16* QH = (LAS bf16*)(F.lds + 8192);
    LAS bf16* QT = QH + 64 * HK;
    LAS bf16* KH = QT + 64 * HK;
    LAS bf16* VT = KH + 160 * HK;
    LAS bf16* KT = VT + 128 * HS;
    LAS bf16* AL = KT + 128 * HS;
    const int w = __builtin_amdgcn_readfirstlane(F.wave), sc = w >> 1, lr_ = F.lane & 15, lq_ = F.lane >> 4; const unsigned k0_ = 2u * (unsigned)F.lane;
    f32x4 S[8];
#pragma unroll
    for (int kb = 0; kb < 8; ++kb)
#pragma unroll
        for (int r = 0; r < 4; ++r) S[kb][r] = s_in ? s_in[(size_t)(16 * kb + 4 * lq_ + r) * 128 + 16 * w + lr_] : 0.f;
    const float gv = P.ghg[16 * w + lr_];
    f32x2v bseg = {0.f, 0.f};
    f32x2v lf[8]; unsigned qv[8], kv[8], vv[8];
    hg_load(P, row0 * 1024 + h * 128, k0_, w, nvalid, lf, qv, kv, vv);
    for (int c = 0; c < nchunk; ++c) {
        int lr = lr_, lq = lq_; unsigned k0 = k0_; asm volatile("" : "+v"(lr), "+v"(lq), "+v"(k0));
        const size_t crow = row0 + (size_t)c * 64;
        f32x2v cs[8]; { f32x2v run = {0.f, 0.f};
#pragma unroll
            for (int i = 0; i < 8; ++i) { run = run + lf[i]; cs[i] = run; }
            *(LAS f32x2v*)(seg + w * 128 + k0) = run; }
        HG_BAR();
        f32x2v P2[4], mypre = {0.f, 0.f}, tot; { f32x2v p = {0.f, 0.f};
#pragma unroll
            for (int s = 0; s < 8; ++s) { if ((s & 1) == 0) P2[s >> 1] = p; mypre = (s == w) ? p : mypre; p = p + *(const LAS f32x2v*)(seg + s * 128 + k0); } tot = p; }
        f32x2v myref = P2[0], nref = P2[1];
#pragma unroll
        for (int s = 1; s < 4; ++s) { myref = (s == sc) ? P2[s] : myref; nref = (s == sc) ? (s == 3 ? tot : P2[s < 3 ? s + 1 : 3]) : nref; }
        const f32x2v dq = mypre - myref;
        f32x2v fq, fT, fK[4]; fq.x = __expf(myref.x); fq.y = __expf(myref.y); fT.x = __expf(tot.x - nref.x); fT.y = __expf(tot.y - nref.y);
#pragma unroll
        for (int ii = 1; ii < 4; ++ii) { fK[ii].x = __expf(__builtin_fminf(P2[ii].x - nref.x, 0.f)); fK[ii].y = __expf(__builtin_fminf(P2[ii].y - nref.y, 0.f)); }
        f32x2v fqs = fq; if constexpr (MODE == 1) { fqs.x = fq.x * __expf(bseg.x); fqs.y = fq.y * __expf(bseg.y); bseg = bseg + tot; }
        float t0[8], t1[8];
#pragma unroll
        for (int i = 0; i < 8; ++i) { const int r = w * 8 + i; const float q0 = bfu(qv[i] & 0xffffu), q1 = bfu(qv[i] >> 16), a0 = bfu(kv[i] & 0xffffu), a1 = bfu(kv[i] >> 16);
            const float E0 = dq.x + cs[i].x, E1 = dq.y + cs[i].y;
            const float e1x = __expf(E0), e1y = __expf(E1);
            const float e2x = __builtin_fminf(__builtin_amdgcn_rcpf(e1x), 5.5e34f), e2y = __builtin_fminf(__builtin_amdgcn_rcpf(e1y), 5.5e34f);
            const float e3x = __expf((nref.x - myref.x) - E0), e3y = __expf((nref.y - myref.y) - E1);
            *(LAS unsigned*)(QH + r * HK + k0) = cvtpk(q0 * e1x, q1 * e1y);
            *(LAS unsigned*)(QT + r * HK + k0) = cvtpk(q0 * e1x * fq.x, q1 * e1y * fq.y);
            if constexpr (MODE == 1) { bf16* qsp = QS + (crow + r) * 1024 + h * 128; *(unsigned*)(qsp + k0) = cvtpk(q0 * e1x * fqs.x, q1 * e1y * fqs.y); }
            const float b0 = a0 * e3x, b1 = a1 * e3y;
            { const int rb = (sc == 0) ? 0 : (sc == 1) ? 16 : (sc == 2) ? 48 : 96; *(LAS unsigned*)(KH + (rb + r) * HK + k0) = cvtpk(a0 * e2x, a1 * e2y); }
#pragma unroll
            for (int ii = 1; ii < 4; ++ii) if (ii > sc) { const int rb = (ii == 1) ? 16 : (ii == 2) ? 48 : 96; *(LAS unsigned*)(KH + (rb + r) * HK + k0) = cvtpk(b0 * fK[ii].x, b1 * fK[ii].y); }
            t0[i] = b0 * fT.x; t1[i] = b1 * fT.y; }
        { v4u u0, u1; u0.x = cvtpk(t0[0], t0[1]); u0.y = cvtpk(t0[2], t0[3]); u0.z = cvtpk(t0[4], t0[5]); u0.w = cvtpk(t0[6], t0[7]); u1.x = cvtpk(t1[0], t1[1]); u1.y = cvtpk(t1[2], t1[3]); u1.z = cvtpk(t1[4], t1[5]); u1.w = cvtpk(t1[6], t1[7]);
          *(LAS v4u*)(KT + k0 * HS + 8 * w) = u0; *(LAS v4u*)(KT + (k0 + 1) * HS + 8 * w) = u1; }
        { v4u u0, u1;
          u0.x = (vv[0] & 0xffffu) | (vv[1] << 16); u0.y = (vv[2] & 0xffffu) | (vv[3] << 16); u0.z = (vv[4] & 0xffffu) | (vv[5] << 16); u0.w = (vv[6] & 0xffffu) | (vv[7] << 16);
          u1.x = (vv[0] >> 16) | (vv[1] & 0xffff0000u); u1.y = (vv[2] >> 16) | (vv[3] & 0xffff0000u); u1.z = (vv[4] >> 16) | (vv[5] & 0xffff0000u); u1.w = (vv[6] >> 16) | (vv[7] & 0xffff0000u);
          *(LAS v4u*)(VT + k0 * HS + 8 * w) = u0; *(LAS v4u*)(VT + (k0 + 1) * HS + 8 * w) = u1;
          if (w == 0) { f32x2v d; d.x = __expf(tot.x); d.y = __expf(tot.y); *(LAS f32x2v*)(dvec + k0) = d; } }
        HG_BAR();
        if (c + 1 < nchunk) hg_load(P, (crow + 64) * 1024 + h * 128, k0, w, nvalid, lf, qv, kv, vv);
        unsigned short hgv[16];
        if constexpr (MODE == 0) { const bf16* hp = P.HGS + crow * 1024 + h * 128 + 16 * w;
#pragma unroll
          for (int mt = 0; mt < 4; ++mt)
#pragma unroll
              for (int r = 0; r < 4; ++r) { int t = 16 * mt + 4 * lq + r; t = t < nvalid ? t : nvalid - 1; hgv[mt * 4 + r] = hp[(unsigned)(t * 1024 + lr)]; } }
#pragma unroll
        for (int rr = 0; rr < 2; ++rr) { const int blk = w + 8 * rr, bi = blk >> 2, bj = blk & 3;
            f32x4 acc = {0.f, 0.f, 0.f, 0.f};
            if (bj <= bi) { const int rb = (bi == 0) ? 0 : (bi == 1) ? 16 : (bi == 2) ? 48 : 96;
#pragma unroll
                for (int ks = 0; ks < 4; ++ks) { const bf16x8 a = *(const LAS bf16x8*)(QH + (16 * bi + lr) * HK + ks * 32 + 8 * lq), b = *(const LAS bf16x8*)(KH + (rb + 16 * bj + lr) * HK + ks * 32 + 8 * lq); acc = mfma16(a, b, acc); }
                if (bi == bj) {
#pragma unroll
                    for (int r = 0; r < 4; ++r) acc[r] = (lr <= 4 * lq + r) ? acc[r] : 0.f; } }
#pragma unroll
            for (int r = 0; r < 4; ++r) AL[(16 * bi + 4 * lq + r) * HS + 16 * bj + lr] = (bf16)f2bf(acc[r]); }
        HG_BAR();
        f32x4 o[4];
        { bf16x8 bS[4], bV[2];
#pragma unroll
          for (int kp = 0; kp < 4; ++kp) { v4u t; t.x = cvtpk(S[2 * kp][0], S[2 * kp][1]); t.y = cvtpk(S[2 * kp][2], S[2 * kp][3]); t.z = cvtpk(S[2 * kp + 1][0], S[2 * kp + 1][1]); t.w = cvtpk(S[2 * kp + 1][2], S[2 * kp + 1][3]); bS[kp] = __builtin_bit_cast(bf16x8, t); }
#pragma unroll
          for (int ks = 0; ks < 2; ++ks) bV[ks] = *(const LAS bf16x8*)(VT + (16 * w + lr) * HS + ks * 32 + 8 * lq);
#pragma unroll
          for (int mt = 0; mt < 4; ++mt) { f32x4 acc = {0.f, 0.f, 0.f, 0.f};
#pragma unroll
              for (int kp = 0; kp < 4; ++kp) { const LAS bf16* qp = QT + (16 * mt + lr) * HK + 32 * kp + 4 * lq; const v2u a0 = *(const LAS v2u*)qp, a1 = *(const LAS v2u*)(qp + 16);
                  v4u a; a.x = a0.x; a.y = a0.y; a.z = a1.x; a.w = a1.y; acc = mfma16(__builtin_bit_cast(bf16x8, a), bS[kp], acc); }
#pragma unroll
              for (int ks = 0; ks < 2; ++ks) acc = mfma16(*(const LAS bf16x8*)(AL + (16 * mt + lr) * HS + ks * 32 + 8 * lq), bV[ks], acc);
              o[mt] = acc;
              if constexpr (MODE == 1) { float* rp = RAW + (crow + 16 * mt) * 1024 + h * 128 + 16 * w;
#pragma unroll
                  for (int r = 0; r < 4; ++r) rp[(unsigned)((4 * lq + r) * 1024 + lr)] = acc[r]; }
              if constexpr (MODE == 0)
#pragma unroll
              for (int r = 0; r < 4; ++r) { float p = acc[r] * acc[r]; p += __shfl_xor(p, 1); p += __shfl_xor(p, 2); p += __shfl_xor(p, 4); p += __shfl_xor(p, 8); if (lr == 0) part[(16 * mt + 4 * lq + r) * 8 + w] = p; } } }
        { bf16x8 bV[2];
#pragma unroll
          for (int ks = 0; ks < 2; ++ks) bV[ks] = *(const LAS bf16x8*)(VT + (16 * w + lr) * HS + ks * 32 + 8 * lq);
#pragma unroll
          for (int kb = 0; kb < 8; ++kb) { const f32x4 d = *(const LAS f32x4*)(dvec + 16 * kb + 4 * lq); f32x4 acc = S[kb] * d;
#pragma unroll
              for (int ks = 0; ks < 2; ++ks) acc = mfma16(*(const LAS bf16x8*)(KT + (16 * kb + lr) * HS + ks * 32 + 8 * lq), bV[ks], acc);
              S[kb] = acc; } }
        if constexpr (MODE == 0) {
        HG_BAR();
        { bf16* op = P.OH + crow * 1024 + h * 128 + 16 * w;
#pragma unroll
          for (int mt = 0; mt < 4; ++mt)
#pragma unroll
              for (int r = 0; r < 4; ++r) { const int t = 16 * mt + 4 * lq + r; const f32x4 p0 = *(const LAS f32x4*)(part + t * 8), p1 = *(const LAS f32x4*)(part + t * 8 + 4);
                  const float ss = ((p0[0] + p0[1]) + (p0[2] + p0[3])) + ((p1[0] + p1[1]) + (p1[2] + p1[3]));
                  const float rstd = __builtin_amdgcn_rsqf(ss * (1.f / 128.f) + EPS);
                  const bf16 ov = (bf16)f2bf(o[mt][r] * rstd * gv * bf2f(hgv[mt * 4 + r]));
                  bf16* dst = (t < nvalid) ? op + (unsigned)(t * 1024 + lr) : P.dump + F.tid;
                  *dst = ov; } }
        }
        HG_BAR();
    }
#pragma unroll
    for (int kb = 0; kb < 8; ++kb)
#pragma unroll
        for (int r = 0; r < 4; ++r) s_out[(size_t)(16 * kb + 4 * lq_ + r) * 128 + 16 * w + lr_] = S[kb][r];
    if constexpr (MODE == 1) { if (w == 0) { f32x2v d; d.x = __expf(bseg.x); d.y = __expf(bseg.y); *(f32x2v*)(dseg + k0_) = d; } }
}

__device__ __forceinline__ void hg_fix(Frame& F, const HgPtrs& P, size_t row0, int h, int nchunk, int g, int G, const float* SLseq, const float* DSseq, const bf16* QS, const float* RAW, gu32* mask, float* s_fin) {
    LAS float* part = (LAS float*)(F.lds);
    const int w = __builtin_amdgcn_readfirstlane(F.wave), lr_ = F.lane & 15, lq_ = F.lane >> 4;
    if (F.tid == 0) { const unsigned need = (1u << g) - 1u; unsigned sp = 0;
        while ((__hip_atomic_load(mask, RLX_AGENT) & need) != need) { __builtin_amdgcn_s_sleep(2); if (++sp > (1u << 22)) { __hip_atomic_store(F.ctl + 1, 0x7eb0u, RLX_AGENT); break; } }
        __builtin_amdgcn_fence(__ATOMIC_ACQUIRE, "agent"); asm volatile("s_waitcnt vmcnt(0)" ::: "memory"); }
    __syncthreads();
    f32x4 S[8];
#pragma unroll
    for (int kb = 0; kb < 8; ++kb) S[kb] = (f32x4){0.f, 0.f, 0.f, 0.f};
    for (int p = 0; p < g; ++p) { const float* sl = SLseq + (size_t)p * 16384; const float* ds = DSseq + p * 128;
#pragma unroll
        for (int kb = 0; kb < 8; ++kb) { const f32x4 d = *(const f32x4*)(ds + 16 * kb + 4 * lq_);
#pragma unroll
            for (int r = 0; r < 4; ++r) S[kb][r] = d[r] * S[kb][r] + sl[(size_t)(16 * kb + 4 * lq_ + r) * 128 + 16 * w + lr_]; } }
    if (g == G - 1) { const float* sl = SLseq + (size_t)g * 16384; const float* ds = DSseq + g * 128;
#pragma unroll
        for (int kb = 0; kb < 8; ++kb) { const f32x4 d = *(const f32x4*)(ds + 16 * kb + 4 * lq_);
#pragma unroll
            for (int r = 0; r < 4; ++r) { const size_t o = (size_t)(16 * kb + 4 * lq_ + r) * 128 + 16 * w + lr_; s_fin[o] = d[r] * S[kb][r] + sl[o]; } } }
    bf16x8 bS[4];
#pragma unroll
    for (int kp = 0; kp < 4; ++kp) { v4u t; t.x = cvtpk(S[2 * kp][0], S[2 * kp][1]); t.y = cvtpk(S[2 * kp][2], S[2 * kp][3]); t.z = cvtpk(S[2 * kp + 1][0], S[2 * kp + 1][1]); t.w = cvtpk(S[2 * kp + 1][2], S[2 * kp + 1][3]); bS[kp] = __builtin_bit_cast(bf16x8, t); }
    const float gv = P.ghg[16 * w + lr_];
    for (int c = 0; c < nchunk; ++c) {
        int lr = lr_, lq = lq_; asm volatile("" : "+v"(lr), "+v"(lq));
        const size_t crow = row0 + (size_t)c * 64;
        LAS float* pt = part + (c & 1) * 512;
        f32x4 o[4]; unsigned short hgv[16];
        { const bf16* hp = P.HGS + crow * 1024 + h * 128 + 16 * w; const float* rp = RAW + crow * 1024 + h * 128 + 16 * w;
#pragma unroll
          for (int mt = 0; mt < 4; ++mt)
#pragma unroll
              for (int r = 0; r < 4; ++r) { const unsigned off = (unsigned)((16 * mt + 4 * lq + r) * 1024 + lr); o[mt][r] = rp[off]; hgv[mt * 4 + r] = hp[off]; } }
#pragma unroll
        for (int mt = 0; mt < 4; ++mt) { f32x4 acc = o[mt]; const bf16* qb = QS + (crow + 16 * mt) * 1024 + h * 128;
#pragma unroll
            for (int kp = 0; kp < 4; ++kp) { const bf16* qp = qb + (unsigned)(lr * 1024 + 32 * kp + 4 * lq); const v2u a0 = *(const v2u*)qp, a1 = *(const v2u*)(qp + 16);
                v4u a; a.x = a0.x; a.y = a0.y; a.z = a1.x; a.w = a1.y; acc = mfma16(__builtin_bit_cast(bf16x8, a), bS[kp], acc); }
            o[mt] = acc;
#pragma unroll
            for (int r = 0; r < 4; ++r) { float p = acc[r] * acc[r]; p += __shfl_xor(p, 1); p += __shfl_xor(p, 2); p += __shfl_xor(p, 4); p += __shfl_xor(p, 8); if (lr == 0) pt[(16 * mt + 4 * lq + r) * 8 + w] = p; } }
        HG_BAR();
        { bf16* op = P.OH + crow * 1024 + h * 128 + 16 * w;
#pragma unroll
          for (int mt = 0; mt < 4; ++mt)
#pragma unroll
              for (int r = 0; r < 4; ++r) { const int t = 16 * mt + 4 * lq + r; const f32x4 p0 = *(const LAS f32x4*)(pt + t * 8), p1 = *(const LAS f32x4*)(pt + t * 8 + 4);
                  const float ss = ((p0[0] + p0[1]) + (p0[2] + p0[3])) + ((p1[0] + p1[1]) + (p1[2] + p1[3]));
                  const float rstd = __builtin_amdgcn_rsqf(ss * (1.f / 128.f) + EPS);
                  op[(unsigned)(t * 1024 + lr)] = (bf16)f2bf(o[mt][r] * rstd * gv * bf2f(hgv[mt * 4 + r])); } }
    }
    __syncthreads();
}
#undef HG_BAR
__device__ __forceinline__ void team_barrier(Frame& F, gu32* w, unsigned target) {
    asm volatile("s_waitcnt vmcnt(0)" ::: "memory");
    __syncthreads();
    if (F.tid == 0) {
        __builtin_amdgcn_fence(__ATOMIC_RELEASE, "agent");
        asm volatile("s_waitcnt vmcnt(0)" ::: "memory");
        (void)__hip_atomic_fetch_add(w, 1u, RLX_AGENT);
        unsigned sp = 0;
        while (__hip_atomic_load(w, RLX_AGENT) < target) { __builtin_amdgcn_s_sleep(2); if (++sp > (1u << 22)) { __hip_atomic_store(F.ctl + 1, 0x7ea0u, RLX_AGENT); break; } }
        __builtin_amdgcn_fence(__ATOMIC_ACQUIRE, "agent");
        asm volatile("s_waitcnt vmcnt(0)" ::: "memory");
    }
    __syncthreads();
}
__device__ __forceinline__ int wg_pull(Frame& F, gu32* ctr) {
    if (F.tid == 0) F.MISC[16] = __hip_atomic_fetch_add(ctr, 1u, RLX_AGENT);
    __syncthreads();
    const int v = (int)F.MISC[16];
    __syncthreads();
    return __builtin_amdgcn_readfirstlane(v);
}
#ifdef PROBE_ID
#define PT_BEGIN(id) unsigned long long pt0_##id = 0; if ((id) == PROBE_ID && blockIdx.x == 0) pt0_##id = __builtin_amdgcn_s_memrealtime()
#define PT_END(id) do { if ((id) == PROBE_ID && blockIdx.x == 0) { const unsigned long long t1 = __builtin_amdgcn_s_memrealtime(), d = t1 - pt0_##id; while (__builtin_amdgcn_s_memrealtime() - t1 < d) __builtin_amdgcn_s_sleep(8); } } while (0)
#else
#define PT_BEGIN(id) do {} while (0)
#define PT_END(id) do {} while (0)
#endif
struct Args { const float* in[25]; float* out; unsigned char* ws; };
__global__ void __launch_bounds__(NWAVES * 64, 2) mk_fwd(Args args) {
    extern __shared__ __attribute__((aligned(16))) unsigned char lds[];
    Frame F;
    F.lds = (LAS unsigned char*)lds;
    F.MISC = (volatile LAS unsigned*)(F.lds + MISC_OFF);
#define ENTER() do { F.tid = opaque_tid(); F.lane = F.tid & 63; F.wave = __builtin_amdgcn_readfirstlane(F.tid >> 6); F.G = gridDim.x; { const int bx = opaque_bid(); F.vcu = (F.G % 8 == 0) ? (bx % 8) * (F.G / 8) + bx / 8 : bx; } } while (0)
    ENTER();
    F.ctl = (gu32*)((unsigned char*)karg(A_WS) + WS_CTL);
    for (int u = F.tid; u < (LDS_BYTES - LDSCTL_OFF) / 4; u += NWAVES * 64) ((LAS unsigned*)(F.lds + LDSCTL_OFF))[u] = 0u;
    __syncthreads();
    XcdBarrier bar = xcd_barrier_post((unsigned*)(F.ctl + CW_BAR), F.MISC + 8);
#define GRID_BAR() do { asm volatile("" : "+s"(bar.x)); xcd_barrier(bar); } while (0)
#define WSP(T, off) ((T*)((unsigned char*)karg(A_WS) + (off)))
#define OUTP(off) ((float*)karg(A_OUT) + (off))

#ifndef NO_P0
    p0_prologue(F, WSP(unsigned char, 0));
#ifdef DUP_P0
    GRID_BAR(); ENTER(); p0_prologue(F, WSP(unsigned char, 0));
#endif
#endif
    GRID_BAR();

    for (int l = 0; l < DEPTH; ++l) {
        const size_t wlo = WS_W + (size_t)l * W_LAYER, modo = WS_MOD + (size_t)l * NSEQ * 9216 * 4;
        norm_phase(F, karg(A_XP), nullptr, l == 0, WSP(float, WS_X), karg(A_GFFN1) + l * 1024, WSP(const float, modo), 0, WSP(bf16, WS_XN), 0, MP, F.vcu * NWAVES + F.wave, F.G * NWAVES);
#ifdef DUP_THIN
        GRID_BAR(); ENTER();
        norm_phase(F, nullptr, nullptr, false, WSP(float, WS_X), karg(A_GFFN1) + l * 1024, WSP(const float, modo), 0, WSP(bf16, WS_XN), 0, MP, F.vcu * NWAVES + F.wave, F.G * NWAVES);
#endif
        GRID_BAR(); ENTER();
#ifndef NO_G1
        { pg8::Gemm g{WSP(bf16, WS_XN), WSP(const bf16, wlo + WO_GU1), MP, 2 * DFF, DM}; typedef pg8::FixedOrder<128, 22, 8> Ord; Ord S; S.init(F.G, opaque_bid());
          pg8::EpiSwiglu E{WSP(bf16, WS_BIG)};
          pg8::gemm_phase<pg8::EpiSwiglu, Ord, true, true>(F.lds + RING_OFF, g, S, E);
#ifdef DUP_G1
          GRID_BAR(); ENTER(); pg8::gemm_phase<pg8::EpiSwiglu, Ord, true, true>(F.lds + RING_OFF, g, S, E);
#endif
        }
#endif
        GRID_BAR(); ENTER();
#ifndef NO_G2
        { pg8::Gemm g{WSP(bf16, WS_BIG), WSP(const bf16, wlo + WO_D1), MP, DM, DFF}; typedef pg8::FixedOrder<128, 4, 8> Ord; Ord S; S.init(F.G, opaque_bid());
          pg8::EpiResid E{WSP(float, WS_X), WSP(const float, modo) + 2 * 1024, 0.5f};
          pg8::gemm_phase<pg8::EpiResid, Ord, true, true>(F.lds + RING_OFF, g, S, E);
#ifdef DUP_RES
          GRID_BAR(); ENTER(); { pg8::EpiResid E0{E.X, E.gate, 0.f}; pg8::gemm_phase<pg8::EpiResid, Ord, true, true>(F.lds + RING_OFF, g, S, E0); }
#endif
        }
#endif
        GRID_BAR(); ENTER();
        norm_phase(F, nullptr, nullptr, false, WSP(float, WS_X), karg(A_GMIX) + l * 1024, WSP(const float, modo), 1, WSP(bf16, WS_XN), 0, MP, F.vcu * NWAVES + F.wave, F.G * NWAVES);
#ifdef DUP_THIN
        GRID_BAR(); ENTER();
        norm_phase(F, nullptr, nullptr, false, WSP(float, WS_X), karg(A_GMIX) + l * 1024, WSP(const float, modo), 1, WSP(bf16, WS_XN), 0, MP, F.vcu * NWAVES + F.wave, F.G * NWAVES);
#endif
        GRID_BAR(); ENTER();
        PT_BEGIN(2);
#ifndef NO_G3
        { pg8::Gemm g{WSP(bf16, WS_XN), WSP(const bf16, wlo + WO_IN), MP, DIN, DM}; typedef pg8::FixedOrder<128, 36, 8> Ord; Ord S; S.init(F.G, opaque_bid());
          pg8::EpiWin E{WSP(unsigned char, 0), OUTP(0), l, attn_body::C2};
          pg8::gemm_phase<pg8::EpiWin, Ord, true, true>(F.lds + RING_OFF, g, S, E); }
#endif
        GRID_BAR(); ENTER();
        PT_END(2);
        PT_BEGIN(1);
        { gu32* qbase = F.ctl + CW_Q + 64 * (l * 16);
          const int tk = wg_pull(F, qbase + 64 * 9);
#ifdef PROBE_ROLE
          const unsigned long long pr0 = __builtin_amdgcn_s_memrealtime();
#endif
          const int T_EFF = (F.G + 7) / 8 < T_TEAM ? (F.G + 7) / 8 : T_TEAM;
          const bool team = (tk & 7) == 0 && (tk >> 3) < T_EFF, hfirst = (tk & 7) >= 1 && (tk & 7) <= HG_G; const int ticket = tk >> 3; gu32* tb = qbase + 64 * 10; unsigned tstage = 0;
#define TEAM_BAR() do { ++tstage; team_barrier(F, tb, (unsigned)T_EFF * tstage); ENTER(); } while (0)
#ifndef NO_TEAM
          if (team) {
              const int tgw = ticket * NWAVES + F.wave, TNW = T_EFF * NWAVES;
              norm_phase(F, nullptr, karg(A_XS), l == 0, WSP(float, WS_X), karg(A_GFFN1) + l * 1024, WSP(const float, modo), 0, WSP(bf16, WS_XN), MP, MROWS, tgw, TNW);
              TEAM_BAR();
              { pg8::Gemm g{WSP(bf16, WS_XN), WSP(const bf16, wlo + WO_GU1), MROWS, 2 * DFF, DM}; typedef pg8::TeamOrder<22> Ord; Ord S; S.init(T_EFF, ticket);
                pg8::EpiSwiglu E{WSP(bf16, WS_BIG)};
                pg8::gemm_phase<pg8::EpiSwiglu, Ord, true, true>(F.lds + RING_OFF, g, S, E); }
              TEAM_BAR();
              { pg8::Gemm g{WSP(bf16, WS_BIG), WSP(const bf16, wlo + WO_D1), MROWS, DM, DFF}; typedef pg8::TeamOrder<4> Ord; Ord S; S.init(T_EFF, ticket);
                pg8::EpiResid E{WSP(float, WS_X), WSP(const float, modo) + 2 * 1024, 0.5f};
                pg8::gemm_phase<pg8::EpiResid, Ord, true, true>(F.lds + RING_OFF, g, S, E); }
              TEAM_BAR();
              norm_phase(F, nullptr, nullptr, false, WSP(float, WS_X), karg(A_GMIX) + l * 1024, WSP(const float, modo), 1, WSP(bf16, WS_XN), MP, MROWS, ticket * NWAVES + F.wave, T_EFF * NWAVES);
              TEAM_BAR();
              { pg8::Gemm g{WSP(bf16, WS_XN), WSP(const bf16, wlo + WO_IN), MROWS, DIN, DM}; typedef pg8::TeamOrder<36> Ord; Ord S; S.init(T_EFF, ticket);
                pg8::EpiWin E{WSP(unsigned char, 0), OUTP(0), l, attn_body::C2};
                pg8::gemm_phase<pg8::EpiWin, Ord, true, true>(F.lds + RING_OFF, g, S, E); }
              TEAM_BAR();
          }
#endif
          if (hfirst) {
            for (;;) { const int it = wg_pull(F, qbase); if (it >= 32 * HG_G) break;
              const HgPtrs P{WSP(const float, WS_LOGF), WSP(const bf16, WS_QQ), WSP(const bf16, WS_KK), WSP(const bf16, WS_VV), WSP(const bf16, WS_HGS), karg(A_GHG) + l * 128, WSP(bf16, WS_OH), WSP(bf16, WS_DD)};
#ifndef NO_H
                  const int sqh = it / HG_G, g = it % HG_G, b = sqh >> 3, h = sqh & 7; const int nch = 128 / HG_G;
                  const size_t r0 = (size_t)b * 8192 + (size_t)g * nch * 64;
                  float* SLq = WSP(float, WS_SL) + (size_t)sqh * HG_G * 16384; float* DSq = WSP(float, WS_DSEG) + (size_t)sqh * HG_G * 128;
                  gu32* mask = F.ctl + CW_HS + 64 * (l * 32 + sqh);
                  hg_sequence<1>(F, P, r0, h, nch, 64, nullptr, SLq + (size_t)g * 16384, WSP(bf16, WS_QS), WSP(float, WS_RAW), DSq + g * 128);
                  asm volatile("s_waitcnt vmcnt(0)" ::: "memory"); __syncthreads();
                  if (F.tid == 0) { __builtin_amdgcn_fence(__ATOMIC_RELEASE, "agent"); asm volatile("s_waitcnt vmcnt(0)" ::: "memory"); (void)__hip_atomic_fetch_or(mask, 1u << g, RLX_AGENT); }
                  ENTER();
                  hg_fix(F, P, r0, h, nch, g, HG_G, SLq, DSq, WSP(const bf16, WS_QS), WSP(const float, WS_RAW), mask, OUTP(0) + OS_P + ((size_t)((l * 4 + b) * 8 + h)) * 16384);
                  ENTER();
#endif
            }
            if (F.tid == 0) { unsigned sp = 0; while (__hip_atomic_load(tb, RLX_AGENT) < (unsigned)T_EFF * 5u) { __builtin_amdgcn_s_sleep(2); if (++sp > (1u << 22)) { __hip_atomic_store(F.ctl + 1, 0x7ec0u, RLX_AGENT); break; } }
                __builtin_amdgcn_fence(__ATOMIC_ACQUIRE, "agent"); asm volatile("s_waitcnt vmcnt(0)" ::: "memory"); }
            __syncthreads(); ENTER();
          }
          if (team || hfirst) {
            gu32* qs = qbase + 64 * 11; gu32* done = qbase + 64 * 12;
            for (;;) { const int it = wg_pull(F, qs); if (it >= 256) break;
              const HgPtrs P{WSP(const float, WS_LOGF), WSP(const bf16, WS_QQ), WSP(const bf16, WS_KK), WSP(const bf16, WS_VV), WSP(const bf16, WS_HGS), karg(A_GHG) + l * 128, WSP(bf16, WS_OH), WSP(bf16, WS_DD)};
              if (it < 128) {
#ifndef NO_H
                  const int sq = it >> 3, h = it & 7; const size_t so = OS_S + ((size_t)((l * 16 + sq) * 8 + h)) * 16384;
                  hg_sequence<0>(F, P, (size_t)MP + (size_t)sq * 32, h, 1, 32, karg(A_ST) + ((size_t)((l * 16 + sq) * 8 + h)) * 16384, OUTP(0) + so, nullptr, nullptr, nullptr);
#endif
              } else {
#ifndef NO_SAMP
                  const int u = it - 128; const float lam = lam_of(karg(A_LAM), l, F.lane), osc = 1.f - lam_init_of(l);
                  attn_sample_unit(F, karg(A_CK), karg(A_CV), l, u >> 3, u & 7, WSP(const bf16, WS_Q), WSP(const bf16, WS_K), WSP(const bf16, WS_V), lam, osc, karg(A_GSUB) + l * 128, WSP(bf16, WS_OATT));
#endif
              }
              asm volatile("s_waitcnt vmcnt(0)" ::: "memory"); __syncthreads();
              if (F.tid == 0) { __builtin_amdgcn_fence(__ATOMIC_RELEASE, "agent"); asm volatile("s_waitcnt vmcnt(0)" ::: "memory"); (void)__hip_atomic_fetch_add(done, 1u, RLX_AGENT); }
              ENTER(); }
            if (team) {
                if (F.tid == 0) { unsigned sp = 0; while (__hip_atomic_load(done, RLX_AGENT) < 256u) { __builtin_amdgcn_s_sleep(2); if (++sp > (1u << 22)) { __hip_atomic_store(F.ctl + 1, 0x7ed0u, RLX_AGENT); break; } }
                    __builtin_amdgcn_fence(__ATOMIC_ACQUIRE, "agent"); asm volatile("s_waitcnt vmcnt(0)" ::: "memory"); }
                __syncthreads(); ENTER(); } }
#ifndef NO_TEAM
          if (team) {
              { pg8::Gemm g{WSP(bf16, WS_OATT), WSP(const bf16, wlo + WO_BA), MROWS, DM, DM}; typedef pg8::TeamOrder<4> Ord; Ord S; S.init(T_EFF, ticket);
                pg8::EpiGateT E{WSP(float, WS_LOGF), WSP(const bf16, WS_SZA)};
                pg8::gemm_phase<pg8::EpiGateT, Ord, true, true>(F.lds + RING_OFF, g, S, E); }
              TEAM_BAR();
              { pg8::Gemm g{WSP(bf16, WS_OH), WSP(const bf16, wlo + WO_BH), MROWS, DM, DM}; typedef pg8::TeamOrder<4> Ord; Ord S; S.init(T_EFF, ticket);
                pg8::EpiGateM E{WSP(const float, WS_LOGF), WSP(const bf16, WS_SZH), WSP(bf16, WS_MRG)};
                pg8::gemm_phase<pg8::EpiGateM, Ord, true, true>(F.lds + RING_OFF, g, S, E); }
              TEAM_BAR();
              { pg8::Gemm g{WSP(bf16, WS_MRG), WSP(const bf16, wlo + WO_OUT), MROWS, DM, DM}; typedef pg8::TeamOrder<4> Ord; Ord S; S.init(T_EFF, ticket);
                pg8::EpiResid E{WSP(float, WS_X), WSP(const float, modo) + 5 * 1024, 1.0f};
                pg8::gemm_phase<pg8::EpiResid, Ord, true, true>(F.lds + RING_OFF, g, S, E); }
              TEAM_BAR();
              norm_phase(F, nullptr, nullptr, false, WSP(float, WS_X), karg(A_GFFN2) + l * 1024, WSP(const float, modo), 2, WSP(bf16, WS_XN), MP, MROWS, ticket * NWAVES + F.wave, T_EFF * NWAVES);
              TEAM_BAR();
              { pg8::Gemm g{WSP(bf16, WS_XN), WSP(const bf16, wlo + WO_GU2), MROWS, 2 * DFF, DM}; typedef pg8::TeamOrder<22> Ord; Ord S; S.init(T_EFF, ticket);
                pg8::EpiSwiglu E{WSP(bf16, WS_BIG)};
                pg8::gemm_phase<pg8::EpiSwiglu, Ord, true, true>(F.lds + RING_OFF, g, S, E); }
              TEAM_BAR();
              { pg8::Gemm g{WSP(bf16, WS_BIG), WSP(const bf16, wlo + WO_D2), MROWS, DM, DFF}; typedef pg8::TeamOrder<4> Ord; Ord S; S.init(T_EFF, ticket);
                pg8::EpiResid E{WSP(float, WS_X), WSP(const float, modo) + 8 * 1024, 0.5f};
                pg8::gemm_phase<pg8::EpiResid, Ord, true, true>(F.lds + RING_OFF, g, S, E); }
              ENTER();
          }
#endif
#ifndef NO_ATT
          { const attn_body::bf16* Qb = WSP(const attn_body::bf16, WS_Q); const attn_body::bf16* Kb = WSP(const attn_body::bf16, WS_K); const attn_body::bf16* Vb = WSP(const attn_body::bf16, WS_V); attn_body::bf16* O1 = WSP(attn_body::bf16, WS_O1);
            const int x0 = (int)(xb_xcc_id() & 7u);
            for (int dx = 0; dx < 8; ++dx) { const int head = (x0 + dx) & 7; gu32* qa = qbase + 64 * (1 + head);
                for (;;) { const int it = wg_pull(F, qa); if (it >= 256) break;
                    const int b = it >> 6, r = it & 63, qb = 31 - (r >> 1), mp = r & 1;
                    attn_body::attn_unit128<8>(b, head * 2 + mp, head * 2, qb, Qb, Kb, Vb, O1 + (size_t)mp * ((WS_O2 - WS_O1) / 2), (char*)lds + RING_OFF); } } }
#endif
#undef TEAM_BAR
#ifdef PROBE_ROLE
          if (tk == PROBE_ROLE) { const unsigned long long t1 = __builtin_amdgcn_s_memrealtime(), d = t1 - pr0; while (__builtin_amdgcn_s_memrealtime() - t1 < d) __builtin_amdgcn_s_sleep(8); }
#endif
        }
        GRID_BAR(); ENTER();
        PT_END(1);
        { const float lam = lam_of(karg(A_LAM), l, F.lane), osc = 1.f - lam_init_of(l);
          attn_combine_phase(F, WSP(const bf16, WS_O1), WSP(const bf16, WS_O2), karg(A_GSUB) + l * 128, lam, osc, WSP(bf16, WS_OATT));
#ifdef DUP_THIN
          GRID_BAR(); ENTER();
          attn_combine_phase(F, WSP(const bf16, WS_O1), WSP(const bf16, WS_O2), karg(A_GSUB) + l * 128, lam, osc, WSP(bf16, WS_OATT));
#endif
        }
        GRID_BAR(); ENTER();
#ifndef NO_G4
        { pg8::Gemm g{WSP(bf16, WS_OATT), WSP(const bf16, wlo + WO_BA), MP, DM, DM}; typedef pg8::FixedOrder<128, 4, 8> Ord; Ord S; S.init(F.G, opaque_bid());
          pg8::EpiGateT E{WSP(float, WS_LOGF), WSP(const bf16, WS_SZA)};
          pg8::gemm_phase<pg8::EpiGateT, Ord, true, true>(F.lds + RING_OFF, g, S, E);
#ifdef DUP_THIN
          GRID_BAR(); ENTER(); pg8::gemm_phase<pg8::EpiGateT, Ord, true, true>(F.lds + RING_OFF, g, S, E);
#endif
        }
#endif
        GRID_BAR(); ENTER();
#ifndef NO_G5
        { pg8::Gemm g{WSP(bf16, WS_OH), WSP(const bf16, wlo + WO_BH), MP, DM, DM}; typedef pg8::FixedOrder<128, 4, 8> Ord; Ord S; S.init(F.G, opaque_bid());
          pg8::EpiGateM E{WSP(const float, WS_LOGF), WSP(const bf16, WS_SZH), WSP(bf16, WS_MRG)};
          pg8::gemm_phase<pg8::EpiGateM, Ord, true, true>(F.lds + RING_OFF, g, S, E);
#ifdef DUP_THIN
          GRID_BAR(); ENTER(); pg8::gemm_phase<pg8::EpiGateM, Ord, true, true>(F.lds + RING_OFF, g, S, E);
#endif
        }
#endif
        GRID_BAR(); ENTER();
#ifndef NO_G6
        { pg8::Gemm g{WSP(bf16, WS_MRG), WSP(const bf16, wlo + WO_OUT), MP, DM, DM}; typedef pg8::FixedOrder<128, 4, 8> Ord; Ord S; S.init(F.G, opaque_bid());
          pg8::EpiResid E{WSP(float, WS_X), WSP(const float, modo) + 5 * 1024, 1.0f};
          pg8::gemm_phase<pg8::EpiResid, Ord, true, true>(F.lds + RING_OFF, g, S, E);
#ifdef DUP_RES
          GRID_BAR(); ENTER(); { pg8::EpiResid E0{E.X, E.gate, 0.f}; pg8::gemm_phase<pg8::EpiResid, Ord, true, true>(F.lds + RING_OFF, g, S, E0); }
#endif
        }
#endif
        GRID_BAR(); ENTER();
        norm_phase(F, nullptr, nullptr, false, WSP(float, WS_X), karg(A_GFFN2) + l * 1024, WSP(const float, modo), 2, WSP(bf16, WS_XN), 0, MP, F.vcu * NWAVES + F.wave, F.G * NWAVES);
#ifdef DUP_THIN
        GRID_BAR(); ENTER();
        norm_phase(F, nullptr, nullptr, false, WSP(float, WS_X), karg(A_GFFN2) + l * 1024, WSP(const float, modo), 2, WSP(bf16, WS_XN), 0, MP, F.vcu * NWAVES + F.wave, F.G * NWAVES);
#endif
        GRID_BAR(); ENTER();
#ifndef NO_G7
        { pg8::Gemm g{WSP(bf16, WS_XN), WSP(const bf16, wlo + WO_GU2), MP, 2 * DFF, DM}; typedef pg8::FixedOrder<128, 22, 8> Ord; Ord S; S.init(F.G, opaque_bid());
          pg8::EpiSwiglu E{WSP(bf16, WS_BIG)};
          pg8::gemm_phase<pg8::EpiSwiglu, Ord, true, true>(F.lds + RING_OFF, g, S, E); }
#endif
        GRID_BAR(); ENTER();
#ifndef NO_G8
        { pg8::Gemm g{WSP(bf16, WS_BIG), WSP(const bf16, wlo + WO_D2), MP, DM, DFF}; typedef pg8::FixedOrder<128, 4, 8> Ord; Ord S; S.init(F.G, opaque_bid());
          pg8::EpiResid E{WSP(float, WS_X), WSP(const float, modo) + 8 * 1024, 0.5f};
          pg8::gemm_phase<pg8::EpiResid, Ord, true, true>(F.lds + RING_OFF, g, S, E);
#ifdef DUP_RES
          GRID_BAR(); ENTER(); { pg8::EpiResid E0{E.X, E.gate, 0.f}; pg8::gemm_phase<pg8::EpiResid, Ord, true, true>(F.lds + RING_OFF, g, S, E0); }
#endif
        }
#endif
        GRID_BAR(); ENTER();
    }
    final_norm_phase(F, WSP(const float, WS_X), karg(A_GFIN), OUTP(0));
#undef GRID_BAR
#undef ENTER
#undef WSP
#undef OUTP
}

extern "C" void kernel_launch(void* const* d_in, const int* in_sizes, int n_in, void* d_out, int out_size, void* d_ws, size_t ws_size, hipStream_t stream) {
    static int grid = 0;
    if (grid == 0) {
        if (n_in != 25 || (size_t)out_size != OUT_TOTAL || ws_size < WS_END) { fprintf(stderr, "kernel_launch: unexpected sizes: n_in %d out %d ws %zu (need %zu)\n", n_in, out_size, ws_size, (size_t)WS_END); grid = -1; return; }
        int dev = 0, cus = 0, per_cu = 0;
        if (hipGetDevice(&dev) != hipSuccess || hipDeviceGetAttribute(&cus, hipDeviceAttributeMultiprocessorCount, dev) != hipSuccess) { grid = -1; return; }
        if (hipFuncSetAttribute((const void*)mk_fwd, hipFuncAttributeMaxDynamicSharedMemorySize, LDS_BYTES) != hipSuccess) { fprintf(stderr, "kernel_launch: hipFuncSetAttribute failed\n"); grid = -1; return; }
        if (hipOccupancyMaxActiveBlocksPerMultiprocessor(&per_cu, (const void*)mk_fwd, NWAVES * 64, LDS_BYTES) != hipSuccess || per_cu < 1) { fprintf(stderr, "kernel_launch: occupancy query reports %d\n", per_cu); }
        (void)hipGetLastError();
        grid = cus;
    }
    if (grid < 0) return;
    if (hipMemsetAsync((char*)d_ws + WS_CTL, 0, CTL_ZERO_BYTES, stream) != hipSuccess) return;
    Args a{};
    for (int i = 0; i < 25; ++i) a.in[i] = (const float*)d_in[i];
    a.out = (float*)d_out; a.ws = (unsigned char*)d_ws;
    hipLaunchKernelGGL(mk_fwd, dim3(grid), dim3(NWAVES * 64), LDS_BYTES, stream, a);
    (void)in_sizes;
}
```

```cpp
#define TEAM_STRIDE 16
#define STARTERS 8
#include <hip/hip_runtime.h>
#include <hip/hip_bf16.h>
#include <cstdio>
#include <cstdint>
#include <cmath>
__device__ __forceinline__ int opaque_tid() { int t = (int)threadIdx.x; asm volatile("" : "+v"(t)); return t; }
__device__ __forceinline__ int opaque_bid() { int b = (int)blockIdx.x; asm volatile("" : "+s"(b)); return b; }
namespace pg8 {
#define PG8_LAS __attribute__((address_space(3)))
typedef unsigned short bf16_t;
typedef short bf16x8 __attribute__((ext_vector_type(8)));
typedef float f32x4 __attribute__((ext_vector_type(4)));
typedef unsigned u32x4 __attribute__((ext_vector_type(4)));
constexpr int BM = 256, BK = 64, HALF = 128, HTB = HALF * BK * 2  , STAGE_BYTES = 8 * HTB, NXCD = 8, WGM = 8;

__host__ __device__ __forceinline__ int lds_byte(int r, int c) { const int st = (r >> 4) * 2 + (c >> 5), rr = r & 15, cc = c & 31, ob = rr * 64 + cc * 2; return st * 1024 + (ob ^ (((ob >> 9) & 1) << 5)); }
__host__ __device__ __forceinline__ void stage_rc(int b, int& R, int& C) { const int st = b / 1024, sb = b % 1024, swz = sb ^ (((sb >> 9) & 1) << 5); R = (st >> 1) * 16 + swz / 64; C = (st & 1) * 32 + (swz % 64) / 2; }
__host__ __device__ __forceinline__ int perm32(int rho) { const int n = rho >> 4, i = rho & 15; return 8 * (i >> 2) + 4 * n + (i & 3); }

struct Unit { int pm, pn; };
struct Gemm { const bf16_t* A; const bf16_t* Bt; int M, N, K; };

struct StaticOrder {
    int nM, nN, nwg, G, c;
    __host__ __device__ void init(int M, int N, int G_, int c_) { nM = M / BM; nN = N / BM; nwg = nM * nN; G = G_; c = c_; }
    __host__ __device__ bool next(int i, Unit& u) const {
        const long L = (long)i * G + c; if (L >= nwg) return false;
        int wgid = (int)L; { const int q = nwg / NXCD, r = nwg % NXCD, xcd = wgid % NXCD, off = wgid / NXCD; wgid = (xcd < r ? xcd * (q + 1) : r * (q + 1) + (xcd - r) * q) + off; }
        const int nig = WGM * nN, gid = wgid / nig, fm = gid * WGM, gsz = (nM - fm) < WGM ? (nM - fm) : WGM;
        u.pm = fm + ((wgid % nig) % gsz); u.pn = (wgid % nig) / gsz; return true;
    }
    __device__ __forceinline__ void a_ready(const Unit&) const {}
    __device__ __forceinline__ void done(const Unit&) const {}
};

__device__ __forceinline__ unsigned cvt_pk_bf16(float lo, float hi) { unsigned r; asm volatile("v_cvt_pk_bf16_f32 %0, %1, %2" : "=v"(r) : "v"(lo), "v"(hi)); return r; }
__device__ __forceinline__ float bf_lo(unsigned w) { return __builtin_bit_cast(float, w << 16); }
__device__ __forceinline__ float bf_hi(unsigned w) { return __builtin_bit_cast(float, w & 0xffff0000u); }
__device__ __forceinline__ float sigmoid_f(float x) { return __builtin_amdgcn_rcpf(1.f + __expf(-x)); }
__device__ __forceinline__ float silu_f(float x) { return x * sigmoid_f(x); }
__device__ __forceinline__ void store8bf(bf16_t* p, f32x4 a, f32x4 b) { u32x4 w; w.x = cvt_pk_bf16(a[0], a[1]); w.y = cvt_pk_bf16(a[2], a[3]); w.z = cvt_pk_bf16(b[0], b[1]); w.w = cvt_pk_bf16(b[2], b[3]); *(u32x4*)p = w; }
__device__ __forceinline__ int row_seq(int row) { return row < 32768 ? (row >> 13) : 4 + ((row - 32768) >> 5); }

struct EpiSwiglu {
    static constexpr bool PERM = true, AFTER_DRAIN = false;
    bf16_t* O;
    __device__ __forceinline__ void operator()(const f32x4 (&acc)[2][2][4][2], const Unit& u, int wr, int wc, int fr, int fq) const {
        const int row0 = u.pm * BM + wr * 64 + fr, col0 = u.pn * HALF + wc * 32 + 8 * fq;
#pragma unroll
        for (int ai = 0; ai < 2; ++ai)
#pragma unroll
            for (int m = 0; m < 4; ++m) {
                f32x4 g0 = acc[ai][0][m][0], g1 = acc[ai][0][m][1]; const f32x4 u0 = acc[ai][1][m][0], u1 = acc[ai][1][m][1];
#pragma unroll
                for (int i = 0; i < 4; ++i) { g0[i] = silu_f(g0[i]) * u0[i]; g1[i] = silu_f(g1[i]) * u1[i]; }
                store8bf(O + (size_t)(row0 + ai * HALF + m * 16) * 2816 + col0, g0, g1); asm volatile("" ::: "memory");
            }
    }
};

struct EpiResid {
    static constexpr bool PERM = true, AFTER_DRAIN = false;
    float* X; const float* gate; float coef;
    __device__ __forceinline__ void operator()(const f32x4 (&acc)[2][2][4][2], const Unit& u, int wr, int wc, int fr, int fq) const {
        if (u.pm < 128) {
            const float* gp = gate + (size_t)(u.pm >> 5) * 9216 + u.pn * BM + wc * 32 + 8 * fq;
            f32x4 gv[2][2];
#pragma unroll
            for (int bj = 0; bj < 2; ++bj)
#pragma unroll
                for (int n = 0; n < 2; ++n) gv[bj][n] = *(const f32x4*)(gp + bj * HALF + 4 * n) * coef;
            float* xb = X + (size_t)(u.pm * BM + wr * 64 + fr) * 1024 + u.pn * BM + wc * 32 + 8 * fq;
            f32x4 xc[2][2], xn[2][2];
#pragma unroll
            for (int bj = 0; bj < 2; ++bj)
#pragma unroll
                for (int n = 0; n < 2; ++n) xc[bj][n] = *(const f32x4*)(xb + bj * HALF + 4 * n);
#pragma unroll
            for (int g = 0; g < 8; ++g) { const int ai = g >> 2, m = g & 3; float* xr = xb + (size_t)(ai * HALF + m * 16) * 1024;
                if (g + 1 < 8) { const float* xq = xb + (size_t)(((g + 1) >> 2) * HALF + ((g + 1) & 3) * 16) * 1024;
#pragma unroll
                    for (int bj = 0; bj < 2; ++bj)
#pragma unroll
                        for (int n = 0; n < 2; ++n) xn[bj][n] = *(const f32x4*)(xq + bj * HALF + 4 * n); }
#pragma unroll
                for (int bj = 0; bj < 2; ++bj)
#pragma unroll
                    for (int n = 0; n < 2; ++n) *(f32x4*)(xr + bj * HALF + 4 * n) = xc[bj][n] + gv[bj][n] * acc[ai][bj][m][n];
                asm volatile("" ::: "memory");
#pragma unroll
                for (int bj = 0; bj < 2; ++bj)
#pragma unroll
                    for (int n = 0; n < 2; ++n) xc[bj][n] = xn[bj][n]; }
        } else {
#pragma unroll
        for (int ai = 0; ai < 2; ++ai)
#pragma unroll
            for (int m = 0; m < 4; ++m) {
                const int row = u.pm * BM + ai * HALF + wr * 64 + m * 16 + fr; const float* gp = gate + (size_t)row_seq(row) * 9216;
#pragma unroll
                for (int bj = 0; bj < 2; ++bj) { const int col = u.pn * BM + bj * HALF + wc * 32 + 8 * fq;
#pragma unroll
                    for (int n = 0; n < 2; ++n) { const f32x4 g = *(const f32x4*)(gp + col + 4 * n); f32x4* xp = (f32x4*)(X + (size_t)row * 1024 + col + 4 * n); const f32x4 xv = *xp; *xp = xv + (g * coef) * acc[ai][bj][m][n]; } asm volatile("" ::: "memory"); }
            }
        }
    }
};

struct EpiWin {
    static constexpr bool PERM = true, AFTER_DRAIN = false;
    unsigned char* ws; float* out; int l; float qscale;
    static constexpr size_t MiB_ = 1u << 20;
    static constexpr size_t O_Q = 435 * MiB_, O_K = 500 * MiB_, O_V = 565 * MiB_, O_QQ = 630 * MiB_, O_KK = 695 * MiB_, O_VV = 760 * MiB_, O_HGS = 825 * MiB_, O_SZA = 890 * MiB_, O_SZH = 955 * MiB_, O_LOGF = 1020 * MiB_, O_LB = 4 * MiB_;
    static constexpr size_t OK_P_ = 34078720, OV_P_ = 168296448, OK_S_ = 304611328, OV_S_ = 306708480;
    __device__ __forceinline__ void operator()(const f32x4 (&acc)[2][2][4][2], const Unit& u, int wr, int wc, int fr, int fq) const {
        const int seg = u.pn >> 2, cb = (u.pn & 3) * BM + wc * 32 + 8 * fq, row0 = u.pm * BM + wr * 64 + fr;
        const size_t boff = seg == 0 ? O_Q : seg == 1 ? O_K : seg == 2 ? O_V : seg == 3 ? O_QQ : seg == 4 ? O_KK : seg == 5 ? O_VV : seg == 6 ? O_HGS : seg == 7 ? O_SZA : O_SZH;
        bf16_t* const O = (bf16_t*)(ws + boff) + (size_t)row0 * 1024 + cb;
        float* F32 = nullptr;
        if (seg == 1 || seg == 2) { const size_t ob = (u.pm < 128) ? (seg == 1 ? OK_P_ : OV_P_) + (size_t)l * 32768 * 1024 + (size_t)(u.pm * BM) * 1024 : (seg == 1 ? OK_S_ : OV_S_) + (size_t)l * 512 * 1024 + (size_t)((u.pm - 128) * BM) * 1024;
            F32 = out + ob + (size_t)(wr * 64 + fr) * 1024 + cb; }
        else if (seg == 4) F32 = (float*)(ws + O_LOGF) + (size_t)row0 * 1024 + cb;
        const float* const lb = (const float*)(ws + O_LB) + l * 1024 + cb;
        const float sc = seg == 0 ? qscale : 1.f;
#pragma unroll
        for (int bj = 0; bj < 2; ++bj) {
            f32x4 l0 = {0.f, 0.f, 0.f, 0.f}, l1 = l0; if (seg == 4) { l0 = *(const f32x4*)(lb + bj * HALF); l1 = *(const f32x4*)(lb + bj * HALF + 4); }
#pragma unroll
            for (int ai = 0; ai < 2; ++ai)
#pragma unroll
                for (int m = 0; m < 4; ++m) { const size_t off = (size_t)(ai * HALF + m * 16) * 1024 + bj * HALF;
                    f32x4 a = acc[ai][bj][m][0], b = acc[ai][bj][m][1];
                    if (seg == 4) { f32x4 fa, fb;
#pragma unroll
                        for (int i = 0; i < 4; ++i) {
                            { const float x = a[i], lbv = l0[i], e = __expf(-__builtin_fabsf(x)), r = __builtin_amdgcn_rcpf(1.f + e), er = e * r, sig = x >= 0.f ? r : er, om = x >= 0.f ? er : r;
                              fa[i] = __logf(__builtin_fmaxf(lbv + (1.f - lbv) * sig, 1e-30f)); a[i] = (1.f - lbv) * om; }
                            { const float x = b[i], lbv = l1[i], e = __expf(-__builtin_fabsf(x)), r = __builtin_amdgcn_rcpf(1.f + e), er = e * r, sig = x >= 0.f ? r : er, om = x >= 0.f ? er : r;
                              fb[i] = __logf(__builtin_fmaxf(lbv + (1.f - lbv) * sig, 1e-30f)); b[i] = (1.f - lbv) * om; } }
                        *(f32x4*)(F32 + off) = fa; *(f32x4*)(F32 + off + 4) = fb;
                    } else if (seg == 3 || seg == 6) {
#pragma unroll
                        for (int i = 0; i < 4; ++i) { a[i] = silu_f(a[i]); b[i] = silu_f(b[i]); }
                    } else if (seg >= 7) {
#pragma unroll
                        for (int i = 0; i < 4; ++i) { a[i] = sigmoid_f(a[i]); b[i] = sigmoid_f(b[i]); }
                    } else {
                        if (seg == 1 || seg == 2) { *(f32x4*)(F32 + off) = a; *(f32x4*)(F32 + off + 4) = b; }
                        a = a * sc; b = b * sc;
                    }
                    store8bf(O + off, a, b); asm volatile("" ::: "memory"); }
        }
    }
};

struct EpiGateT {
    static constexpr bool PERM = true, AFTER_DRAIN = false;
    float* T; const bf16_t* G;
    __device__ __forceinline__ void operator()(const f32x4 (&acc)[2][2][4][2], const Unit& u, int wr, int wc, int fr, int fq) const {
        const size_t base = (size_t)(u.pm * BM + wr * 64 + fr) * 1024 + u.pn * BM + wc * 32 + 8 * fq;
        u32x4 gc[2], gn[2];
#pragma unroll
        for (int bj = 0; bj < 2; ++bj) gc[bj] = *(const u32x4*)(G + base + bj * HALF);
#pragma unroll
        for (int g = 0; g < 8; ++g) { const int ai = g >> 2, m = g & 3; const size_t off = base + (size_t)(ai * HALF + m * 16) * 1024;
            if (g + 1 < 8) { const size_t offn = base + (size_t)(((g + 1) >> 2) * HALF + ((g + 1) & 3) * 16) * 1024;
#pragma unroll
                for (int bj = 0; bj < 2; ++bj) gn[bj] = *(const u32x4*)(G + offn + bj * HALF); }
#pragma unroll
            for (int bj = 0; bj < 2; ++bj) { const u32x4 gg = gc[bj];
                const f32x4 g0 = {bf_lo(gg.x), bf_hi(gg.x), bf_lo(gg.y), bf_hi(gg.y)}, g1 = {bf_lo(gg.z), bf_hi(gg.z), bf_lo(gg.w), bf_hi(gg.w)};
                *(f32x4*)(T + off + bj * HALF) = g0 * acc[ai][bj][m][0]; *(f32x4*)(T + off + bj * HALF + 4) = g1 * acc[ai][bj][m][1]; }
            asm volatile("" ::: "memory");
#pragma unroll
            for (int bj = 0; bj < 2; ++bj) gc[bj] = gn[bj]; }
    }
};
struct EpiGateM {
    static constexpr bool PERM = true, AFTER_DRAIN = false;
    const float* T; const bf16_t* G; bf16_t* O;
    __device__ __forceinline__ void operator()(const f32x4 (&acc)[2][2][4][2], const Unit& u, int wr, int wc, int fr, int fq) const {
        const size_t base = (size_t)(u.pm * BM + wr * 64 + fr) * 1024 + u.pn * BM + wc * 32 + 8 * fq;
        u32x4 gc[2], gn[2]; f32x4 tc[2][2], tn[2][2];
#pragma unroll
        for (int bj = 0; bj < 2; ++bj) { gc[bj] = *(const u32x4*)(G + base + bj * HALF); tc[bj][0] = *(const f32x4*)(T + base + bj * HALF); tc[bj][1] = *(const f32x4*)(T + base + bj * HALF + 4); }
#pragma unroll
        for (int g = 0; g < 8; ++g) { const int ai = g >> 2, m = g & 3; const size_t off = base + (size_t)(ai * HALF + m * 16) * 1024;
            if (g + 1 < 8) { const size_t offn = base + (size_t)(((g + 1) >> 2) * HALF + ((g + 1) & 3) * 16) * 1024;
#pragma unroll
                for (int bj = 0; bj < 2; ++bj) { gn[bj] = *(const u32x4*)(G + offn + bj * HALF); tn[bj][0] = *(const f32x4*)(T + offn + bj * HALF); tn[bj][1] = *(const f32x4*)(T + offn + bj * HALF + 4); } }
#pragma unroll
            for (int bj = 0; bj < 2; ++bj) { const u32x4 gg = gc[bj];
                const f32x4 g0 = {bf_lo(gg.x), bf_hi(gg.x), bf_lo(gg.y), bf_hi(gg.y)}, g1 = {bf_lo(gg.z), bf_hi(gg.z), bf_lo(gg.w), bf_hi(gg.w)};
                store8bf(O + off + bj * HALF, tc[bj][0] + g0 * acc[ai][bj][m][0], tc[bj][1] + g1 * acc[ai][bj][m][1]); }
            asm volatile("" ::: "memory");
#pragma unroll
            for (int bj = 0; bj < 2; ++bj) { gc[bj] = gn[bj]; tc[bj][0] = tn[bj][0]; tc[bj][1] = tn[bj][1]; } }
    }
};

template <int NM, int NN, int GM> struct FixedOrder {
    static_assert(NM % GM == 0, "GM divides NM");
    int G, c;
    __device__ __forceinline__ void init(int G_, int c_) { G = G_; c = c_; }
    __device__ __forceinline__ bool next(int i, Unit& u) const {
        constexpr int nwg = NM * NN, q = nwg / NXCD, r = nwg % NXCD, nig = GM * NN;
        const int L = i * G + c; if (L >= nwg) return false;
        const int xcd = L % NXCD, off = L / NXCD; const int wgid = (xcd < r ? xcd * (q + 1) : r * (q + 1) + (xcd - r) * q) + off;
        const int gid = wgid / nig, w = wgid % nig; u.pm = gid * GM + (w % GM); u.pn = w / GM; return true;
    }
    __device__ __forceinline__ void a_ready(const Unit&) const {}
    __device__ __forceinline__ void done(const Unit&) const {}
};

template <int NN> struct TeamOrder {
    int T, r;
    __device__ __forceinline__ void init(int T_, int r_) { T = T_; r = r_; }
    __device__ __forceinline__ bool next(int i, Unit& u) const { const int L = i * T + r; if (L >= 2 * NN) return false; u.pm = 128 + L / NN; u.pn = L % NN; return true; }
    __device__ __forceinline__ void a_ready(const Unit&) const {}
    __device__ __forceinline__ void done(const Unit&) const {}
};
template <class Epi, class Sched, bool ALIGN_EPI = false, bool SP2 = false>
__device__ __forceinline__ void gemm_phase(PG8_LAS unsigned char* lds, const Gemm g, const Sched& S, const Epi& E) {
    const int tid = opaque_tid(), wid = __builtin_amdgcn_readfirstlane(tid >> 6), lane = tid & 63, wr = wid >> 2, wc = wid & 3, fr = lane & 15, fq = lane >> 4;
    const int K = g.K, nt = K / BK;
    unsigned voffA[2], voffB[2];
#pragma unroll
    for (int i = 0; i < 2; ++i) { int R, C; stage_rc(tid * 16 + i * 8192, R, C); const int Rb = Epi::PERM ? ((R & ~31) + perm32(R & 31)) : R;
        voffA[i] = (unsigned)(R * K + C) * 2u; voffB[i] = (unsigned)(Rb * K + C) * 2u; }
    const size_t kstep = (size_t)(BK * 2);
    const size_t hstep = (size_t)HALF * K * 2;
    const size_t tstep = 2 * hstep;
    const unsigned ldsw = (unsigned)wid * 1024u;
    const int aoff = lds_byte(wr * 64 + fr, fq * 8), boff = lds_byte(wc * 32 + fr, fq * 8);
#define PG8_SA(b, h) (((b) * 2 + (h)) * HTB)
#define PG8_SB(b, h) ((4 + (b) * 2 + (h)) * HTB)
#define PG8_STAGE(bufoff, gbase, voff) do { _Pragma("unroll") for (int _i = 0; _i < 2; ++_i) \
        __builtin_amdgcn_global_load_lds((const unsigned*)((const char*)(gbase) + (voff)[_i]), (PG8_LAS unsigned*)(lds + (bufoff) + ldsw + _i * 8192), 16, 0, 0); } while (0)
#define PG8_LDA(dst, b, h) do { _Pragma("unroll") for (int m = 0; m < 4; ++m) _Pragma("unroll") for (int k = 0; k < 2; ++k) dst[m][k] = *(const PG8_LAS bf16x8*)(lds + PG8_SA(b, h) + aoff + m * 2048 + k * 1024); } while (0)
#define PG8_LDB(dst, b, h) do { _Pragma("unroll") for (int n = 0; n < 2; ++n) _Pragma("unroll") for (int k = 0; k < 2; ++k) dst[n][k] = *(const PG8_LAS bf16x8*)(lds + PG8_SB(b, h) + boff + n * 2048 + k * 1024); } while (0)
#define PG8_MMA(ai, bj, At, Bt) do { __builtin_amdgcn_s_setprio(1); _Pragma("unroll") for (int m = 0; m < 4; ++m) _Pragma("unroll") for (int n = 0; n < 2; ++n) _Pragma("unroll") for (int k = 0; k < 2; ++k) \
        acc[ai][bj][m][n] = __builtin_amdgcn_mfma_f32_16x16x32_bf16(Bt[n][k], At[m][k], acc[ai][bj][m][n], 0, 0, 0); __builtin_amdgcn_s_setprio(0); } while (0)
#define PG8_WAIT_V(n) asm volatile("s_waitcnt vmcnt(" #n ")" ::: "memory")
#define PG8_WAIT_L(n) asm volatile("s_waitcnt lgkmcnt(" #n ")" ::: "memory")
#define PG8_BAR __builtin_amdgcn_s_barrier()
#define PG8_SCHED __builtin_amdgcn_sched_barrier(0)
    Unit cur, nxt; int ui = 0;
    if (!S.next(0, cur)) return;
    f32x4 acc[2][2][4][2];
#pragma unroll
    for (int a = 0; a < 2; ++a)
#pragma unroll
        for (int b = 0; b < 2; ++b)
#pragma unroll
            for (int m = 0; m < 4; ++m)
#pragma unroll
                for (int n = 0; n < 2; ++n) acc[a][b][m][n] = (f32x4){0.f, 0.f, 0.f, 0.f};
    bf16x8 At[4][2], B0[2][2], B1[2][2];
    const char* cA = (const char*)g.A + (size_t)cur.pm * tstep; const char* cB = (const char*)g.Bt + (size_t)cur.pn * tstep;
    S.a_ready(cur);
    if constexpr (SP2) {
        PG8_STAGE(PG8_SB(0, 0), cB, voffB); PG8_STAGE(PG8_SB(0, 1), cB + hstep, voffB); PG8_STAGE(PG8_SA(0, 0), cA, voffA); PG8_STAGE(PG8_SA(0, 1), cA + hstep, voffA);
        if (wr == 1) PG8_BAR;
        PG8_WAIT_V(2); PG8_BAR;
        PG8_STAGE(PG8_SB(1, 0), cB + kstep, voffB); PG8_STAGE(PG8_SA(1, 0), cA + kstep, voffA); PG8_STAGE(PG8_SB(1, 1), cB + hstep + kstep, voffB);
        PG8_WAIT_V(6); PG8_BAR;
    } else {
        PG8_STAGE(PG8_SB(0, 0), cB, voffB); PG8_STAGE(PG8_SA(0, 0), cA, voffA); PG8_STAGE(PG8_SB(0, 1), cB + hstep, voffB); PG8_STAGE(PG8_SA(0, 1), cA + hstep, voffA);
        if (wr == 1) PG8_BAR;
        PG8_WAIT_V(4); PG8_BAR;
        PG8_STAGE(PG8_SB(1, 0), cB + kstep, voffB); PG8_STAGE(PG8_SA(1, 0), cA + kstep, voffA); PG8_STAGE(PG8_SB(1, 1), cB + hstep + kstep, voffB);
        PG8_WAIT_V(6); PG8_BAR;
    }
    for (;;) {
        const bool has_next = S.next(ui + 1, nxt);
        const char* nA = has_next ? (const char*)g.A + (size_t)nxt.pm * tstep : cA; const char* nB = has_next ? (const char*)g.Bt + (size_t)nxt.pn * tstep : cB;
        for (int t = 0; t < nt; t += 2) {
            const bool last = (t == nt - 2);
            const char* a1 = cA + (size_t)(t + 1) * kstep;
            const char* a2 = last ? nA : cA + (size_t)(t + 2) * kstep; const char* b2 = last ? nB : cB + (size_t)(t + 2) * kstep;
            const char* a3 = a2 + kstep; const char* b3 = b2 + kstep;
            if (last && has_next) S.a_ready(nxt);
            if constexpr (SP2) {
            PG8_LDB(B0, 0, 0); PG8_LDB(B1, 0, 1); PG8_SCHED; PG8_LDA(At, 0, 0); PG8_STAGE(PG8_SA(1, 1), a1 + hstep, voffA);
            PG8_WAIT_V(8); PG8_WAIT_L(0); PG8_BAR; PG8_MMA(0, 0, At, B0); PG8_MMA(0, 1, At, B1); PG8_BAR; PG8_SCHED;
            PG8_LDA(At, 0, 1); PG8_STAGE(PG8_SB(0, 0), b2, voffB); PG8_STAGE(PG8_SB(0, 1), b2 + hstep, voffB); PG8_STAGE(PG8_SA(0, 0), a2, voffA);
            PG8_WAIT_V(8); PG8_WAIT_L(0); PG8_BAR; PG8_MMA(1, 0, At, B0); PG8_MMA(1, 1, At, B1); PG8_BAR; PG8_SCHED;
            PG8_LDB(B0, 1, 0); PG8_LDB(B1, 1, 1); PG8_SCHED; PG8_LDA(At, 1, 0); PG8_STAGE(PG8_SA(0, 1), a2 + hstep, voffA);
            PG8_WAIT_V(8); PG8_WAIT_L(0); PG8_BAR; PG8_MMA(0, 0, At, B0); PG8_MMA(0, 1, At, B1); PG8_BAR; PG8_SCHED;
            PG8_LDA(At, 1, 1); PG8_STAGE(PG8_SB(1, 0), b3, voffB); PG8_STAGE(PG8_SB(1, 1), b3 + hstep, voffB); PG8_STAGE(PG8_SA(1, 0), a3, voffA);
            PG8_WAIT_V(8); PG8_WAIT_L(0); PG8_BAR; PG8_MMA(1, 0, At, B0); PG8_MMA(1, 1, At, B1); PG8_BAR; PG8_SCHED;
            } else {
            PG8_LDB(B0, 0, 0); PG8_SCHED; PG8_LDA(At, 0, 0); PG8_STAGE(PG8_SA(1, 1), a1 + hstep, voffA);
            PG8_WAIT_L(8); PG8_BAR; PG8_WAIT_L(0); PG8_MMA(0, 0, At, B0); PG8_BAR; PG8_SCHED;
            PG8_LDB(B1, 0, 1); PG8_STAGE(PG8_SB(0, 0), b2, voffB);
            PG8_BAR; PG8_WAIT_L(0); PG8_MMA(0, 1, At, B1); PG8_BAR;
            PG8_LDA(At, 0, 1); PG8_STAGE(PG8_SA(0, 0), a2, voffA);
            PG8_BAR; PG8_WAIT_L(0); PG8_MMA(1, 0, At, B0); PG8_BAR; PG8_SCHED;
            PG8_STAGE(PG8_SB(0, 1), b2 + hstep, voffB);
            PG8_WAIT_V(6); PG8_BAR; PG8_MMA(1, 1, At, B1); PG8_BAR;
            PG8_LDB(B0, 1, 0); PG8_SCHED; PG8_LDA(At, 1, 0); PG8_STAGE(PG8_SA(0, 1), a2 + hstep, voffA);
            PG8_WAIT_L(8); PG8_BAR; PG8_WAIT_L(0); PG8_MMA(0, 0, At, B0); PG8_BAR; PG8_SCHED;
            PG8_LDB(B1, 1, 1); PG8_STAGE(PG8_SB(1, 0), b3, voffB);
            PG8_BAR; PG8_WAIT_L(0); PG8_MMA(0, 1, At, B1); PG8_BAR;
            PG8_LDA(At, 1, 1); PG8_STAGE(PG8_SA(1, 0), a3, voffA);
            PG8_BAR; PG8_WAIT_L(0); PG8_MMA(1, 0, At, B0); PG8_BAR; PG8_SCHED;
            PG8_STAGE(PG8_SB(1, 1), b3 + hstep, voffB);
            PG8_WAIT_V(6); PG8_BAR; PG8_MMA(1, 1, At, B1); PG8_BAR;
            }
        }
        if constexpr (ALIGN_EPI) { if (wr == 0) PG8_BAR; }
        if constexpr (!Epi::AFTER_DRAIN) { E(acc, cur, wr, wc, fr, fq); S.done(cur); }
        if (!has_next) break;
#pragma unroll
        for (int a = 0; a < 2; ++a)
#pragma unroll
            for (int b = 0; b < 2; ++b)
#pragma unroll
                for (int m = 0; m < 4; ++m)
#pragma unroll
                    for (int n = 0; n < 2; ++n) acc[a][b][m][n] = (f32x4){0.f, 0.f, 0.f, 0.f};
        cur = nxt; cA = nA; cB = nB; ++ui;
        if constexpr (ALIGN_EPI) { if (wr == 1) PG8_BAR; }
    }
    PG8_WAIT_V(0);
    if constexpr (!ALIGN_EPI) { if (wr == 0) PG8_BAR; }
    PG8_BAR;
    if constexpr (Epi::AFTER_DRAIN) { E.fused(acc, cur, wr, wc, fr, fq, lds, wid, lane); S.done(cur); }
#undef PG8_SA
#undef PG8_SB
#undef PG8_STAGE
#undef PG8_LDA
#undef PG8_LDB
#undef PG8_MMA
#undef PG8_WAIT_V
#undef PG8_WAIT_L
#undef PG8_BAR
#undef PG8_SCHED
}
}
namespace attn_body {
using bf16=__hip_bfloat16;
using bf16x8=__attribute__((ext_vector_type(8)))short;
using s16x4=__attribute__((ext_vector_type(4)))short;
using f32x16=__attribute__((ext_vector_type(16)))float;
using u32x4=__attribute__((ext_vector_type(4)))unsigned;
constexpr int BATCH=4,NHEAD=16,SEQ=8192,D=64,DM=NHEAD*D;
constexpr int NW=8,QBLK=32,QB=QBLK*NW,KVBLK=64,NQB=SEQ/QB;
constexpr int ATTN_PITCH=DM, ATTN_UNIT_ROWS=QB;
__device__ __forceinline__ int crow(int r,int hi){return (r&3)+8*(r>>2)+4*hi;}
#define SBAR() __builtin_amdgcn_sched_barrier(0)
__device__ __forceinline__ void cmask(f32x16&p0,f32x16&p1,int jb,int qrel,int hi){
  const float NEG=-INFINITY; (void)hi;
  if(jb>(qrel>>6)){
  #pragma unroll
  for(int r=0;r<16;++r){p0[r]=NEG;p1[r]=NEG;} }
}

constexpr int NSLOT=3, SLOTB=8192;
constexpr int LDS_K=0, LDS_V=NSLOT*SLOTB, LDS_WS=2*NSLOT*SLOTB, LDS_OST=LDS_WS+NW*64*4, LDS_BYTES=LDS_OST+NW*4096;
constexpr float C2=0.125f*1.4426950408889634f;
__device__ __forceinline__ void glds16(const void*gsrc,unsigned lds_dst){unsigned keep;
  asm volatile("s_mov_b32 %0, m0\n\ts_mov_b32 m0, %2\n\ts_nop 0\n\tglobal_load_lds_dwordx4 %1, off\n\ts_mov_b32 m0, %0":"=&s"(keep):"v"(gsrc),"s"(lds_dst):"memory");}
__device__ __forceinline__ float max3f(float a,float b,float c){float r;asm("v_max3_f32 %0, %1, %2, %3":"=v"(r):"v"(a),"v"(b),"v"(c));return r;}
__device__ __forceinline__ float max2f(float a,float b){float r;asm("v_max_f32_e32 %0, %1, %2":"=v"(r):"v"(a),"v"(b));return r;}
__device__ __forceinline__ float fadd_s(float a,float b){float r;asm("v_add_f32_e32 %0, %1, %2":"=v"(r):"v"(a),"v"(b));return r;}
__device__ __forceinline__ float fsub_s(float a,float b){float r;asm("v_sub_f32_e32 %0, %1, %2":"=v"(r):"v"(a),"v"(b));return r;}
typedef float f32x2_t __attribute__((ext_vector_type(2))); typedef __bf16 bf16x2_t __attribute__((ext_vector_type(2)));
__device__ __forceinline__ unsigned cvtpk_s(float lo,float hi){f32x2_t v={lo,hi};bf16x2_t b=__builtin_convertvector(v,bf16x2_t);return __builtin_bit_cast(unsigned,b);}
#define WAIT_BAR(N) asm volatile("s_waitcnt vmcnt(" #N ") lgkmcnt(0)\n\ts_barrier":::"memory")

__device__ __forceinline__ void qkt(f32x16&p0,f32x16&p1,const char*Kslot,const bf16x8*qr,const f32x16&negm,int r32,int hi){
  const char*kb=Kslot+hi*1024+r32*16;
  #pragma unroll
  for(int d0=0;d0<4;++d0){
    const bf16x8 b0=*reinterpret_cast<const bf16x8*>(kb+d0*2048);
    const bf16x8 b1=*reinterpret_cast<const bf16x8*>(kb+d0*2048+512);
    if(d0==0){p0=__builtin_amdgcn_mfma_f32_32x32x16_bf16(b0,qr[0],negm,0,0,0);p1=__builtin_amdgcn_mfma_f32_32x32x16_bf16(b1,qr[0],negm,0,0,0);}
    else{p0=__builtin_amdgcn_mfma_f32_32x32x16_bf16(b0,qr[d0],p0,0,0,0);p1=__builtin_amdgcn_mfma_f32_32x32x16_bf16(b1,qr[d0],p1,0,0,0);}}
}
typedef __attribute__((address_space(3))) const char* lds_cptr;
typedef short v4i16_t __attribute__((ext_vector_type(4)));
__device__ __forceinline__ void kload8(bf16x8*kf,lds_cptr kp){
  kf[0]=*(const __attribute__((address_space(3))) bf16x8*)(kp);      kf[1]=*(const __attribute__((address_space(3))) bf16x8*)(kp+512);
  kf[2]=*(const __attribute__((address_space(3))) bf16x8*)(kp+2048); kf[3]=*(const __attribute__((address_space(3))) bf16x8*)(kp+2560);
  kf[4]=*(const __attribute__((address_space(3))) bf16x8*)(kp+4096); kf[5]=*(const __attribute__((address_space(3))) bf16x8*)(kp+4608);
  kf[6]=*(const __attribute__((address_space(3))) bf16x8*)(kp+6144); kf[7]=*(const __attribute__((address_space(3))) bf16x8*)(kp+6656);
}
__device__ __forceinline__ void kload2(bf16x8*kf,lds_cptr kp,int j){ kf[2*j]=*(const __attribute__((address_space(3))) bf16x8*)(kp+j*2048); kf[2*j+1]=*(const __attribute__((address_space(3))) bf16x8*)(kp+j*2048+512); }
__device__ __forceinline__ s16x4 vtr(lds_cptr p){ return __builtin_bit_cast(s16x4,__builtin_amdgcn_ds_read_tr16_b64_v4i16((__attribute__((address_space(3))) v4i16_t*)p)); }
__device__ __forceinline__ float rowmax(const f32x16&p0,const f32x16&p1){
  float a=max3f(p0[0],p0[1],p1[0]),b=max3f(p0[2],p0[3],p1[1]);a=max3f(a,p1[2],p1[3]);
  #pragma unroll
  for(int r=4;r<16;r+=4){a=max3f(a,p0[r],p0[r+1]);b=max3f(b,p0[r+2],p0[r+3]);a=max3f(a,p1[r],p1[r+1]);b=max3f(b,p1[r+2],p1[r+3]);}
  const float m=max2f(a,b);
  auto rr=__builtin_amdgcn_permlane32_swap(__float_as_uint(m),__float_as_uint(m),false,false);
  return max2f(__uint_as_float(rr[0]),__uint_as_float(rr[1]));
}
__device__ __forceinline__ void pv(f32x16*o,int vb,bf16x8 pa0,bf16x8 pa1,bf16x8 pa2,bf16x8 pa3){
  #pragma unroll
  for(int d0=0;d0<2;++d0){s16x4 lo[4],hi[4];
    #pragma unroll
    for(int ks=0;ks<4;++ks){
      asm volatile("ds_read_b64_tr_b16 %0,%1 offset:%c2":"=&v"(lo[ks]):"v"(vb),"i"(d0*4096+ks*1024):"memory");
      asm volatile("ds_read_b64_tr_b16 %0,%1 offset:%c2":"=&v"(hi[ks]):"v"(vb),"i"(d0*4096+ks*1024+512):"memory");}
    asm volatile("s_waitcnt lgkmcnt(0)":::"memory");SBAR();
    #define PK(k) (bf16x8){lo[k][0],lo[k][1],lo[k][2],lo[k][3],hi[k][0],hi[k][1],hi[k][2],hi[k][3]}
    o[d0]=__builtin_amdgcn_mfma_f32_32x32x16_bf16(pa0,PK(0),o[d0],0,0,0);
    o[d0]=__builtin_amdgcn_mfma_f32_32x32x16_bf16(pa1,PK(1),o[d0],0,0,0);
    o[d0]=__builtin_amdgcn_mfma_f32_32x32x16_bf16(pa2,PK(2),o[d0],0,0,0);
    o[d0]=__builtin_amdgcn_mfma_f32_32x32x16_bf16(pa3,PK(3),o[d0],0,0,0);
    #undef PK
  }
}

#ifndef ATTN_STORE16
#define ATTN_STORE16(p,v) (*(u32x4*)(p)=(v))
#endif
template<int THRL> __device__ __forceinline__ void attn_unit(int b,int hq,int hv,int qb,const bf16*Q,const bf16*__restrict__ K,const bf16*__restrict__ V,bf16*O,char*shm){
  const int tid=opaque_tid(),lane=tid&63,r32=lane&31,hi=lane>>5; const int wid=__builtin_amdgcn_readfirstlane(tid>>6);
  const long rowbase=(long)b*SEQ; const int q0=qb*QB;
  const bf16*Qw=Q+(rowbase+q0+wid*QBLK)*DM+hq*D;
  const bf16*Kh=K+rowbase*DM+hq*D,*Vh=V+rowbase*DM+hv*D;
  const unsigned lds0=(unsigned)(uintptr_t)shm;
  float*wsf=(float*)(shm+LDS_WS)+wid*64;
  const bf16*ksrc=Kh+(long)lane*DM+wid*8;
  const bf16*vsrc=Vh+(long)(16*(wid&3)+(lane>>2))*DM+(wid>>2)*32+(lane&3)*8;
  const unsigned kdst=lds0+LDS_K+wid*1024, vdst=lds0+LDS_V+wid*1024;
  #define DMA_K(t,slot) glds16(ksrc+(long)(t)*KVBLK*DM,(unsigned)__builtin_amdgcn_readfirstlane(kdst+(slot)))
  #define DMA_V(t,slot) glds16(vsrc+(long)(t)*KVBLK*DM,(unsigned)__builtin_amdgcn_readfirstlane(vdst+(slot)))
  const int vb0=(int)(lds0+LDS_V)+((lane>>4)&1)*32+(lane&3)*8+(4*hi+((lane&15)>>2))*64;
  const char*Kbase=shm+LDS_K; bf16x8 kf[8];
  const lds_cptr shm3=(lds_cptr)shm; const lds_cptr kp0=shm3+LDS_K+hi*1024+r32*16; const lds_cptr vp0=shm3+LDS_V+((lane>>4)&1)*32+(lane&3)*8+(4*hi+((lane&15)>>2))*64;
  const int NT=(q0+QB)/KVBLK;
  DMA_K(0,0);DMA_V(0,0);DMA_K(1,SLOTB);
  bf16x8 qr[4];
  #pragma unroll
  for(int d0=0;d0<4;++d0)qr[d0]=*reinterpret_cast<const bf16x8*>(&Qw[(long)r32*DM+d0*16+hi*8]);
  float mhat=0.f,l_reg=0.f;f32x16 o[2];o[0]=f32x16{};o[1]=f32x16{};f32x16 negm=f32x16{};asm volatile("":"+v"(negm));
  const int qrel=wid*QBLK+r32;
  #define CMASK(P0,P1,t) do{int jb_=(t)-(NT-4); if(jb_>=0)cmask(P0,P1,jb_,qrel,hi);}while(0)
  bool resc=false;
  #define START(P0,P1) do{ const float rm=rowmax(P0,P1); resc=false; \
    { const float dl=rm; mhat=fadd_s(mhat,dl); \
      _Pragma("unroll") for(int r=0;r<16;++r){P0[r]=fsub_s(P0[r],dl);P1[r]=fsub_s(P1[r],dl);} \
      _Pragma("unroll") for(int r=0;r<16;++r)negm[r]=-mhat; asm volatile("":"+v"(negm)); } \
    _Pragma("unroll") for(int r=0;r<16;++r)P0[r]=__builtin_amdgcn_exp2f(P0[r]); }while(0)
  #define RESC() do{ if(resc){ asm volatile("s_waitcnt lgkmcnt(0)":::"memory"); \
      _Pragma("unroll") for(int d_=0;d_<2;++d_) _Pragma("unroll") for(int r=0;r<16;++r)o[d_][r]*=wsf[crow(r,hi)]; } }while(0)
  f32x16 pA0,pA1,pB0,pB1;
  int sl_prev=0,sl_cur=0,sl_next=SLOTB;
  #define ROT() do{sl_prev=sl_cur;sl_cur=sl_next;sl_next=(sl_next==(NSLOT-1)*SLOTB)?0:sl_next+SLOTB;}while(0)
  DMA_K(2,2*SLOTB);
  WAIT_BAR(3);
  qkt(pA0,pA1,Kbase,qr,negm,r32,hi);asm volatile("s_nop 15\n\ts_nop 7":"+v"(pA0),"+v"(pA1));CMASK(pA0,pA1,0);
  START(pA0,pA1);
  _Pragma("unroll") for(int r=0;r<16;++r)pA1[r]=__builtin_amdgcn_exp2f(pA1[r]);
  WAIT_BAR(0);
  DMA_K(3,0);DMA_V(1,SLOTB);
  ROT();
  kload8(kf,kp0+sl_cur);
  WAIT_BAR(2);
  s16x4 vlo[8],vhi[8]; u32x4 pw0,pw1,pw2,pw3;
  #define PKW(P,B) cvtpk_s(P[B],P[B+1])
  #define PAF(k) __builtin_bit_cast(bf16x8,pw##k)
  #define VFR(i) (bf16x8){vlo[i][0],vlo[i][1],vlo[i][2],vlo[i][3],vhi[i][0],vhi[i][1],vhi[i][2],vhi[i][3]}
  #define PIN(x) asm volatile("":"+v"(x))
  #define MX3(a,b,c) __builtin_fmaxf(__builtin_fmaxf((a),(b)),(c))
  #define GAPA(MF,A0,A1,A2,A3,W0,W1,PW) do{ MF; sacc+=A0; sacc+=A1; sacc+=A2; sacc+=A3; PIN(sacc); W0; W1; PIN(PW); SBAR(); }while(0)
  #define EX(v) __builtin_amdgcn_exp2f(v)
  #define GAPB(MF,X,B) do{ MF; X[B]=EX(X[B]); X[B+1]=EX(X[B+1]); X[B+2]=EX(X[B+2]); X[B+3]=EX(X[B+3]); PIN(X); SBAR(); }while(0)
  #define VRD(i) do{ vlo[i]=vtr(vp_+(((i)>>2)*4096+((i)&3)*1024)); vhi[i]=vtr(vp_+(((i)>>2)*4096+((i)&3)*1024+512)); }while(0)
  #define KRD(G,j) do{ if(G){ kload2(kf,kp0+sl_next,j); SBAR(); } }while(0)
  #define STEP(C0,C1,P0,P1,t,GK,GV,GL) do{ SBAR(); \
    const lds_cptr vp_=vp0+sl_prev; \
    VRD(0); SBAR(); float sacc=(P0[0]+P0[1]); \
    GAPA(C0=__builtin_amdgcn_mfma_f32_32x32x16_bf16(kf[0],qr[0],negm,0,0,0), P0[2],P0[3],P0[4],P0[5],     pw0[0]=PKW(P0,0), pw0[1]=PKW(P0,2), pw0); \
    VRD(4); SBAR(); GAPA(C1=__builtin_amdgcn_mfma_f32_32x32x16_bf16(kf[1],qr[0],negm,0,0,0), P0[6],P0[7],P0[8],P0[9],     pw0[2]=PKW(P0,4), pw0[3]=PKW(P0,6), pw0); \
    VRD(1); SBAR(); GAPA(C0=__builtin_amdgcn_mfma_f32_32x32x16_bf16(kf[2],qr[1],C0,0,0,0),   P0[10],P0[11],P0[12],P0[13], pw1[0]=PKW(P0,8), pw1[1]=PKW(P0,10), pw1); \
    VRD(5); SBAR(); GAPA(C1=__builtin_amdgcn_mfma_f32_32x32x16_bf16(kf[3],qr[1],C1,0,0,0),   P0[14],P0[15],P1[0],P1[1],   pw1[2]=PKW(P0,12),pw1[3]=PKW(P0,14), pw1); \
    VRD(2); SBAR(); GAPA(C0=__builtin_amdgcn_mfma_f32_32x32x16_bf16(kf[4],qr[2],C0,0,0,0),   P1[2],P1[3],P1[4],P1[5],     pw2[0]=PKW(P1,0), pw2[1]=PKW(P1,2), pw2); \
    VRD(6); SBAR(); GAPA(C1=__builtin_amdgcn_mfma_f32_32x32x16_bf16(kf[5],qr[2],C1,0,0,0),   P1[6],P1[7],P1[8],P1[9],     pw2[2]=PKW(P1,4), pw2[3]=PKW(P1,6), pw2); \
    VRD(3); SBAR(); GAPA(C0=__builtin_amdgcn_mfma_f32_32x32x16_bf16(kf[6],qr[3],C0,0,0,0),   P1[10],P1[11],P1[12],P1[13], pw3[0]=PKW(P1,8), pw3[1]=PKW(P1,10), pw3); \
    VRD(7); SBAR(); GAPA(C1=__builtin_amdgcn_mfma_f32_32x32x16_bf16(kf[7],qr[3],C1,0,0,0),   P1[14],P1[15],0.f,0.f,       pw3[2]=PKW(P1,12),pw3[3]=PKW(P1,14), pw3); \
    l_reg+=sacc; \
    if(GK){DMA_K((t)+3,sl_cur);} if(GV){DMA_V((t)+1,sl_next);} \
    CMASK(C0,C1,t); \
    { float a=MX3(C0[0],C0[1],C1[0]),b=MX3(C0[2],C0[3],C1[1]); a=MX3(a,C1[2],C1[3]); \
      _Pragma("unroll") for(int r=4;r<16;r+=4){a=MX3(a,C0[r],C0[r+1]);b=MX3(b,C0[r+2],C0[r+3]);a=MX3(a,C1[r],C1[r+1]);b=MX3(b,C1[r+2],C1[r+3]);} \
      float rm=__builtin_fmaxf(a,b); { auto rr=__builtin_amdgcn_permlane32_swap(__float_as_uint(rm),__float_as_uint(rm),false,false); rm=__builtin_fmaxf(__uint_as_float(rr[0]),__uint_as_float(rr[1])); } \
      resc=false; \
      if(__builtin_expect(__any(rm>(float)THRL),0)){ const float dl=__builtin_fmaxf(rm,0.f); mhat+=dl; \
        _Pragma("unroll") for(int r=0;r<16;++r){C0[r]-=dl;C1[r]-=dl;} \
        _Pragma("unroll") for(int r=0;r<16;++r)negm[r]=-mhat; asm volatile("":"+v"(negm)); \
        const float f=__builtin_amdgcn_exp2f(-dl); l_reg*=f; if(hi==0)wsf[r32]=f; resc=true; } } \
    SBAR(); \
    GAPB(o[0]=__builtin_amdgcn_mfma_f32_32x32x16_bf16(PAF(0),VFR(0),o[0],0,0,0), C0,0); \
    GAPB(o[1]=__builtin_amdgcn_mfma_f32_32x32x16_bf16(PAF(0),VFR(4),o[1],0,0,0), C0,4); \
    KRD(GL,0); GAPB(o[0]=__builtin_amdgcn_mfma_f32_32x32x16_bf16(PAF(1),VFR(1),o[0],0,0,0), C0,8); \
    KRD(GL,1); GAPB(o[1]=__builtin_amdgcn_mfma_f32_32x32x16_bf16(PAF(1),VFR(5),o[1],0,0,0), C0,12); \
    KRD(GL,2); GAPB(o[0]=__builtin_amdgcn_mfma_f32_32x32x16_bf16(PAF(2),VFR(2),o[0],0,0,0), C1,0); \
    KRD(GL,3); GAPB(o[1]=__builtin_amdgcn_mfma_f32_32x32x16_bf16(PAF(2),VFR(6),o[1],0,0,0), C1,4); \
    GAPB(o[0]=__builtin_amdgcn_mfma_f32_32x32x16_bf16(PAF(3),VFR(3),o[0],0,0,0), C1,8); \
    GAPB(o[1]=__builtin_amdgcn_mfma_f32_32x32x16_bf16(PAF(3),VFR(7),o[1],0,0,0), C1,12); \
    }while(0)
  int t=1;
  #undef CMASK
  #define CMASK(P0,P1,t) do{}while(0)
  for(;t+5<NT;t+=2){
    STEP(pB0,pB1,pA0,pA1,t,true,true,true);     WAIT_BAR(2); RESC(); ROT();
    STEP(pA0,pA1,pB0,pB1,t+1,true,true,true);   WAIT_BAR(2); RESC(); ROT();
  }
  #undef CMASK
  #define CMASK(P0,P1,t) do{int jb_=(t)-(NT-4); if(jb_>=0)cmask(P0,P1,jb_,qrel,hi);}while(0)
  #define ENDW(tt) do{ if((tt)+3<NT){WAIT_BAR(2);} else if((tt)+2<NT){WAIT_BAR(1);} else {WAIT_BAR(0);} }while(0)
  for(;t+1<NT;t+=2){
    STEP(pB0,pB1,pA0,pA1,t,(t+3<NT),(t+1<NT),(t+1<NT));       ENDW(t);   RESC(); ROT();
    STEP(pA0,pA1,pB0,pB1,t+1,(t+4<NT),(t+2<NT),(t+2<NT));     ENDW(t+1); RESC(); ROT();
  }
  STEP(pB0,pB1,pA0,pA1,NT-1,false,false,false); RESC();
  { float sacc=pB0[0]+pB0[1]; _Pragma("unroll") for(int r=2;r<16;++r)sacc+=pB0[r]; _Pragma("unroll") for(int r=0;r<16;++r)sacc+=pB1[r]; l_reg+=sacc;
    pw0=(u32x4){PKW(pB0,0),PKW(pB0,2),PKW(pB0,4),PKW(pB0,6)};pw1=(u32x4){PKW(pB0,8),PKW(pB0,10),PKW(pB0,12),PKW(pB0,14)};pw2=(u32x4){PKW(pB1,0),PKW(pB1,2),PKW(pB1,4),PKW(pB1,6)};pw3=(u32x4){PKW(pB1,8),PKW(pB1,10),PKW(pB1,12),PKW(pB1,14)};
    SBAR(); pv(o,vb0+sl_cur,PAF(0),PAF(1),PAF(2),PAF(3)); }
  #undef PKW
  #undef PAF
  #undef VFR
  #undef PIN
  #undef MX3
  #undef GAPA
  #undef GAPB
  #undef EX
  #undef VRD
  #undef KRD
  #undef STEP
  #undef ENDW
  {auto rr=__builtin_amdgcn_permlane32_swap(__float_as_uint(l_reg),__float_as_uint(l_reg),false,false);l_reg=__uint_as_float(rr[0])+__uint_as_float(rr[1]);}
  if(hi==0)wsf[32+r32]=l_reg;asm volatile("s_waitcnt lgkmcnt(0)":::"memory");
  float rli[16];
  #pragma unroll
  for(int r=0;r<16;++r)rli[r]=__builtin_amdgcn_rcpf(wsf[32+crow(r,hi)]);
  bf16*Ow=O+(rowbase+q0+wid*QBLK)*DM+hv*D;
  { bf16*stg=(bf16*)(shm+LDS_OST)+wid*2048;
    #pragma unroll
    for(int r=0;r<16;++r){const int orow=crow(r,hi);
      #pragma unroll
      for(int d0=0;d0<2;++d0)stg[orow*64+d0*32+r32]=__float2bfloat16(o[d0][r]*rli[r]);}
    asm volatile("s_waitcnt lgkmcnt(0)":::"memory");
    #pragma unroll
    for(int i=0;i<4;++i){const int row=i*8+(lane>>3),ch=lane&7; const u32x4 v=*(const u32x4*)(stg+row*64+ch*8); ATTN_STORE16(Ow+(long)row*DM+ch*8,v);} }
  asm volatile("s_waitcnt lgkmcnt(0)\n\ts_barrier":::"memory");
  #undef DMA_K
  #undef DMA_V
  #undef CMASK
  #undef START
  #undef RESC
  #undef ROT
}
__device__ __forceinline__ void pv128(f32x16*o,int vb,bf16x8 pa0,bf16x8 pa1,bf16x8 pa2,bf16x8 pa3){
  #pragma unroll
  for(int d0=0;d0<4;++d0){s16x4 lo[4],hi[4];
    #pragma unroll
    for(int ks=0;ks<4;++ks){
      asm volatile("ds_read_b64_tr_b16 %0,%1 offset:%c2":"=&v"(lo[ks]):"v"(vb),"i"(d0*4096+ks*1024):"memory");
      asm volatile("ds_read_b64_tr_b16 %0,%1 offset:%c2":"=&v"(hi[ks]):"v"(vb),"i"(d0*4096+ks*1024+512):"memory");}
    asm volatile("s_waitcnt lgkmcnt(0)":::"memory");SBAR();
    #define PK(k) (bf16x8){lo[k][0],lo[k][1],lo[k][2],lo[k][3],hi[k][0],hi[k][1],hi[k][2],hi[k][3]}
    o[d0]=__builtin_amdgcn_mfma_f32_32x32x16_bf16(pa0,PK(0),o[d0],0,0,0);
    o[d0]=__builtin_amdgcn_mfma_f32_32x32x16_bf16(pa1,PK(1),o[d0],0,0,0);
    o[d0]=__builtin_amdgcn_mfma_f32_32x32x16_bf16(pa2,PK(2),o[d0],0,0,0);
    o[d0]=__builtin_amdgcn_mfma_f32_32x32x16_bf16(pa3,PK(3),o[d0],0,0,0);
    #undef PK
  }
}
constexpr int SLOTV=16384, LDS_V2=NSLOT*SLOTB, LDS_WS2=LDS_V2+NSLOT*SLOTV, LDS_OST2=LDS_WS2+NW*64*4, LDS_BYTES2=LDS_OST2+NW*4096;
template<int THRL> __device__ __forceinline__ void attn_unit128(int b,int hq,int hv,int qb,const bf16*Q,const bf16*__restrict__ K,const bf16*__restrict__ V,bf16*O,char*shm){
  const int tid=opaque_tid(),lane=tid&63,r32=lane&31,hi=lane>>5; const int wid=__builtin_amdgcn_readfirstlane(tid>>6);
  const long rowbase=(long)b*SEQ; const int q0=qb*QB;
  const bf16*Qw=Q+(rowbase+q0+wid*QBLK)*DM+hq*D;
  const bf16*Kh=K+rowbase*DM+hq*D,*Vh=V+rowbase*DM+hv*D;
  const unsigned lds0=(unsigned)(uintptr_t)shm;
  float*wsf=(float*)(shm+LDS_WS2)+wid*64;
  const bf16*ksrc=Kh+(long)lane*DM+wid*8;
  const bf16*vsrc=Vh+(long)(16*(wid&3)+(lane>>2))*DM+(wid>>2)*32+(lane&3)*8;
  const unsigned kdst=lds0+LDS_K+wid*1024, vdst=lds0+LDS_V2+wid*1024;
  #define DMA_K(t,slot) glds16(ksrc+(long)(t)*KVBLK*DM,(unsigned)__builtin_amdgcn_readfirstlane(kdst+(slot)))
  #define DMA_V(t,slot) do{ glds16(vsrc+(long)(t)*KVBLK*DM,(unsigned)__builtin_amdgcn_readfirstlane(vdst+2*(slot))); glds16(vsrc+64+(long)(t)*KVBLK*DM,(unsigned)__builtin_amdgcn_readfirstlane(vdst+8192+2*(slot))); }while(0)
  const int vb0=(int)(lds0+LDS_V2)+((lane>>4)&1)*32+(lane&3)*8+(4*hi+((lane&15)>>2))*64;
  const char*Kbase=shm+LDS_K; bf16x8 kf[8];
  const lds_cptr shm3=(lds_cptr)shm; const lds_cptr kp0=shm3+LDS_K+hi*1024+r32*16; const lds_cptr vp0=shm3+LDS_V2+((lane>>4)&1)*32+(lane&3)*8+(4*hi+((lane&15)>>2))*64;
  const int NT=(q0+QB)/KVBLK;
  DMA_K(0,0);DMA_V(0,0);DMA_K(1,SLOTB);
  bf16x8 qr[4];
  #pragma unroll
  for(int d0=0;d0<4;++d0)qr[d0]=*reinterpret_cast<const bf16x8*>(&Qw[(long)r32*DM+d0*16+hi*8]);
  float mhat=0.f,l_reg=0.f;f32x16 o[4];o[0]=f32x16{};o[1]=f32x16{};o[2]=f32x16{};o[3]=f32x16{};const f32x16 zc=f32x16{};
  const int qrel=wid*QBLK+r32;
  #define CMASK(P0,P1,t) do{int jb_=(t)-(NT-4); if(jb_>=0)cmask(P0,P1,jb_,qrel,hi);}while(0)
  bool resc=false;
  #define START(P0,P1) do{ const float rm=rowmax(P0,P1); resc=false; \
    { const float dl=rm; mhat=fadd_s(mhat,dl); \
      _Pragma("unroll") for(int r=0;r<16;++r){P0[r]=fsub_s(P0[r],dl);P1[r]=fsub_s(P1[r],dl);} \
      } \
    _Pragma("unroll") for(int r=0;r<16;++r)P0[r]=__builtin_amdgcn_exp2f(P0[r]); }while(0)
  #define RESC() do{ if(resc){ asm volatile("s_waitcnt lgkmcnt(0)":::"memory"); \
      _Pragma("unroll") for(int d_=0;d_<4;++d_) _Pragma("unroll") for(int r=0;r<16;++r)o[d_][r]*=wsf[crow(r,hi)]; } }while(0)
  f32x16 pA0,pA1,pB0,pB1;
  int sl_prev=0,sl_cur=0,sl_next=SLOTB;
  #define ROT() do{sl_prev=sl_cur;sl_cur=sl_next;sl_next=(sl_next==(NSLOT-1)*SLOTB)?0:sl_next+SLOTB;}while(0)
  DMA_K(2,2*SLOTB);
  WAIT_BAR(3);
  qkt(pA0,pA1,Kbase,qr,zc,r32,hi);asm volatile("s_nop 15\n\ts_nop 7":"+v"(pA0),"+v"(pA1));CMASK(pA0,pA1,0);
  START(pA0,pA1);
  _Pragma("unroll") for(int r=0;r<16;++r)pA1[r]=__builtin_amdgcn_exp2f(pA1[r]);
  WAIT_BAR(0);
  DMA_K(3,0);DMA_V(1,SLOTB);
  ROT();
  kload8(kf,kp0+sl_cur);
  WAIT_BAR(3);
  s16x4 vlo[8],vhi[8]; u32x4 pw0,pw1,pw2,pw3;
  #define PKW(P,B) cvtpk_s(P[B],P[B+1])
  #define PAF(k) __builtin_bit_cast(bf16x8,pw##k)
  #define VFR(i) (bf16x8){vlo[i][0],vlo[i][1],vlo[i][2],vlo[i][3],vhi[i][0],vhi[i][1],vhi[i][2],vhi[i][3]}
  #define PIN(x) asm volatile("":"+v"(x))
  #define MX3(a,b,c) __builtin_fmaxf(__builtin_fmaxf((a),(b)),(c))
  #define GAPA(MF,A0,A1,A2,A3,W0,W1,PW) do{ MF; sacc+=A0; sacc+=A1; sacc+=A2; sacc+=A3; PIN(sacc); W0; W1; PIN(PW); SBAR(); }while(0)
  #define EX(v) __builtin_amdgcn_exp2f(v)
  #define GAPB(MF,X,B) do{ MF; X[B]=EX(X[B]); X[B+1]=EX(X[B+1]); X[B+2]=EX(X[B+2]); X[B+3]=EX(X[B+3]); PIN(X); SBAR(); }while(0)
  #define VRD(i) do{ vlo[i]=vtr(vp_+(((i)>>2)*4096+((i)&3)*1024)); vhi[i]=vtr(vp_+(((i)>>2)*4096+((i)&3)*1024+512)); }while(0)
  #define VRX(i) do{ vlo[i]=vtr(vp_+((((i)>>2)+2)*4096+((i)&3)*1024)); vhi[i]=vtr(vp_+((((i)>>2)+2)*4096+((i)&3)*1024+512)); SBAR(); }while(0)
  #define GAPB2(MF,X,B) do{ MF; X[B]=EX(X[B]-mhat); X[B+1]=EX(X[B+1]-mhat); PIN(X); SBAR(); }while(0)
  #define KRD(G,j) do{ if(G){ kload2(kf,kp0+sl_next,j); SBAR(); } }while(0)
  #define STEP(C0,C1,P0,P1,t,GK,GV,GL) do{ SBAR(); \
    const lds_cptr vp_=vp0+2*sl_prev; \
    VRD(0); SBAR(); float sacc=(P0[0]+P0[1]); \
    GAPA(C0=__builtin_amdgcn_mfma_f32_32x32x16_bf16(kf[0],qr[0],zc,0,0,0), P0[2],P0[3],P0[4],P0[5],     pw0[0]=PKW(P0,0), pw0[1]=PKW(P0,2), pw0); \
    VRD(4); SBAR(); GAPA(C1=__builtin_amdgcn_mfma_f32_32x32x16_bf16(kf[1],qr[0],zc,0,0,0), P0[6],P0[7],P0[8],P0[9],     pw0[2]=PKW(P0,4), pw0[3]=PKW(P0,6), pw0); \
    VRD(1); SBAR(); GAPA(C0=__builtin_amdgcn_mfma_f32_32x32x16_bf16(kf[2],qr[1],C0,0,0,0),   P0[10],P0[11],P0[12],P0[13], pw1[0]=PKW(P0,8), pw1[1]=PKW(P0,10), pw1); \
    VRD(5); SBAR(); GAPA(C1=__builtin_amdgcn_mfma_f32_32x32x16_bf16(kf[3],qr[1],C1,0,0,0),   P0[14],P0[15],P1[0],P1[1],   pw1[2]=PKW(P0,12),pw1[3]=PKW(P0,14), pw1); \
    VRD(2); SBAR(); GAPA(C0=__builtin_amdgcn_mfma_f32_32x32x16_bf16(kf[4],qr[2],C0,0,0,0),   P1[2],P1[3],P1[4],P1[5],     pw2[0]=PKW(P1,0), pw2[1]=PKW(P1,2), pw2); \
    VRD(6); SBAR(); GAPA(C1=__builtin_amdgcn_mfma_f32_32x32x16_bf16(kf[5],qr[2],C1,0,0,0),   P1[6],P1[7],P1[8],P1[9],     pw2[2]=PKW(P1,4), pw2[3]=PKW(P1,6), pw2); \
    VRD(3); SBAR(); GAPA(C0=__builtin_amdgcn_mfma_f32_32x32x16_bf16(kf[6],qr[3],C0,0,0,0),   P1[10],P1[11],P1[12],P1[13], pw3[0]=PKW(P1,8), pw3[1]=PKW(P1,10), pw3); \
    VRD(7); SBAR(); GAPA(C1=__builtin_amdgcn_mfma_f32_32x32x16_bf16(kf[7],qr[3],C1,0,0,0),   P1[14],P1[15],0.f,0.f,       pw3[2]=PKW(P1,12),pw3[3]=PKW(P1,14), pw3); \
    l_reg+=sacc; \
    if(GK){DMA_K((t)+3,sl_cur);} if(GV){DMA_V((t)+1,sl_next);} \
    CMASK(C0,C1,t); \
    { float a=MX3(C0[0],C0[1],C1[0]),b=MX3(C0[2],C0[3],C1[1]); a=MX3(a,C1[2],C1[3]); \
      _Pragma("unroll") for(int r=4;r<16;r+=4){a=MX3(a,C0[r],C0[r+1]);b=MX3(b,C0[r+2],C0[r+3]);a=MX3(a,C1[r],C1[r+1]);b=MX3(b,C1[r+2],C1[r+3]);} \
      float rm=__builtin_fmaxf(a,b); { auto rr=__builtin_amdgcn_permlane32_swap(__float_as_uint(rm),__float_as_uint(rm),false,false); rm=__builtin_fmaxf(__uint_as_float(rr[0]),__uint_as_float(rr[1])); } \
      rm-=mhat; resc=false; \
      if(__builtin_expect(__any(rm>(float)THRL),0)){ const float dl=__builtin_fmaxf(rm,0.f); mhat+=dl; \
        const float f=__builtin_amdgcn_exp2f(-dl); l_reg*=f; if(hi==0)wsf[r32]=f; resc=true; } } \
    SBAR(); \
    GAPB2(o[0]=__builtin_amdgcn_mfma_f32_32x32x16_bf16(PAF(0),VFR(0),o[0],0,0,0), C0,0);  VRX(0); \
    GAPB2(o[1]=__builtin_amdgcn_mfma_f32_32x32x16_bf16(PAF(0),VFR(4),o[1],0,0,0), C0,2);  VRX(4); \
    KRD(GL,0); GAPB2(o[0]=__builtin_amdgcn_mfma_f32_32x32x16_bf16(PAF(1),VFR(1),o[0],0,0,0), C0,4);  VRX(1); \
    KRD(GL,1); GAPB2(o[1]=__builtin_amdgcn_mfma_f32_32x32x16_bf16(PAF(1),VFR(5),o[1],0,0,0), C0,6);  VRX(5); \
    KRD(GL,2); GAPB2(o[0]=__builtin_amdgcn_mfma_f32_32x32x16_bf16(PAF(2),VFR(2),o[0],0,0,0), C0,8);  VRX(2); \
    KRD(GL,3); GAPB2(o[1]=__builtin_amdgcn_mfma_f32_32x32x16_bf16(PAF(2),VFR(6),o[1],0,0,0), C0,10); VRX(6); \
    GAPB2(o[0]=__builtin_amdgcn_mfma_f32_32x32x16_bf16(PAF(3),VFR(3),o[0],0,0,0), C0,12); VRX(3); \
    GAPB2(o[1]=__builtin_amdgcn_mfma_f32_32x32x16_bf16(PAF(3),VFR(7),o[1],0,0,0), C0,14); VRX(7); \
    GAPB2(o[2]=__builtin_amdgcn_mfma_f32_32x32x16_bf16(PAF(0),VFR(0),o[2],0,0,0), C1,0); \
    GAPB2(o[3]=__builtin_amdgcn_mfma_f32_32x32x16_bf16(PAF(0),VFR(4),o[3],0,0,0), C1,2); \
    GAPB2(o[2]=__builtin_amdgcn_mfma_f32_32x32x16_bf16(PAF(1),VFR(1),o[2],0,0,0), C1,4); \
    GAPB2(o[3]=__builtin_amdgcn_mfma_f32_32x32x16_bf16(PAF(1),VFR(5),o[3],0,0,0), C1,6); \
    GAPB2(o[2]=__builtin_amdgcn_mfma_f32_32x32x16_bf16(PAF(2),VFR(2),o[2],0,0,0), C1,8); \
    GAPB2(o[3]=__builtin_amdgcn_mfma_f32_32x32x16_bf16(PAF(2),VFR(6),o[3],0,0,0), C1,10); \
    GAPB2(o[2]=__builtin_amdgcn_mfma_f32_32x32x16_bf16(PAF(3),VFR(3),o[2],0,0,0), C1,12); \
    GAPB2(o[3]=__builtin_amdgcn_mfma_f32_32x32x16_bf16(PAF(3),VFR(7),o[3],0,0,0), C1,14); \
    }while(0)
  int t=1;
  #undef CMASK
  #define CMASK(P0,P1,t) do{}while(0)
  for(;t+5<NT;t+=2){
    STEP(pB0,pB1,pA0,pA1,t,true,true,true);     WAIT_BAR(3); RESC(); ROT();
    STEP(pA0,pA1,pB0,pB1,t+1,true,true,true);   WAIT_BAR(3); RESC(); ROT();
  }
  #undef CMASK
  #define CMASK(P0,P1,t) do{int jb_=(t)-(NT-4); if(jb_>=0)cmask(P0,P1,jb_,qrel,hi);}while(0)
  #define ENDW(tt) do{ if((tt)+3<NT){WAIT_BAR(3);} else if((tt)+2<NT){WAIT_BAR(2);} else {WAIT_BAR(0);} }while(0)
  for(;t+1<NT;t+=2){
    STEP(pB0,pB1,pA0,pA1,t,(t+3<NT),(t+1<NT),(t+1<NT));       ENDW(t);   RESC(); ROT();
    STEP(pA0,pA1,pB0,pB1,t+1,(t+4<NT),(t+2<NT),(t+2<NT));     ENDW(t+1); RESC(); ROT();
  }
  STEP(pB0,pB1,pA0,pA1,NT-1,false,false,false); RESC();
  { float sacc=pB0[0]+pB0[1]; _Pragma("unroll") for(int r=2;r<16;++r)sacc+=pB0[r]; _Pragma("unroll") for(int r=0;r<16;++r)sacc+=pB1[r]; l_reg+=sacc;
    pw0=(u32x4){PKW(pB0,0),PKW(pB0,2),PKW(pB0,4),PKW(pB0,6)};pw1=(u32x4){PKW(pB0,8),PKW(pB0,10),PKW(pB0,12),PKW(pB0,14)};pw2=(u32x4){PKW(pB1,0),PKW(pB1,2),PKW(pB1,4),PKW(pB1,6)};pw3=(u32x4){PKW(pB1,8),PKW(pB1,10),PKW(pB1,12),PKW(pB1,14)};
    SBAR(); pv128(o,vb0+2*sl_cur,PAF(0),PAF(1),PAF(2),PAF(3)); }
  #undef PKW
  #undef PAF
  #undef VFR
  #undef PIN
  #undef MX3
  #undef GAPA
  #undef GAPB
  #undef EX
  #undef VRD
  #undef VRX
  #undef GAPB2
  #undef KRD
  #undef STEP
  #undef ENDW
  {auto rr=__builtin_amdgcn_permlane32_swap(__float_as_uint(l_reg),__float_as_uint(l_reg),false,false);l_reg=__uint_as_float(rr[0])+__uint_as_float(rr[1]);}
  if(hi==0)wsf[32+r32]=l_reg;asm volatile("s_waitcnt lgkmcnt(0)":::"memory");
  float rli[16];
  #pragma unroll
  for(int r=0;r<16;++r)rli[r]=__builtin_amdgcn_rcpf(wsf[32+crow(r,hi)]);
  bf16*Ow=O+(rowbase+q0+wid*QBLK)*DM+hv*D;
  { bf16*stg=(bf16*)(shm+LDS_OST2)+wid*2048;
    #pragma unroll
    for(int hp=0;hp<2;++hp){
      #pragma unroll
      for(int r=0;r<16;++r){const int orow=crow(r,hi);
        #pragma unroll
        for(int d0=0;d0<2;++d0)stg[orow*64+d0*32+r32]=__float2bfloat16(o[2*hp+d0][r]*rli[r]);}
      asm volatile("s_waitcnt lgkmcnt(0)":::"memory");
      #pragma unroll
      for(int i=0;i<4;++i){const int row=i*8+(lane>>3),ch=lane&7; const u32x4 v=*(const u32x4*)(stg+row*64+ch*8); ATTN_STORE16(Ow+(long)row*DM+hp*64+ch*8,v);}
      asm volatile("s_waitcnt lgkmcnt(0)":::"memory"); } }
  asm volatile("s_waitcnt lgkmcnt(0)\n\ts_barrier":::"memory");
  #undef DMA_K
  #undef DMA_V
  #undef CMASK
  #undef START
  #undef RESC
  #undef ROT
}
constexpr int ATTN_LDS_BYTES=LDS_BYTES;
#undef SBAR
#undef WAIT_BAR
}
#define GAS __attribute__((address_space(1)))
#define LAS __attribute__((address_space(3)))
typedef unsigned short bf16;
typedef unsigned v4u __attribute__((ext_vector_type(4)));
typedef float f32x4 __attribute__((ext_vector_type(4)));
typedef short bf16x8 __attribute__((ext_vector_type(8)));
typedef GAS unsigned gu32;
typedef GAS unsigned long long gu64;
#define RLX_AGENT __ATOMIC_RELAXED, __HIP_MEMORY_SCOPE_AGENT
#define LDS_WAIT() asm volatile("s_waitcnt lgkmcnt(0)" ::: "memory")
#define VM_WAIT() asm volatile("s_waitcnt vmcnt(0)" ::: "memory")
__device__ __forceinline__ unsigned long long rt() { return __builtin_amdgcn_s_memrealtime(); }
__device__ __forceinline__ unsigned f2bf(float f) { unsigned u = __builtin_bit_cast(unsigned, f); return (u + 0x7fffu + ((u >> 16) & 1u)) >> 16; }
__device__ __forceinline__ unsigned pk2(float lo, float hi) { return f2bf(lo) | (f2bf(hi) << 16); }

#define XB_TMO      128
#define XB_XCNT(j)  (256  + 64 * (j))
#define XB_XSUB(j)  (1280 + 64 * (j))
#define XB_XGEN(j)  (2304 + 64 * (j))
#define XB_TOP      3328
#define XB_TOPGEN   3392
#define XCD_BAR_WORDS 3456
#define XB_SPIN_CAP (1u << 18)

__device__ __forceinline__ unsigned xb_ld(unsigned* p)              { return __hip_atomic_load(p, __ATOMIC_RELAXED, __HIP_MEMORY_SCOPE_AGENT); }
__device__ __forceinline__ unsigned xb_add(unsigned* p, unsigned v) { return __hip_atomic_fetch_add(p, v, __ATOMIC_RELAXED, __HIP_MEMORY_SCOPE_AGENT); }
__device__ __forceinline__ unsigned xb_xcc_id() { return (unsigned)__builtin_amdgcn_s_getreg((3 << 11) | 20) & 0xFu; }
#define XB_SPIN(cond, bar) do { unsigned _sp = 0; while (cond) { __builtin_amdgcn_s_sleep(1); \
    if ((++_sp & 255u) == 0u) { if (xb_ld(&(bar)[XB_TMO])) break; if (_sp > XB_SPIN_CAP) { atomicAdd(&(bar)[XB_TMO], 1u); break; } } } } while (0)

struct XcdBarrier {
    unsigned* bar; unsigned x;
    volatile LAS unsigned* st;
};

__device__ __forceinline__ XcdBarrier xcd_barrier_post(unsigned* bar, volatile LAS unsigned* st) {
    XcdBarrier b; b.bar = bar; b.x = xb_xcc_id(); b.st = st;
    if (threadIdx.x == 0) (void)xb_add(&bar[XB_XCNT(b.x)], 1u);
    return b;
}
__device__ __forceinline__ void xcd_barrier_complete(unsigned* bar, unsigned x, unsigned& nloc, unsigned& nx) {
    const unsigned G = gridDim.x * gridDim.y * gridDim.z;
    unsigned sum, cnt, mine, sp = 0u;
    for (;;) {
        sum = 0u; cnt = 0u;
#pragma unroll
        for (unsigned j = 0; j < 16; ++j) { const unsigned c = xb_ld(&bar[XB_XCNT(j)]); sum += c; cnt += (c > 0u) ? 1u : 0u; }
        if (sum == G) break;
        __builtin_amdgcn_s_sleep(1);
        if ((++sp & 255u) == 0u) { if (xb_ld(&bar[XB_TMO])) break; if (sp > XB_SPIN_CAP) { atomicAdd(&bar[XB_TMO], 1u); break; } }
    }
    mine = xb_ld(&bar[XB_XCNT(x)]);
    nloc = mine > 0u ? mine : 1u; nx = cnt > 0u ? cnt : 1u;
}

__device__ __forceinline__ void xcd_barrier(const XcdBarrier& b) {
    asm volatile("s_waitcnt vmcnt(0)" ::: "memory");
    __syncthreads();
    if (threadIdx.x == 0) {
        unsigned* bar = b.bar;
        __builtin_amdgcn_s_waitcnt(0);
        unsigned nloc = b.st[0], nx = b.st[1];
        if (nloc == 0u) { xcd_barrier_complete(bar, b.x, nloc, nx); b.st[0] = nloc; b.st[1] = nx; }
        const unsigned old = xb_add(&bar[XB_XSUB(b.x)], 1u);
        const unsigned gen = old / nloc;
        if (old + 1u == (gen + 1u) * nloc) {
            __builtin_amdgcn_fence(__ATOMIC_RELEASE, "agent");
            asm volatile("s_waitcnt vmcnt(0)" ::: "memory");
            const unsigned og = xb_add(&bar[XB_TOP], 1u);
            const unsigned tg = og / nx;
            if (og + 1u == (tg + 1u) * nx) xb_add(&bar[XB_TOPGEN], 1u);
            else XB_SPIN(xb_ld(&bar[XB_TOPGEN]) == tg, bar);
            __builtin_amdgcn_fence(__ATOMIC_ACQUIRE, "agent");
            xb_add(&bar[XB_XGEN(b.x)], 1u);
            asm volatile("s_waitcnt vmcnt(0)" ::: "memory");
        } else {
            XB_SPIN(xb_ld(&bar[XB_XGEN(b.x)]) == gen, bar);
            __builtin_amdgcn_fence(__ATOMIC_ACQUIRE, "agent");
            asm volatile("s_waitcnt vmcnt(0)" ::: "memory");
        }
    }
    __syncthreads();
}
constexpr int NWAVES = 8;
constexpr int DM = 1024, MP = 32768, MS = 512, MROWS = MP + MS, NSEQ = 20, DEPTH = 4, DFF = 2816, DIN = 9216, PAST = 2048;
constexpr int NCHUNK_P = 512, NCHUNK = 528;
constexpr float EPS = 1e-6f;
constexpr size_t OY_P = 0, OY_S = 33554432, OK_P = 34078720, OV_P = 168296448, OS_P = 302514176, OK_S = 304611328, OV_S = 306708480, OS_S = 308805632, OUT_TOTAL = 317194240;

constexpr size_t MiB = 1u << 20;
constexpr size_t WS_CTL = 0, CTL_ZERO_BYTES = 1 * MiB;
constexpr size_t WS_MOD = 1 * MiB;
constexpr size_t WS_LB = 4 * MiB;
constexpr size_t WS_W = 8 * MiB, W_LAYER = 57 * MiB;
constexpr size_t WO_GU1 = 0, WO_D1 = 11 * MiB, WO_IN = 16 * MiB + MiB / 2, WO_BA = 34 * MiB + MiB / 2, WO_BH = 36 * MiB + MiB / 2, WO_OUT = 38 * MiB + MiB / 2, WO_GU2 = 40 * MiB + MiB / 2, WO_D2 = 51 * MiB + MiB / 2;
constexpr size_t WS_X = 240 * MiB;
constexpr size_t WS_XN = 370 * MiB;
constexpr size_t WS_Q = 435 * MiB, WS_K = 500 * MiB, WS_V = 565 * MiB;
constexpr size_t WS_QQ = 630 * MiB, WS_KK = 695 * MiB, WS_VV = 760 * MiB, WS_HGS = 825 * MiB, WS_SZA = 890 * MiB, WS_SZH = 955 * MiB;
constexpr size_t WS_LOGF = 1020 * MiB;
constexpr size_t WS_O1 = 1150 * MiB, WS_O2 = 1215 * MiB, WS_OATT = 1280 * MiB, WS_OH = 1345 * MiB, WS_MRG = 1410 * MiB;
constexpr size_t WS_BIG = 1475 * MiB;
constexpr size_t WS_SST = 1739 * MiB;
constexpr size_t WS_DD = 1871 * MiB;
constexpr size_t WS_END = 1874 * MiB;
#ifndef TEAM_STRIDE
#define TEAM_STRIDE 8
#endif
#ifndef STARTERS
#define STARTERS 4
#endif
constexpr int T_TEAM = 256 / TEAM_STRIDE;
#ifndef G3_STAGGER_TICKS
#define G3_STAGGER_TICKS 800
#endif
constexpr int HG_G = 4;
constexpr size_t WS_QS = WS_BIG, WS_SL = WS_BIG + 64 * MiB, WS_DSEG = WS_BIG + 72 * MiB, WS_RAW = WS_SST;
constexpr int CW_BAR = 4096, CW_Q = 8192, CW_HS = 16384;
static_assert(pg8::EpiWin::O_Q == WS_Q && pg8::EpiWin::O_K == WS_K && pg8::EpiWin::O_V == WS_V && pg8::EpiWin::O_QQ == WS_QQ && pg8::EpiWin::O_KK == WS_KK && pg8::EpiWin::O_VV == WS_VV && pg8::EpiWin::O_HGS == WS_HGS && pg8::EpiWin::O_SZA == WS_SZA && pg8::EpiWin::O_SZH == WS_SZH && pg8::EpiWin::O_LOGF == WS_LOGF && pg8::EpiWin::O_LB == WS_LB && pg8::EpiWin::OK_P_ == OK_P && pg8::EpiWin::OV_P_ == OV_P && pg8::EpiWin::OK_S_ == OK_S && pg8::EpiWin::OV_S_ == OV_S, "EpiWin offsets");

constexpr int RING_OFF = 0, RING_BYTES = 139264;
constexpr int LDSCTL_OFF = RING_BYTES, MISC_OFF = LDSCTL_OFF + 320;
constexpr int LDS_BYTES = 147456;

struct Frame {
    LAS unsigned char* lds;
    volatile LAS unsigned* MISC;
    gu32* ctl;
    int tid, lane, wave;
    int vcu, G;
};
typedef float f32x16 __attribute__((ext_vector_type(16)));
typedef unsigned v2u __attribute__((ext_vector_type(2)));

__device__ __forceinline__ float wave_sum(float v) {
#pragma unroll
    for (int o = 1; o < 64; o <<= 1) v += __shfl_xor(v, o);
    return v;
}
__device__ __forceinline__ float bf2f(bf16 b) { return __builtin_bit_cast(float, (unsigned)b << 16); }
__device__ __forceinline__ unsigned cvtpk(float lo, float hi) { return pg8::cvt_pk_bf16(lo, hi); }
__device__ __forceinline__ bf16x8 pack8(f32x4 a, f32x4 b) { v4u w; w.x = cvtpk(a[0], a[1]); w.y = cvtpk(a[2], a[3]); w.z = cvtpk(b[0], b[1]); w.w = cvtpk(b[2], b[3]); return __builtin_bit_cast(bf16x8, w); }
__device__ __forceinline__ float lam_init_of(int l) { asm volatile("" : "+s"(l)); return 0.8f - 0.6f * __expf(-0.3f * (float)l); }

__device__ __forceinline__ void p0_transpose_item(const float* W, int K, int N, bf16* WT, bool gu, LAS float* scr, int item, int lane) {
    const int nblk = N / 32, kb = item / nblk, nb = item % nblk, k0 = 64 * kb, nd0 = 32 * nb;
    const int ns0 = gu ? (((nd0 >> 7) & 1) * 2816 + (nd0 >> 8) * 128 + (nd0 & 127)) : nd0;
#pragma unroll 8
    for (int i = 0; i < 32; ++i) { const int kk = 2 * i + (lane >> 5); scr[kk * 33 + (lane & 31)] = W[(size_t)(k0 + kk) * N + ns0 + (lane & 31)]; }
    LDS_WAIT(); asm volatile("" ::: "memory");
    const int c = lane & 7;
#pragma unroll
    for (int j = 0; j < 4; ++j) { const int n = (lane >> 3) + 8 * j; const LAS float* s = scr + (8 * c) * 33 + n;
        v4u o; o.x = pk2(s[0 * 33], s[1 * 33]); o.y = pk2(s[2 * 33], s[3 * 33]); o.z = pk2(s[4 * 33], s[5 * 33]); o.w = pk2(s[6 * 33], s[7 * 33]);
        *(GAS v4u*)(WT + (size_t)(nd0 + n) * K + k0 + 8 * c) = o; }
    LDS_WAIT(); asm volatile("" ::: "memory");
}
typedef const __attribute__((address_space(4))) char* kaptr_t;
__device__ __forceinline__ const float* karg(int i) { kaptr_t ka = (kaptr_t)__builtin_amdgcn_kernarg_segment_ptr(); asm volatile("" : "+s"(ka)); return *(const float* const __attribute__((address_space(4)))*)(ka + 8 * i); }
enum { A_XP = 0, A_XS, A_CK, A_CV, A_ST, A_CP, A_CS, A_WADA, A_BADA, A_GFFN1, A_WGU1, A_WD1, A_GMIX, A_WIN, A_LAM, A_GSUB, A_LBL, A_GHG, A_WBA, A_WBH, A_WOUT, A_GFFN2, A_WGU2, A_WD2, A_GFIN, A_OUT, A_WS };
__device__ __forceinline__ void p0_prologue(Frame& F, unsigned char* ws) {
    { LAS float* scr = (LAS float*)(F.lds + RING_OFF + F.wave * 16384);
      const int gw = F.vcu * NWAVES + F.wave, NGW = F.G * NWAVES;
      constexpr int I_GU = 16 * 176, I_D = 44 * 32, I_IN = 16 * 288, I_SQ = 16 * 32, I_LAYER = 2 * I_GU + 2 * I_D + I_IN + 3 * I_SQ;
      for (int it = gw; it < DEPTH * I_LAYER; it += NGW) {
          const int l = it / I_LAYER; int r = it % I_LAYER; unsigned char* wl = ws + WS_W + (size_t)l * W_LAYER;
          if (r < I_GU) { p0_transpose_item(karg(A_WGU1) + (size_t)l * 1024 * 5632, 1024, 5632, (bf16*)(wl + WO_GU1), true, scr, r, F.lane); continue; } r -= I_GU;
          if (r < I_D)  { p0_transpose_item(karg(A_WD1) + (size_t)l * 2816 * 1024, 2816, 1024, (bf16*)(wl + WO_D1), false, scr, r, F.lane); continue; } r -= I_D;
          if (r < I_IN) { p0_transpose_item(karg(A_WIN) + (size_t)l * 1024 * 9216, 1024, 9216, (bf16*)(wl + WO_IN), false, scr, r, F.lane); continue; } r -= I_IN;
          if (r < I_SQ) { p0_transpose_item(karg(A_WBA) + (size_t)l * 1024 * 1024, 1024, 1024, (bf16*)(wl + WO_BA), false, scr, r, F.lane); continue; } r -= I_SQ;
          if (r < I_SQ) { p0_transpose_item(karg(A_WBH) + (size_t)l * 1024 * 1024, 1024, 1024, (bf16*)(wl + WO_BH), false, scr, r, F.lane); continue; } r -= I_SQ;
          if (r < I_SQ) { p0_transpose_item(karg(A_WOUT) + (size_t)l * 1024 * 1024, 1024, 1024, (bf16*)(wl + WO_OUT), false, scr, r, F.lane); continue; } r -= I_SQ;
          if (r < I_GU) { p0_transpose_item(karg(A_WGU2) + (size_t)l * 1024 * 5632, 1024, 5632, (bf16*)(wl + WO_GU2), true, scr, r, F.lane); continue; } r -= I_GU;
          p0_transpose_item(karg(A_WD2) + (size_t)l * 2816 * 1024, 2816, 1024, (bf16*)(wl + WO_D2), false, scr, r, F.lane);
      } }
    __syncthreads();
    { const float* c_p = karg(A_CP); const float* c_s = karg(A_CS); const float* w_ada = karg(A_WADA); const float* b_ada = karg(A_BADA);
      LAS float* ca = (LAS float*)(F.lds);
      LAS float* red = (LAS float*)(F.lds + 81920);
      for (int i = F.tid; i < NSEQ * 1024; i += NWAVES * 64) { const int s = i >> 10, k = i & 1023; const float c = s < 4 ? c_p[s * 1024 + k] : c_s[(s - 4) * 1024 + k]; ca[i] = pg8::silu_f(c); }
      __syncthreads();
      float* MOD = (float*)(ws + WS_MOD);
      for (int it = F.vcu; it < DEPTH * 144; it += F.G) {
          const int l = it / 144, n = (it % 144) * 64 + F.lane; const float* wp = w_ada + ((size_t)l * 1024 + F.wave * 128) * 9216 + n;
          float acc[NSEQ];
#pragma unroll
          for (int s = 0; s < NSEQ; ++s) acc[s] = 0.f;
#pragma unroll 4
          for (int k = 0; k < 128; ++k) { const float w = wp[(size_t)k * 9216];
#pragma unroll
              for (int s = 0; s < NSEQ; ++s) acc[s] += ca[s * 1024 + F.wave * 128 + k] * w; }
#pragma unroll
          for (int s = 0; s < NSEQ; ++s) red[(F.wave * NSEQ + s) * 64 + F.lane] = acc[s];
          __syncthreads();
          for (int i = F.tid; i < NSEQ * 64; i += NWAVES * 64) { const int s = i >> 6, c = i & 63; float v = 0.f;
#pragma unroll
              for (int w = 0; w < 8; ++w) v += red[(w * NSEQ + s) * 64 + c];
              const int nn = (it % 144) * 64 + c; MOD[((size_t)l * NSEQ + s) * 9216 + nn] = v + b_ada[(size_t)l * 9216 + nn]; }
          __syncthreads();
      } }
    if (F.vcu == 0) { float* LB = (float*)(ws + WS_LB); const float* lb_logits = karg(A_LBL);
        for (int c = F.tid; c < 1024; c += NWAVES * 64) { float lg[4], mx = -INFINITY;
#pragma unroll
            for (int l = 0; l < 4; ++l) { lg[l] = lb_logits[l * 1024 + c]; mx = __builtin_fmaxf(mx, lg[l]); }
            float sum = 0.f;
#pragma unroll
            for (int l = 0; l < 4; ++l) { lg[l] = __expf(lg[l] - mx); sum += lg[l]; }
            const float inv = 1.f / sum; float cs = 0.f;
#pragma unroll
            for (int l = 0; l < 4; ++l) { cs += lg[l] * inv; LB[l * 1024 + c] = cs - lg[0] * inv; } } }
}

__device__ __forceinline__ void norm_phase(Frame& F, const float* x_p, const float* x_s, bool first, float* X, const float* g, const float* mod_l, int sub, bf16* XN, int row0, int row1, int gw, int NGW) {
    for (int row = row0 + gw; row < row1; row += NGW) {
        const float* src = first ? (row < MP ? x_p + (size_t)row * DM : x_s + (size_t)(row - MP) * DM) : X + (size_t)row * DM;
        const float* mp = mod_l + (size_t)pg8::row_seq(row) * 9216 + sub * 3 * 1024;
        const f32x4* xr = (const f32x4*)src + F.lane; f32x4 v[4]; float s2 = 0.f;
#pragma unroll
        for (int j = 0; j < 4; ++j) { v[j] = xr[64 * j]; s2 += (v[j].x * v[j].x + v[j].y * v[j].y) + (v[j].z * v[j].z + v[j].w * v[j].w); }
        const float rstd = __builtin_amdgcn_rsqf(wave_sum(s2) * (1.f / DM) + EPS);
        if (first) { f32x4* xo = (f32x4*)(X + (size_t)row * DM) + F.lane;
#pragma unroll
            for (int j = 0; j < 4; ++j) xo[64 * j] = v[j]; }
        v2u* o8 = (v2u*)(XN + (size_t)row * DM) + F.lane;
#pragma unroll
        for (int j = 0; j < 4; ++j) { const int c = 4 * F.lane + 256 * j; const f32x4 gg = *(const f32x4*)(g + c), sh = *(const f32x4*)(mp + c), sc = *(const f32x4*)(mp + 1024 + c);
            const f32x4 h = (v[j] * rstd) * gg * (sc + 1.f) + sh; v2u o; o.x = cvtpk(h.x, h.y); o.y = cvtpk(h.z, h.w); o8[64 * j] = o; }
    }
}
__device__ __forceinline__ void final_norm_phase(Frame& F, const float* X, const float* g, float* out) {
    const int gw = F.vcu * NWAVES + F.wave, NGW = F.G * NWAVES;
    for (int row = gw; row < MROWS; row += NGW) {
        const f32x4* xr = (const f32x4*)(X + (size_t)row * DM) + F.lane; f32x4 v[4]; float s2 = 0.f;
#pragma unroll
        for (int j = 0; j < 4; ++j) { v[j] = xr[64 * j]; s2 += (v[j].x * v[j].x + v[j].y * v[j].y) + (v[j].z * v[j].z + v[j].w * v[j].w); }
        const float rstd = __builtin_amdgcn_rsqf(wave_sum(s2) * (1.f / DM) + EPS);
        f32x4* o = (f32x4*)(out + (row < MP ? OY_P + (size_t)row * DM : OY_S + (size_t)(row - MP) * DM)) + F.lane;
#pragma unroll
        for (int j = 0; j < 4; ++j) { const f32x4 gg = *(const f32x4*)(g + 4 * F.lane + 256 * j); o[64 * j] = (v[j] * rstd) * gg; }
    }
}
__device__ __forceinline__ float lam_of(const float* att_lambda, int l, int lane) {
    const float* lp = att_lambda + (size_t)l * 256;
    const float a = wave_sum(lp[lane] * lp[64 + lane]), b = wave_sum(lp[128 + lane] * lp[192 + lane]);
    return __expf(a) - __expf(b) + lam_init_of(l);
}
__device__ __forceinline__ void attn_combine_phase(Frame& F, const bf16* O1, const bf16* O2, const float* gsub, float lam, float osc, bf16* OATT) {
    const int gw = F.vcu * NWAVES + F.wave, NGW = F.G * NWAVES; const int cl = (F.lane & 7) * 16;
    float gv[16];
#pragma unroll
    for (int i = 0; i < 16; ++i) gv[i] = gsub[cl + i] * osc;
    for (int row = gw; row < MP; row += NGW) {
        const size_t off = (size_t)row * DM + F.lane * 16; const v4u a0 = *(const v4u*)(O1 + off), a1 = *(const v4u*)(O1 + off + 8), b0 = *(const v4u*)(O2 + off), b1 = *(const v4u*)(O2 + off + 8);
        const unsigned aw[8] = {a0.x, a0.y, a0.z, a0.w, a1.x, a1.y, a1.z, a1.w}, bw[8] = {b0.x, b0.y, b0.z, b0.w, b1.x, b1.y, b1.z, b1.w};
        float o[16]; float ss = 0.f;
#pragma unroll
        for (int i = 0; i < 8; ++i) { o[2 * i] = pg8::bf_lo(aw[i]) - lam * pg8::bf_lo(bw[i]); o[2 * i + 1] = pg8::bf_hi(aw[i]) - lam * pg8::bf_hi(bw[i]); ss += o[2 * i] * o[2 * i] + o[2 * i + 1] * o[2 * i + 1]; }
        ss += __shfl_xor(ss, 1); ss += __shfl_xor(ss, 2); ss += __shfl_xor(ss, 4);
        const float rstd = __builtin_amdgcn_rsqf(ss * (1.f / 128.f) + EPS);
        v4u w0, w1;
        w0.x = cvtpk(o[0] * rstd * gv[0], o[1] * rstd * gv[1]); w0.y = cvtpk(o[2] * rstd * gv[2], o[3] * rstd * gv[3]); w0.z = cvtpk(o[4] * rstd * gv[4], o[5] * rstd * gv[5]); w0.w = cvtpk(o[6] * rstd * gv[6], o[7] * rstd * gv[7]);
        w1.x = cvtpk(o[8] * rstd * gv[8], o[9] * rstd * gv[9]); w1.y = cvtpk(o[10] * rstd * gv[10], o[11] * rstd * gv[11]); w1.z = cvtpk(o[12] * rstd * gv[12], o[13] * rstd * gv[13]); w1.w = cvtpk(o[14] * rstd * gv[14], o[15] * rstd * gv[15]);
        *(v4u*)(OATT + off) = w0; *(v4u*)(OATT + off + 8) = w1;
    }
}

__device__ __forceinline__ void attn_sample_unit(Frame& F, const float* cache_k, const float* cache_v, int l, int s, int head, const bf16* Qb, const bf16* Kb, const bf16* Vb, float lam, float osc, const float* gsub, bf16* OATT) {
    const int lane = F.lane, w = F.wave, q = lane & 31, hh = lane >> 5, vt = w & 3, kh = w >> 2;
    LAS float* SLOT = (LAS float*)(F.lds);
    LAS float* ML = (LAS float*)(F.lds + 16384);
    LAS float* SSQ = (LAS float*)(F.lds + 16384 + 512);
    const size_t qrow = (size_t)MP + (size_t)s * 32;
    const float* ck = cache_k + ((size_t)(l * 16 + s) * PAST) * 1024 + head * 128;
    const float* cv = cache_v + ((size_t)(l * 16 + s) * PAST) * 1024 + head * 128;
    f32x16 o1;
#pragma unroll
    for (int r = 0; r < 16; ++r) o1[r] = 0.f;
    for (int m = 0; m < 2; ++m) {
        bf16x8 qf[4];
#pragma unroll
        for (int ks = 0; ks < 4; ++ks) qf[ks] = *(const bf16x8*)(Qb + (qrow + q) * 1024 + head * 128 + m * 64 + ks * 16 + 8 * hh);
        float mrun = -INFINITY, lrun = 0.f; f32x16 ot;
#pragma unroll
        for (int r = 0; r < 16; ++r) ot[r] = 0.f;
        const int ntile = 32 + kh;
        for (int t = 0; t < ntile; ++t) {
            const bool nw = (t == 32); const int key0 = kh * 1024 + t * 32;
            bf16x8 kf[4];
            if (!nw) { const float* kp = ck + (size_t)(key0 + q) * 1024 + m * 64 + 8 * hh;
#pragma unroll
                for (int ks = 0; ks < 4; ++ks) { const f32x4 a = *(const f32x4*)(kp + ks * 16), b = *(const f32x4*)(kp + ks * 16 + 4); kf[ks] = pack8(a, b); } }
            else {
#pragma unroll
                for (int ks = 0; ks < 4; ++ks) kf[ks] = *(const bf16x8*)(Kb + (qrow + q) * 1024 + head * 128 + m * 64 + ks * 16 + 8 * hh); }
            float vf[2][8];
            { const float* vp = cv + (size_t)(key0 + 4 * hh) * 1024 + 32 * vt + q; const bf16* vpn = Vb + (qrow + 4 * hh) * 1024 + head * 128 + 32 * vt + q;
#pragma unroll
              for (int s2 = 0; s2 < 2; ++s2)
#pragma unroll
                  for (int j = 0; j < 8; ++j) { const int kr = 16 * s2 + 8 * (j >> 2) + (j & 3);
                      vf[s2][j] = nw ? bf2f(vpn[kr * 1024]) : vp[kr * 1024]; } }
            f32x16 st;
#pragma unroll
            for (int r = 0; r < 16; ++r) st[r] = 0.f;
#pragma unroll
            for (int ks = 0; ks < 4; ++ks) st = __builtin_amdgcn_mfma_f32_32x32x16_bf16(kf[ks], qf[ks], st, 0, 0, 0);
            float tm = st[0];
#pragma unroll
            for (int r = 1; r < 16; ++r) tm = __builtin_fmaxf(tm, st[r]);
            tm = __builtin_fmaxf(tm, __shfl_xor(tm, 32));
            const float mnew = __builtin_fmaxf(mrun, tm), alpha = __builtin_amdgcn_exp2f(mrun - mnew);
            float ls = 0.f;
#pragma unroll
            for (int r = 0; r < 16; ++r) { st[r] = __builtin_amdgcn_exp2f(st[r] - mnew); ls += st[r]; }
            ls += __shfl_xor(ls, 32);
            lrun = lrun * alpha + ls; mrun = mnew;
#pragma unroll
            for (int r = 0; r < 16; ++r) ot[r] *= alpha;
#pragma unroll
            for (int s2 = 0; s2 < 2; ++s2) { v4u pw; pw.x = cvtpk(st[8 * s2], st[8 * s2 + 1]); pw.y = cvtpk(st[8 * s2 + 2], st[8 * s2 + 3]); pw.z = cvtpk(st[8 * s2 + 4], st[8 * s2 + 5]); pw.w = cvtpk(st[8 * s2 + 6], st[8 * s2 + 7]);
                v4u aw; aw.x = cvtpk(vf[s2][0], vf[s2][1]); aw.y = cvtpk(vf[s2][2], vf[s2][3]); aw.z = cvtpk(vf[s2][4], vf[s2][5]); aw.w = cvtpk(vf[s2][6], vf[s2][7]);
                ot = __builtin_amdgcn_mfma_f32_32x32x16_bf16(__builtin_bit_cast(bf16x8, aw), __builtin_bit_cast(bf16x8, pw), ot, 0, 0, 0); }
        }
        if (vt == 0 && hh == 0) { ML[(kh * 32 + q) * 2] = mrun; ML[(kh * 32 + q) * 2 + 1] = lrun; }
        __syncthreads();
        const float m0 = ML[q * 2], l0 = ML[q * 2 + 1], m1 = ML[(32 + q) * 2], l1 = ML[(32 + q) * 2 + 1];
        const float Mx = __builtin_fmaxf(m0, m1), L = l0 * __builtin_amdgcn_exp2f(m0 - Mx) + l1 * __builtin_amdgcn_exp2f(m1 - Mx);
        { const float sc = __builtin_amdgcn_exp2f(mrun - Mx);
#pragma unroll
          for (int r = 0; r < 16; ++r) ot[r] *= sc; }
        if (kh == 1) {
#pragma unroll
            for (int r = 0; r < 16; ++r) SLOT[(vt * 16 + r) * 64 + lane] = ot[r]; }
        __syncthreads();
        if (kh == 0) { const float rl = 1.f / L;
#pragma unroll
            for (int r = 0; r < 16; ++r) ot[r] = (ot[r] + SLOT[(vt * 16 + r) * 64 + lane]) * rl;
            if (m == 0) {
#pragma unroll
                for (int r = 0; r < 16; ++r) o1[r] = ot[r];
            } else { float ss = 0.f;
#pragma unroll
                for (int r = 0; r < 16; ++r) { o1[r] = o1[r] - lam * ot[r]; ss += o1[r] * o1[r]; }
                ss += __shfl_xor(ss, 32);
                if (hh == 0) SSQ[vt * 32 + q] = ss; } }
        __syncthreads();
    }
    if (kh == 0) {
        const float ss = SSQ[q] + SSQ[32 + q] + SSQ[64 + q] + SSQ[96 + q];
        const float rstd = __builtin_amdgcn_rsqf(ss * (1.f / 128.f) + EPS) * osc;
#pragma unroll
        for (int r = 0; r < 16; ++r) { const int v = 32 * vt + (r & 3) + 8 * (r >> 2) + 4 * hh; OATT[(qrow + q) * 1024 + head * 128 + v] = (bf16)f2bf(o1[r] * rstd * gsub[v]); }
    }
    __syncthreads();
}

constexpr int HS = 72, HK = 136;
__device__ __forceinline__ f32x4 mfma16(bf16x8 a, bf16x8 b, f32x4 c) { return __builtin_amdgcn_mfma_f32_16x16x32_bf16(a, b, c, 0, 0, 0); }
__device__ __forceinline__ void st16bf(LAS bf16* p, const float (&v)[16]) {
    v4u a, b; a.x = cvtpk(v[0], v[1]); a.y = cvtpk(v[2], v[3]); a.z = cvtpk(v[4], v[5]); a.w = cvtpk(v[6], v[7]); b.x = cvtpk(v[8], v[9]); b.y = cvtpk(v[10], v[11]); b.z = cvtpk(v[12], v[13]); b.w = cvtpk(v[14], v[15]);
    *(LAS v4u*)p = a; *(LAS v4u*)(p + 8) = b;
}
__device__ __forceinline__ float bfu(unsigned b) { return __builtin_bit_cast(float, b << 16); }
struct HgPtrs { const float* LOGF; const bf16 *QQ, *KK, *VV, *HGS; const float* ghg; bf16* OH; bf16* dump; };
typedef float f32x2v __attribute__((ext_vector_type(2)));
__device__ __forceinline__ void hg_load(const HgPtrs& P, size_t ubase  , unsigned k0, int w, int nvalid, f32x2v (&lf)[8], unsigned (&qv)[8], unsigned (&kv)[8], unsigned (&vv)[8]) {
    if (w * 8 < nvalid) {
#pragma unroll
        for (int i = 0; i < 8; ++i) { const size_t o = ubase + (size_t)(w * 8 + i) * 1024;
            const float* lp = P.LOGF + o; const bf16* qp = P.QQ + o; const bf16* kp = P.KK + o; const bf16* vp = P.VV + o;
            lf[i] = *(const f32x2v*)(lp + k0); qv[i] = *(const unsigned*)(qp + k0); kv[i] = *(const unsigned*)(kp + k0); vv[i] = *(const unsigned*)(vp + k0); }
    } else {
#pragma unroll
        for (int i = 0; i < 8; ++i) { lf[i] = (f32x2v){0.f, 0.f}; qv[i] = 0u; kv[i] = 0u; vv[i] = 0u; }
    }
}
#define HG_BAR() asm volatile("s_waitcnt lgkmcnt(0)\n\ts_barrier" ::: "memory")
template <int MODE> __device__ __forceinline__ void hg_sequence(Frame& F, const HgPtrs& P, size_t row0, int h, int nchunk, int nvalid, const float* s_in, float* s_out, bf16* QS, float* RAW, float* dseg) {
    LAS float* seg = (LAS float*)(F.lds);
    LAS float* part = (LAS float*)(F.lds + 4096);
    LAS float* dvec = (LAS float*)(F.lds + 6144);
    LAS bf16* QH = (LAS bf16*)(F.lds + 8192);
    LAS bf16* QT = QH + 64 * HK;
    LAS bf16* KH = QT + 64 * HK;
    LAS bf16* VT = KH + 160 * HK;
    LAS bf16* KT = VT + 128 * HS;
    LAS bf16* AL = KT + 128 * HS;
    const int w = __builtin_amdgcn_readfirstlane(F.wave), sc = w >> 1, lr_ = F.lane & 15, lq_ = F.lane >> 4; const unsigned k0_ = 2u * (unsigned)F.lane;
    f32x4 S[8];
#pragma unroll
    for (int kb = 0; kb < 8; ++kb)
#pragma unroll
        for (int r = 0; r < 4; ++r) S[kb][r] = s_in ? s_in[(size_t)(16 * kb + 4 * lq_ + r) * 128 + 16 * w + lr_] : 0.f;
    const float gv = P.ghg[16 * w + lr_];
    f32x2v bseg = {0.f, 0.f};
    f32x2v lf[8]; unsigned qv[8], kv[8], vv[8];
    hg_load(P, row0 * 1024 + h * 128, k0_, w, nvalid, lf, qv, kv, vv);
    for (int c = 0; c < nchunk; ++c) {
        int lr = lr_, lq = lq_; unsigned k0 = k0_; asm volatile("" : "+v"(lr), "+v"(lq), "+v"(k0));
        const size_t crow = row0 + (size_t)c * 64;
        f32x2v cs[8]; { f32x2v run = {0.f, 0.f};
#pragma unroll
            for (int i = 0; i < 8; ++i) { run = run + lf[i]; cs[i] = run; }
            *(LAS f32x2v*)(seg + w * 128 + k0) = run; }
        HG_BAR();
        f32x2v P2[4], mypre = {0.f, 0.f}, tot; { f32x2v p = {0.f, 0.f};
#pragma unroll
            for (int s = 0; s < 8; ++s) { if ((s & 1) == 0) P2[s >> 1] = p; mypre = (s == w) ? p : mypre; p = p + *(const LAS f32x2v*)(seg + s * 128 + k0); } tot = p; }
        f32x2v myref = P2[0], nref = P2[1];
#pragma unroll
        for (int s = 1; s < 4; ++s) { myref = (s == sc) ? P2[s] : myref; nref = (s == sc) ? (s == 3 ? tot : P2[s < 3 ? s + 1 : 3]) : nref; }
        const f32x2v dq = mypre - myref;
        f32x2v fq, fT, fK[4]; fq.x = __expf(myref.x); fq.y = __expf(myref.y); fT.x = __expf(tot.x - nref.x); fT.y = __expf(tot.y - nref.y);
#pragma unroll
        for (int ii = 1; ii < 4; ++ii) { fK[ii].x = __expf(__builtin_fminf(P2[ii].x - nref.x, 0.f)); fK[ii].y = __expf(__builtin_fminf(P2[ii].y - nref.y, 0.f)); }
        f32x2v fqs = fq; if constexpr (MODE == 1) { fqs.x = fq.x * __expf(bseg.x); fqs.y = fq.y * __expf(bseg.y); bseg = bseg + tot; }
        float t0[8], t1[8];
#pragma unroll
        for (int i = 0; i < 8; ++i) { const int r = w * 8 + i; const float q0 = bfu(qv[i] & 0xffffu), q1 = bfu(qv[i] >> 16), a0 = bfu(kv[i] & 0xffffu), a1 = bfu(kv[i] >> 16);
            const float E0 = dq.x + cs[i].x, E1 = dq.y + cs[i].y;
            const float e1x = __expf(E0), e1y = __expf(E1);
            const float e2x = __builtin_fminf(__builtin_amdgcn_rcpf(e1x), 5.5e34f), e2y = __builtin_fminf(__builtin_amdgcn_rcpf(e1y), 5.5e34f);
            const float e3x = __expf((nref.x - myref.x) - E0), e3y = __expf((nref.y - myref.y) - E1);
            *(LAS unsigned*)(QH + r * HK + k0) = cvtpk(q0 * e1x, q1 * e1y);
            *(LAS unsigned*)(QT + r * HK + k0) = cvtpk(q0 * e1x * fq.x, q1 * e1y * fq.y);
            if constexpr (MODE == 1) { bf16* qsp = QS + (crow + r) * 1024 + h * 128; *(unsigned*)(qsp + k0) = cvtpk(q0 * e1x * fqs.x, q1 * e1y * fqs.y); }
            const float b0 = a0 * e3x, b1 = a1 * e3y;
            { const int rb = (sc == 0) ? 0 : (sc == 1) ? 16 : (sc == 2) ? 48 : 96; *(LAS unsigned*)(KH + (rb + r) * HK + k0) = cvtpk(a0 * e2x, a1 * e2y); }
#pragma unroll
            for (int ii = 1; ii < 4; ++ii) if (ii > sc) { const int rb = (ii == 1) ? 16 : (ii == 2) ? 48 : 96; *(LAS unsigned*)(KH + (rb + r) * HK + k0) = cvtpk(b0 * fK[ii].x, b1 * fK[ii].y); }
            t0[i] = b0 * fT.x; t1[i] = b1 * fT.y; }
        { v4u u0, u1; u0.x = cvtpk(t0[0], t0[1]); u0.y = cvtpk(t0[2], t0[3]); u0.z = cvtpk(t0[4], t0[5]); u0.w = cvtpk(t0[6], t0[7]); u1.x = cvtpk(t1[0], t1[1]); u1.y = cvtpk(t1[2], t1[3]); u1.z = cvtpk(t1[4], t1[5]); u1.w = cvtpk(t1[6], t1[7]);
          *(LAS v4u*)(KT + k0 * HS + 8 * w) = u0; *(LAS v4u*)(KT + (k0 + 1) * HS + 8 * w) = u1; }
        { v4u u0, u1;
          u0.x = (vv[0] & 0xffffu) | (vv[1] << 16); u0.y = (vv[2] & 0xffffu) | (vv[3] << 16); u0.z = (vv[4] & 0xffffu) | (vv[5] << 16); u0.w = (vv[6] & 0xffffu) | (vv[7] << 16);
          u1.x = (vv[0] >> 16) | (vv[1] & 0xffff0000u); u1.y = (vv[2] >> 16) | (vv[3] & 0xffff0000u); u1.z = (vv[4] >> 16) | (vv[5] & 0xffff0000u); u1.w = (vv[6] >> 16) | (vv[7] & 0xffff0000u);
          *(LAS v4u*)(VT + k0 * HS + 8 * w) = u0; *(LAS v4u*)(VT + (k0 + 1) * HS + 8 * w) = u1;
          if (w == 0) { f32x2v d; d.x = __expf(tot.x); d.y = __expf(tot.y); *(LAS f32x2v*)(dvec + k0) = d; } }
        HG_BAR();
        if (c + 1 < nchunk) hg_load(P, (crow + 64) * 1024 + h * 128, k0, w, nvalid, lf, qv, kv, vv);
        unsigned short hgv[16];
        if constexpr (MODE == 0) { const bf16* hp = P.HGS + crow * 1024 + h * 128 + 16 * w;
#pragma unroll
          for (int mt = 0; mt < 4; ++mt)
#pragma unroll
              for (int r = 0; r < 4; ++r) { int t = 16 * mt + 4 * lq + r; t = t < nvalid ? t : nvalid - 1; hgv[mt * 4 + r] = hp[(unsigned)(t * 1024 + lr)]; } }
#pragma unroll
        for (int rr = 0; rr < 2; ++rr) { const int blk = w + 8 * rr, bi = blk >> 2, bj = blk & 3;
            f32x4 acc = {0.f, 0.f, 0.f, 0.f};
            if (bj <= bi) { const int rb = (bi == 0) ? 0 : (bi == 1) ? 16 : (bi == 2) ? 48 : 96;
#pragma unroll
                for (int ks = 0; ks < 4; ++ks) { const bf16x8 a = *(const LAS bf16x8*)(QH + (16 * bi + lr) * HK + ks * 32 + 8 * lq), b = *(const LAS bf16x8*)(KH + (rb + 16 * bj + lr) * HK + ks * 32 + 8 * lq); acc = mfma16(a, b, acc); }
                if (bi == bj) {
#pragma unroll
                    for (int r = 0; r < 4; ++r) acc[r] = (lr <= 4 * lq + r) ? acc[r] : 0.f; } }
#pragma unroll
            for (int r = 0; r < 4; ++r) AL[(16 * bi + 4 * lq + r) * HS + 16 * bj + lr] = (bf16)f2bf(acc[r]); }
        HG_BAR();
        f32x4 o[4];
        { bf16x8 bS[4], bV[2];
#pragma unroll
          for (int kp = 0; kp < 4; ++kp) { v4u t; t.x = cvtpk(S[2 * kp][0], S[2 * kp][1]); t.y = cvtpk(S[2 * kp][2], S[2 * kp][3]); t.z = cvtpk(S[2 * kp + 1][0], S[2 * kp + 1][1]); t.w = cvtpk(S[2 * kp + 1][2], S[2 * kp + 1][3]); bS[kp] = __builtin_bit_cast(bf16x8, t); }
#pragma unroll
          for (int ks = 0; ks < 2; ++ks) bV[ks] = *(const LAS bf16x8*)(VT + (16 * w + lr) * HS + ks * 32 + 8 * lq);
#pragma unroll
          for (int mt = 0; mt < 4; ++mt) { f32x4 acc = {0.f, 0.f, 0.f, 0.f};
#pragma unroll
              for (int kp = 0; kp < 4; ++kp) { const LAS bf16* qp = QT + (16 * mt + lr) * HK + 32 * kp + 4 * lq; const v2u a0 = *(const LAS v2u*)qp, a1 = *(const LAS v2u*)(qp + 16);
                  v4u a; a.x = a0.x; a.y = a0.y; a.z = a1.x; a.w = a1.y; acc = mfma16(__builtin_bit_cast(bf16x8, a), bS[kp], acc); }
#pragma unroll
              for (int ks = 0; ks < 2; ++ks) acc = mfma16(*(const LAS bf16x8*)(AL + (16 * mt + lr) * HS + ks * 32 + 8 * lq), bV[ks], acc);
              o[mt] = acc;
              if constexpr (MODE == 1) { float* rp = RAW + (crow + 16 * mt) * 1024 + h * 128 + 16 * w;
#pragma unroll
                  for (int r = 0; r < 4; ++r) rp[(unsigned)((4 * lq + r) * 1024 + lr)] = acc[r]; }
              if constexpr (MODE == 0)
#pragma unroll
              for (int r = 0; r < 4; ++r) { float p = acc[r] * acc[r]; p += __shfl_xor(p, 1); p += __shfl_xor(p, 2); p += __shfl_xor(p, 4); p += __shfl_xor(p, 8); if (lr == 0) part[(16 * mt + 4 * lq + r) * 8 + w] = p; } } }
        { bf16x8 bV[2];
#pragma unroll
          for (int ks = 0; ks < 2; ++ks) bV[ks] = *(const LAS bf16x8*)(VT + (16 * w + lr) * HS + ks * 32 + 8 * lq);
#pragma unroll
          for (int kb = 0; kb < 8; ++kb) { const f32x4 d = *(const LAS f32x4*)(dvec + 16 * kb + 4 * lq); f32x4 acc = S[kb] * d;
#pragma unroll
              for (int ks = 0; ks < 2; ++ks) acc = mfma16(*(const LAS bf16x8*)(KT + (16 * kb + lr) * HS + ks * 32 + 8 * lq), bV[ks], acc);
              S[kb] = acc; } }
        if constexpr (MODE == 0) {
        HG_BAR();
        { bf16* op = P.OH + crow * 1024 + h * 128 + 16 * w;
#pragma unroll
          for (int mt = 0; mt < 4; ++mt)
#pragma unroll
              for (int r = 0; r < 4; ++r) { const int t = 16 * mt + 4 * lq + r; const f32x4 p0 = *(const LAS f32x4*)(part + t * 8), p1 = *(const LAS f32x4*)(part + t * 8 + 4);
                  const float ss = ((p0[0] + p0[1]) + (p0[2] + p0[3])) + ((p1[0] + p1[1]) + (p1[2] + p1[3]));
                  const float rstd = __builtin_amdgcn_rsqf(ss * (1.f / 128.f) + EPS);
                  const bf16 ov = (bf16)f2bf(o[mt][r] * rstd * gv * bf2f(hgv[mt * 4 + r]));
                  bf16* dst = (t < nvalid) ? op + (unsigned)(t * 1024 + lr) : P.dump + F.tid;
                  *dst = ov; } }
        }
        HG_BAR();
    }
#pragma unroll
    for (int kb = 0; kb < 8; ++kb)
#pragma unroll
        for (int r = 0; r < 4; ++r) s_out[(size_t)(16 * kb + 4 * lq_ + r) * 128 + 16 * w + lr_] = S[kb][r];
    if constexpr (MODE == 1) { if (w == 0) { f32x2v d; d.x = __expf(bseg.x); d.y = __expf(bseg.y); *(f32x2v*)(dseg + k0_) = d; } }
}

__device__ __forceinline__ void hg_fix(Frame& F, const HgPtrs& P, size_t row0, int h, int nchunk, int g, int G, const float* SLseq, const float* DSseq, const bf16* QS, const float* RAW, gu32* mask, float* s_fin) {
    LAS float* part = (LAS float*)(F.lds);
    const int w = __builtin_amdgcn_readfirstlane(F.wave), lr_ = F.lane & 15, lq_ = F.lane >> 4;
    if (F.tid == 0) { const unsigned need = (1u << g) - 1u; unsigned sp = 0;
        while ((__hip_atomic_load(mask, RLX_AGENT) & need) != need) { __builtin_amdgcn_s_sleep(2); if (++sp > (1u << 22)) { __hip_atomic_store(F.ctl + 1, 0x7eb0u, RLX_AGENT); break; } }
        __builtin_amdgcn_fence(__ATOMIC_ACQUIRE, "agent"); asm volatile("s_waitcnt vmcnt(0)" ::: "memory"); }
    __syncthreads();
    f32x4 S[8];
#pragma unroll
    for (int kb = 0; kb < 8; ++kb) S[kb] = (f32x4){0.f, 0.f, 0.f, 0.f};
    for (int p = 0; p < g; ++p) { const float* sl = SLseq + (size_t)p * 16384; const float* ds = DSseq + p * 128;
#pragma unroll
        for (int kb = 0; kb < 8; ++kb) { const f32x4 d = *(const f32x4*)(ds + 16 * kb + 4 * lq_);
#pragma unroll
            for (int r = 0; r < 4; ++r) S[kb][r] = d[r] * S[kb][r] + sl[(size_t)(16 * kb + 4 * lq_ + r) * 128 + 16 * w + lr_]; } }
    if (g == G - 1) { const float* sl = SLseq + (size_t)g * 16384; const float* ds = DSseq + g * 128;
#pragma unroll
        for (int kb = 0; kb < 8; ++kb) { const f32x4 d = *(const f32x4*)(ds + 16 * kb + 4 * lq_);
#pragma unroll
            for (int r = 0; r < 4; ++r) { const size_t o = (size_t)(16 * kb + 4 * lq_ + r) * 128 + 16 * w + lr_; s_fin[o] = d[r] * S[kb][r] + sl[o]; } } }
    bf16x8 bS[4];
#pragma unroll
    for (int kp = 0; kp < 4; ++kp) { v4u t; t.x = cvtpk(S[2 * kp][0], S[2 * kp][1]); t.y = cvtpk(S[2 * kp][2], S[2 * kp][3]); t.z = cvtpk(S[2 * kp + 1][0], S[2 * kp + 1][1]); t.w = cvtpk(S[2 * kp + 1][2], S[2 * kp + 1][3]); bS[kp] = __builtin_bit_cast(bf16x8, t); }
    const float gv = P.ghg[16 * w + lr_];
    f32x4 on[4]; unsigned short hn[16]; v2u qn[4][4][2];
#define HGF_LOAD(cc) do { const size_t cr_ = row0 + (size_t)(cc) * 64; const bf16* hp = P.HGS + cr_ * 1024 + h * 128 + 16 * w; const float* rp = RAW + cr_ * 1024 + h * 128 + 16 * w; \
        _Pragma("unroll") for (int mt = 0; mt < 4; ++mt) { \
            _Pragma("unroll") for (int r = 0; r < 4; ++r) { const unsigned off = (unsigned)((16 * mt + 4 * lq_ + r) * 1024 + lr_); on[mt][r] = rp[off]; hn[mt * 4 + r] = hp[off]; } \
            const bf16* qb = QS + (cr_ + 16 * mt) * 1024 + h * 128; \
            _Pragma("unroll") for (int kp = 0; kp < 4; ++kp) { const bf16* qp = qb + (unsigned)(lr_ * 1024 + 32 * kp + 4 * lq_); qn[mt][kp][0] = *(const v2u*)qp; qn[mt][kp][1] = *(const v2u*)(qp + 16); } } } while (0)
    HGF_LOAD(0);
    for (int c = 0; c < nchunk; ++c) {
        int lr = lr_, lq = lq_; asm volatile("" : "+v"(lr), "+v"(lq));
        const size_t crow = row0 + (size_t)c * 64;
        LAS float* pt = part + (c & 1) * 512;
        f32x4 o[4]; unsigned short hgv[16];
#pragma unroll
        for (int mt = 0; mt < 4; ++mt) { f32x4 acc = on[mt];
#pragma unroll
            for (int r = 0; r < 4; ++r) hgv[mt * 4 + r] = hn[mt * 4 + r];
#pragma unroll
            for (int kp = 0; kp < 4; ++kp) { v4u a; a.x = qn[mt][kp][0].x; a.y = qn[mt][kp][0].y; a.z = qn[mt][kp][1].x; a.w = qn[mt][kp][1].y; acc = mfma16(__builtin_bit_cast(bf16x8, a), bS[kp], acc); }
            o[mt] = acc; }
        asm volatile("" ::: "memory");
        if (c + 1 < nchunk) HGF_LOAD(c + 1);
        asm volatile("" ::: "memory");
#pragma unroll
        for (int mt = 0; mt < 4; ++mt)
#pragma unroll
            for (int r = 0; r < 4; ++r) { float p = o[mt][r] * o[mt][r]; p += __shfl_xor(p, 1); p += __shfl_xor(p, 2); p += __shfl_xor(p, 4); p += __shfl_xor(p, 8); if (lr == 0) pt[(16 * mt + 4 * lq + r) * 8 + w] = p; }
        HG_BAR();
        { bf16* op = P.OH + crow * 1024 + h * 128 + 16 * w;
#pragma unroll
          for (int mt = 0; mt < 4; ++mt)
#pragma unroll
              for (int r = 0; r < 4; ++r) { const int t = 16 * mt + 4 * lq + r; const f32x4 p0 = *(const LAS f32x4*)(pt + t * 8), p1 = *(const LAS f32x4*)(pt + t * 8 + 4);
                  const float ss = ((p0[0] + p0[1]) + (p0[2] + p0[3])) + ((p1[0] + p1[1]) + (p1[2] + p1[3]));
                  const float rstd = __builtin_amdgcn_rsqf(ss * (1.f / 128.f) + EPS);
                  op[(unsigned)(t * 1024 + lr)] = (bf16)f2bf(o[mt][r] * rstd * gv * bf2f(hgv[mt * 4 + r])); } }
    }
#undef HGF_LOAD
    __syncthreads();
}
#undef HG_BAR
__device__ __forceinline__ void team_barrier(Frame& F, gu32* w, unsigned target) {
    asm volatile("s_waitcnt vmcnt(0)" ::: "memory");
    __syncthreads();
    if (F.tid == 0) {
        __builtin_amdgcn_fence(__ATOMIC_RELEASE, "agent");
        asm volatile("s_waitcnt vmcnt(0)" ::: "memory");
        (void)__hip_atomic_fetch_add(w, 1u, RLX_AGENT);
        unsigned sp = 0;
        while (__hip_atomic_load(w, RLX_AGENT) < target) { __builtin_amdgcn_s_sleep(2); if (++sp > (1u << 22)) { __hip_atomic_store(F.ctl + 1, 0x7ea0u, RLX_AGENT); break; } }
        __builtin_amdgcn_fence(__ATOMIC_ACQUIRE, "agent");
        asm volatile("s_waitcnt vmcnt(0)" ::: "memory");
    }
    __syncthreads();
}
__device__ __forceinline__ int wg_pull(Frame& F, gu32* ctr) {
    if (F.tid == 0) F.MISC[16] = __hip_atomic_fetch_add(ctr, 1u, RLX_AGENT);
    __syncthreads();
    const int v = (int)F.MISC[16];
    __syncthreads();
    return __builtin_amdgcn_readfirstlane(v);
}
#ifdef PROBE_ID
#define PT_BEGIN(id) unsigned long long pt0_##id = 0; if ((id) == PROBE_ID && blockIdx.x == 0) pt0_##id = __builtin_amdgcn_s_memrealtime()
#define PT_END(id) do { if ((id) == PROBE_ID && blockIdx.x == 0) { const unsigned long long t1 = __builtin_amdgcn_s_memrealtime(), d = t1 - pt0_##id; while (__builtin_amdgcn_s_memrealtime() - t1 < d) __builtin_amdgcn_s_sleep(8); } } while (0)
#else
#define PT_BEGIN(id) do {} while (0)
#define PT_END(id) do {} while (0)
#endif
struct Args { const float* in[25]; float* out; unsigned char* ws; };
__global__ void __launch_bounds__(NWAVES * 64, 2) mk_fwd(Args args) {
    extern __shared__ __attribute__((aligned(16))) unsigned char lds[];
    Frame F;
    F.lds = (LAS unsigned char*)lds;
    F.MISC = (volatile LAS unsigned*)(F.lds + MISC_OFF);
#define ENTER() do { F.tid = opaque_tid(); F.lane = F.tid & 63; F.wave = __builtin_amdgcn_readfirstlane(F.tid >> 6); F.G = gridDim.x; { const int bx = opaque_bid(); F.vcu = (F.G % 8 == 0) ? (bx % 8) * (F.G / 8) + bx / 8 : bx; } } while (0)
    ENTER();
    F.ctl = (gu32*)((unsigned char*)karg(A_WS) + WS_CTL);
    for (int u = F.tid; u < (LDS_BYTES - LDSCTL_OFF) / 4; u += NWAVES * 64) ((LAS unsigned*)(F.lds + LDSCTL_OFF))[u] = 0u;
    __syncthreads();
    XcdBarrier bar = xcd_barrier_post((unsigned*)(F.ctl + CW_BAR), F.MISC + 8);
#define GRID_BAR() do { asm volatile("" : "+s"(bar.x)); xcd_barrier(bar); } while (0)
#define WSP(T, off) ((T*)((unsigned char*)karg(A_WS) + (off)))
#define OUTP(off) ((float*)karg(A_OUT) + (off))

#ifndef NO_P0
    p0_prologue(F, WSP(unsigned char, 0));
#ifdef DUP_P0
    GRID_BAR(); ENTER(); p0_prologue(F, WSP(unsigned char, 0));
#endif
#endif
    GRID_BAR();

    for (int l = 0; l < DEPTH; ++l) {
        const size_t wlo = WS_W + (size_t)l * W_LAYER, modo = WS_MOD + (size_t)l * NSEQ * 9216 * 4;
        norm_phase(F, karg(A_XP), nullptr, l == 0, WSP(float, WS_X), karg(A_GFFN1) + l * 1024, WSP(const float, modo), 0, WSP(bf16, WS_XN), 0, MP, F.vcu * NWAVES + F.wave, F.G * NWAVES);
#ifdef DUP_THIN
        GRID_BAR(); ENTER();
        norm_phase(F, nullptr, nullptr, false, WSP(float, WS_X), karg(A_GFFN1) + l * 1024, WSP(const float, modo), 0, WSP(bf16, WS_XN), 0, MP, F.vcu * NWAVES + F.wave, F.G * NWAVES);
#endif
        GRID_BAR(); ENTER();
#ifndef NO_G1
        { pg8::Gemm g{WSP(bf16, WS_XN), WSP(const bf16, wlo + WO_GU1), MP, 2 * DFF, DM}; typedef pg8::FixedOrder<128, 22, 8> Ord; Ord S; S.init(F.G, opaque_bid());
          pg8::EpiSwiglu E{WSP(bf16, WS_BIG)};
          pg8::gemm_phase<pg8::EpiSwiglu, Ord, true, true>(F.lds + RING_OFF, g, S, E);
#ifdef DUP_G1
          GRID_BAR(); ENTER(); pg8::gemm_phase<pg8::EpiSwiglu, Ord, true, true>(F.lds + RING_OFF, g, S, E);
#endif
        }
#endif
        GRID_BAR(); ENTER();
#ifndef NO_G2
        { pg8::Gemm g{WSP(bf16, WS_BIG), WSP(const bf16, wlo + WO_D1), MP, DM, DFF}; typedef pg8::FixedOrder<128, 4, 8> Ord; Ord S; S.init(F.G, opaque_bid());
          pg8::EpiResid E{WSP(float, WS_X), WSP(const float, modo) + 2 * 1024, 0.5f};
          pg8::gemm_phase<pg8::EpiResid, Ord, true, true>(F.lds + RING_OFF, g, S, E);
#ifdef DUP_RES
          GRID_BAR(); ENTER(); { pg8::EpiResid E0{E.X, E.gate, 0.f}; pg8::gemm_phase<pg8::EpiResid, Ord, true, true>(F.lds + RING_OFF, g, S, E0); }
#endif
        }
#endif
        GRID_BAR(); ENTER();
        norm_phase(F, nullptr, nullptr, false, WSP(float, WS_X), karg(A_GMIX) + l * 1024, WSP(const float, modo), 1, WSP(bf16, WS_XN), 0, MP, F.vcu * NWAVES + F.wave, F.G * NWAVES);
#ifdef DUP_THIN
        GRID_BAR(); ENTER();
        norm_phase(F, nullptr, nullptr, false, WSP(float, WS_X), karg(A_GMIX) + l * 1024, WSP(const float, modo), 1, WSP(bf16, WS_XN), 0, MP, F.vcu * NWAVES + F.wave, F.G * NWAVES);
#endif
        GRID_BAR(); ENTER();
        PT_BEGIN(2);
#ifndef NO_G3
        { pg8::Gemm g{WSP(bf16, WS_XN), WSP(const bf16, wlo + WO_IN), MP, DIN, DM}; typedef pg8::FixedOrder<128, 36, 8> Ord; Ord S; S.init(F.G, opaque_bid());
          pg8::EpiWin E{WSP(unsigned char, 0), OUTP(0), l, attn_body::C2};
          pg8::gemm_phase<pg8::EpiWin, Ord, true, true>(F.lds + RING_OFF, g, S, E); }
#endif
        GRID_BAR(); ENTER();
        PT_END(2);
        PT_BEGIN(1);
        { gu32* qbase = F.ctl + CW_Q + 64 * (l * 16);
          const int tk = wg_pull(F, qbase + 64 * 9);
#ifdef PROBE_ROLE
          const unsigned long long pr0 = __builtin_amdgcn_s_memrealtime();
#endif
          const int T_EFF = (F.G + TEAM_STRIDE - 1) / TEAM_STRIDE;
          const bool team = (tk % TEAM_STRIDE) == 0, hfirst = (tk % TEAM_STRIDE) >= 1 && (tk % TEAM_STRIDE) <= STARTERS; const int ticket = tk / TEAM_STRIDE; gu32* tb = qbase + 64 * 10; unsigned tstage = 0;
#define TEAM_BAR() do { ++tstage; team_barrier(F, tb, (unsigned)T_EFF * tstage); ENTER(); } while (0)
#ifndef NO_TEAM
          if (team) {
              const int tgw = ticket * NWAVES + F.wave, TNW = T_EFF * NWAVES;
              norm_phase(F, nullptr, karg(A_XS), l == 0, WSP(float, WS_X), karg(A_GFFN1) + l * 1024, WSP(const float, modo), 0, WSP(bf16, WS_XN), MP, MROWS, tgw, TNW);
              TEAM_BAR();
              { pg8::Gemm g{WSP(bf16, WS_XN), WSP(const bf16, wlo + WO_GU1), MROWS, 2 * DFF, DM}; typedef pg8::TeamOrder<22> Ord; Ord S; S.init(T_EFF, ticket);
                pg8::EpiSwiglu E{WSP(bf16, WS_BIG)};
                pg8::gemm_phase<pg8::EpiSwiglu, Ord, true, true>(F.lds + RING_OFF, g, S, E); }
              TEAM_BAR();
              { pg8::Gemm g{WSP(bf16, WS_BIG), WSP(const bf16, wlo + WO_D1), MROWS, DM, DFF}; typedef pg8::TeamOrder<4> Ord; Ord S; S.init(T_EFF, ticket);
                pg8::EpiResid E{WSP(float, WS_X), WSP(const float, modo) + 2 * 1024, 0.5f};
                pg8::gemm_phase<pg8::EpiResid, Ord, true, true>(F.lds + RING_OFF, g, S, E); }
              TEAM_BAR();
              norm_phase(F, nullptr, nullptr, false, WSP(float, WS_X), karg(A_GMIX) + l * 1024, WSP(const float, modo), 1, WSP(bf16, WS_XN), MP, MROWS, ticket * NWAVES + F.wave, T_EFF * NWAVES);
              TEAM_BAR();
              { pg8::Gemm g{WSP(bf16, WS_XN), WSP(const bf16, wlo + WO_IN), MROWS, DIN, DM}; typedef pg8::TeamOrder<36> Ord; Ord S; S.init(T_EFF, ticket);
                pg8::EpiWin E{WSP(unsigned char, 0), OUTP(0), l, attn_body::C2};
                pg8::gemm_phase<pg8::EpiWin, Ord, true, true>(F.lds + RING_OFF, g, S, E); }
              TEAM_BAR();
          }
#endif
          if (hfirst) {
            for (;;) { const int it = wg_pull(F, qbase); if (it >= 32 * HG_G) break;
              const HgPtrs P{WSP(const float, WS_LOGF), WSP(const bf16, WS_QQ), WSP(const bf16, WS_KK), WSP(const bf16, WS_VV), WSP(const bf16, WS_HGS), karg(A_GHG) + l * 128, WSP(bf16, WS_OH), WSP(bf16, WS_DD)};
#ifndef NO_H
                  const int sqh = it / HG_G, g = it % HG_G, b = sqh >> 3, h = sqh & 7; const int nch = 128 / HG_G;
                  const size_t r0 = (size_t)b * 8192 + (size_t)g * nch * 64;
                  float* SLq = WSP(float, WS_SL) + (size_t)sqh * HG_G * 16384; float* DSq = WSP(float, WS_DSEG) + (size_t)sqh * HG_G * 128;
                  gu32* mask = F.ctl + CW_HS + 64 * (l * 32 + sqh);
                  hg_sequence<1>(F, P, r0, h, nch, 64, nullptr, SLq + (size_t)g * 16384, WSP(bf16, WS_QS), WSP(float, WS_RAW), DSq + g * 128);
                  asm volatile("s_waitcnt vmcnt(0)" ::: "memory"); __syncthreads();
                  if (F.tid == 0) { __builtin_amdgcn_fence(__ATOMIC_RELEASE, "agent"); asm volatile("s_waitcnt vmcnt(0)" ::: "memory"); (void)__hip_atomic_fetch_or(mask, 1u << g, RLX_AGENT); }
                  ENTER();
                  hg_fix(F, P, r0, h, nch, g, HG_G, SLq, DSq, WSP(const bf16, WS_QS), WSP(const float, WS_RAW), mask, OUTP(0) + OS_P + ((size_t)((l * 4 + b) * 8 + h)) * 16384);
                  ENTER();
#endif
            }
            if (F.tid == 0) { unsigned sp = 0; while (__hip_atomic_load(tb, RLX_AGENT) < (unsigned)T_EFF * 5u) { __builtin_amdgcn_s_sleep(2); if (++sp > (1u << 22)) { __hip_atomic_store(F.ctl + 1, 0x7ec0u, RLX_AGENT); break; } }
                __builtin_amdgcn_fence(__ATOMIC_ACQUIRE, "agent"); asm volatile("s_waitcnt vmcnt(0)" ::: "memory"); }
            __syncthreads(); ENTER();
          }
          if (team || hfirst) {
            gu32* qs = qbase + 64 * 11; gu32* done = qbase + 64 * 12;
            for (;;) { const int it = wg_pull(F, qs); if (it >= 256) break;
              const HgPtrs P{WSP(const float, WS_LOGF), WSP(const bf16, WS_QQ), WSP(const bf16, WS_KK), WSP(const bf16, WS_VV), WSP(const bf16, WS_HGS), karg(A_GHG) + l * 128, WSP(bf16, WS_OH), WSP(bf16, WS_DD)};
              if (it < 128) {
#ifndef NO_H
                  const int sq = it >> 3, h = it & 7; const size_t so = OS_S + ((size_t)((l * 16 + sq) * 8 + h)) * 16384;
                  hg_sequence<0>(F, P, (size_t)MP + (size_t)sq * 32, h, 1, 32, karg(A_ST) + ((size_t)((l * 16 + sq) * 8 + h)) * 16384, OUTP(0) + so, nullptr, nullptr, nullptr);
#endif
              } else {
#ifndef NO_SAMP
                  const int u = it - 128; const float lam = lam_of(karg(A_LAM), l, F.lane), osc = 1.f - lam_init_of(l);
                  attn_sample_unit(F, karg(A_CK), karg(A_CV), l, u >> 3, u & 7, WSP(const bf16, WS_Q), WSP(const bf16, WS_K), WSP(const bf16, WS_V), lam, osc, karg(A_GSUB) + l * 128, WSP(bf16, WS_OATT));
#endif
              }
              asm volatile("s_waitcnt vmcnt(0)" ::: "memory"); __syncthreads();
              if (F.tid == 0) { __builtin_amdgcn_fence(__ATOMIC_RELEASE, "agent"); asm volatile("s_waitcnt vmcnt(0)" ::: "memory"); (void)__hip_atomic_fetch_add(done, 1u, RLX_AGENT); }
              ENTER(); }
            if (team) {
                if (F.tid == 0) { unsigned sp = 0; while (__hip_atomic_load(done, RLX_AGENT) < 256u) { __builtin_amdgcn_s_sleep(2); if (++sp > (1u << 22)) { __hip_atomic_store(F.ctl + 1, 0x7ed0u, RLX_AGENT); break; } }
                    __builtin_amdgcn_fence(__ATOMIC_ACQUIRE, "agent"); asm volatile("s_waitcnt vmcnt(0)" ::: "memory"); }
                __syncthreads(); ENTER(); } }
#ifndef NO_TEAM
          if (team) {
              { pg8::Gemm g{WSP(bf16, WS_OATT), WSP(const bf16, wlo + WO_BA), MROWS, DM, DM}; typedef pg8::TeamOrder<4> Ord; Ord S; S.init(T_EFF, ticket);
                pg8::EpiGateT E{WSP(float, WS_LOGF), WSP(const bf16, WS_SZA)};
                pg8::gemm_phase<pg8::EpiGateT, Ord, true, true>(F.lds + RING_OFF, g, S, E); }
              TEAM_BAR();
              { pg8::Gemm g{WSP(bf16, WS_OH), WSP(const bf16, wlo + WO_BH), MROWS, DM, DM}; typedef pg8::TeamOrder<4> Ord; Ord S; S.init(T_EFF, ticket);
                pg8::EpiGateM E{WSP(const float, WS_LOGF), WSP(const bf16, WS_SZH), WSP(bf16, WS_MRG)};
                pg8::gemm_phase<pg8::EpiGateM, Ord, true, true>(F.lds + RING_OFF, g, S, E); }
              TEAM_BAR();
              { pg8::Gemm g{WSP(bf16, WS_MRG), WSP(const bf16, wlo + WO_OUT), MROWS, DM, DM}; typedef pg8::TeamOrder<4> Ord; Ord S; S.init(T_EFF, ticket);
                pg8::EpiResid E{WSP(float, WS_X), WSP(const float, modo) + 5 * 1024, 1.0f};
                pg8::gemm_phase<pg8::EpiResid, Ord, true, true>(F.lds + RING_OFF, g, S, E); }
              TEAM_BAR();
              norm_phase(F, nullptr, nullptr, false, WSP(float, WS_X), karg(A_GFFN2) + l * 1024, WSP(const float, modo), 2, WSP(bf16, WS_XN), MP, MROWS, ticket * NWAVES + F.wave, T_EFF * NWAVES);
              TEAM_BAR();
              { pg8::Gemm g{WSP(bf16, WS_XN), WSP(const bf16, wlo + WO_GU2), MROWS, 2 * DFF, DM}; typedef pg8::TeamOrder<22> Ord; Ord S; S.init(T_EFF, ticket);
                pg8::EpiSwiglu E{WSP(bf16, WS_BIG)};
                pg8::gemm_phase<pg8::EpiSwiglu, Ord, true, true>(F.lds + RING_OFF, g, S, E); }
              TEAM_BAR();
              { pg8::Gemm g{WSP(bf16, WS_BIG), WSP(const bf16, wlo + WO_D2), MROWS, DM, DFF}; typedef pg8::TeamOrder<4> Ord; Ord S; S.init(T_EFF, ticket);
                pg8::EpiResid E{WSP(float, WS_X), WSP(const float, modo) + 8 * 1024, 0.5f};
                pg8::gemm_phase<pg8::EpiResid, Ord, true, true>(F.lds + RING_OFF, g, S, E); }
              ENTER();
          }
#endif
#ifndef NO_ATT
          { const attn_body::bf16* Qb = WSP(const attn_body::bf16, WS_Q); const attn_body::bf16* Kb = WSP(const attn_body::bf16, WS_K); const attn_body::bf16* Vb = WSP(const attn_body::bf16, WS_V); attn_body::bf16* O1 = WSP(attn_body::bf16, WS_O1);
            const int x0 = (int)(xb_xcc_id() & 7u);
            for (int dx = 0; dx < 8; ++dx) { const int head = (x0 + dx) & 7; gu32* qa = qbase + 64 * (1 + head);
                for (;;) { const int it = wg_pull(F, qa); if (it >= 256) break;
                    const int b = it >> 6, r = it & 63, qb = 31 - (r >> 1), mp = r & 1;
                    attn_body::attn_unit128<8>(b, head * 2 + mp, head * 2, qb, Qb, Kb, Vb, O1 + (size_t)mp * ((WS_O2 - WS_O1) / 2), (char*)lds + RING_OFF); } } }
#endif
#undef TEAM_BAR
#ifdef PROBE_ROLE
          if (tk == PROBE_ROLE) { const unsigned long long t1 = __builtin_amdgcn_s_memrealtime(), d = t1 - pr0; while (__builtin_amdgcn_s_memrealtime() - t1 < d) __builtin_amdgcn_s_sleep(8); }
#endif
        }
        GRID_BAR(); ENTER();
        PT_END(1);
        { const float lam = lam_of(karg(A_LAM), l, F.lane), osc = 1.f - lam_init_of(l);
          attn_combine_phase(F, WSP(const bf16, WS_O1), WSP(const bf16, WS_O2), karg(A_GSUB) + l * 128, lam, osc, WSP(bf16, WS_OATT));
#ifdef DUP_THIN
          GRID_BAR(); ENTER();
          attn_combine_phase(F, WSP(const bf16, WS_O1), WSP(const bf16, WS_O2), karg(A_GSUB) + l * 128, lam, osc, WSP(bf16, WS_OATT));
#endif
        }
        GRID_BAR(); ENTER();
#ifndef NO_G4
        { pg8::Gemm g{WSP(bf16, WS_OATT), WSP(const bf16, wlo + WO_BA), MP, DM, DM}; typedef pg8::FixedOrder<128, 4, 8> Ord; Ord S; S.init(F.G, opaque_bid());
          pg8::EpiGateT E{WSP(float, WS_LOGF), WSP(const bf16, WS_SZA)};
          pg8::gemm_phase<pg8::EpiGateT, Ord, true, true>(F.lds + RING_OFF, g, S, E);
#ifdef DUP_THIN
          GRID_BAR(); ENTER(); pg8::gemm_phase<pg8::EpiGateT, Ord, true, true>(F.lds + RING_OFF, g, S, E);
#endif
        }
#endif
        GRID_BAR(); ENTER();
#ifndef NO_G5
        { pg8::Gemm g{WSP(bf16, WS_OH), WSP(const bf16, wlo + WO_BH), MP, DM, DM}; typedef pg8::FixedOrder<128, 4, 8> Ord; Ord S; S.init(F.G, opaque_bid());
          pg8::EpiGateM E{WSP(const float, WS_LOGF), WSP(const bf16, WS_SZH), WSP(bf16, WS_MRG)};
          pg8::gemm_phase<pg8::EpiGateM, Ord, true, true>(F.lds + RING_OFF, g, S, E);
#ifdef DUP_THIN
          GRID_BAR(); ENTER(); pg8::gemm_phase<pg8::EpiGateM, Ord, true, true>(F.lds + RING_OFF, g, S, E);
#endif
        }
#endif
        GRID_BAR(); ENTER();
#ifndef NO_G6
        { pg8::Gemm g{WSP(bf16, WS_MRG), WSP(const bf16, wlo + WO_OUT), MP, DM, DM}; typedef pg8::FixedOrder<128, 4, 8> Ord; Ord S; S.init(F.G, opaque_bid());
          pg8::EpiResid E{WSP(float, WS_X), WSP(const float, modo) + 5 * 1024, 1.0f};
          pg8::gemm_phase<pg8::EpiResid, Ord, true, true>(F.lds + RING_OFF, g, S, E);
#ifdef DUP_RES
          GRID_BAR(); ENTER(); { pg8::EpiResid E0{E.X, E.gate, 0.f}; pg8::gemm_phase<pg8::EpiResid, Ord, true, true>(F.lds + RING_OFF, g, S, E0); }
#endif
        }
#endif
        GRID_BAR(); ENTER();
        norm_phase(F, nullptr, nullptr, false, WSP(float, WS_X), karg(A_GFFN2) + l * 1024, WSP(const float, modo), 2, WSP(bf16, WS_XN), 0, MP, F.vcu * NWAVES + F.wave, F.G * NWAVES);
#ifdef DUP_THIN
        GRID_BAR(); ENTER();
        norm_phase(F, nullptr, nullptr, false, WSP(float, WS_X), karg(A_GFFN2) + l * 1024, WSP(const float, modo), 2, WSP(bf16, WS_XN), 0, MP, F.vcu * NWAVES + F.wave, F.G * NWAVES);
#endif
        GRID_BAR(); ENTER();
#ifndef NO_G7
        { pg8::Gemm g{WSP(bf16, WS_XN), WSP(const bf16, wlo + WO_GU2), MP, 2 * DFF, DM}; typedef pg8::FixedOrder<128, 22, 8> Ord; Ord S; S.init(F.G, opaque_bid());
          pg8::EpiSwiglu E{WSP(bf16, WS_BIG)};
          pg8::gemm_phase<pg8::EpiSwiglu, Ord, true, true>(F.lds + RING_OFF, g, S, E); }
#endif
        GRID_BAR(); ENTER();
#ifndef NO_G8
        { pg8::Gemm g{WSP(bf16, WS_BIG), WSP(const bf16, wlo + WO_D2), MP, DM, DFF}; typedef pg8::FixedOrder<128, 4, 8> Ord; Ord S; S.init(F.G, opaque_bid());
          pg8::EpiResid E{WSP(float, WS_X), WSP(const float, modo) + 8 * 1024, 0.5f};
          pg8::gemm_phase<pg8::EpiResid, Ord, true, true>(F.lds + RING_OFF, g, S, E);
#ifdef DUP_RES
          GRID_BAR(); ENTER(); { pg8::EpiResid E0{E.X, E.gate, 0.f}; pg8::gemm_phase<pg8::EpiResid, Ord, true, true>(F.lds + RING_OFF, g, S, E0); }
#endif
        }
#endif
        GRID_BAR(); ENTER();
    }
    final_norm_phase(F, WSP(const float, WS_X), karg(A_GFIN), OUTP(0));
#undef GRID_BAR
#undef ENTER
#undef WSP
#undef OUTP
}

extern "C" void kernel_launch(void* const* d_in, const int* in_sizes, int n_in, void* d_out, int out_size, void* d_ws, size_t ws_size, hipStream_t stream) {
    static int grid = 0;
    if (grid == 0) {
        if (n_in != 25 || (size_t)out_size != OUT_TOTAL || ws_size < WS_END) { fprintf(stderr, "kernel_launch: unexpected sizes: n_in %d out %d ws %zu (need %zu)\n", n_in, out_size, ws_size, (size_t)WS_END); grid = -1; return; }
        int dev = 0, cus = 0, per_cu = 0;
        if (hipGetDevice(&dev) != hipSuccess || hipDeviceGetAttribute(&cus, hipDeviceAttributeMultiprocessorCount, dev) != hipSuccess) { grid = -1; return; }
        if (hipFuncSetAttribute((const void*)mk_fwd, hipFuncAttributeMaxDynamicSharedMemorySize, LDS_BYTES) != hipSuccess) { fprintf(stderr, "kernel_launch: hipFuncSetAttribute failed\n"); grid = -1; return; }
        if (hipOccupancyMaxActiveBlocksPerMultiprocessor(&per_cu, (const void*)mk_fwd, NWAVES * 64, LDS_BYTES) != hipSuccess || per_cu < 1) { fprintf(stderr, "kernel_launch: occupancy query reports %d\n", per_cu); }
        (void)hipGetLastError();
        grid = cus;
    }
    if (grid < 0) return;
    if (hipMemsetAsync((char*)d_ws + WS_CTL, 0, CTL_ZERO_BYTES, stream) != hipSuccess) return;
    Args a{};
    for (int i = 0; i < 25; ++i) a.in[i] = (const float*)d_in[i];
    a.out = (float*)d_out; a.ws = (unsigned char*)d_ws;
    hipLaunchKernelGGL(mk_fwd, dim3(grid), dim3(NWAVES * 64), LDS_BYTES, stream, a);
    (void)in_sizes;
}
```

```cpp
#define TEAM_STRIDE 16
#define STARTERS 8
#include <hip/hip_runtime.h>
#include <hip/hip_bf16.h>
#include <cstdio>
#include <cstdint>
#include <cmath>
constexpr unsigned WTAB_LDS_ADDR = 139264u + 320u + 256u;
__device__ __forceinline__ unsigned hw_wave_slot() { return (unsigned)__builtin_amdgcn_s_getreg((6 << 11) | 4) & 0x3fu; }
__device__ __forceinline__ void tid_table_init() { ((volatile __attribute__((address_space(3))) unsigned*)(size_t)WTAB_LDS_ADDR)[hw_wave_slot()] = threadIdx.x >> 6; }
__device__ __forceinline__ int opaque_tid() { const unsigned w = ((volatile __attribute__((address_space(3))) unsigned*)(size_t)WTAB_LDS_ADDR)[hw_wave_slot()];
    unsigned ln; asm volatile("v_mbcnt_lo_u32_b32 %0, -1, 0\n\tv_mbcnt_hi_u32_b32 %0, -1, %0" : "=v"(ln));
    return (int)((w << 6) | ln); }
__device__ __forceinline__ int opaque_bid() { int b = (int)blockIdx.x; asm volatile("" : "+s"(b)); return b; }
namespace pg8 {
#define PG8_LAS __attribute__((address_space(3)))
typedef unsigned short bf16_t;
typedef short bf16x8 __attribute__((ext_vector_type(8)));
typedef float f32x4 __attribute__((ext_vector_type(4)));
typedef unsigned u32x4 __attribute__((ext_vector_type(4)));
constexpr int BM = 256, BK = 64, HALF = 128, HTB = HALF * BK * 2  , STAGE_BYTES = 8 * HTB, NXCD = 8, WGM = 8;

__host__ __device__ __forceinline__ int lds_byte(int r, int c) { const int st = (r >> 4) * 2 + (c >> 5), rr = r & 15, cc = c & 31, ob = rr * 64 + cc * 2; return st * 1024 + (ob ^ (((ob >> 9) & 1) << 5)); }
__host__ __device__ __forceinline__ void stage_rc(int b, int& R, int& C) { const int st = b / 1024, sb = b % 1024, swz = sb ^ (((sb >> 9) & 1) << 5); R = (st >> 1) * 16 + swz / 64; C = (st & 1) * 32 + (swz % 64) / 2; }
__host__ __device__ __forceinline__ int perm32(int rho) { const int n = rho >> 4, i = rho & 15; return 8 * (i >> 2) + 4 * n + (i & 3); }

struct Unit { int pm, pn; };
struct Gemm { const bf16_t* A; const bf16_t* Bt; int M, N, K; };

struct StaticOrder {
    int nM, nN, nwg, G, c;
    __host__ __device__ void init(int M, int N, int G_, int c_) { nM = M / BM; nN = N / BM; nwg = nM * nN; G = G_; c = c_; }
    __host__ __device__ bool next(int i, Unit& u) const {
        const long L = (long)i * G + c; if (L >= nwg) return false;
        int wgid = (int)L; { const int q = nwg / NXCD, r = nwg % NXCD, xcd = wgid % NXCD, off = wgid / NXCD; wgid = (xcd < r ? xcd * (q + 1) : r * (q + 1) + (xcd - r) * q) + off; }
        const int nig = WGM * nN, gid = wgid / nig, fm = gid * WGM, gsz = (nM - fm) < WGM ? (nM - fm) : WGM;
        u.pm = fm + ((wgid % nig) % gsz); u.pn = (wgid % nig) / gsz; return true;
    }
    __device__ __forceinline__ void a_ready(const Unit&) const {}
    __device__ __forceinline__ void done(const Unit&) const {}
};

__device__ __forceinline__ unsigned cvt_pk_bf16(float lo, float hi) { unsigned r; asm volatile("v_cvt_pk_bf16_f32 %0, %1, %2" : "=v"(r) : "v"(lo), "v"(hi)); return r; }
__device__ __forceinline__ float bf_lo(unsigned w) { return __builtin_bit_cast(float, w << 16); }
__device__ __forceinline__ float bf_hi(unsigned w) { return __builtin_bit_cast(float, w & 0xffff0000u); }
__device__ __forceinline__ float sigmoid_f(float x) { return __builtin_amdgcn_rcpf(1.f + __expf(-x)); }
__device__ __forceinline__ float silu_f(float x) { return x * sigmoid_f(x); }
__device__ __forceinline__ void store8bf(bf16_t* p, f32x4 a, f32x4 b) { u32x4 w; w.x = cvt_pk_bf16(a[0], a[1]); w.y = cvt_pk_bf16(a[2], a[3]); w.z = cvt_pk_bf16(b[0], b[1]); w.w = cvt_pk_bf16(b[2], b[3]); *(u32x4*)p = w; }
__device__ __forceinline__ int row_seq(int row) { return row < 32768 ? (row >> 13) : 4 + ((row - 32768) >> 5); }

struct EpiSwiglu {
    static constexpr bool PERM = true, AFTER_DRAIN = false;
    bf16_t* O;
    __device__ __forceinline__ void operator()(const f32x4 (&acc)[2][2][4][2], const Unit& u, int wr, int wc, int fr, int fq) const {
        const int row0 = u.pm * BM + wr * 64 + fr, col0 = u.pn * HALF + wc * 32 + 8 * fq;
#pragma unroll
        for (int ai = 0; ai < 2; ++ai)
#pragma unroll
            for (int m = 0; m < 4; ++m) {
                f32x4 g0 = acc[ai][0][m][0], g1 = acc[ai][0][m][1]; const f32x4 u0 = acc[ai][1][m][0], u1 = acc[ai][1][m][1];
#pragma unroll
                for (int i = 0; i < 4; ++i) { g0[i] = silu_f(g0[i]) * u0[i]; g1[i] = silu_f(g1[i]) * u1[i]; }
                store8bf(O + (size_t)(row0 + ai * HALF + m * 16) * 2816 + col0, g0, g1); asm volatile("" ::: "memory");
            }
    }
};

struct EpiResid {
    static constexpr bool PERM = true, AFTER_DRAIN = false;
    float* X; const float* gate; float coef;
    __device__ __forceinline__ void operator()(const f32x4 (&acc)[2][2][4][2], const Unit& u, int wr, int wc, int fr, int fq) const {
        if (u.pm < 128) {
            const float* gp = gate + (size_t)(u.pm >> 5) * 9216 + u.pn * BM + wc * 32 + 8 * fq;
            f32x4 gv[2][2];
#pragma unroll
            for (int bj = 0; bj < 2; ++bj)
#pragma unroll
                for (int n = 0; n < 2; ++n) gv[bj][n] = *(const f32x4*)(gp + bj * HALF + 4 * n) * coef;
            float* xb = X + (size_t)(u.pm * BM + wr * 64 + fr) * 1024 + u.pn * BM + wc * 32 + 8 * fq;
            f32x4 xc[2][2], xn[2][2];
#pragma unroll
            for (int bj = 0; bj < 2; ++bj)
#pragma unroll
                for (int n = 0; n < 2; ++n) xc[bj][n] = *(const f32x4*)(xb + bj * HALF + 4 * n);
#pragma unroll
            for (int g = 0; g < 8; ++g) { const int ai = g >> 2, m = g & 3; float* xr = xb + (size_t)(ai * HALF + m * 16) * 1024;
                if (g + 1 < 8) { const float* xq = xb + (size_t)(((g + 1) >> 2) * HALF + ((g + 1) & 3) * 16) * 1024;
#pragma unroll
                    for (int bj = 0; bj < 2; ++bj)
#pragma unroll
                        for (int n = 0; n < 2; ++n) xn[bj][n] = *(const f32x4*)(xq + bj * HALF + 4 * n); }
#pragma unroll
                for (int bj = 0; bj < 2; ++bj)
#pragma unroll
                    for (int n = 0; n < 2; ++n) *(f32x4*)(xr + bj * HALF + 4 * n) = xc[bj][n] + gv[bj][n] * acc[ai][bj][m][n];
                asm volatile("" ::: "memory");
#pragma unroll
                for (int bj = 0; bj < 2; ++bj)
#pragma unroll
                    for (int n = 0; n < 2; ++n) xc[bj][n] = xn[bj][n]; }
        } else {
#pragma unroll
        for (int ai = 0; ai < 2; ++ai)
#pragma unroll
            for (int m = 0; m < 4; ++m) {
                const int row = u.pm * BM + ai * HALF + wr * 64 + m * 16 + fr; const float* gp = gate + (size_t)row_seq(row) * 9216;
#pragma unroll
                for (int bj = 0; bj < 2; ++bj) { const int col = u.pn * BM + bj * HALF + wc * 32 + 8 * fq;
#pragma unroll
                    for (int n = 0; n < 2; ++n) { const f32x4 g = *(const f32x4*)(gp + col + 4 * n); f32x4* xp = (f32x4*)(X + (size_t)row * 1024 + col + 4 * n); const f32x4 xv = *xp; *xp = xv + (g * coef) * acc[ai][bj][m][n]; } asm volatile("" ::: "memory"); }
            }
        }
    }
};

struct EpiWin {
    static constexpr bool PERM = true, AFTER_DRAIN = false;
    unsigned char* ws; float* out; int l; float qscale;
    static constexpr size_t MiB_ = 1u << 20;
    static constexpr size_t O_Q = 435 * MiB_, O_K = 500 * MiB_, O_V = 565 * MiB_, O_QQ = 630 * MiB_, O_KK = 695 * MiB_, O_VV = 760 * MiB_, O_HGS = 825 * MiB_, O_SZA = 890 * MiB_, O_SZH = 955 * MiB_, O_LOGF = 1020 * MiB_, O_LB = 4 * MiB_;
    static constexpr size_t OK_P_ = 34078720, OV_P_ = 168296448, OK_S_ = 304611328, OV_S_ = 306708480;
    __device__ __forceinline__ void operator()(const f32x4 (&acc)[2][2][4][2], const Unit& u, int wr, int wc, int fr, int fq) const {
        const int seg = u.pn >> 2, cb = (u.pn & 3) * BM + wc * 32 + 8 * fq, row0 = u.pm * BM + wr * 64 + fr;
        const size_t boff = seg == 0 ? O_Q : seg == 1 ? O_K : seg == 2 ? O_V : seg == 3 ? O_QQ : seg == 4 ? O_KK : seg == 5 ? O_VV : seg == 6 ? O_HGS : seg == 7 ? O_SZA : O_SZH;
        bf16_t* const O = (bf16_t*)(ws + boff) + (size_t)row0 * 1024 + cb;
        float* F32 = nullptr;
        if (seg == 1 || seg == 2) { const size_t ob = (u.pm < 128) ? (seg == 1 ? OK_P_ : OV_P_) + (size_t)l * 32768 * 1024 + (size_t)(u.pm * BM) * 1024 : (seg == 1 ? OK_S_ : OV_S_) + (size_t)l * 512 * 1024 + (size_t)((u.pm - 128) * BM) * 1024;
            F32 = out + ob + (size_t)(wr * 64 + fr) * 1024 + cb; }
        else if (seg == 4) F32 = (float*)(ws + O_LOGF) + (size_t)row0 * 1024 + cb;
        const float* const lb = (const float*)(ws + O_LB) + l * 1024 + cb;
        const float sc = seg == 0 ? qscale : 1.f;
#pragma unroll
        for (int bj = 0; bj < 2; ++bj) {
            f32x4 l0 = {0.f, 0.f, 0.f, 0.f}, l1 = l0; if (seg == 4) { l0 = *(const f32x4*)(lb + bj * HALF); l1 = *(const f32x4*)(lb + bj * HALF + 4); }
#pragma unroll
            for (int ai = 0; ai < 2; ++ai)
#pragma unroll
                for (int m = 0; m < 4; ++m) { const size_t off = (size_t)(ai * HALF + m * 16) * 1024 + bj * HALF;
                    f32x4 a = acc[ai][bj][m][0], b = acc[ai][bj][m][1];
                    if (seg == 4) { f32x4 fa, fb;
#pragma unroll
                        for (int i = 0; i < 4; ++i) {
                            { const float x = a[i], lbv = l0[i], e = __expf(-__builtin_fabsf(x)), r = __builtin_amdgcn_rcpf(1.f + e), er = e * r, sig = x >= 0.f ? r : er, om = x >= 0.f ? er : r;
                              fa[i] = __logf(__builtin_fmaxf(lbv + (1.f - lbv) * sig, 1e-30f)); a[i] = (1.f - lbv) * om; }
                            { const float x = b[i], lbv = l1[i], e = __expf(-__builtin_fabsf(x)), r = __builtin_amdgcn_rcpf(1.f + e), er = e * r, sig = x >= 0.f ? r : er, om = x >= 0.f ? er : r;
                              fb[i] = __logf(__builtin_fmaxf(lbv + (1.f - lbv) * sig, 1e-30f)); b[i] = (1.f - lbv) * om; } }
                        *(f32x4*)(F32 + off) = fa; *(f32x4*)(F32 + off + 4) = fb;
                    } else if (seg == 3 || seg == 6) {
#pragma unroll
                        for (int i = 0; i < 4; ++i) { a[i] = silu_f(a[i]); b[i] = silu_f(b[i]); }
                    } else if (seg >= 7) {
#pragma unroll
                        for (int i = 0; i < 4; ++i) { a[i] = sigmoid_f(a[i]); b[i] = sigmoid_f(b[i]); }
                    } else {
                        if (seg == 1 || seg == 2) { *(f32x4*)(F32 + off) = a; *(f32x4*)(F32 + off + 4) = b; }
                        a = a * sc; b = b * sc;
                    }
                    store8bf(O + off, a, b); asm volatile("" ::: "memory"); }
        }
    }
};

struct EpiGateT {
    static constexpr bool PERM = true, AFTER_DRAIN = false;
    float* T; const bf16_t* G;
    __device__ __forceinline__ void operator()(const f32x4 (&acc)[2][2][4][2], const Unit& u, int wr, int wc, int fr, int fq) const {
        const size_t base = (size_t)(u.pm * BM + wr * 64 + fr) * 1024 + u.pn * BM + wc * 32 + 8 * fq;
        u32x4 gc[2], gn[2];
#pragma unroll
        for (int bj = 0; bj < 2; ++bj) gc[bj] = *(const u32x4*)(G + base + bj * HALF);
#pragma unroll
        for (int g = 0; g < 8; ++g) { const int ai = g >> 2, m = g & 3; const size_t off = base + (size_t)(ai * HALF + m * 16) * 1024;
            if (g + 1 < 8) { const size_t offn = base + (size_t)(((g + 1) >> 2) * HALF + ((g + 1) & 3) * 16) * 1024;
#pragma unroll
                for (int bj = 0; bj < 2; ++bj) gn[bj] = *(const u32x4*)(G + offn + bj * HALF); }
#pragma unroll
            for (int bj = 0; bj < 2; ++bj) { const u32x4 gg = gc[bj];
                const f32x4 g0 = {bf_lo(gg.x), bf_hi(gg.x), bf_lo(gg.y), bf_hi(gg.y)}, g1 = {bf_lo(gg.z), bf_hi(gg.z), bf_lo(gg.w), bf_hi(gg.w)};
                *(f32x4*)(T + off + bj * HALF) = g0 * acc[ai][bj][m][0]; *(f32x4*)(T + off + bj * HALF + 4) = g1 * acc[ai][bj][m][1]; }
            asm volatile("" ::: "memory");
#pragma unroll
            for (int bj = 0; bj < 2; ++bj) gc[bj] = gn[bj]; }
    }
};
struct EpiGateM {
    static constexpr bool PERM = true, AFTER_DRAIN = false;
    const float* T; const bf16_t* G; bf16_t* O;
    __device__ __forceinline__ void operator()(const f32x4 (&acc)[2][2][4][2], const Unit& u, int wr, int wc, int fr, int fq) const {
        const size_t base = (size_t)(u.pm * BM + wr * 64 + fr) * 1024 + u.pn * BM + wc * 32 + 8 * fq;
        u32x4 gc[2], gn[2]; f32x4 tc[2][2], tn[2][2];
#pragma unroll
        for (int bj = 0; bj < 2; ++bj) { gc[bj] = *(const u32x4*)(G + base + bj * HALF); tc[bj][0] = *(const f32x4*)(T + base + bj * HALF); tc[bj][1] = *(const f32x4*)(T + base + bj * HALF + 4); }
#pragma unroll
        for (int g = 0; g < 8; ++g) { const int ai = g >> 2, m = g & 3; const size_t off = base + (size_t)(ai * HALF + m * 16) * 1024;
            if (g + 1 < 8) { const size_t offn = base + (size_t)(((g + 1) >> 2) * HALF + ((g + 1) & 3) * 16) * 1024;
#pragma unroll
                for (int bj = 0; bj < 2; ++bj) { gn[bj] = *(const u32x4*)(G + offn + bj * HALF); tn[bj][0] = *(const f32x4*)(T + offn + bj * HALF); tn[bj][1] = *(const f32x4*)(T + offn + bj * HALF + 4); } }
#pragma unroll
            for (int bj = 0; bj < 2; ++bj) { const u32x4 gg = gc[bj];
                const f32x4 g0 = {bf_lo(gg.x), bf_hi(gg.x), bf_lo(gg.y), bf_hi(gg.y)}, g1 = {bf_lo(gg.z), bf_hi(gg.z), bf_lo(gg.w), bf_hi(gg.w)};
                store8bf(O + off + bj * HALF, tc[bj][0] + g0 * acc[ai][bj][m][0], tc[bj][1] + g1 * acc[ai][bj][m][1]); }
            asm volatile("" ::: "memory");
#pragma unroll
            for (int bj = 0; bj < 2; ++bj) { gc[bj] = gn[bj]; tc[bj][0] = tn[bj][0]; tc[bj][1] = tn[bj][1]; } }
    }
};

struct EpiNull {
    static constexpr bool PERM = true, AFTER_DRAIN = false; float* sink;
    __device__ __forceinline__ void operator()(const f32x4 (&acc)[2][2][4][2], const Unit& u, int wr, int wc, int fr, int fq) const { f32x4 s = {0.f, 0.f, 0.f, 0.f};
#pragma unroll
        for (int a = 0; a < 2; ++a)
#pragma unroll
            for (int b = 0; b < 2; ++b)
#pragma unroll
                for (int m = 0; m < 4; ++m)
#pragma unroll
                    for (int n = 0; n < 2; ++n) s = s + acc[a][b][m][n];
        if (sink) sink[0] = s[0] + s[1] + s[2] + s[3]; (void)u; (void)wr; (void)wc; (void)fr; (void)fq; }
};

template <int NM, int NN, int GM> struct FixedOrder {
    static_assert(NM % GM == 0, "GM divides NM");
    int G, c;
    __device__ __forceinline__ void init(int G_, int c_) { G = G_; c = c_; }
    __device__ __forceinline__ bool next(int i, Unit& u) const {
        constexpr int nwg = NM * NN, q = nwg / NXCD, r = nwg % NXCD, nig = GM * NN;
        const int L = i * G + c; if (L >= nwg) return false;
        const int xcd = L % NXCD, off = L / NXCD; const int wgid = (xcd < r ? xcd * (q + 1) : r * (q + 1) + (xcd - r) * q) + off;
        const int gid = wgid / nig, w = wgid % nig; u.pm = gid * GM + (w % GM); u.pn = w / GM; return true;
    }
    __device__ __forceinline__ void a_ready(const Unit&) const {}
    __device__ __forceinline__ void done(const Unit&) const {}
};

template <int NN> struct TeamOrder {
    int T, r;
    __device__ __forceinline__ void init(int T_, int r_) { T = T_; r = r_; }
    __device__ __forceinline__ bool next(int i, Unit& u) const { const int L = i * T + r; if (L >= 2 * NN) return false; u.pm = 128 + L / NN; u.pn = L % NN; return true; }
    __device__ __forceinline__ void a_ready(const Unit&) const {}
    __device__ __forceinline__ void done(const Unit&) const {}
};
template <class Epi, class Sched, bool ALIGN_EPI = false, bool SP2 = false>
__device__ __forceinline__ void gemm_phase(PG8_LAS unsigned char* lds, const Gemm g, const Sched& S, const Epi& E) {
    const int tid = opaque_tid(), wid = __builtin_amdgcn_readfirstlane(tid >> 6), lane = tid & 63, wr = wid >> 2, wc = wid & 3, fr = lane & 15, fq = lane >> 4;
    const int K = g.K, nt = K / BK;
    unsigned voffA[2], voffB[2];
#pragma unroll
    for (int i = 0; i < 2; ++i) { int R, C; stage_rc(tid * 16 + i * 8192, R, C); const int Rb = Epi::PERM ? ((R & ~31) + perm32(R & 31)) : R;
        voffA[i] = (unsigned)(R * K + C) * 2u; voffB[i] = (unsigned)(Rb * K + C) * 2u; }
    const size_t kstep = (size_t)(BK * 2);
    const size_t hstep = (size_t)HALF * K * 2;
    const size_t tstep = 2 * hstep;
    const unsigned ldsw = (unsigned)wid * 1024u;
    const int aoff = lds_byte(wr * 64 + fr, fq * 8), boff = lds_byte(wc * 32 + fr, fq * 8);
#define PG8_SA(b, h) (((b) * 2 + (h)) * HTB)
#define PG8_SB(b, h) ((4 + (b) * 2 + (h)) * HTB)
#define PG8_STAGE(bufoff, gbase, voff) do { _Pragma("unroll") for (int _i = 0; _i < 2; ++_i) \
        __builtin_amdgcn_global_load_lds((const unsigned*)((const char*)(gbase) + (voff)[_i]), (PG8_LAS unsigned*)(lds + (bufoff) + ldsw + _i * 8192), 16, 0, 0); } while (0)
#define PG8_LDA(dst, b, h) do { _Pragma("unroll") for (int m = 0; m < 4; ++m) _Pragma("unroll") for (int k = 0; k < 2; ++k) dst[m][k] = *(const PG8_LAS bf16x8*)(lds + PG8_SA(b, h) + aoff + m * 2048 + k * 1024); } while (0)
#define PG8_LDB(dst, b, h) do { _Pragma("unroll") for (int n = 0; n < 2; ++n) _Pragma("unroll") for (int k = 0; k < 2; ++k) dst[n][k] = *(const PG8_LAS bf16x8*)(lds + PG8_SB(b, h) + boff + n * 2048 + k * 1024); } while (0)
#define PG8_MMA(ai, bj, At, Bt) do { __builtin_amdgcn_s_setprio(1); _Pragma("unroll") for (int m = 0; m < 4; ++m) _Pragma("unroll") for (int n = 0; n < 2; ++n) _Pragma("unroll") for (int k = 0; k < 2; ++k) \
        acc[ai][bj][m][n] = __builtin_amdgcn_mfma_f32_16x16x32_bf16(Bt[n][k], At[m][k], acc[ai][bj][m][n], 0, 0, 0); __builtin_amdgcn_s_setprio(0); } while (0)
#define PG8_WAIT_V(n) asm volatile("s_waitcnt vmcnt(" #n ")" ::: "memory")
#define PG8_WAIT_L(n) asm volatile("s_waitcnt lgkmcnt(" #n ")" ::: "memory")
#define PG8_BAR __builtin_amdgcn_s_barrier()
#define PG8_SCHED __builtin_amdgcn_sched_barrier(0)
    Unit cur, nxt; int ui = 0;
    if (!S.next(0, cur)) return;
    f32x4 acc[2][2][4][2];
#pragma unroll
    for (int a = 0; a < 2; ++a)
#pragma unroll
        for (int b = 0; b < 2; ++b)
#pragma unroll
            for (int m = 0; m < 4; ++m)
#pragma unroll
                for (int n = 0; n < 2; ++n) acc[a][b][m][n] = (f32x4){0.f, 0.f, 0.f, 0.f};
    bf16x8 At[4][2], B0[2][2], B1[2][2];
    const char* cA = (const char*)g.A + (size_t)cur.pm * tstep; const char* cB = (const char*)g.Bt + (size_t)cur.pn * tstep;
    S.a_ready(cur);
    if constexpr (SP2) {
        PG8_STAGE(PG8_SB(0, 0), cB, voffB); PG8_STAGE(PG8_SB(0, 1), cB + hstep, voffB); PG8_STAGE(PG8_SA(0, 0), cA, voffA); PG8_STAGE(PG8_SA(0, 1), cA + hstep, voffA);
        if (wr == 1) PG8_BAR;
        PG8_WAIT_V(2); PG8_BAR;
        PG8_STAGE(PG8_SB(1, 0), cB + kstep, voffB); PG8_STAGE(PG8_SA(1, 0), cA + kstep, voffA); PG8_STAGE(PG8_SB(1, 1), cB + hstep + kstep, voffB);
        PG8_WAIT_V(6); PG8_BAR;
    } else {
        PG8_STAGE(PG8_SB(0, 0), cB, voffB); PG8_STAGE(PG8_SA(0, 0), cA, voffA); PG8_STAGE(PG8_SB(0, 1), cB + hstep, voffB); PG8_STAGE(PG8_SA(0, 1), cA + hstep, voffA);
        if (wr == 1) PG8_BAR;
        PG8_WAIT_V(4); PG8_BAR;
        PG8_STAGE(PG8_SB(1, 0), cB + kstep, voffB); PG8_STAGE(PG8_SA(1, 0), cA + kstep, voffA); PG8_STAGE(PG8_SB(1, 1), cB + hstep + kstep, voffB);
        PG8_WAIT_V(6); PG8_BAR;
    }
    for (;;) {
        const bool has_next = S.next(ui + 1, nxt);
        const char* nA = has_next ? (const char*)g.A + (size_t)nxt.pm * tstep : cA; const char* nB = has_next ? (const char*)g.Bt + (size_t)nxt.pn * tstep : cB;
        for (int t = 0; t < nt; t += 2) {
            const bool last = (t == nt - 2);
            const char* a1 = cA + (size_t)(t + 1) * kstep;
            const char* a2 = last ? nA : cA + (size_t)(t + 2) * kstep; const char* b2 = last ? nB : cB + (size_t)(t + 2) * kstep;
            const char* a3 = a2 + kstep; const char* b3 = b2 + kstep;
            if (last && has_next) S.a_ready(nxt);
            if constexpr (SP2) {
            PG8_LDB(B0, 0, 0); PG8_LDB(B1, 0, 1); PG8_SCHED; PG8_LDA(At, 0, 0); PG8_STAGE(PG8_SA(1, 1), a1 + hstep, voffA);
            PG8_WAIT_V(8); PG8_WAIT_L(0); PG8_BAR; PG8_MMA(0, 0, At, B0); PG8_MMA(0, 1, At, B1); PG8_BAR; PG8_SCHED;
            PG8_LDA(At, 0, 1); PG8_STAGE(PG8_SB(0, 0), b2, voffB); PG8_STAGE(PG8_SB(0, 1), b2 + hstep, voffB); PG8_STAGE(PG8_SA(0, 0), a2, voffA);
            PG8_WAIT_V(8); PG8_WAIT_L(0); PG8_BAR; PG8_MMA(1, 0, At, B0); PG8_MMA(1, 1, At, B1); PG8_BAR; PG8_SCHED;
            PG8_LDB(B0, 1, 0); PG8_LDB(B1, 1, 1); PG8_SCHED; PG8_LDA(At, 1, 0); PG8_STAGE(PG8_SA(0, 1), a2 + hstep, voffA);
            PG8_WAIT_V(8); PG8_WAIT_L(0); PG8_BAR; PG8_MMA(0, 0, At, B0); PG8_MMA(0, 1, At, B1); PG8_BAR; PG8_SCHED;
            PG8_LDA(At, 1, 1); PG8_STAGE(PG8_SB(1, 0), b3, voffB); PG8_STAGE(PG8_SB(1, 1), b3 + hstep, voffB); PG8_STAGE(PG8_SA(1, 0), a3, voffA);
            PG8_WAIT_V(8); PG8_WAIT_L(0); PG8_BAR; PG8_MMA(1, 0, At, B0); PG8_MMA(1, 1, At, B1); PG8_BAR; PG8_SCHED;
            } else {
            PG8_LDB(B0, 0, 0); PG8_SCHED; PG8_LDA(At, 0, 0); PG8_STAGE(PG8_SA(1, 1), a1 + hstep, voffA);
            PG8_WAIT_L(8); PG8_BAR; PG8_WAIT_L(0); PG8_MMA(0, 0, At, B0); PG8_BAR; PG8_SCHED;
            PG8_LDB(B1, 0, 1); PG8_STAGE(PG8_SB(0, 0), b2, voffB);
            PG8_BAR; PG8_WAIT_L(0); PG8_MMA(0, 1, At, B1); PG8_BAR;
            PG8_LDA(At, 0, 1); PG8_STAGE(PG8_SA(0, 0), a2, voffA);
            PG8_BAR; PG8_WAIT_L(0); PG8_MMA(1, 0, At, B0); PG8_BAR; PG8_SCHED;
            PG8_STAGE(PG8_SB(0, 1), b2 + hstep, voffB);
            PG8_WAIT_V(6); PG8_BAR; PG8_MMA(1, 1, At, B1); PG8_BAR;
            PG8_LDB(B0, 1, 0); PG8_SCHED; PG8_LDA(At, 1, 0); PG8_STAGE(PG8_SA(0, 1), a2 + hstep, voffA);
            PG8_WAIT_L(8); PG8_BAR; PG8_WAIT_L(0); PG8_MMA(0, 0, At, B0); PG8_BAR; PG8_SCHED;
            PG8_LDB(B1, 1, 1); PG8_STAGE(PG8_SB(1, 0), b3, voffB);
            PG8_BAR; PG8_WAIT_L(0); PG8_MMA(0, 1, At, B1); PG8_BAR;
            PG8_LDA(At, 1, 1); PG8_STAGE(PG8_SA(1, 0), a3, voffA);
            PG8_BAR; PG8_WAIT_L(0); PG8_MMA(1, 0, At, B0); PG8_BAR; PG8_SCHED;
            PG8_STAGE(PG8_SB(1, 1), b3 + hstep, voffB);
            PG8_WAIT_V(6); PG8_BAR; PG8_MMA(1, 1, At, B1); PG8_BAR;
            }
        }
        if constexpr (ALIGN_EPI) { if (wr == 0) PG8_BAR; }
        if constexpr (!Epi::AFTER_DRAIN) { E(acc, cur, wr, wc, fr, fq); S.done(cur); }
        if (!has_next) break;
#pragma unroll
        for (int a = 0; a < 2; ++a)
#pragma unroll
            for (int b = 0; b < 2; ++b)
#pragma unroll
                for (int m = 0; m < 4; ++m)
#pragma unroll
                    for (int n = 0; n < 2; ++n) acc[a][b][m][n] = (f32x4){0.f, 0.f, 0.f, 0.f};
        cur = nxt; cA = nA; cB = nB; ++ui;
        if constexpr (ALIGN_EPI) { if (wr == 1) PG8_BAR; }
    }
    PG8_WAIT_V(0);
    if constexpr (!ALIGN_EPI) { if (wr == 0) PG8_BAR; }
    PG8_BAR;
    if constexpr (Epi::AFTER_DRAIN) { E.fused(acc, cur, wr, wc, fr, fq, lds, wid, lane); S.done(cur); }
#undef PG8_SA
#undef PG8_SB
#undef PG8_STAGE
#undef PG8_LDA
#undef PG8_LDB
#undef PG8_MMA
#undef PG8_WAIT_V
#undef PG8_WAIT_L
#undef PG8_BAR
#undef PG8_SCHED
}
}
namespace attn_body {
using bf16=__hip_bfloat16;
using bf16x8=__attribute__((ext_vector_type(8)))short;
using s16x4=__attribute__((ext_vector_type(4)))short;
using f32x16=__attribute__((ext_vector_type(16)))float;
using u32x4=__attribute__((ext_vector_type(4)))unsigned;
constexpr int BATCH=4,NHEAD=16,SEQ=8192,D=64,DM=NHEAD*D;
constexpr int NW=8,QBLK=32,QB=QBLK*NW,KVBLK=64,NQB=SEQ/QB;
constexpr int ATTN_PITCH=DM, ATTN_UNIT_ROWS=QB;
__device__ __forceinline__ int crow(int r,int hi){return (r&3)+8*(r>>2)+4*hi;}
#define SBAR() __builtin_amdgcn_sched_barrier(0)
__device__ __forceinline__ void cmask(f32x16&p0,f32x16&p1,int jb,int qrel,int hi){
  const float NEG=-INFINITY; (void)hi;
  if(jb>(qrel>>6)){
  #pragma unroll
  for(int r=0;r<16;++r){p0[r]=NEG;p1[r]=NEG;} }
}

constexpr int NSLOT=3, SLOTB=8192;
constexpr int LDS_K=0, LDS_V=NSLOT*SLOTB, LDS_WS=2*NSLOT*SLOTB, LDS_OST=LDS_WS+NW*64*4, LDS_BYTES=LDS_OST+NW*4096;
constexpr float C2=0.125f*1.4426950408889634f;
__device__ __forceinline__ void glds16(const void*gsrc,unsigned lds_dst){unsigned keep;
  asm volatile("s_mov_b32 %0, m0\n\ts_mov_b32 m0, %2\n\ts_nop 0\n\tglobal_load_lds_dwordx4 %1, off\n\ts_mov_b32 m0, %0":"=&s"(keep):"v"(gsrc),"s"(lds_dst):"memory");}
__device__ __forceinline__ float max3f(float a,float b,float c){float r;asm("v_max3_f32 %0, %1, %2, %3":"=v"(r):"v"(a),"v"(b),"v"(c));return r;}
__device__ __forceinline__ float max2f(float a,float b){float r;asm("v_max_f32_e32 %0, %1, %2":"=v"(r):"v"(a),"v"(b));return r;}
__device__ __forceinline__ float fadd_s(float a,float b){float r;asm("v_add_f32_e32 %0, %1, %2":"=v"(r):"v"(a),"v"(b));return r;}
__device__ __forceinline__ float fsub_s(float a,float b){float r;asm("v_sub_f32_e32 %0, %1, %2":"=v"(r):"v"(a),"v"(b));return r;}
typedef float f32x2_t __attribute__((ext_vector_type(2))); typedef __bf16 bf16x2_t __attribute__((ext_vector_type(2)));
__device__ __forceinline__ unsigned cvtpk_s(float lo,float hi){f32x2_t v={lo,hi};bf16x2_t b=__builtin_convertvector(v,bf16x2_t);return __builtin_bit_cast(unsigned,b);}
#define WAIT_BAR(N) asm volatile("s_waitcnt vmcnt(" #N ") lgkmcnt(0)\n\ts_barrier":::"memory")

__device__ __forceinline__ void qkt(f32x16&p0,f32x16&p1,const char*Kslot,const bf16x8*qr,const f32x16&negm,int r32,int hi){
  const char*kb=Kslot+hi*1024+r32*16;
  #pragma unroll
  for(int d0=0;d0<4;++d0){
    const bf16x8 b0=*reinterpret_cast<const bf16x8*>(kb+d0*2048);
    const bf16x8 b1=*reinterpret_cast<const bf16x8*>(kb+d0*2048+512);
    if(d0==0){p0=__builtin_amdgcn_mfma_f32_32x32x16_bf16(b0,qr[0],negm,0,0,0);p1=__builtin_amdgcn_mfma_f32_32x32x16_bf16(b1,qr[0],negm,0,0,0);}
    else{p0=__builtin_amdgcn_mfma_f32_32x32x16_bf16(b0,qr[d0],p0,0,0,0);p1=__builtin_amdgcn_mfma_f32_32x32x16_bf16(b1,qr[d0],p1,0,0,0);}}
}
typedef __attribute__((address_space(3))) const char* lds_cptr;
typedef short v4i16_t __attribute__((ext_vector_type(4)));
__device__ __forceinline__ void kload8(bf16x8*kf,lds_cptr kp){
  kf[0]=*(const __attribute__((address_space(3))) bf16x8*)(kp);      kf[1]=*(const __attribute__((address_space(3))) bf16x8*)(kp+512);
  kf[2]=*(const __attribute__((address_space(3))) bf16x8*)(kp+2048); kf[3]=*(const __attribute__((address_space(3))) bf16x8*)(kp+2560);
  kf[4]=*(const __attribute__((address_space(3))) bf16x8*)(kp+4096); kf[5]=*(const __attribute__((address_space(3))) bf16x8*)(kp+4608);
  kf[6]=*(const __attribute__((address_space(3))) bf16x8*)(kp+6144); kf[7]=*(const __attribute__((address_space(3))) bf16x8*)(kp+6656);
}
__device__ __forceinline__ void kload2(bf16x8*kf,lds_cptr kp,int j){ kf[2*j]=*(const __attribute__((address_space(3))) bf16x8*)(kp+j*2048); kf[2*j+1]=*(const __attribute__((address_space(3))) bf16x8*)(kp+j*2048+512); }
__device__ __forceinline__ s16x4 vtr(lds_cptr p){ return __builtin_bit_cast(s16x4,__builtin_amdgcn_ds_read_tr16_b64_v4i16((__attribute__((address_space(3))) v4i16_t*)p)); }
__device__ __forceinline__ float rowmax(const f32x16&p0,const f32x16&p1){
  float a=max3f(p0[0],p0[1],p1[0]),b=max3f(p0[2],p0[3],p1[1]);a=max3f(a,p1[2],p1[3]);
  #pragma unroll
  for(int r=4;r<16;r+=4){a=max3f(a,p0[r],p0[r+1]);b=max3f(b,p0[r+2],p0[r+3]);a=max3f(a,p1[r],p1[r+1]);b=max3f(b,p1[r+2],p1[r+3]);}
  const float m=max2f(a,b);
  auto rr=__builtin_amdgcn_permlane32_swap(__float_as_uint(m),__float_as_uint(m),false,false);
  return max2f(__uint_as_float(rr[0]),__uint_as_float(rr[1]));
}
__device__ __forceinline__ void pv(f32x16*o,int vb,bf16x8 pa0,bf16x8 pa1,bf16x8 pa2,bf16x8 pa3){
  #pragma unroll
  for(int d0=0;d0<2;++d0){s16x4 lo[4],hi[4];
    #pragma unroll
    for(int ks=0;ks<4;++ks){
      asm volatile("ds_read_b64_tr_b16 %0,%1 offset:%c2":"=&v"(lo[ks]):"v"(vb),"i"(d0*4096+ks*1024):"memory");
      asm volatile("ds_read_b64_tr_b16 %0,%1 offset:%c2":"=&v"(hi[ks]):"v"(vb),"i"(d0*4096+ks*1024+512):"memory");}
    asm volatile("s_waitcnt lgkmcnt(0)":::"memory");SBAR();
    #define PK(k) (bf16x8){lo[k][0],lo[k][1],lo[k][2],lo[k][3],hi[k][0],hi[k][1],hi[k][2],hi[k][3]}
    o[d0]=__builtin_amdgcn_mfma_f32_32x32x16_bf16(pa0,PK(0),o[d0],0,0,0);
    o[d0]=__builtin_amdgcn_mfma_f32_32x32x16_bf16(pa1,PK(1),o[d0],0,0,0);
    o[d0]=__builtin_amdgcn_mfma_f32_32x32x16_bf16(pa2,PK(2),o[d0],0,0,0);
    o[d0]=__builtin_amdgcn_mfma_f32_32x32x16_bf16(pa3,PK(3),o[d0],0,0,0);
    #undef PK
  }
}

#ifndef ATTN_STORE16
#define ATTN_STORE16(p,v) (*(u32x4*)(p)=(v))
#endif
template<int THRL> __device__ __forceinline__ void attn_unit(int b,int hq,int hv,int qb,const bf16*Q,const bf16*__restrict__ K,const bf16*__restrict__ V,bf16*O,char*shm){
  const int tid=opaque_tid(),lane=tid&63,r32=lane&31,hi=lane>>5; const int wid=__builtin_amdgcn_readfirstlane(tid>>6);
  const long rowbase=(long)b*SEQ; const int q0=qb*QB;
  const bf16*Qw=Q+(rowbase+q0+wid*QBLK)*DM+hq*D;
  const bf16*Kh=K+rowbase*DM+hq*D,*Vh=V+rowbase*DM+hv*D;
  const unsigned lds0=(unsigned)(uintptr_t)shm;
  float*wsf=(float*)(shm+LDS_WS)+wid*64;
  const bf16*ksrc=Kh+(long)lane*DM+wid*8;
  const bf16*vsrc=Vh+(long)(16*(wid&3)+(lane>>2))*DM+(wid>>2)*32+(lane&3)*8;
  const unsigned kdst=lds0+LDS_K+wid*1024, vdst=lds0+LDS_V+wid*1024;
  #define DMA_K(t,slot) glds16(ksrc+(long)(t)*KVBLK*DM,(unsigned)__builtin_amdgcn_readfirstlane(kdst+(slot)))
  #define DMA_V(t,slot) glds16(vsrc+(long)(t)*KVBLK*DM,(unsigned)__builtin_amdgcn_readfirstlane(vdst+(slot)))
  const int vb0=(int)(lds0+LDS_V)+((lane>>4)&1)*32+(lane&3)*8+(4*hi+((lane&15)>>2))*64;
  const char*Kbase=shm+LDS_K; bf16x8 kf[8];
  const lds_cptr shm3=(lds_cptr)shm; const lds_cptr kp0=shm3+LDS_K+hi*1024+r32*16; const lds_cptr vp0=shm3+LDS_V+((lane>>4)&1)*32+(lane&3)*8+(4*hi+((lane&15)>>2))*64;
  const int NT=(q0+QB)/KVBLK;
  DMA_K(0,0);DMA_V(0,0);DMA_K(1,SLOTB);
  bf16x8 qr[4];
  #pragma unroll
  for(int d0=0;d0<4;++d0)qr[d0]=*reinterpret_cast<const bf16x8*>(&Qw[(long)r32*DM+d0*16+hi*8]);
  float mhat=0.f,l_reg=0.f;f32x16 o[2];o[0]=f32x16{};o[1]=f32x16{};f32x16 negm=f32x16{};asm volatile("":"+v"(negm));
  const int qrel=wid*QBLK+r32;
  #define CMASK(P0,P1,t) do{int jb_=(t)-(NT-4); if(jb_>=0)cmask(P0,P1,jb_,qrel,hi);}while(0)
  bool resc=false;
  #define START(P0,P1) do{ const float rm=rowmax(P0,P1); resc=false; \
    { const float dl=rm; mhat=fadd_s(mhat,dl); \
      _Pragma("unroll") for(int r=0;r<16;++r){P0[r]=fsub_s(P0[r],dl);P1[r]=fsub_s(P1[r],dl);} \
      _Pragma("unroll") for(int r=0;r<16;++r)negm[r]=-mhat; asm volatile("":"+v"(negm)); } \
    _Pragma("unroll") for(int r=0;r<16;++r)P0[r]=__builtin_amdgcn_exp2f(P0[r]); }while(0)
  #define RESC() do{ if(resc){ asm volatile("s_waitcnt lgkmcnt(0)":::"memory"); \
      _Pragma("unroll") for(int d_=0;d_<2;++d_) _Pragma("unroll") for(int r=0;r<16;++r)o[d_][r]*=wsf[crow(r,hi)]; } }while(0)
  f32x16 pA0,pA1,pB0,pB1;
  int sl_prev=0,sl_cur=0,sl_next=SLOTB;
  #define ROT() do{sl_prev=sl_cur;sl_cur=sl_next;sl_next=(sl_next==(NSLOT-1)*SLOTB)?0:sl_next+SLOTB;}while(0)
  DMA_K(2,2*SLOTB);
  WAIT_BAR(3);
  qkt(pA0,pA1,Kbase,qr,negm,r32,hi);asm volatile("s_nop 15\n\ts_nop 7":"+v"(pA0),"+v"(pA1));CMASK(pA0,pA1,0);
  START(pA0,pA1);
  _Pragma("unroll") for(int r=0;r<16;++r)pA1[r]=__builtin_amdgcn_exp2f(pA1[r]);
  WAIT_BAR(0);
  DMA_K(3,0);DMA_V(1,SLOTB);
  ROT();
  kload8(kf,kp0+sl_cur);
  WAIT_BAR(2);
  s16x4 vlo[8],vhi[8]; u32x4 pw0,pw1,pw2,pw3;
  #define PKW(P,B) cvtpk_s(P[B],P[B+1])
  #define PAF(k) __builtin_bit_cast(bf16x8,pw##k)
  #define VFR(i) (bf16x8){vlo[i][0],vlo[i][1],vlo[i][2],vlo[i][3],vhi[i][0],vhi[i][1],vhi[i][2],vhi[i][3]}
  #define PIN(x) asm volatile("":"+v"(x))
  #define MX3(a,b,c) __builtin_fmaxf(__builtin_fmaxf((a),(b)),(c))
  #define GAPA(MF,A0,A1,A2,A3,W0,W1,PW) do{ MF; sacc+=A0; sacc+=A1; sacc+=A2; sacc+=A3; PIN(sacc); W0; W1; PIN(PW); SBAR(); }while(0)
  #define EX(v) __builtin_amdgcn_exp2f(v)
  #define GAPB(MF,X,B) do{ MF; X[B]=EX(X[B]); X[B+1]=EX(X[B+1]); X[B+2]=EX(X[B+2]); X[B+3]=EX(X[B+3]); PIN(X); SBAR(); }while(0)
  #define VRD(i) do{ vlo[i]=vtr(vp_+(((i)>>2)*4096+((i)&3)*1024)); vhi[i]=vtr(vp_+(((i)>>2)*4096+((i)&3)*1024+512)); }while(0)
  #define KRD(G,j) do{ if(G){ kload2(kf,kp0+sl_next,j); SBAR(); } }while(0)
  #define STEP(C0,C1,P0,P1,t,GK,GV,GL) do{ SBAR(); \
    const lds_cptr vp_=vp0+sl_prev; \
    VRD(0); SBAR(); float sacc=(P0[0]+P0[1]); \
    GAPA(C0=__builtin_amdgcn_mfma_f32_32x32x16_bf16(kf[0],qr[0],negm,0,0,0), P0[2],P0[3],P0[4],P0[5],     pw0[0]=PKW(P0,0), pw0[1]=PKW(P0,2), pw0); \
    VRD(4); SBAR(); GAPA(C1=__builtin_amdgcn_mfma_f32_32x32x16_bf16(kf[1],qr[0],negm,0,0,0), P0[6],P0[7],P0[8],P0[9],     pw0[2]=PKW(P0,4), pw0[3]=PKW(P0,6), pw0); \
    VRD(1); SBAR(); GAPA(C0=__builtin_amdgcn_mfma_f32_32x32x16_bf16(kf[2],qr[1],C0,0,0,0),   P0[10],P0[11],P0[12],P0[13], pw1[0]=PKW(P0,8), pw1[1]=PKW(P0,10), pw1); \
    VRD(5); SBAR(); GAPA(C1=__builtin_amdgcn_mfma_f32_32x32x16_bf16(kf[3],qr[1],C1,0,0,0),   P0[14],P0[15],P1[0],P1[1],   pw1[2]=PKW(P0,12),pw1[3]=PKW(P0,14), pw1); \
    VRD(2); SBAR(); GAPA(C0=__builtin_amdgcn_mfma_f32_32x32x16_bf16(kf[4],qr[2],C0,0,0,0),   P1[2],P1[3],P1[4],P1[5],     pw2[0]=PKW(P1,0), pw2[1]=PKW(P1,2), pw2); \
    VRD(6); SBAR(); GAPA(C1=__builtin_amdgcn_mfma_f32_32x32x16_bf16(kf[5],qr[2],C1,0,0,0),   P1[6],P1[7],P1[8],P1[9],     pw2[2]=PKW(P1,4), pw2[3]=PKW(P1,6), pw2); \
    VRD(3); SBAR(); GAPA(C0=__builtin_amdgcn_mfma_f32_32x32x16_bf16(kf[6],qr[3],C0,0,0,0),   P1[10],P1[11],P1[12],P1[13], pw3[0]=PKW(P1,8), pw3[1]=PKW(P1,10), pw3); \
    VRD(7); SBAR(); GAPA(C1=__builtin_amdgcn_mfma_f32_32x32x16_bf16(kf[7],qr[3],C1,0,0,0),   P1[14],P1[15],0.f,0.f,       pw3[2]=PKW(P1,12),pw3[3]=PKW(P1,14), pw3); \
    l_reg+=sacc; \
    if(GK){DMA_K((t)+3,sl_cur);} if(GV){DMA_V((t)+1,sl_next);} \
    CMASK(C0,C1,t); \
    { float a=MX3(C0[0],C0[1],C1[0]),b=MX3(C0[2],C0[3],C1[1]); a=MX3(a,C1[2],C1[3]); \
      _Pragma("unroll") for(int r=4;r<16;r+=4){a=MX3(a,C0[r],C0[r+1]);b=MX3(b,C0[r+2],C0[r+3]);a=MX3(a,C1[r],C1[r+1]);b=MX3(b,C1[r+2],C1[r+3]);} \
      float rm=__builtin_fmaxf(a,b); { auto rr=__builtin_amdgcn_permlane32_swap(__float_as_uint(rm),__float_as_uint(rm),false,false); rm=__builtin_fmaxf(__uint_as_float(rr[0]),__uint_as_float(rr[1])); } \
      resc=false; \
      if(__builtin_expect(__any(rm>(float)THRL),0)){ const float dl=__builtin_fmaxf(rm,0.f); mhat+=dl; \
        _Pragma("unroll") for(int r=0;r<16;++r){C0[r]-=dl;C1[r]-=dl;} \
        _Pragma("unroll") for(int r=0;r<16;++r)negm[r]=-mhat; asm volatile("":"+v"(negm)); \
        const float f=__builtin_amdgcn_exp2f(-dl); l_reg*=f; if(hi==0)wsf[r32]=f; resc=true; } } \
    SBAR(); \
    GAPB(o[0]=__builtin_amdgcn_mfma_f32_32x32x16_bf16(PAF(0),VFR(0),o[0],0,0,0), C0,0); \
    GAPB(o[1]=__builtin_amdgcn_mfma_f32_32x32x16_bf16(PAF(0),VFR(4),o[1],0,0,0), C0,4); \
    KRD(GL,0); GAPB(o[0]=__builtin_amdgcn_mfma_f32_32x32x16_bf16(PAF(1),VFR(1),o[0],0,0,0), C0,8); \
    KRD(GL,1); GAPB(o[1]=__builtin_amdgcn_mfma_f32_32x32x16_bf16(PAF(1),VFR(5),o[1],0,0,0), C0,12); \
    KRD(GL,2); GAPB(o[0]=__builtin_amdgcn_mfma_f32_32x32x16_bf16(PAF(2),VFR(2),o[0],0,0,0), C1,0); \
    KRD(GL,3); GAPB(o[1]=__builtin_amdgcn_mfma_f32_32x32x16_bf16(PAF(2),VFR(6),o[1],0,0,0), C1,4); \
    GAPB(o[0]=__builtin_amdgcn_mfma_f32_32x32x16_bf16(PAF(3),VFR(3),o[0],0,0,0), C1,8); \
    GAPB(o[1]=__builtin_amdgcn_mfma_f32_32x32x16_bf16(PAF(3),VFR(7),o[1],0,0,0), C1,12); \
    }while(0)
  int t=1;
  #undef CMASK
  #define CMASK(P0,P1,t) do{}while(0)
  for(;t+5<NT;t+=2){
    STEP(pB0,pB1,pA0,pA1,t,true,true,true);     WAIT_BAR(2); RESC(); ROT();
    STEP(pA0,pA1,pB0,pB1,t+1,true,true,true);   WAIT_BAR(2); RESC(); ROT();
  }
  #undef CMASK
  #define CMASK(P0,P1,t) do{int jb_=(t)-(NT-4); if(jb_>=0)cmask(P0,P1,jb_,qrel,hi);}while(0)
  #define ENDW(tt) do{ if((tt)+3<NT){WAIT_BAR(2);} else if((tt)+2<NT){WAIT_BAR(1);} else {WAIT_BAR(0);} }while(0)
  for(;t+1<NT;t+=2){
    STEP(pB0,pB1,pA0,pA1,t,(t+3<NT),(t+1<NT),(t+1<NT));       ENDW(t);   RESC(); ROT();
    STEP(pA0,pA1,pB0,pB1,t+1,(t+4<NT),(t+2<NT),(t+2<NT));     ENDW(t+1); RESC(); ROT();
  }
  STEP(pB0,pB1,pA0,pA1,NT-1,false,false,false); RESC();
  { float sacc=pB0[0]+pB0[1]; _Pragma("unroll") for(int r=2;r<16;++r)sacc+=pB0[r]; _Pragma("unroll") for(int r=0;r<16;++r)sacc+=pB1[r]; l_reg+=sacc;
    pw0=(u32x4){PKW(pB0,0),PKW(pB0,2),PKW(pB0,4),PKW(pB0,6)};pw1=(u32x4){PKW(pB0,8),PKW(pB0,10),PKW(pB0,12),PKW(pB0,14)};pw2=(u32x4){PKW(pB1,0),PKW(pB1,2),PKW(pB1,4),PKW(pB1,6)};pw3=(u32x4){PKW(pB1,8),PKW(pB1,10),PKW(pB1,12),PKW(pB1,14)};
    SBAR(); pv(o,vb0+sl_cur,PAF(0),PAF(1),PAF(2),PAF(3)); }
  #undef PKW
  #undef PAF
  #undef VFR
  #undef PIN
  #undef MX3
  #undef GAPA
  #undef GAPB
  #undef EX
  #undef VRD
  #undef KRD
  #undef STEP
  #undef ENDW
  {auto rr=__builtin_amdgcn_permlane32_swap(__float_as_uint(l_reg),__float_as_uint(l_reg),false,false);l_reg=__uint_as_float(rr[0])+__uint_as_float(rr[1]);}
  if(hi==0)wsf[32+r32]=l_reg;asm volatile("s_waitcnt lgkmcnt(0)":::"memory");
  float rli[16];
  #pragma unroll
  for(int r=0;r<16;++r)rli[r]=__builtin_amdgcn_rcpf(wsf[32+crow(r,hi)]);
  bf16*Ow=O+(rowbase+q0+wid*QBLK)*DM+hv*D;
  { bf16*stg=(bf16*)(shm+LDS_OST)+wid*2048;
    #pragma unroll
    for(int r=0;r<16;++r){const int orow=crow(r,hi);
      #pragma unroll
      for(int d0=0;d0<2;++d0)stg[orow*64+d0*32+r32]=__float2bfloat16(o[d0][r]*rli[r]);}
    asm volatile("s_waitcnt lgkmcnt(0)":::"memory");
    #pragma unroll
    for(int i=0;i<4;++i){const int row=i*8+(lane>>3),ch=lane&7; const u32x4 v=*(const u32x4*)(stg+row*64+ch*8); ATTN_STORE16(Ow+(long)row*DM+ch*8,v);} }
  asm volatile("s_waitcnt lgkmcnt(0)\n\ts_barrier":::"memory");
  #undef DMA_K
  #undef DMA_V
  #undef CMASK
  #undef START
  #undef RESC
  #undef ROT
}
__device__ __forceinline__ void pv128(f32x16*o,int vb,bf16x8 pa0,bf16x8 pa1,bf16x8 pa2,bf16x8 pa3){
  #pragma unroll
  for(int d0=0;d0<4;++d0){s16x4 lo[4],hi[4];
    #pragma unroll
    for(int ks=0;ks<4;++ks){
      asm volatile("ds_read_b64_tr_b16 %0,%1 offset:%c2":"=&v"(lo[ks]):"v"(vb),"i"(d0*4096+ks*1024):"memory");
      asm volatile("ds_read_b64_tr_b16 %0,%1 offset:%c2":"=&v"(hi[ks]):"v"(vb),"i"(d0*4096+ks*1024+512):"memory");}
    asm volatile("s_waitcnt lgkmcnt(0)":::"memory");SBAR();
    #define PK(k) (bf16x8){lo[k][0],lo[k][1],lo[k][2],lo[k][3],hi[k][0],hi[k][1],hi[k][2],hi[k][3]}
    o[d0]=__builtin_amdgcn_mfma_f32_32x32x16_bf16(pa0,PK(0),o[d0],0,0,0);
    o[d0]=__builtin_amdgcn_mfma_f32_32x32x16_bf16(pa1,PK(1),o[d0],0,0,0);
    o[d0]=__builtin_amdgcn_mfma_f32_32x32x16_bf16(pa2,PK(2),o[d0],0,0,0);
    o[d0]=__builtin_amdgcn_mfma_f32_32x32x16_bf16(pa3,PK(3),o[d0],0,0,0);
    #undef PK
  }
}
constexpr int SLOTV=16384, LDS_V2=NSLOT*SLOTB, LDS_WS2=LDS_V2+NSLOT*SLOTV, LDS_OST2=LDS_WS2+NW*64*4, LDS_BYTES2=LDS_OST2+NW*4096;
template<int THRL> __device__ __forceinline__ void attn_unit128(int b,int hq,int hv,int qb,const bf16*Q,const bf16*__restrict__ K,const bf16*__restrict__ V,bf16*O,char*shm){
  const int tid=opaque_tid(),lane=tid&63,r32=lane&31,hi=lane>>5; const int wid=__builtin_amdgcn_readfirstlane(tid>>6);
  const long rowbase=(long)b*SEQ; const int q0=qb*QB;
  const bf16*Qw=Q+(rowbase+q0+wid*QBLK)*DM+hq*D;
  const bf16*Kh=K+rowbase*DM+hq*D,*Vh=V+rowbase*DM+hv*D;
  const unsigned lds0=(unsigned)(uintptr_t)shm;
  float*wsf=(float*)(shm+LDS_WS2)+wid*64;
  const bf16*ksrc=Kh+(long)lane*DM+wid*8;
  const bf16*vsrc=Vh+(long)(16*(wid&3)+(lane>>2))*DM+(wid>>2)*32+(lane&3)*8;
  const unsigned kdst=lds0+LDS_K+wid*1024, vdst=lds0+LDS_V2+wid*1024;
  #define DMA_K(t,slot) glds16(ksrc+(long)(t)*KVBLK*DM,(unsigned)__builtin_amdgcn_readfirstlane(kdst+(slot)))
  #define DMA_V(t,slot) do{ glds16(vsrc+(long)(t)*KVBLK*DM,(unsigned)__builtin_amdgcn_readfirstlane(vdst+2*(slot))); glds16(vsrc+64+(long)(t)*KVBLK*DM,(unsigned)__builtin_amdgcn_readfirstlane(vdst+8192+2*(slot))); }while(0)
  const int vb0=(int)(lds0+LDS_V2)+((lane>>4)&1)*32+(lane&3)*8+(4*hi+((lane&15)>>2))*64;
  const char*Kbase=shm+LDS_K; bf16x8 kf[8];
  const lds_cptr shm3=(lds_cptr)shm; const lds_cptr kp0=shm3+LDS_K+hi*1024+r32*16; const lds_cptr vp0=shm3+LDS_V2+((lane>>4)&1)*32+(lane&3)*8+(4*hi+((lane&15)>>2))*64;
  const int NT=(q0+QB)/KVBLK;
  DMA_K(0,0);DMA_V(0,0);DMA_K(1,SLOTB);
  bf16x8 qr[4];
  #pragma unroll
  for(int d0=0;d0<4;++d0)qr[d0]=*reinterpret_cast<const bf16x8*>(&Qw[(long)r32*DM+d0*16+hi*8]);
  float mhat=0.f,l_reg=0.f;f32x16 o[4];o[0]=f32x16{};o[1]=f32x16{};o[2]=f32x16{};o[3]=f32x16{};const f32x16 zc=f32x16{};
  const int qrel=wid*QBLK+r32;
  #define CMASK(P0,P1,t) do{int jb_=(t)-(NT-4); if(jb_>=0)cmask(P0,P1,jb_,qrel,hi);}while(0)
  bool resc=false;
  #define START(P0,P1) do{ const float rm=rowmax(P0,P1); resc=false; \
    { const float dl=rm; mhat=fadd_s(mhat,dl); \
      _Pragma("unroll") for(int r=0;r<16;++r){P0[r]=fsub_s(P0[r],dl);P1[r]=fsub_s(P1[r],dl);} \
      } \
    _Pragma("unroll") for(int r=0;r<16;++r)P0[r]=__builtin_amdgcn_exp2f(P0[r]); }while(0)
  #define RESC() do{ if(resc){ asm volatile("s_waitcnt lgkmcnt(0)":::"memory"); \
      _Pragma("unroll") for(int d_=0;d_<4;++d_) _Pragma("unroll") for(int r=0;r<16;++r)o[d_][r]*=wsf[crow(r,hi)]; } }while(0)
  f32x16 pA0,pA1,pB0,pB1;
  int sl_prev=0,sl_cur=0,sl_next=SLOTB;
  #define ROT() do{sl_prev=sl_cur;sl_cur=sl_next;sl_next=(sl_next==(NSLOT-1)*SLOTB)?0:sl_next+SLOTB;}while(0)
  DMA_K(2,2*SLOTB);
  WAIT_BAR(3);
  qkt(pA0,pA1,Kbase,qr,zc,r32,hi);asm volatile("s_nop 15\n\ts_nop 7":"+v"(pA0),"+v"(pA1));CMASK(pA0,pA1,0);
  START(pA0,pA1);
  _Pragma("unroll") for(int r=0;r<16;++r)pA1[r]=__builtin_amdgcn_exp2f(pA1[r]);
  WAIT_BAR(0);
  DMA_K(3,0);DMA_V(1,SLOTB);
  ROT();
  kload8(kf,kp0+sl_cur);
  WAIT_BAR(3);
  s16x4 vlo[8],vhi[8]; u32x4 pw0,pw1,pw2,pw3;
  #define PKW(P,B) cvtpk_s(P[B],P[B+1])
  #define PAF(k) __builtin_bit_cast(bf16x8,pw##k)
  #define VFR(i) (bf16x8){vlo[i][0],vlo[i][1],vlo[i][2],vlo[i][3],vhi[i][0],vhi[i][1],vhi[i][2],vhi[i][3]}
  #define PIN(x) asm volatile("":"+v"(x))
  #define MX3(a,b,c) __builtin_fmaxf(__builtin_fmaxf((a),(b)),(c))
  #define GAPA(MF,A0,A1,A2,A3,W0,W1,PW) do{ MF; sacc+=A0; sacc+=A1; sacc+=A2; sacc+=A3; PIN(sacc); W0; W1; PIN(PW); SBAR(); }while(0)
  #define EX(v) __builtin_amdgcn_exp2f(v)
  #define GAPB(MF,X,B) do{ MF; X[B]=EX(X[B]); X[B+1]=EX(X[B+1]); X[B+2]=EX(X[B+2]); X[B+3]=EX(X[B+3]); PIN(X); SBAR(); }while(0)
  #define VRD(i) do{ vlo[i]=vtr(vp_+(((i)>>2)*4096+((i)&3)*1024)); vhi[i]=vtr(vp_+(((i)>>2)*4096+((i)&3)*1024+512)); }while(0)
  #define VRX(i) do{ vlo[i]=vtr(vp_+((((i)>>2)+2)*4096+((i)&3)*1024)); vhi[i]=vtr(vp_+((((i)>>2)+2)*4096+((i)&3)*1024+512)); SBAR(); }while(0)
  #define GAPB2(MF,X,B) do{ MF; X[B]=EX(X[B]-mhat); X[B+1]=EX(X[B+1]-mhat); PIN(X); SBAR(); }while(0)
  #define KRD(G,j) do{ if(G){ kload2(kf,kp0+sl_next,j); SBAR(); } }while(0)
  #define STEP(C0,C1,P0,P1,t,GK,GV,GL) do{ SBAR(); \
    const lds_cptr vp_=vp0+2*sl_prev; \
    VRD(0); SBAR(); float sacc=(P0[0]+P0[1]); \
    GAPA(C0=__builtin_amdgcn_mfma_f32_32x32x16_bf16(kf[0],qr[0],zc,0,0,0), P0[2],P0[3],P0[4],P0[5],     pw0[0]=PKW(P0,0), pw0[1]=PKW(P0,2), pw0); \
    VRD(4); SBAR(); GAPA(C1=__builtin_amdgcn_mfma_f32_32x32x16_bf16(kf[1],qr[0],zc,0,0,0), P0[6],P0[7],P0[8],P0[9],     pw0[2]=PKW(P0,4), pw0[3]=PKW(P0,6), pw0); \
    VRD(1); SBAR(); GAPA(C0=__builtin_amdgcn_mfma_f32_32x32x16_bf16(kf[2],qr[1],C0,0,0,0),   P0[10],P0[11],P0[12],P0[13], pw1[0]=PKW(P0,8), pw1[1]=PKW(P0,10), pw1); \
    VRD(5); SBAR(); GAPA(C1=__builtin_amdgcn_mfma_f32_32x32x16_bf16(kf[3],qr[1],C1,0,0,0),   P0[14],P0[15],P1[0],P1[1],   pw1[2]=PKW(P0,12),pw1[3]=PKW(P0,14), pw1); \
    VRD(2); SBAR(); GAPA(C0=__builtin_amdgcn_mfma_f32_32x32x16_bf16(kf[4],qr[2],C0,0,0,0),   P1[2],P1[3],P1[4],P1[5],     pw2[0]=PKW(P1,0), pw2[1]=PKW(P1,2), pw2); \
    VRD(6); SBAR(); GAPA(C1=__builtin_amdgcn_mfma_f32_32x32x16_bf16(kf[5],qr[2],C1,0,0,0),   P1[6],P1[7],P1[8],P1[9],     pw2[2]=PKW(P1,4), pw2[3]=PKW(P1,6), pw2); \
    VRD(3); SBAR(); GAPA(C0=__builtin_amdgcn_mfma_f32_32x32x16_bf16(kf[6],qr[3],C0,0,0,0),   P1[10],P1[11],P1[12],P1[13], pw3[0]=PKW(P1,8), pw3[1]=PKW(P1,10), pw3); \
    VRD(7); SBAR(); GAPA(C1=__builtin_amdgcn_mfma_f32_32x32x16_bf16(kf[7],qr[3],C1,0,0,0),   P1[14],P1[15],0.f,0.f,       pw3[2]=PKW(P1,12),pw3[3]=PKW(P1,14), pw3); \
    l_reg+=sacc; \
    if(GK){DMA_K((t)+3,sl_cur);} if(GV){DMA_V((t)+1,sl_next);} \
    CMASK(C0,C1,t); \
    { float a=MX3(C0[0],C0[1],C1[0]),b=MX3(C0[2],C0[3],C1[1]); a=MX3(a,C1[2],C1[3]); \
      _Pragma("unroll") for(int r=4;r<16;r+=4){a=MX3(a,C0[r],C0[r+1]);b=MX3(b,C0[r+2],C0[r+3]);a=MX3(a,C1[r],C1[r+1]);b=MX3(b,C1[r+2],C1[r+3]);} \
      float rm=__builtin_fmaxf(a,b); { auto rr=__builtin_amdgcn_permlane32_swap(__float_as_uint(rm),__float_as_uint(rm),false,false); rm=__builtin_fmaxf(__uint_as_float(rr[0]),__uint_as_float(rr[1])); } \
      rm-=mhat; resc=false; \
      if(__builtin_expect(__any(rm>(float)THRL),0)){ const float dl=__builtin_fmaxf(rm,0.f); mhat+=dl; \
        const float f=__builtin_amdgcn_exp2f(-dl); l_reg*=f; if(hi==0)wsf[r32]=f; resc=true; } } \
    SBAR(); \
    GAPB2(o[0]=__builtin_amdgcn_mfma_f32_32x32x16_bf16(PAF(0),VFR(0),o[0],0,0,0), C0,0);  VRX(0); \
    GAPB2(o[1]=__builtin_amdgcn_mfma_f32_32x32x16_bf16(PAF(0),VFR(4),o[1],0,0,0), C0,2);  VRX(4); \
    KRD(GL,0); GAPB2(o[0]=__builtin_amdgcn_mfma_f32_32x32x16_bf16(PAF(1),VFR(1),o[0],0,0,0), C0,4);  VRX(1); \
    KRD(GL,1); GAPB2(o[1]=__builtin_amdgcn_mfma_f32_32x32x16_bf16(PAF(1),VFR(5),o[1],0,0,0), C0,6);  VRX(5); \
    KRD(GL,2); GAPB2(o[0]=__builtin_amdgcn_mfma_f32_32x32x16_bf16(PAF(2),VFR(2),o[0],0,0,0), C0,8);  VRX(2); \
    KRD(GL,3); GAPB2(o[1]=__builtin_amdgcn_mfma_f32_32x32x16_bf16(PAF(2),VFR(6),o[1],0,0,0), C0,10); VRX(6); \
    GAPB2(o[0]=__builtin_amdgcn_mfma_f32_32x32x16_bf16(PAF(3),VFR(3),o[0],0,0,0), C0,12); VRX(3); \
    GAPB2(o[1]=__builtin_amdgcn_mfma_f32_32x32x16_bf16(PAF(3),VFR(7),o[1],0,0,0), C0,14); VRX(7); \
    GAPB2(o[2]=__builtin_amdgcn_mfma_f32_32x32x16_bf16(PAF(0),VFR(0),o[2],0,0,0), C1,0); \
    GAPB2(o[3]=__builtin_amdgcn_mfma_f32_32x32x16_bf16(PAF(0),VFR(4),o[3],0,0,0), C1,2); \
    GAPB2(o[2]=__builtin_amdgcn_mfma_f32_32x32x16_bf16(PAF(1),VFR(1),o[2],0,0,0), C1,4); \
    GAPB2(o[3]=__builtin_amdgcn_mfma_f32_32x32x16_bf16(PAF(1),VFR(5),o[3],0,0,0), C1,6); \
    GAPB2(o[2]=__builtin_amdgcn_mfma_f32_32x32x16_bf16(PAF(2),VFR(2),o[2],0,0,0), C1,8); \
    GAPB2(o[3]=__builtin_amdgcn_mfma_f32_32x32x16_bf16(PAF(2),VFR(6),o[3],0,0,0), C1,10); \
    GAPB2(o[2]=__builtin_amdgcn_mfma_f32_32x32x16_bf16(PAF(3),VFR(3),o[2],0,0,0), C1,12); \
    GAPB2(o[3]=__builtin_amdgcn_mfma_f32_32x32x16_bf16(PAF(3),VFR(7),o[3],0,0,0), C1,14); \
    }while(0)
  int t=1;
  #undef CMASK
  #define CMASK(P0,P1,t) do{}while(0)
  for(;t+5<NT;t+=2){
    STEP(pB0,pB1,pA0,pA1,t,true,true,true);     WAIT_BAR(3); RESC(); ROT();
    STEP(pA0,pA1,pB0,pB1,t+1,true,true,true);   WAIT_BAR(3); RESC(); ROT();
  }
  #undef CMASK
  #define CMASK(P0,P1,t) do{int jb_=(t)-(NT-4); if(jb_>=0)cmask(P0,P1,jb_,qrel,hi);}while(0)
  #define ENDW(tt) do{ if((tt)+3<NT){WAIT_BAR(3);} else if((tt)+2<NT){WAIT_BAR(2);} else {WAIT_BAR(0);} }while(0)
  for(;t+1<NT;t+=2){
    STEP(pB0,pB1,pA0,pA1,t,(t+3<NT),(t+1<NT),(t+1<NT));       ENDW(t);   RESC(); ROT();
    STEP(pA0,pA1,pB0,pB1,t+1,(t+4<NT),(t+2<NT),(t+2<NT));     ENDW(t+1); RESC(); ROT();
  }
  STEP(pB0,pB1,pA0,pA1,NT-1,false,false,false); RESC();
  { float sacc=pB0[0]+pB0[1]; _Pragma("unroll") for(int r=2;r<16;++r)sacc+=pB0[r]; _Pragma("unroll") for(int r=0;r<16;++r)sacc+=pB1[r]; l_reg+=sacc;
    pw0=(u32x4){PKW(pB0,0),PKW(pB0,2),PKW(pB0,4),PKW(pB0,6)};pw1=(u32x4){PKW(pB0,8),PKW(pB0,10),PKW(pB0,12),PKW(pB0,14)};pw2=(u32x4){PKW(pB1,0),PKW(pB1,2),PKW(pB1,4),PKW(pB1,6)};pw3=(u32x4){PKW(pB1,8),PKW(pB1,10),PKW(pB1,12),PKW(pB1,14)};
    SBAR(); pv128(o,vb0+2*sl_cur,PAF(0),PAF(1),PAF(2),PAF(3)); }
  #undef PKW
  #undef PAF
  #undef VFR
  #undef PIN
  #undef MX3
  #undef GAPA
  #undef GAPB
  #undef EX
  #undef VRD
  #undef VRX
  #undef GAPB2
  #undef KRD
  #undef STEP
  #undef ENDW
  {auto rr=__builtin_amdgcn_permlane32_swap(__float_as_uint(l_reg),__float_as_uint(l_reg),false,false);l_reg=__uint_as_float(rr[0])+__uint_as_float(rr[1]);}
  if(hi==0)wsf[32+r32]=l_reg;asm volatile("s_waitcnt lgkmcnt(0)":::"memory");
  float rli[16];
  #pragma unroll
  for(int r=0;r<16;++r)rli[r]=__builtin_amdgcn_rcpf(wsf[32+crow(r,hi)]);
  bf16*Ow=O+(rowbase+q0+wid*QBLK)*DM+hv*D;
  { bf16*stg=(bf16*)(shm+LDS_OST2)+wid*2048;
    #pragma unroll
    for(int hp=0;hp<2;++hp){
      #pragma unroll
      for(int r=0;r<16;++r){const int orow=crow(r,hi);
        #pragma unroll
        for(int d0=0;d0<2;++d0)stg[orow*64+d0*32+r32]=__float2bfloat16(o[2*hp+d0][r]*rli[r]);}
      asm volatile("s_waitcnt lgkmcnt(0)":::"memory");
      #pragma unroll
      for(int i=0;i<4;++i){const int row=i*8+(lane>>3),ch=lane&7; const u32x4 v=*(const u32x4*)(stg+row*64+ch*8); ATTN_STORE16(Ow+(long)row*DM+hp*64+ch*8,v);}
      asm volatile("s_waitcnt lgkmcnt(0)":::"memory"); } }
  asm volatile("s_waitcnt lgkmcnt(0)\n\ts_barrier":::"memory");
  #undef DMA_K
  #undef DMA_V
  #undef CMASK
  #undef START
  #undef RESC
  #undef ROT
}
constexpr int ATTN_LDS_BYTES=LDS_BYTES;
#undef SBAR
#undef WAIT_BAR
}
#define GAS __attribute__((address_space(1)))
#define LAS __attribute__((address_space(3)))
typedef unsigned short bf16;
typedef unsigned v4u __attribute__((ext_vector_type(4)));
typedef float f32x4 __attribute__((ext_vector_type(4)));
typedef short bf16x8 __attribute__((ext_vector_type(8)));
typedef GAS unsigned gu32;
typedef GAS unsigned long long gu64;
#define RLX_AGENT __ATOMIC_RELAXED, __HIP_MEMORY_SCOPE_AGENT
#define LDS_WAIT() asm volatile("s_waitcnt lgkmcnt(0)" ::: "memory")
#define VM_WAIT() asm volatile("s_waitcnt vmcnt(0)" ::: "memory")
__device__ __forceinline__ unsigned long long rt() { return __builtin_amdgcn_s_memrealtime(); }
__device__ __forceinline__ unsigned f2bf(float f) { unsigned u = __builtin_bit_cast(unsigned, f); return (u + 0x7fffu + ((u >> 16) & 1u)) >> 16; }
__device__ __forceinline__ unsigned pk2(float lo, float hi) { return f2bf(lo) | (f2bf(hi) << 16); }

#define XB_TMO      128
#define XB_XCNT(j)  (256  + 64 * (j))
#define XB_XSUB(j)  (1280 + 64 * (j))
#define XB_XGEN(j)  (2304 + 64 * (j))
#define XB_TOP      3328
#define XB_TOPGEN   3392
#define XCD_BAR_WORDS 3456
#define XB_SPIN_CAP (1u << 18)

__device__ __forceinline__ unsigned xb_ld(unsigned* p)              { return __hip_atomic_load(p, __ATOMIC_RELAXED, __HIP_MEMORY_SCOPE_AGENT); }
__device__ __forceinline__ unsigned xb_add(unsigned* p, unsigned v) { return __hip_atomic_fetch_add(p, v, __ATOMIC_RELAXED, __HIP_MEMORY_SCOPE_AGENT); }
__device__ __forceinline__ unsigned xb_xcc_id() { return (unsigned)__builtin_amdgcn_s_getreg((3 << 11) | 20) & 0xFu; }
#define XB_SPIN(cond, bar) do { unsigned _sp = 0; while (cond) { __builtin_amdgcn_s_sleep(1); \
    if ((++_sp & 255u) == 0u) { if (xb_ld(&(bar)[XB_TMO])) break; if (_sp > XB_SPIN_CAP) { atomicAdd(&(bar)[XB_TMO], 1u); break; } } } } while (0)

struct XcdBarrier {
    unsigned* bar; unsigned x;
    volatile LAS unsigned* st;
};

__device__ __forceinline__ XcdBarrier xcd_barrier_post(unsigned* bar, volatile LAS unsigned* st) {
    XcdBarrier b; b.bar = bar; b.x = xb_xcc_id(); b.st = st;
    if (opaque_tid() == 0) (void)xb_add(&bar[XB_XCNT(b.x)], 1u);
    return b;
}
__device__ __forceinline__ void xcd_barrier_complete(unsigned* bar, unsigned x, unsigned& nloc, unsigned& nx) {
    const unsigned G = gridDim.x * gridDim.y * gridDim.z;
    unsigned sum, cnt, mine, sp = 0u;
    for (;;) {
        sum = 0u; cnt = 0u;
#pragma unroll
        for (unsigned j = 0; j < 16; ++j) { const unsigned c = xb_ld(&bar[XB_XCNT(j)]); sum += c; cnt += (c > 0u) ? 1u : 0u; }
        if (sum == G) break;
        __builtin_amdgcn_s_sleep(1);
        if ((++sp & 255u) == 0u) { if (xb_ld(&bar[XB_TMO])) break; if (sp > XB_SPIN_CAP) { atomicAdd(&bar[XB_TMO], 1u); break; } }
    }
    mine = xb_ld(&bar[XB_XCNT(x)]);
    nloc = mine > 0u ? mine : 1u; nx = cnt > 0u ? cnt : 1u;
}

__device__ __forceinline__ void xcd_barrier(const XcdBarrier& b) {
    asm volatile("s_waitcnt vmcnt(0)" ::: "memory");
    __syncthreads();
    if (opaque_tid() == 0) {
        unsigned* bar = b.bar;
        __builtin_amdgcn_s_waitcnt(0);
        unsigned nloc = b.st[0], nx = b.st[1];
        if (nloc == 0u) { xcd_barrier_complete(bar, b.x, nloc, nx); b.st[0] = nloc; b.st[1] = nx; }
        const unsigned old = xb_add(&bar[XB_XSUB(b.x)], 1u);
        const unsigned gen = old / nloc;
        if (old + 1u == (gen + 1u) * nloc) {
            __builtin_amdgcn_fence(__ATOMIC_RELEASE, "agent");
            asm volatile("s_waitcnt vmcnt(0)" ::: "memory");
            const unsigned og = xb_add(&bar[XB_TOP], 1u);
            const unsigned tg = og / nx;
            if (og + 1u == (tg + 1u) * nx) xb_add(&bar[XB_TOPGEN], 1u);
            else XB_SPIN(xb_ld(&bar[XB_TOPGEN]) == tg, bar);
            __builtin_amdgcn_fence(__ATOMIC_ACQUIRE, "agent");
            xb_add(&bar[XB_XGEN(b.x)], 1u);
            asm volatile("s_waitcnt vmcnt(0)" ::: "memory");
        } else {
            XB_SPIN(xb_ld(&bar[XB_XGEN(b.x)]) == gen, bar);
            __builtin_amdgcn_fence(__ATOMIC_ACQUIRE, "agent");
            asm volatile("s_waitcnt vmcnt(0)" ::: "memory");
        }
    }
    __syncthreads();
}
constexpr int NWAVES = 8;
constexpr int DM = 1024, MP = 32768, MS = 512, MROWS = MP + MS, NSEQ = 20, DEPTH = 4, DFF = 2816, DIN = 9216, PAST = 2048;
constexpr int NCHUNK_P = 512, NCHUNK = 528;
constexpr float EPS = 1e-6f;
constexpr size_t OY_P = 0, OY_S = 33554432, OK_P = 34078720, OV_P = 168296448, OS_P = 302514176, OK_S = 304611328, OV_S = 306708480, OS_S = 308805632, OUT_TOTAL = 317194240;

constexpr size_t MiB = 1u << 20;
constexpr size_t WS_CTL = 0, CTL_ZERO_BYTES = 1 * MiB;
constexpr size_t WS_MOD = 1 * MiB;
constexpr size_t WS_LB = 4 * MiB;
constexpr size_t WS_W = 8 * MiB, W_LAYER = 57 * MiB;
constexpr size_t WO_GU1 = 0, WO_D1 = 11 * MiB, WO_IN = 16 * MiB + MiB / 2, WO_BA = 34 * MiB + MiB / 2, WO_BH = 36 * MiB + MiB / 2, WO_OUT = 38 * MiB + MiB / 2, WO_GU2 = 40 * MiB + MiB / 2, WO_D2 = 51 * MiB + MiB / 2;
constexpr size_t WS_X = 240 * MiB;
constexpr size_t WS_XN = 370 * MiB;
constexpr size_t WS_Q = 435 * MiB, WS_K = 500 * MiB, WS_V = 565 * MiB;
constexpr size_t WS_QQ = 630 * MiB, WS_KK = 695 * MiB, WS_VV = 760 * MiB, WS_HGS = 825 * MiB, WS_SZA = 890 * MiB, WS_SZH = 955 * MiB;
constexpr size_t WS_LOGF = 1020 * MiB;
constexpr size_t WS_O1 = 1150 * MiB, WS_O2 = 1215 * MiB, WS_OATT = 1280 * MiB, WS_OH = 1345 * MiB, WS_MRG = 1410 * MiB;
constexpr size_t WS_BIG = 1475 * MiB;
constexpr size_t WS_SST = 1739 * MiB;
constexpr size_t WS_DD = 1871 * MiB;
constexpr size_t WS_END = 1874 * MiB;
#ifndef TEAM_STRIDE
#define TEAM_STRIDE 8
#endif
#ifndef STARTERS
#define STARTERS 4
#endif
constexpr int T_TEAM = 256 / TEAM_STRIDE;
#ifndef G3_STAGGER_TICKS
#define G3_STAGGER_TICKS 800
#endif
constexpr int HG_G = 4;
constexpr size_t WS_QS = WS_BIG, WS_SL = WS_BIG + 64 * MiB, WS_DSEG = WS_BIG + 72 * MiB, WS_RAW = WS_SST;
constexpr int CW_BAR = 4096, CW_Q = 8192, CW_HS = 16384;
static_assert(pg8::EpiWin::O_Q == WS_Q && pg8::EpiWin::O_K == WS_K && pg8::EpiWin::O_V == WS_V && pg8::EpiWin::O_QQ == WS_QQ && pg8::EpiWin::O_KK == WS_KK && pg8::EpiWin::O_VV == WS_VV && pg8::EpiWin::O_HGS == WS_HGS && pg8::EpiWin::O_SZA == WS_SZA && pg8::EpiWin::O_SZH == WS_SZH && pg8::EpiWin::O_LOGF == WS_LOGF && pg8::EpiWin::O_LB == WS_LB && pg8::EpiWin::OK_P_ == OK_P && pg8::EpiWin::OV_P_ == OV_P && pg8::EpiWin::OK_S_ == OK_S && pg8::EpiWin::OV_S_ == OV_S, "EpiWin offsets");

constexpr int RING_OFF = 0, RING_BYTES = 139264;
constexpr int LDSCTL_OFF = RING_BYTES, MISC_OFF = LDSCTL_OFF + 320;
constexpr int LDS_BYTES = 147456;

struct Frame {
    LAS unsigned char* lds;
    volatile LAS unsigned* MISC;
    gu32* ctl;
    int tid, lane, wave;
    int vcu, G;
};
typedef float f32x16 __attribute__((ext_vector_type(16)));
typedef unsigned v2u __attribute__((ext_vector_type(2)));

__device__ __forceinline__ float shx(float v, int mask, int lane) { return __builtin_bit_cast(float, __builtin_amdgcn_ds_bpermute((lane ^ mask) << 2, __builtin_bit_cast(int, v))); }
__device__ __forceinline__ float wave_sum(float v, int lane) {
#pragma unroll
    for (int o = 1; o < 64; o <<= 1) v += shx(v, o, lane);
    return v;
}
__device__ __forceinline__ float bf2f(bf16 b) { return __builtin_bit_cast(float, (unsigned)b << 16); }
__device__ __forceinline__ unsigned cvtpk(float lo, float hi) { return pg8::cvt_pk_bf16(lo, hi); }
__device__ __forceinline__ bf16x8 pack8(f32x4 a, f32x4 b) { v4u w; w.x = cvtpk(a[0], a[1]); w.y = cvtpk(a[2], a[3]); w.z = cvtpk(b[0], b[1]); w.w = cvtpk(b[2], b[3]); return __builtin_bit_cast(bf16x8, w); }
__device__ __forceinline__ float lam_init_of(int l) { asm volatile("" : "+s"(l)); return 0.8f - 0.6f * __expf(-0.3f * (float)l); }

__device__ __forceinline__ void p0_transpose_item(const float* W, int K, int N, bf16* WT, bool gu, LAS float* scr, int item, int lane) {
    const int nblk = N / 32, kb = item / nblk, nb = item % nblk, k0 = 64 * kb, nd0 = 32 * nb;
    const int ns0 = gu ? (((nd0 >> 7) & 1) * 2816 + (nd0 >> 8) * 128 + (nd0 & 127)) : nd0;
#pragma unroll 8
    for (int i = 0; i < 32; ++i) { const int kk = 2 * i + (lane >> 5); scr[kk * 33 + (lane & 31)] = W[(size_t)(k0 + kk) * N + ns0 + (lane & 31)]; }
    LDS_WAIT(); asm volatile("" ::: "memory");
    const int c = lane & 7;
#pragma unroll
    for (int j = 0; j < 4; ++j) { const int n = (lane >> 3) + 8 * j; const LAS float* s = scr + (8 * c) * 33 + n;
        v4u o; o.x = pk2(s[0 * 33], s[1 * 33]); o.y = pk2(s[2 * 33], s[3 * 33]); o.z = pk2(s[4 * 33], s[5 * 33]); o.w = pk2(s[6 * 33], s[7 * 33]);
        *(GAS v4u*)(WT + (size_t)(nd0 + n) * K + k0 + 8 * c) = o; }
    LDS_WAIT(); asm volatile("" ::: "memory");
}
typedef const __attribute__((address_space(4))) char* kaptr_t;
__device__ __forceinline__ const float* karg(int i) { kaptr_t ka = (kaptr_t)__builtin_amdgcn_kernarg_segment_ptr(); asm volatile("" : "+s"(ka)); return *(const float* const __attribute__((address_space(4)))*)(ka + 8 * i); }
enum { A_XP = 0, A_XS, A_CK, A_CV, A_ST, A_CP, A_CS, A_WADA, A_BADA, A_GFFN1, A_WGU1, A_WD1, A_GMIX, A_WIN, A_LAM, A_GSUB, A_LBL, A_GHG, A_WBA, A_WBH, A_WOUT, A_GFFN2, A_WGU2, A_WD2, A_GFIN, A_OUT, A_WS };
__device__ __forceinline__ void p0_prologue(Frame& F, unsigned char* ws) {
    { LAS float* scr = (LAS float*)(F.lds + RING_OFF + F.wave * 16384);
      const int gw = F.vcu * NWAVES + F.wave, NGW = F.G * NWAVES;
      constexpr int I_GU = 16 * 176, I_D = 44 * 32, I_IN = 16 * 288, I_SQ = 16 * 32, I_LAYER = 2 * I_GU + 2 * I_D + I_IN + 3 * I_SQ;
      for (int it = gw; it < DEPTH * I_LAYER; it += NGW) {
          const int l = it / I_LAYER; int r = it % I_LAYER; unsigned char* wl = ws + WS_W + (size_t)l * W_LAYER;
          if (r < I_GU) { p0_transpose_item(karg(A_WGU1) + (size_t)l * 1024 * 5632, 1024, 5632, (bf16*)(wl + WO_GU1), true, scr, r, F.lane); continue; } r -= I_GU;
          if (r < I_D)  { p0_transpose_item(karg(A_WD1) + (size_t)l * 2816 * 1024, 2816, 1024, (bf16*)(wl + WO_D1), false, scr, r, F.lane); continue; } r -= I_D;
          if (r < I_IN) { p0_transpose_item(karg(A_WIN) + (size_t)l * 1024 * 9216, 1024, 9216, (bf16*)(wl + WO_IN), false, scr, r, F.lane); continue; } r -= I_IN;
          if (r < I_SQ) { p0_transpose_item(karg(A_WBA) + (size_t)l * 1024 * 1024, 1024, 1024, (bf16*)(wl + WO_BA), false, scr, r, F.lane); continue; } r -= I_SQ;
          if (r < I_SQ) { p0_transpose_item(karg(A_WBH) + (size_t)l * 1024 * 1024, 1024, 1024, (bf16*)(wl + WO_BH), false, scr, r, F.lane); continue; } r -= I_SQ;
          if (r < I_SQ) { p0_transpose_item(karg(A_WOUT) + (size_t)l * 1024 * 1024, 1024, 1024, (bf16*)(wl + WO_OUT), false, scr, r, F.lane); continue; } r -= I_SQ;
          if (r < I_GU) { p0_transpose_item(karg(A_WGU2) + (size_t)l * 1024 * 5632, 1024, 5632, (bf16*)(wl + WO_GU2), true, scr, r, F.lane); continue; } r -= I_GU;
          p0_transpose_item(karg(A_WD2) + (size_t)l * 2816 * 1024, 2816, 1024, (bf16*)(wl + WO_D2), false, scr, r, F.lane);
      } }
    __syncthreads();
    { const float* c_p = karg(A_CP); const float* c_s = karg(A_CS); const float* w_ada = karg(A_WADA); const float* b_ada = karg(A_BADA);
      LAS float* ca = (LAS float*)(F.lds);
      LAS float* red = (LAS float*)(F.lds + 81920);
      for (int i = F.tid; i < NSEQ * 1024; i += NWAVES * 64) { const int s = i >> 10, k = i & 1023; const float c = s < 4 ? c_p[s * 1024 + k] : c_s[(s - 4) * 1024 + k]; ca[i] = pg8::silu_f(c); }
      __syncthreads();
      float* MOD = (float*)(ws + WS_MOD);
      for (int it = F.vcu; it < DEPTH * 144; it += F.G) {
          const int l = it / 144, n = (it % 144) * 64 + F.lane; const float* wp = w_ada + ((size_t)l * 1024 + F.wave * 128) * 9216 + n;
          float acc[NSEQ];
#pragma unroll
          for (int s = 0; s < NSEQ; ++s) acc[s] = 0.f;
#pragma unroll 4
          for (int k = 0; k < 128; ++k) { const float w = wp[(size_t)k * 9216];
#pragma unroll
              for (int s = 0; s < NSEQ; ++s) acc[s] += ca[s * 1024 + F.wave * 128 + k] * w; }
#pragma unroll
          for (int s = 0; s < NSEQ; ++s) red[(F.wave * NSEQ + s) * 64 + F.lane] = acc[s];
          __syncthreads();
          for (int i = F.tid; i < NSEQ * 64; i += NWAVES * 64) { const int s = i >> 6, c = i & 63; float v = 0.f;
#pragma unroll
              for (int w = 0; w < 8; ++w) v += red[(w * NSEQ + s) * 64 + c];
              const int nn = (it % 144) * 64 + c; MOD[((size_t)l * NSEQ + s) * 9216 + nn] = v + b_ada[(size_t)l * 9216 + nn]; }
          __syncthreads();
      } }
    { float* X = (float*)(ws + WS_X); const float* xp = karg(A_XP); const float* xs = karg(A_XS);
      const size_t nv = (size_t)MROWS * DM / 4, np = (size_t)MP * DM / 4;
      for (size_t i = (size_t)F.vcu * (NWAVES * 64) + F.tid; i < nv; i += (size_t)F.G * NWAVES * 64) { const f32x4 v = i < np ? ((const f32x4*)xp)[i] : ((const f32x4*)xs)[i - np]; ((f32x4*)X)[i] = v; } }
    if (F.vcu == 0) { float* LB = (float*)(ws + WS_LB); const float* lb_logits = karg(A_LBL);
        for (int c = F.tid; c < 1024; c += NWAVES * 64) { float lg[4], mx = -INFINITY;
#pragma unroll
            for (int l = 0; l < 4; ++l) { lg[l] = lb_logits[l * 1024 + c]; mx = __builtin_fmaxf(mx, lg[l]); }
            float sum = 0.f;
#pragma unroll
            for (int l = 0; l < 4; ++l) { lg[l] = __expf(lg[l] - mx); sum += lg[l]; }
            const float inv = 1.f / sum; float cs = 0.f;
#pragma unroll
            for (int l = 0; l < 4; ++l) { cs += lg[l] * inv; LB[l * 1024 + c] = cs - lg[0] * inv; } } }
}

__device__ __forceinline__ void norm_phase(Frame& F, const float* X, const float* g, const float* mod_l, int sub, bf16* XN, int row0, int row1, int gw, int NGW) {
    const int RW = (row1 - row0) / NGW, rbeg = row0 + gw * RW;
    const float* mp = mod_l + (size_t)pg8::row_seq(rbeg) * 9216 + sub * 3 * 1024;
    f32x4 av[4], bv[4];
#pragma unroll
    for (int j = 0; j < 4; ++j) { const int c = 4 * F.lane + 256 * j; const f32x4 gg = *(const f32x4*)(g + c), sc = *(const f32x4*)(mp + 1024 + c); bv[j] = *(const f32x4*)(mp + c); av[j] = gg * (sc + 1.f); }
    for (int i = 0; i < RW; i += 2) {
        const int row = rbeg + i;
        const float* src = X + (size_t)row * DM;
        const f32x4* xr = (const f32x4*)src + F.lane; f32x4 v[2][4]; float s2[2] = {0.f, 0.f};
#pragma unroll
        for (int u = 0; u < 2; ++u)
#pragma unroll
            for (int j = 0; j < 4; ++j) v[u][j] = xr[u * 256 + 64 * j];
#pragma unroll
        for (int u = 0; u < 2; ++u)
#pragma unroll
            for (int j = 0; j < 4; ++j) s2[u] += (v[u][j].x * v[u][j].x + v[u][j].y * v[u][j].y) + (v[u][j].z * v[u][j].z + v[u][j].w * v[u][j].w);
#pragma unroll
        for (int u = 0; u < 2; ++u) { const float rstd = __builtin_amdgcn_rsqf(wave_sum(s2[u], F.lane) * (1.f / DM) + EPS);
            v2u* o8 = (v2u*)(XN + (size_t)(row + u) * DM) + F.lane;
#pragma unroll
            for (int j = 0; j < 4; ++j) { const f32x4 h = (v[u][j] * rstd) * av[j] + bv[j]; v2u o; o.x = cvtpk(h.x, h.y); o.y = cvtpk(h.z, h.w); o8[64 * j] = o; } }
    }
}
__device__ __forceinline__ void final_norm_phase(Frame& F, const float* X, const float* g, float* out) {
    const int gw = F.vcu * NWAVES + F.wave, NGW = F.G * NWAVES;
    for (int row = gw; row < MROWS; row += NGW) {
        const f32x4* xr = (const f32x4*)(X + (size_t)row * DM) + F.lane; f32x4 v[4]; float s2 = 0.f;
#pragma unroll
        for (int j = 0; j < 4; ++j) { v[j] = xr[64 * j]; s2 += (v[j].x * v[j].x + v[j].y * v[j].y) + (v[j].z * v[j].z + v[j].w * v[j].w); }
        const float rstd = __builtin_amdgcn_rsqf(wave_sum(s2, F.lane) * (1.f / DM) + EPS);
        f32x4* o = (f32x4*)(out + (row < MP ? OY_P + (size_t)row * DM : OY_S + (size_t)(row - MP) * DM)) + F.lane;
#pragma unroll
        for (int j = 0; j < 4; ++j) { const f32x4 gg = *(const f32x4*)(g + 4 * F.lane + 256 * j); o[64 * j] = (v[j] * rstd) * gg; }
    }
}
__device__ __forceinline__ float lam_of(const float* att_lambda, int l, int lane) {
    const float* lp = att_lambda + (size_t)l * 256;
    const float a = wave_sum(lp[lane] * lp[64 + lane], lane), b = wave_sum(lp[128 + lane] * lp[192 + lane], lane);
    return __expf(a) - __expf(b) + lam_init_of(l);
}
__device__ __forceinline__ void attn_combine_phase(Frame& F, const bf16* O1, const bf16* O2, const float* gsub, float lam, float osc, bf16* OATT) {
    const int gw = F.vcu * NWAVES + F.wave, NGW = F.G * NWAVES; const int cl = (F.lane & 7) * 16;
    float gv[16];
#pragma unroll
    for (int i = 0; i < 16; ++i) gv[i] = gsub[cl + i] * osc;
    for (int row = gw; row < MP; row += 2 * NGW) {
        v4u a0[2], a1[2], b0[2], b1[2];
#pragma unroll
        for (int u = 0; u < 2; ++u) { const size_t off = (size_t)(row + u * NGW) * DM + F.lane * 16; a0[u] = *(const v4u*)(O1 + off); a1[u] = *(const v4u*)(O1 + off + 8); b0[u] = *(const v4u*)(O2 + off); b1[u] = *(const v4u*)(O2 + off + 8); }
#pragma unroll
        for (int u = 0; u < 2; ++u) { const size_t off = (size_t)(row + u * NGW) * DM + F.lane * 16;
            const unsigned aw[8] = {a0[u].x, a0[u].y, a0[u].z, a0[u].w, a1[u].x, a1[u].y, a1[u].z, a1[u].w}, bw[8] = {b0[u].x, b0[u].y, b0[u].z, b0[u].w, b1[u].x, b1[u].y, b1[u].z, b1[u].w};
            float o[16]; float ss = 0.f;
#pragma unroll
            for (int i = 0; i < 8; ++i) { o[2 * i] = pg8::bf_lo(aw[i]) - lam * pg8::bf_lo(bw[i]); o[2 * i + 1] = pg8::bf_hi(aw[i]) - lam * pg8::bf_hi(bw[i]); ss += o[2 * i] * o[2 * i] + o[2 * i + 1] * o[2 * i + 1]; }
            ss += shx(ss, 1, F.lane); ss += shx(ss, 2, F.lane); ss += shx(ss, 4, F.lane);
            const float rstd = __builtin_amdgcn_rsqf(ss * (1.f / 128.f) + EPS);
            v4u w0, w1;
            w0.x = cvtpk(o[0] * rstd * gv[0], o[1] * rstd * gv[1]); w0.y = cvtpk(o[2] * rstd * gv[2], o[3] * rstd * gv[3]); w0.z = cvtpk(o[4] * rstd * gv[4], o[5] * rstd * gv[5]); w0.w = cvtpk(o[6] * rstd * gv[6], o[7] * rstd * gv[7]);
            w1.x = cvtpk(o[8] * rstd * gv[8], o[9] * rstd * gv[9]); w1.y = cvtpk(o[10] * rstd * gv[10], o[11] * rstd * gv[11]); w1.z = cvtpk(o[12] * rstd * gv[12], o[13] * rstd * gv[13]); w1.w = cvtpk(o[14] * rstd * gv[14], o[15] * rstd * gv[15]);
            *(v4u*)(OATT + off) = w0; *(v4u*)(OATT + off + 8) = w1; }
    }
}

__device__ __forceinline__ void attn_sample_unit(Frame& F, const float* cache_k, const float* cache_v, int l, int s, int head, const bf16* Qb, const bf16* Kb, const bf16* Vb, float lam, float osc, const float* gsub, bf16* OATT) {
    const int lane = F.lane, w = F.wave, q = lane & 31, hh = lane >> 5, vt = w & 3, kh = w >> 2;
    LAS float* SLOT = (LAS float*)(F.lds);
    LAS float* ML = (LAS float*)(F.lds + 16384);
    LAS float* SSQ = (LAS float*)(F.lds + 16384 + 512);
    const size_t qrow = (size_t)MP + (size_t)s * 32;
    const float* ck = cache_k + ((size_t)(l * 16 + s) * PAST) * 1024 + head * 128;
    const float* cv = cache_v + ((size_t)(l * 16 + s) * PAST) * 1024 + head * 128;
    f32x16 o1;
#pragma unroll
    for (int r = 0; r < 16; ++r) o1[r] = 0.f;
    for (int m = 0; m < 2; ++m) {
        bf16x8 qf[4];
#pragma unroll
        for (int ks = 0; ks < 4; ++ks) qf[ks] = *(const bf16x8*)(Qb + (qrow + q) * 1024 + head * 128 + m * 64 + ks * 16 + 8 * hh);
        float mrun = -INFINITY, lrun = 0.f; f32x16 ot;
#pragma unroll
        for (int r = 0; r < 16; ++r) ot[r] = 0.f;
        const int ntile = 32 + kh;
        for (int t = 0; t < ntile; ++t) {
            const bool nw = (t == 32); const int key0 = kh * 1024 + t * 32;
            bf16x8 kf[4];
            if (!nw) { const float* kp = ck + (size_t)(key0 + q) * 1024 + m * 64 + 8 * hh;
#pragma unroll
                for (int ks = 0; ks < 4; ++ks) { const f32x4 a = *(const f32x4*)(kp + ks * 16), b = *(const f32x4*)(kp + ks * 16 + 4); kf[ks] = pack8(a, b); } }
            else {
#pragma unroll
                for (int ks = 0; ks < 4; ++ks) kf[ks] = *(const bf16x8*)(Kb + (qrow + q) * 1024 + head * 128 + m * 64 + ks * 16 + 8 * hh); }
            float vf[2][8];
            { const float* vp = cv + (size_t)(key0 + 4 * hh) * 1024 + 32 * vt + q; const bf16* vpn = Vb + (qrow + 4 * hh) * 1024 + head * 128 + 32 * vt + q;
#pragma unroll
              for (int s2 = 0; s2 < 2; ++s2)
#pragma unroll
                  for (int j = 0; j < 8; ++j) { const int kr = 16 * s2 + 8 * (j >> 2) + (j & 3);
                      vf[s2][j] = nw ? bf2f(vpn[kr * 1024]) : vp[kr * 1024]; } }
            f32x16 st;
#pragma unroll
            for (int r = 0; r < 16; ++r) st[r] = 0.f;
#pragma unroll
            for (int ks = 0; ks < 4; ++ks) st = __builtin_amdgcn_mfma_f32_32x32x16_bf16(kf[ks], qf[ks], st, 0, 0, 0);
            float tm = st[0];
#pragma unroll
            for (int r = 1; r < 16; ++r) tm = __builtin_fmaxf(tm, st[r]);
            tm = __builtin_fmaxf(tm, shx(tm, 32, lane));
            const float mnew = __builtin_fmaxf(mrun, tm), alpha = __builtin_amdgcn_exp2f(mrun - mnew);
            float ls = 0.f;
#pragma unroll
            for (int r = 0; r < 16; ++r) { st[r] = __builtin_amdgcn_exp2f(st[r] - mnew); ls += st[r]; }
            ls += shx(ls, 32, lane);
            lrun = lrun * alpha + ls; mrun = mnew;
#pragma unroll
            for (int r = 0; r < 16; ++r) ot[r] *= alpha;
#pragma unroll
            for (int s2 = 0; s2 < 2; ++s2) { v4u pw; pw.x = cvtpk(st[8 * s2], st[8 * s2 + 1]); pw.y = cvtpk(st[8 * s2 + 2], st[8 * s2 + 3]); pw.z = cvtpk(st[8 * s2 + 4], st[8 * s2 + 5]); pw.w = cvtpk(st[8 * s2 + 6], st[8 * s2 + 7]);
                v4u aw; aw.x = cvtpk(vf[s2][0], vf[s2][1]); aw.y = cvtpk(vf[s2][2], vf[s2][3]); aw.z = cvtpk(vf[s2][4], vf[s2][5]); aw.w = cvtpk(vf[s2][6], vf[s2][7]);
                ot = __builtin_amdgcn_mfma_f32_32x32x16_bf16(__builtin_bit_cast(bf16x8, aw), __builtin_bit_cast(bf16x8, pw), ot, 0, 0, 0); }
        }
        if (vt == 0 && hh == 0) { ML[(kh * 32 + q) * 2] = mrun; ML[(kh * 32 + q) * 2 + 1] = lrun; }
        __syncthreads();
        const float m0 = ML[q * 2], l0 = ML[q * 2 + 1], m1 = ML[(32 + q) * 2], l1 = ML[(32 + q) * 2 + 1];
        const float Mx = __builtin_fmaxf(m0, m1), L = l0 * __builtin_amdgcn_exp2f(m0 - Mx) + l1 * __builtin_amdgcn_exp2f(m1 - Mx);
        { const float sc = __builtin_amdgcn_exp2f(mrun - Mx);
#pragma unroll
          for (int r = 0; r < 16; ++r) ot[r] *= sc; }
        if (kh == 1) {
#pragma unroll
            for (int r = 0; r < 16; ++r) SLOT[(vt * 16 + r) * 64 + lane] = ot[r]; }
        __syncthreads();
        if (kh == 0) { const float rl = 1.f / L;
#pragma unroll
            for (int r = 0; r < 16; ++r) ot[r] = (ot[r] + SLOT[(vt * 16 + r) * 64 + lane]) * rl;
            if (m == 0) {
#pragma unroll
                for (int r = 0; r < 16; ++r) o1[r] = ot[r];
            } else { float ss = 0.f;
#pragma unroll
                for (int r = 0; r < 16; ++r) { o1[r] = o1[r] - lam * ot[r]; ss += o1[r] * o1[r]; }
                ss += shx(ss, 32, lane);
                if (hh == 0) SSQ[vt * 32 + q] = ss; } }
        __syncthreads();
    }
    if (kh == 0) {
        const float ss = SSQ[q] + SSQ[32 + q] + SSQ[64 + q] + SSQ[96 + q];
        const float rstd = __builtin_amdgcn_rsqf(ss * (1.f / 128.f) + EPS) * osc;
#pragma unroll
        for (int r = 0; r < 16; ++r) { const int v = 32 * vt + (r & 3) + 8 * (r >> 2) + 4 * hh; OATT[(qrow + q) * 1024 + head * 128 + v] = (bf16)f2bf(o1[r] * rstd * gsub[v]); }
    }
    __syncthreads();
}

constexpr int HS = 72, HK = 136;
__device__ __forceinline__ f32x4 mfma16(bf16x8 a, bf16x8 b, f32x4 c) { return __builtin_amdgcn_mfma_f32_16x16x32_bf16(a, b, c, 0, 0, 0); }
__device__ __forceinline__ void st16bf(LAS bf16* p, const float (&v)[16]) {
    v4u a, b; a.x = cvtpk(v[0], v[1]); a.y = cvtpk(v[2], v[3]); a.z = cvtpk(v[4], v[5]); a.w = cvtpk(v[6], v[7]); b.x = cvtpk(v[8], v[9]); b.y = cvtpk(v[10], v[11]); b.z = cvtpk(v[12], v[13]); b.w = cvtpk(v[14], v[15]);
    *(LAS v4u*)p = a; *(LAS v4u*)(p + 8) = b;
}
__device__ __forceinline__ float bfu(unsigned b) { return __builtin_bit_cast(float, b << 16); }
struct HgPtrs { const float* LOGF; const bf16 *QQ, *KK, *VV, *HGS; const float* ghg; bf16* OH; bf16* dump; };
typedef float f32x2v __attribute__((ext_vector_type(2)));
__device__ __forceinline__ void hg_load(const HgPtrs& P, size_t ubase  , unsigned k0, int w, int nvalid, f32x2v (&lf)[8], unsigned (&qv)[8], unsigned (&kv)[8], unsigned (&vv)[8]) {
    if (w * 8 < nvalid) {
#pragma unroll
        for (int i = 0; i < 8; ++i) { const size_t o = ubase + (size_t)(w * 8 + i) * 1024;
            const float* lp = P.LOGF + o; const bf16* qp = P.QQ + o; const bf16* kp = P.KK + o; const bf16* vp = P.VV + o;
            lf[i] = *(const f32x2v*)(lp + k0); qv[i] = *(const unsigned*)(qp + k0); kv[i] = *(const unsigned*)(kp + k0); vv[i] = *(const unsigned*)(vp + k0); }
    } else {
#pragma unroll
        for (int i = 0; i < 8; ++i) { lf[i] = (f32x2v){0.f, 0.f}; qv[i] = 0u; kv[i] = 0u; vv[i] = 0u; }
    }
}
#define HG_BAR() asm volatile("s_waitcnt lgkmcnt(0)\n\ts_barrier" ::: "memory")
template <int MODE> __device__ __forceinline__ void hg_sequence(Frame& F, const HgPtrs& P, size_t row0, int h, int nchunk, int nvalid, const float* s_in, float* s_out, bf16* QS, float* RAW, float* dseg) {
    LAS float* seg = (LAS float*)(F.lds);
    LAS float* part = (LAS float*)(F.lds + 4096);
    LAS float* dvec = (LAS float*)(F.lds + 6144);
    LAS bf16* QH = (LAS bf16*)(F.lds + 8192);
    LAS bf16* QT = QH + 64 * HK;
    LAS bf16* KH = QT + 64 * HK;
    LAS bf16* VT = KH + 160 * HK;
    LAS bf16* KT = VT + 128 * HS;
    LAS bf16* AL = KT + 128 * HS;
    const int w = __builtin_amdgcn_readfirstlane(F.wave), sc = w >> 1, lr_ = F.lane & 15, lq_ = F.lane >> 4; const unsigned k0_ = 2u * (unsigned)F.lane;
    f32x4 S[8];
#pragma unroll
    for (int kb = 0; kb < 8; ++kb)
#pragma unroll
        for (int r = 0; r < 4; ++r) S[kb][r] = s_in ? s_in[(size_t)(16 * kb + 4 * lq_ + r) * 128 + 16 * w + lr_] : 0.f;
    const float gv = P.ghg[16 * w + lr_];
    f32x2v bseg = {0.f, 0.f};
    f32x2v lf[8]; unsigned qv[8], kv[8], vv[8];
    hg_load(P, row0 * 1024 + h * 128, k0_, w, nvalid, lf, qv, kv, vv);
    for (int c = 0; c < nchunk; ++c) {
        int lr = lr_, lq = lq_; unsigned k0 = k0_; asm volatile("" : "+v"(lr), "+v"(lq), "+v"(k0));
        const int lx = lq * 16 + lr;
        const size_t crow = row0 + (size_t)c * 64;
        f32x2v cs[8]; { f32x2v run = {0.f, 0.f};
#pragma unroll
            for (int i = 0; i < 8; ++i) { run = run + lf[i]; cs[i] = run; }
            *(LAS f32x2v*)(seg + w * 128 + k0) = run; }
        HG_BAR();
        f32x2v P2[4], mypre = {0.f, 0.f}, tot; { f32x2v p = {0.f, 0.f};
#pragma unroll
            for (int s = 0; s < 8; ++s) { if ((s & 1) == 0) P2[s >> 1] = p; mypre = (s == w) ? p : mypre; p = p + *(const LAS f32x2v*)(seg + s * 128 + k0); } tot = p; }
        f32x2v myref = P2[0], nref = P2[1];
#pragma unroll
        for (int s = 1; s < 4; ++s) { myref = (s == sc) ? P2[s] : myref; nref = (s == sc) ? (s == 3 ? tot : P2[s < 3 ? s + 1 : 3]) : nref; }
        const f32x2v dq = mypre - myref;
        f32x2v fq, fT, fK[4]; fq.x = __expf(myref.x); fq.y = __expf(myref.y); fT.x = __expf(tot.x - nref.x); fT.y = __expf(tot.y - nref.y);
#pragma unroll
        for (int ii = 1; ii < 4; ++ii) { fK[ii].x = __expf(__builtin_fminf(P2[ii].x - nref.x, 0.f)); fK[ii].y = __expf(__builtin_fminf(P2[ii].y - nref.y, 0.f)); }
        f32x2v fqs = fq; if constexpr (MODE == 1) { fqs.x = fq.x * __expf(bseg.x); fqs.y = fq.y * __expf(bseg.y); bseg = bseg + tot; }
        float t0[8], t1[8];
#pragma unroll
        for (int i = 0; i < 8; ++i) { const int r = w * 8 + i; const float q0 = bfu(qv[i] & 0xffffu), q1 = bfu(qv[i] >> 16), a0 = bfu(kv[i] & 0xffffu), a1 = bfu(kv[i] >> 16);
            const float E0 = dq.x + cs[i].x, E1 = dq.y + cs[i].y;
            const float e1x = __expf(E0), e1y = __expf(E1);
            const float e2x = __builtin_fminf(__builtin_amdgcn_rcpf(e1x), 5.5e34f), e2y = __builtin_fminf(__builtin_amdgcn_rcpf(e1y), 5.5e34f);
            const float e3x = __expf((nref.x - myref.x) - E0), e3y = __expf((nref.y - myref.y) - E1);
            *(LAS unsigned*)(QH + r * HK + k0) = cvtpk(q0 * e1x, q1 * e1y);
            *(LAS unsigned*)(QT + r * HK + k0) = cvtpk(q0 * e1x * fq.x, q1 * e1y * fq.y);
            if constexpr (MODE == 1) { bf16* qsp = QS + (crow + r) * 1024 + h * 128; *(unsigned*)(qsp + k0) = cvtpk(q0 * e1x * fqs.x, q1 * e1y * fqs.y); }
            const float b0 = a0 * e3x, b1 = a1 * e3y;
            { const int rb = (sc == 0) ? 0 : (sc == 1) ? 16 : (sc == 2) ? 48 : 96; *(LAS unsigned*)(KH + (rb + r) * HK + k0) = cvtpk(a0 * e2x, a1 * e2y); }
#pragma unroll
            for (int ii = 1; ii < 4; ++ii) if (ii > sc) { const int rb = (ii == 1) ? 16 : (ii == 2) ? 48 : 96; *(LAS unsigned*)(KH + (rb + r) * HK + k0) = cvtpk(b0 * fK[ii].x, b1 * fK[ii].y); }
            t0[i] = b0 * fT.x; t1[i] = b1 * fT.y; }
        { v4u u0, u1; u0.x = cvtpk(t0[0], t0[1]); u0.y = cvtpk(t0[2], t0[3]); u0.z = cvtpk(t0[4], t0[5]); u0.w = cvtpk(t0[6], t0[7]); u1.x = cvtpk(t1[0], t1[1]); u1.y = cvtpk(t1[2], t1[3]); u1.z = cvtpk(t1[4], t1[5]); u1.w = cvtpk(t1[6], t1[7]);
          *(LAS v4u*)(KT + k0 * HS + 8 * w) = u0; *(LAS v4u*)(KT + (k0 + 1) * HS + 8 * w) = u1; }
        { v4u u0, u1;
          u0.x = (vv[0] & 0xffffu) | (vv[1] << 16); u0.y = (vv[2] & 0xffffu) | (vv[3] << 16); u0.z = (vv[4] & 0xffffu) | (vv[5] << 16); u0.w = (vv[6] & 0xffffu) | (vv[7] << 16);
          u1.x = (vv[0] >> 16) | (vv[1] & 0xffff0000u); u1.y = (vv[2] >> 16) | (vv[3] & 0xffff0000u); u1.z = (vv[4] >> 16) | (vv[5] & 0xffff0000u); u1.w = (vv[6] >> 16) | (vv[7] & 0xffff0000u);
          *(LAS v4u*)(VT + k0 * HS + 8 * w) = u0; *(LAS v4u*)(VT + (k0 + 1) * HS + 8 * w) = u1;
          if (w == 0) { f32x2v d; d.x = __expf(tot.x); d.y = __expf(tot.y); *(LAS f32x2v*)(dvec + k0) = d; } }
        HG_BAR();
        if (c + 1 < nchunk) hg_load(P, (crow + 64) * 1024 + h * 128, k0, w, nvalid, lf, qv, kv, vv);
        unsigned short hgv[16];
        if constexpr (MODE == 0) { const bf16* hp = P.HGS + crow * 1024 + h * 128 + 16 * w;
#pragma unroll
          for (int mt = 0; mt < 4; ++mt)
#pragma unroll
              for (int r = 0; r < 4; ++r) { int t = 16 * mt + 4 * lq + r; t = t < nvalid ? t : nvalid - 1; hgv[mt * 4 + r] = hp[(unsigned)(t * 1024 + lr)]; } }
#pragma unroll
        for (int rr = 0; rr < 2; ++rr) { const int blk = w + 8 * rr, bi = blk >> 2, bj = blk & 3;
            f32x4 acc = {0.f, 0.f, 0.f, 0.f};
            if (bj <= bi) { const int rb = (bi == 0) ? 0 : (bi == 1) ? 16 : (bi == 2) ? 48 : 96;
#pragma unroll
                for (int ks = 0; ks < 4; ++ks) { const bf16x8 a = *(const LAS bf16x8*)(QH + (16 * bi + lr) * HK + ks * 32 + 8 * lq), b = *(const LAS bf16x8*)(KH + (rb + 16 * bj + lr) * HK + ks * 32 + 8 * lq); acc = mfma16(a, b, acc); }
                if (bi == bj) {
#pragma unroll
                    for (int r = 0; r < 4; ++r) acc[r] = (lr <= 4 * lq + r) ? acc[r] : 0.f; } }
#pragma unroll
            for (int r = 0; r < 4; ++r) AL[(16 * bi + 4 * lq + r) * HS + 16 * bj + lr] = (bf16)f2bf(acc[r]); }
        HG_BAR();
        f32x4 o[4];
        { bf16x8 bS[4], bV[2];
#pragma unroll
          for (int kp = 0; kp < 4; ++kp) { v4u t; t.x = cvtpk(S[2 * kp][0], S[2 * kp][1]); t.y = cvtpk(S[2 * kp][2], S[2 * kp][3]); t.z = cvtpk(S[2 * kp + 1][0], S[2 * kp + 1][1]); t.w = cvtpk(S[2 * kp + 1][2], S[2 * kp + 1][3]); bS[kp] = __builtin_bit_cast(bf16x8, t); }
#pragma unroll
          for (int ks = 0; ks < 2; ++ks) bV[ks] = *(const LAS bf16x8*)(VT + (16 * w + lr) * HS + ks * 32 + 8 * lq);
#pragma unroll
          for (int mt = 0; mt < 4; ++mt) { f32x4 acc = {0.f, 0.f, 0.f, 0.f};
#pragma unroll
              for (int kp = 0; kp < 4; ++kp) { const LAS bf16* qp = QT + (16 * mt + lr) * HK + 32 * kp + 4 * lq; const v2u a0 = *(const LAS v2u*)qp, a1 = *(const LAS v2u*)(qp + 16);
                  v4u a; a.x = a0.x; a.y = a0.y; a.z = a1.x; a.w = a1.y; acc = mfma16(__builtin_bit_cast(bf16x8, a), bS[kp], acc); }
#pragma unroll
              for (int ks = 0; ks < 2; ++ks) acc = mfma16(*(const LAS bf16x8*)(AL + (16 * mt + lr) * HS + ks * 32 + 8 * lq), bV[ks], acc);
              o[mt] = acc;
              if constexpr (MODE == 1) { float* rp = RAW + (crow + 16 * mt) * 1024 + h * 128 + 16 * w;
#pragma unroll
                  for (int r = 0; r < 4; ++r) rp[(unsigned)((4 * lq + r) * 1024 + lr)] = acc[r]; }
              if constexpr (MODE == 0)
#pragma unroll
              for (int r = 0; r < 4; ++r) { float p = acc[r] * acc[r]; p += shx(p, 1, lx); p += shx(p, 2, lx); p += shx(p, 4, lx); p += shx(p, 8, lx); if (lr == 0) part[(16 * mt + 4 * lq + r) * 8 + w] = p; } } }
        { bf16x8 bV[2];
#pragma unroll
          for (int ks = 0; ks < 2; ++ks) bV[ks] = *(const LAS bf16x8*)(VT + (16 * w + lr) * HS + ks * 32 + 8 * lq);
#pragma unroll
          for (int kb = 0; kb < 8; ++kb) { const f32x4 d = *(const LAS f32x4*)(dvec + 16 * kb + 4 * lq); f32x4 acc = S[kb] * d;
#pragma unroll
              for (int ks = 0; ks < 2; ++ks) acc = mfma16(*(const LAS bf16x8*)(KT + (16 * kb + lr) * HS + ks * 32 + 8 * lq), bV[ks], acc);
              S[kb] = acc; } }
        if constexpr (MODE == 0) {
        HG_BAR();
        { bf16* op = P.OH + crow * 1024 + h * 128 + 16 * w;
#pragma unroll
          for (int mt = 0; mt < 4; ++mt)
#pragma unroll
              for (int r = 0; r < 4; ++r) { const int t = 16 * mt + 4 * lq + r; const f32x4 p0 = *(const LAS f32x4*)(part + t * 8), p1 = *(const LAS f32x4*)(part + t * 8 + 4);
                  const float ss = ((p0[0] + p0[1]) + (p0[2] + p0[3])) + ((p1[0] + p1[1]) + (p1[2] + p1[3]));
                  const float rstd = __builtin_amdgcn_rsqf(ss * (1.f / 128.f) + EPS);
                  const bf16 ov = (bf16)f2bf(o[mt][r] * rstd * gv * bf2f(hgv[mt * 4 + r]));
                  bf16* dst = (t < nvalid) ? op + (unsigned)(t * 1024 + lr) : P.dump + F.tid;
                  *dst = ov; } }
        }
        HG_BAR();
    }
#pragma unroll
    for (int kb = 0; kb < 8; ++kb)
#pragma unroll
        for (int r = 0; r < 4; ++r) s_out[(size_t)(16 * kb + 4 * lq_ + r) * 128 + 16 * w + lr_] = S[kb][r];
    if constexpr (MODE == 1) { if (w == 0) { f32x2v d; d.x = __expf(bseg.x); d.y = __expf(bseg.y); *(f32x2v*)(dseg + k0_) = d; } }
}

__device__ __forceinline__ void hg_fix(Frame& F, const HgPtrs& P, size_t row0, int h, int nchunk, int g, int G, const float* SLseq, const float* DSseq, const bf16* QS, const float* RAW, gu32* mask, float* s_fin) {
    LAS float* part = (LAS float*)(F.lds);
    const int w = __builtin_amdgcn_readfirstlane(F.wave), lr_ = F.lane & 15, lq_ = F.lane >> 4;
    if (F.tid == 0) { const unsigned need = (1u << g) - 1u; unsigned sp = 0;
        while ((__hip_atomic_load(mask, RLX_AGENT) & need) != need) { __builtin_amdgcn_s_sleep(2); if (++sp > (1u << 22)) { __hip_atomic_store(F.ctl + 1, 0x7eb0u, RLX_AGENT); break; } }
        __builtin_amdgcn_fence(__ATOMIC_ACQUIRE, "agent"); asm volatile("s_waitcnt vmcnt(0)" ::: "memory"); }
    __syncthreads();
    f32x4 S[8];
#pragma unroll
    for (int kb = 0; kb < 8; ++kb) S[kb] = (f32x4){0.f, 0.f, 0.f, 0.f};
    for (int p = 0; p < g; ++p) { const float* sl = SLseq + (size_t)p * 16384; const float* ds = DSseq + p * 128;
#pragma unroll
        for (int kb = 0; kb < 8; ++kb) { const f32x4 d = *(const f32x4*)(ds + 16 * kb + 4 * lq_);
#pragma unroll
            for (int r = 0; r < 4; ++r) S[kb][r] = d[r] * S[kb][r] + sl[(size_t)(16 * kb + 4 * lq_ + r) * 128 + 16 * w + lr_]; } }
    if (g == G - 1) { const float* sl = SLseq + (size_t)g * 16384; const float* ds = DSseq + g * 128;
#pragma unroll
        for (int kb = 0; kb < 8; ++kb) { const f32x4 d = *(const f32x4*)(ds + 16 * kb + 4 * lq_);
#pragma unroll
            for (int r = 0; r < 4; ++r) { const size_t o = (size_t)(16 * kb + 4 * lq_ + r) * 128 + 16 * w + lr_; s_fin[o] = d[r] * S[kb][r] + sl[o]; } } }
    bf16x8 bS[4];
#pragma unroll
    for (int kp = 0; kp < 4; ++kp) { v4u t; t.x = cvtpk(S[2 * kp][0], S[2 * kp][1]); t.y = cvtpk(S[2 * kp][2], S[2 * kp][3]); t.z = cvtpk(S[2 * kp + 1][0], S[2 * kp + 1][1]); t.w = cvtpk(S[2 * kp + 1][2], S[2 * kp + 1][3]); bS[kp] = __builtin_bit_cast(bf16x8, t); }
    const float gv = P.ghg[16 * w + lr_];
    f32x4 on[4]; unsigned short hn[16]; v2u qn[4][4][2];
#define HGF_LOAD(cc) do { const size_t cr_ = row0 + (size_t)(cc) * 64; const bf16* hp = P.HGS + cr_ * 1024 + h * 128 + 16 * w; const float* rp = RAW + cr_ * 1024 + h * 128 + 16 * w; \
        _Pragma("unroll") for (int mt = 0; mt < 4; ++mt) { \
            _Pragma("unroll") for (int r = 0; r < 4; ++r) { const unsigned off = (unsigned)((16 * mt + 4 * lq_ + r) * 1024 + lr_); on[mt][r] = rp[off]; hn[mt * 4 + r] = hp[off]; } \
            const bf16* qb = QS + (cr_ + 16 * mt) * 1024 + h * 128; \
            _Pragma("unroll") for (int kp = 0; kp < 4; ++kp) { const bf16* qp = qb + (unsigned)(lr_ * 1024 + 32 * kp + 4 * lq_); qn[mt][kp][0] = *(const v2u*)qp; qn[mt][kp][1] = *(const v2u*)(qp + 16); } } } while (0)
    HGF_LOAD(0);
    for (int c = 0; c < nchunk; ++c) {
        int lr = lr_, lq = lq_; asm volatile("" : "+v"(lr), "+v"(lq)); const int lx = lq * 16 + lr;
        const size_t crow = row0 + (size_t)c * 64;
        LAS float* pt = part + (c & 1) * 512;
        f32x4 o[4]; unsigned short hgv[16];
#pragma unroll
        for (int mt = 0; mt < 4; ++mt) { f32x4 acc = on[mt];
#pragma unroll
            for (int r = 0; r < 4; ++r) hgv[mt * 4 + r] = hn[mt * 4 + r];
#pragma unroll
            for (int kp = 0; kp < 4; ++kp) { v4u a; a.x = qn[mt][kp][0].x; a.y = qn[mt][kp][0].y; a.z = qn[mt][kp][1].x; a.w = qn[mt][kp][1].y; acc = mfma16(__builtin_bit_cast(bf16x8, a), bS[kp], acc); }
            o[mt] = acc; }
        asm volatile("" ::: "memory");
        if (c + 1 < nchunk) HGF_LOAD(c + 1);
        asm volatile("" ::: "memory");
#pragma unroll
        for (int mt = 0; mt < 4; ++mt)
#pragma unroll
            for (int r = 0; r < 4; ++r) { float p = o[mt][r] * o[mt][r]; p += shx(p, 1, lx); p += shx(p, 2, lx); p += shx(p, 4, lx); p += shx(p, 8, lx); if (lr == 0) pt[(16 * mt + 4 * lq + r) * 8 + w] = p; }
        HG_BAR();
        { bf16* op = P.OH + crow * 1024 + h * 128 + 16 * w;
#pragma unroll
          for (int mt = 0; mt < 4; ++mt)
#pragma unroll
              for (int r = 0; r < 4; ++r) { const int t = 16 * mt + 4 * lq + r; const f32x4 p0 = *(const LAS f32x4*)(pt + t * 8), p1 = *(const LAS f32x4*)(pt + t * 8 + 4);
                  const float ss = ((p0[0] + p0[1]) + (p0[2] + p0[3])) + ((p1[0] + p1[1]) + (p1[2] + p1[3]));
                  const float rstd = __builtin_amdgcn_rsqf(ss * (1.f / 128.f) + EPS);
                  op[(unsigned)(t * 1024 + lr)] = (bf16)f2bf(o[mt][r] * rstd * gv * bf2f(hgv[mt * 4 + r])); } }
    }
#undef HGF_LOAD
    __syncthreads();
}
#undef HG_BAR
__device__ __forceinline__ void team_barrier(Frame& F, gu32* w, unsigned target) {
    asm volatile("s_waitcnt vmcnt(0)" ::: "memory");
    __syncthreads();
    if (F.tid == 0) {
        __builtin_amdgcn_fence(__ATOMIC_RELEASE, "agent");
        asm volatile("s_waitcnt vmcnt(0)" ::: "memory");
        (void)__hip_atomic_fetch_add(w, 1u, RLX_AGENT);
        unsigned sp = 0;
        while (__hip_atomic_load(w, RLX_AGENT) < target) { __builtin_amdgcn_s_sleep(2); if (++sp > (1u << 22)) { __hip_atomic_store(F.ctl + 1, 0x7ea0u, RLX_AGENT); break; } }
        __builtin_amdgcn_fence(__ATOMIC_ACQUIRE, "agent");
        asm volatile("s_waitcnt vmcnt(0)" ::: "memory");
    }
    __syncthreads();
}
__device__ __forceinline__ int attn_pull(Frame& F, gu32* q8  , int x0, int nitems) {
    if (F.tid == 0) {
        int res = -1;
        for (int tries = 0; tries < 16; ++tries) {
            unsigned c[8]; unsigned cmin = 0xffffffffu; int imin = 0;
#pragma unroll
            for (int h = 0; h < 8; ++h) { c[h] = __hip_atomic_load(q8 + 64 * h, RLX_AGENT); if (c[h] < cmin) { cmin = c[h]; imin = h; } }
            if (cmin >= (unsigned)nitems) break;
            unsigned cx = c[0];
#pragma unroll
            for (int h = 1; h < 8; ++h) cx = (h == x0) ? c[h] : cx;
            const int hsel = (cx < (unsigned)nitems && cx <= cmin + 6u) ? x0 : imin;
            const unsigned it = __hip_atomic_fetch_add(q8 + 64 * hsel, 1u, RLX_AGENT);
            if (it < (unsigned)nitems) { res = (hsel << 16) | (int)it; break; }
        }
        F.MISC[16] = (unsigned)res;
    }
    __syncthreads();
    const int v = (int)F.MISC[16];
    __syncthreads();
    return __builtin_amdgcn_readfirstlane(v);
}
__device__ __forceinline__ int wg_pull(Frame& F, gu32* ctr) {
    if (F.tid == 0) F.MISC[16] = __hip_atomic_fetch_add(ctr, 1u, RLX_AGENT);
    __syncthreads();
    const int v = (int)F.MISC[16];
    __syncthreads();
    return __builtin_amdgcn_readfirstlane(v);
}
#ifdef PROBE_ID
#define PT_BEGIN(id) unsigned long long pt0_##id = 0; if ((id) == PROBE_ID && blockIdx.x == 0) pt0_##id = __builtin_amdgcn_s_memrealtime()
#define PT_END(id) do { if ((id) == PROBE_ID && blockIdx.x == 0) { const unsigned long long t1 = __builtin_amdgcn_s_memrealtime(), d = t1 - pt0_##id; while (__builtin_amdgcn_s_memrealtime() - t1 < d) __builtin_amdgcn_s_sleep(8); } } while (0)
#else
#define PT_BEGIN(id) do {} while (0)
#define PT_END(id) do {} while (0)
#endif
struct Args { const float* in[25]; float* out; unsigned char* ws; };
__global__ void __launch_bounds__(NWAVES * 64, 2) mk_fwd(Args args) {
    extern __shared__ __attribute__((aligned(16))) unsigned char lds[];
    Frame F;
    F.lds = (LAS unsigned char*)lds;
    F.MISC = (volatile LAS unsigned*)(F.lds + MISC_OFF);
#define ENTER() do { F.tid = opaque_tid(); F.lane = F.tid & 63; F.wave = __builtin_amdgcn_readfirstlane(F.tid >> 6); F.G = gridDim.x; { const int bx = opaque_bid(); F.vcu = (F.G % 8 == 0) ? (bx % 8) * (F.G / 8) + bx / 8 : bx; } } while (0)
    for (int u = threadIdx.x; u < (LDS_BYTES - LDSCTL_OFF) / 4; u += NWAVES * 64) ((LAS unsigned*)(F.lds + LDSCTL_OFF))[u] = 0u;
    __syncthreads();
    tid_table_init();
    __syncthreads();
    static_assert(WTAB_LDS_ADDR == (unsigned)(MISC_OFF + 256) && MISC_OFF + 256 + 256 <= LDS_BYTES, "wave-slot table inside the LDS control area");
    ENTER();
    F.ctl = (gu32*)((unsigned char*)karg(A_WS) + WS_CTL);
    XcdBarrier bar = xcd_barrier_post((unsigned*)(F.ctl + CW_BAR), F.MISC + 8);
#define GRID_BAR() do { asm volatile("" : "+s"(bar.x)); xcd_barrier(bar); } while (0)
#define WSP(T, off) ((T*)((unsigned char*)karg(A_WS) + (off)))
#define OUTP(off) ((float*)karg(A_OUT) + (off))

#ifndef NO_P0
    p0_prologue(F, WSP(unsigned char, 0));
#ifdef DUP_P0
    GRID_BAR(); ENTER(); p0_prologue(F, WSP(unsigned char, 0));
#endif
#endif
    GRID_BAR();

    for (int l = 0; l < DEPTH; ++l) {
        const size_t wlo = WS_W + (size_t)l * W_LAYER, modo = WS_MOD + (size_t)l * NSEQ * 9216 * 4;
        norm_phase(F, WSP(const float, WS_X), karg(A_GFFN1) + l * 1024, WSP(const float, modo), 0, WSP(bf16, WS_XN), 0, MP, F.vcu * NWAVES + F.wave, 256 * NWAVES);
#ifdef DUP_THIN
        GRID_BAR(); ENTER();
        norm_phase(F, WSP(const float, WS_X), karg(A_GFFN1) + l * 1024, WSP(const float, modo), 0, WSP(bf16, WS_XN), 0, MP, F.vcu * NWAVES + F.wave, 256 * NWAVES);
#endif
        GRID_BAR(); ENTER();
#ifndef NO_G1
        { pg8::Gemm g{WSP(bf16, WS_XN), WSP(const bf16, wlo + WO_GU1), MP, 2 * DFF, DM}; typedef pg8::FixedOrder<128, 22, 8> Ord; Ord S; S.init(F.G, opaque_bid());
          pg8::EpiSwiglu E{WSP(bf16, WS_BIG)};
          pg8::gemm_phase<pg8::EpiSwiglu, Ord, true, true>(F.lds + RING_OFF, g, S, E);
#ifdef DUP_G1
          GRID_BAR(); ENTER(); pg8::gemm_phase<pg8::EpiSwiglu, Ord, true, true>(F.lds + RING_OFF, g, S, E);
#endif
        }
#endif
        GRID_BAR(); ENTER();
#ifndef NO_G2
        { pg8::Gemm g{WSP(bf16, WS_BIG), WSP(const bf16, wlo + WO_D1), MP, DM, DFF}; typedef pg8::FixedOrder<128, 4, 8> Ord; Ord S; S.init(F.G, opaque_bid());
          pg8::EpiResid E{WSP(float, WS_X), WSP(const float, modo) + 2 * 1024, 0.5f};
          pg8::gemm_phase<pg8::EpiResid, Ord, true, true>(F.lds + RING_OFF, g, S, E);
#ifdef DUP_RES
          GRID_BAR(); ENTER(); { pg8::EpiResid E0{E.X, E.gate, 0.f}; pg8::gemm_phase<pg8::EpiResid, Ord, true, true>(F.lds + RING_OFF, g, S, E0); }
#endif
        }
#endif
        GRID_BAR(); ENTER();
        norm_phase(F, WSP(const float, WS_X), karg(A_GMIX) + l * 1024, WSP(const float, modo), 1, WSP(bf16, WS_XN), 0, MP, F.vcu * NWAVES + F.wave, 256 * NWAVES);
#ifdef DUP_THIN
        GRID_BAR(); ENTER();
        norm_phase(F, WSP(const float, WS_X), karg(A_GMIX) + l * 1024, WSP(const float, modo), 1, WSP(bf16, WS_XN), 0, MP, F.vcu * NWAVES + F.wave, 256 * NWAVES);
#endif
        GRID_BAR(); ENTER();
        PT_BEGIN(2);
#ifndef NO_G3
        { pg8::Gemm g{WSP(bf16, WS_XN), WSP(const bf16, wlo + WO_IN), MP, DIN, DM}; typedef pg8::FixedOrder<128, 36, 8> Ord; Ord S; S.init(F.G, opaque_bid());
          pg8::EpiWin E{WSP(unsigned char, 0), OUTP(0), l, attn_body::C2};
          pg8::gemm_phase<pg8::EpiWin, Ord, true, true>(F.lds + RING_OFF, g, S, E);
#ifdef PROBE_G3NULL
          GRID_BAR(); ENTER(); PT_BEGIN(3); { float* sk_ = nullptr; asm volatile("" : "+s"(sk_)); pg8::EpiNull E0{sk_}; pg8::gemm_phase<pg8::EpiNull, Ord, true, true>(F.lds + RING_OFF, g, S, E0); } GRID_BAR(); ENTER(); PT_END(3);
#endif
        }
#endif
        GRID_BAR(); ENTER();
        PT_END(2);
        PT_BEGIN(1);
        { gu32* qbase = F.ctl + CW_Q + 64 * (l * 16);
          const int tk = wg_pull(F, qbase + 64 * 9);
#ifdef PROBE_ROLE
          const unsigned long long pr0 = __builtin_amdgcn_s_memrealtime();
#endif
          constexpr int T_EFF = T_TEAM;
          const bool team = (tk % TEAM_STRIDE) == 0, hfirst = (tk % TEAM_STRIDE) >= 1 && (tk % TEAM_STRIDE) <= STARTERS; const int ticket = tk / TEAM_STRIDE; gu32* tb = qbase + 64 * 10; unsigned tstage = 0;
#define TEAM_BAR() do { ++tstage; team_barrier(F, tb, (unsigned)T_EFF * tstage); ENTER(); } while (0)
#ifndef NO_TEAM
          if (team) {
              const int tgw = ticket * NWAVES + F.wave, TNW = T_EFF * NWAVES;
              norm_phase(F, WSP(const float, WS_X), karg(A_GFFN1) + l * 1024, WSP(const float, modo), 0, WSP(bf16, WS_XN), MP, MROWS, tgw, TNW);
              TEAM_BAR();
              { pg8::Gemm g{WSP(bf16, WS_XN), WSP(const bf16, wlo + WO_GU1), MROWS, 2 * DFF, DM}; typedef pg8::TeamOrder<22> Ord; Ord S; S.init(T_EFF, ticket);
                pg8::EpiSwiglu E{WSP(bf16, WS_BIG)};
                pg8::gemm_phase<pg8::EpiSwiglu, Ord, true, true>(F.lds + RING_OFF, g, S, E); }
              TEAM_BAR();
              { pg8::Gemm g{WSP(bf16, WS_BIG), WSP(const bf16, wlo + WO_D1), MROWS, DM, DFF}; typedef pg8::TeamOrder<4> Ord; Ord S; S.init(T_EFF, ticket);
                pg8::EpiResid E{WSP(float, WS_X), WSP(const float, modo) + 2 * 1024, 0.5f};
                pg8::gemm_phase<pg8::EpiResid, Ord, true, true>(F.lds + RING_OFF, g, S, E); }
              TEAM_BAR();
              norm_phase(F, WSP(const float, WS_X), karg(A_GMIX) + l * 1024, WSP(const float, modo), 1, WSP(bf16, WS_XN), MP, MROWS, ticket * NWAVES + F.wave, T_EFF * NWAVES);
              TEAM_BAR();
              { pg8::Gemm g{WSP(bf16, WS_XN), WSP(const bf16, wlo + WO_IN), MROWS, DIN, DM}; typedef pg8::TeamOrder<36> Ord; Ord S; S.init(T_EFF, ticket);
                pg8::EpiWin E{WSP(unsigned char, 0), OUTP(0), l, attn_body::C2};
                pg8::gemm_phase<pg8::EpiWin, Ord, true, true>(F.lds + RING_OFF, g, S, E); }
              TEAM_BAR();
          }
#endif
          if (hfirst) {
            for (;;) { const int it = wg_pull(F, qbase); if (it >= 32 * HG_G) break;
              const HgPtrs P{WSP(const float, WS_LOGF), WSP(const bf16, WS_QQ), WSP(const bf16, WS_KK), WSP(const bf16, WS_VV), WSP(const bf16, WS_HGS), karg(A_GHG) + l * 128, WSP(bf16, WS_OH), WSP(bf16, WS_DD)};
#ifndef NO_H
                  const int sqh = it / HG_G, g = it % HG_G, b = sqh >> 3, h = sqh & 7; const int nch = 128 / HG_G;
                  const size_t r0 = (size_t)b * 8192 + (size_t)g * nch * 64;
                  float* SLq = WSP(float, WS_SL) + (size_t)sqh * HG_G * 16384; float* DSq = WSP(float, WS_DSEG) + (size_t)sqh * HG_G * 128;
                  gu32* mask = F.ctl + CW_HS + 64 * (l * 32 + sqh);
                  hg_sequence<1>(F, P, r0, h, nch, 64, nullptr, SLq + (size_t)g * 16384, WSP(bf16, WS_QS), WSP(float, WS_RAW), DSq + g * 128);
                  asm volatile("s_waitcnt vmcnt(0)" ::: "memory"); __syncthreads();
                  if (F.tid == 0) { __builtin_amdgcn_fence(__ATOMIC_RELEASE, "agent"); asm volatile("s_waitcnt vmcnt(0)" ::: "memory"); (void)__hip_atomic_fetch_or(mask, 1u << g, RLX_AGENT); }
                  ENTER();
                  hg_fix(F, P, r0, h, nch, g, HG_G, SLq, DSq, WSP(const bf16, WS_QS), WSP(const float, WS_RAW), mask, OUTP(0) + OS_P + ((size_t)((l * 4 + b) * 8 + h)) * 16384);
                  ENTER();
#endif
            }
            if (F.tid == 0) { unsigned sp = 0; while (__hip_atomic_load(tb, RLX_AGENT) < (unsigned)T_EFF * 5u) { __builtin_amdgcn_s_sleep(2); if (++sp > (1u << 22)) { __hip_atomic_store(F.ctl + 1, 0x7ec0u, RLX_AGENT); break; } }
                __builtin_amdgcn_fence(__ATOMIC_ACQUIRE, "agent"); asm volatile("s_waitcnt vmcnt(0)" ::: "memory"); }
            __syncthreads(); ENTER();
          }
          if (team || hfirst) {
            gu32* qs = qbase + 64 * 11; gu32* done = qbase + 64 * 12;
            for (;;) { const int it = wg_pull(F, qs); if (it >= 256) break;
              const HgPtrs P{WSP(const float, WS_LOGF), WSP(const bf16, WS_QQ), WSP(const bf16, WS_KK), WSP(const bf16, WS_VV), WSP(const bf16, WS_HGS), karg(A_GHG) + l * 128, WSP(bf16, WS_OH), WSP(bf16, WS_DD)};
              if (it < 128) {
#ifndef NO_H
                  const int sq = it >> 3, h = it & 7; const size_t so = OS_S + ((size_t)((l * 16 + sq) * 8 + h)) * 16384;
                  hg_sequence<0>(F, P, (size_t)MP + (size_t)sq * 32, h, 1, 32, karg(A_ST) + ((size_t)((l * 16 + sq) * 8 + h)) * 16384, OUTP(0) + so, nullptr, nullptr, nullptr);
#endif
              } else {
#ifndef NO_SAMP
                  const int u = it - 128; const float lam = lam_of(karg(A_LAM), l, F.lane), osc = 1.f - lam_init_of(l);
                  attn_sample_unit(F, karg(A_CK), karg(A_CV), l, u >> 3, u & 7, WSP(const bf16, WS_Q), WSP(const bf16, WS_K), WSP(const bf16, WS_V), lam, osc, karg(A_GSUB) + l * 128, WSP(bf16, WS_OATT));
#endif
              }
              asm volatile("s_waitcnt vmcnt(0)" ::: "memory"); __syncthreads();
              if (F.tid == 0) { __builtin_amdgcn_fence(__ATOMIC_RELEASE, "agent"); asm volatile("s_waitcnt vmcnt(0)" ::: "memory"); (void)__hip_atomic_fetch_add(done, 1u, RLX_AGENT); }
              ENTER(); }
            if (team) {
                if (F.tid == 0) { unsigned sp = 0; while (__hip_atomic_load(done, RLX_AGENT) < 256u) { __builtin_amdgcn_s_sleep(2); if (++sp > (1u << 22)) { __hip_atomic_store(F.ctl + 1, 0x7ed0u, RLX_AGENT); break; } }
                    __builtin_amdgcn_fence(__ATOMIC_ACQUIRE, "agent"); asm volatile("s_waitcnt vmcnt(0)" ::: "memory"); }
                __syncthreads(); ENTER(); } }
#ifndef NO_TEAM
          if (team) {
              { pg8::Gemm g{WSP(bf16, WS_OATT), WSP(const bf16, wlo + WO_BA), MROWS, DM, DM}; typedef pg8::TeamOrder<4> Ord; Ord S; S.init(T_EFF, ticket);
                pg8::EpiGateT E{WSP(float, WS_LOGF), WSP(const bf16, WS_SZA)};
                pg8::gemm_phase<pg8::EpiGateT, Ord, true, true>(F.lds + RING_OFF, g, S, E); }
              TEAM_BAR();
              { pg8::Gemm g{WSP(bf16, WS_OH), WSP(const bf16, wlo + WO_BH), MROWS, DM, DM}; typedef pg8::TeamOrder<4> Ord; Ord S; S.init(T_EFF, ticket);
                pg8::EpiGateM E{WSP(const float, WS_LOGF), WSP(const bf16, WS_SZH), WSP(bf16, WS_MRG)};
                pg8::gemm_phase<pg8::EpiGateM, Ord, true, true>(F.lds + RING_OFF, g, S, E); }
              TEAM_BAR();
              { pg8::Gemm g{WSP(bf16, WS_MRG), WSP(const bf16, wlo + WO_OUT), MROWS, DM, DM}; typedef pg8::TeamOrder<4> Ord; Ord S; S.init(T_EFF, ticket);
                pg8::EpiResid E{WSP(float, WS_X), WSP(const float, modo) + 5 * 1024, 1.0f};
                pg8::gemm_phase<pg8::EpiResid, Ord, true, true>(F.lds + RING_OFF, g, S, E); }
              TEAM_BAR();
              norm_phase(F, WSP(const float, WS_X), karg(A_GFFN2) + l * 1024, WSP(const float, modo), 2, WSP(bf16, WS_XN), MP, MROWS, ticket * NWAVES + F.wave, T_EFF * NWAVES);
              TEAM_BAR();
              { pg8::Gemm g{WSP(bf16, WS_XN), WSP(const bf16, wlo + WO_GU2), MROWS, 2 * DFF, DM}; typedef pg8::TeamOrder<22> Ord; Ord S; S.init(T_EFF, ticket);
                pg8::EpiSwiglu E{WSP(bf16, WS_BIG)};
                pg8::gemm_phase<pg8::EpiSwiglu, Ord, true, true>(F.lds + RING_OFF, g, S, E); }
              TEAM_BAR();
              { pg8::Gemm g{WSP(bf16, WS_BIG), WSP(const bf16, wlo + WO_D2), MROWS, DM, DFF}; typedef pg8::TeamOrder<4> Ord; Ord S; S.init(T_EFF, ticket);
                pg8::EpiResid E{WSP(float, WS_X), WSP(const float, modo) + 8 * 1024, 0.5f};
                pg8::gemm_phase<pg8::EpiResid, Ord, true, true>(F.lds + RING_OFF, g, S, E); }
              ENTER();
          }
#endif
#ifndef NO_ATT
          { const attn_body::bf16* Qb = WSP(const attn_body::bf16, WS_Q); const attn_body::bf16* Kb = WSP(const attn_body::bf16, WS_K); const attn_body::bf16* Vb = WSP(const attn_body::bf16, WS_V); attn_body::bf16* O1 = WSP(attn_body::bf16, WS_O1);
            const int x0 = (int)(xb_xcc_id() & 7u);
            for (;;) { const int pk = attn_pull(F, qbase + 64, x0, 256); if (pk < 0) break;
                const int head = pk >> 16, it = pk & 0xffff, b = it >> 6, r = it & 63, qb = 31 - (r >> 1), mp = r & 1;
                attn_body::attn_unit128<8>(b, head * 2 + mp, head * 2, qb, Qb, Kb, Vb, O1 + (size_t)mp * ((WS_O2 - WS_O1) / 2), (char*)lds + RING_OFF); } }
#endif
#undef TEAM_BAR
#ifdef PROBE_ROLE
          if (tk == PROBE_ROLE) { const unsigned long long t1 = __builtin_amdgcn_s_memrealtime(), d = t1 - pr0; while (__builtin_amdgcn_s_memrealtime() - t1 < d) __builtin_amdgcn_s_sleep(8); }
#endif
        }
        GRID_BAR(); ENTER();
        PT_END(1);
        { const float lam = lam_of(karg(A_LAM), l, F.lane), osc = 1.f - lam_init_of(l);
          attn_combine_phase(F, WSP(const bf16, WS_O1), WSP(const bf16, WS_O2), karg(A_GSUB) + l * 128, lam, osc, WSP(bf16, WS_OATT));
#ifdef DUP_THIN
          GRID_BAR(); ENTER();
          attn_combine_phase(F, WSP(const bf16, WS_O1), WSP(const bf16, WS_O2), karg(A_GSUB) + l * 128, lam, osc, WSP(bf16, WS_OATT));
#endif
        }
        GRID_BAR(); ENTER();
#ifndef NO_G4
        { pg8::Gemm g{WSP(bf16, WS_OATT), WSP(const bf16, wlo + WO_BA), MP, DM, DM}; typedef pg8::FixedOrder<128, 4, 8> Ord; Ord S; S.init(F.G, opaque_bid());
          pg8::EpiGateT E{WSP(float, WS_LOGF), WSP(const bf16, WS_SZA)};
          pg8::gemm_phase<pg8::EpiGateT, Ord, true, true>(F.lds + RING_OFF, g, S, E);
#ifdef DUP_THIN
          GRID_BAR(); ENTER(); pg8::gemm_phase<pg8::EpiGateT, Ord, true, true>(F.lds + RING_OFF, g, S, E);
#endif
        }
#endif
        GRID_BAR(); ENTER();
#ifndef NO_G5
        { pg8::Gemm g{WSP(bf16, WS_OH), WSP(const bf16, wlo + WO_BH), MP, DM, DM}; typedef pg8::FixedOrder<128, 4, 8> Ord; Ord S; S.init(F.G, opaque_bid());
          pg8::EpiGateM E{WSP(const float, WS_LOGF), WSP(const bf16, WS_SZH), WSP(bf16, WS_MRG)};
          pg8::gemm_phase<pg8::EpiGateM, Ord, true, true>(F.lds + RING_OFF, g, S, E);
#ifdef DUP_THIN
          GRID_BAR(); ENTER(); pg8::gemm_phase<pg8::EpiGateM, Ord, true, true>(F.lds + RING_OFF, g, S, E);
#endif
        }
#endif
        GRID_BAR(); ENTER();
#ifndef NO_G6
        { pg8::Gemm g{WSP(bf16, WS_MRG), WSP(const bf16, wlo + WO_OUT), MP, DM, DM}; typedef pg8::FixedOrder<128, 4, 8> Ord; Ord S; S.init(F.G, opaque_bid());
          pg8::EpiResid E{WSP(float, WS_X), WSP(const float, modo) + 5 * 1024, 1.0f};
          pg8::gemm_phase<pg8::EpiResid, Ord, true, true>(F.lds + RING_OFF, g, S, E);
#ifdef DUP_RES
          GRID_BAR(); ENTER(); { pg8::EpiResid E0{E.X, E.gate, 0.f}; pg8::gemm_phase<pg8::EpiResid, Ord, true, true>(F.lds + RING_OFF, g, S, E0); }
#endif
        }
#endif
        GRID_BAR(); ENTER();
        norm_phase(F, WSP(const float, WS_X), karg(A_GFFN2) + l * 1024, WSP(const float, modo), 2, WSP(bf16, WS_XN), 0, MP, F.vcu * NWAVES + F.wave, 256 * NWAVES);
#ifdef DUP_THIN
        GRID_BAR(); ENTER();
        norm_phase(F, WSP(const float, WS_X), karg(A_GFFN2) + l * 1024, WSP(const float, modo), 2, WSP(bf16, WS_XN), 0, MP, F.vcu * NWAVES + F.wave, 256 * NWAVES);
#endif
        GRID_BAR(); ENTER();
#ifndef NO_G7
        { pg8::Gemm g{WSP(bf16, WS_XN), WSP(const bf16, wlo + WO_GU2), MP, 2 * DFF, DM}; typedef pg8::FixedOrder<128, 22, 8> Ord; Ord S; S.init(F.G, opaque_bid());
          pg8::EpiSwiglu E{WSP(bf16, WS_BIG)};
          pg8::gemm_phase<pg8::EpiSwiglu, Ord, true, true>(F.lds + RING_OFF, g, S, E); }
#endif
        GRID_BAR(); ENTER();
#ifndef NO_G8
        { pg8::Gemm g{WSP(bf16, WS_BIG), WSP(const bf16, wlo + WO_D2), MP, DM, DFF}; typedef pg8::FixedOrder<128, 4, 8> Ord; Ord S; S.init(F.G, opaque_bid());
          pg8::EpiResid E{WSP(float, WS_X), WSP(const float, modo) + 8 * 1024, 0.5f};
          pg8::gemm_phase<pg8::EpiResid, Ord, true, true>(F.lds + RING_OFF, g, S, E);
#ifdef DUP_RES
          GRID_BAR(); ENTER(); { pg8::EpiResid E0{E.X, E.gate, 0.f}; pg8::gemm_phase<pg8::EpiResid, Ord, true, true>(F.lds + RING_OFF, g, S, E0); }
#endif
        }
#endif
        GRID_BAR(); ENTER();
    }
    final_norm_phase(F, WSP(const float, WS_X), karg(A_GFIN), OUTP(0));
#undef GRID_BAR
#undef ENTER
#undef WSP
#undef OUTP
}

extern "C" void kernel_launch(void* const* d_in, const int* in_sizes, int n_in, void* d_out, int out_size, void* d_ws, size_t ws_size, hipStream_t stream) {
    static int grid = 0;
    if (grid == 0) {
        if (n_in != 25 || (size_t)out_size != OUT_TOTAL || ws_size < WS_END) { fprintf(stderr, "kernel_launch: unexpected sizes: n_in %d out %d ws %zu (need %zu)\n", n_in, out_size, ws_size, (size_t)WS_END); grid = -1; return; }
        int dev = 0, cus = 0, per_cu = 0;
        if (hipGetDevice(&dev) != hipSuccess || hipDeviceGetAttribute(&cus, hipDeviceAttributeMultiprocessorCount, dev) != hipSuccess) { grid = -1; return; }
        if (hipFuncSetAttribute((const void*)mk_fwd, hipFuncAttributeMaxDynamicSharedMemorySize, LDS_BYTES) != hipSuccess) { fprintf(stderr, "kernel_launch: hipFuncSetAttribute failed\n"); grid = -1; return; }
        if (hipOccupancyMaxActiveBlocksPerMultiprocessor(&per_cu, (const void*)mk_fwd, NWAVES * 64, LDS_BYTES) != hipSuccess || per_cu < 1) { fprintf(stderr, "kernel_launch: occupancy query reports %d\n", per_cu); }
        (void)hipGetLastError();
        grid = cus;
        if (grid != 256) { fprintf(stderr, "kernel_launch: built for a 256-CU device (team size, row split and work queues assume 256 workgroups); found %d CUs; nothing launched\n", cus); grid = -1; return; }
    }
    if (grid < 0) return;
    if (hipMemsetAsync((char*)d_ws + WS_CTL, 0, CTL_ZERO_BYTES, stream) != hipSuccess) return;
    Args a{};
    for (int i = 0; i < 25; ++i) a.in[i] = (const float*)d_in[i];
    a.out = (float*)d_out; a.ws = (unsigned char*)d_ws;
    hipLaunchKernelGGL(mk_fwd, dim3(grid), dim3(NWAVES * 64), LDS_BYTES, stream, a);
    (void)in_sizes;
}
```

```cpp
#define TEAM_STRIDE 16
#define STARTERS 8
#include <hip/hip_runtime.h>
#include <hip/hip_bf16.h>
#include <cstdio>
#include <cstdint>
#include <cmath>
constexpr unsigned WTAB_LDS_ADDR = 139264u + 320u + 256u;
__device__ __forceinline__ unsigned hw_wave_slot() { return (unsigned)__builtin_amdgcn_s_getreg((6 << 11) | 4) & 0x3fu; }
__device__ __forceinline__ void tid_table_init() { ((volatile __attribute__((address_space(3))) unsigned*)(size_t)WTAB_LDS_ADDR)[hw_wave_slot()] = threadIdx.x >> 6; }
__device__ __forceinline__ int opaque_tid() { const unsigned w = ((volatile __attribute__((address_space(3))) unsigned*)(size_t)WTAB_LDS_ADDR)[hw_wave_slot()];
    unsigned ln; asm volatile("v_mbcnt_lo_u32_b32 %0, -1, 0\n\tv_mbcnt_hi_u32_b32 %0, -1, %0" : "=v"(ln));
    return (int)((w << 6) | ln); }
__device__ __forceinline__ int opaque_bid() { int b = (int)blockIdx.x; asm volatile("" : "+s"(b)); return b; }
namespace pg8 {
#define PG8_LAS __attribute__((address_space(3)))
typedef unsigned short bf16_t;
typedef short bf16x8 __attribute__((ext_vector_type(8)));
typedef float f32x4 __attribute__((ext_vector_type(4)));
typedef unsigned u32x4 __attribute__((ext_vector_type(4)));
constexpr int BM = 256, BK = 64, HALF = 128, HTB = HALF * BK * 2  , STAGE_BYTES = 8 * HTB, NXCD = 8, WGM = 8;

__host__ __device__ __forceinline__ int lds_byte(int r, int c) { const int st = (r >> 4) * 2 + (c >> 5), rr = r & 15, cc = c & 31, ob = rr * 64 + cc * 2; return st * 1024 + (ob ^ (((ob >> 9) & 1) << 5)); }
__host__ __device__ __forceinline__ void stage_rc(int b, int& R, int& C) { const int st = b / 1024, sb = b % 1024, swz = sb ^ (((sb >> 9) & 1) << 5); R = (st >> 1) * 16 + swz / 64; C = (st & 1) * 32 + (swz % 64) / 2; }
__host__ __device__ __forceinline__ int perm32(int rho) { const int n = rho >> 4, i = rho & 15; return 8 * (i >> 2) + 4 * n + (i & 3); }

struct Unit { int pm, pn; };
struct Gemm { const bf16_t* A; const bf16_t* Bt; int M, N, K; };

struct StaticOrder {
    int nM, nN, nwg, G, c;
    __host__ __device__ void init(int M, int N, int G_, int c_) { nM = M / BM; nN = N / BM; nwg = nM * nN; G = G_; c = c_; }
    __host__ __device__ bool next(int i, Unit& u) const {
        const long L = (long)i * G + c; if (L >= nwg) return false;
        int wgid = (int)L; { const int q = nwg / NXCD, r = nwg % NXCD, xcd = wgid % NXCD, off = wgid / NXCD; wgid = (xcd < r ? xcd * (q + 1) : r * (q + 1) + (xcd - r) * q) + off; }
        const int nig = WGM * nN, gid = wgid / nig, fm = gid * WGM, gsz = (nM - fm) < WGM ? (nM - fm) : WGM;
        u.pm = fm + ((wgid % nig) % gsz); u.pn = (wgid % nig) / gsz; return true;
    }
    __device__ __forceinline__ void a_ready(const Unit&) const {}
    __device__ __forceinline__ void done(const Unit&) const {}
};

__device__ __forceinline__ unsigned cvt_pk_bf16(float lo, float hi) { unsigned r; asm volatile("v_cvt_pk_bf16_f32 %0, %1, %2" : "=v"(r) : "v"(lo), "v"(hi)); return r; }
__device__ __forceinline__ float bf_lo(unsigned w) { return __builtin_bit_cast(float, w << 16); }
__device__ __forceinline__ float bf_hi(unsigned w) { return __builtin_bit_cast(float, w & 0xffff0000u); }
__device__ __forceinline__ float sigmoid_f(float x) { return __builtin_amdgcn_rcpf(1.f + __expf(-x)); }
__device__ __forceinline__ float silu_f(float x) { return x * sigmoid_f(x); }
__device__ __forceinline__ void store8bf(bf16_t* p, f32x4 a, f32x4 b) { u32x4 w; w.x = cvt_pk_bf16(a[0], a[1]); w.y = cvt_pk_bf16(a[2], a[3]); w.z = cvt_pk_bf16(b[0], b[1]); w.w = cvt_pk_bf16(b[2], b[3]); *(u32x4*)p = w; }
__device__ __forceinline__ int row_seq(int row) { return row < 32768 ? (row >> 13) : 4 + ((row - 32768) >> 5); }

struct EpiSwiglu {
    static constexpr bool PERM = true, AFTER_DRAIN = false;
    bf16_t* O;
    __device__ __forceinline__ void operator()(const f32x4 (&acc)[2][2][4][2], const Unit& u, int wr, int wc, int fr, int fq) const {
        const int row0 = u.pm * BM + wr * 64 + fr, col0 = u.pn * HALF + wc * 32 + 8 * fq;
#pragma unroll
        for (int ai = 0; ai < 2; ++ai)
#pragma unroll
            for (int m = 0; m < 4; ++m) {
                f32x4 g0 = acc[ai][0][m][0], g1 = acc[ai][0][m][1]; const f32x4 u0 = acc[ai][1][m][0], u1 = acc[ai][1][m][1];
#pragma unroll
                for (int i = 0; i < 4; ++i) { g0[i] = silu_f(g0[i]) * u0[i]; g1[i] = silu_f(g1[i]) * u1[i]; }
                store8bf(O + (size_t)(row0 + ai * HALF + m * 16) * 2816 + col0, g0, g1); asm volatile("" ::: "memory");
            }
    }
};

struct EpiResid {
    static constexpr bool PERM = true, AFTER_DRAIN = false;
    float* X; const float* gate; float coef; int xsel;
    __device__ __forceinline__ void operator()(const f32x4 (&acc)[2][2][4][2], const Unit& u, int wr, int wc, int fr, int fq) const {
        const float* Xin = X;
        if (xsel) { const __attribute__((address_space(4))) char* ka = (const __attribute__((address_space(4))) char*)__builtin_amdgcn_kernarg_segment_ptr(); asm volatile("" : "+s"(ka));
            Xin = (xsel == 1) ? *(const float* const __attribute__((address_space(4)))*)(ka) : *(const float* const __attribute__((address_space(4)))*)(ka + 8) - (size_t)32768 * 1024; }
        if (u.pm < 128) {
            const float* gp = gate + (size_t)(u.pm >> 5) * 9216 + u.pn * BM + wc * 32 + 8 * fq;
            f32x4 gv[2][2];
#pragma unroll
            for (int bj = 0; bj < 2; ++bj)
#pragma unroll
                for (int n = 0; n < 2; ++n) gv[bj][n] = *(const f32x4*)(gp + bj * HALF + 4 * n) * coef;
            float* xb = X + (size_t)(u.pm * BM + wr * 64 + fr) * 1024 + u.pn * BM + wc * 32 + 8 * fq;
            const float* xi = Xin + (size_t)(u.pm * BM + wr * 64 + fr) * 1024 + u.pn * BM + wc * 32 + 8 * fq;
            f32x4 xc[2][2], xn[2][2];
#pragma unroll
            for (int bj = 0; bj < 2; ++bj)
#pragma unroll
                for (int n = 0; n < 2; ++n) xc[bj][n] = *(const f32x4*)(xi + bj * HALF + 4 * n);
#pragma unroll
            for (int g = 0; g < 8; ++g) { const int ai = g >> 2, m = g & 3; float* xr = xb + (size_t)(ai * HALF + m * 16) * 1024;
                if (g + 1 < 8) { const float* xq = xi + (size_t)(((g + 1) >> 2) * HALF + ((g + 1) & 3) * 16) * 1024;
#pragma unroll
                    for (int bj = 0; bj < 2; ++bj)
#pragma unroll
                        for (int n = 0; n < 2; ++n) xn[bj][n] = *(const f32x4*)(xq + bj * HALF + 4 * n); }
#pragma unroll
                for (int bj = 0; bj < 2; ++bj)
#pragma unroll
                    for (int n = 0; n < 2; ++n) *(f32x4*)(xr + bj * HALF + 4 * n) = xc[bj][n] + gv[bj][n] * acc[ai][bj][m][n];
                asm volatile("" ::: "memory");
#pragma unroll
                for (int bj = 0; bj < 2; ++bj)
#pragma unroll
                    for (int n = 0; n < 2; ++n) xc[bj][n] = xn[bj][n]; }
        } else {
#pragma unroll
        for (int ai = 0; ai < 2; ++ai)
#pragma unroll
            for (int m = 0; m < 4; ++m) {
                const int row = u.pm * BM + ai * HALF + wr * 64 + m * 16 + fr; const float* gp = gate + (size_t)row_seq(row) * 9216;
#pragma unroll
                for (int bj = 0; bj < 2; ++bj) { const int col = u.pn * BM + bj * HALF + wc * 32 + 8 * fq;
#pragma unroll
                    for (int n = 0; n < 2; ++n) { const f32x4 g = *(const f32x4*)(gp + col + 4 * n); f32x4* xp = (f32x4*)(X + (size_t)row * 1024 + col + 4 * n); const f32x4 xv = *(const f32x4*)(Xin + (size_t)row * 1024 + col + 4 * n); *xp = xv + (g * coef) * acc[ai][bj][m][n]; } asm volatile("" ::: "memory"); }
            }
        }
    }
};

struct EpiWin {
    static constexpr bool PERM = true, AFTER_DRAIN = false;
    unsigned char* ws; float* out; int l; float qscale;
    static constexpr size_t MiB_ = 1u << 20;
    static constexpr size_t O_Q = 435 * MiB_, O_K = 500 * MiB_, O_V = 565 * MiB_, O_QQ = 630 * MiB_, O_KK = 695 * MiB_, O_VV = 760 * MiB_, O_HGS = 825 * MiB_, O_SZA = 890 * MiB_, O_SZH = 955 * MiB_, O_LOGF = 1020 * MiB_, O_LB = 4 * MiB_;
    static constexpr size_t OK_P_ = 34078720, OV_P_ = 168296448, OK_S_ = 304611328, OV_S_ = 306708480;
    __device__ __forceinline__ void operator()(const f32x4 (&acc)[2][2][4][2], const Unit& u, int wr, int wc, int fr, int fq) const {
        const int seg = u.pn >> 2, cb = (u.pn & 3) * BM + wc * 32 + 8 * fq, row0 = u.pm * BM + wr * 64 + fr;
        const size_t boff = seg == 0 ? O_Q : seg == 1 ? O_K : seg == 2 ? O_V : seg == 3 ? O_QQ : seg == 4 ? O_KK : seg == 5 ? O_VV : seg == 6 ? O_HGS : seg == 7 ? O_SZA : O_SZH;
        bf16_t* const O = (bf16_t*)(ws + boff) + (size_t)row0 * 1024 + cb;
        float* F32 = nullptr;
        if (seg == 1 || seg == 2) { const size_t ob = (u.pm < 128) ? (seg == 1 ? OK_P_ : OV_P_) + (size_t)l * 32768 * 1024 + (size_t)(u.pm * BM) * 1024 : (seg == 1 ? OK_S_ : OV_S_) + (size_t)l * 512 * 1024 + (size_t)((u.pm - 128) * BM) * 1024;
            F32 = out + ob + (size_t)(wr * 64 + fr) * 1024 + cb; }
        else if (seg == 4) F32 = (float*)(ws + O_LOGF) + (size_t)row0 * 1024 + cb;
        const float* const lb = (const float*)(ws + O_LB) + l * 1024 + cb;
        const float sc = seg == 0 ? qscale : 1.f;
#pragma unroll
        for (int bj = 0; bj < 2; ++bj) {
            f32x4 l0 = {0.f, 0.f, 0.f, 0.f}, l1 = l0; if (seg == 4) { l0 = *(const f32x4*)(lb + bj * HALF); l1 = *(const f32x4*)(lb + bj * HALF + 4); }
#pragma unroll
            for (int ai = 0; ai < 2; ++ai)
#pragma unroll
                for (int m = 0; m < 4; ++m) { const size_t off = (size_t)(ai * HALF + m * 16) * 1024 + bj * HALF;
                    f32x4 a = acc[ai][bj][m][0], b = acc[ai][bj][m][1];
                    if (seg == 4) { f32x4 fa, fb;
#pragma unroll
                        for (int i = 0; i < 4; ++i) {
                            { const float x = a[i], lbv = l0[i], e = __expf(-__builtin_fabsf(x)), r = __builtin_amdgcn_rcpf(1.f + e), er = e * r, sig = x >= 0.f ? r : er, om = x >= 0.f ? er : r;
                              fa[i] = __logf(__builtin_fmaxf(lbv + (1.f - lbv) * sig, 1e-30f)); a[i] = (1.f - lbv) * om; }
                            { const float x = b[i], lbv = l1[i], e = __expf(-__builtin_fabsf(x)), r = __builtin_amdgcn_rcpf(1.f + e), er = e * r, sig = x >= 0.f ? r : er, om = x >= 0.f ? er : r;
                              fb[i] = __logf(__builtin_fmaxf(lbv + (1.f - lbv) * sig, 1e-30f)); b[i] = (1.f - lbv) * om; } }
                        *(f32x4*)(F32 + off) = fa; *(f32x4*)(F32 + off + 4) = fb;
                    } else if (seg == 3 || seg == 6) {
#pragma unroll
                        for (int i = 0; i < 4; ++i) { a[i] = silu_f(a[i]); b[i] = silu_f(b[i]); }
                    } else if (seg >= 7) {
#pragma unroll
                        for (int i = 0; i < 4; ++i) { a[i] = sigmoid_f(a[i]); b[i] = sigmoid_f(b[i]); }
                    } else {
                        if (seg == 1 || seg == 2) { *(f32x4*)(F32 + off) = a; *(f32x4*)(F32 + off + 4) = b; }
                        a = a * sc; b = b * sc;
                    }
                    store8bf(O + off, a, b); asm volatile("" ::: "memory"); }
        }
    }
};

struct EpiGateT {
    static constexpr bool PERM = true, AFTER_DRAIN = false;
    bf16_t* T; const bf16_t* G;
    __device__ __forceinline__ void operator()(const f32x4 (&acc)[2][2][4][2], const Unit& u, int wr, int wc, int fr, int fq) const {
        const size_t base = (size_t)(u.pm * BM + wr * 64 + fr) * 1024 + u.pn * BM + wc * 32 + 8 * fq;
        u32x4 gc[2], gn[2];
#pragma unroll
        for (int bj = 0; bj < 2; ++bj) gc[bj] = *(const u32x4*)(G + base + bj * HALF);
#pragma unroll
        for (int g = 0; g < 8; ++g) { const int ai = g >> 2, m = g & 3; const size_t off = base + (size_t)(ai * HALF + m * 16) * 1024;
            if (g + 1 < 8) { const size_t offn = base + (size_t)(((g + 1) >> 2) * HALF + ((g + 1) & 3) * 16) * 1024;
#pragma unroll
                for (int bj = 0; bj < 2; ++bj) gn[bj] = *(const u32x4*)(G + offn + bj * HALF); }
#pragma unroll
            for (int bj = 0; bj < 2; ++bj) { const u32x4 gg = gc[bj];
                const f32x4 g0 = {bf_lo(gg.x), bf_hi(gg.x), bf_lo(gg.y), bf_hi(gg.y)}, g1 = {bf_lo(gg.z), bf_hi(gg.z), bf_lo(gg.w), bf_hi(gg.w)};
                store8bf(T + off + bj * HALF, g0 * acc[ai][bj][m][0], g1 * acc[ai][bj][m][1]); }
            asm volatile("" ::: "memory");
#pragma unroll
            for (int bj = 0; bj < 2; ++bj) gc[bj] = gn[bj]; }
    }
};
struct EpiGateM {
    static constexpr bool PERM = true, AFTER_DRAIN = false;
    const bf16_t* T; const bf16_t* G; bf16_t* O;
    __device__ __forceinline__ void operator()(const f32x4 (&acc)[2][2][4][2], const Unit& u, int wr, int wc, int fr, int fq) const {
        const size_t base = (size_t)(u.pm * BM + wr * 64 + fr) * 1024 + u.pn * BM + wc * 32 + 8 * fq;
        u32x4 gc[2], gn[2], tc[2], tn[2];
#pragma unroll
        for (int bj = 0; bj < 2; ++bj) { gc[bj] = *(const u32x4*)(G + base + bj * HALF); tc[bj] = *(const u32x4*)(T + base + bj * HALF); }
#pragma unroll
        for (int g = 0; g < 8; ++g) { const int ai = g >> 2, m = g & 3; const size_t off = base + (size_t)(ai * HALF + m * 16) * 1024;
            if (g + 1 < 8) { const size_t offn = base + (size_t)(((g + 1) >> 2) * HALF + ((g + 1) & 3) * 16) * 1024;
#pragma unroll
                for (int bj = 0; bj < 2; ++bj) { gn[bj] = *(const u32x4*)(G + offn + bj * HALF); tn[bj] = *(const u32x4*)(T + offn + bj * HALF); } }
#pragma unroll
            for (int bj = 0; bj < 2; ++bj) { const u32x4 gg = gc[bj];
                const f32x4 g0 = {bf_lo(gg.x), bf_hi(gg.x), bf_lo(gg.y), bf_hi(gg.y)}, g1 = {bf_lo(gg.z), bf_hi(gg.z), bf_lo(gg.w), bf_hi(gg.w)};
                const u32x4 tt = tc[bj]; const f32x4 t0 = {bf_lo(tt.x), bf_hi(tt.x), bf_lo(tt.y), bf_hi(tt.y)}, t1 = {bf_lo(tt.z), bf_hi(tt.z), bf_lo(tt.w), bf_hi(tt.w)};
                store8bf(O + off + bj * HALF, t0 + g0 * acc[ai][bj][m][0], t1 + g1 * acc[ai][bj][m][1]); }
            asm volatile("" ::: "memory");
#pragma unroll
            for (int bj = 0; bj < 2; ++bj) { gc[bj] = gn[bj]; tc[bj] = tn[bj]; } }
    }
};

struct EpiNull {
    static constexpr bool PERM = true, AFTER_DRAIN = false; float* sink;
    __device__ __forceinline__ void operator()(const f32x4 (&acc)[2][2][4][2], const Unit& u, int wr, int wc, int fr, int fq) const { f32x4 s = {0.f, 0.f, 0.f, 0.f};
#pragma unroll
        for (int a = 0; a < 2; ++a)
#pragma unroll
            for (int b = 0; b < 2; ++b)
#pragma unroll
                for (int m = 0; m < 4; ++m)
#pragma unroll
                    for (int n = 0; n < 2; ++n) s = s + acc[a][b][m][n];
        if (sink) sink[0] = s[0] + s[1] + s[2] + s[3]; (void)u; (void)wr; (void)wc; (void)fr; (void)fq; }
};

template <int NM, int NN, int GM> struct FixedOrder {
    static_assert(NM % GM == 0, "GM divides NM");
    int G, c;
    __device__ __forceinline__ void init(int G_, int c_) { G = G_; c = c_; }
    __device__ __forceinline__ bool next(int i, Unit& u) const {
        constexpr int nwg = NM * NN, q = nwg / NXCD, r = nwg % NXCD, nig = GM * NN;
        const int L = i * G + c; if (L >= nwg) return false;
        const int xcd = L % NXCD, off = L / NXCD; const int wgid = (xcd < r ? xcd * (q + 1) : r * (q + 1) + (xcd - r) * q) + off;
        const int gid = wgid / nig, w = wgid % nig; u.pm = gid * GM + (w % GM); u.pn = w / GM; return true;
    }
    __device__ __forceinline__ void a_ready(const Unit&) const {}
    __device__ __forceinline__ void done(const Unit&) const {}
};

template <int NN> struct TeamOrder {
    int T, r;
    __device__ __forceinline__ void init(int T_, int r_) { T = T_; r = r_; }
    __device__ __forceinline__ bool next(int i, Unit& u) const { const int L = i * T + r; if (L >= 2 * NN) return false; u.pm = 128 + L / NN; u.pn = L % NN; return true; }
    __device__ __forceinline__ void a_ready(const Unit&) const {}
    __device__ __forceinline__ void done(const Unit&) const {}
};
template <class Epi, class Sched, bool ALIGN_EPI = false, bool SP2 = false>
__device__ __forceinline__ void gemm_phase(PG8_LAS unsigned char* lds, const Gemm g, const Sched& S, const Epi& E) {
    const int tid = opaque_tid(), wid = __builtin_amdgcn_readfirstlane(tid >> 6), lane = tid & 63, wr = wid >> 2, wc = wid & 3, fr = lane & 15, fq = lane >> 4;
    const int K = g.K, nt = K / BK;
    unsigned voffA[2], voffB[2];
#pragma unroll
    for (int i = 0; i < 2; ++i) { int R, C; stage_rc(tid * 16 + i * 8192, R, C); const int Rb = Epi::PERM ? ((R & ~31) + perm32(R & 31)) : R;
        voffA[i] = (unsigned)(R * K + C) * 2u; voffB[i] = (unsigned)(Rb * K + C) * 2u; }
    const size_t kstep = (size_t)(BK * 2);
    const size_t hstep = (size_t)HALF * K * 2;
    const size_t tstep = 2 * hstep;
    const unsigned ldsw = (unsigned)wid * 1024u;
    const int aoff = lds_byte(wr * 64 + fr, fq * 8), boff = lds_byte(wc * 32 + fr, fq * 8);
#define PG8_SA(b, h) (((b) * 2 + (h)) * HTB)
#define PG8_SB(b, h) ((4 + (b) * 2 + (h)) * HTB)
#define PG8_STAGE(bufoff, gbase, voff) do { _Pragma("unroll") for (int _i = 0; _i < 2; ++_i) \
        __builtin_amdgcn_global_load_lds((const unsigned*)((const char*)(gbase) + (voff)[_i]), (PG8_LAS unsigned*)(lds + (bufoff) + ldsw + _i * 8192), 16, 0, 0); } while (0)
#define PG8_LDA(dst, b, h) do { _Pragma("unroll") for (int m = 0; m < 4; ++m) _Pragma("unroll") for (int k = 0; k < 2; ++k) dst[m][k] = *(const PG8_LAS bf16x8*)(lds + PG8_SA(b, h) + aoff + m * 2048 + k * 1024); } while (0)
#define PG8_LDB(dst, b, h) do { _Pragma("unroll") for (int n = 0; n < 2; ++n) _Pragma("unroll") for (int k = 0; k < 2; ++k) dst[n][k] = *(const PG8_LAS bf16x8*)(lds + PG8_SB(b, h) + boff + n * 2048 + k * 1024); } while (0)
#define PG8_MMA(ai, bj, At, Bt) do { __builtin_amdgcn_s_setprio(1); _Pragma("unroll") for (int m = 0; m < 4; ++m) _Pragma("unroll") for (int n = 0; n < 2; ++n) _Pragma("unroll") for (int k = 0; k < 2; ++k) \
        acc[ai][bj][m][n] = __builtin_amdgcn_mfma_f32_16x16x32_bf16(Bt[n][k], At[m][k], acc[ai][bj][m][n], 0, 0, 0); __builtin_amdgcn_s_setprio(0); } while (0)
#define PG8_WAIT_V(n) asm volatile("s_waitcnt vmcnt(" #n ")" ::: "memory")
#define PG8_WAIT_L(n) asm volatile("s_waitcnt lgkmcnt(" #n ")" ::: "memory")
#define PG8_BAR __builtin_amdgcn_s_barrier()
#define PG8_SCHED __builtin_amdgcn_sched_barrier(0)
    Unit cur, nxt; int ui = 0;
    if (!S.next(0, cur)) return;
    f32x4 acc[2][2][4][2];
#pragma unroll
    for (int a = 0; a < 2; ++a)
#pragma unroll
        for (int b = 0; b < 2; ++b)
#pragma unroll
            for (int m = 0; m < 4; ++m)
#pragma unroll
                for (int n = 0; n < 2; ++n) acc[a][b][m][n] = (f32x4){0.f, 0.f, 0.f, 0.f};
    bf16x8 At[4][2], B0[2][2], B1[2][2];
    const char* cA = (const char*)g.A + (size_t)cur.pm * tstep; const char* cB = (const char*)g.Bt + (size_t)cur.pn * tstep;
    S.a_ready(cur);
    if constexpr (SP2) {
        PG8_STAGE(PG8_SB(0, 0), cB, voffB); PG8_STAGE(PG8_SB(0, 1), cB + hstep, voffB); PG8_STAGE(PG8_SA(0, 0), cA, voffA); PG8_STAGE(PG8_SA(0, 1), cA + hstep, voffA);
        if (wr == 1) PG8_BAR;
        PG8_WAIT_V(2); PG8_BAR;
        PG8_STAGE(PG8_SB(1, 0), cB + kstep, voffB); PG8_STAGE(PG8_SA(1, 0), cA + kstep, voffA); PG8_STAGE(PG8_SB(1, 1), cB + hstep + kstep, voffB);
        PG8_WAIT_V(6); PG8_BAR;
    } else {
        PG8_STAGE(PG8_SB(0, 0), cB, voffB); PG8_STAGE(PG8_SA(0, 0), cA, voffA); PG8_STAGE(PG8_SB(0, 1), cB + hstep, voffB); PG8_STAGE(PG8_SA(0, 1), cA + hstep, voffA);
        if (wr == 1) PG8_BAR;
        PG8_WAIT_V(4); PG8_BAR;
        PG8_STAGE(PG8_SB(1, 0), cB + kstep, voffB); PG8_STAGE(PG8_SA(1, 0), cA + kstep, voffA); PG8_STAGE(PG8_SB(1, 1), cB + hstep + kstep, voffB);
        PG8_WAIT_V(6); PG8_BAR;
    }
    for (;;) {
        const bool has_next = S.next(ui + 1, nxt);
        const char* nA = has_next ? (const char*)g.A + (size_t)nxt.pm * tstep : cA; const char* nB = has_next ? (const char*)g.Bt + (size_t)nxt.pn * tstep : cB;
        for (int t = 0; t < nt; t += 2) {
            const bool last = (t == nt - 2);
            const char* a1 = cA + (size_t)(t + 1) * kstep;
            const char* a2 = last ? nA : cA + (size_t)(t + 2) * kstep; const char* b2 = last ? nB : cB + (size_t)(t + 2) * kstep;
            const char* a3 = a2 + kstep; const char* b3 = b2 + kstep;
            if (last && has_next) S.a_ready(nxt);
            if constexpr (SP2) {
            PG8_LDB(B0, 0, 0); PG8_LDB(B1, 0, 1); PG8_SCHED; PG8_LDA(At, 0, 0); PG8_STAGE(PG8_SA(1, 1), a1 + hstep, voffA);
            PG8_WAIT_V(8); PG8_WAIT_L(0); PG8_BAR; PG8_MMA(0, 0, At, B0); PG8_MMA(0, 1, At, B1); PG8_BAR; PG8_SCHED;
            PG8_LDA(At, 0, 1); PG8_STAGE(PG8_SB(0, 0), b2, voffB); PG8_STAGE(PG8_SB(0, 1), b2 + hstep, voffB); PG8_STAGE(PG8_SA(0, 0), a2, voffA);
            PG8_WAIT_V(8); PG8_WAIT_L(0); PG8_BAR; PG8_MMA(1, 0, At, B0); PG8_MMA(1, 1, At, B1); PG8_BAR; PG8_SCHED;
            PG8_LDB(B0, 1, 0); PG8_LDB(B1, 1, 1); PG8_SCHED; PG8_LDA(At, 1, 0); PG8_STAGE(PG8_SA(0, 1), a2 + hstep, voffA);
            PG8_WAIT_V(8); PG8_WAIT_L(0); PG8_BAR; PG8_MMA(0, 0, At, B0); PG8_MMA(0, 1, At, B1); PG8_BAR; PG8_SCHED;
            PG8_LDA(At, 1, 1); PG8_STAGE(PG8_SB(1, 0), b3, voffB); PG8_STAGE(PG8_SB(1, 1), b3 + hstep, voffB); PG8_STAGE(PG8_SA(1, 0), a3, voffA);
            PG8_WAIT_V(8); PG8_WAIT_L(0); PG8_BAR; PG8_MMA(1, 0, At, B0); PG8_MMA(1, 1, At, B1); PG8_BAR; PG8_SCHED;
            } else {
            PG8_LDB(B0, 0, 0); PG8_SCHED; PG8_LDA(At, 0, 0); PG8_STAGE(PG8_SA(1, 1), a1 + hstep, voffA);
            PG8_WAIT_L(8); PG8_BAR; PG8_WAIT_L(0); PG8_MMA(0, 0, At, B0); PG8_BAR; PG8_SCHED;
            PG8_LDB(B1, 0, 1); PG8_STAGE(PG8_SB(0, 0), b2, voffB);
            PG8_BAR; PG8_WAIT_L(0); PG8_MMA(0, 1, At, B1); PG8_BAR;
            PG8_LDA(At, 0, 1); PG8_STAGE(PG8_SA(0, 0), a2, voffA);
            PG8_BAR; PG8_WAIT_L(0); PG8_MMA(1, 0, At, B0); PG8_BAR; PG8_SCHED;
            PG8_STAGE(PG8_SB(0, 1), b2 + hstep, voffB);
            PG8_WAIT_V(6); PG8_BAR; PG8_MMA(1, 1, At, B1); PG8_BAR;
            PG8_LDB(B0, 1, 0); PG8_SCHED; PG8_LDA(At, 1, 0); PG8_STAGE(PG8_SA(0, 1), a2 + hstep, voffA);
            PG8_WAIT_L(8); PG8_BAR; PG8_WAIT_L(0); PG8_MMA(0, 0, At, B0); PG8_BAR; PG8_SCHED;
            PG8_LDB(B1, 1, 1); PG8_STAGE(PG8_SB(1, 0), b3, voffB);
            PG8_BAR; PG8_WAIT_L(0); PG8_MMA(0, 1, At, B1); PG8_BAR;
            PG8_LDA(At, 1, 1); PG8_STAGE(PG8_SA(1, 0), a3, voffA);
            PG8_BAR; PG8_WAIT_L(0); PG8_MMA(1, 0, At, B0); PG8_BAR; PG8_SCHED;
            PG8_STAGE(PG8_SB(1, 1), b3 + hstep, voffB);
            PG8_WAIT_V(6); PG8_BAR; PG8_MMA(1, 1, At, B1); PG8_BAR;
            }
        }
        if constexpr (ALIGN_EPI) { if (wr == 0) PG8_BAR; }
        if constexpr (!Epi::AFTER_DRAIN) { E(acc, cur, wr, wc, fr, fq); S.done(cur); }
        if (!has_next) break;
#pragma unroll
        for (int a = 0; a < 2; ++a)
#pragma unroll
            for (int b = 0; b < 2; ++b)
#pragma unroll
                for (int m = 0; m < 4; ++m)
#pragma unroll
                    for (int n = 0; n < 2; ++n) acc[a][b][m][n] = (f32x4){0.f, 0.f, 0.f, 0.f};
        cur = nxt; cA = nA; cB = nB; ++ui;
        if constexpr (ALIGN_EPI) { if (wr == 1) PG8_BAR; }
    }
    PG8_WAIT_V(0);
    if constexpr (!ALIGN_EPI) { if (wr == 0) PG8_BAR; }
    PG8_BAR;
    if constexpr (Epi::AFTER_DRAIN) { E.fused(acc, cur, wr, wc, fr, fq, lds, wid, lane); S.done(cur); }
#undef PG8_SA
#undef PG8_SB
#undef PG8_STAGE
#undef PG8_LDA
#undef PG8_LDB
#undef PG8_MMA
#undef PG8_WAIT_V
#undef PG8_WAIT_L
#undef PG8_BAR
#undef PG8_SCHED
}
}
namespace attn_body {
using bf16=__hip_bfloat16;
using bf16x8=__attribute__((ext_vector_type(8)))short;
using s16x4=__attribute__((ext_vector_type(4)))short;
using f32x16=__attribute__((ext_vector_type(16)))float;
using u32x4=__attribute__((ext_vector_type(4)))unsigned;
constexpr int BATCH=4,NHEAD=16,SEQ=8192,D=64,DM=NHEAD*D;
constexpr int NW=8,QBLK=32,QB=QBLK*NW,KVBLK=64,NQB=SEQ/QB;
constexpr int ATTN_PITCH=DM, ATTN_UNIT_ROWS=QB;
__device__ __forceinline__ int crow(int r,int hi){return (r&3)+8*(r>>2)+4*hi;}
#define SBAR() __builtin_amdgcn_sched_barrier(0)
__device__ __forceinline__ void cmask(f32x16&p0,f32x16&p1,int jb,int qrel,int hi){
  const float NEG=-INFINITY; (void)hi;
  if(jb>(qrel>>6)){
  #pragma unroll
  for(int r=0;r<16;++r){p0[r]=NEG;p1[r]=NEG;} }
}

constexpr int NSLOT=3, SLOTB=8192;
constexpr int LDS_K=0, LDS_V=NSLOT*SLOTB, LDS_WS=2*NSLOT*SLOTB, LDS_OST=LDS_WS+NW*64*4, LDS_BYTES=LDS_OST+NW*4096;
constexpr float C2=0.125f*1.4426950408889634f;
__device__ __forceinline__ void glds16(const void*gsrc,unsigned lds_dst){unsigned keep;
  asm volatile("s_mov_b32 %0, m0\n\ts_mov_b32 m0, %2\n\ts_nop 0\n\tglobal_load_lds_dwordx4 %1, off\n\ts_mov_b32 m0, %0":"=&s"(keep):"v"(gsrc),"s"(lds_dst):"memory");}
__device__ __forceinline__ float max3f(float a,float b,float c){float r;asm("v_max3_f32 %0, %1, %2, %3":"=v"(r):"v"(a),"v"(b),"v"(c));return r;}
__device__ __forceinline__ float max2f(float a,float b){float r;asm("v_max_f32_e32 %0, %1, %2":"=v"(r):"v"(a),"v"(b));return r;}
__device__ __forceinline__ float fadd_s(float a,float b){float r;asm("v_add_f32_e32 %0, %1, %2":"=v"(r):"v"(a),"v"(b));return r;}
__device__ __forceinline__ float fsub_s(float a,float b){float r;asm("v_sub_f32_e32 %0, %1, %2":"=v"(r):"v"(a),"v"(b));return r;}
typedef float f32x2_t __attribute__((ext_vector_type(2))); typedef __bf16 bf16x2_t __attribute__((ext_vector_type(2)));
__device__ __forceinline__ unsigned cvtpk_s(float lo,float hi){f32x2_t v={lo,hi};bf16x2_t b=__builtin_convertvector(v,bf16x2_t);return __builtin_bit_cast(unsigned,b);}
#define WAIT_BAR(N) asm volatile("s_waitcnt vmcnt(" #N ") lgkmcnt(0)\n\ts_barrier":::"memory")

__device__ __forceinline__ void qkt(f32x16&p0,f32x16&p1,const char*Kslot,const bf16x8*qr,const f32x16&negm,int r32,int hi){
  const char*kb=Kslot+hi*1024+r32*16;
  #pragma unroll
  for(int d0=0;d0<4;++d0){
    const bf16x8 b0=*reinterpret_cast<const bf16x8*>(kb+d0*2048);
    const bf16x8 b1=*reinterpret_cast<const bf16x8*>(kb+d0*2048+512);
    if(d0==0){p0=__builtin_amdgcn_mfma_f32_32x32x16_bf16(b0,qr[0],negm,0,0,0);p1=__builtin_amdgcn_mfma_f32_32x32x16_bf16(b1,qr[0],negm,0,0,0);}
    else{p0=__builtin_amdgcn_mfma_f32_32x32x16_bf16(b0,qr[d0],p0,0,0,0);p1=__builtin_amdgcn_mfma_f32_32x32x16_bf16(b1,qr[d0],p1,0,0,0);}}
}
typedef __attribute__((address_space(3))) const char* lds_cptr;
typedef short v4i16_t __attribute__((ext_vector_type(4)));
__device__ __forceinline__ void kload8(bf16x8*kf,lds_cptr kp){
  kf[0]=*(const __attribute__((address_space(3))) bf16x8*)(kp);      kf[1]=*(const __attribute__((address_space(3))) bf16x8*)(kp+512);
  kf[2]=*(const __attribute__((address_space(3))) bf16x8*)(kp+2048); kf[3]=*(const __attribute__((address_space(3))) bf16x8*)(kp+2560);
  kf[4]=*(const __attribute__((address_space(3))) bf16x8*)(kp+4096); kf[5]=*(const __attribute__((address_space(3))) bf16x8*)(kp+4608);
  kf[6]=*(const __attribute__((address_space(3))) bf16x8*)(kp+6144); kf[7]=*(const __attribute__((address_space(3))) bf16x8*)(kp+6656);
}
__device__ __forceinline__ void kload2(bf16x8*kf,lds_cptr kp,int j){ kf[2*j]=*(const __attribute__((address_space(3))) bf16x8*)(kp+j*2048); kf[2*j+1]=*(const __attribute__((address_space(3))) bf16x8*)(kp+j*2048+512); }
__device__ __forceinline__ s16x4 vtr(lds_cptr p){ return __builtin_bit_cast(s16x4,__builtin_amdgcn_ds_read_tr16_b64_v4i16((__attribute__((address_space(3))) v4i16_t*)p)); }
__device__ __forceinline__ float rowmax(const f32x16&p0,const f32x16&p1){
  float a=max3f(p0[0],p0[1],p1[0]),b=max3f(p0[2],p0[3],p1[1]);a=max3f(a,p1[2],p1[3]);
  #pragma unroll
  for(int r=4;r<16;r+=4){a=max3f(a,p0[r],p0[r+1]);b=max3f(b,p0[r+2],p0[r+3]);a=max3f(a,p1[r],p1[r+1]);b=max3f(b,p1[r+2],p1[r+3]);}
  const float m=max2f(a,b);
  auto rr=__builtin_amdgcn_permlane32_swap(__float_as_uint(m),__float_as_uint(m),false,false);
  return max2f(__uint_as_float(rr[0]),__uint_as_float(rr[1]));
}
__device__ __forceinline__ void pv(f32x16*o,int vb,bf16x8 pa0,bf16x8 pa1,bf16x8 pa2,bf16x8 pa3){
  #pragma unroll
  for(int d0=0;d0<2;++d0){s16x4 lo[4],hi[4];
    #pragma unroll
    for(int ks=0;ks<4;++ks){
      asm volatile("ds_read_b64_tr_b16 %0,%1 offset:%c2":"=&v"(lo[ks]):"v"(vb),"i"(d0*4096+ks*1024):"memory");
      asm volatile("ds_read_b64_tr_b16 %0,%1 offset:%c2":"=&v"(hi[ks]):"v"(vb),"i"(d0*4096+ks*1024+512):"memory");}
    asm volatile("s_waitcnt lgkmcnt(0)":::"memory");SBAR();
    #define PK(k) (bf16x8){lo[k][0],lo[k][1],lo[k][2],lo[k][3],hi[k][0],hi[k][1],hi[k][2],hi[k][3]}
    o[d0]=__builtin_amdgcn_mfma_f32_32x32x16_bf16(pa0,PK(0),o[d0],0,0,0);
    o[d0]=__builtin_amdgcn_mfma_f32_32x32x16_bf16(pa1,PK(1),o[d0],0,0,0);
    o[d0]=__builtin_amdgcn_mfma_f32_32x32x16_bf16(pa2,PK(2),o[d0],0,0,0);
    o[d0]=__builtin_amdgcn_mfma_f32_32x32x16_bf16(pa3,PK(3),o[d0],0,0,0);
    #undef PK
  }
}

#ifndef ATTN_STORE16
#define ATTN_STORE16(p,v) (*(u32x4*)(p)=(v))
#endif
template<int THRL> __device__ __forceinline__ void attn_unit(int b,int hq,int hv,int qb,const bf16*Q,const bf16*__restrict__ K,const bf16*__restrict__ V,bf16*O,char*shm){
  const int tid=opaque_tid(),lane=tid&63,r32=lane&31,hi=lane>>5; const int wid=__builtin_amdgcn_readfirstlane(tid>>6);
  const long rowbase=(long)b*SEQ; const int q0=qb*QB;
  const bf16*Qw=Q+(rowbase+q0+wid*QBLK)*DM+hq*D;
  const bf16*Kh=K+rowbase*DM+hq*D,*Vh=V+rowbase*DM+hv*D;
  const unsigned lds0=(unsigned)(uintptr_t)shm;
  float*wsf=(float*)(shm+LDS_WS)+wid*64;
  const bf16*ksrc=Kh+(long)lane*DM+wid*8;
  const bf16*vsrc=Vh+(long)(16*(wid&3)+(lane>>2))*DM+(wid>>2)*32+(lane&3)*8;
  const unsigned kdst=lds0+LDS_K+wid*1024, vdst=lds0+LDS_V+wid*1024;
  #define DMA_K(t,slot) glds16(ksrc+(long)(t)*KVBLK*DM,(unsigned)__builtin_amdgcn_readfirstlane(kdst+(slot)))
  #define DMA_V(t,slot) glds16(vsrc+(long)(t)*KVBLK*DM,(unsigned)__builtin_amdgcn_readfirstlane(vdst+(slot)))
  const int vb0=(int)(lds0+LDS_V)+((lane>>4)&1)*32+(lane&3)*8+(4*hi+((lane&15)>>2))*64;
  const char*Kbase=shm+LDS_K; bf16x8 kf[8];
  const lds_cptr shm3=(lds_cptr)shm; const lds_cptr kp0=shm3+LDS_K+hi*1024+r32*16; const lds_cptr vp0=shm3+LDS_V+((lane>>4)&1)*32+(lane&3)*8+(4*hi+((lane&15)>>2))*64;
  const int NT=(q0+QB)/KVBLK;
  DMA_K(0,0);DMA_V(0,0);DMA_K(1,SLOTB);
  bf16x8 qr[4];
  #pragma unroll
  for(int d0=0;d0<4;++d0)qr[d0]=*reinterpret_cast<const bf16x8*>(&Qw[(long)r32*DM+d0*16+hi*8]);
  float mhat=0.f,l_reg=0.f;f32x16 o[2];o[0]=f32x16{};o[1]=f32x16{};f32x16 negm=f32x16{};asm volatile("":"+v"(negm));
  const int qrel=wid*QBLK+r32;
  #define CMASK(P0,P1,t) do{int jb_=(t)-(NT-4); if(jb_>=0)cmask(P0,P1,jb_,qrel,hi);}while(0)
  bool resc=false;
  #define START(P0,P1) do{ const float rm=rowmax(P0,P1); resc=false; \
    { const float dl=rm; mhat=fadd_s(mhat,dl); \
      _Pragma("unroll") for(int r=0;r<16;++r){P0[r]=fsub_s(P0[r],dl);P1[r]=fsub_s(P1[r],dl);} \
      _Pragma("unroll") for(int r=0;r<16;++r)negm[r]=-mhat; asm volatile("":"+v"(negm)); } \
    _Pragma("unroll") for(int r=0;r<16;++r)P0[r]=__builtin_amdgcn_exp2f(P0[r]); }while(0)
  #define RESC() do{ if(resc){ asm volatile("s_waitcnt lgkmcnt(0)":::"memory"); \
      _Pragma("unroll") for(int d_=0;d_<2;++d_) _Pragma("unroll") for(int r=0;r<16;++r)o[d_][r]*=wsf[crow(r,hi)]; } }while(0)
  f32x16 pA0,pA1,pB0,pB1;
  int sl_prev=0,sl_cur=0,sl_next=SLOTB;
  #define ROT() do{sl_prev=sl_cur;sl_cur=sl_next;sl_next=(sl_next==(NSLOT-1)*SLOTB)?0:sl_next+SLOTB;}while(0)
  DMA_K(2,2*SLOTB);
  WAIT_BAR(3);
  qkt(pA0,pA1,Kbase,qr,negm,r32,hi);asm volatile("s_nop 15\n\ts_nop 7":"+v"(pA0),"+v"(pA1));CMASK(pA0,pA1,0);
  START(pA0,pA1);
  _Pragma("unroll") for(int r=0;r<16;++r)pA1[r]=__builtin_amdgcn_exp2f(pA1[r]);
  WAIT_BAR(0);
  DMA_K(3,0);DMA_V(1,SLOTB);
  ROT();
  kload8(kf,kp0+sl_cur);
  WAIT_BAR(2);
  s16x4 vlo[8],vhi[8]; u32x4 pw0,pw1,pw2,pw3;
  #define PKW(P,B) cvtpk_s(P[B],P[B+1])
  #define PAF(k) __builtin_bit_cast(bf16x8,pw##k)
  #define VFR(i) (bf16x8){vlo[i][0],vlo[i][1],vlo[i][2],vlo[i][3],vhi[i][0],vhi[i][1],vhi[i][2],vhi[i][3]}
  #define PIN(x) asm volatile("":"+v"(x))
  #define MX3(a,b,c) __builtin_fmaxf(__builtin_fmaxf((a),(b)),(c))
  #define GAPA(MF,A0,A1,A2,A3,W0,W1,PW) do{ MF; sacc+=A0; sacc+=A1; sacc+=A2; sacc+=A3; PIN(sacc); W0; W1; PIN(PW); SBAR(); }while(0)
  #define EX(v) __builtin_amdgcn_exp2f(v)
  #define GAPB(MF,X,B) do{ MF; X[B]=EX(X[B]); X[B+1]=EX(X[B+1]); X[B+2]=EX(X[B+2]); X[B+3]=EX(X[B+3]); PIN(X); SBAR(); }while(0)
  #define VRD(i) do{ vlo[i]=vtr(vp_+(((i)>>2)*4096+((i)&3)*1024)); vhi[i]=vtr(vp_+(((i)>>2)*4096+((i)&3)*1024+512)); }while(0)
  #define KRD(G,j) do{ if(G){ kload2(kf,kp0+sl_next,j); SBAR(); } }while(0)
  #define STEP(C0,C1,P0,P1,t,GK,GV,GL) do{ SBAR(); \
    const lds_cptr vp_=vp0+sl_prev; \
    VRD(0); SBAR(); float sacc=(P0[0]+P0[1]); \
    GAPA(C0=__builtin_amdgcn_mfma_f32_32x32x16_bf16(kf[0],qr[0],negm,0,0,0), P0[2],P0[3],P0[4],P0[5],     pw0[0]=PKW(P0,0), pw0[1]=PKW(P0,2), pw0); \
    VRD(4); SBAR(); GAPA(C1=__builtin_amdgcn_mfma_f32_32x32x16_bf16(kf[1],qr[0],negm,0,0,0), P0[6],P0[7],P0[8],P0[9],     pw0[2]=PKW(P0,4), pw0[3]=PKW(P0,6), pw0); \
    VRD(1); SBAR(); GAPA(C0=__builtin_amdgcn_mfma_f32_32x32x16_bf16(kf[2],qr[1],C0,0,0,0),   P0[10],P0[11],P0[12],P0[13], pw1[0]=PKW(P0,8), pw1[1]=PKW(P0,10), pw1); \
    VRD(5); SBAR(); GAPA(C1=__builtin_amdgcn_mfma_f32_32x32x16_bf16(kf[3],qr[1],C1,0,0,0),   P0[14],P0[15],P1[0],P1[1],   pw1[2]=PKW(P0,12),pw1[3]=PKW(P0,14), pw1); \
    VRD(2); SBAR(); GAPA(C0=__builtin_amdgcn_mfma_f32_32x32x16_bf16(kf[4],qr[2],C0,0,0,0),   P1[2],P1[3],P1[4],P1[5],     pw2[0]=PKW(P1,0), pw2[1]=PKW(P1,2), pw2); \
    VRD(6); SBAR(); GAPA(C1=__builtin_amdgcn_mfma_f32_32x32x16_bf16(kf[5],qr[2],C1,0,0,0),   P1[6],P1[7],P1[8],P1[9],     pw2[2]=PKW(P1,4), pw2[3]=PKW(P1,6), pw2); \
    VRD(3); SBAR(); GAPA(C0=__builtin_amdgcn_mfma_f32_32x32x16_bf16(kf[6],qr[3],C0,0,0,0),   P1[10],P1[11],P1[12],P1[13], pw3[0]=PKW(P1,8), pw3[1]=PKW(P1,10), pw3); \
    VRD(7); SBAR(); GAPA(C1=__builtin_amdgcn_mfma_f32_32x32x16_bf16(kf[7],qr[3],C1,0,0,0),   P1[14],P1[15],0.f,0.f,       pw3[2]=PKW(P1,12),pw3[3]=PKW(P1,14), pw3); \
    l_reg+=sacc; \
    if(GK){DMA_K((t)+3,sl_cur);} if(GV){DMA_V((t)+1,sl_next);} \
    CMASK(C0,C1,t); \
    { float a=MX3(C0[0],C0[1],C1[0]),b=MX3(C0[2],C0[3],C1[1]); a=MX3(a,C1[2],C1[3]); \
      _Pragma("unroll") for(int r=4;r<16;r+=4){a=MX3(a,C0[r],C0[r+1]);b=MX3(b,C0[r+2],C0[r+3]);a=MX3(a,C1[r],C1[r+1]);b=MX3(b,C1[r+2],C1[r+3]);} \
      float rm=__builtin_fmaxf(a,b); { auto rr=__builtin_amdgcn_permlane32_swap(__float_as_uint(rm),__float_as_uint(rm),false,false); rm=__builtin_fmaxf(__uint_as_float(rr[0]),__uint_as_float(rr[1])); } \
      resc=false; \
      if(__builtin_expect(__any(rm>(float)THRL),0)){ const float dl=__builtin_fmaxf(rm,0.f); mhat+=dl; \
        _Pragma("unroll") for(int r=0;r<16;++r){C0[r]-=dl;C1[r]-=dl;} \
        _Pragma("unroll") for(int r=0;r<16;++r)negm[r]=-mhat; asm volatile("":"+v"(negm)); \
        const float f=__builtin_amdgcn_exp2f(-dl); l_reg*=f; if(hi==0)wsf[r32]=f; resc=true; } } \
    SBAR(); \
    GAPB(o[0]=__builtin_amdgcn_mfma_f32_32x32x16_bf16(PAF(0),VFR(0),o[0],0,0,0), C0,0); \
    GAPB(o[1]=__builtin_amdgcn_mfma_f32_32x32x16_bf16(PAF(0),VFR(4),o[1],0,0,0), C0,4); \
    KRD(GL,0); GAPB(o[0]=__builtin_amdgcn_mfma_f32_32x32x16_bf16(PAF(1),VFR(1),o[0],0,0,0), C0,8); \
    KRD(GL,1); GAPB(o[1]=__builtin_amdgcn_mfma_f32_32x32x16_bf16(PAF(1),VFR(5),o[1],0,0,0), C0,12); \
    KRD(GL,2); GAPB(o[0]=__builtin_amdgcn_mfma_f32_32x32x16_bf16(PAF(2),VFR(2),o[0],0,0,0), C1,0); \
    KRD(GL,3); GAPB(o[1]=__builtin_amdgcn_mfma_f32_32x32x16_bf16(PAF(2),VFR(6),o[1],0,0,0), C1,4); \
    GAPB(o[0]=__builtin_amdgcn_mfma_f32_32x32x16_bf16(PAF(3),VFR(3),o[0],0,0,0), C1,8); \
    GAPB(o[1]=__builtin_amdgcn_mfma_f32_32x32x16_bf16(PAF(3),VFR(7),o[1],0,0,0), C1,12); \
    }while(0)
  int t=1;
  #undef CMASK
  #define CMASK(P0,P1,t) do{}while(0)
  for(;t+5<NT;t+=2){
    STEP(pB0,pB1,pA0,pA1,t,true,true,true);     WAIT_BAR(2); RESC(); ROT();
    STEP(pA0,pA1,pB0,pB1,t+1,true,true,true);   WAIT_BAR(2); RESC(); ROT();
  }
  #undef CMASK
  #define CMASK(P0,P1,t) do{int jb_=(t)-(NT-4); if(jb_>=0)cmask(P0,P1,jb_,qrel,hi);}while(0)
  #define ENDW(tt) do{ if((tt)+3<NT){WAIT_BAR(2);} else if((tt)+2<NT){WAIT_BAR(1);} else {WAIT_BAR(0);} }while(0)
  for(;t+1<NT;t+=2){
    STEP(pB0,pB1,pA0,pA1,t,(t+3<NT),(t+1<NT),(t+1<NT));       ENDW(t);   RESC(); ROT();
    STEP(pA0,pA1,pB0,pB1,t+1,(t+4<NT),(t+2<NT),(t+2<NT));     ENDW(t+1); RESC(); ROT();
  }
  STEP(pB0,pB1,pA0,pA1,NT-1,false,false,false); RESC();
  { float sacc=pB0[0]+pB0[1]; _Pragma("unroll") for(int r=2;r<16;++r)sacc+=pB0[r]; _Pragma("unroll") for(int r=0;r<16;++r)sacc+=pB1[r]; l_reg+=sacc;
    pw0=(u32x4){PKW(pB0,0),PKW(pB0,2),PKW(pB0,4),PKW(pB0,6)};pw1=(u32x4){PKW(pB0,8),PKW(pB0,10),PKW(pB0,12),PKW(pB0,14)};pw2=(u32x4){PKW(pB1,0),PKW(pB1,2),PKW(pB1,4),PKW(pB1,6)};pw3=(u32x4){PKW(pB1,8),PKW(pB1,10),PKW(pB1,12),PKW(pB1,14)};
    SBAR(); pv(o,vb0+sl_cur,PAF(0),PAF(1),PAF(2),PAF(3)); }
  #undef PKW
  #undef PAF
  #undef VFR
  #undef PIN
  #undef MX3
  #undef GAPA
  #undef GAPB
  #undef EX
  #undef VRD
  #undef KRD
  #undef STEP
  #undef ENDW
  {auto rr=__builtin_amdgcn_permlane32_swap(__float_as_uint(l_reg),__float_as_uint(l_reg),false,false);l_reg=__uint_as_float(rr[0])+__uint_as_float(rr[1]);}
  if(hi==0)wsf[32+r32]=l_reg;asm volatile("s_waitcnt lgkmcnt(0)":::"memory");
  float rli[16];
  #pragma unroll
  for(int r=0;r<16;++r)rli[r]=__builtin_amdgcn_rcpf(wsf[32+crow(r,hi)]);
  bf16*Ow=O+(rowbase+q0+wid*QBLK)*DM+hv*D;
  { bf16*stg=(bf16*)(shm+LDS_OST)+wid*2048;
    #pragma unroll
    for(int r=0;r<16;++r){const int orow=crow(r,hi);
      #pragma unroll
      for(int d0=0;d0<2;++d0)stg[orow*64+d0*32+r32]=__float2bfloat16(o[d0][r]*rli[r]);}
    asm volatile("s_waitcnt lgkmcnt(0)":::"memory");
    #pragma unroll
    for(int i=0;i<4;++i){const int row=i*8+(lane>>3),ch=lane&7; const u32x4 v=*(const u32x4*)(stg+row*64+ch*8); ATTN_STORE16(Ow+(long)row*DM+ch*8,v);} }
  asm volatile("s_waitcnt lgkmcnt(0)\n\ts_barrier":::"memory");
  #undef DMA_K
  #undef DMA_V
  #undef CMASK
  #undef START
  #undef RESC
  #undef ROT
}
__device__ __forceinline__ void pv128(f32x16*o,int vb,bf16x8 pa0,bf16x8 pa1,bf16x8 pa2,bf16x8 pa3){
  #pragma unroll
  for(int d0=0;d0<4;++d0){s16x4 lo[4],hi[4];
    #pragma unroll
    for(int ks=0;ks<4;++ks){
      asm volatile("ds_read_b64_tr_b16 %0,%1 offset:%c2":"=&v"(lo[ks]):"v"(vb),"i"(d0*4096+ks*1024):"memory");
      asm volatile("ds_read_b64_tr_b16 %0,%1 offset:%c2":"=&v"(hi[ks]):"v"(vb),"i"(d0*4096+ks*1024+512):"memory");}
    asm volatile("s_waitcnt lgkmcnt(0)":::"memory");SBAR();
    #define PK(k) (bf16x8){lo[k][0],lo[k][1],lo[k][2],lo[k][3],hi[k][0],hi[k][1],hi[k][2],hi[k][3]}
    o[d0]=__builtin_amdgcn_mfma_f32_32x32x16_bf16(pa0,PK(0),o[d0],0,0,0);
    o[d0]=__builtin_amdgcn_mfma_f32_32x32x16_bf16(pa1,PK(1),o[d0],0,0,0);
    o[d0]=__builtin_amdgcn_mfma_f32_32x32x16_bf16(pa2,PK(2),o[d0],0,0,0);
    o[d0]=__builtin_amdgcn_mfma_f32_32x32x16_bf16(pa3,PK(3),o[d0],0,0,0);
    #undef PK
  }
}
constexpr int SLOTV=16384, LDS_V2=NSLOT*SLOTB, LDS_WS2=LDS_V2+NSLOT*SLOTV, LDS_OST2=LDS_WS2+NW*64*4, LDS_BYTES2=LDS_OST2+NW*4096;
template<int THRL> __device__ __forceinline__ void attn_unit128(int b,int hq,int hv,int qb,const bf16*Q,const bf16*__restrict__ K,const bf16*__restrict__ V,bf16*O,char*shm){
  const int tid=opaque_tid(),lane=tid&63,r32=lane&31,hi=lane>>5; const int wid=__builtin_amdgcn_readfirstlane(tid>>6);
  const long rowbase=(long)b*SEQ; const int q0=qb*QB;
  const bf16*Qw=Q+(rowbase+q0+wid*QBLK)*DM+hq*D;
  const bf16*Kh=K+rowbase*DM+hq*D,*Vh=V+rowbase*DM+hv*D;
  const unsigned lds0=(unsigned)(uintptr_t)shm;
  float*wsf=(float*)(shm+LDS_WS2)+wid*64;
  const bf16*ksrc=Kh+(long)lane*DM+wid*8;
  const bf16*vsrc=Vh+(long)(16*(wid&3)+(lane>>2))*DM+(wid>>2)*32+(lane&3)*8;
  const unsigned kdst=lds0+LDS_K+wid*1024, vdst=lds0+LDS_V2+wid*1024;
  #define DMA_K(t,slot) glds16(ksrc+(long)(t)*KVBLK*DM,(unsigned)__builtin_amdgcn_readfirstlane(kdst+(slot)))
  #define DMA_V(t,slot) do{ glds16(vsrc+(long)(t)*KVBLK*DM,(unsigned)__builtin_amdgcn_readfirstlane(vdst+2*(slot))); glds16(vsrc+64+(long)(t)*KVBLK*DM,(unsigned)__builtin_amdgcn_readfirstlane(vdst+8192+2*(slot))); }while(0)
  const int vb0=(int)(lds0+LDS_V2)+((lane>>4)&1)*32+(lane&3)*8+(4*hi+((lane&15)>>2))*64;
  const char*Kbase=shm+LDS_K; bf16x8 kf[8];
  const lds_cptr shm3=(lds_cptr)shm; const lds_cptr kp0=shm3+LDS_K+hi*1024+r32*16; const lds_cptr vp0=shm3+LDS_V2+((lane>>4)&1)*32+(lane&3)*8+(4*hi+((lane&15)>>2))*64;
  const int NT=(q0+QB)/KVBLK;
  DMA_K(0,0);DMA_V(0,0);DMA_K(1,SLOTB);
  bf16x8 qr[4];
  #pragma unroll
  for(int d0=0;d0<4;++d0)qr[d0]=*reinterpret_cast<const bf16x8*>(&Qw[(long)r32*DM+d0*16+hi*8]);
  float mhat=0.f,l_reg=0.f;f32x16 o[4];o[0]=f32x16{};o[1]=f32x16{};o[2]=f32x16{};o[3]=f32x16{};const f32x16 zc=f32x16{};
  const int qrel=wid*QBLK+r32;
  #define CMASK(P0,P1,t) do{int jb_=(t)-(NT-4); if(jb_>=0)cmask(P0,P1,jb_,qrel,hi);}while(0)
  bool resc=false;
  #define START(P0,P1) do{ const float rm=rowmax(P0,P1); resc=false; \
    { const float dl=rm; mhat=fadd_s(mhat,dl); \
      _Pragma("unroll") for(int r=0;r<16;++r){P0[r]=fsub_s(P0[r],dl);P1[r]=fsub_s(P1[r],dl);} \
      } \
    _Pragma("unroll") for(int r=0;r<16;++r)P0[r]=__builtin_amdgcn_exp2f(P0[r]); }while(0)
  #define RESC() do{ if(resc){ asm volatile("s_waitcnt lgkmcnt(0)":::"memory"); \
      _Pragma("unroll") for(int d_=0;d_<4;++d_) _Pragma("unroll") for(int r=0;r<16;++r)o[d_][r]*=wsf[crow(r,hi)]; } }while(0)
  f32x16 pA0,pA1,pB0,pB1;
  int sl_prev=0,sl_cur=0,sl_next=SLOTB;
  #define ROT() do{sl_prev=sl_cur;sl_cur=sl_next;sl_next=(sl_next==(NSLOT-1)*SLOTB)?0:sl_next+SLOTB;}while(0)
  DMA_K(2,2*SLOTB);
  WAIT_BAR(3);
  qkt(pA0,pA1,Kbase,qr,zc,r32,hi);asm volatile("s_nop 15\n\ts_nop 7":"+v"(pA0),"+v"(pA1));CMASK(pA0,pA1,0);
  START(pA0,pA1);
  _Pragma("unroll") for(int r=0;r<16;++r)pA1[r]=__builtin_amdgcn_exp2f(pA1[r]);
  WAIT_BAR(0);
  DMA_K(3,0);DMA_V(1,SLOTB);
  ROT();
  kload8(kf,kp0+sl_cur);
  WAIT_BAR(3);
  s16x4 vlo[8],vhi[8]; u32x4 pw0,pw1,pw2,pw3;
  #define PKW(P,B) cvtpk_s(P[B],P[B+1])
  #define PAF(k) __builtin_bit_cast(bf16x8,pw##k)
  #define VFR(i) (bf16x8){vlo[i][0],vlo[i][1],vlo[i][2],vlo[i][3],vhi[i][0],vhi[i][1],vhi[i][2],vhi[i][3]}
  #define PIN(x) asm volatile("":"+v"(x))
  #define MX3(a,b,c) __builtin_fmaxf(__builtin_fmaxf((a),(b)),(c))
  #define GAPA(MF,A0,A1,A2,A3,W0,W1,PW) do{ MF; sacc+=A0; sacc+=A1; sacc+=A2; sacc+=A3; PIN(sacc); W0; W1; PIN(PW); SBAR(); }while(0)
  #define EX(v) __builtin_amdgcn_exp2f(v)
  #define GAPB(MF,X,B) do{ MF; X[B]=EX(X[B]); X[B+1]=EX(X[B+1]); X[B+2]=EX(X[B+2]); X[B+3]=EX(X[B+3]); PIN(X); SBAR(); }while(0)
  #define VRD(i) do{ vlo[i]=vtr(vp_+(((i)>>2)*4096+((i)&3)*1024)); vhi[i]=vtr(vp_+(((i)>>2)*4096+((i)&3)*1024+512)); }while(0)
  #define VRX(i) do{ vlo[i]=vtr(vp_+((((i)>>2)+2)*4096+((i)&3)*1024)); vhi[i]=vtr(vp_+((((i)>>2)+2)*4096+((i)&3)*1024+512)); SBAR(); }while(0)
  #define GAPB2(MF,X,B) do{ MF; X[B]=EX(X[B]-mhat); X[B+1]=EX(X[B+1]-mhat); PIN(X); SBAR(); }while(0)
  #define KRD(G,j) do{ if(G){ kload2(kf,kp0+sl_next,j); SBAR(); } }while(0)
  #define STEP(C0,C1,P0,P1,t,GK,GV,GL) do{ SBAR(); \
    const lds_cptr vp_=vp0+2*sl_prev; \
    VRD(0); SBAR(); float sacc=(P0[0]+P0[1]); \
    GAPA(C0=__builtin_amdgcn_mfma_f32_32x32x16_bf16(kf[0],qr[0],zc,0,0,0), P0[2],P0[3],P0[4],P0[5],     pw0[0]=PKW(P0,0), pw0[1]=PKW(P0,2), pw0); \
    VRD(4); SBAR(); GAPA(C1=__builtin_amdgcn_mfma_f32_32x32x16_bf16(kf[1],qr[0],zc,0,0,0), P0[6],P0[7],P0[8],P0[9],     pw0[2]=PKW(P0,4), pw0[3]=PKW(P0,6), pw0); \
    VRD(1); SBAR(); GAPA(C0=__builtin_amdgcn_mfma_f32_32x32x16_bf16(kf[2],qr[1],C0,0,0,0),   P0[10],P0[11],P0[12],P0[13], pw1[0]=PKW(P0,8), pw1[1]=PKW(P0,10), pw1); \
    VRD(5); SBAR(); GAPA(C1=__builtin_amdgcn_mfma_f32_32x32x16_bf16(kf[3],qr[1],C1,0,0,0),   P0[14],P0[15],P1[0],P1[1],   pw1[2]=PKW(P0,12),pw1[3]=PKW(P0,14), pw1); \
    VRD(2); SBAR(); GAPA(C0=__builtin_amdgcn_mfma_f32_32x32x16_bf16(kf[4],qr[2],C0,0,0,0),   P1[2],P1[3],P1[4],P1[5],     pw2[0]=PKW(P1,0), pw2[1]=PKW(P1,2), pw2); \
    VRD(6); SBAR(); GAPA(C1=__builtin_amdgcn_mfma_f32_32x32x16_bf16(kf[5],qr[2],C1,0,0,0),   P1[6],P1[7],P1[8],P1[9],     pw2[2]=PKW(P1,4), pw2[3]=PKW(P1,6), pw2); \
    VRD(3); SBAR(); GAPA(C0=__builtin_amdgcn_mfma_f32_32x32x16_bf16(kf[6],qr[3],C0,0,0,0),   P1[10],P1[11],P1[12],P1[13], pw3[0]=PKW(P1,8), pw3[1]=PKW(P1,10), pw3); \
    VRD(7); SBAR(); GAPA(C1=__builtin_amdgcn_mfma_f32_32x32x16_bf16(kf[7],qr[3],C1,0,0,0),   P1[14],P1[15],0.f,0.f,       pw3[2]=PKW(P1,12),pw3[3]=PKW(P1,14), pw3); \
    l_reg+=sacc; \
    if(GK){DMA_K((t)+3,sl_cur);} if(GV){DMA_V((t)+1,sl_next);} \
    CMASK(C0,C1,t); \
    { float a=MX3(C0[0],C0[1],C1[0]),b=MX3(C0[2],C0[3],C1[1]); a=MX3(a,C1[2],C1[3]); \
      _Pragma("unroll") for(int r=4;r<16;r+=4){a=MX3(a,C0[r],C0[r+1]);b=MX3(b,C0[r+2],C0[r+3]);a=MX3(a,C1[r],C1[r+1]);b=MX3(b,C1[r+2],C1[r+3]);} \
      float rm=__builtin_fmaxf(a,b); { auto rr=__builtin_amdgcn_permlane32_swap(__float_as_uint(rm),__float_as_uint(rm),false,false); rm=__builtin_fmaxf(__uint_as_float(rr[0]),__uint_as_float(rr[1])); } \
      rm-=mhat; resc=false; \
      if(__builtin_expect(__any(rm>(float)THRL),0)){ const float dl=__builtin_fmaxf(rm,0.f); mhat+=dl; \
        const float f=__builtin_amdgcn_exp2f(-dl); l_reg*=f; if(hi==0)wsf[r32]=f; resc=true; } } \
    SBAR(); \
    GAPB2(o[0]=__builtin_amdgcn_mfma_f32_32x32x16_bf16(PAF(0),VFR(0),o[0],0,0,0), C0,0);  VRX(0); \
    GAPB2(o[1]=__builtin_amdgcn_mfma_f32_32x32x16_bf16(PAF(0),VFR(4),o[1],0,0,0), C0,2);  VRX(4); \
    KRD(GL,0); GAPB2(o[0]=__builtin_amdgcn_mfma_f32_32x32x16_bf16(PAF(1),VFR(1),o[0],0,0,0), C0,4);  VRX(1); \
    KRD(GL,1); GAPB2(o[1]=__builtin_amdgcn_mfma_f32_32x32x16_bf16(PAF(1),VFR(5),o[1],0,0,0), C0,6);  VRX(5); \
    KRD(GL,2); GAPB2(o[0]=__builtin_amdgcn_mfma_f32_32x32x16_bf16(PAF(2),VFR(2),o[0],0,0,0), C0,8);  VRX(2); \
    KRD(GL,3); GAPB2(o[1]=__builtin_amdgcn_mfma_f32_32x32x16_bf16(PAF(2),VFR(6),o[1],0,0,0), C0,10); VRX(6); \
    GAPB2(o[0]=__builtin_amdgcn_mfma_f32_32x32x16_bf16(PAF(3),VFR(3),o[0],0,0,0), C0,12); VRX(3); \
    GAPB2(o[1]=__builtin_amdgcn_mfma_f32_32x32x16_bf16(PAF(3),VFR(7),o[1],0,0,0), C0,14); VRX(7); \
    GAPB2(o[2]=__builtin_amdgcn_mfma_f32_32x32x16_bf16(PAF(0),VFR(0),o[2],0,0,0), C1,0); \
    GAPB2(o[3]=__builtin_amdgcn_mfma_f32_32x32x16_bf16(PAF(0),VFR(4),o[3],0,0,0), C1,2); \
    GAPB2(o[2]=__builtin_amdgcn_mfma_f32_32x32x16_bf16(PAF(1),VFR(1),o[2],0,0,0), C1,4); \
    GAPB2(o[3]=__builtin_amdgcn_mfma_f32_32x32x16_bf16(PAF(1),VFR(5),o[3],0,0,0), C1,6); \
    GAPB2(o[2]=__builtin_amdgcn_mfma_f32_32x32x16_bf16(PAF(2),VFR(2),o[2],0,0,0), C1,8); \
    GAPB2(o[3]=__builtin_amdgcn_mfma_f32_32x32x16_bf16(PAF(2),VFR(6),o[3],0,0,0), C1,10); \
    GAPB2(o[2]=__builtin_amdgcn_mfma_f32_32x32x16_bf16(PAF(3),VFR(3),o[2],0,0,0), C1,12); \
    GAPB2(o[3]=__builtin_amdgcn_mfma_f32_32x32x16_bf16(PAF(3),VFR(7),o[3],0,0,0), C1,14); \
    }while(0)
  int t=1;
  #undef CMASK
  #define CMASK(P0,P1,t) do{}while(0)
  for(;t+5<NT;t+=2){
    STEP(pB0,pB1,pA0,pA1,t,true,true,true);     WAIT_BAR(3); RESC(); ROT();
    STEP(pA0,pA1,pB0,pB1,t+1,true,true,true);   WAIT_BAR(3); RESC(); ROT();
  }
  #undef CMASK
  #define CMASK(P0,P1,t) do{int jb_=(t)-(NT-4); if(jb_>=0)cmask(P0,P1,jb_,qrel,hi);}while(0)
  #define ENDW(tt) do{ if((tt)+3<NT){WAIT_BAR(3);} else if((tt)+2<NT){WAIT_BAR(2);} else {WAIT_BAR(0);} }while(0)
  for(;t+1<NT;t+=2){
    STEP(pB0,pB1,pA0,pA1,t,(t+3<NT),(t+1<NT),(t+1<NT));       ENDW(t);   RESC(); ROT();
    STEP(pA0,pA1,pB0,pB1,t+1,(t+4<NT),(t+2<NT),(t+2<NT));     ENDW(t+1); RESC(); ROT();
  }
  STEP(pB0,pB1,pA0,pA1,NT-1,false,false,false); RESC();
  { float sacc=pB0[0]+pB0[1]; _Pragma("unroll") for(int r=2;r<16;++r)sacc+=pB0[r]; _Pragma("unroll") for(int r=0;r<16;++r)sacc+=pB1[r]; l_reg+=sacc;
    pw0=(u32x4){PKW(pB0,0),PKW(pB0,2),PKW(pB0,4),PKW(pB0,6)};pw1=(u32x4){PKW(pB0,8),PKW(pB0,10),PKW(pB0,12),PKW(pB0,14)};pw2=(u32x4){PKW(pB1,0),PKW(pB1,2),PKW(pB1,4),PKW(pB1,6)};pw3=(u32x4){PKW(pB1,8),PKW(pB1,10),PKW(pB1,12),PKW(pB1,14)};
    SBAR(); pv128(o,vb0+2*sl_cur,PAF(0),PAF(1),PAF(2),PAF(3)); }
  #undef PKW
  #undef PAF
  #undef VFR
  #undef PIN
  #undef MX3
  #undef GAPA
  #undef GAPB
  #undef EX
  #undef VRD
  #undef VRX
  #undef GAPB2
  #undef KRD
  #undef STEP
  #undef ENDW
  {auto rr=__builtin_amdgcn_permlane32_swap(__float_as_uint(l_reg),__float_as_uint(l_reg),false,false);l_reg=__uint_as_float(rr[0])+__uint_as_float(rr[1]);}
  if(hi==0)wsf[32+r32]=l_reg;asm volatile("s_waitcnt lgkmcnt(0)":::"memory");
  float rli[16];
  #pragma unroll
  for(int r=0;r<16;++r)rli[r]=__builtin_amdgcn_rcpf(wsf[32+crow(r,hi)]);
  bf16*Ow=O+(rowbase+q0+wid*QBLK)*DM+hv*D;
  { bf16*stg=(bf16*)(shm+LDS_OST2)+wid*2048;
    #pragma unroll
    for(int hp=0;hp<2;++hp){
      #pragma unroll
      for(int r=0;r<16;++r){const int orow=crow(r,hi);
        #pragma unroll
        for(int d0=0;d0<2;++d0)stg[orow*64+d0*32+r32]=__float2bfloat16(o[2*hp+d0][r]*rli[r]);}
      asm volatile("s_waitcnt lgkmcnt(0)":::"memory");
      #pragma unroll
      for(int i=0;i<4;++i){const int row=i*8+(lane>>3),ch=lane&7; const u32x4 v=*(const u32x4*)(stg+row*64+ch*8); ATTN_STORE16(Ow+(long)row*DM+hp*64+ch*8,v);}
      asm volatile("s_waitcnt lgkmcnt(0)":::"memory"); } }
  asm volatile("s_waitcnt lgkmcnt(0)\n\ts_barrier":::"memory");
  #undef DMA_K
  #undef DMA_V
  #undef CMASK
  #undef START
  #undef RESC
  #undef ROT
}
constexpr int ATTN_LDS_BYTES=LDS_BYTES;
#undef SBAR
#undef WAIT_BAR
}
#define GAS __attribute__((address_space(1)))
#define LAS __attribute__((address_space(3)))
typedef unsigned short bf16;
typedef unsigned v4u __attribute__((ext_vector_type(4)));
typedef float f32x4 __attribute__((ext_vector_type(4)));
typedef short bf16x8 __attribute__((ext_vector_type(8)));
typedef GAS unsigned gu32;
typedef GAS unsigned long long gu64;
#define RLX_AGENT __ATOMIC_RELAXED, __HIP_MEMORY_SCOPE_AGENT
#define LDS_WAIT() asm volatile("s_waitcnt lgkmcnt(0)" ::: "memory")
#define VM_WAIT() asm volatile("s_waitcnt vmcnt(0)" ::: "memory")
__device__ __forceinline__ unsigned long long rt() { return __builtin_amdgcn_s_memrealtime(); }
__device__ __forceinline__ unsigned f2bf(float f) { unsigned u = __builtin_bit_cast(unsigned, f); return (u + 0x7fffu + ((u >> 16) & 1u)) >> 16; }
__device__ __forceinline__ unsigned pk2(float lo, float hi) { return f2bf(lo) | (f2bf(hi) << 16); }

#define XB_TMO      128
#define XB_XCNT(j)  (256  + 64 * (j))
#define XB_XSUB(j)  (1280 + 64 * (j))
#define XB_XGEN(j)  (2304 + 64 * (j))
#define XB_TOP      3328
#define XB_TOPGEN   3392
#define XCD_BAR_WORDS 3456
#define XB_SPIN_CAP (1u << 18)

__device__ __forceinline__ unsigned xb_ld(unsigned* p)              { return __hip_atomic_load(p, __ATOMIC_RELAXED, __HIP_MEMORY_SCOPE_AGENT); }
__device__ __forceinline__ unsigned xb_add(unsigned* p, unsigned v) { return __hip_atomic_fetch_add(p, v, __ATOMIC_RELAXED, __HIP_MEMORY_SCOPE_AGENT); }
__device__ __forceinline__ unsigned xb_xcc_id() { return (unsigned)__builtin_amdgcn_s_getreg((3 << 11) | 20) & 0xFu; }
#define XB_SPIN(cond, bar) do { unsigned _sp = 0; while (cond) { __builtin_amdgcn_s_sleep(1); \
    if ((++_sp & 255u) == 0u) { if (xb_ld(&(bar)[XB_TMO])) break; if (_sp > XB_SPIN_CAP) { atomicAdd(&(bar)[XB_TMO], 1u); break; } } } } while (0)

struct XcdBarrier {
    unsigned* bar; unsigned x;
    volatile LAS unsigned* st;
};

__device__ __forceinline__ XcdBarrier xcd_barrier_post(unsigned* bar, volatile LAS unsigned* st) {
    XcdBarrier b; b.bar = bar; b.x = xb_xcc_id(); b.st = st;
    if (opaque_tid() == 0) (void)xb_add(&bar[XB_XCNT(b.x)], 1u);
    return b;
}
__device__ __forceinline__ void xcd_barrier_complete(unsigned* bar, unsigned x, unsigned& nloc, unsigned& nx) {
    const unsigned G = gridDim.x * gridDim.y * gridDim.z;
    unsigned sum, cnt, mine, sp = 0u;
    for (;;) {
        sum = 0u; cnt = 0u;
#pragma unroll
        for (unsigned j = 0; j < 16; ++j) { const unsigned c = xb_ld(&bar[XB_XCNT(j)]); sum += c; cnt += (c > 0u) ? 1u : 0u; }
        if (sum == G) break;
        __builtin_amdgcn_s_sleep(1);
        if ((++sp & 255u) == 0u) { if (xb_ld(&bar[XB_TMO])) break; if (sp > XB_SPIN_CAP) { atomicAdd(&bar[XB_TMO], 1u); break; } }
    }
    mine = xb_ld(&bar[XB_XCNT(x)]);
    nloc = mine > 0u ? mine : 1u; nx = cnt > 0u ? cnt : 1u;
}

__device__ __forceinline__ void xcd_barrier(const XcdBarrier& b) {
    asm volatile("s_waitcnt vmcnt(0)" ::: "memory");
    __syncthreads();
    if (opaque_tid() == 0) {
        unsigned* bar = b.bar;
        __builtin_amdgcn_s_waitcnt(0);
        unsigned nloc = b.st[0], nx = b.st[1];
        if (nloc == 0u) { xcd_barrier_complete(bar, b.x, nloc, nx); b.st[0] = nloc; b.st[1] = nx; }
        const unsigned old = xb_add(&bar[XB_XSUB(b.x)], 1u);
        const unsigned gen = old / nloc;
        if (old + 1u == (gen + 1u) * nloc) {
            __builtin_amdgcn_fence(__ATOMIC_RELEASE, "agent");
            asm volatile("s_waitcnt vmcnt(0)" ::: "memory");
            const unsigned og = xb_add(&bar[XB_TOP], 1u);
            const unsigned tg = og / nx;
            if (og + 1u == (tg + 1u) * nx) xb_add(&bar[XB_TOPGEN], 1u);
            else XB_SPIN(xb_ld(&bar[XB_TOPGEN]) == tg, bar);
            __builtin_amdgcn_fence(__ATOMIC_ACQUIRE, "agent");
            xb_add(&bar[XB_XGEN(b.x)], 1u);
            asm volatile("s_waitcnt vmcnt(0)" ::: "memory");
        } else {
            XB_SPIN(xb_ld(&bar[XB_XGEN(b.x)]) == gen, bar);
            __builtin_amdgcn_fence(__ATOMIC_ACQUIRE, "agent");
            asm volatile("s_waitcnt vmcnt(0)" ::: "memory");
        }
    }
    __syncthreads();
}
constexpr int NWAVES = 8;
constexpr int DM = 1024, MP = 32768, MS = 512, MROWS = MP + MS, NSEQ = 20, DEPTH = 4, DFF = 2816, DIN = 9216, PAST = 2048;
constexpr int NCHUNK_P = 512, NCHUNK = 528;
constexpr float EPS = 1e-6f;
constexpr size_t OY_P = 0, OY_S = 33554432, OK_P = 34078720, OV_P = 168296448, OS_P = 302514176, OK_S = 304611328, OV_S = 306708480, OS_S = 308805632, OUT_TOTAL = 317194240;

constexpr size_t MiB = 1u << 20;
constexpr size_t WS_CTL = 0, CTL_ZERO_BYTES = 1 * MiB;
constexpr size_t WS_MOD = 1 * MiB;
constexpr size_t WS_LB = 4 * MiB;
constexpr size_t WS_W = 8 * MiB, W_LAYER = 57 * MiB;
constexpr size_t WO_GU1 = 0, WO_D1 = 11 * MiB, WO_IN = 16 * MiB + MiB / 2, WO_BA = 34 * MiB + MiB / 2, WO_BH = 36 * MiB + MiB / 2, WO_OUT = 38 * MiB + MiB / 2, WO_GU2 = 40 * MiB + MiB / 2, WO_D2 = 51 * MiB + MiB / 2;
constexpr size_t WS_X = 240 * MiB;
constexpr size_t WS_XN = 370 * MiB;
constexpr size_t WS_Q = 435 * MiB, WS_K = 500 * MiB, WS_V = 565 * MiB;
constexpr size_t WS_QQ = 630 * MiB, WS_KK = 695 * MiB, WS_VV = 760 * MiB, WS_HGS = 825 * MiB, WS_SZA = 890 * MiB, WS_SZH = 955 * MiB;
constexpr size_t WS_LOGF = 1020 * MiB;
constexpr size_t WS_O1 = 1150 * MiB, WS_O2 = 1215 * MiB, WS_OATT = 1280 * MiB, WS_OH = 1345 * MiB, WS_MRG = 1410 * MiB;
constexpr size_t WS_BIG = 1475 * MiB;
constexpr size_t WS_SST = 1739 * MiB;
constexpr size_t WS_DD = 1871 * MiB;
constexpr size_t WS_END = 1874 * MiB;
#ifndef TEAM_STRIDE
#define TEAM_STRIDE 8
#endif
#ifndef STARTERS
#define STARTERS 4
#endif
constexpr int T_TEAM = 256 / TEAM_STRIDE;
#ifndef G3_STAGGER_TICKS
#define G3_STAGGER_TICKS 800
#endif
constexpr int HG_G = 4;
constexpr size_t WS_QS = WS_BIG, WS_SL = WS_BIG + 64 * MiB, WS_DSEG = WS_BIG + 72 * MiB, WS_RAW = WS_SST;
constexpr int CW_BAR = 4096, CW_Q = 8192, CW_HS = 16384;
static_assert(pg8::EpiWin::O_Q == WS_Q && pg8::EpiWin::O_K == WS_K && pg8::EpiWin::O_V == WS_V && pg8::EpiWin::O_QQ == WS_QQ && pg8::EpiWin::O_KK == WS_KK && pg8::EpiWin::O_VV == WS_VV && pg8::EpiWin::O_HGS == WS_HGS && pg8::EpiWin::O_SZA == WS_SZA && pg8::EpiWin::O_SZH == WS_SZH && pg8::EpiWin::O_LOGF == WS_LOGF && pg8::EpiWin::O_LB == WS_LB && pg8::EpiWin::OK_P_ == OK_P && pg8::EpiWin::OV_P_ == OV_P && pg8::EpiWin::OK_S_ == OK_S && pg8::EpiWin::OV_S_ == OV_S, "EpiWin offsets");

constexpr int RING_OFF = 0, RING_BYTES = 139264;
constexpr int LDSCTL_OFF = RING_BYTES, MISC_OFF = LDSCTL_OFF + 320;
constexpr int LDS_BYTES = 147456;

struct Frame {
    LAS unsigned char* lds;
    volatile LAS unsigned* MISC;
    gu32* ctl;
    int tid, lane, wave;
    int vcu, G;
};
typedef float f32x16 __attribute__((ext_vector_type(16)));
typedef unsigned v2u __attribute__((ext_vector_type(2)));

__device__ __forceinline__ float shx(float v, int mask, int lane) { return __builtin_bit_cast(float, __builtin_amdgcn_ds_bpermute((lane ^ mask) << 2, __builtin_bit_cast(int, v))); }
__device__ __forceinline__ float wave_sum(float v, int lane) {
#pragma unroll
    for (int o = 1; o < 64; o <<= 1) v += shx(v, o, lane);
    return v;
}
__device__ __forceinline__ float bf2f(bf16 b) { return __builtin_bit_cast(float, (unsigned)b << 16); }
__device__ __forceinline__ unsigned cvtpk(float lo, float hi) { return pg8::cvt_pk_bf16(lo, hi); }
__device__ __forceinline__ bf16x8 pack8(f32x4 a, f32x4 b) { v4u w; w.x = cvtpk(a[0], a[1]); w.y = cvtpk(a[2], a[3]); w.z = cvtpk(b[0], b[1]); w.w = cvtpk(b[2], b[3]); return __builtin_bit_cast(bf16x8, w); }
__device__ __forceinline__ float lam_init_of(int l) { asm volatile("" : "+s"(l)); return 0.8f - 0.6f * __expf(-0.3f * (float)l); }

__device__ __forceinline__ void p0_transpose_item(const float* W, int K, int N, bf16* WT, bool gu, LAS float* scr, int item, int lane) {
    const int nblk = N / 32, kb = item / nblk, nb = item % nblk, k0 = 64 * kb, nd0 = 32 * nb;
    const int ns0 = gu ? (((nd0 >> 7) & 1) * 2816 + (nd0 >> 8) * 128 + (nd0 & 127)) : nd0;
#pragma unroll 8
    for (int i = 0; i < 32; ++i) { const int kk = 2 * i + (lane >> 5); scr[kk * 33 + (lane & 31)] = W[(size_t)(k0 + kk) * N + ns0 + (lane & 31)]; }
    LDS_WAIT(); asm volatile("" ::: "memory");
    const int c = lane & 7;
#pragma unroll
    for (int j = 0; j < 4; ++j) { const int n = (lane >> 3) + 8 * j; const LAS float* s = scr + (8 * c) * 33 + n;
        v4u o; o.x = pk2(s[0 * 33], s[1 * 33]); o.y = pk2(s[2 * 33], s[3 * 33]); o.z = pk2(s[4 * 33], s[5 * 33]); o.w = pk2(s[6 * 33], s[7 * 33]);
        *(GAS v4u*)(WT + (size_t)(nd0 + n) * K + k0 + 8 * c) = o; }
    LDS_WAIT(); asm volatile("" ::: "memory");
}
typedef const __attribute__((address_space(4))) char* kaptr_t;
__device__ __forceinline__ const float* karg(int i) { kaptr_t ka = (kaptr_t)__builtin_amdgcn_kernarg_segment_ptr(); asm volatile("" : "+s"(ka)); return *(const float* const __attribute__((address_space(4)))*)(ka + 8 * i); }
enum { A_XP = 0, A_XS, A_CK, A_CV, A_ST, A_CP, A_CS, A_WADA, A_BADA, A_GFFN1, A_WGU1, A_WD1, A_GMIX, A_WIN, A_LAM, A_GSUB, A_LBL, A_GHG, A_WBA, A_WBH, A_WOUT, A_GFFN2, A_WGU2, A_WD2, A_GFIN, A_OUT, A_WS };
__device__ __forceinline__ void p0_prologue(Frame& F, unsigned char* ws) {
    { LAS float* scr = (LAS float*)(F.lds + RING_OFF + F.wave * 16384);
      const int gw = F.vcu * NWAVES + F.wave, NGW = F.G * NWAVES;
      constexpr int I_GU = 16 * 176, I_D = 44 * 32, I_IN = 16 * 288, I_SQ = 16 * 32, I_LAYER = 2 * I_GU + 2 * I_D + I_IN + 3 * I_SQ;
      for (int it = gw; it < DEPTH * I_LAYER; it += NGW) {
          const int l = it / I_LAYER; int r = it % I_LAYER; unsigned char* wl = ws + WS_W + (size_t)l * W_LAYER;
          if (r < I_GU) { p0_transpose_item(karg(A_WGU1) + (size_t)l * 1024 * 5632, 1024, 5632, (bf16*)(wl + WO_GU1), true, scr, r, F.lane); continue; } r -= I_GU;
          if (r < I_D)  { p0_transpose_item(karg(A_WD1) + (size_t)l * 2816 * 1024, 2816, 1024, (bf16*)(wl + WO_D1), false, scr, r, F.lane); continue; } r -= I_D;
          if (r < I_IN) { p0_transpose_item(karg(A_WIN) + (size_t)l * 1024 * 9216, 1024, 9216, (bf16*)(wl + WO_IN), false, scr, r, F.lane); continue; } r -= I_IN;
          if (r < I_SQ) { p0_transpose_item(karg(A_WBA) + (size_t)l * 1024 * 1024, 1024, 1024, (bf16*)(wl + WO_BA), false, scr, r, F.lane); continue; } r -= I_SQ;
          if (r < I_SQ) { p0_transpose_item(karg(A_WBH) + (size_t)l * 1024 * 1024, 1024, 1024, (bf16*)(wl + WO_BH), false, scr, r, F.lane); continue; } r -= I_SQ;
          if (r < I_SQ) { p0_transpose_item(karg(A_WOUT) + (size_t)l * 1024 * 1024, 1024, 1024, (bf16*)(wl + WO_OUT), false, scr, r, F.lane); continue; } r -= I_SQ;
          if (r < I_GU) { p0_transpose_item(karg(A_WGU2) + (size_t)l * 1024 * 5632, 1024, 5632, (bf16*)(wl + WO_GU2), true, scr, r, F.lane); continue; } r -= I_GU;
          p0_transpose_item(karg(A_WD2) + (size_t)l * 2816 * 1024, 2816, 1024, (bf16*)(wl + WO_D2), false, scr, r, F.lane);
      } }
    __syncthreads();
    { const float* c_p = karg(A_CP); const float* c_s = karg(A_CS); const float* w_ada = karg(A_WADA); const float* b_ada = karg(A_BADA);
      LAS float* ca = (LAS float*)(F.lds);
      LAS float* red = (LAS float*)(F.lds + 81920);
      for (int i = F.tid; i < NSEQ * 1024; i += NWAVES * 64) { const int s = i >> 10, k = i & 1023; const float c = s < 4 ? c_p[s * 1024 + k] : c_s[(s - 4) * 1024 + k]; ca[i] = pg8::silu_f(c); }
      __syncthreads();
      float* MOD = (float*)(ws + WS_MOD);
      for (int it = F.vcu; it < DEPTH * 144; it += F.G) {
          const int l = it / 144, n = (it % 144) * 64 + F.lane; const float* wp = w_ada + ((size_t)l * 1024 + F.wave * 128) * 9216 + n;
          float acc[NSEQ];
#pragma unroll
          for (int s = 0; s < NSEQ; ++s) acc[s] = 0.f;
#pragma unroll 4
          for (int k = 0; k < 128; ++k) { const float w = wp[(size_t)k * 9216];
#pragma unroll
              for (int s = 0; s < NSEQ; ++s) acc[s] += ca[s * 1024 + F.wave * 128 + k] * w; }
#pragma unroll
          for (int s = 0; s < NSEQ; ++s) red[(F.wave * NSEQ + s) * 64 + F.lane] = acc[s];
          __syncthreads();
          for (int i = F.tid; i < NSEQ * 64; i += NWAVES * 64) { const int s = i >> 6, c = i & 63; float v = 0.f;
#pragma unroll
              for (int w = 0; w < 8; ++w) v += red[(w * NSEQ + s) * 64 + c];
              const int nn = (it % 144) * 64 + c; MOD[((size_t)l * NSEQ + s) * 9216 + nn] = v + b_ada[(size_t)l * 9216 + nn]; }
          __syncthreads();
      } }
    if (F.vcu == 0) { float* LB = (float*)(ws + WS_LB); const float* lb_logits = karg(A_LBL);
        for (int c = F.tid; c < 1024; c += NWAVES * 64) { float lg[4], mx = -INFINITY;
#pragma unroll
            for (int l = 0; l < 4; ++l) { lg[l] = lb_logits[l * 1024 + c]; mx = __builtin_fmaxf(mx, lg[l]); }
            float sum = 0.f;
#pragma unroll
            for (int l = 0; l < 4; ++l) { lg[l] = __expf(lg[l] - mx); sum += lg[l]; }
            const float inv = 1.f / sum; float cs = 0.f;
#pragma unroll
            for (int l = 0; l < 4; ++l) { cs += lg[l] * inv; LB[l * 1024 + c] = cs - lg[0] * inv; } } }
}

__device__ __forceinline__ void norm_phase(Frame& F, const float* X, const float* g, const float* mod_l, int sub, bf16* XN, int row0, int row1, int gw, int NGW) {
    const int RW = (row1 - row0) / NGW, rbeg = row0 + gw * RW;
    const float* mp = mod_l + (size_t)pg8::row_seq(rbeg) * 9216 + sub * 3 * 1024;
    f32x4 av[4], bv[4];
#pragma unroll
    for (int j = 0; j < 4; ++j) { const int c = 4 * F.lane + 256 * j; const f32x4 gg = *(const f32x4*)(g + c), sc = *(const f32x4*)(mp + 1024 + c); bv[j] = *(const f32x4*)(mp + c); av[j] = gg * (sc + 1.f); }
    for (int i = 0; i < RW; i += 2) {
        const int row = rbeg + i;
        const float* src = X + (size_t)row * DM;
        const f32x4* xr = (const f32x4*)src + F.lane; f32x4 v[2][4]; float s2[2] = {0.f, 0.f};
#pragma unroll
        for (int u = 0; u < 2; ++u)
#pragma unroll
            for (int j = 0; j < 4; ++j) v[u][j] = xr[u * 256 + 64 * j];
#pragma unroll
        for (int u = 0; u < 2; ++u)
#pragma unroll
            for (int j = 0; j < 4; ++j) s2[u] += (v[u][j].x * v[u][j].x + v[u][j].y * v[u][j].y) + (v[u][j].z * v[u][j].z + v[u][j].w * v[u][j].w);
#pragma unroll
        for (int u = 0; u < 2; ++u) { const float rstd = __builtin_amdgcn_rsqf(wave_sum(s2[u], F.lane) * (1.f / DM) + EPS);
            v2u* o8 = (v2u*)(XN + (size_t)(row + u) * DM) + F.lane;
#pragma unroll
            for (int j = 0; j < 4; ++j) { const f32x4 h = (v[u][j] * rstd) * av[j] + bv[j]; v2u o; o.x = cvtpk(h.x, h.y); o.y = cvtpk(h.z, h.w); o8[64 * j] = o; } }
    }
}
__device__ __forceinline__ void final_norm_phase(Frame& F, const float* X, const float* g, float* out) {
    const int gw = F.vcu * NWAVES + F.wave, NGW = F.G * NWAVES;
    for (int row = gw; row < MROWS; row += NGW) {
        const f32x4* xr = (const f32x4*)(X + (size_t)row * DM) + F.lane; f32x4 v[4]; float s2 = 0.f;
#pragma unroll
        for (int j = 0; j < 4; ++j) { v[j] = xr[64 * j]; s2 += (v[j].x * v[j].x + v[j].y * v[j].y) + (v[j].z * v[j].z + v[j].w * v[j].w); }
        const float rstd = __builtin_amdgcn_rsqf(wave_sum(s2, F.lane) * (1.f / DM) + EPS);
        f32x4* o = (f32x4*)(out + (row < MP ? OY_P + (size_t)row * DM : OY_S + (size_t)(row - MP) * DM)) + F.lane;
#pragma unroll
        for (int j = 0; j < 4; ++j) { const f32x4 gg = *(const f32x4*)(g + 4 * F.lane + 256 * j); o[64 * j] = (v[j] * rstd) * gg; }
    }
}
__device__ __forceinline__ float lam_of(const float* att_lambda, int l, int lane) {
    const float* lp = att_lambda + (size_t)l * 256;
    const float a = wave_sum(lp[lane] * lp[64 + lane], lane), b = wave_sum(lp[128 + lane] * lp[192 + lane], lane);
    return __expf(a) - __expf(b) + lam_init_of(l);
}
__device__ __forceinline__ void attn_combine_phase(Frame& F, const bf16* O1, const bf16* O2, const float* gsub, float lam, float osc, bf16* OATT) {
    const int gw = F.vcu * NWAVES + F.wave, NGW = F.G * NWAVES; const int cl = (F.lane & 7) * 16;
    float gv[16];
#pragma unroll
    for (int i = 0; i < 16; ++i) gv[i] = gsub[cl + i] * osc;
    for (int row = gw; row < MP; row += 2 * NGW) {
        v4u a0[2], a1[2], b0[2], b1[2];
#pragma unroll
        for (int u = 0; u < 2; ++u) { const size_t off = (size_t)(row + u * NGW) * DM + F.lane * 16; a0[u] = *(const v4u*)(O1 + off); a1[u] = *(const v4u*)(O1 + off + 8); b0[u] = *(const v4u*)(O2 + off); b1[u] = *(const v4u*)(O2 + off + 8); }
#pragma unroll
        for (int u = 0; u < 2; ++u) { const size_t off = (size_t)(row + u * NGW) * DM + F.lane * 16;
            const unsigned aw[8] = {a0[u].x, a0[u].y, a0[u].z, a0[u].w, a1[u].x, a1[u].y, a1[u].z, a1[u].w}, bw[8] = {b0[u].x, b0[u].y, b0[u].z, b0[u].w, b1[u].x, b1[u].y, b1[u].z, b1[u].w};
            float o[16]; float ss = 0.f;
#pragma unroll
            for (int i = 0; i < 8; ++i) { o[2 * i] = pg8::bf_lo(aw[i]) - lam * pg8::bf_lo(bw[i]); o[2 * i + 1] = pg8::bf_hi(aw[i]) - lam * pg8::bf_hi(bw[i]); ss += o[2 * i] * o[2 * i] + o[2 * i + 1] * o[2 * i + 1]; }
            ss += shx(ss, 1, F.lane); ss += shx(ss, 2, F.lane); ss += shx(ss, 4, F.lane);
            const float rstd = __builtin_amdgcn_rsqf(ss * (1.f / 128.f) + EPS);
            v4u w0, w1;
            w0.x = cvtpk(o[0] * rstd * gv[0], o[1] * rstd * gv[1]); w0.y = cvtpk(o[2] * rstd * gv[2], o[3] * rstd * gv[3]); w0.z = cvtpk(o[4] * rstd * gv[4], o[5] * rstd * gv[5]); w0.w = cvtpk(o[6] * rstd * gv[6], o[7] * rstd * gv[7]);
            w1.x = cvtpk(o[8] * rstd * gv[8], o[9] * rstd * gv[9]); w1.y = cvtpk(o[10] * rstd * gv[10], o[11] * rstd * gv[11]); w1.z = cvtpk(o[12] * rstd * gv[12], o[13] * rstd * gv[13]); w1.w = cvtpk(o[14] * rstd * gv[14], o[15] * rstd * gv[15]);
            *(v4u*)(OATT + off) = w0; *(v4u*)(OATT + off + 8) = w1; }
    }
}

__device__ __forceinline__ void attn_sample_unit(Frame& F, const float* cache_k, const float* cache_v, int l, int s, int head, const bf16* Qb, const bf16* Kb, const bf16* Vb, float lam, float osc, const float* gsub, bf16* OATT) {
    const int lane = F.lane, w = F.wave, q = lane & 31, hh = lane >> 5, vt = w & 3, kh = w >> 2;
    LAS float* SLOT = (LAS float*)(F.lds);
    LAS float* ML = (LAS float*)(F.lds + 16384);
    LAS float* SSQ = (LAS float*)(F.lds + 16384 + 512);
    const size_t qrow = (size_t)MP + (size_t)s * 32;
    const float* ck = cache_k + ((size_t)(l * 16 + s) * PAST) * 1024 + head * 128;
    const float* cv = cache_v + ((size_t)(l * 16 + s) * PAST) * 1024 + head * 128;
    f32x16 o1;
#pragma unroll
    for (int r = 0; r < 16; ++r) o1[r] = 0.f;
    for (int m = 0; m < 2; ++m) {
        bf16x8 qf[4];
#pragma unroll
        for (int ks = 0; ks < 4; ++ks) qf[ks] = *(const bf16x8*)(Qb + (qrow + q) * 1024 + head * 128 + m * 64 + ks * 16 + 8 * hh);
        float mrun = -INFINITY, lrun = 0.f; f32x16 ot;
#pragma unroll
        for (int r = 0; r < 16; ++r) ot[r] = 0.f;
        const int ntile = 32 + kh;
        for (int t = 0; t < ntile; ++t) {
            const bool nw = (t == 32); const int key0 = kh * 1024 + t * 32;
            bf16x8 kf[4];
            if (!nw) { const float* kp = ck + (size_t)(key0 + q) * 1024 + m * 64 + 8 * hh;
#pragma unroll
                for (int ks = 0; ks < 4; ++ks) { const f32x4 a = *(const f32x4*)(kp + ks * 16), b = *(const f32x4*)(kp + ks * 16 + 4); kf[ks] = pack8(a, b); } }
            else {
#pragma unroll
                for (int ks = 0; ks < 4; ++ks) kf[ks] = *(const bf16x8*)(Kb + (qrow + q) * 1024 + head * 128 + m * 64 + ks * 16 + 8 * hh); }
            float vf[2][8];
            { const float* vp = cv + (size_t)(key0 + 4 * hh) * 1024 + 32 * vt + q; const bf16* vpn = Vb + (qrow + 4 * hh) * 1024 + head * 128 + 32 * vt + q;
#pragma unroll
              for (int s2 = 0; s2 < 2; ++s2)
#pragma unroll
                  for (int j = 0; j < 8; ++j) { const int kr = 16 * s2 + 8 * (j >> 2) + (j & 3);
                      vf[s2][j] = nw ? bf2f(vpn[kr * 1024]) : vp[kr * 1024]; } }
            f32x16 st;
#pragma unroll
            for (int r = 0; r < 16; ++r) st[r] = 0.f;
#pragma unroll
            for (int ks = 0; ks < 4; ++ks) st = __builtin_amdgcn_mfma_f32_32x32x16_bf16(kf[ks], qf[ks], st, 0, 0, 0);
            float tm = st[0];
#pragma unroll
            for (int r = 1; r < 16; ++r) tm = __builtin_fmaxf(tm, st[r]);
            tm = __builtin_fmaxf(tm, shx(tm, 32, lane));
            const float mnew = __builtin_fmaxf(mrun, tm), alpha = __builtin_amdgcn_exp2f(mrun - mnew);
            float ls = 0.f;
#pragma unroll
            for (int r = 0; r < 16; ++r) { st[r] = __builtin_amdgcn_exp2f(st[r] - mnew); ls += st[r]; }
            ls += shx(ls, 32, lane);
            lrun = lrun * alpha + ls; mrun = mnew;
#pragma unroll
            for (int r = 0; r < 16; ++r) ot[r] *= alpha;
#pragma unroll
            for (int s2 = 0; s2 < 2; ++s2) { v4u pw; pw.x = cvtpk(st[8 * s2], st[8 * s2 + 1]); pw.y = cvtpk(st[8 * s2 + 2], st[8 * s2 + 3]); pw.z = cvtpk(st[8 * s2 + 4], st[8 * s2 + 5]); pw.w = cvtpk(st[8 * s2 + 6], st[8 * s2 + 7]);
                v4u aw; aw.x = cvtpk(vf[s2][0], vf[s2][1]); aw.y = cvtpk(vf[s2][2], vf[s2][3]); aw.z = cvtpk(vf[s2][4], vf[s2][5]); aw.w = cvtpk(vf[s2][6], vf[s2][7]);
                ot = __builtin_amdgcn_mfma_f32_32x32x16_bf16(__builtin_bit_cast(bf16x8, aw), __builtin_bit_cast(bf16x8, pw), ot, 0, 0, 0); }
        }
        if (vt == 0 && hh == 0) { ML[(kh * 32 + q) * 2] = mrun; ML[(kh * 32 + q) * 2 + 1] = lrun; }
        __syncthreads();
        const float m0 = ML[q * 2], l0 = ML[q * 2 + 1], m1 = ML[(32 + q) * 2], l1 = ML[(32 + q) * 2 + 1];
        const float Mx = __builtin_fmaxf(m0, m1), L = l0 * __builtin_amdgcn_exp2f(m0 - Mx) + l1 * __builtin_amdgcn_exp2f(m1 - Mx);
        { const float sc = __builtin_amdgcn_exp2f(mrun - Mx);
#pragma unroll
          for (int r = 0; r < 16; ++r) ot[r] *= sc; }
        if (kh == 1) {
#pragma unroll
            for (int r = 0; r < 16; ++r) SLOT[(vt * 16 + r) * 64 + lane] = ot[r]; }
        __syncthreads();
        if (kh == 0) { const float rl = 1.f / L;
#pragma unroll
            for (int r = 0; r < 16; ++r) ot[r] = (ot[r] + SLOT[(vt * 16 + r) * 64 + lane]) * rl;
            if (m == 0) {
#pragma unroll
                for (int r = 0; r < 16; ++r) o1[r] = ot[r];
            } else { float ss = 0.f;
#pragma unroll
                for (int r = 0; r < 16; ++r) { o1[r] = o1[r] - lam * ot[r]; ss += o1[r] * o1[r]; }
                ss += shx(ss, 32, lane);
                if (hh == 0) SSQ[vt * 32 + q] = ss; } }
        __syncthreads();
    }
    if (kh == 0) {
        const float ss = SSQ[q] + SSQ[32 + q] + SSQ[64 + q] + SSQ[96 + q];
        const float rstd = __builtin_amdgcn_rsqf(ss * (1.f / 128.f) + EPS) * osc;
#pragma unroll
        for (int r = 0; r < 16; ++r) { const int v = 32 * vt + (r & 3) + 8 * (r >> 2) + 4 * hh; OATT[(qrow + q) * 1024 + head * 128 + v] = (bf16)f2bf(o1[r] * rstd * gsub[v]); }
    }
    __syncthreads();
}

constexpr int HS = 72, HK = 136;
__device__ __forceinline__ f32x4 mfma16(bf16x8 a, bf16x8 b, f32x4 c) { return __builtin_amdgcn_mfma_f32_16x16x32_bf16(a, b, c, 0, 0, 0); }
__device__ __forceinline__ void st16bf(LAS bf16* p, const float (&v)[16]) {
    v4u a, b; a.x = cvtpk(v[0], v[1]); a.y = cvtpk(v[2], v[3]); a.z = cvtpk(v[4], v[5]); a.w = cvtpk(v[6], v[7]); b.x = cvtpk(v[8], v[9]); b.y = cvtpk(v[10], v[11]); b.z = cvtpk(v[12], v[13]); b.w = cvtpk(v[14], v[15]);
    *(LAS v4u*)p = a; *(LAS v4u*)(p + 8) = b;
}
__device__ __forceinline__ float bfu(unsigned b) { return __builtin_bit_cast(float, b << 16); }
struct HgPtrs { const float* LOGF; const bf16 *QQ, *KK, *VV, *HGS; const float* ghg; bf16* OH; bf16* dump; };
typedef float f32x2v __attribute__((ext_vector_type(2)));
__device__ __forceinline__ void hg_load(const HgPtrs& P, size_t ubase  , unsigned k0, int w, int nvalid, f32x2v (&lf)[8], unsigned (&qv)[8], unsigned (&kv)[8], unsigned (&vv)[8]) {
    if (w * 8 < nvalid) {
#pragma unroll
        for (int i = 0; i < 8; ++i) { const size_t o = ubase + (size_t)(w * 8 + i) * 1024;
            const float* lp = P.LOGF + o; const bf16* qp = P.QQ + o; const bf16* kp = P.KK + o; const bf16* vp = P.VV + o;
            lf[i] = *(const f32x2v*)(lp + k0); qv[i] = *(const unsigned*)(qp + k0); kv[i] = *(const unsigned*)(kp + k0); vv[i] = *(const unsigned*)(vp + k0); }
    } else {
#pragma unroll
        for (int i = 0; i < 8; ++i) { lf[i] = (f32x2v){0.f, 0.f}; qv[i] = 0u; kv[i] = 0u; vv[i] = 0u; }
    }
}
#define HG_BAR() asm volatile("s_waitcnt lgkmcnt(0)\n\ts_barrier" ::: "memory")
template <int MODE> __device__ __forceinline__ void hg_sequence(Frame& F, const HgPtrs& P, size_t row0, int h, int nchunk, int nvalid, const float* s_in, float* s_out, bf16* QS, float* RAW, float* dseg) {
    LAS float* seg = (LAS float*)(F.lds);
    LAS float* part = (LAS float*)(F.lds + 4096);
    LAS float* dvec = (LAS float*)(F.lds + 6144);
    LAS bf16* QH = (LAS bf16*)(F.lds + 8192);
    LAS bf16* QT = QH + 64 * HK;
    LAS bf16* KH = QT + 64 * HK;
    LAS bf16* VT = KH + 160 * HK;
    LAS bf16* KT = VT + 128 * HS;
    LAS bf16* AL = KT + 128 * HS;
    const int w = __builtin_amdgcn_readfirstlane(F.wave), sc = w >> 1, lr_ = F.lane & 15, lq_ = F.lane >> 4; const unsigned k0_ = 2u * (unsigned)F.lane;
    f32x4 S[8];
#pragma unroll
    for (int kb = 0; kb < 8; ++kb)
#pragma unroll
        for (int r = 0; r < 4; ++r) S[kb][r] = s_in ? s_in[(size_t)(16 * kb + 4 * lq_ + r) * 128 + 16 * w + lr_] : 0.f;
    const float gv = P.ghg[16 * w + lr_];
    f32x2v bseg = {0.f, 0.f};
    f32x2v lf[8]; unsigned qv[8], kv[8], vv[8];
    hg_load(P, row0 * 1024 + h * 128, k0_, w, nvalid, lf, qv, kv, vv);
    for (int c = 0; c < nchunk; ++c) {
        int lr = lr_, lq = lq_; unsigned k0 = k0_; asm volatile("" : "+v"(lr), "+v"(lq), "+v"(k0));
        const int lx = lq * 16 + lr;
        const size_t crow = row0 + (size_t)c * 64;
        f32x2v cs[8]; { f32x2v run = {0.f, 0.f};
#pragma unroll
            for (int i = 0; i < 8; ++i) { run = run + lf[i]; cs[i] = run; }
            *(LAS f32x2v*)(seg + w * 128 + k0) = run; }
        HG_BAR();
        f32x2v P2[4], mypre = {0.f, 0.f}, tot; { f32x2v p = {0.f, 0.f};
#pragma unroll
            for (int s = 0; s < 8; ++s) { if ((s & 1) == 0) P2[s >> 1] = p; mypre = (s == w) ? p : mypre; p = p + *(const LAS f32x2v*)(seg + s * 128 + k0); } tot = p; }
        f32x2v myref = P2[0], nref = P2[1];
#pragma unroll
        for (int s = 1; s < 4; ++s) { myref = (s == sc) ? P2[s] : myref; nref = (s == sc) ? (s == 3 ? tot : P2[s < 3 ? s + 1 : 3]) : nref; }
        const f32x2v dq = mypre - myref;
        f32x2v fq, fT, fK[4]; fq.x = __expf(myref.x); fq.y = __expf(myref.y); fT.x = __expf(tot.x - nref.x); fT.y = __expf(tot.y - nref.y);
#pragma unroll
        for (int ii = 1; ii < 4; ++ii) { fK[ii].x = __expf(__builtin_fminf(P2[ii].x - nref.x, 0.f)); fK[ii].y = __expf(__builtin_fminf(P2[ii].y - nref.y, 0.f)); }
        f32x2v fqs = fq; if constexpr (MODE == 1) { fqs.x = fq.x * __expf(bseg.x); fqs.y = fq.y * __expf(bseg.y); bseg = bseg + tot; }
        float t0[8], t1[8];
#pragma unroll
        for (int i = 0; i < 8; ++i) { const int r = w * 8 + i; const float q0 = bfu(qv[i] & 0xffffu), q1 = bfu(qv[i] >> 16), a0 = bfu(kv[i] & 0xffffu), a1 = bfu(kv[i] >> 16);
            const float E0 = dq.x + cs[i].x, E1 = dq.y + cs[i].y;
            const float e1x = __expf(E0), e1y = __expf(E1);
            const float e2x = __builtin_fminf(__builtin_amdgcn_rcpf(e1x), 5.5e34f), e2y = __builtin_fminf(__builtin_amdgcn_rcpf(e1y), 5.5e34f);
            const float e3x = __expf((nref.x - myref.x) - E0), e3y = __expf((nref.y - myref.y) - E1);
            *(LAS unsigned*)(QH + r * HK + k0) = cvtpk(q0 * e1x, q1 * e1y);
            *(LAS unsigned*)(QT + r * HK + k0) = cvtpk(q0 * e1x * fq.x, q1 * e1y * fq.y);
            if constexpr (MODE == 1) { bf16* qsp = QS + (crow + r) * 1024 + h * 128; *(unsigned*)(qsp + k0) = cvtpk(q0 * e1x * fqs.x, q1 * e1y * fqs.y); }
            const float b0 = a0 * e3x, b1 = a1 * e3y;
            { const int rb = (sc == 0) ? 0 : (sc == 1) ? 16 : (sc == 2) ? 48 : 96; *(LAS unsigned*)(KH + (rb + r) * HK + k0) = cvtpk(a0 * e2x, a1 * e2y); }
#pragma unroll
            for (int ii = 1; ii < 4; ++ii) if (ii > sc) { const int rb = (ii == 1) ? 16 : (ii == 2) ? 48 : 96; *(LAS unsigned*)(KH + (rb + r) * HK + k0) = cvtpk(b0 * fK[ii].x, b1 * fK[ii].y); }
            t0[i] = b0 * fT.x; t1[i] = b1 * fT.y; }
        { v4u u0, u1; u0.x = cvtpk(t0[0], t0[1]); u0.y = cvtpk(t0[2], t0[3]); u0.z = cvtpk(t0[4], t0[5]); u0.w = cvtpk(t0[6], t0[7]); u1.x = cvtpk(t1[0], t1[1]); u1.y = cvtpk(t1[2], t1[3]); u1.z = cvtpk(t1[4], t1[5]); u1.w = cvtpk(t1[6], t1[7]);
          *(LAS v4u*)(KT + k0 * HS + 8 * w) = u0; *(LAS v4u*)(KT + (k0 + 1) * HS + 8 * w) = u1; }
        { v4u u0, u1;
          u0.x = (vv[0] & 0xffffu) | (vv[1] << 16); u0.y = (vv[2] & 0xffffu) | (vv[3] << 16); u0.z = (vv[4] & 0xffffu) | (vv[5] << 16); u0.w = (vv[6] & 0xffffu) | (vv[7] << 16);
          u1.x = (vv[0] >> 16) | (vv[1] & 0xffff0000u); u1.y = (vv[2] >> 16) | (vv[3] & 0xffff0000u); u1.z = (vv[4] >> 16) | (vv[5] & 0xffff0000u); u1.w = (vv[6] >> 16) | (vv[7] & 0xffff0000u);
          *(LAS v4u*)(VT + k0 * HS + 8 * w) = u0; *(LAS v4u*)(VT + (k0 + 1) * HS + 8 * w) = u1;
          if (w == 0) { f32x2v d; d.x = __expf(tot.x); d.y = __expf(tot.y); *(LAS f32x2v*)(dvec + k0) = d; } }
        HG_BAR();
        if (c + 1 < nchunk) hg_load(P, (crow + 64) * 1024 + h * 128, k0, w, nvalid, lf, qv, kv, vv);
        unsigned short hgv[16];
        if constexpr (MODE == 0) { const bf16* hp = P.HGS + crow * 1024 + h * 128 + 16 * w;
#pragma unroll
          for (int mt = 0; mt < 4; ++mt)
#pragma unroll
              for (int r = 0; r < 4; ++r) { int t = 16 * mt + 4 * lq + r; t = t < nvalid ? t : nvalid - 1; hgv[mt * 4 + r] = hp[(unsigned)(t * 1024 + lr)]; } }
#pragma unroll
        for (int rr = 0; rr < 2; ++rr) { const int blk = w + 8 * rr, bi = blk >> 2, bj = blk & 3;
            f32x4 acc = {0.f, 0.f, 0.f, 0.f};
            if (bj <= bi) { const int rb = (bi == 0) ? 0 : (bi == 1) ? 16 : (bi == 2) ? 48 : 96;
#pragma unroll
                for (int ks = 0; ks < 4; ++ks) { const bf16x8 a = *(const LAS bf16x8*)(QH + (16 * bi + lr) * HK + ks * 32 + 8 * lq), b = *(const LAS bf16x8*)(KH + (rb + 16 * bj + lr) * HK + ks * 32 + 8 * lq); acc = mfma16(a, b, acc); }
                if (bi == bj) {
#pragma unroll
                    for (int r = 0; r < 4; ++r) acc[r] = (lr <= 4 * lq + r) ? acc[r] : 0.f; } }
#pragma unroll
            for (int r = 0; r < 4; ++r) AL[(16 * bi + 4 * lq + r) * HS + 16 * bj + lr] = (bf16)f2bf(acc[r]); }
        HG_BAR();
        f32x4 o[4];
        { bf16x8 bS[4], bV[2];
#pragma unroll
          for (int kp = 0; kp < 4; ++kp) { v4u t; t.x = cvtpk(S[2 * kp][0], S[2 * kp][1]); t.y = cvtpk(S[2 * kp][2], S[2 * kp][3]); t.z = cvtpk(S[2 * kp + 1][0], S[2 * kp + 1][1]); t.w = cvtpk(S[2 * kp + 1][2], S[2 * kp + 1][3]); bS[kp] = __builtin_bit_cast(bf16x8, t); }
#pragma unroll
          for (int ks = 0; ks < 2; ++ks) bV[ks] = *(const LAS bf16x8*)(VT + (16 * w + lr) * HS + ks * 32 + 8 * lq);
#pragma unroll
          for (int mt = 0; mt < 4; ++mt) { f32x4 acc = {0.f, 0.f, 0.f, 0.f};
#pragma unroll
              for (int kp = 0; kp < 4; ++kp) { const LAS bf16* qp = QT + (16 * mt + lr) * HK + 32 * kp + 4 * lq; const v2u a0 = *(const LAS v2u*)qp, a1 = *(const LAS v2u*)(qp + 16);
                  v4u a; a.x = a0.x; a.y = a0.y; a.z = a1.x; a.w = a1.y; acc = mfma16(__builtin_bit_cast(bf16x8, a), bS[kp], acc); }
#pragma unroll
              for (int ks = 0; ks < 2; ++ks) acc = mfma16(*(const LAS bf16x8*)(AL + (16 * mt + lr) * HS + ks * 32 + 8 * lq), bV[ks], acc);
              o[mt] = acc;
              if constexpr (MODE == 1) { float* rp = RAW + (crow + 16 * mt) * 1024 + h * 128 + 16 * w;
#pragma unroll
                  for (int r = 0; r < 4; ++r) rp[(unsigned)((4 * lq + r) * 1024 + lr)] = acc[r]; }
              if constexpr (MODE == 0)
#pragma unroll
              for (int r = 0; r < 4; ++r) { float p = acc[r] * acc[r]; p += shx(p, 1, lx); p += shx(p, 2, lx); p += shx(p, 4, lx); p += shx(p, 8, lx); if (lr == 0) part[(16 * mt + 4 * lq + r) * 8 + w] = p; } } }
        { bf16x8 bV[2];
#pragma unroll
          for (int ks = 0; ks < 2; ++ks) bV[ks] = *(const LAS bf16x8*)(VT + (16 * w + lr) * HS + ks * 32 + 8 * lq);
#pragma unroll
          for (int kb = 0; kb < 8; ++kb) { const f32x4 d = *(const LAS f32x4*)(dvec + 16 * kb + 4 * lq); f32x4 acc = S[kb] * d;
#pragma unroll
              for (int ks = 0; ks < 2; ++ks) acc = mfma16(*(const LAS bf16x8*)(KT + (16 * kb + lr) * HS + ks * 32 + 8 * lq), bV[ks], acc);
              S[kb] = acc; } }
        if constexpr (MODE == 0) {
        HG_BAR();
        { bf16* op = P.OH + crow * 1024 + h * 128 + 16 * w;
#pragma unroll
          for (int mt = 0; mt < 4; ++mt)
#pragma unroll
              for (int r = 0; r < 4; ++r) { const int t = 16 * mt + 4 * lq + r; const f32x4 p0 = *(const LAS f32x4*)(part + t * 8), p1 = *(const LAS f32x4*)(part + t * 8 + 4);
                  const float ss = ((p0[0] + p0[1]) + (p0[2] + p0[3])) + ((p1[0] + p1[1]) + (p1[2] + p1[3]));
                  const float rstd = __builtin_amdgcn_rsqf(ss * (1.f / 128.f) + EPS);
                  const bf16 ov = (bf16)f2bf(o[mt][r] * rstd * gv * bf2f(hgv[mt * 4 + r]));
                  bf16* dst = (t < nvalid) ? op + (unsigned)(t * 1024 + lr) : P.dump + F.tid;
                  *dst = ov; } }
        }
        HG_BAR();
    }
#pragma unroll
    for (int kb = 0; kb < 8; ++kb)
#pragma unroll
        for (int r = 0; r < 4; ++r) s_out[(size_t)(16 * kb + 4 * lq_ + r) * 128 + 16 * w + lr_] = S[kb][r];
    if constexpr (MODE == 1) { if (w == 0) { f32x2v d; d.x = __expf(bseg.x); d.y = __expf(bseg.y); *(f32x2v*)(dseg + k0_) = d; } }
}

__device__ __forceinline__ void hg_fix(Frame& F, const HgPtrs& P, size_t row0, int h, int nchunk, int g, int G, const float* SLseq, const float* DSseq, const bf16* QS, const float* RAW, gu32* mask, float* s_fin) {
    LAS float* part = (LAS float*)(F.lds);
    const int w = __builtin_amdgcn_readfirstlane(F.wave), lr_ = F.lane & 15, lq_ = F.lane >> 4;
    if (F.tid == 0) { const unsigned need = (1u << g) - 1u; unsigned sp = 0;
        while ((__hip_atomic_load(mask, RLX_AGENT) & need) != need) { __builtin_amdgcn_s_sleep(2); if (++sp > (1u << 22)) { __hip_atomic_store(F.ctl + 1, 0x7eb0u, RLX_AGENT); break; } }
        __builtin_amdgcn_fence(__ATOMIC_ACQUIRE, "agent"); asm volatile("s_waitcnt vmcnt(0)" ::: "memory"); }
    __syncthreads();
    f32x4 S[8];
#pragma unroll
    for (int kb = 0; kb < 8; ++kb) S[kb] = (f32x4){0.f, 0.f, 0.f, 0.f};
    for (int p = 0; p < g; ++p) { const float* sl = SLseq + (size_t)p * 16384; const float* ds = DSseq + p * 128;
#pragma unroll
        for (int kb = 0; kb < 8; ++kb) { const f32x4 d = *(const f32x4*)(ds + 16 * kb + 4 * lq_);
#pragma unroll
            for (int r = 0; r < 4; ++r) S[kb][r] = d[r] * S[kb][r] + sl[(size_t)(16 * kb + 4 * lq_ + r) * 128 + 16 * w + lr_]; } }
    if (g == G - 1) { const float* sl = SLseq + (size_t)g * 16384; const float* ds = DSseq + g * 128;
#pragma unroll
        for (int kb = 0; kb < 8; ++kb) { const f32x4 d = *(const f32x4*)(ds + 16 * kb + 4 * lq_);
#pragma unroll
            for (int r = 0; r < 4; ++r) { const size_t o = (size_t)(16 * kb + 4 * lq_ + r) * 128 + 16 * w + lr_; s_fin[o] = d[r] * S[kb][r] + sl[o]; } } }
    bf16x8 bS[4];
#pragma unroll
    for (int kp = 0; kp < 4; ++kp) { v4u t; t.x = cvtpk(S[2 * kp][0], S[2 * kp][1]); t.y = cvtpk(S[2 * kp][2], S[2 * kp][3]); t.z = cvtpk(S[2 * kp + 1][0], S[2 * kp + 1][1]); t.w = cvtpk(S[2 * kp + 1][2], S[2 * kp + 1][3]); bS[kp] = __builtin_bit_cast(bf16x8, t); }
    const float gv = P.ghg[16 * w + lr_];
    f32x4 on[4]; unsigned short hn[16]; v2u qn[4][4][2];
#define HGF_LOAD(cc) do { const size_t cr_ = row0 + (size_t)(cc) * 64; const bf16* hp = P.HGS + cr_ * 1024 + h * 128 + 16 * w; const float* rp = RAW + cr_ * 1024 + h * 128 + 16 * w; \
        _Pragma("unroll") for (int mt = 0; mt < 4; ++mt) { \
            _Pragma("unroll") for (int r = 0; r < 4; ++r) { const unsigned off = (unsigned)((16 * mt + 4 * lq_ + r) * 1024 + lr_); on[mt][r] = rp[off]; hn[mt * 4 + r] = hp[off]; } \
            const bf16* qb = QS + (cr_ + 16 * mt) * 1024 + h * 128; \
            _Pragma("unroll") for (int kp = 0; kp < 4; ++kp) { const bf16* qp = qb + (unsigned)(lr_ * 1024 + 32 * kp + 4 * lq_); qn[mt][kp][0] = *(const v2u*)qp; qn[mt][kp][1] = *(const v2u*)(qp + 16); } } } while (0)
    HGF_LOAD(0);
    for (int c = 0; c < nchunk; ++c) {
        int lr = lr_, lq = lq_; asm volatile("" : "+v"(lr), "+v"(lq)); const int lx = lq * 16 + lr;
        const size_t crow = row0 + (size_t)c * 64;
        LAS float* pt = part + (c & 1) * 512;
        f32x4 o[4]; unsigned short hgv[16];
#pragma unroll
        for (int mt = 0; mt < 4; ++mt) { f32x4 acc = on[mt];
#pragma unroll
            for (int r = 0; r < 4; ++r) hgv[mt * 4 + r] = hn[mt * 4 + r];
#pragma unroll
            for (int kp = 0; kp < 4; ++kp) { v4u a; a.x = qn[mt][kp][0].x; a.y = qn[mt][kp][0].y; a.z = qn[mt][kp][1].x; a.w = qn[mt][kp][1].y; acc = mfma16(__builtin_bit_cast(bf16x8, a), bS[kp], acc); }
            o[mt] = acc; }
        asm volatile("" ::: "memory");
        if (c + 1 < nchunk) HGF_LOAD(c + 1);
        asm volatile("" ::: "memory");
#pragma unroll
        for (int mt = 0; mt < 4; ++mt)
#pragma unroll
            for (int r = 0; r < 4; ++r) { float p = o[mt][r] * o[mt][r]; p += shx(p, 1, lx); p += shx(p, 2, lx); p += shx(p, 4, lx); p += shx(p, 8, lx); if (lr == 0) pt[(16 * mt + 4 * lq + r) * 8 + w] = p; }
        HG_BAR();
        { bf16* op = P.OH + crow * 1024 + h * 128 + 16 * w;
#pragma unroll
          for (int mt = 0; mt < 4; ++mt)
#pragma unroll
              for (int r = 0; r < 4; ++r) { const int t = 16 * mt + 4 * lq + r; const f32x4 p0 = *(const LAS f32x4*)(pt + t * 8), p1 = *(const LAS f32x4*)(pt + t * 8 + 4);
                  const float ss = ((p0[0] + p0[1]) + (p0[2] + p0[3])) + ((p1[0] + p1[1]) + (p1[2] + p1[3]));
                  const float rstd = __builtin_amdgcn_rsqf(ss * (1.f / 128.f) + EPS);
                  op[(unsigned)(t * 1024 + lr)] = (bf16)f2bf(o[mt][r] * rstd * gv * bf2f(hgv[mt * 4 + r])); } }
    }
#undef HGF_LOAD
    __syncthreads();
}
#undef HG_BAR
__device__ __forceinline__ void team_barrier(Frame& F, gu32* w, unsigned target) {
    asm volatile("s_waitcnt vmcnt(0)" ::: "memory");
    __syncthreads();
    if (F.tid == 0) {
        __builtin_amdgcn_fence(__ATOMIC_RELEASE, "agent");
        asm volatile("s_waitcnt vmcnt(0)" ::: "memory");
        (void)__hip_atomic_fetch_add(w, 1u, RLX_AGENT);
        unsigned sp = 0;
        while (__hip_atomic_load(w, RLX_AGENT) < target) { __builtin_amdgcn_s_sleep(2); if (++sp > (1u << 22)) { __hip_atomic_store(F.ctl + 1, 0x7ea0u, RLX_AGENT); break; } }
        __builtin_amdgcn_fence(__ATOMIC_ACQUIRE, "agent");
        asm volatile("s_waitcnt vmcnt(0)" ::: "memory");
    }
    __syncthreads();
}
__device__ __forceinline__ int attn_pull(Frame& F, gu32* q8  , int x0, int nitems) {
    if (F.tid == 0) {
        int res = -1;
        for (int tries = 0; tries < 16; ++tries) {
            unsigned c[8]; unsigned cmin = 0xffffffffu; int imin = 0;
#pragma unroll
            for (int h = 0; h < 8; ++h) { c[h] = __hip_atomic_load(q8 + 64 * h, RLX_AGENT); if (c[h] < cmin) { cmin = c[h]; imin = h; } }
            if (cmin >= (unsigned)nitems) break;
            unsigned cx = c[0];
#pragma unroll
            for (int h = 1; h < 8; ++h) cx = (h == x0) ? c[h] : cx;
            const int hsel = (cx < (unsigned)nitems && cx <= cmin + 6u) ? x0 : imin;
            const unsigned it = __hip_atomic_fetch_add(q8 + 64 * hsel, 1u, RLX_AGENT);
            if (it < (unsigned)nitems) { res = (hsel << 16) | (int)it; break; }
        }
        F.MISC[16] = (unsigned)res;
    }
    __syncthreads();
    const int v = (int)F.MISC[16];
    __syncthreads();
    return __builtin_amdgcn_readfirstlane(v);
}
__device__ __forceinline__ int wg_pull(Frame& F, gu32* ctr) {
    if (F.tid == 0) F.MISC[16] = __hip_atomic_fetch_add(ctr, 1u, RLX_AGENT);
    __syncthreads();
    const int v = (int)F.MISC[16];
    __syncthreads();
    return __builtin_amdgcn_readfirstlane(v);
}
#ifdef PROBE_ID
#define PT_BEGIN(id) unsigned long long pt0_##id = 0; if ((id) == PROBE_ID && blockIdx.x == 0) pt0_##id = __builtin_amdgcn_s_memrealtime()
#define PT_END(id) do { if ((id) == PROBE_ID && blockIdx.x == 0) { const unsigned long long t1 = __builtin_amdgcn_s_memrealtime(), d = t1 - pt0_##id; while (__builtin_amdgcn_s_memrealtime() - t1 < d) __builtin_amdgcn_s_sleep(8); } } while (0)
#else
#define PT_BEGIN(id) do {} while (0)
#define PT_END(id) do {} while (0)
#endif
struct Args { const float* in[25]; float* out; unsigned char* ws; };
__global__ void __launch_bounds__(NWAVES * 64, 2) mk_fwd(Args args) {
    extern __shared__ __attribute__((aligned(16))) unsigned char lds[];
    Frame F;
    F.lds = (LAS unsigned char*)lds;
    F.MISC = (volatile LAS unsigned*)(F.lds + MISC_OFF);
#define ENTER() do { F.tid = opaque_tid(); F.lane = F.tid & 63; F.wave = __builtin_amdgcn_readfirstlane(F.tid >> 6); F.G = gridDim.x; { const int bx = opaque_bid(); F.vcu = (F.G % 8 == 0) ? (bx % 8) * (F.G / 8) + bx / 8 : bx; } } while (0)
    for (int u = threadIdx.x; u < (LDS_BYTES - LDSCTL_OFF) / 4; u += NWAVES * 64) ((LAS unsigned*)(F.lds + LDSCTL_OFF))[u] = 0u;
    __syncthreads();
    tid_table_init();
    __syncthreads();
    static_assert(WTAB_LDS_ADDR == (unsigned)(MISC_OFF + 256) && MISC_OFF + 256 + 256 <= LDS_BYTES, "wave-slot table inside the LDS control area");
    ENTER();
    F.ctl = (gu32*)((unsigned char*)karg(A_WS) + WS_CTL);
    XcdBarrier bar = xcd_barrier_post((unsigned*)(F.ctl + CW_BAR), F.MISC + 8);
#define GRID_BAR() do { asm volatile("" : "+s"(bar.x)); xcd_barrier(bar); } while (0)
#define WSP(T, off) ((T*)((unsigned char*)karg(A_WS) + (off)))
#define OUTP(off) ((float*)karg(A_OUT) + (off))
#define XIN_P (l == 0 ? karg(A_XP) : WSP(const float, WS_X))
#define XIN_S (l == 0 ? karg(A_XS) - (size_t)MP * DM : WSP(const float, WS_X))

#ifndef NO_P0
    p0_prologue(F, WSP(unsigned char, 0));
#ifdef DUP_P0
    GRID_BAR(); ENTER(); p0_prologue(F, WSP(unsigned char, 0));
#endif
#endif
    GRID_BAR();

    for (int l = 0; l < DEPTH; ++l) {
        const size_t wlo = WS_W + (size_t)l * W_LAYER, modo = WS_MOD + (size_t)l * NSEQ * 9216 * 4;
        norm_phase(F, XIN_P, karg(A_GFFN1) + l * 1024, WSP(const float, modo), 0, WSP(bf16, WS_XN), 0, MP, F.vcu * NWAVES + F.wave, 256 * NWAVES);
#ifdef DUP_THIN
        GRID_BAR(); ENTER();
        norm_phase(F, XIN_P, karg(A_GFFN1) + l * 1024, WSP(const float, modo), 0, WSP(bf16, WS_XN), 0, MP, F.vcu * NWAVES + F.wave, 256 * NWAVES);
#endif
        GRID_BAR(); ENTER();
#ifndef NO_G1
        { pg8::Gemm g{WSP(bf16, WS_XN), WSP(const bf16, wlo + WO_GU1), MP, 2 * DFF, DM}; typedef pg8::FixedOrder<128, 22, 8> Ord; Ord S; S.init(F.G, opaque_bid());
          pg8::EpiSwiglu E{WSP(bf16, WS_BIG)};
          pg8::gemm_phase<pg8::EpiSwiglu, Ord, true, true>(F.lds + RING_OFF, g, S, E);
#ifdef DUP_G1
          GRID_BAR(); ENTER(); pg8::gemm_phase<pg8::EpiSwiglu, Ord, true, true>(F.lds + RING_OFF, g, S, E);
#endif
        }
#endif
        GRID_BAR(); ENTER();
#ifndef NO_G2
        { pg8::Gemm g{WSP(bf16, WS_BIG), WSP(const bf16, wlo + WO_D1), MP, DM, DFF}; typedef pg8::FixedOrder<128, 4, 8> Ord; Ord S; S.init(F.G, opaque_bid());
          pg8::EpiResid E{WSP(float, WS_X), WSP(const float, modo) + 2 * 1024, 0.5f, l == 0 ? 1 : 0};
          pg8::gemm_phase<pg8::EpiResid, Ord, true, true>(F.lds + RING_OFF, g, S, E);
#ifdef DUP_RES
          GRID_BAR(); ENTER(); { pg8::EpiResid E0{E.X, E.gate, 0.f, 0}; pg8::gemm_phase<pg8::EpiResid, Ord, true, true>(F.lds + RING_OFF, g, S, E0); }
#endif
        }
#endif
        GRID_BAR(); ENTER();
        norm_phase(F, WSP(const float, WS_X), karg(A_GMIX) + l * 1024, WSP(const float, modo), 1, WSP(bf16, WS_XN), 0, MP, F.vcu * NWAVES + F.wave, 256 * NWAVES);
#ifdef DUP_THIN
        GRID_BAR(); ENTER();
        norm_phase(F, WSP(const float, WS_X), karg(A_GMIX) + l * 1024, WSP(const float, modo), 1, WSP(bf16, WS_XN), 0, MP, F.vcu * NWAVES + F.wave, 256 * NWAVES);
#endif
        GRID_BAR(); ENTER();
        PT_BEGIN(2);
#ifndef NO_G3
        { pg8::Gemm g{WSP(bf16, WS_XN), WSP(const bf16, wlo + WO_IN), MP, DIN, DM}; typedef pg8::FixedOrder<128, 36, 8> Ord; Ord S; S.init(F.G, opaque_bid());
          pg8::EpiWin E{WSP(unsigned char, 0), OUTP(0), l, attn_body::C2};
          pg8::gemm_phase<pg8::EpiWin, Ord, true, true>(F.lds + RING_OFF, g, S, E);
#ifdef PROBE_G3NULL
          GRID_BAR(); ENTER(); PT_BEGIN(3); { float* sk_ = nullptr; asm volatile("" : "+s"(sk_)); pg8::EpiNull E0{sk_}; pg8::gemm_phase<pg8::EpiNull, Ord, true, true>(F.lds + RING_OFF, g, S, E0); } GRID_BAR(); ENTER(); PT_END(3);
#endif
        }
#endif
        GRID_BAR(); ENTER();
        PT_END(2);
        PT_BEGIN(1);
        { gu32* qbase = F.ctl + CW_Q + 64 * (l * 16);
          const int tk = wg_pull(F, qbase + 64 * 9);
#ifdef PROBE_ROLE
          const unsigned long long pr0 = __builtin_amdgcn_s_memrealtime();
#endif
          constexpr int T_EFF = T_TEAM;
          const bool team = (tk % TEAM_STRIDE) == 0, hfirst = (tk % TEAM_STRIDE) >= 1 && (tk % TEAM_STRIDE) <= STARTERS; const int ticket = tk / TEAM_STRIDE; gu32* tb = qbase + 64 * 10; unsigned tstage = 0;
#define TEAM_BAR() do { ++tstage; team_barrier(F, tb, (unsigned)T_EFF * tstage); ENTER(); } while (0)
#ifndef NO_TEAM
          if (team) {
              const int tgw = ticket * NWAVES + F.wave, TNW = T_EFF * NWAVES;
              norm_phase(F, XIN_S, karg(A_GFFN1) + l * 1024, WSP(const float, modo), 0, WSP(bf16, WS_XN), MP, MROWS, tgw, TNW);
              TEAM_BAR();
              { pg8::Gemm g{WSP(bf16, WS_XN), WSP(const bf16, wlo + WO_GU1), MROWS, 2 * DFF, DM}; typedef pg8::TeamOrder<22> Ord; Ord S; S.init(T_EFF, ticket);
                pg8::EpiSwiglu E{WSP(bf16, WS_BIG)};
                pg8::gemm_phase<pg8::EpiSwiglu, Ord, true, true>(F.lds + RING_OFF, g, S, E); }
              TEAM_BAR();
              { pg8::Gemm g{WSP(bf16, WS_BIG), WSP(const bf16, wlo + WO_D1), MROWS, DM, DFF}; typedef pg8::TeamOrder<4> Ord; Ord S; S.init(T_EFF, ticket);
                pg8::EpiResid E{WSP(float, WS_X), WSP(const float, modo) + 2 * 1024, 0.5f, l == 0 ? 2 : 0};
                pg8::gemm_phase<pg8::EpiResid, Ord, true, true>(F.lds + RING_OFF, g, S, E); }
              TEAM_BAR();
              norm_phase(F, WSP(const float, WS_X), karg(A_GMIX) + l * 1024, WSP(const float, modo), 1, WSP(bf16, WS_XN), MP, MROWS, ticket * NWAVES + F.wave, T_EFF * NWAVES);
              TEAM_BAR();
              { pg8::Gemm g{WSP(bf16, WS_XN), WSP(const bf16, wlo + WO_IN), MROWS, DIN, DM}; typedef pg8::TeamOrder<36> Ord; Ord S; S.init(T_EFF, ticket);
                pg8::EpiWin E{WSP(unsigned char, 0), OUTP(0), l, attn_body::C2};
                pg8::gemm_phase<pg8::EpiWin, Ord, true, true>(F.lds + RING_OFF, g, S, E); }
              TEAM_BAR();
          }
#endif
          if (hfirst) {
            for (;;) { const int it = wg_pull(F, qbase); if (it >= 32 * HG_G) break;
              const HgPtrs P{WSP(const float, WS_LOGF), WSP(const bf16, WS_QQ), WSP(const bf16, WS_KK), WSP(const bf16, WS_VV), WSP(const bf16, WS_HGS), karg(A_GHG) + l * 128, WSP(bf16, WS_OH), WSP(bf16, WS_DD)};
#ifndef NO_H
                  const int sqh = it / HG_G, g = it % HG_G, b = sqh >> 3, h = sqh & 7; const int nch = 128 / HG_G;
                  const size_t r0 = (size_t)b * 8192 + (size_t)g * nch * 64;
                  float* SLq = WSP(float, WS_SL) + (size_t)sqh * HG_G * 16384; float* DSq = WSP(float, WS_DSEG) + (size_t)sqh * HG_G * 128;
                  gu32* mask = F.ctl + CW_HS + 64 * (l * 32 + sqh);
                  hg_sequence<1>(F, P, r0, h, nch, 64, nullptr, SLq + (size_t)g * 16384, WSP(bf16, WS_QS), WSP(float, WS_RAW), DSq + g * 128);
                  asm volatile("s_waitcnt vmcnt(0)" ::: "memory"); __syncthreads();
                  if (F.tid == 0) { __builtin_amdgcn_fence(__ATOMIC_RELEASE, "agent"); asm volatile("s_waitcnt vmcnt(0)" ::: "memory"); (void)__hip_atomic_fetch_or(mask, 1u << g, RLX_AGENT); }
                  ENTER();
                  hg_fix(F, P, r0, h, nch, g, HG_G, SLq, DSq, WSP(const bf16, WS_QS), WSP(const float, WS_RAW), mask, OUTP(0) + OS_P + ((size_t)((l * 4 + b) * 8 + h)) * 16384);
                  ENTER();
#endif
            }
            if (F.tid == 0) { unsigned sp = 0; while (__hip_atomic_load(tb, RLX_AGENT) < (unsigned)T_EFF * 5u) { __builtin_amdgcn_s_sleep(2); if (++sp > (1u << 22)) { __hip_atomic_store(F.ctl + 1, 0x7ec0u, RLX_AGENT); break; } }
                __builtin_amdgcn_fence(__ATOMIC_ACQUIRE, "agent"); asm volatile("s_waitcnt vmcnt(0)" ::: "memory"); }
            __syncthreads(); ENTER();
          }
          if (team || hfirst) {
            gu32* qs = qbase + 64 * 11; gu32* done = qbase + 64 * 12;
            for (;;) { const int it = wg_pull(F, qs); if (it >= 256) break;
              const HgPtrs P{WSP(const float, WS_LOGF), WSP(const bf16, WS_QQ), WSP(const bf16, WS_KK), WSP(const bf16, WS_VV), WSP(const bf16, WS_HGS), karg(A_GHG) + l * 128, WSP(bf16, WS_OH), WSP(bf16, WS_DD)};
              if (it < 128) {
#ifndef NO_H
                  const int sq = it >> 3, h = it & 7; const size_t so = OS_S + ((size_t)((l * 16 + sq) * 8 + h)) * 16384;
                  hg_sequence<0>(F, P, (size_t)MP + (size_t)sq * 32, h, 1, 32, karg(A_ST) + ((size_t)((l * 16 + sq) * 8 + h)) * 16384, OUTP(0) + so, nullptr, nullptr, nullptr);
#endif
              } else {
#ifndef NO_SAMP
                  const int u = it - 128; const float lam = lam_of(karg(A_LAM), l, F.lane), osc = 1.f - lam_init_of(l);
                  attn_sample_unit(F, karg(A_CK), karg(A_CV), l, u >> 3, u & 7, WSP(const bf16, WS_Q), WSP(const bf16, WS_K), WSP(const bf16, WS_V), lam, osc, karg(A_GSUB) + l * 128, WSP(bf16, WS_OATT));
#endif
              }
              asm volatile("s_waitcnt vmcnt(0)" ::: "memory"); __syncthreads();
              if (F.tid == 0) { __builtin_amdgcn_fence(__ATOMIC_RELEASE, "agent"); asm volatile("s_waitcnt vmcnt(0)" ::: "memory"); (void)__hip_atomic_fetch_add(done, 1u, RLX_AGENT); }
              ENTER(); }
            if (team) {
                if (F.tid == 0) { unsigned sp = 0; while (__hip_atomic_load(done, RLX_AGENT) < 256u) { __builtin_amdgcn_s_sleep(2); if (++sp > (1u << 22)) { __hip_atomic_store(F.ctl + 1, 0x7ed0u, RLX_AGENT); break; } }
                    __builtin_amdgcn_fence(__ATOMIC_ACQUIRE, "agent"); asm volatile("s_waitcnt vmcnt(0)" ::: "memory"); }
                __syncthreads(); ENTER(); } }
#ifndef NO_TEAM
          if (team) {
              { pg8::Gemm g{WSP(bf16, WS_OATT), WSP(const bf16, wlo + WO_BA), MROWS, DM, DM}; typedef pg8::TeamOrder<4> Ord; Ord S; S.init(T_EFF, ticket);
                pg8::EpiGateT E{WSP(bf16, WS_LOGF), WSP(const bf16, WS_SZA)};
                pg8::gemm_phase<pg8::EpiGateT, Ord, true, true>(F.lds + RING_OFF, g, S, E); }
              TEAM_BAR();
              { pg8::Gemm g{WSP(bf16, WS_OH), WSP(const bf16, wlo + WO_BH), MROWS, DM, DM}; typedef pg8::TeamOrder<4> Ord; Ord S; S.init(T_EFF, ticket);
                pg8::EpiGateM E{WSP(const bf16, WS_LOGF), WSP(const bf16, WS_SZH), WSP(bf16, WS_MRG)};
                pg8::gemm_phase<pg8::EpiGateM, Ord, true, true>(F.lds + RING_OFF, g, S, E); }
              TEAM_BAR();
              { pg8::Gemm g{WSP(bf16, WS_MRG), WSP(const bf16, wlo + WO_OUT), MROWS, DM, DM}; typedef pg8::TeamOrder<4> Ord; Ord S; S.init(T_EFF, ticket);
                pg8::EpiResid E{WSP(float, WS_X), WSP(const float, modo) + 5 * 1024, 1.0f, 0};
                pg8::gemm_phase<pg8::EpiResid, Ord, true, true>(F.lds + RING_OFF, g, S, E); }
              TEAM_BAR();
              norm_phase(F, WSP(const float, WS_X), karg(A_GFFN2) + l * 1024, WSP(const float, modo), 2, WSP(bf16, WS_XN), MP, MROWS, ticket * NWAVES + F.wave, T_EFF * NWAVES);
              TEAM_BAR();
              { pg8::Gemm g{WSP(bf16, WS_XN), WSP(const bf16, wlo + WO_GU2), MROWS, 2 * DFF, DM}; typedef pg8::TeamOrder<22> Ord; Ord S; S.init(T_EFF, ticket);
                pg8::EpiSwiglu E{WSP(bf16, WS_BIG)};
                pg8::gemm_phase<pg8::EpiSwiglu, Ord, true, true>(F.lds + RING_OFF, g, S, E); }
              TEAM_BAR();
              { pg8::Gemm g{WSP(bf16, WS_BIG), WSP(const bf16, wlo + WO_D2), MROWS, DM, DFF}; typedef pg8::TeamOrder<4> Ord; Ord S; S.init(T_EFF, ticket);
                pg8::EpiResid E{WSP(float, WS_X), WSP(const float, modo) + 8 * 1024, 0.5f, 0};
                pg8::gemm_phase<pg8::EpiResid, Ord, true, true>(F.lds + RING_OFF, g, S, E); }
              ENTER();
          }
#endif
#ifndef NO_ATT
          { const attn_body::bf16* Qb = WSP(const attn_body::bf16, WS_Q); const attn_body::bf16* Kb = WSP(const attn_body::bf16, WS_K); const attn_body::bf16* Vb = WSP(const attn_body::bf16, WS_V); attn_body::bf16* O1 = WSP(attn_body::bf16, WS_O1);
            const int x0 = (int)(xb_xcc_id() & 7u);
            for (;;) { const int pk = attn_pull(F, qbase + 64, x0, 256); if (pk < 0) break;
                const int head = pk >> 16, it = pk & 0xffff, b = it >> 6, r = it & 63, qb = 31 - (r >> 1), mp = r & 1;
                attn_body::attn_unit128<8>(b, head * 2 + mp, head * 2, qb, Qb, Kb, Vb, O1 + (size_t)mp * ((WS_O2 - WS_O1) / 2), (char*)lds + RING_OFF); } }
#endif
#undef TEAM_BAR
#ifdef PROBE_ROLE
          if (tk == PROBE_ROLE) { const unsigned long long t1 = __builtin_amdgcn_s_memrealtime(), d = t1 - pr0; while (__builtin_amdgcn_s_memrealtime() - t1 < d) __builtin_amdgcn_s_sleep(8); }
#endif
        }
        GRID_BAR(); ENTER();
        PT_END(1);
        { const float lam = lam_of(karg(A_LAM), l, F.lane), osc = 1.f - lam_init_of(l);
          attn_combine_phase(F, WSP(const bf16, WS_O1), WSP(const bf16, WS_O2), karg(A_GSUB) + l * 128, lam, osc, WSP(bf16, WS_OATT));
#ifdef DUP_THIN
          GRID_BAR(); ENTER();
          attn_combine_phase(F, WSP(const bf16, WS_O1), WSP(const bf16, WS_O2), karg(A_GSUB) + l * 128, lam, osc, WSP(bf16, WS_OATT));
#endif
        }
        GRID_BAR(); ENTER();
#ifndef NO_G4
        { pg8::Gemm g{WSP(bf16, WS_OATT), WSP(const bf16, wlo + WO_BA), MP, DM, DM}; typedef pg8::FixedOrder<128, 4, 8> Ord; Ord S; S.init(F.G, opaque_bid());
          pg8::EpiGateT E{WSP(bf16, WS_LOGF), WSP(const bf16, WS_SZA)};
          pg8::gemm_phase<pg8::EpiGateT, Ord, true, true>(F.lds + RING_OFF, g, S, E);
#ifdef DUP_THIN
          GRID_BAR(); ENTER(); pg8::gemm_phase<pg8::EpiGateT, Ord, true, true>(F.lds + RING_OFF, g, S, E);
#endif
        }
#endif
        GRID_BAR(); ENTER();
#ifndef NO_G5
        { pg8::Gemm g{WSP(bf16, WS_OH), WSP(const bf16, wlo + WO_BH), MP, DM, DM}; typedef pg8::FixedOrder<128, 4, 8> Ord; Ord S; S.init(F.G, opaque_bid());
          pg8::EpiGateM E{WSP(const bf16, WS_LOGF), WSP(const bf16, WS_SZH), WSP(bf16, WS_MRG)};
          pg8::gemm_phase<pg8::EpiGateM, Ord, true, true>(F.lds + RING_OFF, g, S, E);
#ifdef DUP_THIN
          GRID_BAR(); ENTER(); pg8::gemm_phase<pg8::EpiGateM, Ord, true, true>(F.lds + RING_OFF, g, S, E);
#endif
        }
#endif
        GRID_BAR(); ENTER();
#ifndef NO_G6
        { pg8::Gemm g{WSP(bf16, WS_MRG), WSP(const bf16, wlo + WO_OUT), MP, DM, DM}; typedef pg8::FixedOrder<128, 4, 8> Ord; Ord S; S.init(F.G, opaque_bid());
          pg8::EpiResid E{WSP(float, WS_X), WSP(const float, modo) + 5 * 1024, 1.0f, 0};
          pg8::gemm_phase<pg8::EpiResid, Ord, true, true>(F.lds + RING_OFF, g, S, E);
#ifdef DUP_RES
          GRID_BAR(); ENTER(); { pg8::EpiResid E0{E.X, E.gate, 0.f, 0}; pg8::gemm_phase<pg8::EpiResid, Ord, true, true>(F.lds + RING_OFF, g, S, E0); }
#endif
        }
#endif
        GRID_BAR(); ENTER();
        norm_phase(F, WSP(const float, WS_X), karg(A_GFFN2) + l * 1024, WSP(const float, modo), 2, WSP(bf16, WS_XN), 0, MP, F.vcu * NWAVES + F.wave, 256 * NWAVES);
#ifdef DUP_THIN
        GRID_BAR(); ENTER();
        norm_phase(F, WSP(const float, WS_X), karg(A_GFFN2) + l * 1024, WSP(const float, modo), 2, WSP(bf16, WS_XN), 0, MP, F.vcu * NWAVES + F.wave, 256 * NWAVES);
#endif
        GRID_BAR(); ENTER();
#ifndef NO_G7
        { pg8::Gemm g{WSP(bf16, WS_XN), WSP(const bf16, wlo + WO_GU2), MP, 2 * DFF, DM}; typedef pg8::FixedOrder<128, 22, 8> Ord; Ord S; S.init(F.G, opaque_bid());
          pg8::EpiSwiglu E{WSP(bf16, WS_BIG)};
          pg8::gemm_phase<pg8::EpiSwiglu, Ord, true, true>(F.lds + RING_OFF, g, S, E); }
#endif
        GRID_BAR(); ENTER();
#ifndef NO_G8
        { pg8::Gemm g{WSP(bf16, WS_BIG), WSP(const bf16, wlo + WO_D2), MP, DM, DFF}; typedef pg8::FixedOrder<128, 4, 8> Ord; Ord S; S.init(F.G, opaque_bid());
          pg8::EpiResid E{WSP(float, WS_X), WSP(const float, modo) + 8 * 1024, 0.5f, 0};
          pg8::gemm_phase<pg8::EpiResid, Ord, true, true>(F.lds + RING_OFF, g, S, E);
#ifdef DUP_RES
          GRID_BAR(); ENTER(); { pg8::EpiResid E0{E.X, E.gate, 0.f, 0}; pg8::gemm_phase<pg8::EpiResid, Ord, true, true>(F.lds + RING_OFF, g, S, E0); }
#endif
        }
#endif
        GRID_BAR(); ENTER();
    }
    final_norm_phase(F, WSP(const float, WS_X), karg(A_GFIN), OUTP(0));
#undef GRID_BAR
#undef ENTER
#undef WSP
#undef OUTP
}

extern "C" void kernel_launch(void* const* d_in, const int* in_sizes, int n_in, void* d_out, int out_size, void* d_ws, size_t ws_size, hipStream_t stream) {
    static int grid = 0;
    if (grid == 0) {
        if (n_in != 25 || (size_t)out_size != OUT_TOTAL || ws_size < WS_END) { fprintf(stderr, "kernel_launch: unexpected sizes: n_in %d out %d ws %zu (need %zu)\n", n_in, out_size, ws_size, (size_t)WS_END); grid = -1; return; }
        int dev = 0, cus = 0, per_cu = 0;
        if (hipGetDevice(&dev) != hipSuccess || hipDeviceGetAttribute(&cus, hipDeviceAttributeMultiprocessorCount, dev) != hipSuccess) { grid = -1; return; }
        if (hipFuncSetAttribute((const void*)mk_fwd, hipFuncAttributeMaxDynamicSharedMemorySize, LDS_BYTES) != hipSuccess) { fprintf(stderr, "kernel_launch: hipFuncSetAttribute failed\n"); grid = -1; return; }
        if (hipOccupancyMaxActiveBlocksPerMultiprocessor(&per_cu, (const void*)mk_fwd, NWAVES * 64, LDS_BYTES) != hipSuccess || per_cu < 1) { fprintf(stderr, "kernel_launch: occupancy query reports %d\n", per_cu); }
        (void)hipGetLastError();
        grid = cus;
        if (grid != 256) { fprintf(stderr, "kernel_launch: built for a 256-CU device (team size, row split and work queues assume 256 workgroups); found %d CUs; nothing launched\n", cus); grid = -1; return; }
    }
    if (grid < 0) return;
    if (hipMemsetAsync((char*)d_ws + WS_CTL, 0, CTL_ZERO_BYTES, stream) != hipSuccess) return;
    Args a{};
    for (int i = 0; i < 25; ++i) a.in[i] = (const float*)d_in[i];
    a.out = (float*)d_out; a.ws = (unsigned char*)d_ws;
    hipLaunchKernelGGL(mk_fwd, dim3(grid), dim3(NWAVES * 64), LDS_BYTES, stream, a);
    (void)in_sizes;
}
```

```cpp
#include <hip/hip_runtime.h>
#include <hip/hip_bf16.h>
#include <cstdio>
#include <cstdint>
#include <cmath>
constexpr unsigned WTAB_LDS_ADDR = 139264u + 320u + 256u;
__device__ __forceinline__ unsigned hw_wave_slot() { return (unsigned)__builtin_amdgcn_s_getreg((6 << 11) | 4) & 0x3fu; }
__device__ __forceinline__ void tid_table_init() { ((volatile __attribute__((address_space(3))) unsigned*)(size_t)WTAB_LDS_ADDR)[hw_wave_slot()] = threadIdx.x >> 6; }
__device__ __forceinline__ int opaque_tid() { const unsigned w = ((volatile __attribute__((address_space(3))) unsigned*)(size_t)WTAB_LDS_ADDR)[hw_wave_slot()];
    unsigned ln; asm volatile("v_mbcnt_lo_u32_b32 %0, -1, 0\n\tv_mbcnt_hi_u32_b32 %0, -1, %0" : "=v"(ln));
    return (int)((w << 6) | ln); }
__device__ __forceinline__ int opaque_bid() { int b = (int)blockIdx.x; asm volatile("" : "+s"(b)); return b; }
namespace pg8 {
#define PG8_LAS __attribute__((address_space(3)))
typedef unsigned short bf16_t;
typedef short bf16x8 __attribute__((ext_vector_type(8)));
typedef float f32x4 __attribute__((ext_vector_type(4)));
typedef unsigned u32x4 __attribute__((ext_vector_type(4)));
constexpr int BM = 256, BK = 64, HALF = 128, HTB = HALF * BK * 2  , STAGE_BYTES = 8 * HTB, NXCD = 8, WGM = 8;

__host__ __device__ __forceinline__ int lds_byte(int r, int c) { const int st = (r >> 4) * 2 + (c >> 5), rr = r & 15, cc = c & 31, ob = rr * 64 + cc * 2; return st * 1024 + (ob ^ (((ob >> 9) & 1) << 5)); }
__host__ __device__ __forceinline__ void stage_rc(int b, int& R, int& C) { const int st = b / 1024, sb = b % 1024, swz = sb ^ (((sb >> 9) & 1) << 5); R = (st >> 1) * 16 + swz / 64; C = (st & 1) * 32 + (swz % 64) / 2; }
__host__ __device__ __forceinline__ int perm32(int rho) { const int n = rho >> 4, i = rho & 15; return 8 * (i >> 2) + 4 * n + (i & 3); }

struct Unit { int pm, pn; };
struct Gemm { const bf16_t* A; const bf16_t* Bt; int M, N, K; };

struct StaticOrder {
    int nM, nN, nwg, G, c;
    __host__ __device__ void init(int M, int N, int G_, int c_) { nM = M / BM; nN = N / BM; nwg = nM * nN; G = G_; c = c_; }
    __host__ __device__ bool next(int i, Unit& u) const {
        const long L = (long)i * G + c; if (L >= nwg) return false;
        int wgid = (int)L; { const int q = nwg / NXCD, r = nwg % NXCD, xcd = wgid % NXCD, off = wgid / NXCD; wgid = (xcd < r ? xcd * (q + 1) : r * (q + 1) + (xcd - r) * q) + off; }
        const int nig = WGM * nN, gid = wgid / nig, fm = gid * WGM, gsz = (nM - fm) < WGM ? (nM - fm) : WGM;
        u.pm = fm + ((wgid % nig) % gsz); u.pn = (wgid % nig) / gsz; return true;
    }
    __device__ __forceinline__ void a_ready(const Unit&) const {}
    __device__ __forceinline__ void done(const Unit&) const {}
};

__device__ __forceinline__ unsigned cvt_pk_bf16(float lo, float hi) { unsigned r; asm volatile("v_cvt_pk_bf16_f32 %0, %1, %2" : "=v"(r) : "v"(lo), "v"(hi)); return r; }
__device__ __forceinline__ float bf_lo(unsigned w) { return __builtin_bit_cast(float, w << 16); }
__device__ __forceinline__ float bf_hi(unsigned w) { return __builtin_bit_cast(float, w & 0xffff0000u); }
__device__ __forceinline__ float sigmoid_f(float x) { return __builtin_amdgcn_rcpf(1.f + __expf(-x)); }
__device__ __forceinline__ float silu_f(float x) { return x * sigmoid_f(x); }
__device__ __forceinline__ void store8bf(bf16_t* p, f32x4 a, f32x4 b) { u32x4 w; w.x = cvt_pk_bf16(a[0], a[1]); w.y = cvt_pk_bf16(a[2], a[3]); w.z = cvt_pk_bf16(b[0], b[1]); w.w = cvt_pk_bf16(b[2], b[3]); *(u32x4*)p = w; }
__device__ __forceinline__ int row_seq(int row) { return row < 32768 ? (row >> 13) : 4 + ((row - 32768) >> 5); }

struct EpiSwiglu {
    static constexpr bool PERM = true, AFTER_DRAIN = false;
    bf16_t* O;
    __device__ __forceinline__ void operator()(const f32x4 (&acc)[2][2][4][2], const Unit& u, int wr, int wc, int fr, int fq) const {
        const int row0 = u.pm * BM + wr * 64 + fr, col0 = u.pn * HALF + wc * 32 + 8 * fq;
#pragma unroll
        for (int ai = 0; ai < 2; ++ai)
#pragma unroll
            for (int m = 0; m < 4; ++m) {
                f32x4 g0 = acc[ai][0][m][0], g1 = acc[ai][0][m][1]; const f32x4 u0 = acc[ai][1][m][0], u1 = acc[ai][1][m][1];
#pragma unroll
                for (int i = 0; i < 4; ++i) { g0[i] = silu_f(g0[i]) * u0[i]; g1[i] = silu_f(g1[i]) * u1[i]; }
                store8bf(O + (size_t)(row0 + ai * HALF + m * 16) * 2816 + col0, g0, g1); asm volatile("" ::: "memory");
            }
    }
};

struct EpiResid {
    static constexpr bool PERM = true, AFTER_DRAIN = false;
    float* X; const float* gate; float coef; int xsel;
    __device__ __forceinline__ void operator()(const f32x4 (&acc)[2][2][4][2], const Unit& u, int wr, int wc, int fr, int fq) const {
        const float* Xin = X;
        if (xsel) { const __attribute__((address_space(4))) char* ka = (const __attribute__((address_space(4))) char*)__builtin_amdgcn_kernarg_segment_ptr(); asm volatile("" : "+s"(ka));
            Xin = (xsel == 1) ? *(const float* const __attribute__((address_space(4)))*)(ka) : *(const float* const __attribute__((address_space(4)))*)(ka + 8) - (size_t)32768 * 1024; }
        if (u.pm < 128) {
            const float* gp = gate + (size_t)(u.pm >> 5) * 9216 + u.pn * BM + wc * 32 + 8 * fq;
            f32x4 gv[2][2];
#pragma unroll
            for (int bj = 0; bj < 2; ++bj)
#pragma unroll
                for (int n = 0; n < 2; ++n) gv[bj][n] = *(const f32x4*)(gp + bj * HALF + 4 * n) * coef;
            float* xb = X + (size_t)(u.pm * BM + wr * 64 + fr) * 1024 + u.pn * BM + wc * 32 + 8 * fq;
            const float* xi = Xin + (size_t)(u.pm * BM + wr * 64 + fr) * 1024 + u.pn * BM + wc * 32 + 8 * fq;
            f32x4 xc[2][2], xn[2][2];
#pragma unroll
            for (int bj = 0; bj < 2; ++bj)
#pragma unroll
                for (int n = 0; n < 2; ++n) xc[bj][n] = *(const f32x4*)(xi + bj * HALF + 4 * n);
#pragma unroll
            for (int g = 0; g < 8; ++g) { const int ai = g >> 2, m = g & 3; float* xr = xb + (size_t)(ai * HALF + m * 16) * 1024;
                if (g + 1 < 8) { const float* xq = xi + (size_t)(((g + 1) >> 2) * HALF + ((g + 1) & 3) * 16) * 1024;
#pragma unroll
                    for (int bj = 0; bj < 2; ++bj)
#pragma unroll
                        for (int n = 0; n < 2; ++n) xn[bj][n] = *(const f32x4*)(xq + bj * HALF + 4 * n); }
#pragma unroll
                for (int bj = 0; bj < 2; ++bj)
#pragma unroll
                    for (int n = 0; n < 2; ++n) *(f32x4*)(xr + bj * HALF + 4 * n) = xc[bj][n] + gv[bj][n] * acc[ai][bj][m][n];
                asm volatile("" ::: "memory");
#pragma unroll
                for (int bj = 0; bj < 2; ++bj)
#pragma unroll
                    for (int n = 0; n < 2; ++n) xc[bj][n] = xn[bj][n]; }
        } else {
#pragma unroll
        for (int ai = 0; ai < 2; ++ai)
#pragma unroll
            for (int m = 0; m < 4; ++m) {
                const int row = u.pm * BM + ai * HALF + wr * 64 + m * 16 + fr; const float* gp = gate + (size_t)row_seq(row) * 9216;
#pragma unroll
                for (int bj = 0; bj < 2; ++bj) { const int col = u.pn * BM + bj * HALF + wc * 32 + 8 * fq;
#pragma unroll
                    for (int n = 0; n < 2; ++n) { const f32x4 g = *(const f32x4*)(gp + col + 4 * n); f32x4* xp = (f32x4*)(X + (size_t)row * 1024 + col + 4 * n); const f32x4 xv = *(const f32x4*)(Xin + (size_t)row * 1024 + col + 4 * n); *xp = xv + (g * coef) * acc[ai][bj][m][n]; } asm volatile("" ::: "memory"); }
            }
        }
    }
};

struct EpiWin {
    static constexpr bool PERM = true, AFTER_DRAIN = false;
    unsigned char* ws; float* out; int l; float qscale;
    static constexpr size_t MiB_ = 1u << 20;
    static constexpr size_t O_Q = 435 * MiB_, O_K = 500 * MiB_, O_V = 565 * MiB_, O_QQ = 630 * MiB_, O_KK = 695 * MiB_, O_VV = 760 * MiB_, O_HGS = 825 * MiB_, O_SZA = 890 * MiB_, O_SZH = 955 * MiB_, O_LOGF = 1020 * MiB_, O_LB = 4 * MiB_;
    static constexpr size_t OK_P_ = 34078720, OV_P_ = 168296448, OK_S_ = 304611328, OV_S_ = 306708480;
    __device__ __forceinline__ void operator()(const f32x4 (&acc)[2][2][4][2], const Unit& u, int wr, int wc, int fr, int fq) const {
        const int seg = u.pn >> 2, cb = (u.pn & 3) * BM + wc * 32 + 8 * fq, row0 = u.pm * BM + wr * 64 + fr;
        const size_t boff = seg == 0 ? O_Q : seg == 1 ? O_K : seg == 2 ? O_V : seg == 3 ? O_QQ : seg == 4 ? O_KK : seg == 5 ? O_VV : seg == 6 ? O_HGS : seg == 7 ? O_SZA : O_SZH;
        bf16_t* const O = (bf16_t*)(ws + boff) + (size_t)row0 * 1024 + cb;
        float* F32 = nullptr;
        if (seg == 1 || seg == 2) { const size_t ob = (u.pm < 128) ? (seg == 1 ? OK_P_ : OV_P_) + (size_t)l * 32768 * 1024 + (size_t)(u.pm * BM) * 1024 : (seg == 1 ? OK_S_ : OV_S_) + (size_t)l * 512 * 1024 + (size_t)((u.pm - 128) * BM) * 1024;
            F32 = out + ob + (size_t)(wr * 64 + fr) * 1024 + cb; }
        else if (seg == 4) F32 = (float*)(ws + O_LOGF) + (size_t)row0 * 1024 + cb;
        const float* const lb = (const float*)(ws + O_LB) + l * 1024 + cb;
        const float sc = seg == 0 ? qscale : 1.f;
#pragma unroll
        for (int bj = 0; bj < 2; ++bj) {
            f32x4 l0 = {0.f, 0.f, 0.f, 0.f}, l1 = l0; if (seg == 4) { l0 = *(const f32x4*)(lb + bj * HALF); l1 = *(const f32x4*)(lb + bj * HALF + 4); }
#pragma unroll
            for (int ai = 0; ai < 2; ++ai)
#pragma unroll
                for (int m = 0; m < 4; ++m) { const size_t off = (size_t)(ai * HALF + m * 16) * 1024 + bj * HALF;
                    f32x4 a = acc[ai][bj][m][0], b = acc[ai][bj][m][1];
                    if (seg == 4) { f32x4 fa, fb;
#pragma unroll
                        for (int i = 0; i < 4; ++i) {
                            { const float x = a[i], lbv = l0[i], e = __expf(-__builtin_fabsf(x)), r = __builtin_amdgcn_rcpf(1.f + e), er = e * r, sig = x >= 0.f ? r : er, om = x >= 0.f ? er : r;
                              fa[i] = __logf(__builtin_fmaxf(lbv + (1.f - lbv) * sig, 1e-30f)); a[i] = (1.f - lbv) * om; }
                            { const float x = b[i], lbv = l1[i], e = __expf(-__builtin_fabsf(x)), r = __builtin_amdgcn_rcpf(1.f + e), er = e * r, sig = x >= 0.f ? r : er, om = x >= 0.f ? er : r;
                              fb[i] = __logf(__builtin_fmaxf(lbv + (1.f - lbv) * sig, 1e-30f)); b[i] = (1.f - lbv) * om; } }
                        *(f32x4*)(F32 + off) = fa; *(f32x4*)(F32 + off + 4) = fb;
                    } else if (seg == 3 || seg == 6) {
#pragma unroll
                        for (int i = 0; i < 4; ++i) { a[i] = silu_f(a[i]); b[i] = silu_f(b[i]); }
                    } else if (seg >= 7) {
#pragma unroll
                        for (int i = 0; i < 4; ++i) { a[i] = sigmoid_f(a[i]); b[i] = sigmoid_f(b[i]); }
                    } else {
                        if (seg == 1 || seg == 2) { *(f32x4*)(F32 + off) = a; *(f32x4*)(F32 + off + 4) = b; }
                        a = a * sc; b = b * sc;
                    }
                    store8bf(O + off, a, b); asm volatile("" ::: "memory"); }
        }
    }
};

struct EpiGateT {
    static constexpr bool PERM = true, AFTER_DRAIN = false;
    bf16_t* T; const bf16_t* G;
    __device__ __forceinline__ void operator()(const f32x4 (&acc)[2][2][4][2], const Unit& u, int wr, int wc, int fr, int fq) const {
        const size_t base = (size_t)(u.pm * BM + wr * 64 + fr) * 1024 + u.pn * BM + wc * 32 + 8 * fq;
        u32x4 gc[2], gn[2];
#pragma unroll
        for (int bj = 0; bj < 2; ++bj) gc[bj] = *(const u32x4*)(G + base + bj * HALF);
#pragma unroll
        for (int g = 0; g < 8; ++g) { const int ai = g >> 2, m = g & 3; const size_t off = base + (size_t)(ai * HALF + m * 16) * 1024;
            if (g + 1 < 8) { const size_t offn = base + (size_t)(((g + 1) >> 2) * HALF + ((g + 1) & 3) * 16) * 1024;
#pragma unroll
                for (int bj = 0; bj < 2; ++bj) gn[bj] = *(const u32x4*)(G + offn + bj * HALF); }
#pragma unroll
            for (int bj = 0; bj < 2; ++bj) { const u32x4 gg = gc[bj];
                const f32x4 g0 = {bf_lo(gg.x), bf_hi(gg.x), bf_lo(gg.y), bf_hi(gg.y)}, g1 = {bf_lo(gg.z), bf_hi(gg.z), bf_lo(gg.w), bf_hi(gg.w)};
                store8bf(T + off + bj * HALF, g0 * acc[ai][bj][m][0], g1 * acc[ai][bj][m][1]); }
            asm volatile("" ::: "memory");
#pragma unroll
            for (int bj = 0; bj < 2; ++bj) gc[bj] = gn[bj]; }
    }
};
struct EpiGateM {
    static constexpr bool PERM = true, AFTER_DRAIN = false;
    const bf16_t* T; const bf16_t* G; bf16_t* O;
    __device__ __forceinline__ void operator()(const f32x4 (&acc)[2][2][4][2], const Unit& u, int wr, int wc, int fr, int fq) const {
        const size_t base = (size_t)(u.pm * BM + wr * 64 + fr) * 1024 + u.pn * BM + wc * 32 + 8 * fq;
        u32x4 gc[2], gn[2], tc[2], tn[2];
#pragma unroll
        for (int bj = 0; bj < 2; ++bj) { gc[bj] = *(const u32x4*)(G + base + bj * HALF); tc[bj] = *(const u32x4*)(T + base + bj * HALF); }
#pragma unroll
        for (int g = 0; g < 8; ++g) { const int ai = g >> 2, m = g & 3; const size_t off = base + (size_t)(ai * HALF + m * 16) * 1024;
            if (g + 1 < 8) { const size_t offn = base + (size_t)(((g + 1) >> 2) * HALF + ((g + 1) & 3) * 16) * 1024;
#pragma unroll
                for (int bj = 0; bj < 2; ++bj) { gn[bj] = *(const u32x4*)(G + offn + bj * HALF); tn[bj] = *(const u32x4*)(T + offn + bj * HALF); } }
#pragma unroll
            for (int bj = 0; bj < 2; ++bj) { const u32x4 gg = gc[bj];
                const f32x4 g0 = {bf_lo(gg.x), bf_hi(gg.x), bf_lo(gg.y), bf_hi(gg.y)}, g1 = {bf_lo(gg.z), bf_hi(gg.z), bf_lo(gg.w), bf_hi(gg.w)};
                const u32x4 tt = tc[bj]; const f32x4 t0 = {bf_lo(tt.x), bf_hi(tt.x), bf_lo(tt.y), bf_hi(tt.y)}, t1 = {bf_lo(tt.z), bf_hi(tt.z), bf_lo(tt.w), bf_hi(tt.w)};
                store8bf(O + off + bj * HALF, t0 + g0 * acc[ai][bj][m][0], t1 + g1 * acc[ai][bj][m][1]); }
            asm volatile("" ::: "memory");
#pragma unroll
            for (int bj = 0; bj < 2; ++bj) { gc[bj] = gn[bj]; tc[bj] = tn[bj]; } }
    }
};

struct EpiNull {
    static constexpr bool PERM = true, AFTER_DRAIN = false; float* sink;
    __device__ __forceinline__ void operator()(const f32x4 (&acc)[2][2][4][2], const Unit& u, int wr, int wc, int fr, int fq) const { f32x4 s = {0.f, 0.f, 0.f, 0.f};
#pragma unroll
        for (int a = 0; a < 2; ++a)
#pragma unroll
            for (int b = 0; b < 2; ++b)
#pragma unroll
                for (int m = 0; m < 4; ++m)
#pragma unroll
                    for (int n = 0; n < 2; ++n) s = s + acc[a][b][m][n];
        if (sink) sink[0] = s[0] + s[1] + s[2] + s[3]; (void)u; (void)wr; (void)wc; (void)fr; (void)fq; }
};

template <int NM, int NN, int GM> struct FixedOrder {
    static_assert(NM % GM == 0, "GM divides NM");
    int G, c;
    __device__ __forceinline__ void init(int G_, int c_) { G = G_; c = c_; }
    __device__ __forceinline__ bool next(int i, Unit& u) const {
        constexpr int nwg = NM * NN, q = nwg / NXCD, r = nwg % NXCD, nig = GM * NN;
        const int L = i * G + c; if (L >= nwg) return false;
        const int xcd = L % NXCD, off = L / NXCD; const int wgid = (xcd < r ? xcd * (q + 1) : r * (q + 1) + (xcd - r) * q) + off;
        const int gid = wgid / nig, w = wgid % nig; u.pm = gid * GM + (w % GM); u.pn = w / GM; return true;
    }
    __device__ __forceinline__ void a_ready(const Unit&) const {}
    __device__ __forceinline__ void done(const Unit&) const {}
};

template <int NN> struct TeamOrder {
    int T, r;
    __device__ __forceinline__ void init(int T_, int r_) { T = T_; r = r_; }
    __device__ __forceinline__ bool next(int i, Unit& u) const { const int L = i * T + r; if (L >= 2 * NN) return false; u.pm = 128 + L / NN; u.pn = L % NN; return true; }
    __device__ __forceinline__ void a_ready(const Unit&) const {}
    __device__ __forceinline__ void done(const Unit&) const {}
};
template <class Epi, class Sched, bool ALIGN_EPI = false, bool SP2 = false>
__device__ __forceinline__ void gemm_phase(PG8_LAS unsigned char* lds, const Gemm g, const Sched& S, const Epi& E) {
    const int tid = opaque_tid(), wid = __builtin_amdgcn_readfirstlane(tid >> 6), lane = tid & 63, wr = wid >> 2, wc = wid & 3, fr = lane & 15, fq = lane >> 4;
    const int K = g.K, nt = K / BK;
    unsigned voffA[2], voffB[2];
#pragma unroll
    for (int i = 0; i < 2; ++i) { int R, C; stage_rc(tid * 16 + i * 8192, R, C); const int Rb = Epi::PERM ? ((R & ~31) + perm32(R & 31)) : R;
        voffA[i] = (unsigned)(R * K + C) * 2u; voffB[i] = (unsigned)(Rb * K + C) * 2u; }
    const size_t kstep = (size_t)(BK * 2);
    const size_t hstep = (size_t)HALF * K * 2;
    const size_t tstep = 2 * hstep;
    const unsigned ldsw = (unsigned)wid * 1024u;
    const int aoff = lds_byte(wr * 64 + fr, fq * 8), boff = lds_byte(wc * 32 + fr, fq * 8);
#define PG8_SA(b, h) (((b) * 2 + (h)) * HTB)
#define PG8_SB(b, h) ((4 + (b) * 2 + (h)) * HTB)
#define PG8_STAGE(bufoff, gbase, voff) do { _Pragma("unroll") for (int _i = 0; _i < 2; ++_i) \
        __builtin_amdgcn_global_load_lds((const unsigned*)((const char*)(gbase) + (voff)[_i]), (PG8_LAS unsigned*)(lds + (bufoff) + ldsw + _i * 8192), 16, 0, 0); } while (0)
#define PG8_LDA(dst, b, h) do { _Pragma("unroll") for (int m = 0; m < 4; ++m) _Pragma("unroll") for (int k = 0; k < 2; ++k) dst[m][k] = *(const PG8_LAS bf16x8*)(lds + PG8_SA(b, h) + aoff + m * 2048 + k * 1024); } while (0)
#define PG8_LDB(dst, b, h) do { _Pragma("unroll") for (int n = 0; n < 2; ++n) _Pragma("unroll") for (int k = 0; k < 2; ++k) dst[n][k] = *(const PG8_LAS bf16x8*)(lds + PG8_SB(b, h) + boff + n * 2048 + k * 1024); } while (0)
#define PG8_MMA(ai, bj, At, Bt) do { __builtin_amdgcn_s_setprio(1); _Pragma("unroll") for (int m = 0; m < 4; ++m) _Pragma("unroll") for (int n = 0; n < 2; ++n) _Pragma("unroll") for (int k = 0; k < 2; ++k) \
        acc[ai][bj][m][n] = __builtin_amdgcn_mfma_f32_16x16x32_bf16(Bt[n][k], At[m][k], acc[ai][bj][m][n], 0, 0, 0); __builtin_amdgcn_s_setprio(0); } while (0)
#define PG8_WAIT_V(n) asm volatile("s_waitcnt vmcnt(" #n ")" ::: "memory")
#define PG8_WAIT_L(n) asm volatile("s_waitcnt lgkmcnt(" #n ")" ::: "memory")
#define PG8_BAR __builtin_amdgcn_s_barrier()
#define PG8_SCHED __builtin_amdgcn_sched_barrier(0)
    Unit cur, nxt; int ui = 0;
    if (!S.next(0, cur)) return;
    f32x4 acc[2][2][4][2];
#pragma unroll
    for (int a = 0; a < 2; ++a)
#pragma unroll
        for (int b = 0; b < 2; ++b)
#pragma unroll
            for (int m = 0; m < 4; ++m)
#pragma unroll
                for (int n = 0; n < 2; ++n) acc[a][b][m][n] = (f32x4){0.f, 0.f, 0.f, 0.f};
    bf16x8 At[4][2], B0[2][2], B1[2][2];
    const char* cA = (const char*)g.A + (size_t)cur.pm * tstep; const char* cB = (const char*)g.Bt + (size_t)cur.pn * tstep;
    S.a_ready(cur);
    if constexpr (SP2) {
        PG8_STAGE(PG8_SB(0, 0), cB, voffB); PG8_STAGE(PG8_SB(0, 1), cB + hstep, voffB); PG8_STAGE(PG8_SA(0, 0), cA, voffA); PG8_STAGE(PG8_SA(0, 1), cA + hstep, voffA);
        if (wr == 1) PG8_BAR;
        PG8_WAIT_V(2); PG8_BAR;
        PG8_STAGE(PG8_SB(1, 0), cB + kstep, voffB); PG8_STAGE(PG8_SA(1, 0), cA + kstep, voffA); PG8_STAGE(PG8_SB(1, 1), cB + hstep + kstep, voffB);
        PG8_WAIT_V(6); PG8_BAR;
    } else {
        PG8_STAGE(PG8_SB(0, 0), cB, voffB); PG8_STAGE(PG8_SA(0, 0), cA, voffA); PG8_STAGE(PG8_SB(0, 1), cB + hstep, voffB); PG8_STAGE(PG8_SA(0, 1), cA + hstep, voffA);
        if (wr == 1) PG8_BAR;
        PG8_WAIT_V(4); PG8_BAR;
        PG8_STAGE(PG8_SB(1, 0), cB + kstep, voffB); PG8_STAGE(PG8_SA(1, 0), cA + kstep, voffA); PG8_STAGE(PG8_SB(1, 1), cB + hstep + kstep, voffB);
        PG8_WAIT_V(6); PG8_BAR;
    }
    for (;;) {
        const bool has_next = S.next(ui + 1, nxt);
        const char* nA = has_next ? (const char*)g.A + (size_t)nxt.pm * tstep : cA; const char* nB = has_next ? (const char*)g.Bt + (size_t)nxt.pn * tstep : cB;
        for (int t = 0; t < nt; t += 2) {
            const bool last = (t == nt - 2);
            const char* a1 = cA + (size_t)(t + 1) * kstep;
            const char* a2 = last ? nA : cA + (size_t)(t + 2) * kstep; const char* b2 = last ? nB : cB + (size_t)(t + 2) * kstep;
            const char* a3 = a2 + kstep; const char* b3 = b2 + kstep;
            if (last && has_next) S.a_ready(nxt);
            if constexpr (SP2) {
            PG8_LDB(B0, 0, 0); PG8_LDB(B1, 0, 1); PG8_SCHED; PG8_LDA(At, 0, 0); PG8_STAGE(PG8_SA(1, 1), a1 + hstep, voffA);
            PG8_WAIT_V(8); PG8_WAIT_L(0); PG8_BAR; PG8_MMA(0, 0, At, B0); PG8_MMA(0, 1, At, B1); PG8_BAR; PG8_SCHED;
            PG8_LDA(At, 0, 1); PG8_STAGE(PG8_SB(0, 0), b2, voffB); PG8_STAGE(PG8_SB(0, 1), b2 + hstep, voffB); PG8_STAGE(PG8_SA(0, 0), a2, voffA);
            PG8_WAIT_V(8); PG8_WAIT_L(0); PG8_BAR; PG8_MMA(1, 0, At, B0); PG8_MMA(1, 1, At, B1); PG8_BAR; PG8_SCHED;
            PG8_LDB(B0, 1, 0); PG8_LDB(B1, 1, 1); PG8_SCHED; PG8_LDA(At, 1, 0); PG8_STAGE(PG8_SA(0, 1), a2 + hstep, voffA);
            PG8_WAIT_V(8); PG8_WAIT_L(0); PG8_BAR; PG8_MMA(0, 0, At, B0); PG8_MMA(0, 1, At, B1); PG8_BAR; PG8_SCHED;
            PG8_LDA(At, 1, 1); PG8_STAGE(PG8_SB(1, 0), b3, voffB); PG8_STAGE(PG8_SB(1, 1), b3 + hstep, voffB); PG8_STAGE(PG8_SA(1, 0), a3, voffA);
            PG8_WAIT_V(8); PG8_WAIT_L(0); PG8_BAR; PG8_MMA(1, 0, At, B0); PG8_MMA(1, 1, At, B1); PG8_BAR; PG8_SCHED;
            } else {
            PG8_LDB(B0, 0, 0); PG8_SCHED; PG8_LDA(At, 0, 0); PG8_STAGE(PG8_SA(1, 1), a1 + hstep, voffA);
            PG8_WAIT_L(8); PG8_BAR; PG8_WAIT_L(0); PG8_MMA(0, 0, At, B0); PG8_BAR; PG8_SCHED;
            PG8_LDB(B1, 0, 1); PG8_STAGE(PG8_SB(0, 0), b2, voffB);
            PG8_BAR; PG8_WAIT_L(0); PG8_MMA(0, 1, At, B1); PG8_BAR;
            PG8_LDA(At, 0, 1); PG8_STAGE(PG8_SA(0, 0), a2, voffA);
            PG8_BAR; PG8_WAIT_L(0); PG8_MMA(1, 0, At, B0); PG8_BAR; PG8_SCHED;
            PG8_STAGE(PG8_SB(0, 1), b2 + hstep, voffB);
            PG8_WAIT_V(6); PG8_BAR; PG8_MMA(1, 1, At, B1); PG8_BAR;
            PG8_LDB(B0, 1, 0); PG8_SCHED; PG8_LDA(At, 1, 0); PG8_STAGE(PG8_SA(0, 1), a2 + hstep, voffA);
            PG8_WAIT_L(8); PG8_BAR; PG8_WAIT_L(0); PG8_MMA(0, 0, At, B0); PG8_BAR; PG8_SCHED;
            PG8_LDB(B1, 1, 1); PG8_STAGE(PG8_SB(1, 0), b3, voffB);
            PG8_BAR; PG8_WAIT_L(0); PG8_MMA(0, 1, At, B1); PG8_BAR;
            PG8_LDA(At, 1, 1); PG8_STAGE(PG8_SA(1, 0), a3, voffA);
            PG8_BAR; PG8_WAIT_L(0); PG8_MMA(1, 0, At, B0); PG8_BAR; PG8_SCHED;
            PG8_STAGE(PG8_SB(1, 1), b3 + hstep, voffB);
            PG8_WAIT_V(6); PG8_BAR; PG8_MMA(1, 1, At, B1); PG8_BAR;
            }
        }
        if constexpr (ALIGN_EPI) { if (wr == 0) PG8_BAR; }
        if constexpr (!Epi::AFTER_DRAIN) { E(acc, cur, wr, wc, fr, fq); S.done(cur); }
        if (!has_next) break;
#pragma unroll
        for (int a = 0; a < 2; ++a)
#pragma unroll
            for (int b = 0; b < 2; ++b)
#pragma unroll
                for (int m = 0; m < 4; ++m)
#pragma unroll
                    for (int n = 0; n < 2; ++n) acc[a][b][m][n] = (f32x4){0.f, 0.f, 0.f, 0.f};
        cur = nxt; cA = nA; cB = nB; ++ui;
        if constexpr (ALIGN_EPI) { if (wr == 1) PG8_BAR; }
    }
    PG8_WAIT_V(0);
    if constexpr (!ALIGN_EPI) { if (wr == 0) PG8_BAR; }
    PG8_BAR;
    if constexpr (Epi::AFTER_DRAIN) { E.fused(acc, cur, wr, wc, fr, fq, lds, wid, lane); S.done(cur); }
#undef PG8_SA
#undef PG8_SB
#undef PG8_STAGE
#undef PG8_LDA
#undef PG8_LDB
#undef PG8_MMA
#undef PG8_WAIT_V
#undef PG8_WAIT_L
#undef PG8_BAR
#undef PG8_SCHED
}
}
namespace attn_body {
using bf16=__hip_bfloat16;
using bf16x8=__attribute__((ext_vector_type(8)))short;
using s16x4=__attribute__((ext_vector_type(4)))short;
using f32x16=__attribute__((ext_vector_type(16)))float;
using u32x4=__attribute__((ext_vector_type(4)))unsigned;
constexpr int BATCH=4,NHEAD=16,SEQ=8192,D=64,DM=NHEAD*D;
constexpr int NW=8,QBLK=32,QB=QBLK*NW,KVBLK=64,NQB=SEQ/QB;
constexpr int ATTN_PITCH=DM, ATTN_UNIT_ROWS=QB;
__device__ __forceinline__ int crow(int r,int hi){return (r&3)+8*(r>>2)+4*hi;}
#define SBAR() __builtin_amdgcn_sched_barrier(0)
__device__ __forceinline__ void cmask(f32x16&p0,f32x16&p1,int jb,int qrel,int hi){
  const float NEG=-INFINITY; (void)hi;
  if(jb>(qrel>>6)){
  #pragma unroll
  for(int r=0;r<16;++r){p0[r]=NEG;p1[r]=NEG;} }
}

constexpr int NSLOT=3, SLOTB=8192;
constexpr int LDS_K=0, LDS_V=NSLOT*SLOTB, LDS_WS=2*NSLOT*SLOTB, LDS_OST=LDS_WS+NW*64*4, LDS_BYTES=LDS_OST+NW*4096;
constexpr float C2=0.125f*1.4426950408889634f;
__device__ __forceinline__ void glds16(const void*gsrc,unsigned lds_dst){unsigned keep;
  asm volatile("s_mov_b32 %0, m0\n\ts_mov_b32 m0, %2\n\ts_nop 0\n\tglobal_load_lds_dwordx4 %1, off\n\ts_mov_b32 m0, %0":"=&s"(keep):"v"(gsrc),"s"(lds_dst):"memory");}
__device__ __forceinline__ float max3f(float a,float b,float c){float r;asm("v_max3_f32 %0, %1, %2, %3":"=v"(r):"v"(a),"v"(b),"v"(c));return r;}
__device__ __forceinline__ float max2f(float a,float b){float r;asm("v_max_f32_e32 %0, %1, %2":"=v"(r):"v"(a),"v"(b));return r;}
__device__ __forceinline__ float fadd_s(float a,float b){float r;asm("v_add_f32_e32 %0, %1, %2":"=v"(r):"v"(a),"v"(b));return r;}
__device__ __forceinline__ float fsub_s(float a,float b){float r;asm("v_sub_f32_e32 %0, %1, %2":"=v"(r):"v"(a),"v"(b));return r;}
typedef float f32x2_t __attribute__((ext_vector_type(2))); typedef __bf16 bf16x2_t __attribute__((ext_vector_type(2)));
__device__ __forceinline__ unsigned cvtpk_s(float lo,float hi){f32x2_t v={lo,hi};bf16x2_t b=__builtin_convertvector(v,bf16x2_t);return __builtin_bit_cast(unsigned,b);}
#define WAIT_BAR(N) asm volatile("s_waitcnt vmcnt(" #N ") lgkmcnt(0)\n\ts_barrier":::"memory")

__device__ __forceinline__ void qkt(f32x16&p0,f32x16&p1,const char*Kslot,const bf16x8*qr,const f32x16&negm,int r32,int hi){
  const char*kb=Kslot+hi*1024+r32*16;
  #pragma unroll
  for(int d0=0;d0<4;++d0){
    const bf16x8 b0=*reinterpret_cast<const bf16x8*>(kb+d0*2048);
    const bf16x8 b1=*reinterpret_cast<const bf16x8*>(kb+d0*2048+512);
    if(d0==0){p0=__builtin_amdgcn_mfma_f32_32x32x16_bf16(b0,qr[0],negm,0,0,0);p1=__builtin_amdgcn_mfma_f32_32x32x16_bf16(b1,qr[0],negm,0,0,0);}
    else{p0=__builtin_amdgcn_mfma_f32_32x32x16_bf16(b0,qr[d0],p0,0,0,0);p1=__builtin_amdgcn_mfma_f32_32x32x16_bf16(b1,qr[d0],p1,0,0,0);}}
}
typedef __attribute__((address_space(3))) const char* lds_cptr;
typedef short v4i16_t __attribute__((ext_vector_type(4)));
__device__ __forceinline__ void kload8(bf16x8*kf,lds_cptr kp){
  kf[0]=*(const __attribute__((address_space(3))) bf16x8*)(kp);      kf[1]=*(const __attribute__((address_space(3))) bf16x8*)(kp+512);
  kf[2]=*(const __attribute__((address_space(3))) bf16x8*)(kp+2048); kf[3]=*(const __attribute__((address_space(3))) bf16x8*)(kp+2560);
  kf[4]=*(const __attribute__((address_space(3))) bf16x8*)(kp+4096); kf[5]=*(const __attribute__((address_space(3))) bf16x8*)(kp+4608);
  kf[6]=*(const __attribute__((address_space(3))) bf16x8*)(kp+6144); kf[7]=*(const __attribute__((address_space(3))) bf16x8*)(kp+6656);
}
__device__ __forceinline__ void kload2(bf16x8*kf,lds_cptr kp,int j){ kf[2*j]=*(const __attribute__((address_space(3))) bf16x8*)(kp+j*2048); kf[2*j+1]=*(const __attribute__((address_space(3))) bf16x8*)(kp+j*2048+512); }
__device__ __forceinline__ s16x4 vtr(lds_cptr p){ return __builtin_bit_cast(s16x4,__builtin_amdgcn_ds_read_tr16_b64_v4i16((__attribute__((address_space(3))) v4i16_t*)p)); }
__device__ __forceinline__ float rowmax(const f32x16&p0,const f32x16&p1){
  float a=max3f(p0[0],p0[1],p1[0]),b=max3f(p0[2],p0[3],p1[1]);a=max3f(a,p1[2],p1[3]);
  #pragma unroll
  for(int r=4;r<16;r+=4){a=max3f(a,p0[r],p0[r+1]);b=max3f(b,p0[r+2],p0[r+3]);a=max3f(a,p1[r],p1[r+1]);b=max3f(b,p1[r+2],p1[r+3]);}
  const float m=max2f(a,b);
  auto rr=__builtin_amdgcn_permlane32_swap(__float_as_uint(m),__float_as_uint(m),false,false);
  return max2f(__uint_as_float(rr[0]),__uint_as_float(rr[1]));
}
__device__ __forceinline__ void pv(f32x16*o,int vb,bf16x8 pa0,bf16x8 pa1,bf16x8 pa2,bf16x8 pa3){
  #pragma unroll
  for(int d0=0;d0<2;++d0){s16x4 lo[4],hi[4];
    #pragma unroll
    for(int ks=0;ks<4;++ks){
      asm volatile("ds_read_b64_tr_b16 %0,%1 offset:%c2":"=&v"(lo[ks]):"v"(vb),"i"(d0*4096+ks*1024):"memory");
      asm volatile("ds_read_b64_tr_b16 %0,%1 offset:%c2":"=&v"(hi[ks]):"v"(vb),"i"(d0*4096+ks*1024+512):"memory");}
    asm volatile("s_waitcnt lgkmcnt(0)":::"memory");SBAR();
    #define PK(k) (bf16x8){lo[k][0],lo[k][1],lo[k][2],lo[k][3],hi[k][0],hi[k][1],hi[k][2],hi[k][3]}
    o[d0]=__builtin_amdgcn_mfma_f32_32x32x16_bf16(pa0,PK(0),o[d0],0,0,0);
    o[d0]=__builtin_amdgcn_mfma_f32_32x32x16_bf16(pa1,PK(1),o[d0],0,0,0);
    o[d0]=__builtin_amdgcn_mfma_f32_32x32x16_bf16(pa2,PK(2),o[d0],0,0,0);
    o[d0]=__builtin_amdgcn_mfma_f32_32x32x16_bf16(pa3,PK(3),o[d0],0,0,0);
    #undef PK
  }
}

#ifndef ATTN_STORE16
#define ATTN_STORE16(p,v) (*(u32x4*)(p)=(v))
#endif
template<int THRL> __device__ __forceinline__ void attn_unit(int b,int hq,int hv,int qb,const bf16*Q,const bf16*__restrict__ K,const bf16*__restrict__ V,bf16*O,char*shm){
  const int tid=opaque_tid(),lane=tid&63,r32=lane&31,hi=lane>>5; const int wid=__builtin_amdgcn_readfirstlane(tid>>6);
  const long rowbase=(long)b*SEQ; const int q0=qb*QB;
  const bf16*Qw=Q+(rowbase+q0+wid*QBLK)*DM+hq*D;
  const bf16*Kh=K+rowbase*DM+hq*D,*Vh=V+rowbase*DM+hv*D;
  const unsigned lds0=(unsigned)(uintptr_t)shm;
  float*wsf=(float*)(shm+LDS_WS)+wid*64;
  const bf16*ksrc=Kh+(long)lane*DM+wid*8;
  const bf16*vsrc=Vh+(long)(16*(wid&3)+(lane>>2))*DM+(wid>>2)*32+(lane&3)*8;
  const unsigned kdst=lds0+LDS_K+wid*1024, vdst=lds0+LDS_V+wid*1024;
  #define DMA_K(t,slot) glds16(ksrc+(long)(t)*KVBLK*DM,(unsigned)__builtin_amdgcn_readfirstlane(kdst+(slot)))
  #define DMA_V(t,slot) glds16(vsrc+(long)(t)*KVBLK*DM,(unsigned)__builtin_amdgcn_readfirstlane(vdst+(slot)))
  const int vb0=(int)(lds0+LDS_V)+((lane>>4)&1)*32+(lane&3)*8+(4*hi+((lane&15)>>2))*64;
  const char*Kbase=shm+LDS_K; bf16x8 kf[8];
  const lds_cptr shm3=(lds_cptr)shm; const lds_cptr kp0=shm3+LDS_K+hi*1024+r32*16; const lds_cptr vp0=shm3+LDS_V+((lane>>4)&1)*32+(lane&3)*8+(4*hi+((lane&15)>>2))*64;
  const int NT=(q0+QB)/KVBLK;
  DMA_K(0,0);DMA_V(0,0);DMA_K(1,SLOTB);
  bf16x8 qr[4];
  #pragma unroll
  for(int d0=0;d0<4;++d0)qr[d0]=*reinterpret_cast<const bf16x8*>(&Qw[(long)r32*DM+d0*16+hi*8]);
  float mhat=0.f,l_reg=0.f;f32x16 o[2];o[0]=f32x16{};o[1]=f32x16{};f32x16 negm=f32x16{};asm volatile("":"+v"(negm));
  const int qrel=wid*QBLK+r32;
  #define CMASK(P0,P1,t) do{int jb_=(t)-(NT-4); if(jb_>=0)cmask(P0,P1,jb_,qrel,hi);}while(0)
  bool resc=false;
  #define START(P0,P1) do{ const float rm=rowmax(P0,P1); resc=false; \
    { const float dl=rm; mhat=fadd_s(mhat,dl); \
      _Pragma("unroll") for(int r=0;r<16;++r){P0[r]=fsub_s(P0[r],dl);P1[r]=fsub_s(P1[r],dl);} \
      _Pragma("unroll") for(int r=0;r<16;++r)negm[r]=-mhat; asm volatile("":"+v"(negm)); } \
    _Pragma("unroll") for(int r=0;r<16;++r)P0[r]=__builtin_amdgcn_exp2f(P0[r]); }while(0)
  #define RESC() do{ if(resc){ asm volatile("s_waitcnt lgkmcnt(0)":::"memory"); \
      _Pragma("unroll") for(int d_=0;d_<2;++d_) _Pragma("unroll") for(int r=0;r<16;++r)o[d_][r]*=wsf[crow(r,hi)]; } }while(0)
  f32x16 pA0,pA1,pB0,pB1;
  int sl_prev=0,sl_cur=0,sl_next=SLOTB;
  #define ROT() do{sl_prev=sl_cur;sl_cur=sl_next;sl_next=(sl_next==(NSLOT-1)*SLOTB)?0:sl_next+SLOTB;}while(0)
  DMA_K(2,2*SLOTB);
  WAIT_BAR(3);
  qkt(pA0,pA1,Kbase,qr,negm,r32,hi);asm volatile("s_nop 15\n\ts_nop 7":"+v"(pA0),"+v"(pA1));CMASK(pA0,pA1,0);
  START(pA0,pA1);
  _Pragma("unroll") for(int r=0;r<16;++r)pA1[r]=__builtin_amdgcn_exp2f(pA1[r]);
  WAIT_BAR(0);
  DMA_K(3,0);DMA_V(1,SLOTB);
  ROT();
  kload8(kf,kp0+sl_cur);
  WAIT_BAR(2);
  s16x4 vlo[8],vhi[8]; u32x4 pw0,pw1,pw2,pw3;
  #define PKW(P,B) cvtpk_s(P[B],P[B+1])
  #define PAF(k) __builtin_bit_cast(bf16x8,pw##k)
  #define VFR(i) (bf16x8){vlo[i][0],vlo[i][1],vlo[i][2],vlo[i][3],vhi[i][0],vhi[i][1],vhi[i][2],vhi[i][3]}
  #define PIN(x) asm volatile("":"+v"(x))
  #define MX3(a,b,c) __builtin_fmaxf(__builtin_fmaxf((a),(b)),(c))
  #define GAPA(MF,A0,A1,A2,A3,W0,W1,PW) do{ MF; sacc+=A0; sacc+=A1; sacc+=A2; sacc+=A3; PIN(sacc); W0; W1; PIN(PW); SBAR(); }while(0)
  #define EX(v) __builtin_amdgcn_exp2f(v)
  #define GAPB(MF,X,B) do{ MF; X[B]=EX(X[B]); X[B+1]=EX(X[B+1]); X[B+2]=EX(X[B+2]); X[B+3]=EX(X[B+3]); PIN(X); SBAR(); }while(0)
  #define VRD(i) do{ vlo[i]=vtr(vp_+(((i)>>2)*4096+((i)&3)*1024)); vhi[i]=vtr(vp_+(((i)>>2)*4096+((i)&3)*1024+512)); }while(0)
  #define KRD(G,j) do{ if(G){ kload2(kf,kp0+sl_next,j); SBAR(); } }while(0)
  #define STEP(C0,C1,P0,P1,t,GK,GV,GL) do{ SBAR(); \
    const lds_cptr vp_=vp0+sl_prev; \
    VRD(0); SBAR(); float sacc=(P0[0]+P0[1]); \
    GAPA(C0=__builtin_amdgcn_mfma_f32_32x32x16_bf16(kf[0],qr[0],negm,0,0,0), P0[2],P0[3],P0[4],P0[5],     pw0[0]=PKW(P0,0), pw0[1]=PKW(P0,2), pw0); \
    VRD(4); SBAR(); GAPA(C1=__builtin_amdgcn_mfma_f32_32x32x16_bf16(kf[1],qr[0],negm,0,0,0), P0[6],P0[7],P0[8],P0[9],     pw0[2]=PKW(P0,4), pw0[3]=PKW(P0,6), pw0); \
    VRD(1); SBAR(); GAPA(C0=__builtin_amdgcn_mfma_f32_32x32x16_bf16(kf[2],qr[1],C0,0,0,0),   P0[10],P0[11],P0[12],P0[13], pw1[0]=PKW(P0,8), pw1[1]=PKW(P0,10), pw1); \
    VRD(5); SBAR(); GAPA(C1=__builtin_amdgcn_mfma_f32_32x32x16_bf16(kf[3],qr[1],C1,0,0,0),   P0[14],P0[15],P1[0],P1[1],   pw1[2]=PKW(P0,12),pw1[3]=PKW(P0,14), pw1); \
    VRD(2); SBAR(); GAPA(C0=__builtin_amdgcn_mfma_f32_32x32x16_bf16(kf[4],qr[2],C0,0,0,0),   P1[2],P1[3],P1[4],P1[5],     pw2[0]=PKW(P1,0), pw2[1]=PKW(P1,2), pw2); \
    VRD(6); SBAR(); GAPA(C1=__builtin_amdgcn_mfma_f32_32x32x16_bf16(kf[5],qr[2],C1,0,0,0),   P1[6],P1[7],P1[8],P1[9],     pw2[2]=PKW(P1,4), pw2[3]=PKW(P1,6), pw2); \
    VRD(3); SBAR(); GAPA(C0=__builtin_amdgcn_mfma_f32_32x32x16_bf16(kf[6],qr[3],C0,0,0,0),   P1[10],P1[11],P1[12],P1[13], pw3[0]=PKW(P1,8), pw3[1]=PKW(P1,10), pw3); \
    VRD(7); SBAR(); GAPA(C1=__builtin_amdgcn_mfma_f32_32x32x16_bf16(kf[7],qr[3],C1,0,0,0),   P1[14],P1[15],0.f,0.f,       pw3[2]=PKW(P1,12),pw3[3]=PKW(P1,14), pw3); \
    l_reg+=sacc; \
    if(GK){DMA_K((t)+3,sl_cur);} if(GV){DMA_V((t)+1,sl_next);} \
    CMASK(C0,C1,t); \
    { float a=MX3(C0[0],C0[1],C1[0]),b=MX3(C0[2],C0[3],C1[1]); a=MX3(a,C1[2],C1[3]); \
      _Pragma("unroll") for(int r=4;r<16;r+=4){a=MX3(a,C0[r],C0[r+1]);b=MX3(b,C0[r+2],C0[r+3]);a=MX3(a,C1[r],C1[r+1]);b=MX3(b,C1[r+2],C1[r+3]);} \
      float rm=__builtin_fmaxf(a,b); { auto rr=__builtin_amdgcn_permlane32_swap(__float_as_uint(rm),__float_as_uint(rm),false,false); rm=__builtin_fmaxf(__uint_as_float(rr[0]),__uint_as_float(rr[1])); } \
      resc=false; \
      if(__builtin_expect(__any(rm>(float)THRL),0)){ const float dl=__builtin_fmaxf(rm,0.f); mhat+=dl; \
        _Pragma("unroll") for(int r=0;r<16;++r){C0[r]-=dl;C1[r]-=dl;} \
        _Pragma("unroll") for(int r=0;r<16;++r)negm[r]=-mhat; asm volatile("":"+v"(negm)); \
        const float f=__builtin_amdgcn_exp2f(-dl); l_reg*=f; if(hi==0)wsf[r32]=f; resc=true; } } \
    SBAR(); \
    GAPB(o[0]=__builtin_amdgcn_mfma_f32_32x32x16_bf16(PAF(0),VFR(0),o[0],0,0,0), C0,0); \
    GAPB(o[1]=__builtin_amdgcn_mfma_f32_32x32x16_bf16(PAF(0),VFR(4),o[1],0,0,0), C0,4); \
    KRD(GL,0); GAPB(o[0]=__builtin_amdgcn_mfma_f32_32x32x16_bf16(PAF(1),VFR(1),o[0],0,0,0), C0,8); \
    KRD(GL,1); GAPB(o[1]=__builtin_amdgcn_mfma_f32_32x32x16_bf16(PAF(1),VFR(5),o[1],0,0,0), C0,12); \
    KRD(GL,2); GAPB(o[0]=__builtin_amdgcn_mfma_f32_32x32x16_bf16(PAF(2),VFR(2),o[0],0,0,0), C1,0); \
    KRD(GL,3); GAPB(o[1]=__builtin_amdgcn_mfma_f32_32x32x16_bf16(PAF(2),VFR(6),o[1],0,0,0), C1,4); \
    GAPB(o[0]=__builtin_amdgcn_mfma_f32_32x32x16_bf16(PAF(3),VFR(3),o[0],0,0,0), C1,8); \
    GAPB(o[1]=__builtin_amdgcn_mfma_f32_32x32x16_bf16(PAF(3),VFR(7),o[1],0,0,0), C1,12); \
    }while(0)
  int t=1;
  #undef CMASK
  #define CMASK(P0,P1,t) do{}while(0)
  for(;t+5<NT;t+=2){
    STEP(pB0,pB1,pA0,pA1,t,true,true,true);     WAIT_BAR(2); RESC(); ROT();
    STEP(pA0,pA1,pB0,pB1,t+1,true,true,true);   WAIT_BAR(2); RESC(); ROT();
  }
  #undef CMASK
  #define CMASK(P0,P1,t) do{int jb_=(t)-(NT-4); if(jb_>=0)cmask(P0,P1,jb_,qrel,hi);}while(0)
  #define ENDW(tt) do{ if((tt)+3<NT){WAIT_BAR(2);} else if((tt)+2<NT){WAIT_BAR(1);} else {WAIT_BAR(0);} }while(0)
  for(;t+1<NT;t+=2){
    STEP(pB0,pB1,pA0,pA1,t,(t+3<NT),(t+1<NT),(t+1<NT));       ENDW(t);   RESC(); ROT();
    STEP(pA0,pA1,pB0,pB1,t+1,(t+4<NT),(t+2<NT),(t+2<NT));     ENDW(t+1); RESC(); ROT();
  }
  STEP(pB0,pB1,pA0,pA1,NT-1,false,false,false); RESC();
  { float sacc=pB0[0]+pB0[1]; _Pragma("unroll") for(int r=2;r<16;++r)sacc+=pB0[r]; _Pragma("unroll") for(int r=0;r<16;++r)sacc+=pB1[r]; l_reg+=sacc;
    pw0=(u32x4){PKW(pB0,0),PKW(pB0,2),PKW(pB0,4),PKW(pB0,6)};pw1=(u32x4){PKW(pB0,8),PKW(pB0,10),PKW(pB0,12),PKW(pB0,14)};pw2=(u32x4){PKW(pB1,0),PKW(pB1,2),PKW(pB1,4),PKW(pB1,6)};pw3=(u32x4){PKW(pB1,8),PKW(pB1,10),PKW(pB1,12),PKW(pB1,14)};
    SBAR(); pv(o,vb0+sl_cur,PAF(0),PAF(1),PAF(2),PAF(3)); }
  #undef PKW
  #undef PAF
  #undef VFR
  #undef PIN
  #undef MX3
  #undef GAPA
  #undef GAPB
  #undef EX
  #undef VRD
  #undef KRD
  #undef STEP
  #undef ENDW
  {auto rr=__builtin_amdgcn_permlane32_swap(__float_as_uint(l_reg),__float_as_uint(l_reg),false,false);l_reg=__uint_as_float(rr[0])+__uint_as_float(rr[1]);}
  if(hi==0)wsf[32+r32]=l_reg;asm volatile("s_waitcnt lgkmcnt(0)":::"memory");
  float rli[16];
  #pragma unroll
  for(int r=0;r<16;++r)rli[r]=__builtin_amdgcn_rcpf(wsf[32+crow(r,hi)]);
  bf16*Ow=O+(rowbase+q0+wid*QBLK)*DM+hv*D;
  { bf16*stg=(bf16*)(shm+LDS_OST)+wid*2048;
    #pragma unroll
    for(int r=0;r<16;++r){const int orow=crow(r,hi);
      #pragma unroll
      for(int d0=0;d0<2;++d0)stg[orow*64+d0*32+r32]=__float2bfloat16(o[d0][r]*rli[r]);}
    asm volatile("s_waitcnt lgkmcnt(0)":::"memory");
    #pragma unroll
    for(int i=0;i<4;++i){const int row=i*8+(lane>>3),ch=lane&7; const u32x4 v=*(const u32x4*)(stg+row*64+ch*8); ATTN_STORE16(Ow+(long)row*DM+ch*8,v);} }
  asm volatile("s_waitcnt lgkmcnt(0)\n\ts_barrier":::"memory");
  #undef DMA_K
  #undef DMA_V
  #undef CMASK
  #undef START
  #undef RESC
  #undef ROT
}
__device__ __forceinline__ void pv128(f32x16*o,int vb,bf16x8 pa0,bf16x8 pa1,bf16x8 pa2,bf16x8 pa3){
  #pragma unroll
  for(int d0=0;d0<4;++d0){s16x4 lo[4],hi[4];
    #pragma unroll
    for(int ks=0;ks<4;++ks){
      asm volatile("ds_read_b64_tr_b16 %0,%1 offset:%c2":"=&v"(lo[ks]):"v"(vb),"i"(d0*4096+ks*1024):"memory");
      asm volatile("ds_read_b64_tr_b16 %0,%1 offset:%c2":"=&v"(hi[ks]):"v"(vb),"i"(d0*4096+ks*1024+512):"memory");}
    asm volatile("s_waitcnt lgkmcnt(0)":::"memory");SBAR();
    #define PK(k) (bf16x8){lo[k][0],lo[k][1],lo[k][2],lo[k][3],hi[k][0],hi[k][1],hi[k][2],hi[k][3]}
    o[d0]=__builtin_amdgcn_mfma_f32_32x32x16_bf16(pa0,PK(0),o[d0],0,0,0);
    o[d0]=__builtin_amdgcn_mfma_f32_32x32x16_bf16(pa1,PK(1),o[d0],0,0,0);
    o[d0]=__builtin_amdgcn_mfma_f32_32x32x16_bf16(pa2,PK(2),o[d0],0,0,0);
    o[d0]=__builtin_amdgcn_mfma_f32_32x32x16_bf16(pa3,PK(3),o[d0],0,0,0);
    #undef PK
  }
}
constexpr int SLOTV=16384, LDS_V2=NSLOT*SLOTB, LDS_WS2=LDS_V2+NSLOT*SLOTV, LDS_OST2=LDS_WS2+NW*64*4, LDS_BYTES2=LDS_OST2+NW*4096;
template<int THRL> __device__ __forceinline__ void attn_unit128(int b,int hq,int hv,int qb,const bf16*Q,const bf16*__restrict__ K,const bf16*__restrict__ V,bf16*O,char*shm){
  const int tid=opaque_tid(),lane=tid&63,r32=lane&31,hi=lane>>5; const int wid=__builtin_amdgcn_readfirstlane(tid>>6);
  const long rowbase=(long)b*SEQ; const int q0=qb*QB;
  const bf16*Qw=Q+(rowbase+q0+wid*QBLK)*DM+hq*D;
  const bf16*Kh=K+rowbase*DM+hq*D,*Vh=V+rowbase*DM+hv*D;
  const unsigned lds0=(unsigned)(uintptr_t)shm;
  float*wsf=(float*)(shm+LDS_WS2)+wid*64;
  const bf16*ksrc=Kh+(long)lane*DM+wid*8;
  const bf16*vsrc=Vh+(long)(16*(wid&3)+(lane>>2))*DM+(wid>>2)*32+(lane&3)*8;
  const unsigned kdst=lds0+LDS_K+wid*1024, vdst=lds0+LDS_V2+wid*1024;
  #define DMA_K(t,slot) glds16(ksrc+(long)(t)*KVBLK*DM,(unsigned)__builtin_amdgcn_readfirstlane(kdst+(slot)))
  #define DMA_V(t,slot) do{ glds16(vsrc+(long)(t)*KVBLK*DM,(unsigned)__builtin_amdgcn_readfirstlane(vdst+2*(slot))); glds16(vsrc+64+(long)(t)*KVBLK*DM,(unsigned)__builtin_amdgcn_readfirstlane(vdst+8192+2*(slot))); }while(0)
  const int vb0=(int)(lds0+LDS_V2)+((lane>>4)&1)*32+(lane&3)*8+(4*hi+((lane&15)>>2))*64;
  const char*Kbase=shm+LDS_K; bf16x8 kf[8];
  const lds_cptr shm3=(lds_cptr)shm; const lds_cptr kp0=shm3+LDS_K+hi*1024+r32*16; const lds_cptr vp0=shm3+LDS_V2+((lane>>4)&1)*32+(lane&3)*8+(4*hi+((lane&15)>>2))*64;
  const int NT=(q0+QB)/KVBLK;
  DMA_K(0,0);DMA_V(0,0);DMA_K(1,SLOTB);
  bf16x8 qr[4];
  #pragma unroll
  for(int d0=0;d0<4;++d0)qr[d0]=*reinterpret_cast<const bf16x8*>(&Qw[(long)r32*DM+d0*16+hi*8]);
  float mhat=0.f,l_reg=0.f;f32x16 o[4];o[0]=f32x16{};o[1]=f32x16{};o[2]=f32x16{};o[3]=f32x16{};const f32x16 zc=f32x16{};
  const int qrel=wid*QBLK+r32;
  #define CMASK(P0,P1,t) do{int jb_=(t)-(NT-4); if(jb_>=0)cmask(P0,P1,jb_,qrel,hi);}while(0)
  bool resc=false;
  #define START(P0,P1) do{ const float rm=rowmax(P0,P1); resc=false; \
    { const float dl=rm; mhat=fadd_s(mhat,dl); \
      _Pragma("unroll") for(int r=0;r<16;++r){P0[r]=fsub_s(P0[r],dl);P1[r]=fsub_s(P1[r],dl);} \
      } \
    _Pragma("unroll") for(int r=0;r<16;++r)P0[r]=__builtin_amdgcn_exp2f(P0[r]); }while(0)
  #define RESC() do{ if(resc){ asm volatile("s_waitcnt lgkmcnt(0)":::"memory"); \
      _Pragma("unroll") for(int d_=0;d_<4;++d_) _Pragma("unroll") for(int r=0;r<16;++r)o[d_][r]*=wsf[crow(r,hi)]; } }while(0)
  f32x16 pA0,pA1,pB0,pB1;
  int sl_prev=0,sl_cur=0,sl_next=SLOTB;
  #define ROT() do{sl_prev=sl_cur;sl_cur=sl_next;sl_next=(sl_next==(NSLOT-1)*SLOTB)?0:sl_next+SLOTB;}while(0)
  DMA_K(2,2*SLOTB);
  WAIT_BAR(3);
  qkt(pA0,pA1,Kbase,qr,zc,r32,hi);asm volatile("s_nop 15\n\ts_nop 7":"+v"(pA0),"+v"(pA1));CMASK(pA0,pA1,0);
  START(pA0,pA1);
  _Pragma("unroll") for(int r=0;r<16;++r)pA1[r]=__builtin_amdgcn_exp2f(pA1[r]);
  WAIT_BAR(0);
  DMA_K(3,0);DMA_V(1,SLOTB);
  ROT();
  kload8(kf,kp0+sl_cur);
  WAIT_BAR(3);
  s16x4 vlo[8],vhi[8]; u32x4 pw0,pw1,pw2,pw3;
  #define PKW(P,B) cvtpk_s(P[B],P[B+1])
  #define PAF(k) __builtin_bit_cast(bf16x8,pw##k)
  #define VFR(i) (bf16x8){vlo[i][0],vlo[i][1],vlo[i][2],vlo[i][3],vhi[i][0],vhi[i][1],vhi[i][2],vhi[i][3]}
  #define PIN(x) asm volatile("":"+v"(x))
  #define MX3(a,b,c) __builtin_fmaxf(__builtin_fmaxf((a),(b)),(c))
  #define GAPA(MF,A0,A1,A2,A3,W0,W1,PW) do{ MF; sacc+=A0; sacc+=A1; sacc+=A2; sacc+=A3; PIN(sacc); W0; W1; PIN(PW); SBAR(); }while(0)
  #define EX(v) __builtin_amdgcn_exp2f(v)
  #define GAPB(MF,X,B) do{ MF; X[B]=EX(X[B]); X[B+1]=EX(X[B+1]); X[B+2]=EX(X[B+2]); X[B+3]=EX(X[B+3]); PIN(X); SBAR(); }while(0)
  #define VRD(i) do{ vlo[i]=vtr(vp_+(((i)>>2)*4096+((i)&3)*1024)); vhi[i]=vtr(vp_+(((i)>>2)*4096+((i)&3)*1024+512)); }while(0)
  #define VRX(i) do{ vlo[i]=vtr(vp_+((((i)>>2)+2)*4096+((i)&3)*1024)); vhi[i]=vtr(vp_+((((i)>>2)+2)*4096+((i)&3)*1024+512)); SBAR(); }while(0)
  #define GAPB2(MF,X,B) do{ MF; X[B]=EX(X[B]-mhat); X[B+1]=EX(X[B+1]-mhat); PIN(X); SBAR(); }while(0)
  #define KRD(G,j) do{ if(G){ kload2(kf,kp0+sl_next,j); SBAR(); } }while(0)
  #define STEP(C0,C1,P0,P1,t,GK,GV,GL) do{ SBAR(); \
    const lds_cptr vp_=vp0+2*sl_prev; \
    VRD(0); SBAR(); float sacc=(P0[0]+P0[1]); \
    GAPA(C0=__builtin_amdgcn_mfma_f32_32x32x16_bf16(kf[0],qr[0],zc,0,0,0), P0[2],P0[3],P0[4],P0[5],     pw0[0]=PKW(P0,0), pw0[1]=PKW(P0,2), pw0); \
    VRD(4); SBAR(); GAPA(C1=__builtin_amdgcn_mfma_f32_32x32x16_bf16(kf[1],qr[0],zc,0,0,0), P0[6],P0[7],P0[8],P0[9],     pw0[2]=PKW(P0,4), pw0[3]=PKW(P0,6), pw0); \
    VRD(1); SBAR(); GAPA(C0=__builtin_amdgcn_mfma_f32_32x32x16_bf16(kf[2],qr[1],C0,0,0,0),   P0[10],P0[11],P0[12],P0[13], pw1[0]=PKW(P0,8), pw1[1]=PKW(P0,10), pw1); \
    VRD(5); SBAR(); GAPA(C1=__builtin_amdgcn_mfma_f32_32x32x16_bf16(kf[3],qr[1],C1,0,0,0),   P0[14],P0[15],P1[0],P1[1],   pw1[2]=PKW(P0,12),pw1[3]=PKW(P0,14), pw1); \
    VRD(2); SBAR(); GAPA(C0=__builtin_amdgcn_mfma_f32_32x32x16_bf16(kf[4],qr[2],C0,0,0,0),   P1[2],P1[3],P1[4],P1[5],     pw2[0]=PKW(P1,0), pw2[1]=PKW(P1,2), pw2); \
    VRD(6); SBAR(); GAPA(C1=__builtin_amdgcn_mfma_f32_32x32x16_bf16(kf[5],qr[2],C1,0,0,0),   P1[6],P1[7],P1[8],P1[9],     pw2[2]=PKW(P1,4), pw2[3]=PKW(P1,6), pw2); \
    VRD(3); SBAR(); GAPA(C0=__builtin_amdgcn_mfma_f32_32x32x16_bf16(kf[6],qr[3],C0,0,0,0),   P1[10],P1[11],P1[12],P1[13], pw3[0]=PKW(P1,8), pw3[1]=PKW(P1,10), pw3); \
    VRD(7); SBAR(); GAPA(C1=__builtin_amdgcn_mfma_f32_32x32x16_bf16(kf[7],qr[3],C1,0,0,0),   P1[14],P1[15],0.f,0.f,       pw3[2]=PKW(P1,12),pw3[3]=PKW(P1,14), pw3); \
    l_reg+=sacc; \
    if(GK){DMA_K((t)+3,sl_cur);} if(GV){DMA_V((t)+1,sl_next);} \
    CMASK(C0,C1,t); \
    { float a=MX3(C0[0],C0[1],C1[0]),b=MX3(C0[2],C0[3],C1[1]); a=MX3(a,C1[2],C1[3]); \
      _Pragma("unroll") for(int r=4;r<16;r+=4){a=MX3(a,C0[r],C0[r+1]);b=MX3(b,C0[r+2],C0[r+3]);a=MX3(a,C1[r],C1[r+1]);b=MX3(b,C1[r+2],C1[r+3]);} \
      float rm=__builtin_fmaxf(a,b); { auto rr=__builtin_amdgcn_permlane32_swap(__float_as_uint(rm),__float_as_uint(rm),false,false); rm=__builtin_fmaxf(__uint_as_float(rr[0]),__uint_as_float(rr[1])); } \
      rm-=mhat; resc=false; \
      if(__builtin_expect(__any(rm>(float)THRL),0)){ const float dl=__builtin_fmaxf(rm,0.f); mhat+=dl; \
        const float f=__builtin_amdgcn_exp2f(-dl); l_reg*=f; if(hi==0)wsf[r32]=f; resc=true; } } \
    SBAR(); \
    GAPB2(o[0]=__builtin_amdgcn_mfma_f32_32x32x16_bf16(PAF(0),VFR(0),o[0],0,0,0), C0,0);  VRX(0); \
    GAPB2(o[1]=__builtin_amdgcn_mfma_f32_32x32x16_bf16(PAF(0),VFR(4),o[1],0,0,0), C0,2);  VRX(4); \
    KRD(GL,0); GAPB2(o[0]=__builtin_amdgcn_mfma_f32_32x32x16_bf16(PAF(1),VFR(1),o[0],0,0,0), C0,4);  VRX(1); \
    KRD(GL,1); GAPB2(o[1]=__builtin_amdgcn_mfma_f32_32x32x16_bf16(PAF(1),VFR(5),o[1],0,0,0), C0,6);  VRX(5); \
    KRD(GL,2); GAPB2(o[0]=__builtin_amdgcn_mfma_f32_32x32x16_bf16(PAF(2),VFR(2),o[0],0,0,0), C0,8);  VRX(2); \
    KRD(GL,3); GAPB2(o[1]=__builtin_amdgcn_mfma_f32_32x32x16_bf16(PAF(2),VFR(6),o[1],0,0,0), C0,10); VRX(6); \
    GAPB2(o[0]=__builtin_amdgcn_mfma_f32_32x32x16_bf16(PAF(3),VFR(3),o[0],0,0,0), C0,12); VRX(3); \
    GAPB2(o[1]=__builtin_amdgcn_mfma_f32_32x32x16_bf16(PAF(3),VFR(7),o[1],0,0,0), C0,14); VRX(7); \
    GAPB2(o[2]=__builtin_amdgcn_mfma_f32_32x32x16_bf16(PAF(0),VFR(0),o[2],0,0,0), C1,0); \
    GAPB2(o[3]=__builtin_amdgcn_mfma_f32_32x32x16_bf16(PAF(0),VFR(4),o[3],0,0,0), C1,2); \
    GAPB2(o[2]=__builtin_amdgcn_mfma_f32_32x32x16_bf16(PAF(1),VFR(1),o[2],0,0,0), C1,4); \
    GAPB2(o[3]=__builtin_amdgcn_mfma_f32_32x32x16_bf16(PAF(1),VFR(5),o[3],0,0,0), C1,6); \
    GAPB2(o[2]=__builtin_amdgcn_mfma_f32_32x32x16_bf16(PAF(2),VFR(2),o[2],0,0,0), C1,8); \
    GAPB2(o[3]=__builtin_amdgcn_mfma_f32_32x32x16_bf16(PAF(2),VFR(6),o[3],0,0,0), C1,10); \
    GAPB2(o[2]=__builtin_amdgcn_mfma_f32_32x32x16_bf16(PAF(3),VFR(3),o[2],0,0,0), C1,12); \
    GAPB2(o[3]=__builtin_amdgcn_mfma_f32_32x32x16_bf16(PAF(3),VFR(7),o[3],0,0,0), C1,14); \
    }while(0)
  int t=1;
  #undef CMASK
  #define CMASK(P0,P1,t) do{}while(0)
  for(;t+5<NT;t+=2){
    STEP(pB0,pB1,pA0,pA1,t,true,true,true);     WAIT_BAR(3); RESC(); ROT();
    STEP(pA0,pA1,pB0,pB1,t+1,true,true,true);   WAIT_BAR(3); RESC(); ROT();
  }
  #undef CMASK
  #define CMASK(P0,P1,t) do{int jb_=(t)-(NT-4); if(jb_>=0)cmask(P0,P1,jb_,qrel,hi);}while(0)
  #define ENDW(tt) do{ if((tt)+3<NT){WAIT_BAR(3);} else if((tt)+2<NT){WAIT_BAR(2);} else {WAIT_BAR(0);} }while(0)
  for(;t+1<NT;t+=2){
    STEP(pB0,pB1,pA0,pA1,t,(t+3<NT),(t+1<NT),(t+1<NT));       ENDW(t);   RESC(); ROT();
    STEP(pA0,pA1,pB0,pB1,t+1,(t+4<NT),(t+2<NT),(t+2<NT));     ENDW(t+1); RESC(); ROT();
  }
  STEP(pB0,pB1,pA0,pA1,NT-1,false,false,false); RESC();
  { float sacc=pB0[0]+pB0[1]; _Pragma("unroll") for(int r=2;r<16;++r)sacc+=pB0[r]; _Pragma("unroll") for(int r=0;r<16;++r)sacc+=pB1[r]; l_reg+=sacc;
    pw0=(u32x4){PKW(pB0,0),PKW(pB0,2),PKW(pB0,4),PKW(pB0,6)};pw1=(u32x4){PKW(pB0,8),PKW(pB0,10),PKW(pB0,12),PKW(pB0,14)};pw2=(u32x4){PKW(pB1,0),PKW(pB1,2),PKW(pB1,4),PKW(pB1,6)};pw3=(u32x4){PKW(pB1,8),PKW(pB1,10),PKW(pB1,12),PKW(pB1,14)};
    SBAR(); pv128(o,vb0+2*sl_cur,PAF(0),PAF(1),PAF(2),PAF(3)); }
  #undef PKW
  #undef PAF
  #undef VFR
  #undef PIN
  #undef MX3
  #undef GAPA
  #undef GAPB
  #undef EX
  #undef VRD
  #undef VRX
  #undef GAPB2
  #undef KRD
  #undef STEP
  #undef ENDW
  {auto rr=__builtin_amdgcn_permlane32_swap(__float_as_uint(l_reg),__float_as_uint(l_reg),false,false);l_reg=__uint_as_float(rr[0])+__uint_as_float(rr[1]);}
  if(hi==0)wsf[32+r32]=l_reg;asm volatile("s_waitcnt lgkmcnt(0)":::"memory");
  float rli[16];
  #pragma unroll
  for(int r=0;r<16;++r)rli[r]=__builtin_amdgcn_rcpf(wsf[32+crow(r,hi)]);
  bf16*Ow=O+(rowbase+q0+wid*QBLK)*DM+hv*D;
  { bf16*stg=(bf16*)(shm+LDS_OST2)+wid*2048;
    #pragma unroll
    for(int hp=0;hp<2;++hp){
      #pragma unroll
      for(int r=0;r<16;++r){const int orow=crow(r,hi);
        #pragma unroll
        for(int d0=0;d0<2;++d0)stg[orow*64+d0*32+r32]=__float2bfloat16(o[2*hp+d0][r]*rli[r]);}
      asm volatile("s_waitcnt lgkmcnt(0)":::"memory");
      #pragma unroll
      for(int i=0;i<4;++i){const int row=i*8+(lane>>3),ch=lane&7; const u32x4 v=*(const u32x4*)(stg+row*64+ch*8); ATTN_STORE16(Ow+(long)row*DM+hp*64+ch*8,v);}
      asm volatile("s_waitcnt lgkmcnt(0)":::"memory"); } }
  asm volatile("s_waitcnt lgkmcnt(0)\n\ts_barrier":::"memory");
  #undef DMA_K
  #undef DMA_V
  #undef CMASK
  #undef START
  #undef RESC
  #undef ROT
}
constexpr int ATTN_LDS_BYTES=LDS_BYTES;
#undef SBAR
#undef WAIT_BAR
}
#define GAS __attribute__((address_space(1)))
#define LAS __attribute__((address_space(3)))
typedef unsigned short bf16;
typedef unsigned v4u __attribute__((ext_vector_type(4)));
typedef float f32x4 __attribute__((ext_vector_type(4)));
typedef short bf16x8 __attribute__((ext_vector_type(8)));
typedef GAS unsigned gu32;
typedef GAS unsigned long long gu64;
#define RLX_AGENT __ATOMIC_RELAXED, __HIP_MEMORY_SCOPE_AGENT
#define LDS_WAIT() asm volatile("s_waitcnt lgkmcnt(0)" ::: "memory")
#define VM_WAIT() asm volatile("s_waitcnt vmcnt(0)" ::: "memory")
__device__ __forceinline__ unsigned long long rt() { return __builtin_amdgcn_s_memrealtime(); }
__device__ __forceinline__ unsigned f2bf(float f) { unsigned u = __builtin_bit_cast(unsigned, f); return (u + 0x7fffu + ((u >> 16) & 1u)) >> 16; }
__device__ __forceinline__ unsigned pk2(float lo, float hi) { return f2bf(lo) | (f2bf(hi) << 16); }

#define XB_TMO      128
#define XB_XCNT(j)  (256  + 64 * (j))
#define XB_XSUB(j)  (1280 + 64 * (j))
#define XB_XGEN(j)  (2304 + 64 * (j))
#define XB_TOP      3328
#define XB_TOPGEN   3392
#define XCD_BAR_WORDS 3456
#define XB_SPIN_CAP (1u << 18)

__device__ __forceinline__ unsigned xb_ld(unsigned* p)              { return __hip_atomic_load(p, __ATOMIC_RELAXED, __HIP_MEMORY_SCOPE_AGENT); }
__device__ __forceinline__ unsigned xb_add(unsigned* p, unsigned v) { return __hip_atomic_fetch_add(p, v, __ATOMIC_RELAXED, __HIP_MEMORY_SCOPE_AGENT); }
__device__ __forceinline__ unsigned xb_xcc_id() { return (unsigned)__builtin_amdgcn_s_getreg((3 << 11) | 20) & 0xFu; }
#define XB_SPIN(cond, bar) do { unsigned _sp = 0; while (cond) { __builtin_amdgcn_s_sleep(1); \
    if ((++_sp & 255u) == 0u) { if (xb_ld(&(bar)[XB_TMO])) break; if (_sp > XB_SPIN_CAP) { atomicAdd(&(bar)[XB_TMO], 1u); break; } } } } while (0)

struct XcdBarrier {
    unsigned* bar; unsigned x;
    volatile LAS unsigned* st;
};

__device__ __forceinline__ XcdBarrier xcd_barrier_post(unsigned* bar, volatile LAS unsigned* st) {
    XcdBarrier b; b.bar = bar; b.x = xb_xcc_id(); b.st = st;
    if (opaque_tid() == 0) (void)xb_add(&bar[XB_XCNT(b.x)], 1u);
    return b;
}
__device__ __forceinline__ void xcd_barrier_complete(unsigned* bar, unsigned x, unsigned& nloc, unsigned& nx) {
    const unsigned G = gridDim.x * gridDim.y * gridDim.z;
    unsigned sum, cnt, mine, sp = 0u;
    for (;;) {
        sum = 0u; cnt = 0u;
#pragma unroll
        for (unsigned j = 0; j < 16; ++j) { const unsigned c = xb_ld(&bar[XB_XCNT(j)]); sum += c; cnt += (c > 0u) ? 1u : 0u; }
        if (sum == G) break;
        __builtin_amdgcn_s_sleep(1);
        if ((++sp & 255u) == 0u) { if (xb_ld(&bar[XB_TMO])) break; if (sp > XB_SPIN_CAP) { atomicAdd(&bar[XB_TMO], 1u); break; } }
    }
    mine = xb_ld(&bar[XB_XCNT(x)]);
    nloc = mine > 0u ? mine : 1u; nx = cnt > 0u ? cnt : 1u;
}

__device__ __forceinline__ void xcd_barrier(const XcdBarrier& b) {
    asm volatile("s_waitcnt vmcnt(0)" ::: "memory");
    __syncthreads();
    if (opaque_tid() == 0) {
        unsigned* bar = b.bar;
        __builtin_amdgcn_s_waitcnt(0);
        unsigned nloc = b.st[0], nx = b.st[1];
        if (nloc == 0u) { xcd_barrier_complete(bar, b.x, nloc, nx); b.st[0] = nloc; b.st[1] = nx; }
        const unsigned old = xb_add(&bar[XB_XSUB(b.x)], 1u);
        const unsigned gen = old / nloc;
        if (old + 1u == (gen + 1u) * nloc) {
            __builtin_amdgcn_fence(__ATOMIC_RELEASE, "agent");
            asm volatile("s_waitcnt vmcnt(0)" ::: "memory");
            const unsigned og = xb_add(&bar[XB_TOP], 1u);
            const unsigned tg = og / nx;
            if (og + 1u == (tg + 1u) * nx) xb_add(&bar[XB_TOPGEN], 1u);
            else XB_SPIN(xb_ld(&bar[XB_TOPGEN]) == tg, bar);
            __builtin_amdgcn_fence(__ATOMIC_ACQUIRE, "agent");
            xb_add(&bar[XB_XGEN(b.x)], 1u);
            asm volatile("s_waitcnt vmcnt(0)" ::: "memory");
        } else {
            XB_SPIN(xb_ld(&bar[XB_XGEN(b.x)]) == gen, bar);
            __builtin_amdgcn_fence(__ATOMIC_ACQUIRE, "agent");
            asm volatile("s_waitcnt vmcnt(0)" ::: "memory");
        }
    }
    __syncthreads();
}
constexpr int NWAVES = 8;
constexpr int DM = 1024, MP = 32768, MS = 512, MROWS = MP + MS, NSEQ = 20, DEPTH = 4, DFF = 2816, DIN = 9216, PAST = 2048;
constexpr int NCHUNK_P = 512, NCHUNK = 528;
constexpr float EPS = 1e-6f;
constexpr size_t OY_P = 0, OY_S = 33554432, OK_P = 34078720, OV_P = 168296448, OS_P = 302514176, OK_S = 304611328, OV_S = 306708480, OS_S = 308805632, OUT_TOTAL = 317194240;

constexpr size_t MiB = 1u << 20;
constexpr size_t WS_CTL = 0, CTL_ZERO_BYTES = 1 * MiB;
constexpr size_t WS_MOD = 1 * MiB;
constexpr size_t WS_LB = 4 * MiB;
constexpr size_t WS_W = 8 * MiB, W_LAYER = 57 * MiB;
constexpr size_t WO_GU1 = 0, WO_D1 = 11 * MiB, WO_IN = 16 * MiB + MiB / 2, WO_BA = 34 * MiB + MiB / 2, WO_BH = 36 * MiB + MiB / 2, WO_OUT = 38 * MiB + MiB / 2, WO_GU2 = 40 * MiB + MiB / 2, WO_D2 = 51 * MiB + MiB / 2;
constexpr size_t WS_X = 240 * MiB;
constexpr size_t WS_XN = 370 * MiB;
constexpr size_t WS_Q = 435 * MiB, WS_K = 500 * MiB, WS_V = 565 * MiB;
constexpr size_t WS_QQ = 630 * MiB, WS_KK = 695 * MiB, WS_VV = 760 * MiB, WS_HGS = 825 * MiB, WS_SZA = 890 * MiB, WS_SZH = 955 * MiB;
constexpr size_t WS_LOGF = 1020 * MiB;
constexpr size_t WS_O1 = 1150 * MiB, WS_O2 = 1215 * MiB, WS_OATT = 1280 * MiB, WS_OH = 1345 * MiB, WS_MRG = 1410 * MiB;
constexpr size_t WS_BIG = 1475 * MiB;
constexpr size_t WS_SST = 1739 * MiB;
constexpr size_t WS_DD = 1871 * MiB;
constexpr size_t WS_END = 1874 * MiB;
#ifndef TEAM_STRIDE
#define TEAM_STRIDE 16
#endif
#ifndef STARTERS
#define STARTERS 8
#endif
constexpr int T_TEAM = 256 / TEAM_STRIDE;
#ifndef G3_STAGGER_TICKS
#define G3_STAGGER_TICKS 800
#endif
#ifndef HG_SEGS
#define HG_SEGS 4
#endif
constexpr int HG_G = HG_SEGS;
constexpr size_t WS_QS = WS_BIG, WS_SL = WS_BIG + 64 * MiB, WS_DSEG = WS_BIG + 96 * MiB, WS_RAW = WS_SST;
constexpr int CW_BAR = 4096, CW_Q = 8192, CW_HS = 16384;
static_assert(pg8::EpiWin::O_Q == WS_Q && pg8::EpiWin::O_K == WS_K && pg8::EpiWin::O_V == WS_V && pg8::EpiWin::O_QQ == WS_QQ && pg8::EpiWin::O_KK == WS_KK && pg8::EpiWin::O_VV == WS_VV && pg8::EpiWin::O_HGS == WS_HGS && pg8::EpiWin::O_SZA == WS_SZA && pg8::EpiWin::O_SZH == WS_SZH && pg8::EpiWin::O_LOGF == WS_LOGF && pg8::EpiWin::O_LB == WS_LB && pg8::EpiWin::OK_P_ == OK_P && pg8::EpiWin::OV_P_ == OV_P && pg8::EpiWin::OK_S_ == OK_S && pg8::EpiWin::OV_S_ == OV_S, "EpiWin offsets");

constexpr int RING_OFF = 0, RING_BYTES = 139264;
constexpr int LDSCTL_OFF = RING_BYTES, MISC_OFF = LDSCTL_OFF + 320;
constexpr int LDS_BYTES = 147456;

struct Frame {
    LAS unsigned char* lds;
    volatile LAS unsigned* MISC;
    gu32* ctl;
    int tid, lane, wave;
    int vcu, G;
};
typedef float f32x16 __attribute__((ext_vector_type(16)));
typedef unsigned v2u __attribute__((ext_vector_type(2)));

__device__ __forceinline__ float shx(float v, int mask, int lane) { return __builtin_bit_cast(float, __builtin_amdgcn_ds_bpermute((lane ^ mask) << 2, __builtin_bit_cast(int, v))); }
__device__ __forceinline__ float wave_sum(float v, int lane) {
#pragma unroll
    for (int o = 1; o < 64; o <<= 1) v += shx(v, o, lane);
    return v;
}
__device__ __forceinline__ float bf2f(bf16 b) { return __builtin_bit_cast(float, (unsigned)b << 16); }
__device__ __forceinline__ unsigned cvtpk(float lo, float hi) { return pg8::cvt_pk_bf16(lo, hi); }
__device__ __forceinline__ bf16x8 pack8(f32x4 a, f32x4 b) { v4u w; w.x = cvtpk(a[0], a[1]); w.y = cvtpk(a[2], a[3]); w.z = cvtpk(b[0], b[1]); w.w = cvtpk(b[2], b[3]); return __builtin_bit_cast(bf16x8, w); }
__device__ __forceinline__ float lam_init_of(int l) { asm volatile("" : "+s"(l)); return 0.8f - 0.6f * __expf(-0.3f * (float)l); }

__device__ __forceinline__ void p0_transpose_item(const float* W, int K, int N, bf16* WT, bool gu, LAS float* scr, int item, int lane) {
    const int nblk = N / 32, kb = item / nblk, nb = item % nblk, k0 = 64 * kb, nd0 = 32 * nb;
    const int ns0 = gu ? (((nd0 >> 7) & 1) * 2816 + (nd0 >> 8) * 128 + (nd0 & 127)) : nd0;
#pragma unroll 8
    for (int i = 0; i < 32; ++i) { const int kk = 2 * i + (lane >> 5); scr[kk * 33 + (lane & 31)] = W[(size_t)(k0 + kk) * N + ns0 + (lane & 31)]; }
    LDS_WAIT(); asm volatile("" ::: "memory");
    const int c = lane & 7;
#pragma unroll
    for (int j = 0; j < 4; ++j) { const int n = (lane >> 3) + 8 * j; const LAS float* s = scr + (8 * c) * 33 + n;
        v4u o; o.x = pk2(s[0 * 33], s[1 * 33]); o.y = pk2(s[2 * 33], s[3 * 33]); o.z = pk2(s[4 * 33], s[5 * 33]); o.w = pk2(s[6 * 33], s[7 * 33]);
        *(GAS v4u*)(WT + (size_t)(nd0 + n) * K + k0 + 8 * c) = o; }
    LDS_WAIT(); asm volatile("" ::: "memory");
}
typedef const __attribute__((address_space(4))) char* kaptr_t;
__device__ __forceinline__ const float* karg(int i) { kaptr_t ka = (kaptr_t)__builtin_amdgcn_kernarg_segment_ptr(); asm volatile("" : "+s"(ka)); return *(const float* const __attribute__((address_space(4)))*)(ka + 8 * i); }
enum { A_XP = 0, A_XS, A_CK, A_CV, A_ST, A_CP, A_CS, A_WADA, A_BADA, A_GFFN1, A_WGU1, A_WD1, A_GMIX, A_WIN, A_LAM, A_GSUB, A_LBL, A_GHG, A_WBA, A_WBH, A_WOUT, A_GFFN2, A_WGU2, A_WD2, A_GFIN, A_OUT, A_WS };
__device__ __forceinline__ void p0_prologue(Frame& F, unsigned char* ws) {
    { LAS float* scr = (LAS float*)(F.lds + RING_OFF + F.wave * 16384);
      const int gw = F.vcu * NWAVES + F.wave, NGW = F.G * NWAVES;
      constexpr int I_GU = 16 * 176, I_D = 44 * 32, I_IN = 16 * 288, I_SQ = 16 * 32, I_LAYER = 2 * I_GU + 2 * I_D + I_IN + 3 * I_SQ;
      for (int it = gw; it < DEPTH * I_LAYER; it += NGW) {
          const int l = it / I_LAYER; int r = it % I_LAYER; unsigned char* wl = ws + WS_W + (size_t)l * W_LAYER;
          if (r < I_GU) { p0_transpose_item(karg(A_WGU1) + (size_t)l * 1024 * 5632, 1024, 5632, (bf16*)(wl + WO_GU1), true, scr, r, F.lane); continue; } r -= I_GU;
          if (r < I_D)  { p0_transpose_item(karg(A_WD1) + (size_t)l * 2816 * 1024, 2816, 1024, (bf16*)(wl + WO_D1), false, scr, r, F.lane); continue; } r -= I_D;
          if (r < I_IN) { p0_transpose_item(karg(A_WIN) + (size_t)l * 1024 * 9216, 1024, 9216, (bf16*)(wl + WO_IN), false, scr, r, F.lane); continue; } r -= I_IN;
          if (r < I_SQ) { p0_transpose_item(karg(A_WBA) + (size_t)l * 1024 * 1024, 1024, 1024, (bf16*)(wl + WO_BA), false, scr, r, F.lane); continue; } r -= I_SQ;
          if (r < I_SQ) { p0_transpose_item(karg(A_WBH) + (size_t)l * 1024 * 1024, 1024, 1024, (bf16*)(wl + WO_BH), false, scr, r, F.lane); continue; } r -= I_SQ;
          if (r < I_SQ) { p0_transpose_item(karg(A_WOUT) + (size_t)l * 1024 * 1024, 1024, 1024, (bf16*)(wl + WO_OUT), false, scr, r, F.lane); continue; } r -= I_SQ;
          if (r < I_GU) { p0_transpose_item(karg(A_WGU2) + (size_t)l * 1024 * 5632, 1024, 5632, (bf16*)(wl + WO_GU2), true, scr, r, F.lane); continue; } r -= I_GU;
          p0_transpose_item(karg(A_WD2) + (size_t)l * 2816 * 1024, 2816, 1024, (bf16*)(wl + WO_D2), false, scr, r, F.lane);
      } }
    __syncthreads();
    { const float* c_p = karg(A_CP); const float* c_s = karg(A_CS); const float* w_ada = karg(A_WADA); const float* b_ada = karg(A_BADA);
      LAS float* ca = (LAS float*)(F.lds);
      LAS float* red = (LAS float*)(F.lds + 81920);
      for (int i = F.tid; i < NSEQ * 1024; i += NWAVES * 64) { const int s = i >> 10, k = i & 1023; const float c = s < 4 ? c_p[s * 1024 + k] : c_s[(s - 4) * 1024 + k]; ca[i] = pg8::silu_f(c); }
      __syncthreads();
      float* MOD = (float*)(ws + WS_MOD);
      for (int it = F.vcu; it < DEPTH * 144; it += F.G) {
          const int l = it / 144, n = (it % 144) * 64 + F.lane; const float* wp = w_ada + ((size_t)l * 1024 + F.wave * 128) * 9216 + n;
          float acc[NSEQ];
#pragma unroll
          for (int s = 0; s < NSEQ; ++s) acc[s] = 0.f;
#pragma unroll 4
          for (int k = 0; k < 128; ++k) { const float w = wp[(size_t)k * 9216];
#pragma unroll
              for (int s = 0; s < NSEQ; ++s) acc[s] += ca[s * 1024 + F.wave * 128 + k] * w; }
#pragma unroll
          for (int s = 0; s < NSEQ; ++s) red[(F.wave * NSEQ + s) * 64 + F.lane] = acc[s];
          __syncthreads();
          for (int i = F.tid; i < NSEQ * 64; i += NWAVES * 64) { const int s = i >> 6, c = i & 63; float v = 0.f;
#pragma unroll
              for (int w = 0; w < 8; ++w) v += red[(w * NSEQ + s) * 64 + c];
              const int nn = (it % 144) * 64 + c; MOD[((size_t)l * NSEQ + s) * 9216 + nn] = v + b_ada[(size_t)l * 9216 + nn]; }
          __syncthreads();
      } }
    if (F.vcu == 0) { float* LB = (float*)(ws + WS_LB); const float* lb_logits = karg(A_LBL);
        for (int c = F.tid; c < 1024; c += NWAVES * 64) { float lg[4], mx = -INFINITY;
#pragma unroll
            for (int l = 0; l < 4; ++l) { lg[l] = lb_logits[l * 1024 + c]; mx = __builtin_fmaxf(mx, lg[l]); }
            float sum = 0.f;
#pragma unroll
            for (int l = 0; l < 4; ++l) { lg[l] = __expf(lg[l] - mx); sum += lg[l]; }
            const float inv = 1.f / sum; float cs = 0.f;
#pragma unroll
            for (int l = 0; l < 4; ++l) { cs += lg[l] * inv; LB[l * 1024 + c] = cs - lg[0] * inv; } } }
}

__device__ __forceinline__ void norm_phase(Frame& F, const float* X, const float* g, const float* mod_l, int sub, bf16* XN, int row0, int row1, int gw, int NGW) {
    const int RW = (row1 - row0) / NGW, rbeg = row0 + gw * RW;
    const float* mp = mod_l + (size_t)pg8::row_seq(rbeg) * 9216 + sub * 3 * 1024;
    f32x4 av[4], bv[4];
#pragma unroll
    for (int j = 0; j < 4; ++j) { const int c = 4 * F.lane + 256 * j; const f32x4 gg = *(const f32x4*)(g + c), sc = *(const f32x4*)(mp + 1024 + c); bv[j] = *(const f32x4*)(mp + c); av[j] = gg * (sc + 1.f); }
    for (int i = 0; i < RW; i += 2) {
        const int row = rbeg + i;
        const float* src = X + (size_t)row * DM;
        const f32x4* xr = (const f32x4*)src + F.lane; f32x4 v[2][4]; float s2[2] = {0.f, 0.f};
#pragma unroll
        for (int u = 0; u < 2; ++u)
#pragma unroll
            for (int j = 0; j < 4; ++j) v[u][j] = xr[u * 256 + 64 * j];
#pragma unroll
        for (int u = 0; u < 2; ++u)
#pragma unroll
            for (int j = 0; j < 4; ++j) s2[u] += (v[u][j].x * v[u][j].x + v[u][j].y * v[u][j].y) + (v[u][j].z * v[u][j].z + v[u][j].w * v[u][j].w);
#pragma unroll
        for (int u = 0; u < 2; ++u) { const float rstd = __builtin_amdgcn_rsqf(wave_sum(s2[u], F.lane) * (1.f / DM) + EPS);
            v2u* o8 = (v2u*)(XN + (size_t)(row + u) * DM) + F.lane;
#pragma unroll
            for (int j = 0; j < 4; ++j) { const f32x4 h = (v[u][j] * rstd) * av[j] + bv[j]; v2u o; o.x = cvtpk(h.x, h.y); o.y = cvtpk(h.z, h.w); o8[64 * j] = o; } }
    }
}
__device__ __forceinline__ void final_norm_phase(Frame& F, const float* X, const float* g, float* out) {
    const int gw = F.vcu * NWAVES + F.wave, NGW = F.G * NWAVES;
    for (int row = gw; row < MROWS; row += NGW) {
        const f32x4* xr = (const f32x4*)(X + (size_t)row * DM) + F.lane; f32x4 v[4]; float s2 = 0.f;
#pragma unroll
        for (int j = 0; j < 4; ++j) { v[j] = xr[64 * j]; s2 += (v[j].x * v[j].x + v[j].y * v[j].y) + (v[j].z * v[j].z + v[j].w * v[j].w); }
        const float rstd = __builtin_amdgcn_rsqf(wave_sum(s2, F.lane) * (1.f / DM) + EPS);
        f32x4* o = (f32x4*)(out + (row < MP ? OY_P + (size_t)row * DM : OY_S + (size_t)(row - MP) * DM)) + F.lane;
#pragma unroll
        for (int j = 0; j < 4; ++j) { const f32x4 gg = *(const f32x4*)(g + 4 * F.lane + 256 * j); o[64 * j] = (v[j] * rstd) * gg; }
    }
}
__device__ __forceinline__ float lam_of(const float* att_lambda, int l, int lane) {
    const float* lp = att_lambda + (size_t)l * 256;
    const float a = wave_sum(lp[lane] * lp[64 + lane], lane), b = wave_sum(lp[128 + lane] * lp[192 + lane], lane);
    return __expf(a) - __expf(b) + lam_init_of(l);
}
__device__ __forceinline__ void attn_combine_phase(Frame& F, const bf16* O1, const bf16* O2, const float* gsub, float lam, float osc, bf16* OATT) {
    const int gw = F.vcu * NWAVES + F.wave, NGW = F.G * NWAVES; const int cl = (F.lane & 7) * 16;
    float gv[16];
#pragma unroll
    for (int i = 0; i < 16; ++i) gv[i] = gsub[cl + i] * osc;
    for (int row = gw; row < MP; row += 2 * NGW) {
        v4u a0[2], a1[2], b0[2], b1[2];
#pragma unroll
        for (int u = 0; u < 2; ++u) { const size_t off = (size_t)(row + u * NGW) * DM + F.lane * 16; a0[u] = *(const v4u*)(O1 + off); a1[u] = *(const v4u*)(O1 + off + 8); b0[u] = *(const v4u*)(O2 + off); b1[u] = *(const v4u*)(O2 + off + 8); }
#pragma unroll
        for (int u = 0; u < 2; ++u) { const size_t off = (size_t)(row + u * NGW) * DM + F.lane * 16;
            const unsigned aw[8] = {a0[u].x, a0[u].y, a0[u].z, a0[u].w, a1[u].x, a1[u].y, a1[u].z, a1[u].w}, bw[8] = {b0[u].x, b0[u].y, b0[u].z, b0[u].w, b1[u].x, b1[u].y, b1[u].z, b1[u].w};
            float o[16]; float ss = 0.f;
#pragma unroll
            for (int i = 0; i < 8; ++i) { o[2 * i] = pg8::bf_lo(aw[i]) - lam * pg8::bf_lo(bw[i]); o[2 * i + 1] = pg8::bf_hi(aw[i]) - lam * pg8::bf_hi(bw[i]); ss += o[2 * i] * o[2 * i] + o[2 * i + 1] * o[2 * i + 1]; }
            ss += shx(ss, 1, F.lane); ss += shx(ss, 2, F.lane); ss += shx(ss, 4, F.lane);
            const float rstd = __builtin_amdgcn_rsqf(ss * (1.f / 128.f) + EPS);
            v4u w0, w1;
            w0.x = cvtpk(o[0] * rstd * gv[0], o[1] * rstd * gv[1]); w0.y = cvtpk(o[2] * rstd * gv[2], o[3] * rstd * gv[3]); w0.z = cvtpk(o[4] * rstd * gv[4], o[5] * rstd * gv[5]); w0.w = cvtpk(o[6] * rstd * gv[6], o[7] * rstd * gv[7]);
            w1.x = cvtpk(o[8] * rstd * gv[8], o[9] * rstd * gv[9]); w1.y = cvtpk(o[10] * rstd * gv[10], o[11] * rstd * gv[11]); w1.z = cvtpk(o[12] * rstd * gv[12], o[13] * rstd * gv[13]); w1.w = cvtpk(o[14] * rstd * gv[14], o[15] * rstd * gv[15]);
            *(v4u*)(OATT + off) = w0; *(v4u*)(OATT + off + 8) = w1; }
    }
}

__device__ __forceinline__ void attn_sample_unit(Frame& F, const float* cache_k, const float* cache_v, int l, int s, int head, const bf16* Qb, const bf16* Kb, const bf16* Vb, float lam, float osc, const float* gsub, bf16* OATT) {
    const int lane = F.lane, w = F.wave, q = lane & 31, hh = lane >> 5, vt = w & 3, kh = w >> 2;
    LAS float* SLOT = (LAS float*)(F.lds);
    LAS float* ML = (LAS float*)(F.lds + 16384);
    LAS float* SSQ = (LAS float*)(F.lds + 16384 + 512);
    const size_t qrow = (size_t)MP + (size_t)s * 32;
    const float* ck = cache_k + ((size_t)(l * 16 + s) * PAST) * 1024 + head * 128;
    const float* cv = cache_v + ((size_t)(l * 16 + s) * PAST) * 1024 + head * 128;
    f32x16 o1;
#pragma unroll
    for (int r = 0; r < 16; ++r) o1[r] = 0.f;
    for (int m = 0; m < 2; ++m) {
        bf16x8 qf[4];
#pragma unroll
        for (int ks = 0; ks < 4; ++ks) qf[ks] = *(const bf16x8*)(Qb + (qrow + q) * 1024 + head * 128 + m * 64 + ks * 16 + 8 * hh);
        float mrun = -INFINITY, lrun = 0.f; f32x16 ot;
#pragma unroll
        for (int r = 0; r < 16; ++r) ot[r] = 0.f;
        const int ntile = 32 + kh;
        f32x4 kraw[8]; float vraw[16];
#define SA_ISSUE(tt) do { const int k0_ = kh * 1024 + (tt) * 32; const float* kp = ck + (size_t)(k0_ + q) * 1024 + m * 64 + 8 * hh; const float* vp = cv + (size_t)(k0_ + 4 * hh) * 1024 + 32 * vt + q; \
            _Pragma("unroll") for (int ks = 0; ks < 4; ++ks) { kraw[2 * ks] = *(const f32x4*)(kp + ks * 16); kraw[2 * ks + 1] = *(const f32x4*)(kp + ks * 16 + 4); } \
            _Pragma("unroll") for (int s2 = 0; s2 < 2; ++s2) _Pragma("unroll") for (int j = 0; j < 8; ++j) vraw[s2 * 8 + j] = vp[(16 * s2 + 8 * (j >> 2) + (j & 3)) * 1024]; } while (0)
        SA_ISSUE(0);
        for (int t = 0; t < ntile; ++t) {
            const bool nw = (t == 32);
            bf16x8 kf[4]; bf16x8 awv[2];
            if (!nw) {
#pragma unroll
                for (int ks = 0; ks < 4; ++ks) kf[ks] = pack8(kraw[2 * ks], kraw[2 * ks + 1]);
#pragma unroll
                for (int s2 = 0; s2 < 2; ++s2) { v4u aw; aw.x = cvtpk(vraw[s2 * 8 + 0], vraw[s2 * 8 + 1]); aw.y = cvtpk(vraw[s2 * 8 + 2], vraw[s2 * 8 + 3]); aw.z = cvtpk(vraw[s2 * 8 + 4], vraw[s2 * 8 + 5]); aw.w = cvtpk(vraw[s2 * 8 + 6], vraw[s2 * 8 + 7]); awv[s2] = __builtin_bit_cast(bf16x8, aw); }
                asm volatile("" ::: "memory");
                if (t + 1 < 32) SA_ISSUE(t + 1);
                asm volatile("" ::: "memory");
            } else {
#pragma unroll
                for (int ks = 0; ks < 4; ++ks) kf[ks] = *(const bf16x8*)(Kb + (qrow + q) * 1024 + head * 128 + m * 64 + ks * 16 + 8 * hh);
                const bf16* vpn = Vb + (qrow + 4 * hh) * 1024 + head * 128 + 32 * vt + q;
#pragma unroll
                for (int s2 = 0; s2 < 2; ++s2) { float vf[8];
#pragma unroll
                    for (int j = 0; j < 8; ++j) vf[j] = bf2f(vpn[(16 * s2 + 8 * (j >> 2) + (j & 3)) * 1024]);
                    v4u aw; aw.x = cvtpk(vf[0], vf[1]); aw.y = cvtpk(vf[2], vf[3]); aw.z = cvtpk(vf[4], vf[5]); aw.w = cvtpk(vf[6], vf[7]); awv[s2] = __builtin_bit_cast(bf16x8, aw); }
            }
            f32x16 st;
#pragma unroll
            for (int r = 0; r < 16; ++r) st[r] = 0.f;
#pragma unroll
            for (int ks = 0; ks < 4; ++ks) st = __builtin_amdgcn_mfma_f32_32x32x16_bf16(kf[ks], qf[ks], st, 0, 0, 0);
            float tm = st[0];
#pragma unroll
            for (int r = 1; r < 16; ++r) tm = __builtin_fmaxf(tm, st[r]);
            tm = __builtin_fmaxf(tm, shx(tm, 32, lane));
            const float mnew = __builtin_fmaxf(mrun, tm), alpha = __builtin_amdgcn_exp2f(mrun - mnew);
            float ls = 0.f;
#pragma unroll
            for (int r = 0; r < 16; ++r) { st[r] = __builtin_amdgcn_exp2f(st[r] - mnew); ls += st[r]; }
            ls += shx(ls, 32, lane);
            lrun = lrun * alpha + ls; mrun = mnew;
#pragma unroll
            for (int r = 0; r < 16; ++r) ot[r] *= alpha;
#pragma unroll
            for (int s2 = 0; s2 < 2; ++s2) { v4u pw; pw.x = cvtpk(st[8 * s2], st[8 * s2 + 1]); pw.y = cvtpk(st[8 * s2 + 2], st[8 * s2 + 3]); pw.z = cvtpk(st[8 * s2 + 4], st[8 * s2 + 5]); pw.w = cvtpk(st[8 * s2 + 6], st[8 * s2 + 7]);
                ot = __builtin_amdgcn_mfma_f32_32x32x16_bf16(awv[s2], __builtin_bit_cast(bf16x8, pw), ot, 0, 0, 0); }
        }
#undef SA_ISSUE
        if (vt == 0 && hh == 0) { ML[(kh * 32 + q) * 2] = mrun; ML[(kh * 32 + q) * 2 + 1] = lrun; }
        __syncthreads();
        const float m0 = ML[q * 2], l0 = ML[q * 2 + 1], m1 = ML[(32 + q) * 2], l1 = ML[(32 + q) * 2 + 1];
        const float Mx = __builtin_fmaxf(m0, m1), L = l0 * __builtin_amdgcn_exp2f(m0 - Mx) + l1 * __builtin_amdgcn_exp2f(m1 - Mx);
        { const float sc = __builtin_amdgcn_exp2f(mrun - Mx);
#pragma unroll
          for (int r = 0; r < 16; ++r) ot[r] *= sc; }
        if (kh == 1) {
#pragma unroll
            for (int r = 0; r < 16; ++r) SLOT[(vt * 16 + r) * 64 + lane] = ot[r]; }
        __syncthreads();
        if (kh == 0) { const float rl = 1.f / L;
#pragma unroll
            for (int r = 0; r < 16; ++r) ot[r] = (ot[r] + SLOT[(vt * 16 + r) * 64 + lane]) * rl;
            if (m == 0) {
#pragma unroll
                for (int r = 0; r < 16; ++r) o1[r] = ot[r];
            } else { float ss = 0.f;
#pragma unroll
                for (int r = 0; r < 16; ++r) { o1[r] = o1[r] - lam * ot[r]; ss += o1[r] * o1[r]; }
                ss += shx(ss, 32, lane);
                if (hh == 0) SSQ[vt * 32 + q] = ss; } }
        __syncthreads();
    }
    if (kh == 0) {
        const float ss = SSQ[q] + SSQ[32 + q] + SSQ[64 + q] + SSQ[96 + q];
        const float rstd = __builtin_amdgcn_rsqf(ss * (1.f / 128.f) + EPS) * osc;
#pragma unroll
        for (int r = 0; r < 16; ++r) { const int v = 32 * vt + (r & 3) + 8 * (r >> 2) + 4 * hh; OATT[(qrow + q) * 1024 + head * 128 + v] = (bf16)f2bf(o1[r] * rstd * gsub[v]); }
    }
    __syncthreads();
}

constexpr int HS = 72, HK = 136;
__device__ __forceinline__ f32x4 mfma16(bf16x8 a, bf16x8 b, f32x4 c) { return __builtin_amdgcn_mfma_f32_16x16x32_bf16(a, b, c, 0, 0, 0); }
__device__ __forceinline__ void st16bf(LAS bf16* p, const float (&v)[16]) {
    v4u a, b; a.x = cvtpk(v[0], v[1]); a.y = cvtpk(v[2], v[3]); a.z = cvtpk(v[4], v[5]); a.w = cvtpk(v[6], v[7]); b.x = cvtpk(v[8], v[9]); b.y = cvtpk(v[10], v[11]); b.z = cvtpk(v[12], v[13]); b.w = cvtpk(v[14], v[15]);
    *(LAS v4u*)p = a; *(LAS v4u*)(p + 8) = b;
}
__device__ __forceinline__ float bfu(unsigned b) { return __builtin_bit_cast(float, b << 16); }
struct HgPtrs { const float* LOGF; const bf16 *QQ, *KK, *VV, *HGS; const float* ghg; bf16* OH; bf16* dump; };
typedef float f32x2v __attribute__((ext_vector_type(2)));
__device__ __forceinline__ void hg_load(const HgPtrs& P, size_t ubase  , unsigned k0, int w, int nvalid, f32x2v (&lf)[8], unsigned (&qv)[8], unsigned (&kv)[8], unsigned (&vv)[8]) {
    if (w * 8 < nvalid) {
#pragma unroll
        for (int i = 0; i < 8; ++i) { const size_t o = ubase + (size_t)(w * 8 + i) * 1024;
            const float* lp = P.LOGF + o; const bf16* qp = P.QQ + o; const bf16* kp = P.KK + o; const bf16* vp = P.VV + o;
            lf[i] = *(const f32x2v*)(lp + k0); qv[i] = *(const unsigned*)(qp + k0); kv[i] = *(const unsigned*)(kp + k0); vv[i] = *(const unsigned*)(vp + k0); }
    } else {
#pragma unroll
        for (int i = 0; i < 8; ++i) { lf[i] = (f32x2v){0.f, 0.f}; qv[i] = 0u; kv[i] = 0u; vv[i] = 0u; }
    }
}
#define HG_BAR() asm volatile("s_waitcnt lgkmcnt(0)\n\ts_barrier" ::: "memory")
template <int MODE> __device__ __forceinline__ void hg_sequence(Frame& F, const HgPtrs& P, size_t row0, int h, int nchunk, int nvalid, const float* s_in, float* s_out, bf16* QS, float* RAW, float* dseg) {
    LAS float* seg = (LAS float*)(F.lds);
    LAS float* part = (LAS float*)(F.lds + 4096);
    LAS float* dvec = (LAS float*)(F.lds + 6144);
    LAS bf16* QH = (LAS bf16*)(F.lds + 8192);
    LAS bf16* QT = QH + 64 * HK;
    LAS bf16* KH = QT + 64 * HK;
    LAS bf16* VT = KH + 160 * HK;
    LAS bf16* KT = VT + 128 * HS;
    LAS bf16* AL = KT + 128 * HS;
    const int w = __builtin_amdgcn_readfirstlane(F.wave), sc = w >> 1, lr_ = F.lane & 15, lq_ = F.lane >> 4; const unsigned k0_ = 2u * (unsigned)F.lane;
    f32x4 S[8];
#pragma unroll
    for (int kb = 0; kb < 8; ++kb)
#pragma unroll
        for (int r = 0; r < 4; ++r) S[kb][r] = s_in ? s_in[(size_t)(16 * kb + 4 * lq_ + r) * 128 + 16 * w + lr_] : 0.f;
    const float gv = P.ghg[16 * w + lr_];
    f32x2v bseg = {0.f, 0.f};
    f32x2v lf[8]; unsigned qv[8], kv[8], vv[8];
    hg_load(P, row0 * 1024 + h * 128, k0_, w, nvalid, lf, qv, kv, vv);
    for (int c = 0; c < nchunk; ++c) {
        int lr = lr_, lq = lq_; unsigned k0 = k0_; asm volatile("" : "+v"(lr), "+v"(lq), "+v"(k0));
        const int lx = lq * 16 + lr;
        const size_t crow = row0 + (size_t)c * 64;
        f32x2v cs[8]; { f32x2v run = {0.f, 0.f};
#pragma unroll
            for (int i = 0; i < 8; ++i) { run = run + lf[i]; cs[i] = run; }
            *(LAS f32x2v*)(seg + w * 128 + k0) = run; }
        HG_BAR();
        f32x2v P2[4], mypre = {0.f, 0.f}, tot; { f32x2v p = {0.f, 0.f};
#pragma unroll
            for (int s = 0; s < 8; ++s) { if ((s & 1) == 0) P2[s >> 1] = p; mypre = (s == w) ? p : mypre; p = p + *(const LAS f32x2v*)(seg + s * 128 + k0); } tot = p; }
        f32x2v myref = P2[0], nref = P2[1];
#pragma unroll
        for (int s = 1; s < 4; ++s) { myref = (s == sc) ? P2[s] : myref; nref = (s == sc) ? (s == 3 ? tot : P2[s < 3 ? s + 1 : 3]) : nref; }
        const f32x2v dq = mypre - myref;
        f32x2v fq, fT, fK[4]; fq.x = __expf(myref.x); fq.y = __expf(myref.y); fT.x = __expf(tot.x - nref.x); fT.y = __expf(tot.y - nref.y);
#pragma unroll
        for (int ii = 1; ii < 4; ++ii) { fK[ii].x = __expf(__builtin_fminf(P2[ii].x - nref.x, 0.f)); fK[ii].y = __expf(__builtin_fminf(P2[ii].y - nref.y, 0.f)); }
        f32x2v fqs = fq; if constexpr (MODE == 1) { fqs.x = fq.x * __expf(bseg.x); fqs.y = fq.y * __expf(bseg.y); bseg = bseg + tot; }
        float t0[8], t1[8];
#pragma unroll
        for (int i = 0; i < 8; ++i) { const int r = w * 8 + i; const float q0 = bfu(qv[i] & 0xffffu), q1 = bfu(qv[i] >> 16), a0 = bfu(kv[i] & 0xffffu), a1 = bfu(kv[i] >> 16);
            const float E0 = dq.x + cs[i].x, E1 = dq.y + cs[i].y;
            const float e1x = __expf(E0), e1y = __expf(E1);
            const float e2x = __builtin_fminf(__builtin_amdgcn_rcpf(e1x), 5.5e34f), e2y = __builtin_fminf(__builtin_amdgcn_rcpf(e1y), 5.5e34f);
            const float e3x = __expf((nref.x - myref.x) - E0), e3y = __expf((nref.y - myref.y) - E1);
            *(LAS unsigned*)(QH + r * HK + k0) = cvtpk(q0 * e1x, q1 * e1y);
            *(LAS unsigned*)(QT + r * HK + k0) = cvtpk(q0 * e1x * fq.x, q1 * e1y * fq.y);
            if constexpr (MODE == 1) { bf16* qsp = QS + (crow + r) * 1024 + h * 128; *(unsigned*)(qsp + k0) = cvtpk(q0 * e1x * fqs.x, q1 * e1y * fqs.y); }
            const float b0 = a0 * e3x, b1 = a1 * e3y;
            { const int rb = (sc == 0) ? 0 : (sc == 1) ? 16 : (sc == 2) ? 48 : 96; *(LAS unsigned*)(KH + (rb + r) * HK + k0) = cvtpk(a0 * e2x, a1 * e2y); }
#pragma unroll
            for (int ii = 1; ii < 4; ++ii) if (ii > sc) { const int rb = (ii == 1) ? 16 : (ii == 2) ? 48 : 96; *(LAS unsigned*)(KH + (rb + r) * HK + k0) = cvtpk(b0 * fK[ii].x, b1 * fK[ii].y); }
            t0[i] = b0 * fT.x; t1[i] = b1 * fT.y; }
        { v4u u0, u1; u0.x = cvtpk(t0[0], t0[1]); u0.y = cvtpk(t0[2], t0[3]); u0.z = cvtpk(t0[4], t0[5]); u0.w = cvtpk(t0[6], t0[7]); u1.x = cvtpk(t1[0], t1[1]); u1.y = cvtpk(t1[2], t1[3]); u1.z = cvtpk(t1[4], t1[5]); u1.w = cvtpk(t1[6], t1[7]);
          *(LAS v4u*)(KT + k0 * HS + 8 * w) = u0; *(LAS v4u*)(KT + (k0 + 1) * HS + 8 * w) = u1; }
        { v4u u0, u1;
          u0.x = (vv[0] & 0xffffu) | (vv[1] << 16); u0.y = (vv[2] & 0xffffu) | (vv[3] << 16); u0.z = (vv[4] & 0xffffu) | (vv[5] << 16); u0.w = (vv[6] & 0xffffu) | (vv[7] << 16);
          u1.x = (vv[0] >> 16) | (vv[1] & 0xffff0000u); u1.y = (vv[2] >> 16) | (vv[3] & 0xffff0000u); u1.z = (vv[4] >> 16) | (vv[5] & 0xffff0000u); u1.w = (vv[6] >> 16) | (vv[7] & 0xffff0000u);
          *(LAS v4u*)(VT + k0 * HS + 8 * w) = u0; *(LAS v4u*)(VT + (k0 + 1) * HS + 8 * w) = u1;
          if (w == 0) { f32x2v d; d.x = __expf(tot.x); d.y = __expf(tot.y); *(LAS f32x2v*)(dvec + k0) = d; } }
        HG_BAR();
        if (c + 1 < nchunk) hg_load(P, (crow + 64) * 1024 + h * 128, k0, w, nvalid, lf, qv, kv, vv);
        unsigned short hgv[16];
        if constexpr (MODE == 0) { const bf16* hp = P.HGS + crow * 1024 + h * 128 + 16 * w;
#pragma unroll
          for (int mt = 0; mt < 4; ++mt)
#pragma unroll
              for (int r = 0; r < 4; ++r) { int t = 16 * mt + 4 * lq + r; t = t < nvalid ? t : nvalid - 1; hgv[mt * 4 + r] = hp[(unsigned)(t * 1024 + lr)]; } }
#pragma unroll
        for (int rr = 0; rr < 2; ++rr) { const int blk = w + 8 * rr, bi = blk >> 2, bj = blk & 3;
            f32x4 acc = {0.f, 0.f, 0.f, 0.f};
            if (bj <= bi) { const int rb = (bi == 0) ? 0 : (bi == 1) ? 16 : (bi == 2) ? 48 : 96;
#pragma unroll
                for (int ks = 0; ks < 4; ++ks) { const bf16x8 a = *(const LAS bf16x8*)(QH + (16 * bi + lr) * HK + ks * 32 + 8 * lq), b = *(const LAS bf16x8*)(KH + (rb + 16 * bj + lr) * HK + ks * 32 + 8 * lq); acc = mfma16(a, b, acc); }
                if (bi == bj) {
#pragma unroll
                    for (int r = 0; r < 4; ++r) acc[r] = (lr <= 4 * lq + r) ? acc[r] : 0.f; } }
#pragma unroll
            for (int r = 0; r < 4; ++r) AL[(16 * bi + 4 * lq + r) * HS + 16 * bj + lr] = (bf16)f2bf(acc[r]); }
        HG_BAR();
        f32x4 o[4];
        { bf16x8 bS[4], bV[2];
#pragma unroll
          for (int kp = 0; kp < 4; ++kp) { v4u t; t.x = cvtpk(S[2 * kp][0], S[2 * kp][1]); t.y = cvtpk(S[2 * kp][2], S[2 * kp][3]); t.z = cvtpk(S[2 * kp + 1][0], S[2 * kp + 1][1]); t.w = cvtpk(S[2 * kp + 1][2], S[2 * kp + 1][3]); bS[kp] = __builtin_bit_cast(bf16x8, t); }
#pragma unroll
          for (int ks = 0; ks < 2; ++ks) bV[ks] = *(const LAS bf16x8*)(VT + (16 * w + lr) * HS + ks * 32 + 8 * lq);
#pragma unroll
          for (int mt = 0; mt < 4; ++mt) { f32x4 acc = {0.f, 0.f, 0.f, 0.f};
#pragma unroll
              for (int kp = 0; kp < 4; ++kp) { const LAS bf16* qp = QT + (16 * mt + lr) * HK + 32 * kp + 4 * lq; const v2u a0 = *(const LAS v2u*)qp, a1 = *(const LAS v2u*)(qp + 16);
                  v4u a; a.x = a0.x; a.y = a0.y; a.z = a1.x; a.w = a1.y; acc = mfma16(__builtin_bit_cast(bf16x8, a), bS[kp], acc); }
#pragma unroll
              for (int ks = 0; ks < 2; ++ks) acc = mfma16(*(const LAS bf16x8*)(AL + (16 * mt + lr) * HS + ks * 32 + 8 * lq), bV[ks], acc);
              o[mt] = acc;
              if constexpr (MODE == 1) { float* rp = RAW + (crow + 16 * mt) * 1024 + h * 128 + 16 * w;
#pragma unroll
                  for (int r = 0; r < 4; ++r) rp[(unsigned)((4 * lq + r) * 1024 + lr)] = acc[r]; }
              if constexpr (MODE == 0)
#pragma unroll
              for (int r = 0; r < 4; ++r) { float p = acc[r] * acc[r]; p += shx(p, 1, lx); p += shx(p, 2, lx); p += shx(p, 4, lx); p += shx(p, 8, lx); if (lr == 0) part[(16 * mt + 4 * lq + r) * 8 + w] = p; } } }
        { bf16x8 bV[2];
#pragma unroll
          for (int ks = 0; ks < 2; ++ks) bV[ks] = *(const LAS bf16x8*)(VT + (16 * w + lr) * HS + ks * 32 + 8 * lq);
#pragma unroll
          for (int kb = 0; kb < 8; ++kb) { const f32x4 d = *(const LAS f32x4*)(dvec + 16 * kb + 4 * lq); f32x4 acc = S[kb] * d;
#pragma unroll
              for (int ks = 0; ks < 2; ++ks) acc = mfma16(*(const LAS bf16x8*)(KT + (16 * kb + lr) * HS + ks * 32 + 8 * lq), bV[ks], acc);
              S[kb] = acc; } }
        if constexpr (MODE == 0) {
        HG_BAR();
        { bf16* op = P.OH + crow * 1024 + h * 128 + 16 * w;
#pragma unroll
          for (int mt = 0; mt < 4; ++mt)
#pragma unroll
              for (int r = 0; r < 4; ++r) { const int t = 16 * mt + 4 * lq + r; const f32x4 p0 = *(const LAS f32x4*)(part + t * 8), p1 = *(const LAS f32x4*)(part + t * 8 + 4);
                  const float ss = ((p0[0] + p0[1]) + (p0[2] + p0[3])) + ((p1[0] + p1[1]) + (p1[2] + p1[3]));
                  const float rstd = __builtin_amdgcn_rsqf(ss * (1.f / 128.f) + EPS);
                  const bf16 ov = (bf16)f2bf(o[mt][r] * rstd * gv * bf2f(hgv[mt * 4 + r]));
                  bf16* dst = (t < nvalid) ? op + (unsigned)(t * 1024 + lr) : P.dump + F.tid;
                  *dst = ov; } }
        }
        HG_BAR();
    }
#pragma unroll
    for (int kb = 0; kb < 8; ++kb)
#pragma unroll
        for (int r = 0; r < 4; ++r) s_out[(size_t)(16 * kb + 4 * lq_ + r) * 128 + 16 * w + lr_] = S[kb][r];
    if constexpr (MODE == 1) { if (w == 0) { f32x2v d; d.x = __expf(bseg.x); d.y = __expf(bseg.y); *(f32x2v*)(dseg + k0_) = d; } }
}

__device__ __forceinline__ void hg_fix(Frame& F, const HgPtrs& P, size_t row0, int h, int nchunk, int g, int G, const float* SLseq, const float* DSseq, const bf16* QS, const float* RAW, gu32* mask, float* s_fin) {
    LAS float* part = (LAS float*)(F.lds);
    const int w = __builtin_amdgcn_readfirstlane(F.wave), lr_ = F.lane & 15, lq_ = F.lane >> 4;
    if (F.tid == 0) { const unsigned need = (1u << g) - 1u; unsigned sp = 0;
        while ((__hip_atomic_load(mask, RLX_AGENT) & need) != need) { __builtin_amdgcn_s_sleep(2); if (++sp > (1u << 22)) { __hip_atomic_store(F.ctl + 1, 0x7eb0u, RLX_AGENT); break; } }
        __builtin_amdgcn_fence(__ATOMIC_ACQUIRE, "agent"); asm volatile("s_waitcnt vmcnt(0)" ::: "memory"); }
    __syncthreads();
    f32x4 S[8];
#pragma unroll
    for (int kb = 0; kb < 8; ++kb) S[kb] = (f32x4){0.f, 0.f, 0.f, 0.f};
    for (int p = 0; p < g; ++p) { const float* sl = SLseq + (size_t)p * 16384; const float* ds = DSseq + p * 128;
#pragma unroll
        for (int kb = 0; kb < 8; ++kb) { const f32x4 d = *(const f32x4*)(ds + 16 * kb + 4 * lq_);
#pragma unroll
            for (int r = 0; r < 4; ++r) S[kb][r] = d[r] * S[kb][r] + sl[(size_t)(16 * kb + 4 * lq_ + r) * 128 + 16 * w + lr_]; } }
    if (g == G - 1) { const float* sl = SLseq + (size_t)g * 16384; const float* ds = DSseq + g * 128;
#pragma unroll
        for (int kb = 0; kb < 8; ++kb) { const f32x4 d = *(const f32x4*)(ds + 16 * kb + 4 * lq_);
#pragma unroll
            for (int r = 0; r < 4; ++r) { const size_t o = (size_t)(16 * kb + 4 * lq_ + r) * 128 + 16 * w + lr_; s_fin[o] = d[r] * S[kb][r] + sl[o]; } } }
    bf16x8 bS[4];
#pragma unroll
    for (int kp = 0; kp < 4; ++kp) { v4u t; t.x = cvtpk(S[2 * kp][0], S[2 * kp][1]); t.y = cvtpk(S[2 * kp][2], S[2 * kp][3]); t.z = cvtpk(S[2 * kp + 1][0], S[2 * kp + 1][1]); t.w = cvtpk(S[2 * kp + 1][2], S[2 * kp + 1][3]); bS[kp] = __builtin_bit_cast(bf16x8, t); }
    const float gv = P.ghg[16 * w + lr_];
    f32x4 on[4]; unsigned short hn[16]; v2u qn[4][4][2];
#define HGF_LOAD(cc) do { const size_t cr_ = row0 + (size_t)(cc) * 64; const bf16* hp = P.HGS + cr_ * 1024 + h * 128 + 16 * w; const float* rp = RAW + cr_ * 1024 + h * 128 + 16 * w; \
        _Pragma("unroll") for (int mt = 0; mt < 4; ++mt) { \
            _Pragma("unroll") for (int r = 0; r < 4; ++r) { const unsigned off = (unsigned)((16 * mt + 4 * lq_ + r) * 1024 + lr_); on[mt][r] = rp[off]; hn[mt * 4 + r] = hp[off]; } \
            const bf16* qb = QS + (cr_ + 16 * mt) * 1024 + h * 128; \
            _Pragma("unroll") for (int kp = 0; kp < 4; ++kp) { const bf16* qp = qb + (unsigned)(lr_ * 1024 + 32 * kp + 4 * lq_); qn[mt][kp][0] = *(const v2u*)qp; qn[mt][kp][1] = *(const v2u*)(qp + 16); } } } while (0)
    HGF_LOAD(0);
    for (int c = 0; c < nchunk; ++c) {
        int lr = lr_, lq = lq_; asm volatile("" : "+v"(lr), "+v"(lq)); const int lx = lq * 16 + lr;
        const size_t crow = row0 + (size_t)c * 64;
        LAS float* pt = part + (c & 1) * 512;
        f32x4 o[4]; unsigned short hgv[16];
#pragma unroll
        for (int mt = 0; mt < 4; ++mt) { f32x4 acc = on[mt];
#pragma unroll
            for (int r = 0; r < 4; ++r) hgv[mt * 4 + r] = hn[mt * 4 + r];
#pragma unroll
            for (int kp = 0; kp < 4; ++kp) { v4u a; a.x = qn[mt][kp][0].x; a.y = qn[mt][kp][0].y; a.z = qn[mt][kp][1].x; a.w = qn[mt][kp][1].y; acc = mfma16(__builtin_bit_cast(bf16x8, a), bS[kp], acc); }
            o[mt] = acc; }
        asm volatile("" ::: "memory");
        if (c + 1 < nchunk) HGF_LOAD(c + 1);
        asm volatile("" ::: "memory");
#pragma unroll
        for (int mt = 0; mt < 4; ++mt)
#pragma unroll
            for (int r = 0; r < 4; ++r) { float p = o[mt][r] * o[mt][r]; p += shx(p, 1, lx); p += shx(p, 2, lx); p += shx(p, 4, lx); p += shx(p, 8, lx); if (lr == 0) pt[(16 * mt + 4 * lq + r) * 8 + w] = p; }
        HG_BAR();
        { bf16* op = P.OH + crow * 1024 + h * 128 + 16 * w;
#pragma unroll
          for (int mt = 0; mt < 4; ++mt)
#pragma unroll
              for (int r = 0; r < 4; ++r) { const int t = 16 * mt + 4 * lq + r; const f32x4 p0 = *(const LAS f32x4*)(pt + t * 8), p1 = *(const LAS f32x4*)(pt + t * 8 + 4);
                  const float ss = ((p0[0] + p0[1]) + (p0[2] + p0[3])) + ((p1[0] + p1[1]) + (p1[2] + p1[3]));
                  const float rstd = __builtin_amdgcn_rsqf(ss * (1.f / 128.f) + EPS);
                  op[(unsigned)(t * 1024 + lr)] = (bf16)f2bf(o[mt][r] * rstd * gv * bf2f(hgv[mt * 4 + r])); } }
    }
#undef HGF_LOAD
    __syncthreads();
}
#undef HG_BAR
__device__ __forceinline__ void team_barrier(Frame& F, gu32* w, unsigned target) {
    asm volatile("s_waitcnt vmcnt(0)" ::: "memory");
    __syncthreads();
    if (F.tid == 0) {
        __builtin_amdgcn_fence(__ATOMIC_RELEASE, "agent");
        asm volatile("s_waitcnt vmcnt(0)" ::: "memory");
        (void)__hip_atomic_fetch_add(w, 1u, RLX_AGENT);
        unsigned sp = 0;
        while (__hip_atomic_load(w, RLX_AGENT) < target) { __builtin_amdgcn_s_sleep(2); if (++sp > (1u << 22)) { __hip_atomic_store(F.ctl + 1, 0x7ea0u, RLX_AGENT); break; } }
        __builtin_amdgcn_fence(__ATOMIC_ACQUIRE, "agent");
        asm volatile("s_waitcnt vmcnt(0)" ::: "memory");
    }
    __syncthreads();
}
__device__ __forceinline__ int attn_pull(Frame& F, gu32* q8  , int x0, int nitems) {
    if (F.tid == 0) {
        int res = -1;
        for (int tries = 0; tries < 16; ++tries) {
            unsigned c[8]; unsigned cmin = 0xffffffffu; int imin = 0;
#pragma unroll
            for (int h = 0; h < 8; ++h) { c[h] = __hip_atomic_load(q8 + 64 * h, RLX_AGENT); if (c[h] < cmin) { cmin = c[h]; imin = h; } }
            if (cmin >= (unsigned)nitems) break;
            unsigned cx = c[0];
#pragma unroll
            for (int h = 1; h < 8; ++h) cx = (h == x0) ? c[h] : cx;
            const int hsel = (cx < (unsigned)nitems && cx <= cmin + 6u) ? x0 : imin;
            const unsigned it = __hip_atomic_fetch_add(q8 + 64 * hsel, 1u, RLX_AGENT);
            if (it < (unsigned)nitems) { res = (hsel << 16) | (int)it; break; }
        }
        F.MISC[16] = (unsigned)res;
    }
    __syncthreads();
    const int v = (int)F.MISC[16];
    __syncthreads();
    return __builtin_amdgcn_readfirstlane(v);
}
__device__ __forceinline__ int wg_pull(Frame& F, gu32* ctr) {
    if (F.tid == 0) F.MISC[16] = __hip_atomic_fetch_add(ctr, 1u, RLX_AGENT);
    __syncthreads();
    const int v = (int)F.MISC[16];
    __syncthreads();
    return __builtin_amdgcn_readfirstlane(v);
}
#ifdef PROBE_ID
#define PT_BEGIN(id) unsigned long long pt0_##id = 0; if ((id) == PROBE_ID && blockIdx.x == 0) pt0_##id = __builtin_amdgcn_s_memrealtime()
#define PT_END(id) do { if ((id) == PROBE_ID && blockIdx.x == 0) { const unsigned long long t1 = __builtin_amdgcn_s_memrealtime(), d = t1 - pt0_##id; while (__builtin_amdgcn_s_memrealtime() - t1 < d) __builtin_amdgcn_s_sleep(8); } } while (0)
#else
#define PT_BEGIN(id) do {} while (0)
#define PT_END(id) do {} while (0)
#endif
struct Args { const float* in[25]; float* out; unsigned char* ws; };
__global__ void __launch_bounds__(NWAVES * 64, 2) mk_fwd(Args args) {
    extern __shared__ __attribute__((aligned(16))) unsigned char lds[];
    Frame F;
    F.lds = (LAS unsigned char*)lds;
    F.MISC = (volatile LAS unsigned*)(F.lds + MISC_OFF);
#define ENTER() do { F.tid = opaque_tid(); F.lane = F.tid & 63; F.wave = __builtin_amdgcn_readfirstlane(F.tid >> 6); F.G = gridDim.x; { const int bx = opaque_bid(); F.vcu = (F.G % 8 == 0) ? (bx % 8) * (F.G / 8) + bx / 8 : bx; } } while (0)
    for (int u = threadIdx.x; u < (LDS_BYTES - LDSCTL_OFF) / 4; u += NWAVES * 64) ((LAS unsigned*)(F.lds + LDSCTL_OFF))[u] = 0u;
    __syncthreads();
    tid_table_init();
    __syncthreads();
    static_assert(WTAB_LDS_ADDR == (unsigned)(MISC_OFF + 256) && MISC_OFF + 256 + 256 <= LDS_BYTES, "wave-slot table inside the LDS control area");
    ENTER();
    F.ctl = (gu32*)((unsigned char*)karg(A_WS) + WS_CTL);
    XcdBarrier bar = xcd_barrier_post((unsigned*)(F.ctl + CW_BAR), F.MISC + 8);
#define GRID_BAR() do { asm volatile("" : "+s"(bar.x)); xcd_barrier(bar); } while (0)
#define WSP(T, off) ((T*)((unsigned char*)karg(A_WS) + (off)))
#define OUTP(off) ((float*)karg(A_OUT) + (off))
#define XIN_P (l == 0 ? karg(A_XP) : WSP(const float, WS_X))
#define XIN_S (l == 0 ? karg(A_XS) - (size_t)MP * DM : WSP(const float, WS_X))

#ifndef NO_P0
    p0_prologue(F, WSP(unsigned char, 0));
#ifdef DUP_P0
    GRID_BAR(); ENTER(); p0_prologue(F, WSP(unsigned char, 0));
#endif
#endif
    GRID_BAR();

    for (int l = 0; l < DEPTH; ++l) {
        const size_t wlo = WS_W + (size_t)l * W_LAYER, modo = WS_MOD + (size_t)l * NSEQ * 9216 * 4;
        norm_phase(F, XIN_P, karg(A_GFFN1) + l * 1024, WSP(const float, modo), 0, WSP(bf16, WS_XN), 0, MP, F.vcu * NWAVES + F.wave, 256 * NWAVES);
#ifdef DUP_THIN
        GRID_BAR(); ENTER();
        norm_phase(F, XIN_P, karg(A_GFFN1) + l * 1024, WSP(const float, modo), 0, WSP(bf16, WS_XN), 0, MP, F.vcu * NWAVES + F.wave, 256 * NWAVES);
#endif
        GRID_BAR(); ENTER();
#ifndef NO_G1
        { pg8::Gemm g{WSP(bf16, WS_XN), WSP(const bf16, wlo + WO_GU1), MP, 2 * DFF, DM}; typedef pg8::FixedOrder<128, 22, 8> Ord; Ord S; S.init(F.G, opaque_bid());
          pg8::EpiSwiglu E{WSP(bf16, WS_BIG)};
          pg8::gemm_phase<pg8::EpiSwiglu, Ord, true, true>(F.lds + RING_OFF, g, S, E);
#ifdef DUP_G1
          GRID_BAR(); ENTER(); pg8::gemm_phase<pg8::EpiSwiglu, Ord, true, true>(F.lds + RING_OFF, g, S, E);
#endif
        }
#endif
        GRID_BAR(); ENTER();
#ifndef NO_G2
        { pg8::Gemm g{WSP(bf16, WS_BIG), WSP(const bf16, wlo + WO_D1), MP, DM, DFF}; typedef pg8::FixedOrder<128, 4, 8> Ord; Ord S; S.init(F.G, opaque_bid());
          pg8::EpiResid E{WSP(float, WS_X), WSP(const float, modo) + 2 * 1024, 0.5f, l == 0 ? 1 : 0};
          pg8::gemm_phase<pg8::EpiResid, Ord, true, true>(F.lds + RING_OFF, g, S, E);
#ifdef DUP_RES
          GRID_BAR(); ENTER(); { pg8::EpiResid E0{E.X, E.gate, 0.f, 0}; pg8::gemm_phase<pg8::EpiResid, Ord, true, true>(F.lds + RING_OFF, g, S, E0); }
#endif
        }
#endif
        GRID_BAR(); ENTER();
        norm_phase(F, WSP(const float, WS_X), karg(A_GMIX) + l * 1024, WSP(const float, modo), 1, WSP(bf16, WS_XN), 0, MP, F.vcu * NWAVES + F.wave, 256 * NWAVES);
#ifdef DUP_THIN
        GRID_BAR(); ENTER();
        norm_phase(F, WSP(const float, WS_X), karg(A_GMIX) + l * 1024, WSP(const float, modo), 1, WSP(bf16, WS_XN), 0, MP, F.vcu * NWAVES + F.wave, 256 * NWAVES);
#endif
        GRID_BAR(); ENTER();
        PT_BEGIN(2);
#ifndef NO_G3
        { pg8::Gemm g{WSP(bf16, WS_XN), WSP(const bf16, wlo + WO_IN), MP, DIN, DM}; typedef pg8::FixedOrder<128, 36, 8> Ord; Ord S; S.init(F.G, opaque_bid());
          pg8::EpiWin E{WSP(unsigned char, 0), OUTP(0), l, attn_body::C2};
          pg8::gemm_phase<pg8::EpiWin, Ord, true, true>(F.lds + RING_OFF, g, S, E);
#ifdef PROBE_G3NULL
          GRID_BAR(); ENTER(); PT_BEGIN(3); { float* sk_ = nullptr; asm volatile("" : "+s"(sk_)); pg8::EpiNull E0{sk_}; pg8::gemm_phase<pg8::EpiNull, Ord, true, true>(F.lds + RING_OFF, g, S, E0); } GRID_BAR(); ENTER(); PT_END(3);
#endif
        }
#endif
        GRID_BAR(); ENTER();
        PT_END(2);
        PT_BEGIN(1);
        { gu32* qbase = F.ctl + CW_Q + 64 * (l * 16);
          const int tk = wg_pull(F, qbase + 64 * 9);
#ifdef PROBE_ROLE
          const unsigned long long pr0 = __builtin_amdgcn_s_memrealtime();
#endif
          constexpr int T_EFF = T_TEAM;
          const bool team = (tk % TEAM_STRIDE) == 0, hfirst = (tk % TEAM_STRIDE) >= 1 && (tk % TEAM_STRIDE) <= STARTERS; const int ticket = tk / TEAM_STRIDE; gu32* tb = qbase + 64 * 10; unsigned tstage = 0;
#define TEAM_BAR() do { ++tstage; team_barrier(F, tb, (unsigned)T_EFF * tstage); ENTER(); } while (0)
#ifndef NO_TEAM
          if (team) {
              const int tgw = ticket * NWAVES + F.wave, TNW = T_EFF * NWAVES;
              norm_phase(F, XIN_S, karg(A_GFFN1) + l * 1024, WSP(const float, modo), 0, WSP(bf16, WS_XN), MP, MROWS, tgw, TNW);
              TEAM_BAR();
              { pg8::Gemm g{WSP(bf16, WS_XN), WSP(const bf16, wlo + WO_GU1), MROWS, 2 * DFF, DM}; typedef pg8::TeamOrder<22> Ord; Ord S; S.init(T_EFF, ticket);
                pg8::EpiSwiglu E{WSP(bf16, WS_BIG)};
                pg8::gemm_phase<pg8::EpiSwiglu, Ord, true, true>(F.lds + RING_OFF, g, S, E); }
              TEAM_BAR();
              { pg8::Gemm g{WSP(bf16, WS_BIG), WSP(const bf16, wlo + WO_D1), MROWS, DM, DFF}; typedef pg8::TeamOrder<4> Ord; Ord S; S.init(T_EFF, ticket);
                pg8::EpiResid E{WSP(float, WS_X), WSP(const float, modo) + 2 * 1024, 0.5f, l == 0 ? 2 : 0};
                pg8::gemm_phase<pg8::EpiResid, Ord, true, true>(F.lds + RING_OFF, g, S, E); }
              TEAM_BAR();
              norm_phase(F, WSP(const float, WS_X), karg(A_GMIX) + l * 1024, WSP(const float, modo), 1, WSP(bf16, WS_XN), MP, MROWS, ticket * NWAVES + F.wave, T_EFF * NWAVES);
              TEAM_BAR();
              { pg8::Gemm g{WSP(bf16, WS_XN), WSP(const bf16, wlo + WO_IN), MROWS, DIN, DM}; typedef pg8::TeamOrder<36> Ord; Ord S; S.init(T_EFF, ticket);
                pg8::EpiWin E{WSP(unsigned char, 0), OUTP(0), l, attn_body::C2};
                pg8::gemm_phase<pg8::EpiWin, Ord, true, true>(F.lds + RING_OFF, g, S, E); }
              TEAM_BAR();
          }
#endif
          if (hfirst) {
            for (;;) { const int it = wg_pull(F, qbase); if (it >= 32 * HG_G) break;
              const HgPtrs P{WSP(const float, WS_LOGF), WSP(const bf16, WS_QQ), WSP(const bf16, WS_KK), WSP(const bf16, WS_VV), WSP(const bf16, WS_HGS), karg(A_GHG) + l * 128, WSP(bf16, WS_OH), WSP(bf16, WS_DD)};
#ifndef NO_H
                  const int sqh = it / HG_G, g = it % HG_G, b = sqh >> 3, h = sqh & 7; const int nch = 128 / HG_G;
                  const size_t r0 = (size_t)b * 8192 + (size_t)g * nch * 64;
                  float* SLq = WSP(float, WS_SL) + (size_t)sqh * HG_G * 16384; float* DSq = WSP(float, WS_DSEG) + (size_t)sqh * HG_G * 128;
                  gu32* mask = F.ctl + CW_HS + 64 * (l * 32 + sqh);
                  hg_sequence<1>(F, P, r0, h, nch, 64, nullptr, SLq + (size_t)g * 16384, WSP(bf16, WS_QS), WSP(float, WS_RAW), DSq + g * 128);
                  asm volatile("s_waitcnt vmcnt(0)" ::: "memory"); __syncthreads();
                  if (F.tid == 0) { __builtin_amdgcn_fence(__ATOMIC_RELEASE, "agent"); asm volatile("s_waitcnt vmcnt(0)" ::: "memory"); (void)__hip_atomic_fetch_or(mask, 1u << g, RLX_AGENT); }
                  ENTER();
                  hg_fix(F, P, r0, h, nch, g, HG_G, SLq, DSq, WSP(const bf16, WS_QS), WSP(const float, WS_RAW), mask, OUTP(0) + OS_P + ((size_t)((l * 4 + b) * 8 + h)) * 16384);
                  ENTER();
#endif
            }
            if (F.tid == 0) { unsigned sp = 0; while (__hip_atomic_load(tb, RLX_AGENT) < (unsigned)T_EFF * 5u) { __builtin_amdgcn_s_sleep(2); if (++sp > (1u << 22)) { __hip_atomic_store(F.ctl + 1, 0x7ec0u, RLX_AGENT); break; } }
                __builtin_amdgcn_fence(__ATOMIC_ACQUIRE, "agent"); asm volatile("s_waitcnt vmcnt(0)" ::: "memory"); }
            __syncthreads(); ENTER();
          }
          if (team || hfirst) {
            gu32* qs = qbase + 64 * 11; gu32* done = qbase + 64 * 12;
            for (;;) { const int it = wg_pull(F, qs); if (it >= 256) break;
              const HgPtrs P{WSP(const float, WS_LOGF), WSP(const bf16, WS_QQ), WSP(const bf16, WS_KK), WSP(const bf16, WS_VV), WSP(const bf16, WS_HGS), karg(A_GHG) + l * 128, WSP(bf16, WS_OH), WSP(bf16, WS_DD)};
              if (it < 128) {
#ifndef NO_H
                  const int sq = it >> 3, h = it & 7; const size_t so = OS_S + ((size_t)((l * 16 + sq) * 8 + h)) * 16384;
                  hg_sequence<0>(F, P, (size_t)MP + (size_t)sq * 32, h, 1, 32, karg(A_ST) + ((size_t)((l * 16 + sq) * 8 + h)) * 16384, OUTP(0) + so, nullptr, nullptr, nullptr);
#endif
              } else {
#ifndef NO_SAMP
                  const int u = it - 128; const float lam = lam_of(karg(A_LAM), l, F.lane), osc = 1.f - lam_init_of(l);
                  attn_sample_unit(F, karg(A_CK), karg(A_CV), l, u >> 3, u & 7, WSP(const bf16, WS_Q), WSP(const bf16, WS_K), WSP(const bf16, WS_V), lam, osc, karg(A_GSUB) + l * 128, WSP(bf16, WS_OATT));
#endif
              }
              asm volatile("s_waitcnt vmcnt(0)" ::: "memory"); __syncthreads();
              if (F.tid == 0) { __builtin_amdgcn_fence(__ATOMIC_RELEASE, "agent"); asm volatile("s_waitcnt vmcnt(0)" ::: "memory"); (void)__hip_atomic_fetch_add(done, 1u, RLX_AGENT); }
              ENTER(); }
            if (team) {
                if (F.tid == 0) { unsigned sp = 0; while (__hip_atomic_load(done, RLX_AGENT) < 256u) { __builtin_amdgcn_s_sleep(2); if (++sp > (1u << 22)) { __hip_atomic_store(F.ctl + 1, 0x7ed0u, RLX_AGENT); break; } }
                    __builtin_amdgcn_fence(__ATOMIC_ACQUIRE, "agent"); asm volatile("s_waitcnt vmcnt(0)" ::: "memory"); }
                __syncthreads(); ENTER(); } }
#ifndef NO_TEAM
          if (team) {
              { pg8::Gemm g{WSP(bf16, WS_OATT), WSP(const bf16, wlo + WO_BA), MROWS, DM, DM}; typedef pg8::TeamOrder<4> Ord; Ord S; S.init(T_EFF, ticket);
                pg8::EpiGateT E{WSP(bf16, WS_LOGF), WSP(const bf16, WS_SZA)};
                pg8::gemm_phase<pg8::EpiGateT, Ord, true, true>(F.lds + RING_OFF, g, S, E); }
              TEAM_BAR();
              { pg8::Gemm g{WSP(bf16, WS_OH), WSP(const bf16, wlo + WO_BH), MROWS, DM, DM}; typedef pg8::TeamOrder<4> Ord; Ord S; S.init(T_EFF, ticket);
                pg8::EpiGateM E{WSP(const bf16, WS_LOGF), WSP(const bf16, WS_SZH), WSP(bf16, WS_MRG)};
                pg8::gemm_phase<pg8::EpiGateM, Ord, true, true>(F.lds + RING_OFF, g, S, E); }
              TEAM_BAR();
              { pg8::Gemm g{WSP(bf16, WS_MRG), WSP(const bf16, wlo + WO_OUT), MROWS, DM, DM}; typedef pg8::TeamOrder<4> Ord; Ord S; S.init(T_EFF, ticket);
                pg8::EpiResid E{WSP(float, WS_X), WSP(const float, modo) + 5 * 1024, 1.0f, 0};
                pg8::gemm_phase<pg8::EpiResid, Ord, true, true>(F.lds + RING_OFF, g, S, E); }
              TEAM_BAR();
              norm_phase(F, WSP(const float, WS_X), karg(A_GFFN2) + l * 1024, WSP(const float, modo), 2, WSP(bf16, WS_XN), MP, MROWS, ticket * NWAVES + F.wave, T_EFF * NWAVES);
              TEAM_BAR();
              { pg8::Gemm g{WSP(bf16, WS_XN), WSP(const bf16, wlo + WO_GU2), MROWS, 2 * DFF, DM}; typedef pg8::TeamOrder<22> Ord; Ord S; S.init(T_EFF, ticket);
                pg8::EpiSwiglu E{WSP(bf16, WS_BIG)};
                pg8::gemm_phase<pg8::EpiSwiglu, Ord, true, true>(F.lds + RING_OFF, g, S, E); }
              TEAM_BAR();
              { pg8::Gemm g{WSP(bf16, WS_BIG), WSP(const bf16, wlo + WO_D2), MROWS, DM, DFF}; typedef pg8::TeamOrder<4> Ord; Ord S; S.init(T_EFF, ticket);
                pg8::EpiResid E{WSP(float, WS_X), WSP(const float, modo) + 8 * 1024, 0.5f, 0};
                pg8::gemm_phase<pg8::EpiResid, Ord, true, true>(F.lds + RING_OFF, g, S, E); }
              ENTER();
          }
#endif
#ifndef NO_ATT
          { const attn_body::bf16* Qb = WSP(const attn_body::bf16, WS_Q); const attn_body::bf16* Kb = WSP(const attn_body::bf16, WS_K); const attn_body::bf16* Vb = WSP(const attn_body::bf16, WS_V); attn_body::bf16* O1 = WSP(attn_body::bf16, WS_O1);
            const int x0 = (int)(xb_xcc_id() & 7u);
            for (;;) { const int pk = attn_pull(F, qbase + 64, x0, 256); if (pk < 0) break;
                const int head = pk >> 16, it = pk & 0xffff, b = it >> 6, r = it & 63, qb = 31 - (r >> 1), mp = r & 1;
                attn_body::attn_unit128<8>(b, head * 2 + mp, head * 2, qb, Qb, Kb, Vb, O1 + (size_t)mp * ((WS_O2 - WS_O1) / 2), (char*)lds + RING_OFF); } }
#endif
#undef TEAM_BAR
#ifdef PROBE_ROLE
          if (tk == PROBE_ROLE) { const unsigned long long t1 = __builtin_amdgcn_s_memrealtime(), d = t1 - pr0; while (__builtin_amdgcn_s_memrealtime() - t1 < d) __builtin_amdgcn_s_sleep(8); }
#endif
        }
        GRID_BAR(); ENTER();
        PT_END(1);
        { const float lam = lam_of(karg(A_LAM), l, F.lane), osc = 1.f - lam_init_of(l);
          attn_combine_phase(F, WSP(const bf16, WS_O1), WSP(const bf16, WS_O2), karg(A_GSUB) + l * 128, lam, osc, WSP(bf16, WS_OATT));
#ifdef DUP_THIN
          GRID_BAR(); ENTER();
          attn_combine_phase(F, WSP(const bf16, WS_O1), WSP(const bf16, WS_O2), karg(A_GSUB) + l * 128, lam, osc, WSP(bf16, WS_OATT));
#endif
        }
        GRID_BAR(); ENTER();
#ifndef NO_G4
        { pg8::Gemm g{WSP(bf16, WS_OATT), WSP(const bf16, wlo + WO_BA), MP, DM, DM}; typedef pg8::FixedOrder<128, 4, 8> Ord; Ord S; S.init(F.G, opaque_bid());
          pg8::EpiGateT E{WSP(bf16, WS_LOGF), WSP(const bf16, WS_SZA)};
          pg8::gemm_phase<pg8::EpiGateT, Ord, true, true>(F.lds + RING_OFF, g, S, E);
#ifdef DUP_THIN
          GRID_BAR(); ENTER(); pg8::gemm_phase<pg8::EpiGateT, Ord, true, true>(F.lds + RING_OFF, g, S, E);
#endif
        }
#endif
        GRID_BAR(); ENTER();
#ifndef NO_G5
        { pg8::Gemm g{WSP(bf16, WS_OH), WSP(const bf16, wlo + WO_BH), MP, DM, DM}; typedef pg8::FixedOrder<128, 4, 8> Ord; Ord S; S.init(F.G, opaque_bid());
          pg8::EpiGateM E{WSP(const bf16, WS_LOGF), WSP(const bf16, WS_SZH), WSP(bf16, WS_MRG)};
          pg8::gemm_phase<pg8::EpiGateM, Ord, true, true>(F.lds + RING_OFF, g, S, E);
#ifdef DUP_THIN
          GRID_BAR(); ENTER(); pg8::gemm_phase<pg8::EpiGateM, Ord, true, true>(F.lds + RING_OFF, g, S, E);
#endif
        }
#endif
        GRID_BAR(); ENTER();
#ifndef NO_G6
        { pg8::Gemm g{WSP(bf16, WS_MRG), WSP(const bf16, wlo + WO_OUT), MP, DM, DM}; typedef pg8::FixedOrder<128, 4, 8> Ord; Ord S; S.init(F.G, opaque_bid());
          pg8::EpiResid E{WSP(float, WS_X), WSP(const float, modo) + 5 * 1024, 1.0f, 0};
          pg8::gemm_phase<pg8::EpiResid, Ord, true, true>(F.lds + RING_OFF, g, S, E);
#ifdef DUP_RES
          GRID_BAR(); ENTER(); { pg8::EpiResid E0{E.X, E.gate, 0.f, 0}; pg8::gemm_phase<pg8::EpiResid, Ord, true, true>(F.lds + RING_OFF, g, S, E0); }
#endif
        }
#endif
        GRID_BAR(); ENTER();
        norm_phase(F, WSP(const float, WS_X), karg(A_GFFN2) + l * 1024, WSP(const float, modo), 2, WSP(bf16, WS_XN), 0, MP, F.vcu * NWAVES + F.wave, 256 * NWAVES);
#ifdef DUP_THIN
        GRID_BAR(); ENTER();
        norm_phase(F, WSP(const float, WS_X), karg(A_GFFN2) + l * 1024, WSP(const float, modo), 2, WSP(bf16, WS_XN), 0, MP, F.vcu * NWAVES + F.wave, 256 * NWAVES);
#endif
        GRID_BAR(); ENTER();
#ifndef NO_G7
        { pg8::Gemm g{WSP(bf16, WS_XN), WSP(const bf16, wlo + WO_GU2), MP, 2 * DFF, DM}; typedef pg8::FixedOrder<128, 22, 8> Ord; Ord S; S.init(F.G, opaque_bid());
          pg8::EpiSwiglu E{WSP(bf16, WS_BIG)};
          pg8::gemm_phase<pg8::EpiSwiglu, Ord, true, true>(F.lds + RING_OFF, g, S, E); }
#endif
        GRID_BAR(); ENTER();
#ifndef NO_G8
        { pg8::Gemm g{WSP(bf16, WS_BIG), WSP(const bf16, wlo + WO_D2), MP, DM, DFF}; typedef pg8::FixedOrder<128, 4, 8> Ord; Ord S; S.init(F.G, opaque_bid());
          pg8::EpiResid E{WSP(float, WS_X), WSP(const float, modo) + 8 * 1024, 0.5f, 0};
          pg8::gemm_phase<pg8::EpiResid, Ord, true, true>(F.lds + RING_OFF, g, S, E);
#ifdef DUP_RES
          GRID_BAR(); ENTER(); { pg8::EpiResid E0{E.X, E.gate, 0.f, 0}; pg8::gemm_phase<pg8::EpiResid, Ord, true, true>(F.lds + RING_OFF, g, S, E0); }
#endif
        }
#endif
        GRID_BAR(); ENTER();
    }
    final_norm_phase(F, WSP(const float, WS_X), karg(A_GFIN), OUTP(0));
#undef GRID_BAR
#undef ENTER
#undef WSP
#undef OUTP
}

extern "C" void kernel_launch(void* const* d_in, const int* in_sizes, int n_in, void* d_out, int out_size, void* d_ws, size_t ws_size, hipStream_t stream) {
    static int grid = 0;
    if (grid == 0) {
        if (n_in != 25 || (size_t)out_size != OUT_TOTAL || ws_size < WS_END) { fprintf(stderr, "kernel_launch: unexpected sizes: n_in %d out %d ws %zu (need %zu)\n", n_in, out_size, ws_size, (size_t)WS_END); grid = -1; return; }
        int dev = 0, cus = 0, per_cu = 0;
        if (hipGetDevice(&dev) != hipSuccess || hipDeviceGetAttribute(&cus, hipDeviceAttributeMultiprocessorCount, dev) != hipSuccess) { grid = -1; return; }
        if (hipFuncSetAttribute((const void*)mk_fwd, hipFuncAttributeMaxDynamicSharedMemorySize, LDS_BYTES) != hipSuccess) { fprintf(stderr, "kernel_launch: hipFuncSetAttribute failed\n"); grid = -1; return; }
        if (hipOccupancyMaxActiveBlocksPerMultiprocessor(&per_cu, (const void*)mk_fwd, NWAVES * 64, LDS_BYTES) != hipSuccess || per_cu < 1) { fprintf(stderr, "kernel_launch: occupancy query reports %d\n", per_cu); }
        (void)hipGetLastError();
        grid = cus;
        if (grid != 256) { fprintf(stderr, "kernel_launch: built for a 256-CU device (team size, row split and work queues assume 256 workgroups); found %d CUs; nothing launched\n", cus); grid = -1; return; }
    }
    if (grid < 0) return;
    if (hipMemsetAsync((char*)d_ws + WS_CTL, 0, CTL_ZERO_BYTES, stream) != hipSuccess) return;
    Args a{};
    for (int i = 0; i < 25; ++i) a.in[i] = (const float*)d_in[i];
    a.out = (float*)d_out; a.ws = (unsigned char*)d_ws;
    hipLaunchKernelGGL(mk_fwd, dim3(grid), dim3(NWAVES * 64), LDS_BYTES, stream, a);
    (void)in_sizes;
}
```

```cpp
#include <hip/hip_runtime.h>
#include <hip/hip_bf16.h>
#include <cstdio>
#include <cstdint>
#include <cmath>
constexpr unsigned WTAB_LDS_ADDR = 139264u + 320u + 256u;
__device__ __forceinline__ unsigned hw_wave_slot() { return (unsigned)__builtin_amdgcn_s_getreg((6 << 11) | 4) & 0x3fu; }
__device__ __forceinline__ void tid_table_init() { ((volatile __attribute__((address_space(3))) unsigned*)(size_t)WTAB_LDS_ADDR)[hw_wave_slot()] = threadIdx.x >> 6; }
__device__ __forceinline__ int opaque_tid() { const unsigned w = ((volatile __attribute__((address_space(3))) unsigned*)(size_t)WTAB_LDS_ADDR)[hw_wave_slot()];
    unsigned ln; asm volatile("v_mbcnt_lo_u32_b32 %0, -1, 0\n\tv_mbcnt_hi_u32_b32 %0, -1, %0" : "=v"(ln));
    return (int)((w << 6) | ln); }
__device__ __forceinline__ int opaque_bid() { int b = (int)blockIdx.x; asm volatile("" : "+s"(b)); return b; }
namespace pg8 {
#define PG8_LAS __attribute__((address_space(3)))
typedef unsigned short bf16_t;
typedef short bf16x8 __attribute__((ext_vector_type(8)));
typedef float f32x4 __attribute__((ext_vector_type(4)));
typedef unsigned u32x4 __attribute__((ext_vector_type(4)));
constexpr int BM = 256, BK = 64, HALF = 128, HTB = HALF * BK * 2  , STAGE_BYTES = 8 * HTB, NXCD = 8, WGM = 8;

__host__ __device__ __forceinline__ int lds_byte(int r, int c) { const int st = (r >> 4) * 2 + (c >> 5), rr = r & 15, cc = c & 31, ob = rr * 64 + cc * 2; return st * 1024 + (ob ^ (((ob >> 9) & 1) << 5)); }
__host__ __device__ __forceinline__ void stage_rc(int b, int& R, int& C) { const int st = b / 1024, sb = b % 1024, swz = sb ^ (((sb >> 9) & 1) << 5); R = (st >> 1) * 16 + swz / 64; C = (st & 1) * 32 + (swz % 64) / 2; }
__host__ __device__ __forceinline__ int perm32(int rho) { const int n = rho >> 4, i = rho & 15; return 8 * (i >> 2) + 4 * n + (i & 3); }

struct Unit { int pm, pn; };
struct Gemm { const bf16_t* A; const bf16_t* Bt; int M, N, K; };

struct StaticOrder {
    int nM, nN, nwg, G, c;
    __host__ __device__ void init(int M, int N, int G_, int c_) { nM = M / BM; nN = N / BM; nwg = nM * nN; G = G_; c = c_; }
    __host__ __device__ bool next(int i, Unit& u) const {
        const long L = (long)i * G + c; if (L >= nwg) return false;
        int wgid = (int)L; { const int q = nwg / NXCD, r = nwg % NXCD, xcd = wgid % NXCD, off = wgid / NXCD; wgid = (xcd < r ? xcd * (q + 1) : r * (q + 1) + (xcd - r) * q) + off; }
        const int nig = WGM * nN, gid = wgid / nig, fm = gid * WGM, gsz = (nM - fm) < WGM ? (nM - fm) : WGM;
        u.pm = fm + ((wgid % nig) % gsz); u.pn = (wgid % nig) / gsz; return true;
    }
    __device__ __forceinline__ void a_ready(const Unit&) const {}
    __device__ __forceinline__ void done(const Unit&) const {}
};

__device__ __forceinline__ unsigned cvt_pk_bf16(float lo, float hi) { unsigned r; asm volatile("v_cvt_pk_bf16_f32 %0, %1, %2" : "=v"(r) : "v"(lo), "v"(hi)); return r; }
__device__ __forceinline__ float bf_lo(unsigned w) { return __builtin_bit_cast(float, w << 16); }
__device__ __forceinline__ float bf_hi(unsigned w) { return __builtin_bit_cast(float, w & 0xffff0000u); }
__device__ __forceinline__ float sigmoid_f(float x) { return __builtin_amdgcn_rcpf(1.f + __expf(-x)); }
__device__ __forceinline__ float silu_f(float x) { return x * sigmoid_f(x); }
__device__ __forceinline__ void store8bf(bf16_t* p, f32x4 a, f32x4 b) { u32x4 w; w.x = cvt_pk_bf16(a[0], a[1]); w.y = cvt_pk_bf16(a[2], a[3]); w.z = cvt_pk_bf16(b[0], b[1]); w.w = cvt_pk_bf16(b[2], b[3]); *(u32x4*)p = w; }
__device__ __forceinline__ int row_seq(int row) { return row < 32768 ? (row >> 13) : 4 + ((row - 32768) >> 5); }

struct EpiSwiglu {
    static constexpr bool PERM = true, AFTER_DRAIN = false;
    bf16_t* O;
    __device__ __forceinline__ void operator()(const f32x4 (&acc)[2][2][4][2], const Unit& u, int wr, int wc, int fr, int fq) const {
        const int row0 = u.pm * BM + wr * 64 + fr, col0 = u.pn * HALF + wc * 32 + 8 * fq;
#pragma unroll
        for (int ai = 0; ai < 2; ++ai)
#pragma unroll
            for (int m = 0; m < 4; ++m) {
                f32x4 g0 = acc[ai][0][m][0], g1 = acc[ai][0][m][1]; const f32x4 u0 = acc[ai][1][m][0], u1 = acc[ai][1][m][1];
#pragma unroll
                for (int i = 0; i < 4; ++i) { g0[i] = silu_f(g0[i]) * u0[i]; g1[i] = silu_f(g1[i]) * u1[i]; }
                store8bf(O + (size_t)(row0 + ai * HALF + m * 16) * 2816 + col0, g0, g1); asm volatile("" ::: "memory");
            }
    }
};

struct EpiResid {
    static constexpr bool PERM = true, AFTER_DRAIN = false;
    float* X; const float* gate; float coef; int xsel;
    __device__ __forceinline__ void operator()(const f32x4 (&acc)[2][2][4][2], const Unit& u, int wr, int wc, int fr, int fq) const {
        const float* Xin = X;
        if (xsel) { const __attribute__((address_space(4))) char* ka = (const __attribute__((address_space(4))) char*)__builtin_amdgcn_kernarg_segment_ptr(); asm volatile("" : "+s"(ka));
            Xin = (xsel == 1) ? *(const float* const __attribute__((address_space(4)))*)(ka) : *(const float* const __attribute__((address_space(4)))*)(ka + 8) - (size_t)32768 * 1024; }
        if (u.pm < 128) {
            const float* gp = gate + (size_t)(u.pm >> 5) * 9216 + u.pn * BM + wc * 32 + 8 * fq;
            f32x4 gv[2][2];
#pragma unroll
            for (int bj = 0; bj < 2; ++bj)
#pragma unroll
                for (int n = 0; n < 2; ++n) gv[bj][n] = *(const f32x4*)(gp + bj * HALF + 4 * n) * coef;
            float* xb = X + (size_t)(u.pm * BM + wr * 64 + fr) * 1024 + u.pn * BM + wc * 32 + 8 * fq;
            const float* xi = Xin + (size_t)(u.pm * BM + wr * 64 + fr) * 1024 + u.pn * BM + wc * 32 + 8 * fq;
            f32x4 xc[2][2], xn[2][2];
#pragma unroll
            for (int bj = 0; bj < 2; ++bj)
#pragma unroll
                for (int n = 0; n < 2; ++n) xc[bj][n] = *(const f32x4*)(xi + bj * HALF + 4 * n);
#pragma unroll
            for (int g = 0; g < 8; ++g) { const int ai = g >> 2, m = g & 3; float* xr = xb + (size_t)(ai * HALF + m * 16) * 1024;
                if (g + 1 < 8) { const float* xq = xi + (size_t)(((g + 1) >> 2) * HALF + ((g + 1) & 3) * 16) * 1024;
#pragma unroll
                    for (int bj = 0; bj < 2; ++bj)
#pragma unroll
                        for (int n = 0; n < 2; ++n) xn[bj][n] = *(const f32x4*)(xq + bj * HALF + 4 * n); }
#pragma unroll
                for (int bj = 0; bj < 2; ++bj)
#pragma unroll
                    for (int n = 0; n < 2; ++n) *(f32x4*)(xr + bj * HALF + 4 * n) = xc[bj][n] + gv[bj][n] * acc[ai][bj][m][n];
                asm volatile("" ::: "memory");
#pragma unroll
                for (int bj = 0; bj < 2; ++bj)
#pragma unroll
                    for (int n = 0; n < 2; ++n) xc[bj][n] = xn[bj][n]; }
        } else {
#pragma unroll
        for (int ai = 0; ai < 2; ++ai)
#pragma unroll
            for (int m = 0; m < 4; ++m) {
                const int row = u.pm * BM + ai * HALF + wr * 64 + m * 16 + fr; const float* gp = gate + (size_t)row_seq(row) * 9216;
#pragma unroll
                for (int bj = 0; bj < 2; ++bj) { const int col = u.pn * BM + bj * HALF + wc * 32 + 8 * fq;
#pragma unroll
                    for (int n = 0; n < 2; ++n) { const f32x4 g = *(const f32x4*)(gp + col + 4 * n); f32x4* xp = (f32x4*)(X + (size_t)row * 1024 + col + 4 * n); const f32x4 xv = *(const f32x4*)(Xin + (size_t)row * 1024 + col + 4 * n); *xp = xv + (g * coef) * acc[ai][bj][m][n]; } asm volatile("" ::: "memory"); }
            }
        }
    }
};

struct EpiWin {
    static constexpr bool PERM = true, AFTER_DRAIN = false;
    unsigned char* ws; float* out; int l; float qscale;
    static constexpr size_t MiB_ = 1u << 20;
    static constexpr size_t O_Q = 435 * MiB_, O_K = 500 * MiB_, O_V = 565 * MiB_, O_QQ = 630 * MiB_, O_KK = 695 * MiB_, O_VV = 760 * MiB_, O_HGS = 825 * MiB_, O_SZA = 890 * MiB_, O_SZH = 955 * MiB_, O_LOGF = 1020 * MiB_, O_LB = 4 * MiB_;
    static constexpr size_t OK_P_ = 34078720, OV_P_ = 168296448, OK_S_ = 304611328, OV_S_ = 306708480;
    __device__ __forceinline__ void operator()(const f32x4 (&acc)[2][2][4][2], const Unit& u, int wr, int wc, int fr, int fq) const {
        const int seg = u.pn >> 2, cb = (u.pn & 3) * BM + wc * 32 + 8 * fq, row0 = u.pm * BM + wr * 64 + fr;
        const size_t boff = seg == 0 ? O_Q : seg == 1 ? O_K : seg == 2 ? O_V : seg == 3 ? O_QQ : seg == 4 ? O_KK : seg == 5 ? O_VV : seg == 6 ? O_HGS : seg == 7 ? O_SZA : O_SZH;
        bf16_t* const O = (bf16_t*)(ws + boff) + (size_t)row0 * 1024 + cb;
        float* F32 = nullptr;
        if (seg == 1 || seg == 2) { const size_t ob = (u.pm < 128) ? (seg == 1 ? OK_P_ : OV_P_) + (size_t)l * 32768 * 1024 + (size_t)(u.pm * BM) * 1024 : (seg == 1 ? OK_S_ : OV_S_) + (size_t)l * 512 * 1024 + (size_t)((u.pm - 128) * BM) * 1024;
            F32 = out + ob + (size_t)(wr * 64 + fr) * 1024 + cb; }
        else if (seg == 4) F32 = (float*)(ws + O_LOGF) + (size_t)row0 * 1024 + cb;
        const float* const lb = (const float*)(ws + O_LB) + l * 1024 + cb;
        const float sc = seg == 0 ? qscale : 1.f;
        f32x4 lbv[2][2]; { const f32x4 z = {0.f, 0.f, 0.f, 0.f}; lbv[0][0] = z; lbv[0][1] = z; lbv[1][0] = z; lbv[1][1] = z; }
        if (seg == 4) { lbv[0][0] = *(const f32x4*)(lb); lbv[0][1] = *(const f32x4*)(lb + 4); lbv[1][0] = *(const f32x4*)(lb + HALF); lbv[1][1] = *(const f32x4*)(lb + HALF + 4); }
#pragma unroll
        for (int ai = 0; ai < 2; ++ai) {
#pragma unroll
            for (int m = 0; m < 4; ++m)
#pragma unroll
                for (int bj = 0; bj < 2; ++bj) { const size_t off = (size_t)(ai * HALF + m * 16) * 1024 + bj * HALF; const f32x4 l0 = lbv[bj][0], l1 = lbv[bj][1];
                    f32x4 a = acc[ai][bj][m][0], b = acc[ai][bj][m][1];
                    if (seg == 4) { f32x4 fa, fb;
#pragma unroll
                        for (int i = 0; i < 4; ++i) {
                            { const float x = a[i], lbv = l0[i], e = __expf(-__builtin_fabsf(x)), r = __builtin_amdgcn_rcpf(1.f + e), er = e * r, sig = x >= 0.f ? r : er, om = x >= 0.f ? er : r;
                              fa[i] = __logf(__builtin_fmaxf(lbv + (1.f - lbv) * sig, 1e-30f)); a[i] = (1.f - lbv) * om; }
                            { const float x = b[i], lbv = l1[i], e = __expf(-__builtin_fabsf(x)), r = __builtin_amdgcn_rcpf(1.f + e), er = e * r, sig = x >= 0.f ? r : er, om = x >= 0.f ? er : r;
                              fb[i] = __logf(__builtin_fmaxf(lbv + (1.f - lbv) * sig, 1e-30f)); b[i] = (1.f - lbv) * om; } }
                        *(f32x4*)(F32 + off) = fa; *(f32x4*)(F32 + off + 4) = fb;
                    } else if (seg == 3 || seg == 6) {
#pragma unroll
                        for (int i = 0; i < 4; ++i) { a[i] = silu_f(a[i]); b[i] = silu_f(b[i]); }
                    } else if (seg >= 7) {
#pragma unroll
                        for (int i = 0; i < 4; ++i) { a[i] = sigmoid_f(a[i]); b[i] = sigmoid_f(b[i]); }
                    } else {
                        if (seg == 1 || seg == 2) { *(f32x4*)(F32 + off) = a; *(f32x4*)(F32 + off + 4) = b; }
                        a = a * sc; b = b * sc;
                    }
                    store8bf(O + off, a, b); asm volatile("" ::: "memory"); }
        }
    }
};

struct EpiGateT {
    static constexpr bool PERM = true, AFTER_DRAIN = false;
    bf16_t* T; const bf16_t* G;
    __device__ __forceinline__ void operator()(const f32x4 (&acc)[2][2][4][2], const Unit& u, int wr, int wc, int fr, int fq) const {
        const size_t base = (size_t)(u.pm * BM + wr * 64 + fr) * 1024 + u.pn * BM + wc * 32 + 8 * fq;
        u32x4 gc[2], gn[2];
#pragma unroll
        for (int bj = 0; bj < 2; ++bj) gc[bj] = *(const u32x4*)(G + base + bj * HALF);
#pragma unroll
        for (int g = 0; g < 8; ++g) { const int ai = g >> 2, m = g & 3; const size_t off = base + (size_t)(ai * HALF + m * 16) * 1024;
            if (g + 1 < 8) { const size_t offn = base + (size_t)(((g + 1) >> 2) * HALF + ((g + 1) & 3) * 16) * 1024;
#pragma unroll
                for (int bj = 0; bj < 2; ++bj) gn[bj] = *(const u32x4*)(G + offn + bj * HALF); }
#pragma unroll
            for (int bj = 0; bj < 2; ++bj) { const u32x4 gg = gc[bj];
                const f32x4 g0 = {bf_lo(gg.x), bf_hi(gg.x), bf_lo(gg.y), bf_hi(gg.y)}, g1 = {bf_lo(gg.z), bf_hi(gg.z), bf_lo(gg.w), bf_hi(gg.w)};
                store8bf(T + off + bj * HALF, g0 * acc[ai][bj][m][0], g1 * acc[ai][bj][m][1]); }
            asm volatile("" ::: "memory");
#pragma unroll
            for (int bj = 0; bj < 2; ++bj) gc[bj] = gn[bj]; }
    }
};
struct EpiGateM {
    static constexpr bool PERM = true, AFTER_DRAIN = false;
    const bf16_t* T; const bf16_t* G; bf16_t* O;
    __device__ __forceinline__ void operator()(const f32x4 (&acc)[2][2][4][2], const Unit& u, int wr, int wc, int fr, int fq) const {
        const size_t base = (size_t)(u.pm * BM + wr * 64 + fr) * 1024 + u.pn * BM + wc * 32 + 8 * fq;
        u32x4 gc[2], gn[2], tc[2], tn[2];
#pragma unroll
        for (int bj = 0; bj < 2; ++bj) { gc[bj] = *(const u32x4*)(G + base + bj * HALF); tc[bj] = *(const u32x4*)(T + base + bj * HALF); }
#pragma unroll
        for (int g = 0; g < 8; ++g) { const int ai = g >> 2, m = g & 3; const size_t off = base + (size_t)(ai * HALF + m * 16) * 1024;
            if (g + 1 < 8) { const size_t offn = base + (size_t)(((g + 1) >> 2) * HALF + ((g + 1) & 3) * 16) * 1024;
#pragma unroll
                for (int bj = 0; bj < 2; ++bj) { gn[bj] = *(const u32x4*)(G + offn + bj * HALF); tn[bj] = *(const u32x4*)(T + offn + bj * HALF); } }
#pragma unroll
            for (int bj = 0; bj < 2; ++bj) { const u32x4 gg = gc[bj];
                const f32x4 g0 = {bf_lo(gg.x), bf_hi(gg.x), bf_lo(gg.y), bf_hi(gg.y)}, g1 = {bf_lo(gg.z), bf_hi(gg.z), bf_lo(gg.w), bf_hi(gg.w)};
                const u32x4 tt = tc[bj]; const f32x4 t0 = {bf_lo(tt.x), bf_hi(tt.x), bf_lo(tt.y), bf_hi(tt.y)}, t1 = {bf_lo(tt.z), bf_hi(tt.z), bf_lo(tt.w), bf_hi(tt.w)};
                store8bf(O + off + bj * HALF, t0 + g0 * acc[ai][bj][m][0], t1 + g1 * acc[ai][bj][m][1]); }
            asm volatile("" ::: "memory");
#pragma unroll
            for (int bj = 0; bj < 2; ++bj) { gc[bj] = gn[bj]; tc[bj] = tn[bj]; } }
    }
};

struct EpiNull {
    static constexpr bool PERM = true, AFTER_DRAIN = false; float* sink;
    __device__ __forceinline__ void operator()(const f32x4 (&acc)[2][2][4][2], const Unit& u, int wr, int wc, int fr, int fq) const { f32x4 s = {0.f, 0.f, 0.f, 0.f};
#pragma unroll
        for (int a = 0; a < 2; ++a)
#pragma unroll
            for (int b = 0; b < 2; ++b)
#pragma unroll
                for (int m = 0; m < 4; ++m)
#pragma unroll
                    for (int n = 0; n < 2; ++n) s = s + acc[a][b][m][n];
        if (sink) sink[0] = s[0] + s[1] + s[2] + s[3]; (void)u; (void)wr; (void)wc; (void)fr; (void)fq; }
};

template <int NM, int NN, int GM> struct FixedOrder {
    static_assert(NM % GM == 0, "GM divides NM");
    int G, c;
    __device__ __forceinline__ void init(int G_, int c_) { G = G_; c = c_; }
    __device__ __forceinline__ bool next(int i, Unit& u) const {
        constexpr int nwg = NM * NN, q = nwg / NXCD, r = nwg % NXCD, nig = GM * NN;
        const int L = i * G + c; if (L >= nwg) return false;
        const int xcd = L % NXCD, off = L / NXCD; const int wgid = (xcd < r ? xcd * (q + 1) : r * (q + 1) + (xcd - r) * q) + off;
        const int gid = wgid / nig, w = wgid % nig; u.pm = gid * GM + (w % GM); u.pn = w / GM; return true;
    }
    __device__ __forceinline__ void a_ready(const Unit&) const {}
    __device__ __forceinline__ void done(const Unit&) const {}
};

template <int NN> struct TeamOrder {
    int T, r;
    __device__ __forceinline__ void init(int T_, int r_) { T = T_; r = r_; }
    __device__ __forceinline__ bool next(int i, Unit& u) const { const int L = i * T + r; if (L >= 2 * NN) return false; u.pm = 128 + L / NN; u.pn = L % NN; return true; }
    __device__ __forceinline__ void a_ready(const Unit&) const {}
    __device__ __forceinline__ void done(const Unit&) const {}
};
template <class Epi, class Sched, bool ALIGN_EPI = false, bool SP2 = false>
__device__ __forceinline__ void gemm_phase(PG8_LAS unsigned char* lds, const Gemm g, const Sched& S, const Epi& E) {
    const int tid = opaque_tid(), wid = __builtin_amdgcn_readfirstlane(tid >> 6), lane = tid & 63, wr = wid >> 2, wc = wid & 3, fr = lane & 15, fq = lane >> 4;
    const int K = g.K, nt = K / BK;
    unsigned voffA[2], voffB[2];
#pragma unroll
    for (int i = 0; i < 2; ++i) { int R, C; stage_rc(tid * 16 + i * 8192, R, C); const int Rb = Epi::PERM ? ((R & ~31) + perm32(R & 31)) : R;
        voffA[i] = (unsigned)(R * K + C) * 2u; voffB[i] = (unsigned)(Rb * K + C) * 2u; }
    const size_t kstep = (size_t)(BK * 2);
    const size_t hstep = (size_t)HALF * K * 2;
    const size_t tstep = 2 * hstep;
    const unsigned ldsw = (unsigned)wid * 1024u;
    const int aoff = lds_byte(wr * 64 + fr, fq * 8), boff = lds_byte(wc * 32 + fr, fq * 8);
#define PG8_SA(b, h) (((b) * 2 + (h)) * HTB)
#define PG8_SB(b, h) ((4 + (b) * 2 + (h)) * HTB)
#define PG8_STAGE(bufoff, gbase, voff) do { _Pragma("unroll") for (int _i = 0; _i < 2; ++_i) \
        __builtin_amdgcn_global_load_lds((const unsigned*)((const char*)(gbase) + (voff)[_i]), (PG8_LAS unsigned*)(lds + (bufoff) + ldsw + _i * 8192), 16, 0, 0); } while (0)
#define PG8_LDA(dst, b, h) do { _Pragma("unroll") for (int m = 0; m < 4; ++m) _Pragma("unroll") for (int k = 0; k < 2; ++k) dst[m][k] = *(const PG8_LAS bf16x8*)(lds + PG8_SA(b, h) + aoff + m * 2048 + k * 1024); } while (0)
#define PG8_LDB(dst, b, h) do { _Pragma("unroll") for (int n = 0; n < 2; ++n) _Pragma("unroll") for (int k = 0; k < 2; ++k) dst[n][k] = *(const PG8_LAS bf16x8*)(lds + PG8_SB(b, h) + boff + n * 2048 + k * 1024); } while (0)
#define PG8_MMA(ai, bj, At, Bt) do { __builtin_amdgcn_s_setprio(1); _Pragma("unroll") for (int m = 0; m < 4; ++m) _Pragma("unroll") for (int n = 0; n < 2; ++n) _Pragma("unroll") for (int k = 0; k < 2; ++k) \
        acc[ai][bj][m][n] = __builtin_amdgcn_mfma_f32_16x16x32_bf16(Bt[n][k], At[m][k], acc[ai][bj][m][n], 0, 0, 0); __builtin_amdgcn_s_setprio(0); } while (0)
#define PG8_WAIT_V(n) asm volatile("s_waitcnt vmcnt(" #n ")" ::: "memory")
#define PG8_WAIT_L(n) asm volatile("s_waitcnt lgkmcnt(" #n ")" ::: "memory")
#define PG8_BAR __builtin_amdgcn_s_barrier()
#define PG8_SCHED __builtin_amdgcn_sched_barrier(0)
    Unit cur, nxt; int ui = 0;
    if (!S.next(0, cur)) return;
    f32x4 acc[2][2][4][2];
#pragma unroll
    for (int a = 0; a < 2; ++a)
#pragma unroll
        for (int b = 0; b < 2; ++b)
#pragma unroll
            for (int m = 0; m < 4; ++m)
#pragma unroll
                for (int n = 0; n < 2; ++n) acc[a][b][m][n] = (f32x4){0.f, 0.f, 0.f, 0.f};
    bf16x8 At[4][2], B0[2][2], B1[2][2];
    const char* cA = (const char*)g.A + (size_t)cur.pm * tstep; const char* cB = (const char*)g.Bt + (size_t)cur.pn * tstep;
    S.a_ready(cur);
    if constexpr (SP2) {
        PG8_STAGE(PG8_SB(0, 0), cB, voffB); PG8_STAGE(PG8_SB(0, 1), cB + hstep, voffB); PG8_STAGE(PG8_SA(0, 0), cA, voffA); PG8_STAGE(PG8_SA(0, 1), cA + hstep, voffA);
        if (wr == 1) PG8_BAR;
        PG8_WAIT_V(2); PG8_BAR;
        PG8_STAGE(PG8_SB(1, 0), cB + kstep, voffB); PG8_STAGE(PG8_SA(1, 0), cA + kstep, voffA); PG8_STAGE(PG8_SB(1, 1), cB + hstep + kstep, voffB);
        PG8_WAIT_V(6); PG8_BAR;
    } else {
        PG8_STAGE(PG8_SB(0, 0), cB, voffB); PG8_STAGE(PG8_SA(0, 0), cA, voffA); PG8_STAGE(PG8_SB(0, 1), cB + hstep, voffB); PG8_STAGE(PG8_SA(0, 1), cA + hstep, voffA);
        if (wr == 1) PG8_BAR;
        PG8_WAIT_V(4); PG8_BAR;
        PG8_STAGE(PG8_SB(1, 0), cB + kstep, voffB); PG8_STAGE(PG8_SA(1, 0), cA + kstep, voffA); PG8_STAGE(PG8_SB(1, 1), cB + hstep + kstep, voffB);
        PG8_WAIT_V(6); PG8_BAR;
    }
    for (;;) {
        const bool has_next = S.next(ui + 1, nxt);
        const char* nA = has_next ? (const char*)g.A + (size_t)nxt.pm * tstep : cA; const char* nB = has_next ? (const char*)g.Bt + (size_t)nxt.pn * tstep : cB;
        for (int t = 0; t < nt; t += 2) {
            const bool last = (t == nt - 2);
            const char* a1 = cA + (size_t)(t + 1) * kstep;
            const char* a2 = last ? nA : cA + (size_t)(t + 2) * kstep; const char* b2 = last ? nB : cB + (size_t)(t + 2) * kstep;
            const char* a3 = a2 + kstep; const char* b3 = b2 + kstep;
            if (last && has_next) S.a_ready(nxt);
            if constexpr (SP2) {
            PG8_LDB(B0, 0, 0); PG8_LDB(B1, 0, 1); PG8_SCHED; PG8_LDA(At, 0, 0); PG8_STAGE(PG8_SA(1, 1), a1 + hstep, voffA);
            PG8_WAIT_V(8); PG8_WAIT_L(0); PG8_BAR; PG8_MMA(0, 0, At, B0); PG8_MMA(0, 1, At, B1); PG8_BAR; PG8_SCHED;
            PG8_LDA(At, 0, 1); PG8_STAGE(PG8_SB(0, 0), b2, voffB); PG8_STAGE(PG8_SB(0, 1), b2 + hstep, voffB); PG8_STAGE(PG8_SA(0, 0), a2, voffA);
            PG8_WAIT_V(8); PG8_WAIT_L(0); PG8_BAR; PG8_MMA(1, 0, At, B0); PG8_MMA(1, 1, At, B1); PG8_BAR; PG8_SCHED;
            PG8_LDB(B0, 1, 0); PG8_LDB(B1, 1, 1); PG8_SCHED; PG8_LDA(At, 1, 0); PG8_STAGE(PG8_SA(0, 1), a2 + hstep, voffA);
            PG8_WAIT_V(8); PG8_WAIT_L(0); PG8_BAR; PG8_MMA(0, 0, At, B0); PG8_MMA(0, 1, At, B1); PG8_BAR; PG8_SCHED;
            PG8_LDA(At, 1, 1); PG8_STAGE(PG8_SB(1, 0), b3, voffB); PG8_STAGE(PG8_SB(1, 1), b3 + hstep, voffB); PG8_STAGE(PG8_SA(1, 0), a3, voffA);
            PG8_WAIT_V(8); PG8_WAIT_L(0); PG8_BAR; PG8_MMA(1, 0, At, B0); PG8_MMA(1, 1, At, B1); PG8_BAR; PG8_SCHED;
            } else {
            PG8_LDB(B0, 0, 0); PG8_SCHED; PG8_LDA(At, 0, 0); PG8_STAGE(PG8_SA(1, 1), a1 + hstep, voffA);
            PG8_WAIT_L(8); PG8_BAR; PG8_WAIT_L(0); PG8_MMA(0, 0, At, B0); PG8_BAR; PG8_SCHED;
            PG8_LDB(B1, 0, 1); PG8_STAGE(PG8_SB(0, 0), b2, voffB);
            PG8_BAR; PG8_WAIT_L(0); PG8_MMA(0, 1, At, B1); PG8_BAR;
            PG8_LDA(At, 0, 1); PG8_STAGE(PG8_SA(0, 0), a2, voffA);
            PG8_BAR; PG8_WAIT_L(0); PG8_MMA(1, 0, At, B0); PG8_BAR; PG8_SCHED;
            PG8_STAGE(PG8_SB(0, 1), b2 + hstep, voffB);
            PG8_WAIT_V(6); PG8_BAR; PG8_MMA(1, 1, At, B1); PG8_BAR;
            PG8_LDB(B0, 1, 0); PG8_SCHED; PG8_LDA(At, 1, 0); PG8_STAGE(PG8_SA(0, 1), a2 + hstep, voffA);
            PG8_WAIT_L(8); PG8_BAR; PG8_WAIT_L(0); PG8_MMA(0, 0, At, B0); PG8_BAR; PG8_SCHED;
            PG8_LDB(B1, 1, 1); PG8_STAGE(PG8_SB(1, 0), b3, voffB);
            PG8_BAR; PG8_WAIT_L(0); PG8_MMA(0, 1, At, B1); PG8_BAR;
            PG8_LDA(At, 1, 1); PG8_STAGE(PG8_SA(1, 0), a3, voffA);
            PG8_BAR; PG8_WAIT_L(0); PG8_MMA(1, 0, At, B0); PG8_BAR; PG8_SCHED;
            PG8_STAGE(PG8_SB(1, 1), b3 + hstep, voffB);
            PG8_WAIT_V(6); PG8_BAR; PG8_MMA(1, 1, At, B1); PG8_BAR;
            }
        }
        if constexpr (ALIGN_EPI) { if (wr == 0) PG8_BAR; }
        if constexpr (!Epi::AFTER_DRAIN) { E(acc, cur, wr, wc, fr, fq); S.done(cur); }
        if (!has_next) break;
#pragma unroll
        for (int a = 0; a < 2; ++a)
#pragma unroll
            for (int b = 0; b < 2; ++b)
#pragma unroll
                for (int m = 0; m < 4; ++m)
#pragma unroll
                    for (int n = 0; n < 2; ++n) acc[a][b][m][n] = (f32x4){0.f, 0.f, 0.f, 0.f};
        cur = nxt; cA = nA; cB = nB; ++ui;
        if constexpr (ALIGN_EPI) { if (wr == 1) PG8_BAR; }
    }
    PG8_WAIT_V(0);
    if constexpr (!ALIGN_EPI) { if (wr == 0) PG8_BAR; }
    PG8_BAR;
    if constexpr (Epi::AFTER_DRAIN) { E.fused(acc, cur, wr, wc, fr, fq, lds, wid, lane); S.done(cur); }
#undef PG8_SA
#undef PG8_SB
#undef PG8_STAGE
#undef PG8_LDA
#undef PG8_LDB
#undef PG8_MMA
#undef PG8_WAIT_V
#undef PG8_WAIT_L
#undef PG8_BAR
#undef PG8_SCHED
}
}
namespace attn_body {
using bf16=__hip_bfloat16;
using bf16x8=__attribute__((ext_vector_type(8)))short;
using s16x4=__attribute__((ext_vector_type(4)))short;
using f32x16=__attribute__((ext_vector_type(16)))float;
using u32x4=__attribute__((ext_vector_type(4)))unsigned;
constexpr int BATCH=4,NHEAD=16,SEQ=8192,D=64,DM=NHEAD*D;
constexpr int NW=8,QBLK=32,QB=QBLK*NW,KVBLK=64,NQB=SEQ/QB;
constexpr int ATTN_PITCH=DM, ATTN_UNIT_ROWS=QB;
__device__ __forceinline__ int crow(int r,int hi){return (r&3)+8*(r>>2)+4*hi;}
#define SBAR() __builtin_amdgcn_sched_barrier(0)
__device__ __forceinline__ void cmask(f32x16&p0,f32x16&p1,int jb,int qrel,int hi){
  const float NEG=-INFINITY; (void)hi;
  if(jb>(qrel>>6)){
  #pragma unroll
  for(int r=0;r<16;++r){p0[r]=NEG;p1[r]=NEG;} }
}

constexpr int NSLOT=3, SLOTB=8192;
constexpr int LDS_K=0, LDS_V=NSLOT*SLOTB, LDS_WS=2*NSLOT*SLOTB, LDS_OST=LDS_WS+NW*64*4, LDS_BYTES=LDS_OST+NW*4096;
constexpr float C2=0.125f*1.4426950408889634f;
__device__ __forceinline__ void glds16(const void*gsrc,unsigned lds_dst){unsigned keep;
  asm volatile("s_mov_b32 %0, m0\n\ts_mov_b32 m0, %2\n\ts_nop 0\n\tglobal_load_lds_dwordx4 %1, off\n\ts_mov_b32 m0, %0":"=&s"(keep):"v"(gsrc),"s"(lds_dst):"memory");}
__device__ __forceinline__ float max3f(float a,float b,float c){float r;asm("v_max3_f32 %0, %1, %2, %3":"=v"(r):"v"(a),"v"(b),"v"(c));return r;}
__device__ __forceinline__ float max2f(float a,float b){float r;asm("v_max_f32_e32 %0, %1, %2":"=v"(r):"v"(a),"v"(b));return r;}
__device__ __forceinline__ float fadd_s(float a,float b){float r;asm("v_add_f32_e32 %0, %1, %2":"=v"(r):"v"(a),"v"(b));return r;}
__device__ __forceinline__ float fsub_s(float a,float b){float r;asm("v_sub_f32_e32 %0, %1, %2":"=v"(r):"v"(a),"v"(b));return r;}
typedef float f32x2_t __attribute__((ext_vector_type(2))); typedef __bf16 bf16x2_t __attribute__((ext_vector_type(2)));
__device__ __forceinline__ unsigned cvtpk_s(float lo,float hi){f32x2_t v={lo,hi};bf16x2_t b=__builtin_convertvector(v,bf16x2_t);return __builtin_bit_cast(unsigned,b);}
#define WAIT_BAR(N) asm volatile("s_waitcnt vmcnt(" #N ") lgkmcnt(0)\n\ts_barrier":::"memory")

__device__ __forceinline__ void qkt(f32x16&p0,f32x16&p1,const char*Kslot,const bf16x8*qr,const f32x16&negm,int r32,int hi){
  const char*kb=Kslot+hi*1024+r32*16;
  #pragma unroll
  for(int d0=0;d0<4;++d0){
    const bf16x8 b0=*reinterpret_cast<const bf16x8*>(kb+d0*2048);
    const bf16x8 b1=*reinterpret_cast<const bf16x8*>(kb+d0*2048+512);
    if(d0==0){p0=__builtin_amdgcn_mfma_f32_32x32x16_bf16(b0,qr[0],negm,0,0,0);p1=__builtin_amdgcn_mfma_f32_32x32x16_bf16(b1,qr[0],negm,0,0,0);}
    else{p0=__builtin_amdgcn_mfma_f32_32x32x16_bf16(b0,qr[d0],p0,0,0,0);p1=__builtin_amdgcn_mfma_f32_32x32x16_bf16(b1,qr[d0],p1,0,0,0);}}
}
typedef __attribute__((address_space(3))) const char* lds_cptr;
typedef short v4i16_t __attribute__((ext_vector_type(4)));
__device__ __forceinline__ void kload8(bf16x8*kf,lds_cptr kp){
  kf[0]=*(const __attribute__((address_space(3))) bf16x8*)(kp);      kf[1]=*(const __attribute__((address_space(3))) bf16x8*)(kp+512);
  kf[2]=*(const __attribute__((address_space(3))) bf16x8*)(kp+2048); kf[3]=*(const __attribute__((address_space(3))) bf16x8*)(kp+2560);
  kf[4]=*(const __attribute__((address_space(3))) bf16x8*)(kp+4096); kf[5]=*(const __attribute__((address_space(3))) bf16x8*)(kp+4608);
  kf[6]=*(const __attribute__((address_space(3))) bf16x8*)(kp+6144); kf[7]=*(const __attribute__((address_space(3))) bf16x8*)(kp+6656);
}
__device__ __forceinline__ void kload2(bf16x8*kf,lds_cptr kp,int j){ kf[2*j]=*(const __attribute__((address_space(3))) bf16x8*)(kp+j*2048); kf[2*j+1]=*(const __attribute__((address_space(3))) bf16x8*)(kp+j*2048+512); }
__device__ __forceinline__ s16x4 vtr(lds_cptr p){ return __builtin_bit_cast(s16x4,__builtin_amdgcn_ds_read_tr16_b64_v4i16((__attribute__((address_space(3))) v4i16_t*)p)); }
__device__ __forceinline__ float rowmax(const f32x16&p0,const f32x16&p1){
  float a=max3f(p0[0],p0[1],p1[0]),b=max3f(p0[2],p0[3],p1[1]);a=max3f(a,p1[2],p1[3]);
  #pragma unroll
  for(int r=4;r<16;r+=4){a=max3f(a,p0[r],p0[r+1]);b=max3f(b,p0[r+2],p0[r+3]);a=max3f(a,p1[r],p1[r+1]);b=max3f(b,p1[r+2],p1[r+3]);}
  const float m=max2f(a,b);
  auto rr=__builtin_amdgcn_permlane32_swap(__float_as_uint(m),__float_as_uint(m),false,false);
  return max2f(__uint_as_float(rr[0]),__uint_as_float(rr[1]));
}
__device__ __forceinline__ void pv(f32x16*o,int vb,bf16x8 pa0,bf16x8 pa1,bf16x8 pa2,bf16x8 pa3){
  #pragma unroll
  for(int d0=0;d0<2;++d0){s16x4 lo[4],hi[4];
    #pragma unroll
    for(int ks=0;ks<4;++ks){
      asm volatile("ds_read_b64_tr_b16 %0,%1 offset:%c2":"=&v"(lo[ks]):"v"(vb),"i"(d0*4096+ks*1024):"memory");
      asm volatile("ds_read_b64_tr_b16 %0,%1 offset:%c2":"=&v"(hi[ks]):"v"(vb),"i"(d0*4096+ks*1024+512):"memory");}
    asm volatile("s_waitcnt lgkmcnt(0)":::"memory");SBAR();
    #define PK(k) (bf16x8){lo[k][0],lo[k][1],lo[k][2],lo[k][3],hi[k][0],hi[k][1],hi[k][2],hi[k][3]}
    o[d0]=__builtin_amdgcn_mfma_f32_32x32x16_bf16(pa0,PK(0),o[d0],0,0,0);
    o[d0]=__builtin_amdgcn_mfma_f32_32x32x16_bf16(pa1,PK(1),o[d0],0,0,0);
    o[d0]=__builtin_amdgcn_mfma_f32_32x32x16_bf16(pa2,PK(2),o[d0],0,0,0);
    o[d0]=__builtin_amdgcn_mfma_f32_32x32x16_bf16(pa3,PK(3),o[d0],0,0,0);
    #undef PK
  }
}

#ifndef ATTN_STORE16
#define ATTN_STORE16(p,v) (*(u32x4*)(p)=(v))
#endif
template<int THRL> __device__ __forceinline__ void attn_unit(int b,int hq,int hv,int qb,const bf16*Q,const bf16*__restrict__ K,const bf16*__restrict__ V,bf16*O,char*shm){
  const int tid=opaque_tid(),lane=tid&63,r32=lane&31,hi=lane>>5; const int wid=__builtin_amdgcn_readfirstlane(tid>>6);
  const long rowbase=(long)b*SEQ; const int q0=qb*QB;
  const bf16*Qw=Q+(rowbase+q0+wid*QBLK)*DM+hq*D;
  const bf16*Kh=K+rowbase*DM+hq*D,*Vh=V+rowbase*DM+hv*D;
  const unsigned lds0=(unsigned)(uintptr_t)shm;
  float*wsf=(float*)(shm+LDS_WS)+wid*64;
  const bf16*ksrc=Kh+(long)lane*DM+wid*8;
  const bf16*vsrc=Vh+(long)(16*(wid&3)+(lane>>2))*DM+(wid>>2)*32+(lane&3)*8;
  const unsigned kdst=lds0+LDS_K+wid*1024, vdst=lds0+LDS_V+wid*1024;
  #define DMA_K(t,slot) glds16(ksrc+(long)(t)*KVBLK*DM,(unsigned)__builtin_amdgcn_readfirstlane(kdst+(slot)))
  #define DMA_V(t,slot) glds16(vsrc+(long)(t)*KVBLK*DM,(unsigned)__builtin_amdgcn_readfirstlane(vdst+(slot)))
  const int vb0=(int)(lds0+LDS_V)+((lane>>4)&1)*32+(lane&3)*8+(4*hi+((lane&15)>>2))*64;
  const char*Kbase=shm+LDS_K; bf16x8 kf[8];
  const lds_cptr shm3=(lds_cptr)shm; const lds_cptr kp0=shm3+LDS_K+hi*1024+r32*16; const lds_cptr vp0=shm3+LDS_V+((lane>>4)&1)*32+(lane&3)*8+(4*hi+((lane&15)>>2))*64;
  const int NT=(q0+QB)/KVBLK;
  DMA_K(0,0);DMA_V(0,0);DMA_K(1,SLOTB);
  bf16x8 qr[4];
  #pragma unroll
  for(int d0=0;d0<4;++d0)qr[d0]=*reinterpret_cast<const bf16x8*>(&Qw[(long)r32*DM+d0*16+hi*8]);
  float mhat=0.f,l_reg=0.f;f32x16 o[2];o[0]=f32x16{};o[1]=f32x16{};f32x16 negm=f32x16{};asm volatile("":"+v"(negm));
  const int qrel=wid*QBLK+r32;
  #define CMASK(P0,P1,t) do{int jb_=(t)-(NT-4); if(jb_>=0)cmask(P0,P1,jb_,qrel,hi);}while(0)
  bool resc=false;
  #define START(P0,P1) do{ const float rm=rowmax(P0,P1); resc=false; \
    { const float dl=rm; mhat=fadd_s(mhat,dl); \
      _Pragma("unroll") for(int r=0;r<16;++r){P0[r]=fsub_s(P0[r],dl);P1[r]=fsub_s(P1[r],dl);} \
      _Pragma("unroll") for(int r=0;r<16;++r)negm[r]=-mhat; asm volatile("":"+v"(negm)); } \
    _Pragma("unroll") for(int r=0;r<16;++r)P0[r]=__builtin_amdgcn_exp2f(P0[r]); }while(0)
  #define RESC() do{ if(resc){ asm volatile("s_waitcnt lgkmcnt(0)":::"memory"); \
      _Pragma("unroll") for(int d_=0;d_<2;++d_) _Pragma("unroll") for(int r=0;r<16;++r)o[d_][r]*=wsf[crow(r,hi)]; } }while(0)
  f32x16 pA0,pA1,pB0,pB1;
  int sl_prev=0,sl_cur=0,sl_next=SLOTB;
  #define ROT() do{sl_prev=sl_cur;sl_cur=sl_next;sl_next=(sl_next==(NSLOT-1)*SLOTB)?0:sl_next+SLOTB;}while(0)
  DMA_K(2,2*SLOTB);
  WAIT_BAR(3);
  qkt(pA0,pA1,Kbase,qr,negm,r32,hi);asm volatile("s_nop 15\n\ts_nop 7":"+v"(pA0),"+v"(pA1));CMASK(pA0,pA1,0);
  START(pA0,pA1);
  _Pragma("unroll") for(int r=0;r<16;++r)pA1[r]=__builtin_amdgcn_exp2f(pA1[r]);
  WAIT_BAR(0);
  DMA_K(3,0);DMA_V(1,SLOTB);
  ROT();
  kload8(kf,kp0+sl_cur);
  WAIT_BAR(2);
  s16x4 vlo[8],vhi[8]; u32x4 pw0,pw1,pw2,pw3;
  #define PKW(P,B) cvtpk_s(P[B],P[B+1])
  #define PAF(k) __builtin_bit_cast(bf16x8,pw##k)
  #define VFR(i) (bf16x8){vlo[i][0],vlo[i][1],vlo[i][2],vlo[i][3],vhi[i][0],vhi[i][1],vhi[i][2],vhi[i][3]}
  #define PIN(x) asm volatile("":"+v"(x))
  #define MX3(a,b,c) __builtin_fmaxf(__builtin_fmaxf((a),(b)),(c))
  #define GAPA(MF,A0,A1,A2,A3,W0,W1,PW) do{ MF; sacc+=A0; sacc+=A1; sacc+=A2; sacc+=A3; PIN(sacc); W0; W1; PIN(PW); SBAR(); }while(0)
  #define EX(v) __builtin_amdgcn_exp2f(v)
  #define GAPB(MF,X,B) do{ MF; X[B]=EX(X[B]); X[B+1]=EX(X[B+1]); X[B+2]=EX(X[B+2]); X[B+3]=EX(X[B+3]); PIN(X); SBAR(); }while(0)
  #define VRD(i) do{ vlo[i]=vtr(vp_+(((i)>>2)*4096+((i)&3)*1024)); vhi[i]=vtr(vp_+(((i)>>2)*4096+((i)&3)*1024+512)); }while(0)
  #define KRD(G,j) do{ if(G){ kload2(kf,kp0+sl_next,j); SBAR(); } }while(0)
  #define STEP(C0,C1,P0,P1,t,GK,GV,GL) do{ SBAR(); \
    const lds_cptr vp_=vp0+sl_prev; \
    VRD(0); SBAR(); float sacc=(P0[0]+P0[1]); \
    GAPA(C0=__builtin_amdgcn_mfma_f32_32x32x16_bf16(kf[0],qr[0],negm,0,0,0), P0[2],P0[3],P0[4],P0[5],     pw0[0]=PKW(P0,0), pw0[1]=PKW(P0,2), pw0); \
    VRD(4); SBAR(); GAPA(C1=__builtin_amdgcn_mfma_f32_32x32x16_bf16(kf[1],qr[0],negm,0,0,0), P0[6],P0[7],P0[8],P0[9],     pw0[2]=PKW(P0,4), pw0[3]=PKW(P0,6), pw0); \
    VRD(1); SBAR(); GAPA(C0=__builtin_amdgcn_mfma_f32_32x32x16_bf16(kf[2],qr[1],C0,0,0,0),   P0[10],P0[11],P0[12],P0[13], pw1[0]=PKW(P0,8), pw1[1]=PKW(P0,10), pw1); \
    VRD(5); SBAR(); GAPA(C1=__builtin_amdgcn_mfma_f32_32x32x16_bf16(kf[3],qr[1],C1,0,0,0),   P0[14],P0[15],P1[0],P1[1],   pw1[2]=PKW(P0,12),pw1[3]=PKW(P0,14), pw1); \
    VRD(2); SBAR(); GAPA(C0=__builtin_amdgcn_mfma_f32_32x32x16_bf16(kf[4],qr[2],C0,0,0,0),   P1[2],P1[3],P1[4],P1[5],     pw2[0]=PKW(P1,0), pw2[1]=PKW(P1,2), pw2); \
    VRD(6); SBAR(); GAPA(C1=__builtin_amdgcn_mfma_f32_32x32x16_bf16(kf[5],qr[2],C1,0,0,0),   P1[6],P1[7],P1[8],P1[9],     pw2[2]=PKW(P1,4), pw2[3]=PKW(P1,6), pw2); \
    VRD(3); SBAR(); GAPA(C0=__builtin_amdgcn_mfma_f32_32x32x16_bf16(kf[6],qr[3],C0,0,0,0),   P1[10],P1[11],P1[12],P1[13], pw3[0]=PKW(P1,8), pw3[1]=PKW(P1,10), pw3); \
    VRD(7); SBAR(); GAPA(C1=__builtin_amdgcn_mfma_f32_32x32x16_bf16(kf[7],qr[3],C1,0,0,0),   P1[14],P1[15],0.f,0.f,       pw3[2]=PKW(P1,12),pw3[3]=PKW(P1,14), pw3); \
    l_reg+=sacc; \
    if(GK){DMA_K((t)+3,sl_cur);} if(GV){DMA_V((t)+1,sl_next);} \
    CMASK(C0,C1,t); \
    { float a=MX3(C0[0],C0[1],C1[0]),b=MX3(C0[2],C0[3],C1[1]); a=MX3(a,C1[2],C1[3]); \
      _Pragma("unroll") for(int r=4;r<16;r+=4){a=MX3(a,C0[r],C0[r+1]);b=MX3(b,C0[r+2],C0[r+3]);a=MX3(a,C1[r],C1[r+1]);b=MX3(b,C1[r+2],C1[r+3]);} \
      float rm=__builtin_fmaxf(a,b); { auto rr=__builtin_amdgcn_permlane32_swap(__float_as_uint(rm),__float_as_uint(rm),false,false); rm=__builtin_fmaxf(__uint_as_float(rr[0]),__uint_as_float(rr[1])); } \
      resc=false; \
      if(__builtin_expect(__any(rm>(float)THRL),0)){ const float dl=__builtin_fmaxf(rm,0.f); mhat+=dl; \
        _Pragma("unroll") for(int r=0;r<16;++r){C0[r]-=dl;C1[r]-=dl;} \
        _Pragma("unroll") for(int r=0;r<16;++r)negm[r]=-mhat; asm volatile("":"+v"(negm)); \
        const float f=__builtin_amdgcn_exp2f(-dl); l_reg*=f; if(hi==0)wsf[r32]=f; resc=true; } } \
    SBAR(); \
    GAPB(o[0]=__builtin_amdgcn_mfma_f32_32x32x16_bf16(PAF(0),VFR(0),o[0],0,0,0), C0,0); \
    GAPB(o[1]=__builtin_amdgcn_mfma_f32_32x32x16_bf16(PAF(0),VFR(4),o[1],0,0,0), C0,4); \
    KRD(GL,0); GAPB(o[0]=__builtin_amdgcn_mfma_f32_32x32x16_bf16(PAF(1),VFR(1),o[0],0,0,0), C0,8); \
    KRD(GL,1); GAPB(o[1]=__builtin_amdgcn_mfma_f32_32x32x16_bf16(PAF(1),VFR(5),o[1],0,0,0), C0,12); \
    KRD(GL,2); GAPB(o[0]=__builtin_amdgcn_mfma_f32_32x32x16_bf16(PAF(2),VFR(2),o[0],0,0,0), C1,0); \
    KRD(GL,3); GAPB(o[1]=__builtin_amdgcn_mfma_f32_32x32x16_bf16(PAF(2),VFR(6),o[1],0,0,0), C1,4); \
    GAPB(o[0]=__builtin_amdgcn_mfma_f32_32x32x16_bf16(PAF(3),VFR(3),o[0],0,0,0), C1,8); \
    GAPB(o[1]=__builtin_amdgcn_mfma_f32_32x32x16_bf16(PAF(3),VFR(7),o[1],0,0,0), C1,12); \
    }while(0)
  int t=1;
  #undef CMASK
  #define CMASK(P0,P1,t) do{}while(0)
  for(;t+5<NT;t+=2){
    STEP(pB0,pB1,pA0,pA1,t,true,true,true);     WAIT_BAR(2); RESC(); ROT();
    STEP(pA0,pA1,pB0,pB1,t+1,true,true,true);   WAIT_BAR(2); RESC(); ROT();
  }
  #undef CMASK
  #define CMASK(P0,P1,t) do{int jb_=(t)-(NT-4); if(jb_>=0)cmask(P0,P1,jb_,qrel,hi);}while(0)
  #define ENDW(tt) do{ if((tt)+3<NT){WAIT_BAR(2);} else if((tt)+2<NT){WAIT_BAR(1);} else {WAIT_BAR(0);} }while(0)
  for(;t+1<NT;t+=2){
    STEP(pB0,pB1,pA0,pA1,t,(t+3<NT),(t+1<NT),(t+1<NT));       ENDW(t);   RESC(); ROT();
    STEP(pA0,pA1,pB0,pB1,t+1,(t+4<NT),(t+2<NT),(t+2<NT));     ENDW(t+1); RESC(); ROT();
  }
  STEP(pB0,pB1,pA0,pA1,NT-1,false,false,false); RESC();
  { float sacc=pB0[0]+pB0[1]; _Pragma("unroll") for(int r=2;r<16;++r)sacc+=pB0[r]; _Pragma("unroll") for(int r=0;r<16;++r)sacc+=pB1[r]; l_reg+=sacc;
    pw0=(u32x4){PKW(pB0,0),PKW(pB0,2),PKW(pB0,4),PKW(pB0,6)};pw1=(u32x4){PKW(pB0,8),PKW(pB0,10),PKW(pB0,12),PKW(pB0,14)};pw2=(u32x4){PKW(pB1,0),PKW(pB1,2),PKW(pB1,4),PKW(pB1,6)};pw3=(u32x4){PKW(pB1,8),PKW(pB1,10),PKW(pB1,12),PKW(pB1,14)};
    SBAR(); pv(o,vb0+sl_cur,PAF(0),PAF(1),PAF(2),PAF(3)); }
  #undef PKW
  #undef PAF
  #undef VFR
  #undef PIN
  #undef MX3
  #undef GAPA
  #undef GAPB
  #undef EX
  #undef VRD
  #undef KRD
  #undef STEP
  #undef ENDW
  {auto rr=__builtin_amdgcn_permlane32_swap(__float_as_uint(l_reg),__float_as_uint(l_reg),false,false);l_reg=__uint_as_float(rr[0])+__uint_as_float(rr[1]);}
  if(hi==0)wsf[32+r32]=l_reg;asm volatile("s_waitcnt lgkmcnt(0)":::"memory");
  float rli[16];
  #pragma unroll
  for(int r=0;r<16;++r)rli[r]=__builtin_amdgcn_rcpf(wsf[32+crow(r,hi)]);
  bf16*Ow=O+(rowbase+q0+wid*QBLK)*DM+hv*D;
  { bf16*stg=(bf16*)(shm+LDS_OST)+wid*2048;
    #pragma unroll
    for(int r=0;r<16;++r){const int orow=crow(r,hi);
      #pragma unroll
      for(int d0=0;d0<2;++d0)stg[orow*64+d0*32+r32]=__float2bfloat16(o[d0][r]*rli[r]);}
    asm volatile("s_waitcnt lgkmcnt(0)":::"memory");
    #pragma unroll
    for(int i=0;i<4;++i){const int row=i*8+(lane>>3),ch=lane&7; const u32x4 v=*(const u32x4*)(stg+row*64+ch*8); ATTN_STORE16(Ow+(long)row*DM+ch*8,v);} }
  asm volatile("s_waitcnt lgkmcnt(0)\n\ts_barrier":::"memory");
  #undef DMA_K
  #undef DMA_V
  #undef CMASK
  #undef START
  #undef RESC
  #undef ROT
}
__device__ __forceinline__ void pv128(f32x16*o,int vb,bf16x8 pa0,bf16x8 pa1,bf16x8 pa2,bf16x8 pa3){
  #pragma unroll
  for(int d0=0;d0<4;++d0){s16x4 lo[4],hi[4];
    #pragma unroll
    for(int ks=0;ks<4;++ks){
      asm volatile("ds_read_b64_tr_b16 %0,%1 offset:%c2":"=&v"(lo[ks]):"v"(vb),"i"(d0*4096+ks*1024):"memory");
      asm volatile("ds_read_b64_tr_b16 %0,%1 offset:%c2":"=&v"(hi[ks]):"v"(vb),"i"(d0*4096+ks*1024+512):"memory");}
    asm volatile("s_waitcnt lgkmcnt(0)":::"memory");SBAR();
    #define PK(k) (bf16x8){lo[k][0],lo[k][1],lo[k][2],lo[k][3],hi[k][0],hi[k][1],hi[k][2],hi[k][3]}
    o[d0]=__builtin_amdgcn_mfma_f32_32x32x16_bf16(pa0,PK(0),o[d0],0,0,0);
    o[d0]=__builtin_amdgcn_mfma_f32_32x32x16_bf16(pa1,PK(1),o[d0],0,0,0);
    o[d0]=__builtin_amdgcn_mfma_f32_32x32x16_bf16(pa2,PK(2),o[d0],0,0,0);
    o[d0]=__builtin_amdgcn_mfma_f32_32x32x16_bf16(pa3,PK(3),o[d0],0,0,0);
    #undef PK
  }
}
constexpr int SLOTV=16384, LDS_V2=NSLOT*SLOTB, LDS_WS2=LDS_V2+NSLOT*SLOTV, LDS_OST2=LDS_WS2+NW*64*4, LDS_BYTES2=LDS_OST2+NW*4096;
template<int THRL> __device__ __forceinline__ void attn_unit128(int b,int hq,int hv,int qb,const bf16*Q,const bf16*__restrict__ K,const bf16*__restrict__ V,bf16*O,char*shm){
  const int tid=opaque_tid(),lane=tid&63,r32=lane&31,hi=lane>>5; const int wid=__builtin_amdgcn_readfirstlane(tid>>6);
  const long rowbase=(long)b*SEQ; const int q0=qb*QB;
  const bf16*Qw=Q+(rowbase+q0+wid*QBLK)*DM+hq*D;
  const bf16*Kh=K+rowbase*DM+hq*D,*Vh=V+rowbase*DM+hv*D;
  const unsigned lds0=(unsigned)(uintptr_t)shm;
  float*wsf=(float*)(shm+LDS_WS2)+wid*64;
  const bf16*ksrc=Kh+(long)lane*DM+wid*8;
  const bf16*vsrc=Vh+(long)(16*(wid&3)+(lane>>2))*DM+(wid>>2)*32+(lane&3)*8;
  const unsigned kdst=lds0+LDS_K+wid*1024, vdst=lds0+LDS_V2+wid*1024;
  #define DMA_K(t,slot) glds16(ksrc+(long)(t)*KVBLK*DM,(unsigned)__builtin_amdgcn_readfirstlane(kdst+(slot)))
  #define DMA_V(t,slot) do{ glds16(vsrc+(long)(t)*KVBLK*DM,(unsigned)__builtin_amdgcn_readfirstlane(vdst+2*(slot))); glds16(vsrc+64+(long)(t)*KVBLK*DM,(unsigned)__builtin_amdgcn_readfirstlane(vdst+8192+2*(slot))); }while(0)
  const int vb0=(int)(lds0+LDS_V2)+((lane>>4)&1)*32+(lane&3)*8+(4*hi+((lane&15)>>2))*64;
  const char*Kbase=shm+LDS_K; bf16x8 kf[8];
  const lds_cptr shm3=(lds_cptr)shm; const lds_cptr kp0=shm3+LDS_K+hi*1024+r32*16; const lds_cptr vp0=shm3+LDS_V2+((lane>>4)&1)*32+(lane&3)*8+(4*hi+((lane&15)>>2))*64;
  const int NT=(q0+QB)/KVBLK;
  DMA_K(0,0);DMA_V(0,0);DMA_K(1,SLOTB);
  bf16x8 qr[4];
  #pragma unroll
  for(int d0=0;d0<4;++d0)qr[d0]=*reinterpret_cast<const bf16x8*>(&Qw[(long)r32*DM+d0*16+hi*8]);
  float mhat=0.f,l_reg=0.f;f32x16 o[4];o[0]=f32x16{};o[1]=f32x16{};o[2]=f32x16{};o[3]=f32x16{};const f32x16 zc=f32x16{};
  const int qrel=wid*QBLK+r32;
  #define CMASK(P0,P1,t) do{int jb_=(t)-(NT-4); if(jb_>=0)cmask(P0,P1,jb_,qrel,hi);}while(0)
  bool resc=false;
  #define START(P0,P1) do{ const float rm=rowmax(P0,P1); resc=false; \
    { const float dl=rm; mhat=fadd_s(mhat,dl); \
      _Pragma("unroll") for(int r=0;r<16;++r){P0[r]=fsub_s(P0[r],dl);P1[r]=fsub_s(P1[r],dl);} \
      } \
    _Pragma("unroll") for(int r=0;r<16;++r)P0[r]=__builtin_amdgcn_exp2f(P0[r]); }while(0)
  #define RESC() do{ if(resc){ asm volatile("s_waitcnt lgkmcnt(0)":::"memory"); \
      _Pragma("unroll") for(int d_=0;d_<4;++d_) _Pragma("unroll") for(int r=0;r<16;++r)o[d_][r]*=wsf[crow(r,hi)]; } }while(0)
  f32x16 pA0,pA1,pB0,pB1;
  int sl_prev=0,sl_cur=0,sl_next=SLOTB;
  #define ROT() do{sl_prev=sl_cur;sl_cur=sl_next;sl_next=(sl_next==(NSLOT-1)*SLOTB)?0:sl_next+SLOTB;}while(0)
  DMA_K(2,2*SLOTB);
  WAIT_BAR(3);
  qkt(pA0,pA1,Kbase,qr,zc,r32,hi);asm volatile("s_nop 15\n\ts_nop 7":"+v"(pA0),"+v"(pA1));CMASK(pA0,pA1,0);
  START(pA0,pA1);
  _Pragma("unroll") for(int r=0;r<16;++r)pA1[r]=__builtin_amdgcn_exp2f(pA1[r]);
  WAIT_BAR(0);
  DMA_K(3,0);DMA_V(1,SLOTB);
  ROT();
  kload8(kf,kp0+sl_cur);
  WAIT_BAR(3);
  s16x4 vlo[8],vhi[8]; u32x4 pw0,pw1,pw2,pw3;
  #define PKW(P,B) cvtpk_s(P[B],P[B+1])
  #define PAF(k) __builtin_bit_cast(bf16x8,pw##k)
  #define VFR(i) (bf16x8){vlo[i][0],vlo[i][1],vlo[i][2],vlo[i][3],vhi[i][0],vhi[i][1],vhi[i][2],vhi[i][3]}
  #define PIN(x) asm volatile("":"+v"(x))
  #define MX3(a,b,c) __builtin_fmaxf(__builtin_fmaxf((a),(b)),(c))
  #define GAPA(MF,A0,A1,A2,A3,W0,W1,PW) do{ MF; sacc+=A0; sacc+=A1; sacc+=A2; sacc+=A3; PIN(sacc); W0; W1; PIN(PW); SBAR(); }while(0)
  #define EX(v) __builtin_amdgcn_exp2f(v)
  #define GAPB(MF,X,B) do{ MF; X[B]=EX(X[B]); X[B+1]=EX(X[B+1]); X[B+2]=EX(X[B+2]); X[B+3]=EX(X[B+3]); PIN(X); SBAR(); }while(0)
  #define VRD(i) do{ vlo[i]=vtr(vp_+(((i)>>2)*4096+((i)&3)*1024)); vhi[i]=vtr(vp_+(((i)>>2)*4096+((i)&3)*1024+512)); }while(0)
  #define VRX(i) do{ vlo[i]=vtr(vp_+((((i)>>2)+2)*4096+((i)&3)*1024)); vhi[i]=vtr(vp_+((((i)>>2)+2)*4096+((i)&3)*1024+512)); SBAR(); }while(0)
  #define GAPB2(MF,X,B) do{ MF; X[B]=EX(X[B]-mhat); X[B+1]=EX(X[B+1]-mhat); PIN(X); SBAR(); }while(0)
  #define KRD(G,j) do{ if(G){ kload2(kf,kp0+sl_next,j); SBAR(); } }while(0)
  #define STEP(C0,C1,P0,P1,t,GK,GV,GL) do{ SBAR(); \
    const lds_cptr vp_=vp0+2*sl_prev; \
    VRD(0); SBAR(); float sacc=(P0[0]+P0[1]); \
    GAPA(C0=__builtin_amdgcn_mfma_f32_32x32x16_bf16(kf[0],qr[0],zc,0,0,0), P0[2],P0[3],P0[4],P0[5],     pw0[0]=PKW(P0,0), pw0[1]=PKW(P0,2), pw0); \
    VRD(4); SBAR(); GAPA(C1=__builtin_amdgcn_mfma_f32_32x32x16_bf16(kf[1],qr[0],zc,0,0,0), P0[6],P0[7],P0[8],P0[9],     pw0[2]=PKW(P0,4), pw0[3]=PKW(P0,6), pw0); \
    VRD(1); SBAR(); GAPA(C0=__builtin_amdgcn_mfma_f32_32x32x16_bf16(kf[2],qr[1],C0,0,0,0),   P0[10],P0[11],P0[12],P0[13], pw1[0]=PKW(P0,8), pw1[1]=PKW(P0,10), pw1); \
    VRD(5); SBAR(); GAPA(C1=__builtin_amdgcn_mfma_f32_32x32x16_bf16(kf[3],qr[1],C1,0,0,0),   P0[14],P0[15],P1[0],P1[1],   pw1[2]=PKW(P0,12),pw1[3]=PKW(P0,14), pw1); \
    VRD(2); SBAR(); GAPA(C0=__builtin_amdgcn_mfma_f32_32x32x16_bf16(kf[4],qr[2],C0,0,0,0),   P1[2],P1[3],P1[4],P1[5],     pw2[0]=PKW(P1,0), pw2[1]=PKW(P1,2), pw2); \
    VRD(6); SBAR(); GAPA(C1=__builtin_amdgcn_mfma_f32_32x32x16_bf16(kf[5],qr[2],C1,0,0,0),   P1[6],P1[7],P1[8],P1[9],     pw2[2]=PKW(P1,4), pw2[3]=PKW(P1,6), pw2); \
    VRD(3); SBAR(); GAPA(C0=__builtin_amdgcn_mfma_f32_32x32x16_bf16(kf[6],qr[3],C0,0,0,0),   P1[10],P1[11],P1[12],P1[13], pw3[0]=PKW(P1,8), pw3[1]=PKW(P1,10), pw3); \
    VRD(7); SBAR(); GAPA(C1=__builtin_amdgcn_mfma_f32_32x32x16_bf16(kf[7],qr[3],C1,0,0,0),   P1[14],P1[15],0.f,0.f,       pw3[2]=PKW(P1,12),pw3[3]=PKW(P1,14), pw3); \
    l_reg+=sacc; \
    if(GK){DMA_K((t)+3,sl_cur);} if(GV){DMA_V((t)+1,sl_next);} \
    CMASK(C0,C1,t); \
    { float a=MX3(C0[0],C0[1],C1[0]),b=MX3(C0[2],C0[3],C1[1]); a=MX3(a,C1[2],C1[3]); \
      _Pragma("unroll") for(int r=4;r<16;r+=4){a=MX3(a,C0[r],C0[r+1]);b=MX3(b,C0[r+2],C0[r+3]);a=MX3(a,C1[r],C1[r+1]);b=MX3(b,C1[r+2],C1[r+3]);} \
      float rm=__builtin_fmaxf(a,b); { auto rr=__builtin_amdgcn_permlane32_swap(__float_as_uint(rm),__float_as_uint(rm),false,false); rm=__builtin_fmaxf(__uint_as_float(rr[0]),__uint_as_float(rr[1])); } \
      rm-=mhat; resc=false; \
      if(__builtin_expect(__any(rm>(float)THRL),0)){ const float dl=__builtin_fmaxf(rm,0.f); mhat+=dl; \
        const float f=__builtin_amdgcn_exp2f(-dl); l_reg*=f; if(hi==0)wsf[r32]=f; resc=true; } } \
    SBAR(); \
    GAPB2(o[0]=__builtin_amdgcn_mfma_f32_32x32x16_bf16(PAF(0),VFR(0),o[0],0,0,0), C0,0);  VRX(0); \
    GAPB2(o[1]=__builtin_amdgcn_mfma_f32_32x32x16_bf16(PAF(0),VFR(4),o[1],0,0,0), C0,2);  VRX(4); \
    KRD(GL,0); GAPB2(o[0]=__builtin_amdgcn_mfma_f32_32x32x16_bf16(PAF(1),VFR(1),o[0],0,0,0), C0,4);  VRX(1); \
    KRD(GL,1); GAPB2(o[1]=__builtin_amdgcn_mfma_f32_32x32x16_bf16(PAF(1),VFR(5),o[1],0,0,0), C0,6);  VRX(5); \
    KRD(GL,2); GAPB2(o[0]=__builtin_amdgcn_mfma_f32_32x32x16_bf16(PAF(2),VFR(2),o[0],0,0,0), C0,8);  VRX(2); \
    KRD(GL,3); GAPB2(o[1]=__builtin_amdgcn_mfma_f32_32x32x16_bf16(PAF(2),VFR(6),o[1],0,0,0), C0,10); VRX(6); \
    GAPB2(o[0]=__builtin_amdgcn_mfma_f32_32x32x16_bf16(PAF(3),VFR(3),o[0],0,0,0), C0,12); VRX(3); \
    GAPB2(o[1]=__builtin_amdgcn_mfma_f32_32x32x16_bf16(PAF(3),VFR(7),o[1],0,0,0), C0,14); VRX(7); \
    GAPB2(o[2]=__builtin_amdgcn_mfma_f32_32x32x16_bf16(PAF(0),VFR(0),o[2],0,0,0), C1,0); \
    GAPB2(o[3]=__builtin_amdgcn_mfma_f32_32x32x16_bf16(PAF(0),VFR(4),o[3],0,0,0), C1,2); \
    GAPB2(o[2]=__builtin_amdgcn_mfma_f32_32x32x16_bf16(PAF(1),VFR(1),o[2],0,0,0), C1,4); \
    GAPB2(o[3]=__builtin_amdgcn_mfma_f32_32x32x16_bf16(PAF(1),VFR(5),o[3],0,0,0), C1,6); \
    GAPB2(o[2]=__builtin_amdgcn_mfma_f32_32x32x16_bf16(PAF(2),VFR(2),o[2],0,0,0), C1,8); \
    GAPB2(o[3]=__builtin_amdgcn_mfma_f32_32x32x16_bf16(PAF(2),VFR(6),o[3],0,0,0), C1,10); \
    GAPB2(o[2]=__builtin_amdgcn_mfma_f32_32x32x16_bf16(PAF(3),VFR(3),o[2],0,0,0), C1,12); \
    GAPB2(o[3]=__builtin_amdgcn_mfma_f32_32x32x16_bf16(PAF(3),VFR(7),o[3],0,0,0), C1,14); \
    }while(0)
  int t=1;
  #undef CMASK
  #define CMASK(P0,P1,t) do{}while(0)
  for(;t+5<NT;t+=2){
    STEP(pB0,pB1,pA0,pA1,t,true,true,true);     WAIT_BAR(3); RESC(); ROT();
    STEP(pA0,pA1,pB0,pB1,t+1,true,true,true);   WAIT_BAR(3); RESC(); ROT();
  }
  #undef CMASK
  #define CMASK(P0,P1,t) do{int jb_=(t)-(NT-4); if(jb_>=0)cmask(P0,P1,jb_,qrel,hi);}while(0)
  #define ENDW(tt) do{ if((tt)+3<NT){WAIT_BAR(3);} else if((tt)+2<NT){WAIT_BAR(2);} else {WAIT_BAR(0);} }while(0)
  for(;t+1<NT;t+=2){
    STEP(pB0,pB1,pA0,pA1,t,(t+3<NT),(t+1<NT),(t+1<NT));       ENDW(t);   RESC(); ROT();
    STEP(pA0,pA1,pB0,pB1,t+1,(t+4<NT),(t+2<NT),(t+2<NT));     ENDW(t+1); RESC(); ROT();
  }
  STEP(pB0,pB1,pA0,pA1,NT-1,false,false,false); RESC();
  { float sacc=pB0[0]+pB0[1]; _Pragma("unroll") for(int r=2;r<16;++r)sacc+=pB0[r]; _Pragma("unroll") for(int r=0;r<16;++r)sacc+=pB1[r]; l_reg+=sacc;
    pw0=(u32x4){PKW(pB0,0),PKW(pB0,2),PKW(pB0,4),PKW(pB0,6)};pw1=(u32x4){PKW(pB0,8),PKW(pB0,10),PKW(pB0,12),PKW(pB0,14)};pw2=(u32x4){PKW(pB1,0),PKW(pB1,2),PKW(pB1,4),PKW(pB1,6)};pw3=(u32x4){PKW(pB1,8),PKW(pB1,10),PKW(pB1,12),PKW(pB1,14)};
    SBAR(); pv128(o,vb0+2*sl_cur,PAF(0),PAF(1),PAF(2),PAF(3)); }
  #undef PKW
  #undef PAF
  #undef VFR
  #undef PIN
  #undef MX3
  #undef GAPA
  #undef GAPB
  #undef EX
  #undef VRD
  #undef VRX
  #undef GAPB2
  #undef KRD
  #undef STEP
  #undef ENDW
  {auto rr=__builtin_amdgcn_permlane32_swap(__float_as_uint(l_reg),__float_as_uint(l_reg),false,false);l_reg=__uint_as_float(rr[0])+__uint_as_float(rr[1]);}
  if(hi==0)wsf[32+r32]=l_reg;asm volatile("s_waitcnt lgkmcnt(0)":::"memory");
  float rli[16];
  #pragma unroll
  for(int r=0;r<16;++r)rli[r]=__builtin_amdgcn_rcpf(wsf[32+crow(r,hi)]);
  bf16*Ow=O+(rowbase+q0+wid*QBLK)*DM+hv*D;
  { bf16*stg=(bf16*)(shm+LDS_OST2)+wid*2048;
    #pragma unroll
    for(int hp=0;hp<2;++hp){
      #pragma unroll
      for(int r=0;r<16;++r){const int orow=crow(r,hi);
        #pragma unroll
        for(int d0=0;d0<2;++d0)stg[orow*64+d0*32+r32]=__float2bfloat16(o[2*hp+d0][r]*rli[r]);}
      asm volatile("s_waitcnt lgkmcnt(0)":::"memory");
      #pragma unroll
      for(int i=0;i<4;++i){const int row=i*8+(lane>>3),ch=lane&7; const u32x4 v=*(const u32x4*)(stg+row*64+ch*8); ATTN_STORE16(Ow+(long)row*DM+hp*64+ch*8,v);}
      asm volatile("s_waitcnt lgkmcnt(0)":::"memory"); } }
  asm volatile("s_waitcnt lgkmcnt(0)\n\ts_barrier":::"memory");
  #undef DMA_K
  #undef DMA_V
  #undef CMASK
  #undef START
  #undef RESC
  #undef ROT
}
constexpr int ATTN_LDS_BYTES=LDS_BYTES;
#undef SBAR
#undef WAIT_BAR
}
#define GAS __attribute__((address_space(1)))
#define LAS __attribute__((address_space(3)))
typedef unsigned short bf16;
typedef unsigned v4u __attribute__((ext_vector_type(4)));
typedef float f32x4 __attribute__((ext_vector_type(4)));
typedef short bf16x8 __attribute__((ext_vector_type(8)));
typedef GAS unsigned gu32;
typedef GAS unsigned long long gu64;
#define RLX_AGENT __ATOMIC_RELAXED, __HIP_MEMORY_SCOPE_AGENT
#define LDS_WAIT() asm volatile("s_waitcnt lgkmcnt(0)" ::: "memory")
#define VM_WAIT() asm volatile("s_waitcnt vmcnt(0)" ::: "memory")
__device__ __forceinline__ unsigned long long rt() { return __builtin_amdgcn_s_memrealtime(); }
__device__ __forceinline__ unsigned f2bf(float f) { unsigned u = __builtin_bit_cast(unsigned, f); return (u + 0x7fffu + ((u >> 16) & 1u)) >> 16; }
__device__ __forceinline__ unsigned pk2(float lo, float hi) { return f2bf(lo) | (f2bf(hi) << 16); }

#define XB_TMO      128
#define XB_XCNT(j)  (256  + 64 * (j))
#define XB_XSUB(j)  (1280 + 64 * (j))
#define XB_XGEN(j)  (2304 + 64 * (j))
#define XB_TOP      3328
#define XB_TOPGEN   3392
#define XCD_BAR_WORDS 3456
#define XB_SPIN_CAP (1u << 18)

__device__ __forceinline__ unsigned xb_ld(unsigned* p)              { return __hip_atomic_load(p, __ATOMIC_RELAXED, __HIP_MEMORY_SCOPE_AGENT); }
__device__ __forceinline__ unsigned xb_add(unsigned* p, unsigned v) { return __hip_atomic_fetch_add(p, v, __ATOMIC_RELAXED, __HIP_MEMORY_SCOPE_AGENT); }
__device__ __forceinline__ unsigned xb_xcc_id() { return (unsigned)__builtin_amdgcn_s_getreg((3 << 11) | 20) & 0xFu; }
#define XB_SPIN(cond, bar) do { unsigned _sp = 0; while (cond) { __builtin_amdgcn_s_sleep(1); \
    if ((++_sp & 255u) == 0u) { if (xb_ld(&(bar)[XB_TMO])) break; if (_sp > XB_SPIN_CAP) { atomicAdd(&(bar)[XB_TMO], 1u); break; } } } } while (0)

struct XcdBarrier {
    unsigned* bar; unsigned x;
    volatile LAS unsigned* st;
};

__device__ __forceinline__ XcdBarrier xcd_barrier_post(unsigned* bar, volatile LAS unsigned* st) {
    XcdBarrier b; b.bar = bar; b.x = xb_xcc_id(); b.st = st;
    if (opaque_tid() == 0) (void)xb_add(&bar[XB_XCNT(b.x)], 1u);
    return b;
}
__device__ __forceinline__ void xcd_barrier_complete(unsigned* bar, unsigned x, unsigned& nloc, unsigned& nx) {
    const unsigned G = gridDim.x * gridDim.y * gridDim.z;
    unsigned sum, cnt, mine, sp = 0u;
    for (;;) {
        sum = 0u; cnt = 0u;
#pragma unroll
        for (unsigned j = 0; j < 16; ++j) { const unsigned c = xb_ld(&bar[XB_XCNT(j)]); sum += c; cnt += (c > 0u) ? 1u : 0u; }
        if (sum == G) break;
        __builtin_amdgcn_s_sleep(1);
        if ((++sp & 255u) == 0u) { if (xb_ld(&bar[XB_TMO])) break; if (sp > XB_SPIN_CAP) { atomicAdd(&bar[XB_TMO], 1u); break; } }
    }
    mine = xb_ld(&bar[XB_XCNT(x)]);
    nloc = mine > 0u ? mine : 1u; nx = cnt > 0u ? cnt : 1u;
}

__device__ __forceinline__ void xcd_barrier(const XcdBarrier& b) {
    asm volatile("s_waitcnt vmcnt(0)" ::: "memory");
    __syncthreads();
    if (opaque_tid() == 0) {
        unsigned* bar = b.bar;
        __builtin_amdgcn_s_waitcnt(0);
        unsigned nloc = b.st[0], nx = b.st[1];
        if (nloc == 0u) { xcd_barrier_complete(bar, b.x, nloc, nx); b.st[0] = nloc; b.st[1] = nx; }
        const unsigned old = xb_add(&bar[XB_XSUB(b.x)], 1u);
        const unsigned gen = old / nloc;
        if (old + 1u == (gen + 1u) * nloc) {
            __builtin_amdgcn_fence(__ATOMIC_RELEASE, "agent");
            asm volatile("s_waitcnt vmcnt(0)" ::: "memory");
            const unsigned og = xb_add(&bar[XB_TOP], 1u);
            const unsigned tg = og / nx;
            if (og + 1u == (tg + 1u) * nx) xb_add(&bar[XB_TOPGEN], 1u);
            else XB_SPIN(xb_ld(&bar[XB_TOPGEN]) == tg, bar);
            __builtin_amdgcn_fence(__ATOMIC_ACQUIRE, "agent");
            xb_add(&bar[XB_XGEN(b.x)], 1u);
            asm volatile("s_waitcnt vmcnt(0)" ::: "memory");
        } else {
            XB_SPIN(xb_ld(&bar[XB_XGEN(b.x)]) == gen, bar);
            __builtin_amdgcn_fence(__ATOMIC_ACQUIRE, "agent");
            asm volatile("s_waitcnt vmcnt(0)" ::: "memory");
        }
    }
    __syncthreads();
}
constexpr int NWAVES = 8;
constexpr int DM = 1024, MP = 32768, MS = 512, MROWS = MP + MS, NSEQ = 20, DEPTH = 4, DFF = 2816, DIN = 9216, PAST = 2048;
constexpr int NCHUNK_P = 512, NCHUNK = 528;
constexpr float EPS = 1e-6f;
constexpr size_t OY_P = 0, OY_S = 33554432, OK_P = 34078720, OV_P = 168296448, OS_P = 302514176, OK_S = 304611328, OV_S = 306708480, OS_S = 308805632, OUT_TOTAL = 317194240;

constexpr size_t MiB = 1u << 20;
constexpr size_t WS_CTL = 0, CTL_ZERO_BYTES = 1 * MiB;
constexpr size_t WS_MOD = 1 * MiB;
constexpr size_t WS_LB = 4 * MiB;
constexpr size_t WS_W = 8 * MiB, W_LAYER = 57 * MiB;
constexpr size_t WO_GU1 = 0, WO_D1 = 11 * MiB, WO_IN = 16 * MiB + MiB / 2, WO_BA = 34 * MiB + MiB / 2, WO_BH = 36 * MiB + MiB / 2, WO_OUT = 38 * MiB + MiB / 2, WO_GU2 = 40 * MiB + MiB / 2, WO_D2 = 51 * MiB + MiB / 2;
constexpr size_t WS_X = 240 * MiB;
constexpr size_t WS_XN = 370 * MiB;
constexpr size_t WS_Q = 435 * MiB, WS_K = 500 * MiB, WS_V = 565 * MiB;
constexpr size_t WS_QQ = 630 * MiB, WS_KK = 695 * MiB, WS_VV = 760 * MiB, WS_HGS = 825 * MiB, WS_SZA = 890 * MiB, WS_SZH = 955 * MiB;
constexpr size_t WS_LOGF = 1020 * MiB;
constexpr size_t WS_O1 = 1150 * MiB, WS_O2 = 1215 * MiB, WS_OATT = 1280 * MiB, WS_OH = 1345 * MiB, WS_MRG = 1410 * MiB;
constexpr size_t WS_BIG = 1475 * MiB;
constexpr size_t WS_SST = 1739 * MiB;
constexpr size_t WS_DD = 1871 * MiB;
constexpr size_t WS_END = 1874 * MiB;
#ifndef TEAM_STRIDE
#define TEAM_STRIDE 16
#endif
#ifndef STARTERS
#define STARTERS 8
#endif
constexpr int T_TEAM = 256 / TEAM_STRIDE;
#ifndef G3_STAGGER_TICKS
#define G3_STAGGER_TICKS 800
#endif
#ifndef HG_SEGS
#define HG_SEGS 4
#endif
constexpr int HG_G = HG_SEGS;
constexpr size_t WS_QS = WS_BIG, WS_SL = WS_BIG + 64 * MiB, WS_DSEG = WS_BIG + 96 * MiB, WS_RAW = WS_SST;
constexpr int CW_BAR = 4096, CW_Q = 8192, CW_HS = 16384;
static_assert(pg8::EpiWin::O_Q == WS_Q && pg8::EpiWin::O_K == WS_K && pg8::EpiWin::O_V == WS_V && pg8::EpiWin::O_QQ == WS_QQ && pg8::EpiWin::O_KK == WS_KK && pg8::EpiWin::O_VV == WS_VV && pg8::EpiWin::O_HGS == WS_HGS && pg8::EpiWin::O_SZA == WS_SZA && pg8::EpiWin::O_SZH == WS_SZH && pg8::EpiWin::O_LOGF == WS_LOGF && pg8::EpiWin::O_LB == WS_LB && pg8::EpiWin::OK_P_ == OK_P && pg8::EpiWin::OV_P_ == OV_P && pg8::EpiWin::OK_S_ == OK_S && pg8::EpiWin::OV_S_ == OV_S, "EpiWin offsets");

constexpr int RING_OFF = 0, RING_BYTES = 139264;
constexpr int LDSCTL_OFF = RING_BYTES, MISC_OFF = LDSCTL_OFF + 320;
constexpr int LDS_BYTES = 147456;

struct Frame {
    LAS unsigned char* lds;
    volatile LAS unsigned* MISC;
    gu32* ctl;
    int tid, lane, wave;
    int vcu, G;
};
typedef float f32x16 __attribute__((ext_vector_type(16)));
typedef unsigned v2u __attribute__((ext_vector_type(2)));

__device__ __forceinline__ float shx(float v, int mask, int lane) { return __builtin_bit_cast(float, __builtin_amdgcn_ds_bpermute((lane ^ mask) << 2, __builtin_bit_cast(int, v))); }
__device__ __forceinline__ float wave_sum(float v, int lane) {
#pragma unroll
    for (int o = 1; o < 64; o <<= 1) v += shx(v, o, lane);
    return v;
}
__device__ __forceinline__ float bf2f(bf16 b) { return __builtin_bit_cast(float, (unsigned)b << 16); }
__device__ __forceinline__ unsigned cvtpk(float lo, float hi) { return pg8::cvt_pk_bf16(lo, hi); }
__device__ __forceinline__ bf16x8 pack8(f32x4 a, f32x4 b) { v4u w; w.x = cvtpk(a[0], a[1]); w.y = cvtpk(a[2], a[3]); w.z = cvtpk(b[0], b[1]); w.w = cvtpk(b[2], b[3]); return __builtin_bit_cast(bf16x8, w); }
__device__ __forceinline__ float lam_init_of(int l) { asm volatile("" : "+s"(l)); return 0.8f - 0.6f * __expf(-0.3f * (float)l); }

__device__ __forceinline__ void p0_transpose_item(const float* W, int K, int N, bf16* WT, bool gu, LAS float* scr, int item, int lane) {
    const int nblk = N / 32, kb = item / nblk, nb = item % nblk, k0 = 64 * kb, nd0 = 32 * nb;
    const int ns0 = gu ? (((nd0 >> 7) & 1) * 2816 + (nd0 >> 8) * 128 + (nd0 & 127)) : nd0;
#pragma unroll 8
    for (int i = 0; i < 32; ++i) { const int kk = 2 * i + (lane >> 5); scr[kk * 33 + (lane & 31)] = W[(size_t)(k0 + kk) * N + ns0 + (lane & 31)]; }
    LDS_WAIT(); asm volatile("" ::: "memory");
    const int c = lane & 7;
#pragma unroll
    for (int j = 0; j < 4; ++j) { const int n = (lane >> 3) + 8 * j; const LAS float* s = scr + (8 * c) * 33 + n;
        v4u o; o.x = pk2(s[0 * 33], s[1 * 33]); o.y = pk2(s[2 * 33], s[3 * 33]); o.z = pk2(s[4 * 33], s[5 * 33]); o.w = pk2(s[6 * 33], s[7 * 33]);
        *(GAS v4u*)(WT + (size_t)(nd0 + n) * K + k0 + 8 * c) = o; }
    LDS_WAIT(); asm volatile("" ::: "memory");
}
typedef const __attribute__((address_space(4))) char* kaptr_t;
__device__ __forceinline__ const float* karg(int i) { kaptr_t ka = (kaptr_t)__builtin_amdgcn_kernarg_segment_ptr(); asm volatile("" : "+s"(ka)); return *(const float* const __attribute__((address_space(4)))*)(ka + 8 * i); }
enum { A_XP = 0, A_XS, A_CK, A_CV, A_ST, A_CP, A_CS, A_WADA, A_BADA, A_GFFN1, A_WGU1, A_WD1, A_GMIX, A_WIN, A_LAM, A_GSUB, A_LBL, A_GHG, A_WBA, A_WBH, A_WOUT, A_GFFN2, A_WGU2, A_WD2, A_GFIN, A_OUT, A_WS };
__device__ __forceinline__ void p0_prologue(Frame& F, unsigned char* ws) {
    { LAS float* scr = (LAS float*)(F.lds + RING_OFF + F.wave * 16384);
      const int gw = F.vcu * NWAVES + F.wave, NGW = F.G * NWAVES;
      constexpr int I_GU = 16 * 176, I_D = 44 * 32, I_IN = 16 * 288, I_SQ = 16 * 32, I_LAYER = 2 * I_GU + 2 * I_D + I_IN + 3 * I_SQ;
      for (int it = gw; it < DEPTH * I_LAYER; it += NGW) {
          const int l = it / I_LAYER; int r = it % I_LAYER; unsigned char* wl = ws + WS_W + (size_t)l * W_LAYER;
          if (r < I_GU) { p0_transpose_item(karg(A_WGU1) + (size_t)l * 1024 * 5632, 1024, 5632, (bf16*)(wl + WO_GU1), true, scr, r, F.lane); continue; } r -= I_GU;
          if (r < I_D)  { p0_transpose_item(karg(A_WD1) + (size_t)l * 2816 * 1024, 2816, 1024, (bf16*)(wl + WO_D1), false, scr, r, F.lane); continue; } r -= I_D;
          if (r < I_IN) { p0_transpose_item(karg(A_WIN) + (size_t)l * 1024 * 9216, 1024, 9216, (bf16*)(wl + WO_IN), false, scr, r, F.lane); continue; } r -= I_IN;
          if (r < I_SQ) { p0_transpose_item(karg(A_WBA) + (size_t)l * 1024 * 1024, 1024, 1024, (bf16*)(wl + WO_BA), false, scr, r, F.lane); continue; } r -= I_SQ;
          if (r < I_SQ) { p0_transpose_item(karg(A_WBH) + (size_t)l * 1024 * 1024, 1024, 1024, (bf16*)(wl + WO_BH), false, scr, r, F.lane); continue; } r -= I_SQ;
          if (r < I_SQ) { p0_transpose_item(karg(A_WOUT) + (size_t)l * 1024 * 1024, 1024, 1024, (bf16*)(wl + WO_OUT), false, scr, r, F.lane); continue; } r -= I_SQ;
          if (r < I_GU) { p0_transpose_item(karg(A_WGU2) + (size_t)l * 1024 * 5632, 1024, 5632, (bf16*)(wl + WO_GU2), true, scr, r, F.lane); continue; } r -= I_GU;
          p0_transpose_item(karg(A_WD2) + (size_t)l * 2816 * 1024, 2816, 1024, (bf16*)(wl + WO_D2), false, scr, r, F.lane);
      } }
    __syncthreads();
    { const float* c_p = karg(A_CP); const float* c_s = karg(A_CS); const float* w_ada = karg(A_WADA); const float* b_ada = karg(A_BADA);
      LAS float* ca = (LAS float*)(F.lds);
      LAS float* red = (LAS float*)(F.lds + 81920);
      for (int i = F.tid; i < NSEQ * 1024; i += NWAVES * 64) { const int s = i >> 10, k = i & 1023; const float c = s < 4 ? c_p[s * 1024 + k] : c_s[(s - 4) * 1024 + k]; ca[i] = pg8::silu_f(c); }
      __syncthreads();
      float* MOD = (float*)(ws + WS_MOD);
      for (int it = F.vcu; it < DEPTH * 144; it += F.G) {
          const int l = it / 144, n = (it % 144) * 64 + F.lane; const float* wp = w_ada + ((size_t)l * 1024 + F.wave * 128) * 9216 + n;
          float acc[NSEQ];
#pragma unroll
          for (int s = 0; s < NSEQ; ++s) acc[s] = 0.f;
#pragma unroll 4
          for (int k = 0; k < 128; ++k) { const float w = wp[(size_t)k * 9216];
#pragma unroll
              for (int s = 0; s < NSEQ; ++s) acc[s] += ca[s * 1024 + F.wave * 128 + k] * w; }
#pragma unroll
          for (int s = 0; s < NSEQ; ++s) red[(F.wave * NSEQ + s) * 64 + F.lane] = acc[s];
          __syncthreads();
          for (int i = F.tid; i < NSEQ * 64; i += NWAVES * 64) { const int s = i >> 6, c = i & 63; float v = 0.f;
#pragma unroll
              for (int w = 0; w < 8; ++w) v += red[(w * NSEQ + s) * 64 + c];
              const int nn = (it % 144) * 64 + c; MOD[((size_t)l * NSEQ + s) * 9216 + nn] = v + b_ada[(size_t)l * 9216 + nn]; }
          __syncthreads();
      } }
    if (F.vcu == 0) { float* LB = (float*)(ws + WS_LB); const float* lb_logits = karg(A_LBL);
        for (int c = F.tid; c < 1024; c += NWAVES * 64) { float lg[4], mx = -INFINITY;
#pragma unroll
            for (int l = 0; l < 4; ++l) { lg[l] = lb_logits[l * 1024 + c]; mx = __builtin_fmaxf(mx, lg[l]); }
            float sum = 0.f;
#pragma unroll
            for (int l = 0; l < 4; ++l) { lg[l] = __expf(lg[l] - mx); sum += lg[l]; }
            const float inv = 1.f / sum; float cs = 0.f;
#pragma unroll
            for (int l = 0; l < 4; ++l) { cs += lg[l] * inv; LB[l * 1024 + c] = cs - lg[0] * inv; } } }
}

__device__ __forceinline__ void norm_phase(Frame& F, const float* X, const float* g, const float* mod_l, int sub, bf16* XN, int row0, int row1, int gw, int NGW) {
    const int RW = (row1 - row0) / NGW, rbeg = row0 + gw * RW;
    const float* mp = mod_l + (size_t)pg8::row_seq(rbeg) * 9216 + sub * 3 * 1024;
    f32x4 av[4], bv[4];
#pragma unroll
    for (int j = 0; j < 4; ++j) { const int c = 4 * F.lane + 256 * j; const f32x4 gg = *(const f32x4*)(g + c), sc = *(const f32x4*)(mp + 1024 + c); bv[j] = *(const f32x4*)(mp + c); av[j] = gg * (sc + 1.f); }
    for (int i = 0; i < RW; i += 2) {
        const int row = rbeg + i;
        const float* src = X + (size_t)row * DM;
        const f32x4* xr = (const f32x4*)src + F.lane; f32x4 v[2][4]; float s2[2] = {0.f, 0.f};
#pragma unroll
        for (int u = 0; u < 2; ++u)
#pragma unroll
            for (int j = 0; j < 4; ++j) v[u][j] = xr[u * 256 + 64 * j];
#pragma unroll
        for (int u = 0; u < 2; ++u)
#pragma unroll
            for (int j = 0; j < 4; ++j) s2[u] += (v[u][j].x * v[u][j].x + v[u][j].y * v[u][j].y) + (v[u][j].z * v[u][j].z + v[u][j].w * v[u][j].w);
#pragma unroll
        for (int u = 0; u < 2; ++u) { const float rstd = __builtin_amdgcn_rsqf(wave_sum(s2[u], F.lane) * (1.f / DM) + EPS);
            v2u* o8 = (v2u*)(XN + (size_t)(row + u) * DM) + F.lane;
#pragma unroll
            for (int j = 0; j < 4; ++j) { const f32x4 h = (v[u][j] * rstd) * av[j] + bv[j]; v2u o; o.x = cvtpk(h.x, h.y); o.y = cvtpk(h.z, h.w); o8[64 * j] = o; } }
    }
}
__device__ __forceinline__ void final_norm_phase(Frame& F, const float* X, const float* g, float* out) {
    const int gw = F.vcu * NWAVES + F.wave, NGW = F.G * NWAVES;
    for (int row = gw; row < MROWS; row += NGW) {
        const f32x4* xr = (const f32x4*)(X + (size_t)row * DM) + F.lane; f32x4 v[4]; float s2 = 0.f;
#pragma unroll
        for (int j = 0; j < 4; ++j) { v[j] = xr[64 * j]; s2 += (v[j].x * v[j].x + v[j].y * v[j].y) + (v[j].z * v[j].z + v[j].w * v[j].w); }
        const float rstd = __builtin_amdgcn_rsqf(wave_sum(s2, F.lane) * (1.f / DM) + EPS);
        f32x4* o = (f32x4*)(out + (row < MP ? OY_P + (size_t)row * DM : OY_S + (size_t)(row - MP) * DM)) + F.lane;
#pragma unroll
        for (int j = 0; j < 4; ++j) { const f32x4 gg = *(const f32x4*)(g + 4 * F.lane + 256 * j); o[64 * j] = (v[j] * rstd) * gg; }
    }
}
__device__ __forceinline__ float lam_of(const float* att_lambda, int l, int lane) {
    const float* lp = att_lambda + (size_t)l * 256;
    const float a = wave_sum(lp[lane] * lp[64 + lane], lane), b = wave_sum(lp[128 + lane] * lp[192 + lane], lane);
    return __expf(a) - __expf(b) + lam_init_of(l);
}
__device__ __forceinline__ void attn_combine_phase(Frame& F, const bf16* O1, const bf16* O2, const float* gsub, float lam, float osc, bf16* OATT) {
    const int gw = F.vcu * NWAVES + F.wave, NGW = F.G * NWAVES; const int cl = (F.lane & 7) * 16;
    float gv[16];
#pragma unroll
    for (int i = 0; i < 16; ++i) gv[i] = gsub[cl + i] * osc;
    for (int row = gw; row < MP; row += 2 * NGW) {
        v4u a0[2], a1[2], b0[2], b1[2];
#pragma unroll
        for (int u = 0; u < 2; ++u) { const size_t off = (size_t)(row + u * NGW) * DM + F.lane * 16; a0[u] = *(const v4u*)(O1 + off); a1[u] = *(const v4u*)(O1 + off + 8); b0[u] = *(const v4u*)(O2 + off); b1[u] = *(const v4u*)(O2 + off + 8); }
#pragma unroll
        for (int u = 0; u < 2; ++u) { const size_t off = (size_t)(row + u * NGW) * DM + F.lane * 16;
            const unsigned aw[8] = {a0[u].x, a0[u].y, a0[u].z, a0[u].w, a1[u].x, a1[u].y, a1[u].z, a1[u].w}, bw[8] = {b0[u].x, b0[u].y, b0[u].z, b0[u].w, b1[u].x, b1[u].y, b1[u].z, b1[u].w};
            float o[16]; float ss = 0.f;
#pragma unroll
            for (int i = 0; i < 8; ++i) { o[2 * i] = pg8::bf_lo(aw[i]) - lam * pg8::bf_lo(bw[i]); o[2 * i + 1] = pg8::bf_hi(aw[i]) - lam * pg8::bf_hi(bw[i]); ss += o[2 * i] * o[2 * i] + o[2 * i + 1] * o[2 * i + 1]; }
            ss += shx(ss, 1, F.lane); ss += shx(ss, 2, F.lane); ss += shx(ss, 4, F.lane);
            const float rstd = __builtin_amdgcn_rsqf(ss * (1.f / 128.f) + EPS);
            v4u w0, w1;
            w0.x = cvtpk(o[0] * rstd * gv[0], o[1] * rstd * gv[1]); w0.y = cvtpk(o[2] * rstd * gv[2], o[3] * rstd * gv[3]); w0.z = cvtpk(o[4] * rstd * gv[4], o[5] * rstd * gv[5]); w0.w = cvtpk(o[6] * rstd * gv[6], o[7] * rstd * gv[7]);
            w1.x = cvtpk(o[8] * rstd * gv[8], o[9] * rstd * gv[9]); w1.y = cvtpk(o[10] * rstd * gv[10], o[11] * rstd * gv[11]); w1.z = cvtpk(o[12] * rstd * gv[12], o[13] * rstd * gv[13]); w1.w = cvtpk(o[14] * rstd * gv[14], o[15] * rstd * gv[15]);
            *(v4u*)(OATT + off) = w0; *(v4u*)(OATT + off + 8) = w1; }
    }
}

__device__ __forceinline__ void attn_sample_unit(Frame& F, const float* cache_k, const float* cache_v, int l, int s, int head, const bf16* Qb, const bf16* Kb, const bf16* Vb, float lam, float osc, const float* gsub, bf16* OATT) {
    const int lane = F.lane, w = F.wave, q = lane & 31, hh = lane >> 5, vt = w & 3, kh = w >> 2;
    LAS float* SLOT = (LAS float*)(F.lds);
    LAS float* ML = (LAS float*)(F.lds + 16384);
    LAS float* SSQ = (LAS float*)(F.lds + 16384 + 512);
    const size_t qrow = (size_t)MP + (size_t)s * 32;
    const float* ck = cache_k + ((size_t)(l * 16 + s) * PAST) * 1024 + head * 128;
    const float* cv = cache_v + ((size_t)(l * 16 + s) * PAST) * 1024 + head * 128;
    f32x16 o1;
#pragma unroll
    for (int r = 0; r < 16; ++r) o1[r] = 0.f;
    for (int m = 0; m < 2; ++m) {
        bf16x8 qf[4];
#pragma unroll
        for (int ks = 0; ks < 4; ++ks) qf[ks] = *(const bf16x8*)(Qb + (qrow + q) * 1024 + head * 128 + m * 64 + ks * 16 + 8 * hh);
        float mrun = -INFINITY, lrun = 0.f; f32x16 ot;
#pragma unroll
        for (int r = 0; r < 16; ++r) ot[r] = 0.f;
        const int ntile = 32 + kh;
        f32x4 kraw[8]; float vraw[16];
#define SA_ISSUE(tt) do { const int k0_ = kh * 1024 + (tt) * 32; const float* kp = ck + (size_t)(k0_ + q) * 1024 + m * 64 + 8 * hh; const float* vp = cv + (size_t)(k0_ + 4 * hh) * 1024 + 32 * vt + q; \
            _Pragma("unroll") for (int ks = 0; ks < 4; ++ks) { kraw[2 * ks] = *(const f32x4*)(kp + ks * 16); kraw[2 * ks + 1] = *(const f32x4*)(kp + ks * 16 + 4); } \
            _Pragma("unroll") for (int s2 = 0; s2 < 2; ++s2) _Pragma("unroll") for (int j = 0; j < 8; ++j) vraw[s2 * 8 + j] = vp[(16 * s2 + 8 * (j >> 2) + (j & 3)) * 1024]; } while (0)
        SA_ISSUE(0);
        for (int t = 0; t < ntile; ++t) {
            const bool nw = (t == 32);
            bf16x8 kf[4]; bf16x8 awv[2];
            if (!nw) {
#pragma unroll
                for (int ks = 0; ks < 4; ++ks) kf[ks] = pack8(kraw[2 * ks], kraw[2 * ks + 1]);
#pragma unroll
                for (int s2 = 0; s2 < 2; ++s2) { v4u aw; aw.x = cvtpk(vraw[s2 * 8 + 0], vraw[s2 * 8 + 1]); aw.y = cvtpk(vraw[s2 * 8 + 2], vraw[s2 * 8 + 3]); aw.z = cvtpk(vraw[s2 * 8 + 4], vraw[s2 * 8 + 5]); aw.w = cvtpk(vraw[s2 * 8 + 6], vraw[s2 * 8 + 7]); awv[s2] = __builtin_bit_cast(bf16x8, aw); }
                asm volatile("" ::: "memory");
                if (t + 1 < 32) SA_ISSUE(t + 1);
                asm volatile("" ::: "memory");
            } else {
#pragma unroll
                for (int ks = 0; ks < 4; ++ks) kf[ks] = *(const bf16x8*)(Kb + (qrow + q) * 1024 + head * 128 + m * 64 + ks * 16 + 8 * hh);
                const bf16* vpn = Vb + (qrow + 4 * hh) * 1024 + head * 128 + 32 * vt + q;
#pragma unroll
                for (int s2 = 0; s2 < 2; ++s2) { float vf[8];
#pragma unroll
                    for (int j = 0; j < 8; ++j) vf[j] = bf2f(vpn[(16 * s2 + 8 * (j >> 2) + (j & 3)) * 1024]);
                    v4u aw; aw.x = cvtpk(vf[0], vf[1]); aw.y = cvtpk(vf[2], vf[3]); aw.z = cvtpk(vf[4], vf[5]); aw.w = cvtpk(vf[6], vf[7]); awv[s2] = __builtin_bit_cast(bf16x8, aw); }
            }
            f32x16 st;
#pragma unroll
            for (int r = 0; r < 16; ++r) st[r] = 0.f;
#pragma unroll
            for (int ks = 0; ks < 4; ++ks) st = __builtin_amdgcn_mfma_f32_32x32x16_bf16(kf[ks], qf[ks], st, 0, 0, 0);
            float tm = st[0];
#pragma unroll
            for (int r = 1; r < 16; ++r) tm = __builtin_fmaxf(tm, st[r]);
            tm = __builtin_fmaxf(tm, shx(tm, 32, lane));
            const float mnew = __builtin_fmaxf(mrun, tm), alpha = __builtin_amdgcn_exp2f(mrun - mnew);
            float ls = 0.f;
#pragma unroll
            for (int r = 0; r < 16; ++r) { st[r] = __builtin_amdgcn_exp2f(st[r] - mnew); ls += st[r]; }
            ls += shx(ls, 32, lane);
            lrun = lrun * alpha + ls; mrun = mnew;
#pragma unroll
            for (int r = 0; r < 16; ++r) ot[r] *= alpha;
#pragma unroll
            for (int s2 = 0; s2 < 2; ++s2) { v4u pw; pw.x = cvtpk(st[8 * s2], st[8 * s2 + 1]); pw.y = cvtpk(st[8 * s2 + 2], st[8 * s2 + 3]); pw.z = cvtpk(st[8 * s2 + 4], st[8 * s2 + 5]); pw.w = cvtpk(st[8 * s2 + 6], st[8 * s2 + 7]);
                ot = __builtin_amdgcn_mfma_f32_32x32x16_bf16(awv[s2], __builtin_bit_cast(bf16x8, pw), ot, 0, 0, 0); }
        }
#undef SA_ISSUE
        if (vt == 0 && hh == 0) { ML[(kh * 32 + q) * 2] = mrun; ML[(kh * 32 + q) * 2 + 1] = lrun; }
        __syncthreads();
        const float m0 = ML[q * 2], l0 = ML[q * 2 + 1], m1 = ML[(32 + q) * 2], l1 = ML[(32 + q) * 2 + 1];
        const float Mx = __builtin_fmaxf(m0, m1), L = l0 * __builtin_amdgcn_exp2f(m0 - Mx) + l1 * __builtin_amdgcn_exp2f(m1 - Mx);
        { const float sc = __builtin_amdgcn_exp2f(mrun - Mx);
#pragma unroll
          for (int r = 0; r < 16; ++r) ot[r] *= sc; }
        if (kh == 1) {
#pragma unroll
            for (int r = 0; r < 16; ++r) SLOT[(vt * 16 + r) * 64 + lane] = ot[r]; }
        __syncthreads();
        if (kh == 0) { const float rl = 1.f / L;
#pragma unroll
            for (int r = 0; r < 16; ++r) ot[r] = (ot[r] + SLOT[(vt * 16 + r) * 64 + lane]) * rl;
            if (m == 0) {
#pragma unroll
                for (int r = 0; r < 16; ++r) o1[r] = ot[r];
            } else { float ss = 0.f;
#pragma unroll
                for (int r = 0; r < 16; ++r) { o1[r] = o1[r] - lam * ot[r]; ss += o1[r] * o1[r]; }
                ss += shx(ss, 32, lane);
                if (hh == 0) SSQ[vt * 32 + q] = ss; } }
        __syncthreads();
    }
    if (kh == 0) {
        const float ss = SSQ[q] + SSQ[32 + q] + SSQ[64 + q] + SSQ[96 + q];
        const float rstd = __builtin_amdgcn_rsqf(ss * (1.f / 128.f) + EPS) * osc;
#pragma unroll
        for (int r = 0; r < 16; ++r) { const int v = 32 * vt + (r & 3) + 8 * (r >> 2) + 4 * hh; OATT[(qrow + q) * 1024 + head * 128 + v] = (bf16)f2bf(o1[r] * rstd * gsub[v]); }
    }
    __syncthreads();
}

constexpr int HS = 72, HK = 136;
__device__ __forceinline__ f32x4 mfma16(bf16x8 a, bf16x8 b, f32x4 c) { return __builtin_amdgcn_mfma_f32_16x16x32_bf16(a, b, c, 0, 0, 0); }
__device__ __forceinline__ void st16bf(LAS bf16* p, const float (&v)[16]) {
    v4u a, b; a.x = cvtpk(v[0], v[1]); a.y = cvtpk(v[2], v[3]); a.z = cvtpk(v[4], v[5]); a.w = cvtpk(v[6], v[7]); b.x = cvtpk(v[8], v[9]); b.y = cvtpk(v[10], v[11]); b.z = cvtpk(v[12], v[13]); b.w = cvtpk(v[14], v[15]);
    *(LAS v4u*)p = a; *(LAS v4u*)(p + 8) = b;
}
__device__ __forceinline__ float bfu(unsigned b) { return __builtin_bit_cast(float, b << 16); }
struct HgPtrs { const float* LOGF; const bf16 *QQ, *KK, *VV, *HGS; const float* ghg; bf16* OH; bf16* dump; };
typedef float f32x2v __attribute__((ext_vector_type(2)));
__device__ __forceinline__ void hg_load(const HgPtrs& P, size_t ubase  , unsigned k0, int w, int nvalid, f32x2v (&lf)[8], unsigned (&qv)[8], unsigned (&kv)[8], unsigned (&vv)[8]) {
    if (w * 8 < nvalid) {
#pragma unroll
        for (int i = 0; i < 8; ++i) { const size_t o = ubase + (size_t)(w * 8 + i) * 1024;
            const float* lp = P.LOGF + o; const bf16* qp = P.QQ + o; const bf16* kp = P.KK + o; const bf16* vp = P.VV + o;
            lf[i] = *(const f32x2v*)(lp + k0); qv[i] = *(const unsigned*)(qp + k0); kv[i] = *(const unsigned*)(kp + k0); vv[i] = *(const unsigned*)(vp + k0); }
    } else {
#pragma unroll
        for (int i = 0; i < 8; ++i) { lf[i] = (f32x2v){0.f, 0.f}; qv[i] = 0u; kv[i] = 0u; vv[i] = 0u; }
    }
}
#define HG_BAR() asm volatile("s_waitcnt lgkmcnt(0)\n\ts_barrier" ::: "memory")
template <int MODE> __device__ __forceinline__ void hg_sequence(Frame& F, const HgPtrs& P, size_t row0, int h, int nchunk, int nvalid, const float* s_in, float* s_out, bf16* QS, float* RAW, float* dseg) {
    LAS float* seg = (LAS float*)(F.lds);
    LAS float* part = (LAS float*)(F.lds + 4096);
    LAS float* dvec = (LAS float*)(F.lds + 6144);
    LAS bf16* QH = (LAS bf16*)(F.lds + 8192);
    LAS bf16* QT = QH + 64 * HK;
    LAS bf16* KH = QT + 64 * HK;
    LAS bf16* VT = KH + 160 * HK;
    LAS bf16* KT = VT + 128 * HS;
    LAS bf16* AL = KT + 128 * HS;
    const int w = __builtin_amdgcn_readfirstlane(F.wave), sc = w >> 1, lr_ = F.lane & 15, lq_ = F.lane >> 4; const unsigned k0_ = 2u * (unsigned)F.lane;
    f32x4 S[8];
#pragma unroll
    for (int kb = 0; kb < 8; ++kb)
#pragma unroll
        for (int r = 0; r < 4; ++r) S[kb][r] = s_in ? s_in[(size_t)(16 * kb + 4 * lq_ + r) * 128 + 16 * w + lr_] : 0.f;
    const float gv = P.ghg[16 * w + lr_];
    f32x2v bseg = {0.f, 0.f};
#ifdef PROBE_HSEC
    unsigned long long tacc = 0, tq0 = 0;
#define HT0(id) do { if (PROBE_HSEC == (id)) tq0 = __builtin_amdgcn_s_memrealtime(); } while (0)
#define HT1(id) do { if (PROBE_HSEC == (id)) tacc += __builtin_amdgcn_s_memrealtime() - tq0; } while (0)
#else
#define HT0(id) do {} while (0)
#define HT1(id) do {} while (0)
#endif
    f32x2v lf[8]; unsigned qv[8], kv[8], vv[8];
    hg_load(P, row0 * 1024 + h * 128, k0_, w, nvalid, lf, qv, kv, vv);
    for (int c = 0; c < nchunk; ++c) {
        int lr = lr_, lq = lq_; unsigned k0 = k0_; asm volatile("" : "+v"(lr), "+v"(lq), "+v"(k0));
        const int lx = lq * 16 + lr;
        const size_t crow = row0 + (size_t)c * 64;
        HT0(1);
        f32x2v cs[8]; { f32x2v run = {0.f, 0.f};
#pragma unroll
            for (int i = 0; i < 8; ++i) { run = run + lf[i]; cs[i] = run; }
            *(LAS f32x2v*)(seg + w * 128 + k0) = run; }
        HG_BAR();
        f32x2v P2[4], mypre = {0.f, 0.f}, tot; { f32x2v p = {0.f, 0.f};
#pragma unroll
            for (int s = 0; s < 8; ++s) { if ((s & 1) == 0) P2[s >> 1] = p; mypre = (s == w) ? p : mypre; p = p + *(const LAS f32x2v*)(seg + s * 128 + k0); } tot = p; }
        f32x2v myref = P2[0], nref = P2[1];
#pragma unroll
        for (int s = 1; s < 4; ++s) { myref = (s == sc) ? P2[s] : myref; nref = (s == sc) ? (s == 3 ? tot : P2[s < 3 ? s + 1 : 3]) : nref; }
        const f32x2v dq = mypre - myref;
        f32x2v fq, fT, fK[4]; fq.x = __expf(myref.x); fq.y = __expf(myref.y); fT.x = __expf(tot.x - nref.x); fT.y = __expf(tot.y - nref.y);
#pragma unroll
        for (int ii = 1; ii < 4; ++ii) { fK[ii].x = __expf(__builtin_fminf(P2[ii].x - nref.x, 0.f)); fK[ii].y = __expf(__builtin_fminf(P2[ii].y - nref.y, 0.f)); }
        f32x2v fqs = fq; if constexpr (MODE == 1) { fqs.x = fq.x * __expf(bseg.x); fqs.y = fq.y * __expf(bseg.y); bseg = bseg + tot; }
        float t0[8], t1[8];
#pragma unroll
        for (int i = 0; i < 8; ++i) { const int r = w * 8 + i; const float q0 = bfu(qv[i] & 0xffffu), q1 = bfu(qv[i] >> 16), a0 = bfu(kv[i] & 0xffffu), a1 = bfu(kv[i] >> 16);
            const float E0 = dq.x + cs[i].x, E1 = dq.y + cs[i].y;
            const float e1x = __expf(E0), e1y = __expf(E1);
            const float e2x = __builtin_fminf(__builtin_amdgcn_rcpf(e1x), 5.5e34f), e2y = __builtin_fminf(__builtin_amdgcn_rcpf(e1y), 5.5e34f);
            const float e3x = __expf((nref.x - myref.x) - E0), e3y = __expf((nref.y - myref.y) - E1);
            *(LAS unsigned*)(QH + r * HK + k0) = cvtpk(q0 * e1x, q1 * e1y);
            *(LAS unsigned*)(QT + r * HK + k0) = cvtpk(q0 * e1x * fq.x, q1 * e1y * fq.y);
            if constexpr (MODE == 1) { bf16* qsp = QS + (crow + r) * 1024 + h * 128; *(unsigned*)(qsp + k0) = cvtpk(q0 * e1x * fqs.x, q1 * e1y * fqs.y); }
            const float b0 = a0 * e3x, b1 = a1 * e3y;
            { const int rb = (sc == 0) ? 0 : (sc == 1) ? 16 : (sc == 2) ? 48 : 96; *(LAS unsigned*)(KH + (rb + r) * HK + k0) = cvtpk(a0 * e2x, a1 * e2y); }
#pragma unroll
            for (int ii = 1; ii < 4; ++ii) if (ii > sc) { const int rb = (ii == 1) ? 16 : (ii == 2) ? 48 : 96; *(LAS unsigned*)(KH + (rb + r) * HK + k0) = cvtpk(b0 * fK[ii].x, b1 * fK[ii].y); }
            t0[i] = b0 * fT.x; t1[i] = b1 * fT.y; }
        { v4u u0, u1; u0.x = cvtpk(t0[0], t0[1]); u0.y = cvtpk(t0[2], t0[3]); u0.z = cvtpk(t0[4], t0[5]); u0.w = cvtpk(t0[6], t0[7]); u1.x = cvtpk(t1[0], t1[1]); u1.y = cvtpk(t1[2], t1[3]); u1.z = cvtpk(t1[4], t1[5]); u1.w = cvtpk(t1[6], t1[7]);
          *(LAS v4u*)(KT + k0 * HS + 8 * w) = u0; *(LAS v4u*)(KT + (k0 + 1) * HS + 8 * w) = u1; }
        { v4u u0, u1;
          u0.x = (vv[0] & 0xffffu) | (vv[1] << 16); u0.y = (vv[2] & 0xffffu) | (vv[3] << 16); u0.z = (vv[4] & 0xffffu) | (vv[5] << 16); u0.w = (vv[6] & 0xffffu) | (vv[7] << 16);
          u1.x = (vv[0] >> 16) | (vv[1] & 0xffff0000u); u1.y = (vv[2] >> 16) | (vv[3] & 0xffff0000u); u1.z = (vv[4] >> 16) | (vv[5] & 0xffff0000u); u1.w = (vv[6] >> 16) | (vv[7] & 0xffff0000u);
          *(LAS v4u*)(VT + k0 * HS + 8 * w) = u0; *(LAS v4u*)(VT + (k0 + 1) * HS + 8 * w) = u1;
          if (w == 0) { f32x2v d; d.x = __expf(tot.x); d.y = __expf(tot.y); *(LAS f32x2v*)(dvec + k0) = d; } }
        HG_BAR();
        HT1(1); HT0(2);
        if (c + 1 < nchunk) hg_load(P, (crow + 64) * 1024 + h * 128, k0, w, nvalid, lf, qv, kv, vv);
        unsigned short hgv[16];
        if constexpr (MODE == 0) { const bf16* hp = P.HGS + crow * 1024 + h * 128 + 16 * w;
#pragma unroll
          for (int mt = 0; mt < 4; ++mt)
#pragma unroll
              for (int r = 0; r < 4; ++r) { int t = 16 * mt + 4 * lq + r; t = t < nvalid ? t : nvalid - 1; hgv[mt * 4 + r] = hp[(unsigned)(t * 1024 + lr)]; } }
#pragma unroll
        for (int rr = 0; rr < 2; ++rr) { const int blk = w + 8 * rr, bi = blk >> 2, bj = blk & 3;
            f32x4 acc = {0.f, 0.f, 0.f, 0.f};
            if (bj <= bi) { const int rb = (bi == 0) ? 0 : (bi == 1) ? 16 : (bi == 2) ? 48 : 96;
#pragma unroll
                for (int ks = 0; ks < 4; ++ks) { const bf16x8 a = *(const LAS bf16x8*)(QH + (16 * bi + lr) * HK + ks * 32 + 8 * lq), b = *(const LAS bf16x8*)(KH + (rb + 16 * bj + lr) * HK + ks * 32 + 8 * lq); acc = mfma16(a, b, acc); }
                if (bi == bj) {
#pragma unroll
                    for (int r = 0; r < 4; ++r) acc[r] = (lr <= 4 * lq + r) ? acc[r] : 0.f; } }
#pragma unroll
            for (int r = 0; r < 4; ++r) AL[(16 * bi + 4 * lq + r) * HS + 16 * bj + lr] = (bf16)f2bf(acc[r]); }
        HG_BAR();
        HT1(2); HT0(3);
        f32x4 o[4];
        { bf16x8 bS[4], bV[2];
#pragma unroll
          for (int kp = 0; kp < 4; ++kp) { v4u t; t.x = cvtpk(S[2 * kp][0], S[2 * kp][1]); t.y = cvtpk(S[2 * kp][2], S[2 * kp][3]); t.z = cvtpk(S[2 * kp + 1][0], S[2 * kp + 1][1]); t.w = cvtpk(S[2 * kp + 1][2], S[2 * kp + 1][3]); bS[kp] = __builtin_bit_cast(bf16x8, t); }
#pragma unroll
          for (int ks = 0; ks < 2; ++ks) bV[ks] = *(const LAS bf16x8*)(VT + (16 * w + lr) * HS + ks * 32 + 8 * lq);
#pragma unroll
          for (int mt = 0; mt < 4; ++mt) { f32x4 acc = {0.f, 0.f, 0.f, 0.f};
#pragma unroll
              for (int kp = 0; kp < 4; ++kp) { const LAS bf16* qp = QT + (16 * mt + lr) * HK + 32 * kp + 4 * lq; const v2u a0 = *(const LAS v2u*)qp, a1 = *(const LAS v2u*)(qp + 16);
                  v4u a; a.x = a0.x; a.y = a0.y; a.z = a1.x; a.w = a1.y; acc = mfma16(__builtin_bit_cast(bf16x8, a), bS[kp], acc); }
#pragma unroll
              for (int ks = 0; ks < 2; ++ks) acc = mfma16(*(const LAS bf16x8*)(AL + (16 * mt + lr) * HS + ks * 32 + 8 * lq), bV[ks], acc);
              o[mt] = acc;
              if constexpr (MODE == 1) { float* rp = RAW + (crow + 16 * mt) * 1024 + h * 128 + 16 * w;
#pragma unroll
                  for (int r = 0; r < 4; ++r) rp[(unsigned)((4 * lq + r) * 1024 + lr)] = acc[r]; }
              if constexpr (MODE == 0)
#pragma unroll
              for (int r = 0; r < 4; ++r) { float p = acc[r] * acc[r]; p += shx(p, 1, lx); p += shx(p, 2, lx); p += shx(p, 4, lx); p += shx(p, 8, lx); if (lr == 0) part[(16 * mt + 4 * lq + r) * 8 + w] = p; } } }
        { bf16x8 bV[2];
#pragma unroll
          for (int ks = 0; ks < 2; ++ks) bV[ks] = *(const LAS bf16x8*)(VT + (16 * w + lr) * HS + ks * 32 + 8 * lq);
#pragma unroll
          for (int kb = 0; kb < 8; ++kb) { const f32x4 d = *(const LAS f32x4*)(dvec + 16 * kb + 4 * lq); f32x4 acc = S[kb] * d;
#pragma unroll
              for (int ks = 0; ks < 2; ++ks) acc = mfma16(*(const LAS bf16x8*)(KT + (16 * kb + lr) * HS + ks * 32 + 8 * lq), bV[ks], acc);
              S[kb] = acc; } }
        if constexpr (MODE == 0) {
        HG_BAR();
        { bf16* op = P.OH + crow * 1024 + h * 128 + 16 * w;
#pragma unroll
          for (int mt = 0; mt < 4; ++mt)
#pragma unroll
              for (int r = 0; r < 4; ++r) { const int t = 16 * mt + 4 * lq + r; const f32x4 p0 = *(const LAS f32x4*)(part + t * 8), p1 = *(const LAS f32x4*)(part + t * 8 + 4);
                  const float ss = ((p0[0] + p0[1]) + (p0[2] + p0[3])) + ((p1[0] + p1[1]) + (p1[2] + p1[3]));
                  const float rstd = __builtin_amdgcn_rsqf(ss * (1.f / 128.f) + EPS);
                  const bf16 ov = (bf16)f2bf(o[mt][r] * rstd * gv * bf2f(hgv[mt * 4 + r]));
                  bf16* dst = (t < nvalid) ? op + (unsigned)(t * 1024 + lr) : P.dump + F.tid;
                  *dst = ov; } }
        }
        HG_BAR();
        HT1(3);
    }
#pragma unroll
    for (int kb = 0; kb < 8; ++kb)
#pragma unroll
        for (int r = 0; r < 4; ++r) s_out[(size_t)(16 * kb + 4 * lq_ + r) * 128 + 16 * w + lr_] = S[kb][r];
    if constexpr (MODE == 1) { if (w == 0) { f32x2v d; d.x = __expf(bseg.x); d.y = __expf(bseg.y); *(f32x2v*)(dseg + k0_) = d; } }
#ifdef PROBE_HSEC
    if constexpr (MODE == 1) { if (row0 == 0 && h == 0) { const unsigned long long t1 = __builtin_amdgcn_s_memrealtime(); while (__builtin_amdgcn_s_memrealtime() - t1 < 20ull * tacc) __builtin_amdgcn_s_sleep(8); } }
#endif
#undef HT0
#undef HT1
}

__device__ __forceinline__ void hg_fix(Frame& F, const HgPtrs& P, size_t row0, int h, int nchunk, int g, int G, const float* SLseq, const float* DSseq, const bf16* QS, const float* RAW, gu32* mask, float* s_fin) {
    LAS float* part = (LAS float*)(F.lds);
    const int w = __builtin_amdgcn_readfirstlane(F.wave), lr_ = F.lane & 15, lq_ = F.lane >> 4;
    if (F.tid == 0) { const unsigned need = (1u << g) - 1u; unsigned sp = 0;
        while ((__hip_atomic_load(mask, RLX_AGENT) & need) != need) { __builtin_amdgcn_s_sleep(2); if (++sp > (1u << 22)) { __hip_atomic_store(F.ctl + 1, 0x7eb0u, RLX_AGENT); break; } }
        __builtin_amdgcn_fence(__ATOMIC_ACQUIRE, "agent"); asm volatile("s_waitcnt vmcnt(0)" ::: "memory"); }
    __syncthreads();
    f32x4 S[8];
#pragma unroll
    for (int kb = 0; kb < 8; ++kb) S[kb] = (f32x4){0.f, 0.f, 0.f, 0.f};
    for (int p = 0; p < g; ++p) { const float* sl = SLseq + (size_t)p * 16384; const float* ds = DSseq + p * 128;
#pragma unroll
        for (int kb = 0; kb < 8; ++kb) { const f32x4 d = *(const f32x4*)(ds + 16 * kb + 4 * lq_);
#pragma unroll
            for (int r = 0; r < 4; ++r) S[kb][r] = d[r] * S[kb][r] + sl[(size_t)(16 * kb + 4 * lq_ + r) * 128 + 16 * w + lr_]; } }
    if (g == G - 1) { const float* sl = SLseq + (size_t)g * 16384; const float* ds = DSseq + g * 128;
#pragma unroll
        for (int kb = 0; kb < 8; ++kb) { const f32x4 d = *(const f32x4*)(ds + 16 * kb + 4 * lq_);
#pragma unroll
            for (int r = 0; r < 4; ++r) { const size_t o = (size_t)(16 * kb + 4 * lq_ + r) * 128 + 16 * w + lr_; s_fin[o] = d[r] * S[kb][r] + sl[o]; } } }
    bf16x8 bS[4];
#pragma unroll
    for (int kp = 0; kp < 4; ++kp) { v4u t; t.x = cvtpk(S[2 * kp][0], S[2 * kp][1]); t.y = cvtpk(S[2 * kp][2], S[2 * kp][3]); t.z = cvtpk(S[2 * kp + 1][0], S[2 * kp + 1][1]); t.w = cvtpk(S[2 * kp + 1][2], S[2 * kp + 1][3]); bS[kp] = __builtin_bit_cast(bf16x8, t); }
    const float gv = P.ghg[16 * w + lr_];
    f32x4 on[4]; unsigned short hn[16]; v2u qn[4][4][2];
#define HGF_LOAD(cc) do { const size_t cr_ = row0 + (size_t)(cc) * 64; const bf16* hp = P.HGS + cr_ * 1024 + h * 128 + 16 * w; const float* rp = RAW + cr_ * 1024 + h * 128 + 16 * w; \
        _Pragma("unroll") for (int mt = 0; mt < 4; ++mt) { \
            _Pragma("unroll") for (int r = 0; r < 4; ++r) { const unsigned off = (unsigned)((16 * mt + 4 * lq_ + r) * 1024 + lr_); on[mt][r] = rp[off]; hn[mt * 4 + r] = hp[off]; } \
            const bf16* qb = QS + (cr_ + 16 * mt) * 1024 + h * 128; \
            _Pragma("unroll") for (int kp = 0; kp < 4; ++kp) { const bf16* qp = qb + (unsigned)(lr_ * 1024 + 32 * kp + 4 * lq_); qn[mt][kp][0] = *(const v2u*)qp; qn[mt][kp][1] = *(const v2u*)(qp + 16); } } } while (0)
    HGF_LOAD(0);
    for (int c = 0; c < nchunk; ++c) {
        int lr = lr_, lq = lq_; asm volatile("" : "+v"(lr), "+v"(lq)); const int lx = lq * 16 + lr;
        const size_t crow = row0 + (size_t)c * 64;
        LAS float* pt = part + (c & 1) * 512;
        f32x4 o[4]; unsigned short hgv[16];
#pragma unroll
        for (int mt = 0; mt < 4; ++mt) { f32x4 acc = on[mt];
#pragma unroll
            for (int r = 0; r < 4; ++r) hgv[mt * 4 + r] = hn[mt * 4 + r];
#pragma unroll
            for (int kp = 0; kp < 4; ++kp) { v4u a; a.x = qn[mt][kp][0].x; a.y = qn[mt][kp][0].y; a.z = qn[mt][kp][1].x; a.w = qn[mt][kp][1].y; acc = mfma16(__builtin_bit_cast(bf16x8, a), bS[kp], acc); }
            o[mt] = acc; }
        asm volatile("" ::: "memory");
        if (c + 1 < nchunk) HGF_LOAD(c + 1);
        asm volatile("" ::: "memory");
#pragma unroll
        for (int mt = 0; mt < 4; ++mt)
#pragma unroll
            for (int r = 0; r < 4; ++r) { float p = o[mt][r] * o[mt][r]; p += shx(p, 1, lx); p += shx(p, 2, lx); p += shx(p, 4, lx); p += shx(p, 8, lx); if (lr == 0) pt[(16 * mt + 4 * lq + r) * 8 + w] = p; }
        HG_BAR();
        { bf16* op = P.OH + crow * 1024 + h * 128 + 16 * w;
#pragma unroll
          for (int mt = 0; mt < 4; ++mt)
#pragma unroll
              for (int r = 0; r < 4; ++r) { const int t = 16 * mt + 4 * lq + r; const f32x4 p0 = *(const LAS f32x4*)(pt + t * 8), p1 = *(const LAS f32x4*)(pt + t * 8 + 4);
                  const float ss = ((p0[0] + p0[1]) + (p0[2] + p0[3])) + ((p1[0] + p1[1]) + (p1[2] + p1[3]));
                  const float rstd = __builtin_amdgcn_rsqf(ss * (1.f / 128.f) + EPS);
                  op[(unsigned)(t * 1024 + lr)] = (bf16)f2bf(o[mt][r] * rstd * gv * bf2f(hgv[mt * 4 + r])); } }
    }
#undef HGF_LOAD
    __syncthreads();
}
#undef HG_BAR
__device__ __forceinline__ void team_barrier(Frame& F, gu32* w, unsigned target) {
    asm volatile("s_waitcnt vmcnt(0)" ::: "memory");
    __syncthreads();
    if (F.tid == 0) {
        __builtin_amdgcn_fence(__ATOMIC_RELEASE, "agent");
        asm volatile("s_waitcnt vmcnt(0)" ::: "memory");
        (void)__hip_atomic_fetch_add(w, 1u, RLX_AGENT);
        unsigned sp = 0;
        while (__hip_atomic_load(w, RLX_AGENT) < target) { __builtin_amdgcn_s_sleep(2); if (++sp > (1u << 22)) { __hip_atomic_store(F.ctl + 1, 0x7ea0u, RLX_AGENT); break; } }
        __builtin_amdgcn_fence(__ATOMIC_ACQUIRE, "agent");
        asm volatile("s_waitcnt vmcnt(0)" ::: "memory");
    }
    __syncthreads();
}
__device__ __forceinline__ int attn_pull(Frame& F, gu32* q8  , int x0, int nitems) {
    if (F.tid == 0) {
        int res = -1;
        for (int tries = 0; tries < 16; ++tries) {
            unsigned c[8]; unsigned cmin = 0xffffffffu; int imin = 0;
#pragma unroll
            for (int h = 0; h < 8; ++h) { c[h] = __hip_atomic_load(q8 + 64 * h, RLX_AGENT); if (c[h] < cmin) { cmin = c[h]; imin = h; } }
            if (cmin >= (unsigned)nitems) break;
            unsigned cx = c[0];
#pragma unroll
            for (int h = 1; h < 8; ++h) cx = (h == x0) ? c[h] : cx;
            const int hsel = (cx < (unsigned)nitems && cx <= cmin + 6u) ? x0 : imin;
            const unsigned it = __hip_atomic_fetch_add(q8 + 64 * hsel, 1u, RLX_AGENT);
            if (it < (unsigned)nitems) { res = (hsel << 16) | (int)it; break; }
        }
        F.MISC[16] = (unsigned)res;
    }
    __syncthreads();
    const int v = (int)F.MISC[16];
    __syncthreads();
    return __builtin_amdgcn_readfirstlane(v);
}
__device__ __forceinline__ int wg_pull(Frame& F, gu32* ctr) {
    if (F.tid == 0) F.MISC[16] = __hip_atomic_fetch_add(ctr, 1u, RLX_AGENT);
    __syncthreads();
    const int v = (int)F.MISC[16];
    __syncthreads();
    return __builtin_amdgcn_readfirstlane(v);
}
#ifdef PROBE_ID
#define PT_BEGIN(id) unsigned long long pt0_##id = 0; if ((id) == PROBE_ID && blockIdx.x == 0) pt0_##id = __builtin_amdgcn_s_memrealtime()
#define PT_END(id) do { if ((id) == PROBE_ID && blockIdx.x == 0) { const unsigned long long t1 = __builtin_amdgcn_s_memrealtime(), d = t1 - pt0_##id; while (__builtin_amdgcn_s_memrealtime() - t1 < d) __builtin_amdgcn_s_sleep(8); } } while (0)
#else
#define PT_BEGIN(id) do {} while (0)
#define PT_END(id) do {} while (0)
#endif
struct Args { const float* in[25]; float* out; unsigned char* ws; };
__global__ void __launch_bounds__(NWAVES * 64, 2) mk_fwd(Args args) {
    extern __shared__ __attribute__((aligned(16))) unsigned char lds[];
    Frame F;
    F.lds = (LAS unsigned char*)lds;
    F.MISC = (volatile LAS unsigned*)(F.lds + MISC_OFF);
#define ENTER() do { F.tid = opaque_tid(); F.lane = F.tid & 63; F.wave = __builtin_amdgcn_readfirstlane(F.tid >> 6); F.G = gridDim.x; { const int bx = opaque_bid(); F.vcu = (F.G % 8 == 0) ? (bx % 8) * (F.G / 8) + bx / 8 : bx; } } while (0)
    for (int u = threadIdx.x; u < (LDS_BYTES - LDSCTL_OFF) / 4; u += NWAVES * 64) ((LAS unsigned*)(F.lds + LDSCTL_OFF))[u] = 0u;
    __syncthreads();
    tid_table_init();
    __syncthreads();
    static_assert(WTAB_LDS_ADDR == (unsigned)(MISC_OFF + 256) && MISC_OFF + 256 + 256 <= LDS_BYTES, "wave-slot table inside the LDS control area");
    ENTER();
    F.ctl = (gu32*)((unsigned char*)karg(A_WS) + WS_CTL);
    XcdBarrier bar = xcd_barrier_post((unsigned*)(F.ctl + CW_BAR), F.MISC + 8);
#define GRID_BAR() do { asm volatile("" : "+s"(bar.x)); xcd_barrier(bar); } while (0)
#define WSP(T, off) ((T*)((unsigned char*)karg(A_WS) + (off)))
#define OUTP(off) ((float*)karg(A_OUT) + (off))
#define XIN_P (l == 0 ? karg(A_XP) : WSP(const float, WS_X))
#define XIN_S (l == 0 ? karg(A_XS) - (size_t)MP * DM : WSP(const float, WS_X))

#ifndef NO_P0
    p0_prologue(F, WSP(unsigned char, 0));
#ifdef DUP_P0
    GRID_BAR(); ENTER(); p0_prologue(F, WSP(unsigned char, 0));
#endif
#endif
    GRID_BAR();

    for (int l = 0; l < DEPTH; ++l) {
        const size_t wlo = WS_W + (size_t)l * W_LAYER, modo = WS_MOD + (size_t)l * NSEQ * 9216 * 4;
        norm_phase(F, XIN_P, karg(A_GFFN1) + l * 1024, WSP(const float, modo), 0, WSP(bf16, WS_XN), 0, MP, F.vcu * NWAVES + F.wave, 256 * NWAVES);
#ifdef DUP_THIN
        GRID_BAR(); ENTER();
        norm_phase(F, XIN_P, karg(A_GFFN1) + l * 1024, WSP(const float, modo), 0, WSP(bf16, WS_XN), 0, MP, F.vcu * NWAVES + F.wave, 256 * NWAVES);
#endif
        GRID_BAR(); ENTER();
#ifndef NO_G1
        { pg8::Gemm g{WSP(bf16, WS_XN), WSP(const bf16, wlo + WO_GU1), MP, 2 * DFF, DM}; typedef pg8::FixedOrder<128, 22, 8> Ord; Ord S; S.init(F.G, opaque_bid());
          pg8::EpiSwiglu E{WSP(bf16, WS_BIG)};
          pg8::gemm_phase<pg8::EpiSwiglu, Ord, true, true>(F.lds + RING_OFF, g, S, E);
#ifdef DUP_G1
          GRID_BAR(); ENTER(); pg8::gemm_phase<pg8::EpiSwiglu, Ord, true, true>(F.lds + RING_OFF, g, S, E);
#endif
        }
#endif
        GRID_BAR(); ENTER();
#ifndef NO_G2
        { pg8::Gemm g{WSP(bf16, WS_BIG), WSP(const bf16, wlo + WO_D1), MP, DM, DFF}; typedef pg8::FixedOrder<128, 4, 8> Ord; Ord S; S.init(F.G, opaque_bid());
          pg8::EpiResid E{WSP(float, WS_X), WSP(const float, modo) + 2 * 1024, 0.5f, l == 0 ? 1 : 0};
          pg8::gemm_phase<pg8::EpiResid, Ord, true, true>(F.lds + RING_OFF, g, S, E);
#ifdef DUP_RES
          GRID_BAR(); ENTER(); { pg8::EpiResid E0{E.X, E.gate, 0.f, 0}; pg8::gemm_phase<pg8::EpiResid, Ord, true, true>(F.lds + RING_OFF, g, S, E0); }
#endif
        }
#endif
        GRID_BAR(); ENTER();
        norm_phase(F, WSP(const float, WS_X), karg(A_GMIX) + l * 1024, WSP(const float, modo), 1, WSP(bf16, WS_XN), 0, MP, F.vcu * NWAVES + F.wave, 256 * NWAVES);
#ifdef DUP_THIN
        GRID_BAR(); ENTER();
        norm_phase(F, WSP(const float, WS_X), karg(A_GMIX) + l * 1024, WSP(const float, modo), 1, WSP(bf16, WS_XN), 0, MP, F.vcu * NWAVES + F.wave, 256 * NWAVES);
#endif
        GRID_BAR(); ENTER();
        PT_BEGIN(2);
#ifndef NO_G3
        { pg8::Gemm g{WSP(bf16, WS_XN), WSP(const bf16, wlo + WO_IN), MP, DIN, DM}; typedef pg8::FixedOrder<128, 36, 8> Ord; Ord S; S.init(F.G, opaque_bid());
          pg8::EpiWin E{WSP(unsigned char, 0), OUTP(0), l, attn_body::C2};
          pg8::gemm_phase<pg8::EpiWin, Ord, true, true>(F.lds + RING_OFF, g, S, E);
#ifdef PROBE_G3NULL
          GRID_BAR(); ENTER(); PT_BEGIN(3); { float* sk_ = nullptr; asm volatile("" : "+s"(sk_)); pg8::EpiNull E0{sk_}; pg8::gemm_phase<pg8::EpiNull, Ord, true, true>(F.lds + RING_OFF, g, S, E0); } GRID_BAR(); ENTER(); PT_END(3);
#endif
        }
#endif
        GRID_BAR(); ENTER();
        PT_END(2);
        PT_BEGIN(1);
        { gu32* qbase = F.ctl + CW_Q + 64 * (l * 16);
          const int tk = wg_pull(F, qbase + 64 * 9);
#ifdef PROBE_ROLE
          const unsigned long long pr0 = __builtin_amdgcn_s_memrealtime();
#endif
          constexpr int T_EFF = T_TEAM;
          const bool team = (tk % TEAM_STRIDE) == 0, hfirst = (tk % TEAM_STRIDE) >= 1 && (tk % TEAM_STRIDE) <= STARTERS; const int ticket = tk / TEAM_STRIDE; gu32* tb = qbase + 64 * 10; unsigned tstage = 0;
#define TEAM_BAR() do { ++tstage; team_barrier(F, tb, (unsigned)T_EFF * tstage); ENTER(); } while (0)
#ifndef NO_TEAM
          if (team) {
              const int tgw = ticket * NWAVES + F.wave, TNW = T_EFF * NWAVES;
              norm_phase(F, XIN_S, karg(A_GFFN1) + l * 1024, WSP(const float, modo), 0, WSP(bf16, WS_XN), MP, MROWS, tgw, TNW);
              TEAM_BAR();
              { pg8::Gemm g{WSP(bf16, WS_XN), WSP(const bf16, wlo + WO_GU1), MROWS, 2 * DFF, DM}; typedef pg8::TeamOrder<22> Ord; Ord S; S.init(T_EFF, ticket);
                pg8::EpiSwiglu E{WSP(bf16, WS_BIG)};
                pg8::gemm_phase<pg8::EpiSwiglu, Ord, true, true>(F.lds + RING_OFF, g, S, E); }
              TEAM_BAR();
              { pg8::Gemm g{WSP(bf16, WS_BIG), WSP(const bf16, wlo + WO_D1), MROWS, DM, DFF}; typedef pg8::TeamOrder<4> Ord; Ord S; S.init(T_EFF, ticket);
                pg8::EpiResid E{WSP(float, WS_X), WSP(const float, modo) + 2 * 1024, 0.5f, l == 0 ? 2 : 0};
                pg8::gemm_phase<pg8::EpiResid, Ord, true, true>(F.lds + RING_OFF, g, S, E); }
              TEAM_BAR();
              norm_phase(F, WSP(const float, WS_X), karg(A_GMIX) + l * 1024, WSP(const float, modo), 1, WSP(bf16, WS_XN), MP, MROWS, ticket * NWAVES + F.wave, T_EFF * NWAVES);
              TEAM_BAR();
              { pg8::Gemm g{WSP(bf16, WS_XN), WSP(const bf16, wlo + WO_IN), MROWS, DIN, DM}; typedef pg8::TeamOrder<36> Ord; Ord S; S.init(T_EFF, ticket);
                pg8::EpiWin E{WSP(unsigned char, 0), OUTP(0), l, attn_body::C2};
                pg8::gemm_phase<pg8::EpiWin, Ord, true, true>(F.lds + RING_OFF, g, S, E); }
              TEAM_BAR();
          }
#endif
          if (hfirst) {
            for (;;) { const int it = wg_pull(F, qbase); if (it >= 32 * HG_G) break;
              const HgPtrs P{WSP(const float, WS_LOGF), WSP(const bf16, WS_QQ), WSP(const bf16, WS_KK), WSP(const bf16, WS_VV), WSP(const bf16, WS_HGS), karg(A_GHG) + l * 128, WSP(bf16, WS_OH), WSP(bf16, WS_DD)};
#ifndef NO_H
                  const int sqh = it / HG_G, g = it % HG_G, b = sqh >> 3, h = sqh & 7; const int nch = 128 / HG_G;
                  const size_t r0 = (size_t)b * 8192 + (size_t)g * nch * 64;
                  float* SLq = WSP(float, WS_SL) + (size_t)sqh * HG_G * 16384; float* DSq = WSP(float, WS_DSEG) + (size_t)sqh * HG_G * 128;
                  gu32* mask = F.ctl + CW_HS + 64 * (l * 32 + sqh);
                  hg_sequence<1>(F, P, r0, h, nch, 64, nullptr, SLq + (size_t)g * 16384, WSP(bf16, WS_QS), WSP(float, WS_RAW), DSq + g * 128);
                  asm volatile("s_waitcnt vmcnt(0)" ::: "memory"); __syncthreads();
                  if (F.tid == 0) { __builtin_amdgcn_fence(__ATOMIC_RELEASE, "agent"); asm volatile("s_waitcnt vmcnt(0)" ::: "memory"); (void)__hip_atomic_fetch_or(mask, 1u << g, RLX_AGENT); }
                  ENTER();
                  hg_fix(F, P, r0, h, nch, g, HG_G, SLq, DSq, WSP(const bf16, WS_QS), WSP(const float, WS_RAW), mask, OUTP(0) + OS_P + ((size_t)((l * 4 + b) * 8 + h)) * 16384);
                  ENTER();
#endif
            }
            if (F.tid == 0) { unsigned sp = 0; while (__hip_atomic_load(tb, RLX_AGENT) < (unsigned)T_EFF * 5u) { __builtin_amdgcn_s_sleep(2); if (++sp > (1u << 22)) { __hip_atomic_store(F.ctl + 1, 0x7ec0u, RLX_AGENT); break; } }
                __builtin_amdgcn_fence(__ATOMIC_ACQUIRE, "agent"); asm volatile("s_waitcnt vmcnt(0)" ::: "memory"); }
            __syncthreads(); ENTER();
          }
          if (team || hfirst) {
            gu32* qs = qbase + 64 * 11; gu32* done = qbase + 64 * 12;
            for (;;) { const int it = wg_pull(F, qs); if (it >= 256) break;
              const HgPtrs P{WSP(const float, WS_LOGF), WSP(const bf16, WS_QQ), WSP(const bf16, WS_KK), WSP(const bf16, WS_VV), WSP(const bf16, WS_HGS), karg(A_GHG) + l * 128, WSP(bf16, WS_OH), WSP(bf16, WS_DD)};
              if (it < 128) {
#ifndef NO_H
                  const int sq = it >> 3, h = it & 7; const size_t so = OS_S + ((size_t)((l * 16 + sq) * 8 + h)) * 16384;
                  hg_sequence<0>(F, P, (size_t)MP + (size_t)sq * 32, h, 1, 32, karg(A_ST) + ((size_t)((l * 16 + sq) * 8 + h)) * 16384, OUTP(0) + so, nullptr, nullptr, nullptr);
#endif
              } else {
#ifndef NO_SAMP
                  const int u = it - 128; const float lam = lam_of(karg(A_LAM), l, F.lane), osc = 1.f - lam_init_of(l);
                  attn_sample_unit(F, karg(A_CK), karg(A_CV), l, u >> 3, u & 7, WSP(const bf16, WS_Q), WSP(const bf16, WS_K), WSP(const bf16, WS_V), lam, osc, karg(A_GSUB) + l * 128, WSP(bf16, WS_OATT));
#endif
              }
              asm volatile("s_waitcnt vmcnt(0)" ::: "memory"); __syncthreads();
              if (F.tid == 0) { __builtin_amdgcn_fence(__ATOMIC_RELEASE, "agent"); asm volatile("s_waitcnt vmcnt(0)" ::: "memory"); (void)__hip_atomic_fetch_add(done, 1u, RLX_AGENT); }
              ENTER(); }
            if (team) {
                if (F.tid == 0) { unsigned sp = 0; while (__hip_atomic_load(done, RLX_AGENT) < 256u) { __builtin_amdgcn_s_sleep(2); if (++sp > (1u << 22)) { __hip_atomic_store(F.ctl + 1, 0x7ed0u, RLX_AGENT); break; } }
                    __builtin_amdgcn_fence(__ATOMIC_ACQUIRE, "agent"); asm volatile("s_waitcnt vmcnt(0)" ::: "memory"); }
                __syncthreads(); ENTER(); } }
#ifndef NO_TEAM
          if (team) {
              { pg8::Gemm g{WSP(bf16, WS_OATT), WSP(const bf16, wlo + WO_BA), MROWS, DM, DM}; typedef pg8::TeamOrder<4> Ord; Ord S; S.init(T_EFF, ticket);
                pg8::EpiGateT E{WSP(bf16, WS_LOGF), WSP(const bf16, WS_SZA)};
                pg8::gemm_phase<pg8::EpiGateT, Ord, true, true>(F.lds + RING_OFF, g, S, E); }
              TEAM_BAR();
              { pg8::Gemm g{WSP(bf16, WS_OH), WSP(const bf16, wlo + WO_BH), MROWS, DM, DM}; typedef pg8::TeamOrder<4> Ord; Ord S; S.init(T_EFF, ticket);
                pg8::EpiGateM E{WSP(const bf16, WS_LOGF), WSP(const bf16, WS_SZH), WSP(bf16, WS_MRG)};
                pg8::gemm_phase<pg8::EpiGateM, Ord, true, true>(F.lds + RING_OFF, g, S, E); }
              TEAM_BAR();
              { pg8::Gemm g{WSP(bf16, WS_MRG), WSP(const bf16, wlo + WO_OUT), MROWS, DM, DM}; typedef pg8::TeamOrder<4> Ord; Ord S; S.init(T_EFF, ticket);
                pg8::EpiResid E{WSP(float, WS_X), WSP(const float, modo) + 5 * 1024, 1.0f, 0};
                pg8::gemm_phase<pg8::EpiResid, Ord, true, true>(F.lds + RING_OFF, g, S, E); }
              TEAM_BAR();
              norm_phase(F, WSP(const float, WS_X), karg(A_GFFN2) + l * 1024, WSP(const float, modo), 2, WSP(bf16, WS_XN), MP, MROWS, ticket * NWAVES + F.wave, T_EFF * NWAVES);
              TEAM_BAR();
              { pg8::Gemm g{WSP(bf16, WS_XN), WSP(const bf16, wlo + WO_GU2), MROWS, 2 * DFF, DM}; typedef pg8::TeamOrder<22> Ord; Ord S; S.init(T_EFF, ticket);
                pg8::EpiSwiglu E{WSP(bf16, WS_BIG)};
                pg8::gemm_phase<pg8::EpiSwiglu, Ord, true, true>(F.lds + RING_OFF, g, S, E); }
              TEAM_BAR();
              { pg8::Gemm g{WSP(bf16, WS_BIG), WSP(const bf16, wlo + WO_D2), MROWS, DM, DFF}; typedef pg8::TeamOrder<4> Ord; Ord S; S.init(T_EFF, ticket);
                pg8::EpiResid E{WSP(float, WS_X), WSP(const float, modo) + 8 * 1024, 0.5f, 0};
                pg8::gemm_phase<pg8::EpiResid, Ord, true, true>(F.lds + RING_OFF, g, S, E); }
              ENTER();
          }
#endif
#ifndef NO_ATT
          { const attn_body::bf16* Qb = WSP(const attn_body::bf16, WS_Q); const attn_body::bf16* Kb = WSP(const attn_body::bf16, WS_K); const attn_body::bf16* Vb = WSP(const attn_body::bf16, WS_V); attn_body::bf16* O1 = WSP(attn_body::bf16, WS_O1);
            const int x0 = (int)(xb_xcc_id() & 7u);
            for (;;) { const int pk = attn_pull(F, qbase + 64, x0, 256); if (pk < 0) break;
                const int head = pk >> 16, it = pk & 0xffff, b = it >> 6, r = it & 63, qb = 31 - (r >> 1), mp = r & 1;
                attn_body::attn_unit128<8>(b, head * 2 + mp, head * 2, qb, Qb, Kb, Vb, O1 + (size_t)mp * ((WS_O2 - WS_O1) / 2), (char*)lds + RING_OFF); } }
#endif
#undef TEAM_BAR
#ifdef PROBE_ROLE
          if (tk == PROBE_ROLE) { const unsigned long long t1 = __builtin_amdgcn_s_memrealtime(), d = t1 - pr0; while (__builtin_amdgcn_s_memrealtime() - t1 < d) __builtin_amdgcn_s_sleep(8); }
#endif
        }
        GRID_BAR(); ENTER();
        PT_END(1);
        { const float lam = lam_of(karg(A_LAM), l, F.lane), osc = 1.f - lam_init_of(l);
          attn_combine_phase(F, WSP(const bf16, WS_O1), WSP(const bf16, WS_O2), karg(A_GSUB) + l * 128, lam, osc, WSP(bf16, WS_OATT));
#ifdef DUP_THIN
          GRID_BAR(); ENTER();
          attn_combine_phase(F, WSP(const bf16, WS_O1), WSP(const bf16, WS_O2), karg(A_GSUB) + l * 128, lam, osc, WSP(bf16, WS_OATT));
#endif
        }
        GRID_BAR(); ENTER();
#ifndef NO_G4
        { pg8::Gemm g{WSP(bf16, WS_OATT), WSP(const bf16, wlo + WO_BA), MP, DM, DM}; typedef pg8::FixedOrder<128, 4, 8> Ord; Ord S; S.init(F.G, opaque_bid());
          pg8::EpiGateT E{WSP(bf16, WS_LOGF), WSP(const bf16, WS_SZA)};
          pg8::gemm_phase<pg8::EpiGateT, Ord, true, true>(F.lds + RING_OFF, g, S, E);
#ifdef DUP_THIN
          GRID_BAR(); ENTER(); pg8::gemm_phase<pg8::EpiGateT, Ord, true, true>(F.lds + RING_OFF, g, S, E);
#endif
        }
#endif
        GRID_BAR(); ENTER();
#ifndef NO_G5
        { pg8::Gemm g{WSP(bf16, WS_OH), WSP(const bf16, wlo + WO_BH), MP, DM, DM}; typedef pg8::FixedOrder<128, 4, 8> Ord; Ord S; S.init(F.G, opaque_bid());
          pg8::EpiGateM E{WSP(const bf16, WS_LOGF), WSP(const bf16, WS_SZH), WSP(bf16, WS_MRG)};
          pg8::gemm_phase<pg8::EpiGateM, Ord, true, true>(F.lds + RING_OFF, g, S, E);
#ifdef DUP_THIN
          GRID_BAR(); ENTER(); pg8::gemm_phase<pg8::EpiGateM, Ord, true, true>(F.lds + RING_OFF, g, S, E);
#endif
        }
#endif
        GRID_BAR(); ENTER();
#ifndef NO_G6
        { pg8::Gemm g{WSP(bf16, WS_MRG), WSP(const bf16, wlo + WO_OUT), MP, DM, DM}; typedef pg8::FixedOrder<128, 4, 8> Ord; Ord S; S.init(F.G, opaque_bid());
          pg8::EpiResid E{WSP(float, WS_X), WSP(const float, modo) + 5 * 1024, 1.0f, 0};
          pg8::gemm_phase<pg8::EpiResid, Ord, true, true>(F.lds + RING_OFF, g, S, E);
#ifdef DUP_RES
          GRID_BAR(); ENTER(); { pg8::EpiResid E0{E.X, E.gate, 0.f, 0}; pg8::gemm_phase<pg8::EpiResid, Ord, true, true>(F.lds + RING_OFF, g, S, E0); }
#endif
        }
#endif
        GRID_BAR(); ENTER();
        norm_phase(F, WSP(const float, WS_X), karg(A_GFFN2) + l * 1024, WSP(const float, modo), 2, WSP(bf16, WS_XN), 0, MP, F.vcu * NWAVES + F.wave, 256 * NWAVES);
#ifdef DUP_THIN
        GRID_BAR(); ENTER();
        norm_phase(F, WSP(const float, WS_X), karg(A_GFFN2) + l * 1024, WSP(const float, modo), 2, WSP(bf16, WS_XN), 0, MP, F.vcu * NWAVES + F.wave, 256 * NWAVES);
#endif
        GRID_BAR(); ENTER();
#ifndef NO_G7
        { pg8::Gemm g{WSP(bf16, WS_XN), WSP(const bf16, wlo + WO_GU2), MP, 2 * DFF, DM}; typedef pg8::FixedOrder<128, 22, 8> Ord; Ord S; S.init(F.G, opaque_bid());
          pg8::EpiSwiglu E{WSP(bf16, WS_BIG)};
          pg8::gemm_phase<pg8::EpiSwiglu, Ord, true, true>(F.lds + RING_OFF, g, S, E); }
#endif
        GRID_BAR(); ENTER();
#ifndef NO_G8
        { pg8::Gemm g{WSP(bf16, WS_BIG), WSP(const bf16, wlo + WO_D2), MP, DM, DFF}; typedef pg8::FixedOrder<128, 4, 8> Ord; Ord S; S.init(F.G, opaque_bid());
          pg8::EpiResid E{WSP(float, WS_X), WSP(const float, modo) + 8 * 1024, 0.5f, 0};
          pg8::gemm_phase<pg8::EpiResid, Ord, true, true>(F.lds + RING_OFF, g, S, E);
#ifdef DUP_RES
          GRID_BAR(); ENTER(); { pg8::EpiResid E0{E.X, E.gate, 0.f, 0}; pg8::gemm_phase<pg8::EpiResid, Ord, true, true>(F.lds + RING_OFF, g, S, E0); }
#endif
        }
#endif
        GRID_BAR(); ENTER();
    }
    final_norm_phase(F, WSP(const float, WS_X), karg(A_GFIN), OUTP(0));
#undef GRID_BAR
#undef ENTER
#undef WSP
#undef OUTP
}

extern "C" void kernel_launch(void* const* d_in, const int* in_sizes, int n_in, void* d_out, int out_size, void* d_ws, size_t ws_size, hipStream_t stream) {
    static int grid = 0;
    if (grid == 0) {
        if (n_in != 25 || (size_t)out_size != OUT_TOTAL || ws_size < WS_END) { fprintf(stderr, "kernel_launch: unexpected sizes: n_in %d out %d ws %zu (need %zu)\n", n_in, out_size, ws_size, (size_t)WS_END); grid = -1; return; }
        int dev = 0, cus = 0, per_cu = 0;
        if (hipGetDevice(&dev) != hipSuccess || hipDeviceGetAttribute(&cus, hipDeviceAttributeMultiprocessorCount, dev) != hipSuccess) { grid = -1; return; }
        if (hipFuncSetAttribute((const void*)mk_fwd, hipFuncAttributeMaxDynamicSharedMemorySize, LDS_BYTES) != hipSuccess) { fprintf(stderr, "kernel_launch: hipFuncSetAttribute failed\n"); grid = -1; return; }
        if (hipOccupancyMaxActiveBlocksPerMultiprocessor(&per_cu, (const void*)mk_fwd, NWAVES * 64, LDS_BYTES) != hipSuccess || per_cu < 1) { fprintf(stderr, "kernel_launch: occupancy query reports %d\n", per_cu); }
        (void)hipGetLastError();
        grid = cus;
        if (grid != 256) { fprintf(stderr, "kernel_launch: built for a 256-CU device (team size, row split and work queues assume 256 workgroups); found %d CUs; nothing launched\n", cus); grid = -1; return; }
    }
    if (grid < 0) return;
    if (hipMemsetAsync((char*)d_ws + WS_CTL, 0, CTL_ZERO_BYTES, stream) != hipSuccess) return;
    Args a{};
    for (int i = 0; i < 25; ++i) a.in[i] = (const float*)d_in[i];
    a.out = (float*)d_out; a.ws = (unsigned char*)d_ws;
    hipLaunchKernelGGL(mk_fwd, dim3(grid), dim3(NWAVES * 64), LDS_BYTES, stream, a);
    (void)in_sizes;
}
```

```cpp
#include <hip/hip_runtime.h>
#include <hip/hip_bf16.h>
#include <cstdio>
#include <cstdint>
#include <cmath>
constexpr unsigned WTAB_LDS_ADDR = 139264u + 320u + 256u;
__device__ __forceinline__ unsigned hw_wave_slot() { return (unsigned)__builtin_amdgcn_s_getreg((6 << 11) | 4) & 0x3fu; }
__device__ __forceinline__ void tid_table_init() { ((volatile __attribute__((address_space(3))) unsigned*)(size_t)WTAB_LDS_ADDR)[hw_wave_slot()] = threadIdx.x >> 6; }
__device__ __forceinline__ int opaque_tid() { const unsigned w = ((volatile __attribute__((address_space(3))) unsigned*)(size_t)WTAB_LDS_ADDR)[hw_wave_slot()];
    unsigned ln; asm volatile("v_mbcnt_lo_u32_b32 %0, -1, 0\n\tv_mbcnt_hi_u32_b32 %0, -1, %0" : "=v"(ln));
    return (int)((w << 6) | ln); }
__device__ __forceinline__ int opaque_bid() { int b = (int)blockIdx.x; asm volatile("" : "+s"(b)); return b; }
namespace pg8 {
#define PG8_LAS __attribute__((address_space(3)))
typedef unsigned short bf16_t;
typedef short bf16x8 __attribute__((ext_vector_type(8)));
typedef float f32x4 __attribute__((ext_vector_type(4)));
typedef unsigned u32x4 __attribute__((ext_vector_type(4)));
constexpr int BM = 256, BK = 64, HALF = 128, HTB = HALF * BK * 2  , STAGE_BYTES = 8 * HTB, NXCD = 8, WGM = 8;

__host__ __device__ __forceinline__ int lds_byte(int r, int c) { const int st = (r >> 4) * 2 + (c >> 5), rr = r & 15, cc = c & 31, ob = rr * 64 + cc * 2; return st * 1024 + (ob ^ (((ob >> 9) & 1) << 5)); }
__host__ __device__ __forceinline__ void stage_rc(int b, int& R, int& C) { const int st = b / 1024, sb = b % 1024, swz = sb ^ (((sb >> 9) & 1) << 5); R = (st >> 1) * 16 + swz / 64; C = (st & 1) * 32 + (swz % 64) / 2; }
__host__ __device__ __forceinline__ int perm32(int rho) { const int n = rho >> 4, i = rho & 15; return 8 * (i >> 2) + 4 * n + (i & 3); }

struct Unit { int pm, pn; };
struct Gemm { const bf16_t* A; const bf16_t* Bt; int M, N, K; };

struct StaticOrder {
    int nM, nN, nwg, G, c;
    __host__ __device__ void init(int M, int N, int G_, int c_) { nM = M / BM; nN = N / BM; nwg = nM * nN; G = G_; c = c_; }
    __host__ __device__ bool next(int i, Unit& u) const {
        const long L = (long)i * G + c; if (L >= nwg) return false;
        int wgid = (int)L; { const int q = nwg / NXCD, r = nwg % NXCD, xcd = wgid % NXCD, off = wgid / NXCD; wgid = (xcd < r ? xcd * (q + 1) : r * (q + 1) + (xcd - r) * q) + off; }
        const int nig = WGM * nN, gid = wgid / nig, fm = gid * WGM, gsz = (nM - fm) < WGM ? (nM - fm) : WGM;
        u.pm = fm + ((wgid % nig) % gsz); u.pn = (wgid % nig) / gsz; return true;
    }
    __device__ __forceinline__ void a_ready(const Unit&) const {}
    __device__ __forceinline__ void done(const Unit&) const {}
};

__device__ __forceinline__ unsigned cvt_pk_bf16(float lo, float hi) { unsigned r; asm volatile("v_cvt_pk_bf16_f32 %0, %1, %2" : "=v"(r) : "v"(lo), "v"(hi)); return r; }
__device__ __forceinline__ float bf_lo(unsigned w) { return __builtin_bit_cast(float, w << 16); }
__device__ __forceinline__ float bf_hi(unsigned w) { return __builtin_bit_cast(float, w & 0xffff0000u); }
__device__ __forceinline__ float sigmoid_f(float x) { return __builtin_amdgcn_rcpf(1.f + __expf(-x)); }
__device__ __forceinline__ float silu_f(float x) { return x * sigmoid_f(x); }
__device__ __forceinline__ void store8bf(bf16_t* p, f32x4 a, f32x4 b) { u32x4 w; w.x = cvt_pk_bf16(a[0], a[1]); w.y = cvt_pk_bf16(a[2], a[3]); w.z = cvt_pk_bf16(b[0], b[1]); w.w = cvt_pk_bf16(b[2], b[3]); *(u32x4*)p = w; }
__device__ __forceinline__ int row_seq(int row) { return row < 32768 ? (row >> 13) : 4 + ((row - 32768) >> 5); }

struct EpiSwiglu {
    static constexpr bool PERM = true, AFTER_DRAIN = false;
    bf16_t* O;
    __device__ __forceinline__ void operator()(const f32x4 (&acc)[2][2][4][2], const Unit& u, int wr, int wc, int fr, int fq) const {
        const int row0 = u.pm * BM + wr * 64 + fr, col0 = u.pn * HALF + wc * 32 + 8 * fq;
#pragma unroll
        for (int ai = 0; ai < 2; ++ai)
#pragma unroll
            for (int m = 0; m < 4; ++m) {
                f32x4 g0 = acc[ai][0][m][0], g1 = acc[ai][0][m][1]; const f32x4 u0 = acc[ai][1][m][0], u1 = acc[ai][1][m][1];
#pragma unroll
                for (int i = 0; i < 4; ++i) { g0[i] = silu_f(g0[i]) * u0[i]; g1[i] = silu_f(g1[i]) * u1[i]; }
                store8bf(O + (size_t)(row0 + ai * HALF + m * 16) * 2816 + col0, g0, g1); asm volatile("" ::: "memory");
            }
    }
};

struct EpiResid {
    static constexpr bool PERM = true, AFTER_DRAIN = false;
    float* X; const float* gate; float coef; int xsel;
    __device__ __forceinline__ void operator()(const f32x4 (&acc)[2][2][4][2], const Unit& u, int wr, int wc, int fr, int fq) const {
        const float* Xin = X;
        if (xsel) { const __attribute__((address_space(4))) char* ka = (const __attribute__((address_space(4))) char*)__builtin_amdgcn_kernarg_segment_ptr(); asm volatile("" : "+s"(ka));
            Xin = (xsel == 1) ? *(const float* const __attribute__((address_space(4)))*)(ka) : *(const float* const __attribute__((address_space(4)))*)(ka + 8) - (size_t)32768 * 1024; }
        if (u.pm < 128) {
            const float* gp = gate + (size_t)(u.pm >> 5) * 9216 + u.pn * BM + wc * 32 + 8 * fq;
            f32x4 gv[2][2];
#pragma unroll
            for (int bj = 0; bj < 2; ++bj)
#pragma unroll
                for (int n = 0; n < 2; ++n) gv[bj][n] = *(const f32x4*)(gp + bj * HALF + 4 * n) * coef;
            float* xb = X + (size_t)(u.pm * BM + wr * 64 + fr) * 1024 + u.pn * BM + wc * 32 + 8 * fq;
            const float* xi = Xin + (size_t)(u.pm * BM + wr * 64 + fr) * 1024 + u.pn * BM + wc * 32 + 8 * fq;
            f32x4 xc[2][2], xn[2][2];
#pragma unroll
            for (int bj = 0; bj < 2; ++bj)
#pragma unroll
                for (int n = 0; n < 2; ++n) xc[bj][n] = *(const f32x4*)(xi + bj * HALF + 4 * n);
#pragma unroll
            for (int g = 0; g < 8; ++g) { const int ai = g >> 2, m = g & 3; float* xr = xb + (size_t)(ai * HALF + m * 16) * 1024;
                if (g + 1 < 8) { const float* xq = xi + (size_t)(((g + 1) >> 2) * HALF + ((g + 1) & 3) * 16) * 1024;
#pragma unroll
                    for (int bj = 0; bj < 2; ++bj)
#pragma unroll
                        for (int n = 0; n < 2; ++n) xn[bj][n] = *(const f32x4*)(xq + bj * HALF + 4 * n); }
#pragma unroll
                for (int bj = 0; bj < 2; ++bj)
#pragma unroll
                    for (int n = 0; n < 2; ++n) *(f32x4*)(xr + bj * HALF + 4 * n) = xc[bj][n] + gv[bj][n] * acc[ai][bj][m][n];
                asm volatile("" ::: "memory");
#pragma unroll
                for (int bj = 0; bj < 2; ++bj)
#pragma unroll
                    for (int n = 0; n < 2; ++n) xc[bj][n] = xn[bj][n]; }
        } else {
#pragma unroll
        for (int ai = 0; ai < 2; ++ai)
#pragma unroll
            for (int m = 0; m < 4; ++m) {
                const int row = u.pm * BM + ai * HALF + wr * 64 + m * 16 + fr; const float* gp = gate + (size_t)row_seq(row) * 9216;
#pragma unroll
                for (int bj = 0; bj < 2; ++bj) { const int col = u.pn * BM + bj * HALF + wc * 32 + 8 * fq;
#pragma unroll
                    for (int n = 0; n < 2; ++n) { const f32x4 g = *(const f32x4*)(gp + col + 4 * n); f32x4* xp = (f32x4*)(X + (size_t)row * 1024 + col + 4 * n); const f32x4 xv = *(const f32x4*)(Xin + (size_t)row * 1024 + col + 4 * n); *xp = xv + (g * coef) * acc[ai][bj][m][n]; } asm volatile("" ::: "memory"); }
            }
        }
    }
};

struct EpiWin {
    static constexpr bool PERM = true, AFTER_DRAIN = false;
    unsigned char* ws; float* out; int l; float qscale;
    static constexpr size_t MiB_ = 1u << 20;
    static constexpr size_t O_Q = 435 * MiB_, O_K = 500 * MiB_, O_V = 565 * MiB_, O_QQ = 630 * MiB_, O_KK = 695 * MiB_, O_VV = 760 * MiB_, O_HGS = 825 * MiB_, O_SZA = 890 * MiB_, O_SZH = 955 * MiB_, O_LOGF = 1020 * MiB_, O_LB = 4 * MiB_;
    static constexpr size_t OK_P_ = 34078720, OV_P_ = 168296448, OK_S_ = 304611328, OV_S_ = 306708480;
    __device__ __forceinline__ void operator()(const f32x4 (&acc)[2][2][4][2], const Unit& u, int wr, int wc, int fr, int fq) const {
        const int seg = u.pn >> 2, cb = (u.pn & 3) * BM + wc * 32 + 8 * fq, row0 = u.pm * BM + wr * 64 + fr;
        const size_t boff = seg == 0 ? O_Q : seg == 1 ? O_K : seg == 2 ? O_V : seg == 3 ? O_QQ : seg == 4 ? O_KK : seg == 5 ? O_VV : seg == 6 ? O_HGS : seg == 7 ? O_SZA : O_SZH;
        bf16_t* const O = (bf16_t*)(ws + boff) + (size_t)row0 * 1024 + cb;
        float* F32 = nullptr;
        if (seg == 1 || seg == 2) { const size_t ob = (u.pm < 128) ? (seg == 1 ? OK_P_ : OV_P_) + (size_t)l * 32768 * 1024 + (size_t)(u.pm * BM) * 1024 : (seg == 1 ? OK_S_ : OV_S_) + (size_t)l * 512 * 1024 + (size_t)((u.pm - 128) * BM) * 1024;
            F32 = out + ob + (size_t)(wr * 64 + fr) * 1024 + cb; }
        const float* const lb = (const float*)(ws + O_LB) + l * 1024 + cb;
        const float sc = seg == 0 ? qscale : 1.f;
        f32x4 lbv[2][2]; { const f32x4 z = {0.f, 0.f, 0.f, 0.f}; lbv[0][0] = z; lbv[0][1] = z; lbv[1][0] = z; lbv[1][1] = z; }
        if (seg == 4) { lbv[0][0] = *(const f32x4*)(lb); lbv[0][1] = *(const f32x4*)(lb + 4); lbv[1][0] = *(const f32x4*)(lb + HALF); lbv[1][1] = *(const f32x4*)(lb + HALF + 4); }
#pragma unroll
        for (int ai = 0; ai < 2; ++ai) {
#pragma unroll
            for (int m = 0; m < 4; ++m)
#pragma unroll
                for (int bj = 0; bj < 2; ++bj) { const size_t off = (size_t)(ai * HALF + m * 16) * 1024 + bj * HALF; const f32x4 l0 = lbv[bj][0], l1 = lbv[bj][1];
                    f32x4 a = acc[ai][bj][m][0], b = acc[ai][bj][m][1];
                    if (seg == 4) {
#pragma unroll
                        for (int i = 0; i < 4; ++i) {
                            { const float x = a[i], lbv = l0[i], e = __expf(-__builtin_fabsf(x)), r = __builtin_amdgcn_rcpf(1.f + e), er = e * r, om = x >= 0.f ? er : r; a[i] = (1.f - lbv) * om; }
                            { const float x = b[i], lbv = l1[i], e = __expf(-__builtin_fabsf(x)), r = __builtin_amdgcn_rcpf(1.f + e), er = e * r, om = x >= 0.f ? er : r; b[i] = (1.f - lbv) * om; } }
                    } else if (seg == 3 || seg == 6) {
#pragma unroll
                        for (int i = 0; i < 4; ++i) { a[i] = silu_f(a[i]); b[i] = silu_f(b[i]); }
                    } else if (seg >= 7) {
#pragma unroll
                        for (int i = 0; i < 4; ++i) { a[i] = sigmoid_f(a[i]); b[i] = sigmoid_f(b[i]); }
                    } else {
                        if (seg == 1 || seg == 2) { *(f32x4*)(F32 + off) = a; *(f32x4*)(F32 + off + 4) = b; }
                        a = a * sc; b = b * sc;
                    }
                    store8bf(O + off, a, b); asm volatile("" ::: "memory"); }
        }
    }
};

struct EpiGateT {
    static constexpr bool PERM = true, AFTER_DRAIN = false;
    bf16_t* T; const bf16_t* G;
    __device__ __forceinline__ void operator()(const f32x4 (&acc)[2][2][4][2], const Unit& u, int wr, int wc, int fr, int fq) const {
        const size_t base = (size_t)(u.pm * BM + wr * 64 + fr) * 1024 + u.pn * BM + wc * 32 + 8 * fq;
        u32x4 gc[2], gn[2];
#pragma unroll
        for (int bj = 0; bj < 2; ++bj) gc[bj] = *(const u32x4*)(G + base + bj * HALF);
#pragma unroll
        for (int g = 0; g < 8; ++g) { const int ai = g >> 2, m = g & 3; const size_t off = base + (size_t)(ai * HALF + m * 16) * 1024;
            if (g + 1 < 8) { const size_t offn = base + (size_t)(((g + 1) >> 2) * HALF + ((g + 1) & 3) * 16) * 1024;
#pragma unroll
                for (int bj = 0; bj < 2; ++bj) gn[bj] = *(const u32x4*)(G + offn + bj * HALF); }
#pragma unroll
            for (int bj = 0; bj < 2; ++bj) { const u32x4 gg = gc[bj];
                const f32x4 g0 = {bf_lo(gg.x), bf_hi(gg.x), bf_lo(gg.y), bf_hi(gg.y)}, g1 = {bf_lo(gg.z), bf_hi(gg.z), bf_lo(gg.w), bf_hi(gg.w)};
                store8bf(T + off + bj * HALF, g0 * acc[ai][bj][m][0], g1 * acc[ai][bj][m][1]); }
            asm volatile("" ::: "memory");
#pragma unroll
            for (int bj = 0; bj < 2; ++bj) gc[bj] = gn[bj]; }
    }
};
struct EpiGateM {
    static constexpr bool PERM = true, AFTER_DRAIN = false;
    const bf16_t* T; const bf16_t* G; bf16_t* O;
    __device__ __forceinline__ void operator()(const f32x4 (&acc)[2][2][4][2], const Unit& u, int wr, int wc, int fr, int fq) const {
        const size_t base = (size_t)(u.pm * BM + wr * 64 + fr) * 1024 + u.pn * BM + wc * 32 + 8 * fq;
        u32x4 gc[2], gn[2], tc[2], tn[2];
#pragma unroll
        for (int bj = 0; bj < 2; ++bj) { gc[bj] = *(const u32x4*)(G + base + bj * HALF); tc[bj] = *(const u32x4*)(T + base + bj * HALF); }
#pragma unroll
        for (int g = 0; g < 8; ++g) { const int ai = g >> 2, m = g & 3; const size_t off = base + (size_t)(ai * HALF + m * 16) * 1024;
            if (g + 1 < 8) { const size_t offn = base + (size_t)(((g + 1) >> 2) * HALF + ((g + 1) & 3) * 16) * 1024;
#pragma unroll
                for (int bj = 0; bj < 2; ++bj) { gn[bj] = *(const u32x4*)(G + offn + bj * HALF); tn[bj] = *(const u32x4*)(T + offn + bj * HALF); } }
#pragma unroll
            for (int bj = 0; bj < 2; ++bj) { const u32x4 gg = gc[bj];
                const f32x4 g0 = {bf_lo(gg.x), bf_hi(gg.x), bf_lo(gg.y), bf_hi(gg.y)}, g1 = {bf_lo(gg.z), bf_hi(gg.z), bf_lo(gg.w), bf_hi(gg.w)};
                const u32x4 tt = tc[bj]; const f32x4 t0 = {bf_lo(tt.x), bf_hi(tt.x), bf_lo(tt.y), bf_hi(tt.y)}, t1 = {bf_lo(tt.z), bf_hi(tt.z), bf_lo(tt.w), bf_hi(tt.w)};
                store8bf(O + off + bj * HALF, t0 + g0 * acc[ai][bj][m][0], t1 + g1 * acc[ai][bj][m][1]); }
            asm volatile("" ::: "memory");
#pragma unroll
            for (int bj = 0; bj < 2; ++bj) { gc[bj] = gn[bj]; tc[bj] = tn[bj]; } }
    }
};

struct EpiNull {
    static constexpr bool PERM = true, AFTER_DRAIN = false; float* sink;
    __device__ __forceinline__ void operator()(const f32x4 (&acc)[2][2][4][2], const Unit& u, int wr, int wc, int fr, int fq) const { f32x4 s = {0.f, 0.f, 0.f, 0.f};
#pragma unroll
        for (int a = 0; a < 2; ++a)
#pragma unroll
            for (int b = 0; b < 2; ++b)
#pragma unroll
                for (int m = 0; m < 4; ++m)
#pragma unroll
                    for (int n = 0; n < 2; ++n) s = s + acc[a][b][m][n];
        if (sink) sink[0] = s[0] + s[1] + s[2] + s[3]; (void)u; (void)wr; (void)wc; (void)fr; (void)fq; }
};

template <int NM, int NN, int GM> struct FixedOrder {
    static_assert(NM % GM == 0, "GM divides NM");
    int G, c;
    __device__ __forceinline__ void init(int G_, int c_) { G = G_; c = c_; }
    __device__ __forceinline__ bool next(int i, Unit& u) const {
        constexpr int nwg = NM * NN, q = nwg / NXCD, r = nwg % NXCD, nig = GM * NN;
        const int L = i * G + c; if (L >= nwg) return false;
        const int xcd = L % NXCD, off = L / NXCD; const int wgid = (xcd < r ? xcd * (q + 1) : r * (q + 1) + (xcd - r) * q) + off;
        const int gid = wgid / nig, w = wgid % nig; u.pm = gid * GM + (w % GM); u.pn = w / GM; return true;
    }
    __device__ __forceinline__ void a_ready(const Unit&) const {}
    __device__ __forceinline__ void done(const Unit&) const {}
};

template <int NN> struct TeamOrder {
    int T, r;
    __device__ __forceinline__ void init(int T_, int r_) { T = T_; r = r_; }
    __device__ __forceinline__ bool next(int i, Unit& u) const { const int L = i * T + r; if (L >= 2 * NN) return false; u.pm = 128 + L / NN; u.pn = L % NN; return true; }
    __device__ __forceinline__ void a_ready(const Unit&) const {}
    __device__ __forceinline__ void done(const Unit&) const {}
};
template <class Epi, class Sched, bool ALIGN_EPI = false, bool SP2 = false>
__device__ __forceinline__ void gemm_phase(PG8_LAS unsigned char* lds, const Gemm g, const Sched& S, const Epi& E) {
    const int tid = opaque_tid(), wid = __builtin_amdgcn_readfirstlane(tid >> 6), lane = tid & 63, wr = wid >> 2, wc = wid & 3, fr = lane & 15, fq = lane >> 4;
    const int K = g.K, nt = K / BK;
    unsigned voffA[2], voffB[2];
#pragma unroll
    for (int i = 0; i < 2; ++i) { int R, C; stage_rc(tid * 16 + i * 8192, R, C); const int Rb = Epi::PERM ? ((R & ~31) + perm32(R & 31)) : R;
        voffA[i] = (unsigned)(R * K + C) * 2u; voffB[i] = (unsigned)(Rb * K + C) * 2u; }
    const size_t kstep = (size_t)(BK * 2);
    const size_t hstep = (size_t)HALF * K * 2;
    const size_t tstep = 2 * hstep;
    const unsigned ldsw = (unsigned)wid * 1024u;
    const int aoff = lds_byte(wr * 64 + fr, fq * 8), boff = lds_byte(wc * 32 + fr, fq * 8);
#define PG8_SA(b, h) (((b) * 2 + (h)) * HTB)
#define PG8_SB(b, h) ((4 + (b) * 2 + (h)) * HTB)
#define PG8_STAGE(bufoff, gbase, voff) do { _Pragma("unroll") for (int _i = 0; _i < 2; ++_i) \
        __builtin_amdgcn_global_load_lds((const unsigned*)((const char*)(gbase) + (voff)[_i]), (PG8_LAS unsigned*)(lds + (bufoff) + ldsw + _i * 8192), 16, 0, 0); } while (0)
#define PG8_LDA(dst, b, h) do { _Pragma("unroll") for (int m = 0; m < 4; ++m) _Pragma("unroll") for (int k = 0; k < 2; ++k) dst[m][k] = *(const PG8_LAS bf16x8*)(lds + PG8_SA(b, h) + aoff + m * 2048 + k * 1024); } while (0)
#define PG8_LDB(dst, b, h) do { _Pragma("unroll") for (int n = 0; n < 2; ++n) _Pragma("unroll") for (int k = 0; k < 2; ++k) dst[n][k] = *(const PG8_LAS bf16x8*)(lds + PG8_SB(b, h) + boff + n * 2048 + k * 1024); } while (0)
#define PG8_MMA(ai, bj, At, Bt) do { __builtin_amdgcn_s_setprio(1); _Pragma("unroll") for (int m = 0; m < 4; ++m) _Pragma("unroll") for (int n = 0; n < 2; ++n) _Pragma("unroll") for (int k = 0; k < 2; ++k) \
        acc[ai][bj][m][n] = __builtin_amdgcn_mfma_f32_16x16x32_bf16(Bt[n][k], At[m][k], acc[ai][bj][m][n], 0, 0, 0); __builtin_amdgcn_s_setprio(0); } while (0)
#define PG8_WAIT_V(n) asm volatile("s_waitcnt vmcnt(" #n ")" ::: "memory")
#define PG8_WAIT_L(n) asm volatile("s_waitcnt lgkmcnt(" #n ")" ::: "memory")
#define PG8_BAR __builtin_amdgcn_s_barrier()
#define PG8_SCHED __builtin_amdgcn_sched_barrier(0)
    Unit cur, nxt; int ui = 0;
    if (!S.next(0, cur)) return;
    f32x4 acc[2][2][4][2];
#pragma unroll
    for (int a = 0; a < 2; ++a)
#pragma unroll
        for (int b = 0; b < 2; ++b)
#pragma unroll
            for (int m = 0; m < 4; ++m)
#pragma unroll
                for (int n = 0; n < 2; ++n) acc[a][b][m][n] = (f32x4){0.f, 0.f, 0.f, 0.f};
    bf16x8 At[4][2], B0[2][2], B1[2][2];
    const char* cA = (const char*)g.A + (size_t)cur.pm * tstep; const char* cB = (const char*)g.Bt + (size_t)cur.pn * tstep;
    S.a_ready(cur);
    if constexpr (SP2) {
        PG8_STAGE(PG8_SB(0, 0), cB, voffB); PG8_STAGE(PG8_SB(0, 1), cB + hstep, voffB); PG8_STAGE(PG8_SA(0, 0), cA, voffA); PG8_STAGE(PG8_SA(0, 1), cA + hstep, voffA);
        if (wr == 1) PG8_BAR;
        PG8_WAIT_V(2); PG8_BAR;
        PG8_STAGE(PG8_SB(1, 0), cB + kstep, voffB); PG8_STAGE(PG8_SA(1, 0), cA + kstep, voffA); PG8_STAGE(PG8_SB(1, 1), cB + hstep + kstep, voffB);
        PG8_WAIT_V(6); PG8_BAR;
    } else {
        PG8_STAGE(PG8_SB(0, 0), cB, voffB); PG8_STAGE(PG8_SA(0, 0), cA, voffA); PG8_STAGE(PG8_SB(0, 1), cB + hstep, voffB); PG8_STAGE(PG8_SA(0, 1), cA + hstep, voffA);
        if (wr == 1) PG8_BAR;
        PG8_WAIT_V(4); PG8_BAR;
        PG8_STAGE(PG8_SB(1, 0), cB + kstep, voffB); PG8_STAGE(PG8_SA(1, 0), cA + kstep, voffA); PG8_STAGE(PG8_SB(1, 1), cB + hstep + kstep, voffB);
        PG8_WAIT_V(6); PG8_BAR;
    }
    for (;;) {
        const bool has_next = S.next(ui + 1, nxt);
        const char* nA = has_next ? (const char*)g.A + (size_t)nxt.pm * tstep : cA; const char* nB = has_next ? (const char*)g.Bt + (size_t)nxt.pn * tstep : cB;
        for (int t = 0; t < nt; t += 2) {
            const bool last = (t == nt - 2);
            const char* a1 = cA + (size_t)(t + 1) * kstep;
            const char* a2 = last ? nA : cA + (size_t)(t + 2) * kstep; const char* b2 = last ? nB : cB + (size_t)(t + 2) * kstep;
            const char* a3 = a2 + kstep; const char* b3 = b2 + kstep;
            if (last && has_next) S.a_ready(nxt);
            if constexpr (SP2) {
            PG8_LDB(B0, 0, 0); PG8_LDB(B1, 0, 1); PG8_SCHED; PG8_LDA(At, 0, 0); PG8_STAGE(PG8_SA(1, 1), a1 + hstep, voffA);
            PG8_WAIT_V(8); PG8_WAIT_L(0); PG8_BAR; PG8_MMA(0, 0, At, B0); PG8_MMA(0, 1, At, B1); PG8_BAR; PG8_SCHED;
            PG8_LDA(At, 0, 1); PG8_STAGE(PG8_SB(0, 0), b2, voffB); PG8_STAGE(PG8_SB(0, 1), b2 + hstep, voffB); PG8_STAGE(PG8_SA(0, 0), a2, voffA);
            PG8_WAIT_V(8); PG8_WAIT_L(0); PG8_BAR; PG8_MMA(1, 0, At, B0); PG8_MMA(1, 1, At, B1); PG8_BAR; PG8_SCHED;
            PG8_LDB(B0, 1, 0); PG8_LDB(B1, 1, 1); PG8_SCHED; PG8_LDA(At, 1, 0); PG8_STAGE(PG8_SA(0, 1), a2 + hstep, voffA);
            PG8_WAIT_V(8); PG8_WAIT_L(0); PG8_BAR; PG8_MMA(0, 0, At, B0); PG8_MMA(0, 1, At, B1); PG8_BAR; PG8_SCHED;
            PG8_LDA(At, 1, 1); PG8_STAGE(PG8_SB(1, 0), b3, voffB); PG8_STAGE(PG8_SB(1, 1), b3 + hstep, voffB); PG8_STAGE(PG8_SA(1, 0), a3, voffA);
            PG8_WAIT_V(8); PG8_WAIT_L(0); PG8_BAR; PG8_MMA(1, 0, At, B0); PG8_MMA(1, 1, At, B1); PG8_BAR; PG8_SCHED;
            } else {
            PG8_LDB(B0, 0, 0); PG8_SCHED; PG8_LDA(At, 0, 0); PG8_STAGE(PG8_SA(1, 1), a1 + hstep, voffA);
            PG8_WAIT_L(8); PG8_BAR; PG8_WAIT_L(0); PG8_MMA(0, 0, At, B0); PG8_BAR; PG8_SCHED;
            PG8_LDB(B1, 0, 1); PG8_STAGE(PG8_SB(0, 0), b2, voffB);
            PG8_BAR; PG8_WAIT_L(0); PG8_MMA(0, 1, At, B1); PG8_BAR;
            PG8_LDA(At, 0, 1); PG8_STAGE(PG8_SA(0, 0), a2, voffA);
            PG8_BAR; PG8_WAIT_L(0); PG8_MMA(1, 0, At, B0); PG8_BAR; PG8_SCHED;
            PG8_STAGE(PG8_SB(0, 1), b2 + hstep, voffB);
            PG8_WAIT_V(6); PG8_BAR; PG8_MMA(1, 1, At, B1); PG8_BAR;
            PG8_LDB(B0, 1, 0); PG8_SCHED; PG8_LDA(At, 1, 0); PG8_STAGE(PG8_SA(0, 1), a2 + hstep, voffA);
            PG8_WAIT_L(8); PG8_BAR; PG8_WAIT_L(0); PG8_MMA(0, 0, At, B0); PG8_BAR; PG8_SCHED;
            PG8_LDB(B1, 1, 1); PG8_STAGE(PG8_SB(1, 0), b3, voffB);
            PG8_BAR; PG8_WAIT_L(0); PG8_MMA(0, 1, At, B1); PG8_BAR;
            PG8_LDA(At, 1, 1); PG8_STAGE(PG8_SA(1, 0), a3, voffA);
            PG8_BAR; PG8_WAIT_L(0); PG8_MMA(1, 0, At, B0); PG8_BAR; PG8_SCHED;
            PG8_STAGE(PG8_SB(1, 1), b3 + hstep, voffB);
            PG8_WAIT_V(6); PG8_BAR; PG8_MMA(1, 1, At, B1); PG8_BAR;
            }
        }
        if constexpr (ALIGN_EPI) { if (wr == 0) PG8_BAR; }
        if constexpr (!Epi::AFTER_DRAIN) { E(acc, cur, wr, wc, fr, fq); S.done(cur); }
        if (!has_next) break;
#pragma unroll
        for (int a = 0; a < 2; ++a)
#pragma unroll
            for (int b = 0; b < 2; ++b)
#pragma unroll
                for (int m = 0; m < 4; ++m)
#pragma unroll
                    for (int n = 0; n < 2; ++n) acc[a][b][m][n] = (f32x4){0.f, 0.f, 0.f, 0.f};
        cur = nxt; cA = nA; cB = nB; ++ui;
        if constexpr (ALIGN_EPI) { if (wr == 1) PG8_BAR; }
    }
    PG8_WAIT_V(0);
    if constexpr (!ALIGN_EPI) { if (wr == 0) PG8_BAR; }
    PG8_BAR;
    if constexpr (Epi::AFTER_DRAIN) { E.fused(acc, cur, wr, wc, fr, fq, lds, wid, lane); S.done(cur); }
#undef PG8_SA
#undef PG8_SB
#undef PG8_STAGE
#undef PG8_LDA
#undef PG8_LDB
#undef PG8_MMA
#undef PG8_WAIT_V
#undef PG8_WAIT_L
#undef PG8_BAR
#undef PG8_SCHED
}
}
namespace attn_body {
using bf16=__hip_bfloat16;
using bf16x8=__attribute__((ext_vector_type(8)))short;
using s16x4=__attribute__((ext_vector_type(4)))short;
using f32x16=__attribute__((ext_vector_type(16)))float;
using u32x4=__attribute__((ext_vector_type(4)))unsigned;
constexpr int BATCH=4,NHEAD=16,SEQ=8192,D=64,DM=NHEAD*D;
constexpr int NW=8,QBLK=32,QB=QBLK*NW,KVBLK=64,NQB=SEQ/QB;
constexpr int ATTN_PITCH=DM, ATTN_UNIT_ROWS=QB;
__device__ __forceinline__ int crow(int r,int hi){return (r&3)+8*(r>>2)+4*hi;}
#define SBAR() __builtin_amdgcn_sched_barrier(0)
__device__ __forceinline__ void cmask(f32x16&p0,f32x16&p1,int jb,int qrel,int hi){
  const float NEG=-INFINITY; (void)hi;
  if(jb>(qrel>>6)){
  #pragma unroll
  for(int r=0;r<16;++r){p0[r]=NEG;p1[r]=NEG;} }
}

constexpr int NSLOT=3, SLOTB=8192;
constexpr int LDS_K=0, LDS_V=NSLOT*SLOTB, LDS_WS=2*NSLOT*SLOTB, LDS_OST=LDS_WS+NW*64*4, LDS_BYTES=LDS_OST+NW*4096;
constexpr float C2=0.125f*1.4426950408889634f;
__device__ __forceinline__ void glds16(const void*gsrc,unsigned lds_dst){unsigned keep;
  asm volatile("s_mov_b32 %0, m0\n\ts_mov_b32 m0, %2\n\ts_nop 0\n\tglobal_load_lds_dwordx4 %1, off\n\ts_mov_b32 m0, %0":"=&s"(keep):"v"(gsrc),"s"(lds_dst):"memory");}
__device__ __forceinline__ float max3f(float a,float b,float c){float r;asm("v_max3_f32 %0, %1, %2, %3":"=v"(r):"v"(a),"v"(b),"v"(c));return r;}
__device__ __forceinline__ float max2f(float a,float b){float r;asm("v_max_f32_e32 %0, %1, %2":"=v"(r):"v"(a),"v"(b));return r;}
__device__ __forceinline__ float fadd_s(float a,float b){float r;asm("v_add_f32_e32 %0, %1, %2":"=v"(r):"v"(a),"v"(b));return r;}
__device__ __forceinline__ float fsub_s(float a,float b){float r;asm("v_sub_f32_e32 %0, %1, %2":"=v"(r):"v"(a),"v"(b));return r;}
typedef float f32x2_t __attribute__((ext_vector_type(2))); typedef __bf16 bf16x2_t __attribute__((ext_vector_type(2)));
__device__ __forceinline__ unsigned cvtpk_s(float lo,float hi){f32x2_t v={lo,hi};bf16x2_t b=__builtin_convertvector(v,bf16x2_t);return __builtin_bit_cast(unsigned,b);}
#define WAIT_BAR(N) asm volatile("s_waitcnt vmcnt(" #N ") lgkmcnt(0)\n\ts_barrier":::"memory")

__device__ __forceinline__ void qkt(f32x16&p0,f32x16&p1,const char*Kslot,const bf16x8*qr,const f32x16&negm,int r32,int hi){
  const char*kb=Kslot+hi*1024+r32*16;
  #pragma unroll
  for(int d0=0;d0<4;++d0){
    const bf16x8 b0=*reinterpret_cast<const bf16x8*>(kb+d0*2048);
    const bf16x8 b1=*reinterpret_cast<const bf16x8*>(kb+d0*2048+512);
    if(d0==0){p0=__builtin_amdgcn_mfma_f32_32x32x16_bf16(b0,qr[0],negm,0,0,0);p1=__builtin_amdgcn_mfma_f32_32x32x16_bf16(b1,qr[0],negm,0,0,0);}
    else{p0=__builtin_amdgcn_mfma_f32_32x32x16_bf16(b0,qr[d0],p0,0,0,0);p1=__builtin_amdgcn_mfma_f32_32x32x16_bf16(b1,qr[d0],p1,0,0,0);}}
}
typedef __attribute__((address_space(3))) const char* lds_cptr;
typedef short v4i16_t __attribute__((ext_vector_type(4)));
__device__ __forceinline__ void kload8(bf16x8*kf,lds_cptr kp){
  kf[0]=*(const __attribute__((address_space(3))) bf16x8*)(kp);      kf[1]=*(const __attribute__((address_space(3))) bf16x8*)(kp+512);
  kf[2]=*(const __attribute__((address_space(3))) bf16x8*)(kp+2048); kf[3]=*(const __attribute__((address_space(3))) bf16x8*)(kp+2560);
  kf[4]=*(const __attribute__((address_space(3))) bf16x8*)(kp+4096); kf[5]=*(const __attribute__((address_space(3))) bf16x8*)(kp+4608);
  kf[6]=*(const __attribute__((address_space(3))) bf16x8*)(kp+6144); kf[7]=*(const __attribute__((address_space(3))) bf16x8*)(kp+6656);
}
__device__ __forceinline__ void kload2(bf16x8*kf,lds_cptr kp,int j){ kf[2*j]=*(const __attribute__((address_space(3))) bf16x8*)(kp+j*2048); kf[2*j+1]=*(const __attribute__((address_space(3))) bf16x8*)(kp+j*2048+512); }
__device__ __forceinline__ s16x4 vtr(lds_cptr p){ return __builtin_bit_cast(s16x4,__builtin_amdgcn_ds_read_tr16_b64_v4i16((__attribute__((address_space(3))) v4i16_t*)p)); }
__device__ __forceinline__ float rowmax(const f32x16&p0,const f32x16&p1){
  float a=max3f(p0[0],p0[1],p1[0]),b=max3f(p0[2],p0[3],p1[1]);a=max3f(a,p1[2],p1[3]);
  #pragma unroll
  for(int r=4;r<16;r+=4){a=max3f(a,p0[r],p0[r+1]);b=max3f(b,p0[r+2],p0[r+3]);a=max3f(a,p1[r],p1[r+1]);b=max3f(b,p1[r+2],p1[r+3]);}
  const float m=max2f(a,b);
  auto rr=__builtin_amdgcn_permlane32_swap(__float_as_uint(m),__float_as_uint(m),false,false);
  return max2f(__uint_as_float(rr[0]),__uint_as_float(rr[1]));
}
__device__ __forceinline__ void pv(f32x16*o,int vb,bf16x8 pa0,bf16x8 pa1,bf16x8 pa2,bf16x8 pa3){
  #pragma unroll
  for(int d0=0;d0<2;++d0){s16x4 lo[4],hi[4];
    #pragma unroll
    for(int ks=0;ks<4;++ks){
      asm volatile("ds_read_b64_tr_b16 %0,%1 offset:%c2":"=&v"(lo[ks]):"v"(vb),"i"(d0*4096+ks*1024):"memory");
      asm volatile("ds_read_b64_tr_b16 %0,%1 offset:%c2":"=&v"(hi[ks]):"v"(vb),"i"(d0*4096+ks*1024+512):"memory");}
    asm volatile("s_waitcnt lgkmcnt(0)":::"memory");SBAR();
    #define PK(k) (bf16x8){lo[k][0],lo[k][1],lo[k][2],lo[k][3],hi[k][0],hi[k][1],hi[k][2],hi[k][3]}
    o[d0]=__builtin_amdgcn_mfma_f32_32x32x16_bf16(pa0,PK(0),o[d0],0,0,0);
    o[d0]=__builtin_amdgcn_mfma_f32_32x32x16_bf16(pa1,PK(1),o[d0],0,0,0);
    o[d0]=__builtin_amdgcn_mfma_f32_32x32x16_bf16(pa2,PK(2),o[d0],0,0,0);
    o[d0]=__builtin_amdgcn_mfma_f32_32x32x16_bf16(pa3,PK(3),o[d0],0,0,0);
    #undef PK
  }
}

#ifndef ATTN_STORE16
#define ATTN_STORE16(p,v) (*(u32x4*)(p)=(v))
#endif
template<int THRL> __device__ __forceinline__ void attn_unit(int b,int hq,int hv,int qb,const bf16*Q,const bf16*__restrict__ K,const bf16*__restrict__ V,bf16*O,char*shm){
  const int tid=opaque_tid(),lane=tid&63,r32=lane&31,hi=lane>>5; const int wid=__builtin_amdgcn_readfirstlane(tid>>6);
  const long rowbase=(long)b*SEQ; const int q0=qb*QB;
  const bf16*Qw=Q+(rowbase+q0+wid*QBLK)*DM+hq*D;
  const bf16*Kh=K+rowbase*DM+hq*D,*Vh=V+rowbase*DM+hv*D;
  const unsigned lds0=(unsigned)(uintptr_t)shm;
  float*wsf=(float*)(shm+LDS_WS)+wid*64;
  const bf16*ksrc=Kh+(long)lane*DM+wid*8;
  const bf16*vsrc=Vh+(long)(16*(wid&3)+(lane>>2))*DM+(wid>>2)*32+(lane&3)*8;
  const unsigned kdst=lds0+LDS_K+wid*1024, vdst=lds0+LDS_V+wid*1024;
  #define DMA_K(t,slot) glds16(ksrc+(long)(t)*KVBLK*DM,(unsigned)__builtin_amdgcn_readfirstlane(kdst+(slot)))
  #define DMA_V(t,slot) glds16(vsrc+(long)(t)*KVBLK*DM,(unsigned)__builtin_amdgcn_readfirstlane(vdst+(slot)))
  const int vb0=(int)(lds0+LDS_V)+((lane>>4)&1)*32+(lane&3)*8+(4*hi+((lane&15)>>2))*64;
  const char*Kbase=shm+LDS_K; bf16x8 kf[8];
  const lds_cptr shm3=(lds_cptr)shm; const lds_cptr kp0=shm3+LDS_K+hi*1024+r32*16; const lds_cptr vp0=shm3+LDS_V+((lane>>4)&1)*32+(lane&3)*8+(4*hi+((lane&15)>>2))*64;
  const int NT=(q0+QB)/KVBLK;
  DMA_K(0,0);DMA_V(0,0);DMA_K(1,SLOTB);
  bf16x8 qr[4];
  #pragma unroll
  for(int d0=0;d0<4;++d0)qr[d0]=*reinterpret_cast<const bf16x8*>(&Qw[(long)r32*DM+d0*16+hi*8]);
  float mhat=0.f,l_reg=0.f;f32x16 o[2];o[0]=f32x16{};o[1]=f32x16{};f32x16 negm=f32x16{};asm volatile("":"+v"(negm));
  const int qrel=wid*QBLK+r32;
  #define CMASK(P0,P1,t) do{int jb_=(t)-(NT-4); if(jb_>=0)cmask(P0,P1,jb_,qrel,hi);}while(0)
  bool resc=false;
  #define START(P0,P1) do{ const float rm=rowmax(P0,P1); resc=false; \
    { const float dl=rm; mhat=fadd_s(mhat,dl); \
      _Pragma("unroll") for(int r=0;r<16;++r){P0[r]=fsub_s(P0[r],dl);P1[r]=fsub_s(P1[r],dl);} \
      _Pragma("unroll") for(int r=0;r<16;++r)negm[r]=-mhat; asm volatile("":"+v"(negm)); } \
    _Pragma("unroll") for(int r=0;r<16;++r)P0[r]=__builtin_amdgcn_exp2f(P0[r]); }while(0)
  #define RESC() do{ if(resc){ asm volatile("s_waitcnt lgkmcnt(0)":::"memory"); \
      _Pragma("unroll") for(int d_=0;d_<2;++d_) _Pragma("unroll") for(int r=0;r<16;++r)o[d_][r]*=wsf[crow(r,hi)]; } }while(0)
  f32x16 pA0,pA1,pB0,pB1;
  int sl_prev=0,sl_cur=0,sl_next=SLOTB;
  #define ROT() do{sl_prev=sl_cur;sl_cur=sl_next;sl_next=(sl_next==(NSLOT-1)*SLOTB)?0:sl_next+SLOTB;}while(0)
  DMA_K(2,2*SLOTB);
  WAIT_BAR(3);
  qkt(pA0,pA1,Kbase,qr,negm,r32,hi);asm volatile("s_nop 15\n\ts_nop 7":"+v"(pA0),"+v"(pA1));CMASK(pA0,pA1,0);
  START(pA0,pA1);
  _Pragma("unroll") for(int r=0;r<16;++r)pA1[r]=__builtin_amdgcn_exp2f(pA1[r]);
  WAIT_BAR(0);
  DMA_K(3,0);DMA_V(1,SLOTB);
  ROT();
  kload8(kf,kp0+sl_cur);
  WAIT_BAR(2);
  s16x4 vlo[8],vhi[8]; u32x4 pw0,pw1,pw2,pw3;
  #define PKW(P,B) cvtpk_s(P[B],P[B+1])
  #define PAF(k) __builtin_bit_cast(bf16x8,pw##k)
  #define VFR(i) (bf16x8){vlo[i][0],vlo[i][1],vlo[i][2],vlo[i][3],vhi[i][0],vhi[i][1],vhi[i][2],vhi[i][3]}
  #define PIN(x) asm volatile("":"+v"(x))
  #define MX3(a,b,c) __builtin_fmaxf(__builtin_fmaxf((a),(b)),(c))
  #define GAPA(MF,A0,A1,A2,A3,W0,W1,PW) do{ MF; sacc+=A0; sacc+=A1; sacc+=A2; sacc+=A3; PIN(sacc); W0; W1; PIN(PW); SBAR(); }while(0)
  #define EX(v) __builtin_amdgcn_exp2f(v)
  #define GAPB(MF,X,B) do{ MF; X[B]=EX(X[B]); X[B+1]=EX(X[B+1]); X[B+2]=EX(X[B+2]); X[B+3]=EX(X[B+3]); PIN(X); SBAR(); }while(0)
  #define VRD(i) do{ vlo[i]=vtr(vp_+(((i)>>2)*4096+((i)&3)*1024)); vhi[i]=vtr(vp_+(((i)>>2)*4096+((i)&3)*1024+512)); }while(0)
  #define KRD(G,j) do{ if(G){ kload2(kf,kp0+sl_next,j); SBAR(); } }while(0)
  #define STEP(C0,C1,P0,P1,t,GK,GV,GL) do{ SBAR(); \
    const lds_cptr vp_=vp0+sl_prev; \
    VRD(0); SBAR(); float sacc=(P0[0]+P0[1]); \
    GAPA(C0=__builtin_amdgcn_mfma_f32_32x32x16_bf16(kf[0],qr[0],negm,0,0,0), P0[2],P0[3],P0[4],P0[5],     pw0[0]=PKW(P0,0), pw0[1]=PKW(P0,2), pw0); \
    VRD(4); SBAR(); GAPA(C1=__builtin_amdgcn_mfma_f32_32x32x16_bf16(kf[1],qr[0],negm,0,0,0), P0[6],P0[7],P0[8],P0[9],     pw0[2]=PKW(P0,4), pw0[3]=PKW(P0,6), pw0); \
    VRD(1); SBAR(); GAPA(C0=__builtin_amdgcn_mfma_f32_32x32x16_bf16(kf[2],qr[1],C0,0,0,0),   P0[10],P0[11],P0[12],P0[13], pw1[0]=PKW(P0,8), pw1[1]=PKW(P0,10), pw1); \
    VRD(5); SBAR(); GAPA(C1=__builtin_amdgcn_mfma_f32_32x32x16_bf16(kf[3],qr[1],C1,0,0,0),   P0[14],P0[15],P1[0],P1[1],   pw1[2]=PKW(P0,12),pw1[3]=PKW(P0,14), pw1); \
    VRD(2); SBAR(); GAPA(C0=__builtin_amdgcn_mfma_f32_32x32x16_bf16(kf[4],qr[2],C0,0,0,0),   P1[2],P1[3],P1[4],P1[5],     pw2[0]=PKW(P1,0), pw2[1]=PKW(P1,2), pw2); \
    VRD(6); SBAR(); GAPA(C1=__builtin_amdgcn_mfma_f32_32x32x16_bf16(kf[5],qr[2],C1,0,0,0),   P1[6],P1[7],P1[8],P1[9],     pw2[2]=PKW(P1,4), pw2[3]=PKW(P1,6), pw2); \
    VRD(3); SBAR(); GAPA(C0=__builtin_amdgcn_mfma_f32_32x32x16_bf16(kf[6],qr[3],C0,0,0,0),   P1[10],P1[11],P1[12],P1[13], pw3[0]=PKW(P1,8), pw3[1]=PKW(P1,10), pw3); \
    VRD(7); SBAR(); GAPA(C1=__builtin_amdgcn_mfma_f32_32x32x16_bf16(kf[7],qr[3],C1,0,0,0),   P1[14],P1[15],0.f,0.f,       pw3[2]=PKW(P1,12),pw3[3]=PKW(P1,14), pw3); \
    l_reg+=sacc; \
    if(GK){DMA_K((t)+3,sl_cur);} if(GV){DMA_V((t)+1,sl_next);} \
    CMASK(C0,C1,t); \
    { float a=MX3(C0[0],C0[1],C1[0]),b=MX3(C0[2],C0[3],C1[1]); a=MX3(a,C1[2],C1[3]); \
      _Pragma("unroll") for(int r=4;r<16;r+=4){a=MX3(a,C0[r],C0[r+1]);b=MX3(b,C0[r+2],C0[r+3]);a=MX3(a,C1[r],C1[r+1]);b=MX3(b,C1[r+2],C1[r+3]);} \
      float rm=__builtin_fmaxf(a,b); { auto rr=__builtin_amdgcn_permlane32_swap(__float_as_uint(rm),__float_as_uint(rm),false,false); rm=__builtin_fmaxf(__uint_as_float(rr[0]),__uint_as_float(rr[1])); } \
      resc=false; \
      if(__builtin_expect(__any(rm>(float)THRL),0)){ const float dl=__builtin_fmaxf(rm,0.f); mhat+=dl; \
        _Pragma("unroll") for(int r=0;r<16;++r){C0[r]-=dl;C1[r]-=dl;} \
        _Pragma("unroll") for(int r=0;r<16;++r)negm[r]=-mhat; asm volatile("":"+v"(negm)); \
        const float f=__builtin_amdgcn_exp2f(-dl); l_reg*=f; if(hi==0)wsf[r32]=f; resc=true; } } \
    SBAR(); \
    GAPB(o[0]=__builtin_amdgcn_mfma_f32_32x32x16_bf16(PAF(0),VFR(0),o[0],0,0,0), C0,0); \
    GAPB(o[1]=__builtin_amdgcn_mfma_f32_32x32x16_bf16(PAF(0),VFR(4),o[1],0,0,0), C0,4); \
    KRD(GL,0); GAPB(o[0]=__builtin_amdgcn_mfma_f32_32x32x16_bf16(PAF(1),VFR(1),o[0],0,0,0), C0,8); \
    KRD(GL,1); GAPB(o[1]=__builtin_amdgcn_mfma_f32_32x32x16_bf16(PAF(1),VFR(5),o[1],0,0,0), C0,12); \
    KRD(GL,2); GAPB(o[0]=__builtin_amdgcn_mfma_f32_32x32x16_bf16(PAF(2),VFR(2),o[0],0,0,0), C1,0); \
    KRD(GL,3); GAPB(o[1]=__builtin_amdgcn_mfma_f32_32x32x16_bf16(PAF(2),VFR(6),o[1],0,0,0), C1,4); \
    GAPB(o[0]=__builtin_amdgcn_mfma_f32_32x32x16_bf16(PAF(3),VFR(3),o[0],0,0,0), C1,8); \
    GAPB(o[1]=__builtin_amdgcn_mfma_f32_32x32x16_bf16(PAF(3),VFR(7),o[1],0,0,0), C1,12); \
    }while(0)
  int t=1;
  #undef CMASK
  #define CMASK(P0,P1,t) do{}while(0)
  for(;t+5<NT;t+=2){
    STEP(pB0,pB1,pA0,pA1,t,true,true,true);     WAIT_BAR(2); RESC(); ROT();
    STEP(pA0,pA1,pB0,pB1,t+1,true,true,true);   WAIT_BAR(2); RESC(); ROT();
  }
  #undef CMASK
  #define CMASK(P0,P1,t) do{int jb_=(t)-(NT-4); if(jb_>=0)cmask(P0,P1,jb_,qrel,hi);}while(0)
  #define ENDW(tt) do{ if((tt)+3<NT){WAIT_BAR(2);} else if((tt)+2<NT){WAIT_BAR(1);} else {WAIT_BAR(0);} }while(0)
  for(;t+1<NT;t+=2){
    STEP(pB0,pB1,pA0,pA1,t,(t+3<NT),(t+1<NT),(t+1<NT));       ENDW(t);   RESC(); ROT();
    STEP(pA0,pA1,pB0,pB1,t+1,(t+4<NT),(t+2<NT),(t+2<NT));     ENDW(t+1); RESC(); ROT();
  }
  STEP(pB0,pB1,pA0,pA1,NT-1,false,false,false); RESC();
  { float sacc=pB0[0]+pB0[1]; _Pragma("unroll") for(int r=2;r<16;++r)sacc+=pB0[r]; _Pragma("unroll") for(int r=0;r<16;++r)sacc+=pB1[r]; l_reg+=sacc;
    pw0=(u32x4){PKW(pB0,0),PKW(pB0,2),PKW(pB0,4),PKW(pB0,6)};pw1=(u32x4){PKW(pB0,8),PKW(pB0,10),PKW(pB0,12),PKW(pB0,14)};pw2=(u32x4){PKW(pB1,0),PKW(pB1,2),PKW(pB1,4),PKW(pB1,6)};pw3=(u32x4){PKW(pB1,8),PKW(pB1,10),PKW(pB1,12),PKW(pB1,14)};
    SBAR(); pv(o,vb0+sl_cur,PAF(0),PAF(1),PAF(2),PAF(3)); }
  #undef PKW
  #undef PAF
  #undef VFR
  #undef PIN
  #undef MX3
  #undef GAPA
  #undef GAPB
  #undef EX
  #undef VRD
  #undef KRD
  #undef STEP
  #undef ENDW
  {auto rr=__builtin_amdgcn_permlane32_swap(__float_as_uint(l_reg),__float_as_uint(l_reg),false,false);l_reg=__uint_as_float(rr[0])+__uint_as_float(rr[1]);}
  if(hi==0)wsf[32+r32]=l_reg;asm volatile("s_waitcnt lgkmcnt(0)":::"memory");
  float rli[16];
  #pragma unroll
  for(int r=0;r<16;++r)rli[r]=__builtin_amdgcn_rcpf(wsf[32+crow(r,hi)]);
  bf16*Ow=O+(rowbase+q0+wid*QBLK)*DM+hv*D;
  { bf16*stg=(bf16*)(shm+LDS_OST)+wid*2048;
    #pragma unroll
    for(int r=0;r<16;++r){const int orow=crow(r,hi);
      #pragma unroll
      for(int d0=0;d0<2;++d0)stg[orow*64+d0*32+r32]=__float2bfloat16(o[d0][r]*rli[r]);}
    asm volatile("s_waitcnt lgkmcnt(0)":::"memory");
    #pragma unroll
    for(int i=0;i<4;++i){const int row=i*8+(lane>>3),ch=lane&7; const u32x4 v=*(const u32x4*)(stg+row*64+ch*8); ATTN_STORE16(Ow+(long)row*DM+ch*8,v);} }
  asm volatile("s_waitcnt lgkmcnt(0)\n\ts_barrier":::"memory");
  #undef DMA_K
  #undef DMA_V
  #undef CMASK
  #undef START
  #undef RESC
  #undef ROT
}
__device__ __forceinline__ void pv128(f32x16*o,int vb,bf16x8 pa0,bf16x8 pa1,bf16x8 pa2,bf16x8 pa3){
  #pragma unroll
  for(int d0=0;d0<4;++d0){s16x4 lo[4],hi[4];
    #pragma unroll
    for(int ks=0;ks<4;++ks){
      asm volatile("ds_read_b64_tr_b16 %0,%1 offset:%c2":"=&v"(lo[ks]):"v"(vb),"i"(d0*4096+ks*1024):"memory");
      asm volatile("ds_read_b64_tr_b16 %0,%1 offset:%c2":"=&v"(hi[ks]):"v"(vb),"i"(d0*4096+ks*1024+512):"memory");}
    asm volatile("s_waitcnt lgkmcnt(0)":::"memory");SBAR();
    #define PK(k) (bf16x8){lo[k][0],lo[k][1],lo[k][2],lo[k][3],hi[k][0],hi[k][1],hi[k][2],hi[k][3]}
    o[d0]=__builtin_amdgcn_mfma_f32_32x32x16_bf16(pa0,PK(0),o[d0],0,0,0);
    o[d0]=__builtin_amdgcn_mfma_f32_32x32x16_bf16(pa1,PK(1),o[d0],0,0,0);
    o[d0]=__builtin_amdgcn_mfma_f32_32x32x16_bf16(pa2,PK(2),o[d0],0,0,0);
    o[d0]=__builtin_amdgcn_mfma_f32_32x32x16_bf16(pa3,PK(3),o[d0],0,0,0);
    #undef PK
  }
}
constexpr int SLOTV=16384, LDS_V2=NSLOT*SLOTB, LDS_WS2=LDS_V2+NSLOT*SLOTV, LDS_OST2=LDS_WS2+NW*64*4, LDS_BYTES2=LDS_OST2+NW*4096;
template<int THRL> __device__ __forceinline__ void attn_unit128(int b,int hq,int hv,int qb,const bf16*Q,const bf16*__restrict__ K,const bf16*__restrict__ V,bf16*O,char*shm){
  const int tid=opaque_tid(),lane=tid&63,r32=lane&31,hi=lane>>5; const int wid=__builtin_amdgcn_readfirstlane(tid>>6);
  const long rowbase=(long)b*SEQ; const int q0=qb*QB;
  const bf16*Qw=Q+(rowbase+q0+wid*QBLK)*DM+hq*D;
  const bf16*Kh=K+rowbase*DM+hq*D,*Vh=V+rowbase*DM+hv*D;
  const unsigned lds0=(unsigned)(uintptr_t)shm;
  float*wsf=(float*)(shm+LDS_WS2)+wid*64;
  const bf16*ksrc=Kh+(long)lane*DM+wid*8;
  const bf16*vsrc=Vh+(long)(16*(wid&3)+(lane>>2))*DM+(wid>>2)*32+(lane&3)*8;
  const unsigned kdst=lds0+LDS_K+wid*1024, vdst=lds0+LDS_V2+wid*1024;
  #define DMA_K(t,slot) glds16(ksrc+(long)(t)*KVBLK*DM,(unsigned)__builtin_amdgcn_readfirstlane(kdst+(slot)))
  #define DMA_V(t,slot) do{ glds16(vsrc+(long)(t)*KVBLK*DM,(unsigned)__builtin_amdgcn_readfirstlane(vdst+2*(slot))); glds16(vsrc+64+(long)(t)*KVBLK*DM,(unsigned)__builtin_amdgcn_readfirstlane(vdst+8192+2*(slot))); }while(0)
  const int vb0=(int)(lds0+LDS_V2)+((lane>>4)&1)*32+(lane&3)*8+(4*hi+((lane&15)>>2))*64;
  const char*Kbase=shm+LDS_K; bf16x8 kf[8];
  const lds_cptr shm3=(lds_cptr)shm; const lds_cptr kp0=shm3+LDS_K+hi*1024+r32*16; const lds_cptr vp0=shm3+LDS_V2+((lane>>4)&1)*32+(lane&3)*8+(4*hi+((lane&15)>>2))*64;
  const int NT=(q0+QB)/KVBLK;
  DMA_K(0,0);DMA_V(0,0);DMA_K(1,SLOTB);
  bf16x8 qr[4];
  #pragma unroll
  for(int d0=0;d0<4;++d0)qr[d0]=*reinterpret_cast<const bf16x8*>(&Qw[(long)r32*DM+d0*16+hi*8]);
  float mhat=0.f,l_reg=0.f;f32x16 o[4];o[0]=f32x16{};o[1]=f32x16{};o[2]=f32x16{};o[3]=f32x16{};const f32x16 zc=f32x16{};
  const int qrel=wid*QBLK+r32;
  #define CMASK(P0,P1,t) do{int jb_=(t)-(NT-4); if(jb_>=0)cmask(P0,P1,jb_,qrel,hi);}while(0)
  bool resc=false;
  #define START(P0,P1) do{ const float rm=rowmax(P0,P1); resc=false; \
    { const float dl=rm; mhat=fadd_s(mhat,dl); \
      _Pragma("unroll") for(int r=0;r<16;++r){P0[r]=fsub_s(P0[r],dl);P1[r]=fsub_s(P1[r],dl);} \
      } \
    _Pragma("unroll") for(int r=0;r<16;++r)P0[r]=__builtin_amdgcn_exp2f(P0[r]); }while(0)
  #define RESC() do{ if(resc){ asm volatile("s_waitcnt lgkmcnt(0)":::"memory"); \
      _Pragma("unroll") for(int d_=0;d_<4;++d_) _Pragma("unroll") for(int r=0;r<16;++r)o[d_][r]*=wsf[crow(r,hi)]; } }while(0)
  f32x16 pA0,pA1,pB0,pB1;
  int sl_prev=0,sl_cur=0,sl_next=SLOTB;
  #define ROT() do{sl_prev=sl_cur;sl_cur=sl_next;sl_next=(sl_next==(NSLOT-1)*SLOTB)?0:sl_next+SLOTB;}while(0)
  DMA_K(2,2*SLOTB);
  WAIT_BAR(3);
  qkt(pA0,pA1,Kbase,qr,zc,r32,hi);asm volatile("s_nop 15\n\ts_nop 7":"+v"(pA0),"+v"(pA1));CMASK(pA0,pA1,0);
  START(pA0,pA1);
  _Pragma("unroll") for(int r=0;r<16;++r)pA1[r]=__builtin_amdgcn_exp2f(pA1[r]);
  WAIT_BAR(0);
  DMA_K(3,0);DMA_V(1,SLOTB);
  ROT();
  kload8(kf,kp0+sl_cur);
  WAIT_BAR(3);
  s16x4 vlo[8],vhi[8]; u32x4 pw0,pw1,pw2,pw3;
  #define PKW(P,B) cvtpk_s(P[B],P[B+1])
  #define PAF(k) __builtin_bit_cast(bf16x8,pw##k)
  #define VFR(i) (bf16x8){vlo[i][0],vlo[i][1],vlo[i][2],vlo[i][3],vhi[i][0],vhi[i][1],vhi[i][2],vhi[i][3]}
  #define PIN(x) asm volatile("":"+v"(x))
  #define MX3(a,b,c) __builtin_fmaxf(__builtin_fmaxf((a),(b)),(c))
  #define GAPA(MF,A0,A1,A2,A3,W0,W1,PW) do{ MF; sacc+=A0; sacc+=A1; sacc+=A2; sacc+=A3; PIN(sacc); W0; W1; PIN(PW); SBAR(); }while(0)
  #define EX(v) __builtin_amdgcn_exp2f(v)
  #define GAPB(MF,X,B) do{ MF; X[B]=EX(X[B]); X[B+1]=EX(X[B+1]); X[B+2]=EX(X[B+2]); X[B+3]=EX(X[B+3]); PIN(X); SBAR(); }while(0)
  #define VRD(i) do{ vlo[i]=vtr(vp_+(((i)>>2)*4096+((i)&3)*1024)); vhi[i]=vtr(vp_+(((i)>>2)*4096+((i)&3)*1024+512)); }while(0)
  #define VRX(i) do{ vlo[i]=vtr(vp_+((((i)>>2)+2)*4096+((i)&3)*1024)); vhi[i]=vtr(vp_+((((i)>>2)+2)*4096+((i)&3)*1024+512)); SBAR(); }while(0)
  #define GAPB2(MF,X,B) do{ MF; X[B]=EX(X[B]-mhat); X[B+1]=EX(X[B+1]-mhat); PIN(X); SBAR(); }while(0)
  #define KRD(G,j) do{ if(G){ kload2(kf,kp0+sl_next,j); SBAR(); } }while(0)
  #define STEP(C0,C1,P0,P1,t,GK,GV,GL) do{ SBAR(); \
    const lds_cptr vp_=vp0+2*sl_prev; \
    VRD(0); SBAR(); float sacc=(P0[0]+P0[1]); \
    GAPA(C0=__builtin_amdgcn_mfma_f32_32x32x16_bf16(kf[0],qr[0],zc,0,0,0), P0[2],P0[3],P0[4],P0[5],     pw0[0]=PKW(P0,0), pw0[1]=PKW(P0,2), pw0); \
    VRD(4); SBAR(); GAPA(C1=__builtin_amdgcn_mfma_f32_32x32x16_bf16(kf[1],qr[0],zc,0,0,0), P0[6],P0[7],P0[8],P0[9],     pw0[2]=PKW(P0,4), pw0[3]=PKW(P0,6), pw0); \
    VRD(1); SBAR(); GAPA(C0=__builtin_amdgcn_mfma_f32_32x32x16_bf16(kf[2],qr[1],C0,0,0,0),   P0[10],P0[11],P0[12],P0[13], pw1[0]=PKW(P0,8), pw1[1]=PKW(P0,10), pw1); \
    VRD(5); SBAR(); GAPA(C1=__builtin_amdgcn_mfma_f32_32x32x16_bf16(kf[3],qr[1],C1,0,0,0),   P0[14],P0[15],P1[0],P1[1],   pw1[2]=PKW(P0,12),pw1[3]=PKW(P0,14), pw1); \
    VRD(2); SBAR(); GAPA(C0=__builtin_amdgcn_mfma_f32_32x32x16_bf16(kf[4],qr[2],C0,0,0,0),   P1[2],P1[3],P1[4],P1[5],     pw2[0]=PKW(P1,0), pw2[1]=PKW(P1,2), pw2); \
    VRD(6); SBAR(); GAPA(C1=__builtin_amdgcn_mfma_f32_32x32x16_bf16(kf[5],qr[2],C1,0,0,0),   P1[6],P1[7],P1[8],P1[9],     pw2[2]=PKW(P1,4), pw2[3]=PKW(P1,6), pw2); \
    VRD(3); SBAR(); GAPA(C0=__builtin_amdgcn_mfma_f32_32x32x16_bf16(kf[6],qr[3],C0,0,0,0),   P1[10],P1[11],P1[12],P1[13], pw3[0]=PKW(P1,8), pw3[1]=PKW(P1,10), pw3); \
    VRD(7); SBAR(); GAPA(C1=__builtin_amdgcn_mfma_f32_32x32x16_bf16(kf[7],qr[3],C1,0,0,0),   P1[14],P1[15],0.f,0.f,       pw3[2]=PKW(P1,12),pw3[3]=PKW(P1,14), pw3); \
    l_reg+=sacc; \
    if(GK){DMA_K((t)+3,sl_cur);} if(GV){DMA_V((t)+1,sl_next);} \
    CMASK(C0,C1,t); \
    { float a=MX3(C0[0],C0[1],C1[0]),b=MX3(C0[2],C0[3],C1[1]); a=MX3(a,C1[2],C1[3]); \
      _Pragma("unroll") for(int r=4;r<16;r+=4){a=MX3(a,C0[r],C0[r+1]);b=MX3(b,C0[r+2],C0[r+3]);a=MX3(a,C1[r],C1[r+1]);b=MX3(b,C1[r+2],C1[r+3]);} \
      float rm=__builtin_fmaxf(a,b); { auto rr=__builtin_amdgcn_permlane32_swap(__float_as_uint(rm),__float_as_uint(rm),false,false); rm=__builtin_fmaxf(__uint_as_float(rr[0]),__uint_as_float(rr[1])); } \
      rm-=mhat; resc=false; \
      if(__builtin_expect(__any(rm>(float)THRL),0)){ const float dl=__builtin_fmaxf(rm,0.f); mhat+=dl; \
        const float f=__builtin_amdgcn_exp2f(-dl); l_reg*=f; if(hi==0)wsf[r32]=f; resc=true; } } \
    SBAR(); \
    GAPB2(o[0]=__builtin_amdgcn_mfma_f32_32x32x16_bf16(PAF(0),VFR(0),o[0],0,0,0), C0,0);  VRX(0); \
    GAPB2(o[1]=__builtin_amdgcn_mfma_f32_32x32x16_bf16(PAF(0),VFR(4),o[1],0,0,0), C0,2);  VRX(4); \
    KRD(GL,0); GAPB2(o[0]=__builtin_amdgcn_mfma_f32_32x32x16_bf16(PAF(1),VFR(1),o[0],0,0,0), C0,4);  VRX(1); \
    KRD(GL,1); GAPB2(o[1]=__builtin_amdgcn_mfma_f32_32x32x16_bf16(PAF(1),VFR(5),o[1],0,0,0), C0,6);  VRX(5); \
    KRD(GL,2); GAPB2(o[0]=__builtin_amdgcn_mfma_f32_32x32x16_bf16(PAF(2),VFR(2),o[0],0,0,0), C0,8);  VRX(2); \
    KRD(GL,3); GAPB2(o[1]=__builtin_amdgcn_mfma_f32_32x32x16_bf16(PAF(2),VFR(6),o[1],0,0,0), C0,10); VRX(6); \
    GAPB2(o[0]=__builtin_amdgcn_mfma_f32_32x32x16_bf16(PAF(3),VFR(3),o[0],0,0,0), C0,12); VRX(3); \
    GAPB2(o[1]=__builtin_amdgcn_mfma_f32_32x32x16_bf16(PAF(3),VFR(7),o[1],0,0,0), C0,14); VRX(7); \
    GAPB2(o[2]=__builtin_amdgcn_mfma_f32_32x32x16_bf16(PAF(0),VFR(0),o[2],0,0,0), C1,0); \
    GAPB2(o[3]=__builtin_amdgcn_mfma_f32_32x32x16_bf16(PAF(0),VFR(4),o[3],0,0,0), C1,2); \
    GAPB2(o[2]=__builtin_amdgcn_mfma_f32_32x32x16_bf16(PAF(1),VFR(1),o[2],0,0,0), C1,4); \
    GAPB2(o[3]=__builtin_amdgcn_mfma_f32_32x32x16_bf16(PAF(1),VFR(5),o[3],0,0,0), C1,6); \
    GAPB2(o[2]=__builtin_amdgcn_mfma_f32_32x32x16_bf16(PAF(2),VFR(2),o[2],0,0,0), C1,8); \
    GAPB2(o[3]=__builtin_amdgcn_mfma_f32_32x32x16_bf16(PAF(2),VFR(6),o[3],0,0,0), C1,10); \
    GAPB2(o[2]=__builtin_amdgcn_mfma_f32_32x32x16_bf16(PAF(3),VFR(3),o[2],0,0,0), C1,12); \
    GAPB2(o[3]=__builtin_amdgcn_mfma_f32_32x32x16_bf16(PAF(3),VFR(7),o[3],0,0,0), C1,14); \
    }while(0)
  int t=1;
  #undef CMASK
  #define CMASK(P0,P1,t) do{}while(0)
  for(;t+5<NT;t+=2){
    STEP(pB0,pB1,pA0,pA1,t,true,true,true);     WAIT_BAR(3); RESC(); ROT();
    STEP(pA0,pA1,pB0,pB1,t+1,true,true,true);   WAIT_BAR(3); RESC(); ROT();
  }
  #undef CMASK
  #define CMASK(P0,P1,t) do{int jb_=(t)-(NT-4); if(jb_>=0)cmask(P0,P1,jb_,qrel,hi);}while(0)
  #define ENDW(tt) do{ if((tt)+3<NT){WAIT_BAR(3);} else if((tt)+2<NT){WAIT_BAR(2);} else {WAIT_BAR(0);} }while(0)
  for(;t+1<NT;t+=2){
    STEP(pB0,pB1,pA0,pA1,t,(t+3<NT),(t+1<NT),(t+1<NT));       ENDW(t);   RESC(); ROT();
    STEP(pA0,pA1,pB0,pB1,t+1,(t+4<NT),(t+2<NT),(t+2<NT));     ENDW(t+1); RESC(); ROT();
  }
  STEP(pB0,pB1,pA0,pA1,NT-1,false,false,false); RESC();
  { float sacc=pB0[0]+pB0[1]; _Pragma("unroll") for(int r=2;r<16;++r)sacc+=pB0[r]; _Pragma("unroll") for(int r=0;r<16;++r)sacc+=pB1[r]; l_reg+=sacc;
    pw0=(u32x4){PKW(pB0,0),PKW(pB0,2),PKW(pB0,4),PKW(pB0,6)};pw1=(u32x4){PKW(pB0,8),PKW(pB0,10),PKW(pB0,12),PKW(pB0,14)};pw2=(u32x4){PKW(pB1,0),PKW(pB1,2),PKW(pB1,4),PKW(pB1,6)};pw3=(u32x4){PKW(pB1,8),PKW(pB1,10),PKW(pB1,12),PKW(pB1,14)};
    SBAR(); pv128(o,vb0+2*sl_cur,PAF(0),PAF(1),PAF(2),PAF(3)); }
  #undef PKW
  #undef PAF
  #undef VFR
  #undef PIN
  #undef MX3
  #undef GAPA
  #undef GAPB
  #undef EX
  #undef VRD
  #undef VRX
  #undef GAPB2
  #undef KRD
  #undef STEP
  #undef ENDW
  {auto rr=__builtin_amdgcn_permlane32_swap(__float_as_uint(l_reg),__float_as_uint(l_reg),false,false);l_reg=__uint_as_float(rr[0])+__uint_as_float(rr[1]);}
  if(hi==0)wsf[32+r32]=l_reg;asm volatile("s_waitcnt lgkmcnt(0)":::"memory");
  float rli[16];
  #pragma unroll
  for(int r=0;r<16;++r)rli[r]=__builtin_amdgcn_rcpf(wsf[32+crow(r,hi)]);
  bf16*Ow=O+(rowbase+q0+wid*QBLK)*DM+hv*D;
  { bf16*stg=(bf16*)(shm+LDS_OST2)+wid*2048;
    #pragma unroll
    for(int hp=0;hp<2;++hp){
      #pragma unroll
      for(int r=0;r<16;++r){const int orow=crow(r,hi);
        #pragma unroll
        for(int d0=0;d0<2;++d0)stg[orow*64+d0*32+r32]=__float2bfloat16(o[2*hp+d0][r]*rli[r]);}
      asm volatile("s_waitcnt lgkmcnt(0)":::"memory");
      #pragma unroll
      for(int i=0;i<4;++i){const int row=i*8+(lane>>3),ch=lane&7; const u32x4 v=*(const u32x4*)(stg+row*64+ch*8); ATTN_STORE16(Ow+(long)row*DM+hp*64+ch*8,v);}
      asm volatile("s_waitcnt lgkmcnt(0)":::"memory"); } }
  asm volatile("s_waitcnt lgkmcnt(0)\n\ts_barrier":::"memory");
  #undef DMA_K
  #undef DMA_V
  #undef CMASK
  #undef START
  #undef RESC
  #undef ROT
}
constexpr int ATTN_LDS_BYTES=LDS_BYTES;
#undef SBAR
#undef WAIT_BAR
}
#define GAS __attribute__((address_space(1)))
#define LAS __attribute__((address_space(3)))
typedef unsigned short bf16;
typedef unsigned v4u __attribute__((ext_vector_type(4)));
typedef float f32x4 __attribute__((ext_vector_type(4)));
typedef short bf16x8 __attribute__((ext_vector_type(8)));
typedef GAS unsigned gu32;
typedef GAS unsigned long long gu64;
#define RLX_AGENT __ATOMIC_RELAXED, __HIP_MEMORY_SCOPE_AGENT
#define LDS_WAIT() asm volatile("s_waitcnt lgkmcnt(0)" ::: "memory")
#define VM_WAIT() asm volatile("s_waitcnt vmcnt(0)" ::: "memory")
__device__ __forceinline__ unsigned long long rt() { return __builtin_amdgcn_s_memrealtime(); }
__device__ __forceinline__ unsigned f2bf(float f) { unsigned u = __builtin_bit_cast(unsigned, f); return (u + 0x7fffu + ((u >> 16) & 1u)) >> 16; }
__device__ __forceinline__ unsigned pk2(float lo, float hi) { return f2bf(lo) | (f2bf(hi) << 16); }

#define XB_TMO      128
#define XB_XCNT(j)  (256  + 64 * (j))
#define XB_XSUB(j)  (1280 + 64 * (j))
#define XB_XGEN(j)  (2304 + 64 * (j))
#define XB_TOP      3328
#define XB_TOPGEN   3392
#define XCD_BAR_WORDS 3456
#define XB_SPIN_CAP (1u << 18)

__device__ __forceinline__ unsigned xb_ld(unsigned* p)              { return __hip_atomic_load(p, __ATOMIC_RELAXED, __HIP_MEMORY_SCOPE_AGENT); }
__device__ __forceinline__ unsigned xb_add(unsigned* p, unsigned v) { return __hip_atomic_fetch_add(p, v, __ATOMIC_RELAXED, __HIP_MEMORY_SCOPE_AGENT); }
__device__ __forceinline__ unsigned xb_xcc_id() { return (unsigned)__builtin_amdgcn_s_getreg((3 << 11) | 20) & 0xFu; }
#define XB_SPIN(cond, bar) do { unsigned _sp = 0; while (cond) { __builtin_amdgcn_s_sleep(1); \
    if ((++_sp & 255u) == 0u) { if (xb_ld(&(bar)[XB_TMO])) break; if (_sp > XB_SPIN_CAP) { atomicAdd(&(bar)[XB_TMO], 1u); break; } } } } while (0)

struct XcdBarrier {
    unsigned* bar; unsigned x;
    volatile LAS unsigned* st;
};

__device__ __forceinline__ XcdBarrier xcd_barrier_post(unsigned* bar, volatile LAS unsigned* st) {
    XcdBarrier b; b.bar = bar; b.x = xb_xcc_id(); b.st = st;
    if (opaque_tid() == 0) (void)xb_add(&bar[XB_XCNT(b.x)], 1u);
    return b;
}
__device__ __forceinline__ void xcd_barrier_complete(unsigned* bar, unsigned x, unsigned& nloc, unsigned& nx) {
    const unsigned G = gridDim.x * gridDim.y * gridDim.z;
    unsigned sum, cnt, mine, sp = 0u;
    for (;;) {
        sum = 0u; cnt = 0u;
#pragma unroll
        for (unsigned j = 0; j < 16; ++j) { const unsigned c = xb_ld(&bar[XB_XCNT(j)]); sum += c; cnt += (c > 0u) ? 1u : 0u; }
        if (sum == G) break;
        __builtin_amdgcn_s_sleep(1);
        if ((++sp & 255u) == 0u) { if (xb_ld(&bar[XB_TMO])) break; if (sp > XB_SPIN_CAP) { atomicAdd(&bar[XB_TMO], 1u); break; } }
    }
    mine = xb_ld(&bar[XB_XCNT(x)]);
    nloc = mine > 0u ? mine : 1u; nx = cnt > 0u ? cnt : 1u;
}

__device__ __forceinline__ void xcd_barrier(const XcdBarrier& b) {
    asm volatile("s_waitcnt vmcnt(0)" ::: "memory");
    __syncthreads();
    if (opaque_tid() == 0) {
        unsigned* bar = b.bar;
        __builtin_amdgcn_s_waitcnt(0);
        unsigned nloc = b.st[0], nx = b.st[1];
        if (nloc == 0u) { xcd_barrier_complete(bar, b.x, nloc, nx); b.st[0] = nloc; b.st[1] = nx; }
        const unsigned old = xb_add(&bar[XB_XSUB(b.x)], 1u);
        const unsigned gen = old / nloc;
        if (old + 1u == (gen + 1u) * nloc) {
            __builtin_amdgcn_fence(__ATOMIC_RELEASE, "agent");
            asm volatile("s_waitcnt vmcnt(0)" ::: "memory");
            const unsigned og = xb_add(&bar[XB_TOP], 1u);
            const unsigned tg = og / nx;
            if (og + 1u == (tg + 1u) * nx) xb_add(&bar[XB_TOPGEN], 1u);
            else XB_SPIN(xb_ld(&bar[XB_TOPGEN]) == tg, bar);
            __builtin_amdgcn_fence(__ATOMIC_ACQUIRE, "agent");
            xb_add(&bar[XB_XGEN(b.x)], 1u);
            asm volatile("s_waitcnt vmcnt(0)" ::: "memory");
        } else {
            XB_SPIN(xb_ld(&bar[XB_XGEN(b.x)]) == gen, bar);
            __builtin_amdgcn_fence(__ATOMIC_ACQUIRE, "agent");
            asm volatile("s_waitcnt vmcnt(0)" ::: "memory");
        }
    }
    __syncthreads();
}
constexpr int NWAVES = 8;
constexpr int DM = 1024, MP = 32768, MS = 512, MROWS = MP + MS, NSEQ = 20, DEPTH = 4, DFF = 2816, DIN = 9216, PAST = 2048;
constexpr int NCHUNK_P = 512, NCHUNK = 528;
constexpr float EPS = 1e-6f;
constexpr size_t OY_P = 0, OY_S = 33554432, OK_P = 34078720, OV_P = 168296448, OS_P = 302514176, OK_S = 304611328, OV_S = 306708480, OS_S = 308805632, OUT_TOTAL = 317194240;

constexpr size_t MiB = 1u << 20;
constexpr size_t WS_CTL = 0, CTL_ZERO_BYTES = 1 * MiB;
constexpr size_t WS_MOD = 1 * MiB;
constexpr size_t WS_LB = 4 * MiB;
constexpr size_t WS_W = 8 * MiB, W_LAYER = 57 * MiB;
constexpr size_t WO_GU1 = 0, WO_D1 = 11 * MiB, WO_IN = 16 * MiB + MiB / 2, WO_BA = 34 * MiB + MiB / 2, WO_BH = 36 * MiB + MiB / 2, WO_OUT = 38 * MiB + MiB / 2, WO_GU2 = 40 * MiB + MiB / 2, WO_D2 = 51 * MiB + MiB / 2;
constexpr size_t WS_X = 240 * MiB;
constexpr size_t WS_XN = 370 * MiB;
constexpr size_t WS_Q = 435 * MiB, WS_K = 500 * MiB, WS_V = 565 * MiB;
constexpr size_t WS_QQ = 630 * MiB, WS_KK = 695 * MiB, WS_VV = 760 * MiB, WS_HGS = 825 * MiB, WS_SZA = 890 * MiB, WS_SZH = 955 * MiB;
constexpr size_t WS_LOGF = 1020 * MiB;
constexpr size_t WS_O1 = 1150 * MiB, WS_O2 = 1215 * MiB, WS_OATT = 1280 * MiB, WS_OH = 1345 * MiB, WS_MRG = 1410 * MiB;
constexpr size_t WS_BIG = 1475 * MiB;
constexpr size_t WS_SST = 1739 * MiB;
constexpr size_t WS_DD = 1871 * MiB;
constexpr size_t WS_END = 1874 * MiB;
#ifndef TEAM_STRIDE
#define TEAM_STRIDE 16
#endif
#ifndef STARTERS
#define STARTERS 8
#endif
constexpr int T_TEAM = 256 / TEAM_STRIDE;
#ifndef G3_STAGGER_TICKS
#define G3_STAGGER_TICKS 800
#endif
#ifndef HG_SEGS
#define HG_SEGS 4
#endif
constexpr int HG_G = HG_SEGS;
constexpr size_t WS_QS = WS_BIG, WS_SL = WS_BIG + 64 * MiB, WS_DSEG = WS_BIG + 96 * MiB, WS_RAW = WS_SST;
constexpr int CW_BAR = 4096, CW_Q = 8192, CW_HS = 16384;
static_assert(pg8::EpiWin::O_Q == WS_Q && pg8::EpiWin::O_K == WS_K && pg8::EpiWin::O_V == WS_V && pg8::EpiWin::O_QQ == WS_QQ && pg8::EpiWin::O_KK == WS_KK && pg8::EpiWin::O_VV == WS_VV && pg8::EpiWin::O_HGS == WS_HGS && pg8::EpiWin::O_SZA == WS_SZA && pg8::EpiWin::O_SZH == WS_SZH && pg8::EpiWin::O_LOGF == WS_LOGF && pg8::EpiWin::O_LB == WS_LB && pg8::EpiWin::OK_P_ == OK_P && pg8::EpiWin::OV_P_ == OV_P && pg8::EpiWin::OK_S_ == OK_S && pg8::EpiWin::OV_S_ == OV_S, "EpiWin offsets");

constexpr int RING_OFF = 0, RING_BYTES = 139264;
constexpr int LDSCTL_OFF = RING_BYTES, MISC_OFF = LDSCTL_OFF + 320;
constexpr int LDS_BYTES = 147456;

struct Frame {
    LAS unsigned char* lds;
    volatile LAS unsigned* MISC;
    gu32* ctl;
    int tid, lane, wave;
    int vcu, G;
};
typedef float f32x16 __attribute__((ext_vector_type(16)));
typedef unsigned v2u __attribute__((ext_vector_type(2)));

__device__ __forceinline__ float shx(float v, int mask, int lane) { return __builtin_bit_cast(float, __builtin_amdgcn_ds_bpermute((lane ^ mask) << 2, __builtin_bit_cast(int, v))); }
__device__ __forceinline__ float wave_sum(float v, int lane) {
#pragma unroll
    for (int o = 1; o < 64; o <<= 1) v += shx(v, o, lane);
    return v;
}
__device__ __forceinline__ float bf2f(bf16 b) { return __builtin_bit_cast(float, (unsigned)b << 16); }
__device__ __forceinline__ unsigned cvtpk(float lo, float hi) { return pg8::cvt_pk_bf16(lo, hi); }
__device__ __forceinline__ bf16x8 pack8(f32x4 a, f32x4 b) { v4u w; w.x = cvtpk(a[0], a[1]); w.y = cvtpk(a[2], a[3]); w.z = cvtpk(b[0], b[1]); w.w = cvtpk(b[2], b[3]); return __builtin_bit_cast(bf16x8, w); }
__device__ __forceinline__ float lam_init_of(int l) { asm volatile("" : "+s"(l)); return 0.8f - 0.6f * __expf(-0.3f * (float)l); }

__device__ __forceinline__ void p0_transpose_item(const float* W, int K, int N, bf16* WT, bool gu, LAS float* scr, int item, int lane) {
    const int nblk = N / 32, kb = item / nblk, nb = item % nblk, k0 = 64 * kb, nd0 = 32 * nb;
    const int ns0 = gu ? (((nd0 >> 7) & 1) * 2816 + (nd0 >> 8) * 128 + (nd0 & 127)) : nd0;
#pragma unroll 8
    for (int i = 0; i < 32; ++i) { const int kk = 2 * i + (lane >> 5); scr[kk * 33 + (lane & 31)] = W[(size_t)(k0 + kk) * N + ns0 + (lane & 31)]; }
    LDS_WAIT(); asm volatile("" ::: "memory");
    const int c = lane & 7;
#pragma unroll
    for (int j = 0; j < 4; ++j) { const int n = (lane >> 3) + 8 * j; const LAS float* s = scr + (8 * c) * 33 + n;
        v4u o; o.x = pk2(s[0 * 33], s[1 * 33]); o.y = pk2(s[2 * 33], s[3 * 33]); o.z = pk2(s[4 * 33], s[5 * 33]); o.w = pk2(s[6 * 33], s[7 * 33]);
        *(GAS v4u*)(WT + (size_t)(nd0 + n) * K + k0 + 8 * c) = o; }
    LDS_WAIT(); asm volatile("" ::: "memory");
}
typedef const __attribute__((address_space(4))) char* kaptr_t;
__device__ __forceinline__ const float* karg(int i) { kaptr_t ka = (kaptr_t)__builtin_amdgcn_kernarg_segment_ptr(); asm volatile("" : "+s"(ka)); return *(const float* const __attribute__((address_space(4)))*)(ka + 8 * i); }
enum { A_XP = 0, A_XS, A_CK, A_CV, A_ST, A_CP, A_CS, A_WADA, A_BADA, A_GFFN1, A_WGU1, A_WD1, A_GMIX, A_WIN, A_LAM, A_GSUB, A_LBL, A_GHG, A_WBA, A_WBH, A_WOUT, A_GFFN2, A_WGU2, A_WD2, A_GFIN, A_OUT, A_WS };
__device__ __forceinline__ void p0_prologue(Frame& F, unsigned char* ws) {
    { LAS float* scr = (LAS float*)(F.lds + RING_OFF + F.wave * 16384);
      const int gw = F.vcu * NWAVES + F.wave, NGW = F.G * NWAVES;
      constexpr int I_GU = 16 * 176, I_D = 44 * 32, I_IN = 16 * 288, I_SQ = 16 * 32, I_LAYER = 2 * I_GU + 2 * I_D + I_IN + 3 * I_SQ;
      for (int it = gw; it < DEPTH * I_LAYER; it += NGW) {
          const int l = it / I_LAYER; int r = it % I_LAYER; unsigned char* wl = ws + WS_W + (size_t)l * W_LAYER;
          if (r < I_GU) { p0_transpose_item(karg(A_WGU1) + (size_t)l * 1024 * 5632, 1024, 5632, (bf16*)(wl + WO_GU1), true, scr, r, F.lane); continue; } r -= I_GU;
          if (r < I_D)  { p0_transpose_item(karg(A_WD1) + (size_t)l * 2816 * 1024, 2816, 1024, (bf16*)(wl + WO_D1), false, scr, r, F.lane); continue; } r -= I_D;
          if (r < I_IN) { p0_transpose_item(karg(A_WIN) + (size_t)l * 1024 * 9216, 1024, 9216, (bf16*)(wl + WO_IN), false, scr, r, F.lane); continue; } r -= I_IN;
          if (r < I_SQ) { p0_transpose_item(karg(A_WBA) + (size_t)l * 1024 * 1024, 1024, 1024, (bf16*)(wl + WO_BA), false, scr, r, F.lane); continue; } r -= I_SQ;
          if (r < I_SQ) { p0_transpose_item(karg(A_WBH) + (size_t)l * 1024 * 1024, 1024, 1024, (bf16*)(wl + WO_BH), false, scr, r, F.lane); continue; } r -= I_SQ;
          if (r < I_SQ) { p0_transpose_item(karg(A_WOUT) + (size_t)l * 1024 * 1024, 1024, 1024, (bf16*)(wl + WO_OUT), false, scr, r, F.lane); continue; } r -= I_SQ;
          if (r < I_GU) { p0_transpose_item(karg(A_WGU2) + (size_t)l * 1024 * 5632, 1024, 5632, (bf16*)(wl + WO_GU2), true, scr, r, F.lane); continue; } r -= I_GU;
          p0_transpose_item(karg(A_WD2) + (size_t)l * 2816 * 1024, 2816, 1024, (bf16*)(wl + WO_D2), false, scr, r, F.lane);
      } }
    __syncthreads();
    { const float* c_p = karg(A_CP); const float* c_s = karg(A_CS); const float* w_ada = karg(A_WADA); const float* b_ada = karg(A_BADA);
      LAS float* ca = (LAS float*)(F.lds);
      LAS float* red = (LAS float*)(F.lds + 81920);
      for (int i = F.tid; i < NSEQ * 1024; i += NWAVES * 64) { const int s = i >> 10, k = i & 1023; const float c = s < 4 ? c_p[s * 1024 + k] : c_s[(s - 4) * 1024 + k]; ca[i] = pg8::silu_f(c); }
      __syncthreads();
      float* MOD = (float*)(ws + WS_MOD);
      for (int it = F.vcu; it < DEPTH * 144; it += F.G) {
          const int l = it / 144, n = (it % 144) * 64 + F.lane; const float* wp = w_ada + ((size_t)l * 1024 + F.wave * 128) * 9216 + n;
          float acc[NSEQ];
#pragma unroll
          for (int s = 0; s < NSEQ; ++s) acc[s] = 0.f;
#pragma unroll 4
          for (int k = 0; k < 128; ++k) { const float w = wp[(size_t)k * 9216];
#pragma unroll
              for (int s = 0; s < NSEQ; ++s) acc[s] += ca[s * 1024 + F.wave * 128 + k] * w; }
#pragma unroll
          for (int s = 0; s < NSEQ; ++s) red[(F.wave * NSEQ + s) * 64 + F.lane] = acc[s];
          __syncthreads();
          for (int i = F.tid; i < NSEQ * 64; i += NWAVES * 64) { const int s = i >> 6, c = i & 63; float v = 0.f;
#pragma unroll
              for (int w = 0; w < 8; ++w) v += red[(w * NSEQ + s) * 64 + c];
              const int nn = (it % 144) * 64 + c; MOD[((size_t)l * NSEQ + s) * 9216 + nn] = v + b_ada[(size_t)l * 9216 + nn]; }
          __syncthreads();
      } }
    if (F.vcu == 0) { float* LB = (float*)(ws + WS_LB); const float* lb_logits = karg(A_LBL);
        for (int c = F.tid; c < 1024; c += NWAVES * 64) { float lg[4], mx = -INFINITY;
#pragma unroll
            for (int l = 0; l < 4; ++l) { lg[l] = lb_logits[l * 1024 + c]; mx = __builtin_fmaxf(mx, lg[l]); }
            float sum = 0.f;
#pragma unroll
            for (int l = 0; l < 4; ++l) { lg[l] = __expf(lg[l] - mx); sum += lg[l]; }
            const float inv = 1.f / sum; float cs = 0.f;
#pragma unroll
            for (int l = 0; l < 4; ++l) { cs += lg[l] * inv; LB[l * 1024 + c] = cs - lg[0] * inv; } } }
}

#ifndef NRF
#define NRF 2
#endif
__device__ __forceinline__ void norm_phase(Frame& F, const float* X, const float* g, const float* mod_l, int sub, bf16* XN, int row0, int row1, int gw, int NGW) {
    const int RW = (row1 - row0) / NGW, rbeg = row0 + gw * RW;
    const float* mp = mod_l + (size_t)pg8::row_seq(rbeg) * 9216 + sub * 3 * 1024;
    f32x4 av[4], bv[4];
#pragma unroll
    for (int j = 0; j < 4; ++j) { const int c = 4 * F.lane + 256 * j; const f32x4 gg = *(const f32x4*)(g + c), sc = *(const f32x4*)(mp + 1024 + c); bv[j] = *(const f32x4*)(mp + c); av[j] = gg * (sc + 1.f); }
    for (int i = 0; i < RW; i += NRF) {
        const int row = rbeg + i;
        const float* src = X + (size_t)row * DM;
        const f32x4* xr = (const f32x4*)src + F.lane; f32x4 v[NRF][4]; float s2[NRF];
#pragma unroll
        for (int u = 0; u < NRF; ++u) s2[u] = 0.f;
#pragma unroll
        for (int u = 0; u < NRF; ++u)
#pragma unroll
            for (int j = 0; j < 4; ++j) v[u][j] = xr[u * 256 + 64 * j];
#pragma unroll
        for (int u = 0; u < NRF; ++u)
#pragma unroll
            for (int j = 0; j < 4; ++j) s2[u] += (v[u][j].x * v[u][j].x + v[u][j].y * v[u][j].y) + (v[u][j].z * v[u][j].z + v[u][j].w * v[u][j].w);
#pragma unroll
        for (int u = 0; u < NRF; ++u) { const float rstd = __builtin_amdgcn_rsqf(wave_sum(s2[u], F.lane) * (1.f / DM) + EPS);
            v2u* o8 = (v2u*)(XN + (size_t)(row + u) * DM) + F.lane;
#pragma unroll
            for (int j = 0; j < 4; ++j) { const f32x4 h = (v[u][j] * rstd) * av[j] + bv[j]; v2u o; o.x = cvtpk(h.x, h.y); o.y = cvtpk(h.z, h.w); o8[64 * j] = o; } }
    }
}
__device__ __forceinline__ void final_norm_phase(Frame& F, const float* X, const float* g, float* out) {
    const int gw = F.vcu * NWAVES + F.wave, NGW = F.G * NWAVES;
    for (int row = gw; row < MROWS; row += NGW) {
        const f32x4* xr = (const f32x4*)(X + (size_t)row * DM) + F.lane; f32x4 v[4]; float s2 = 0.f;
#pragma unroll
        for (int j = 0; j < 4; ++j) { v[j] = xr[64 * j]; s2 += (v[j].x * v[j].x + v[j].y * v[j].y) + (v[j].z * v[j].z + v[j].w * v[j].w); }
        const float rstd = __builtin_amdgcn_rsqf(wave_sum(s2, F.lane) * (1.f / DM) + EPS);
        f32x4* o = (f32x4*)(out + (row < MP ? OY_P + (size_t)row * DM : OY_S + (size_t)(row - MP) * DM)) + F.lane;
#pragma unroll
        for (int j = 0; j < 4; ++j) { const f32x4 gg = *(const f32x4*)(g + 4 * F.lane + 256 * j); o[64 * j] = (v[j] * rstd) * gg; }
    }
}
__device__ __forceinline__ float lam_of(const float* att_lambda, int l, int lane) {
    const float* lp = att_lambda + (size_t)l * 256;
    const float a = wave_sum(lp[lane] * lp[64 + lane], lane), b = wave_sum(lp[128 + lane] * lp[192 + lane], lane);
    return __expf(a) - __expf(b) + lam_init_of(l);
}
__device__ __forceinline__ void attn_combine_phase(Frame& F, const bf16* O1, const bf16* O2, const float* gsub, float lam, float osc, bf16* OATT) {
    const int gw = F.vcu * NWAVES + F.wave, NGW = F.G * NWAVES; const int cl = (F.lane & 7) * 16;
    float gv[16];
#pragma unroll
    for (int i = 0; i < 16; ++i) gv[i] = gsub[cl + i] * osc;
    for (int row = gw; row < MP; row += 2 * NGW) {
        v4u a0[2], a1[2], b0[2], b1[2];
#pragma unroll
        for (int u = 0; u < 2; ++u) { const size_t off = (size_t)(row + u * NGW) * DM + F.lane * 16; a0[u] = *(const v4u*)(O1 + off); a1[u] = *(const v4u*)(O1 + off + 8); b0[u] = *(const v4u*)(O2 + off); b1[u] = *(const v4u*)(O2 + off + 8); }
#pragma unroll
        for (int u = 0; u < 2; ++u) { const size_t off = (size_t)(row + u * NGW) * DM + F.lane * 16;
            const unsigned aw[8] = {a0[u].x, a0[u].y, a0[u].z, a0[u].w, a1[u].x, a1[u].y, a1[u].z, a1[u].w}, bw[8] = {b0[u].x, b0[u].y, b0[u].z, b0[u].w, b1[u].x, b1[u].y, b1[u].z, b1[u].w};
            float o[16]; float ss = 0.f;
#pragma unroll
            for (int i = 0; i < 8; ++i) { o[2 * i] = pg8::bf_lo(aw[i]) - lam * pg8::bf_lo(bw[i]); o[2 * i + 1] = pg8::bf_hi(aw[i]) - lam * pg8::bf_hi(bw[i]); ss += o[2 * i] * o[2 * i] + o[2 * i + 1] * o[2 * i + 1]; }
            ss += shx(ss, 1, F.lane); ss += shx(ss, 2, F.lane); ss += shx(ss, 4, F.lane);
            const float rstd = __builtin_amdgcn_rsqf(ss * (1.f / 128.f) + EPS);
            v4u w0, w1;
            w0.x = cvtpk(o[0] * rstd * gv[0], o[1] * rstd * gv[1]); w0.y = cvtpk(o[2] * rstd * gv[2], o[3] * rstd * gv[3]); w0.z = cvtpk(o[4] * rstd * gv[4], o[5] * rstd * gv[5]); w0.w = cvtpk(o[6] * rstd * gv[6], o[7] * rstd * gv[7]);
            w1.x = cvtpk(o[8] * rstd * gv[8], o[9] * rstd * gv[9]); w1.y = cvtpk(o[10] * rstd * gv[10], o[11] * rstd * gv[11]); w1.z = cvtpk(o[12] * rstd * gv[12], o[13] * rstd * gv[13]); w1.w = cvtpk(o[14] * rstd * gv[14], o[15] * rstd * gv[15]);
            *(v4u*)(OATT + off) = w0; *(v4u*)(OATT + off + 8) = w1; }
    }
}

__device__ __forceinline__ void attn_sample_unit(Frame& F, const float* cache_k, const float* cache_v, int l, int s, int head, const bf16* Qb, const bf16* Kb, const bf16* Vb, float lam, float osc, const float* gsub, bf16* OATT) {
    const int lane = F.lane, w = F.wave, q = lane & 31, hh = lane >> 5, vt = w & 3, kh = w >> 2;
    LAS float* SLOT = (LAS float*)(F.lds);
    LAS float* ML = (LAS float*)(F.lds + 16384);
    LAS float* SSQ = (LAS float*)(F.lds + 16384 + 512);
    const size_t qrow = (size_t)MP + (size_t)s * 32;
    const float* ck = cache_k + ((size_t)(l * 16 + s) * PAST) * 1024 + head * 128;
    const float* cv = cache_v + ((size_t)(l * 16 + s) * PAST) * 1024 + head * 128;
    f32x16 o1;
#pragma unroll
    for (int r = 0; r < 16; ++r) o1[r] = 0.f;
    for (int m = 0; m < 2; ++m) {
        bf16x8 qf[4];
#pragma unroll
        for (int ks = 0; ks < 4; ++ks) qf[ks] = *(const bf16x8*)(Qb + (qrow + q) * 1024 + head * 128 + m * 64 + ks * 16 + 8 * hh);
        float mrun = -INFINITY, lrun = 0.f; f32x16 ot;
#pragma unroll
        for (int r = 0; r < 16; ++r) ot[r] = 0.f;
        const int ntile = 32 + kh;
        f32x4 kraw[8]; float vraw[16];
#define SA_ISSUE(tt) do { const int k0_ = kh * 1024 + (tt) * 32; const float* kp = ck + (size_t)(k0_ + q) * 1024 + m * 64 + 8 * hh; const float* vp = cv + (size_t)(k0_ + 4 * hh) * 1024 + 32 * vt + q; \
            _Pragma("unroll") for (int ks = 0; ks < 4; ++ks) { kraw[2 * ks] = *(const f32x4*)(kp + ks * 16); kraw[2 * ks + 1] = *(const f32x4*)(kp + ks * 16 + 4); } \
            _Pragma("unroll") for (int s2 = 0; s2 < 2; ++s2) _Pragma("unroll") for (int j = 0; j < 8; ++j) vraw[s2 * 8 + j] = vp[(16 * s2 + 8 * (j >> 2) + (j & 3)) * 1024]; } while (0)
        SA_ISSUE(0);
        for (int t = 0; t < ntile; ++t) {
            const bool nw = (t == 32);
            bf16x8 kf[4]; bf16x8 awv[2];
            if (!nw) {
#pragma unroll
                for (int ks = 0; ks < 4; ++ks) kf[ks] = pack8(kraw[2 * ks], kraw[2 * ks + 1]);
#pragma unroll
                for (int s2 = 0; s2 < 2; ++s2) { v4u aw; aw.x = cvtpk(vraw[s2 * 8 + 0], vraw[s2 * 8 + 1]); aw.y = cvtpk(vraw[s2 * 8 + 2], vraw[s2 * 8 + 3]); aw.z = cvtpk(vraw[s2 * 8 + 4], vraw[s2 * 8 + 5]); aw.w = cvtpk(vraw[s2 * 8 + 6], vraw[s2 * 8 + 7]); awv[s2] = __builtin_bit_cast(bf16x8, aw); }
                asm volatile("" ::: "memory");
                if (t + 1 < 32) SA_ISSUE(t + 1);
                asm volatile("" ::: "memory");
            } else {
#pragma unroll
                for (int ks = 0; ks < 4; ++ks) kf[ks] = *(const bf16x8*)(Kb + (qrow + q) * 1024 + head * 128 + m * 64 + ks * 16 + 8 * hh);
                const bf16* vpn = Vb + (qrow + 4 * hh) * 1024 + head * 128 + 32 * vt + q;
#pragma unroll
                for (int s2 = 0; s2 < 2; ++s2) { float vf[8];
#pragma unroll
                    for (int j = 0; j < 8; ++j) vf[j] = bf2f(vpn[(16 * s2 + 8 * (j >> 2) + (j & 3)) * 1024]);
                    v4u aw; aw.x = cvtpk(vf[0], vf[1]); aw.y = cvtpk(vf[2], vf[3]); aw.z = cvtpk(vf[4], vf[5]); aw.w = cvtpk(vf[6], vf[7]); awv[s2] = __builtin_bit_cast(bf16x8, aw); }
            }
            f32x16 st;
#pragma unroll
            for (int r = 0; r < 16; ++r) st[r] = 0.f;
#pragma unroll
            for (int ks = 0; ks < 4; ++ks) st = __builtin_amdgcn_mfma_f32_32x32x16_bf16(kf[ks], qf[ks], st, 0, 0, 0);
            float tm = st[0];
#pragma unroll
            for (int r = 1; r < 16; ++r) tm = __builtin_fmaxf(tm, st[r]);
            tm = __builtin_fmaxf(tm, shx(tm, 32, lane));
            const float mnew = __builtin_fmaxf(mrun, tm), alpha = __builtin_amdgcn_exp2f(mrun - mnew);
            float ls = 0.f;
#pragma unroll
            for (int r = 0; r < 16; ++r) { st[r] = __builtin_amdgcn_exp2f(st[r] - mnew); ls += st[r]; }
            ls += shx(ls, 32, lane);
            lrun = lrun * alpha + ls; mrun = mnew;
#pragma unroll
            for (int r = 0; r < 16; ++r) ot[r] *= alpha;
#pragma unroll
            for (int s2 = 0; s2 < 2; ++s2) { v4u pw; pw.x = cvtpk(st[8 * s2], st[8 * s2 + 1]); pw.y = cvtpk(st[8 * s2 + 2], st[8 * s2 + 3]); pw.z = cvtpk(st[8 * s2 + 4], st[8 * s2 + 5]); pw.w = cvtpk(st[8 * s2 + 6], st[8 * s2 + 7]);
                ot = __builtin_amdgcn_mfma_f32_32x32x16_bf16(awv[s2], __builtin_bit_cast(bf16x8, pw), ot, 0, 0, 0); }
        }
#undef SA_ISSUE
        if (vt == 0 && hh == 0) { ML[(kh * 32 + q) * 2] = mrun; ML[(kh * 32 + q) * 2 + 1] = lrun; }
        __syncthreads();
        const float m0 = ML[q * 2], l0 = ML[q * 2 + 1], m1 = ML[(32 + q) * 2], l1 = ML[(32 + q) * 2 + 1];
        const float Mx = __builtin_fmaxf(m0, m1), L = l0 * __builtin_amdgcn_exp2f(m0 - Mx) + l1 * __builtin_amdgcn_exp2f(m1 - Mx);
        { const float sc = __builtin_amdgcn_exp2f(mrun - Mx);
#pragma unroll
          for (int r = 0; r < 16; ++r) ot[r] *= sc; }
        if (kh == 1) {
#pragma unroll
            for (int r = 0; r < 16; ++r) SLOT[(vt * 16 + r) * 64 + lane] = ot[r]; }
        __syncthreads();
        if (kh == 0) { const float rl = 1.f / L;
#pragma unroll
            for (int r = 0; r < 16; ++r) ot[r] = (ot[r] + SLOT[(vt * 16 + r) * 64 + lane]) * rl;
            if (m == 0) {
#pragma unroll
                for (int r = 0; r < 16; ++r) o1[r] = ot[r];
            } else { float ss = 0.f;
#pragma unroll
                for (int r = 0; r < 16; ++r) { o1[r] = o1[r] - lam * ot[r]; ss += o1[r] * o1[r]; }
                ss += shx(ss, 32, lane);
                if (hh == 0) SSQ[vt * 32 + q] = ss; } }
        __syncthreads();
    }
    if (kh == 0) {
        const float ss = SSQ[q] + SSQ[32 + q] + SSQ[64 + q] + SSQ[96 + q];
        const float rstd = __builtin_amdgcn_rsqf(ss * (1.f / 128.f) + EPS) * osc;
#pragma unroll
        for (int r = 0; r < 16; ++r) { const int v = 32 * vt + (r & 3) + 8 * (r >> 2) + 4 * hh; OATT[(qrow + q) * 1024 + head * 128 + v] = (bf16)f2bf(o1[r] * rstd * gsub[v]); }
    }
    __syncthreads();
}

constexpr int HS = 72, HK = 136;
__device__ __forceinline__ f32x4 mfma16(bf16x8 a, bf16x8 b, f32x4 c) { return __builtin_amdgcn_mfma_f32_16x16x32_bf16(a, b, c, 0, 0, 0); }
__device__ __forceinline__ void st16bf(LAS bf16* p, const float (&v)[16]) {
    v4u a, b; a.x = cvtpk(v[0], v[1]); a.y = cvtpk(v[2], v[3]); a.z = cvtpk(v[4], v[5]); a.w = cvtpk(v[6], v[7]); b.x = cvtpk(v[8], v[9]); b.y = cvtpk(v[10], v[11]); b.z = cvtpk(v[12], v[13]); b.w = cvtpk(v[14], v[15]);
    *(LAS v4u*)p = a; *(LAS v4u*)(p + 8) = b;
}
__device__ __forceinline__ float bfu(unsigned b) { return __builtin_bit_cast(float, b << 16); }
struct HgPtrs { const float* LOGF; const bf16 *QQ, *KK, *VV, *HGS; const float* ghg; bf16* OH; bf16* dump; };
typedef float f32x2v __attribute__((ext_vector_type(2)));
__device__ __forceinline__ void hg_load(const HgPtrs& P, size_t ubase  , unsigned k0, int w, int nvalid, unsigned (&qv)[8], unsigned (&kv)[8], unsigned (&vv)[8]) {
    if (w * 8 < nvalid) {
#pragma unroll
        for (int i = 0; i < 8; ++i) { const size_t o = ubase + (size_t)(w * 8 + i) * 1024;
            const bf16* qp = P.QQ + o; const bf16* kp = P.KK + o; const bf16* vp = P.VV + o;
            qv[i] = *(const unsigned*)(qp + k0); kv[i] = *(const unsigned*)(kp + k0); vv[i] = *(const unsigned*)(vp + k0); }
    } else {
#pragma unroll
        for (int i = 0; i < 8; ++i) { qv[i] = 0u; kv[i] = 0u; vv[i] = 0u; }
    }
}
#define HG_BAR() asm volatile("s_waitcnt lgkmcnt(0)\n\ts_barrier" ::: "memory")
template <int MODE> __device__ __forceinline__ void hg_sequence(Frame& F, const HgPtrs& P, size_t row0, int h, int nchunk, int nvalid, const float* s_in, float* s_out, bf16* QS, float* RAW, float* dseg) {
    LAS float* seg = (LAS float*)(F.lds);
    LAS float* part = (LAS float*)(F.lds + 4096);
    LAS float* dvec = (LAS float*)(F.lds + 6144);
    LAS bf16* QH = (LAS bf16*)(F.lds + 8192);
    LAS bf16* QT = QH + 64 * HK;
    LAS bf16* KH = QT + 64 * HK;
    LAS bf16* VT = KH + 160 * HK;
    LAS bf16* KT = VT + 128 * HS;
    LAS bf16* AL = KT + 128 * HS;
    const int w = __builtin_amdgcn_readfirstlane(F.wave), sc = w >> 1, lr_ = F.lane & 15, lq_ = F.lane >> 4; const unsigned k0_ = 2u * (unsigned)F.lane;
    f32x4 S[8];
#pragma unroll
    for (int kb = 0; kb < 8; ++kb)
#pragma unroll
        for (int r = 0; r < 4; ++r) S[kb][r] = s_in ? s_in[(size_t)(16 * kb + 4 * lq_ + r) * 128 + 16 * w + lr_] : 0.f;
    const float gv = P.ghg[16 * w + lr_];
    f32x2v bseg = {0.f, 0.f};
#ifdef PROBE_HSEC
    unsigned long long tacc = 0, tq0 = 0;
#define HT0(id) do { if (PROBE_HSEC == (id)) tq0 = __builtin_amdgcn_s_memrealtime(); } while (0)
#define HT1(id) do { if (PROBE_HSEC == (id)) tacc += __builtin_amdgcn_s_memrealtime() - tq0; } while (0)
#else
#define HT0(id) do {} while (0)
#define HT1(id) do {} while (0)
#endif
    unsigned qv[8], kv[8], vv[8];
    hg_load(P, row0 * 1024 + h * 128, k0_, w, nvalid, qv, kv, vv);
    for (int c = 0; c < nchunk; ++c) {
        int lr = lr_, lq = lq_; unsigned k0 = k0_; asm volatile("" : "+v"(lr), "+v"(lq), "+v"(k0));
        const int lx = lq * 16 + lr;
        const size_t crow = row0 + (size_t)c * 64;
        HT0(1);
        f32x2v cs[8]; { f32x2v run = {0.f, 0.f};
#pragma unroll
            for (int i = 0; i < 8; ++i) { f32x2v lfi; lfi.x = __logf(__builtin_fmaxf(1.f - bfu(kv[i] & 0xffffu), 9.765625e-4f)); lfi.y = __logf(__builtin_fmaxf(1.f - bfu(kv[i] >> 16), 9.765625e-4f));
                run = run + lfi; cs[i] = run; }
            *(LAS f32x2v*)(seg + w * 128 + k0) = run; }
        HG_BAR();
        f32x2v P2[4], mypre = {0.f, 0.f}, tot; { f32x2v p = {0.f, 0.f};
#pragma unroll
            for (int s = 0; s < 8; ++s) { if ((s & 1) == 0) P2[s >> 1] = p; mypre = (s == w) ? p : mypre; p = p + *(const LAS f32x2v*)(seg + s * 128 + k0); } tot = p; }
        f32x2v myref = P2[0], nref = P2[1];
#pragma unroll
        for (int s = 1; s < 4; ++s) { myref = (s == sc) ? P2[s] : myref; nref = (s == sc) ? (s == 3 ? tot : P2[s < 3 ? s + 1 : 3]) : nref; }
        const f32x2v dq = mypre - myref;
        f32x2v fq, fT, fK[4]; fq.x = __expf(myref.x); fq.y = __expf(myref.y); fT.x = __expf(tot.x - nref.x); fT.y = __expf(tot.y - nref.y);
#pragma unroll
        for (int ii = 1; ii < 4; ++ii) { fK[ii].x = __expf(__builtin_fminf(P2[ii].x - nref.x, 0.f)); fK[ii].y = __expf(__builtin_fminf(P2[ii].y - nref.y, 0.f)); }
        f32x2v fqs = fq; if constexpr (MODE == 1) { fqs.x = fq.x * __expf(bseg.x); fqs.y = fq.y * __expf(bseg.y); bseg = bseg + tot; }
        float t0[8], t1[8];
#pragma unroll
        for (int i = 0; i < 8; ++i) { const int r = w * 8 + i; const float q0 = bfu(qv[i] & 0xffffu), q1 = bfu(qv[i] >> 16), a0 = bfu(kv[i] & 0xffffu), a1 = bfu(kv[i] >> 16);
            const float E0 = dq.x + cs[i].x, E1 = dq.y + cs[i].y;
            const float e1x = __expf(E0), e1y = __expf(E1);
            const float e2x = __builtin_fminf(__builtin_amdgcn_rcpf(e1x), 5.5e34f), e2y = __builtin_fminf(__builtin_amdgcn_rcpf(e1y), 5.5e34f);
            const float e3x = __expf((nref.x - myref.x) - E0), e3y = __expf((nref.y - myref.y) - E1);
            *(LAS unsigned*)(QH + r * HK + k0) = cvtpk(q0 * e1x, q1 * e1y);
            *(LAS unsigned*)(QT + r * HK + k0) = cvtpk(q0 * e1x * fq.x, q1 * e1y * fq.y);
            if constexpr (MODE == 1) { bf16* qsp = QS + (crow + r) * 1024 + h * 128; *(unsigned*)(qsp + k0) = cvtpk(q0 * e1x * fqs.x, q1 * e1y * fqs.y); }
            const float b0 = a0 * e3x, b1 = a1 * e3y;
            { const int rb = (sc == 0) ? 0 : (sc == 1) ? 16 : (sc == 2) ? 48 : 96; *(LAS unsigned*)(KH + (rb + r) * HK + k0) = cvtpk(a0 * e2x, a1 * e2y); }
#pragma unroll
            for (int ii = 1; ii < 4; ++ii) if (ii > sc) { const int rb = (ii == 1) ? 16 : (ii == 2) ? 48 : 96; *(LAS unsigned*)(KH + (rb + r) * HK + k0) = cvtpk(b0 * fK[ii].x, b1 * fK[ii].y); }
            t0[i] = b0 * fT.x; t1[i] = b1 * fT.y; }
        { v4u u0, u1; u0.x = cvtpk(t0[0], t0[1]); u0.y = cvtpk(t0[2], t0[3]); u0.z = cvtpk(t0[4], t0[5]); u0.w = cvtpk(t0[6], t0[7]); u1.x = cvtpk(t1[0], t1[1]); u1.y = cvtpk(t1[2], t1[3]); u1.z = cvtpk(t1[4], t1[5]); u1.w = cvtpk(t1[6], t1[7]);
          *(LAS v4u*)(KT + k0 * HS + 8 * w) = u0; *(LAS v4u*)(KT + (k0 + 1) * HS + 8 * w) = u1; }
        { v4u u0, u1;
          u0.x = (vv[0] & 0xffffu) | (vv[1] << 16); u0.y = (vv[2] & 0xffffu) | (vv[3] << 16); u0.z = (vv[4] & 0xffffu) | (vv[5] << 16); u0.w = (vv[6] & 0xffffu) | (vv[7] << 16);
          u1.x = (vv[0] >> 16) | (vv[1] & 0xffff0000u); u1.y = (vv[2] >> 16) | (vv[3] & 0xffff0000u); u1.z = (vv[4] >> 16) | (vv[5] & 0xffff0000u); u1.w = (vv[6] >> 16) | (vv[7] & 0xffff0000u);
          *(LAS v4u*)(VT + k0 * HS + 8 * w) = u0; *(LAS v4u*)(VT + (k0 + 1) * HS + 8 * w) = u1;
          if (w == 0) { f32x2v d; d.x = __expf(tot.x); d.y = __expf(tot.y); *(LAS f32x2v*)(dvec + k0) = d; } }
        HG_BAR();
        HT1(1); HT0(2);
        if (c + 1 < nchunk) hg_load(P, (crow + 64) * 1024 + h * 128, k0, w, nvalid, qv, kv, vv);
        unsigned short hgv[16];
        if constexpr (MODE == 0) { const bf16* hp = P.HGS + crow * 1024 + h * 128 + 16 * w;
#pragma unroll
          for (int mt = 0; mt < 4; ++mt)
#pragma unroll
              for (int r = 0; r < 4; ++r) { int t = 16 * mt + 4 * lq + r; t = t < nvalid ? t : nvalid - 1; hgv[mt * 4 + r] = hp[(unsigned)(t * 1024 + lr)]; } }
#pragma unroll
        for (int rr = 0; rr < 2; ++rr) { const int blk = w + 8 * rr, bi = blk >> 2, bj = blk & 3;
            f32x4 acc = {0.f, 0.f, 0.f, 0.f};
            if (bj <= bi) { const int rb = (bi == 0) ? 0 : (bi == 1) ? 16 : (bi == 2) ? 48 : 96;
#pragma unroll
                for (int ks = 0; ks < 4; ++ks) { const bf16x8 a = *(const LAS bf16x8*)(QH + (16 * bi + lr) * HK + ks * 32 + 8 * lq), b = *(const LAS bf16x8*)(KH + (rb + 16 * bj + lr) * HK + ks * 32 + 8 * lq); acc = mfma16(a, b, acc); }
                if (bi == bj) {
#pragma unroll
                    for (int r = 0; r < 4; ++r) acc[r] = (lr <= 4 * lq + r) ? acc[r] : 0.f; } }
#pragma unroll
            for (int r = 0; r < 4; ++r) AL[(16 * bi + 4 * lq + r) * HS + 16 * bj + lr] = (bf16)f2bf(acc[r]); }
        HG_BAR();
        HT1(2); HT0(3);
        f32x4 o[4];
        { bf16x8 bS[4], bV[2];
#pragma unroll
          for (int kp = 0; kp < 4; ++kp) { v4u t; t.x = cvtpk(S[2 * kp][0], S[2 * kp][1]); t.y = cvtpk(S[2 * kp][2], S[2 * kp][3]); t.z = cvtpk(S[2 * kp + 1][0], S[2 * kp + 1][1]); t.w = cvtpk(S[2 * kp + 1][2], S[2 * kp + 1][3]); bS[kp] = __builtin_bit_cast(bf16x8, t); }
#pragma unroll
          for (int ks = 0; ks < 2; ++ks) bV[ks] = *(const LAS bf16x8*)(VT + (16 * w + lr) * HS + ks * 32 + 8 * lq);
#pragma unroll
          for (int mt = 0; mt < 4; ++mt) { f32x4 acc = {0.f, 0.f, 0.f, 0.f};
#pragma unroll
              for (int kp = 0; kp < 4; ++kp) { const LAS bf16* qp = QT + (16 * mt + lr) * HK + 32 * kp + 4 * lq; const v2u a0 = *(const LAS v2u*)qp, a1 = *(const LAS v2u*)(qp + 16);
                  v4u a; a.x = a0.x; a.y = a0.y; a.z = a1.x; a.w = a1.y; acc = mfma16(__builtin_bit_cast(bf16x8, a), bS[kp], acc); }
#pragma unroll
              for (int ks = 0; ks < 2; ++ks) acc = mfma16(*(const LAS bf16x8*)(AL + (16 * mt + lr) * HS + ks * 32 + 8 * lq), bV[ks], acc);
              o[mt] = acc;
              if constexpr (MODE == 1) { float* rp = RAW + (crow + 16 * mt) * 1024 + h * 128 + 16 * w;
#pragma unroll
                  for (int r = 0; r < 4; ++r) rp[(unsigned)((4 * lq + r) * 1024 + lr)] = acc[r]; }
              if constexpr (MODE == 0)
#pragma unroll
              for (int r = 0; r < 4; ++r) { float p = acc[r] * acc[r]; p += shx(p, 1, lx); p += shx(p, 2, lx); p += shx(p, 4, lx); p += shx(p, 8, lx); if (lr == 0) part[(16 * mt + 4 * lq + r) * 8 + w] = p; } } }
        { bf16x8 bV[2];
#pragma unroll
          for (int ks = 0; ks < 2; ++ks) bV[ks] = *(const LAS bf16x8*)(VT + (16 * w + lr) * HS + ks * 32 + 8 * lq);
#pragma unroll
          for (int kb = 0; kb < 8; ++kb) { const f32x4 d = *(const LAS f32x4*)(dvec + 16 * kb + 4 * lq); f32x4 acc = S[kb] * d;
#pragma unroll
              for (int ks = 0; ks < 2; ++ks) acc = mfma16(*(const LAS bf16x8*)(KT + (16 * kb + lr) * HS + ks * 32 + 8 * lq), bV[ks], acc);
              S[kb] = acc; } }
        if constexpr (MODE == 0) {
        HG_BAR();
        { bf16* op = P.OH + crow * 1024 + h * 128 + 16 * w;
#pragma unroll
          for (int mt = 0; mt < 4; ++mt)
#pragma unroll
              for (int r = 0; r < 4; ++r) { const int t = 16 * mt + 4 * lq + r; const f32x4 p0 = *(const LAS f32x4*)(part + t * 8), p1 = *(const LAS f32x4*)(part + t * 8 + 4);
                  const float ss = ((p0[0] + p0[1]) + (p0[2] + p0[3])) + ((p1[0] + p1[1]) + (p1[2] + p1[3]));
                  const float rstd = __builtin_amdgcn_rsqf(ss * (1.f / 128.f) + EPS);
                  const bf16 ov = (bf16)f2bf(o[mt][r] * rstd * gv * bf2f(hgv[mt * 4 + r]));
                  bf16* dst = (t < nvalid) ? op + (unsigned)(t * 1024 + lr) : P.dump + F.tid;
                  *dst = ov; } }
        }
        HG_BAR();
        HT1(3);
    }
#pragma unroll
    for (int kb = 0; kb < 8; ++kb)
#pragma unroll
        for (int r = 0; r < 4; ++r) s_out[(size_t)(16 * kb + 4 * lq_ + r) * 128 + 16 * w + lr_] = S[kb][r];
    if constexpr (MODE == 1) { if (w == 0) { f32x2v d; d.x = __expf(bseg.x); d.y = __expf(bseg.y); *(f32x2v*)(dseg + k0_) = d; } }
#ifdef PROBE_HSEC
    if constexpr (MODE == 1) { if (row0 == 0 && h == 0) { const unsigned long long t1 = __builtin_amdgcn_s_memrealtime(); while (__builtin_amdgcn_s_memrealtime() - t1 < 20ull * tacc) __builtin_amdgcn_s_sleep(8); } }
#endif
#undef HT0
#undef HT1
}

__device__ __forceinline__ void hg_fix(Frame& F, const HgPtrs& P, size_t row0, int h, int nchunk, int g, int G, const float* SLseq, const float* DSseq, const bf16* QS, const float* RAW, gu32* mask, float* s_fin) {
    LAS float* part = (LAS float*)(F.lds);
    const int w = __builtin_amdgcn_readfirstlane(F.wave), lr_ = F.lane & 15, lq_ = F.lane >> 4;
    if (F.tid == 0) { const unsigned need = (1u << g) - 1u; unsigned sp = 0;
        while ((__hip_atomic_load(mask, RLX_AGENT) & need) != need) { __builtin_amdgcn_s_sleep(2); if (++sp > (1u << 22)) { __hip_atomic_store(F.ctl + 1, 0x7eb0u, RLX_AGENT); break; } }
        __builtin_amdgcn_fence(__ATOMIC_ACQUIRE, "agent"); asm volatile("s_waitcnt vmcnt(0)" ::: "memory"); }
    __syncthreads();
    f32x4 S[8];
#pragma unroll
    for (int kb = 0; kb < 8; ++kb) S[kb] = (f32x4){0.f, 0.f, 0.f, 0.f};
    for (int p = 0; p < g; ++p) { const float* sl = SLseq + (size_t)p * 16384; const float* ds = DSseq + p * 128;
#pragma unroll
        for (int kb = 0; kb < 8; ++kb) { const f32x4 d = *(const f32x4*)(ds + 16 * kb + 4 * lq_);
#pragma unroll
            for (int r = 0; r < 4; ++r) S[kb][r] = d[r] * S[kb][r] + sl[(size_t)(16 * kb + 4 * lq_ + r) * 128 + 16 * w + lr_]; } }
    if (g == G - 1) { const float* sl = SLseq + (size_t)g * 16384; const float* ds = DSseq + g * 128;
#pragma unroll
        for (int kb = 0; kb < 8; ++kb) { const f32x4 d = *(const f32x4*)(ds + 16 * kb + 4 * lq_);
#pragma unroll
            for (int r = 0; r < 4; ++r) { const size_t o = (size_t)(16 * kb + 4 * lq_ + r) * 128 + 16 * w + lr_; s_fin[o] = d[r] * S[kb][r] + sl[o]; } } }
    bf16x8 bS[4];
#pragma unroll
    for (int kp = 0; kp < 4; ++kp) { v4u t; t.x = cvtpk(S[2 * kp][0], S[2 * kp][1]); t.y = cvtpk(S[2 * kp][2], S[2 * kp][3]); t.z = cvtpk(S[2 * kp + 1][0], S[2 * kp + 1][1]); t.w = cvtpk(S[2 * kp + 1][2], S[2 * kp + 1][3]); bS[kp] = __builtin_bit_cast(bf16x8, t); }
    const float gv = P.ghg[16 * w + lr_];
    f32x4 on[4]; unsigned short hn[16]; v2u qn[4][4][2];
#define HGF_LOAD(cc) do { const size_t cr_ = row0 + (size_t)(cc) * 64; const bf16* hp = P.HGS + cr_ * 1024 + h * 128 + 16 * w; const float* rp = RAW + cr_ * 1024 + h * 128 + 16 * w; \
        _Pragma("unroll") for (int mt = 0; mt < 4; ++mt) { \
            _Pragma("unroll") for (int r = 0; r < 4; ++r) { const unsigned off = (unsigned)((16 * mt + 4 * lq_ + r) * 1024 + lr_); on[mt][r] = rp[off]; hn[mt * 4 + r] = hp[off]; } \
            const bf16* qb = QS + (cr_ + 16 * mt) * 1024 + h * 128; \
            _Pragma("unroll") for (int kp = 0; kp < 4; ++kp) { const bf16* qp = qb + (unsigned)(lr_ * 1024 + 32 * kp + 4 * lq_); qn[mt][kp][0] = *(const v2u*)qp; qn[mt][kp][1] = *(const v2u*)(qp + 16); } } } while (0)
    HGF_LOAD(0);
    for (int c = 0; c < nchunk; ++c) {
        int lr = lr_, lq = lq_; asm volatile("" : "+v"(lr), "+v"(lq)); const int lx = lq * 16 + lr;
        const size_t crow = row0 + (size_t)c * 64;
        LAS float* pt = part + (c & 1) * 512;
        f32x4 o[4]; unsigned short hgv[16];
#pragma unroll
        for (int mt = 0; mt < 4; ++mt) { f32x4 acc = on[mt];
#pragma unroll
            for (int r = 0; r < 4; ++r) hgv[mt * 4 + r] = hn[mt * 4 + r];
#pragma unroll
            for (int kp = 0; kp < 4; ++kp) { v4u a; a.x = qn[mt][kp][0].x; a.y = qn[mt][kp][0].y; a.z = qn[mt][kp][1].x; a.w = qn[mt][kp][1].y; acc = mfma16(__builtin_bit_cast(bf16x8, a), bS[kp], acc); }
            o[mt] = acc; }
        asm volatile("" ::: "memory");
        if (c + 1 < nchunk) HGF_LOAD(c + 1);
        asm volatile("" ::: "memory");
#pragma unroll
        for (int mt = 0; mt < 4; ++mt)
#pragma unroll
            for (int r = 0; r < 4; ++r) { float p = o[mt][r] * o[mt][r]; p += shx(p, 1, lx); p += shx(p, 2, lx); p += shx(p, 4, lx); p += shx(p, 8, lx); if (lr == 0) pt[(16 * mt + 4 * lq + r) * 8 + w] = p; }
        HG_BAR();
        { bf16* op = P.OH + crow * 1024 + h * 128 + 16 * w;
#pragma unroll
          for (int mt = 0; mt < 4; ++mt)
#pragma unroll
              for (int r = 0; r < 4; ++r) { const int t = 16 * mt + 4 * lq + r; const f32x4 p0 = *(const LAS f32x4*)(pt + t * 8), p1 = *(const LAS f32x4*)(pt + t * 8 + 4);
                  const float ss = ((p0[0] + p0[1]) + (p0[2] + p0[3])) + ((p1[0] + p1[1]) + (p1[2] + p1[3]));
                  const float rstd = __builtin_amdgcn_rsqf(ss * (1.f / 128.f) + EPS);
                  op[(unsigned)(t * 1024 + lr)] = (bf16)f2bf(o[mt][r] * rstd * gv * bf2f(hgv[mt * 4 + r])); } }
    }
#undef HGF_LOAD
    __syncthreads();
}
#undef HG_BAR
__device__ __forceinline__ void team_barrier(Frame& F, gu32* w, unsigned target) {
    asm volatile("s_waitcnt vmcnt(0)" ::: "memory");
    __syncthreads();
    if (F.tid == 0) {
        __builtin_amdgcn_fence(__ATOMIC_RELEASE, "agent");
        asm volatile("s_waitcnt vmcnt(0)" ::: "memory");
        (void)__hip_atomic_fetch_add(w, 1u, RLX_AGENT);
        unsigned sp = 0;
        while (__hip_atomic_load(w, RLX_AGENT) < target) { __builtin_amdgcn_s_sleep(2); if (++sp > (1u << 22)) { __hip_atomic_store(F.ctl + 1, 0x7ea0u, RLX_AGENT); break; } }
        __builtin_amdgcn_fence(__ATOMIC_ACQUIRE, "agent");
        asm volatile("s_waitcnt vmcnt(0)" ::: "memory");
    }
    __syncthreads();
}
__device__ __forceinline__ int attn_pull(Frame& F, gu32* q8  , int x0, int nitems) {
    if (F.tid == 0) {
        int res = -1;
        for (int tries = 0; tries < 16; ++tries) {
            unsigned c[8]; unsigned cmin = 0xffffffffu; int imin = 0;
#pragma unroll
            for (int h = 0; h < 8; ++h) { c[h] = __hip_atomic_load(q8 + 64 * h, RLX_AGENT); if (c[h] < cmin) { cmin = c[h]; imin = h; } }
            if (cmin >= (unsigned)nitems) break;
            unsigned cx = c[0];
#pragma unroll
            for (int h = 1; h < 8; ++h) cx = (h == x0) ? c[h] : cx;
            const int hsel = (cx < (unsigned)nitems && cx <= cmin + 6u) ? x0 : imin;
            const unsigned it = __hip_atomic_fetch_add(q8 + 64 * hsel, 1u, RLX_AGENT);
            if (it < (unsigned)nitems) { res = (hsel << 16) | (int)it; break; }
        }
        F.MISC[16] = (unsigned)res;
    }
    __syncthreads();
    const int v = (int)F.MISC[16];
    __syncthreads();
    return __builtin_amdgcn_readfirstlane(v);
}
__device__ __forceinline__ int wg_pull(Frame& F, gu32* ctr) {
    if (F.tid == 0) F.MISC[16] = __hip_atomic_fetch_add(ctr, 1u, RLX_AGENT);
    __syncthreads();
    const int v = (int)F.MISC[16];
    __syncthreads();
    return __builtin_amdgcn_readfirstlane(v);
}
#ifdef PROBE_ID
#define PT_BEGIN(id) unsigned long long pt0_##id = 0; if ((id) == PROBE_ID && blockIdx.x == 0) pt0_##id = __builtin_amdgcn_s_memrealtime()
#define PT_END(id) do { if ((id) == PROBE_ID && blockIdx.x == 0) { const unsigned long long t1 = __builtin_amdgcn_s_memrealtime(), d = t1 - pt0_##id; while (__builtin_amdgcn_s_memrealtime() - t1 < d) __builtin_amdgcn_s_sleep(8); } } while (0)
#else
#define PT_BEGIN(id) do {} while (0)
#define PT_END(id) do {} while (0)
#endif
struct Args { const float* in[25]; float* out; unsigned char* ws; };
__global__ void __launch_bounds__(NWAVES * 64, 2) mk_fwd(Args args) {
    extern __shared__ __attribute__((aligned(16))) unsigned char lds[];
    Frame F;
    F.lds = (LAS unsigned char*)lds;
    F.MISC = (volatile LAS unsigned*)(F.lds + MISC_OFF);
#define ENTER() do { F.tid = opaque_tid(); F.lane = F.tid & 63; F.wave = __builtin_amdgcn_readfirstlane(F.tid >> 6); F.G = gridDim.x; { const int bx = opaque_bid(); F.vcu = (F.G % 8 == 0) ? (bx % 8) * (F.G / 8) + bx / 8 : bx; } } while (0)
    for (int u = threadIdx.x; u < (LDS_BYTES - LDSCTL_OFF) / 4; u += NWAVES * 64) ((LAS unsigned*)(F.lds + LDSCTL_OFF))[u] = 0u;
    __syncthreads();
    tid_table_init();
    __syncthreads();
    static_assert(WTAB_LDS_ADDR == (unsigned)(MISC_OFF + 256) && MISC_OFF + 256 + 256 <= LDS_BYTES, "wave-slot table inside the LDS control area");
    ENTER();
    F.ctl = (gu32*)((unsigned char*)karg(A_WS) + WS_CTL);
    XcdBarrier bar = xcd_barrier_post((unsigned*)(F.ctl + CW_BAR), F.MISC + 8);
#define GRID_BAR() do { asm volatile("" : "+s"(bar.x)); xcd_barrier(bar); } while (0)
#define WSP(T, off) ((T*)((unsigned char*)karg(A_WS) + (off)))
#define OUTP(off) ((float*)karg(A_OUT) + (off))
#define XIN_P (l == 0 ? karg(A_XP) : WSP(const float, WS_X))
#define XIN_S (l == 0 ? karg(A_XS) - (size_t)MP * DM : WSP(const float, WS_X))

#ifndef NO_P0
    p0_prologue(F, WSP(unsigned char, 0));
#ifdef DUP_P0
    GRID_BAR(); ENTER(); p0_prologue(F, WSP(unsigned char, 0));
#endif
#endif
    GRID_BAR();

    for (int l = 0; l < DEPTH; ++l) {
        const size_t wlo = WS_W + (size_t)l * W_LAYER, modo = WS_MOD + (size_t)l * NSEQ * 9216 * 4;
        norm_phase(F, XIN_P, karg(A_GFFN1) + l * 1024, WSP(const float, modo), 0, WSP(bf16, WS_XN), 0, MP, F.vcu * NWAVES + F.wave, 256 * NWAVES);
#ifdef DUP_THIN
        GRID_BAR(); ENTER();
        norm_phase(F, XIN_P, karg(A_GFFN1) + l * 1024, WSP(const float, modo), 0, WSP(bf16, WS_XN), 0, MP, F.vcu * NWAVES + F.wave, 256 * NWAVES);
#endif
        GRID_BAR(); ENTER();
#ifndef NO_G1
        { pg8::Gemm g{WSP(bf16, WS_XN), WSP(const bf16, wlo + WO_GU1), MP, 2 * DFF, DM}; typedef pg8::FixedOrder<128, 22, 8> Ord; Ord S; S.init(F.G, opaque_bid());
          pg8::EpiSwiglu E{WSP(bf16, WS_BIG)};
          pg8::gemm_phase<pg8::EpiSwiglu, Ord, true, true>(F.lds + RING_OFF, g, S, E);
#ifdef DUP_G1
          GRID_BAR(); ENTER(); pg8::gemm_phase<pg8::EpiSwiglu, Ord, true, true>(F.lds + RING_OFF, g, S, E);
#endif
        }
#endif
        GRID_BAR(); ENTER();
#ifndef NO_G2
        { pg8::Gemm g{WSP(bf16, WS_BIG), WSP(const bf16, wlo + WO_D1), MP, DM, DFF}; typedef pg8::FixedOrder<128, 4, 8> Ord; Ord S; S.init(F.G, opaque_bid());
          pg8::EpiResid E{WSP(float, WS_X), WSP(const float, modo) + 2 * 1024, 0.5f, l == 0 ? 1 : 0};
          pg8::gemm_phase<pg8::EpiResid, Ord, true, true>(F.lds + RING_OFF, g, S, E);
#ifdef DUP_RES
          GRID_BAR(); ENTER(); { pg8::EpiResid E0{E.X, E.gate, 0.f, 0}; pg8::gemm_phase<pg8::EpiResid, Ord, true, true>(F.lds + RING_OFF, g, S, E0); }
#endif
        }
#endif
        GRID_BAR(); ENTER();
        norm_phase(F, WSP(const float, WS_X), karg(A_GMIX) + l * 1024, WSP(const float, modo), 1, WSP(bf16, WS_XN), 0, MP, F.vcu * NWAVES + F.wave, 256 * NWAVES);
#ifdef DUP_THIN
        GRID_BAR(); ENTER();
        norm_phase(F, WSP(const float, WS_X), karg(A_GMIX) + l * 1024, WSP(const float, modo), 1, WSP(bf16, WS_XN), 0, MP, F.vcu * NWAVES + F.wave, 256 * NWAVES);
#endif
        GRID_BAR(); ENTER();
        PT_BEGIN(2);
#ifndef NO_G3
        { pg8::Gemm g{WSP(bf16, WS_XN), WSP(const bf16, wlo + WO_IN), MP, DIN, DM}; typedef pg8::FixedOrder<128, 36, 8> Ord; Ord S; S.init(F.G, opaque_bid());
          pg8::EpiWin E{WSP(unsigned char, 0), OUTP(0), l, attn_body::C2};
          pg8::gemm_phase<pg8::EpiWin, Ord, true, true>(F.lds + RING_OFF, g, S, E);
#ifdef PROBE_G3NULL
          GRID_BAR(); ENTER(); PT_BEGIN(3); { float* sk_ = nullptr; asm volatile("" : "+s"(sk_)); pg8::EpiNull E0{sk_}; pg8::gemm_phase<pg8::EpiNull, Ord, true, true>(F.lds + RING_OFF, g, S, E0); } GRID_BAR(); ENTER(); PT_END(3);
#endif
        }
#endif
        GRID_BAR(); ENTER();
        PT_END(2);
        PT_BEGIN(1);
        { gu32* qbase = F.ctl + CW_Q + 64 * (l * 16);
          const int tk = wg_pull(F, qbase + 64 * 9);
#ifdef PROBE_ROLE
          const unsigned long long pr0 = __builtin_amdgcn_s_memrealtime();
#endif
          constexpr int T_EFF = T_TEAM;
          const bool team = (tk % TEAM_STRIDE) == 0, hfirst = (tk % TEAM_STRIDE) >= 1 && (tk % TEAM_STRIDE) <= STARTERS; const int ticket = tk / TEAM_STRIDE; gu32* tb = qbase + 64 * 10; unsigned tstage = 0;
#define TEAM_BAR() do { ++tstage; team_barrier(F, tb, (unsigned)T_EFF * tstage); ENTER(); } while (0)
#ifndef NO_TEAM
          if (team) {
              const int tgw = ticket * NWAVES + F.wave, TNW = T_EFF * NWAVES;
              norm_phase(F, XIN_S, karg(A_GFFN1) + l * 1024, WSP(const float, modo), 0, WSP(bf16, WS_XN), MP, MROWS, tgw, TNW);
              TEAM_BAR();
              { pg8::Gemm g{WSP(bf16, WS_XN), WSP(const bf16, wlo + WO_GU1), MROWS, 2 * DFF, DM}; typedef pg8::TeamOrder<22> Ord; Ord S; S.init(T_EFF, ticket);
                pg8::EpiSwiglu E{WSP(bf16, WS_BIG)};
                pg8::gemm_phase<pg8::EpiSwiglu, Ord, true, true>(F.lds + RING_OFF, g, S, E); }
              TEAM_BAR();
              { pg8::Gemm g{WSP(bf16, WS_BIG), WSP(const bf16, wlo + WO_D1), MROWS, DM, DFF}; typedef pg8::TeamOrder<4> Ord; Ord S; S.init(T_EFF, ticket);
                pg8::EpiResid E{WSP(float, WS_X), WSP(const float, modo) + 2 * 1024, 0.5f, l == 0 ? 2 : 0};
                pg8::gemm_phase<pg8::EpiResid, Ord, true, true>(F.lds + RING_OFF, g, S, E); }
              TEAM_BAR();
              norm_phase(F, WSP(const float, WS_X), karg(A_GMIX) + l * 1024, WSP(const float, modo), 1, WSP(bf16, WS_XN), MP, MROWS, ticket * NWAVES + F.wave, T_EFF * NWAVES);
              TEAM_BAR();
              { pg8::Gemm g{WSP(bf16, WS_XN), WSP(const bf16, wlo + WO_IN), MROWS, DIN, DM}; typedef pg8::TeamOrder<36> Ord; Ord S; S.init(T_EFF, ticket);
                pg8::EpiWin E{WSP(unsigned char, 0), OUTP(0), l, attn_body::C2};
                pg8::gemm_phase<pg8::EpiWin, Ord, true, true>(F.lds + RING_OFF, g, S, E); }
              TEAM_BAR();
          }
#endif
          if (hfirst) {
            for (;;) { const int it = wg_pull(F, qbase); if (it >= 32 * HG_G) break;
              const HgPtrs P{WSP(const float, WS_LOGF), WSP(const bf16, WS_QQ), WSP(const bf16, WS_KK), WSP(const bf16, WS_VV), WSP(const bf16, WS_HGS), karg(A_GHG) + l * 128, WSP(bf16, WS_OH), WSP(bf16, WS_DD)};
#ifndef NO_H
                  const int sqh = it / HG_G, g = it % HG_G, b = sqh >> 3, h = sqh & 7; const int nch = 128 / HG_G;
                  const size_t r0 = (size_t)b * 8192 + (size_t)g * nch * 64;
                  float* SLq = WSP(float, WS_SL) + (size_t)sqh * HG_G * 16384; float* DSq = WSP(float, WS_DSEG) + (size_t)sqh * HG_G * 128;
                  gu32* mask = F.ctl + CW_HS + 64 * (l * 32 + sqh);
                  hg_sequence<1>(F, P, r0, h, nch, 64, nullptr, SLq + (size_t)g * 16384, WSP(bf16, WS_QS), WSP(float, WS_RAW), DSq + g * 128);
                  asm volatile("s_waitcnt vmcnt(0)" ::: "memory"); __syncthreads();
                  if (F.tid == 0) { __builtin_amdgcn_fence(__ATOMIC_RELEASE, "agent"); asm volatile("s_waitcnt vmcnt(0)" ::: "memory"); (void)__hip_atomic_fetch_or(mask, 1u << g, RLX_AGENT); }
                  ENTER();
                  hg_fix(F, P, r0, h, nch, g, HG_G, SLq, DSq, WSP(const bf16, WS_QS), WSP(const float, WS_RAW), mask, OUTP(0) + OS_P + ((size_t)((l * 4 + b) * 8 + h)) * 16384);
                  ENTER();
#endif
            }
            if (F.tid == 0) { unsigned sp = 0; while (__hip_atomic_load(tb, RLX_AGENT) < (unsigned)T_EFF * 5u) { __builtin_amdgcn_s_sleep(2); if (++sp > (1u << 22)) { __hip_atomic_store(F.ctl + 1, 0x7ec0u, RLX_AGENT); break; } }
                __builtin_amdgcn_fence(__ATOMIC_ACQUIRE, "agent"); asm volatile("s_waitcnt vmcnt(0)" ::: "memory"); }
            __syncthreads(); ENTER();
          }
          if (team || hfirst) {
            gu32* qs = qbase + 64 * 11; gu32* done = qbase + 64 * 12;
            for (;;) { const int it = wg_pull(F, qs); if (it >= 256) break;
              const HgPtrs P{WSP(const float, WS_LOGF), WSP(const bf16, WS_QQ), WSP(const bf16, WS_KK), WSP(const bf16, WS_VV), WSP(const bf16, WS_HGS), karg(A_GHG) + l * 128, WSP(bf16, WS_OH), WSP(bf16, WS_DD)};
              if (it < 128) {
#ifndef NO_H
                  const int sq = it >> 3, h = it & 7; const size_t so = OS_S + ((size_t)((l * 16 + sq) * 8 + h)) * 16384;
                  hg_sequence<0>(F, P, (size_t)MP + (size_t)sq * 32, h, 1, 32, karg(A_ST) + ((size_t)((l * 16 + sq) * 8 + h)) * 16384, OUTP(0) + so, nullptr, nullptr, nullptr);
#endif
              } else {
#ifndef NO_SAMP
                  const int u = it - 128; const float lam = lam_of(karg(A_LAM), l, F.lane), osc = 1.f - lam_init_of(l);
                  attn_sample_unit(F, karg(A_CK), karg(A_CV), l, u >> 3, u & 7, WSP(const bf16, WS_Q), WSP(const bf16, WS_K), WSP(const bf16, WS_V), lam, osc, karg(A_GSUB) + l * 128, WSP(bf16, WS_OATT));
#endif
              }
              asm volatile("s_waitcnt vmcnt(0)" ::: "memory"); __syncthreads();
              if (F.tid == 0) { __builtin_amdgcn_fence(__ATOMIC_RELEASE, "agent"); asm volatile("s_waitcnt vmcnt(0)" ::: "memory"); (void)__hip_atomic_fetch_add(done, 1u, RLX_AGENT); }
              ENTER(); }
            if (team) {
                if (F.tid == 0) { unsigned sp = 0; while (__hip_atomic_load(done, RLX_AGENT) < 256u) { __builtin_amdgcn_s_sleep(2); if (++sp > (1u << 22)) { __hip_atomic_store(F.ctl + 1, 0x7ed0u, RLX_AGENT); break; } }
                    __builtin_amdgcn_fence(__ATOMIC_ACQUIRE, "agent"); asm volatile("s_waitcnt vmcnt(0)" ::: "memory"); }
                __syncthreads(); ENTER(); } }
#ifndef NO_TEAM
          if (team) {
              { pg8::Gemm g{WSP(bf16, WS_OATT), WSP(const bf16, wlo + WO_BA), MROWS, DM, DM}; typedef pg8::TeamOrder<4> Ord; Ord S; S.init(T_EFF, ticket);
                pg8::EpiGateT E{WSP(bf16, WS_LOGF), WSP(const bf16, WS_SZA)};
                pg8::gemm_phase<pg8::EpiGateT, Ord, true, true>(F.lds + RING_OFF, g, S, E); }
              TEAM_BAR();
              { pg8::Gemm g{WSP(bf16, WS_OH), WSP(const bf16, wlo + WO_BH), MROWS, DM, DM}; typedef pg8::TeamOrder<4> Ord; Ord S; S.init(T_EFF, ticket);
                pg8::EpiGateM E{WSP(const bf16, WS_LOGF), WSP(const bf16, WS_SZH), WSP(bf16, WS_MRG)};
                pg8::gemm_phase<pg8::EpiGateM, Ord, true, true>(F.lds + RING_OFF, g, S, E); }
              TEAM_BAR();
              { pg8::Gemm g{WSP(bf16, WS_MRG), WSP(const bf16, wlo + WO_OUT), MROWS, DM, DM}; typedef pg8::TeamOrder<4> Ord; Ord S; S.init(T_EFF, ticket);
                pg8::EpiResid E{WSP(float, WS_X), WSP(const float, modo) + 5 * 1024, 1.0f, 0};
                pg8::gemm_phase<pg8::EpiResid, Ord, true, true>(F.lds + RING_OFF, g, S, E); }
              TEAM_BAR();
              norm_phase(F, WSP(const float, WS_X), karg(A_GFFN2) + l * 1024, WSP(const float, modo), 2, WSP(bf16, WS_XN), MP, MROWS, ticket * NWAVES + F.wave, T_EFF * NWAVES);
              TEAM_BAR();
              { pg8::Gemm g{WSP(bf16, WS_XN), WSP(const bf16, wlo + WO_GU2), MROWS, 2 * DFF, DM}; typedef pg8::TeamOrder<22> Ord; Ord S; S.init(T_EFF, ticket);
                pg8::EpiSwiglu E{WSP(bf16, WS_BIG)};
                pg8::gemm_phase<pg8::EpiSwiglu, Ord, true, true>(F.lds + RING_OFF, g, S, E); }
              TEAM_BAR();
              { pg8::Gemm g{WSP(bf16, WS_BIG), WSP(const bf16, wlo + WO_D2), MROWS, DM, DFF}; typedef pg8::TeamOrder<4> Ord; Ord S; S.init(T_EFF, ticket);
                pg8::EpiResid E{WSP(float, WS_X), WSP(const float, modo) + 8 * 1024, 0.5f, 0};
                pg8::gemm_phase<pg8::EpiResid, Ord, true, true>(F.lds + RING_OFF, g, S, E); }
              ENTER();
          }
#endif
#ifndef NO_ATT
          { const attn_body::bf16* Qb = WSP(const attn_body::bf16, WS_Q); const attn_body::bf16* Kb = WSP(const attn_body::bf16, WS_K); const attn_body::bf16* Vb = WSP(const attn_body::bf16, WS_V); attn_body::bf16* O1 = WSP(attn_body::bf16, WS_O1);
            const int x0 = (int)(xb_xcc_id() & 7u);
            for (;;) { const int pk = attn_pull(F, qbase + 64, x0, 256); if (pk < 0) break;
                const int head = pk >> 16, it = pk & 0xffff, b = it >> 6, r = it & 63, qb = 31 - (r >> 1), mp = r & 1;
                attn_body::attn_unit128<8>(b, head * 2 + mp, head * 2, qb, Qb, Kb, Vb, O1 + (size_t)mp * ((WS_O2 - WS_O1) / 2), (char*)lds + RING_OFF); } }
#endif
#undef TEAM_BAR
#ifdef PROBE_ROLE
          if (tk == PROBE_ROLE) { const unsigned long long t1 = __builtin_amdgcn_s_memrealtime(), d = t1 - pr0; while (__builtin_amdgcn_s_memrealtime() - t1 < d) __builtin_amdgcn_s_sleep(8); }
#endif
        }
        GRID_BAR(); ENTER();
        PT_END(1);
        { const float lam = lam_of(karg(A_LAM), l, F.lane), osc = 1.f - lam_init_of(l);
          attn_combine_phase(F, WSP(const bf16, WS_O1), WSP(const bf16, WS_O2), karg(A_GSUB) + l * 128, lam, osc, WSP(bf16, WS_OATT));
#ifdef DUP_THIN
          GRID_BAR(); ENTER();
          attn_combine_phase(F, WSP(const bf16, WS_O1), WSP(const bf16, WS_O2), karg(A_GSUB) + l * 128, lam, osc, WSP(bf16, WS_OATT));
#endif
        }
        GRID_BAR(); ENTER();
#ifndef NO_G4
        { pg8::Gemm g{WSP(bf16, WS_OATT), WSP(const bf16, wlo + WO_BA), MP, DM, DM}; typedef pg8::FixedOrder<128, 4, 8> Ord; Ord S; S.init(F.G, opaque_bid());
          pg8::EpiGateT E{WSP(bf16, WS_LOGF), WSP(const bf16, WS_SZA)};
          pg8::gemm_phase<pg8::EpiGateT, Ord, true, true>(F.lds + RING_OFF, g, S, E);
#ifdef DUP_THIN
          GRID_BAR(); ENTER(); pg8::gemm_phase<pg8::EpiGateT, Ord, true, true>(F.lds + RING_OFF, g, S, E);
#endif
        }
#endif
        GRID_BAR(); ENTER();
#ifndef NO_G5
        { pg8::Gemm g{WSP(bf16, WS_OH), WSP(const bf16, wlo + WO_BH), MP, DM, DM}; typedef pg8::FixedOrder<128, 4, 8> Ord; Ord S; S.init(F.G, opaque_bid());
          pg8::EpiGateM E{WSP(const bf16, WS_LOGF), WSP(const bf16, WS_SZH), WSP(bf16, WS_MRG)};
          pg8::gemm_phase<pg8::EpiGateM, Ord, true, true>(F.lds + RING_OFF, g, S, E);
#ifdef DUP_THIN
          GRID_BAR(); ENTER(); pg8::gemm_phase<pg8::EpiGateM, Ord, true, true>(F.lds + RING_OFF, g, S, E);
#endif
        }
#endif
        GRID_BAR(); ENTER();
#ifndef NO_G6
        { pg8::Gemm g{WSP(bf16, WS_MRG), WSP(const bf16, wlo + WO_OUT), MP, DM, DM}; typedef pg8::FixedOrder<128, 4, 8> Ord; Ord S; S.init(F.G, opaque_bid());
          pg8::EpiResid E{WSP(float, WS_X), WSP(const float, modo) + 5 * 1024, 1.0f, 0};
          pg8::gemm_phase<pg8::EpiResid, Ord, true, true>(F.lds + RING_OFF, g, S, E);
#ifdef DUP_RES
          GRID_BAR(); ENTER(); { pg8::EpiResid E0{E.X, E.gate, 0.f, 0}; pg8::gemm_phase<pg8::EpiResid, Ord, true, true>(F.lds + RING_OFF, g, S, E0); }
#endif
        }
#endif
        GRID_BAR(); ENTER();
        norm_phase(F, WSP(const float, WS_X), karg(A_GFFN2) + l * 1024, WSP(const float, modo), 2, WSP(bf16, WS_XN), 0, MP, F.vcu * NWAVES + F.wave, 256 * NWAVES);
#ifdef DUP_THIN
        GRID_BAR(); ENTER();
        norm_phase(F, WSP(const float, WS_X), karg(A_GFFN2) + l * 1024, WSP(const float, modo), 2, WSP(bf16, WS_XN), 0, MP, F.vcu * NWAVES + F.wave, 256 * NWAVES);
#endif
        GRID_BAR(); ENTER();
#ifndef NO_G7
        { pg8::Gemm g{WSP(bf16, WS_XN), WSP(const bf16, wlo + WO_GU2), MP, 2 * DFF, DM}; typedef pg8::FixedOrder<128, 22, 8> Ord; Ord S; S.init(F.G, opaque_bid());
          pg8::EpiSwiglu E{WSP(bf16, WS_BIG)};
          pg8::gemm_phase<pg8::EpiSwiglu, Ord, true, true>(F.lds + RING_OFF, g, S, E); }
#endif
        GRID_BAR(); ENTER();
#ifndef NO_G8
        { pg8::Gemm g{WSP(bf16, WS_BIG), WSP(const bf16, wlo + WO_D2), MP, DM, DFF}; typedef pg8::FixedOrder<128, 4, 8> Ord; Ord S; S.init(F.G, opaque_bid());
          pg8::EpiResid E{WSP(float, WS_X), WSP(const float, modo) + 8 * 1024, 0.5f, 0};
          pg8::gemm_phase<pg8::EpiResid, Ord, true, true>(F.lds + RING_OFF, g, S, E);
#ifdef DUP_RES
          GRID_BAR(); ENTER(); { pg8::EpiResid E0{E.X, E.gate, 0.f, 0}; pg8::gemm_phase<pg8::EpiResid, Ord, true, true>(F.lds + RING_OFF, g, S, E0); }
#endif
        }
#endif
        GRID_BAR(); ENTER();
    }
    final_norm_phase(F, WSP(const float, WS_X), karg(A_GFIN), OUTP(0));
#undef GRID_BAR
#undef ENTER
#undef WSP
#undef OUTP
}

extern "C" void kernel_launch(void* const* d_in, const int* in_sizes, int n_in, void* d_out, int out_size, void* d_ws, size_t ws_size, hipStream_t stream) {
    static int grid = 0;
    if (grid == 0) {
        if (n_in != 25 || (size_t)out_size != OUT_TOTAL || ws_size < WS_END) { fprintf(stderr, "kernel_launch: unexpected sizes: n_in %d out %d ws %zu (need %zu)\n", n_in, out_size, ws_size, (size_t)WS_END); grid = -1; return; }
        int dev = 0, cus = 0, per_cu = 0;
        if (hipGetDevice(&dev) != hipSuccess || hipDeviceGetAttribute(&cus, hipDeviceAttributeMultiprocessorCount, dev) != hipSuccess) { grid = -1; return; }
        if (hipFuncSetAttribute((const void*)mk_fwd, hipFuncAttributeMaxDynamicSharedMemorySize, LDS_BYTES) != hipSuccess) { fprintf(stderr, "kernel_launch: hipFuncSetAttribute failed\n"); grid = -1; return; }
        if (hipOccupancyMaxActiveBlocksPerMultiprocessor(&per_cu, (const void*)mk_fwd, NWAVES * 64, LDS_BYTES) != hipSuccess || per_cu < 1) { fprintf(stderr, "kernel_launch: occupancy query reports %d\n", per_cu); }
        (void)hipGetLastError();
        grid = cus;
        if (grid != 256) { fprintf(stderr, "kernel_launch: built for a 256-CU device (team size, row split and work queues assume 256 workgroups); found %d CUs; nothing launched\n", cus); grid = -1; return; }
    }
    if (grid < 0) return;
    if (hipMemsetAsync((char*)d_ws + WS_CTL, 0, CTL_ZERO_BYTES, stream) != hipSuccess) return;
    Args a{};
    for (int i = 0; i < 25; ++i) a.in[i] = (const float*)d_in[i];
    a.out = (float*)d_out; a.ws = (unsigned char*)d_ws;
    hipLaunchKernelGGL(mk_fwd, dim3(grid), dim3(NWAVES * 64), LDS_BYTES, stream, a);
    (void)in_sizes;
}
```

```cpp
#include <hip/hip_runtime.h>
#include <hip/hip_bf16.h>
#include <cstdio>
#include <cstdint>
#include <cmath>
constexpr unsigned WTAB_LDS_ADDR = 139264u + 320u + 256u;
__device__ __forceinline__ unsigned hw_wave_slot() { return (unsigned)__builtin_amdgcn_s_getreg((6 << 11) | 4) & 0x3fu; }
__device__ __forceinline__ void tid_table_init() { ((volatile __attribute__((address_space(3))) unsigned*)(size_t)WTAB_LDS_ADDR)[hw_wave_slot()] = threadIdx.x >> 6; }
__device__ __forceinline__ int opaque_tid() { const unsigned w = ((volatile __attribute__((address_space(3))) unsigned*)(size_t)WTAB_LDS_ADDR)[hw_wave_slot()];
    unsigned ln; asm volatile("v_mbcnt_lo_u32_b32 %0, -1, 0\n\tv_mbcnt_hi_u32_b32 %0, -1, %0" : "=v"(ln));
    return (int)((w << 6) | ln); }
__device__ __forceinline__ int opaque_bid() { int b = (int)blockIdx.x; asm volatile("" : "+s"(b)); return b; }
namespace pg8 {
#define PG8_LAS __attribute__((address_space(3)))
typedef unsigned short bf16_t;
typedef short bf16x8 __attribute__((ext_vector_type(8)));
typedef float f32x4 __attribute__((ext_vector_type(4)));
typedef unsigned u32x4 __attribute__((ext_vector_type(4)));
constexpr int BM = 256, BK = 64, HALF = 128, HTB = HALF * BK * 2  , STAGE_BYTES = 8 * HTB, NXCD = 8, WGM = 8;

__host__ __device__ __forceinline__ int lds_byte(int r, int c) { const int st = (r >> 4) * 2 + (c >> 5), rr = r & 15, cc = c & 31, ob = rr * 64 + cc * 2; return st * 1024 + (ob ^ (((ob >> 9) & 1) << 5)); }
__host__ __device__ __forceinline__ void stage_rc(int b, int& R, int& C) { const int st = b / 1024, sb = b % 1024, swz = sb ^ (((sb >> 9) & 1) << 5); R = (st >> 1) * 16 + swz / 64; C = (st & 1) * 32 + (swz % 64) / 2; }
__host__ __device__ __forceinline__ int perm32(int rho) { const int n = rho >> 4, i = rho & 15; return 8 * (i >> 2) + 4 * n + (i & 3); }

struct Unit { int pm, pn; };
struct Gemm { const bf16_t* A; const bf16_t* Bt; int M, N, K; };

struct StaticOrder {
    int nM, nN, nwg, G, c;
    __host__ __device__ void init(int M, int N, int G_, int c_) { nM = M / BM; nN = N / BM; nwg = nM * nN; G = G_; c = c_; }
    __host__ __device__ bool next(int i, Unit& u) const {
        const long L = (long)i * G + c; if (L >= nwg) return false;
        int wgid = (int)L; { const int q = nwg / NXCD, r = nwg % NXCD, xcd = wgid % NXCD, off = wgid / NXCD; wgid = (xcd < r ? xcd * (q + 1) : r * (q + 1) + (xcd - r) * q) + off; }
        const int nig = WGM * nN, gid = wgid / nig, fm = gid * WGM, gsz = (nM - fm) < WGM ? (nM - fm) : WGM;
        u.pm = fm + ((wgid % nig) % gsz); u.pn = (wgid % nig) / gsz; return true;
    }
    __device__ __forceinline__ void a_ready(const Unit&) const {}
    __device__ __forceinline__ void done(const Unit&) const {}
};

__device__ __forceinline__ unsigned cvt_pk_bf16(float lo, float hi) { unsigned r; asm volatile("v_cvt_pk_bf16_f32 %0, %1, %2" : "=v"(r) : "v"(lo), "v"(hi)); return r; }
__device__ __forceinline__ float bf_lo(unsigned w) { return __builtin_bit_cast(float, w << 16); }
__device__ __forceinline__ float bf_hi(unsigned w) { return __builtin_bit_cast(float, w & 0xffff0000u); }
__device__ __forceinline__ float sigmoid_f(float x) { return __builtin_amdgcn_rcpf(1.f + __expf(-x)); }
__device__ __forceinline__ float silu_f(float x) { return x * sigmoid_f(x); }
__device__ __forceinline__ void store8bf(bf16_t* p, f32x4 a, f32x4 b) { u32x4 w; w.x = cvt_pk_bf16(a[0], a[1]); w.y = cvt_pk_bf16(a[2], a[3]); w.z = cvt_pk_bf16(b[0], b[1]); w.w = cvt_pk_bf16(b[2], b[3]); *(u32x4*)p = w; }
__device__ __forceinline__ int row_seq(int row) { return row < 32768 ? (row >> 13) : 4 + ((row - 32768) >> 5); }

struct EpiSwiglu {
    static constexpr bool PERM = true, AFTER_DRAIN = false;
    bf16_t* O;
    __device__ __forceinline__ void operator()(const f32x4 (&acc)[2][2][4][2], const Unit& u, int wr, int wc, int fr, int fq) const {
        const int row0 = u.pm * BM + wr * 64 + fr, col0 = u.pn * HALF + wc * 32 + 8 * fq;
#pragma unroll
        for (int ai = 0; ai < 2; ++ai)
#pragma unroll
            for (int m = 0; m < 4; ++m) {
                f32x4 g0 = acc[ai][0][m][0], g1 = acc[ai][0][m][1]; const f32x4 u0 = acc[ai][1][m][0], u1 = acc[ai][1][m][1];
#pragma unroll
                for (int i = 0; i < 4; ++i) { g0[i] = silu_f(g0[i]) * u0[i]; g1[i] = silu_f(g1[i]) * u1[i]; }
                store8bf(O + (size_t)(row0 + ai * HALF + m * 16) * 2816 + col0, g0, g1); asm volatile("" ::: "memory");
            }
    }
};

struct EpiResid {
    static constexpr bool PERM = true, AFTER_DRAIN = false;
    bf16_t* X; const float* gate; float coef; int xsel;
    __device__ __forceinline__ static u32x4 ldx(const bf16_t* xb, const float* xf, size_t off) {
        if (xf) { const f32x4 a = *(const f32x4*)(xf + off), b = *(const f32x4*)(xf + off + 4); u32x4 w; w.x = cvt_pk_bf16(a[0], a[1]); w.y = cvt_pk_bf16(a[2], a[3]); w.z = cvt_pk_bf16(b[0], b[1]); w.w = cvt_pk_bf16(b[2], b[3]); return w; }
        return *(const u32x4*)(xb + off); }
    __device__ __forceinline__ void operator()(const f32x4 (&acc)[2][2][4][2], const Unit& u, int wr, int wc, int fr, int fq) const {
        const float* Xf = nullptr;
        if (xsel) { const __attribute__((address_space(4))) char* ka = (const __attribute__((address_space(4))) char*)__builtin_amdgcn_kernarg_segment_ptr(); asm volatile("" : "+s"(ka));
            Xf = (xsel == 1) ? *(const float* const __attribute__((address_space(4)))*)(ka) : *(const float* const __attribute__((address_space(4)))*)(ka + 8) - (size_t)32768 * 1024; }
        if (u.pm < 128) {
            const float* gp = gate + (size_t)(u.pm >> 5) * 9216 + u.pn * BM + wc * 32 + 8 * fq;
            f32x4 gv[2][2];
#pragma unroll
            for (int bj = 0; bj < 2; ++bj)
#pragma unroll
                for (int n = 0; n < 2; ++n) gv[bj][n] = *(const f32x4*)(gp + bj * HALF + 4 * n) * coef;
            const size_t base = (size_t)(u.pm * BM + wr * 64 + fr) * 1024 + u.pn * BM + wc * 32 + 8 * fq;
            u32x4 xc[2], xn[2];
#pragma unroll
            for (int bj = 0; bj < 2; ++bj) xc[bj] = ldx(X, Xf, base + bj * HALF);
#pragma unroll
            for (int g = 0; g < 8; ++g) { const int ai = g >> 2, m = g & 3; const size_t off = base + (size_t)(ai * HALF + m * 16) * 1024;
                if (g + 1 < 8) { const size_t offn = base + (size_t)(((g + 1) >> 2) * HALF + ((g + 1) & 3) * 16) * 1024;
#pragma unroll
                    for (int bj = 0; bj < 2; ++bj) xn[bj] = ldx(X, Xf, offn + bj * HALF); }
#pragma unroll
                for (int bj = 0; bj < 2; ++bj) { const u32x4 t = xc[bj]; const f32x4 x0 = {bf_lo(t.x), bf_hi(t.x), bf_lo(t.y), bf_hi(t.y)}, x1 = {bf_lo(t.z), bf_hi(t.z), bf_lo(t.w), bf_hi(t.w)};
                    store8bf(X + off + bj * HALF, x0 + gv[bj][0] * acc[ai][bj][m][0], x1 + gv[bj][1] * acc[ai][bj][m][1]); }
                asm volatile("" ::: "memory");
#pragma unroll
                for (int bj = 0; bj < 2; ++bj) xc[bj] = xn[bj]; }
        } else {
#pragma unroll
        for (int ai = 0; ai < 2; ++ai)
#pragma unroll
            for (int m = 0; m < 4; ++m) {
                const int row = u.pm * BM + ai * HALF + wr * 64 + m * 16 + fr; const float* gp = gate + (size_t)row_seq(row) * 9216;
#pragma unroll
                for (int bj = 0; bj < 2; ++bj) { const int col = u.pn * BM + bj * HALF + wc * 32 + 8 * fq; const size_t off = (size_t)row * 1024 + col;
                    const f32x4 g0 = *(const f32x4*)(gp + col) * coef, g1 = *(const f32x4*)(gp + col + 4) * coef; const u32x4 t = ldx(X, Xf, off);
                    const f32x4 x0 = {bf_lo(t.x), bf_hi(t.x), bf_lo(t.y), bf_hi(t.y)}, x1 = {bf_lo(t.z), bf_hi(t.z), bf_lo(t.w), bf_hi(t.w)};
                    store8bf(X + off, x0 + g0 * acc[ai][bj][m][0], x1 + g1 * acc[ai][bj][m][1]); asm volatile("" ::: "memory"); }
            }
        }
    }
};

struct EpiWin {
    static constexpr bool PERM = true, AFTER_DRAIN = false;
    unsigned char* ws; float* out; int l; float qscale;
    static constexpr size_t MiB_ = 1u << 20;
    static constexpr size_t O_Q = 435 * MiB_, O_K = 500 * MiB_, O_V = 565 * MiB_, O_QQ = 630 * MiB_, O_KK = 695 * MiB_, O_VV = 760 * MiB_, O_HGS = 825 * MiB_, O_SZA = 890 * MiB_, O_SZH = 955 * MiB_, O_LOGF = 1020 * MiB_, O_LB = 4 * MiB_;
    static constexpr size_t OK_P_ = 34078720, OV_P_ = 168296448, OK_S_ = 304611328, OV_S_ = 306708480;
    __device__ __forceinline__ void operator()(const f32x4 (&acc)[2][2][4][2], const Unit& u, int wr, int wc, int fr, int fq) const {
        const int seg = u.pn >> 2, cb = (u.pn & 3) * BM + wc * 32 + 8 * fq, row0 = u.pm * BM + wr * 64 + fr;
        const size_t boff = seg == 0 ? O_Q : seg == 1 ? O_K : seg == 2 ? O_V : seg == 3 ? O_QQ : seg == 4 ? O_KK : seg == 5 ? O_VV : seg == 6 ? O_HGS : seg == 7 ? O_SZA : O_SZH;
        bf16_t* const O = (bf16_t*)(ws + boff) + (size_t)row0 * 1024 + cb;
        float* F32 = nullptr;
        if (seg == 1 || seg == 2) { const size_t ob = (u.pm < 128) ? (seg == 1 ? OK_P_ : OV_P_) + (size_t)l * 32768 * 1024 + (size_t)(u.pm * BM) * 1024 : (seg == 1 ? OK_S_ : OV_S_) + (size_t)l * 512 * 1024 + (size_t)((u.pm - 128) * BM) * 1024;
            F32 = out + ob + (size_t)(wr * 64 + fr) * 1024 + cb; }
        const float* const lb = (const float*)(ws + O_LB) + l * 1024 + cb;
        const float sc = seg == 0 ? qscale : 1.f;
        f32x4 lbv[2][2]; { const f32x4 z = {0.f, 0.f, 0.f, 0.f}; lbv[0][0] = z; lbv[0][1] = z; lbv[1][0] = z; lbv[1][1] = z; }
        if (seg == 4) { lbv[0][0] = *(const f32x4*)(lb); lbv[0][1] = *(const f32x4*)(lb + 4); lbv[1][0] = *(const f32x4*)(lb + HALF); lbv[1][1] = *(const f32x4*)(lb + HALF + 4); }
#pragma unroll
        for (int ai = 0; ai < 2; ++ai) {
#pragma unroll
            for (int m = 0; m < 4; ++m)
#pragma unroll
                for (int bj = 0; bj < 2; ++bj) { const size_t off = (size_t)(ai * HALF + m * 16) * 1024 + bj * HALF; const f32x4 l0 = lbv[bj][0], l1 = lbv[bj][1];
                    f32x4 a = acc[ai][bj][m][0], b = acc[ai][bj][m][1];
                    if (seg == 4) {
#pragma unroll
                        for (int i = 0; i < 4; ++i) {
                            { const float x = a[i], lbv = l0[i], e = __expf(-__builtin_fabsf(x)), r = __builtin_amdgcn_rcpf(1.f + e), er = e * r, om = x >= 0.f ? er : r; a[i] = (1.f - lbv) * om; }
                            { const float x = b[i], lbv = l1[i], e = __expf(-__builtin_fabsf(x)), r = __builtin_amdgcn_rcpf(1.f + e), er = e * r, om = x >= 0.f ? er : r; b[i] = (1.f - lbv) * om; } }
                    } else if (seg == 3 || seg == 6) {
#pragma unroll
                        for (int i = 0; i < 4; ++i) { a[i] = silu_f(a[i]); b[i] = silu_f(b[i]); }
                    } else if (seg >= 7) {
#pragma unroll
                        for (int i = 0; i < 4; ++i) { a[i] = sigmoid_f(a[i]); b[i] = sigmoid_f(b[i]); }
                    } else {
                        if (seg == 1 || seg == 2) { *(f32x4*)(F32 + off) = a; *(f32x4*)(F32 + off + 4) = b; }
                        a = a * sc; b = b * sc;
                    }
                    store8bf(O + off, a, b); asm volatile("" ::: "memory"); }
        }
    }
};

struct EpiGateT {
    static constexpr bool PERM = true, AFTER_DRAIN = false;
    bf16_t* T; const bf16_t* G;
    __device__ __forceinline__ void operator()(const f32x4 (&acc)[2][2][4][2], const Unit& u, int wr, int wc, int fr, int fq) const {
        const size_t base = (size_t)(u.pm * BM + wr * 64 + fr) * 1024 + u.pn * BM + wc * 32 + 8 * fq;
        u32x4 gc[2], gn[2];
#pragma unroll
        for (int bj = 0; bj < 2; ++bj) gc[bj] = *(const u32x4*)(G + base + bj * HALF);
#pragma unroll
        for (int g = 0; g < 8; ++g) { const int ai = g >> 2, m = g & 3; const size_t off = base + (size_t)(ai * HALF + m * 16) * 1024;
            if (g + 1 < 8) { const size_t offn = base + (size_t)(((g + 1) >> 2) * HALF + ((g + 1) & 3) * 16) * 1024;
#pragma unroll
                for (int bj = 0; bj < 2; ++bj) gn[bj] = *(const u32x4*)(G + offn + bj * HALF); }
#pragma unroll
            for (int bj = 0; bj < 2; ++bj) { const u32x4 gg = gc[bj];
                const f32x4 g0 = {bf_lo(gg.x), bf_hi(gg.x), bf_lo(gg.y), bf_hi(gg.y)}, g1 = {bf_lo(gg.z), bf_hi(gg.z), bf_lo(gg.w), bf_hi(gg.w)};
                store8bf(T + off + bj * HALF, g0 * acc[ai][bj][m][0], g1 * acc[ai][bj][m][1]); }
            asm volatile("" ::: "memory");
#pragma unroll
            for (int bj = 0; bj < 2; ++bj) gc[bj] = gn[bj]; }
    }
};
struct EpiGateM {
    static constexpr bool PERM = true, AFTER_DRAIN = false;
    const bf16_t* T; const bf16_t* G; bf16_t* O;
    __device__ __forceinline__ void operator()(const f32x4 (&acc)[2][2][4][2], const Unit& u, int wr, int wc, int fr, int fq) const {
        const size_t base = (size_t)(u.pm * BM + wr * 64 + fr) * 1024 + u.pn * BM + wc * 32 + 8 * fq;
        u32x4 gc[2], gn[2], tc[2], tn[2];
#pragma unroll
        for (int bj = 0; bj < 2; ++bj) { gc[bj] = *(const u32x4*)(G + base + bj * HALF); tc[bj] = *(const u32x4*)(T + base + bj * HALF); }
#pragma unroll
        for (int g = 0; g < 8; ++g) { const int ai = g >> 2, m = g & 3; const size_t off = base + (size_t)(ai * HALF + m * 16) * 1024;
            if (g + 1 < 8) { const size_t offn = base + (size_t)(((g + 1) >> 2) * HALF + ((g + 1) & 3) * 16) * 1024;
#pragma unroll
                for (int bj = 0; bj < 2; ++bj) { gn[bj] = *(const u32x4*)(G + offn + bj * HALF); tn[bj] = *(const u32x4*)(T + offn + bj * HALF); } }
#pragma unroll
            for (int bj = 0; bj < 2; ++bj) { const u32x4 gg = gc[bj];
                const f32x4 g0 = {bf_lo(gg.x), bf_hi(gg.x), bf_lo(gg.y), bf_hi(gg.y)}, g1 = {bf_lo(gg.z), bf_hi(gg.z), bf_lo(gg.w), bf_hi(gg.w)};
                const u32x4 tt = tc[bj]; const f32x4 t0 = {bf_lo(tt.x), bf_hi(tt.x), bf_lo(tt.y), bf_hi(tt.y)}, t1 = {bf_lo(tt.z), bf_hi(tt.z), bf_lo(tt.w), bf_hi(tt.w)};
                store8bf(O + off + bj * HALF, t0 + g0 * acc[ai][bj][m][0], t1 + g1 * acc[ai][bj][m][1]); }
            asm volatile("" ::: "memory");
#pragma unroll
            for (int bj = 0; bj < 2; ++bj) { gc[bj] = gn[bj]; tc[bj] = tn[bj]; } }
    }
};

struct EpiNull {
    static constexpr bool PERM = true, AFTER_DRAIN = false; float* sink;
    __device__ __forceinline__ void operator()(const f32x4 (&acc)[2][2][4][2], const Unit& u, int wr, int wc, int fr, int fq) const { f32x4 s = {0.f, 0.f, 0.f, 0.f};
#pragma unroll
        for (int a = 0; a < 2; ++a)
#pragma unroll
            for (int b = 0; b < 2; ++b)
#pragma unroll
                for (int m = 0; m < 4; ++m)
#pragma unroll
                    for (int n = 0; n < 2; ++n) s = s + acc[a][b][m][n];
        if (sink) sink[0] = s[0] + s[1] + s[2] + s[3]; (void)u; (void)wr; (void)wc; (void)fr; (void)fq; }
};

template <int NM, int NN, int GM> struct FixedOrder {
    static_assert(NM % GM == 0, "GM divides NM");
    int G, c;
    __device__ __forceinline__ void init(int G_, int c_) { G = G_; c = c_; }
    __device__ __forceinline__ bool next(int i, Unit& u) const {
        constexpr int nwg = NM * NN, q = nwg / NXCD, r = nwg % NXCD, nig = GM * NN;
        const int L = i * G + c; if (L >= nwg) return false;
        const int xcd = L % NXCD, off = L / NXCD; const int wgid = (xcd < r ? xcd * (q + 1) : r * (q + 1) + (xcd - r) * q) + off;
        const int gid = wgid / nig, w = wgid % nig; u.pm = gid * GM + (w % GM); u.pn = w / GM; return true;
    }
    __device__ __forceinline__ void a_ready(const Unit&) const {}
    __device__ __forceinline__ void done(const Unit&) const {}
};

template <int NN> struct TeamOrder {
    int T, r;
    __device__ __forceinline__ void init(int T_, int r_) { T = T_; r = r_; }
    __device__ __forceinline__ bool next(int i, Unit& u) const { const int L = i * T + r; if (L >= 2 * NN) return false; u.pm = 128 + L / NN; u.pn = L % NN; return true; }
    __device__ __forceinline__ void a_ready(const Unit&) const {}
    __device__ __forceinline__ void done(const Unit&) const {}
};
template <class Epi, class Sched, bool ALIGN_EPI = false, bool SP2 = false>
__device__ __forceinline__ void gemm_phase(PG8_LAS unsigned char* lds, const Gemm g, const Sched& S, const Epi& E) {
    const int tid = opaque_tid(), wid = __builtin_amdgcn_readfirstlane(tid >> 6), lane = tid & 63, wr = wid >> 2, wc = wid & 3, fr = lane & 15, fq = lane >> 4;
    const int K = g.K, nt = K / BK;
    unsigned voffA[2], voffB[2];
#pragma unroll
    for (int i = 0; i < 2; ++i) { int R, C; stage_rc(tid * 16 + i * 8192, R, C); const int Rb = Epi::PERM ? ((R & ~31) + perm32(R & 31)) : R;
        voffA[i] = (unsigned)(R * K + C) * 2u; voffB[i] = (unsigned)(Rb * K + C) * 2u; }
    const size_t kstep = (size_t)(BK * 2);
    const size_t hstep = (size_t)HALF * K * 2;
    const size_t tstep = 2 * hstep;
    const unsigned ldsw = (unsigned)wid * 1024u;
    const int aoff = lds_byte(wr * 64 + fr, fq * 8), boff = lds_byte(wc * 32 + fr, fq * 8);
#define PG8_SA(b, h) (((b) * 2 + (h)) * HTB)
#define PG8_SB(b, h) ((4 + (b) * 2 + (h)) * HTB)
#define PG8_STAGE(bufoff, gbase, voff) do { _Pragma("unroll") for (int _i = 0; _i < 2; ++_i) \
        __builtin_amdgcn_global_load_lds((const unsigned*)((const char*)(gbase) + (voff)[_i]), (PG8_LAS unsigned*)(lds + (bufoff) + ldsw + _i * 8192), 16, 0, 0); } while (0)
#define PG8_LDA(dst, b, h) do { _Pragma("unroll") for (int m = 0; m < 4; ++m) _Pragma("unroll") for (int k = 0; k < 2; ++k) dst[m][k] = *(const PG8_LAS bf16x8*)(lds + PG8_SA(b, h) + aoff + m * 2048 + k * 1024); } while (0)
#define PG8_LDB(dst, b, h) do { _Pragma("unroll") for (int n = 0; n < 2; ++n) _Pragma("unroll") for (int k = 0; k < 2; ++k) dst[n][k] = *(const PG8_LAS bf16x8*)(lds + PG8_SB(b, h) + boff + n * 2048 + k * 1024); } while (0)
#define PG8_MMA(ai, bj, At, Bt) do { __builtin_amdgcn_s_setprio(1); _Pragma("unroll") for (int m = 0; m < 4; ++m) _Pragma("unroll") for (int n = 0; n < 2; ++n) _Pragma("unroll") for (int k = 0; k < 2; ++k) \
        acc[ai][bj][m][n] = __builtin_amdgcn_mfma_f32_16x16x32_bf16(Bt[n][k], At[m][k], acc[ai][bj][m][n], 0, 0, 0); __builtin_amdgcn_s_setprio(0); } while (0)
#define PG8_WAIT_V(n) asm volatile("s_waitcnt vmcnt(" #n ")" ::: "memory")
#define PG8_WAIT_L(n) asm volatile("s_waitcnt lgkmcnt(" #n ")" ::: "memory")
#define PG8_BAR __builtin_amdgcn_s_barrier()
#define PG8_SCHED __builtin_amdgcn_sched_barrier(0)
    Unit cur, nxt; int ui = 0;
    if (!S.next(0, cur)) return;
    f32x4 acc[2][2][4][2];
#pragma unroll
    for (int a = 0; a < 2; ++a)
#pragma unroll
        for (int b = 0; b < 2; ++b)
#pragma unroll
            for (int m = 0; m < 4; ++m)
#pragma unroll
                for (int n = 0; n < 2; ++n) acc[a][b][m][n] = (f32x4){0.f, 0.f, 0.f, 0.f};
    bf16x8 At[4][2], B0[2][2], B1[2][2];
    const char* cA = (const char*)g.A + (size_t)cur.pm * tstep; const char* cB = (const char*)g.Bt + (size_t)cur.pn * tstep;
    S.a_ready(cur);
    if constexpr (SP2) {
        PG8_STAGE(PG8_SB(0, 0), cB, voffB); PG8_STAGE(PG8_SB(0, 1), cB + hstep, voffB); PG8_STAGE(PG8_SA(0, 0), cA, voffA); PG8_STAGE(PG8_SA(0, 1), cA + hstep, voffA);
        if (wr == 1) PG8_BAR;
        PG8_WAIT_V(2); PG8_BAR;
        PG8_STAGE(PG8_SB(1, 0), cB + kstep, voffB); PG8_STAGE(PG8_SA(1, 0), cA + kstep, voffA); PG8_STAGE(PG8_SB(1, 1), cB + hstep + kstep, voffB);
        PG8_WAIT_V(6); PG8_BAR;
    } else {
        PG8_STAGE(PG8_SB(0, 0), cB, voffB); PG8_STAGE(PG8_SA(0, 0), cA, voffA); PG8_STAGE(PG8_SB(0, 1), cB + hstep, voffB); PG8_STAGE(PG8_SA(0, 1), cA + hstep, voffA);
        if (wr == 1) PG8_BAR;
        PG8_WAIT_V(4); PG8_BAR;
        PG8_STAGE(PG8_SB(1, 0), cB + kstep, voffB); PG8_STAGE(PG8_SA(1, 0), cA + kstep, voffA); PG8_STAGE(PG8_SB(1, 1), cB + hstep + kstep, voffB);
        PG8_WAIT_V(6); PG8_BAR;
    }
    for (;;) {
        const bool has_next = S.next(ui + 1, nxt);
        const char* nA = has_next ? (const char*)g.A + (size_t)nxt.pm * tstep : cA; const char* nB = has_next ? (const char*)g.Bt + (size_t)nxt.pn * tstep : cB;
        for (int t = 0; t < nt; t += 2) {
            const bool last = (t == nt - 2);
            const char* a1 = cA + (size_t)(t + 1) * kstep;
            const char* a2 = last ? nA : cA + (size_t)(t + 2) * kstep; const char* b2 = last ? nB : cB + (size_t)(t + 2) * kstep;
            const char* a3 = a2 + kstep; const char* b3 = b2 + kstep;
            if (last && has_next) S.a_ready(nxt);
            if constexpr (SP2) {
            PG8_LDB(B0, 0, 0); PG8_LDB(B1, 0, 1); PG8_SCHED; PG8_LDA(At, 0, 0); PG8_STAGE(PG8_SA(1, 1), a1 + hstep, voffA);
            PG8_WAIT_V(8); PG8_WAIT_L(0); PG8_BAR; PG8_MMA(0, 0, At, B0); PG8_MMA(0, 1, At, B1); PG8_BAR; PG8_SCHED;
            PG8_LDA(At, 0, 1); PG8_STAGE(PG8_SB(0, 0), b2, voffB); PG8_STAGE(PG8_SB(0, 1), b2 + hstep, voffB); PG8_STAGE(PG8_SA(0, 0), a2, voffA);
            PG8_WAIT_V(8); PG8_WAIT_L(0); PG8_BAR; PG8_MMA(1, 0, At, B0); PG8_MMA(1, 1, At, B1); PG8_BAR; PG8_SCHED;
            PG8_LDB(B0, 1, 0); PG8_LDB(B1, 1, 1); PG8_SCHED; PG8_LDA(At, 1, 0); PG8_STAGE(PG8_SA(0, 1), a2 + hstep, voffA);
            PG8_WAIT_V(8); PG8_WAIT_L(0); PG8_BAR; PG8_MMA(0, 0, At, B0); PG8_MMA(0, 1, At, B1); PG8_BAR; PG8_SCHED;
            PG8_LDA(At, 1, 1); PG8_STAGE(PG8_SB(1, 0), b3, voffB); PG8_STAGE(PG8_SB(1, 1), b3 + hstep, voffB); PG8_STAGE(PG8_SA(1, 0), a3, voffA);
            PG8_WAIT_V(8); PG8_WAIT_L(0); PG8_BAR; PG8_MMA(1, 0, At, B0); PG8_MMA(1, 1, At, B1); PG8_BAR; PG8_SCHED;
            } else {
            PG8_LDB(B0, 0, 0); PG8_SCHED; PG8_LDA(At, 0, 0); PG8_STAGE(PG8_SA(1, 1), a1 + hstep, voffA);
            PG8_WAIT_L(8); PG8_BAR; PG8_WAIT_L(0); PG8_MMA(0, 0, At, B0); PG8_BAR; PG8_SCHED;
            PG8_LDB(B1, 0, 1); PG8_STAGE(PG8_SB(0, 0), b2, voffB);
            PG8_BAR; PG8_WAIT_L(0); PG8_MMA(0, 1, At, B1); PG8_BAR;
            PG8_LDA(At, 0, 1); PG8_STAGE(PG8_SA(0, 0), a2, voffA);
            PG8_BAR; PG8_WAIT_L(0); PG8_MMA(1, 0, At, B0); PG8_BAR; PG8_SCHED;
            PG8_STAGE(PG8_SB(0, 1), b2 + hstep, voffB);
            PG8_WAIT_V(6); PG8_BAR; PG8_MMA(1, 1, At, B1); PG8_BAR;
            PG8_LDB(B0, 1, 0); PG8_SCHED; PG8_LDA(At, 1, 0); PG8_STAGE(PG8_SA(0, 1), a2 + hstep, voffA);
            PG8_WAIT_L(8); PG8_BAR; PG8_WAIT_L(0); PG8_MMA(0, 0, At, B0); PG8_BAR; PG8_SCHED;
            PG8_LDB(B1, 1, 1); PG8_STAGE(PG8_SB(1, 0), b3, voffB);
            PG8_BAR; PG8_WAIT_L(0); PG8_MMA(0, 1, At, B1); PG8_BAR;
            PG8_LDA(At, 1, 1); PG8_STAGE(PG8_SA(1, 0), a3, voffA);
            PG8_BAR; PG8_WAIT_L(0); PG8_MMA(1, 0, At, B0); PG8_BAR; PG8_SCHED;
            PG8_STAGE(PG8_SB(1, 1), b3 + hstep, voffB);
            PG8_WAIT_V(6); PG8_BAR; PG8_MMA(1, 1, At, B1); PG8_BAR;
            }
        }
        if constexpr (ALIGN_EPI) { if (wr == 0) PG8_BAR; }
        if constexpr (!Epi::AFTER_DRAIN) { E(acc, cur, wr, wc, fr, fq); S.done(cur); }
        if (!has_next) break;
#pragma unroll
        for (int a = 0; a < 2; ++a)
#pragma unroll
            for (int b = 0; b < 2; ++b)
#pragma unroll
                for (int m = 0; m < 4; ++m)
#pragma unroll
                    for (int n = 0; n < 2; ++n) acc[a][b][m][n] = (f32x4){0.f, 0.f, 0.f, 0.f};
        cur = nxt; cA = nA; cB = nB; ++ui;
        if constexpr (ALIGN_EPI) { if (wr == 1) PG8_BAR; }
    }
    PG8_WAIT_V(0);
    if constexpr (!ALIGN_EPI) { if (wr == 0) PG8_BAR; }
    PG8_BAR;
    if constexpr (Epi::AFTER_DRAIN) { E.fused(acc, cur, wr, wc, fr, fq, lds, wid, lane); S.done(cur); }
#undef PG8_SA
#undef PG8_SB
#undef PG8_STAGE
#undef PG8_LDA
#undef PG8_LDB
#undef PG8_MMA
#undef PG8_WAIT_V
#undef PG8_WAIT_L
#undef PG8_BAR
#undef PG8_SCHED
}
}
namespace attn_body {
using bf16=__hip_bfloat16;
using bf16x8=__attribute__((ext_vector_type(8)))short;
using s16x4=__attribute__((ext_vector_type(4)))short;
using f32x16=__attribute__((ext_vector_type(16)))float;
using u32x4=__attribute__((ext_vector_type(4)))unsigned;
constexpr int BATCH=4,NHEAD=16,SEQ=8192,D=64,DM=NHEAD*D;
constexpr int NW=8,QBLK=32,QB=QBLK*NW,KVBLK=64,NQB=SEQ/QB;
constexpr int ATTN_PITCH=DM, ATTN_UNIT_ROWS=QB;
__device__ __forceinline__ int crow(int r,int hi){return (r&3)+8*(r>>2)+4*hi;}
#define SBAR() __builtin_amdgcn_sched_barrier(0)
__device__ __forceinline__ void cmask(f32x16&p0,f32x16&p1,int jb,int qrel,int hi){
  const float NEG=-INFINITY; (void)hi;
  if(jb>(qrel>>6)){
  #pragma unroll
  for(int r=0;r<16;++r){p0[r]=NEG;p1[r]=NEG;} }
}

constexpr int NSLOT=3, SLOTB=8192;
constexpr int LDS_K=0, LDS_V=NSLOT*SLOTB, LDS_WS=2*NSLOT*SLOTB, LDS_OST=LDS_WS+NW*64*4, LDS_BYTES=LDS_OST+NW*4096;
constexpr float C2=0.125f*1.4426950408889634f;
__device__ __forceinline__ void glds16(const void*gsrc,unsigned lds_dst){unsigned keep;
  asm volatile("s_mov_b32 %0, m0\n\ts_mov_b32 m0, %2\n\ts_nop 0\n\tglobal_load_lds_dwordx4 %1, off\n\ts_mov_b32 m0, %0":"=&s"(keep):"v"(gsrc),"s"(lds_dst):"memory");}
__device__ __forceinline__ float max3f(float a,float b,float c){float r;asm("v_max3_f32 %0, %1, %2, %3":"=v"(r):"v"(a),"v"(b),"v"(c));return r;}
__device__ __forceinline__ float max2f(float a,float b){float r;asm("v_max_f32_e32 %0, %1, %2":"=v"(r):"v"(a),"v"(b));return r;}
__device__ __forceinline__ float fadd_s(float a,float b){float r;asm("v_add_f32_e32 %0, %1, %2":"=v"(r):"v"(a),"v"(b));return r;}
__device__ __forceinline__ float fsub_s(float a,float b){float r;asm("v_sub_f32_e32 %0, %1, %2":"=v"(r):"v"(a),"v"(b));return r;}
typedef float f32x2_t __attribute__((ext_vector_type(2))); typedef __bf16 bf16x2_t __attribute__((ext_vector_type(2)));
__device__ __forceinline__ unsigned cvtpk_s(float lo,float hi){f32x2_t v={lo,hi};bf16x2_t b=__builtin_convertvector(v,bf16x2_t);return __builtin_bit_cast(unsigned,b);}
#define WAIT_BAR(N) asm volatile("s_waitcnt vmcnt(" #N ") lgkmcnt(0)\n\ts_barrier":::"memory")

__device__ __forceinline__ void qkt(f32x16&p0,f32x16&p1,const char*Kslot,const bf16x8*qr,const f32x16&negm,int r32,int hi){
  const char*kb=Kslot+hi*1024+r32*16;
  #pragma unroll
  for(int d0=0;d0<4;++d0){
    const bf16x8 b0=*reinterpret_cast<const bf16x8*>(kb+d0*2048);
    const bf16x8 b1=*reinterpret_cast<const bf16x8*>(kb+d0*2048+512);
    if(d0==0){p0=__builtin_amdgcn_mfma_f32_32x32x16_bf16(b0,qr[0],negm,0,0,0);p1=__builtin_amdgcn_mfma_f32_32x32x16_bf16(b1,qr[0],negm,0,0,0);}
    else{p0=__builtin_amdgcn_mfma_f32_32x32x16_bf16(b0,qr[d0],p0,0,0,0);p1=__builtin_amdgcn_mfma_f32_32x32x16_bf16(b1,qr[d0],p1,0,0,0);}}
}
typedef __attribute__((address_space(3))) const char* lds_cptr;
typedef short v4i16_t __attribute__((ext_vector_type(4)));
__device__ __forceinline__ void kload8(bf16x8*kf,lds_cptr kp){
  kf[0]=*(const __attribute__((address_space(3))) bf16x8*)(kp);      kf[1]=*(const __attribute__((address_space(3))) bf16x8*)(kp+512);
  kf[2]=*(const __attribute__((address_space(3))) bf16x8*)(kp+2048); kf[3]=*(const __attribute__((address_space(3))) bf16x8*)(kp+2560);
  kf[4]=*(const __attribute__((address_space(3))) bf16x8*)(kp+4096); kf[5]=*(const __attribute__((address_space(3))) bf16x8*)(kp+4608);
  kf[6]=*(const __attribute__((address_space(3))) bf16x8*)(kp+6144); kf[7]=*(const __attribute__((address_space(3))) bf16x8*)(kp+6656);
}
__device__ __forceinline__ void kload2(bf16x8*kf,lds_cptr kp,int j){ kf[2*j]=*(const __attribute__((address_space(3))) bf16x8*)(kp+j*2048); kf[2*j+1]=*(const __attribute__((address_space(3))) bf16x8*)(kp+j*2048+512); }
__device__ __forceinline__ s16x4 vtr(lds_cptr p){ return __builtin_bit_cast(s16x4,__builtin_amdgcn_ds_read_tr16_b64_v4i16((__attribute__((address_space(3))) v4i16_t*)p)); }
__device__ __forceinline__ float rowmax(const f32x16&p0,const f32x16&p1){
  float a=max3f(p0[0],p0[1],p1[0]),b=max3f(p0[2],p0[3],p1[1]);a=max3f(a,p1[2],p1[3]);
  #pragma unroll
  for(int r=4;r<16;r+=4){a=max3f(a,p0[r],p0[r+1]);b=max3f(b,p0[r+2],p0[r+3]);a=max3f(a,p1[r],p1[r+1]);b=max3f(b,p1[r+2],p1[r+3]);}
  const float m=max2f(a,b);
  auto rr=__builtin_amdgcn_permlane32_swap(__float_as_uint(m),__float_as_uint(m),false,false);
  return max2f(__uint_as_float(rr[0]),__uint_as_float(rr[1]));
}
__device__ __forceinline__ void pv(f32x16*o,int vb,bf16x8 pa0,bf16x8 pa1,bf16x8 pa2,bf16x8 pa3){
  #pragma unroll
  for(int d0=0;d0<2;++d0){s16x4 lo[4],hi[4];
    #pragma unroll
    for(int ks=0;ks<4;++ks){
      asm volatile("ds_read_b64_tr_b16 %0,%1 offset:%c2":"=&v"(lo[ks]):"v"(vb),"i"(d0*4096+ks*1024):"memory");
      asm volatile("ds_read_b64_tr_b16 %0,%1 offset:%c2":"=&v"(hi[ks]):"v"(vb),"i"(d0*4096+ks*1024+512):"memory");}
    asm volatile("s_waitcnt lgkmcnt(0)":::"memory");SBAR();
    #define PK(k) (bf16x8){lo[k][0],lo[k][1],lo[k][2],lo[k][3],hi[k][0],hi[k][1],hi[k][2],hi[k][3]}
    o[d0]=__builtin_amdgcn_mfma_f32_32x32x16_bf16(pa0,PK(0),o[d0],0,0,0);
    o[d0]=__builtin_amdgcn_mfma_f32_32x32x16_bf16(pa1,PK(1),o[d0],0,0,0);
    o[d0]=__builtin_amdgcn_mfma_f32_32x32x16_bf16(pa2,PK(2),o[d0],0,0,0);
    o[d0]=__builtin_amdgcn_mfma_f32_32x32x16_bf16(pa3,PK(3),o[d0],0,0,0);
    #undef PK
  }
}

#ifndef ATTN_STORE16
#define ATTN_STORE16(p,v) (*(u32x4*)(p)=(v))
#endif
template<int THRL> __device__ __forceinline__ void attn_unit(int b,int hq,int hv,int qb,const bf16*Q,const bf16*__restrict__ K,const bf16*__restrict__ V,bf16*O,char*shm){
  const int tid=opaque_tid(),lane=tid&63,r32=lane&31,hi=lane>>5; const int wid=__builtin_amdgcn_readfirstlane(tid>>6);
  const long rowbase=(long)b*SEQ; const int q0=qb*QB;
  const bf16*Qw=Q+(rowbase+q0+wid*QBLK)*DM+hq*D;
  const bf16*Kh=K+rowbase*DM+hq*D,*Vh=V+rowbase*DM+hv*D;
  const unsigned lds0=(unsigned)(uintptr_t)shm;
  float*wsf=(float*)(shm+LDS_WS)+wid*64;
  const bf16*ksrc=Kh+(long)lane*DM+wid*8;
  const bf16*vsrc=Vh+(long)(16*(wid&3)+(lane>>2))*DM+(wid>>2)*32+(lane&3)*8;
  const unsigned kdst=lds0+LDS_K+wid*1024, vdst=lds0+LDS_V+wid*1024;
  #define DMA_K(t,slot) glds16(ksrc+(long)(t)*KVBLK*DM,(unsigned)__builtin_amdgcn_readfirstlane(kdst+(slot)))
  #define DMA_V(t,slot) glds16(vsrc+(long)(t)*KVBLK*DM,(unsigned)__builtin_amdgcn_readfirstlane(vdst+(slot)))
  const int vb0=(int)(lds0+LDS_V)+((lane>>4)&1)*32+(lane&3)*8+(4*hi+((lane&15)>>2))*64;
  const char*Kbase=shm+LDS_K; bf16x8 kf[8];
  const lds_cptr shm3=(lds_cptr)shm; const lds_cptr kp0=shm3+LDS_K+hi*1024+r32*16; const lds_cptr vp0=shm3+LDS_V+((lane>>4)&1)*32+(lane&3)*8+(4*hi+((lane&15)>>2))*64;
  const int NT=(q0+QB)/KVBLK;
  DMA_K(0,0);DMA_V(0,0);DMA_K(1,SLOTB);
  bf16x8 qr[4];
  #pragma unroll
  for(int d0=0;d0<4;++d0)qr[d0]=*reinterpret_cast<const bf16x8*>(&Qw[(long)r32*DM+d0*16+hi*8]);
  float mhat=0.f,l_reg=0.f;f32x16 o[2];o[0]=f32x16{};o[1]=f32x16{};f32x16 negm=f32x16{};asm volatile("":"+v"(negm));
  const int qrel=wid*QBLK+r32;
  #define CMASK(P0,P1,t) do{int jb_=(t)-(NT-4); if(jb_>=0)cmask(P0,P1,jb_,qrel,hi);}while(0)
  bool resc=false;
  #define START(P0,P1) do{ const float rm=rowmax(P0,P1); resc=false; \
    { const float dl=rm; mhat=fadd_s(mhat,dl); \
      _Pragma("unroll") for(int r=0;r<16;++r){P0[r]=fsub_s(P0[r],dl);P1[r]=fsub_s(P1[r],dl);} \
      _Pragma("unroll") for(int r=0;r<16;++r)negm[r]=-mhat; asm volatile("":"+v"(negm)); } \
    _Pragma("unroll") for(int r=0;r<16;++r)P0[r]=__builtin_amdgcn_exp2f(P0[r]); }while(0)
  #define RESC() do{ if(resc){ asm volatile("s_waitcnt lgkmcnt(0)":::"memory"); \
      _Pragma("unroll") for(int d_=0;d_<2;++d_) _Pragma("unroll") for(int r=0;r<16;++r)o[d_][r]*=wsf[crow(r,hi)]; } }while(0)
  f32x16 pA0,pA1,pB0,pB1;
  int sl_prev=0,sl_cur=0,sl_next=SLOTB;
  #define ROT() do{sl_prev=sl_cur;sl_cur=sl_next;sl_next=(sl_next==(NSLOT-1)*SLOTB)?0:sl_next+SLOTB;}while(0)
  DMA_K(2,2*SLOTB);
  WAIT_BAR(3);
  qkt(pA0,pA1,Kbase,qr,negm,r32,hi);asm volatile("s_nop 15\n\ts_nop 7":"+v"(pA0),"+v"(pA1));CMASK(pA0,pA1,0);
  START(pA0,pA1);
  _Pragma("unroll") for(int r=0;r<16;++r)pA1[r]=__builtin_amdgcn_exp2f(pA1[r]);
  WAIT_BAR(0);
  DMA_K(3,0);DMA_V(1,SLOTB);
  ROT();
  kload8(kf,kp0+sl_cur);
  WAIT_BAR(2);
  s16x4 vlo[8],vhi[8]; u32x4 pw0,pw1,pw2,pw3;
  #define PKW(P,B) cvtpk_s(P[B],P[B+1])
  #define PAF(k) __builtin_bit_cast(bf16x8,pw##k)
  #define VFR(i) (bf16x8){vlo[i][0],vlo[i][1],vlo[i][2],vlo[i][3],vhi[i][0],vhi[i][1],vhi[i][2],vhi[i][3]}
  #define PIN(x) asm volatile("":"+v"(x))
  #define MX3(a,b,c) __builtin_fmaxf(__builtin_fmaxf((a),(b)),(c))
  #define GAPA(MF,A0,A1,A2,A3,W0,W1,PW) do{ MF; sacc+=A0; sacc+=A1; sacc+=A2; sacc+=A3; PIN(sacc); W0; W1; PIN(PW); SBAR(); }while(0)
  #define EX(v) __builtin_amdgcn_exp2f(v)
  #define GAPB(MF,X,B) do{ MF; X[B]=EX(X[B]); X[B+1]=EX(X[B+1]); X[B+2]=EX(X[B+2]); X[B+3]=EX(X[B+3]); PIN(X); SBAR(); }while(0)
  #define VRD(i) do{ vlo[i]=vtr(vp_+(((i)>>2)*4096+((i)&3)*1024)); vhi[i]=vtr(vp_+(((i)>>2)*4096+((i)&3)*1024+512)); }while(0)
  #define KRD(G,j) do{ if(G){ kload2(kf,kp0+sl_next,j); SBAR(); } }while(0)
  #define STEP(C0,C1,P0,P1,t,GK,GV,GL) do{ SBAR(); \
    const lds_cptr vp_=vp0+sl_prev; \
    VRD(0); SBAR(); float sacc=(P0[0]+P0[1]); \
    GAPA(C0=__builtin_amdgcn_mfma_f32_32x32x16_bf16(kf[0],qr[0],negm,0,0,0), P0[2],P0[3],P0[4],P0[5],     pw0[0]=PKW(P0,0), pw0[1]=PKW(P0,2), pw0); \
    VRD(4); SBAR(); GAPA(C1=__builtin_amdgcn_mfma_f32_32x32x16_bf16(kf[1],qr[0],negm,0,0,0), P0[6],P0[7],P0[8],P0[9],     pw0[2]=PKW(P0,4), pw0[3]=PKW(P0,6), pw0); \
    VRD(1); SBAR(); GAPA(C0=__builtin_amdgcn_mfma_f32_32x32x16_bf16(kf[2],qr[1],C0,0,0,0),   P0[10],P0[11],P0[12],P0[13], pw1[0]=PKW(P0,8), pw1[1]=PKW(P0,10), pw1); \
    VRD(5); SBAR(); GAPA(C1=__builtin_amdgcn_mfma_f32_32x32x16_bf16(kf[3],qr[1],C1,0,0,0),   P0[14],P0[15],P1[0],P1[1],   pw1[2]=PKW(P0,12),pw1[3]=PKW(P0,14), pw1); \
    VRD(2); SBAR(); GAPA(C0=__builtin_amdgcn_mfma_f32_32x32x16_bf16(kf[4],qr[2],C0,0,0,0),   P1[2],P1[3],P1[4],P1[5],     pw2[0]=PKW(P1,0), pw2[1]=PKW(P1,2), pw2); \
    VRD(6); SBAR(); GAPA(C1=__builtin_amdgcn_mfma_f32_32x32x16_bf16(kf[5],qr[2],C1,0,0,0),   P1[6],P1[7],P1[8],P1[9],     pw2[2]=PKW(P1,4), pw2[3]=PKW(P1,6), pw2); \
    VRD(3); SBAR(); GAPA(C0=__builtin_amdgcn_mfma_f32_32x32x16_bf16(kf[6],qr[3],C0,0,0,0),   P1[10],P1[11],P1[12],P1[13], pw3[0]=PKW(P1,8), pw3[1]=PKW(P1,10), pw3); \
    VRD(7); SBAR(); GAPA(C1=__builtin_amdgcn_mfma_f32_32x32x16_bf16(kf[7],qr[3],C1,0,0,0),   P1[14],P1[15],0.f,0.f,       pw3[2]=PKW(P1,12),pw3[3]=PKW(P1,14), pw3); \
    l_reg+=sacc; \
    if(GK){DMA_K((t)+3,sl_cur);} if(GV){DMA_V((t)+1,sl_next);} \
    CMASK(C0,C1,t); \
    { float a=MX3(C0[0],C0[1],C1[0]),b=MX3(C0[2],C0[3],C1[1]); a=MX3(a,C1[2],C1[3]); \
      _Pragma("unroll") for(int r=4;r<16;r+=4){a=MX3(a,C0[r],C0[r+1]);b=MX3(b,C0[r+2],C0[r+3]);a=MX3(a,C1[r],C1[r+1]);b=MX3(b,C1[r+2],C1[r+3]);} \
      float rm=__builtin_fmaxf(a,b); { auto rr=__builtin_amdgcn_permlane32_swap(__float_as_uint(rm),__float_as_uint(rm),false,false); rm=__builtin_fmaxf(__uint_as_float(rr[0]),__uint_as_float(rr[1])); } \
      resc=false; \
      if(__builtin_expect(__any(rm>(float)THRL),0)){ const float dl=__builtin_fmaxf(rm,0.f); mhat+=dl; \
        _Pragma("unroll") for(int r=0;r<16;++r){C0[r]-=dl;C1[r]-=dl;} \
        _Pragma("unroll") for(int r=0;r<16;++r)negm[r]=-mhat; asm volatile("":"+v"(negm)); \
        const float f=__builtin_amdgcn_exp2f(-dl); l_reg*=f; if(hi==0)wsf[r32]=f; resc=true; } } \
    SBAR(); \
    GAPB(o[0]=__builtin_amdgcn_mfma_f32_32x32x16_bf16(PAF(0),VFR(0),o[0],0,0,0), C0,0); \
    GAPB(o[1]=__builtin_amdgcn_mfma_f32_32x32x16_bf16(PAF(0),VFR(4),o[1],0,0,0), C0,4); \
    KRD(GL,0); GAPB(o[0]=__builtin_amdgcn_mfma_f32_32x32x16_bf16(PAF(1),VFR(1),o[0],0,0,0), C0,8); \
    KRD(GL,1); GAPB(o[1]=__builtin_amdgcn_mfma_f32_32x32x16_bf16(PAF(1),VFR(5),o[1],0,0,0), C0,12); \
    KRD(GL,2); GAPB(o[0]=__builtin_amdgcn_mfma_f32_32x32x16_bf16(PAF(2),VFR(2),o[0],0,0,0), C1,0); \
    KRD(GL,3); GAPB(o[1]=__builtin_amdgcn_mfma_f32_32x32x16_bf16(PAF(2),VFR(6),o[1],0,0,0), C1,4); \
    GAPB(o[0]=__builtin_amdgcn_mfma_f32_32x32x16_bf16(PAF(3),VFR(3),o[0],0,0,0), C1,8); \
    GAPB(o[1]=__builtin_amdgcn_mfma_f32_32x32x16_bf16(PAF(3),VFR(7),o[1],0,0,0), C1,12); \
    }while(0)
  int t=1;
  #undef CMASK
  #define CMASK(P0,P1,t) do{}while(0)
  for(;t+5<NT;t+=2){
    STEP(pB0,pB1,pA0,pA1,t,true,true,true);     WAIT_BAR(2); RESC(); ROT();
    STEP(pA0,pA1,pB0,pB1,t+1,true,true,true);   WAIT_BAR(2); RESC(); ROT();
  }
  #undef CMASK
  #define CMASK(P0,P1,t) do{int jb_=(t)-(NT-4); if(jb_>=0)cmask(P0,P1,jb_,qrel,hi);}while(0)
  #define ENDW(tt) do{ if((tt)+3<NT){WAIT_BAR(2);} else if((tt)+2<NT){WAIT_BAR(1);} else {WAIT_BAR(0);} }while(0)
  for(;t+1<NT;t+=2){
    STEP(pB0,pB1,pA0,pA1,t,(t+3<NT),(t+1<NT),(t+1<NT));       ENDW(t);   RESC(); ROT();
    STEP(pA0,pA1,pB0,pB1,t+1,(t+4<NT),(t+2<NT),(t+2<NT));     ENDW(t+1); RESC(); ROT();
  }
  STEP(pB0,pB1,pA0,pA1,NT-1,false,false,false); RESC();
  { float sacc=pB0[0]+pB0[1]; _Pragma("unroll") for(int r=2;r<16;++r)sacc+=pB0[r]; _Pragma("unroll") for(int r=0;r<16;++r)sacc+=pB1[r]; l_reg+=sacc;
    pw0=(u32x4){PKW(pB0,0),PKW(pB0,2),PKW(pB0,4),PKW(pB0,6)};pw1=(u32x4){PKW(pB0,8),PKW(pB0,10),PKW(pB0,12),PKW(pB0,14)};pw2=(u32x4){PKW(pB1,0),PKW(pB1,2),PKW(pB1,4),PKW(pB1,6)};pw3=(u32x4){PKW(pB1,8),PKW(pB1,10),PKW(pB1,12),PKW(pB1,14)};
    SBAR(); pv(o,vb0+sl_cur,PAF(0),PAF(1),PAF(2),PAF(3)); }
  #undef PKW
  #undef PAF
  #undef VFR
  #undef PIN
  #undef MX3
  #undef GAPA
  #undef GAPB
  #undef EX
  #undef VRD
  #undef KRD
  #undef STEP
  #undef ENDW
  {auto rr=__builtin_amdgcn_permlane32_swap(__float_as_uint(l_reg),__float_as_uint(l_reg),false,false);l_reg=__uint_as_float(rr[0])+__uint_as_float(rr[1]);}
  if(hi==0)wsf[32+r32]=l_reg;asm volatile("s_waitcnt lgkmcnt(0)":::"memory");
  float rli[16];
  #pragma unroll
  for(int r=0;r<16;++r)rli[r]=__builtin_amdgcn_rcpf(wsf[32+crow(r,hi)]);
  bf16*Ow=O+(rowbase+q0+wid*QBLK)*DM+hv*D;
  { bf16*stg=(bf16*)(shm+LDS_OST)+wid*2048;
    #pragma unroll
    for(int r=0;r<16;++r){const int orow=crow(r,hi);
      #pragma unroll
      for(int d0=0;d0<2;++d0)stg[orow*64+d0*32+r32]=__float2bfloat16(o[d0][r]*rli[r]);}
    asm volatile("s_waitcnt lgkmcnt(0)":::"memory");
    #pragma unroll
    for(int i=0;i<4;++i){const int row=i*8+(lane>>3),ch=lane&7; const u32x4 v=*(const u32x4*)(stg+row*64+ch*8); ATTN_STORE16(Ow+(long)row*DM+ch*8,v);} }
  asm volatile("s_waitcnt lgkmcnt(0)\n\ts_barrier":::"memory");
  #undef DMA_K
  #undef DMA_V
  #undef CMASK
  #undef START
  #undef RESC
  #undef ROT
}
__device__ __forceinline__ void pv128(f32x16*o,int vb,bf16x8 pa0,bf16x8 pa1,bf16x8 pa2,bf16x8 pa3){
  #pragma unroll
  for(int d0=0;d0<4;++d0){s16x4 lo[4],hi[4];
    #pragma unroll
    for(int ks=0;ks<4;++ks){
      asm volatile("ds_read_b64_tr_b16 %0,%1 offset:%c2":"=&v"(lo[ks]):"v"(vb),"i"(d0*4096+ks*1024):"memory");
      asm volatile("ds_read_b64_tr_b16 %0,%1 offset:%c2":"=&v"(hi[ks]):"v"(vb),"i"(d0*4096+ks*1024+512):"memory");}
    asm volatile("s_waitcnt lgkmcnt(0)":::"memory");SBAR();
    #define PK(k) (bf16x8){lo[k][0],lo[k][1],lo[k][2],lo[k][3],hi[k][0],hi[k][1],hi[k][2],hi[k][3]}
    o[d0]=__builtin_amdgcn_mfma_f32_32x32x16_bf16(pa0,PK(0),o[d0],0,0,0);
    o[d0]=__builtin_amdgcn_mfma_f32_32x32x16_bf16(pa1,PK(1),o[d0],0,0,0);
    o[d0]=__builtin_amdgcn_mfma_f32_32x32x16_bf16(pa2,PK(2),o[d0],0,0,0);
    o[d0]=__builtin_amdgcn_mfma_f32_32x32x16_bf16(pa3,PK(3),o[d0],0,0,0);
    #undef PK
  }
}
constexpr int SLOTV=16384, LDS_V2=NSLOT*SLOTB, LDS_WS2=LDS_V2+NSLOT*SLOTV, LDS_OST2=LDS_WS2+NW*64*4, LDS_BYTES2=LDS_OST2+NW*4096;
template<int THRL> __device__ __forceinline__ void attn_unit128(int b,int hq,int hv,int qb,const bf16*Q,const bf16*__restrict__ K,const bf16*__restrict__ V,bf16*O,char*shm){
  const int tid=opaque_tid(),lane=tid&63,r32=lane&31,hi=lane>>5; const int wid=__builtin_amdgcn_readfirstlane(tid>>6);
  const long rowbase=(long)b*SEQ; const int q0=qb*QB;
  const bf16*Qw=Q+(rowbase+q0+wid*QBLK)*DM+hq*D;
  const bf16*Kh=K+rowbase*DM+hq*D,*Vh=V+rowbase*DM+hv*D;
  const unsigned lds0=(unsigned)(uintptr_t)shm;
  float*wsf=(float*)(shm+LDS_WS2)+wid*64;
  const bf16*ksrc=Kh+(long)lane*DM+wid*8;
  const bf16*vsrc=Vh+(long)(16*(wid&3)+(lane>>2))*DM+(wid>>2)*32+(lane&3)*8;
  const unsigned kdst=lds0+LDS_K+wid*1024, vdst=lds0+LDS_V2+wid*1024;
  #define DMA_K(t,slot) glds16(ksrc+(long)(t)*KVBLK*DM,(unsigned)__builtin_amdgcn_readfirstlane(kdst+(slot)))
  #define DMA_V(t,slot) do{ glds16(vsrc+(long)(t)*KVBLK*DM,(unsigned)__builtin_amdgcn_readfirstlane(vdst+2*(slot))); glds16(vsrc+64+(long)(t)*KVBLK*DM,(unsigned)__builtin_amdgcn_readfirstlane(vdst+8192+2*(slot))); }while(0)
  const int vb0=(int)(lds0+LDS_V2)+((lane>>4)&1)*32+(lane&3)*8+(4*hi+((lane&15)>>2))*64;
  const char*Kbase=shm+LDS_K; bf16x8 kf[8];
  const lds_cptr shm3=(lds_cptr)shm; const lds_cptr kp0=shm3+LDS_K+hi*1024+r32*16; const lds_cptr vp0=shm3+LDS_V2+((lane>>4)&1)*32+(lane&3)*8+(4*hi+((lane&15)>>2))*64;
  const int NT=(q0+QB)/KVBLK;
  DMA_K(0,0);DMA_V(0,0);DMA_K(1,SLOTB);
  bf16x8 qr[4];
  #pragma unroll
  for(int d0=0;d0<4;++d0)qr[d0]=*reinterpret_cast<const bf16x8*>(&Qw[(long)r32*DM+d0*16+hi*8]);
  float mhat=0.f,l_reg=0.f;f32x16 o[4];o[0]=f32x16{};o[1]=f32x16{};o[2]=f32x16{};o[3]=f32x16{};const f32x16 zc=f32x16{};
  const int qrel=wid*QBLK+r32;
  #define CMASK(P0,P1,t) do{int jb_=(t)-(NT-4); if(jb_>=0)cmask(P0,P1,jb_,qrel,hi);}while(0)
  bool resc=false;
  #define START(P0,P1) do{ const float rm=rowmax(P0,P1); resc=false; \
    { const float dl=rm; mhat=fadd_s(mhat,dl); \
      _Pragma("unroll") for(int r=0;r<16;++r){P0[r]=fsub_s(P0[r],dl);P1[r]=fsub_s(P1[r],dl);} \
      } \
    _Pragma("unroll") for(int r=0;r<16;++r)P0[r]=__builtin_amdgcn_exp2f(P0[r]); }while(0)
  #define RESC() do{ if(resc){ asm volatile("s_waitcnt lgkmcnt(0)":::"memory"); \
      _Pragma("unroll") for(int d_=0;d_<4;++d_) _Pragma("unroll") for(int r=0;r<16;++r)o[d_][r]*=wsf[crow(r,hi)]; } }while(0)
  f32x16 pA0,pA1,pB0,pB1;
  int sl_prev=0,sl_cur=0,sl_next=SLOTB;
  #define ROT() do{sl_prev=sl_cur;sl_cur=sl_next;sl_next=(sl_next==(NSLOT-1)*SLOTB)?0:sl_next+SLOTB;}while(0)
  DMA_K(2,2*SLOTB);
  WAIT_BAR(3);
  qkt(pA0,pA1,Kbase,qr,zc,r32,hi);asm volatile("s_nop 15\n\ts_nop 7":"+v"(pA0),"+v"(pA1));CMASK(pA0,pA1,0);
  START(pA0,pA1);
  _Pragma("unroll") for(int r=0;r<16;++r)pA1[r]=__builtin_amdgcn_exp2f(pA1[r]);
  WAIT_BAR(0);
  DMA_K(3,0);DMA_V(1,SLOTB);
  ROT();
  kload8(kf,kp0+sl_cur);
  WAIT_BAR(3);
  s16x4 vlo[8],vhi[8]; u32x4 pw0,pw1,pw2,pw3;
  #define PKW(P,B) cvtpk_s(P[B],P[B+1])
  #define PAF(k) __builtin_bit_cast(bf16x8,pw##k)
  #define VFR(i) (bf16x8){vlo[i][0],vlo[i][1],vlo[i][2],vlo[i][3],vhi[i][0],vhi[i][1],vhi[i][2],vhi[i][3]}
  #define PIN(x) asm volatile("":"+v"(x))
  #define MX3(a,b,c) __builtin_fmaxf(__builtin_fmaxf((a),(b)),(c))
  #define GAPA(MF,A0,A1,A2,A3,W0,W1,PW) do{ MF; sacc+=A0; sacc+=A1; sacc+=A2; sacc+=A3; PIN(sacc); W0; W1; PIN(PW); SBAR(); }while(0)
  #define EX(v) __builtin_amdgcn_exp2f(v)
  #define GAPB(MF,X,B) do{ MF; X[B]=EX(X[B]); X[B+1]=EX(X[B+1]); X[B+2]=EX(X[B+2]); X[B+3]=EX(X[B+3]); PIN(X); SBAR(); }while(0)
  #define VRD(i) do{ vlo[i]=vtr(vp_+(((i)>>2)*4096+((i)&3)*1024)); vhi[i]=vtr(vp_+(((i)>>2)*4096+((i)&3)*1024+512)); }while(0)
  #define VRX(i) do{ vlo[i]=vtr(vp_+((((i)>>2)+2)*4096+((i)&3)*1024)); vhi[i]=vtr(vp_+((((i)>>2)+2)*4096+((i)&3)*1024+512)); SBAR(); }while(0)
  #define GAPB2(MF,X,B) do{ MF; X[B]=EX(X[B]-mhat); X[B+1]=EX(X[B+1]-mhat); PIN(X); SBAR(); }while(0)
  #define KRD(G,j) do{ if(G){ kload2(kf,kp0+sl_next,j); SBAR(); } }while(0)
  #define STEP(C0,C1,P0,P1,t,GK,GV,GL) do{ SBAR(); \
    const lds_cptr vp_=vp0+2*sl_prev; \
    VRD(0); SBAR(); float sacc=(P0[0]+P0[1]); \
    GAPA(C0=__builtin_amdgcn_mfma_f32_32x32x16_bf16(kf[0],qr[0],zc,0,0,0), P0[2],P0[3],P0[4],P0[5],     pw0[0]=PKW(P0,0), pw0[1]=PKW(P0,2), pw0); \
    VRD(4); SBAR(); GAPA(C1=__builtin_amdgcn_mfma_f32_32x32x16_bf16(kf[1],qr[0],zc,0,0,0), P0[6],P0[7],P0[8],P0[9],     pw0[2]=PKW(P0,4), pw0[3]=PKW(P0,6), pw0); \
    VRD(1); SBAR(); GAPA(C0=__builtin_amdgcn_mfma_f32_32x32x16_bf16(kf[2],qr[1],C0,0,0,0),   P0[10],P0[11],P0[12],P0[13], pw1[0]=PKW(P0,8), pw1[1]=PKW(P0,10), pw1); \
    VRD(5); SBAR(); GAPA(C1=__builtin_amdgcn_mfma_f32_32x32x16_bf16(kf[3],qr[1],C1,0,0,0),   P0[14],P0[15],P1[0],P1[1],   pw1[2]=PKW(P0,12),pw1[3]=PKW(P0,14), pw1); \
    VRD(2); SBAR(); GAPA(C0=__builtin_amdgcn_mfma_f32_32x32x16_bf16(kf[4],qr[2],C0,0,0,0),   P1[2],P1[3],P1[4],P1[5],     pw2[0]=PKW(P1,0), pw2[1]=PKW(P1,2), pw2); \
    VRD(6); SBAR(); GAPA(C1=__builtin_amdgcn_mfma_f32_32x32x16_bf16(kf[5],qr[2],C1,0,0,0),   P1[6],P1[7],P1[8],P1[9],     pw2[2]=PKW(P1,4), pw2[3]=PKW(P1,6), pw2); \
    VRD(3); SBAR(); GAPA(C0=__builtin_amdgcn_mfma_f32_32x32x16_bf16(kf[6],qr[3],C0,0,0,0),   P1[10],P1[11],P1[12],P1[13], pw3[0]=PKW(P1,8), pw3[1]=PKW(P1,10), pw3); \
    VRD(7); SBAR(); GAPA(C1=__builtin_amdgcn_mfma_f32_32x32x16_bf16(kf[7],qr[3],C1,0,0,0),   P1[14],P1[15],0.f,0.f,       pw3[2]=PKW(P1,12),pw3[3]=PKW(P1,14), pw3); \
    l_reg+=sacc; \
    if(GK){DMA_K((t)+3,sl_cur);} if(GV){DMA_V((t)+1,sl_next);} \
    CMASK(C0,C1,t); \
    { float a=MX3(C0[0],C0[1],C1[0]),b=MX3(C0[2],C0[3],C1[1]); a=MX3(a,C1[2],C1[3]); \
      _Pragma("unroll") for(int r=4;r<16;r+=4){a=MX3(a,C0[r],C0[r+1]);b=MX3(b,C0[r+2],C0[r+3]);a=MX3(a,C1[r],C1[r+1]);b=MX3(b,C1[r+2],C1[r+3]);} \
      float rm=__builtin_fmaxf(a,b); { auto rr=__builtin_amdgcn_permlane32_swap(__float_as_uint(rm),__float_as_uint(rm),false,false); rm=__builtin_fmaxf(__uint_as_float(rr[0]),__uint_as_float(rr[1])); } \
      rm-=mhat; resc=false; \
      if(__builtin_expect(__any(rm>(float)THRL),0)){ const float dl=__builtin_fmaxf(rm,0.f); mhat+=dl; \
        const float f=__builtin_amdgcn_exp2f(-dl); l_reg*=f; if(hi==0)wsf[r32]=f; resc=true; } } \
    SBAR(); \
    GAPB2(o[0]=__builtin_amdgcn_mfma_f32_32x32x16_bf16(PAF(0),VFR(0),o[0],0,0,0), C0,0);  VRX(0); \
    GAPB2(o[1]=__builtin_amdgcn_mfma_f32_32x32x16_bf16(PAF(0),VFR(4),o[1],0,0,0), C0,2);  VRX(4); \
    KRD(GL,0); GAPB2(o[0]=__builtin_amdgcn_mfma_f32_32x32x16_bf16(PAF(1),VFR(1),o[0],0,0,0), C0,4);  VRX(1); \
    KRD(GL,1); GAPB2(o[1]=__builtin_amdgcn_mfma_f32_32x32x16_bf16(PAF(1),VFR(5),o[1],0,0,0), C0,6);  VRX(5); \
    KRD(GL,2); GAPB2(o[0]=__builtin_amdgcn_mfma_f32_32x32x16_bf16(PAF(2),VFR(2),o[0],0,0,0), C0,8);  VRX(2); \
    KRD(GL,3); GAPB2(o[1]=__builtin_amdgcn_mfma_f32_32x32x16_bf16(PAF(2),VFR(6),o[1],0,0,0), C0,10); VRX(6); \
    GAPB2(o[0]=__builtin_amdgcn_mfma_f32_32x32x16_bf16(PAF(3),VFR(3),o[0],0,0,0), C0,12); VRX(3); \
    GAPB2(o[1]=__builtin_amdgcn_mfma_f32_32x32x16_bf16(PAF(3),VFR(7),o[1],0,0,0), C0,14); VRX(7); \
    GAPB2(o[2]=__builtin_amdgcn_mfma_f32_32x32x16_bf16(PAF(0),VFR(0),o[2],0,0,0), C1,0); \
    GAPB2(o[3]=__builtin_amdgcn_mfma_f32_32x32x16_bf16(PAF(0),VFR(4),o[3],0,0,0), C1,2); \
    GAPB2(o[2]=__builtin_amdgcn_mfma_f32_32x32x16_bf16(PAF(1),VFR(1),o[2],0,0,0), C1,4); \
    GAPB2(o[3]=__builtin_amdgcn_mfma_f32_32x32x16_bf16(PAF(1),VFR(5),o[3],0,0,0), C1,6); \
    GAPB2(o[2]=__builtin_amdgcn_mfma_f32_32x32x16_bf16(PAF(2),VFR(2),o[2],0,0,0), C1,8); \
    GAPB2(o[3]=__builtin_amdgcn_mfma_f32_32x32x16_bf16(PAF(2),VFR(6),o[3],0,0,0), C1,10); \
    GAPB2(o[2]=__builtin_amdgcn_mfma_f32_32x32x16_bf16(PAF(3),VFR(3),o[2],0,0,0), C1,12); \
    GAPB2(o[3]=__builtin_amdgcn_mfma_f32_32x32x16_bf16(PAF(3),VFR(7),o[3],0,0,0), C1,14); \
    }while(0)
  int t=1;
  #undef CMASK
  #define CMASK(P0,P1,t) do{}while(0)
  for(;t+5<NT;t+=2){
    STEP(pB0,pB1,pA0,pA1,t,true,true,true);     WAIT_BAR(3); RESC(); ROT();
    STEP(pA0,pA1,pB0,pB1,t+1,true,true,true);   WAIT_BAR(3); RESC(); ROT();
  }
  #undef CMASK
  #define CMASK(P0,P1,t) do{int jb_=(t)-(NT-4); if(jb_>=0)cmask(P0,P1,jb_,qrel,hi);}while(0)
  #define ENDW(tt) do{ if((tt)+3<NT){WAIT_BAR(3);} else if((tt)+2<NT){WAIT_BAR(2);} else {WAIT_BAR(0);} }while(0)
  for(;t+1<NT;t+=2){
    STEP(pB0,pB1,pA0,pA1,t,(t+3<NT),(t+1<NT),(t+1<NT));       ENDW(t);   RESC(); ROT();
    STEP(pA0,pA1,pB0,pB1,t+1,(t+4<NT),(t+2<NT),(t+2<NT));     ENDW(t+1); RESC(); ROT();
  }
  STEP(pB0,pB1,pA0,pA1,NT-1,false,false,false); RESC();
  { float sacc=pB0[0]+pB0[1]; _Pragma("unroll") for(int r=2;r<16;++r)sacc+=pB0[r]; _Pragma("unroll") for(int r=0;r<16;++r)sacc+=pB1[r]; l_reg+=sacc;
    pw0=(u32x4){PKW(pB0,0),PKW(pB0,2),PKW(pB0,4),PKW(pB0,6)};pw1=(u32x4){PKW(pB0,8),PKW(pB0,10),PKW(pB0,12),PKW(pB0,14)};pw2=(u32x4){PKW(pB1,0),PKW(pB1,2),PKW(pB1,4),PKW(pB1,6)};pw3=(u32x4){PKW(pB1,8),PKW(pB1,10),PKW(pB1,12),PKW(pB1,14)};
    SBAR(); pv128(o,vb0+2*sl_cur,PAF(0),PAF(1),PAF(2),PAF(3)); }
  #undef PKW
  #undef PAF
  #undef VFR
  #undef PIN
  #undef MX3
  #undef GAPA
  #undef GAPB
  #undef EX
  #undef VRD
  #undef VRX
  #undef GAPB2
  #undef KRD
  #undef STEP
  #undef ENDW
  {auto rr=__builtin_amdgcn_permlane32_swap(__float_as_uint(l_reg),__float_as_uint(l_reg),false,false);l_reg=__uint_as_float(rr[0])+__uint_as_float(rr[1]);}
  if(hi==0)wsf[32+r32]=l_reg;asm volatile("s_waitcnt lgkmcnt(0)":::"memory");
  float rli[16];
  #pragma unroll
  for(int r=0;r<16;++r)rli[r]=__builtin_amdgcn_rcpf(wsf[32+crow(r,hi)]);
  bf16*Ow=O+(rowbase+q0+wid*QBLK)*DM+hv*D;
  { bf16*stg=(bf16*)(shm+LDS_OST2)+wid*2048;
    #pragma unroll
    for(int hp=0;hp<2;++hp){
      #pragma unroll
      for(int r=0;r<16;++r){const int orow=crow(r,hi);
        #pragma unroll
        for(int d0=0;d0<2;++d0)stg[orow*64+d0*32+r32]=__float2bfloat16(o[2*hp+d0][r]*rli[r]);}
      asm volatile("s_waitcnt lgkmcnt(0)":::"memory");
      #pragma unroll
      for(int i=0;i<4;++i){const int row=i*8+(lane>>3),ch=lane&7; const u32x4 v=*(const u32x4*)(stg+row*64+ch*8); ATTN_STORE16(Ow+(long)row*DM+hp*64+ch*8,v);}
      asm volatile("s_waitcnt lgkmcnt(0)":::"memory"); } }
  asm volatile("s_waitcnt lgkmcnt(0)\n\ts_barrier":::"memory");
  #undef DMA_K
  #undef DMA_V
  #undef CMASK
  #undef START
  #undef RESC
  #undef ROT
}
constexpr int ATTN_LDS_BYTES=LDS_BYTES;
#undef SBAR
#undef WAIT_BAR
}
#define GAS __attribute__((address_space(1)))
#define LAS __attribute__((address_space(3)))
typedef unsigned short bf16;
typedef unsigned v4u __attribute__((ext_vector_type(4)));
typedef float f32x4 __attribute__((ext_vector_type(4)));
typedef short bf16x8 __attribute__((ext_vector_type(8)));
typedef GAS unsigned gu32;
typedef GAS unsigned long long gu64;
#define RLX_AGENT __ATOMIC_RELAXED, __HIP_MEMORY_SCOPE_AGENT
#define LDS_WAIT() asm volatile("s_waitcnt lgkmcnt(0)" ::: "memory")
#define VM_WAIT() asm volatile("s_waitcnt vmcnt(0)" ::: "memory")
__device__ __forceinline__ unsigned long long rt() { return __builtin_amdgcn_s_memrealtime(); }
__device__ __forceinline__ unsigned f2bf(float f) { unsigned u = __builtin_bit_cast(unsigned, f); return (u + 0x7fffu + ((u >> 16) & 1u)) >> 16; }
__device__ __forceinline__ unsigned pk2(float lo, float hi) { return f2bf(lo) | (f2bf(hi) << 16); }

#define XB_TMO      128
#define XB_XCNT(j)  (256  + 64 * (j))
#define XB_XSUB(j)  (1280 + 64 * (j))
#define XB_XGEN(j)  (2304 + 64 * (j))
#define XB_TOP      3328
#define XB_TOPGEN   3392
#define XCD_BAR_WORDS 3456
#define XB_SPIN_CAP (1u << 18)

__device__ __forceinline__ unsigned xb_ld(unsigned* p)              { return __hip_atomic_load(p, __ATOMIC_RELAXED, __HIP_MEMORY_SCOPE_AGENT); }
__device__ __forceinline__ unsigned xb_add(unsigned* p, unsigned v) { return __hip_atomic_fetch_add(p, v, __ATOMIC_RELAXED, __HIP_MEMORY_SCOPE_AGENT); }
__device__ __forceinline__ unsigned xb_xcc_id() { return (unsigned)__builtin_amdgcn_s_getreg((3 << 11) | 20) & 0xFu; }
#define XB_SPIN(cond, bar) do { unsigned _sp = 0; while (cond) { __builtin_amdgcn_s_sleep(1); \
    if ((++_sp & 255u) == 0u) { if (xb_ld(&(bar)[XB_TMO])) break; if (_sp > XB_SPIN_CAP) { atomicAdd(&(bar)[XB_TMO], 1u); break; } } } } while (0)

struct XcdBarrier {
    unsigned* bar; unsigned x;
    volatile LAS unsigned* st;
};

__device__ __forceinline__ XcdBarrier xcd_barrier_post(unsigned* bar, volatile LAS unsigned* st) {
    XcdBarrier b; b.bar = bar; b.x = xb_xcc_id(); b.st = st;
    if (opaque_tid() == 0) (void)xb_add(&bar[XB_XCNT(b.x)], 1u);
    return b;
}
__device__ __forceinline__ void xcd_barrier_complete(unsigned* bar, unsigned x, unsigned& nloc, unsigned& nx) {
    const unsigned G = gridDim.x * gridDim.y * gridDim.z;
    unsigned sum, cnt, mine, sp = 0u;
    for (;;) {
        sum = 0u; cnt = 0u;
#pragma unroll
        for (unsigned j = 0; j < 16; ++j) { const unsigned c = xb_ld(&bar[XB_XCNT(j)]); sum += c; cnt += (c > 0u) ? 1u : 0u; }
        if (sum == G) break;
        __builtin_amdgcn_s_sleep(1);
        if ((++sp & 255u) == 0u) { if (xb_ld(&bar[XB_TMO])) break; if (sp > XB_SPIN_CAP) { atomicAdd(&bar[XB_TMO], 1u); break; } }
    }
    mine = xb_ld(&bar[XB_XCNT(x)]);
    nloc = mine > 0u ? mine : 1u; nx = cnt > 0u ? cnt : 1u;
}

__device__ __forceinline__ void xcd_barrier(const XcdBarrier& b) {
    asm volatile("s_waitcnt vmcnt(0)" ::: "memory");
    __syncthreads();
    if (opaque_tid() == 0) {
        unsigned* bar = b.bar;
        __builtin_amdgcn_s_waitcnt(0);
        unsigned nloc = b.st[0], nx = b.st[1];
        if (nloc == 0u) { xcd_barrier_complete(bar, b.x, nloc, nx); b.st[0] = nloc; b.st[1] = nx; }
        const unsigned old = xb_add(&bar[XB_XSUB(b.x)], 1u);
        const unsigned gen = old / nloc;
        if (old + 1u == (gen + 1u) * nloc) {
            __builtin_amdgcn_fence(__ATOMIC_RELEASE, "agent");
            asm volatile("s_waitcnt vmcnt(0)" ::: "memory");
            const unsigned og = xb_add(&bar[XB_TOP], 1u);
            const unsigned tg = og / nx;
            if (og + 1u == (tg + 1u) * nx) xb_add(&bar[XB_TOPGEN], 1u);
            else XB_SPIN(xb_ld(&bar[XB_TOPGEN]) == tg, bar);
            __builtin_amdgcn_fence(__ATOMIC_ACQUIRE, "agent");
            xb_add(&bar[XB_XGEN(b.x)], 1u);
            asm volatile("s_waitcnt vmcnt(0)" ::: "memory");
        } else {
            XB_SPIN(xb_ld(&bar[XB_XGEN(b.x)]) == gen, bar);
            __builtin_amdgcn_fence(__ATOMIC_ACQUIRE, "agent");
            asm volatile("s_waitcnt vmcnt(0)" ::: "memory");
        }
    }
    __syncthreads();
}
constexpr int NWAVES = 8;
constexpr int DM = 1024, MP = 32768, MS = 512, MROWS = MP + MS, NSEQ = 20, DEPTH = 4, DFF = 2816, DIN = 9216, PAST = 2048;
constexpr int NCHUNK_P = 512, NCHUNK = 528;
constexpr float EPS = 1e-6f;
constexpr size_t OY_P = 0, OY_S = 33554432, OK_P = 34078720, OV_P = 168296448, OS_P = 302514176, OK_S = 304611328, OV_S = 306708480, OS_S = 308805632, OUT_TOTAL = 317194240;

constexpr size_t MiB = 1u << 20;
constexpr size_t WS_CTL = 0, CTL_ZERO_BYTES = 1 * MiB;
constexpr size_t WS_MOD = 1 * MiB;
constexpr size_t WS_LB = 4 * MiB;
constexpr size_t WS_W = 8 * MiB, W_LAYER = 57 * MiB;
constexpr size_t WO_GU1 = 0, WO_D1 = 11 * MiB, WO_IN = 16 * MiB + MiB / 2, WO_BA = 34 * MiB + MiB / 2, WO_BH = 36 * MiB + MiB / 2, WO_OUT = 38 * MiB + MiB / 2, WO_GU2 = 40 * MiB + MiB / 2, WO_D2 = 51 * MiB + MiB / 2;
constexpr size_t WS_X = 240 * MiB;
constexpr size_t WS_XN = 370 * MiB;
constexpr size_t WS_Q = 435 * MiB, WS_K = 500 * MiB, WS_V = 565 * MiB;
constexpr size_t WS_QQ = 630 * MiB, WS_KK = 695 * MiB, WS_VV = 760 * MiB, WS_HGS = 825 * MiB, WS_SZA = 890 * MiB, WS_SZH = 955 * MiB;
constexpr size_t WS_LOGF = 1020 * MiB;
constexpr size_t WS_O1 = 1150 * MiB, WS_O2 = 1215 * MiB, WS_OATT = 1280 * MiB, WS_OH = 1345 * MiB, WS_MRG = 1410 * MiB;
constexpr size_t WS_BIG = 1475 * MiB;
constexpr size_t WS_SST = 1739 * MiB;
constexpr size_t WS_DD = 1871 * MiB;
constexpr size_t WS_END = 1874 * MiB;
#ifndef TEAM_STRIDE
#define TEAM_STRIDE 16
#endif
#ifndef STARTERS
#define STARTERS 8
#endif
constexpr int T_TEAM = 256 / TEAM_STRIDE;
#ifndef G3_STAGGER_TICKS
#define G3_STAGGER_TICKS 800
#endif
#ifndef HG_SEGS
#define HG_SEGS 4
#endif
constexpr int HG_G = HG_SEGS;
constexpr size_t WS_QS = WS_BIG, WS_SL = WS_BIG + 64 * MiB, WS_DSEG = WS_BIG + 96 * MiB, WS_RAW = WS_SST;
constexpr int CW_BAR = 4096, CW_Q = 8192, CW_HS = 16384;
static_assert(pg8::EpiWin::O_Q == WS_Q && pg8::EpiWin::O_K == WS_K && pg8::EpiWin::O_V == WS_V && pg8::EpiWin::O_QQ == WS_QQ && pg8::EpiWin::O_KK == WS_KK && pg8::EpiWin::O_VV == WS_VV && pg8::EpiWin::O_HGS == WS_HGS && pg8::EpiWin::O_SZA == WS_SZA && pg8::EpiWin::O_SZH == WS_SZH && pg8::EpiWin::O_LOGF == WS_LOGF && pg8::EpiWin::O_LB == WS_LB && pg8::EpiWin::OK_P_ == OK_P && pg8::EpiWin::OV_P_ == OV_P && pg8::EpiWin::OK_S_ == OK_S && pg8::EpiWin::OV_S_ == OV_S, "EpiWin offsets");

constexpr int RING_OFF = 0, RING_BYTES = 139264;
constexpr int LDSCTL_OFF = RING_BYTES, MISC_OFF = LDSCTL_OFF + 320;
constexpr int LDS_BYTES = 147456;

struct Frame {
    LAS unsigned char* lds;
    volatile LAS unsigned* MISC;
    gu32* ctl;
    int tid, lane, wave;
    int vcu, G;
};
typedef float f32x16 __attribute__((ext_vector_type(16)));
typedef unsigned v2u __attribute__((ext_vector_type(2)));

__device__ __forceinline__ float shx(float v, int mask, int lane) { return __builtin_bit_cast(float, __builtin_amdgcn_ds_bpermute((lane ^ mask) << 2, __builtin_bit_cast(int, v))); }
__device__ __forceinline__ float wave_sum(float v, int lane) {
#pragma unroll
    for (int o = 1; o < 64; o <<= 1) v += shx(v, o, lane);
    return v;
}
__device__ __forceinline__ float bf2f(bf16 b) { return __builtin_bit_cast(float, (unsigned)b << 16); }
__device__ __forceinline__ unsigned cvtpk(float lo, float hi) { return pg8::cvt_pk_bf16(lo, hi); }
__device__ __forceinline__ bf16x8 pack8(f32x4 a, f32x4 b) { v4u w; w.x = cvtpk(a[0], a[1]); w.y = cvtpk(a[2], a[3]); w.z = cvtpk(b[0], b[1]); w.w = cvtpk(b[2], b[3]); return __builtin_bit_cast(bf16x8, w); }
__device__ __forceinline__ float lam_init_of(int l) { asm volatile("" : "+s"(l)); return 0.8f - 0.6f * __expf(-0.3f * (float)l); }

__device__ __forceinline__ void p0_transpose_item(const float* W, int K, int N, bf16* WT, bool gu, LAS float* scr, int item, int lane) {
    const int nblk = N / 32, kb = item / nblk, nb = item % nblk, k0 = 64 * kb, nd0 = 32 * nb;
    const int ns0 = gu ? (((nd0 >> 7) & 1) * 2816 + (nd0 >> 8) * 128 + (nd0 & 127)) : nd0;
#pragma unroll 8
    for (int i = 0; i < 32; ++i) { const int kk = 2 * i + (lane >> 5); scr[kk * 33 + (lane & 31)] = W[(size_t)(k0 + kk) * N + ns0 + (lane & 31)]; }
    LDS_WAIT(); asm volatile("" ::: "memory");
    const int c = lane & 7;
#pragma unroll
    for (int j = 0; j < 4; ++j) { const int n = (lane >> 3) + 8 * j; const LAS float* s = scr + (8 * c) * 33 + n;
        v4u o; o.x = pk2(s[0 * 33], s[1 * 33]); o.y = pk2(s[2 * 33], s[3 * 33]); o.z = pk2(s[4 * 33], s[5 * 33]); o.w = pk2(s[6 * 33], s[7 * 33]);
        *(GAS v4u*)(WT + (size_t)(nd0 + n) * K + k0 + 8 * c) = o; }
    LDS_WAIT(); asm volatile("" ::: "memory");
}
typedef const __attribute__((address_space(4))) char* kaptr_t;
__device__ __forceinline__ const float* karg(int i) { kaptr_t ka = (kaptr_t)__builtin_amdgcn_kernarg_segment_ptr(); asm volatile("" : "+s"(ka)); return *(const float* const __attribute__((address_space(4)))*)(ka + 8 * i); }
enum { A_XP = 0, A_XS, A_CK, A_CV, A_ST, A_CP, A_CS, A_WADA, A_BADA, A_GFFN1, A_WGU1, A_WD1, A_GMIX, A_WIN, A_LAM, A_GSUB, A_LBL, A_GHG, A_WBA, A_WBH, A_WOUT, A_GFFN2, A_WGU2, A_WD2, A_GFIN, A_OUT, A_WS };
__device__ __forceinline__ void p0_prologue(Frame& F, unsigned char* ws) {
    { LAS float* scr = (LAS float*)(F.lds + RING_OFF + F.wave * 16384);
      const int gw = F.vcu * NWAVES + F.wave, NGW = F.G * NWAVES;
      constexpr int I_GU = 16 * 176, I_D = 44 * 32, I_IN = 16 * 288, I_SQ = 16 * 32, I_LAYER = 2 * I_GU + 2 * I_D + I_IN + 3 * I_SQ;
      for (int it = gw; it < DEPTH * I_LAYER; it += NGW) {
          const int l = it / I_LAYER; int r = it % I_LAYER; unsigned char* wl = ws + WS_W + (size_t)l * W_LAYER;
          if (r < I_GU) { p0_transpose_item(karg(A_WGU1) + (size_t)l * 1024 * 5632, 1024, 5632, (bf16*)(wl + WO_GU1), true, scr, r, F.lane); continue; } r -= I_GU;
          if (r < I_D)  { p0_transpose_item(karg(A_WD1) + (size_t)l * 2816 * 1024, 2816, 1024, (bf16*)(wl + WO_D1), false, scr, r, F.lane); continue; } r -= I_D;
          if (r < I_IN) { p0_transpose_item(karg(A_WIN) + (size_t)l * 1024 * 9216, 1024, 9216, (bf16*)(wl + WO_IN), false, scr, r, F.lane); continue; } r -= I_IN;
          if (r < I_SQ) { p0_transpose_item(karg(A_WBA) + (size_t)l * 1024 * 1024, 1024, 1024, (bf16*)(wl + WO_BA), false, scr, r, F.lane); continue; } r -= I_SQ;
          if (r < I_SQ) { p0_transpose_item(karg(A_WBH) + (size_t)l * 1024 * 1024, 1024, 1024, (bf16*)(wl + WO_BH), false, scr, r, F.lane); continue; } r -= I_SQ;
          if (r < I_SQ) { p0_transpose_item(karg(A_WOUT) + (size_t)l * 1024 * 1024, 1024, 1024, (bf16*)(wl + WO_OUT), false, scr, r, F.lane); continue; } r -= I_SQ;
          if (r < I_GU) { p0_transpose_item(karg(A_WGU2) + (size_t)l * 1024 * 5632, 1024, 5632, (bf16*)(wl + WO_GU2), true, scr, r, F.lane); continue; } r -= I_GU;
          p0_transpose_item(karg(A_WD2) + (size_t)l * 2816 * 1024, 2816, 1024, (bf16*)(wl + WO_D2), false, scr, r, F.lane);
      } }
    __syncthreads();
    { const float* c_p = karg(A_CP); const float* c_s = karg(A_CS); const float* w_ada = karg(A_WADA); const float* b_ada = karg(A_BADA);
      LAS float* ca = (LAS float*)(F.lds);
      LAS float* red = (LAS float*)(F.lds + 81920);
      for (int i = F.tid; i < NSEQ * 1024; i += NWAVES * 64) { const int s = i >> 10, k = i & 1023; const float c = s < 4 ? c_p[s * 1024 + k] : c_s[(s - 4) * 1024 + k]; ca[i] = pg8::silu_f(c); }
      __syncthreads();
      float* MOD = (float*)(ws + WS_MOD);
      for (int it = F.vcu; it < DEPTH * 144; it += F.G) {
          const int l = it / 144, n = (it % 144) * 64 + F.lane; const float* wp = w_ada + ((size_t)l * 1024 + F.wave * 128) * 9216 + n;
          float acc[NSEQ];
#pragma unroll
          for (int s = 0; s < NSEQ; ++s) acc[s] = 0.f;
#pragma unroll 4
          for (int k = 0; k < 128; ++k) { const float w = wp[(size_t)k * 9216];
#pragma unroll
              for (int s = 0; s < NSEQ; ++s) acc[s] += ca[s * 1024 + F.wave * 128 + k] * w; }
#pragma unroll
          for (int s = 0; s < NSEQ; ++s) red[(F.wave * NSEQ + s) * 64 + F.lane] = acc[s];
          __syncthreads();
          for (int i = F.tid; i < NSEQ * 64; i += NWAVES * 64) { const int s = i >> 6, c = i & 63; float v = 0.f;
#pragma unroll
              for (int w = 0; w < 8; ++w) v += red[(w * NSEQ + s) * 64 + c];
              const int nn = (it % 144) * 64 + c; MOD[((size_t)l * NSEQ + s) * 9216 + nn] = v + b_ada[(size_t)l * 9216 + nn]; }
          __syncthreads();
      } }
    if (F.vcu == 0) { float* LB = (float*)(ws + WS_LB); const float* lb_logits = karg(A_LBL);
        for (int c = F.tid; c < 1024; c += NWAVES * 64) { float lg[4], mx = -INFINITY;
#pragma unroll
            for (int l = 0; l < 4; ++l) { lg[l] = lb_logits[l * 1024 + c]; mx = __builtin_fmaxf(mx, lg[l]); }
            float sum = 0.f;
#pragma unroll
            for (int l = 0; l < 4; ++l) { lg[l] = __expf(lg[l] - mx); sum += lg[l]; }
            const float inv = 1.f / sum; float cs = 0.f;
#pragma unroll
            for (int l = 0; l < 4; ++l) { cs += lg[l] * inv; LB[l * 1024 + c] = cs - lg[0] * inv; } } }
}

#ifndef NRF
#define NRF 2
#endif
__device__ __forceinline__ float bfu(unsigned b) { return __builtin_bit_cast(float, b << 16); }
__device__ __forceinline__ void norm_phase(Frame& F, const void* X, bool xf32, const float* g, const float* mod_l, int sub, bf16* XN, int row0, int row1, int gw, int NGW) {
    const int RW = (row1 - row0) / NGW, rbeg = row0 + gw * RW;
    const float* mp = mod_l + (size_t)pg8::row_seq(rbeg) * 9216 + sub * 3 * 1024;
    f32x4 av[4], bv[4];
#pragma unroll
    for (int j = 0; j < 4; ++j) { const int c = 4 * F.lane + 256 * j; const f32x4 gg = *(const f32x4*)(g + c), sc = *(const f32x4*)(mp + 1024 + c); bv[j] = *(const f32x4*)(mp + c); av[j] = gg * (sc + 1.f); }
    for (int i = 0; i < RW; i += NRF) {
        const int row = rbeg + i;
        f32x4 v[NRF][4]; float s2[NRF];
#pragma unroll
        for (int u = 0; u < NRF; ++u) s2[u] = 0.f;
        if (xf32) { const f32x4* xr = (const f32x4*)((const float*)X + (size_t)row * DM) + F.lane;
#pragma unroll
            for (int u = 0; u < NRF; ++u)
#pragma unroll
                for (int j = 0; j < 4; ++j) v[u][j] = xr[u * 256 + 64 * j];
        } else { const v2u* xr = (const v2u*)((const bf16*)X + (size_t)row * DM) + F.lane; v2u t[NRF][4];
#pragma unroll
            for (int u = 0; u < NRF; ++u)
#pragma unroll
                for (int j = 0; j < 4; ++j) t[u][j] = xr[u * 256 + 64 * j];
#pragma unroll
            for (int u = 0; u < NRF; ++u)
#pragma unroll
                for (int j = 0; j < 4; ++j) { v[u][j].x = bfu(t[u][j].x & 0xffffu); v[u][j].y = bfu(t[u][j].x >> 16); v[u][j].z = bfu(t[u][j].y & 0xffffu); v[u][j].w = bfu(t[u][j].y >> 16); } }
#pragma unroll
        for (int u = 0; u < NRF; ++u)
#pragma unroll
            for (int j = 0; j < 4; ++j) s2[u] += (v[u][j].x * v[u][j].x + v[u][j].y * v[u][j].y) + (v[u][j].z * v[u][j].z + v[u][j].w * v[u][j].w);
#pragma unroll
        for (int u = 0; u < NRF; ++u) { const float rstd = __builtin_amdgcn_rsqf(wave_sum(s2[u], F.lane) * (1.f / DM) + EPS);
            v2u* o8 = (v2u*)(XN + (size_t)(row + u) * DM) + F.lane;
#pragma unroll
            for (int j = 0; j < 4; ++j) { const f32x4 h = (v[u][j] * rstd) * av[j] + bv[j]; v2u o; o.x = cvtpk(h.x, h.y); o.y = cvtpk(h.z, h.w); o8[64 * j] = o; } }
    }
}
__device__ __forceinline__ void final_norm_phase(Frame& F, const bf16* X, const float* g, float* out) {
    const int gw = F.vcu * NWAVES + F.wave, NGW = F.G * NWAVES;
    for (int row = gw; row < MROWS; row += NGW) {
        const v2u* xr = (const v2u*)(X + (size_t)row * DM) + F.lane; f32x4 v[4]; float s2 = 0.f;
#pragma unroll
        for (int j = 0; j < 4; ++j) { const v2u t = xr[64 * j]; v[j].x = bfu(t.x & 0xffffu); v[j].y = bfu(t.x >> 16); v[j].z = bfu(t.y & 0xffffu); v[j].w = bfu(t.y >> 16); s2 += (v[j].x * v[j].x + v[j].y * v[j].y) + (v[j].z * v[j].z + v[j].w * v[j].w); }
        const float rstd = __builtin_amdgcn_rsqf(wave_sum(s2, F.lane) * (1.f / DM) + EPS);
        f32x4* o = (f32x4*)(out + (row < MP ? OY_P + (size_t)row * DM : OY_S + (size_t)(row - MP) * DM)) + F.lane;
#pragma unroll
        for (int j = 0; j < 4; ++j) { const f32x4 gg = *(const f32x4*)(g + 4 * F.lane + 256 * j); o[64 * j] = (v[j] * rstd) * gg; }
    }
}
__device__ __forceinline__ float lam_of(const float* att_lambda, int l, int lane) {
    const float* lp = att_lambda + (size_t)l * 256;
    const float a = wave_sum(lp[lane] * lp[64 + lane], lane), b = wave_sum(lp[128 + lane] * lp[192 + lane], lane);
    return __expf(a) - __expf(b) + lam_init_of(l);
}
__device__ __forceinline__ void attn_combine_phase(Frame& F, const bf16* O1, const bf16* O2, const float* gsub, float lam, float osc, bf16* OATT) {
    const int gw = F.vcu * NWAVES + F.wave, NGW = F.G * NWAVES; const int cl = (F.lane & 7) * 16;
    float gv[16];
#pragma unroll
    for (int i = 0; i < 16; ++i) gv[i] = gsub[cl + i] * osc;
    for (int row = gw; row < MP; row += 2 * NGW) {
        v4u a0[2], a1[2], b0[2], b1[2];
#pragma unroll
        for (int u = 0; u < 2; ++u) { const size_t off = (size_t)(row + u * NGW) * DM + F.lane * 16; a0[u] = *(const v4u*)(O1 + off); a1[u] = *(const v4u*)(O1 + off + 8); b0[u] = *(const v4u*)(O2 + off); b1[u] = *(const v4u*)(O2 + off + 8); }
#pragma unroll
        for (int u = 0; u < 2; ++u) { const size_t off = (size_t)(row + u * NGW) * DM + F.lane * 16;
            const unsigned aw[8] = {a0[u].x, a0[u].y, a0[u].z, a0[u].w, a1[u].x, a1[u].y, a1[u].z, a1[u].w}, bw[8] = {b0[u].x, b0[u].y, b0[u].z, b0[u].w, b1[u].x, b1[u].y, b1[u].z, b1[u].w};
            float o[16]; float ss = 0.f;
#pragma unroll
            for (int i = 0; i < 8; ++i) { o[2 * i] = pg8::bf_lo(aw[i]) - lam * pg8::bf_lo(bw[i]); o[2 * i + 1] = pg8::bf_hi(aw[i]) - lam * pg8::bf_hi(bw[i]); ss += o[2 * i] * o[2 * i] + o[2 * i + 1] * o[2 * i + 1]; }
            ss += shx(ss, 1, F.lane); ss += shx(ss, 2, F.lane); ss += shx(ss, 4, F.lane);
            const float rstd = __builtin_amdgcn_rsqf(ss * (1.f / 128.f) + EPS);
            v4u w0, w1;
            w0.x = cvtpk(o[0] * rstd * gv[0], o[1] * rstd * gv[1]); w0.y = cvtpk(o[2] * rstd * gv[2], o[3] * rstd * gv[3]); w0.z = cvtpk(o[4] * rstd * gv[4], o[5] * rstd * gv[5]); w0.w = cvtpk(o[6] * rstd * gv[6], o[7] * rstd * gv[7]);
            w1.x = cvtpk(o[8] * rstd * gv[8], o[9] * rstd * gv[9]); w1.y = cvtpk(o[10] * rstd * gv[10], o[11] * rstd * gv[11]); w1.z = cvtpk(o[12] * rstd * gv[12], o[13] * rstd * gv[13]); w1.w = cvtpk(o[14] * rstd * gv[14], o[15] * rstd * gv[15]);
            *(v4u*)(OATT + off) = w0; *(v4u*)(OATT + off + 8) = w1; }
    }
}

__device__ __forceinline__ void attn_sample_unit(Frame& F, const float* cache_k, const float* cache_v, int l, int s, int head, const bf16* Qb, const bf16* Kb, const bf16* Vb, float lam, float osc, const float* gsub, bf16* OATT) {
    const int lane = F.lane, w = F.wave, q = lane & 31, hh = lane >> 5, vt = w & 3, kh = w >> 2;
    LAS float* SLOT = (LAS float*)(F.lds);
    LAS float* ML = (LAS float*)(F.lds + 16384);
    LAS float* SSQ = (LAS float*)(F.lds + 16384 + 512);
    const size_t qrow = (size_t)MP + (size_t)s * 32;
    const float* ck = cache_k + ((size_t)(l * 16 + s) * PAST) * 1024 + head * 128;
    const float* cv = cache_v + ((size_t)(l * 16 + s) * PAST) * 1024 + head * 128;
    f32x16 o1;
#pragma unroll
    for (int r = 0; r < 16; ++r) o1[r] = 0.f;
    for (int m = 0; m < 2; ++m) {
        bf16x8 qf[4];
#pragma unroll
        for (int ks = 0; ks < 4; ++ks) qf[ks] = *(const bf16x8*)(Qb + (qrow + q) * 1024 + head * 128 + m * 64 + ks * 16 + 8 * hh);
        float mrun = -INFINITY, lrun = 0.f; f32x16 ot;
#pragma unroll
        for (int r = 0; r < 16; ++r) ot[r] = 0.f;
        const int ntile = 32 + kh;
        f32x4 kraw[8]; float vraw[16];
#define SA_ISSUE(tt) do { const int k0_ = kh * 1024 + (tt) * 32; const float* kp = ck + (size_t)(k0_ + q) * 1024 + m * 64 + 8 * hh; const float* vp = cv + (size_t)(k0_ + 4 * hh) * 1024 + 32 * vt + q; \
            _Pragma("unroll") for (int ks = 0; ks < 4; ++ks) { kraw[2 * ks] = *(const f32x4*)(kp + ks * 16); kraw[2 * ks + 1] = *(const f32x4*)(kp + ks * 16 + 4); } \
            _Pragma("unroll") for (int s2 = 0; s2 < 2; ++s2) _Pragma("unroll") for (int j = 0; j < 8; ++j) vraw[s2 * 8 + j] = vp[(16 * s2 + 8 * (j >> 2) + (j & 3)) * 1024]; } while (0)
        SA_ISSUE(0);
        for (int t = 0; t < ntile; ++t) {
            const bool nw = (t == 32);
            bf16x8 kf[4]; bf16x8 awv[2];
            if (!nw) {
#pragma unroll
                for (int ks = 0; ks < 4; ++ks) kf[ks] = pack8(kraw[2 * ks], kraw[2 * ks + 1]);
#pragma unroll
                for (int s2 = 0; s2 < 2; ++s2) { v4u aw; aw.x = cvtpk(vraw[s2 * 8 + 0], vraw[s2 * 8 + 1]); aw.y = cvtpk(vraw[s2 * 8 + 2], vraw[s2 * 8 + 3]); aw.z = cvtpk(vraw[s2 * 8 + 4], vraw[s2 * 8 + 5]); aw.w = cvtpk(vraw[s2 * 8 + 6], vraw[s2 * 8 + 7]); awv[s2] = __builtin_bit_cast(bf16x8, aw); }
                asm volatile("" ::: "memory");
                if (t + 1 < 32) SA_ISSUE(t + 1);
                asm volatile("" ::: "memory");
            } else {
#pragma unroll
                for (int ks = 0; ks < 4; ++ks) kf[ks] = *(const bf16x8*)(Kb + (qrow + q) * 1024 + head * 128 + m * 64 + ks * 16 + 8 * hh);
                const bf16* vpn = Vb + (qrow + 4 * hh) * 1024 + head * 128 + 32 * vt + q;
#pragma unroll
                for (int s2 = 0; s2 < 2; ++s2) { float vf[8];
#pragma unroll
                    for (int j = 0; j < 8; ++j) vf[j] = bf2f(vpn[(16 * s2 + 8 * (j >> 2) + (j & 3)) * 1024]);
                    v4u aw; aw.x = cvtpk(vf[0], vf[1]); aw.y = cvtpk(vf[2], vf[3]); aw.z = cvtpk(vf[4], vf[5]); aw.w = cvtpk(vf[6], vf[7]); awv[s2] = __builtin_bit_cast(bf16x8, aw); }
            }
            f32x16 st;
#pragma unroll
            for (int r = 0; r < 16; ++r) st[r] = 0.f;
#pragma unroll
            for (int ks = 0; ks < 4; ++ks) st = __builtin_amdgcn_mfma_f32_32x32x16_bf16(kf[ks], qf[ks], st, 0, 0, 0);
            float tm = st[0];
#pragma unroll
            for (int r = 1; r < 16; ++r) tm = __builtin_fmaxf(tm, st[r]);
            tm = __builtin_fmaxf(tm, shx(tm, 32, lane));
            const float mnew = __builtin_fmaxf(mrun, tm), alpha = __builtin_amdgcn_exp2f(mrun - mnew);
            float ls = 0.f;
#pragma unroll
            for (int r = 0; r < 16; ++r) { st[r] = __builtin_amdgcn_exp2f(st[r] - mnew); ls += st[r]; }
            ls += shx(ls, 32, lane);
            lrun = lrun * alpha + ls; mrun = mnew;
#pragma unroll
            for (int r = 0; r < 16; ++r) ot[r] *= alpha;
#pragma unroll
            for (int s2 = 0; s2 < 2; ++s2) { v4u pw; pw.x = cvtpk(st[8 * s2], st[8 * s2 + 1]); pw.y = cvtpk(st[8 * s2 + 2], st[8 * s2 + 3]); pw.z = cvtpk(st[8 * s2 + 4], st[8 * s2 + 5]); pw.w = cvtpk(st[8 * s2 + 6], st[8 * s2 + 7]);
                ot = __builtin_amdgcn_mfma_f32_32x32x16_bf16(awv[s2], __builtin_bit_cast(bf16x8, pw), ot, 0, 0, 0); }
        }
#undef SA_ISSUE
        if (vt == 0 && hh == 0) { ML[(kh * 32 + q) * 2] = mrun; ML[(kh * 32 + q) * 2 + 1] = lrun; }
        __syncthreads();
        const float m0 = ML[q * 2], l0 = ML[q * 2 + 1], m1 = ML[(32 + q) * 2], l1 = ML[(32 + q) * 2 + 1];
        const float Mx = __builtin_fmaxf(m0, m1), L = l0 * __builtin_amdgcn_exp2f(m0 - Mx) + l1 * __builtin_amdgcn_exp2f(m1 - Mx);
        { const float sc = __builtin_amdgcn_exp2f(mrun - Mx);
#pragma unroll
          for (int r = 0; r < 16; ++r) ot[r] *= sc; }
        if (kh == 1) {
#pragma unroll
            for (int r = 0; r < 16; ++r) SLOT[(vt * 16 + r) * 64 + lane] = ot[r]; }
        __syncthreads();
        if (kh == 0) { const float rl = 1.f / L;
#pragma unroll
            for (int r = 0; r < 16; ++r) ot[r] = (ot[r] + SLOT[(vt * 16 + r) * 64 + lane]) * rl;
            if (m == 0) {
#pragma unroll
                for (int r = 0; r < 16; ++r) o1[r] = ot[r];
            } else { float ss = 0.f;
#pragma unroll
                for (int r = 0; r < 16; ++r) { o1[r] = o1[r] - lam * ot[r]; ss += o1[r] * o1[r]; }
                ss += shx(ss, 32, lane);
                if (hh == 0) SSQ[vt * 32 + q] = ss; } }
        __syncthreads();
    }
    if (kh == 0) {
        const float ss = SSQ[q] + SSQ[32 + q] + SSQ[64 + q] + SSQ[96 + q];
        const float rstd = __builtin_amdgcn_rsqf(ss * (1.f / 128.f) + EPS) * osc;
#pragma unroll
        for (int r = 0; r < 16; ++r) { const int v = 32 * vt + (r & 3) + 8 * (r >> 2) + 4 * hh; OATT[(qrow + q) * 1024 + head * 128 + v] = (bf16)f2bf(o1[r] * rstd * gsub[v]); }
    }
    __syncthreads();
}

constexpr int HS = 72, HK = 136;
__device__ __forceinline__ f32x4 mfma16(bf16x8 a, bf16x8 b, f32x4 c) { return __builtin_amdgcn_mfma_f32_16x16x32_bf16(a, b, c, 0, 0, 0); }
__device__ __forceinline__ void st16bf(LAS bf16* p, const float (&v)[16]) {
    v4u a, b; a.x = cvtpk(v[0], v[1]); a.y = cvtpk(v[2], v[3]); a.z = cvtpk(v[4], v[5]); a.w = cvtpk(v[6], v[7]); b.x = cvtpk(v[8], v[9]); b.y = cvtpk(v[10], v[11]); b.z = cvtpk(v[12], v[13]); b.w = cvtpk(v[14], v[15]);
    *(LAS v4u*)p = a; *(LAS v4u*)(p + 8) = b;
}
struct HgPtrs { const float* LOGF; const bf16 *QQ, *KK, *VV, *HGS; const float* ghg; bf16* OH; bf16* dump; };
typedef float f32x2v __attribute__((ext_vector_type(2)));
__device__ __forceinline__ void hg_load(const HgPtrs& P, size_t ubase  , unsigned k0, int w, int nvalid, unsigned (&qv)[8], unsigned (&kv)[8], unsigned (&vv)[8]) {
    if (w * 8 < nvalid) {
#pragma unroll
        for (int i = 0; i < 8; ++i) { const size_t o = ubase + (size_t)(w * 8 + i) * 1024;
            const bf16* qp = P.QQ + o; const bf16* kp = P.KK + o; const bf16* vp = P.VV + o;
            qv[i] = *(const unsigned*)(qp + k0); kv[i] = *(const unsigned*)(kp + k0); vv[i] = *(const unsigned*)(vp + k0); }
    } else {
#pragma unroll
        for (int i = 0; i < 8; ++i) { qv[i] = 0u; kv[i] = 0u; vv[i] = 0u; }
    }
}
#define HG_BAR() asm volatile("s_waitcnt lgkmcnt(0)\n\ts_barrier" ::: "memory")
template <int MODE> __device__ __forceinline__ void hg_sequence(Frame& F, const HgPtrs& P, size_t row0, int h, int nchunk, int nvalid, const float* s_in, float* s_out, bf16* QS, float* RAW, float* dseg) {
    LAS float* seg = (LAS float*)(F.lds);
    LAS float* part = (LAS float*)(F.lds + 4096);
    LAS float* dvec = (LAS float*)(F.lds + 6144);
    LAS bf16* QH = (LAS bf16*)(F.lds + 8192);
    LAS bf16* QT = QH + 64 * HK;
    LAS bf16* KH = QT + 64 * HK;
    LAS bf16* VT = KH + 160 * HK;
    LAS bf16* KT = VT + 128 * HS;
    LAS bf16* AL = KT + 128 * HS;
    const int w = __builtin_amdgcn_readfirstlane(F.wave), sc = w >> 1, lr_ = F.lane & 15, lq_ = F.lane >> 4; const unsigned k0_ = 2u * (unsigned)F.lane;
    f32x4 S[8];
#pragma unroll
    for (int kb = 0; kb < 8; ++kb)
#pragma unroll
        for (int r = 0; r < 4; ++r) S[kb][r] = s_in ? s_in[(size_t)(16 * kb + 4 * lq_ + r) * 128 + 16 * w + lr_] : 0.f;
    const float gv = P.ghg[16 * w + lr_];
    f32x2v bseg = {0.f, 0.f};
#ifdef PROBE_HSEC
    unsigned long long tacc = 0, tq0 = 0;
#define HT0(id) do { if (PROBE_HSEC == (id)) tq0 = __builtin_amdgcn_s_memrealtime(); } while (0)
#define HT1(id) do { if (PROBE_HSEC == (id)) tacc += __builtin_amdgcn_s_memrealtime() - tq0; } while (0)
#else
#define HT0(id) do {} while (0)
#define HT1(id) do {} while (0)
#endif
    unsigned qv[8], kv[8], vv[8];
    hg_load(P, row0 * 1024 + h * 128, k0_, w, nvalid, qv, kv, vv);
    for (int c = 0; c < nchunk; ++c) {
        int lr = lr_, lq = lq_; unsigned k0 = k0_; asm volatile("" : "+v"(lr), "+v"(lq), "+v"(k0));
        const int lx = lq * 16 + lr;
        const size_t crow = row0 + (size_t)c * 64;
        HT0(1);
        f32x2v cs[8]; { f32x2v run = {0.f, 0.f};
#pragma unroll
            for (int i = 0; i < 8; ++i) { f32x2v lfi; lfi.x = __logf(__builtin_fmaxf(1.f - bfu(kv[i] & 0xffffu), 9.765625e-4f)); lfi.y = __logf(__builtin_fmaxf(1.f - bfu(kv[i] >> 16), 9.765625e-4f));
                run = run + lfi; cs[i] = run; }
            *(LAS f32x2v*)(seg + w * 128 + k0) = run; }
        HG_BAR();
        f32x2v P2[4], mypre = {0.f, 0.f}, tot; { f32x2v p = {0.f, 0.f};
#pragma unroll
            for (int s = 0; s < 8; ++s) { if ((s & 1) == 0) P2[s >> 1] = p; mypre = (s == w) ? p : mypre; p = p + *(const LAS f32x2v*)(seg + s * 128 + k0); } tot = p; }
        f32x2v myref = P2[0], nref = P2[1];
#pragma unroll
        for (int s = 1; s < 4; ++s) { myref = (s == sc) ? P2[s] : myref; nref = (s == sc) ? (s == 3 ? tot : P2[s < 3 ? s + 1 : 3]) : nref; }
        const f32x2v dq = mypre - myref;
        f32x2v fq, fT, fK[4]; fq.x = __expf(myref.x); fq.y = __expf(myref.y); fT.x = __expf(tot.x - nref.x); fT.y = __expf(tot.y - nref.y);
#pragma unroll
        for (int ii = 1; ii < 4; ++ii) { fK[ii].x = __expf(__builtin_fminf(P2[ii].x - nref.x, 0.f)); fK[ii].y = __expf(__builtin_fminf(P2[ii].y - nref.y, 0.f)); }
        f32x2v fqs = fq; if constexpr (MODE == 1) { fqs.x = fq.x * __expf(bseg.x); fqs.y = fq.y * __expf(bseg.y); bseg = bseg + tot; }
        float t0[8], t1[8];
#pragma unroll
        for (int i = 0; i < 8; ++i) { const int r = w * 8 + i; const float q0 = bfu(qv[i] & 0xffffu), q1 = bfu(qv[i] >> 16), a0 = bfu(kv[i] & 0xffffu), a1 = bfu(kv[i] >> 16);
            const float E0 = dq.x + cs[i].x, E1 = dq.y + cs[i].y;
            const float e1x = __expf(E0), e1y = __expf(E1);
            const float e2x = __builtin_fminf(__builtin_amdgcn_rcpf(e1x), 5.5e34f), e2y = __builtin_fminf(__builtin_amdgcn_rcpf(e1y), 5.5e34f);
            const float e3x = __expf((nref.x - myref.x) - E0), e3y = __expf((nref.y - myref.y) - E1);
            *(LAS unsigned*)(QH + r * HK + k0) = cvtpk(q0 * e1x, q1 * e1y);
            *(LAS unsigned*)(QT + r * HK + k0) = cvtpk(q0 * e1x * fq.x, q1 * e1y * fq.y);
            if constexpr (MODE == 1) { bf16* qsp = QS + (crow + r) * 1024 + h * 128; *(unsigned*)(qsp + k0) = cvtpk(q0 * e1x * fqs.x, q1 * e1y * fqs.y); }
            const float b0 = a0 * e3x, b1 = a1 * e3y;
            { const int rb = (sc == 0) ? 0 : (sc == 1) ? 16 : (sc == 2) ? 48 : 96; *(LAS unsigned*)(KH + (rb + r) * HK + k0) = cvtpk(a0 * e2x, a1 * e2y); }
#pragma unroll
            for (int ii = 1; ii < 4; ++ii) if (ii > sc) { const int rb = (ii == 1) ? 16 : (ii == 2) ? 48 : 96; *(LAS unsigned*)(KH + (rb + r) * HK + k0) = cvtpk(b0 * fK[ii].x, b1 * fK[ii].y); }
            t0[i] = b0 * fT.x; t1[i] = b1 * fT.y; }
        { v4u u0, u1; u0.x = cvtpk(t0[0], t0[1]); u0.y = cvtpk(t0[2], t0[3]); u0.z = cvtpk(t0[4], t0[5]); u0.w = cvtpk(t0[6], t0[7]); u1.x = cvtpk(t1[0], t1[1]); u1.y = cvtpk(t1[2], t1[3]); u1.z = cvtpk(t1[4], t1[5]); u1.w = cvtpk(t1[6], t1[7]);
          *(LAS v4u*)(KT + k0 * HS + 8 * w) = u0; *(LAS v4u*)(KT + (k0 + 1) * HS + 8 * w) = u1; }
        { v4u u0, u1;
          u0.x = (vv[0] & 0xffffu) | (vv[1] << 16); u0.y = (vv[2] & 0xffffu) | (vv[3] << 16); u0.z = (vv[4] & 0xffffu) | (vv[5] << 16); u0.w = (vv[6] & 0xffffu) | (vv[7] << 16);
          u1.x = (vv[0] >> 16) | (vv[1] & 0xffff0000u); u1.y = (vv[2] >> 16) | (vv[3] & 0xffff0000u); u1.z = (vv[4] >> 16) | (vv[5] & 0xffff0000u); u1.w = (vv[6] >> 16) | (vv[7] & 0xffff0000u);
          *(LAS v4u*)(VT + k0 * HS + 8 * w) = u0; *(LAS v4u*)(VT + (k0 + 1) * HS + 8 * w) = u1;
          if (w == 0) { f32x2v d; d.x = __expf(tot.x); d.y = __expf(tot.y); *(LAS f32x2v*)(dvec + k0) = d; } }
        HG_BAR();
        HT1(1); HT0(2);
        if (c + 1 < nchunk) hg_load(P, (crow + 64) * 1024 + h * 128, k0, w, nvalid, qv, kv, vv);
        unsigned short hgv[16];
        if constexpr (MODE == 0) { const bf16* hp = P.HGS + crow * 1024 + h * 128 + 16 * w;
#pragma unroll
          for (int mt = 0; mt < 4; ++mt)
#pragma unroll
              for (int r = 0; r < 4; ++r) { int t = 16 * mt + 4 * lq + r; t = t < nvalid ? t : nvalid - 1; hgv[mt * 4 + r] = hp[(unsigned)(t * 1024 + lr)]; } }
#pragma unroll
        for (int rr = 0; rr < 2; ++rr) { const int blk = w + 8 * rr, bi = blk >> 2, bj = blk & 3;
            f32x4 acc = {0.f, 0.f, 0.f, 0.f};
            if (bj <= bi) { const int rb = (bi == 0) ? 0 : (bi == 1) ? 16 : (bi == 2) ? 48 : 96;
#pragma unroll
                for (int ks = 0; ks < 4; ++ks) { const bf16x8 a = *(const LAS bf16x8*)(QH + (16 * bi + lr) * HK + ks * 32 + 8 * lq), b = *(const LAS bf16x8*)(KH + (rb + 16 * bj + lr) * HK + ks * 32 + 8 * lq); acc = mfma16(a, b, acc); }
                if (bi == bj) {
#pragma unroll
                    for (int r = 0; r < 4; ++r) acc[r] = (lr <= 4 * lq + r) ? acc[r] : 0.f; } }
#pragma unroll
            for (int r = 0; r < 4; ++r) AL[(16 * bi + 4 * lq + r) * HS + 16 * bj + lr] = (bf16)f2bf(acc[r]); }
        HG_BAR();
        HT1(2); HT0(3);
        f32x4 o[4];
        { bf16x8 bS[4], bV[2];
#pragma unroll
          for (int kp = 0; kp < 4; ++kp) { v4u t; t.x = cvtpk(S[2 * kp][0], S[2 * kp][1]); t.y = cvtpk(S[2 * kp][2], S[2 * kp][3]); t.z = cvtpk(S[2 * kp + 1][0], S[2 * kp + 1][1]); t.w = cvtpk(S[2 * kp + 1][2], S[2 * kp + 1][3]); bS[kp] = __builtin_bit_cast(bf16x8, t); }
#pragma unroll
          for (int ks = 0; ks < 2; ++ks) bV[ks] = *(const LAS bf16x8*)(VT + (16 * w + lr) * HS + ks * 32 + 8 * lq);
#pragma unroll
          for (int mt = 0; mt < 4; ++mt) { f32x4 acc = {0.f, 0.f, 0.f, 0.f};
#pragma unroll
              for (int kp = 0; kp < 4; ++kp) { const LAS bf16* qp = QT + (16 * mt + lr) * HK + 32 * kp + 4 * lq; const v2u a0 = *(const LAS v2u*)qp, a1 = *(const LAS v2u*)(qp + 16);
                  v4u a; a.x = a0.x; a.y = a0.y; a.z = a1.x; a.w = a1.y; acc = mfma16(__builtin_bit_cast(bf16x8, a), bS[kp], acc); }
#pragma unroll
              for (int ks = 0; ks < 2; ++ks) acc = mfma16(*(const LAS bf16x8*)(AL + (16 * mt + lr) * HS + ks * 32 + 8 * lq), bV[ks], acc);
              o[mt] = acc;
              if constexpr (MODE == 1) { float* rp = RAW + (crow + 16 * mt) * 1024 + h * 128 + 16 * w;
#pragma unroll
                  for (int r = 0; r < 4; ++r) rp[(unsigned)((4 * lq + r) * 1024 + lr)] = acc[r]; }
              if constexpr (MODE == 0)
#pragma unroll
              for (int r = 0; r < 4; ++r) { float p = acc[r] * acc[r]; p += shx(p, 1, lx); p += shx(p, 2, lx); p += shx(p, 4, lx); p += shx(p, 8, lx); if (lr == 0) part[(16 * mt + 4 * lq + r) * 8 + w] = p; } } }
        { bf16x8 bV[2];
#pragma unroll
          for (int ks = 0; ks < 2; ++ks) bV[ks] = *(const LAS bf16x8*)(VT + (16 * w + lr) * HS + ks * 32 + 8 * lq);
#pragma unroll
          for (int kb = 0; kb < 8; ++kb) { const f32x4 d = *(const LAS f32x4*)(dvec + 16 * kb + 4 * lq); f32x4 acc = S[kb] * d;
#pragma unroll
              for (int ks = 0; ks < 2; ++ks) acc = mfma16(*(const LAS bf16x8*)(KT + (16 * kb + lr) * HS + ks * 32 + 8 * lq), bV[ks], acc);
              S[kb] = acc; } }
        if constexpr (MODE == 0) {
        HG_BAR();
        { bf16* op = P.OH + crow * 1024 + h * 128 + 16 * w;
#pragma unroll
          for (int mt = 0; mt < 4; ++mt)
#pragma unroll
              for (int r = 0; r < 4; ++r) { const int t = 16 * mt + 4 * lq + r; const f32x4 p0 = *(const LAS f32x4*)(part + t * 8), p1 = *(const LAS f32x4*)(part + t * 8 + 4);
                  const float ss = ((p0[0] + p0[1]) + (p0[2] + p0[3])) + ((p1[0] + p1[1]) + (p1[2] + p1[3]));
                  const float rstd = __builtin_amdgcn_rsqf(ss * (1.f / 128.f) + EPS);
                  const bf16 ov = (bf16)f2bf(o[mt][r] * rstd * gv * bf2f(hgv[mt * 4 + r]));
                  bf16* dst = (t < nvalid) ? op + (unsigned)(t * 1024 + lr) : P.dump + F.tid;
                  *dst = ov; } }
        }
        HG_BAR();
        HT1(3);
    }
#pragma unroll
    for (int kb = 0; kb < 8; ++kb)
#pragma unroll
        for (int r = 0; r < 4; ++r) s_out[(size_t)(16 * kb + 4 * lq_ + r) * 128 + 16 * w + lr_] = S[kb][r];
    if constexpr (MODE == 1) { if (w == 0) { f32x2v d; d.x = __expf(bseg.x); d.y = __expf(bseg.y); *(f32x2v*)(dseg + k0_) = d; } }
#ifdef PROBE_HSEC
    if constexpr (MODE == 1) { if (row0 == 0 && h == 0) { const unsigned long long t1 = __builtin_amdgcn_s_memrealtime(); while (__builtin_amdgcn_s_memrealtime() - t1 < 20ull * tacc) __builtin_amdgcn_s_sleep(8); } }
#endif
#undef HT0
#undef HT1
}

__device__ __forceinline__ void hg_fix(Frame& F, const HgPtrs& P, size_t row0, int h, int nchunk, int g, int G, const float* SLseq, const float* DSseq, const bf16* QS, const float* RAW, gu32* mask, float* s_fin) {
    LAS float* part = (LAS float*)(F.lds);
    const int w = __builtin_amdgcn_readfirstlane(F.wave), lr_ = F.lane & 15, lq_ = F.lane >> 4;
    if (F.tid == 0) { const unsigned need = (1u << g) - 1u; unsigned sp = 0;
        while ((__hip_atomic_load(mask, RLX_AGENT) & need) != need) { __builtin_amdgcn_s_sleep(2); if (++sp > (1u << 22)) { __hip_atomic_store(F.ctl + 1, 0x7eb0u, RLX_AGENT); break; } }
        __builtin_amdgcn_fence(__ATOMIC_ACQUIRE, "agent"); asm volatile("s_waitcnt vmcnt(0)" ::: "memory"); }
    __syncthreads();
    f32x4 S[8];
#pragma unroll
    for (int kb = 0; kb < 8; ++kb) S[kb] = (f32x4){0.f, 0.f, 0.f, 0.f};
    for (int p = 0; p < g; ++p) { const float* sl = SLseq + (size_t)p * 16384; const float* ds = DSseq + p * 128;
#pragma unroll
        for (int kb = 0; kb < 8; ++kb) { const f32x4 d = *(const f32x4*)(ds + 16 * kb + 4 * lq_);
#pragma unroll
            for (int r = 0; r < 4; ++r) S[kb][r] = d[r] * S[kb][r] + sl[(size_t)(16 * kb + 4 * lq_ + r) * 128 + 16 * w + lr_]; } }
    if (g == G - 1) { const float* sl = SLseq + (size_t)g * 16384; const float* ds = DSseq + g * 128;
#pragma unroll
        for (int kb = 0; kb < 8; ++kb) { const f32x4 d = *(const f32x4*)(ds + 16 * kb + 4 * lq_);
#pragma unroll
            for (int r = 0; r < 4; ++r) { const size_t o = (size_t)(16 * kb + 4 * lq_ + r) * 128 + 16 * w + lr_; s_fin[o] = d[r] * S[kb][r] + sl[o]; } } }
    bf16x8 bS[4];
#pragma unroll
    for (int kp = 0; kp < 4; ++kp) { v4u t; t.x = cvtpk(S[2 * kp][0], S[2 * kp][1]); t.y = cvtpk(S[2 * kp][2], S[2 * kp][3]); t.z = cvtpk(S[2 * kp + 1][0], S[2 * kp + 1][1]); t.w = cvtpk(S[2 * kp + 1][2], S[2 * kp + 1][3]); bS[kp] = __builtin_bit_cast(bf16x8, t); }
    const float gv = P.ghg[16 * w + lr_];
    f32x4 on[4]; unsigned short hn[16]; v2u qn[4][4][2];
#define HGF_LOAD(cc) do { const size_t cr_ = row0 + (size_t)(cc) * 64; const bf16* hp = P.HGS + cr_ * 1024 + h * 128 + 16 * w; const float* rp = RAW + cr_ * 1024 + h * 128 + 16 * w; \
        _Pragma("unroll") for (int mt = 0; mt < 4; ++mt) { \
            _Pragma("unroll") for (int r = 0; r < 4; ++r) { const unsigned off = (unsigned)((16 * mt + 4 * lq_ + r) * 1024 + lr_); on[mt][r] = rp[off]; hn[mt * 4 + r] = hp[off]; } \
            const bf16* qb = QS + (cr_ + 16 * mt) * 1024 + h * 128; \
            _Pragma("unroll") for (int kp = 0; kp < 4; ++kp) { const bf16* qp = qb + (unsigned)(lr_ * 1024 + 32 * kp + 4 * lq_); qn[mt][kp][0] = *(const v2u*)qp; qn[mt][kp][1] = *(const v2u*)(qp + 16); } } } while (0)
    HGF_LOAD(0);
    for (int c = 0; c < nchunk; ++c) {
        int lr = lr_, lq = lq_; asm volatile("" : "+v"(lr), "+v"(lq)); const int lx = lq * 16 + lr;
        const size_t crow = row0 + (size_t)c * 64;
        LAS float* pt = part + (c & 1) * 512;
        f32x4 o[4]; unsigned short hgv[16];
#pragma unroll
        for (int mt = 0; mt < 4; ++mt) { f32x4 acc = on[mt];
#pragma unroll
            for (int r = 0; r < 4; ++r) hgv[mt * 4 + r] = hn[mt * 4 + r];
#pragma unroll
            for (int kp = 0; kp < 4; ++kp) { v4u a; a.x = qn[mt][kp][0].x; a.y = qn[mt][kp][0].y; a.z = qn[mt][kp][1].x; a.w = qn[mt][kp][1].y; acc = mfma16(__builtin_bit_cast(bf16x8, a), bS[kp], acc); }
            o[mt] = acc; }
        asm volatile("" ::: "memory");
        if (c + 1 < nchunk) HGF_LOAD(c + 1);
        asm volatile("" ::: "memory");
#pragma unroll
        for (int mt = 0; mt < 4; ++mt)
#pragma unroll
            for (int r = 0; r < 4; ++r) { float p = o[mt][r] * o[mt][r]; p += shx(p, 1, lx); p += shx(p, 2, lx); p += shx(p, 4, lx); p += shx(p, 8, lx); if (lr == 0) pt[(16 * mt + 4 * lq + r) * 8 + w] = p; }
        HG_BAR();
        { bf16* op = P.OH + crow * 1024 + h * 128 + 16 * w;
#pragma unroll
          for (int mt = 0; mt < 4; ++mt)
#pragma unroll
              for (int r = 0; r < 4; ++r) { const int t = 16 * mt + 4 * lq + r; const f32x4 p0 = *(const LAS f32x4*)(pt + t * 8), p1 = *(const LAS f32x4*)(pt + t * 8 + 4);
                  const float ss = ((p0[0] + p0[1]) + (p0[2] + p0[3])) + ((p1[0] + p1[1]) + (p1[2] + p1[3]));
                  const float rstd = __builtin_amdgcn_rsqf(ss * (1.f / 128.f) + EPS);
                  op[(unsigned)(t * 1024 + lr)] = (bf16)f2bf(o[mt][r] * rstd * gv * bf2f(hgv[mt * 4 + r])); } }
    }
#undef HGF_LOAD
    __syncthreads();
}
#undef HG_BAR
__device__ __forceinline__ void team_barrier(Frame& F, gu32* w, unsigned target) {
    asm volatile("s_waitcnt vmcnt(0)" ::: "memory");
    __syncthreads();
    if (F.tid == 0) {
        __builtin_amdgcn_fence(__ATOMIC_RELEASE, "agent");
        asm volatile("s_waitcnt vmcnt(0)" ::: "memory");
        (void)__hip_atomic_fetch_add(w, 1u, RLX_AGENT);
        unsigned sp = 0;
        while (__hip_atomic_load(w, RLX_AGENT) < target) { __builtin_amdgcn_s_sleep(2); if (++sp > (1u << 22)) { __hip_atomic_store(F.ctl + 1, 0x7ea0u, RLX_AGENT); break; } }
        __builtin_amdgcn_fence(__ATOMIC_ACQUIRE, "agent");
        asm volatile("s_waitcnt vmcnt(0)" ::: "memory");
    }
    __syncthreads();
}
__device__ __forceinline__ int attn_pull(Frame& F, gu32* q8  , int x0, int nitems) {
    if (F.tid == 0) {
        int res = -1;
        for (int tries = 0; tries < 16; ++tries) {
            unsigned c[8]; unsigned cmin = 0xffffffffu; int imin = 0;
#pragma unroll
            for (int h = 0; h < 8; ++h) { c[h] = __hip_atomic_load(q8 + 64 * h, RLX_AGENT); if (c[h] < cmin) { cmin = c[h]; imin = h; } }
            if (cmin >= (unsigned)nitems) break;
            unsigned cx = c[0];
#pragma unroll
            for (int h = 1; h < 8; ++h) cx = (h == x0) ? c[h] : cx;
            const int hsel = (cx < (unsigned)nitems && cx <= cmin + 6u) ? x0 : imin;
            const unsigned it = __hip_atomic_fetch_add(q8 + 64 * hsel, 1u, RLX_AGENT);
            if (it < (unsigned)nitems) { res = (hsel << 16) | (int)it; break; }
        }
        F.MISC[16] = (unsigned)res;
    }
    __syncthreads();
    const int v = (int)F.MISC[16];
    __syncthreads();
    return __builtin_amdgcn_readfirstlane(v);
}
__device__ __forceinline__ int wg_pull(Frame& F, gu32* ctr) {
    if (F.tid == 0) F.MISC[16] = __hip_atomic_fetch_add(ctr, 1u, RLX_AGENT);
    __syncthreads();
    const int v = (int)F.MISC[16];
    __syncthreads();
    return __builtin_amdgcn_readfirstlane(v);
}
#ifdef PROBE_ID
#define PT_BEGIN(id) unsigned long long pt0_##id = 0; if ((id) == PROBE_ID && blockIdx.x == 0) pt0_##id = __builtin_amdgcn_s_memrealtime()
#define PT_END(id) do { if ((id) == PROBE_ID && blockIdx.x == 0) { const unsigned long long t1 = __builtin_amdgcn_s_memrealtime(), d = t1 - pt0_##id; while (__builtin_amdgcn_s_memrealtime() - t1 < d) __builtin_amdgcn_s_sleep(8); } } while (0)
#else
#define PT_BEGIN(id) do {} while (0)
#define PT_END(id) do {} while (0)
#endif
struct Args { const float* in[25]; float* out; unsigned char* ws; };
__global__ void __launch_bounds__(NWAVES * 64, 2) mk_fwd(Args args) {
    extern __shared__ __attribute__((aligned(16))) unsigned char lds[];
    Frame F;
    F.lds = (LAS unsigned char*)lds;
    F.MISC = (volatile LAS unsigned*)(F.lds + MISC_OFF);
#define ENTER() do { F.tid = opaque_tid(); F.lane = F.tid & 63; F.wave = __builtin_amdgcn_readfirstlane(F.tid >> 6); F.G = gridDim.x; { const int bx = opaque_bid(); F.vcu = (F.G % 8 == 0) ? (bx % 8) * (F.G / 8) + bx / 8 : bx; } } while (0)
    for (int u = threadIdx.x; u < (LDS_BYTES - LDSCTL_OFF) / 4; u += NWAVES * 64) ((LAS unsigned*)(F.lds + LDSCTL_OFF))[u] = 0u;
    __syncthreads();
    tid_table_init();
    __syncthreads();
    static_assert(WTAB_LDS_ADDR == (unsigned)(MISC_OFF + 256) && MISC_OFF + 256 + 256 <= LDS_BYTES, "wave-slot table inside the LDS control area");
    ENTER();
    F.ctl = (gu32*)((unsigned char*)karg(A_WS) + WS_CTL);
    XcdBarrier bar = xcd_barrier_post((unsigned*)(F.ctl + CW_BAR), F.MISC + 8);
#define GRID_BAR() do { asm volatile("" : "+s"(bar.x)); xcd_barrier(bar); } while (0)
#define WSP(T, off) ((T*)((unsigned char*)karg(A_WS) + (off)))
#define OUTP(off) ((float*)karg(A_OUT) + (off))
#define XIN_P (l == 0 ? (const void*)karg(A_XP) : (const void*)WSP(const bf16, WS_X)), (l == 0)
#define XIN_S (l == 0 ? (const void*)(karg(A_XS) - (size_t)MP * DM) : (const void*)WSP(const bf16, WS_X)), (l == 0)

#ifndef NO_P0
    p0_prologue(F, WSP(unsigned char, 0));
#ifdef DUP_P0
    GRID_BAR(); ENTER(); p0_prologue(F, WSP(unsigned char, 0));
#endif
#endif
    GRID_BAR();

    for (int l = 0; l < DEPTH; ++l) {
        const size_t wlo = WS_W + (size_t)l * W_LAYER, modo = WS_MOD + (size_t)l * NSEQ * 9216 * 4;
        norm_phase(F, XIN_P, karg(A_GFFN1) + l * 1024, WSP(const float, modo), 0, WSP(bf16, WS_XN), 0, MP, F.vcu * NWAVES + F.wave, 256 * NWAVES);
#ifdef DUP_THIN
        GRID_BAR(); ENTER();
        norm_phase(F, XIN_P, karg(A_GFFN1) + l * 1024, WSP(const float, modo), 0, WSP(bf16, WS_XN), 0, MP, F.vcu * NWAVES + F.wave, 256 * NWAVES);
#endif
        GRID_BAR(); ENTER();
#ifndef NO_G1
        { pg8::Gemm g{WSP(bf16, WS_XN), WSP(const bf16, wlo + WO_GU1), MP, 2 * DFF, DM}; typedef pg8::FixedOrder<128, 22, 8> Ord; Ord S; S.init(F.G, opaque_bid());
          pg8::EpiSwiglu E{WSP(bf16, WS_BIG)};
          pg8::gemm_phase<pg8::EpiSwiglu, Ord, true, true>(F.lds + RING_OFF, g, S, E);
#ifdef DUP_G1
          GRID_BAR(); ENTER(); pg8::gemm_phase<pg8::EpiSwiglu, Ord, true, true>(F.lds + RING_OFF, g, S, E);
#endif
        }
#endif
        GRID_BAR(); ENTER();
#ifndef NO_G2
        { pg8::Gemm g{WSP(bf16, WS_BIG), WSP(const bf16, wlo + WO_D1), MP, DM, DFF}; typedef pg8::FixedOrder<128, 4, 8> Ord; Ord S; S.init(F.G, opaque_bid());
          pg8::EpiResid E{WSP(bf16, WS_X), WSP(const float, modo) + 2 * 1024, 0.5f, l == 0 ? 1 : 0};
          pg8::gemm_phase<pg8::EpiResid, Ord, true, true>(F.lds + RING_OFF, g, S, E);
#ifdef DUP_RES
          GRID_BAR(); ENTER(); { pg8::EpiResid E0{E.X, E.gate, 0.f, 0}; pg8::gemm_phase<pg8::EpiResid, Ord, true, true>(F.lds + RING_OFF, g, S, E0); }
#endif
        }
#endif
        GRID_BAR(); ENTER();
        norm_phase(F, WSP(const bf16, WS_X), false, karg(A_GMIX) + l * 1024, WSP(const float, modo), 1, WSP(bf16, WS_XN), 0, MP, F.vcu * NWAVES + F.wave, 256 * NWAVES);
#ifdef DUP_THIN
        GRID_BAR(); ENTER();
        norm_phase(F, WSP(const bf16, WS_X), false, karg(A_GMIX) + l * 1024, WSP(const float, modo), 1, WSP(bf16, WS_XN), 0, MP, F.vcu * NWAVES + F.wave, 256 * NWAVES);
#endif
        GRID_BAR(); ENTER();
        PT_BEGIN(2);
#ifndef NO_G3
        { pg8::Gemm g{WSP(bf16, WS_XN), WSP(const bf16, wlo + WO_IN), MP, DIN, DM}; typedef pg8::FixedOrder<128, 36, 8> Ord; Ord S; S.init(F.G, opaque_bid());
          pg8::EpiWin E{WSP(unsigned char, 0), OUTP(0), l, attn_body::C2};
          pg8::gemm_phase<pg8::EpiWin, Ord, true, true>(F.lds + RING_OFF, g, S, E);
#ifdef PROBE_G3NULL
          GRID_BAR(); ENTER(); PT_BEGIN(3); { float* sk_ = nullptr; asm volatile("" : "+s"(sk_)); pg8::EpiNull E0{sk_}; pg8::gemm_phase<pg8::EpiNull, Ord, true, true>(F.lds + RING_OFF, g, S, E0); } GRID_BAR(); ENTER(); PT_END(3);
#endif
        }
#endif
        GRID_BAR(); ENTER();
        PT_END(2);
        PT_BEGIN(1);
        { gu32* qbase = F.ctl + CW_Q + 64 * (l * 16);
          const int tk = wg_pull(F, qbase + 64 * 9);
#ifdef PROBE_ROLE
          const unsigned long long pr0 = __builtin_amdgcn_s_memrealtime();
#endif
          constexpr int T_EFF = T_TEAM;
          const bool team = (tk % TEAM_STRIDE) == 0, hfirst = (tk % TEAM_STRIDE) >= 1 && (tk % TEAM_STRIDE) <= STARTERS; const int ticket = tk / TEAM_STRIDE; gu32* tb = qbase + 64 * 10; unsigned tstage = 0;
#define TEAM_BAR() do { ++tstage; team_barrier(F, tb, (unsigned)T_EFF * tstage); ENTER(); } while (0)
#ifndef NO_TEAM
          if (team) {
              const int tgw = ticket * NWAVES + F.wave, TNW = T_EFF * NWAVES;
              norm_phase(F, XIN_S, karg(A_GFFN1) + l * 1024, WSP(const float, modo), 0, WSP(bf16, WS_XN), MP, MROWS, tgw, TNW);
              TEAM_BAR();
              { pg8::Gemm g{WSP(bf16, WS_XN), WSP(const bf16, wlo + WO_GU1), MROWS, 2 * DFF, DM}; typedef pg8::TeamOrder<22> Ord; Ord S; S.init(T_EFF, ticket);
                pg8::EpiSwiglu E{WSP(bf16, WS_BIG)};
                pg8::gemm_phase<pg8::EpiSwiglu, Ord, true, true>(F.lds + RING_OFF, g, S, E); }
              TEAM_BAR();
              { pg8::Gemm g{WSP(bf16, WS_BIG), WSP(const bf16, wlo + WO_D1), MROWS, DM, DFF}; typedef pg8::TeamOrder<4> Ord; Ord S; S.init(T_EFF, ticket);
                pg8::EpiResid E{WSP(bf16, WS_X), WSP(const float, modo) + 2 * 1024, 0.5f, l == 0 ? 2 : 0};
                pg8::gemm_phase<pg8::EpiResid, Ord, true, true>(F.lds + RING_OFF, g, S, E); }
              TEAM_BAR();
              norm_phase(F, WSP(const bf16, WS_X), false, karg(A_GMIX) + l * 1024, WSP(const float, modo), 1, WSP(bf16, WS_XN), MP, MROWS, ticket * NWAVES + F.wave, T_EFF * NWAVES);
              TEAM_BAR();
              { pg8::Gemm g{WSP(bf16, WS_XN), WSP(const bf16, wlo + WO_IN), MROWS, DIN, DM}; typedef pg8::TeamOrder<36> Ord; Ord S; S.init(T_EFF, ticket);
                pg8::EpiWin E{WSP(unsigned char, 0), OUTP(0), l, attn_body::C2};
                pg8::gemm_phase<pg8::EpiWin, Ord, true, true>(F.lds + RING_OFF, g, S, E); }
              TEAM_BAR();
          }
#endif
          if (hfirst) {
            for (;;) { const int it = wg_pull(F, qbase); if (it >= 32 * HG_G) break;
              const HgPtrs P{WSP(const float, WS_LOGF), WSP(const bf16, WS_QQ), WSP(const bf16, WS_KK), WSP(const bf16, WS_VV), WSP(const bf16, WS_HGS), karg(A_GHG) + l * 128, WSP(bf16, WS_OH), WSP(bf16, WS_DD)};
#ifndef NO_H
                  const int sqh = it / HG_G, g = it % HG_G, b = sqh >> 3, h = sqh & 7; const int nch = 128 / HG_G;
                  const size_t r0 = (size_t)b * 8192 + (size_t)g * nch * 64;
                  float* SLq = WSP(float, WS_SL) + (size_t)sqh * HG_G * 16384; float* DSq = WSP(float, WS_DSEG) + (size_t)sqh * HG_G * 128;
                  gu32* mask = F.ctl + CW_HS + 64 * (l * 32 + sqh);
                  hg_sequence<1>(F, P, r0, h, nch, 64, nullptr, SLq + (size_t)g * 16384, WSP(bf16, WS_QS), WSP(float, WS_RAW), DSq + g * 128);
                  asm volatile("s_waitcnt vmcnt(0)" ::: "memory"); __syncthreads();
                  if (F.tid == 0) { __builtin_amdgcn_fence(__ATOMIC_RELEASE, "agent"); asm volatile("s_waitcnt vmcnt(0)" ::: "memory"); (void)__hip_atomic_fetch_or(mask, 1u << g, RLX_AGENT); }
                  ENTER();
                  hg_fix(F, P, r0, h, nch, g, HG_G, SLq, DSq, WSP(const bf16, WS_QS), WSP(const float, WS_RAW), mask, OUTP(0) + OS_P + ((size_t)((l * 4 + b) * 8 + h)) * 16384);
                  ENTER();
#endif
            }
            if (F.tid == 0) { unsigned sp = 0; while (__hip_atomic_load(tb, RLX_AGENT) < (unsigned)T_EFF * 5u) { __builtin_amdgcn_s_sleep(2); if (++sp > (1u << 22)) { __hip_atomic_store(F.ctl + 1, 0x7ec0u, RLX_AGENT); break; } }
                __builtin_amdgcn_fence(__ATOMIC_ACQUIRE, "agent"); asm volatile("s_waitcnt vmcnt(0)" ::: "memory"); }
            __syncthreads(); ENTER();
          }
          if (team || hfirst) {
            gu32* qs = qbase + 64 * 11; gu32* done = qbase + 64 * 12;
            for (;;) { const int it = wg_pull(F, qs); if (it >= 256) break;
              const HgPtrs P{WSP(const float, WS_LOGF), WSP(const bf16, WS_QQ), WSP(const bf16, WS_KK), WSP(const bf16, WS_VV), WSP(const bf16, WS_HGS), karg(A_GHG) + l * 128, WSP(bf16, WS_OH), WSP(bf16, WS_DD)};
              if (it < 128) {
#ifndef NO_H
                  const int sq = it >> 3, h = it & 7; const size_t so = OS_S + ((size_t)((l * 16 + sq) * 8 + h)) * 16384;
                  hg_sequence<0>(F, P, (size_t)MP + (size_t)sq * 32, h, 1, 32, karg(A_ST) + ((size_t)((l * 16 + sq) * 8 + h)) * 16384, OUTP(0) + so, nullptr, nullptr, nullptr);
#endif
              } else {
#ifndef NO_SAMP
                  const int u = it - 128; const float lam = lam_of(karg(A_LAM), l, F.lane), osc = 1.f - lam_init_of(l);
                  attn_sample_unit(F, karg(A_CK), karg(A_CV), l, u >> 3, u & 7, WSP(const bf16, WS_Q), WSP(const bf16, WS_K), WSP(const bf16, WS_V), lam, osc, karg(A_GSUB) + l * 128, WSP(bf16, WS_OATT));
#endif
              }
              asm volatile("s_waitcnt vmcnt(0)" ::: "memory"); __syncthreads();
              if (F.tid == 0) { __builtin_amdgcn_fence(__ATOMIC_RELEASE, "agent"); asm volatile("s_waitcnt vmcnt(0)" ::: "memory"); (void)__hip_atomic_fetch_add(done, 1u, RLX_AGENT); }
              ENTER(); }
            if (team) {
                if (F.tid == 0) { unsigned sp = 0; while (__hip_atomic_load(done, RLX_AGENT) < 256u) { __builtin_amdgcn_s_sleep(2); if (++sp > (1u << 22)) { __hip_atomic_store(F.ctl + 1, 0x7ed0u, RLX_AGENT); break; } }
                    __builtin_amdgcn_fence(__ATOMIC_ACQUIRE, "agent"); asm volatile("s_waitcnt vmcnt(0)" ::: "memory"); }
                __syncthreads(); ENTER(); } }
#ifndef NO_TEAM
          if (team) {
              { pg8::Gemm g{WSP(bf16, WS_OATT), WSP(const bf16, wlo + WO_BA), MROWS, DM, DM}; typedef pg8::TeamOrder<4> Ord; Ord S; S.init(T_EFF, ticket);
                pg8::EpiGateT E{WSP(bf16, WS_LOGF), WSP(const bf16, WS_SZA)};
                pg8::gemm_phase<pg8::EpiGateT, Ord, true, true>(F.lds + RING_OFF, g, S, E); }
              TEAM_BAR();
              { pg8::Gemm g{WSP(bf16, WS_OH), WSP(const bf16, wlo + WO_BH), MROWS, DM, DM}; typedef pg8::TeamOrder<4> Ord; Ord S; S.init(T_EFF, ticket);
                pg8::EpiGateM E{WSP(const bf16, WS_LOGF), WSP(const bf16, WS_SZH), WSP(bf16, WS_MRG)};
                pg8::gemm_phase<pg8::EpiGateM, Ord, true, true>(F.lds + RING_OFF, g, S, E); }
              TEAM_BAR();
              { pg8::Gemm g{WSP(bf16, WS_MRG), WSP(const bf16, wlo + WO_OUT), MROWS, DM, DM}; typedef pg8::TeamOrder<4> Ord; Ord S; S.init(T_EFF, ticket);
                pg8::EpiResid E{WSP(bf16, WS_X), WSP(const float, modo) + 5 * 1024, 1.0f, 0};
                pg8::gemm_phase<pg8::EpiResid, Ord, true, true>(F.lds + RING_OFF, g, S, E); }
              TEAM_BAR();
              norm_phase(F, WSP(const bf16, WS_X), false, karg(A_GFFN2) + l * 1024, WSP(const float, modo), 2, WSP(bf16, WS_XN), MP, MROWS, ticket * NWAVES + F.wave, T_EFF * NWAVES);
              TEAM_BAR();
              { pg8::Gemm g{WSP(bf16, WS_XN), WSP(const bf16, wlo + WO_GU2), MROWS, 2 * DFF, DM}; typedef pg8::TeamOrder<22> Ord; Ord S; S.init(T_EFF, ticket);
                pg8::EpiSwiglu E{WSP(bf16, WS_BIG)};
                pg8::gemm_phase<pg8::EpiSwiglu, Ord, true, true>(F.lds + RING_OFF, g, S, E); }
              TEAM_BAR();
              { pg8::Gemm g{WSP(bf16, WS_BIG), WSP(const bf16, wlo + WO_D2), MROWS, DM, DFF}; typedef pg8::TeamOrder<4> Ord; Ord S; S.init(T_EFF, ticket);
                pg8::EpiResid E{WSP(bf16, WS_X), WSP(const float, modo) + 8 * 1024, 0.5f, 0};
                pg8::gemm_phase<pg8::EpiResid, Ord, true, true>(F.lds + RING_OFF, g, S, E); }
              ENTER();
          }
#endif
#ifndef NO_ATT
          { const attn_body::bf16* Qb = WSP(const attn_body::bf16, WS_Q); const attn_body::bf16* Kb = WSP(const attn_body::bf16, WS_K); const attn_body::bf16* Vb = WSP(const attn_body::bf16, WS_V); attn_body::bf16* O1 = WSP(attn_body::bf16, WS_O1);
            const int x0 = (int)(xb_xcc_id() & 7u);
            for (;;) { const int pk = attn_pull(F, qbase + 64, x0, 256); if (pk < 0) break;
                const int head = pk >> 16, it = pk & 0xffff, b = it >> 6, r = it & 63, qb = 31 - (r >> 1), mp = r & 1;
                attn_body::attn_unit128<8>(b, head * 2 + mp, head * 2, qb, Qb, Kb, Vb, O1 + (size_t)mp * ((WS_O2 - WS_O1) / 2), (char*)lds + RING_OFF); } }
#endif
#undef TEAM_BAR
#ifdef PROBE_ROLE
          if (tk == PROBE_ROLE) { const unsigned long long t1 = __builtin_amdgcn_s_memrealtime(), d = t1 - pr0; while (__builtin_amdgcn_s_memrealtime() - t1 < d) __builtin_amdgcn_s_sleep(8); }
#endif
        }
        GRID_BAR(); ENTER();
        PT_END(1);
        { const float lam = lam_of(karg(A_LAM), l, F.lane), osc = 1.f - lam_init_of(l);
          attn_combine_phase(F, WSP(const bf16, WS_O1), WSP(const bf16, WS_O2), karg(A_GSUB) + l * 128, lam, osc, WSP(bf16, WS_OATT));
#ifdef DUP_THIN
          GRID_BAR(); ENTER();
          attn_combine_phase(F, WSP(const bf16, WS_O1), WSP(const bf16, WS_O2), karg(A_GSUB) + l * 128, lam, osc, WSP(bf16, WS_OATT));
#endif
        }
        GRID_BAR(); ENTER();
#ifndef NO_G4
        { pg8::Gemm g{WSP(bf16, WS_OATT), WSP(const bf16, wlo + WO_BA), MP, DM, DM}; typedef pg8::FixedOrder<128, 4, 8> Ord; Ord S; S.init(F.G, opaque_bid());
          pg8::EpiGateT E{WSP(bf16, WS_LOGF), WSP(const bf16, WS_SZA)};
          pg8::gemm_phase<pg8::EpiGateT, Ord, true, true>(F.lds + RING_OFF, g, S, E);
#ifdef DUP_THIN
          GRID_BAR(); ENTER(); pg8::gemm_phase<pg8::EpiGateT, Ord, true, true>(F.lds + RING_OFF, g, S, E);
#endif
        }
#endif
        GRID_BAR(); ENTER();
#ifndef NO_G5
        { pg8::Gemm g{WSP(bf16, WS_OH), WSP(const bf16, wlo + WO_BH), MP, DM, DM}; typedef pg8::FixedOrder<128, 4, 8> Ord; Ord S; S.init(F.G, opaque_bid());
          pg8::EpiGateM E{WSP(const bf16, WS_LOGF), WSP(const bf16, WS_SZH), WSP(bf16, WS_MRG)};
          pg8::gemm_phase<pg8::EpiGateM, Ord, true, true>(F.lds + RING_OFF, g, S, E);
#ifdef DUP_THIN
          GRID_BAR(); ENTER(); pg8::gemm_phase<pg8::EpiGateM, Ord, true, true>(F.lds + RING_OFF, g, S, E);
#endif
        }
#endif
        GRID_BAR(); ENTER();
#ifndef NO_G6
        { pg8::Gemm g{WSP(bf16, WS_MRG), WSP(const bf16, wlo + WO_OUT), MP, DM, DM}; typedef pg8::FixedOrder<128, 4, 8> Ord; Ord S; S.init(F.G, opaque_bid());
          pg8::EpiResid E{WSP(bf16, WS_X), WSP(const float, modo) + 5 * 1024, 1.0f, 0};
          pg8::gemm_phase<pg8::EpiResid, Ord, true, true>(F.lds + RING_OFF, g, S, E);
#ifdef DUP_RES
          GRID_BAR(); ENTER(); { pg8::EpiResid E0{E.X, E.gate, 0.f, 0}; pg8::gemm_phase<pg8::EpiResid, Ord, true, true>(F.lds + RING_OFF, g, S, E0); }
#endif
        }
#endif
        GRID_BAR(); ENTER();
        norm_phase(F, WSP(const bf16, WS_X), false, karg(A_GFFN2) + l * 1024, WSP(const float, modo), 2, WSP(bf16, WS_XN), 0, MP, F.vcu * NWAVES + F.wave, 256 * NWAVES);
#ifdef DUP_THIN
        GRID_BAR(); ENTER();
        norm_phase(F, WSP(const bf16, WS_X), false, karg(A_GFFN2) + l * 1024, WSP(const float, modo), 2, WSP(bf16, WS_XN), 0, MP, F.vcu * NWAVES + F.wave, 256 * NWAVES);
#endif
        GRID_BAR(); ENTER();
#ifndef NO_G7
        { pg8::Gemm g{WSP(bf16, WS_XN), WSP(const bf16, wlo + WO_GU2), MP, 2 * DFF, DM}; typedef pg8::FixedOrder<128, 22, 8> Ord; Ord S; S.init(F.G, opaque_bid());
          pg8::EpiSwiglu E{WSP(bf16, WS_BIG)};
          pg8::gemm_phase<pg8::EpiSwiglu, Ord, true, true>(F.lds + RING_OFF, g, S, E); }
#endif
        GRID_BAR(); ENTER();
#ifndef NO_G8
        { pg8::Gemm g{WSP(bf16, WS_BIG), WSP(const bf16, wlo + WO_D2), MP, DM, DFF}; typedef pg8::FixedOrder<128, 4, 8> Ord; Ord S; S.init(F.G, opaque_bid());
          pg8::EpiResid E{WSP(bf16, WS_X), WSP(const float, modo) + 8 * 1024, 0.5f, 0};
          pg8::gemm_phase<pg8::EpiResid, Ord, true, true>(F.lds + RING_OFF, g, S, E);
#ifdef DUP_RES
          GRID_BAR(); ENTER(); { pg8::EpiResid E0{E.X, E.gate, 0.f, 0}; pg8::gemm_phase<pg8::EpiResid, Ord, true, true>(F.lds + RING_OFF, g, S, E0); }
#endif
        }
#endif
        GRID_BAR(); ENTER();
    }
    final_norm_phase(F, WSP(const bf16, WS_X), karg(A_GFIN), OUTP(0));
#undef GRID_BAR
#undef ENTER
#undef WSP
#undef OUTP
}

extern "C" void kernel_launch(void* const* d_in, const int* in_sizes, int n_in, void* d_out, int out_size, void* d_ws, size_t ws_size, hipStream_t stream) {
    static int grid = 0;
    if (grid == 0) {
        if (n_in != 25 || (size_t)out_size != OUT_TOTAL || ws_size < WS_END) { fprintf(stderr, "kernel_launch: unexpected sizes: n_in %d out %d ws %zu (need %zu)\n", n_in, out_size, ws_size, (size_t)WS_END); grid = -1; return; }
        int dev = 0, cus = 0, per_cu = 0;
        if (hipGetDevice(&dev) != hipSuccess || hipDeviceGetAttribute(&cus, hipDeviceAttributeMultiprocessorCount, dev) != hipSuccess) { grid = -1; return; }
        if (hipFuncSetAttribute((const void*)mk_fwd, hipFuncAttributeMaxDynamicSharedMemorySize, LDS_BYTES) != hipSuccess) { fprintf(stderr, "kernel_launch: hipFuncSetAttribute failed\n"); grid = -1; return; }
        if (hipOccupancyMaxActiveBlocksPerMultiprocessor(&per_cu, (const void*)mk_fwd, NWAVES * 64, LDS_BYTES) != hipSuccess || per_cu < 1) { fprintf(stderr, "kernel_launch: occupancy query reports %d\n", per_cu); }
        (void)hipGetLastError();
        grid = cus;
        if (grid != 256) { fprintf(stderr, "kernel_launch: built for a 256-CU device (team size, row split and work queues assume 256 workgroups); found %d CUs; nothing launched\n", cus); grid = -1; return; }
    }
    if (grid < 0) return;
    if (hipMemsetAsync((char*)d_ws + WS_CTL, 0, CTL_ZERO_BYTES, stream) != hipSuccess) return;
    Args a{};
    for (int i = 0; i < 25; ++i) a.in[i] = (const float*)d_in[i];
    a.out = (float*)d_out; a.ws = (unsigned char*)d_ws;
    hipLaunchKernelGGL(mk_fwd, dim3(grid), dim3(NWAVES * 64), LDS_BYTES, stream, a);
    (void)in_sizes;
}
```

```cpp
#include <hip/hip_runtime.h>
#include <hip/hip_bf16.h>
#include <cstdio>
#include <cstdint>
#include <cmath>
constexpr unsigned WTAB_LDS_ADDR = 139264u + 320u + 256u;
__device__ __forceinline__ unsigned hw_wave_slot() { return (unsigned)__builtin_amdgcn_s_getreg((6 << 11) | 4) & 0x3fu; }
__device__ __forceinline__ void tid_table_init() { ((volatile __attribute__((address_space(3))) unsigned*)(size_t)WTAB_LDS_ADDR)[hw_wave_slot()] = threadIdx.x >> 6; }
__device__ __forceinline__ int opaque_tid() { const unsigned w = ((volatile __attribute__((address_space(3))) unsigned*)(size_t)WTAB_LDS_ADDR)[hw_wave_slot()];
    unsigned ln; asm volatile("v_mbcnt_lo_u32_b32 %0, -1, 0\n\tv_mbcnt_hi_u32_b32 %0, -1, %0" : "=v"(ln));
    return (int)((w << 6) | ln); }
__device__ __forceinline__ int opaque_bid() { int b = (int)blockIdx.x; asm volatile("" : "+s"(b)); return b; }
namespace pg8 {
#define PG8_LAS __attribute__((address_space(3)))
typedef unsigned short bf16_t;
typedef short bf16x8 __attribute__((ext_vector_type(8)));
typedef float f32x4 __attribute__((ext_vector_type(4)));
typedef unsigned u32x4 __attribute__((ext_vector_type(4)));
constexpr int BM = 256, BK = 64, HALF = 128, HTB = HALF * BK * 2  , STAGE_BYTES = 8 * HTB, NXCD = 8, WGM = 8;

__host__ __device__ __forceinline__ int lds_byte(int r, int c) { const int st = (r >> 4) * 2 + (c >> 5), rr = r & 15, cc = c & 31, ob = rr * 64 + cc * 2; return st * 1024 + (ob ^ (((ob >> 9) & 1) << 5)); }
__host__ __device__ __forceinline__ void stage_rc(int b, int& R, int& C) { const int st = b / 1024, sb = b % 1024, swz = sb ^ (((sb >> 9) & 1) << 5); R = (st >> 1) * 16 + swz / 64; C = (st & 1) * 32 + (swz % 64) / 2; }
__host__ __device__ __forceinline__ int perm32(int rho) { const int n = rho >> 4, i = rho & 15; return 8 * (i >> 2) + 4 * n + (i & 3); }

struct Unit { int pm, pn; };
struct Gemm { const bf16_t* A; const bf16_t* Bt; int M, N, K; };

struct StaticOrder {
    int nM, nN, nwg, G, c;
    __host__ __device__ void init(int M, int N, int G_, int c_) { nM = M / BM; nN = N / BM; nwg = nM * nN; G = G_; c = c_; }
    __host__ __device__ bool next(int i, Unit& u) const {
        const long L = (long)i * G + c; if (L >= nwg) return false;
        int wgid = (int)L; { const int q = nwg / NXCD, r = nwg % NXCD, xcd = wgid % NXCD, off = wgid / NXCD; wgid = (xcd < r ? xcd * (q + 1) : r * (q + 1) + (xcd - r) * q) + off; }
        const int nig = WGM * nN, gid = wgid / nig, fm = gid * WGM, gsz = (nM - fm) < WGM ? (nM - fm) : WGM;
        u.pm = fm + ((wgid % nig) % gsz); u.pn = (wgid % nig) / gsz; return true;
    }
    __device__ __forceinline__ void a_ready(const Unit&) const {}
    __device__ __forceinline__ void done(const Unit&) const {}
};

__device__ __forceinline__ unsigned cvt_pk_bf16(float lo, float hi) { unsigned r; asm volatile("v_cvt_pk_bf16_f32 %0, %1, %2" : "=v"(r) : "v"(lo), "v"(hi)); return r; }
__device__ __forceinline__ float bf_lo(unsigned w) { return __builtin_bit_cast(float, w << 16); }
__device__ __forceinline__ float bf_hi(unsigned w) { return __builtin_bit_cast(float, w & 0xffff0000u); }
__device__ __forceinline__ float sigmoid_f(float x) { return __builtin_amdgcn_rcpf(1.f + __expf(-x)); }
__device__ __forceinline__ float silu_f(float x) { return x * sigmoid_f(x); }
__device__ __forceinline__ void store8bf(bf16_t* p, f32x4 a, f32x4 b) { u32x4 w; w.x = cvt_pk_bf16(a[0], a[1]); w.y = cvt_pk_bf16(a[2], a[3]); w.z = cvt_pk_bf16(b[0], b[1]); w.w = cvt_pk_bf16(b[2], b[3]); *(u32x4*)p = w; }
__device__ __forceinline__ int row_seq(int row) { return row < 32768 ? (row >> 13) : 4 + ((row - 32768) >> 5); }

struct EpiSwiglu {
    static constexpr bool PERM = true, AFTER_DRAIN = false;
    bf16_t* O;
    __device__ __forceinline__ void operator()(const f32x4 (&acc)[2][2][4][2], const Unit& u, int wr, int wc, int fr, int fq) const {
        const int row0 = u.pm * BM + wr * 64 + fr, col0 = u.pn * HALF + wc * 32 + 8 * fq;
#pragma unroll
        for (int ai = 0; ai < 2; ++ai)
#pragma unroll
            for (int m = 0; m < 4; ++m) {
                f32x4 g0 = acc[ai][0][m][0], g1 = acc[ai][0][m][1]; const f32x4 u0 = acc[ai][1][m][0], u1 = acc[ai][1][m][1];
#pragma unroll
                for (int i = 0; i < 4; ++i) { g0[i] = silu_f(g0[i]) * u0[i]; g1[i] = silu_f(g1[i]) * u1[i]; }
                store8bf(O + (size_t)(row0 + ai * HALF + m * 16) * 2816 + col0, g0, g1); asm volatile("" ::: "memory");
            }
    }
};

struct EpiResid {
    static constexpr bool PERM = true, AFTER_DRAIN = false;
    bf16_t* X; const float* gate; float coef; int xsel;
    __device__ __forceinline__ static u32x4 ldx(const bf16_t* xb, const float* xf, size_t off) {
        if (xf) { const f32x4 a = *(const f32x4*)(xf + off), b = *(const f32x4*)(xf + off + 4); u32x4 w; w.x = cvt_pk_bf16(a[0], a[1]); w.y = cvt_pk_bf16(a[2], a[3]); w.z = cvt_pk_bf16(b[0], b[1]); w.w = cvt_pk_bf16(b[2], b[3]); return w; }
        return *(const u32x4*)(xb + off); }
    __device__ __forceinline__ void operator()(const f32x4 (&acc)[2][2][4][2], const Unit& u, int wr, int wc, int fr, int fq) const {
        const float* Xf = nullptr;
        if (xsel) { const __attribute__((address_space(4))) char* ka = (const __attribute__((address_space(4))) char*)__builtin_amdgcn_kernarg_segment_ptr(); asm volatile("" : "+s"(ka));
            Xf = (xsel == 1) ? *(const float* const __attribute__((address_space(4)))*)(ka) : *(const float* const __attribute__((address_space(4)))*)(ka + 8) - (size_t)32768 * 1024; }
        if (u.pm < 128) {
            const float* gp = gate + (size_t)(u.pm >> 5) * 9216 + u.pn * BM + wc * 32 + 8 * fq;
            f32x4 gv[2][2];
#pragma unroll
            for (int bj = 0; bj < 2; ++bj)
#pragma unroll
                for (int n = 0; n < 2; ++n) gv[bj][n] = *(const f32x4*)(gp + bj * HALF + 4 * n) * coef;
            const size_t base = (size_t)(u.pm * BM + wr * 64 + fr) * 1024 + u.pn * BM + wc * 32 + 8 * fq;
            u32x4 xc[2], xn[2];
#pragma unroll
            for (int bj = 0; bj < 2; ++bj) xc[bj] = ldx(X, Xf, base + bj * HALF);
#pragma unroll
            for (int g = 0; g < 8; ++g) { const int ai = g >> 2, m = g & 3; const size_t off = base + (size_t)(ai * HALF + m * 16) * 1024;
                if (g + 1 < 8) { const size_t offn = base + (size_t)(((g + 1) >> 2) * HALF + ((g + 1) & 3) * 16) * 1024;
#pragma unroll
                    for (int bj = 0; bj < 2; ++bj) xn[bj] = ldx(X, Xf, offn + bj * HALF); }
#pragma unroll
                for (int bj = 0; bj < 2; ++bj) { const u32x4 t = xc[bj]; const f32x4 x0 = {bf_lo(t.x), bf_hi(t.x), bf_lo(t.y), bf_hi(t.y)}, x1 = {bf_lo(t.z), bf_hi(t.z), bf_lo(t.w), bf_hi(t.w)};
                    store8bf(X + off + bj * HALF, x0 + gv[bj][0] * acc[ai][bj][m][0], x1 + gv[bj][1] * acc[ai][bj][m][1]); }
                asm volatile("" ::: "memory");
#pragma unroll
                for (int bj = 0; bj < 2; ++bj) xc[bj] = xn[bj]; }
        } else {
#pragma unroll
        for (int ai = 0; ai < 2; ++ai)
#pragma unroll
            for (int m = 0; m < 4; ++m) {
                const int row = u.pm * BM + ai * HALF + wr * 64 + m * 16 + fr; const float* gp = gate + (size_t)row_seq(row) * 9216;
#pragma unroll
                for (int bj = 0; bj < 2; ++bj) { const int col = u.pn * BM + bj * HALF + wc * 32 + 8 * fq; const size_t off = (size_t)row * 1024 + col;
                    const f32x4 g0 = *(const f32x4*)(gp + col) * coef, g1 = *(const f32x4*)(gp + col + 4) * coef; const u32x4 t = ldx(X, Xf, off);
                    const f32x4 x0 = {bf_lo(t.x), bf_hi(t.x), bf_lo(t.y), bf_hi(t.y)}, x1 = {bf_lo(t.z), bf_hi(t.z), bf_lo(t.w), bf_hi(t.w)};
                    store8bf(X + off, x0 + g0 * acc[ai][bj][m][0], x1 + g1 * acc[ai][bj][m][1]); asm volatile("" ::: "memory"); }
            }
        }
    }
};

struct EpiResidNorm {
    static constexpr bool PERM = true, AFTER_DRAIN = false;
    unsigned char* ws; const float* modl; const float* gN; float coef; int cfg;
    static constexpr size_t MiB_ = 1u << 20, O_X = 240 * MiB_, O_XN = 370 * MiB_, O_SLOT = 1088 * MiB_;
    static constexpr unsigned P_OFF = 140288u, S_OFF = 144384u;
    __device__ __forceinline__ void operator()(f32x4 (&acc)[2][2][4][2], const Unit& u, int wr, int wc, int fr, int fq) const {
        typedef __attribute__((address_space(3))) float lf32; typedef __attribute__((address_space(3))) f32x4 lf32x4;
        lf32* const P = (lf32*)(P_OFF); lf32* const S = (lf32*)(S_OFF);
        const int xsel = cfg & 1, gidx = (cfg >> 1) & 15, sub = (cfg >> 5) & 3, nxt = (cfg >> 7) & 1, ph = cfg >> 8;
        bf16_t* const X = (bf16_t*)(ws + O_X); bf16_t* const XN = (bf16_t*)(ws + O_XN);
        const float* Xf = nullptr;
        if (xsel) { const __attribute__((address_space(4))) char* ka = (const __attribute__((address_space(4))) char*)__builtin_amdgcn_kernarg_segment_ptr(); asm volatile("" : "+s"(ka)); Xf = *(const float* const __attribute__((address_space(4)))*)(ka); }
        const int seq = u.pm >> 5, col = u.pn * BM + wc * 32 + 8 * fq, lane = fr + 16 * fq, wid = wr * 4 + wc;
        const size_t base = (size_t)(u.pm * BM + wr * 64 + fr) * 1024 + col;
        { const float* gp = modl + (size_t)seq * 9216 + gidx * 1024 + col;
          f32x4 gv[2][2];
#pragma unroll
          for (int bj = 0; bj < 2; ++bj)
#pragma unroll
              for (int n = 0; n < 2; ++n) gv[bj][n] = *(const f32x4*)(gp + bj * HALF + 4 * n) * coef;
          u32x4 xc[2], xn[2];
#pragma unroll
          for (int bj = 0; bj < 2; ++bj) xc[bj] = EpiResid::ldx(X, Xf, base + bj * HALF);
#pragma unroll
          for (int g = 0; g < 8; ++g) { const int ai = g >> 2, m = g & 3; const size_t off = base + (size_t)(ai * HALF + m * 16) * 1024;
              if (g + 1 < 8) { const size_t offn = base + (size_t)(((g + 1) >> 2) * HALF + ((g + 1) & 3) * 16) * 1024;
#pragma unroll
                  for (int bj = 0; bj < 2; ++bj) xn[bj] = EpiResid::ldx(X, Xf, offn + bj * HALF); }
              float ss = 0.f;
#pragma unroll
              for (int bj = 0; bj < 2; ++bj) { const u32x4 t = xc[bj]; const f32x4 x0 = {bf_lo(t.x), bf_hi(t.x), bf_lo(t.y), bf_hi(t.y)}, x1 = {bf_lo(t.z), bf_hi(t.z), bf_lo(t.w), bf_hi(t.w)};
                  const f32x4 v0 = x0 + gv[bj][0] * acc[ai][bj][m][0], v1 = x1 + gv[bj][1] * acc[ai][bj][m][1];
                  store8bf(X + off + bj * HALF, v0, v1); acc[ai][bj][m][0] = v0; acc[ai][bj][m][1] = v1;
                  ss += ((v0[0] * v0[0] + v0[1] * v0[1]) + (v0[2] * v0[2] + v0[3] * v0[3])) + ((v1[0] * v1[0] + v1[1] * v1[1]) + (v1[2] * v1[2] + v1[3] * v1[3])); }
              ss += __builtin_bit_cast(float, __builtin_amdgcn_ds_bpermute((lane ^ 16) << 2, __builtin_bit_cast(int, ss)));
              ss += __builtin_bit_cast(float, __builtin_amdgcn_ds_bpermute((lane ^ 32) << 2, __builtin_bit_cast(int, ss)));
              if (fq == 0) P[(ai * HALF + wr * 64 + m * 16 + fr) * 4 + wc] = ss;
              asm volatile("" ::: "memory");
#pragma unroll
              for (int bj = 0; bj < 2; ++bj) xc[bj] = xn[bj]; } }
        asm volatile("s_waitcnt lgkmcnt(0)\n\ts_barrier" ::: "memory");
        float* const slot = (float*)(ws + O_SLOT) + ((size_t)(u.pm * BM) + wid * 32 + (lane & 31)) * 4;
        unsigned* const cnt = (unsigned*)ws + 65536 + (ph * 128 + u.pm) * 16;
        if (lane < 32) { const f32x4 p = *(const lf32x4*)(P + (wid * 32 + lane) * 4);
            __hip_atomic_store((unsigned*)slot + u.pn, __builtin_bit_cast(unsigned, (p[0] + p[1]) + (p[2] + p[3])), __ATOMIC_RELAXED, __HIP_MEMORY_SCOPE_AGENT); }
        asm volatile("s_waitcnt vmcnt(0)" ::: "memory");
        if (lane == 0) __hip_atomic_fetch_add(cnt, 1u, __ATOMIC_RELAXED, __HIP_MEMORY_SCOPE_AGENT);
        if (wid == 0) { unsigned sp = 0;
            while ((unsigned)__builtin_amdgcn_readfirstlane(__hip_atomic_load(cnt, __ATOMIC_RELAXED, __HIP_MEMORY_SCOPE_AGENT)) < 32u) { __builtin_amdgcn_s_sleep(1); if (++sp > (1u << 22)) break; }
            __builtin_amdgcn_fence(__ATOMIC_ACQUIRE, "agent"); }
        asm volatile("s_waitcnt vmcnt(0) lgkmcnt(0)\n\ts_barrier" ::: "memory");
        if (lane < 32) { float t = 0.f;
#pragma unroll
            for (int k = 0; k < 4; ++k) t += __builtin_bit_cast(float, __hip_atomic_load((const unsigned*)slot + k, __ATOMIC_RELAXED, __HIP_MEMORY_SCOPE_AGENT));
            S[wid * 32 + lane] = __builtin_amdgcn_rsqf(t * (1.f / 1024.f) + 1e-6f); }
        asm volatile("s_waitcnt vmcnt(0) lgkmcnt(0)\n\ts_barrier" ::: "memory");
        { const float* mp = modl + (size_t)(nxt ? 20 * 9216 : 0) + (size_t)seq * 9216 + sub * 3072 + col; const float* gq = gN + col;
          f32x4 av[2][2], bv[2][2];
#pragma unroll
          for (int bj = 0; bj < 2; ++bj)
#pragma unroll
              for (int n = 0; n < 2; ++n) { const f32x4 gg = *(const f32x4*)(gq + bj * HALF + 4 * n), sc = *(const f32x4*)(mp + 1024 + bj * HALF + 4 * n); bv[bj][n] = *(const f32x4*)(mp + bj * HALF + 4 * n); av[bj][n] = gg * (sc + 1.f); }
#pragma unroll
          for (int g = 0; g < 8; ++g) { const int ai = g >> 2, m = g & 3; const size_t off = base + (size_t)(ai * HALF + m * 16) * 1024;
              const float rstd = S[ai * HALF + wr * 64 + m * 16 + fr];
#pragma unroll
              for (int bj = 0; bj < 2; ++bj) store8bf(XN + off + bj * HALF, (acc[ai][bj][m][0] * rstd) * av[bj][0] + bv[bj][0], (acc[ai][bj][m][1] * rstd) * av[bj][1] + bv[bj][1]);
              asm volatile("" ::: "memory"); } }
    }
};

struct EpiWin {
    static constexpr bool PERM = true, AFTER_DRAIN = false;
    unsigned char* ws; float* out; int l; float qscale;
    static constexpr size_t MiB_ = 1u << 20;
    static constexpr size_t O_Q = 435 * MiB_, O_K = 500 * MiB_, O_V = 565 * MiB_, O_QQ = 630 * MiB_, O_KK = 695 * MiB_, O_VV = 760 * MiB_, O_HGS = 825 * MiB_, O_SZA = 890 * MiB_, O_SZH = 955 * MiB_, O_LOGF = 1020 * MiB_, O_LB = 4 * MiB_;
    static constexpr size_t OK_P_ = 34078720, OV_P_ = 168296448, OK_S_ = 304611328, OV_S_ = 306708480;
    __device__ __forceinline__ void operator()(const f32x4 (&acc)[2][2][4][2], const Unit& u, int wr, int wc, int fr, int fq) const {
        const int seg = u.pn >> 2, cb = (u.pn & 3) * BM + wc * 32 + 8 * fq, row0 = u.pm * BM + wr * 64 + fr;
        const size_t boff = seg == 0 ? O_Q : seg == 1 ? O_K : seg == 2 ? O_V : seg == 3 ? O_QQ : seg == 4 ? O_KK : seg == 5 ? O_VV : seg == 6 ? O_HGS : seg == 7 ? O_SZA : O_SZH;
        bf16_t* const O = (bf16_t*)(ws + boff) + (size_t)row0 * 1024 + cb;
        float* F32 = nullptr;
        if (seg == 1 || seg == 2) { const size_t ob = (u.pm < 128) ? (seg == 1 ? OK_P_ : OV_P_) + (size_t)l * 32768 * 1024 + (size_t)(u.pm * BM) * 1024 : (seg == 1 ? OK_S_ : OV_S_) + (size_t)l * 512 * 1024 + (size_t)((u.pm - 128) * BM) * 1024;
            F32 = out + ob + (size_t)(wr * 64 + fr) * 1024 + cb; }
        const float* const lb = (const float*)(ws + O_LB) + l * 1024 + cb;
        const float sc = seg == 0 ? qscale : 1.f;
        f32x4 lbv[2][2]; { const f32x4 z = {0.f, 0.f, 0.f, 0.f}; lbv[0][0] = z; lbv[0][1] = z; lbv[1][0] = z; lbv[1][1] = z; }
        if (seg == 4) { lbv[0][0] = *(const f32x4*)(lb); lbv[0][1] = *(const f32x4*)(lb + 4); lbv[1][0] = *(const f32x4*)(lb + HALF); lbv[1][1] = *(const f32x4*)(lb + HALF + 4); }
#pragma unroll
        for (int ai = 0; ai < 2; ++ai) {
#pragma unroll
            for (int m = 0; m < 4; ++m)
#pragma unroll
                for (int bj = 0; bj < 2; ++bj) { const size_t off = (size_t)(ai * HALF + m * 16) * 1024 + bj * HALF; const f32x4 l0 = lbv[bj][0], l1 = lbv[bj][1];
                    f32x4 a = acc[ai][bj][m][0], b = acc[ai][bj][m][1];
                    if (seg == 4) {
#pragma unroll
                        for (int i = 0; i < 4; ++i) {
                            { const float x = a[i], lbv = l0[i], e = __expf(-__builtin_fabsf(x)), r = __builtin_amdgcn_rcpf(1.f + e), er = e * r, om = x >= 0.f ? er : r; a[i] = (1.f - lbv) * om; }
                            { const float x = b[i], lbv = l1[i], e = __expf(-__builtin_fabsf(x)), r = __builtin_amdgcn_rcpf(1.f + e), er = e * r, om = x >= 0.f ? er : r; b[i] = (1.f - lbv) * om; } }
                    } else if (seg == 3 || seg == 6) {
#pragma unroll
                        for (int i = 0; i < 4; ++i) { a[i] = silu_f(a[i]); b[i] = silu_f(b[i]); }
                    } else if (seg >= 7) {
#pragma unroll
                        for (int i = 0; i < 4; ++i) { a[i] = sigmoid_f(a[i]); b[i] = sigmoid_f(b[i]); }
                    } else {
                        if (seg == 1 || seg == 2) { *(f32x4*)(F32 + off) = a; *(f32x4*)(F32 + off + 4) = b; }
                        a = a * sc; b = b * sc;
                    }
                    store8bf(O + off, a, b); asm volatile("" ::: "memory"); }
        }
    }
};

struct EpiGateT {
    static constexpr bool PERM = true, AFTER_DRAIN = false;
    bf16_t* T; const bf16_t* G;
    __device__ __forceinline__ void operator()(const f32x4 (&acc)[2][2][4][2], const Unit& u, int wr, int wc, int fr, int fq) const {
        const size_t base = (size_t)(u.pm * BM + wr * 64 + fr) * 1024 + u.pn * BM + wc * 32 + 8 * fq;
        u32x4 gc[2], gn[2];
#pragma unroll
        for (int bj = 0; bj < 2; ++bj) gc[bj] = *(const u32x4*)(G + base + bj * HALF);
#pragma unroll
        for (int g = 0; g < 8; ++g) { const int ai = g >> 2, m = g & 3; const size_t off = base + (size_t)(ai * HALF + m * 16) * 1024;
            if (g + 1 < 8) { const size_t offn = base + (size_t)(((g + 1) >> 2) * HALF + ((g + 1) & 3) * 16) * 1024;
#pragma unroll
                for (int bj = 0; bj < 2; ++bj) gn[bj] = *(const u32x4*)(G + offn + bj * HALF); }
#pragma unroll
            for (int bj = 0; bj < 2; ++bj) { const u32x4 gg = gc[bj];
                const f32x4 g0 = {bf_lo(gg.x), bf_hi(gg.x), bf_lo(gg.y), bf_hi(gg.y)}, g1 = {bf_lo(gg.z), bf_hi(gg.z), bf_lo(gg.w), bf_hi(gg.w)};
                store8bf(T + off + bj * HALF, g0 * acc[ai][bj][m][0], g1 * acc[ai][bj][m][1]); }
            asm volatile("" ::: "memory");
#pragma unroll
            for (int bj = 0; bj < 2; ++bj) gc[bj] = gn[bj]; }
    }
};
struct EpiGateM {
    static constexpr bool PERM = true, AFTER_DRAIN = false;
    const bf16_t* T; const bf16_t* G; bf16_t* O;
    __device__ __forceinline__ void operator()(const f32x4 (&acc)[2][2][4][2], const Unit& u, int wr, int wc, int fr, int fq) const {
        const size_t base = (size_t)(u.pm * BM + wr * 64 + fr) * 1024 + u.pn * BM + wc * 32 + 8 * fq;
        u32x4 gc[2], gn[2], tc[2], tn[2];
#pragma unroll
        for (int bj = 0; bj < 2; ++bj) { gc[bj] = *(const u32x4*)(G + base + bj * HALF); tc[bj] = *(const u32x4*)(T + base + bj * HALF); }
#pragma unroll
        for (int g = 0; g < 8; ++g) { const int ai = g >> 2, m = g & 3; const size_t off = base + (size_t)(ai * HALF + m * 16) * 1024;
            if (g + 1 < 8) { const size_t offn = base + (size_t)(((g + 1) >> 2) * HALF + ((g + 1) & 3) * 16) * 1024;
#pragma unroll
                for (int bj = 0; bj < 2; ++bj) { gn[bj] = *(const u32x4*)(G + offn + bj * HALF); tn[bj] = *(const u32x4*)(T + offn + bj * HALF); } }
#pragma unroll
            for (int bj = 0; bj < 2; ++bj) { const u32x4 gg = gc[bj];
                const f32x4 g0 = {bf_lo(gg.x), bf_hi(gg.x), bf_lo(gg.y), bf_hi(gg.y)}, g1 = {bf_lo(gg.z), bf_hi(gg.z), bf_lo(gg.w), bf_hi(gg.w)};
                const u32x4 tt = tc[bj]; const f32x4 t0 = {bf_lo(tt.x), bf_hi(tt.x), bf_lo(tt.y), bf_hi(tt.y)}, t1 = {bf_lo(tt.z), bf_hi(tt.z), bf_lo(tt.w), bf_hi(tt.w)};
                store8bf(O + off + bj * HALF, t0 + g0 * acc[ai][bj][m][0], t1 + g1 * acc[ai][bj][m][1]); }
            asm volatile("" ::: "memory");
#pragma unroll
            for (int bj = 0; bj < 2; ++bj) { gc[bj] = gn[bj]; tc[bj] = tn[bj]; } }
    }
};

struct EpiNull {
    static constexpr bool PERM = true, AFTER_DRAIN = false; float* sink;
    __device__ __forceinline__ void operator()(const f32x4 (&acc)[2][2][4][2], const Unit& u, int wr, int wc, int fr, int fq) const { f32x4 s = {0.f, 0.f, 0.f, 0.f};
#pragma unroll
        for (int a = 0; a < 2; ++a)
#pragma unroll
            for (int b = 0; b < 2; ++b)
#pragma unroll
                for (int m = 0; m < 4; ++m)
#pragma unroll
                    for (int n = 0; n < 2; ++n) s = s + acc[a][b][m][n];
        if (sink) sink[0] = s[0] + s[1] + s[2] + s[3]; (void)u; (void)wr; (void)wc; (void)fr; (void)fq; }
};

template <int NM, int NN, int GM> struct FixedOrder {
    static_assert(NM % GM == 0, "GM divides NM");
    int G, c;
    __device__ __forceinline__ void init(int G_, int c_) { G = G_; c = c_; }
    __device__ __forceinline__ bool next(int i, Unit& u) const {
        constexpr int nwg = NM * NN, q = nwg / NXCD, r = nwg % NXCD, nig = GM * NN;
        const int L = i * G + c; if (L >= nwg) return false;
        const int xcd = L % NXCD, off = L / NXCD; const int wgid = (xcd < r ? xcd * (q + 1) : r * (q + 1) + (xcd - r) * q) + off;
        const int gid = wgid / nig, w = wgid % nig; u.pm = gid * GM + (w % GM); u.pn = w / GM; return true;
    }
    __device__ __forceinline__ void a_ready(const Unit&) const {}
    __device__ __forceinline__ void done(const Unit&) const {}
};

template <int NN> struct TeamOrder {
    int T, r;
    __device__ __forceinline__ void init(int T_, int r_) { T = T_; r = r_; }
    __device__ __forceinline__ bool next(int i, Unit& u) const { const int L = i * T + r; if (L >= 2 * NN) return false; u.pm = 128 + L / NN; u.pn = L % NN; return true; }
    __device__ __forceinline__ void a_ready(const Unit&) const {}
    __device__ __forceinline__ void done(const Unit&) const {}
};
template <class Epi, class Sched, bool ALIGN_EPI = false, bool SP2 = false>
__device__ __forceinline__ void gemm_phase(PG8_LAS unsigned char* lds, const Gemm g, const Sched& S, const Epi& E) {
    const int tid = opaque_tid(), wid = __builtin_amdgcn_readfirstlane(tid >> 6), lane = tid & 63, wr = wid >> 2, wc = wid & 3, fr = lane & 15, fq = lane >> 4;
    const int K = g.K, nt = K / BK;
    unsigned voffA[2], voffB[2];
#pragma unroll
    for (int i = 0; i < 2; ++i) { int R, C; stage_rc(tid * 16 + i * 8192, R, C); const int Rb = Epi::PERM ? ((R & ~31) + perm32(R & 31)) : R;
        voffA[i] = (unsigned)(R * K + C) * 2u; voffB[i] = (unsigned)(Rb * K + C) * 2u; }
    const size_t kstep = (size_t)(BK * 2);
    const size_t hstep = (size_t)HALF * K * 2;
    const size_t tstep = 2 * hstep;
    const unsigned ldsw = (unsigned)wid * 1024u;
    const int aoff = lds_byte(wr * 64 + fr, fq * 8), boff = lds_byte(wc * 32 + fr, fq * 8);
#define PG8_SA(b, h) (((b) * 2 + (h)) * HTB)
#define PG8_SB(b, h) ((4 + (b) * 2 + (h)) * HTB)
#define PG8_STAGE(bufoff, gbase, voff) do { _Pragma("unroll") for (int _i = 0; _i < 2; ++_i) \
        __builtin_amdgcn_global_load_lds((const unsigned*)((const char*)(gbase) + (voff)[_i]), (PG8_LAS unsigned*)(lds + (bufoff) + ldsw + _i * 8192), 16, 0, 0); } while (0)
#define PG8_LDA(dst, b, h) do { _Pragma("unroll") for (int m = 0; m < 4; ++m) _Pragma("unroll") for (int k = 0; k < 2; ++k) dst[m][k] = *(const PG8_LAS bf16x8*)(lds + PG8_SA(b, h) + aoff + m * 2048 + k * 1024); } while (0)
#define PG8_LDB(dst, b, h) do { _Pragma("unroll") for (int n = 0; n < 2; ++n) _Pragma("unroll") for (int k = 0; k < 2; ++k) dst[n][k] = *(const PG8_LAS bf16x8*)(lds + PG8_SB(b, h) + boff + n * 2048 + k * 1024); } while (0)
#define PG8_MMA(ai, bj, At, Bt) do { __builtin_amdgcn_s_setprio(1); _Pragma("unroll") for (int m = 0; m < 4; ++m) _Pragma("unroll") for (int n = 0; n < 2; ++n) _Pragma("unroll") for (int k = 0; k < 2; ++k) \
        acc[ai][bj][m][n] = __builtin_amdgcn_mfma_f32_16x16x32_bf16(Bt[n][k], At[m][k], acc[ai][bj][m][n], 0, 0, 0); __builtin_amdgcn_s_setprio(0); } while (0)
#define PG8_WAIT_V(n) asm volatile("s_waitcnt vmcnt(" #n ")" ::: "memory")
#define PG8_WAIT_L(n) asm volatile("s_waitcnt lgkmcnt(" #n ")" ::: "memory")
#define PG8_BAR __builtin_amdgcn_s_barrier()
#define PG8_SCHED __builtin_amdgcn_sched_barrier(0)
    Unit cur, nxt; int ui = 0;
    if (!S.next(0, cur)) return;
    f32x4 acc[2][2][4][2];
#pragma unroll
    for (int a = 0; a < 2; ++a)
#pragma unroll
        for (int b = 0; b < 2; ++b)
#pragma unroll
            for (int m = 0; m < 4; ++m)
#pragma unroll
                for (int n = 0; n < 2; ++n) acc[a][b][m][n] = (f32x4){0.f, 0.f, 0.f, 0.f};
    bf16x8 At[4][2], B0[2][2], B1[2][2];
    const char* cA = (const char*)g.A + (size_t)cur.pm * tstep; const char* cB = (const char*)g.Bt + (size_t)cur.pn * tstep;
    S.a_ready(cur);
    if constexpr (SP2) {
        PG8_STAGE(PG8_SB(0, 0), cB, voffB); PG8_STAGE(PG8_SB(0, 1), cB + hstep, voffB); PG8_STAGE(PG8_SA(0, 0), cA, voffA); PG8_STAGE(PG8_SA(0, 1), cA + hstep, voffA);
        if (wr == 1) PG8_BAR;
        PG8_WAIT_V(2); PG8_BAR;
        PG8_STAGE(PG8_SB(1, 0), cB + kstep, voffB); PG8_STAGE(PG8_SA(1, 0), cA + kstep, voffA); PG8_STAGE(PG8_SB(1, 1), cB + hstep + kstep, voffB);
        PG8_WAIT_V(6); PG8_BAR;
    } else {
        PG8_STAGE(PG8_SB(0, 0), cB, voffB); PG8_STAGE(PG8_SA(0, 0), cA, voffA); PG8_STAGE(PG8_SB(0, 1), cB + hstep, voffB); PG8_STAGE(PG8_SA(0, 1), cA + hstep, voffA);
        if (wr == 1) PG8_BAR;
        PG8_WAIT_V(4); PG8_BAR;
        PG8_STAGE(PG8_SB(1, 0), cB + kstep, voffB); PG8_STAGE(PG8_SA(1, 0), cA + kstep, voffA); PG8_STAGE(PG8_SB(1, 1), cB + hstep + kstep, voffB);
        PG8_WAIT_V(6); PG8_BAR;
    }
    for (;;) {
        const bool has_next = S.next(ui + 1, nxt);
        const char* nA = has_next ? (const char*)g.A + (size_t)nxt.pm * tstep : cA; const char* nB = has_next ? (const char*)g.Bt + (size_t)nxt.pn * tstep : cB;
        for (int t = 0; t < nt; t += 2) {
            const bool last = (t == nt - 2);
            const char* a1 = cA + (size_t)(t + 1) * kstep;
            const char* a2 = last ? nA : cA + (size_t)(t + 2) * kstep; const char* b2 = last ? nB : cB + (size_t)(t + 2) * kstep;
            const char* a3 = a2 + kstep; const char* b3 = b2 + kstep;
            if (last && has_next) S.a_ready(nxt);
            if constexpr (SP2) {
            PG8_LDB(B0, 0, 0); PG8_LDB(B1, 0, 1); PG8_SCHED; PG8_LDA(At, 0, 0); PG8_STAGE(PG8_SA(1, 1), a1 + hstep, voffA);
            PG8_WAIT_V(8); PG8_WAIT_L(0); PG8_BAR; PG8_MMA(0, 0, At, B0); PG8_MMA(0, 1, At, B1); PG8_BAR; PG8_SCHED;
            PG8_LDA(At, 0, 1); PG8_STAGE(PG8_SB(0, 0), b2, voffB); PG8_STAGE(PG8_SB(0, 1), b2 + hstep, voffB); PG8_STAGE(PG8_SA(0, 0), a2, voffA);
            PG8_WAIT_V(8); PG8_WAIT_L(0); PG8_BAR; PG8_MMA(1, 0, At, B0); PG8_MMA(1, 1, At, B1); PG8_BAR; PG8_SCHED;
            PG8_LDB(B0, 1, 0); PG8_LDB(B1, 1, 1); PG8_SCHED; PG8_LDA(At, 1, 0); PG8_STAGE(PG8_SA(0, 1), a2 + hstep, voffA);
            PG8_WAIT_V(8); PG8_WAIT_L(0); PG8_BAR; PG8_MMA(0, 0, At, B0); PG8_MMA(0, 1, At, B1); PG8_BAR; PG8_SCHED;
            PG8_LDA(At, 1, 1); PG8_STAGE(PG8_SB(1, 0), b3, voffB); PG8_STAGE(PG8_SB(1, 1), b3 + hstep, voffB); PG8_STAGE(PG8_SA(1, 0), a3, voffA);
            PG8_WAIT_V(8); PG8_WAIT_L(0); PG8_BAR; PG8_MMA(1, 0, At, B0); PG8_MMA(1, 1, At, B1); PG8_BAR; PG8_SCHED;
            } else {
            PG8_LDB(B0, 0, 0); PG8_SCHED; PG8_LDA(At, 0, 0); PG8_STAGE(PG8_SA(1, 1), a1 + hstep, voffA);
            PG8_WAIT_L(8); PG8_BAR; PG8_WAIT_L(0); PG8_MMA(0, 0, At, B0); PG8_BAR; PG8_SCHED;
            PG8_LDB(B1, 0, 1); PG8_STAGE(PG8_SB(0, 0), b2, voffB);
            PG8_BAR; PG8_WAIT_L(0); PG8_MMA(0, 1, At, B1); PG8_BAR;
            PG8_LDA(At, 0, 1); PG8_STAGE(PG8_SA(0, 0), a2, voffA);
            PG8_BAR; PG8_WAIT_L(0); PG8_MMA(1, 0, At, B0); PG8_BAR; PG8_SCHED;
            PG8_STAGE(PG8_SB(0, 1), b2 + hstep, voffB);
            PG8_WAIT_V(6); PG8_BAR; PG8_MMA(1, 1, At, B1); PG8_BAR;
            PG8_LDB(B0, 1, 0); PG8_SCHED; PG8_LDA(At, 1, 0); PG8_STAGE(PG8_SA(0, 1), a2 + hstep, voffA);
            PG8_WAIT_L(8); PG8_BAR; PG8_WAIT_L(0); PG8_MMA(0, 0, At, B0); PG8_BAR; PG8_SCHED;
            PG8_LDB(B1, 1, 1); PG8_STAGE(PG8_SB(1, 0), b3, voffB);
            PG8_BAR; PG8_WAIT_L(0); PG8_MMA(0, 1, At, B1); PG8_BAR;
            PG8_LDA(At, 1, 1); PG8_STAGE(PG8_SA(1, 0), a3, voffA);
            PG8_BAR; PG8_WAIT_L(0); PG8_MMA(1, 0, At, B0); PG8_BAR; PG8_SCHED;
            PG8_STAGE(PG8_SB(1, 1), b3 + hstep, voffB);
            PG8_WAIT_V(6); PG8_BAR; PG8_MMA(1, 1, At, B1); PG8_BAR;
            }
        }
        if constexpr (ALIGN_EPI) { if (wr == 0) PG8_BAR; }
        if constexpr (!Epi::AFTER_DRAIN) { E(acc, cur, wr, wc, fr, fq); S.done(cur); }
        if (!has_next) break;
#pragma unroll
        for (int a = 0; a < 2; ++a)
#pragma unroll
            for (int b = 0; b < 2; ++b)
#pragma unroll
                for (int m = 0; m < 4; ++m)
#pragma unroll
                    for (int n = 0; n < 2; ++n) acc[a][b][m][n] = (f32x4){0.f, 0.f, 0.f, 0.f};
        cur = nxt; cA = nA; cB = nB; ++ui;
        if constexpr (ALIGN_EPI) { if (wr == 1) PG8_BAR; }
    }
    PG8_WAIT_V(0);
    if constexpr (!ALIGN_EPI) { if (wr == 0) PG8_BAR; }
    PG8_BAR;
    if constexpr (Epi::AFTER_DRAIN) { E.fused(acc, cur, wr, wc, fr, fq, lds, wid, lane); S.done(cur); }
#undef PG8_SA
#undef PG8_SB
#undef PG8_STAGE
#undef PG8_LDA
#undef PG8_LDB
#undef PG8_MMA
#undef PG8_WAIT_V
#undef PG8_WAIT_L
#undef PG8_BAR
#undef PG8_SCHED
}
}
namespace attn_body {
using bf16=__hip_bfloat16;
using bf16x8=__attribute__((ext_vector_type(8)))short;
using s16x4=__attribute__((ext_vector_type(4)))short;
using f32x16=__attribute__((ext_vector_type(16)))float;
using u32x4=__attribute__((ext_vector_type(4)))unsigned;
constexpr int BATCH=4,NHEAD=16,SEQ=8192,D=64,DM=NHEAD*D;
constexpr int NW=8,QBLK=32,QB=QBLK*NW,KVBLK=64,NQB=SEQ/QB;
constexpr int ATTN_PITCH=DM, ATTN_UNIT_ROWS=QB;
__device__ __forceinline__ int crow(int r,int hi){return (r&3)+8*(r>>2)+4*hi;}
#define SBAR() __builtin_amdgcn_sched_barrier(0)
__device__ __forceinline__ void cmask(f32x16&p0,f32x16&p1,int jb,int qrel,int hi){
  const float NEG=-INFINITY; (void)hi;
  if(jb>(qrel>>6)){
  #pragma unroll
  for(int r=0;r<16;++r){p0[r]=NEG;p1[r]=NEG;} }
}

constexpr int NSLOT=3, SLOTB=8192;
constexpr int LDS_K=0, LDS_V=NSLOT*SLOTB, LDS_WS=2*NSLOT*SLOTB, LDS_OST=LDS_WS+NW*64*4, LDS_BYTES=LDS_OST+NW*4096;
constexpr float C2=0.125f*1.4426950408889634f;
__device__ __forceinline__ void glds16(const void*gsrc,unsigned lds_dst){unsigned keep;
  asm volatile("s_mov_b32 %0, m0\n\ts_mov_b32 m0, %2\n\ts_nop 0\n\tglobal_load_lds_dwordx4 %1, off\n\ts_mov_b32 m0, %0":"=&s"(keep):"v"(gsrc),"s"(lds_dst):"memory");}
__device__ __forceinline__ float max3f(float a,float b,float c){float r;asm("v_max3_f32 %0, %1, %2, %3":"=v"(r):"v"(a),"v"(b),"v"(c));return r;}
__device__ __forceinline__ float max2f(float a,float b){float r;asm("v_max_f32_e32 %0, %1, %2":"=v"(r):"v"(a),"v"(b));return r;}
__device__ __forceinline__ float fadd_s(float a,float b){float r;asm("v_add_f32_e32 %0, %1, %2":"=v"(r):"v"(a),"v"(b));return r;}
__device__ __forceinline__ float fsub_s(float a,float b){float r;asm("v_sub_f32_e32 %0, %1, %2":"=v"(r):"v"(a),"v"(b));return r;}
typedef float f32x2_t __attribute__((ext_vector_type(2))); typedef __bf16 bf16x2_t __attribute__((ext_vector_type(2)));
__device__ __forceinline__ unsigned cvtpk_s(float lo,float hi){f32x2_t v={lo,hi};bf16x2_t b=__builtin_convertvector(v,bf16x2_t);return __builtin_bit_cast(unsigned,b);}
#define WAIT_BAR(N) asm volatile("s_waitcnt vmcnt(" #N ") lgkmcnt(0)\n\ts_barrier":::"memory")

__device__ __forceinline__ void qkt(f32x16&p0,f32x16&p1,const char*Kslot,const bf16x8*qr,const f32x16&negm,int r32,int hi){
  const char*kb=Kslot+hi*1024+r32*16;
  #pragma unroll
  for(int d0=0;d0<4;++d0){
    const bf16x8 b0=*reinterpret_cast<const bf16x8*>(kb+d0*2048);
    const bf16x8 b1=*reinterpret_cast<const bf16x8*>(kb+d0*2048+512);
    if(d0==0){p0=__builtin_amdgcn_mfma_f32_32x32x16_bf16(b0,qr[0],negm,0,0,0);p1=__builtin_amdgcn_mfma_f32_32x32x16_bf16(b1,qr[0],negm,0,0,0);}
    else{p0=__builtin_amdgcn_mfma_f32_32x32x16_bf16(b0,qr[d0],p0,0,0,0);p1=__builtin_amdgcn_mfma_f32_32x32x16_bf16(b1,qr[d0],p1,0,0,0);}}
}
typedef __attribute__((address_space(3))) const char* lds_cptr;
typedef short v4i16_t __attribute__((ext_vector_type(4)));
__device__ __forceinline__ void kload8(bf16x8*kf,lds_cptr kp){
  kf[0]=*(const __attribute__((address_space(3))) bf16x8*)(kp);      kf[1]=*(const __attribute__((address_space(3))) bf16x8*)(kp+512);
  kf[2]=*(const __attribute__((address_space(3))) bf16x8*)(kp+2048); kf[3]=*(const __attribute__((address_space(3))) bf16x8*)(kp+2560);
  kf[4]=*(const __attribute__((address_space(3))) bf16x8*)(kp+4096); kf[5]=*(const __attribute__((address_space(3))) bf16x8*)(kp+4608);
  kf[6]=*(const __attribute__((address_space(3))) bf16x8*)(kp+6144); kf[7]=*(const __attribute__((address_space(3))) bf16x8*)(kp+6656);
}
__device__ __forceinline__ void kload2(bf16x8*kf,lds_cptr kp,int j){ kf[2*j]=*(const __attribute__((address_space(3))) bf16x8*)(kp+j*2048); kf[2*j+1]=*(const __attribute__((address_space(3))) bf16x8*)(kp+j*2048+512); }
__device__ __forceinline__ s16x4 vtr(lds_cptr p){ return __builtin_bit_cast(s16x4,__builtin_amdgcn_ds_read_tr16_b64_v4i16((__attribute__((address_space(3))) v4i16_t*)p)); }
__device__ __forceinline__ float rowmax(const f32x16&p0,const f32x16&p1){
  float a=max3f(p0[0],p0[1],p1[0]),b=max3f(p0[2],p0[3],p1[1]);a=max3f(a,p1[2],p1[3]);
  #pragma unroll
  for(int r=4;r<16;r+=4){a=max3f(a,p0[r],p0[r+1]);b=max3f(b,p0[r+2],p0[r+3]);a=max3f(a,p1[r],p1[r+1]);b=max3f(b,p1[r+2],p1[r+3]);}
  const float m=max2f(a,b);
  auto rr=__builtin_amdgcn_permlane32_swap(__float_as_uint(m),__float_as_uint(m),false,false);
  return max2f(__uint_as_float(rr[0]),__uint_as_float(rr[1]));
}
__device__ __forceinline__ void pv(f32x16*o,int vb,bf16x8 pa0,bf16x8 pa1,bf16x8 pa2,bf16x8 pa3){
  #pragma unroll
  for(int d0=0;d0<2;++d0){s16x4 lo[4],hi[4];
    #pragma unroll
    for(int ks=0;ks<4;++ks){
      asm volatile("ds_read_b64_tr_b16 %0,%1 offset:%c2":"=&v"(lo[ks]):"v"(vb),"i"(d0*4096+ks*1024):"memory");
      asm volatile("ds_read_b64_tr_b16 %0,%1 offset:%c2":"=&v"(hi[ks]):"v"(vb),"i"(d0*4096+ks*1024+512):"memory");}
    asm volatile("s_waitcnt lgkmcnt(0)":::"memory");SBAR();
    #define PK(k) (bf16x8){lo[k][0],lo[k][1],lo[k][2],lo[k][3],hi[k][0],hi[k][1],hi[k][2],hi[k][3]}
    o[d0]=__builtin_amdgcn_mfma_f32_32x32x16_bf16(pa0,PK(0),o[d0],0,0,0);
    o[d0]=__builtin_amdgcn_mfma_f32_32x32x16_bf16(pa1,PK(1),o[d0],0,0,0);
    o[d0]=__builtin_amdgcn_mfma_f32_32x32x16_bf16(pa2,PK(2),o[d0],0,0,0);
    o[d0]=__builtin_amdgcn_mfma_f32_32x32x16_bf16(pa3,PK(3),o[d0],0,0,0);
    #undef PK
  }
}

#ifndef ATTN_STORE16
#define ATTN_STORE16(p,v) (*(u32x4*)(p)=(v))
#endif
template<int THRL> __device__ __forceinline__ void attn_unit(int b,int hq,int hv,int qb,const bf16*Q,const bf16*__restrict__ K,const bf16*__restrict__ V,bf16*O,char*shm){
  const int tid=opaque_tid(),lane=tid&63,r32=lane&31,hi=lane>>5; const int wid=__builtin_amdgcn_readfirstlane(tid>>6);
  const long rowbase=(long)b*SEQ; const int q0=qb*QB;
  const bf16*Qw=Q+(rowbase+q0+wid*QBLK)*DM+hq*D;
  const bf16*Kh=K+rowbase*DM+hq*D,*Vh=V+rowbase*DM+hv*D;
  const unsigned lds0=(unsigned)(uintptr_t)shm;
  float*wsf=(float*)(shm+LDS_WS)+wid*64;
  const bf16*ksrc=Kh+(long)lane*DM+wid*8;
  const bf16*vsrc=Vh+(long)(16*(wid&3)+(lane>>2))*DM+(wid>>2)*32+(lane&3)*8;
  const unsigned kdst=lds0+LDS_K+wid*1024, vdst=lds0+LDS_V+wid*1024;
  #define DMA_K(t,slot) glds16(ksrc+(long)(t)*KVBLK*DM,(unsigned)__builtin_amdgcn_readfirstlane(kdst+(slot)))
  #define DMA_V(t,slot) glds16(vsrc+(long)(t)*KVBLK*DM,(unsigned)__builtin_amdgcn_readfirstlane(vdst+(slot)))
  const int vb0=(int)(lds0+LDS_V)+((lane>>4)&1)*32+(lane&3)*8+(4*hi+((lane&15)>>2))*64;
  const char*Kbase=shm+LDS_K; bf16x8 kf[8];
  const lds_cptr shm3=(lds_cptr)shm; const lds_cptr kp0=shm3+LDS_K+hi*1024+r32*16; const lds_cptr vp0=shm3+LDS_V+((lane>>4)&1)*32+(lane&3)*8+(4*hi+((lane&15)>>2))*64;
  const int NT=(q0+QB)/KVBLK;
  DMA_K(0,0);DMA_V(0,0);DMA_K(1,SLOTB);
  bf16x8 qr[4];
  #pragma unroll
  for(int d0=0;d0<4;++d0)qr[d0]=*reinterpret_cast<const bf16x8*>(&Qw[(long)r32*DM+d0*16+hi*8]);
  float mhat=0.f,l_reg=0.f;f32x16 o[2];o[0]=f32x16{};o[1]=f32x16{};f32x16 negm=f32x16{};asm volatile("":"+v"(negm));
  const int qrel=wid*QBLK+r32;
  #define CMASK(P0,P1,t) do{int jb_=(t)-(NT-4); if(jb_>=0)cmask(P0,P1,jb_,qrel,hi);}while(0)
  bool resc=false;
  #define START(P0,P1) do{ const float rm=rowmax(P0,P1); resc=false; \
    { const float dl=rm; mhat=fadd_s(mhat,dl); \
      _Pragma("unroll") for(int r=0;r<16;++r){P0[r]=fsub_s(P0[r],dl);P1[r]=fsub_s(P1[r],dl);} \
      _Pragma("unroll") for(int r=0;r<16;++r)negm[r]=-mhat; asm volatile("":"+v"(negm)); } \
    _Pragma("unroll") for(int r=0;r<16;++r)P0[r]=__builtin_amdgcn_exp2f(P0[r]); }while(0)
  #define RESC() do{ if(resc){ asm volatile("s_waitcnt lgkmcnt(0)":::"memory"); \
      _Pragma("unroll") for(int d_=0;d_<2;++d_) _Pragma("unroll") for(int r=0;r<16;++r)o[d_][r]*=wsf[crow(r,hi)]; } }while(0)
  f32x16 pA0,pA1,pB0,pB1;
  int sl_prev=0,sl_cur=0,sl_next=SLOTB;
  #define ROT() do{sl_prev=sl_cur;sl_cur=sl_next;sl_next=(sl_next==(NSLOT-1)*SLOTB)?0:sl_next+SLOTB;}while(0)
  DMA_K(2,2*SLOTB);
  WAIT_BAR(3);
  qkt(pA0,pA1,Kbase,qr,negm,r32,hi);asm volatile("s_nop 15\n\ts_nop 7":"+v"(pA0),"+v"(pA1));CMASK(pA0,pA1,0);
  START(pA0,pA1);
  _Pragma("unroll") for(int r=0;r<16;++r)pA1[r]=__builtin_amdgcn_exp2f(pA1[r]);
  WAIT_BAR(0);
  DMA_K(3,0);DMA_V(1,SLOTB);
  ROT();
  kload8(kf,kp0+sl_cur);
  WAIT_BAR(2);
  s16x4 vlo[8],vhi[8]; u32x4 pw0,pw1,pw2,pw3;
  #define PKW(P,B) cvtpk_s(P[B],P[B+1])
  #define PAF(k) __builtin_bit_cast(bf16x8,pw##k)
  #define VFR(i) (bf16x8){vlo[i][0],vlo[i][1],vlo[i][2],vlo[i][3],vhi[i][0],vhi[i][1],vhi[i][2],vhi[i][3]}
  #define PIN(x) asm volatile("":"+v"(x))
  #define MX3(a,b,c) __builtin_fmaxf(__builtin_fmaxf((a),(b)),(c))
  #define GAPA(MF,A0,A1,A2,A3,W0,W1,PW) do{ MF; sacc+=A0; sacc+=A1; sacc+=A2; sacc+=A3; PIN(sacc); W0; W1; PIN(PW); SBAR(); }while(0)
  #define EX(v) __builtin_amdgcn_exp2f(v)
  #define GAPB(MF,X,B) do{ MF; X[B]=EX(X[B]); X[B+1]=EX(X[B+1]); X[B+2]=EX(X[B+2]); X[B+3]=EX(X[B+3]); PIN(X); SBAR(); }while(0)
  #define VRD(i) do{ vlo[i]=vtr(vp_+(((i)>>2)*4096+((i)&3)*1024)); vhi[i]=vtr(vp_+(((i)>>2)*4096+((i)&3)*1024+512)); }while(0)
  #define KRD(G,j) do{ if(G){ kload2(kf,kp0+sl_next,j); SBAR(); } }while(0)
  #define STEP(C0,C1,P0,P1,t,GK,GV,GL) do{ SBAR(); \
    const lds_cptr vp_=vp0+sl_prev; \
    VRD(0); SBAR(); float sacc=(P0[0]+P0[1]); \
    GAPA(C0=__builtin_amdgcn_mfma_f32_32x32x16_bf16(kf[0],qr[0],negm,0,0,0), P0[2],P0[3],P0[4],P0[5],     pw0[0]=PKW(P0,0), pw0[1]=PKW(P0,2), pw0); \
    VRD(4); SBAR(); GAPA(C1=__builtin_amdgcn_mfma_f32_32x32x16_bf16(kf[1],qr[0],negm,0,0,0), P0[6],P0[7],P0[8],P0[9],     pw0[2]=PKW(P0,4), pw0[3]=PKW(P0,6), pw0); \
    VRD(1); SBAR(); GAPA(C0=__builtin_amdgcn_mfma_f32_32x32x16_bf16(kf[2],qr[1],C0,0,0,0),   P0[10],P0[11],P0[12],P0[13], pw1[0]=PKW(P0,8), pw1[1]=PKW(P0,10), pw1); \
    VRD(5); SBAR(); GAPA(C1=__builtin_amdgcn_mfma_f32_32x32x16_bf16(kf[3],qr[1],C1,0,0,0),   P0[14],P0[15],P1[0],P1[1],   pw1[2]=PKW(P0,12),pw1[3]=PKW(P0,14), pw1); \
    VRD(2); SBAR(); GAPA(C0=__builtin_amdgcn_mfma_f32_32x32x16_bf16(kf[4],qr[2],C0,0,0,0),   P1[2],P1[3],P1[4],P1[5],     pw2[0]=PKW(P1,0), pw2[1]=PKW(P1,2), pw2); \
    VRD(6); SBAR(); GAPA(C1=__builtin_amdgcn_mfma_f32_32x32x16_bf16(kf[5],qr[2],C1,0,0,0),   P1[6],P1[7],P1[8],P1[9],     pw2[2]=PKW(P1,4), pw2[3]=PKW(P1,6), pw2); \
    VRD(3); SBAR(); GAPA(C0=__builtin_amdgcn_mfma_f32_32x32x16_bf16(kf[6],qr[3],C0,0,0,0),   P1[10],P1[11],P1[12],P1[13], pw3[0]=PKW(P1,8), pw3[1]=PKW(P1,10), pw3); \
    VRD(7); SBAR(); GAPA(C1=__builtin_amdgcn_mfma_f32_32x32x16_bf16(kf[7],qr[3],C1,0,0,0),   P1[14],P1[15],0.f,0.f,       pw3[2]=PKW(P1,12),pw3[3]=PKW(P1,14), pw3); \
    l_reg+=sacc; \
    if(GK){DMA_K((t)+3,sl_cur);} if(GV){DMA_V((t)+1,sl_next);} \
    CMASK(C0,C1,t); \
    { float a=MX3(C0[0],C0[1],C1[0]),b=MX3(C0[2],C0[3],C1[1]); a=MX3(a,C1[2],C1[3]); \
      _Pragma("unroll") for(int r=4;r<16;r+=4){a=MX3(a,C0[r],C0[r+1]);b=MX3(b,C0[r+2],C0[r+3]);a=MX3(a,C1[r],C1[r+1]);b=MX3(b,C1[r+2],C1[r+3]);} \
      float rm=__builtin_fmaxf(a,b); { auto rr=__builtin_amdgcn_permlane32_swap(__float_as_uint(rm),__float_as_uint(rm),false,false); rm=__builtin_fmaxf(__uint_as_float(rr[0]),__uint_as_float(rr[1])); } \
      resc=false; \
      if(__builtin_expect(__any(rm>(float)THRL),0)){ const float dl=__builtin_fmaxf(rm,0.f); mhat+=dl; \
        _Pragma("unroll") for(int r=0;r<16;++r){C0[r]-=dl;C1[r]-=dl;} \
        _Pragma("unroll") for(int r=0;r<16;++r)negm[r]=-mhat; asm volatile("":"+v"(negm)); \
        const float f=__builtin_amdgcn_exp2f(-dl); l_reg*=f; if(hi==0)wsf[r32]=f; resc=true; } } \
    SBAR(); \
    GAPB(o[0]=__builtin_amdgcn_mfma_f32_32x32x16_bf16(PAF(0),VFR(0),o[0],0,0,0), C0,0); \
    GAPB(o[1]=__builtin_amdgcn_mfma_f32_32x32x16_bf16(PAF(0),VFR(4),o[1],0,0,0), C0,4); \
    KRD(GL,0); GAPB(o[0]=__builtin_amdgcn_mfma_f32_32x32x16_bf16(PAF(1),VFR(1),o[0],0,0,0), C0,8); \
    KRD(GL,1); GAPB(o[1]=__builtin_amdgcn_mfma_f32_32x32x16_bf16(PAF(1),VFR(5),o[1],0,0,0), C0,12); \
    KRD(GL,2); GAPB(o[0]=__builtin_amdgcn_mfma_f32_32x32x16_bf16(PAF(2),VFR(2),o[0],0,0,0), C1,0); \
    KRD(GL,3); GAPB(o[1]=__builtin_amdgcn_mfma_f32_32x32x16_bf16(PAF(2),VFR(6),o[1],0,0,0), C1,4); \
    GAPB(o[0]=__builtin_amdgcn_mfma_f32_32x32x16_bf16(PAF(3),VFR(3),o[0],0,0,0), C1,8); \
    GAPB(o[1]=__builtin_amdgcn_mfma_f32_32x32x16_bf16(PAF(3),VFR(7),o[1],0,0,0), C1,12); \
    }while(0)
  int t=1;
  #undef CMASK
  #define CMASK(P0,P1,t) do{}while(0)
  for(;t+5<NT;t+=2){
    STEP(pB0,pB1,pA0,pA1,t,true,true,true);     WAIT_BAR(2); RESC(); ROT();
    STEP(pA0,pA1,pB0,pB1,t+1,true,true,true);   WAIT_BAR(2); RESC(); ROT();
  }
  #undef CMASK
  #define CMASK(P0,P1,t) do{int jb_=(t)-(NT-4); if(jb_>=0)cmask(P0,P1,jb_,qrel,hi);}while(0)
  #define ENDW(tt) do{ if((tt)+3<NT){WAIT_BAR(2);} else if((tt)+2<NT){WAIT_BAR(1);} else {WAIT_BAR(0);} }while(0)
  for(;t+1<NT;t+=2){
    STEP(pB0,pB1,pA0,pA1,t,(t+3<NT),(t+1<NT),(t+1<NT));       ENDW(t);   RESC(); ROT();
    STEP(pA0,pA1,pB0,pB1,t+1,(t+4<NT),(t+2<NT),(t+2<NT));     ENDW(t+1); RESC(); ROT();
  }
  STEP(pB0,pB1,pA0,pA1,NT-1,false,false,false); RESC();
  { float sacc=pB0[0]+pB0[1]; _Pragma("unroll") for(int r=2;r<16;++r)sacc+=pB0[r]; _Pragma("unroll") for(int r=0;r<16;++r)sacc+=pB1[r]; l_reg+=sacc;
    pw0=(u32x4){PKW(pB0,0),PKW(pB0,2),PKW(pB0,4),PKW(pB0,6)};pw1=(u32x4){PKW(pB0,8),PKW(pB0,10),PKW(pB0,12),PKW(pB0,14)};pw2=(u32x4){PKW(pB1,0),PKW(pB1,2),PKW(pB1,4),PKW(pB1,6)};pw3=(u32x4){PKW(pB1,8),PKW(pB1,10),PKW(pB1,12),PKW(pB1,14)};
    SBAR(); pv(o,vb0+sl_cur,PAF(0),PAF(1),PAF(2),PAF(3)); }
  #undef PKW
  #undef PAF
  #undef VFR
  #undef PIN
  #undef MX3
  #undef GAPA
  #undef GAPB
  #undef EX
  #undef VRD
  #undef KRD
  #undef STEP
  #undef ENDW
  {auto rr=__builtin_amdgcn_permlane32_swap(__float_as_uint(l_reg),__float_as_uint(l_reg),false,false);l_reg=__uint_as_float(rr[0])+__uint_as_float(rr[1]);}
  if(hi==0)wsf[32+r32]=l_reg;asm volatile("s_waitcnt lgkmcnt(0)":::"memory");
  float rli[16];
  #pragma unroll
  for(int r=0;r<16;++r)rli[r]=__builtin_amdgcn_rcpf(wsf[32+crow(r,hi)]);
  bf16*Ow=O+(rowbase+q0+wid*QBLK)*DM+hv*D;
  { bf16*stg=(bf16*)(shm+LDS_OST)+wid*2048;
    #pragma unroll
    for(int r=0;r<16;++r){const int orow=crow(r,hi);
      #pragma unroll
      for(int d0=0;d0<2;++d0)stg[orow*64+d0*32+r32]=__float2bfloat16(o[d0][r]*rli[r]);}
    asm volatile("s_waitcnt lgkmcnt(0)":::"memory");
    #pragma unroll
    for(int i=0;i<4;++i){const int row=i*8+(lane>>3),ch=lane&7; const u32x4 v=*(const u32x4*)(stg+row*64+ch*8); ATTN_STORE16(Ow+(long)row*DM+ch*8,v);} }
  asm volatile("s_waitcnt lgkmcnt(0)\n\ts_barrier":::"memory");
  #undef DMA_K
  #undef DMA_V
  #undef CMASK
  #undef START
  #undef RESC
  #undef ROT
}
__device__ __forceinline__ void pv128(f32x16*o,int vb,bf16x8 pa0,bf16x8 pa1,bf16x8 pa2,bf16x8 pa3){
  #pragma unroll
  for(int d0=0;d0<4;++d0){s16x4 lo[4],hi[4];
    #pragma unroll
    for(int ks=0;ks<4;++ks){
      asm volatile("ds_read_b64_tr_b16 %0,%1 offset:%c2":"=&v"(lo[ks]):"v"(vb),"i"(d0*4096+ks*1024):"memory");
      asm volatile("ds_read_b64_tr_b16 %0,%1 offset:%c2":"=&v"(hi[ks]):"v"(vb),"i"(d0*4096+ks*1024+512):"memory");}
    asm volatile("s_waitcnt lgkmcnt(0)":::"memory");SBAR();
    #define PK(k) (bf16x8){lo[k][0],lo[k][1],lo[k][2],lo[k][3],hi[k][0],hi[k][1],hi[k][2],hi[k][3]}
    o[d0]=__builtin_amdgcn_mfma_f32_32x32x16_bf16(pa0,PK(0),o[d0],0,0,0);
    o[d0]=__builtin_amdgcn_mfma_f32_32x32x16_bf16(pa1,PK(1),o[d0],0,0,0);
    o[d0]=__builtin_amdgcn_mfma_f32_32x32x16_bf16(pa2,PK(2),o[d0],0,0,0);
    o[d0]=__builtin_amdgcn_mfma_f32_32x32x16_bf16(pa3,PK(3),o[d0],0,0,0);
    #undef PK
  }
}
constexpr int SLOTV=16384, LDS_V2=NSLOT*SLOTB, LDS_WS2=LDS_V2+NSLOT*SLOTV, LDS_OST2=LDS_WS2+NW*64*4, LDS_BYTES2=LDS_OST2+NW*4096;
template<int THRL> __device__ __forceinline__ void attn_unit128(int b,int hq,int hv,int qb,const bf16*Q,const bf16*__restrict__ K,const bf16*__restrict__ V,bf16*O,char*shm){
  const int tid=opaque_tid(),lane=tid&63,r32=lane&31,hi=lane>>5; const int wid=__builtin_amdgcn_readfirstlane(tid>>6);
  const long rowbase=(long)b*SEQ; const int q0=qb*QB;
  const bf16*Qw=Q+(rowbase+q0+wid*QBLK)*DM+hq*D;
  const bf16*Kh=K+rowbase*DM+hq*D,*Vh=V+rowbase*DM+hv*D;
  const unsigned lds0=(unsigned)(uintptr_t)shm;
  float*wsf=(float*)(shm+LDS_WS2)+wid*64;
  const bf16*ksrc=Kh+(long)lane*DM+wid*8;
  const bf16*vsrc=Vh+(long)(16*(wid&3)+(lane>>2))*DM+(wid>>2)*32+(lane&3)*8;
  const unsigned kdst=lds0+LDS_K+wid*1024, vdst=lds0+LDS_V2+wid*1024;
  #define DMA_K(t,slot) glds16(ksrc+(long)(t)*KVBLK*DM,(unsigned)__builtin_amdgcn_readfirstlane(kdst+(slot)))
  #define DMA_V(t,slot) do{ glds16(vsrc+(long)(t)*KVBLK*DM,(unsigned)__builtin_amdgcn_readfirstlane(vdst+2*(slot))); glds16(vsrc+64+(long)(t)*KVBLK*DM,(unsigned)__builtin_amdgcn_readfirstlane(vdst+8192+2*(slot))); }while(0)
  const int vb0=(int)(lds0+LDS_V2)+((lane>>4)&1)*32+(lane&3)*8+(4*hi+((lane&15)>>2))*64;
  const char*Kbase=shm+LDS_K; bf16x8 kf[8];
  const lds_cptr shm3=(lds_cptr)shm; const lds_cptr kp0=shm3+LDS_K+hi*1024+r32*16; const lds_cptr vp0=shm3+LDS_V2+((lane>>4)&1)*32+(lane&3)*8+(4*hi+((lane&15)>>2))*64;
  const int NT=(q0+QB)/KVBLK;
  DMA_K(0,0);DMA_V(0,0);DMA_K(1,SLOTB);
  bf16x8 qr[4];
  #pragma unroll
  for(int d0=0;d0<4;++d0)qr[d0]=*reinterpret_cast<const bf16x8*>(&Qw[(long)r32*DM+d0*16+hi*8]);
  float mhat=0.f,l_reg=0.f;f32x16 o[4];o[0]=f32x16{};o[1]=f32x16{};o[2]=f32x16{};o[3]=f32x16{};const f32x16 zc=f32x16{};
  const int qrel=wid*QBLK+r32;
  #define CMASK(P0,P1,t) do{int jb_=(t)-(NT-4); if(jb_>=0)cmask(P0,P1,jb_,qrel,hi);}while(0)
  bool resc=false;
  #define START(P0,P1) do{ const float rm=rowmax(P0,P1); resc=false; \
    { const float dl=rm; mhat=fadd_s(mhat,dl); \
      _Pragma("unroll") for(int r=0;r<16;++r){P0[r]=fsub_s(P0[r],dl);P1[r]=fsub_s(P1[r],dl);} \
      } \
    _Pragma("unroll") for(int r=0;r<16;++r)P0[r]=__builtin_amdgcn_exp2f(P0[r]); }while(0)
  #define RESC() do{ if(resc){ asm volatile("s_waitcnt lgkmcnt(0)":::"memory"); \
      _Pragma("unroll") for(int d_=0;d_<4;++d_) _Pragma("unroll") for(int r=0;r<16;++r)o[d_][r]*=wsf[crow(r,hi)]; } }while(0)
  f32x16 pA0,pA1,pB0,pB1;
  int sl_prev=0,sl_cur=0,sl_next=SLOTB;
  #define ROT() do{sl_prev=sl_cur;sl_cur=sl_next;sl_next=(sl_next==(NSLOT-1)*SLOTB)?0:sl_next+SLOTB;}while(0)
  DMA_K(2,2*SLOTB);
  WAIT_BAR(3);
  qkt(pA0,pA1,Kbase,qr,zc,r32,hi);asm volatile("s_nop 15\n\ts_nop 7":"+v"(pA0),"+v"(pA1));CMASK(pA0,pA1,0);
  START(pA0,pA1);
  _Pragma("unroll") for(int r=0;r<16;++r)pA1[r]=__builtin_amdgcn_exp2f(pA1[r]);
  WAIT_BAR(0);
  DMA_K(3,0);DMA_V(1,SLOTB);
  ROT();
  kload8(kf,kp0+sl_cur);
  WAIT_BAR(3);
  s16x4 vlo[8],vhi[8]; u32x4 pw0,pw1,pw2,pw3;
  #define PKW(P,B) cvtpk_s(P[B],P[B+1])
  #define PAF(k) __builtin_bit_cast(bf16x8,pw##k)
  #define VFR(i) (bf16x8){vlo[i][0],vlo[i][1],vlo[i][2],vlo[i][3],vhi[i][0],vhi[i][1],vhi[i][2],vhi[i][3]}
  #define PIN(x) asm volatile("":"+v"(x))
  #define MX3(a,b,c) __builtin_fmaxf(__builtin_fmaxf((a),(b)),(c))
  #define GAPA(MF,A0,A1,A2,A3,W0,W1,PW) do{ MF; sacc+=A0; sacc+=A1; sacc+=A2; sacc+=A3; PIN(sacc); W0; W1; PIN(PW); SBAR(); }while(0)
  #define EX(v) __builtin_amdgcn_exp2f(v)
  #define GAPB(MF,X,B) do{ MF; X[B]=EX(X[B]); X[B+1]=EX(X[B+1]); X[B+2]=EX(X[B+2]); X[B+3]=EX(X[B+3]); PIN(X); SBAR(); }while(0)
  #define VRD(i) do{ vlo[i]=vtr(vp_+(((i)>>2)*4096+((i)&3)*1024)); vhi[i]=vtr(vp_+(((i)>>2)*4096+((i)&3)*1024+512)); }while(0)
  #define VRX(i) do{ vlo[i]=vtr(vp_+((((i)>>2)+2)*4096+((i)&3)*1024)); vhi[i]=vtr(vp_+((((i)>>2)+2)*4096+((i)&3)*1024+512)); SBAR(); }while(0)
  #define GAPB2(MF,X,B) do{ MF; X[B]=EX(X[B]-mhat); X[B+1]=EX(X[B+1]-mhat); PIN(X); SBAR(); }while(0)
  #define KRD(G,j) do{ if(G){ kload2(kf,kp0+sl_next,j); SBAR(); } }while(0)
  #define STEP(C0,C1,P0,P1,t,GK,GV,GL) do{ SBAR(); \
    const lds_cptr vp_=vp0+2*sl_prev; \
    VRD(0); SBAR(); float sacc=(P0[0]+P0[1]); \
    GAPA(C0=__builtin_amdgcn_mfma_f32_32x32x16_bf16(kf[0],qr[0],zc,0,0,0), P0[2],P0[3],P0[4],P0[5],     pw0[0]=PKW(P0,0), pw0[1]=PKW(P0,2), pw0); \
    VRD(4); SBAR(); GAPA(C1=__builtin_amdgcn_mfma_f32_32x32x16_bf16(kf[1],qr[0],zc,0,0,0), P0[6],P0[7],P0[8],P0[9],     pw0[2]=PKW(P0,4), pw0[3]=PKW(P0,6), pw0); \
    VRD(1); SBAR(); GAPA(C0=__builtin_amdgcn_mfma_f32_32x32x16_bf16(kf[2],qr[1],C0,0,0,0),   P0[10],P0[11],P0[12],P0[13], pw1[0]=PKW(P0,8), pw1[1]=PKW(P0,10), pw1); \
    VRD(5); SBAR(); GAPA(C1=__builtin_amdgcn_mfma_f32_32x32x16_bf16(kf[3],qr[1],C1,0,0,0),   P0[14],P0[15],P1[0],P1[1],   pw1[2]=PKW(P0,12),pw1[3]=PKW(P0,14), pw1); \
    VRD(2); SBAR(); GAPA(C0=__builtin_amdgcn_mfma_f32_32x32x16_bf16(kf[4],qr[2],C0,0,0,0),   P1[2],P1[3],P1[4],P1[5],     pw2[0]=PKW(P1,0), pw2[1]=PKW(P1,2), pw2); \
    VRD(6); SBAR(); GAPA(C1=__builtin_amdgcn_mfma_f32_32x32x16_bf16(kf[5],qr[2],C1,0,0,0),   P1[6],P1[7],P1[8],P1[9],     pw2[2]=PKW(P1,4), pw2[3]=PKW(P1,6), pw2); \
    VRD(3); SBAR(); GAPA(C0=__builtin_amdgcn_mfma_f32_32x32x16_bf16(kf[6],qr[3],C0,0,0,0),   P1[10],P1[11],P1[12],P1[13], pw3[0]=PKW(P1,8), pw3[1]=PKW(P1,10), pw3); \
    VRD(7); SBAR(); GAPA(C1=__builtin_amdgcn_mfma_f32_32x32x16_bf16(kf[7],qr[3],C1,0,0,0),   P1[14],P1[15],0.f,0.f,       pw3[2]=PKW(P1,12),pw3[3]=PKW(P1,14), pw3); \
    l_reg+=sacc; \
    if(GK){DMA_K((t)+3,sl_cur);} if(GV){DMA_V((t)+1,sl_next);} \
    CMASK(C0,C1,t); \
    { float a=MX3(C0[0],C0[1],C1[0]),b=MX3(C0[2],C0[3],C1[1]); a=MX3(a,C1[2],C1[3]); \
      _Pragma("unroll") for(int r=4;r<16;r+=4){a=MX3(a,C0[r],C0[r+1]);b=MX3(b,C0[r+2],C0[r+3]);a=MX3(a,C1[r],C1[r+1]);b=MX3(b,C1[r+2],C1[r+3]);} \
      float rm=__builtin_fmaxf(a,b); { auto rr=__builtin_amdgcn_permlane32_swap(__float_as_uint(rm),__float_as_uint(rm),false,false); rm=__builtin_fmaxf(__uint_as_float(rr[0]),__uint_as_float(rr[1])); } \
      rm-=mhat; resc=false; \
      if(__builtin_expect(__any(rm>(float)THRL),0)){ const float dl=__builtin_fmaxf(rm,0.f); mhat+=dl; \
        const float f=__builtin_amdgcn_exp2f(-dl); l_reg*=f; if(hi==0)wsf[r32]=f; resc=true; } } \
    SBAR(); \
    GAPB2(o[0]=__builtin_amdgcn_mfma_f32_32x32x16_bf16(PAF(0),VFR(0),o[0],0,0,0), C0,0);  VRX(0); \
    GAPB2(o[1]=__builtin_amdgcn_mfma_f32_32x32x16_bf16(PAF(0),VFR(4),o[1],0,0,0), C0,2);  VRX(4); \
    KRD(GL,0); GAPB2(o[0]=__builtin_amdgcn_mfma_f32_32x32x16_bf16(PAF(1),VFR(1),o[0],0,0,0), C0,4);  VRX(1); \
    KRD(GL,1); GAPB2(o[1]=__builtin_amdgcn_mfma_f32_32x32x16_bf16(PAF(1),VFR(5),o[1],0,0,0), C0,6);  VRX(5); \
    KRD(GL,2); GAPB2(o[0]=__builtin_amdgcn_mfma_f32_32x32x16_bf16(PAF(2),VFR(2),o[0],0,0,0), C0,8);  VRX(2); \
    KRD(GL,3); GAPB2(o[1]=__builtin_amdgcn_mfma_f32_32x32x16_bf16(PAF(2),VFR(6),o[1],0,0,0), C0,10); VRX(6); \
    GAPB2(o[0]=__builtin_amdgcn_mfma_f32_32x32x16_bf16(PAF(3),VFR(3),o[0],0,0,0), C0,12); VRX(3); \
    GAPB2(o[1]=__builtin_amdgcn_mfma_f32_32x32x16_bf16(PAF(3),VFR(7),o[1],0,0,0), C0,14); VRX(7); \
    GAPB2(o[2]=__builtin_amdgcn_mfma_f32_32x32x16_bf16(PAF(0),VFR(0),o[2],0,0,0), C1,0); \
    GAPB2(o[3]=__builtin_amdgcn_mfma_f32_32x32x16_bf16(PAF(0),VFR(4),o[3],0,0,0), C1,2); \
    GAPB2(o[2]=__builtin_amdgcn_mfma_f32_32x32x16_bf16(PAF(1),VFR(1),o[2],0,0,0), C1,4); \
    GAPB2(o[3]=__builtin_amdgcn_mfma_f32_32x32x16_bf16(PAF(1),VFR(5),o[3],0,0,0), C1,6); \
    GAPB2(o[2]=__builtin_amdgcn_mfma_f32_32x32x16_bf16(PAF(2),VFR(2),o[2],0,0,0), C1,8); \
    GAPB2(o[3]=__builtin_amdgcn_mfma_f32_32x32x16_bf16(PAF(2),VFR(6),o[3],0,0,0), C1,10); \
    GAPB2(o[2]=__builtin_amdgcn_mfma_f32_32x32x16_bf16(PAF(3),VFR(3),o[2],0,0,0), C1,12); \
    GAPB2(o[3]=__builtin_amdgcn_mfma_f32_32x32x16_bf16(PAF(3),VFR(7),o[3],0,0,0), C1,14); \
    }while(0)
  int t=1;
  #undef CMASK
  #define CMASK(P0,P1,t) do{}while(0)
  for(;t+5<NT;t+=2){
    STEP(pB0,pB1,pA0,pA1,t,true,true,true);     WAIT_BAR(3); RESC(); ROT();
    STEP(pA0,pA1,pB0,pB1,t+1,true,true,true);   WAIT_BAR(3); RESC(); ROT();
  }
  #undef CMASK
  #define CMASK(P0,P1,t) do{int jb_=(t)-(NT-4); if(jb_>=0)cmask(P0,P1,jb_,qrel,hi);}while(0)
  #define ENDW(tt) do{ if((tt)+3<NT){WAIT_BAR(3);} else if((tt)+2<NT){WAIT_BAR(2);} else {WAIT_BAR(0);} }while(0)
  for(;t+1<NT;t+=2){
    STEP(pB0,pB1,pA0,pA1,t,(t+3<NT),(t+1<NT),(t+1<NT));       ENDW(t);   RESC(); ROT();
    STEP(pA0,pA1,pB0,pB1,t+1,(t+4<NT),(t+2<NT),(t+2<NT));     ENDW(t+1); RESC(); ROT();
  }
  STEP(pB0,pB1,pA0,pA1,NT-1,false,false,false); RESC();
  { float sacc=pB0[0]+pB0[1]; _Pragma("unroll") for(int r=2;r<16;++r)sacc+=pB0[r]; _Pragma("unroll") for(int r=0;r<16;++r)sacc+=pB1[r]; l_reg+=sacc;
    pw0=(u32x4){PKW(pB0,0),PKW(pB0,2),PKW(pB0,4),PKW(pB0,6)};pw1=(u32x4){PKW(pB0,8),PKW(pB0,10),PKW(pB0,12),PKW(pB0,14)};pw2=(u32x4){PKW(pB1,0),PKW(pB1,2),PKW(pB1,4),PKW(pB1,6)};pw3=(u32x4){PKW(pB1,8),PKW(pB1,10),PKW(pB1,12),PKW(pB1,14)};
    SBAR(); pv128(o,vb0+2*sl_cur,PAF(0),PAF(1),PAF(2),PAF(3)); }
  #undef PKW
  #undef PAF
  #undef VFR
  #undef PIN
  #undef MX3
  #undef GAPA
  #undef GAPB
  #undef EX
  #undef VRD
  #undef VRX
  #undef GAPB2
  #undef KRD
  #undef STEP
  #undef ENDW
  {auto rr=__builtin_amdgcn_permlane32_swap(__float_as_uint(l_reg),__float_as_uint(l_reg),false,false);l_reg=__uint_as_float(rr[0])+__uint_as_float(rr[1]);}
  if(hi==0)wsf[32+r32]=l_reg;asm volatile("s_waitcnt lgkmcnt(0)":::"memory");
  float rli[16];
  #pragma unroll
  for(int r=0;r<16;++r)rli[r]=__builtin_amdgcn_rcpf(wsf[32+crow(r,hi)]);
  bf16*Ow=O+(rowbase+q0+wid*QBLK)*DM+hv*D;
  { bf16*stg=(bf16*)(shm+LDS_OST2)+wid*2048;
    #pragma unroll
    for(int hp=0;hp<2;++hp){
      #pragma unroll
      for(int r=0;r<16;++r){const int orow=crow(r,hi);
        #pragma unroll
        for(int d0=0;d0<2;++d0)stg[orow*64+d0*32+r32]=__float2bfloat16(o[2*hp+d0][r]*rli[r]);}
      asm volatile("s_waitcnt lgkmcnt(0)":::"memory");
      #pragma unroll
      for(int i=0;i<4;++i){const int row=i*8+(lane>>3),ch=lane&7; const u32x4 v=*(const u32x4*)(stg+row*64+ch*8); ATTN_STORE16(Ow+(long)row*DM+hp*64+ch*8,v);}
      asm volatile("s_waitcnt lgkmcnt(0)":::"memory"); } }
  asm volatile("s_waitcnt lgkmcnt(0)\n\ts_barrier":::"memory");
  #undef DMA_K
  #undef DMA_V
  #undef CMASK
  #undef START
  #undef RESC
  #undef ROT
}
constexpr int ATTN_LDS_BYTES=LDS_BYTES;
#undef SBAR
#undef WAIT_BAR
}
#define GAS __attribute__((address_space(1)))
#define LAS __attribute__((address_space(3)))
typedef unsigned short bf16;
typedef unsigned v4u __attribute__((ext_vector_type(4)));
typedef float f32x4 __attribute__((ext_vector_type(4)));
typedef short bf16x8 __attribute__((ext_vector_type(8)));
typedef GAS unsigned gu32;
typedef GAS unsigned long long gu64;
#define RLX_AGENT __ATOMIC_RELAXED, __HIP_MEMORY_SCOPE_AGENT
#define LDS_WAIT() asm volatile("s_waitcnt lgkmcnt(0)" ::: "memory")
#define VM_WAIT() asm volatile("s_waitcnt vmcnt(0)" ::: "memory")
__device__ __forceinline__ unsigned long long rt() { return __builtin_amdgcn_s_memrealtime(); }
__device__ __forceinline__ unsigned f2bf(float f) { unsigned u = __builtin_bit_cast(unsigned, f); return (u + 0x7fffu + ((u >> 16) & 1u)) >> 16; }
__device__ __forceinline__ unsigned pk2(float lo, float hi) { return f2bf(lo) | (f2bf(hi) << 16); }

#define XB_TMO      128
#define XB_XCNT(j)  (256  + 64 * (j))
#define XB_XSUB(j)  (1280 + 64 * (j))
#define XB_XGEN(j)  (2304 + 64 * (j))
#define XB_TOP      3328
#define XB_TOPGEN   3392
#define XCD_BAR_WORDS 3456
#define XB_SPIN_CAP (1u << 18)

__device__ __forceinline__ unsigned xb_ld(unsigned* p)              { return __hip_atomic_load(p, __ATOMIC_RELAXED, __HIP_MEMORY_SCOPE_AGENT); }
__device__ __forceinline__ unsigned xb_add(unsigned* p, unsigned v) { return __hip_atomic_fetch_add(p, v, __ATOMIC_RELAXED, __HIP_MEMORY_SCOPE_AGENT); }
__device__ __forceinline__ unsigned xb_xcc_id() { return (unsigned)__builtin_amdgcn_s_getreg((3 << 11) | 20) & 0xFu; }
#define XB_SPIN(cond, bar) do { unsigned _sp = 0; while (cond) { __builtin_amdgcn_s_sleep(1); \
    if ((++_sp & 255u) == 0u) { if (xb_ld(&(bar)[XB_TMO])) break; if (_sp > XB_SPIN_CAP) { atomicAdd(&(bar)[XB_TMO], 1u); break; } } } } while (0)

struct XcdBarrier {
    unsigned* bar; unsigned x;
    volatile LAS unsigned* st;
};

__device__ __forceinline__ XcdBarrier xcd_barrier_post(unsigned* bar, volatile LAS unsigned* st) {
    XcdBarrier b; b.bar = bar; b.x = xb_xcc_id(); b.st = st;
    if (opaque_tid() == 0) (void)xb_add(&bar[XB_XCNT(b.x)], 1u);
    return b;
}
__device__ __forceinline__ void xcd_barrier_complete(unsigned* bar, unsigned x, unsigned& nloc, unsigned& nx) {
    const unsigned G = gridDim.x * gridDim.y * gridDim.z;
    unsigned sum, cnt, mine, sp = 0u;
    for (;;) {
        sum = 0u; cnt = 0u;
#pragma unroll
        for (unsigned j = 0; j < 16; ++j) { const unsigned c = xb_ld(&bar[XB_XCNT(j)]); sum += c; cnt += (c > 0u) ? 1u : 0u; }
        if (sum == G) break;
        __builtin_amdgcn_s_sleep(1);
        if ((++sp & 255u) == 0u) { if (xb_ld(&bar[XB_TMO])) break; if (sp > XB_SPIN_CAP) { atomicAdd(&bar[XB_TMO], 1u); break; } }
    }
    mine = xb_ld(&bar[XB_XCNT(x)]);
    nloc = mine > 0u ? mine : 1u; nx = cnt > 0u ? cnt : 1u;
}

__device__ __forceinline__ void xcd_barrier(const XcdBarrier& b) {
    asm volatile("s_waitcnt vmcnt(0)" ::: "memory");
    __syncthreads();
    if (opaque_tid() == 0) {
        unsigned* bar = b.bar;
        __builtin_amdgcn_s_waitcnt(0);
        unsigned nloc = b.st[0], nx = b.st[1];
        if (nloc == 0u) { xcd_barrier_complete(bar, b.x, nloc, nx); b.st[0] = nloc; b.st[1] = nx; }
        const unsigned old = xb_add(&bar[XB_XSUB(b.x)], 1u);
        const unsigned gen = old / nloc;
        if (old + 1u == (gen + 1u) * nloc) {
            __builtin_amdgcn_fence(__ATOMIC_RELEASE, "agent");
            asm volatile("s_waitcnt vmcnt(0)" ::: "memory");
            const unsigned og = xb_add(&bar[XB_TOP], 1u);
            const unsigned tg = og / nx;
            if (og + 1u == (tg + 1u) * nx) xb_add(&bar[XB_TOPGEN], 1u);
            else XB_SPIN(xb_ld(&bar[XB_TOPGEN]) == tg, bar);
            __builtin_amdgcn_fence(__ATOMIC_ACQUIRE, "agent");
            xb_add(&bar[XB_XGEN(b.x)], 1u);
            asm volatile("s_waitcnt vmcnt(0)" ::: "memory");
        } else {
            XB_SPIN(xb_ld(&bar[XB_XGEN(b.x)]) == gen, bar);
            __builtin_amdgcn_fence(__ATOMIC_ACQUIRE, "agent");
            asm volatile("s_waitcnt vmcnt(0)" ::: "memory");
        }
    }
    __syncthreads();
}
constexpr int NWAVES = 8;
constexpr int DM = 1024, MP = 32768, MS = 512, MROWS = MP + MS, NSEQ = 20, DEPTH = 4, DFF = 2816, DIN = 9216, PAST = 2048;
constexpr int NCHUNK_P = 512, NCHUNK = 528;
constexpr float EPS = 1e-6f;
constexpr size_t OY_P = 0, OY_S = 33554432, OK_P = 34078720, OV_P = 168296448, OS_P = 302514176, OK_S = 304611328, OV_S = 306708480, OS_S = 308805632, OUT_TOTAL = 317194240;

constexpr size_t MiB = 1u << 20;
constexpr size_t WS_CTL = 0, CTL_ZERO_BYTES = 1 * MiB;
constexpr size_t WS_MOD = 1 * MiB;
constexpr size_t WS_LB = 4 * MiB;
constexpr size_t WS_W = 8 * MiB, W_LAYER = 57 * MiB;
constexpr size_t WO_GU1 = 0, WO_D1 = 11 * MiB, WO_IN = 16 * MiB + MiB / 2, WO_BA = 34 * MiB + MiB / 2, WO_BH = 36 * MiB + MiB / 2, WO_OUT = 38 * MiB + MiB / 2, WO_GU2 = 40 * MiB + MiB / 2, WO_D2 = 51 * MiB + MiB / 2;
constexpr size_t WS_X = 240 * MiB;
constexpr size_t WS_XN = 370 * MiB;
constexpr size_t WS_Q = 435 * MiB, WS_K = 500 * MiB, WS_V = 565 * MiB;
constexpr size_t WS_QQ = 630 * MiB, WS_KK = 695 * MiB, WS_VV = 760 * MiB, WS_HGS = 825 * MiB, WS_SZA = 890 * MiB, WS_SZH = 955 * MiB;
constexpr size_t WS_LOGF = 1020 * MiB;
constexpr size_t WS_O1 = 1150 * MiB, WS_O2 = 1215 * MiB, WS_OATT = 1280 * MiB, WS_OH = 1345 * MiB, WS_MRG = 1410 * MiB;
constexpr size_t WS_BIG = 1475 * MiB;
constexpr size_t WS_SST = 1739 * MiB;
constexpr size_t WS_DD = 1871 * MiB;
constexpr size_t WS_END = 1874 * MiB;
#ifndef TEAM_STRIDE
#define TEAM_STRIDE 16
#endif
#ifndef STARTERS
#define STARTERS 8
#endif
constexpr int T_TEAM = 256 / TEAM_STRIDE;
#ifndef G3_STAGGER_TICKS
#define G3_STAGGER_TICKS 800
#endif
#ifndef HG_SEGS
#define HG_SEGS 4
#endif
constexpr int HG_G = HG_SEGS;
constexpr size_t WS_QS = WS_BIG, WS_SL = WS_BIG + 64 * MiB, WS_DSEG = WS_BIG + 96 * MiB, WS_RAW = WS_SST;
constexpr int CW_BAR = 4096, CW_Q = 8192, CW_HS = 16384;
static_assert(pg8::EpiWin::O_Q == WS_Q && pg8::EpiWin::O_K == WS_K && pg8::EpiWin::O_V == WS_V && pg8::EpiWin::O_QQ == WS_QQ && pg8::EpiWin::O_KK == WS_KK && pg8::EpiWin::O_VV == WS_VV && pg8::EpiWin::O_HGS == WS_HGS && pg8::EpiWin::O_SZA == WS_SZA && pg8::EpiWin::O_SZH == WS_SZH && pg8::EpiWin::O_LOGF == WS_LOGF && pg8::EpiWin::O_LB == WS_LB && pg8::EpiWin::OK_P_ == OK_P && pg8::EpiWin::OV_P_ == OV_P && pg8::EpiWin::OK_S_ == OK_S && pg8::EpiWin::OV_S_ == OV_S, "EpiWin offsets");

constexpr int RING_OFF = 0, RING_BYTES = 139264;
constexpr int LDSCTL_OFF = RING_BYTES, MISC_OFF = LDSCTL_OFF + 320;
constexpr int LDS_BYTES = 147456;

struct Frame {
    LAS unsigned char* lds;
    volatile LAS unsigned* MISC;
    gu32* ctl;
    int tid, lane, wave;
    int vcu, G;
};
typedef float f32x16 __attribute__((ext_vector_type(16)));
typedef unsigned v2u __attribute__((ext_vector_type(2)));

__device__ __forceinline__ float shx(float v, int mask, int lane) { return __builtin_bit_cast(float, __builtin_amdgcn_ds_bpermute((lane ^ mask) << 2, __builtin_bit_cast(int, v))); }
__device__ __forceinline__ float wave_sum(float v, int lane) {
#pragma unroll
    for (int o = 1; o < 64; o <<= 1) v += shx(v, o, lane);
    return v;
}
__device__ __forceinline__ float bf2f(bf16 b) { return __builtin_bit_cast(float, (unsigned)b << 16); }
__device__ __forceinline__ unsigned cvtpk(float lo, float hi) { return pg8::cvt_pk_bf16(lo, hi); }
__device__ __forceinline__ bf16x8 pack8(f32x4 a, f32x4 b) { v4u w; w.x = cvtpk(a[0], a[1]); w.y = cvtpk(a[2], a[3]); w.z = cvtpk(b[0], b[1]); w.w = cvtpk(b[2], b[3]); return __builtin_bit_cast(bf16x8, w); }
__device__ __forceinline__ float lam_init_of(int l) { asm volatile("" : "+s"(l)); return 0.8f - 0.6f * __expf(-0.3f * (float)l); }

__device__ __forceinline__ void p0_transpose_item(const float* W, int K, int N, bf16* WT, bool gu, LAS float* scr, int item, int lane) {
    const int nblk = N / 32, kb = item / nblk, nb = item % nblk, k0 = 64 * kb, nd0 = 32 * nb;
    const int ns0 = gu ? (((nd0 >> 7) & 1) * 2816 + (nd0 >> 8) * 128 + (nd0 & 127)) : nd0;
#pragma unroll 8
    for (int i = 0; i < 32; ++i) { const int kk = 2 * i + (lane >> 5); scr[kk * 33 + (lane & 31)] = W[(size_t)(k0 + kk) * N + ns0 + (lane & 31)]; }
    LDS_WAIT(); asm volatile("" ::: "memory");
    const int c = lane & 7;
#pragma unroll
    for (int j = 0; j < 4; ++j) { const int n = (lane >> 3) + 8 * j; const LAS float* s = scr + (8 * c) * 33 + n;
        v4u o; o.x = pk2(s[0 * 33], s[1 * 33]); o.y = pk2(s[2 * 33], s[3 * 33]); o.z = pk2(s[4 * 33], s[5 * 33]); o.w = pk2(s[6 * 33], s[7 * 33]);
        *(GAS v4u*)(WT + (size_t)(nd0 + n) * K + k0 + 8 * c) = o; }
    LDS_WAIT(); asm volatile("" ::: "memory");
}
typedef const __attribute__((address_space(4))) char* kaptr_t;
__device__ __forceinline__ const float* karg(int i) { kaptr_t ka = (kaptr_t)__builtin_amdgcn_kernarg_segment_ptr(); asm volatile("" : "+s"(ka)); return *(const float* const __attribute__((address_space(4)))*)(ka + 8 * i); }
enum { A_XP = 0, A_XS, A_CK, A_CV, A_ST, A_CP, A_CS, A_WADA, A_BADA, A_GFFN1, A_WGU1, A_WD1, A_GMIX, A_WIN, A_LAM, A_GSUB, A_LBL, A_GHG, A_WBA, A_WBH, A_WOUT, A_GFFN2, A_WGU2, A_WD2, A_GFIN, A_OUT, A_WS };
__device__ __forceinline__ void p0_prologue(Frame& F, unsigned char* ws) {
    { LAS float* scr = (LAS float*)(F.lds + RING_OFF + F.wave * 16384);
      const int gw = F.vcu * NWAVES + F.wave, NGW = F.G * NWAVES;
      constexpr int I_GU = 16 * 176, I_D = 44 * 32, I_IN = 16 * 288, I_SQ = 16 * 32, I_LAYER = 2 * I_GU + 2 * I_D + I_IN + 3 * I_SQ;
      for (int it = gw; it < DEPTH * I_LAYER; it += NGW) {
          const int l = it / I_LAYER; int r = it % I_LAYER; unsigned char* wl = ws + WS_W + (size_t)l * W_LAYER;
          if (r < I_GU) { p0_transpose_item(karg(A_WGU1) + (size_t)l * 1024 * 5632, 1024, 5632, (bf16*)(wl + WO_GU1), true, scr, r, F.lane); continue; } r -= I_GU;
          if (r < I_D)  { p0_transpose_item(karg(A_WD1) + (size_t)l * 2816 * 1024, 2816, 1024, (bf16*)(wl + WO_D1), false, scr, r, F.lane); continue; } r -= I_D;
          if (r < I_IN) { p0_transpose_item(karg(A_WIN) + (size_t)l * 1024 * 9216, 1024, 9216, (bf16*)(wl + WO_IN), false, scr, r, F.lane); continue; } r -= I_IN;
          if (r < I_SQ) { p0_transpose_item(karg(A_WBA) + (size_t)l * 1024 * 1024, 1024, 1024, (bf16*)(wl + WO_BA), false, scr, r, F.lane); continue; } r -= I_SQ;
          if (r < I_SQ) { p0_transpose_item(karg(A_WBH) + (size_t)l * 1024 * 1024, 1024, 1024, (bf16*)(wl + WO_BH), false, scr, r, F.lane); continue; } r -= I_SQ;
          if (r < I_SQ) { p0_transpose_item(karg(A_WOUT) + (size_t)l * 1024 * 1024, 1024, 1024, (bf16*)(wl + WO_OUT), false, scr, r, F.lane); continue; } r -= I_SQ;
          if (r < I_GU) { p0_transpose_item(karg(A_WGU2) + (size_t)l * 1024 * 5632, 1024, 5632, (bf16*)(wl + WO_GU2), true, scr, r, F.lane); continue; } r -= I_GU;
          p0_transpose_item(karg(A_WD2) + (size_t)l * 2816 * 1024, 2816, 1024, (bf16*)(wl + WO_D2), false, scr, r, F.lane);
      } }
    __syncthreads();
    { const float* c_p = karg(A_CP); const float* c_s = karg(A_CS); const float* w_ada = karg(A_WADA); const float* b_ada = karg(A_BADA);
      LAS float* ca = (LAS float*)(F.lds);
      LAS float* red = (LAS float*)(F.lds + 81920);
      for (int i = F.tid; i < NSEQ * 1024; i += NWAVES * 64) { const int s = i >> 10, k = i & 1023; const float c = s < 4 ? c_p[s * 1024 + k] : c_s[(s - 4) * 1024 + k]; ca[i] = pg8::silu_f(c); }
      __syncthreads();
      float* MOD = (float*)(ws + WS_MOD);
      for (int it = F.vcu; it < DEPTH * 144; it += F.G) {
          const int l = it / 144, n = (it % 144) * 64 + F.lane; const float* wp = w_ada + ((size_t)l * 1024 + F.wave * 128) * 9216 + n;
          float acc[NSEQ];
#pragma unroll
          for (int s = 0; s < NSEQ; ++s) acc[s] = 0.f;
#pragma unroll 4
          for (int k = 0; k < 128; ++k) { const float w = wp[(size_t)k * 9216];
#pragma unroll
              for (int s = 0; s < NSEQ; ++s) acc[s] += ca[s * 1024 + F.wave * 128 + k] * w; }
#pragma unroll
          for (int s = 0; s < NSEQ; ++s) red[(F.wave * NSEQ + s) * 64 + F.lane] = acc[s];
          __syncthreads();
          for (int i = F.tid; i < NSEQ * 64; i += NWAVES * 64) { const int s = i >> 6, c = i & 63; float v = 0.f;
#pragma unroll
              for (int w = 0; w < 8; ++w) v += red[(w * NSEQ + s) * 64 + c];
              const int nn = (it % 144) * 64 + c; MOD[((size_t)l * NSEQ + s) * 9216 + nn] = v + b_ada[(size_t)l * 9216 + nn]; }
          __syncthreads();
      } }
    if (F.vcu == 0) { float* LB = (float*)(ws + WS_LB); const float* lb_logits = karg(A_LBL);
        for (int c = F.tid; c < 1024; c += NWAVES * 64) { float lg[4], mx = -INFINITY;
#pragma unroll
            for (int l = 0; l < 4; ++l) { lg[l] = lb_logits[l * 1024 + c]; mx = __builtin_fmaxf(mx, lg[l]); }
            float sum = 0.f;
#pragma unroll
            for (int l = 0; l < 4; ++l) { lg[l] = __expf(lg[l] - mx); sum += lg[l]; }
            const float inv = 1.f / sum; float cs = 0.f;
#pragma unroll
            for (int l = 0; l < 4; ++l) { cs += lg[l] * inv; LB[l * 1024 + c] = cs - lg[0] * inv; } } }
}

#ifndef NRF
#define NRF 2
#endif
__device__ __forceinline__ float bfu(unsigned b) { return __builtin_bit_cast(float, b << 16); }
__device__ __forceinline__ void norm_phase(Frame& F, const void* X, bool xf32, const float* g, const float* mod_l, int sub, bf16* XN, int row0, int row1, int gw, int NGW) {
    const int RW = (row1 - row0) / NGW, rbeg = row0 + gw * RW;
    const float* mp = mod_l + (size_t)pg8::row_seq(rbeg) * 9216 + sub * 3 * 1024;
    f32x4 av[4], bv[4];
#pragma unroll
    for (int j = 0; j < 4; ++j) { const int c = 4 * F.lane + 256 * j; const f32x4 gg = *(const f32x4*)(g + c), sc = *(const f32x4*)(mp + 1024 + c); bv[j] = *(const f32x4*)(mp + c); av[j] = gg * (sc + 1.f); }
    for (int i = 0; i < RW; i += NRF) {
        const int row = rbeg + i;
        f32x4 v[NRF][4]; float s2[NRF];
#pragma unroll
        for (int u = 0; u < NRF; ++u) s2[u] = 0.f;
        if (xf32) { const f32x4* xr = (const f32x4*)((const float*)X + (size_t)row * DM) + F.lane;
#pragma unroll
            for (int u = 0; u < NRF; ++u)
#pragma unroll
                for (int j = 0; j < 4; ++j) v[u][j] = xr[u * 256 + 64 * j];
        } else { const v2u* xr = (const v2u*)((const bf16*)X + (size_t)row * DM) + F.lane; v2u t[NRF][4];
#pragma unroll
            for (int u = 0; u < NRF; ++u)
#pragma unroll
                for (int j = 0; j < 4; ++j) t[u][j] = xr[u * 256 + 64 * j];
#pragma unroll
            for (int u = 0; u < NRF; ++u)
#pragma unroll
                for (int j = 0; j < 4; ++j) { v[u][j].x = bfu(t[u][j].x & 0xffffu); v[u][j].y = bfu(t[u][j].x >> 16); v[u][j].z = bfu(t[u][j].y & 0xffffu); v[u][j].w = bfu(t[u][j].y >> 16); } }
#pragma unroll
        for (int u = 0; u < NRF; ++u)
#pragma unroll
            for (int j = 0; j < 4; ++j) s2[u] += (v[u][j].x * v[u][j].x + v[u][j].y * v[u][j].y) + (v[u][j].z * v[u][j].z + v[u][j].w * v[u][j].w);
#pragma unroll
        for (int u = 0; u < NRF; ++u) { const float rstd = __builtin_amdgcn_rsqf(wave_sum(s2[u], F.lane) * (1.f / DM) + EPS);
            v2u* o8 = (v2u*)(XN + (size_t)(row + u) * DM) + F.lane;
#pragma unroll
            for (int j = 0; j < 4; ++j) { const f32x4 h = (v[u][j] * rstd) * av[j] + bv[j]; v2u o; o.x = cvtpk(h.x, h.y); o.y = cvtpk(h.z, h.w); o8[64 * j] = o; } }
    }
}
__device__ __forceinline__ void final_norm_phase(Frame& F, const bf16* X, const float* g, float* out) {
    const int gw = F.vcu * NWAVES + F.wave, NGW = F.G * NWAVES;
    for (int row = gw; row < MROWS; row += NGW) {
        const v2u* xr = (const v2u*)(X + (size_t)row * DM) + F.lane; f32x4 v[4]; float s2 = 0.f;
#pragma unroll
        for (int j = 0; j < 4; ++j) { const v2u t = xr[64 * j]; v[j].x = bfu(t.x & 0xffffu); v[j].y = bfu(t.x >> 16); v[j].z = bfu(t.y & 0xffffu); v[j].w = bfu(t.y >> 16); s2 += (v[j].x * v[j].x + v[j].y * v[j].y) + (v[j].z * v[j].z + v[j].w * v[j].w); }
        const float rstd = __builtin_amdgcn_rsqf(wave_sum(s2, F.lane) * (1.f / DM) + EPS);
        f32x4* o = (f32x4*)(out + (row < MP ? OY_P + (size_t)row * DM : OY_S + (size_t)(row - MP) * DM)) + F.lane;
#pragma unroll
        for (int j = 0; j < 4; ++j) { const f32x4 gg = *(const f32x4*)(g + 4 * F.lane + 256 * j); o[64 * j] = (v[j] * rstd) * gg; }
    }
}
__device__ __forceinline__ float lam_of(const float* att_lambda, int l, int lane) {
    const float* lp = att_lambda + (size_t)l * 256;
    const float a = wave_sum(lp[lane] * lp[64 + lane], lane), b = wave_sum(lp[128 + lane] * lp[192 + lane], lane);
    return __expf(a) - __expf(b) + lam_init_of(l);
}
__device__ __forceinline__ void attn_combine_phase(Frame& F, const bf16* O1, const bf16* O2, const float* gsub, float lam, float osc, bf16* OATT) {
    const int gw = F.vcu * NWAVES + F.wave, NGW = F.G * NWAVES; const int cl = (F.lane & 7) * 16;
    float gv[16];
#pragma unroll
    for (int i = 0; i < 16; ++i) gv[i] = gsub[cl + i] * osc;
    for (int row = gw; row < MP; row += 2 * NGW) {
        v4u a0[2], a1[2], b0[2], b1[2];
#pragma unroll
        for (int u = 0; u < 2; ++u) { const size_t off = (size_t)(row + u * NGW) * DM + F.lane * 16; a0[u] = *(const v4u*)(O1 + off); a1[u] = *(const v4u*)(O1 + off + 8); b0[u] = *(const v4u*)(O2 + off); b1[u] = *(const v4u*)(O2 + off + 8); }
#pragma unroll
        for (int u = 0; u < 2; ++u) { const size_t off = (size_t)(row + u * NGW) * DM + F.lane * 16;
            const unsigned aw[8] = {a0[u].x, a0[u].y, a0[u].z, a0[u].w, a1[u].x, a1[u].y, a1[u].z, a1[u].w}, bw[8] = {b0[u].x, b0[u].y, b0[u].z, b0[u].w, b1[u].x, b1[u].y, b1[u].z, b1[u].w};
            float o[16]; float ss = 0.f;
#pragma unroll
            for (int i = 0; i < 8; ++i) { o[2 * i] = pg8::bf_lo(aw[i]) - lam * pg8::bf_lo(bw[i]); o[2 * i + 1] = pg8::bf_hi(aw[i]) - lam * pg8::bf_hi(bw[i]); ss += o[2 * i] * o[2 * i] + o[2 * i + 1] * o[2 * i + 1]; }
            ss += shx(ss, 1, F.lane); ss += shx(ss, 2, F.lane); ss += shx(ss, 4, F.lane);
            const float rstd = __builtin_amdgcn_rsqf(ss * (1.f / 128.f) + EPS);
            v4u w0, w1;
            w0.x = cvtpk(o[0] * rstd * gv[0], o[1] * rstd * gv[1]); w0.y = cvtpk(o[2] * rstd * gv[2], o[3] * rstd * gv[3]); w0.z = cvtpk(o[4] * rstd * gv[4], o[5] * rstd * gv[5]); w0.w = cvtpk(o[6] * rstd * gv[6], o[7] * rstd * gv[7]);
            w1.x = cvtpk(o[8] * rstd * gv[8], o[9] * rstd * gv[9]); w1.y = cvtpk(o[10] * rstd * gv[10], o[11] * rstd * gv[11]); w1.z = cvtpk(o[12] * rstd * gv[12], o[13] * rstd * gv[13]); w1.w = cvtpk(o[14] * rstd * gv[14], o[15] * rstd * gv[15]);
            *(v4u*)(OATT + off) = w0; *(v4u*)(OATT + off + 8) = w1; }
    }
}

__device__ __forceinline__ void attn_sample_unit(Frame& F, const float* cache_k, const float* cache_v, int l, int s, int head, const bf16* Qb, const bf16* Kb, const bf16* Vb, float lam, float osc, const float* gsub, bf16* OATT) {
    const int lane = F.lane, w = F.wave, q = lane & 31, hh = lane >> 5, vt = w & 3, kh = w >> 2;
    LAS float* SLOT = (LAS float*)(F.lds);
    LAS float* ML = (LAS float*)(F.lds + 16384);
    LAS float* SSQ = (LAS float*)(F.lds + 16384 + 512);
    const size_t qrow = (size_t)MP + (size_t)s * 32;
    const float* ck = cache_k + ((size_t)(l * 16 + s) * PAST) * 1024 + head * 128;
    const float* cv = cache_v + ((size_t)(l * 16 + s) * PAST) * 1024 + head * 128;
    f32x16 o1;
#pragma unroll
    for (int r = 0; r < 16; ++r) o1[r] = 0.f;
    for (int m = 0; m < 2; ++m) {
        bf16x8 qf[4];
#pragma unroll
        for (int ks = 0; ks < 4; ++ks) qf[ks] = *(const bf16x8*)(Qb + (qrow + q) * 1024 + head * 128 + m * 64 + ks * 16 + 8 * hh);
        float mrun = -INFINITY, lrun = 0.f; f32x16 ot;
#pragma unroll
        for (int r = 0; r < 16; ++r) ot[r] = 0.f;
        const int ntile = 32 + kh;
        f32x4 kraw[8]; float vraw[16];
#define SA_ISSUE(tt) do { const int k0_ = kh * 1024 + (tt) * 32; const float* kp = ck + (size_t)(k0_ + q) * 1024 + m * 64 + 8 * hh; const float* vp = cv + (size_t)(k0_ + 4 * hh) * 1024 + 32 * vt + q; \
            _Pragma("unroll") for (int ks = 0; ks < 4; ++ks) { kraw[2 * ks] = *(const f32x4*)(kp + ks * 16); kraw[2 * ks + 1] = *(const f32x4*)(kp + ks * 16 + 4); } \
            _Pragma("unroll") for (int s2 = 0; s2 < 2; ++s2) _Pragma("unroll") for (int j = 0; j < 8; ++j) vraw[s2 * 8 + j] = vp[(16 * s2 + 8 * (j >> 2) + (j & 3)) * 1024]; } while (0)
        SA_ISSUE(0);
        for (int t = 0; t < ntile; ++t) {
            const bool nw = (t == 32);
            bf16x8 kf[4]; bf16x8 awv[2];
            if (!nw) {
#pragma unroll
                for (int ks = 0; ks < 4; ++ks) kf[ks] = pack8(kraw[2 * ks], kraw[2 * ks + 1]);
#pragma unroll
                for (int s2 = 0; s2 < 2; ++s2) { v4u aw; aw.x = cvtpk(vraw[s2 * 8 + 0], vraw[s2 * 8 + 1]); aw.y = cvtpk(vraw[s2 * 8 + 2], vraw[s2 * 8 + 3]); aw.z = cvtpk(vraw[s2 * 8 + 4], vraw[s2 * 8 + 5]); aw.w = cvtpk(vraw[s2 * 8 + 6], vraw[s2 * 8 + 7]); awv[s2] = __builtin_bit_cast(bf16x8, aw); }
                asm volatile("" ::: "memory");
                if (t + 1 < 32) SA_ISSUE(t + 1);
                asm volatile("" ::: "memory");
            } else {
#pragma unroll
                for (int ks = 0; ks < 4; ++ks) kf[ks] = *(const bf16x8*)(Kb + (qrow + q) * 1024 + head * 128 + m * 64 + ks * 16 + 8 * hh);
                const bf16* vpn = Vb + (qrow + 4 * hh) * 1024 + head * 128 + 32 * vt + q;
#pragma unroll
                for (int s2 = 0; s2 < 2; ++s2) { float vf[8];
#pragma unroll
                    for (int j = 0; j < 8; ++j) vf[j] = bf2f(vpn[(16 * s2 + 8 * (j >> 2) + (j & 3)) * 1024]);
                    v4u aw; aw.x = cvtpk(vf[0], vf[1]); aw.y = cvtpk(vf[2], vf[3]); aw.z = cvtpk(vf[4], vf[5]); aw.w = cvtpk(vf[6], vf[7]); awv[s2] = __builtin_bit_cast(bf16x8, aw); }
            }
            f32x16 st;
#pragma unroll
            for (int r = 0; r < 16; ++r) st[r] = 0.f;
#pragma unroll
            for (int ks = 0; ks < 4; ++ks) st = __builtin_amdgcn_mfma_f32_32x32x16_bf16(kf[ks], qf[ks], st, 0, 0, 0);
            float tm = st[0];
#pragma unroll
            for (int r = 1; r < 16; ++r) tm = __builtin_fmaxf(tm, st[r]);
            tm = __builtin_fmaxf(tm, shx(tm, 32, lane));
            const float mnew = __builtin_fmaxf(mrun, tm), alpha = __builtin_amdgcn_exp2f(mrun - mnew);
            float ls = 0.f;
#pragma unroll
            for (int r = 0; r < 16; ++r) { st[r] = __builtin_amdgcn_exp2f(st[r] - mnew); ls += st[r]; }
            ls += shx(ls, 32, lane);
            lrun = lrun * alpha + ls; mrun = mnew;
#pragma unroll
            for (int r = 0; r < 16; ++r) ot[r] *= alpha;
#pragma unroll
            for (int s2 = 0; s2 < 2; ++s2) { v4u pw; pw.x = cvtpk(st[8 * s2], st[8 * s2 + 1]); pw.y = cvtpk(st[8 * s2 + 2], st[8 * s2 + 3]); pw.z = cvtpk(st[8 * s2 + 4], st[8 * s2 + 5]); pw.w = cvtpk(st[8 * s2 + 6], st[8 * s2 + 7]);
                ot = __builtin_amdgcn_mfma_f32_32x32x16_bf16(awv[s2], __builtin_bit_cast(bf16x8, pw), ot, 0, 0, 0); }
        }
#undef SA_ISSUE
        if (vt == 0 && hh == 0) { ML[(kh * 32 + q) * 2] = mrun; ML[(kh * 32 + q) * 2 + 1] = lrun; }
        __syncthreads();
        const float m0 = ML[q * 2], l0 = ML[q * 2 + 1], m1 = ML[(32 + q) * 2], l1 = ML[(32 + q) * 2 + 1];
        const float Mx = __builtin_fmaxf(m0, m1), L = l0 * __builtin_amdgcn_exp2f(m0 - Mx) + l1 * __builtin_amdgcn_exp2f(m1 - Mx);
        { const float sc = __builtin_amdgcn_exp2f(mrun - Mx);
#pragma unroll
          for (int r = 0; r < 16; ++r) ot[r] *= sc; }
        if (kh == 1) {
#pragma unroll
            for (int r = 0; r < 16; ++r) SLOT[(vt * 16 + r) * 64 + lane] = ot[r]; }
        __syncthreads();
        if (kh == 0) { const float rl = 1.f / L;
#pragma unroll
            for (int r = 0; r < 16; ++r) ot[r] = (ot[r] + SLOT[(vt * 16 + r) * 64 + lane]) * rl;
            if (m == 0) {
#pragma unroll
                for (int r = 0; r < 16; ++r) o1[r] = ot[r];
            } else { float ss = 0.f;
#pragma unroll
                for (int r = 0; r < 16; ++r) { o1[r] = o1[r] - lam * ot[r]; ss += o1[r] * o1[r]; }
                ss += shx(ss, 32, lane);
                if (hh == 0) SSQ[vt * 32 + q] = ss; } }
        __syncthreads();
    }
    if (kh == 0) {
        const float ss = SSQ[q] + SSQ[32 + q] + SSQ[64 + q] + SSQ[96 + q];
        const float rstd = __builtin_amdgcn_rsqf(ss * (1.f / 128.f) + EPS) * osc;
#pragma unroll
        for (int r = 0; r < 16; ++r) { const int v = 32 * vt + (r & 3) + 8 * (r >> 2) + 4 * hh; OATT[(qrow + q) * 1024 + head * 128 + v] = (bf16)f2bf(o1[r] * rstd * gsub[v]); }
    }
    __syncthreads();
}

constexpr int HS = 72, HK = 136;
__device__ __forceinline__ f32x4 mfma16(bf16x8 a, bf16x8 b, f32x4 c) { return __builtin_amdgcn_mfma_f32_16x16x32_bf16(a, b, c, 0, 0, 0); }
__device__ __forceinline__ void st16bf(LAS bf16* p, const float (&v)[16]) {
    v4u a, b; a.x = cvtpk(v[0], v[1]); a.y = cvtpk(v[2], v[3]); a.z = cvtpk(v[4], v[5]); a.w = cvtpk(v[6], v[7]); b.x = cvtpk(v[8], v[9]); b.y = cvtpk(v[10], v[11]); b.z = cvtpk(v[12], v[13]); b.w = cvtpk(v[14], v[15]);
    *(LAS v4u*)p = a; *(LAS v4u*)(p + 8) = b;
}
struct HgPtrs { const float* LOGF; const bf16 *QQ, *KK, *VV, *HGS; const float* ghg; bf16* OH; bf16* dump; };
typedef float f32x2v __attribute__((ext_vector_type(2)));
__device__ __forceinline__ void hg_load(const HgPtrs& P, size_t ubase  , unsigned k0, int w, int nvalid, unsigned (&qv)[8], unsigned (&kv)[8], unsigned (&vv)[8]) {
    if (w * 8 < nvalid) {
#pragma unroll
        for (int i = 0; i < 8; ++i) { const size_t o = ubase + (size_t)(w * 8 + i) * 1024;
            const bf16* qp = P.QQ + o; const bf16* kp = P.KK + o; const bf16* vp = P.VV + o;
            qv[i] = *(const unsigned*)(qp + k0); kv[i] = *(const unsigned*)(kp + k0); vv[i] = *(const unsigned*)(vp + k0); }
    } else {
#pragma unroll
        for (int i = 0; i < 8; ++i) { qv[i] = 0u; kv[i] = 0u; vv[i] = 0u; }
    }
}
#define HG_BAR() asm volatile("s_waitcnt lgkmcnt(0)\n\ts_barrier" ::: "memory")
template <int MODE> __device__ __forceinline__ void hg_sequence(Frame& F, const HgPtrs& P, size_t row0, int h, int nchunk, int nvalid, const float* s_in, float* s_out, bf16* QS, float* RAW, float* dseg) {
    LAS float* seg = (LAS float*)(F.lds);
    LAS float* part = (LAS float*)(F.lds + 4096);
    LAS float* dvec = (LAS float*)(F.lds + 6144);
    LAS bf16* QH = (LAS bf16*)(F.lds + 8192);
    LAS bf16* QT = QH + 64 * HK;
    LAS bf16* KH = QT + 64 * HK;
    LAS bf16* VT = KH + 160 * HK;
    LAS bf16* KT = VT + 128 * HS;
    LAS bf16* AL = KT + 128 * HS;
    const int w = __builtin_amdgcn_readfirstlane(F.wave), sc = w >> 1, lr_ = F.lane & 15, lq_ = F.lane >> 4; const unsigned k0_ = 2u * (unsigned)F.lane;
    f32x4 S[8];
#pragma unroll
    for (int kb = 0; kb < 8; ++kb)
#pragma unroll
        for (int r = 0; r < 4; ++r) S[kb][r] = s_in ? s_in[(size_t)(16 * kb + 4 * lq_ + r) * 128 + 16 * w + lr_] : 0.f;
    const float gv = P.ghg[16 * w + lr_];
    f32x2v bseg = {0.f, 0.f};
#ifdef PROBE_HSEC
    unsigned long long tacc = 0, tq0 = 0;
#define HT0(id) do { if (PROBE_HSEC == (id)) tq0 = __builtin_amdgcn_s_memrealtime(); } while (0)
#define HT1(id) do { if (PROBE_HSEC == (id)) tacc += __builtin_amdgcn_s_memrealtime() - tq0; } while (0)
#else
#define HT0(id) do {} while (0)
#define HT1(id) do {} while (0)
#endif
    unsigned qv[8], kv[8], vv[8];
    hg_load(P, row0 * 1024 + h * 128, k0_, w, nvalid, qv, kv, vv);
    for (int c = 0; c < nchunk; ++c) {
        int lr = lr_, lq = lq_; unsigned k0 = k0_; asm volatile("" : "+v"(lr), "+v"(lq), "+v"(k0));
        const int lx = lq * 16 + lr;
        const size_t crow = row0 + (size_t)c * 64;
        HT0(1);
        f32x2v cs[8]; { f32x2v run = {0.f, 0.f};
#pragma unroll
            for (int i = 0; i < 8; ++i) { f32x2v lfi; lfi.x = __logf(__builtin_fmaxf(1.f - bfu(kv[i] & 0xffffu), 9.765625e-4f)); lfi.y = __logf(__builtin_fmaxf(1.f - bfu(kv[i] >> 16), 9.765625e-4f));
                run = run + lfi; cs[i] = run; }
            *(LAS f32x2v*)(seg + w * 128 + k0) = run; }
        HG_BAR();
        f32x2v P2[4], mypre = {0.f, 0.f}, tot; { f32x2v p = {0.f, 0.f};
#pragma unroll
            for (int s = 0; s < 8; ++s) { if ((s & 1) == 0) P2[s >> 1] = p; mypre = (s == w) ? p : mypre; p = p + *(const LAS f32x2v*)(seg + s * 128 + k0); } tot = p; }
        f32x2v myref = P2[0], nref = P2[1];
#pragma unroll
        for (int s = 1; s < 4; ++s) { myref = (s == sc) ? P2[s] : myref; nref = (s == sc) ? (s == 3 ? tot : P2[s < 3 ? s + 1 : 3]) : nref; }
        const f32x2v dq = mypre - myref;
        f32x2v fq, fT, fK[4]; fq.x = __expf(myref.x); fq.y = __expf(myref.y); fT.x = __expf(tot.x - nref.x); fT.y = __expf(tot.y - nref.y);
#pragma unroll
        for (int ii = 1; ii < 4; ++ii) { fK[ii].x = __expf(__builtin_fminf(P2[ii].x - nref.x, 0.f)); fK[ii].y = __expf(__builtin_fminf(P2[ii].y - nref.y, 0.f)); }
        f32x2v fqs = fq; if constexpr (MODE == 1) { fqs.x = fq.x * __expf(bseg.x); fqs.y = fq.y * __expf(bseg.y); bseg = bseg + tot; }
        float t0[8], t1[8];
#pragma unroll
        for (int i = 0; i < 8; ++i) { const int r = w * 8 + i; const float q0 = bfu(qv[i] & 0xffffu), q1 = bfu(qv[i] >> 16), a0 = bfu(kv[i] & 0xffffu), a1 = bfu(kv[i] >> 16);
            const float E0 = dq.x + cs[i].x, E1 = dq.y + cs[i].y;
            const float e1x = __expf(E0), e1y = __expf(E1);
            const float e2x = __builtin_fminf(__builtin_amdgcn_rcpf(e1x), 5.5e34f), e2y = __builtin_fminf(__builtin_amdgcn_rcpf(e1y), 5.5e34f);
            const float e3x = __expf((nref.x - myref.x) - E0), e3y = __expf((nref.y - myref.y) - E1);
            *(LAS unsigned*)(QH + r * HK + k0) = cvtpk(q0 * e1x, q1 * e1y);
            *(LAS unsigned*)(QT + r * HK + k0) = cvtpk(q0 * e1x * fq.x, q1 * e1y * fq.y);
            if constexpr (MODE == 1) { bf16* qsp = QS + (crow + r) * 1024 + h * 128; *(unsigned*)(qsp + k0) = cvtpk(q0 * e1x * fqs.x, q1 * e1y * fqs.y); }
            const float b0 = a0 * e3x, b1 = a1 * e3y;
            { const int rb = (sc == 0) ? 0 : (sc == 1) ? 16 : (sc == 2) ? 48 : 96; *(LAS unsigned*)(KH + (rb + r) * HK + k0) = cvtpk(a0 * e2x, a1 * e2y); }
#pragma unroll
            for (int ii = 1; ii < 4; ++ii) if (ii > sc) { const int rb = (ii == 1) ? 16 : (ii == 2) ? 48 : 96; *(LAS unsigned*)(KH + (rb + r) * HK + k0) = cvtpk(b0 * fK[ii].x, b1 * fK[ii].y); }
            t0[i] = b0 * fT.x; t1[i] = b1 * fT.y; }
        { v4u u0, u1; u0.x = cvtpk(t0[0], t0[1]); u0.y = cvtpk(t0[2], t0[3]); u0.z = cvtpk(t0[4], t0[5]); u0.w = cvtpk(t0[6], t0[7]); u1.x = cvtpk(t1[0], t1[1]); u1.y = cvtpk(t1[2], t1[3]); u1.z = cvtpk(t1[4], t1[5]); u1.w = cvtpk(t1[6], t1[7]);
          *(LAS v4u*)(KT + k0 * HS + 8 * w) = u0; *(LAS v4u*)(KT + (k0 + 1) * HS + 8 * w) = u1; }
        { v4u u0, u1;
          u0.x = (vv[0] & 0xffffu) | (vv[1] << 16); u0.y = (vv[2] & 0xffffu) | (vv[3] << 16); u0.z = (vv[4] & 0xffffu) | (vv[5] << 16); u0.w = (vv[6] & 0xffffu) | (vv[7] << 16);
          u1.x = (vv[0] >> 16) | (vv[1] & 0xffff0000u); u1.y = (vv[2] >> 16) | (vv[3] & 0xffff0000u); u1.z = (vv[4] >> 16) | (vv[5] & 0xffff0000u); u1.w = (vv[6] >> 16) | (vv[7] & 0xffff0000u);
          *(LAS v4u*)(VT + k0 * HS + 8 * w) = u0; *(LAS v4u*)(VT + (k0 + 1) * HS + 8 * w) = u1;
          if (w == 0) { f32x2v d; d.x = __expf(tot.x); d.y = __expf(tot.y); *(LAS f32x2v*)(dvec + k0) = d; } }
        HG_BAR();
        HT1(1); HT0(2);
        if (c + 1 < nchunk) hg_load(P, (crow + 64) * 1024 + h * 128, k0, w, nvalid, qv, kv, vv);
        unsigned short hgv[16];
        if constexpr (MODE == 0) { const bf16* hp = P.HGS + crow * 1024 + h * 128 + 16 * w;
#pragma unroll
          for (int mt = 0; mt < 4; ++mt)
#pragma unroll
              for (int r = 0; r < 4; ++r) { int t = 16 * mt + 4 * lq + r; t = t < nvalid ? t : nvalid - 1; hgv[mt * 4 + r] = hp[(unsigned)(t * 1024 + lr)]; } }
#pragma unroll
        for (int rr = 0; rr < 2; ++rr) { const int blk = w + 8 * rr, bi = blk >> 2, bj = blk & 3;
            f32x4 acc = {0.f, 0.f, 0.f, 0.f};
            if (bj <= bi) { const int rb = (bi == 0) ? 0 : (bi == 1) ? 16 : (bi == 2) ? 48 : 96;
#pragma unroll
                for (int ks = 0; ks < 4; ++ks) { const bf16x8 a = *(const LAS bf16x8*)(QH + (16 * bi + lr) * HK + ks * 32 + 8 * lq), b = *(const LAS bf16x8*)(KH + (rb + 16 * bj + lr) * HK + ks * 32 + 8 * lq); acc = mfma16(a, b, acc); }
                if (bi == bj) {
#pragma unroll
                    for (int r = 0; r < 4; ++r) acc[r] = (lr <= 4 * lq + r) ? acc[r] : 0.f; } }
#pragma unroll
            for (int r = 0; r < 4; ++r) AL[(16 * bi + 4 * lq + r) * HS + 16 * bj + lr] = (bf16)f2bf(acc[r]); }
        HG_BAR();
        HT1(2); HT0(3);
        f32x4 o[4];
        { bf16x8 bS[4], bV[2];
#pragma unroll
          for (int kp = 0; kp < 4; ++kp) { v4u t; t.x = cvtpk(S[2 * kp][0], S[2 * kp][1]); t.y = cvtpk(S[2 * kp][2], S[2 * kp][3]); t.z = cvtpk(S[2 * kp + 1][0], S[2 * kp + 1][1]); t.w = cvtpk(S[2 * kp + 1][2], S[2 * kp + 1][3]); bS[kp] = __builtin_bit_cast(bf16x8, t); }
#pragma unroll
          for (int ks = 0; ks < 2; ++ks) bV[ks] = *(const LAS bf16x8*)(VT + (16 * w + lr) * HS + ks * 32 + 8 * lq);
#pragma unroll
          for (int mt = 0; mt < 4; ++mt) { f32x4 acc = {0.f, 0.f, 0.f, 0.f};
#pragma unroll
              for (int kp = 0; kp < 4; ++kp) { const LAS bf16* qp = QT + (16 * mt + lr) * HK + 32 * kp + 4 * lq; const v2u a0 = *(const LAS v2u*)qp, a1 = *(const LAS v2u*)(qp + 16);
                  v4u a; a.x = a0.x; a.y = a0.y; a.z = a1.x; a.w = a1.y; acc = mfma16(__builtin_bit_cast(bf16x8, a), bS[kp], acc); }
#pragma unroll
              for (int ks = 0; ks < 2; ++ks) acc = mfma16(*(const LAS bf16x8*)(AL + (16 * mt + lr) * HS + ks * 32 + 8 * lq), bV[ks], acc);
              o[mt] = acc;
              if constexpr (MODE == 1) { float* rp = RAW + (crow + 16 * mt) * 1024 + h * 128 + 16 * w;
#pragma unroll
                  for (int r = 0; r < 4; ++r) rp[(unsigned)((4 * lq + r) * 1024 + lr)] = acc[r]; }
              if constexpr (MODE == 0)
#pragma unroll
              for (int r = 0; r < 4; ++r) { float p = acc[r] * acc[r]; p += shx(p, 1, lx); p += shx(p, 2, lx); p += shx(p, 4, lx); p += shx(p, 8, lx); if (lr == 0) part[(16 * mt + 4 * lq + r) * 8 + w] = p; } } }
        { bf16x8 bV[2];
#pragma unroll
          for (int ks = 0; ks < 2; ++ks) bV[ks] = *(const LAS bf16x8*)(VT + (16 * w + lr) * HS + ks * 32 + 8 * lq);
#pragma unroll
          for (int kb = 0; kb < 8; ++kb) { const f32x4 d = *(const LAS f32x4*)(dvec + 16 * kb + 4 * lq); f32x4 acc = S[kb] * d;
#pragma unroll
              for (int ks = 0; ks < 2; ++ks) acc = mfma16(*(const LAS bf16x8*)(KT + (16 * kb + lr) * HS + ks * 32 + 8 * lq), bV[ks], acc);
              S[kb] = acc; } }
        if constexpr (MODE == 0) {
        HG_BAR();
        { bf16* op = P.OH + crow * 1024 + h * 128 + 16 * w;
#pragma unroll
          for (int mt = 0; mt < 4; ++mt)
#pragma unroll
              for (int r = 0; r < 4; ++r) { const int t = 16 * mt + 4 * lq + r; const f32x4 p0 = *(const LAS f32x4*)(part + t * 8), p1 = *(const LAS f32x4*)(part + t * 8 + 4);
                  const float ss = ((p0[0] + p0[1]) + (p0[2] + p0[3])) + ((p1[0] + p1[1]) + (p1[2] + p1[3]));
                  const float rstd = __builtin_amdgcn_rsqf(ss * (1.f / 128.f) + EPS);
                  const bf16 ov = (bf16)f2bf(o[mt][r] * rstd * gv * bf2f(hgv[mt * 4 + r]));
                  bf16* dst = (t < nvalid) ? op + (unsigned)(t * 1024 + lr) : P.dump + F.tid;
                  *dst = ov; } }
        }
        HG_BAR();
        HT1(3);
    }
#pragma unroll
    for (int kb = 0; kb < 8; ++kb)
#pragma unroll
        for (int r = 0; r < 4; ++r) s_out[(size_t)(16 * kb + 4 * lq_ + r) * 128 + 16 * w + lr_] = S[kb][r];
    if constexpr (MODE == 1) { if (w == 0) { f32x2v d; d.x = __expf(bseg.x); d.y = __expf(bseg.y); *(f32x2v*)(dseg + k0_) = d; } }
#ifdef PROBE_HSEC
    if constexpr (MODE == 1) { if (row0 == 0 && h == 0) { const unsigned long long t1 = __builtin_amdgcn_s_memrealtime(); while (__builtin_amdgcn_s_memrealtime() - t1 < 20ull * tacc) __builtin_amdgcn_s_sleep(8); } }
#endif
#undef HT0
#undef HT1
}

__device__ __forceinline__ void hg_fix(Frame& F, const HgPtrs& P, size_t row0, int h, int nchunk, int g, int G, const float* SLseq, const float* DSseq, const bf16* QS, const float* RAW, gu32* mask, float* s_fin) {
    LAS float* part = (LAS float*)(F.lds);
    const int w = __builtin_amdgcn_readfirstlane(F.wave), lr_ = F.lane & 15, lq_ = F.lane >> 4;
    if (F.tid == 0) { const unsigned need = (1u << g) - 1u; unsigned sp = 0;
        while ((__hip_atomic_load(mask, RLX_AGENT) & need) != need) { __builtin_amdgcn_s_sleep(2); if (++sp > (1u << 22)) { __hip_atomic_store(F.ctl + 1, 0x7eb0u, RLX_AGENT); break; } }
        __builtin_amdgcn_fence(__ATOMIC_ACQUIRE, "agent"); asm volatile("s_waitcnt vmcnt(0)" ::: "memory"); }
    __syncthreads();
    f32x4 S[8];
#pragma unroll
    for (int kb = 0; kb < 8; ++kb) S[kb] = (f32x4){0.f, 0.f, 0.f, 0.f};
    for (int p = 0; p < g; ++p) { const float* sl = SLseq + (size_t)p * 16384; const float* ds = DSseq + p * 128;
#pragma unroll
        for (int kb = 0; kb < 8; ++kb) { const f32x4 d = *(const f32x4*)(ds + 16 * kb + 4 * lq_);
#pragma unroll
            for (int r = 0; r < 4; ++r) S[kb][r] = d[r] * S[kb][r] + sl[(size_t)(16 * kb + 4 * lq_ + r) * 128 + 16 * w + lr_]; } }
    if (g == G - 1) { const float* sl = SLseq + (size_t)g * 16384; const float* ds = DSseq + g * 128;
#pragma unroll
        for (int kb = 0; kb < 8; ++kb) { const f32x4 d = *(const f32x4*)(ds + 16 * kb + 4 * lq_);
#pragma unroll
            for (int r = 0; r < 4; ++r) { const size_t o = (size_t)(16 * kb + 4 * lq_ + r) * 128 + 16 * w + lr_; s_fin[o] = d[r] * S[kb][r] + sl[o]; } } }
    bf16x8 bS[4];
#pragma unroll
    for (int kp = 0; kp < 4; ++kp) { v4u t; t.x = cvtpk(S[2 * kp][0], S[2 * kp][1]); t.y = cvtpk(S[2 * kp][2], S[2 * kp][3]); t.z = cvtpk(S[2 * kp + 1][0], S[2 * kp + 1][1]); t.w = cvtpk(S[2 * kp + 1][2], S[2 * kp + 1][3]); bS[kp] = __builtin_bit_cast(bf16x8, t); }
    const float gv = P.ghg[16 * w + lr_];
    f32x4 on[4]; unsigned short hn[16]; v2u qn[4][4][2];
#define HGF_LOAD(cc) do { const size_t cr_ = row0 + (size_t)(cc) * 64; const bf16* hp = P.HGS + cr_ * 1024 + h * 128 + 16 * w; const float* rp = RAW + cr_ * 1024 + h * 128 + 16 * w; \
        _Pragma("unroll") for (int mt = 0; mt < 4; ++mt) { \
            _Pragma("unroll") for (int r = 0; r < 4; ++r) { const unsigned off = (unsigned)((16 * mt + 4 * lq_ + r) * 1024 + lr_); on[mt][r] = rp[off]; hn[mt * 4 + r] = hp[off]; } \
            const bf16* qb = QS + (cr_ + 16 * mt) * 1024 + h * 128; \
            _Pragma("unroll") for (int kp = 0; kp < 4; ++kp) { const bf16* qp = qb + (unsigned)(lr_ * 1024 + 32 * kp + 4 * lq_); qn[mt][kp][0] = *(const v2u*)qp; qn[mt][kp][1] = *(const v2u*)(qp + 16); } } } while (0)
    HGF_LOAD(0);
    for (int c = 0; c < nchunk; ++c) {
        int lr = lr_, lq = lq_; asm volatile("" : "+v"(lr), "+v"(lq)); const int lx = lq * 16 + lr;
        const size_t crow = row0 + (size_t)c * 64;
        LAS float* pt = part + (c & 1) * 512;
        f32x4 o[4]; unsigned short hgv[16];
#pragma unroll
        for (int mt = 0; mt < 4; ++mt) { f32x4 acc = on[mt];
#pragma unroll
            for (int r = 0; r < 4; ++r) hgv[mt * 4 + r] = hn[mt * 4 + r];
#pragma unroll
            for (int kp = 0; kp < 4; ++kp) { v4u a; a.x = qn[mt][kp][0].x; a.y = qn[mt][kp][0].y; a.z = qn[mt][kp][1].x; a.w = qn[mt][kp][1].y; acc = mfma16(__builtin_bit_cast(bf16x8, a), bS[kp], acc); }
            o[mt] = acc; }
        asm volatile("" ::: "memory");
        if (c + 1 < nchunk) HGF_LOAD(c + 1);
        asm volatile("" ::: "memory");
#pragma unroll
        for (int mt = 0; mt < 4; ++mt)
#pragma unroll
            for (int r = 0; r < 4; ++r) { float p = o[mt][r] * o[mt][r]; p += shx(p, 1, lx); p += shx(p, 2, lx); p += shx(p, 4, lx); p += shx(p, 8, lx); if (lr == 0) pt[(16 * mt + 4 * lq + r) * 8 + w] = p; }
        HG_BAR();
        { bf16* op = P.OH + crow * 1024 + h * 128 + 16 * w;
#pragma unroll
          for (int mt = 0; mt < 4; ++mt)
#pragma unroll
              for (int r = 0; r < 4; ++r) { const int t = 16 * mt + 4 * lq + r; const f32x4 p0 = *(const LAS f32x4*)(pt + t * 8), p1 = *(const LAS f32x4*)(pt + t * 8 + 4);
                  const float ss = ((p0[0] + p0[1]) + (p0[2] + p0[3])) + ((p1[0] + p1[1]) + (p1[2] + p1[3]));
                  const float rstd = __builtin_amdgcn_rsqf(ss * (1.f / 128.f) + EPS);
                  op[(unsigned)(t * 1024 + lr)] = (bf16)f2bf(o[mt][r] * rstd * gv * bf2f(hgv[mt * 4 + r])); } }
    }
#undef HGF_LOAD
    __syncthreads();
}
#undef HG_BAR
__device__ __forceinline__ void team_barrier(Frame& F, gu32* w, unsigned target) {
    asm volatile("s_waitcnt vmcnt(0)" ::: "memory");
    __syncthreads();
    if (F.tid == 0) {
        __builtin_amdgcn_fence(__ATOMIC_RELEASE, "agent");
        asm volatile("s_waitcnt vmcnt(0)" ::: "memory");
        (void)__hip_atomic_fetch_add(w, 1u, RLX_AGENT);
        unsigned sp = 0;
        while (__hip_atomic_load(w, RLX_AGENT) < target) { __builtin_amdgcn_s_sleep(2); if (++sp > (1u << 22)) { __hip_atomic_store(F.ctl + 1, 0x7ea0u, RLX_AGENT); break; } }
        __builtin_amdgcn_fence(__ATOMIC_ACQUIRE, "agent");
        asm volatile("s_waitcnt vmcnt(0)" ::: "memory");
    }
    __syncthreads();
}
__device__ __forceinline__ int attn_pull(Frame& F, gu32* q8  , int x0, int nitems) {
    if (F.tid == 0) {
        int res = -1;
        for (int tries = 0; tries < 16; ++tries) {
            unsigned c[8]; unsigned cmin = 0xffffffffu; int imin = 0;
#pragma unroll
            for (int h = 0; h < 8; ++h) { c[h] = __hip_atomic_load(q8 + 64 * h, RLX_AGENT); if (c[h] < cmin) { cmin = c[h]; imin = h; } }
            if (cmin >= (unsigned)nitems) break;
            unsigned cx = c[0];
#pragma unroll
            for (int h = 1; h < 8; ++h) cx = (h == x0) ? c[h] : cx;
            const int hsel = (cx < (unsigned)nitems && cx <= cmin + 6u) ? x0 : imin;
            const unsigned it = __hip_atomic_fetch_add(q8 + 64 * hsel, 1u, RLX_AGENT);
            if (it < (unsigned)nitems) { res = (hsel << 16) | (int)it; break; }
        }
        F.MISC[16] = (unsigned)res;
    }
    __syncthreads();
    const int v = (int)F.MISC[16];
    __syncthreads();
    return __builtin_amdgcn_readfirstlane(v);
}
__device__ __forceinline__ int wg_pull(Frame& F, gu32* ctr) {
    if (F.tid == 0) F.MISC[16] = __hip_atomic_fetch_add(ctr, 1u, RLX_AGENT);
    __syncthreads();
    const int v = (int)F.MISC[16];
    __syncthreads();
    return __builtin_amdgcn_readfirstlane(v);
}
#ifdef PROBE_ID
#define PT_BEGIN(id) unsigned long long pt0_##id = 0; if ((id) == PROBE_ID && blockIdx.x == 0) pt0_##id = __builtin_amdgcn_s_memrealtime()
#define PT_END(id) do { if ((id) == PROBE_ID && blockIdx.x == 0) { const unsigned long long t1 = __builtin_amdgcn_s_memrealtime(), d = t1 - pt0_##id; while (__builtin_amdgcn_s_memrealtime() - t1 < d) __builtin_amdgcn_s_sleep(8); } } while (0)
#else
#define PT_BEGIN(id) do {} while (0)
#define PT_END(id) do {} while (0)
#endif
struct Args { const float* in[25]; float* out; unsigned char* ws; };
__global__ void __launch_bounds__(NWAVES * 64, 2) mk_fwd(Args args) {
    extern __shared__ __attribute__((aligned(16))) unsigned char lds[];
    Frame F;
    F.lds = (LAS unsigned char*)lds;
    F.MISC = (volatile LAS unsigned*)(F.lds + MISC_OFF);
#define ENTER() do { F.tid = opaque_tid(); F.lane = F.tid & 63; F.wave = __builtin_amdgcn_readfirstlane(F.tid >> 6); F.G = gridDim.x; { const int bx = opaque_bid(); F.vcu = (F.G % 8 == 0) ? (bx % 8) * (F.G / 8) + bx / 8 : bx; } } while (0)
    for (int u = threadIdx.x; u < (LDS_BYTES - LDSCTL_OFF) / 4; u += NWAVES * 64) ((LAS unsigned*)(F.lds + LDSCTL_OFF))[u] = 0u;
    __syncthreads();
    tid_table_init();
    __syncthreads();
    static_assert(WTAB_LDS_ADDR == (unsigned)(MISC_OFF + 256) && MISC_OFF + 256 + 256 <= LDS_BYTES, "wave-slot table inside the LDS control area");
    ENTER();
    F.ctl = (gu32*)((unsigned char*)karg(A_WS) + WS_CTL);
    XcdBarrier bar = xcd_barrier_post((unsigned*)(F.ctl + CW_BAR), F.MISC + 8);
#define GRID_BAR() do { asm volatile("" : "+s"(bar.x)); xcd_barrier(bar); } while (0)
#define WSP(T, off) ((T*)((unsigned char*)karg(A_WS) + (off)))
#define OUTP(off) ((float*)karg(A_OUT) + (off))
#define XIN_P (l == 0 ? (const void*)karg(A_XP) : (const void*)WSP(const bf16, WS_X)), (l == 0)
#define XIN_S (l == 0 ? (const void*)(karg(A_XS) - (size_t)MP * DM) : (const void*)WSP(const bf16, WS_X)), (l == 0)

#ifndef NO_P0
    p0_prologue(F, WSP(unsigned char, 0));
#ifdef DUP_P0
    GRID_BAR(); ENTER(); p0_prologue(F, WSP(unsigned char, 0));
#endif
#endif
    GRID_BAR();

    for (int l = 0; l < DEPTH; ++l) {
        const size_t wlo = WS_W + (size_t)l * W_LAYER, modo = WS_MOD + (size_t)l * NSEQ * 9216 * 4;
        if (l == 0) { norm_phase(F, XIN_P, karg(A_GFFN1) + l * 1024, WSP(const float, modo), 0, WSP(bf16, WS_XN), 0, MP, F.vcu * NWAVES + F.wave, 256 * NWAVES);
            GRID_BAR(); ENTER(); }
#ifndef NO_G1
        { pg8::Gemm g{WSP(bf16, WS_XN), WSP(const bf16, wlo + WO_GU1), MP, 2 * DFF, DM}; typedef pg8::FixedOrder<128, 22, 8> Ord; Ord S; S.init(F.G, opaque_bid());
          pg8::EpiSwiglu E{WSP(bf16, WS_BIG)};
          pg8::gemm_phase<pg8::EpiSwiglu, Ord, true, true>(F.lds + RING_OFF, g, S, E);
#ifdef DUP_G1
          GRID_BAR(); ENTER(); pg8::gemm_phase<pg8::EpiSwiglu, Ord, true, true>(F.lds + RING_OFF, g, S, E);
#endif
        }
#endif
        GRID_BAR(); ENTER();
#ifndef NO_G2
        { pg8::Gemm g{WSP(bf16, WS_BIG), WSP(const bf16, wlo + WO_D1), MP, DM, DFF}; typedef pg8::FixedOrder<128, 4, 8> Ord; Ord S; S.init(F.G, opaque_bid());
          pg8::EpiResidNorm E{WSP(unsigned char, 0), WSP(const float, modo), karg(A_GMIX) + l * 1024, 0.5f, (l == 0 ? 1 : 0) | (2 << 1) | (1 << 5) | ((l * 3 + 0) << 8)};
          pg8::gemm_phase<pg8::EpiResidNorm, Ord, true, true>(F.lds + RING_OFF, g, S, E);
        }
#endif
        GRID_BAR(); ENTER();
        PT_BEGIN(2);
#ifndef NO_G3
        { pg8::Gemm g{WSP(bf16, WS_XN), WSP(const bf16, wlo + WO_IN), MP, DIN, DM}; typedef pg8::FixedOrder<128, 36, 8> Ord; Ord S; S.init(F.G, opaque_bid());
          pg8::EpiWin E{WSP(unsigned char, 0), OUTP(0), l, attn_body::C2};
          pg8::gemm_phase<pg8::EpiWin, Ord, true, true>(F.lds + RING_OFF, g, S, E);
#ifdef PROBE_G3NULL
          GRID_BAR(); ENTER(); PT_BEGIN(3); { float* sk_ = nullptr; asm volatile("" : "+s"(sk_)); pg8::EpiNull E0{sk_}; pg8::gemm_phase<pg8::EpiNull, Ord, true, true>(F.lds + RING_OFF, g, S, E0); } GRID_BAR(); ENTER(); PT_END(3);
#endif
        }
#endif
        GRID_BAR(); ENTER();
        PT_END(2);
        PT_BEGIN(1);
        { gu32* qbase = F.ctl + CW_Q + 64 * (l * 16);
          const int tk = wg_pull(F, qbase + 64 * 9);
#ifdef PROBE_ROLE
          const unsigned long long pr0 = __builtin_amdgcn_s_memrealtime();
#endif
          constexpr int T_EFF = T_TEAM;
          const bool team = (tk % TEAM_STRIDE) == 0, hfirst = (tk % TEAM_STRIDE) >= 1 && (tk % TEAM_STRIDE) <= STARTERS; const int ticket = tk / TEAM_STRIDE; gu32* tb = qbase + 64 * 10; unsigned tstage = 0;
#define TEAM_BAR() do { ++tstage; team_barrier(F, tb, (unsigned)T_EFF * tstage); ENTER(); } while (0)
#ifndef NO_TEAM
          if (team) {
              const int tgw = ticket * NWAVES + F.wave, TNW = T_EFF * NWAVES;
              norm_phase(F, XIN_S, karg(A_GFFN1) + l * 1024, WSP(const float, modo), 0, WSP(bf16, WS_XN), MP, MROWS, tgw, TNW);
              TEAM_BAR();
              { pg8::Gemm g{WSP(bf16, WS_XN), WSP(const bf16, wlo + WO_GU1), MROWS, 2 * DFF, DM}; typedef pg8::TeamOrder<22> Ord; Ord S; S.init(T_EFF, ticket);
                pg8::EpiSwiglu E{WSP(bf16, WS_BIG)};
                pg8::gemm_phase<pg8::EpiSwiglu, Ord, true, true>(F.lds + RING_OFF, g, S, E); }
              TEAM_BAR();
              { pg8::Gemm g{WSP(bf16, WS_BIG), WSP(const bf16, wlo + WO_D1), MROWS, DM, DFF}; typedef pg8::TeamOrder<4> Ord; Ord S; S.init(T_EFF, ticket);
                pg8::EpiResid E{WSP(bf16, WS_X), WSP(const float, modo) + 2 * 1024, 0.5f, l == 0 ? 2 : 0};
                pg8::gemm_phase<pg8::EpiResid, Ord, true, true>(F.lds + RING_OFF, g, S, E); }
              TEAM_BAR();
              norm_phase(F, WSP(const bf16, WS_X), false, karg(A_GMIX) + l * 1024, WSP(const float, modo), 1, WSP(bf16, WS_XN), MP, MROWS, ticket * NWAVES + F.wave, T_EFF * NWAVES);
              TEAM_BAR();
              { pg8::Gemm g{WSP(bf16, WS_XN), WSP(const bf16, wlo + WO_IN), MROWS, DIN, DM}; typedef pg8::TeamOrder<36> Ord; Ord S; S.init(T_EFF, ticket);
                pg8::EpiWin E{WSP(unsigned char, 0), OUTP(0), l, attn_body::C2};
                pg8::gemm_phase<pg8::EpiWin, Ord, true, true>(F.lds + RING_OFF, g, S, E); }
              TEAM_BAR();
          }
#endif
          if (hfirst) {
            for (;;) { const int it = wg_pull(F, qbase); if (it >= 32 * HG_G) break;
              const HgPtrs P{WSP(const float, WS_LOGF), WSP(const bf16, WS_QQ), WSP(const bf16, WS_KK), WSP(const bf16, WS_VV), WSP(const bf16, WS_HGS), karg(A_GHG) + l * 128, WSP(bf16, WS_OH), WSP(bf16, WS_DD)};
#ifndef NO_H
                  const int sqh = it / HG_G, g = it % HG_G, b = sqh >> 3, h = sqh & 7; const int nch = 128 / HG_G;
                  const size_t r0 = (size_t)b * 8192 + (size_t)g * nch * 64;
                  float* SLq = WSP(float, WS_SL) + (size_t)sqh * HG_G * 16384; float* DSq = WSP(float, WS_DSEG) + (size_t)sqh * HG_G * 128;
                  gu32* mask = F.ctl + CW_HS + 64 * (l * 32 + sqh);
                  hg_sequence<1>(F, P, r0, h, nch, 64, nullptr, SLq + (size_t)g * 16384, WSP(bf16, WS_QS), WSP(float, WS_RAW), DSq + g * 128);
                  asm volatile("s_waitcnt vmcnt(0)" ::: "memory"); __syncthreads();
                  if (F.tid == 0) { __builtin_amdgcn_fence(__ATOMIC_RELEASE, "agent"); asm volatile("s_waitcnt vmcnt(0)" ::: "memory"); (void)__hip_atomic_fetch_or(mask, 1u << g, RLX_AGENT); }
                  ENTER();
                  hg_fix(F, P, r0, h, nch, g, HG_G, SLq, DSq, WSP(const bf16, WS_QS), WSP(const float, WS_RAW), mask, OUTP(0) + OS_P + ((size_t)((l * 4 + b) * 8 + h)) * 16384);
                  ENTER();
#endif
            }
            if (F.tid == 0) { unsigned sp = 0; while (__hip_atomic_load(tb, RLX_AGENT) < (unsigned)T_EFF * 5u) { __builtin_amdgcn_s_sleep(2); if (++sp > (1u << 22)) { __hip_atomic_store(F.ctl + 1, 0x7ec0u, RLX_AGENT); break; } }
                __builtin_amdgcn_fence(__ATOMIC_ACQUIRE, "agent"); asm volatile("s_waitcnt vmcnt(0)" ::: "memory"); }
            __syncthreads(); ENTER();
          }
          if (team || hfirst) {
            gu32* qs = qbase + 64 * 11; gu32* done = qbase + 64 * 12;
            for (;;) { const int it = wg_pull(F, qs); if (it >= 256) break;
              const HgPtrs P{WSP(const float, WS_LOGF), WSP(const bf16, WS_QQ), WSP(const bf16, WS_KK), WSP(const bf16, WS_VV), WSP(const bf16, WS_HGS), karg(A_GHG) + l * 128, WSP(bf16, WS_OH), WSP(bf16, WS_DD)};
              if (it < 128) {
#ifndef NO_H
                  const int sq = it >> 3, h = it & 7; const size_t so = OS_S + ((size_t)((l * 16 + sq) * 8 + h)) * 16384;
                  hg_sequence<0>(F, P, (size_t)MP + (size_t)sq * 32, h, 1, 32, karg(A_ST) + ((size_t)((l * 16 + sq) * 8 + h)) * 16384, OUTP(0) + so, nullptr, nullptr, nullptr);
#endif
              } else {
#ifndef NO_SAMP
                  const int u = it - 128; const float lam = lam_of(karg(A_LAM), l, F.lane), osc = 1.f - lam_init_of(l);
                  attn_sample_unit(F, karg(A_CK), karg(A_CV), l, u >> 3, u & 7, WSP(const bf16, WS_Q), WSP(const bf16, WS_K), WSP(const bf16, WS_V), lam, osc, karg(A_GSUB) + l * 128, WSP(bf16, WS_OATT));
#endif
              }
              asm volatile("s_waitcnt vmcnt(0)" ::: "memory"); __syncthreads();
              if (F.tid == 0) { __builtin_amdgcn_fence(__ATOMIC_RELEASE, "agent"); asm volatile("s_waitcnt vmcnt(0)" ::: "memory"); (void)__hip_atomic_fetch_add(done, 1u, RLX_AGENT); }
              ENTER(); }
            if (team) {
                if (F.tid == 0) { unsigned sp = 0; while (__hip_atomic_load(done, RLX_AGENT) < 256u) { __builtin_amdgcn_s_sleep(2); if (++sp > (1u << 22)) { __hip_atomic_store(F.ctl + 1, 0x7ed0u, RLX_AGENT); break; } }
                    __builtin_amdgcn_fence(__ATOMIC_ACQUIRE, "agent"); asm volatile("s_waitcnt vmcnt(0)" ::: "memory"); }
                __syncthreads(); ENTER(); } }
#ifndef NO_TEAM
          if (team) {
              { pg8::Gemm g{WSP(bf16, WS_OATT), WSP(const bf16, wlo + WO_BA), MROWS, DM, DM}; typedef pg8::TeamOrder<4> Ord; Ord S; S.init(T_EFF, ticket);
                pg8::EpiGateT E{WSP(bf16, WS_LOGF), WSP(const bf16, WS_SZA)};
                pg8::gemm_phase<pg8::EpiGateT, Ord, true, true>(F.lds + RING_OFF, g, S, E); }
              TEAM_BAR();
              { pg8::Gemm g{WSP(bf16, WS_OH), WSP(const bf16, wlo + WO_BH), MROWS, DM, DM}; typedef pg8::TeamOrder<4> Ord; Ord S; S.init(T_EFF, ticket);
                pg8::EpiGateM E{WSP(const bf16, WS_LOGF), WSP(const bf16, WS_SZH), WSP(bf16, WS_MRG)};
                pg8::gemm_phase<pg8::EpiGateM, Ord, true, true>(F.lds + RING_OFF, g, S, E); }
              TEAM_BAR();
              { pg8::Gemm g{WSP(bf16, WS_MRG), WSP(const bf16, wlo + WO_OUT), MROWS, DM, DM}; typedef pg8::TeamOrder<4> Ord; Ord S; S.init(T_EFF, ticket);
                pg8::EpiResid E{WSP(bf16, WS_X), WSP(const float, modo) + 5 * 1024, 1.0f, 0};
                pg8::gemm_phase<pg8::EpiResid, Ord, true, true>(F.lds + RING_OFF, g, S, E); }
              TEAM_BAR();
              norm_phase(F, WSP(const bf16, WS_X), false, karg(A_GFFN2) + l * 1024, WSP(const float, modo), 2, WSP(bf16, WS_XN), MP, MROWS, ticket * NWAVES + F.wave, T_EFF * NWAVES);
              TEAM_BAR();
              { pg8::Gemm g{WSP(bf16, WS_XN), WSP(const bf16, wlo + WO_GU2), MROWS, 2 * DFF, DM}; typedef pg8::TeamOrder<22> Ord; Ord S; S.init(T_EFF, ticket);
                pg8::EpiSwiglu E{WSP(bf16, WS_BIG)};
                pg8::gemm_phase<pg8::EpiSwiglu, Ord, true, true>(F.lds + RING_OFF, g, S, E); }
              TEAM_BAR();
              { pg8::Gemm g{WSP(bf16, WS_BIG), WSP(const bf16, wlo + WO_D2), MROWS, DM, DFF}; typedef pg8::TeamOrder<4> Ord; Ord S; S.init(T_EFF, ticket);
                pg8::EpiResid E{WSP(bf16, WS_X), WSP(const float, modo) + 8 * 1024, 0.5f, 0};
                pg8::gemm_phase<pg8::EpiResid, Ord, true, true>(F.lds + RING_OFF, g, S, E); }
              ENTER();
          }
#endif
#ifndef NO_ATT
          { const attn_body::bf16* Qb = WSP(const attn_body::bf16, WS_Q); const attn_body::bf16* Kb = WSP(const attn_body::bf16, WS_K); const attn_body::bf16* Vb = WSP(const attn_body::bf16, WS_V); attn_body::bf16* O1 = WSP(attn_body::bf16, WS_O1);
            const int x0 = (int)(xb_xcc_id() & 7u);
            for (;;) { const int pk = attn_pull(F, qbase + 64, x0, 256); if (pk < 0) break;
                const int head = pk >> 16, it = pk & 0xffff, b = it >> 6, r = it & 63, qb = 31 - (r >> 1), mp = r & 1;
                attn_body::attn_unit128<8>(b, head * 2 + mp, head * 2, qb, Qb, Kb, Vb, O1 + (size_t)mp * ((WS_O2 - WS_O1) / 2), (char*)lds + RING_OFF); } }
#endif
#undef TEAM_BAR
#ifdef PROBE_ROLE
          if (tk == PROBE_ROLE) { const unsigned long long t1 = __builtin_amdgcn_s_memrealtime(), d = t1 - pr0; while (__builtin_amdgcn_s_memrealtime() - t1 < d) __builtin_amdgcn_s_sleep(8); }
#endif
        }
        GRID_BAR(); ENTER();
        PT_END(1);
        { const float lam = lam_of(karg(A_LAM), l, F.lane), osc = 1.f - lam_init_of(l);
          attn_combine_phase(F, WSP(const bf16, WS_O1), WSP(const bf16, WS_O2), karg(A_GSUB) + l * 128, lam, osc, WSP(bf16, WS_OATT));
#ifdef DUP_THIN
          GRID_BAR(); ENTER();
          attn_combine_phase(F, WSP(const bf16, WS_O1), WSP(const bf16, WS_O2), karg(A_GSUB) + l * 128, lam, osc, WSP(bf16, WS_OATT));
#endif
        }
        GRID_BAR(); ENTER();
#ifndef NO_G4
        { pg8::Gemm g{WSP(bf16, WS_OATT), WSP(const bf16, wlo + WO_BA), MP, DM, DM}; typedef pg8::FixedOrder<128, 4, 8> Ord; Ord S; S.init(F.G, opaque_bid());
          pg8::EpiGateT E{WSP(bf16, WS_LOGF), WSP(const bf16, WS_SZA)};
          pg8::gemm_phase<pg8::EpiGateT, Ord, true, true>(F.lds + RING_OFF, g, S, E);
#ifdef DUP_THIN
          GRID_BAR(); ENTER(); pg8::gemm_phase<pg8::EpiGateT, Ord, true, true>(F.lds + RING_OFF, g, S, E);
#endif
        }
#endif
        GRID_BAR(); ENTER();
#ifndef NO_G5
        { pg8::Gemm g{WSP(bf16, WS_OH), WSP(const bf16, wlo + WO_BH), MP, DM, DM}; typedef pg8::FixedOrder<128, 4, 8> Ord; Ord S; S.init(F.G, opaque_bid());
          pg8::EpiGateM E{WSP(const bf16, WS_LOGF), WSP(const bf16, WS_SZH), WSP(bf16, WS_MRG)};
          pg8::gemm_phase<pg8::EpiGateM, Ord, true, true>(F.lds + RING_OFF, g, S, E);
#ifdef DUP_THIN
          GRID_BAR(); ENTER(); pg8::gemm_phase<pg8::EpiGateM, Ord, true, true>(F.lds + RING_OFF, g, S, E);
#endif
        }
#endif
        GRID_BAR(); ENTER();
#ifndef NO_G6
        { pg8::Gemm g{WSP(bf16, WS_MRG), WSP(const bf16, wlo + WO_OUT), MP, DM, DM}; typedef pg8::FixedOrder<128, 4, 8> Ord; Ord S; S.init(F.G, opaque_bid());
          pg8::EpiResidNorm E{WSP(unsigned char, 0), WSP(const float, modo), karg(A_GFFN2) + l * 1024, 1.0f, (5 << 1) | (2 << 5) | ((l * 3 + 1) << 8)};
          pg8::gemm_phase<pg8::EpiResidNorm, Ord, true, true>(F.lds + RING_OFF, g, S, E);
        }
#endif
        GRID_BAR(); ENTER();
#ifndef NO_G7
        { pg8::Gemm g{WSP(bf16, WS_XN), WSP(const bf16, wlo + WO_GU2), MP, 2 * DFF, DM}; typedef pg8::FixedOrder<128, 22, 8> Ord; Ord S; S.init(F.G, opaque_bid());
          pg8::EpiSwiglu E{WSP(bf16, WS_BIG)};
          pg8::gemm_phase<pg8::EpiSwiglu, Ord, true, true>(F.lds + RING_OFF, g, S, E); }
#endif
        GRID_BAR(); ENTER();
#ifndef NO_G8
        { pg8::Gemm g{WSP(bf16, WS_BIG), WSP(const bf16, wlo + WO_D2), MP, DM, DFF}; typedef pg8::FixedOrder<128, 4, 8> Ord; Ord S; S.init(F.G, opaque_bid());
          if (l + 1 < DEPTH) {
              pg8::EpiResidNorm E{WSP(unsigned char, 0), WSP(const float, modo), karg(A_GFFN1) + (l + 1) * 1024, 0.5f, (8 << 1) | (0 << 5) | (1 << 7) | ((l * 3 + 2) << 8)};
              pg8::gemm_phase<pg8::EpiResidNorm, Ord, true, true>(F.lds + RING_OFF, g, S, E);
          } else {
              pg8::EpiResid E{WSP(bf16, WS_X), WSP(const float, modo) + 8 * 1024, 0.5f, 0};
              pg8::gemm_phase<pg8::EpiResid, Ord, true, true>(F.lds + RING_OFF, g, S, E); }
        }
#endif
        GRID_BAR(); ENTER();
    }
    final_norm_phase(F, WSP(const bf16, WS_X), karg(A_GFIN), OUTP(0));
#undef GRID_BAR
#undef ENTER
#undef WSP
#undef OUTP
}

extern "C" void kernel_launch(void* const* d_in, const int* in_sizes, int n_in, void* d_out, int out_size, void* d_ws, size_t ws_size, hipStream_t stream) {
    static int grid = 0;
    if (grid == 0) {
        if (n_in != 25 || (size_t)out_size != OUT_TOTAL || ws_size < WS_END) { fprintf(stderr, "kernel_launch: unexpected sizes: n_in %d out %d ws %zu (need %zu)\n", n_in, out_size, ws_size, (size_t)WS_END); grid = -1; return; }
        int dev = 0, cus = 0, per_cu = 0;
        if (hipGetDevice(&dev) != hipSuccess || hipDeviceGetAttribute(&cus, hipDeviceAttributeMultiprocessorCount, dev) != hipSuccess) { grid = -1; return; }
        if (hipFuncSetAttribute((const void*)mk_fwd, hipFuncAttributeMaxDynamicSharedMemorySize, LDS_BYTES) != hipSuccess) { fprintf(stderr, "kernel_launch: hipFuncSetAttribute failed\n"); grid = -1; return; }
        if (hipOccupancyMaxActiveBlocksPerMultiprocessor(&per_cu, (const void*)mk_fwd, NWAVES * 64, LDS_BYTES) != hipSuccess || per_cu < 1) { fprintf(stderr, "kernel_launch: occupancy query reports %d\n", per_cu); }
        (void)hipGetLastError();
        grid = cus;
        if (grid != 256) { fprintf(stderr, "kernel_launch: built for a 256-CU device (team size, row split and work queues assume 256 workgroups); found %d CUs; nothing launched\n", cus); grid = -1; return; }
    }
    if (grid < 0) return;
    if (hipMemsetAsync((char*)d_ws + WS_CTL, 0, CTL_ZERO_BYTES, stream) != hipSuccess) return;
    Args a{};
    for (int i = 0; i < 25; ++i) a.in[i] = (const float*)d_in[i];
    a.out = (float*)d_out; a.ws = (unsigned char*)d_ws;
    hipLaunchKernelGGL(mk_fwd, dim3(grid), dim3(NWAVES * 64), LDS_BYTES, stream, a);
    (void)in_sizes;
}
```
